# Optimizing an MI355X kernel written in HIP

```python
import jax, jax.numpy as jnp
from jax import lax
import numpy as np

D_MODEL = 4096
BATCH = 1
SEQ = 16384
DEPTH = 1

MIX_WIDTH = D_MODEL
POOL_WIDTH = D_MODEL // 4
POOL_WINDOWS = (2, 4, 8, 16)
POOL_GROUPS = len(POOL_WINDOWS)
POOL_GROUP_DIM = POOL_WIDTH // POOL_GROUPS
HEAD_DIM = 128
N_HEADS = (MIX_WIDTH - POOL_WIDTH) // HEAD_DIM
N_KV = 4
HPG = N_HEADS // N_KV
KV_WIDTH = N_KV * HEAD_DIM
ROT_DIM = HEAD_DIM // 4
ROPE_THETA = 500000.0
CMP_LEN = 32
CMP_STRIDE = 16
CMP_HIDDEN = 256
SLC_LEN = 64
SLC_TOPK = 16
WIN = 512
Q_BLOCK = 128
D_FF = 11008
CONV_W = 3
PLE_DIM = 256
EPS = 1e-6
NEG = -1e30
BIG = 1e9
OFF_Q = POOL_WIDTH
OFF_KV = OFF_Q + N_HEADS * HEAD_DIM
OFF_G = OFF_KV + 6 * KV_WIDTH
IN_WIDTH = OFF_G + 3 * N_HEADS

kernel_name = "hymba_pool_nsa_convffn_ple"


def rms_norm(x, w):
    xf = x.astype(jnp.float32)
    y = xf * lax.rsqrt(jnp.mean(xf * xf, axis=-1, keepdims=True) + EPS)
    return (y * w.astype(jnp.float32)).astype(x.dtype)


def rope_partial(x, pos):
    half = ROT_DIM // 2
    inv = ROPE_THETA ** (-jnp.arange(0, ROT_DIM, 2, dtype=jnp.float32) / ROT_DIM)
    ang = pos.astype(jnp.float32)[..., None] * inv
    cos = jnp.cos(ang)[:, :, None, :].astype(x.dtype)
    sin = jnp.sin(ang)[:, :, None, :].astype(x.dtype)
    x1 = x[..., :half]
    x2 = x[..., half:ROT_DIM]
    return jnp.concatenate([x1 * cos - x2 * sin, x2 * cos + x1 * sin, x[..., ROT_DIM:]], axis=-1)


def masked_softmax(s, mask):
    s = jnp.where(mask, s.astype(jnp.float32), NEG)
    return jax.nn.softmax(s, axis=-1) * mask.astype(jnp.float32)


def pool_mixer(u, w_pool, scale):
    B, S, _ = u.shape
    ug = u.reshape(B, S, POOL_GROUPS, POOL_GROUP_DIM).astype(jnp.float32)
    t1 = jnp.arange(1, S + 1, dtype=jnp.float32)
    outs = []
    for gi, w in enumerate(POOL_WINDOWS):
        ch = ug[:, :, gi]
        c = jnp.cumsum(ch, axis=1)
        prev = jnp.pad(c, ((0, 0), (w, 0), (0, 0)))[:, :S]
        cnt = jnp.minimum(t1, float(w))[None, :, None]
        outs.append((c - prev) / cnt - ch)
    m = jnp.stack(outs, axis=2).astype(u.dtype)
    y = jnp.einsum("bsgc,gcd->bsgd", m, w_pool).reshape(B, S, POOL_WIDTH)
    return y * scale


def compress_blocks(kv, pos_emb, w1, w2):
    B, S = kv.shape[:2]
    n_cmp = (S - CMP_LEN) // CMP_STRIDE + 1
    idx = jnp.arange(n_cmp)[:, None] * CMP_STRIDE + jnp.arange(CMP_LEN)[None, :]
    blocks = kv[:, idx] + pos_emb[None, None, :, None, :]
    blocks = blocks.transpose(0, 1, 3, 2, 4).reshape(B, n_cmp, N_KV, CMP_LEN * HEAD_DIM)
    return jax.nn.gelu(blocks @ w1) @ w2


def nsa_attention(q, k_cmp, v_cmp, k_slc, v_slc, k_win, v_win, gates):
    B, S = q.shape[:2]
    n_cmp = k_cmp.shape[1]
    n_slc = S // SLC_LEN
    topk = min(SLC_TOPK, n_slc)
    r = SLC_LEN // CMP_STRIDE
    c = CMP_LEN // CMP_STRIDE
    scale = HEAD_DIM ** -0.5
    cmp_end = jnp.arange(n_cmp) * CMP_STRIDE + CMP_LEN - 1
    kb = k_slc.reshape(B, n_slc, SLC_LEN, N_KV, HEAD_DIM).transpose(0, 3, 1, 2, 4)
    vb = v_slc.reshape(B, n_slc, SLC_LEN, N_KV, HEAD_DIM).transpose(0, 3, 1, 2, 4)
    kw = jnp.pad(k_win, ((0, 0), (WIN, 0), (0, 0), (0, 0)))
    vw = jnp.pad(v_win, ((0, 0), (WIN, 0), (0, 0), (0, 0)))
    bi = jnp.arange(B)[:, None, None, None]
    gi = jnp.arange(N_KV)[None, :, None, None]
    blk_ids = jnp.arange(n_slc)
    pad_imp = r * n_slc + 4 - n_cmp

    def block(qb):
        s0 = qb * Q_BLOCK
        t = s0 + jnp.arange(Q_BLOCK)
        qx = lax.dynamic_slice_in_dim(q, s0, Q_BLOCK, axis=1).reshape(B, Q_BLOCK, N_KV, HPG, HEAD_DIM)
        s_c = jnp.einsum("bqghd,bngd->bghqn", qx, k_cmp) * scale
        p_c = masked_softmax(s_c, cmp_end[None, :] <= t[:, None])
        o_c = jnp.einsum("bghqn,bngd->bqghd", p_c.astype(v_cmp.dtype), v_cmp)
        imp = jnp.pad(p_c.sum(axis=2), ((0, 0), (0, 0), (0, 0), (0, pad_imp)))
        imp_slc = jnp.zeros(imp.shape[:3] + (n_slc,), jnp.float32)
        for m in range(r):
            for n in range(c):
                o = m + n
                imp_slc = imp_slc + imp[..., o:o + r * n_slc:r]
        cur = (t // SLC_LEN)[:, None]
        jj = blk_ids[None, :]
        forced = (jj == 0) | (jj == cur) | (jj == cur - 1)
        sel = jnp.where(jj > cur, NEG, jnp.where(forced, BIG, imp_slc))
        _, idx = lax.top_k(sel, topk)
        ks = kb[bi, gi, idx].reshape(B, N_KV, Q_BLOCK, topk * SLC_LEN, HEAD_DIM)
        vs = vb[bi, gi, idx].reshape(B, N_KV, Q_BLOCK, topk * SLC_LEN, HEAD_DIM)
        kpos = (idx[..., None] * SLC_LEN + jnp.arange(SLC_LEN)).reshape(B, N_KV, 1, Q_BLOCK, topk * SLC_LEN)
        s_s = jnp.einsum("bqghd,bgqkd->bghqk", qx, ks) * scale
        p_s = masked_softmax(s_s, kpos <= t[None, None, None, :, None])
        o_s = jnp.einsum("bghqk,bgqkd->bqghd", p_s.astype(vs.dtype), vs)
        kband = lax.dynamic_slice_in_dim(kw, s0, WIN + Q_BLOCK, axis=1)
        vband = lax.dynamic_slice_in_dim(vw, s0, WIN + Q_BLOCK, axis=1)
        kp = s0 - WIN + jnp.arange(WIN + Q_BLOCK)
        m_w = (kp[None, :] <= t[:, None]) & (kp[None, :] > t[:, None] - WIN) & (kp[None, :] >= 0)
        s_w = jnp.einsum("bqghd,bkgd->bghqk", qx, kband) * scale
        p_w = masked_softmax(s_w, m_w)
        o_w = jnp.einsum("bghqk,bkgd->bqghd", p_w.astype(vband.dtype), vband)
        g = lax.dynamic_slice_in_dim(gates, s0, Q_BLOCK, axis=1)
        shp = (B, Q_BLOCK, N_HEADS, HEAD_DIM)
        out = (g[..., 0:1] * o_c.reshape(shp) + g[..., 1:2] * o_s.reshape(shp)
               + g[..., 2:3] * o_w.reshape(shp))
        return out.reshape(B, Q_BLOCK, N_HEADS * HEAD_DIM)

    out = lax.map(block, jnp.arange(S // Q_BLOCK))
    return out.transpose(1, 0, 2, 3).reshape(B, S, N_HEADS * HEAD_DIM)


def causal_dwconv(a, w, b):
    S = a.shape[1]
    ap = jnp.pad(a, ((0, 0), (CONV_W - 1, 0), (0, 0)))
    y = b
    for k in range(CONV_W):
        y = y + ap[:, k:k + S] * w[k]
    return y


def setup_inputs(seed: int = 0) -> dict:
    key = jax.random.key(seed)
    ks = jax.random.split(key, 32)

    def nrm(k, shape, s):
        return jax.random.normal(k, shape, jnp.float32) * s

    def gain(k, shape):
        return 1.0 + 0.02 * jax.random.normal(k, shape, jnp.float32)

    L = DEPTH
    return {
        "x": nrm(ks[0], (BATCH, SEQ, D_MODEL), 1.0),
        "p": nrm(ks[1], (DEPTH, BATCH, SEQ, PLE_DIM), 1.0),
        "positions": jnp.broadcast_to(jnp.arange(SEQ, dtype=jnp.int32)[None, :], (BATCH, SEQ)),
        "norm1_w": gain(ks[2], (L, D_MODEL)),
        "w_in": nrm(ks[3], (L, D_MODEL, IN_WIDTH), D_MODEL ** -0.5),
        "w_pool": nrm(ks[4], (L, POOL_GROUPS, POOL_GROUP_DIM, POOL_GROUP_DIM), POOL_GROUP_DIM ** -0.5),
        "pool_scale": gain(ks[5], (L, POOL_WIDTH)),
        "q_norm_w": gain(ks[6], (L, HEAD_DIM)),
        "k_norm_cmp_w": gain(ks[7], (L, HEAD_DIM)),
        "k_norm_slc_w": gain(ks[8], (L, HEAD_DIM)),
        "k_norm_win_w": gain(ks[9], (L, HEAD_DIM)),
        "cmp_pos_k": nrm(ks[10], (L, CMP_LEN, HEAD_DIM), 0.02),
        "cmp_pos_v": nrm(ks[11], (L, CMP_LEN, HEAD_DIM), 0.02),
        "cmp_k_w1": nrm(ks[12], (L, CMP_LEN * HEAD_DIM, CMP_HIDDEN), (CMP_LEN * HEAD_DIM) ** -0.5),
        "cmp_k_w2": nrm(ks[13], (L, CMP_HIDDEN, HEAD_DIM), CMP_HIDDEN ** -0.5),
        "cmp_v_w1": nrm(ks[14], (L, CMP_LEN * HEAD_DIM, CMP_HIDDEN), (CMP_LEN * HEAD_DIM) ** -0.5),
        "cmp_v_w2": nrm(ks[15], (L, CMP_HIDDEN, HEAD_DIM), CMP_HIDDEN ** -0.5),
        "w_o": nrm(ks[16], (L, MIX_WIDTH, D_MODEL), MIX_WIDTH ** -0.5),
        "norm2_w": gain(ks[17], (L, D_MODEL)),
        "w_ffn_in": nrm(ks[18], (L, D_MODEL, 2 * D_FF), D_MODEL ** -0.5),
        "conv_w": nrm(ks[19], (L, CONV_W, D_FF), CONV_W ** -0.5),
        "conv_b": nrm(ks[20], (L, D_FF), 0.01),
        "w_ffn_out": nrm(ks[21], (L, D_FF, D_MODEL), D_FF ** -0.5),
        "w_ple_proj": nrm(ks[22], (L, PLE_DIM, D_MODEL), PLE_DIM ** -0.5),
        "ple_norm_w": gain(ks[23], (L, D_MODEL)),
        "ple_gate_norm_w": gain(ks[24], (L, D_MODEL)),
        "w_ple_gate": nrm(ks[25], (L, D_MODEL, D_MODEL), D_MODEL ** -0.5),
    }


def reference(x, p, positions, norm1_w, w_in, w_pool, pool_scale, q_norm_w, k_norm_cmp_w, k_norm_slc_w,
              k_norm_win_w, cmp_pos_k, cmp_pos_v, cmp_k_w1, cmp_k_w2, cmp_v_w1, cmp_v_w2, w_o, norm2_w,
              w_ffn_in, conv_w, conv_b, w_ffn_out, w_ple_proj, ple_norm_w, ple_gate_norm_w, w_ple_gate):
    B, S, _ = x.shape
    n_cmp = (S - CMP_LEN) // CMP_STRIDE + 1
    cmp_end = jnp.arange(n_cmp) * CMP_STRIDE + CMP_LEN - 1
    pos_cmp = positions[:, cmp_end]
    h = x
    for i in range(DEPTH):
        xn = rms_norm(h, norm1_w[i])
        z = xn @ w_in[i]

        def kv(j):
            return z[..., OFF_KV + j * KV_WIDTH:OFF_KV + (j + 1) * KV_WIDTH].reshape(B, S, N_KV, HEAD_DIM)

        u = z[..., :POOL_WIDTH]
        q = z[..., OFF_Q:OFF_KV].reshape(B, S, N_HEADS, HEAD_DIM)
        q = rope_partial(rms_norm(q, q_norm_w[i]), positions)
        kc = compress_blocks(kv(0), cmp_pos_k[i], cmp_k_w1[i], cmp_k_w2[i])
        kc = rope_partial(rms_norm(kc, k_norm_cmp_w[i]), pos_cmp)
        vc = compress_blocks(kv(1), cmp_pos_v[i], cmp_v_w1[i], cmp_v_w2[i])
        k_s = rope_partial(rms_norm(kv(2), k_norm_slc_w[i]), positions)
        v_s = kv(3)
        k_w = rope_partial(rms_norm(kv(4), k_norm_win_w[i]), positions)
        v_w = kv(5)
        gates = jax.nn.sigmoid(z[..., OFF_G:].astype(jnp.float32)).astype(x.dtype).reshape(B, S, N_HEADS, 3)
        o_attn = nsa_attention(q, kc, vc, k_s, v_s, k_w, v_w, gates)
        o_pool = pool_mixer(u, w_pool[i], pool_scale[i])
        h = h + jnp.concatenate([o_pool, o_attn], axis=-1) @ w_o[i]
        hn = rms_norm(h, norm2_w[i])
        ab = hn @ w_ffn_in[i]
        a = causal_dwconv(ab[..., :D_FF], conv_w[i], conv_b[i])
        h = h + (jax.nn.silu(a) * ab[..., D_FF:]) @ w_ffn_out[i]
        e = rms_norm(p[i] @ w_ple_proj[i], ple_norm_w[i])
        g = jax.nn.sigmoid(rms_norm(h, ple_gate_norm_w[i]) @ w_ple_gate[i])
        h = h + e * g
    return h
```

```cpp
#include <hip/hip_runtime.h>
#include <cstdio>
#include <cstdint>

#ifndef MK_ONE_LAUNCH
#define MK_ONE_LAUNCH 1
#endif

#define LAS __attribute__((address_space(3)))
typedef unsigned short bf16_t;
typedef short bf16x8 __attribute__((ext_vector_type(8)));
typedef short s16x4 __attribute__((ext_vector_type(4)));
typedef float f32x2 __attribute__((ext_vector_type(2)));
typedef float f32x4 __attribute__((ext_vector_type(4)));
typedef float f32x16 __attribute__((ext_vector_type(16)));
typedef unsigned u32x2 __attribute__((ext_vector_type(2)));
typedef unsigned u32x4 __attribute__((ext_vector_type(4)));

constexpr int S_ = 16384, DM = 4096, INW = 7240, LDZ = 7424, POOLW = 1024, NH = 24, NKV = 4, HPG = 6, HD = 128;
constexpr int OFF_Q = 1024, OFF_KV = 4096, OFF_G = 7168, DFF = 11008, NFI = 22016, PLE = 256, NGATE = 72;
constexpr int ZROWS = S_ + 64, XNROWS = S_ + 256, CHUNK = 8192;
constexpr float EPS = 1e-6f;
constexpr float SM_C = 0.08838834764831845f * 1.4426950408889634f;
constexpr int NWAVES = 8, NTHREADS = 512;

constexpr size_t al256(size_t x) { return (x + 255) / 256 * 256; }
constexpr size_t WS_CTL   = 0;
constexpr size_t CTL_BYTES = 65536;
constexpr size_t WS_WIN   = WS_CTL + CTL_BYTES;
constexpr size_t WS_WO    = WS_WIN + al256((size_t)LDZ * DM * 2);
constexpr size_t WS_WFI   = WS_WO + al256((size_t)DM * DM * 2);
constexpr size_t WS_WFO   = WS_WFI + al256((size_t)NFI * DM * 2);
constexpr size_t WS_WG    = WS_WFO + al256((size_t)DM * DFF * 2);
constexpr size_t WS_WPLE  = WS_WG + al256((size_t)DM * DM * 2);
constexpr size_t WS_WPOOL = WS_WPLE + al256((size_t)DM * PLE * 2);
constexpr size_t WS_WC1K  = WS_WPOOL + al256((size_t)1024 * 256 * 2);
constexpr size_t WS_WC1V  = WS_WC1K + al256((size_t)256 * 4096 * 2);
constexpr size_t WS_COS   = WS_WC1V + al256((size_t)256 * 4096 * 2);
constexpr size_t WS_SIN   = WS_COS + al256((size_t)S_ * 16 * 4);
constexpr size_t WS_TAB   = WS_SIN + al256((size_t)S_ * 16 * 4);
constexpr size_t WS_XN    = WS_TAB + 4096;
constexpr size_t WS_PB    = WS_XN + al256((size_t)XNROWS * DM * 2);
constexpr size_t WS_R     = WS_PB + al256((size_t)S_ * PLE * 2);
constexpr size_t WS_Z     = WS_R;
constexpr size_t WS_M     = WS_Z + al256((size_t)ZROWS * LDZ * 2);
constexpr size_t WS_G     = WS_M + al256((size_t)S_ * POOLW * 2);
constexpr size_t WS_H1    = WS_G + al256((size_t)S_ * NGATE * 4);
constexpr size_t WS_KC    = WS_H1 + al256((size_t)8192 * 256 * 4);
constexpr size_t WS_VC    = WS_KC + al256((size_t)4 * 1024 * 128 * 2);
constexpr size_t WS_L     = WS_VC + al256((size_t)4 * 1024 * 128 * 2);
constexpr size_t WS_OACC  = WS_L + al256((size_t)S_ * NH * 4);
constexpr size_t WS_IMPP  = WS_OACC + al256((size_t)S_ * 3072 * 4);
constexpr size_t WS_IMPF  = WS_IMPP + al256((size_t)S_ * 4 * 256 * 4);
constexpr size_t WS_BM    = WS_IMPF + al256((size_t)S_ * 4 * 256 * 4);
constexpr size_t WS_MIX   = WS_BM + al256((size_t)S_ * 4 * 8 * 4);
constexpr size_t WS_END_A = WS_MIX + al256((size_t)S_ * DM * 2);
constexpr size_t WS_HALO  = WS_R;
constexpr size_t WS_AB    = WS_HALO + al256((size_t)2 * DFF * 2);
constexpr size_t WS_ACT   = WS_AB + al256((size_t)CHUNK * NFI * 2);
constexpr size_t WS_ERAW  = WS_ACT + al256((size_t)CHUNK * DFF * 2);
constexpr size_t WS_ERSTD = WS_ERAW + al256((size_t)S_ * DM * 2);
constexpr size_t WS_END_B = WS_ERSTD + al256((size_t)S_ * 4);
constexpr size_t WS_NEED  = WS_END_A > WS_END_B ? WS_END_A : WS_END_B;
static_assert(WS_MIX >= WS_END_B || true, "");

constexpr int LDS_STAGE = 131072;
constexpr int LDS_MISC  = LDS_STAGE;
constexpr int LDS_BYTES = LDS_STAGE + 64;

__device__ __forceinline__ unsigned cvt_pk_bf16(float lo, float hi) { unsigned r; asm volatile("v_cvt_pk_bf16_f32 %0, %1, %2" : "=v"(r) : "v"(lo), "v"(hi)); return r; }
__device__ __forceinline__ float bf_lo(unsigned u) { return __uint_as_float(u << 16); }
__device__ __forceinline__ float bf_hi(unsigned u) { return __uint_as_float(u & 0xffff0000u); }
__device__ __forceinline__ float bf2f(bf16_t b) { return __uint_as_float(((unsigned)b) << 16); }
__device__ __forceinline__ float wave_sum(float v) {
#pragma unroll
    for (int o = 32; o >= 1; o >>= 1) v += __shfl_xor(v, o);
    return v;
}
__device__ __forceinline__ float wave_max(float v) {
#pragma unroll
    for (int o = 32; o >= 1; o >>= 1) v = fmaxf(v, __shfl_xor(v, o));
    return v;
}
__device__ __forceinline__ float sigmoidf_(float x) { return 1.0f / (1.0f + __expf(-x)); }

#define XB_TMO      128
#define XB_XCNT(j)  (256  + 64 * (j))
#define XB_XSUB(j)  (1280 + 64 * (j))
#define XB_XGEN(j)  (2304 + 64 * (j))
#define XB_TOP      3328
#define XB_TOPGEN   3392
#define XCD_BAR_WORDS 3456
#define XB_SPIN_CAP (1u << 18)
__device__ __forceinline__ unsigned xb_ld(unsigned* p)              { return __hip_atomic_load(p, __ATOMIC_RELAXED, __HIP_MEMORY_SCOPE_AGENT); }
__device__ __forceinline__ unsigned xb_add(unsigned* p, unsigned v) { return __hip_atomic_fetch_add(p, v, __ATOMIC_RELAXED, __HIP_MEMORY_SCOPE_AGENT); }
__device__ __forceinline__ unsigned xb_xcc_id() { return (unsigned)__builtin_amdgcn_s_getreg((3 << 11) | 20) & 0xFu; }
#define XB_SPIN(cond, bar) do { unsigned _sp = 0; while (cond) { __builtin_amdgcn_s_sleep(1); \
    if ((++_sp & 255u) == 0u) { if (xb_ld(&(bar)[XB_TMO])) break; if (_sp > XB_SPIN_CAP) { atomicAdd(&(bar)[XB_TMO], 1u); break; } } } } while (0)
struct XcdBarrier { unsigned* bar; unsigned x; volatile LAS unsigned* st; };
__device__ __forceinline__ XcdBarrier xcd_barrier_post(unsigned* bar, volatile LAS unsigned* st) {
    XcdBarrier b; b.bar = bar; b.x = xb_xcc_id(); b.st = st;
    if (threadIdx.x == 0) (void)xb_add(&bar[XB_XCNT(b.x)], 1u);
    return b;
}
__device__ __forceinline__ void xcd_barrier_complete(unsigned* bar, unsigned x, unsigned& nloc, unsigned& nx) {
    const unsigned G = gridDim.x * gridDim.y * gridDim.z;
    unsigned sum, cnt, mine, sp = 0u;
    for (;;) {
        sum = 0u; cnt = 0u; mine = 0u;
#pragma unroll
        for (unsigned j = 0; j < 16; ++j) { const unsigned c = xb_ld(&bar[XB_XCNT(j)]); sum += c; cnt += (c > 0u) ? 1u : 0u; mine = (j == x) ? c : mine; }
        if (sum == G) break;
        __builtin_amdgcn_s_sleep(1);
        if ((++sp & 255u) == 0u) { if (xb_ld(&bar[XB_TMO])) break; if (sp > XB_SPIN_CAP) { atomicAdd(&bar[XB_TMO], 1u); break; } }
    }
    nloc = mine > 0u ? mine : 1u; nx = cnt > 0u ? cnt : 1u;
}
__device__ __forceinline__ void xcd_barrier(const XcdBarrier& b) {
    asm volatile("s_waitcnt vmcnt(0)" ::: "memory");
    __syncthreads();
    if (threadIdx.x == 0) {
        unsigned* bar = b.bar;
        __builtin_amdgcn_s_waitcnt(0);
        unsigned nloc = b.st[0], nx = b.st[1];
        if (nloc == 0u) { xcd_barrier_complete(bar, b.x, nloc, nx); b.st[0] = nloc; b.st[1] = nx; }
        const unsigned old = xb_add(&bar[XB_XSUB(b.x)], 1u);
        const unsigned gen = old / nloc;
        if (old + 1u == (gen + 1u) * nloc) {
            __builtin_amdgcn_fence(__ATOMIC_RELEASE, "agent");
            asm volatile("s_waitcnt vmcnt(0)" ::: "memory");
            const unsigned og = xb_add(&bar[XB_TOP], 1u);
            const unsigned tg = og / nx;
            if (og + 1u == (tg + 1u) * nx) xb_add(&bar[XB_TOPGEN], 1u);
            else XB_SPIN(xb_ld(&bar[XB_TOPGEN]) == tg, bar);
            __builtin_amdgcn_fence(__ATOMIC_ACQUIRE, "agent");
            xb_add(&bar[XB_XGEN(b.x)], 1u);
            asm volatile("s_waitcnt vmcnt(0)" ::: "memory");
        } else {
            XB_SPIN(xb_ld(&bar[XB_XGEN(b.x)]) == gen, bar);
            __builtin_amdgcn_fence(__ATOMIC_ACQUIRE, "agent");
            asm volatile("s_waitcnt vmcnt(0)" ::: "memory");
        }
    }
    __syncthreads();
}

struct Params {
    const float* x; const float* p; const int* positions; const float* norm1_w; const float* w_in; const float* w_pool; const float* pool_scale;
    const float* q_norm_w; const float* k_norm_cmp_w; const float* k_norm_slc_w; const float* k_norm_win_w; const float* cmp_pos_k; const float* cmp_pos_v;
    const float* cmp_k_w1; const float* cmp_k_w2; const float* cmp_v_w1; const float* cmp_v_w2; const float* w_o; const float* norm2_w; const float* w_ffn_in;
    const float* conv_w; const float* conv_b; const float* w_ffn_out; const float* w_ple_proj; const float* ple_norm_w; const float* ple_gate_norm_w; const float* w_ple_gate;
    float* out; unsigned char* ws; int ph_lo, ph_hi;
};

namespace pg8 {
constexpr int BM = 256, BK = 64, HALF = 128, HTB = HALF * BK * 2, STAGE_BYTES = 8 * HTB, NXCD = 8, WGM = 8;
__host__ __device__ __forceinline__ int lds_byte(int r, int c) { const int st = (r >> 4) * 2 + (c >> 5), rr = r & 15, cc = c & 31, ob = rr * 64 + cc * 2; return st * 1024 + (ob ^ (((ob >> 9) & 1) << 5)); }
__host__ __device__ __forceinline__ void stage_rc(int b, int& R, int& C) { const int st = b / 1024, sb = b % 1024, swz = sb ^ (((sb >> 9) & 1) << 5); R = (st >> 1) * 16 + swz / 64; C = (st & 1) * 32 + (swz % 64) / 2; }
__host__ __device__ __forceinline__ int perm32(int rho) { const int n = rho >> 4, i = rho & 15; return 8 * (i >> 2) + 4 * n + (i & 3); }
struct Unit { int pm, pn; };

struct StaticOrder {
    int nM, nN, nwg, G, c;
    __device__ void init(int nM_, int nN_, int G_, int c_) { nM = nM_; nN = nN_; nwg = nM * nN; G = G_; c = c_; }
    __device__ bool next(int i, Unit& u) const {
        const long L = (long)i * G + c; if (L >= nwg) return false;
        int wgid = (int)L; { const int q = nwg / NXCD, r = nwg % NXCD, xcd = wgid % NXCD, off = wgid / NXCD; wgid = (xcd < r ? xcd * (q + 1) : r * (q + 1) + (xcd - r) * q) + off; }
        const int nig = WGM * nN, gid = wgid / nig, fm = gid * WGM, gsz = (nM - fm) < WGM ? (nM - fm) : WGM;
        u.pm = fm + ((wgid % nig) % gsz); u.pn = (wgid % nig) / gsz; return true;
    }
};

struct GStd {
    const char* A; const char* B; unsigned lda, ldb; int nt;
    __device__ __forceinline__ const char* a_base(const Unit& u) const { return A + (size_t)u.pm * 256 * lda * 2; }
    __device__ __forceinline__ const char* b_base(const Unit& u) const { return B + (size_t)u.pn * 256 * ldb * 2; }
    __device__ __forceinline__ size_t kpairA() const { return 256; }
};
struct GPool {
    const char* A; const char* B; unsigned lda, ldb; int nt;
    __device__ __forceinline__ const char* a_base(const Unit& u) const { return A + (size_t)u.pm * 256 * lda * 2 + (size_t)u.pn * 512; }
    __device__ __forceinline__ const char* b_base(const Unit& u) const { return B + (size_t)u.pn * 256 * ldb * 2; }
    __device__ __forceinline__ size_t kpairA() const { return 256; }
};
struct GCmp {
    const char* Z; const char* Bk; const char* Bv; unsigned lda, ldb; int nt;
    __device__ __forceinline__ const char* a_base(const Unit& u) const { const int which = u.pm >> 4, g = (u.pm >> 2) & 3, rt = u.pm & 3;
        return Z + (size_t)(OFF_KV + which * 512 + g * 128) * 2 + (size_t)rt * 256 * lda * 2; }
    __device__ __forceinline__ const char* b_base(const Unit& u) const { return (u.pm >> 4) ? Bv : Bk; }
    __device__ __forceinline__ size_t kpairA() const { return (size_t)LDZ * 2; }
};

struct EpiBf16 {
    static constexpr bool PERM = true;
    bf16_t* O; int ldc;
    __device__ __forceinline__ void operator()(const f32x4 (&acc)[2][2][4][2], const Unit& u, int wr, int wc, int fr, int fq) const {
        const int row0 = u.pm * BM + wr * 64 + fr, col0 = u.pn * BM + wc * 32 + 8 * fq;
#pragma unroll
        for (int ai = 0; ai < 2; ++ai)
#pragma unroll
            for (int m = 0; m < 4; ++m) { bf16_t* rowp = O + (size_t)(row0 + ai * HALF + m * 16) * ldc + col0;
#pragma unroll
                for (int bj = 0; bj < 2; ++bj) { const f32x4 v0 = acc[ai][bj][m][0], v1 = acc[ai][bj][m][1];
                    u32x4 w; w.x = cvt_pk_bf16(v0[0], v0[1]); w.y = cvt_pk_bf16(v0[2], v0[3]); w.z = cvt_pk_bf16(v1[0], v1[1]); w.w = cvt_pk_bf16(v1[2], v1[3]);
                    *(u32x4*)(rowp + bj * HALF) = w; } }
    }
};
struct EpiBf16Scale {
    static constexpr bool PERM = true;
    bf16_t* O; int ldc; const float* colscale;
    __device__ __forceinline__ void operator()(const f32x4 (&acc)[2][2][4][2], const Unit& u, int wr, int wc, int fr, int fq) const {
        const int row0 = u.pm * BM + wr * 64 + fr, col0 = u.pn * BM + wc * 32 + 8 * fq;
#pragma unroll
        for (int bj = 0; bj < 2; ++bj) { const f32x4 s0 = *(const f32x4*)(colscale + col0 + bj * HALF), s1 = *(const f32x4*)(colscale + col0 + bj * HALF + 4);
#pragma unroll
            for (int ai = 0; ai < 2; ++ai)
#pragma unroll
                for (int m = 0; m < 4; ++m) { bf16_t* rowp = O + (size_t)(row0 + ai * HALF + m * 16) * ldc + col0;
                    const f32x4 v0 = acc[ai][bj][m][0] * s0, v1 = acc[ai][bj][m][1] * s1;
                    u32x4 w; w.x = cvt_pk_bf16(v0[0], v0[1]); w.y = cvt_pk_bf16(v0[2], v0[3]); w.z = cvt_pk_bf16(v1[0], v1[1]); w.w = cvt_pk_bf16(v1[2], v1[3]);
                    *(u32x4*)(rowp + bj * HALF) = w; } }
    }
};
struct EpiResF32 {
    static constexpr bool PERM = false;
    const float* base; float* C; int ldc; int row_off;
    __device__ __forceinline__ void operator()(const f32x4 (&acc)[2][2][4][2], const Unit& u, int wr, int wc, int fr, int fq) const {
        const int row0 = u.pm * BM + wr * 64 + fr + row_off, col0 = u.pn * BM + wc * 32 + 4 * fq;
#pragma unroll
        for (int ai = 0; ai < 2; ++ai)
#pragma unroll
            for (int m = 0; m < 4; ++m) { const size_t off = (size_t)(row0 + ai * HALF + m * 16) * ldc + col0;
#pragma unroll
                for (int bj = 0; bj < 2; ++bj)
#pragma unroll
                    for (int n = 0; n < 2; ++n) { const f32x4 b = *(const f32x4*)(base + off + bj * HALF + n * 16); *(f32x4*)(C + off + bj * HALF + n * 16) = b + acc[ai][bj][m][n]; }
                asm volatile("" ::: "memory"); }
    }
};
struct EpiCmpGelu {
    static constexpr bool PERM = false;
    float* H; const float* bias;
    __device__ __forceinline__ void operator()(const f32x4 (&acc)[2][2][4][2], const Unit& u, int wr, int wc, int fr, int fq) const {
        const int row0 = u.pm * BM + wr * 64 + fr, col0 = wc * 32 + 4 * fq; const float* bs = bias + (u.pm >> 4) * 256;
#pragma unroll
        for (int ai = 0; ai < 2; ++ai)
#pragma unroll
            for (int m = 0; m < 4; ++m) { float* rowp = H + (size_t)(row0 + ai * HALF + m * 16) * 256 + col0;
#pragma unroll
                for (int bj = 0; bj < 2; ++bj)
#pragma unroll
                    for (int n = 0; n < 2; ++n) { const f32x4 b = *(const f32x4*)(bs + col0 + bj * HALF + n * 16); f32x4 v = acc[ai][bj][m][n] + b;
#pragma unroll
                        for (int j = 0; j < 4; ++j) { const float xx = v[j], uu = 0.7978845608028654f * (xx + 0.044715f * xx * xx * xx); const float th = 1.0f - 2.0f / (1.0f + __expf(2.0f * uu)); v[j] = 0.5f * xx * (1.0f + th); }
                        *(f32x4*)(rowp + bj * HALF + n * 16) = v; } }
    }
};
struct EpiGate {
    static constexpr bool PERM = false;
    float* C; const bf16_t* eraw; const float* erstd; const float* pw; int ldc;
    __device__ __forceinline__ void operator()(const f32x4 (&acc)[2][2][4][2], const Unit& u, int wr, int wc, int fr, int fq) const {
        const int row0 = u.pm * BM + wr * 64 + fr, col0 = u.pn * BM + wc * 32 + 4 * fq;
        f32x4 wv[2][2];
#pragma unroll
        for (int bj = 0; bj < 2; ++bj)
#pragma unroll
            for (int n = 0; n < 2; ++n) wv[bj][n] = *(const f32x4*)(pw + col0 + bj * HALF + n * 16);
#pragma unroll
        for (int ai = 0; ai < 2; ++ai)
#pragma unroll
            for (int m = 0; m < 4; ++m) { const int row = row0 + ai * HALF + m * 16; const size_t off = (size_t)row * ldc + col0; const float rs = erstd[row];
#pragma unroll
                for (int bj = 0; bj < 2; ++bj)
#pragma unroll
                    for (int n = 0; n < 2; ++n) { const f32x4 b = *(const f32x4*)(C + off + bj * HALF + n * 16); const u32x2 e = *(const u32x2*)(eraw + off + bj * HALF + n * 16);
                        const f32x4 a = acc[ai][bj][m][n]; f32x4 o;
                        o[0] = b[0] + bf_lo(e.x) * rs * wv[bj][n][0] * sigmoidf_(a[0]); o[1] = b[1] + bf_hi(e.x) * rs * wv[bj][n][1] * sigmoidf_(a[1]);
                        o[2] = b[2] + bf_lo(e.y) * rs * wv[bj][n][2] * sigmoidf_(a[2]); o[3] = b[3] + bf_hi(e.y) * rs * wv[bj][n][3] * sigmoidf_(a[3]);
                        *(f32x4*)(C + off + bj * HALF + n * 16) = o; }
                asm volatile("" ::: "memory"); }
    }
};

template <class GD, class Epi>
__device__ __forceinline__ void gemm_phase(LAS unsigned char* lds, const GD g, const StaticOrder& S, const Epi& E) {
    const int tid = threadIdx.x, wid = __builtin_amdgcn_readfirstlane(tid >> 6), lane = tid & 63, wr = wid >> 2, wc = wid & 3, fr = lane & 15, fq = lane >> 4;
    const int nt = g.nt;
    unsigned voffA[2], voffB[2];
#pragma unroll
    for (int i = 0; i < 2; ++i) { int R, C; stage_rc(tid * 16 + i * 8192, R, C); const int Rb = Epi::PERM ? ((R & ~31) + perm32(R & 31)) : R;
        voffA[i] = (unsigned)(R * g.lda + C) * 2u; voffB[i] = (unsigned)(Rb * g.ldb + C) * 2u; }
    const size_t kpA = g.kpairA();
    const size_t hstepA = (size_t)HALF * g.lda * 2, hstepB = (size_t)HALF * g.ldb * 2;
    const unsigned ldsw = (unsigned)wid * 1024u;
    const int aoff = lds_byte(wr * 64 + fr, fq * 8), boff = lds_byte(wc * 32 + fr, fq * 8);
#define PG8_SA(b, h) (((b) * 2 + (h)) * HTB)
#define PG8_SB(b, h) ((4 + (b) * 2 + (h)) * HTB)
#define PG8_STAGE(bufoff, gbase, voff) do { _Pragma("unroll") for (int _i = 0; _i < 2; ++_i) \
        __builtin_amdgcn_global_load_lds((const unsigned*)((const char*)(gbase) + (voff)[_i]), (LAS unsigned*)(lds + (bufoff) + ldsw + _i * 8192), 16, 0, 0); } while (0)
#define PG8_LDA(dst, b, h) do { _Pragma("unroll") for (int m = 0; m < 4; ++m) _Pragma("unroll") for (int k = 0; k < 2; ++k) dst[m][k] = *(const LAS bf16x8*)(lds + PG8_SA(b, h) + aoff + m * 2048 + k * 1024); } while (0)
#define PG8_LDB(dst, b, h) do { _Pragma("unroll") for (int n = 0; n < 2; ++n) _Pragma("unroll") for (int k = 0; k < 2; ++k) dst[n][k] = *(const LAS bf16x8*)(lds + PG8_SB(b, h) + boff + n * 2048 + k * 1024); } while (0)
#define PG8_MMA(ai, bj, At, Bt) do { __builtin_amdgcn_s_setprio(1); _Pragma("unroll") for (int m = 0; m < 4; ++m) _Pragma("unroll") for (int n = 0; n < 2; ++n) _Pragma("unroll") for (int k = 0; k < 2; ++k) \
        acc[ai][bj][m][n] = __builtin_amdgcn_mfma_f32_16x16x32_bf16(Bt[n][k], At[m][k], acc[ai][bj][m][n], 0, 0, 0); __builtin_amdgcn_s_setprio(0); } while (0)
#define PG8_WAIT_V(n) asm volatile("s_waitcnt vmcnt(" #n ")" ::: "memory")
#define PG8_WAIT_L(n) asm volatile("s_waitcnt lgkmcnt(" #n ")" ::: "memory")
#define PG8_BAR __builtin_amdgcn_s_barrier()
#define PG8_SCHED __builtin_amdgcn_sched_barrier(0)
    Unit cur, nxt; int ui = 0;
    if (!S.next(0, cur)) return;
    f32x4 acc[2][2][4][2];
#pragma unroll
    for (int a = 0; a < 2; ++a)
#pragma unroll
        for (int b = 0; b < 2; ++b)
#pragma unroll
            for (int m = 0; m < 4; ++m)
#pragma unroll
                for (int n = 0; n < 2; ++n) acc[a][b][m][n] = (f32x4){0.f, 0.f, 0.f, 0.f};
    bf16x8 At[4][2], B0[2][2], B1[2][2];
    const char* cA = g.a_base(cur); const char* cB = g.b_base(cur);
    PG8_STAGE(PG8_SB(0, 0), cB, voffB); PG8_STAGE(PG8_SA(0, 0), cA, voffA); PG8_STAGE(PG8_SB(0, 1), cB + hstepB, voffB); PG8_STAGE(PG8_SA(0, 1), cA + hstepA, voffA);
    if (wr == 1) PG8_BAR;
    PG8_WAIT_V(4); PG8_BAR;
    PG8_STAGE(PG8_SB(1, 0), cB + 128, voffB); PG8_STAGE(PG8_SA(1, 0), cA + 128, voffA); PG8_STAGE(PG8_SB(1, 1), cB + hstepB + 128, voffB);
    PG8_WAIT_V(6); PG8_BAR;
    for (;;) {
        const bool has_next = S.next(ui + 1, nxt);
        const char* nA = has_next ? g.a_base(nxt) : cA; const char* nB = has_next ? g.b_base(nxt) : cB;
        for (int t = 0; t < nt; t += 2) {
            const bool last = (t == nt - 2);
            const char* a0 = cA + (size_t)(t >> 1) * kpA;
            const char* a1 = a0 + 128;
            const char* a2 = last ? nA : a0 + kpA; const char* b2 = last ? nB : cB + (size_t)(t + 2) * 128;
            const char* a3 = a2 + 128; const char* b3 = b2 + 128;
            PG8_LDB(B0, 0, 0); PG8_SCHED; PG8_LDA(At, 0, 0); PG8_STAGE(PG8_SA(1, 1), a1 + hstepA, voffA);
            PG8_WAIT_L(8); PG8_BAR; PG8_WAIT_L(0); PG8_MMA(0, 0, At, B0); PG8_BAR; PG8_SCHED;
            PG8_LDB(B1, 0, 1); PG8_STAGE(PG8_SB(0, 0), b2, voffB);
            PG8_BAR; PG8_WAIT_L(0); PG8_MMA(0, 1, At, B1); PG8_BAR;
            PG8_LDA(At, 0, 1); PG8_STAGE(PG8_SA(0, 0), a2, voffA);
            PG8_BAR; PG8_WAIT_L(0); PG8_MMA(1, 0, At, B0); PG8_BAR; PG8_SCHED;
            PG8_STAGE(PG8_SB(0, 1), b2 + hstepB, voffB);
            PG8_WAIT_V(6); PG8_BAR; PG8_MMA(1, 1, At, B1); PG8_BAR;
            PG8_LDB(B0, 1, 0); PG8_SCHED; PG8_LDA(At, 1, 0); PG8_STAGE(PG8_SA(0, 1), a2 + hstepA, voffA);
            PG8_WAIT_L(8); PG8_BAR; PG8_WAIT_L(0); PG8_MMA(0, 0, At, B0); PG8_BAR; PG8_SCHED;
            PG8_LDB(B1, 1, 1); PG8_STAGE(PG8_SB(1, 0), b3, voffB);
            PG8_BAR; PG8_WAIT_L(0); PG8_MMA(0, 1, At, B1); PG8_BAR;
            PG8_LDA(At, 1, 1); PG8_STAGE(PG8_SA(1, 0), a3, voffA);
            PG8_BAR; PG8_WAIT_L(0); PG8_MMA(1, 0, At, B0); PG8_BAR; PG8_SCHED;
            PG8_STAGE(PG8_SB(1, 1), b3 + hstepB, voffB);
            PG8_WAIT_V(6); PG8_BAR; PG8_MMA(1, 1, At, B1); PG8_BAR;
        }
        E(acc, cur, wr, wc, fr, fq);
        if (!has_next) break;
#pragma unroll
        for (int a = 0; a < 2; ++a)
#pragma unroll
            for (int b = 0; b < 2; ++b)
#pragma unroll
                for (int m = 0; m < 4; ++m)
#pragma unroll
                    for (int n = 0; n < 2; ++n) acc[a][b][m][n] = (f32x4){0.f, 0.f, 0.f, 0.f};
        cur = nxt; cA = nA; cB = nB; ++ui;
    }
    PG8_WAIT_V(0);
    if (wr == 0) PG8_BAR;
    PG8_BAR;
#undef PG8_SA
#undef PG8_SB
#undef PG8_STAGE
#undef PG8_LDA
#undef PG8_LDB
#undef PG8_MMA
#undef PG8_WAIT_V
#undef PG8_WAIT_L
#undef PG8_BAR
#undef PG8_SCHED
}
}

namespace att {
constexpr int KVBLK = 64;
constexpr int SHM_V = KVBLK * HD * 2, SHM_K = KVBLK * HD * 2, SHM_ATTN = 2 * SHM_V + 2 * SHM_K + NWAVES * 64 * 4;
#define KSWZ(row, colB) ((row) * 256 + ((colB) ^ (((row) & 7) << 4)))
#define SBAR() __builtin_amdgcn_sched_barrier(0)
__device__ __forceinline__ int crow(int r, int hi) { return (r & 3) + 8 * (r >> 2) + 4 * hi; }
__device__ __forceinline__ void qkt(f32x16& p0, f32x16& p1, const char* Ks, const bf16x8* qr, int r32, int hi) {
    p0 = f32x16{}; p1 = f32x16{};
#pragma unroll
    for (int d0 = 0; d0 < 8; ++d0) { const int cb = (d0 * 16 + hi * 8) * 2;
        const bf16x8 b0 = *reinterpret_cast<const bf16x8*>(Ks + KSWZ(r32, cb));
        const bf16x8 b1 = *reinterpret_cast<const bf16x8*>(Ks + KSWZ(32 + r32, cb));
        p0 = __builtin_amdgcn_mfma_f32_32x32x16_bf16(b0, qr[d0], p0, 0, 0, 0);
        p1 = __builtin_amdgcn_mfma_f32_32x32x16_bf16(b1, qr[d0], p1, 0, 0, 0); }
}
__device__ __forceinline__ int v_st(int k, int c) { const int kk = (k & ~0xC) | ((k & 4) << 1) | ((k & 8) >> 1); return ((kk >> 3) * 4 + (c >> 5)) * 512 + ((kk & 7) * 32 + (c & 31)) * 2; }
__device__ __forceinline__ int v_rd_base(int lane) { return ((lane & 3) << 3) | (((lane >> 2) & 3) << 6) | (((lane >> 4) & 1) << 5) | (((lane >> 5) & 1) << 8); }
constexpr int v_rd_off(int d0, int ks, int half) { return d0 * 512 + ks * 4096 + half * 2048; }
template <int OFF> __device__ __forceinline__ s16x4 tr_read(int vb) {
    s16x4 r; asm volatile("ds_read_b64_tr_b16 %0, %1 offset:%2" : "=&v"(r) : "v"(vb), "i"(OFF) : "memory"); return r;
}
template <int D0> __device__ __forceinline__ void pv_one(f32x16& od, int vb, bf16x8 pa0, bf16x8 pa1, bf16x8 pa2, bf16x8 pa3) {
    const s16x4 l0 = tr_read<v_rd_off(D0, 0, 0)>(vb), h0 = tr_read<v_rd_off(D0, 0, 1)>(vb), l1 = tr_read<v_rd_off(D0, 1, 0)>(vb), h1 = tr_read<v_rd_off(D0, 1, 1)>(vb);
    const s16x4 l2 = tr_read<v_rd_off(D0, 2, 0)>(vb), h2 = tr_read<v_rd_off(D0, 2, 1)>(vb), l3 = tr_read<v_rd_off(D0, 3, 0)>(vb), h3 = tr_read<v_rd_off(D0, 3, 1)>(vb);
    asm volatile("s_waitcnt lgkmcnt(0)" ::: "memory"); SBAR();
#define PK(L, H) (bf16x8){L[0], L[1], L[2], L[3], H[0], H[1], H[2], H[3]}
    od = __builtin_amdgcn_mfma_f32_32x32x16_bf16(pa0, PK(l0, h0), od, 0, 0, 0);
    od = __builtin_amdgcn_mfma_f32_32x32x16_bf16(pa1, PK(l1, h1), od, 0, 0, 0);
    od = __builtin_amdgcn_mfma_f32_32x32x16_bf16(pa2, PK(l2, h2), od, 0, 0, 0);
    od = __builtin_amdgcn_mfma_f32_32x32x16_bf16(pa3, PK(l3, h3), od, 0, 0, 0);
#undef PK
}
__device__ __forceinline__ void pv_d0(f32x16* o, int vb, bf16x8 pa0, bf16x8 pa1, bf16x8 pa2, bf16x8 pa3) {
    pv_one<0>(o[0], vb, pa0, pa1, pa2, pa3); pv_one<1>(o[1], vb, pa0, pa1, pa2, pa3); pv_one<2>(o[2], vb, pa0, pa1, pa2, pa3); pv_one<3>(o[3], vb, pa0, pa1, pa2, pa3);
}
__device__ __forceinline__ void pack_p(const f32x16& p0, const f32x16& p1, bf16x8& pa0, bf16x8& pa1, bf16x8& pa2, bf16x8& pa3) {
#define PK4(P, BASE, OUT) do { unsigned a0 = cvt_pk_bf16(P[BASE + 0], P[BASE + 1]), a1 = cvt_pk_bf16(P[BASE + 2], P[BASE + 3]);   \
    unsigned b0 = cvt_pk_bf16(P[BASE + 4], P[BASE + 5]), b1 = cvt_pk_bf16(P[BASE + 6], P[BASE + 7]);                              \
    auto r0 = __builtin_amdgcn_permlane32_swap(a0, b0, false, false); auto r1 = __builtin_amdgcn_permlane32_swap(a1, b1, false, false); \
    u32x4 w = {r0[0], r1[0], r0[1], r1[1]}; OUT = *reinterpret_cast<bf16x8*>(&w); } while (0)
    PK4(p0, 0, pa0); PK4(p0, 8, pa1); PK4(p1, 0, pa2); PK4(p1, 8, pa3);
#undef PK4
}

enum { MODE_CMP = 0, MODE_WIN = 1, MODE_SLC = 2 };
struct AttnArgs {
    const bf16_t* Z; const bf16_t* KC; const bf16_t* VC; const float* G; float* L; float* OACC; bf16_t* MIX; const unsigned* BM; const float* TAB;
};
template <int MODE>
__device__ __forceinline__ void attn_unit(const AttnArgs& a, LAS char* ldsL, int qt, int g, int hp) {
    char* lds = (char*)ldsL;
    const int tid = threadIdx.x, wid = __builtin_amdgcn_readfirstlane(tid >> 6), lane = tid & 63, r32 = lane & 31, hi = lane >> 5;
    char* V_lds = lds; char* K_lds = lds + 2 * SHM_V;
    float* li_l = (float*)(lds + 2 * SHM_V + 2 * SHM_K) + wid * 64;
    const int t0 = qt * 128, tq = t0 + wid * 16 + (r32 & 15), hq = g * HPG + hp * 2 + (r32 >> 4);
    const bf16_t* Kb; const bf16_t* Vb; long ldk;
    if (MODE == MODE_CMP) { Kb = a.KC + (size_t)g * 1024 * HD; Vb = a.VC + (size_t)g * 1024 * HD; ldk = HD; }
    else if (MODE == MODE_WIN) { Kb = a.Z + OFF_KV + 4 * 512 + g * HD; Vb = a.Z + OFF_KV + 5 * 512 + g * HD; ldk = LDZ; }
    else { Kb = a.Z + OFF_KV + 2 * 512 + g * HD; Vb = a.Z + OFF_KV + 3 * 512 + g * HD; ldk = LDZ; }
    int j0, j1;
    if (MODE == MODE_CMP) { j0 = 0; j1 = (((t0 + 127 - 31) >> 4) >> 6) + 1; }
    else if (MODE == MODE_WIN) { j0 = (t0 - 511) > 0 ? ((t0 - 511) >> 6) : 0; j1 = ((t0 + 127) >> 6) + 1; }
    else { j0 = 0; j1 = ((t0 + 127) >> 6) + 1; }
    int klo, khi;
    if (MODE == MODE_CMP) { klo = 0; khi = tq >= 31 ? ((tq - 31) >> 4) : -1; }
    else if (MODE == MODE_WIN) { klo = tq - 511; khi = tq; }
    else { klo = 0; khi = tq; }
    const float negBC = -a.TAB[512 + (MODE == MODE_CMP ? 0 : (MODE == MODE_SLC ? 1 : 2))];
    bf16x8 qr[8];
    { const bf16_t* Qw = a.Z + (size_t)tq * LDZ + OFF_Q + hq * HD + hi * 8;
#pragma unroll
      for (int d0 = 0; d0 < 8; ++d0) qr[d0] = *reinterpret_cast<const bf16x8*>(Qw + d0 * 16); }
    f32x16 o[4] = {}; float lsum = 0.f;
    const int sr = tid >> 4, sc = (tid & 15) * 8, vst0 = v_st(sr, sc), vst1 = v_st(32 + sr, sc);
    const int vb0 = (int)(uintptr_t)(LAS char*)ldsL + v_rd_base(lane);
    bf16x8 vs0, vs1, ks0, ks1;
#define SLOAD(k0) do { vs0 = *reinterpret_cast<const bf16x8*>(Vb + (long)((k0) + sr) * ldk + sc); vs1 = *reinterpret_cast<const bf16x8*>(Vb + (long)((k0) + 32 + sr) * ldk + sc); \
    ks0 = *reinterpret_cast<const bf16x8*>(Kb + (long)((k0) + sr) * ldk + sc); ks1 = *reinterpret_cast<const bf16x8*>(Kb + (long)((k0) + 32 + sr) * ldk + sc); } while (0)
#define SWRITE(b) do { *(bf16x8*)(V_lds + (b) * SHM_V + vst0) = vs0; *(bf16x8*)(V_lds + (b) * SHM_V + vst1) = vs1; const int kc = sc * 2; \
    *(bf16x8*)(K_lds + (b) * SHM_K + KSWZ(sr, kc)) = ks0; *(bf16x8*)(K_lds + (b) * SHM_K + KSWZ(32 + sr, kc)) = ks1; } while (0)
    unsigned bmw = 0u;
    __syncthreads();
    SLOAD(j0 * KVBLK); asm volatile("s_waitcnt vmcnt(0)" ::: "memory"); SWRITE(0); __syncthreads();
    for (int j = j0; j < j1; ++j) {
        const int buf = (j - j0) & 1;
        if (j + 1 < j1) SLOAD((j + 1) * KVBLK);
        int lhi = khi;
        if (MODE == MODE_SLC) { if ((j & 31) == 0 || j == j0) bmw = a.BM[((size_t)tq * 4 + g) * 8 + (j >> 5)]; if (!((bmw >> (j & 31)) & 1u)) lhi = -1; }
        const int kb = j * KVBLK;
        const bool l_any = (kb + 63 >= klo) && (kb <= lhi);
        const bool l_full = (kb >= klo) && (kb + 63 <= lhi);
        if (__any(l_any)) {
            f32x16 p0, p1;
            qkt(p0, p1, K_lds + buf * SHM_K, qr, r32, hi);
            if (__all(l_full || !l_any)) {
                const float off = l_any ? negBC : -1.0e30f;
#pragma unroll
                for (int r = 0; r < 16; ++r) { p0[r] = __builtin_amdgcn_exp2f(fmaf(p0[r], SM_C, off)); p1[r] = __builtin_amdgcn_exp2f(fmaf(p1[r], SM_C, off)); }
            } else {
#pragma unroll
                for (int r = 0; r < 16; ++r) { const int k0i = kb + crow(r, hi), k1i = k0i + 32;
                    const float e0 = __builtin_amdgcn_exp2f(fmaf(p0[r], SM_C, negBC)), e1 = __builtin_amdgcn_exp2f(fmaf(p1[r], SM_C, negBC));
                    p0[r] = (k0i >= klo && k0i <= lhi) ? e0 : 0.f; p1[r] = (k1i >= klo && k1i <= lhi) ? e1 : 0.f; }
            }
            float ps = 0.f;
#pragma unroll
            for (int r = 0; r < 16; ++r) ps += p0[r] + p1[r];
            lsum += ps;
            bf16x8 pa0, pa1, pa2, pa3; pack_p(p0, p1, pa0, pa1, pa2, pa3);
            pv_d0(o, vb0 + buf * SHM_V, pa0, pa1, pa2, pa3);
        }
        if (j + 1 < j1) { asm volatile("s_waitcnt vmcnt(0)" ::: "memory"); SWRITE(buf ^ 1); }
        __syncthreads();
    }
#undef SLOAD
#undef SWRITE
    lsum += __shfl_xor(lsum, 32);
    if (hi == 0) li_l[r32] = lsum;
    if (MODE == MODE_CMP) { if (hi == 0) a.L[(size_t)tq * NH + hq] = lsum; }
    asm volatile("s_waitcnt lgkmcnt(0)" ::: "memory");
#pragma unroll
    for (int r = 0; r < 16; ++r) {
        const int orow = crow(r, hi); const float lv = li_l[orow]; const float rl = lv > 0.f ? 1.0f / lv : 0.f;
        const int t = t0 + wid * 16 + (orow & 15), h = g * HPG + hp * 2 + (orow >> 4);
        const float gt = a.G[(size_t)t * NGATE + h * 3 + (MODE == MODE_CMP ? 0 : (MODE == MODE_SLC ? 1 : 2))] * rl;
        float* oa = a.OACC + (size_t)t * 3072 + h * HD + r32;
#pragma unroll
        for (int d0 = 0; d0 < 4; ++d0) {
            const float v = o[d0][r] * gt;
            if (MODE == MODE_CMP) oa[d0 * 32] = v;
            else if (MODE == MODE_WIN) oa[d0 * 32] += v;
            else a.MIX[(size_t)t * DM + POOLW + h * HD + d0 * 32 + r32] = (bf16_t)(cvt_pk_bf16(oa[d0 * 32] + v, 0.f) & 0xffffu);
        }
    }
}

__device__ __forceinline__ void imp_task(const AttnArgs& a, float* IMPP, float* IMPF, int tqi, int g) {
    const int lane = threadIdx.x & 63, fr = lane & 15, fq = lane >> 4;
    const int t = tqi * 16 + fr;
    const int tmax = tqi * 16 + 15;
    if (tmax < 31) return;
    const int lim = t >= 31 ? ((t - 31) >> 4) : -1;
    const int jmax = ((tmax - 31) >> 4) >> 6;
    const float negBC = -a.TAB[512];
    bf16x8 qf[HPG][4]; float rl[HPG];
#pragma unroll
    for (int h = 0; h < HPG; ++h) {
        const bf16_t* qp = a.Z + (size_t)t * LDZ + OFF_Q + (g * HPG + h) * HD + fq * 8;
#pragma unroll
        for (int ks = 0; ks < 4; ++ks) qf[h][ks] = *reinterpret_cast<const bf16x8*>(qp + ks * 32);
        const float lv = a.L[(size_t)t * NH + g * HPG + h]; rl[h] = lv > 0.f ? 1.0f / lv : 0.f;
    }
    const bf16_t* kbase = a.KC + (size_t)g * 1024 * HD + fq * 8;
    for (int j = 0; j <= jmax; ++j) {
#pragma unroll
        for (int mt = 0; mt < 4; ++mt) {
            bf16x8 kf[4];
            const bf16_t* kp = kbase + (size_t)(j * 64 + mt * 16 + fr) * HD;
#pragma unroll
            for (int ks = 0; ks < 4; ++ks) kf[ks] = *reinterpret_cast<const bf16x8*>(kp + ks * 32);
            f32x4 imp4 = {0.f, 0.f, 0.f, 0.f};
            const int n0 = j * 64 + mt * 16 + fq * 4;
#pragma unroll
            for (int h = 0; h < HPG; ++h) {
                f32x4 acc = {0.f, 0.f, 0.f, 0.f};
#pragma unroll
                for (int ks = 0; ks < 4; ++ks) acc = __builtin_amdgcn_mfma_f32_16x16x32_bf16(kf[ks], qf[h][ks], acc, 0, 0, 0);
#pragma unroll
                for (int i = 0; i < 4; ++i) { const float e = __builtin_amdgcn_exp2f(fmaf(acc[i], SM_C, negBC)) * rl[h]; imp4[i] += (n0 + i <= lim) ? e : 0.f; }
            }
            const size_t oi = ((size_t)t * 4 + g) * 256 + (j * 16 + mt * 4 + fq);
            IMPP[oi] = imp4[0] + 2.0f * (imp4[1] + imp4[2] + imp4[3]);
            IMPF[oi] = imp4[0];
        }
    }
}

__device__ __forceinline__ void topk_task(const float* IMPP, const float* IMPF, unsigned* BM, int t, int g) {
    const int lane = threadIdx.x & 63;
    const int cur = t >> 6;
    unsigned word = 0u;
    if (cur <= 15) { if (lane == 0) word = (2u << cur) - 1u; }
    else {
        const size_t base = ((size_t)t * 4 + g) * 256;
        float v[4];
        {
            const int jb = lane * 4;
            f32x4 pp = {0.f, 0.f, 0.f, 0.f}, ff = {0.f, 0.f, 0.f, 0.f};
            if (jb <= cur) { pp = *(const f32x4*)(IMPP + base + jb); ff = *(const f32x4*)(IMPF + base + jb); }
            float fnext = __shfl_down(ff[0], 1);
            if (lane == 63) fnext = 0.f;
            v[0] = pp[0] + ff[1]; v[1] = pp[1] + ff[2]; v[2] = pp[2] + ff[3]; v[3] = pp[3] + fnext;
#pragma unroll
            for (int c = 0; c < 4; ++c) { const int j = jb + c; if (j < 1 || j > cur - 2) v[c] = -1.0f; }
        }
        if (lane == 0) word |= 1u;
        if (lane == (cur >> 5)) word |= 1u << (cur & 31);
        if (lane == ((cur - 1) >> 5)) word |= 1u << ((cur - 1) & 31);
        for (int it = 0; it < 13; ++it) {
            float bv = v[0]; int bi = lane * 4;
#pragma unroll
            for (int c = 1; c < 4; ++c) if (v[c] > bv) { bv = v[c]; bi = lane * 4 + c; }
#pragma unroll
            for (int o = 32; o >= 1; o >>= 1) { const float ov = __shfl_xor(bv, o); const int oi = __shfl_xor(bi, o); if (ov > bv || (ov == bv && oi < bi)) { bv = ov; bi = oi; } }
            if (lane == (bi >> 5)) word |= 1u << (bi & 31);
            if (lane == (bi >> 2)) {
#pragma unroll
                for (int c = 0; c < 4; ++c) if (c == (bi & 3)) v[c] = -2.0f;
            }
        }
    }
    if (lane < 8) BM[((size_t)t * 4 + g) * 8 + lane] = word;
}
#undef KSWZ
}

__device__ __forceinline__ void convT(const float* __restrict__ src, int K, int N, bf16_t* __restrict__ dst, int ldd, LAS float* tile, int bid, int nb) {
    const int tid = threadIdx.x, tk = K >> 6, tn = (N + 63) >> 6, total = tk * tn;
    for (int idx = bid; idx < total; idx += nb) {
        const int nti = idx % tn, kti = idx / tn;
        const int r = tid >> 4, c4 = (tid & 15) * 4, ng = nti * 64 + c4;
#pragma unroll
        for (int h = 0; h < 2; ++h) {
            f32x4 v = {0.f, 0.f, 0.f, 0.f};
            if (ng < N) v = *(const f32x4*)(src + (size_t)(kti * 64 + r + h * 32) * N + ng);
            LAS float* tp = tile + (r + h * 32) * 65 + c4;
            tp[0] = v[0]; tp[1] = v[1]; tp[2] = v[2]; tp[3] = v[3];
        }
        __syncthreads();
        const int n = tid >> 3, k8 = (tid & 7) * 8, ngl = nti * 64 + n;
        float e[8];
#pragma unroll
        for (int i = 0; i < 8; ++i) e[i] = tile[(k8 + i) * 65 + n];
        if (ngl < N) { u32x4 w; w.x = cvt_pk_bf16(e[0], e[1]); w.y = cvt_pk_bf16(e[2], e[3]); w.z = cvt_pk_bf16(e[4], e[5]); w.w = cvt_pk_bf16(e[6], e[7]);
            *(u32x4*)(dst + (size_t)ngl * ldd + kti * 64 + k8) = w; }
        __syncthreads();
    }
}
__device__ __forceinline__ void rmsnorm_rows(const float* __restrict__ src, const float* __restrict__ w, bf16_t* __restrict__ dst, int rows, int gw, int nw) {
    const int lane = threadIdx.x & 63;
    for (int row = gw; row < rows; row += nw) {
        const f32x4* sp = (const f32x4*)(src + (size_t)row * DM);
        f32x4 v[16]; float ss = 0.f;
#pragma unroll
        for (int i = 0; i < 16; ++i) { v[i] = sp[lane + 64 * i]; ss += v[i][0] * v[i][0] + v[i][1] * v[i][1] + v[i][2] * v[i][2] + v[i][3] * v[i][3]; }
        ss = wave_sum(ss);
        const float rstd = rsqrtf(ss * (1.0f / DM) + EPS);
#pragma unroll
        for (int i = 0; i < 16; ++i) { const f32x4 ww = ((const f32x4*)w)[lane + 64 * i];
            u32x2 o; o.x = cvt_pk_bf16(v[i][0] * rstd * ww[0], v[i][1] * rstd * ww[1]); o.y = cvt_pk_bf16(v[i][2] * rstd * ww[2], v[i][3] * rstd * ww[3]);
            *(u32x2*)(dst + (size_t)row * DM + (lane + 64 * i) * 4) = o; }
    }
}

struct Ptrs {
    bf16_t *Win, *Wo, *Wfi, *Wfo, *Wg, *Wple, *Wpool, *Wc1k, *Wc1v, *XN, *PB, *Z, *M, *KC, *VC, *MIX, *HALO, *AB, *ACT, *ERAW;
    float *COS, *SIN, *TAB, *G, *H1, *L, *OACC, *IMPP, *IMPF, *ERSTD; unsigned* BM;
};

__device__ __forceinline__ void phase_prologue(const Params& P, const Ptrs& W, LAS unsigned char* lds) {
    const int bid = blockIdx.x, nb = gridDim.x, tid = threadIdx.x, lane = tid & 63, wv = tid >> 6;
    const int gw = bid * NWAVES + wv, nw = nb * NWAVES; const size_t gt = (size_t)bid * NTHREADS + tid, ntot = (size_t)nb * NTHREADS;
    LAS float* tile = (LAS float*)lds;
    rmsnorm_rows(P.x, P.norm1_w, W.XN, S_, gw, nw);
    convT(P.w_in, DM, INW, W.Win, DM, tile, bid, nb);
    for (size_t i = gt; i < (size_t)(LDZ - INW) * DM / 8; i += ntot) *(u32x4*)(W.Win + (size_t)INW * DM + i * 8) = (u32x4){0u, 0u, 0u, 0u};
    convT(P.w_o, DM, DM, W.Wo, DM, tile, bid, nb);
    convT(P.w_ffn_in, DM, NFI, W.Wfi, DM, tile, bid, nb);
    convT(P.w_ffn_out, DFF, DM, W.Wfo, DFF, tile, bid, nb);
    convT(P.w_ple_gate, DM, DM, W.Wg, DM, tile, bid, nb);
    convT(P.w_ple_proj, PLE, DM, W.Wple, PLE, tile, bid, nb);
    for (int g = 0; g < 4; ++g) convT(P.w_pool + (size_t)g * 65536, 256, 256, W.Wpool + (size_t)g * 65536, 256, tile, bid, nb);
    convT(P.cmp_k_w1, 4096, 256, W.Wc1k, 4096, tile, bid, nb);
    convT(P.cmp_v_w1, 4096, 256, W.Wc1v, 4096, tile, bid, nb);
    for (size_t i = gt; i < (size_t)S_ * PLE / 8; i += ntot) { const f32x4 a = *(const f32x4*)(P.p + i * 8), b = *(const f32x4*)(P.p + i * 8 + 4);
        u32x4 w; w.x = cvt_pk_bf16(a[0], a[1]); w.y = cvt_pk_bf16(a[2], a[3]); w.z = cvt_pk_bf16(b[0], b[1]); w.w = cvt_pk_bf16(b[2], b[3]); *(u32x4*)(W.PB + i * 8) = w; }
    for (size_t i = gt; i < (size_t)S_ * 16; i += ntot) { const int t = (int)(i >> 4), fi = (int)(i & 15);
        const float inv = exp2f(-(float)fi * (18.931568569324174f / 16.0f)); const float ang = (float)P.positions[t] * inv;
        const double ad = (double)ang; const double kk = rint(ad * 0.15915494309189535); const float rf = (float)(ad - kk * 6.283185307179586);
        W.COS[i] = __cosf(rf); W.SIN[i] = __sinf(rf); }
    for (int o = gw; o < 512; o += nw) { const int which = o >> 8, j = o & 255; const float* pe = which ? P.cmp_pos_v : P.cmp_pos_k; const float* w1 = which ? P.cmp_v_w1 : P.cmp_k_w1;
        float s = 0.f; for (int r = lane; r < 4096; r += 64) s += pe[r] * w1[(size_t)r * 256 + j];
        s = wave_sum(s); if (lane == 0) W.TAB[o] = s; }
    if (gw == 0) { float mq = fmaxf(fabsf(P.q_norm_w[lane]), fabsf(P.q_norm_w[lane + 64])); mq = wave_max(mq);
        float mc = wave_max(fmaxf(fabsf(P.k_norm_cmp_w[lane]), fabsf(P.k_norm_cmp_w[lane + 64])));
        float ms = wave_max(fmaxf(fabsf(P.k_norm_slc_w[lane]), fabsf(P.k_norm_slc_w[lane + 64])));
        float mw = wave_max(fmaxf(fabsf(P.k_norm_win_w[lane]), fabsf(P.k_norm_win_w[lane + 64])));
        const float c = 11.313708498984761f * 1.4426950408889634f * mq * 1.01f;
        if (lane == 0) { W.TAB[512] = c * mc; W.TAB[513] = c * ms; W.TAB[514] = c * mw; } }
}

__device__ __forceinline__ void phase_postz(const Params& P, const Ptrs& W) {
    const int tid = threadIdx.x, lane = tid & 63, gw = blockIdx.x * NWAVES + (tid >> 6), nw = gridDim.x * NWAVES;
    const f32x2 wq = *(const f32x2*)(P.q_norm_w + 2 * lane), wks = *(const f32x2*)(P.k_norm_slc_w + 2 * lane), wkw = *(const f32x2*)(P.k_norm_win_w + 2 * lane);
    for (int t = gw; t < S_; t += nw) {
        bf16_t* zr = W.Z + (size_t)t * LDZ;
        float cs0 = 0.f, cs1 = 0.f, sn0 = 0.f, sn1 = 0.f;
        if (lane < 16) { const int i0 = (2 * lane) & 15; cs0 = W.COS[t * 16 + i0]; cs1 = W.COS[t * 16 + i0 + 1]; sn0 = W.SIN[t * 16 + i0]; sn1 = W.SIN[t * 16 + i0 + 1]; }
        for (int v = 0; v < 32; ++v) {
            const int col = v < 24 ? OFF_Q + v * HD : (v < 28 ? OFF_KV + 2 * 512 + (v - 24) * HD : OFF_KV + 4 * 512 + (v - 28) * HD);
            const f32x2 ww = v < 24 ? wq : (v < 28 ? wks : wkw);
            unsigned* ptr = (unsigned*)(zr + col) + lane;
            const unsigned u = *ptr; const float x0 = bf_lo(u), x1 = bf_hi(u);
            const float ss = wave_sum(x0 * x0 + x1 * x1);
            const float rstd = rsqrtf(ss * (1.0f / HD) + EPS);
            float y0 = x0 * rstd * ww[0], y1 = x1 * rstd * ww[1];
            const float p0 = __shfl_xor(y0, 8), p1 = __shfl_xor(y1, 8);
            if (lane < 8) { y0 = y0 * cs0 - p0 * sn0; y1 = y1 * cs1 - p1 * sn1; }
            else if (lane < 16) { y0 = y0 * cs0 + p0 * sn0; y1 = y1 * cs1 + p1 * sn1; }
            *ptr = cvt_pk_bf16(y0, y1);
        }
        for (int c = lane; c < NGATE; c += 64) W.G[(size_t)t * NGATE + c] = sigmoidf_(bf2f(zr[OFF_G + c]));
        {
            const int gi = lane >> 4, wlen = 2 << gi, c0 = lane * 16; const int cnt = (t + 1) < wlen ? (t + 1) : wlen;
            float s[16];
#pragma unroll
            for (int i = 0; i < 16; ++i) s[i] = 0.f;
            float cur[16];
            for (int i = 0; i < cnt; ++i) { const u32x4 a = *(const u32x4*)(W.Z + (size_t)(t - i) * LDZ + c0), b = *(const u32x4*)(W.Z + (size_t)(t - i) * LDZ + c0 + 8);
                const float e[16] = {bf_lo(a.x), bf_hi(a.x), bf_lo(a.y), bf_hi(a.y), bf_lo(a.z), bf_hi(a.z), bf_lo(a.w), bf_hi(a.w), bf_lo(b.x), bf_hi(b.x), bf_lo(b.y), bf_hi(b.y), bf_lo(b.z), bf_hi(b.z), bf_lo(b.w), bf_hi(b.w)};
#pragma unroll
                for (int q = 0; q < 16; ++q) { s[q] += e[q]; if (i == 0) cur[q] = e[q]; } }
            const float rc = 1.0f / (float)cnt;
            u32x4 o0, o1;
            o0.x = cvt_pk_bf16(s[0] * rc - cur[0], s[1] * rc - cur[1]); o0.y = cvt_pk_bf16(s[2] * rc - cur[2], s[3] * rc - cur[3]);
            o0.z = cvt_pk_bf16(s[4] * rc - cur[4], s[5] * rc - cur[5]); o0.w = cvt_pk_bf16(s[6] * rc - cur[6], s[7] * rc - cur[7]);
            o1.x = cvt_pk_bf16(s[8] * rc - cur[8], s[9] * rc - cur[9]); o1.y = cvt_pk_bf16(s[10] * rc - cur[10], s[11] * rc - cur[11]);
            o1.z = cvt_pk_bf16(s[12] * rc - cur[12], s[13] * rc - cur[13]); o1.w = cvt_pk_bf16(s[14] * rc - cur[14], s[15] * rc - cur[15]);
            *(u32x4*)(W.M + (size_t)t * POOLW + c0) = o0; *(u32x4*)(W.M + (size_t)t * POOLW + c0 + 8) = o1;
        }
    }
}

__device__ __forceinline__ void phase_cmpfin(const Params& P, const Ptrs& W) {
    const int tid = threadIdx.x, lane = tid & 63, gw = blockIdx.x * NWAVES + (tid >> 6), nw = gridDim.x * NWAVES;
    const f32x2 wk = *(const f32x2*)(P.k_norm_cmp_w + 2 * lane);
    for (int task = gw; task < 8192; task += nw) {
        const int tk = __builtin_amdgcn_readfirstlane(task);
        const int which = tk >> 12, g = (tk >> 10) & 3, n = tk & 1023;
        bf16_t* dst = (which ? W.VC : W.KC) + ((size_t)g * 1024 + n) * HD;
        if (n == 1023) { ((unsigned*)dst)[lane] = 0u; continue; }
        const float* h = W.H1 + (size_t)tk * 256; const float* w2 = which ? P.cmp_v_w2 : P.cmp_k_w2;
        float a0 = 0.f, a1 = 0.f;
        for (int j = 0; j < 256; ++j) { const float hj = h[j]; const f32x2 wv = *(const f32x2*)(w2 + j * HD + 2 * lane); a0 += hj * wv[0]; a1 += hj * wv[1]; }
        if (which == 0) {
            const float ss = wave_sum(a0 * a0 + a1 * a1); const float rstd = rsqrtf(ss * (1.0f / HD) + EPS);
            a0 = a0 * rstd * wk[0]; a1 = a1 * rstd * wk[1];
            const int tp = 16 * n + 31; const float p0 = __shfl_xor(a0, 8), p1 = __shfl_xor(a1, 8);
            if (lane < 16) { const int i0 = (2 * lane) & 15; const float cs0 = W.COS[tp * 16 + i0], cs1 = W.COS[tp * 16 + i0 + 1], sn0 = W.SIN[tp * 16 + i0], sn1 = W.SIN[tp * 16 + i0 + 1];
                if (lane < 8) { a0 = a0 * cs0 - p0 * sn0; a1 = a1 * cs1 - p1 * sn1; } else { a0 = a0 * cs0 + p0 * sn0; a1 = a1 * cs1 + p1 * sn1; } }
        }
        ((unsigned*)dst)[lane] = cvt_pk_bf16(a0, a1);
    }
}

__device__ __forceinline__ void phase_conv(const Params& P, const Ptrs& W, int chunk) {
    const size_t gt = (size_t)blockIdx.x * NTHREADS + threadIdx.x, ntot = (size_t)gridDim.x * NTHREADS;
    constexpr int FG = DFF / 8;
    for (size_t it = gt; it < (size_t)(CHUNK / 16) * FG; it += ntot) {
        const int fg = (int)(it % FG), strip = (int)(it / FG), f0 = fg * 8, r0 = strip * 16;
        float w0[8], w1[8], w2[8], cb[8];
#pragma unroll
        for (int q = 0; q < 8; ++q) { w0[q] = P.conv_w[f0 + q]; w1[q] = P.conv_w[DFF + f0 + q]; w2[q] = P.conv_w[2 * DFF + f0 + q]; cb[q] = P.conv_b[f0 + q]; }
        float am2[8], am1[8];
#pragma unroll
        for (int q = 0; q < 8; ++q) { am2[q] = 0.f; am1[q] = 0.f; }
        auto unpack = [](const u32x4 a, float* e) { e[0] = bf_lo(a.x); e[1] = bf_hi(a.x); e[2] = bf_lo(a.y); e[3] = bf_hi(a.y); e[4] = bf_lo(a.z); e[5] = bf_hi(a.z); e[6] = bf_lo(a.w); e[7] = bf_hi(a.w); };
        if (r0 > 0) { unpack(*(const u32x4*)(W.AB + (size_t)(r0 - 2) * NFI + f0), am2); unpack(*(const u32x4*)(W.AB + (size_t)(r0 - 1) * NFI + f0), am1); }
        else if (chunk > 0) { unpack(*(const u32x4*)(W.HALO + f0), am2); unpack(*(const u32x4*)(W.HALO + DFF + f0), am1); }
        for (int r = r0; r < r0 + 16; ++r) {
            float a[8], b[8]; unpack(*(const u32x4*)(W.AB + (size_t)r * NFI + f0), a); unpack(*(const u32x4*)(W.AB + (size_t)r * NFI + DFF + f0), b);
            float o[8];
#pragma unroll
            for (int q = 0; q < 8; ++q) { const float y = cb[q] + w0[q] * am2[q] + w1[q] * am1[q] + w2[q] * a[q]; o[q] = y * sigmoidf_(y) * b[q]; am2[q] = am1[q]; am1[q] = a[q]; }
            u32x4 w; w.x = cvt_pk_bf16(o[0], o[1]); w.y = cvt_pk_bf16(o[2], o[3]); w.z = cvt_pk_bf16(o[4], o[5]); w.w = cvt_pk_bf16(o[6], o[7]);
            *(u32x4*)(W.ACT + (size_t)r * DFF + f0) = w;
        }
        if (chunk == 0 && r0 == CHUNK - 16) {
            u32x4 h2, h1; h2.x = cvt_pk_bf16(am2[0], am2[1]); h2.y = cvt_pk_bf16(am2[2], am2[3]); h2.z = cvt_pk_bf16(am2[4], am2[5]); h2.w = cvt_pk_bf16(am2[6], am2[7]);
            h1.x = cvt_pk_bf16(am1[0], am1[1]); h1.y = cvt_pk_bf16(am1[2], am1[3]); h1.z = cvt_pk_bf16(am1[4], am1[5]); h1.w = cvt_pk_bf16(am1[6], am1[7]);
            *(u32x4*)(W.HALO + f0) = h2; *(u32x4*)(W.HALO + DFF + f0) = h1;
        }
    }
}
__device__ __forceinline__ void phase_erstd(const Ptrs& W) {
    const int tid = threadIdx.x, lane = tid & 63, gw = blockIdx.x * NWAVES + (tid >> 6), nw = gridDim.x * NWAVES;
    for (int row = gw; row < S_; row += nw) {
        const u32x4* sp = (const u32x4*)(W.ERAW + (size_t)row * DM); float ss = 0.f;
#pragma unroll
        for (int i = 0; i < 8; ++i) { const u32x4 a = sp[lane + 64 * i];
            const float e0 = bf_lo(a.x), e1 = bf_hi(a.x), e2 = bf_lo(a.y), e3 = bf_hi(a.y), e4 = bf_lo(a.z), e5 = bf_hi(a.z), e6 = bf_lo(a.w), e7 = bf_hi(a.w);
            ss += e0 * e0 + e1 * e1 + e2 * e2 + e3 * e3 + e4 * e4 + e5 * e5 + e6 * e6 + e7 * e7; }
        ss = wave_sum(ss);
        if (lane == 0) W.ERSTD[row] = rsqrtf(ss * (1.0f / DM) + EPS);
    }
}

constexpr int N_PHASES = 19;
__device__ __forceinline__ Params kargs() {
#if defined(__HIP_DEVICE_COMPILE__)
    unsigned long long p = (unsigned long long)__builtin_amdgcn_kernarg_segment_ptr();
    asm volatile("" : "+s"(p));
    return *(const __attribute__((address_space(4))) Params*)p;
#else
    return Params{};
#endif
}
__device__ __forceinline__ Ptrs mkptrs(unsigned char* ws) {
    Ptrs W;
    W.Win = (bf16_t*)(ws + WS_WIN); W.Wo = (bf16_t*)(ws + WS_WO); W.Wfi = (bf16_t*)(ws + WS_WFI); W.Wfo = (bf16_t*)(ws + WS_WFO); W.Wg = (bf16_t*)(ws + WS_WG);
    W.Wple = (bf16_t*)(ws + WS_WPLE); W.Wpool = (bf16_t*)(ws + WS_WPOOL); W.Wc1k = (bf16_t*)(ws + WS_WC1K); W.Wc1v = (bf16_t*)(ws + WS_WC1V);
    W.XN = (bf16_t*)(ws + WS_XN); W.PB = (bf16_t*)(ws + WS_PB); W.Z = (bf16_t*)(ws + WS_Z); W.M = (bf16_t*)(ws + WS_M); W.KC = (bf16_t*)(ws + WS_KC); W.VC = (bf16_t*)(ws + WS_VC);
    W.MIX = (bf16_t*)(ws + WS_MIX); W.HALO = (bf16_t*)(ws + WS_HALO); W.AB = (bf16_t*)(ws + WS_AB); W.ACT = (bf16_t*)(ws + WS_ACT); W.ERAW = (bf16_t*)(ws + WS_ERAW);
    W.COS = (float*)(ws + WS_COS); W.SIN = (float*)(ws + WS_SIN); W.TAB = (float*)(ws + WS_TAB); W.G = (float*)(ws + WS_G); W.H1 = (float*)(ws + WS_H1); W.L = (float*)(ws + WS_L);
    W.OACC = (float*)(ws + WS_OACC); W.IMPP = (float*)(ws + WS_IMPP); W.IMPF = (float*)(ws + WS_IMPF); W.ERSTD = (float*)(ws + WS_ERSTD); W.BM = (unsigned*)(ws + WS_BM);
    return W;
}
__global__ void __launch_bounds__(NTHREADS, 2) fwd(Params Punused) {
    extern __shared__ __attribute__((aligned(16))) unsigned char lds_raw[];
    LAS unsigned char* lds = (LAS unsigned char*)lds_raw;
    const int tid = threadIdx.x;
    const int G = gridDim.x, bid = blockIdx.x;
    const int gw = bid * NWAVES + (tid >> 6), nw = G * NWAVES;

    if (tid < 16) ((LAS unsigned*)(lds + LDS_MISC))[tid] = 0u;
    __syncthreads();
    int lo, hi; XcdBarrier bar;
    { const Params P = kargs(); lo = P.ph_lo; hi = P.ph_hi;
      bar.bar = (unsigned*)(P.ws + WS_CTL); bar.x = 0; bar.st = (volatile LAS unsigned*)(lds + LDS_MISC);
      if (hi - lo > 1) bar = xcd_barrier_post((unsigned*)(P.ws + WS_CTL), (volatile LAS unsigned*)(lds + LDS_MISC)); }
#ifdef PH_MASK
#define IN(k) (((PH_MASK >> (k)) & 1) && lo <= (k) && (k) < hi)
#else
#define IN(k) (lo <= (k) && (k) < hi)
#endif
#define SEAM(k) do { if (IN(k) && IN((k) + 1)) xcd_barrier(bar); } while (0)
#define PHASE_VARS const Params P = kargs(); const Ptrs W = mkptrs(P.ws); (void)W;
#define ATT_ARGS att::AttnArgs AA{W.Z, W.KC, W.VC, W.G, W.L, W.OACC, W.MIX, W.BM, W.TAB};

    if (IN(0)) { PHASE_VARS phase_prologue(P, W, lds); SEAM(0); }
    if (IN(1)) {
        PHASE_VARS
        pg8::GStd g{(const char*)W.XN, (const char*)W.Win, DM, DM, DM / 64}; pg8::StaticOrder S; S.init(S_ / 256, LDZ / 256, G, bid);
        pg8::EpiBf16 E{W.Z, LDZ};
        pg8::gemm_phase(lds, g, S, E); SEAM(1);
    }
    if (IN(2)) { PHASE_VARS phase_postz(P, W); SEAM(2); }
    if (IN(3)) {
        PHASE_VARS
#ifndef NO_CMPG
        { pg8::GCmp g{(const char*)W.Z, (const char*)W.Wc1k, (const char*)W.Wc1v, 16 * LDZ, 4096, 64}; pg8::StaticOrder S; S.init(32, 1, G, bid);
          pg8::EpiCmpGelu E{W.H1, W.TAB}; pg8::gemm_phase(lds, g, S, E); }
#endif
#ifndef NO_POOLG
        { pg8::GPool g{(const char*)W.M, (const char*)W.Wpool, POOLW, 256, 4}; pg8::StaticOrder S; S.init(S_ / 256, 4, G, (bid + G - 32) % G);
          pg8::EpiBf16Scale E{W.MIX, DM, P.pool_scale}; pg8::gemm_phase(lds, g, S, E); }
#endif
        SEAM(3);
    }
    if (IN(4)) { PHASE_VARS phase_cmpfin(P, W); SEAM(4); }
    if (IN(5)) {
        PHASE_VARS ATT_ARGS
        for (int base = 0, rnd = 0; base < 1536; base += G, ++rnd) { const int Lu = base + ((rnd & 1) ? G - 1 - bid : bid); if (Lu >= 1536) continue;
            const int qt = Lu / 12, rem = Lu % 12, g = rem / 3, hp = rem % 3;
            att::attn_unit<att::MODE_CMP>(AA, (LAS char*)lds, qt, g, hp);
            asm volatile("s_waitcnt vmcnt(0)" ::: "memory");
            att::attn_unit<att::MODE_WIN>(AA, (LAS char*)lds, qt, g, hp); }
        SEAM(5);
    }
    if (IN(6)) { PHASE_VARS ATT_ARGS for (int task = gw; task < 4096; task += nw) att::imp_task(AA, W.IMPP, W.IMPF, task >> 2, task & 3); SEAM(6); }
    if (IN(7)) { PHASE_VARS for (int task = gw; task < S_ * 4; task += nw) att::topk_task(W.IMPP, W.IMPF, W.BM, task >> 2, task & 3); SEAM(7); }
    if (IN(8)) {
        PHASE_VARS ATT_ARGS
        for (int base = 0, rnd = 0; base < 1536; base += G, ++rnd) { const int Lu = base + ((rnd & 1) ? G - 1 - bid : bid); if (Lu >= 1536) continue;
            const int qt = Lu / 12, rem = Lu % 12, g = rem / 3, hp = rem % 3;
            att::attn_unit<att::MODE_SLC>(AA, (LAS char*)lds, qt, g, hp); }
        SEAM(8);
    }
    if (IN(9)) {
        PHASE_VARS
        pg8::GStd g{(const char*)W.MIX, (const char*)W.Wo, DM, DM, DM / 64}; pg8::StaticOrder S; S.init(S_ / 256, DM / 256, G, bid);
        pg8::EpiResF32 E{P.x, P.out, DM, 0}; pg8::gemm_phase(lds, g, S, E); SEAM(9);
    }
    if (IN(10)) {
        PHASE_VARS
        rmsnorm_rows(P.out, P.norm2_w, W.XN, S_, gw, nw);
        pg8::GStd g{(const char*)W.PB, (const char*)W.Wple, PLE, PLE, PLE / 64}; pg8::StaticOrder S; S.init(S_ / 256, DM / 256, G, bid);
        pg8::EpiBf16 E{W.ERAW, DM}; pg8::gemm_phase(lds, g, S, E); SEAM(10);
    }
#pragma unroll
    for (int c = 0; c < 2; ++c) {
        if (IN(11 + 3 * c)) {
            PHASE_VARS
            pg8::GStd g{(const char*)(W.XN + (size_t)c * CHUNK * DM), (const char*)W.Wfi, DM, DM, DM / 64}; pg8::StaticOrder S; S.init(CHUNK / 256, NFI / 256, G, bid);
            pg8::EpiBf16 E{W.AB, NFI}; pg8::gemm_phase(lds, g, S, E); SEAM(11 + 3 * c);
        }
        if (IN(12 + 3 * c)) { PHASE_VARS phase_conv(P, W, c); if (c == 0) phase_erstd(W); SEAM(12 + 3 * c); }
        if (IN(13 + 3 * c)) {
            PHASE_VARS
            pg8::GStd g{(const char*)W.ACT, (const char*)W.Wfo, DFF, DFF, DFF / 64}; pg8::StaticOrder S; S.init(CHUNK / 256, DM / 256, G, bid);
            pg8::EpiResF32 E{P.out, P.out, DM, c * CHUNK}; pg8::gemm_phase(lds, g, S, E); SEAM(13 + 3 * c);
        }
    }
    if (IN(17)) { PHASE_VARS rmsnorm_rows(P.out, P.ple_gate_norm_w, W.XN, S_, gw, nw); SEAM(17); }
    if (IN(18)) {
        PHASE_VARS
        pg8::GStd g{(const char*)W.XN, (const char*)W.Wg, DM, DM, DM / 64}; pg8::StaticOrder S; S.init(S_ / 256, DM / 256, G, bid);
        pg8::EpiGate E{P.out, W.ERAW, W.ERSTD, P.ple_norm_w, DM}; pg8::gemm_phase(lds, g, S, E);
    }
#undef IN
#undef SEAM
}

extern "C" void kernel_launch(void* const* d_in, const int* in_sizes, int n_in, void* d_out, int out_size, void* d_ws, size_t ws_size, hipStream_t stream) {
    static int grid = 0;
    if (grid == 0) {
        if (n_in != 27 || in_sizes[0] != S_ * DM || out_size != S_ * DM || ws_size < WS_NEED) {
            fprintf(stderr, "kernel_launch: unexpected shapes (n_in %d, in0 %d, out %d, ws %zu < %zu); nothing launched\n", n_in, n_in > 0 ? in_sizes[0] : -1, out_size, ws_size, (size_t)WS_NEED); grid = -1; return; }
        int dev = 0, cus = 0, per_cu = 0;
        if (hipGetDevice(&dev) != hipSuccess || hipDeviceGetAttribute(&cus, hipDeviceAttributeMultiprocessorCount, dev) != hipSuccess) { grid = -1; return; }
        if (hipFuncSetAttribute((const void*)fwd, hipFuncAttributeMaxDynamicSharedMemorySize, LDS_BYTES) != hipSuccess) { fprintf(stderr, "kernel_launch: hipFuncSetAttribute failed\n"); grid = -1; return; }
        if (hipOccupancyMaxActiveBlocksPerMultiprocessor(&per_cu, (const void*)fwd, NTHREADS, LDS_BYTES) != hipSuccess || per_cu < 1) { fprintf(stderr, "kernel_launch: occupancy query says %d\n", per_cu); (void)hipGetLastError(); }
        grid = cus > 256 ? 256 : cus;
    }
    if (grid < 0) return;
    (void)hipMemsetAsync((char*)d_ws + WS_CTL, 0, CTL_BYTES, stream);
    Params P{};
    const float** fp = (const float**)&P;
    P.x = (const float*)d_in[0]; P.p = (const float*)d_in[1]; P.positions = (const int*)d_in[2]; P.norm1_w = (const float*)d_in[3]; P.w_in = (const float*)d_in[4];
    P.w_pool = (const float*)d_in[5]; P.pool_scale = (const float*)d_in[6]; P.q_norm_w = (const float*)d_in[7]; P.k_norm_cmp_w = (const float*)d_in[8];
    P.k_norm_slc_w = (const float*)d_in[9]; P.k_norm_win_w = (const float*)d_in[10]; P.cmp_pos_k = (const float*)d_in[11]; P.cmp_pos_v = (const float*)d_in[12];
    P.cmp_k_w1 = (const float*)d_in[13]; P.cmp_k_w2 = (const float*)d_in[14]; P.cmp_v_w1 = (const float*)d_in[15]; P.cmp_v_w2 = (const float*)d_in[16];
    P.w_o = (const float*)d_in[17]; P.norm2_w = (const float*)d_in[18]; P.w_ffn_in = (const float*)d_in[19]; P.conv_w = (const float*)d_in[20]; P.conv_b = (const float*)d_in[21];
    P.w_ffn_out = (const float*)d_in[22]; P.w_ple_proj = (const float*)d_in[23]; P.ple_norm_w = (const float*)d_in[24]; P.ple_gate_norm_w = (const float*)d_in[25]; P.w_ple_gate = (const float*)d_in[26];
    (void)fp;
    P.out = (float*)d_out; P.ws = (unsigned char*)d_ws;
#if MK_ONE_LAUNCH
    P.ph_lo = 0; P.ph_hi = N_PHASES;
    hipLaunchKernelGGL(fwd, dim3(grid), dim3(NTHREADS), LDS_BYTES, stream, P);
#else
    for (int ph = 0; ph < N_PHASES; ++ph) { P.ph_lo = ph; P.ph_hi = ph + 1; hipLaunchKernelGGL(fwd, dim3(grid), dim3(NTHREADS), LDS_BYTES, stream, P); }
#endif
    const hipError_t le = hipPeekAtLastError();
    if (le != hipSuccess) fprintf(stderr, "kernel_launch: launch failed: %s\n", hipGetErrorName(le));
}
```

```cpp
#include <hip/hip_runtime.h>
#include <cstdio>
#include <cstdint>

#ifndef PROBE_DBL
#define PROBE_DBL 0
#endif
#define REP(k) _Pragma("unroll") for (int rep_ = 0; rep_ < 1 + ((PROBE_DBL >> (k)) & 1); ++rep_)
#ifndef MK_ONE_LAUNCH
#define MK_ONE_LAUNCH 1
#endif

#define LAS __attribute__((address_space(3)))
typedef unsigned short bf16_t;
typedef short bf16x8 __attribute__((ext_vector_type(8)));
typedef short s16x4 __attribute__((ext_vector_type(4)));
typedef float f32x2 __attribute__((ext_vector_type(2)));
typedef float f32x4 __attribute__((ext_vector_type(4)));
typedef float f32x16 __attribute__((ext_vector_type(16)));
typedef unsigned u32x2 __attribute__((ext_vector_type(2)));
typedef unsigned u32x4 __attribute__((ext_vector_type(4)));

constexpr int S_ = 16384, DM = 4096, INW = 7240, LDZ = 7424, POOLW = 1024, NH = 24, NKV = 4, HPG = 6, HD = 128;
constexpr int OFF_Q = 1024, OFF_KV = 4096, OFF_G = 7168, DFF = 11008, NFI = 22016, PLE = 256, NGATE = 72;
constexpr int ZROWS = S_ + 64, XNROWS = S_ + 256, CHUNK = 8192;
constexpr float EPS = 1e-6f;
constexpr float SM_C = 0.08838834764831845f * 1.4426950408889634f;
constexpr int NWAVES = 8, NTHREADS = 512;

constexpr size_t al256(size_t x) { return (x + 255) / 256 * 256; }
constexpr size_t WS_CTL   = 0;
constexpr size_t CTL_BYTES = 65536;
constexpr size_t WS_WIN   = WS_CTL + CTL_BYTES;
constexpr size_t WS_WO    = WS_WIN + al256((size_t)LDZ * DM * 2);
constexpr size_t WS_WFI   = WS_WO + al256((size_t)DM * DM * 2);
constexpr size_t WS_WFO   = WS_WFI + al256((size_t)NFI * DM * 2);
constexpr size_t WS_WG    = WS_WFO + al256((size_t)DM * DFF * 2);
constexpr size_t WS_WPLE  = WS_WG + al256((size_t)DM * DM * 2);
constexpr size_t WS_WPOOL = WS_WPLE + al256((size_t)DM * PLE * 2);
constexpr size_t WS_WC1K  = WS_WPOOL + al256((size_t)1024 * 256 * 2);
constexpr size_t WS_WC1V  = WS_WC1K + al256((size_t)256 * 4096 * 2);
constexpr size_t WS_COS   = WS_WC1V + al256((size_t)256 * 4096 * 2);
constexpr size_t WS_SIN   = WS_COS + al256((size_t)S_ * 16 * 4);
constexpr size_t WS_TAB   = WS_SIN + al256((size_t)S_ * 16 * 4);
constexpr size_t WS_XNP   = WS_TAB + 4096;
constexpr size_t WS_XN    = WS_XNP + (size_t)2 * DM * 2;
constexpr size_t WS_PB    = WS_XN + al256((size_t)XNROWS * DM * 2);
constexpr size_t WS_R     = WS_PB + al256((size_t)S_ * PLE * 2);
constexpr size_t WS_Z     = WS_R;
constexpr size_t WS_M     = WS_Z + al256((size_t)ZROWS * LDZ * 2);
constexpr size_t WS_G     = WS_M + al256((size_t)S_ * POOLW * 2);
constexpr size_t WS_H1    = WS_G + al256((size_t)S_ * NGATE * 4);
constexpr size_t WS_KC    = WS_H1 + al256((size_t)8192 * 256 * 4);
constexpr size_t WS_VC    = WS_KC + al256((size_t)4 * 1024 * 128 * 2);
constexpr size_t WS_L     = WS_VC + al256((size_t)4 * 1024 * 128 * 2);
constexpr size_t WS_OACC  = WS_L + al256((size_t)S_ * NH * 4);
constexpr size_t WS_IMPP  = WS_OACC + al256((size_t)S_ * 3072 * 4);
constexpr size_t WS_IMPF  = WS_IMPP + al256((size_t)S_ * 4 * 256 * 4);
constexpr size_t WS_BM    = WS_IMPF + al256((size_t)S_ * 4 * 256 * 4);
constexpr size_t WS_MIX   = WS_BM + al256((size_t)S_ * 4 * 8 * 4);
constexpr size_t WS_END_A = WS_MIX + al256((size_t)S_ * DM * 2);
constexpr size_t WS_ACT   = WS_R;
constexpr size_t WS_ERAW  = WS_ACT + al256((size_t)S_ * DFF * 2);
constexpr size_t WS_ERSTD = WS_ERAW + al256((size_t)S_ * DM * 2);
constexpr size_t WS_END_B = WS_ERSTD + al256((size_t)S_ * 4);
constexpr size_t WS_NEED  = WS_END_A > WS_END_B ? WS_END_A : WS_END_B;
static_assert(WS_MIX >= WS_END_B || true, "");

constexpr int LDS_STAGE = 131072;
constexpr int LDS_MISC  = LDS_STAGE;
constexpr int LDS_XCH   = LDS_STAGE + 64;
constexpr int LDS_BYTES = LDS_XCH + 4096;

__device__ __forceinline__ unsigned cvt_pk_bf16(float lo, float hi) { unsigned r; asm volatile("v_cvt_pk_bf16_f32 %0, %1, %2" : "=v"(r) : "v"(lo), "v"(hi)); return r; }
__device__ __forceinline__ float bf_lo(unsigned u) { return __uint_as_float(u << 16); }
__device__ __forceinline__ float bf_hi(unsigned u) { return __uint_as_float(u & 0xffff0000u); }
__device__ __forceinline__ float bf2f(bf16_t b) { return __uint_as_float(((unsigned)b) << 16); }
__device__ __forceinline__ float wave_sum(float v) {
#pragma unroll
    for (int o = 32; o >= 1; o >>= 1) v += __shfl_xor(v, o);
    return v;
}
__device__ __forceinline__ float wave_max(float v) {
#pragma unroll
    for (int o = 32; o >= 1; o >>= 1) v = fmaxf(v, __shfl_xor(v, o));
    return v;
}
__device__ __forceinline__ float sigmoidf_(float x) { return 1.0f / (1.0f + __expf(-x)); }

#define XB_TMO      128
#define XB_XCNT(j)  (256  + 64 * (j))
#define XB_XSUB(j)  (1280 + 64 * (j))
#define XB_XGEN(j)  (2304 + 64 * (j))
#define XB_TOP      3328
#define XB_TOPGEN   3392
#define XCD_BAR_WORDS 3456
#define XB_SPIN_CAP (1u << 18)
__device__ __forceinline__ unsigned xb_ld(unsigned* p)              { return __hip_atomic_load(p, __ATOMIC_RELAXED, __HIP_MEMORY_SCOPE_AGENT); }
__device__ __forceinline__ unsigned xb_add(unsigned* p, unsigned v) { return __hip_atomic_fetch_add(p, v, __ATOMIC_RELAXED, __HIP_MEMORY_SCOPE_AGENT); }
__device__ __forceinline__ unsigned xb_xcc_id() { return (unsigned)__builtin_amdgcn_s_getreg((3 << 11) | 20) & 0xFu; }
#define XB_SPIN(cond, bar) do { unsigned _sp = 0; while (cond) { __builtin_amdgcn_s_sleep(1); \
    if ((++_sp & 255u) == 0u) { if (xb_ld(&(bar)[XB_TMO])) break; if (_sp > XB_SPIN_CAP) { atomicAdd(&(bar)[XB_TMO], 1u); break; } } } } while (0)
struct XcdBarrier { unsigned* bar; unsigned x; volatile LAS unsigned* st; };
__device__ __forceinline__ XcdBarrier xcd_barrier_post(unsigned* bar, volatile LAS unsigned* st) {
    XcdBarrier b; b.bar = bar; b.x = xb_xcc_id(); b.st = st;
    if (threadIdx.x == 0) (void)xb_add(&bar[XB_XCNT(b.x)], 1u);
    return b;
}
__device__ __forceinline__ void xcd_barrier_complete(unsigned* bar, unsigned x, unsigned& nloc, unsigned& nx) {
    const unsigned G = gridDim.x * gridDim.y * gridDim.z;
    unsigned sum, cnt, mine, sp = 0u;
    for (;;) {
        sum = 0u; cnt = 0u; mine = 0u;
#pragma unroll
        for (unsigned j = 0; j < 16; ++j) { const unsigned c = xb_ld(&bar[XB_XCNT(j)]); sum += c; cnt += (c > 0u) ? 1u : 0u; mine = (j == x) ? c : mine; }
        if (sum == G) break;
        __builtin_amdgcn_s_sleep(1);
        if ((++sp & 255u) == 0u) { if (xb_ld(&bar[XB_TMO])) break; if (sp > XB_SPIN_CAP) { atomicAdd(&bar[XB_TMO], 1u); break; } }
    }
    nloc = mine > 0u ? mine : 1u; nx = cnt > 0u ? cnt : 1u;
}
__device__ __forceinline__ void xcd_barrier(const XcdBarrier& b) {
    asm volatile("s_waitcnt vmcnt(0)" ::: "memory");
    __syncthreads();
    if (threadIdx.x == 0) {
        unsigned* bar = b.bar;
        __builtin_amdgcn_s_waitcnt(0);
        unsigned nloc = b.st[0], nx = b.st[1];
        if (nloc == 0u) { xcd_barrier_complete(bar, b.x, nloc, nx); b.st[0] = nloc; b.st[1] = nx; }
        const unsigned old = xb_add(&bar[XB_XSUB(b.x)], 1u);
        const unsigned gen = old / nloc;
        if (old + 1u == (gen + 1u) * nloc) {
            __builtin_amdgcn_fence(__ATOMIC_RELEASE, "agent");
            asm volatile("s_waitcnt vmcnt(0)" ::: "memory");
            const unsigned og = xb_add(&bar[XB_TOP], 1u);
            const unsigned tg = og / nx;
            if (og + 1u == (tg + 1u) * nx) xb_add(&bar[XB_TOPGEN], 1u);
            else XB_SPIN(xb_ld(&bar[XB_TOPGEN]) == tg, bar);
            __builtin_amdgcn_fence(__ATOMIC_ACQUIRE, "agent");
            xb_add(&bar[XB_XGEN(b.x)], 1u);
            asm volatile("s_waitcnt vmcnt(0)" ::: "memory");
        } else {
            XB_SPIN(xb_ld(&bar[XB_XGEN(b.x)]) == gen, bar);
            __builtin_amdgcn_fence(__ATOMIC_ACQUIRE, "agent");
            asm volatile("s_waitcnt vmcnt(0)" ::: "memory");
        }
    }
    __syncthreads();
}

struct Params {
    const float* x; const float* p; const int* positions; const float* norm1_w; const float* w_in; const float* w_pool; const float* pool_scale;
    const float* q_norm_w; const float* k_norm_cmp_w; const float* k_norm_slc_w; const float* k_norm_win_w; const float* cmp_pos_k; const float* cmp_pos_v;
    const float* cmp_k_w1; const float* cmp_k_w2; const float* cmp_v_w1; const float* cmp_v_w2; const float* w_o; const float* norm2_w; const float* w_ffn_in;
    const float* conv_w; const float* conv_b; const float* w_ffn_out; const float* w_ple_proj; const float* ple_norm_w; const float* ple_gate_norm_w; const float* w_ple_gate;
    float* out; unsigned char* ws; int ph_lo, ph_hi;
};

namespace pg8 {
constexpr int BM = 256, BK = 64, HALF = 128, HTB = HALF * BK * 2, STAGE_BYTES = 8 * HTB, NXCD = 8, WGM = 8;
__host__ __device__ __forceinline__ int lds_byte(int r, int c) { const int st = (r >> 4) * 2 + (c >> 5), rr = r & 15, cc = c & 31, ob = rr * 64 + cc * 2; return st * 1024 + (ob ^ (((ob >> 9) & 1) << 5)); }
__host__ __device__ __forceinline__ void stage_rc(int b, int& R, int& C) { const int st = b / 1024, sb = b % 1024, swz = sb ^ (((sb >> 9) & 1) << 5); R = (st >> 1) * 16 + swz / 64; C = (st & 1) * 32 + (swz % 64) / 2; }
__host__ __device__ __forceinline__ int perm32(int rho) { const int n = rho >> 4, i = rho & 15; return 8 * (i >> 2) + 4 * n + (i & 3); }
struct Unit { int pm, pn; };

struct StaticOrder {
    int nM, nN, nwg, G, c;
    __device__ void init(int nM_, int nN_, int G_, int c_) { nM = nM_; nN = nN_; nwg = nM * nN; G = G_; c = c_; }
    __device__ bool next(int i, Unit& u) const {
        const long L = (long)i * G + c; if (L >= nwg) return false;
        int wgid = (int)L; { const int q = nwg / NXCD, r = nwg % NXCD, xcd = wgid % NXCD, off = wgid / NXCD; wgid = (xcd < r ? xcd * (q + 1) : r * (q + 1) + (xcd - r) * q) + off; }
        const int nig = WGM * nN, gid = wgid / nig, fm = gid * WGM, gsz = (nM - fm) < WGM ? (nM - fm) : WGM;
        u.pm = fm + ((wgid % nig) % gsz); u.pn = (wgid % nig) / gsz; return true;
    }
};

struct GStd {
    const char* A; const char* B; unsigned lda, ldb; int nt;
    __device__ __forceinline__ const char* a_base(const Unit& u) const { return A + (size_t)u.pm * 256 * lda * 2; }
    __device__ __forceinline__ const char* b_base(const Unit& u) const { return B + (size_t)u.pn * 256 * ldb * 2; }
    __device__ __forceinline__ size_t kpairA() const { return 256; }
};
struct GPool {
    const char* A; const char* B; unsigned lda, ldb; int nt;
    __device__ __forceinline__ const char* a_base(const Unit& u) const { return A + (size_t)u.pm * 256 * lda * 2 + (size_t)u.pn * 512; }
    __device__ __forceinline__ const char* b_base(const Unit& u) const { return B + (size_t)u.pn * 256 * ldb * 2; }
    __device__ __forceinline__ size_t kpairA() const { return 256; }
};
struct GCmp {
    const char* Z; const char* Bk; const char* Bv; unsigned lda, ldb; int nt;
    __device__ __forceinline__ const char* a_base(const Unit& u) const { const int which = u.pm >> 4, g = (u.pm >> 2) & 3, rt = u.pm & 3;
        return Z + (size_t)(OFF_KV + which * 512 + g * 128) * 2 + (size_t)rt * 256 * lda * 2; }
    __device__ __forceinline__ const char* b_base(const Unit& u) const { return (u.pm >> 4) ? Bv : Bk; }
    __device__ __forceinline__ size_t kpairA() const { return (size_t)LDZ * 2; }
};

struct EpiBf16 {
    static constexpr bool PERM = true;
    bf16_t* O; int ldc;
    __device__ __forceinline__ void operator()(const f32x4 (&acc)[2][2][4][2], const Unit& u, int wr, int wc, int fr, int fq) const {
        const int row0 = u.pm * BM + wr * 64 + fr, col0 = u.pn * BM + wc * 32 + 8 * fq;
#pragma unroll
        for (int ai = 0; ai < 2; ++ai)
#pragma unroll
            for (int m = 0; m < 4; ++m) { bf16_t* rowp = O + (size_t)(row0 + ai * HALF + m * 16) * ldc + col0;
#pragma unroll
                for (int bj = 0; bj < 2; ++bj) { const f32x4 v0 = acc[ai][bj][m][0], v1 = acc[ai][bj][m][1];
                    u32x4 w; w.x = cvt_pk_bf16(v0[0], v0[1]); w.y = cvt_pk_bf16(v0[2], v0[3]); w.z = cvt_pk_bf16(v1[0], v1[1]); w.w = cvt_pk_bf16(v1[2], v1[3]);
                    *(u32x4*)(rowp + bj * HALF) = w; } }
    }
};
struct EpiBf16Scale {
    static constexpr bool PERM = true;
    bf16_t* O; int ldc; const float* colscale;
    __device__ __forceinline__ void operator()(const f32x4 (&acc)[2][2][4][2], const Unit& u, int wr, int wc, int fr, int fq) const {
        const int row0 = u.pm * BM + wr * 64 + fr, col0 = u.pn * BM + wc * 32 + 8 * fq;
#pragma unroll
        for (int bj = 0; bj < 2; ++bj) { const f32x4 s0 = *(const f32x4*)(colscale + col0 + bj * HALF), s1 = *(const f32x4*)(colscale + col0 + bj * HALF + 4);
#pragma unroll
            for (int ai = 0; ai < 2; ++ai)
#pragma unroll
                for (int m = 0; m < 4; ++m) { bf16_t* rowp = O + (size_t)(row0 + ai * HALF + m * 16) * ldc + col0;
                    const f32x4 v0 = acc[ai][bj][m][0] * s0, v1 = acc[ai][bj][m][1] * s1;
                    u32x4 w; w.x = cvt_pk_bf16(v0[0], v0[1]); w.y = cvt_pk_bf16(v0[2], v0[3]); w.z = cvt_pk_bf16(v1[0], v1[1]); w.w = cvt_pk_bf16(v1[2], v1[3]);
                    *(u32x4*)(rowp + bj * HALF) = w; } }
    }
};
struct EpiResF32 {
    static constexpr bool PERM = false;
    const float* base; float* C; int ldc; int row_off;
    __device__ __forceinline__ void operator()(const f32x4 (&acc)[2][2][4][2], const Unit& u, int wr, int wc, int fr, int fq) const {
        const int row0 = u.pm * BM + wr * 64 + fr + row_off, col0 = u.pn * BM + wc * 32 + 4 * fq;
#pragma unroll
        for (int ai = 0; ai < 2; ++ai)
#pragma unroll
            for (int m = 0; m < 4; ++m) { const size_t off = (size_t)(row0 + ai * HALF + m * 16) * ldc + col0;
#pragma unroll
                for (int bj = 0; bj < 2; ++bj)
#pragma unroll
                    for (int n = 0; n < 2; ++n) { const f32x4 b = *(const f32x4*)(base + off + bj * HALF + n * 16); *(f32x4*)(C + off + bj * HALF + n * 16) = b + acc[ai][bj][m][n]; }
                asm volatile("" ::: "memory"); }
    }
};
struct EpiCmpGelu {
    static constexpr bool PERM = false;
    float* H; const float* bias;
    __device__ __forceinline__ void operator()(const f32x4 (&acc)[2][2][4][2], const Unit& u, int wr, int wc, int fr, int fq) const {
        const int row0 = u.pm * BM + wr * 64 + fr, col0 = wc * 32 + 4 * fq; const float* bs = bias + (u.pm >> 4) * 256;
#pragma unroll
        for (int ai = 0; ai < 2; ++ai)
#pragma unroll
            for (int m = 0; m < 4; ++m) { float* rowp = H + (size_t)(row0 + ai * HALF + m * 16) * 256 + col0;
#pragma unroll
                for (int bj = 0; bj < 2; ++bj)
#pragma unroll
                    for (int n = 0; n < 2; ++n) { const f32x4 b = *(const f32x4*)(bs + col0 + bj * HALF + n * 16); f32x4 v = acc[ai][bj][m][n] + b;
#pragma unroll
                        for (int j = 0; j < 4; ++j) { const float xx = v[j], uu = 0.7978845608028654f * (xx + 0.044715f * xx * xx * xx); const float th = 1.0f - 2.0f / (1.0f + __expf(2.0f * uu)); v[j] = 0.5f * xx * (1.0f + th); }
                        *(f32x4*)(rowp + bj * HALF + n * 16) = v; } }
    }
};
struct EpiGate {
    static constexpr bool PERM = false;
    float* C; const bf16_t* eraw; const float* erstd; const float* pw; int ldc;
    __device__ __forceinline__ void operator()(const f32x4 (&acc)[2][2][4][2], const Unit& u, int wr, int wc, int fr, int fq) const {
        const int row0 = u.pm * BM + wr * 64 + fr, col0 = u.pn * BM + wc * 32 + 4 * fq;
        f32x4 wv[2][2];
#pragma unroll
        for (int bj = 0; bj < 2; ++bj)
#pragma unroll
            for (int n = 0; n < 2; ++n) wv[bj][n] = *(const f32x4*)(pw + col0 + bj * HALF + n * 16);
#pragma unroll
        for (int ai = 0; ai < 2; ++ai)
#pragma unroll
            for (int m = 0; m < 4; ++m) { const int row = row0 + ai * HALF + m * 16; const size_t off = (size_t)row * ldc + col0; const float rs = erstd[row];
#pragma unroll
                for (int bj = 0; bj < 2; ++bj)
#pragma unroll
                    for (int n = 0; n < 2; ++n) { const f32x4 b = *(const f32x4*)(C + off + bj * HALF + n * 16); const u32x2 e = *(const u32x2*)(eraw + off + bj * HALF + n * 16);
                        const f32x4 a = acc[ai][bj][m][n]; f32x4 o;
                        o[0] = b[0] + bf_lo(e.x) * rs * wv[bj][n][0] * sigmoidf_(a[0]); o[1] = b[1] + bf_hi(e.x) * rs * wv[bj][n][1] * sigmoidf_(a[1]);
                        o[2] = b[2] + bf_lo(e.y) * rs * wv[bj][n][2] * sigmoidf_(a[2]); o[3] = b[3] + bf_hi(e.y) * rs * wv[bj][n][3] * sigmoidf_(a[3]);
                        *(f32x4*)(C + off + bj * HALF + n * 16) = o; }
                asm volatile("" ::: "memory"); }
    }
};

struct GFfn {
    const char* A; const char* B; unsigned lda, ldb; int nt;
    __device__ __forceinline__ const char* a_base(const Unit& u) const { return A + ((long)u.pm * 254 - 2) * (long)lda * 2; }
    __device__ __forceinline__ const char* b_base(const Unit& u) const { return B + (size_t)u.pn * 256 * ldb * 2; }
    __device__ __forceinline__ size_t kpairA() const { return 256; }
};
template <int CTRL> __device__ __forceinline__ float dpp_f(float v) { return __int_as_float(__builtin_amdgcn_update_dpp(0, __float_as_int(v), CTRL, 0xf, 0xf, false)); }
struct EpiFfn {
    static constexpr bool PERM = true;
    bf16_t* ACT; const float* cw; const float* cb; LAS float* X;
    __device__ __forceinline__ void operator()(const f32x4 (&acc)[2][2][4][2], const Unit& u, int wr, int wc, int fr, int fq) const {
        const int colw = wc * 32 + 8 * fq;
        if (fr >= 14) {
#pragma unroll
            for (int ai = 0; ai < 2; ++ai)
#pragma unroll
                for (int n = 0; n < 2; ++n) *(LAS f32x4*)(X + ((2 * ai + wr) * 2 + (fr - 14)) * 128 + colw + 4 * n) = acc[ai][0][3][n];
        }
        asm volatile("s_waitcnt lgkmcnt(0)" ::: "memory");
        __builtin_amdgcn_s_barrier(); asm volatile("" ::: "memory");
        __builtin_amdgcn_s_barrier(); asm volatile("" ::: "memory");
        const int f0 = u.pn * 128 + colw;
        f32x4 w0[2], w1[2], w2[2], cbv[2];
#pragma unroll
        for (int n = 0; n < 2; ++n) { w0[n] = *(const f32x4*)(cw + f0 + 4 * n); w1[n] = *(const f32x4*)(cw + DFF + f0 + 4 * n); w2[n] = *(const f32x4*)(cw + 2 * DFF + f0 + 4 * n); cbv[n] = *(const f32x4*)(cb + f0 + 4 * n); }
#pragma unroll
        for (int ai = 0; ai < 2; ++ai) {
            f32x4 pv[2];
            const int pseg = 2 * ai + wr - 1;
#pragma unroll
            for (int n = 0; n < 2; ++n) { pv[n] = (f32x4){0.f, 0.f, 0.f, 0.f}; if (pseg >= 0 && fr >= 14) pv[n] = *(const LAS f32x4*)(X + (pseg * 2 + (fr - 14)) * 128 + colw + 4 * n); }
#pragma unroll
            for (int m = 0; m < 4; ++m) {
                const int r = ai * HALF + wr * 64 + m * 16 + fr; const long t = (long)u.pm * 254 - 2 + r;
                unsigned ow[4];
#pragma unroll
                for (int n = 0; n < 2; ++n) {
                    const f32x4 cur = acc[ai][0][m][n], up = acc[ai][1][m][n]; f32x4 o;
#pragma unroll
                    for (int i = 0; i < 4; ++i) {
                        const float c1 = dpp_f<0x121>(cur[i]), p1 = dpp_f<0x121>(pv[n][i]), c2 = dpp_f<0x122>(cur[i]), p2 = dpp_f<0x122>(pv[n][i]);
                        const float x1 = fr >= 1 ? c1 : p1, x2 = fr >= 2 ? c2 : p2;
                        const float y = cbv[n][i] + w0[n][i] * x2 + w1[n][i] * x1 + w2[n][i] * cur[i];
                        o[i] = y * sigmoidf_(y) * up[i];
                    }
                    ow[2 * n] = cvt_pk_bf16(o[0], o[1]); ow[2 * n + 1] = cvt_pk_bf16(o[2], o[3]);
                    pv[n] = cur;
                }
                if (r >= 2 && t < S_) *(u32x4*)(ACT + (size_t)t * DFF + f0) = (u32x4){ow[0], ow[1], ow[2], ow[3]};
            }
        }
    }
};

template <class GD, class Epi>
__device__ __forceinline__ void gemm_phase(LAS unsigned char* lds, const GD g, const StaticOrder& S, const Epi& E) {
    const int tid = threadIdx.x, wid = __builtin_amdgcn_readfirstlane(tid >> 6), lane = tid & 63, wr = wid >> 2, wc = wid & 3, fr = lane & 15, fq = lane >> 4;
    const int nt = g.nt;
    unsigned voffA[2], voffB[2];
#pragma unroll
    for (int i = 0; i < 2; ++i) { int R, C; stage_rc(tid * 16 + i * 8192, R, C); const int Rb = Epi::PERM ? ((R & ~31) + perm32(R & 31)) : R;
        voffA[i] = (unsigned)(R * g.lda + C) * 2u; voffB[i] = (unsigned)(Rb * g.ldb + C) * 2u; }
    const size_t kpA = g.kpairA();
    const size_t hstepA = (size_t)HALF * g.lda * 2, hstepB = (size_t)HALF * g.ldb * 2;
    const unsigned ldsw = (unsigned)wid * 1024u;
    const int aoff = lds_byte(wr * 64 + fr, fq * 8), boff = lds_byte(wc * 32 + fr, fq * 8);
#define PG8_SA(b, h) (((b) * 2 + (h)) * HTB)
#define PG8_SB(b, h) ((4 + (b) * 2 + (h)) * HTB)
#define PG8_STAGE(bufoff, gbase, voff) do { _Pragma("unroll") for (int _i = 0; _i < 2; ++_i) \
        __builtin_amdgcn_global_load_lds((const unsigned*)((const char*)(gbase) + (voff)[_i]), (LAS unsigned*)(lds + (bufoff) + ldsw + _i * 8192), 16, 0, 0); } while (0)
#define PG8_LDA(dst, b, h) do { _Pragma("unroll") for (int m = 0; m < 4; ++m) _Pragma("unroll") for (int k = 0; k < 2; ++k) dst[m][k] = *(const LAS bf16x8*)(lds + PG8_SA(b, h) + aoff + m * 2048 + k * 1024); } while (0)
#define PG8_LDB(dst, b, h) do { _Pragma("unroll") for (int n = 0; n < 2; ++n) _Pragma("unroll") for (int k = 0; k < 2; ++k) dst[n][k] = *(const LAS bf16x8*)(lds + PG8_SB(b, h) + boff + n * 2048 + k * 1024); } while (0)
#define PG8_MMA(ai, bj, At, Bt) do { __builtin_amdgcn_s_setprio(1); _Pragma("unroll") for (int m = 0; m < 4; ++m) _Pragma("unroll") for (int n = 0; n < 2; ++n) _Pragma("unroll") for (int k = 0; k < 2; ++k) \
        acc[ai][bj][m][n] = __builtin_amdgcn_mfma_f32_16x16x32_bf16(Bt[n][k], At[m][k], acc[ai][bj][m][n], 0, 0, 0); __builtin_amdgcn_s_setprio(0); } while (0)
#define PG8_WAIT_V(n) asm volatile("s_waitcnt vmcnt(" #n ")" ::: "memory")
#define PG8_WAIT_L(n) asm volatile("s_waitcnt lgkmcnt(" #n ")" ::: "memory")
#define PG8_BAR __builtin_amdgcn_s_barrier()
#define PG8_SCHED __builtin_amdgcn_sched_barrier(0)
    Unit cur, nxt; int ui = 0;
    if (!S.next(0, cur)) return;
    f32x4 acc[2][2][4][2];
#pragma unroll
    for (int a = 0; a < 2; ++a)
#pragma unroll
        for (int b = 0; b < 2; ++b)
#pragma unroll
            for (int m = 0; m < 4; ++m)
#pragma unroll
                for (int n = 0; n < 2; ++n) acc[a][b][m][n] = (f32x4){0.f, 0.f, 0.f, 0.f};
    bf16x8 At[4][2], B0[2][2], B1[2][2];
    const char* cA = g.a_base(cur); const char* cB = g.b_base(cur);
    PG8_STAGE(PG8_SB(0, 0), cB, voffB); PG8_STAGE(PG8_SA(0, 0), cA, voffA); PG8_STAGE(PG8_SB(0, 1), cB + hstepB, voffB); PG8_STAGE(PG8_SA(0, 1), cA + hstepA, voffA);
    if (wr == 1) PG8_BAR;
    PG8_WAIT_V(4); PG8_BAR;
    PG8_STAGE(PG8_SB(1, 0), cB + 128, voffB); PG8_STAGE(PG8_SA(1, 0), cA + 128, voffA); PG8_STAGE(PG8_SB(1, 1), cB + hstepB + 128, voffB);
    PG8_WAIT_V(6); PG8_BAR;
    for (;;) {
        const bool has_next = S.next(ui + 1, nxt);
        const char* nA = has_next ? g.a_base(nxt) : cA; const char* nB = has_next ? g.b_base(nxt) : cB;
        for (int t = 0; t < nt; t += 2) {
            const bool last = (t == nt - 2);
            const char* a0 = cA + (size_t)(t >> 1) * kpA;
            const char* a1 = a0 + 128;
            const char* a2 = last ? nA : a0 + kpA; const char* b2 = last ? nB : cB + (size_t)(t + 2) * 128;
            const char* a3 = a2 + 128; const char* b3 = b2 + 128;
            PG8_LDB(B0, 0, 0); PG8_SCHED; PG8_LDA(At, 0, 0); PG8_STAGE(PG8_SA(1, 1), a1 + hstepA, voffA);
            PG8_WAIT_L(8); PG8_BAR; PG8_WAIT_L(0); PG8_MMA(0, 0, At, B0); PG8_BAR; PG8_SCHED;
            PG8_LDB(B1, 0, 1); PG8_STAGE(PG8_SB(0, 0), b2, voffB);
            PG8_BAR; PG8_WAIT_L(0); PG8_MMA(0, 1, At, B1); PG8_BAR;
            PG8_LDA(At, 0, 1); PG8_STAGE(PG8_SA(0, 0), a2, voffA);
            PG8_BAR; PG8_WAIT_L(0); PG8_MMA(1, 0, At, B0); PG8_BAR; PG8_SCHED;
            PG8_STAGE(PG8_SB(0, 1), b2 + hstepB, voffB);
            PG8_WAIT_V(6); PG8_BAR; PG8_MMA(1, 1, At, B1); PG8_BAR;
            PG8_LDB(B0, 1, 0); PG8_SCHED; PG8_LDA(At, 1, 0); PG8_STAGE(PG8_SA(0, 1), a2 + hstepA, voffA);
            PG8_WAIT_L(8); PG8_BAR; PG8_WAIT_L(0); PG8_MMA(0, 0, At, B0); PG8_BAR; PG8_SCHED;
            PG8_LDB(B1, 1, 1); PG8_STAGE(PG8_SB(1, 0), b3, voffB);
            PG8_BAR; PG8_WAIT_L(0); PG8_MMA(0, 1, At, B1); PG8_BAR;
            PG8_LDA(At, 1, 1); PG8_STAGE(PG8_SA(1, 0), a3, voffA);
            PG8_BAR; PG8_WAIT_L(0); PG8_MMA(1, 0, At, B0); PG8_BAR; PG8_SCHED;
            PG8_STAGE(PG8_SB(1, 1), b3 + hstepB, voffB);
            PG8_WAIT_V(6); PG8_BAR; PG8_MMA(1, 1, At, B1); PG8_BAR;
        }
        E(acc, cur, wr, wc, fr, fq);
        if (!has_next) break;
#pragma unroll
        for (int a = 0; a < 2; ++a)
#pragma unroll
            for (int b = 0; b < 2; ++b)
#pragma unroll
                for (int m = 0; m < 4; ++m)
#pragma unroll
                    for (int n = 0; n < 2; ++n) acc[a][b][m][n] = (f32x4){0.f, 0.f, 0.f, 0.f};
        cur = nxt; cA = nA; cB = nB; ++ui;
    }
    PG8_WAIT_V(0);
    if (wr == 0) PG8_BAR;
    PG8_BAR;
#undef PG8_SA
#undef PG8_SB
#undef PG8_STAGE
#undef PG8_LDA
#undef PG8_LDB
#undef PG8_MMA
#undef PG8_WAIT_V
#undef PG8_WAIT_L
#undef PG8_BAR
#undef PG8_SCHED
}
}

namespace att {
constexpr int KVBLK = 64;
constexpr int SHM_V = KVBLK * HD * 2, SHM_K = KVBLK * HD * 2, SHM_ATTN = 2 * SHM_V + 2 * SHM_K + NWAVES * 64 * 4;
#define KSWZ(row, colB) ((row) * 256 + ((colB) ^ (((row) & 7) << 4)))
#define SBAR() __builtin_amdgcn_sched_barrier(0)
__device__ __forceinline__ int crow(int r, int hi) { return (r & 3) + 8 * (r >> 2) + 4 * hi; }
__device__ __forceinline__ void qkt(f32x16& p0, f32x16& p1, const char* Ks, const bf16x8* qr, int r32, int hi) {
    p0 = f32x16{}; p1 = f32x16{};
#pragma unroll
    for (int d0 = 0; d0 < 8; ++d0) { const int cb = (d0 * 16 + hi * 8) * 2;
        const bf16x8 b0 = *reinterpret_cast<const bf16x8*>(Ks + KSWZ(r32, cb));
        const bf16x8 b1 = *reinterpret_cast<const bf16x8*>(Ks + KSWZ(32 + r32, cb));
        p0 = __builtin_amdgcn_mfma_f32_32x32x16_bf16(b0, qr[d0], p0, 0, 0, 0);
        p1 = __builtin_amdgcn_mfma_f32_32x32x16_bf16(b1, qr[d0], p1, 0, 0, 0); }
}
__device__ __forceinline__ int v_st(int k, int c) { const int kk = (k & ~0xC) | ((k & 4) << 1) | ((k & 8) >> 1); return ((kk >> 3) * 4 + (c >> 5)) * 512 + ((kk & 7) * 32 + (c & 31)) * 2; }
__device__ __forceinline__ int v_rd_base(int lane) { return ((lane & 3) << 3) | (((lane >> 2) & 3) << 6) | (((lane >> 4) & 1) << 5) | (((lane >> 5) & 1) << 8); }
constexpr int v_rd_off(int d0, int ks, int half) { return d0 * 512 + ks * 4096 + half * 2048; }
template <int OFF> __device__ __forceinline__ s16x4 tr_read(int vb) {
    s16x4 r; asm volatile("ds_read_b64_tr_b16 %0, %1 offset:%2" : "=&v"(r) : "v"(vb), "i"(OFF) : "memory"); return r;
}
template <int D0> __device__ __forceinline__ void pv_one(f32x16& od, int vb, bf16x8 pa0, bf16x8 pa1, bf16x8 pa2, bf16x8 pa3) {
    const s16x4 l0 = tr_read<v_rd_off(D0, 0, 0)>(vb), h0 = tr_read<v_rd_off(D0, 0, 1)>(vb), l1 = tr_read<v_rd_off(D0, 1, 0)>(vb), h1 = tr_read<v_rd_off(D0, 1, 1)>(vb);
    const s16x4 l2 = tr_read<v_rd_off(D0, 2, 0)>(vb), h2 = tr_read<v_rd_off(D0, 2, 1)>(vb), l3 = tr_read<v_rd_off(D0, 3, 0)>(vb), h3 = tr_read<v_rd_off(D0, 3, 1)>(vb);
    asm volatile("s_waitcnt lgkmcnt(0)" ::: "memory"); SBAR();
#define PK(L, H) (bf16x8){L[0], L[1], L[2], L[3], H[0], H[1], H[2], H[3]}
    od = __builtin_amdgcn_mfma_f32_32x32x16_bf16(pa0, PK(l0, h0), od, 0, 0, 0);
    od = __builtin_amdgcn_mfma_f32_32x32x16_bf16(pa1, PK(l1, h1), od, 0, 0, 0);
    od = __builtin_amdgcn_mfma_f32_32x32x16_bf16(pa2, PK(l2, h2), od, 0, 0, 0);
    od = __builtin_amdgcn_mfma_f32_32x32x16_bf16(pa3, PK(l3, h3), od, 0, 0, 0);
#undef PK
}
__device__ __forceinline__ void pv_d0(f32x16* o, int vb, bf16x8 pa0, bf16x8 pa1, bf16x8 pa2, bf16x8 pa3) {
    pv_one<0>(o[0], vb, pa0, pa1, pa2, pa3); pv_one<1>(o[1], vb, pa0, pa1, pa2, pa3); pv_one<2>(o[2], vb, pa0, pa1, pa2, pa3); pv_one<3>(o[3], vb, pa0, pa1, pa2, pa3);
}
__device__ __forceinline__ void pack_p(const f32x16& p0, const f32x16& p1, bf16x8& pa0, bf16x8& pa1, bf16x8& pa2, bf16x8& pa3) {
#define PK4(P, BASE, OUT) do { unsigned a0 = cvt_pk_bf16(P[BASE + 0], P[BASE + 1]), a1 = cvt_pk_bf16(P[BASE + 2], P[BASE + 3]);   \
    unsigned b0 = cvt_pk_bf16(P[BASE + 4], P[BASE + 5]), b1 = cvt_pk_bf16(P[BASE + 6], P[BASE + 7]);                              \
    auto r0 = __builtin_amdgcn_permlane32_swap(a0, b0, false, false); auto r1 = __builtin_amdgcn_permlane32_swap(a1, b1, false, false); \
    u32x4 w = {r0[0], r1[0], r0[1], r1[1]}; OUT = *reinterpret_cast<bf16x8*>(&w); } while (0)
    PK4(p0, 0, pa0); PK4(p0, 8, pa1); PK4(p1, 0, pa2); PK4(p1, 8, pa3);
#undef PK4
}

enum { MODE_CMP = 0, MODE_WIN = 1, MODE_SLC = 2 };
struct AttnArgs {
    const bf16_t* Z; const bf16_t* KC; const bf16_t* VC; const float* G; float* L; float* OACC; bf16_t* MIX; const unsigned* BM; const float* TAB;
};
template <int MODE>
__device__ __forceinline__ void attn_unit(const AttnArgs& a, LAS char* ldsL, int qt, int g, int hp) {
    char* lds = (char*)ldsL;
    const int tid = threadIdx.x, wid = __builtin_amdgcn_readfirstlane(tid >> 6), lane = tid & 63, r32 = lane & 31, hi = lane >> 5;
    char* V_lds = lds; char* K_lds = lds + 2 * SHM_V;
    float* li_l = (float*)(lds + 2 * SHM_V + 2 * SHM_K) + wid * 64;
    const int t0 = qt * 128, tq = t0 + wid * 16 + (r32 & 15), hq = g * HPG + hp * 2 + (r32 >> 4);
    const bf16_t* Kb; const bf16_t* Vb; long ldk;
    if (MODE == MODE_CMP) { Kb = a.KC + (size_t)g * 1024 * HD; Vb = a.VC + (size_t)g * 1024 * HD; ldk = HD; }
    else if (MODE == MODE_WIN) { Kb = a.Z + OFF_KV + 4 * 512 + g * HD; Vb = a.Z + OFF_KV + 5 * 512 + g * HD; ldk = LDZ; }
    else { Kb = a.Z + OFF_KV + 2 * 512 + g * HD; Vb = a.Z + OFF_KV + 3 * 512 + g * HD; ldk = LDZ; }
    int j0, j1;
    if (MODE == MODE_CMP) { j0 = 0; j1 = (((t0 + 127 - 31) >> 4) >> 6) + 1; }
    else if (MODE == MODE_WIN) { j0 = (t0 - 511) > 0 ? ((t0 - 511) >> 6) : 0; j1 = ((t0 + 127) >> 6) + 1; }
    else { j0 = 0; j1 = ((t0 + 127) >> 6) + 1; }
    int klo, khi;
    if (MODE == MODE_CMP) { klo = 0; khi = tq >= 31 ? ((tq - 31) >> 4) : -1; }
    else if (MODE == MODE_WIN) { klo = tq - 511; khi = tq; }
    else { klo = 0; khi = tq; }
    const float negBC = -a.TAB[512 + (MODE == MODE_CMP ? 0 : (MODE == MODE_SLC ? 1 : 2))];
    bf16x8 qr[8];
    { const bf16_t* Qw = a.Z + (size_t)tq * LDZ + OFF_Q + hq * HD + hi * 8;
#pragma unroll
      for (int d0 = 0; d0 < 8; ++d0) qr[d0] = *reinterpret_cast<const bf16x8*>(Qw + d0 * 16); }
    f32x16 o[4] = {}; float lsum = 0.f;
    const int sr = tid >> 4, sc = (tid & 15) * 8, vst0 = v_st(sr, sc), vst1 = v_st(32 + sr, sc);
    const int vb0 = (int)(uintptr_t)(LAS char*)ldsL + v_rd_base(lane);
    bf16x8 vs0, vs1, ks0, ks1;
#define SLOAD(k0) do { vs0 = *reinterpret_cast<const bf16x8*>(Vb + (long)((k0) + sr) * ldk + sc); vs1 = *reinterpret_cast<const bf16x8*>(Vb + (long)((k0) + 32 + sr) * ldk + sc); \
    ks0 = *reinterpret_cast<const bf16x8*>(Kb + (long)((k0) + sr) * ldk + sc); ks1 = *reinterpret_cast<const bf16x8*>(Kb + (long)((k0) + 32 + sr) * ldk + sc); } while (0)
#define SWRITE(b) do { *(bf16x8*)(V_lds + (b) * SHM_V + vst0) = vs0; *(bf16x8*)(V_lds + (b) * SHM_V + vst1) = vs1; const int kc = sc * 2; \
    *(bf16x8*)(K_lds + (b) * SHM_K + KSWZ(sr, kc)) = ks0; *(bf16x8*)(K_lds + (b) * SHM_K + KSWZ(32 + sr, kc)) = ks1; } while (0)
    unsigned bmw = 0u;
    __syncthreads();
    SLOAD(j0 * KVBLK); asm volatile("s_waitcnt vmcnt(0)" ::: "memory"); SWRITE(0); __syncthreads();
    for (int j = j0; j < j1; ++j) {
        const int buf = (j - j0) & 1;
        if (j + 1 < j1) SLOAD((j + 1) * KVBLK);
        int lhi = khi;
        if (MODE == MODE_SLC) { if ((j & 31) == 0 || j == j0) bmw = a.BM[((size_t)tq * 4 + g) * 8 + (j >> 5)]; if (!((bmw >> (j & 31)) & 1u)) lhi = -1; }
        const int kb = j * KVBLK;
        const bool l_any = (kb + 63 >= klo) && (kb <= lhi);
        const bool l_full = (kb >= klo) && (kb + 63 <= lhi);
        if (__any(l_any)) {
            f32x16 p0, p1;
            qkt(p0, p1, K_lds + buf * SHM_K, qr, r32, hi);
            if (__all(l_full || !l_any)) {
                const float off = l_any ? negBC : -1.0e30f;
#pragma unroll
                for (int r = 0; r < 16; ++r) { p0[r] = __builtin_amdgcn_exp2f(fmaf(p0[r], SM_C, off)); p1[r] = __builtin_amdgcn_exp2f(fmaf(p1[r], SM_C, off)); }
            } else {
#pragma unroll
                for (int r = 0; r < 16; ++r) { const int k0i = kb + crow(r, hi), k1i = k0i + 32;
                    const float e0 = __builtin_amdgcn_exp2f(fmaf(p0[r], SM_C, negBC)), e1 = __builtin_amdgcn_exp2f(fmaf(p1[r], SM_C, negBC));
                    p0[r] = (k0i >= klo && k0i <= lhi) ? e0 : 0.f; p1[r] = (k1i >= klo && k1i <= lhi) ? e1 : 0.f; }
            }
            float ps = 0.f;
#pragma unroll
            for (int r = 0; r < 16; ++r) ps += p0[r] + p1[r];
            lsum += ps;
            bf16x8 pa0, pa1, pa2, pa3; pack_p(p0, p1, pa0, pa1, pa2, pa3);
            pv_d0(o, vb0 + buf * SHM_V, pa0, pa1, pa2, pa3);
        }
        if (j + 1 < j1) { asm volatile("s_waitcnt vmcnt(0)" ::: "memory"); SWRITE(buf ^ 1); }
        __syncthreads();
    }
#undef SLOAD
#undef SWRITE
    lsum += __shfl_xor(lsum, 32);
    if (hi == 0) li_l[r32] = lsum;
    if (MODE == MODE_CMP) { if (hi == 0) a.L[(size_t)tq * NH + hq] = lsum; }
    asm volatile("s_waitcnt lgkmcnt(0)" ::: "memory");
#pragma unroll
    for (int r = 0; r < 16; ++r) {
        const int orow = crow(r, hi); const float lv = li_l[orow]; const float rl = lv > 0.f ? 1.0f / lv : 0.f;
        const int t = t0 + wid * 16 + (orow & 15), h = g * HPG + hp * 2 + (orow >> 4);
        const float gt = a.G[(size_t)t * NGATE + h * 3 + (MODE == MODE_CMP ? 0 : (MODE == MODE_SLC ? 1 : 2))] * rl;
        float* oa = a.OACC + (size_t)t * 3072 + h * HD + r32;
#pragma unroll
        for (int d0 = 0; d0 < 4; ++d0) {
            const float v = o[d0][r] * gt;
            if (MODE == MODE_CMP) oa[d0 * 32] = v;
            else if (MODE == MODE_WIN) oa[d0 * 32] += v;
            else a.MIX[(size_t)t * DM + POOLW + h * HD + d0 * 32 + r32] = (bf16_t)(cvt_pk_bf16(oa[d0 * 32] + v, 0.f) & 0xffffu);
        }
    }
}

__device__ __forceinline__ void imp_task(const AttnArgs& a, float* IMPP, float* IMPF, int tqi, int g) {
    const int lane = threadIdx.x & 63, fr = lane & 15, fq = lane >> 4;
    const int t = tqi * 16 + fr;
    const int tmax = tqi * 16 + 15;
    if (tmax < 31) return;
    const int lim = t >= 31 ? ((t - 31) >> 4) : -1;
    const int nstep = ((((tmax - 31) >> 4) >> 6) + 1) * 4;
    const float negBC = -a.TAB[512];
    bf16x8 qf[HPG][4]; float rl[HPG];
#pragma unroll
    for (int h = 0; h < HPG; ++h) {
        const bf16_t* qp = a.Z + (size_t)t * LDZ + OFF_Q + (g * HPG + h) * HD + fq * 8;
#pragma unroll
        for (int ks = 0; ks < 4; ++ks) qf[h][ks] = *reinterpret_cast<const bf16x8*>(qp + ks * 32);
        const float lv = a.L[(size_t)t * NH + g * HPG + h]; rl[h] = lv > 0.f ? 1.0f / lv : 0.f;
    }
    const bf16_t* kbase = a.KC + (size_t)g * 1024 * HD + (size_t)fr * HD + fq * 8;
    bf16x8 kf[4], kn[4];
#pragma unroll
    for (int ks = 0; ks < 4; ++ks) kf[ks] = *reinterpret_cast<const bf16x8*>(kbase + ks * 32);
    float* op = IMPP + ((size_t)t * 4 + g) * 256 + fq; float* of = IMPF + ((size_t)t * 4 + g) * 256 + fq;
    for (int st = 0; st < nstep; ++st) {
        const int sn = (st + 1 < nstep) ? st + 1 : st;
#pragma unroll
        for (int ks = 0; ks < 4; ++ks) kn[ks] = *reinterpret_cast<const bf16x8*>(kbase + (size_t)sn * 16 * HD + ks * 32);
        f32x4 imp4 = {0.f, 0.f, 0.f, 0.f};
        const int n0 = st * 16 + fq * 4;
#pragma unroll
        for (int h = 0; h < HPG; ++h) {
            f32x4 acc = {0.f, 0.f, 0.f, 0.f};
#pragma unroll
            for (int ks = 0; ks < 4; ++ks) acc = __builtin_amdgcn_mfma_f32_16x16x32_bf16(kf[ks], qf[h][ks], acc, 0, 0, 0);
#pragma unroll
            for (int i = 0; i < 4; ++i) { const float e = __builtin_amdgcn_exp2f(fmaf(acc[i], SM_C, negBC)) * rl[h]; imp4[i] += (n0 + i <= lim) ? e : 0.f; }
        }
        op[st * 4] = imp4[0] + 2.0f * (imp4[1] + imp4[2] + imp4[3]);
        of[st * 4] = imp4[0];
#pragma unroll
        for (int ks = 0; ks < 4; ++ks) kf[ks] = kn[ks];
    }
}

__device__ __forceinline__ void topk_task(const float* IMPP, const float* IMPF, unsigned* BM, int t, int g) {
    const int lane = threadIdx.x & 63;
    const int cur = t >> 6;
    unsigned nib = 0u;
    if (cur <= 15) { const int jb = lane * 4;
#pragma unroll
        for (int c = 0; c < 4; ++c) if (jb + c <= cur) nib |= 1u << c; }
    else {
        const size_t base = ((size_t)t * 4 + g) * 256;
        const int jb = lane * 4;
        unsigned key[4];
        {
            f32x4 pp = {0.f, 0.f, 0.f, 0.f}, ff = {0.f, 0.f, 0.f, 0.f};
            if (jb <= cur) { pp = *(const f32x4*)(IMPP + base + jb); ff = *(const f32x4*)(IMPF + base + jb); }
            float fnext = __shfl_down(ff[0], 1);
            if (lane == 63) fnext = 0.f;
            const float v0 = pp[0] + ff[1], v1 = pp[1] + ff[2], v2 = pp[2] + ff[3], v3 = pp[3] + fnext;
            key[0] = (jb + 0 >= 1 && jb + 0 <= cur - 2) ? __float_as_uint(fmaxf(v0, 0.f)) + 1u : 0u;
            key[1] = (jb + 1 >= 1 && jb + 1 <= cur - 2) ? __float_as_uint(fmaxf(v1, 0.f)) + 1u : 0u;
            key[2] = (jb + 2 >= 1 && jb + 2 <= cur - 2) ? __float_as_uint(fmaxf(v2, 0.f)) + 1u : 0u;
            key[3] = (jb + 3 >= 1 && jb + 3 <= cur - 2) ? __float_as_uint(fmaxf(v3, 0.f)) + 1u : 0u;
        }
        unsigned prefix = 0u; bool exact = false;
        for (int b = 30; b >= 0; --b) {
            const unsigned trial = prefix | (1u << b);
            const int cnt = __popcll(__ballot(key[0] >= trial)) + __popcll(__ballot(key[1] >= trial)) + __popcll(__ballot(key[2] >= trial)) + __popcll(__ballot(key[3] >= trial));
            if (cnt >= 13) { prefix = trial; if (cnt == 13) { exact = true; break; } }
        }
#pragma unroll
        for (int c = 0; c < 4; ++c) if (exact ? (key[c] >= prefix) : (key[c] > prefix)) nib |= 1u << c;
        if (!exact) {
            int need = 13 - (__popcll(__ballot(key[0] > prefix)) + __popcll(__ballot(key[1] > prefix)) + __popcll(__ballot(key[2] > prefix)) + __popcll(__ballot(key[3] > prefix)));
            unsigned tie = 0u;
#pragma unroll
            for (int c = 0; c < 4; ++c) if (key[c] == prefix) tie |= 1u << c;
            for (int guard = 0; need > 0 && guard < 16; ++guard) {
                const unsigned long long any = __ballot(tie != 0u);
                if (any == 0ull) break;
                const int L = __builtin_ctzll(any);
                if (lane == L) { const unsigned low = tie & (0u - tie); nib |= low; tie ^= low; }
                --need;
            }
        }
        if (lane == 0) nib |= 1u;
        if (lane == (cur >> 2)) nib |= 1u << (cur & 3);
        if (lane == ((cur - 1) >> 2)) nib |= 1u << ((cur - 1) & 3);
    }
    unsigned x = nib << (4 * (lane & 7));
    x |= __shfl_xor(x, 1); x |= __shfl_xor(x, 2); x |= __shfl_xor(x, 4);
    if ((lane & 7) == 0) BM[((size_t)t * 4 + g) * 8 + (lane >> 3)] = x;
}
#undef KSWZ
}

template <bool FFN_REMAP = false>
__device__ __forceinline__ void convT(const float* __restrict__ src, int K, int N, bf16_t* __restrict__ dst, int ldd, LAS float* tile, int bid, int nb) {
    const int tid = threadIdx.x, tk = K >> 6, tn = (N + 63) >> 6, total = tk * tn;
    for (int idx = bid; idx < total; idx += nb) {
        const int nti = idx % tn, kti = idx / tn;
        const int r = tid >> 4, c4 = (tid & 15) * 4, ng = nti * 64 + c4;
#pragma unroll
        for (int h = 0; h < 2; ++h) {
            f32x4 v = {0.f, 0.f, 0.f, 0.f};
            if (ng < N) v = *(const f32x4*)(src + (size_t)(kti * 64 + r + h * 32) * N + ng);
            LAS float* tp = tile + (r + h * 32) * 65 + c4;
            tp[0] = v[0]; tp[1] = v[1]; tp[2] = v[2]; tp[3] = v[3];
        }
        __syncthreads();
        const int n = tid >> 3, k8 = (tid & 7) * 8, ngl = nti * 64 + n;
        float e[8];
#pragma unroll
        for (int i = 0; i < 8; ++i) e[i] = tile[(k8 + i) * 65 + n];
        if (ngl < N) { u32x4 w; w.x = cvt_pk_bf16(e[0], e[1]); w.y = cvt_pk_bf16(e[2], e[3]); w.z = cvt_pk_bf16(e[4], e[5]); w.w = cvt_pk_bf16(e[6], e[7]);
            int drow = ngl; if (FFN_REMAP) { const int up = ngl >= DFF ? 1 : 0, f = ngl - up * DFF; drow = (f >> 7) * 256 + up * 128 + (f & 127); }
            *(u32x4*)(dst + (size_t)drow * ldd + kti * 64 + k8) = w; }
        __syncthreads();
    }
}
__device__ __forceinline__ void rmsnorm_rows(const float* __restrict__ src, const float* __restrict__ w, bf16_t* __restrict__ dst, int rows, int gw, int nw) {
    const int lane = threadIdx.x & 63;
    for (int row = gw; row < rows; row += nw) {
        const f32x4* sp = (const f32x4*)(src + (size_t)row * DM);
        f32x4 v[16]; float ss = 0.f;
#pragma unroll
        for (int i = 0; i < 16; ++i) { v[i] = sp[lane + 64 * i]; ss += v[i][0] * v[i][0] + v[i][1] * v[i][1] + v[i][2] * v[i][2] + v[i][3] * v[i][3]; }
        ss = wave_sum(ss);
        const float rstd = rsqrtf(ss * (1.0f / DM) + EPS);
#pragma unroll
        for (int i = 0; i < 16; ++i) { const f32x4 ww = ((const f32x4*)w)[lane + 64 * i];
            u32x2 o; o.x = cvt_pk_bf16(v[i][0] * rstd * ww[0], v[i][1] * rstd * ww[1]); o.y = cvt_pk_bf16(v[i][2] * rstd * ww[2], v[i][3] * rstd * ww[3]);
            *(u32x2*)(dst + (size_t)row * DM + (lane + 64 * i) * 4) = o; }
    }
}

struct Ptrs {
    bf16_t *Win, *Wo, *Wfi, *Wfo, *Wg, *Wple, *Wpool, *Wc1k, *Wc1v, *XN, *PB, *Z, *M, *KC, *VC, *MIX, *ACT, *ERAW;
    float *COS, *SIN, *TAB, *G, *H1, *L, *OACC, *IMPP, *IMPF, *ERSTD; unsigned* BM;
};

__device__ __forceinline__ void phase_prologue(const Params& P, const Ptrs& W, LAS unsigned char* lds) {
    const int bid = blockIdx.x, nb = gridDim.x, tid = threadIdx.x, lane = tid & 63, wv = tid >> 6;
    const int gw = bid * NWAVES + wv, nw = nb * NWAVES; const size_t gt = (size_t)bid * NTHREADS + tid, ntot = (size_t)nb * NTHREADS;
    LAS float* tile = (LAS float*)lds;
    rmsnorm_rows(P.x, P.norm1_w, W.XN, S_, gw, nw);
    convT(P.w_in, DM, INW, W.Win, DM, tile, bid, nb);
    for (size_t i = gt; i < (size_t)(LDZ - INW) * DM / 8; i += ntot) *(u32x4*)(W.Win + (size_t)INW * DM + i * 8) = (u32x4){0u, 0u, 0u, 0u};
    convT(P.w_o, DM, DM, W.Wo, DM, tile, bid, nb);
    convT<true>(P.w_ffn_in, DM, NFI, W.Wfi, DM, tile, bid, nb);
    for (size_t i = gt; i < (size_t)2 * DM / 8; i += ntot) *(u32x4*)(W.XN - 2 * DM + i * 8) = (u32x4){0u, 0u, 0u, 0u};
    convT(P.w_ffn_out, DFF, DM, W.Wfo, DFF, tile, bid, nb);
    convT(P.w_ple_gate, DM, DM, W.Wg, DM, tile, bid, nb);
    convT(P.w_ple_proj, PLE, DM, W.Wple, PLE, tile, bid, nb);
    for (int g = 0; g < 4; ++g) convT(P.w_pool + (size_t)g * 65536, 256, 256, W.Wpool + (size_t)g * 65536, 256, tile, bid, nb);
    convT(P.cmp_k_w1, 4096, 256, W.Wc1k, 4096, tile, bid, nb);
    convT(P.cmp_v_w1, 4096, 256, W.Wc1v, 4096, tile, bid, nb);
    for (size_t i = gt; i < (size_t)S_ * PLE / 8; i += ntot) { const f32x4 a = *(const f32x4*)(P.p + i * 8), b = *(const f32x4*)(P.p + i * 8 + 4);
        u32x4 w; w.x = cvt_pk_bf16(a[0], a[1]); w.y = cvt_pk_bf16(a[2], a[3]); w.z = cvt_pk_bf16(b[0], b[1]); w.w = cvt_pk_bf16(b[2], b[3]); *(u32x4*)(W.PB + i * 8) = w; }
    for (size_t i = gt; i < (size_t)S_ * 16; i += ntot) { const int t = (int)(i >> 4), fi = (int)(i & 15);
        const float inv = exp2f(-(float)fi * (18.931568569324174f / 16.0f)); const float ang = (float)P.positions[t] * inv;
        const double ad = (double)ang; const double kk = rint(ad * 0.15915494309189535); const float rf = (float)(ad - kk * 6.283185307179586);
        W.COS[i] = __cosf(rf); W.SIN[i] = __sinf(rf); }
    for (int o = gw; o < 512; o += nw) { const int which = o >> 8, j = o & 255; const float* pe = which ? P.cmp_pos_v : P.cmp_pos_k; const float* w1 = which ? P.cmp_v_w1 : P.cmp_k_w1;
        float s = 0.f; for (int r = lane; r < 4096; r += 64) s += pe[r] * w1[(size_t)r * 256 + j];
        s = wave_sum(s); if (lane == 0) W.TAB[o] = s; }
    if (gw == 0) { float mq = fmaxf(fabsf(P.q_norm_w[lane]), fabsf(P.q_norm_w[lane + 64])); mq = wave_max(mq);
        float mc = wave_max(fmaxf(fabsf(P.k_norm_cmp_w[lane]), fabsf(P.k_norm_cmp_w[lane + 64])));
        float ms = wave_max(fmaxf(fabsf(P.k_norm_slc_w[lane]), fabsf(P.k_norm_slc_w[lane + 64])));
        float mw = wave_max(fmaxf(fabsf(P.k_norm_win_w[lane]), fabsf(P.k_norm_win_w[lane + 64])));
        const float c = 11.313708498984761f * 1.4426950408889634f * mq * 1.01f;
        if (lane == 0) { W.TAB[512] = c * mc; W.TAB[513] = c * ms; W.TAB[514] = c * mw; } }
}

__device__ __forceinline__ void phase_postz(const Params& P, const Ptrs& W) {
    const int tid = threadIdx.x, lane = tid & 63, gw = blockIdx.x * NWAVES + (tid >> 6), nw = gridDim.x * NWAVES;
    const f32x2 wq = *(const f32x2*)(P.q_norm_w + 2 * lane), wks = *(const f32x2*)(P.k_norm_slc_w + 2 * lane), wkw = *(const f32x2*)(P.k_norm_win_w + 2 * lane);
    for (int t = gw; t < S_; t += nw) {
        bf16_t* zr = W.Z + (size_t)t * LDZ;
        float cs0 = 0.f, cs1 = 0.f, sn0 = 0.f, sn1 = 0.f;
        if (lane < 16) { const int i0 = (2 * lane) & 15; cs0 = W.COS[t * 16 + i0]; cs1 = W.COS[t * 16 + i0 + 1]; sn0 = W.SIN[t * 16 + i0]; sn1 = W.SIN[t * 16 + i0 + 1]; }
        for (int v = 0; v < 32; ++v) {
            const int col = v < 24 ? OFF_Q + v * HD : (v < 28 ? OFF_KV + 2 * 512 + (v - 24) * HD : OFF_KV + 4 * 512 + (v - 28) * HD);
            const f32x2 ww = v < 24 ? wq : (v < 28 ? wks : wkw);
            unsigned* ptr = (unsigned*)(zr + col) + lane;
            const unsigned u = *ptr; const float x0 = bf_lo(u), x1 = bf_hi(u);
            const float ss = wave_sum(x0 * x0 + x1 * x1);
            const float rstd = rsqrtf(ss * (1.0f / HD) + EPS);
            float y0 = x0 * rstd * ww[0], y1 = x1 * rstd * ww[1];
            const float p0 = __shfl_xor(y0, 8), p1 = __shfl_xor(y1, 8);
            if (lane < 8) { y0 = y0 * cs0 - p0 * sn0; y1 = y1 * cs1 - p1 * sn1; }
            else if (lane < 16) { y0 = y0 * cs0 + p0 * sn0; y1 = y1 * cs1 + p1 * sn1; }
            *ptr = cvt_pk_bf16(y0, y1);
        }
        for (int c = lane; c < NGATE; c += 64) W.G[(size_t)t * NGATE + c] = sigmoidf_(bf2f(zr[OFF_G + c]));
        {
            const int gi = lane >> 4, wlen = 2 << gi, c0 = lane * 16; const int cnt = (t + 1) < wlen ? (t + 1) : wlen;
            float s[16];
#pragma unroll
            for (int i = 0; i < 16; ++i) s[i] = 0.f;
            float cur[16];
            for (int i = 0; i < cnt; ++i) { const u32x4 a = *(const u32x4*)(W.Z + (size_t)(t - i) * LDZ + c0), b = *(const u32x4*)(W.Z + (size_t)(t - i) * LDZ + c0 + 8);
                const float e[16] = {bf_lo(a.x), bf_hi(a.x), bf_lo(a.y), bf_hi(a.y), bf_lo(a.z), bf_hi(a.z), bf_lo(a.w), bf_hi(a.w), bf_lo(b.x), bf_hi(b.x), bf_lo(b.y), bf_hi(b.y), bf_lo(b.z), bf_hi(b.z), bf_lo(b.w), bf_hi(b.w)};
#pragma unroll
                for (int q = 0; q < 16; ++q) { s[q] += e[q]; if (i == 0) cur[q] = e[q]; } }
            const float rc = 1.0f / (float)cnt;
            u32x4 o0, o1;
            o0.x = cvt_pk_bf16(s[0] * rc - cur[0], s[1] * rc - cur[1]); o0.y = cvt_pk_bf16(s[2] * rc - cur[2], s[3] * rc - cur[3]);
            o0.z = cvt_pk_bf16(s[4] * rc - cur[4], s[5] * rc - cur[5]); o0.w = cvt_pk_bf16(s[6] * rc - cur[6], s[7] * rc - cur[7]);
            o1.x = cvt_pk_bf16(s[8] * rc - cur[8], s[9] * rc - cur[9]); o1.y = cvt_pk_bf16(s[10] * rc - cur[10], s[11] * rc - cur[11]);
            o1.z = cvt_pk_bf16(s[12] * rc - cur[12], s[13] * rc - cur[13]); o1.w = cvt_pk_bf16(s[14] * rc - cur[14], s[15] * rc - cur[15]);
            *(u32x4*)(W.M + (size_t)t * POOLW + c0) = o0; *(u32x4*)(W.M + (size_t)t * POOLW + c0 + 8) = o1;
        }
    }
}

__device__ __forceinline__ void phase_cmpfin(const Params& P, const Ptrs& W) {
    const int tid = threadIdx.x, lane = tid & 63, gw = blockIdx.x * NWAVES + (tid >> 6), nw = gridDim.x * NWAVES;
    const f32x2 wk = *(const f32x2*)(P.k_norm_cmp_w + 2 * lane);
    for (int task = gw; task < 8192; task += nw) {
        const int tk = __builtin_amdgcn_readfirstlane(task);
        const int which = tk >> 12, g = (tk >> 10) & 3, n = tk & 1023;
        bf16_t* dst = (which ? W.VC : W.KC) + ((size_t)g * 1024 + n) * HD;
        if (n == 1023) { ((unsigned*)dst)[lane] = 0u; continue; }
        const float* h = W.H1 + (size_t)tk * 256; const float* w2 = which ? P.cmp_v_w2 : P.cmp_k_w2;
        float a0 = 0.f, a1 = 0.f;
        for (int j = 0; j < 256; ++j) { const float hj = h[j]; const f32x2 wv = *(const f32x2*)(w2 + j * HD + 2 * lane); a0 += hj * wv[0]; a1 += hj * wv[1]; }
        if (which == 0) {
            const float ss = wave_sum(a0 * a0 + a1 * a1); const float rstd = rsqrtf(ss * (1.0f / HD) + EPS);
            a0 = a0 * rstd * wk[0]; a1 = a1 * rstd * wk[1];
            const int tp = 16 * n + 31; const float p0 = __shfl_xor(a0, 8), p1 = __shfl_xor(a1, 8);
            if (lane < 16) { const int i0 = (2 * lane) & 15; const float cs0 = W.COS[tp * 16 + i0], cs1 = W.COS[tp * 16 + i0 + 1], sn0 = W.SIN[tp * 16 + i0], sn1 = W.SIN[tp * 16 + i0 + 1];
                if (lane < 8) { a0 = a0 * cs0 - p0 * sn0; a1 = a1 * cs1 - p1 * sn1; } else { a0 = a0 * cs0 + p0 * sn0; a1 = a1 * cs1 + p1 * sn1; } }
        }
        ((unsigned*)dst)[lane] = cvt_pk_bf16(a0, a1);
    }
}

__device__ __forceinline__ void phase_erstd(const Ptrs& W) {
    const int tid = threadIdx.x, lane = tid & 63, gw = blockIdx.x * NWAVES + (tid >> 6), nw = gridDim.x * NWAVES;
    for (int row = gw; row < S_; row += nw) {
        const u32x4* sp = (const u32x4*)(W.ERAW + (size_t)row * DM); float ss = 0.f;
#pragma unroll
        for (int i = 0; i < 8; ++i) { const u32x4 a = sp[lane + 64 * i];
            const float e0 = bf_lo(a.x), e1 = bf_hi(a.x), e2 = bf_lo(a.y), e3 = bf_hi(a.y), e4 = bf_lo(a.z), e5 = bf_hi(a.z), e6 = bf_lo(a.w), e7 = bf_hi(a.w);
            ss += e0 * e0 + e1 * e1 + e2 * e2 + e3 * e3 + e4 * e4 + e5 * e5 + e6 * e6 + e7 * e7; }
        ss = wave_sum(ss);
        if (lane == 0) W.ERSTD[row] = rsqrtf(ss * (1.0f / DM) + EPS);
    }
}

constexpr int N_PHASES = 15;
__device__ __forceinline__ Params kargs() {
#if defined(__HIP_DEVICE_COMPILE__)
    unsigned long long p = (unsigned long long)__builtin_amdgcn_kernarg_segment_ptr();
    asm volatile("" : "+s"(p));
    return *(const __attribute__((address_space(4))) Params*)p;
#else
    return Params{};
#endif
}
__device__ __forceinline__ Ptrs mkptrs(unsigned char* ws) {
    Ptrs W;
    W.Win = (bf16_t*)(ws + WS_WIN); W.Wo = (bf16_t*)(ws + WS_WO); W.Wfi = (bf16_t*)(ws + WS_WFI); W.Wfo = (bf16_t*)(ws + WS_WFO); W.Wg = (bf16_t*)(ws + WS_WG);
    W.Wple = (bf16_t*)(ws + WS_WPLE); W.Wpool = (bf16_t*)(ws + WS_WPOOL); W.Wc1k = (bf16_t*)(ws + WS_WC1K); W.Wc1v = (bf16_t*)(ws + WS_WC1V);
    W.XN = (bf16_t*)(ws + WS_XN); W.PB = (bf16_t*)(ws + WS_PB); W.Z = (bf16_t*)(ws + WS_Z); W.M = (bf16_t*)(ws + WS_M); W.KC = (bf16_t*)(ws + WS_KC); W.VC = (bf16_t*)(ws + WS_VC);
    W.MIX = (bf16_t*)(ws + WS_MIX); W.ACT = (bf16_t*)(ws + WS_ACT); W.ERAW = (bf16_t*)(ws + WS_ERAW);
    W.COS = (float*)(ws + WS_COS); W.SIN = (float*)(ws + WS_SIN); W.TAB = (float*)(ws + WS_TAB); W.G = (float*)(ws + WS_G); W.H1 = (float*)(ws + WS_H1); W.L = (float*)(ws + WS_L);
    W.OACC = (float*)(ws + WS_OACC); W.IMPP = (float*)(ws + WS_IMPP); W.IMPF = (float*)(ws + WS_IMPF); W.ERSTD = (float*)(ws + WS_ERSTD); W.BM = (unsigned*)(ws + WS_BM);
    return W;
}
__global__ void __launch_bounds__(NTHREADS, 2) fwd(Params Punused) {
    extern __shared__ __attribute__((aligned(16))) unsigned char lds_raw[];
    LAS unsigned char* lds = (LAS unsigned char*)lds_raw;
    const int tid = threadIdx.x;
    const int G = gridDim.x, bid = blockIdx.x;
    const int gw = bid * NWAVES + (tid >> 6), nw = G * NWAVES;

    if (tid < 16) ((LAS unsigned*)(lds + LDS_MISC))[tid] = 0u;
    __syncthreads();
    int lo, hi; XcdBarrier bar;
    { const Params P = kargs(); lo = P.ph_lo; hi = P.ph_hi;
      bar.bar = (unsigned*)(P.ws + WS_CTL); bar.x = 0; bar.st = (volatile LAS unsigned*)(lds + LDS_MISC);
      if (hi - lo > 1) bar = xcd_barrier_post((unsigned*)(P.ws + WS_CTL), (volatile LAS unsigned*)(lds + LDS_MISC)); }
#ifdef PH_MASK
#define IN(k) (((PH_MASK >> (k)) & 1) && lo <= (k) && (k) < hi)
#else
#define IN(k) (lo <= (k) && (k) < hi)
#endif
#define SEAM(k) do { if (IN(k) && IN((k) + 1)) xcd_barrier(bar); } while (0)
#define PHASE_VARS const Params P = kargs(); const Ptrs W = mkptrs(P.ws); (void)W;
#define ATT_ARGS att::AttnArgs AA{W.Z, W.KC, W.VC, W.G, W.L, W.OACC, W.MIX, W.BM, W.TAB};

    if (IN(0)) { PHASE_VARS REP(0) { phase_prologue(P, W, lds); } SEAM(0); }
    if (IN(1)) {
        PHASE_VARS
        pg8::GStd g{(const char*)W.XN, (const char*)W.Win, DM, DM, DM / 64}; pg8::StaticOrder S; S.init(S_ / 256, LDZ / 256, G, bid);
        pg8::EpiBf16 E{W.Z, LDZ};
        REP(1) { pg8::gemm_phase(lds, g, S, E); } SEAM(1);
    }
    if (IN(2)) { PHASE_VARS phase_postz(P, W); SEAM(2); }
    if (IN(3)) {
        PHASE_VARS
        REP(3) {
#ifndef NO_CMPG
        { pg8::GCmp g{(const char*)W.Z, (const char*)W.Wc1k, (const char*)W.Wc1v, 16 * LDZ, 4096, 64}; pg8::StaticOrder S; S.init(32, 1, G, bid);
          pg8::EpiCmpGelu E{W.H1, W.TAB}; pg8::gemm_phase(lds, g, S, E); }
#endif
#ifndef NO_POOLG
        { pg8::GPool g{(const char*)W.M, (const char*)W.Wpool, POOLW, 256, 4}; pg8::StaticOrder S; S.init(S_ / 256, 4, G, (bid + G - 32) % G);
          pg8::EpiBf16Scale E{W.MIX, DM, P.pool_scale}; pg8::gemm_phase(lds, g, S, E); }
#endif
        }
        SEAM(3);
    }
    if (IN(4)) { PHASE_VARS REP(4) { phase_cmpfin(P, W); } SEAM(4); }
    if (IN(5)) {
        PHASE_VARS ATT_ARGS
        REP(5)
        for (int base = 0, rnd = 0; base < 1536; base += G, ++rnd) { const int Lu = base + ((rnd & 1) ? G - 1 - bid : bid); if (Lu >= 1536) continue;
            const int qt = Lu / 12, rem = Lu % 12, g = rem / 3, hp = rem % 3;
            att::attn_unit<att::MODE_CMP>(AA, (LAS char*)lds, qt, g, hp);
            asm volatile("s_waitcnt vmcnt(0)" ::: "memory");
            att::attn_unit<att::MODE_WIN>(AA, (LAS char*)lds, qt, g, hp); }
        SEAM(5);
    }
    if (IN(6)) { PHASE_VARS ATT_ARGS REP(6) for (int k = gw, r = 0; k < 4096; k += nw, ++r) { const int hiT = (r + 1) * nw < 4096 ? (r + 1) * nw : 4096;
            const int task = (r & 1) ? hiT - 1 - (k - r * nw) : k; att::imp_task(AA, W.IMPP, W.IMPF, task >> 2, task & 3); } SEAM(6); }
    if (IN(7)) { PHASE_VARS REP(7) for (int task = gw; task < S_ * 4; task += nw) att::topk_task(W.IMPP, W.IMPF, W.BM, task >> 2, task & 3); SEAM(7); }
    if (IN(8)) {
        PHASE_VARS ATT_ARGS
        REP(8)
        for (int base = 0, rnd = 0; base < 1536; base += G, ++rnd) { const int Lu = base + ((rnd & 1) ? G - 1 - bid : bid); if (Lu >= 1536) continue;
            const int qt = Lu / 12, rem = Lu % 12, g = rem / 3, hp = rem % 3;
            att::attn_unit<att::MODE_SLC>(AA, (LAS char*)lds, qt, g, hp); }
        SEAM(8);
    }
    if (IN(9)) {
        PHASE_VARS
        pg8::GStd g{(const char*)W.MIX, (const char*)W.Wo, DM, DM, DM / 64}; pg8::StaticOrder S; S.init(S_ / 256, DM / 256, G, bid);
        pg8::EpiResF32 E{P.x, P.out, DM, 0}; pg8::gemm_phase(lds, g, S, E); SEAM(9);
    }
    if (IN(10)) {
        PHASE_VARS
        REP(10) { rmsnorm_rows(P.out, P.norm2_w, W.XN, S_, gw, nw); }
        pg8::GStd g{(const char*)W.PB, (const char*)W.Wple, PLE, PLE, PLE / 64}; pg8::StaticOrder S; S.init(S_ / 256, DM / 256, G, bid);
        pg8::EpiBf16 E{W.ERAW, DM}; pg8::gemm_phase(lds, g, S, E); SEAM(10);
    }
    if (IN(11)) {
        PHASE_VARS
        phase_erstd(W);
        pg8::GFfn g{(const char*)W.XN, (const char*)W.Wfi, DM, DM, DM / 64}; pg8::StaticOrder S; S.init(65, DFF / 128, G, bid);
        pg8::EpiFfn E{W.ACT, P.conv_w, P.conv_b, (LAS float*)(lds + LDS_XCH)}; REP(11) { pg8::gemm_phase(lds, g, S, E); } SEAM(11);
    }
    if (IN(12)) {
        PHASE_VARS
        pg8::GStd g{(const char*)W.ACT, (const char*)W.Wfo, DFF, DFF, DFF / 64}; pg8::StaticOrder S; S.init(S_ / 256, DM / 256, G, bid);
        pg8::EpiResF32 E{P.out, P.out, DM, 0}; pg8::gemm_phase(lds, g, S, E); SEAM(12);
    }
    if (IN(13)) { PHASE_VARS rmsnorm_rows(P.out, P.ple_gate_norm_w, W.XN, S_, gw, nw); SEAM(13); }
    if (IN(14)) {
        PHASE_VARS
        pg8::GStd g{(const char*)W.XN, (const char*)W.Wg, DM, DM, DM / 64}; pg8::StaticOrder S; S.init(S_ / 256, DM / 256, G, bid);
        pg8::EpiGate E{P.out, W.ERAW, W.ERSTD, P.ple_norm_w, DM}; pg8::gemm_phase(lds, g, S, E);
    }
#undef IN
#undef SEAM
}

extern "C" void kernel_launch(void* const* d_in, const int* in_sizes, int n_in, void* d_out, int out_size, void* d_ws, size_t ws_size, hipStream_t stream) {
    static int grid = 0;
    if (grid == 0) {
        if (n_in != 27 || in_sizes[0] != S_ * DM || out_size != S_ * DM || ws_size < WS_NEED) {
            fprintf(stderr, "kernel_launch: unexpected shapes (n_in %d, in0 %d, out %d, ws %zu < %zu); nothing launched\n", n_in, n_in > 0 ? in_sizes[0] : -1, out_size, ws_size, (size_t)WS_NEED); grid = -1; return; }
        int dev = 0, cus = 0, per_cu = 0;
        if (hipGetDevice(&dev) != hipSuccess || hipDeviceGetAttribute(&cus, hipDeviceAttributeMultiprocessorCount, dev) != hipSuccess) { grid = -1; return; }
        if (hipFuncSetAttribute((const void*)fwd, hipFuncAttributeMaxDynamicSharedMemorySize, LDS_BYTES) != hipSuccess) { fprintf(stderr, "kernel_launch: hipFuncSetAttribute failed\n"); grid = -1; return; }
        if (hipOccupancyMaxActiveBlocksPerMultiprocessor(&per_cu, (const void*)fwd, NTHREADS, LDS_BYTES) != hipSuccess || per_cu < 1) { fprintf(stderr, "kernel_launch: occupancy query says %d\n", per_cu); (void)hipGetLastError(); }
        grid = cus > 256 ? 256 : cus;
    }
    if (grid < 0) return;
    (void)hipMemsetAsync((char*)d_ws + WS_CTL, 0, CTL_BYTES, stream);
    Params P{};
    const float** fp = (const float**)&P;
    P.x = (const float*)d_in[0]; P.p = (const float*)d_in[1]; P.positions = (const int*)d_in[2]; P.norm1_w = (const float*)d_in[3]; P.w_in = (const float*)d_in[4];
    P.w_pool = (const float*)d_in[5]; P.pool_scale = (const float*)d_in[6]; P.q_norm_w = (const float*)d_in[7]; P.k_norm_cmp_w = (const float*)d_in[8];
    P.k_norm_slc_w = (const float*)d_in[9]; P.k_norm_win_w = (const float*)d_in[10]; P.cmp_pos_k = (const float*)d_in[11]; P.cmp_pos_v = (const float*)d_in[12];
    P.cmp_k_w1 = (const float*)d_in[13]; P.cmp_k_w2 = (const float*)d_in[14]; P.cmp_v_w1 = (const float*)d_in[15]; P.cmp_v_w2 = (const float*)d_in[16];
    P.w_o = (const float*)d_in[17]; P.norm2_w = (const float*)d_in[18]; P.w_ffn_in = (const float*)d_in[19]; P.conv_w = (const float*)d_in[20]; P.conv_b = (const float*)d_in[21];
    P.w_ffn_out = (const float*)d_in[22]; P.w_ple_proj = (const float*)d_in[23]; P.ple_norm_w = (const float*)d_in[24]; P.ple_gate_norm_w = (const float*)d_in[25]; P.w_ple_gate = (const float*)d_in[26];
    (void)fp;
    P.out = (float*)d_out; P.ws = (unsigned char*)d_ws;
#if MK_ONE_LAUNCH
    P.ph_lo = 0; P.ph_hi = N_PHASES;
    hipLaunchKernelGGL(fwd, dim3(grid), dim3(NTHREADS), LDS_BYTES, stream, P);
#else
    for (int ph = 0; ph < N_PHASES; ++ph) { P.ph_lo = ph; P.ph_hi = ph + 1; hipLaunchKernelGGL(fwd, dim3(grid), dim3(NTHREADS), LDS_BYTES, stream, P); }
#endif
    const hipError_t le = hipPeekAtLastError();
    if (le != hipSuccess) fprintf(stderr, "kernel_launch: launch failed: %s\n", hipGetErrorName(le));
}
```

```cpp
#include <hip/hip_runtime.h>
#include <cstdio>
#include <cstdint>

#ifndef PROBE_DBL
#define PROBE_DBL 0
#endif
#define REP(k) _Pragma("unroll") for (int rep_ = 0; rep_ < 1 + ((PROBE_DBL >> (k)) & 1); ++rep_)
#ifndef MK_ONE_LAUNCH
#define MK_ONE_LAUNCH 1
#endif

#define LAS __attribute__((address_space(3)))
typedef unsigned short bf16_t;
typedef short bf16x8 __attribute__((ext_vector_type(8)));
typedef short s16x4 __attribute__((ext_vector_type(4)));
typedef float f32x2 __attribute__((ext_vector_type(2)));
typedef float f32x4 __attribute__((ext_vector_type(4)));
typedef float f32x16 __attribute__((ext_vector_type(16)));
typedef unsigned u32x2 __attribute__((ext_vector_type(2)));
typedef unsigned u32x4 __attribute__((ext_vector_type(4)));

constexpr int S_ = 16384, DM = 4096, INW = 7240, LDZ = 7424, POOLW = 1024, NH = 24, NKV = 4, HPG = 6, HD = 128;
constexpr int OFF_Q = 1024, OFF_KV = 4096, OFF_G = 7168, DFF = 11008, NFI = 22016, PLE = 256, NGATE = 72;
constexpr int ZROWS = S_ + 64, XNROWS = S_ + 256, CHUNK = 8192;
constexpr float EPS = 1e-6f;
constexpr float SM_C = 0.08838834764831845f * 1.4426950408889634f;
constexpr int NWAVES = 8, NTHREADS = 512;

constexpr size_t al256(size_t x) { return (x + 255) / 256 * 256; }
constexpr size_t WS_CTL   = 0;
constexpr size_t CTL_BYTES = 262144;
constexpr size_t WS_SSQ1 = WS_CTL + 65536, WS_SSQ2 = WS_CTL + 131072;
constexpr size_t WS_WIN   = WS_CTL + CTL_BYTES;
constexpr size_t WS_WO    = WS_WIN + al256((size_t)LDZ * DM * 2);
constexpr size_t WS_WFI   = WS_WO + al256((size_t)DM * DM * 2);
constexpr size_t WS_WFO   = WS_WFI + al256((size_t)NFI * DM * 2);
constexpr size_t WS_WG    = WS_WFO + al256((size_t)DM * DFF * 2);
constexpr size_t WS_WPLE  = WS_WG + al256((size_t)DM * DM * 2);
constexpr size_t WS_WPOOL = WS_WPLE + al256((size_t)DM * PLE * 2);
constexpr size_t WS_WC1K  = WS_WPOOL + al256((size_t)1024 * 256 * 2);
constexpr size_t WS_WC1V  = WS_WC1K + al256((size_t)256 * 4096 * 2);
constexpr size_t WS_COS   = WS_WC1V + al256((size_t)256 * 4096 * 2);
constexpr size_t WS_SIN   = WS_COS + al256((size_t)S_ * 16 * 4);
constexpr size_t WS_TAB   = WS_SIN + al256((size_t)S_ * 16 * 4);
constexpr size_t WS_XNP   = WS_TAB + 4096;
constexpr size_t WS_XN    = WS_XNP + (size_t)2 * DM * 2;
constexpr size_t WS_PB    = WS_XN + al256((size_t)XNROWS * DM * 2);
constexpr size_t WS_R     = WS_PB + al256((size_t)S_ * PLE * 2);
constexpr size_t WS_Z     = WS_R;
constexpr size_t WS_M     = WS_Z + al256((size_t)ZROWS * LDZ * 2);
constexpr size_t WS_G     = WS_M + al256((size_t)S_ * POOLW * 2);
constexpr size_t WS_H1    = WS_G + al256((size_t)S_ * NGATE * 4);
constexpr size_t WS_KC    = WS_H1 + al256((size_t)8192 * 256 * 4);
constexpr size_t WS_VC    = WS_KC + al256((size_t)4 * 1024 * 128 * 2);
constexpr size_t WS_L     = WS_VC + al256((size_t)4 * 1024 * 128 * 2);
constexpr size_t WS_OACC  = WS_L + al256((size_t)S_ * NH * 4);
constexpr size_t WS_IMPP  = WS_OACC + al256((size_t)S_ * 3072 * 4);
constexpr size_t WS_IMPF  = WS_IMPP + al256((size_t)S_ * 4 * 256 * 4);
constexpr size_t WS_BM    = WS_IMPF + al256((size_t)S_ * 4 * 256 * 4);
constexpr size_t WS_MIX   = WS_BM + al256((size_t)S_ * 4 * 8 * 4);
constexpr size_t WS_END_A = WS_MIX + al256((size_t)S_ * DM * 2);
constexpr size_t WS_ERAW  = WS_R;
constexpr size_t WS_ACT   = WS_ERAW + al256((size_t)S_ * DM * 2);
constexpr size_t WS_ERSTD = WS_ACT + al256((size_t)S_ * DFF * 2);
constexpr size_t WS_END_B = WS_ERSTD + al256((size_t)S_ * 4);
static_assert(WS_ERAW + (size_t)S_ * DM * 2 <= WS_Z + (size_t)ZROWS * LDZ * 2, "eraw must fit inside the dead z region while mix is still being read");
constexpr size_t WS_NEED  = WS_END_A > WS_END_B ? WS_END_A : WS_END_B;
static_assert(WS_MIX >= WS_END_B || true, "");

constexpr int LDS_STAGE = 131072;
constexpr int LDS_MISC  = LDS_STAGE;
constexpr int LDS_XCH   = LDS_STAGE + 64;
constexpr int LDS_BYTES = LDS_XCH + 4096;

__device__ __forceinline__ unsigned cvt_pk_bf16(float lo, float hi) { unsigned r; asm volatile("v_cvt_pk_bf16_f32 %0, %1, %2" : "=v"(r) : "v"(lo), "v"(hi)); return r; }
__device__ __forceinline__ float bf_lo(unsigned u) { return __uint_as_float(u << 16); }
__device__ __forceinline__ float bf_hi(unsigned u) { return __uint_as_float(u & 0xffff0000u); }
__device__ __forceinline__ float bf2f(bf16_t b) { return __uint_as_float(((unsigned)b) << 16); }
__device__ __forceinline__ float wave_sum(float v) {
#pragma unroll
    for (int o = 32; o >= 1; o >>= 1) v += __shfl_xor(v, o);
    return v;
}
__device__ __forceinline__ float wave_max(float v) {
#pragma unroll
    for (int o = 32; o >= 1; o >>= 1) v = fmaxf(v, __shfl_xor(v, o));
    return v;
}
__device__ __forceinline__ float sigmoidf_(float x) { return 1.0f / (1.0f + __expf(-x)); }

#define XB_TMO      128
#define XB_XCNT(j)  (256  + 64 * (j))
#define XB_XSUB(j)  (1280 + 64 * (j))
#define XB_XGEN(j)  (2304 + 64 * (j))
#define XB_TOP      3328
#define XB_TOPGEN   3392
#define XCD_BAR_WORDS 3456
#define XB_SPIN_CAP (1u << 18)
__device__ __forceinline__ unsigned xb_ld(unsigned* p)              { return __hip_atomic_load(p, __ATOMIC_RELAXED, __HIP_MEMORY_SCOPE_AGENT); }
__device__ __forceinline__ unsigned xb_add(unsigned* p, unsigned v) { return __hip_atomic_fetch_add(p, v, __ATOMIC_RELAXED, __HIP_MEMORY_SCOPE_AGENT); }
__device__ __forceinline__ unsigned xb_xcc_id() { return (unsigned)__builtin_amdgcn_s_getreg((3 << 11) | 20) & 0xFu; }
#define XB_SPIN(cond, bar) do { unsigned _sp = 0; while (cond) { __builtin_amdgcn_s_sleep(1); \
    if ((++_sp & 255u) == 0u) { if (xb_ld(&(bar)[XB_TMO])) break; if (_sp > XB_SPIN_CAP) { atomicAdd(&(bar)[XB_TMO], 1u); break; } } } } while (0)
struct XcdBarrier { unsigned* bar; unsigned x; volatile LAS unsigned* st; };
__device__ __forceinline__ XcdBarrier xcd_barrier_post(unsigned* bar, volatile LAS unsigned* st) {
    XcdBarrier b; b.bar = bar; b.x = xb_xcc_id(); b.st = st;
    if (threadIdx.x == 0) (void)xb_add(&bar[XB_XCNT(b.x)], 1u);
    return b;
}
__device__ __forceinline__ void xcd_barrier_complete(unsigned* bar, unsigned x, unsigned& nloc, unsigned& nx) {
    const unsigned G = gridDim.x * gridDim.y * gridDim.z;
    unsigned sum, cnt, mine, sp = 0u;
    for (;;) {
        sum = 0u; cnt = 0u; mine = 0u;
#pragma unroll
        for (unsigned j = 0; j < 16; ++j) { const unsigned c = xb_ld(&bar[XB_XCNT(j)]); sum += c; cnt += (c > 0u) ? 1u : 0u; mine = (j == x) ? c : mine; }
        if (sum == G) break;
        __builtin_amdgcn_s_sleep(1);
        if ((++sp & 255u) == 0u) { if (xb_ld(&bar[XB_TMO])) break; if (sp > XB_SPIN_CAP) { atomicAdd(&bar[XB_TMO], 1u); break; } }
    }
    nloc = mine > 0u ? mine : 1u; nx = cnt > 0u ? cnt : 1u;
}
__device__ __forceinline__ void xcd_barrier(const XcdBarrier& b) {
    asm volatile("s_waitcnt vmcnt(0)" ::: "memory");
    __syncthreads();
    if (threadIdx.x == 0) {
        unsigned* bar = b.bar;
        __builtin_amdgcn_s_waitcnt(0);
        unsigned nloc = b.st[0], nx = b.st[1];
        if (nloc == 0u) { xcd_barrier_complete(bar, b.x, nloc, nx); b.st[0] = nloc; b.st[1] = nx; }
        const unsigned old = xb_add(&bar[XB_XSUB(b.x)], 1u);
        const unsigned gen = old / nloc;
        if (old + 1u == (gen + 1u) * nloc) {
            __builtin_amdgcn_fence(__ATOMIC_RELEASE, "agent");
            asm volatile("s_waitcnt vmcnt(0)" ::: "memory");
            const unsigned og = xb_add(&bar[XB_TOP], 1u);
            const unsigned tg = og / nx;
            if (og + 1u == (tg + 1u) * nx) xb_add(&bar[XB_TOPGEN], 1u);
            else XB_SPIN(xb_ld(&bar[XB_TOPGEN]) == tg, bar);
            __builtin_amdgcn_fence(__ATOMIC_ACQUIRE, "agent");
            xb_add(&bar[XB_XGEN(b.x)], 1u);
            asm volatile("s_waitcnt vmcnt(0)" ::: "memory");
        } else {
            XB_SPIN(xb_ld(&bar[XB_XGEN(b.x)]) == gen, bar);
            __builtin_amdgcn_fence(__ATOMIC_ACQUIRE, "agent");
            asm volatile("s_waitcnt vmcnt(0)" ::: "memory");
        }
    }
    __syncthreads();
}

struct Params {
    const float* x; const float* p; const int* positions; const float* norm1_w; const float* w_in; const float* w_pool; const float* pool_scale;
    const float* q_norm_w; const float* k_norm_cmp_w; const float* k_norm_slc_w; const float* k_norm_win_w; const float* cmp_pos_k; const float* cmp_pos_v;
    const float* cmp_k_w1; const float* cmp_k_w2; const float* cmp_v_w1; const float* cmp_v_w2; const float* w_o; const float* norm2_w; const float* w_ffn_in;
    const float* conv_w; const float* conv_b; const float* w_ffn_out; const float* w_ple_proj; const float* ple_norm_w; const float* ple_gate_norm_w; const float* w_ple_gate;
    float* out; unsigned char* ws; int ph_lo, ph_hi;
};

namespace pg8 {
constexpr int BM = 256, BK = 64, HALF = 128, HTB = HALF * BK * 2, STAGE_BYTES = 8 * HTB, NXCD = 8, WGM = 8;
__host__ __device__ __forceinline__ int lds_byte(int r, int c) { const int st = (r >> 4) * 2 + (c >> 5), rr = r & 15, cc = c & 31, ob = rr * 64 + cc * 2; return st * 1024 + (ob ^ (((ob >> 9) & 1) << 5)); }
__host__ __device__ __forceinline__ void stage_rc(int b, int& R, int& C) { const int st = b / 1024, sb = b % 1024, swz = sb ^ (((sb >> 9) & 1) << 5); R = (st >> 1) * 16 + swz / 64; C = (st & 1) * 32 + (swz % 64) / 2; }
__host__ __device__ __forceinline__ int perm32(int rho) { const int n = rho >> 4, i = rho & 15; return 8 * (i >> 2) + 4 * n + (i & 3); }
struct Unit { int pm, pn; };

struct StaticOrder {
    int nM, nN, nwg, G, c;
    __device__ void init(int nM_, int nN_, int G_, int c_) { nM = nM_; nN = nN_; nwg = nM * nN; G = G_; c = c_; }
    __device__ bool next(int i, Unit& u) const {
        const long L = (long)i * G + c; if (L >= nwg) return false;
        int wgid = (int)L; { const int q = nwg / NXCD, r = nwg % NXCD, xcd = wgid % NXCD, off = wgid / NXCD; wgid = (xcd < r ? xcd * (q + 1) : r * (q + 1) + (xcd - r) * q) + off; }
        const int nig = WGM * nN, gid = wgid / nig, fm = gid * WGM, gsz = (nM - fm) < WGM ? (nM - fm) : WGM;
        u.pm = fm + ((wgid % nig) % gsz); u.pn = (wgid % nig) / gsz; return true;
    }
};

struct GStd {
    const char* A; const char* B; unsigned lda, ldb; int nt;
    __device__ __forceinline__ const char* a_base(const Unit& u) const { return A + (size_t)u.pm * 256 * lda * 2; }
    __device__ __forceinline__ const char* b_base(const Unit& u) const { return B + (size_t)u.pn * 256 * ldb * 2; }
    __device__ __forceinline__ size_t kpairA() const { return 256; }
};
struct GPool {
    const char* A; const char* B; unsigned lda, ldb; int nt;
    __device__ __forceinline__ const char* a_base(const Unit& u) const { return A + (size_t)u.pm * 256 * lda * 2 + (size_t)u.pn * 512; }
    __device__ __forceinline__ const char* b_base(const Unit& u) const { return B + (size_t)u.pn * 256 * ldb * 2; }
    __device__ __forceinline__ size_t kpairA() const { return 256; }
};
struct GCmp {
    const char* Z; const char* Bk; const char* Bv; unsigned lda, ldb; int nt;
    __device__ __forceinline__ const char* a_base(const Unit& u) const { const int which = u.pm >> 4, g = (u.pm >> 2) & 3, rt = u.pm & 3;
        return Z + (size_t)(OFF_KV + which * 512 + g * 128) * 2 + (size_t)rt * 256 * lda * 2; }
    __device__ __forceinline__ const char* b_base(const Unit& u) const { return (u.pm >> 4) ? Bv : Bk; }
    __device__ __forceinline__ size_t kpairA() const { return (size_t)LDZ * 2; }
};

struct EpiBf16 {
    static constexpr bool PERM = true;
    bf16_t* O; int ldc;
    __device__ __forceinline__ void operator()(const f32x4 (&acc)[2][2][4][2], const Unit& u, int wr, int wc, int fr, int fq) const {
        const int row0 = u.pm * BM + wr * 64 + fr, col0 = u.pn * BM + wc * 32 + 8 * fq;
#pragma unroll
        for (int ai = 0; ai < 2; ++ai)
#pragma unroll
            for (int m = 0; m < 4; ++m) { bf16_t* rowp = O + (size_t)(row0 + ai * HALF + m * 16) * ldc + col0;
#pragma unroll
                for (int bj = 0; bj < 2; ++bj) { const f32x4 v0 = acc[ai][bj][m][0], v1 = acc[ai][bj][m][1];
                    u32x4 w; w.x = cvt_pk_bf16(v0[0], v0[1]); w.y = cvt_pk_bf16(v0[2], v0[3]); w.z = cvt_pk_bf16(v1[0], v1[1]); w.w = cvt_pk_bf16(v1[2], v1[3]);
                    *(u32x4*)(rowp + bj * HALF) = w; } }
    }
};
struct EpiBf16Scale {
    static constexpr bool PERM = true;
    bf16_t* O; int ldc; const float* colscale;
    __device__ __forceinline__ void operator()(const f32x4 (&acc)[2][2][4][2], const Unit& u, int wr, int wc, int fr, int fq) const {
        const int row0 = u.pm * BM + wr * 64 + fr, col0 = u.pn * BM + wc * 32 + 8 * fq;
#pragma unroll
        for (int bj = 0; bj < 2; ++bj) { const f32x4 s0 = *(const f32x4*)(colscale + col0 + bj * HALF), s1 = *(const f32x4*)(colscale + col0 + bj * HALF + 4);
#pragma unroll
            for (int ai = 0; ai < 2; ++ai)
#pragma unroll
                for (int m = 0; m < 4; ++m) { bf16_t* rowp = O + (size_t)(row0 + ai * HALF + m * 16) * ldc + col0;
                    const f32x4 v0 = acc[ai][bj][m][0] * s0, v1 = acc[ai][bj][m][1] * s1;
                    u32x4 w; w.x = cvt_pk_bf16(v0[0], v0[1]); w.y = cvt_pk_bf16(v0[2], v0[3]); w.z = cvt_pk_bf16(v1[0], v1[1]); w.w = cvt_pk_bf16(v1[2], v1[3]);
                    *(u32x4*)(rowp + bj * HALF) = w; } }
    }
};
struct EpiResF32 {
    static constexpr bool PERM = false;
    const float* base; float* C; int ldc; int row_off;
    __device__ __forceinline__ void operator()(const f32x4 (&acc)[2][2][4][2], const Unit& u, int wr, int wc, int fr, int fq) const {
        const int row0 = u.pm * BM + wr * 64 + fr + row_off, col0 = u.pn * BM + wc * 32 + 4 * fq;
#pragma unroll
        for (int ai = 0; ai < 2; ++ai)
#pragma unroll
            for (int m = 0; m < 4; ++m) { const size_t off = (size_t)(row0 + ai * HALF + m * 16) * ldc + col0;
#pragma unroll
                for (int bj = 0; bj < 2; ++bj)
#pragma unroll
                    for (int n = 0; n < 2; ++n) { const f32x4 b = *(const f32x4*)(base + off + bj * HALF + n * 16); *(f32x4*)(C + off + bj * HALF + n * 16) = b + acc[ai][bj][m][n]; }
                asm volatile("" ::: "memory"); }
    }
};
struct EpiResNorm {
    static constexpr bool PERM = false;
    const float* base; float* C; bf16_t* XN; const float* nw; float* ssq; int ldc;
    __device__ __forceinline__ void operator()(const f32x4 (&acc)[2][2][4][2], const Unit& u, int wr, int wc, int fr, int fq) const {
        const int row0 = u.pm * BM + wr * 64 + fr, col0 = u.pn * BM + wc * 32 + 4 * fq;
        f32x4 wv[2][2];
#pragma unroll
        for (int bj = 0; bj < 2; ++bj)
#pragma unroll
            for (int n = 0; n < 2; ++n) wv[bj][n] = *(const f32x4*)(nw + col0 + bj * HALF + n * 16);
        f32x4 bv[2][2][2];
#pragma unroll
        for (int bj = 0; bj < 2; ++bj)
#pragma unroll
            for (int n = 0; n < 2; ++n) bv[0][bj][n] = *(const f32x4*)(base + (size_t)row0 * ldc + col0 + bj * HALF + n * 16);
#pragma unroll
        for (int rg = 0; rg < 8; ++rg) { const int ai = rg >> 2, m = rg & 3; const int row = row0 + ai * HALF + m * 16; const size_t off = (size_t)row * ldc + col0;
            if (rg < 7) { const int ai2 = (rg + 1) >> 2, m2 = (rg + 1) & 3; const size_t off2 = (size_t)(row0 + ai2 * HALF + m2 * 16) * ldc + col0;
#pragma unroll
                for (int bj = 0; bj < 2; ++bj)
#pragma unroll
                    for (int n = 0; n < 2; ++n) bv[(rg + 1) & 1][bj][n] = *(const f32x4*)(base + off2 + bj * HALF + n * 16); }
            float s = 0.f;
#pragma unroll
            for (int bj = 0; bj < 2; ++bj)
#pragma unroll
                for (int n = 0; n < 2; ++n) { const f32x4 v = bv[rg & 1][bj][n] + acc[ai][bj][m][n];
                    *(f32x4*)(C + off + bj * HALF + n * 16) = v; s += v[0] * v[0] + v[1] * v[1] + v[2] * v[2] + v[3] * v[3];
                    u32x2 o; o.x = cvt_pk_bf16(v[0] * wv[bj][n][0], v[1] * wv[bj][n][1]); o.y = cvt_pk_bf16(v[2] * wv[bj][n][2], v[3] * wv[bj][n][3]);
                    *(u32x2*)(XN + off + bj * HALF + n * 16) = o; }
            s += __shfl_xor(s, 16); s += __shfl_xor(s, 32);
            if (fq == 0) unsafeAtomicAdd(ssq + row, s);
        }
    }
};
struct EpiCmpGelu {
    static constexpr bool PERM = false;
    float* H; const float* bias;
    __device__ __forceinline__ void operator()(const f32x4 (&acc)[2][2][4][2], const Unit& u, int wr, int wc, int fr, int fq) const {
        const int row0 = u.pm * BM + wr * 64 + fr, col0 = wc * 32 + 4 * fq; const float* bs = bias + (u.pm >> 4) * 256;
#pragma unroll
        for (int ai = 0; ai < 2; ++ai)
#pragma unroll
            for (int m = 0; m < 4; ++m) { float* rowp = H + (size_t)(row0 + ai * HALF + m * 16) * 256 + col0;
#pragma unroll
                for (int bj = 0; bj < 2; ++bj)
#pragma unroll
                    for (int n = 0; n < 2; ++n) { const f32x4 b = *(const f32x4*)(bs + col0 + bj * HALF + n * 16); f32x4 v = acc[ai][bj][m][n] + b;
#pragma unroll
                        for (int j = 0; j < 4; ++j) { const float xx = v[j], uu = 0.7978845608028654f * (xx + 0.044715f * xx * xx * xx); const float th = 1.0f - 2.0f / (1.0f + __expf(2.0f * uu)); v[j] = 0.5f * xx * (1.0f + th); }
                        *(f32x4*)(rowp + bj * HALF + n * 16) = v; } }
    }
};
struct EpiGate {
    static constexpr bool PERM = false;
    float* C; const bf16_t* eraw; const float* erstd; const float* pw; const float* ssq; int ldc;
    __device__ __forceinline__ void operator()(const f32x4 (&acc)[2][2][4][2], const Unit& u, int wr, int wc, int fr, int fq) const {
        const int row0 = u.pm * BM + wr * 64 + fr, col0 = u.pn * BM + wc * 32 + 4 * fq;
        f32x4 wv[2][2];
#pragma unroll
        for (int bj = 0; bj < 2; ++bj)
#pragma unroll
            for (int n = 0; n < 2; ++n) wv[bj][n] = *(const f32x4*)(pw + col0 + bj * HALF + n * 16);
        f32x4 bv[2][2][2]; u32x2 ev[2][2][2]; float rsv[2], rgv[2];
#pragma unroll
        for (int bj = 0; bj < 2; ++bj)
#pragma unroll
            for (int n = 0; n < 2; ++n) { bv[0][bj][n] = *(const f32x4*)(C + (size_t)row0 * ldc + col0 + bj * HALF + n * 16); ev[0][bj][n] = *(const u32x2*)(eraw + (size_t)row0 * ldc + col0 + bj * HALF + n * 16); }
        rsv[0] = erstd[row0]; rgv[0] = ssq[row0];
#pragma unroll
        for (int rg = 0; rg < 8; ++rg) { const int ai = rg >> 2, m = rg & 3; const int row = row0 + ai * HALF + m * 16; const size_t off = (size_t)row * ldc + col0;
            if (rg < 7) { const int ai2 = (rg + 1) >> 2, m2 = (rg + 1) & 3; const int row2 = row0 + ai2 * HALF + m2 * 16; const size_t off2 = (size_t)row2 * ldc + col0;
#pragma unroll
                for (int bj = 0; bj < 2; ++bj)
#pragma unroll
                    for (int n = 0; n < 2; ++n) { bv[(rg + 1) & 1][bj][n] = *(const f32x4*)(C + off2 + bj * HALF + n * 16); ev[(rg + 1) & 1][bj][n] = *(const u32x2*)(eraw + off2 + bj * HALF + n * 16); }
                rsv[(rg + 1) & 1] = erstd[row2]; rgv[(rg + 1) & 1] = ssq[row2]; }
            const float rs = rsv[rg & 1], rg_ = rsqrtf(rgv[rg & 1] * (1.0f / DM) + EPS);
#pragma unroll
            for (int bj = 0; bj < 2; ++bj)
#pragma unroll
                for (int n = 0; n < 2; ++n) { const f32x4 b = bv[rg & 1][bj][n]; const u32x2 e = ev[rg & 1][bj][n]; const f32x4 a = acc[ai][bj][m][n]; f32x4 o;
                    o[0] = b[0] + bf_lo(e.x) * rs * wv[bj][n][0] * sigmoidf_(a[0] * rg_); o[1] = b[1] + bf_hi(e.x) * rs * wv[bj][n][1] * sigmoidf_(a[1] * rg_);
                    o[2] = b[2] + bf_lo(e.y) * rs * wv[bj][n][2] * sigmoidf_(a[2] * rg_); o[3] = b[3] + bf_hi(e.y) * rs * wv[bj][n][3] * sigmoidf_(a[3] * rg_);
                    *(f32x4*)(C + off + bj * HALF + n * 16) = o; }
        }
    }
};
struct GFfn {
    const char* A; const char* B; unsigned lda, ldb; int nt;
    __device__ __forceinline__ const char* a_base(const Unit& u) const { return A + ((long)u.pm * 254 - 2) * (long)lda * 2; }
    __device__ __forceinline__ const char* b_base(const Unit& u) const { return B + (size_t)u.pn * 256 * ldb * 2; }
    __device__ __forceinline__ size_t kpairA() const { return 256; }
};
template <int CTRL> __device__ __forceinline__ float dpp_f(float v) { return __int_as_float(__builtin_amdgcn_update_dpp(0, __float_as_int(v), CTRL, 0xf, 0xf, false)); }
struct EpiFfn {
    static constexpr bool PERM = true;
    bf16_t* ACT; const float* cw; const float* cb; LAS float* X; const float* ssq;
    __device__ __forceinline__ void operator()(const f32x4 (&acc)[2][2][4][2], const Unit& u, int wr, int wc, int fr, int fq) const {
        const int colw = wc * 32 + 8 * fq;
        float rsv[2][4];
#pragma unroll
        for (int ai = 0; ai < 2; ++ai)
#pragma unroll
            for (int m = 0; m < 4; ++m) { const long t = (long)u.pm * 254 - 2 + ai * HALF + wr * 64 + m * 16 + fr; rsv[ai][m] = (t >= 0 && t < S_) ? rsqrtf(ssq[t] * (1.0f / DM) + EPS) : 0.f; }
        if (fr >= 14) {
#pragma unroll
            for (int ai = 0; ai < 2; ++ai)
#pragma unroll
                for (int n = 0; n < 2; ++n) *(LAS f32x4*)(X + ((2 * ai + wr) * 2 + (fr - 14)) * 128 + colw + 4 * n) = acc[ai][0][3][n] * rsv[ai][3];
        }
        asm volatile("s_waitcnt lgkmcnt(0)" ::: "memory");
        __builtin_amdgcn_s_barrier(); asm volatile("" ::: "memory");
        __builtin_amdgcn_s_barrier(); asm volatile("" ::: "memory");
        const int f0 = u.pn * 128 + colw;
        f32x4 w0[2], w1[2], w2[2], cbv[2];
#pragma unroll
        for (int n = 0; n < 2; ++n) { w0[n] = *(const f32x4*)(cw + f0 + 4 * n); w1[n] = *(const f32x4*)(cw + DFF + f0 + 4 * n); w2[n] = *(const f32x4*)(cw + 2 * DFF + f0 + 4 * n); cbv[n] = *(const f32x4*)(cb + f0 + 4 * n); }
#pragma unroll
        for (int ai = 0; ai < 2; ++ai) {
            f32x4 pv[2];
            const int pseg = 2 * ai + wr - 1;
#pragma unroll
            for (int n = 0; n < 2; ++n) { pv[n] = (f32x4){0.f, 0.f, 0.f, 0.f}; if (pseg >= 0 && fr >= 14) pv[n] = *(const LAS f32x4*)(X + (pseg * 2 + (fr - 14)) * 128 + colw + 4 * n); }
#pragma unroll
            for (int m = 0; m < 4; ++m) {
                const int r = ai * HALF + wr * 64 + m * 16 + fr; const long t = (long)u.pm * 254 - 2 + r;
                unsigned ow[4];
#pragma unroll
                for (int n = 0; n < 2; ++n) {
                    const f32x4 cur = acc[ai][0][m][n] * rsv[ai][m], up = acc[ai][1][m][n] * rsv[ai][m]; f32x4 o;
#pragma unroll
                    for (int i = 0; i < 4; ++i) {
                        const float c1 = dpp_f<0x121>(cur[i]), p1 = dpp_f<0x121>(pv[n][i]), c2 = dpp_f<0x122>(cur[i]), p2 = dpp_f<0x122>(pv[n][i]);
                        const float x1 = fr >= 1 ? c1 : p1, x2 = fr >= 2 ? c2 : p2;
                        const float y = cbv[n][i] + w0[n][i] * x2 + w1[n][i] * x1 + w2[n][i] * cur[i];
                        o[i] = y * sigmoidf_(y) * up[i];
                    }
                    ow[2 * n] = cvt_pk_bf16(o[0], o[1]); ow[2 * n + 1] = cvt_pk_bf16(o[2], o[3]);
                    pv[n] = cur;
                }
                if (r >= 2 && t < S_) *(u32x4*)(ACT + (size_t)t * DFF + f0) = (u32x4){ow[0], ow[1], ow[2], ow[3]};
            }
        }
    }
};

template <class GD, class Epi>
__device__ __forceinline__ void gemm_phase(LAS unsigned char* lds, const GD g, const StaticOrder& S, const Epi& E) {
    const int tid = threadIdx.x, wid = __builtin_amdgcn_readfirstlane(tid >> 6), lane = tid & 63, wr = wid >> 2, wc = wid & 3, fr = lane & 15, fq = lane >> 4;
    const int nt = g.nt;
    unsigned voffA[2], voffB[2];
#pragma unroll
    for (int i = 0; i < 2; ++i) { int R, C; stage_rc(tid * 16 + i * 8192, R, C); const int Rb = Epi::PERM ? ((R & ~31) + perm32(R & 31)) : R;
        voffA[i] = (unsigned)(R * g.lda + C) * 2u; voffB[i] = (unsigned)(Rb * g.ldb + C) * 2u; }
    const size_t kpA = g.kpairA();
    const size_t hstepA = (size_t)HALF * g.lda * 2, hstepB = (size_t)HALF * g.ldb * 2;
    const unsigned ldsw = (unsigned)wid * 1024u;
    const int aoff = lds_byte(wr * 64 + fr, fq * 8), boff = lds_byte(wc * 32 + fr, fq * 8);
#define PG8_SA(b, h) (((b) * 2 + (h)) * HTB)
#define PG8_SB(b, h) ((4 + (b) * 2 + (h)) * HTB)
#define PG8_STAGE(bufoff, gbase, voff) do { _Pragma("unroll") for (int _i = 0; _i < 2; ++_i) \
        __builtin_amdgcn_global_load_lds((const unsigned*)((const char*)(gbase) + (voff)[_i]), (LAS unsigned*)(lds + (bufoff) + ldsw + _i * 8192), 16, 0, 0); } while (0)
#define PG8_LDA(dst, b, h) do { _Pragma("unroll") for (int m = 0; m < 4; ++m) _Pragma("unroll") for (int k = 0; k < 2; ++k) dst[m][k] = *(const LAS bf16x8*)(lds + PG8_SA(b, h) + aoff + m * 2048 + k * 1024); } while (0)
#define PG8_LDB(dst, b, h) do { _Pragma("unroll") for (int n = 0; n < 2; ++n) _Pragma("unroll") for (int k = 0; k < 2; ++k) dst[n][k] = *(const LAS bf16x8*)(lds + PG8_SB(b, h) + boff + n * 2048 + k * 1024); } while (0)
#define PG8_MMA(ai, bj, At, Bt) do { __builtin_amdgcn_s_setprio(1); _Pragma("unroll") for (int m = 0; m < 4; ++m) _Pragma("unroll") for (int n = 0; n < 2; ++n) _Pragma("unroll") for (int k = 0; k < 2; ++k) \
        acc[ai][bj][m][n] = __builtin_amdgcn_mfma_f32_16x16x32_bf16(Bt[n][k], At[m][k], acc[ai][bj][m][n], 0, 0, 0); __builtin_amdgcn_s_setprio(0); } while (0)
#define PG8_WAIT_V(n) asm volatile("s_waitcnt vmcnt(" #n ")" ::: "memory")
#define PG8_WAIT_L(n) asm volatile("s_waitcnt lgkmcnt(" #n ")" ::: "memory")
#define PG8_BAR __builtin_amdgcn_s_barrier()
#define PG8_SCHED __builtin_amdgcn_sched_barrier(0)
    Unit cur, nxt; int ui = 0;
    if (!S.next(0, cur)) return;
    f32x4 acc[2][2][4][2];
#pragma unroll
    for (int a = 0; a < 2; ++a)
#pragma unroll
        for (int b = 0; b < 2; ++b)
#pragma unroll
            for (int m = 0; m < 4; ++m)
#pragma unroll
                for (int n = 0; n < 2; ++n) acc[a][b][m][n] = (f32x4){0.f, 0.f, 0.f, 0.f};
    bf16x8 At[4][2], B0[2][2], B1[2][2];
    const char* cA = g.a_base(cur); const char* cB = g.b_base(cur);
    PG8_STAGE(PG8_SB(0, 0), cB, voffB); PG8_STAGE(PG8_SA(0, 0), cA, voffA); PG8_STAGE(PG8_SB(0, 1), cB + hstepB, voffB); PG8_STAGE(PG8_SA(0, 1), cA + hstepA, voffA);
    if (wr == 1) PG8_BAR;
    PG8_WAIT_V(4); PG8_BAR;
    PG8_STAGE(PG8_SB(1, 0), cB + 128, voffB); PG8_STAGE(PG8_SA(1, 0), cA + 128, voffA); PG8_STAGE(PG8_SB(1, 1), cB + hstepB + 128, voffB);
    PG8_WAIT_V(6); PG8_BAR;
    for (;;) {
        const bool has_next = S.next(ui + 1, nxt);
        const char* nA = has_next ? g.a_base(nxt) : cA; const char* nB = has_next ? g.b_base(nxt) : cB;
        for (int t = 0; t < nt; t += 2) {
            const bool last = (t == nt - 2);
            const char* a0 = cA + (size_t)(t >> 1) * kpA;
            const char* a1 = a0 + 128;
            const char* a2 = last ? nA : a0 + kpA; const char* b2 = last ? nB : cB + (size_t)(t + 2) * 128;
            const char* a3 = a2 + 128; const char* b3 = b2 + 128;
            PG8_LDB(B0, 0, 0); PG8_SCHED; PG8_LDA(At, 0, 0); PG8_STAGE(PG8_SA(1, 1), a1 + hstepA, voffA);
            PG8_WAIT_L(8); PG8_BAR; PG8_WAIT_L(0); PG8_MMA(0, 0, At, B0); PG8_BAR; PG8_SCHED;
            PG8_LDB(B1, 0, 1); PG8_STAGE(PG8_SB(0, 0), b2, voffB);
            PG8_BAR; PG8_WAIT_L(0); PG8_MMA(0, 1, At, B1); PG8_BAR;
            PG8_LDA(At, 0, 1); PG8_STAGE(PG8_SA(0, 0), a2, voffA);
            PG8_BAR; PG8_WAIT_L(0); PG8_MMA(1, 0, At, B0); PG8_BAR; PG8_SCHED;
            PG8_STAGE(PG8_SB(0, 1), b2 + hstepB, voffB);
            PG8_WAIT_V(6); PG8_BAR; PG8_MMA(1, 1, At, B1); PG8_BAR;
            PG8_LDB(B0, 1, 0); PG8_SCHED; PG8_LDA(At, 1, 0); PG8_STAGE(PG8_SA(0, 1), a2 + hstepA, voffA);
            PG8_WAIT_L(8); PG8_BAR; PG8_WAIT_L(0); PG8_MMA(0, 0, At, B0); PG8_BAR; PG8_SCHED;
            PG8_LDB(B1, 1, 1); PG8_STAGE(PG8_SB(1, 0), b3, voffB);
            PG8_BAR; PG8_WAIT_L(0); PG8_MMA(0, 1, At, B1); PG8_BAR;
            PG8_LDA(At, 1, 1); PG8_STAGE(PG8_SA(1, 0), a3, voffA);
            PG8_BAR; PG8_WAIT_L(0); PG8_MMA(1, 0, At, B0); PG8_BAR; PG8_SCHED;
            PG8_STAGE(PG8_SB(1, 1), b3 + hstepB, voffB);
            PG8_WAIT_V(6); PG8_BAR; PG8_MMA(1, 1, At, B1); PG8_BAR;
        }
        E(acc, cur, wr, wc, fr, fq);
        if (!has_next) break;
#pragma unroll
        for (int a = 0; a < 2; ++a)
#pragma unroll
            for (int b = 0; b < 2; ++b)
#pragma unroll
                for (int m = 0; m < 4; ++m)
#pragma unroll
                    for (int n = 0; n < 2; ++n) acc[a][b][m][n] = (f32x4){0.f, 0.f, 0.f, 0.f};
        cur = nxt; cA = nA; cB = nB; ++ui;
    }
    PG8_WAIT_V(0);
    if (wr == 0) PG8_BAR;
    PG8_BAR;
#undef PG8_SA
#undef PG8_SB
#undef PG8_STAGE
#undef PG8_LDA
#undef PG8_LDB
#undef PG8_MMA
#undef PG8_WAIT_V
#undef PG8_WAIT_L
#undef PG8_BAR
#undef PG8_SCHED
}
}

namespace att {
constexpr int KVBLK = 64;
constexpr int SHM_V = KVBLK * HD * 2, SHM_K = KVBLK * HD * 2, SHM_ATTN = 2 * SHM_V + 2 * SHM_K + NWAVES * 64 * 4;
#define KSWZ(row, colB) ((row) * 256 + ((colB) ^ (((row) & 7) << 4)))
#define SBAR() __builtin_amdgcn_sched_barrier(0)
__device__ __forceinline__ int crow(int r, int hi) { return (r & 3) + 8 * (r >> 2) + 4 * hi; }
__device__ __forceinline__ void qkt(f32x16& p0, f32x16& p1, const char* Ks, const bf16x8* qr, int r32, int hi) {
    p0 = f32x16{}; p1 = f32x16{};
    bf16x8 ka[2], kb[2];
    { const int cb = (hi * 8) * 2; ka[0] = *reinterpret_cast<const bf16x8*>(Ks + KSWZ(r32, cb)); kb[0] = *reinterpret_cast<const bf16x8*>(Ks + KSWZ(32 + r32, cb)); }
#pragma unroll
    for (int d0 = 0; d0 < 8; ++d0) {
        if (d0 < 7) { const int cb = ((d0 + 1) * 16 + hi * 8) * 2;
            ka[(d0 + 1) & 1] = *reinterpret_cast<const bf16x8*>(Ks + KSWZ(r32, cb)); kb[(d0 + 1) & 1] = *reinterpret_cast<const bf16x8*>(Ks + KSWZ(32 + r32, cb)); }
        SBAR();
        p0 = __builtin_amdgcn_mfma_f32_32x32x16_bf16(ka[d0 & 1], qr[d0], p0, 0, 0, 0);
        p1 = __builtin_amdgcn_mfma_f32_32x32x16_bf16(kb[d0 & 1], qr[d0], p1, 0, 0, 0);
        SBAR();
    }
}
__device__ __forceinline__ int v_st(int k, int c) { const int kk = (k & ~0xC) | ((k & 4) << 1) | ((k & 8) >> 1); return ((kk >> 3) * 4 + (c >> 5)) * 512 + ((kk & 7) * 32 + (c & 31)) * 2; }
__device__ __forceinline__ int v_rd_base(int lane) { return ((lane & 3) << 3) | (((lane >> 2) & 3) << 6) | (((lane >> 4) & 1) << 5) | (((lane >> 5) & 1) << 8); }
constexpr int v_rd_off(int d0, int ks, int half) { return d0 * 512 + ks * 4096 + half * 2048; }
__device__ __forceinline__ s16x4 tr_read(int vb, int off) { return __builtin_amdgcn_ds_read_tr16_b64_v4i16((LAS s16x4*)(unsigned long)(unsigned)(vb + off)); }
__device__ __forceinline__ void pv_d0(f32x16* o, int vb, bf16x8 pa0, bf16x8 pa1, bf16x8 pa2, bf16x8 pa3) {
    s16x4 L[2][4], H[2][4];
#pragma unroll
    for (int d0 = 0; d0 < 4; ++d0) { L[0][d0] = tr_read(vb, v_rd_off(d0, 0, 0)); H[0][d0] = tr_read(vb, v_rd_off(d0, 0, 1)); }
#pragma unroll
    for (int ks = 0; ks < 4; ++ks) {
        if (ks < 3) {
#pragma unroll
            for (int d0 = 0; d0 < 4; ++d0) { L[(ks + 1) & 1][d0] = tr_read(vb, v_rd_off(d0, ks + 1, 0)); H[(ks + 1) & 1][d0] = tr_read(vb, v_rd_off(d0, ks + 1, 1)); }
        }
        const bf16x8 pa = ks == 0 ? pa0 : (ks == 1 ? pa1 : (ks == 2 ? pa2 : pa3));
#pragma unroll
        for (int d0 = 0; d0 < 4; ++d0) { const s16x4 l = L[ks & 1][d0], h = H[ks & 1][d0];
            o[d0] = __builtin_amdgcn_mfma_f32_32x32x16_bf16(pa, (bf16x8){l[0], l[1], l[2], l[3], h[0], h[1], h[2], h[3]}, o[d0], 0, 0, 0); }
    }
}
__device__ __forceinline__ void pack_p(const f32x16& p0, const f32x16& p1, bf16x8& pa0, bf16x8& pa1, bf16x8& pa2, bf16x8& pa3) {
#define PK4(P, BASE, OUT) do { unsigned a0 = cvt_pk_bf16(P[BASE + 0], P[BASE + 1]), a1 = cvt_pk_bf16(P[BASE + 2], P[BASE + 3]);   \
    unsigned b0 = cvt_pk_bf16(P[BASE + 4], P[BASE + 5]), b1 = cvt_pk_bf16(P[BASE + 6], P[BASE + 7]);                              \
    auto r0 = __builtin_amdgcn_permlane32_swap(a0, b0, false, false); auto r1 = __builtin_amdgcn_permlane32_swap(a1, b1, false, false); \
    u32x4 w = {r0[0], r1[0], r0[1], r1[1]}; OUT = *reinterpret_cast<bf16x8*>(&w); } while (0)
    PK4(p0, 0, pa0); PK4(p0, 8, pa1); PK4(p1, 0, pa2); PK4(p1, 8, pa3);
#undef PK4
}

enum { MODE_CMP = 0, MODE_WIN = 1, MODE_SLC = 2 };
struct AttnArgs {
    const bf16_t* Z; const bf16_t* KC; const bf16_t* VC; const float* G; float* L; float* OACC; bf16_t* MIX; const unsigned* BM; const float* TAB;
};
template <int MODE>
__device__ __forceinline__ void attn_unit(const AttnArgs& a, LAS char* ldsL, int qt, int g, int hp) {
    char* lds = (char*)ldsL;
    const int tid = threadIdx.x, wid = __builtin_amdgcn_readfirstlane(tid >> 6), lane = tid & 63, r32 = lane & 31, hi = lane >> 5;
    float* li_l = (float*)(lds + LDS_XCH) + wid * 64;
    const int t0 = MODE == MODE_SLC ? qt * 40 : qt * 128;
    const int tq_raw = MODE == MODE_SLC ? t0 + wid * 5 + r32 / 6 : t0 + wid * 16 + (r32 & 15);
    const bool rvalid = MODE == MODE_SLC ? (r32 < 30 && tq_raw < S_) : true;
    const int tq = tq_raw < S_ ? tq_raw : S_ - 1;
    const int hq = MODE == MODE_SLC ? g * HPG + r32 % 6 : g * HPG + hp * 2 + (r32 >> 4);
    const int tlast = MODE == MODE_SLC ? ((t0 + 39) < S_ ? (t0 + 39) : S_ - 1) : t0 + 127;
    const bf16_t* Kb; const bf16_t* Vb; long ldk;
    if (MODE == MODE_CMP) { Kb = a.KC + (size_t)g * 1024 * HD; Vb = a.VC + (size_t)g * 1024 * HD; ldk = HD; }
    else if (MODE == MODE_WIN) { Kb = a.Z + OFF_KV + 4 * 512 + g * HD; Vb = a.Z + OFF_KV + 5 * 512 + g * HD; ldk = LDZ; }
    else { Kb = a.Z + OFF_KV + 2 * 512 + g * HD; Vb = a.Z + OFF_KV + 3 * 512 + g * HD; ldk = LDZ; }
    int j0, j1;
    if (MODE == MODE_CMP) { j0 = 0; j1 = (((t0 + 127 - 31) >> 4) >> 6) + 1; }
    else if (MODE == MODE_WIN) { j0 = (t0 - 511) > 0 ? ((t0 - 511) >> 6) : 0; j1 = ((t0 + 127) >> 6) + 1; }
    else { j0 = 0; j1 = (tlast >> 6) + 1; }
    int klo, khi;
    if (MODE == MODE_CMP) { klo = 0; khi = tq >= 31 ? ((tq - 31) >> 4) : -1; }
    else if (MODE == MODE_WIN) { klo = tq - 511; khi = tq; }
    else { klo = 0; khi = rvalid ? tq : -1; }
    float negBC = -a.TAB[512 + (MODE == MODE_CMP ? 0 : (MODE == MODE_SLC ? 1 : 2))];
    bf16x8 qr[8];
    { const bf16_t* Qw = a.Z + (size_t)tq * LDZ + OFF_Q + hq * HD + hi * 8;
#pragma unroll
      for (int d0 = 0; d0 < 8; ++d0) qr[d0] = *reinterpret_cast<const bf16x8*>(Qw + d0 * 16); }
    f32x16 o[4] = {}; float lsum = 0.f;
    unsigned soK[2], soV[2];
#pragma unroll
    for (int i = 0; i < 2; ++i) { const int p = (wid + 8 * i) * 64 + lane;
        { const int row = p >> 4, c = (p & 15) ^ (row & 7); soK[i] = (unsigned)(row * ldk + c * 8) * 2u; }
        { const int sub = p >> 5, within = p & 31, kk = (sub >> 2) * 8 + (within >> 2), c = (sub & 3) * 32 + (within & 3) * 8, k = (kk & ~0xC) | ((kk & 4) << 1) | ((kk & 8) >> 1);
          soV[i] = (unsigned)(k * ldk + c) * 2u; } }
    const int vb0 = (int)(uintptr_t)(LAS char*)ldsL + 16384 + v_rd_base(lane);
#define ISSUE(jt) do { const int _b = ((jt) - j0) & 3; const char* _kp = (const char*)Kb + (size_t)(jt) * KVBLK * ldk * 2; const char* _vp = (const char*)Vb + (size_t)(jt) * KVBLK * ldk * 2; \
    _Pragma("unroll") for (int _i = 0; _i < 2; ++_i) { \
        __builtin_amdgcn_global_load_lds((const unsigned*)(_kp + soK[_i]), (LAS unsigned*)(ldsL + _b * 32768 + (wid + 8 * _i) * 1024), 16, 0, 0); \
        __builtin_amdgcn_global_load_lds((const unsigned*)(_vp + soV[_i]), (LAS unsigned*)(ldsL + _b * 32768 + 16384 + (wid + 8 * _i) * 1024), 16, 0, 0); } } while (0)
    unsigned bmw = 0u;
    if (MODE == MODE_SLC) bmw = a.BM[((size_t)tq * 4 + g) * 8];
    asm volatile("s_waitcnt vmcnt(0) lgkmcnt(0)" : "+v"(bmw), "+v"(negBC), "+v"(qr[0]), "+v"(qr[1]), "+v"(qr[2]), "+v"(qr[3]), "+v"(qr[4]), "+v"(qr[5]), "+v"(qr[6]), "+v"(qr[7]) :: "memory");
    __builtin_amdgcn_s_barrier();
    asm volatile("" ::: "memory");
    ISSUE(j0); if (j0 + 1 < j1) ISSUE(j0 + 1); if (j0 + 2 < j1) ISSUE(j0 + 2);
    for (int j = j0; j < j1; ++j) {
        const int buf = (j - j0) & 3;
        if (j + 2 < j1) asm volatile("s_waitcnt vmcnt(8)" ::: "memory"); else if (j + 1 < j1) asm volatile("s_waitcnt vmcnt(4)" ::: "memory"); else asm volatile("s_waitcnt vmcnt(0)" ::: "memory");
        __builtin_amdgcn_s_barrier();
        asm volatile("" ::: "memory");
        if (j + 3 < j1) ISSUE(j + 3);
        int lhi = khi;
        if (MODE == MODE_SLC) { if (!((bmw >> (j & 31)) & 1u)) lhi = -1; }
        const int kb = j * KVBLK;
        const bool l_any = (kb + 63 >= klo) && (kb <= lhi);
        const bool l_full = (kb >= klo) && (kb + 63 <= lhi);
        if (__any(l_any)) {
            f32x16 p0, p1;
            qkt(p0, p1, lds + buf * 32768, qr, r32, hi);
            if (__all(l_full || !l_any)) {
                const float off = l_any ? negBC : -1.0e30f;
#pragma unroll
                for (int r = 0; r < 16; ++r) { p0[r] = __builtin_amdgcn_exp2f(fmaf(p0[r], SM_C, off)); p1[r] = __builtin_amdgcn_exp2f(fmaf(p1[r], SM_C, off)); }
            } else {
#pragma unroll
                for (int r = 0; r < 16; ++r) { const int k0i = kb + crow(r, hi), k1i = k0i + 32;
                    const float e0 = __builtin_amdgcn_exp2f(fmaf(p0[r], SM_C, negBC)), e1 = __builtin_amdgcn_exp2f(fmaf(p1[r], SM_C, negBC));
                    p0[r] = (k0i >= klo && k0i <= lhi) ? e0 : 0.f; p1[r] = (k1i >= klo && k1i <= lhi) ? e1 : 0.f; }
            }
            float ps = 0.f;
#pragma unroll
            for (int r = 0; r < 16; ++r) ps += p0[r] + p1[r];
            lsum += ps;
            bf16x8 pa0, pa1, pa2, pa3; pack_p(p0, p1, pa0, pa1, pa2, pa3);
            pv_d0(o, vb0 + buf * 32768, pa0, pa1, pa2, pa3);
        }
        if (MODE == MODE_SLC) { if (((j + 1) & 31) == 0 && j + 1 < j1) { bmw = a.BM[((size_t)tq * 4 + g) * 8 + ((j + 1) >> 5)]; asm volatile("s_waitcnt vmcnt(0)" : "+v"(bmw) :: "memory"); } }
    }
#undef ISSUE
    lsum += __shfl_xor(lsum, 32);
    if (hi == 0) li_l[r32] = lsum;
    if (MODE == MODE_CMP) { if (hi == 0) a.L[(size_t)tq * NH + hq] = lsum; }
    asm volatile("s_waitcnt lgkmcnt(0)" ::: "memory");
#pragma unroll
    for (int r = 0; r < 16; ++r) {
        const int orow = crow(r, hi); const float lv = li_l[orow]; const float rl = lv > 0.f ? 1.0f / lv : 0.f;
        const int t = MODE == MODE_SLC ? t0 + wid * 5 + orow / 6 : t0 + wid * 16 + (orow & 15);
        const int h = MODE == MODE_SLC ? g * HPG + orow % 6 : g * HPG + hp * 2 + (orow >> 4);
        if (MODE == MODE_SLC && (orow >= 30 || t >= S_)) continue;
        const float gt = a.G[(size_t)t * NGATE + h * 3 + (MODE == MODE_CMP ? 0 : (MODE == MODE_SLC ? 1 : 2))] * rl;
        float* oa = a.OACC + (size_t)t * 3072 + h * HD + r32;
#pragma unroll
        for (int d0 = 0; d0 < 4; ++d0) {
            const float v = o[d0][r] * gt;
            if (MODE == MODE_CMP) oa[d0 * 32] = v;
            else if (MODE == MODE_WIN) oa[d0 * 32] += v;
            else a.MIX[(size_t)t * DM + POOLW + h * HD + d0 * 32 + r32] = (bf16_t)(cvt_pk_bf16(oa[d0 * 32] + v, 0.f) & 0xffffu);
        }
    }
}

__device__ __forceinline__ void imp_task(const AttnArgs& a, float* IMPP, float* IMPF, int tqi, int g) {
    const int lane = threadIdx.x & 63, fr = lane & 15, fq = lane >> 4;
    const int t = tqi * 16 + fr;
    const int tmax = tqi * 16 + 15;
    if (tmax < 31) return;
    const int lim = t >= 31 ? ((t - 31) >> 4) : -1;
    const int nstep = ((((tmax - 31) >> 4) >> 6) + 1) * 4;
    const float negBC = -a.TAB[512];
    bf16x8 qf[HPG][4]; float rl[HPG];
#pragma unroll
    for (int h = 0; h < HPG; ++h) {
        const bf16_t* qp = a.Z + (size_t)t * LDZ + OFF_Q + (g * HPG + h) * HD + fq * 8;
#pragma unroll
        for (int ks = 0; ks < 4; ++ks) qf[h][ks] = *reinterpret_cast<const bf16x8*>(qp + ks * 32);
        const float lv = a.L[(size_t)t * NH + g * HPG + h]; rl[h] = lv > 0.f ? 1.0f / lv : 0.f;
    }
    const bf16_t* kbase = a.KC + (size_t)g * 1024 * HD + (size_t)fr * HD + fq * 8;
    bf16x8 kf[4], kn[4];
#pragma unroll
    for (int ks = 0; ks < 4; ++ks) kf[ks] = *reinterpret_cast<const bf16x8*>(kbase + ks * 32);
    float* op = IMPP + ((size_t)t * 4 + g) * 256 + fq; float* of = IMPF + ((size_t)t * 4 + g) * 256 + fq;
    for (int st = 0; st < nstep; ++st) {
        const int sn = (st + 1 < nstep) ? st + 1 : st;
#pragma unroll
        for (int ks = 0; ks < 4; ++ks) kn[ks] = *reinterpret_cast<const bf16x8*>(kbase + (size_t)sn * 16 * HD + ks * 32);
        f32x4 imp4 = {0.f, 0.f, 0.f, 0.f};
        const int n0 = st * 16 + fq * 4;
#pragma unroll
        for (int h = 0; h < HPG; ++h) {
            f32x4 acc = {0.f, 0.f, 0.f, 0.f};
#pragma unroll
            for (int ks = 0; ks < 4; ++ks) acc = __builtin_amdgcn_mfma_f32_16x16x32_bf16(kf[ks], qf[h][ks], acc, 0, 0, 0);
#pragma unroll
            for (int i = 0; i < 4; ++i) { const float e = __builtin_amdgcn_exp2f(fmaf(acc[i], SM_C, negBC)) * rl[h]; imp4[i] += (n0 + i <= lim) ? e : 0.f; }
        }
        op[st * 4] = imp4[0] + 2.0f * (imp4[1] + imp4[2] + imp4[3]);
        of[st * 4] = imp4[0];
#pragma unroll
        for (int ks = 0; ks < 4; ++ks) kf[ks] = kn[ks];
    }
}

__device__ __forceinline__ void topk_task(const float* IMPP, const float* IMPF, unsigned* BM, int t, int g) {
    const int lane = threadIdx.x & 63;
    const int cur = t >> 6;
    unsigned nib = 0u;
    if (cur <= 15) { const int jb = lane * 4;
#pragma unroll
        for (int c = 0; c < 4; ++c) if (jb + c <= cur) nib |= 1u << c; }
    else {
        const size_t base = ((size_t)t * 4 + g) * 256;
        const int jb = lane * 4;
        unsigned key[4];
        {
            f32x4 pp = {0.f, 0.f, 0.f, 0.f}, ff = {0.f, 0.f, 0.f, 0.f};
            if (jb <= cur) { pp = *(const f32x4*)(IMPP + base + jb); ff = *(const f32x4*)(IMPF + base + jb); }
            float fnext = __shfl_down(ff[0], 1);
            if (lane == 63) fnext = 0.f;
            const float v0 = pp[0] + ff[1], v1 = pp[1] + ff[2], v2 = pp[2] + ff[3], v3 = pp[3] + fnext;
            key[0] = (jb + 0 >= 1 && jb + 0 <= cur - 2) ? __float_as_uint(fmaxf(v0, 0.f)) + 1u : 0u;
            key[1] = (jb + 1 >= 1 && jb + 1 <= cur - 2) ? __float_as_uint(fmaxf(v1, 0.f)) + 1u : 0u;
            key[2] = (jb + 2 >= 1 && jb + 2 <= cur - 2) ? __float_as_uint(fmaxf(v2, 0.f)) + 1u : 0u;
            key[3] = (jb + 3 >= 1 && jb + 3 <= cur - 2) ? __float_as_uint(fmaxf(v3, 0.f)) + 1u : 0u;
        }
        unsigned prefix = 0u; bool exact = false;
        for (int b = 30; b >= 0; --b) {
            const unsigned trial = prefix | (1u << b);
            const int cnt = __popcll(__ballot(key[0] >= trial)) + __popcll(__ballot(key[1] >= trial)) + __popcll(__ballot(key[2] >= trial)) + __popcll(__ballot(key[3] >= trial));
            if (cnt >= 13) { prefix = trial; if (cnt == 13) { exact = true; break; } }
        }
#pragma unroll
        for (int c = 0; c < 4; ++c) if (exact ? (key[c] >= prefix) : (key[c] > prefix)) nib |= 1u << c;
        if (!exact) {
            int need = 13 - (__popcll(__ballot(key[0] > prefix)) + __popcll(__ballot(key[1] > prefix)) + __popcll(__ballot(key[2] > prefix)) + __popcll(__ballot(key[3] > prefix)));
            unsigned tie = 0u;
#pragma unroll
            for (int c = 0; c < 4; ++c) if (key[c] == prefix) tie |= 1u << c;
            for (int guard = 0; need > 0 && guard < 16; ++guard) {
                const unsigned long long any = __ballot(tie != 0u);
                if (any == 0ull) break;
                const int L = __builtin_ctzll(any);
                if (lane == L) { const unsigned low = tie & (0u - tie); nib |= low; tie ^= low; }
                --need;
            }
        }
        if (lane == 0) nib |= 1u;
        if (lane == (cur >> 2)) nib |= 1u << (cur & 3);
        if (lane == ((cur - 1) >> 2)) nib |= 1u << ((cur - 1) & 3);
    }
    unsigned x = nib << (4 * (lane & 7));
    x |= __shfl_xor(x, 1); x |= __shfl_xor(x, 2); x |= __shfl_xor(x, 4);
    if ((lane & 7) == 0) BM[((size_t)t * 4 + g) * 8 + (lane >> 3)] = x;
}
#undef KSWZ
}

template <bool FFN_REMAP = false>
__device__ __forceinline__ void convT(const float* __restrict__ src, int K, int N, bf16_t* __restrict__ dst, int ldd, LAS float* tile, int bid, int nb) {
    const int tid = threadIdx.x, tk = K >> 6, tn = (N + 63) >> 6, total = tk * tn;
    for (int idx = bid; idx < total; idx += nb) {
        const int nti = idx % tn, kti = idx / tn;
        const int r = tid >> 4, c4 = (tid & 15) * 4, ng = nti * 64 + c4;
#pragma unroll
        for (int h = 0; h < 2; ++h) {
            f32x4 v = {0.f, 0.f, 0.f, 0.f};
            if (ng < N) v = *(const f32x4*)(src + (size_t)(kti * 64 + r + h * 32) * N + ng);
            LAS float* tp = tile + (r + h * 32) * 65 + c4;
            tp[0] = v[0]; tp[1] = v[1]; tp[2] = v[2]; tp[3] = v[3];
        }
        __syncthreads();
        const int n = tid >> 3, k8 = (tid & 7) * 8, ngl = nti * 64 + n;
        float e[8];
#pragma unroll
        for (int i = 0; i < 8; ++i) e[i] = tile[(k8 + i) * 65 + n];
        if (ngl < N) { u32x4 w; w.x = cvt_pk_bf16(e[0], e[1]); w.y = cvt_pk_bf16(e[2], e[3]); w.z = cvt_pk_bf16(e[4], e[5]); w.w = cvt_pk_bf16(e[6], e[7]);
            int drow = ngl; if (FFN_REMAP) { const int up = ngl >= DFF ? 1 : 0, f = ngl - up * DFF; drow = (f >> 7) * 256 + up * 128 + (f & 127); }
            *(u32x4*)(dst + (size_t)drow * ldd + kti * 64 + k8) = w; }
        __syncthreads();
    }
}
__device__ __forceinline__ void rmsnorm_rows(const float* __restrict__ src, const float* __restrict__ w, bf16_t* __restrict__ dst, int rows, int gw, int nw) {
    const int lane = threadIdx.x & 63;
    for (int row = gw; row < rows; row += nw) {
        const f32x4* sp = (const f32x4*)(src + (size_t)row * DM);
        f32x4 v[16]; float ss = 0.f;
#pragma unroll
        for (int i = 0; i < 16; ++i) { v[i] = sp[lane + 64 * i]; ss += v[i][0] * v[i][0] + v[i][1] * v[i][1] + v[i][2] * v[i][2] + v[i][3] * v[i][3]; }
        ss = wave_sum(ss);
        const float rstd = rsqrtf(ss * (1.0f / DM) + EPS);
#pragma unroll
        for (int i = 0; i < 16; ++i) { const f32x4 ww = ((const f32x4*)w)[lane + 64 * i];
            u32x2 o; o.x = cvt_pk_bf16(v[i][0] * rstd * ww[0], v[i][1] * rstd * ww[1]); o.y = cvt_pk_bf16(v[i][2] * rstd * ww[2], v[i][3] * rstd * ww[3]);
            *(u32x2*)(dst + (size_t)row * DM + (lane + 64 * i) * 4) = o; }
    }
}

struct Ptrs {
    bf16_t *Win, *Wo, *Wfi, *Wfo, *Wg, *Wple, *Wpool, *Wc1k, *Wc1v, *XN, *PB, *Z, *M, *KC, *VC, *MIX, *ACT, *ERAW;
    float *COS, *SIN, *TAB, *G, *H1, *L, *OACC, *IMPP, *IMPF, *ERSTD; unsigned* BM;
};

__device__ __forceinline__ void phase_prologue(const Params& P, const Ptrs& W, LAS unsigned char* lds) {
    const int bid = blockIdx.x, nb = gridDim.x, tid = threadIdx.x, lane = tid & 63, wv = tid >> 6;
    const int gw = bid * NWAVES + wv, nw = nb * NWAVES; const size_t gt = (size_t)bid * NTHREADS + tid, ntot = (size_t)nb * NTHREADS;
    LAS float* tile = (LAS float*)lds;
    rmsnorm_rows(P.x, P.norm1_w, W.XN, S_, gw, nw);
    convT(P.w_in, DM, INW, W.Win, DM, tile, bid, nb);
    for (size_t i = gt; i < (size_t)(LDZ - INW) * DM / 8; i += ntot) *(u32x4*)(W.Win + (size_t)INW * DM + i * 8) = (u32x4){0u, 0u, 0u, 0u};
    convT(P.w_o, DM, DM, W.Wo, DM, tile, bid, nb);
    convT<true>(P.w_ffn_in, DM, NFI, W.Wfi, DM, tile, bid, nb);
    for (size_t i = gt; i < (size_t)2 * DM / 8; i += ntot) *(u32x4*)(W.XN - 2 * DM + i * 8) = (u32x4){0u, 0u, 0u, 0u};
    convT(P.w_ffn_out, DFF, DM, W.Wfo, DFF, tile, bid, nb);
    convT(P.w_ple_gate, DM, DM, W.Wg, DM, tile, bid, nb);
    convT(P.w_ple_proj, PLE, DM, W.Wple, PLE, tile, bid, nb);
    for (int g = 0; g < 4; ++g) convT(P.w_pool + (size_t)g * 65536, 256, 256, W.Wpool + (size_t)g * 65536, 256, tile, bid, nb);
    convT(P.cmp_k_w1, 4096, 256, W.Wc1k, 4096, tile, bid, nb);
    convT(P.cmp_v_w1, 4096, 256, W.Wc1v, 4096, tile, bid, nb);
    for (size_t i = gt; i < (size_t)S_ * PLE / 8; i += ntot) { const f32x4 a = *(const f32x4*)(P.p + i * 8), b = *(const f32x4*)(P.p + i * 8 + 4);
        u32x4 w; w.x = cvt_pk_bf16(a[0], a[1]); w.y = cvt_pk_bf16(a[2], a[3]); w.z = cvt_pk_bf16(b[0], b[1]); w.w = cvt_pk_bf16(b[2], b[3]); *(u32x4*)(W.PB + i * 8) = w; }
    for (size_t i = gt; i < (size_t)S_ * 16; i += ntot) { const int t = (int)(i >> 4), fi = (int)(i & 15);
        const float inv = exp2f(-(float)fi * (18.931568569324174f / 16.0f)); const float ang = (float)P.positions[t] * inv;
        const double ad = (double)ang; const double kk = rint(ad * 0.15915494309189535); const float rf = (float)(ad - kk * 6.283185307179586);
        W.COS[i] = __cosf(rf); W.SIN[i] = __sinf(rf); }
    for (int o = gw; o < 512; o += nw) { const int which = o >> 8, j = o & 255; const float* pe = which ? P.cmp_pos_v : P.cmp_pos_k; const float* w1 = which ? P.cmp_v_w1 : P.cmp_k_w1;
        float s = 0.f; for (int r = lane; r < 4096; r += 64) s += pe[r] * w1[(size_t)r * 256 + j];
        s = wave_sum(s); if (lane == 0) W.TAB[o] = s; }
    if (gw == 0) { float mq = fmaxf(fabsf(P.q_norm_w[lane]), fabsf(P.q_norm_w[lane + 64])); mq = wave_max(mq);
        float mc = wave_max(fmaxf(fabsf(P.k_norm_cmp_w[lane]), fabsf(P.k_norm_cmp_w[lane + 64])));
        float ms = wave_max(fmaxf(fabsf(P.k_norm_slc_w[lane]), fabsf(P.k_norm_slc_w[lane + 64])));
        float mw = wave_max(fmaxf(fabsf(P.k_norm_win_w[lane]), fabsf(P.k_norm_win_w[lane + 64])));
        const float c = 11.313708498984761f * 1.4426950408889634f * mq * 1.01f;
        if (lane == 0) { W.TAB[512] = c * mc; W.TAB[513] = c * ms; W.TAB[514] = c * mw; } }
}

__device__ __forceinline__ void phase_postz(const Params& P, const Ptrs& W, int gw, int nw) {
    const int tid = threadIdx.x, lane = tid & 63;
    const f32x2 wq = *(const f32x2*)(P.q_norm_w + 2 * lane), wks = *(const f32x2*)(P.k_norm_slc_w + 2 * lane), wkw = *(const f32x2*)(P.k_norm_win_w + 2 * lane);
    for (int t = gw; t < S_; t += nw) {
        bf16_t* zr = W.Z + (size_t)t * LDZ;
        float cs0 = 0.f, cs1 = 0.f, sn0 = 0.f, sn1 = 0.f;
        if (lane < 16) { const int i0 = (2 * lane) & 15; cs0 = W.COS[t * 16 + i0]; cs1 = W.COS[t * 16 + i0 + 1]; sn0 = W.SIN[t * 16 + i0]; sn1 = W.SIN[t * 16 + i0 + 1]; }
        for (int v = 0; v < 32; ++v) {
            const int col = v < 24 ? OFF_Q + v * HD : (v < 28 ? OFF_KV + 2 * 512 + (v - 24) * HD : OFF_KV + 4 * 512 + (v - 28) * HD);
            const f32x2 ww = v < 24 ? wq : (v < 28 ? wks : wkw);
            unsigned* ptr = (unsigned*)(zr + col) + lane;
            const unsigned u = *ptr; const float x0 = bf_lo(u), x1 = bf_hi(u);
            const float ss = wave_sum(x0 * x0 + x1 * x1);
            const float rstd = rsqrtf(ss * (1.0f / HD) + EPS);
            float y0 = x0 * rstd * ww[0], y1 = x1 * rstd * ww[1];
            const float p0 = __shfl_xor(y0, 8), p1 = __shfl_xor(y1, 8);
            if (lane < 8) { y0 = y0 * cs0 - p0 * sn0; y1 = y1 * cs1 - p1 * sn1; }
            else if (lane < 16) { y0 = y0 * cs0 + p0 * sn0; y1 = y1 * cs1 + p1 * sn1; }
            *ptr = cvt_pk_bf16(y0, y1);
        }
        for (int c = lane; c < NGATE; c += 64) W.G[(size_t)t * NGATE + c] = sigmoidf_(bf2f(zr[OFF_G + c]));
        {
            const int gi = lane >> 4, wlen = 2 << gi, c0 = lane * 16; const int cnt = (t + 1) < wlen ? (t + 1) : wlen;
            float s[16];
#pragma unroll
            for (int i = 0; i < 16; ++i) s[i] = 0.f;
            float cur[16];
            for (int i = 0; i < cnt; ++i) { const u32x4 a = *(const u32x4*)(W.Z + (size_t)(t - i) * LDZ + c0), b = *(const u32x4*)(W.Z + (size_t)(t - i) * LDZ + c0 + 8);
                const float e[16] = {bf_lo(a.x), bf_hi(a.x), bf_lo(a.y), bf_hi(a.y), bf_lo(a.z), bf_hi(a.z), bf_lo(a.w), bf_hi(a.w), bf_lo(b.x), bf_hi(b.x), bf_lo(b.y), bf_hi(b.y), bf_lo(b.z), bf_hi(b.z), bf_lo(b.w), bf_hi(b.w)};
#pragma unroll
                for (int q = 0; q < 16; ++q) { s[q] += e[q]; if (i == 0) cur[q] = e[q]; } }
            const float rc = 1.0f / (float)cnt;
            u32x4 o0, o1;
            o0.x = cvt_pk_bf16(s[0] * rc - cur[0], s[1] * rc - cur[1]); o0.y = cvt_pk_bf16(s[2] * rc - cur[2], s[3] * rc - cur[3]);
            o0.z = cvt_pk_bf16(s[4] * rc - cur[4], s[5] * rc - cur[5]); o0.w = cvt_pk_bf16(s[6] * rc - cur[6], s[7] * rc - cur[7]);
            o1.x = cvt_pk_bf16(s[8] * rc - cur[8], s[9] * rc - cur[9]); o1.y = cvt_pk_bf16(s[10] * rc - cur[10], s[11] * rc - cur[11]);
            o1.z = cvt_pk_bf16(s[12] * rc - cur[12], s[13] * rc - cur[13]); o1.w = cvt_pk_bf16(s[14] * rc - cur[14], s[15] * rc - cur[15]);
            *(u32x4*)(W.M + (size_t)t * POOLW + c0) = o0; *(u32x4*)(W.M + (size_t)t * POOLW + c0 + 8) = o1;
        }
    }
}

__device__ __forceinline__ void phase_cmpfin(const Params& P, const Ptrs& W) {
    const int tid = threadIdx.x, lane = tid & 63, gw = blockIdx.x * NWAVES + (tid >> 6), nw = gridDim.x * NWAVES;
    const f32x2 wk = *(const f32x2*)(P.k_norm_cmp_w + 2 * lane);
    for (int task = gw; task < 8192; task += nw) {
        const int tk = __builtin_amdgcn_readfirstlane(task);
        const int which = tk >> 12, g = (tk >> 10) & 3, n = tk & 1023;
        bf16_t* dst = (which ? W.VC : W.KC) + ((size_t)g * 1024 + n) * HD;
        if (n == 1023) { ((unsigned*)dst)[lane] = 0u; continue; }
        const float* h = W.H1 + (size_t)tk * 256; const float* w2 = which ? P.cmp_v_w2 : P.cmp_k_w2;
        float a0 = 0.f, a1 = 0.f;
        for (int j = 0; j < 256; ++j) { const float hj = h[j]; const f32x2 wv = *(const f32x2*)(w2 + j * HD + 2 * lane); a0 += hj * wv[0]; a1 += hj * wv[1]; }
        if (which == 0) {
            const float ss = wave_sum(a0 * a0 + a1 * a1); const float rstd = rsqrtf(ss * (1.0f / HD) + EPS);
            a0 = a0 * rstd * wk[0]; a1 = a1 * rstd * wk[1];
            const int tp = 16 * n + 31; const float p0 = __shfl_xor(a0, 8), p1 = __shfl_xor(a1, 8);
            if (lane < 16) { const int i0 = (2 * lane) & 15; const float cs0 = W.COS[tp * 16 + i0], cs1 = W.COS[tp * 16 + i0 + 1], sn0 = W.SIN[tp * 16 + i0], sn1 = W.SIN[tp * 16 + i0 + 1];
                if (lane < 8) { a0 = a0 * cs0 - p0 * sn0; a1 = a1 * cs1 - p1 * sn1; } else { a0 = a0 * cs0 + p0 * sn0; a1 = a1 * cs1 + p1 * sn1; } }
        }
        ((unsigned*)dst)[lane] = cvt_pk_bf16(a0, a1);
    }
}

__device__ __forceinline__ void phase_erstd(const Ptrs& W) {
    const int tid = threadIdx.x, lane = tid & 63, gw = blockIdx.x * NWAVES + (tid >> 6), nw = gridDim.x * NWAVES;
    for (int row = gw; row < S_; row += nw) {
        const u32x4* sp = (const u32x4*)(W.ERAW + (size_t)row * DM); float ss = 0.f;
#pragma unroll
        for (int i = 0; i < 8; ++i) { const u32x4 a = sp[lane + 64 * i];
            const float e0 = bf_lo(a.x), e1 = bf_hi(a.x), e2 = bf_lo(a.y), e3 = bf_hi(a.y), e4 = bf_lo(a.z), e5 = bf_hi(a.z), e6 = bf_lo(a.w), e7 = bf_hi(a.w);
            ss += e0 * e0 + e1 * e1 + e2 * e2 + e3 * e3 + e4 * e4 + e5 * e5 + e6 * e6 + e7 * e7; }
        ss = wave_sum(ss);
        if (lane == 0) W.ERSTD[row] = rsqrtf(ss * (1.0f / DM) + EPS);
    }
}

constexpr int N_PHASES = 12;
__device__ __forceinline__ Params kargs() {
#if defined(__HIP_DEVICE_COMPILE__)
    unsigned long long p = (unsigned long long)__builtin_amdgcn_kernarg_segment_ptr();
    asm volatile("" : "+s"(p));
    return *(const __attribute__((address_space(4))) Params*)p;
#else
    return Params{};
#endif
}
__device__ __forceinline__ Ptrs mkptrs(unsigned char* ws) {
    Ptrs W;
    W.Win = (bf16_t*)(ws + WS_WIN); W.Wo = (bf16_t*)(ws + WS_WO); W.Wfi = (bf16_t*)(ws + WS_WFI); W.Wfo = (bf16_t*)(ws + WS_WFO); W.Wg = (bf16_t*)(ws + WS_WG);
    W.Wple = (bf16_t*)(ws + WS_WPLE); W.Wpool = (bf16_t*)(ws + WS_WPOOL); W.Wc1k = (bf16_t*)(ws + WS_WC1K); W.Wc1v = (bf16_t*)(ws + WS_WC1V);
    W.XN = (bf16_t*)(ws + WS_XN); W.PB = (bf16_t*)(ws + WS_PB); W.Z = (bf16_t*)(ws + WS_Z); W.M = (bf16_t*)(ws + WS_M); W.KC = (bf16_t*)(ws + WS_KC); W.VC = (bf16_t*)(ws + WS_VC);
    W.MIX = (bf16_t*)(ws + WS_MIX); W.ACT = (bf16_t*)(ws + WS_ACT); W.ERAW = (bf16_t*)(ws + WS_ERAW);
    W.COS = (float*)(ws + WS_COS); W.SIN = (float*)(ws + WS_SIN); W.TAB = (float*)(ws + WS_TAB); W.G = (float*)(ws + WS_G); W.H1 = (float*)(ws + WS_H1); W.L = (float*)(ws + WS_L);
    W.OACC = (float*)(ws + WS_OACC); W.IMPP = (float*)(ws + WS_IMPP); W.IMPF = (float*)(ws + WS_IMPF); W.ERSTD = (float*)(ws + WS_ERSTD); W.BM = (unsigned*)(ws + WS_BM);
    return W;
}
__global__ void __launch_bounds__(NTHREADS, 2) fwd(Params Punused) {
    extern __shared__ __attribute__((aligned(16))) unsigned char lds_raw[];
    LAS unsigned char* lds = (LAS unsigned char*)lds_raw;
    const int tid = threadIdx.x;
    const int G = gridDim.x, bid = blockIdx.x;
    const int gw = bid * NWAVES + (tid >> 6), nw = G * NWAVES;

    if (tid < 16) ((LAS unsigned*)(lds + LDS_MISC))[tid] = 0u;
    __syncthreads();
    int lo, hi; XcdBarrier bar;
    { const Params P = kargs(); lo = P.ph_lo; hi = P.ph_hi;
      bar.bar = (unsigned*)(P.ws + WS_CTL); bar.x = 0; bar.st = (volatile LAS unsigned*)(lds + LDS_MISC);
      if (hi - lo > 1) bar = xcd_barrier_post((unsigned*)(P.ws + WS_CTL), (volatile LAS unsigned*)(lds + LDS_MISC)); }
#ifdef PH_MASK
#define IN(k) (((PH_MASK >> (k)) & 1) && lo <= (k) && (k) < hi)
#else
#define IN(k) (lo <= (k) && (k) < hi)
#endif
#define SEAM(k) do { if (IN(k) && IN((k) + 1)) xcd_barrier(bar); } while (0)
#define PHASE_VARS const Params P = kargs(); const Ptrs W = mkptrs(P.ws); (void)W;
#define ATT_ARGS att::AttnArgs AA{W.Z, W.KC, W.VC, W.G, W.L, W.OACC, W.MIX, W.BM, W.TAB};

    if (IN(0)) { PHASE_VARS REP(0) { phase_prologue(P, W, lds); } SEAM(0); }
    if (IN(1)) {
        PHASE_VARS
        pg8::GStd g{(const char*)W.XN, (const char*)W.Win, DM, DM, DM / 64}; pg8::StaticOrder S; S.init(S_ / 256, LDZ / 256, G, bid);
        pg8::EpiBf16 E{W.Z, LDZ};
        REP(1) { pg8::gemm_phase(lds, g, S, E); } SEAM(1);
    }
    if (IN(2)) {
        PHASE_VARS
        if (G > 64) {
            if (bid < 32) { pg8::GCmp g{(const char*)W.Z, (const char*)W.Wc1k, (const char*)W.Wc1v, 16 * LDZ, 4096, 64}; pg8::StaticOrder S; S.init(32, 1, 32, bid);
                pg8::EpiCmpGelu E{W.H1, W.TAB}; pg8::gemm_phase(lds, g, S, E); }
            else phase_postz(P, W, (bid - 32) * NWAVES + (tid >> 6), (G - 32) * NWAVES);
        } else {
            { pg8::GCmp g{(const char*)W.Z, (const char*)W.Wc1k, (const char*)W.Wc1v, 16 * LDZ, 4096, 64}; pg8::StaticOrder S; S.init(32, 1, G, bid);
              pg8::EpiCmpGelu E{W.H1, W.TAB}; pg8::gemm_phase(lds, g, S, E); }
            phase_postz(P, W, gw, nw);
        }
        SEAM(2);
    }
    if (IN(3)) {
        PHASE_VARS
        phase_cmpfin(P, W);
        { pg8::GPool g{(const char*)W.M, (const char*)W.Wpool, POOLW, 256, 4}; pg8::StaticOrder S; S.init(S_ / 256, 4, G, bid);
          pg8::EpiBf16Scale E{W.MIX, DM, P.pool_scale}; pg8::gemm_phase(lds, g, S, E); }
        SEAM(3);
    }
    if (IN(4)) {
        PHASE_VARS ATT_ARGS
        REP(4)
        for (int base = 0, rnd = 0; base < 1536; base += G, ++rnd) {
            int qt, g, hp;
            if (G == 256) { const int x = bid & 7, r = bid >> 3, qp = (rnd / 3) ? 63 - r : r; if (rnd >= 6) break; g = x & 3; qt = 2 * qp + (x >> 2); hp = rnd % 3; }
            else { const int Lu = base + ((rnd & 1) ? G - 1 - bid : bid); if (Lu >= 1536) continue; qt = Lu / 12; const int rem = Lu % 12; g = rem / 3; hp = rem % 3; }
            att::attn_unit<att::MODE_CMP>(AA, (LAS char*)lds, qt, g, hp);
            asm volatile("s_waitcnt vmcnt(0)" ::: "memory");
            att::attn_unit<att::MODE_WIN>(AA, (LAS char*)lds, qt, g, hp); }
        SEAM(4);
    }
    if (IN(5)) { PHASE_VARS ATT_ARGS REP(5) for (int k = gw, r = 0; k < 4096; k += nw, ++r) { const int hiT = (r + 1) * nw < 4096 ? (r + 1) * nw : 4096;
            const int task = (r & 1) ? hiT - 1 - (k - r * nw) : k; att::imp_task(AA, W.IMPP, W.IMPF, task >> 2, task & 3); } SEAM(5); }
    if (IN(6)) { PHASE_VARS REP(6) for (int task = gw; task < S_ * 4; task += nw) att::topk_task(W.IMPP, W.IMPF, W.BM, task >> 2, task & 3); SEAM(6); }
    if (IN(7)) {
        PHASE_VARS ATT_ARGS
        REP(7)
        for (int base = 0, rnd = 0; base < 1640 + G; base += G, ++rnd) {
            int ut, g;
            if (G == 256) { const int x = bid & 7, r = bid >> 3, k = rnd * 32 + ((rnd & 1) ? 31 - r : r); if (k >= 205) break; g = x & 3; ut = 409 - (2 * k + (x >> 2)); }
            else { const int Lu = base + ((rnd & 1) ? G - 1 - bid : bid); if (Lu >= 1640) continue; ut = 409 - Lu / 4; g = Lu % 4; }
            att::attn_unit<att::MODE_SLC>(AA, (LAS char*)lds, ut, g, 0); }
        SEAM(7);
    }
    if (IN(8)) {
        PHASE_VARS
        { pg8::GStd g{(const char*)W.MIX, (const char*)W.Wo, DM, DM, DM / 64}; pg8::StaticOrder S; S.init(S_ / 256, DM / 256, G, bid);
          pg8::EpiResNorm E{P.x, P.out, W.XN, P.norm2_w, (float*)(P.ws + WS_SSQ1), DM}; pg8::gemm_phase(lds, g, S, E); }
        { pg8::GStd g{(const char*)W.PB, (const char*)W.Wple, PLE, PLE, PLE / 64}; pg8::StaticOrder S; S.init(S_ / 256, DM / 256, G, bid);
          pg8::EpiBf16 E{W.ERAW, DM}; pg8::gemm_phase(lds, g, S, E); }
        SEAM(8);
    }
    if (IN(9)) {
        PHASE_VARS
        phase_erstd(W);
        pg8::GFfn g{(const char*)W.XN, (const char*)W.Wfi, DM, DM, DM / 64}; pg8::StaticOrder S; S.init(65, DFF / 128, G, bid);
        pg8::EpiFfn E{W.ACT, P.conv_w, P.conv_b, (LAS float*)(lds + LDS_XCH), (const float*)(P.ws + WS_SSQ1)}; REP(9) { pg8::gemm_phase(lds, g, S, E); } SEAM(9);
    }
    if (IN(10)) {
        PHASE_VARS
        pg8::GStd g{(const char*)W.ACT, (const char*)W.Wfo, DFF, DFF, DFF / 64}; pg8::StaticOrder S; S.init(S_ / 256, DM / 256, G, bid);
        pg8::EpiResNorm E{P.out, P.out, W.XN, P.ple_gate_norm_w, (float*)(P.ws + WS_SSQ2), DM}; pg8::gemm_phase(lds, g, S, E); SEAM(10);
    }
    if (IN(11)) {
        PHASE_VARS
        pg8::GStd g{(const char*)W.XN, (const char*)W.Wg, DM, DM, DM / 64}; pg8::StaticOrder S; S.init(S_ / 256, DM / 256, G, bid);
        pg8::EpiGate E{P.out, W.ERAW, W.ERSTD, P.ple_norm_w, (const float*)(P.ws + WS_SSQ2), DM}; pg8::gemm_phase(lds, g, S, E);
    }
#undef IN
#undef SEAM
}

extern "C" void kernel_launch(void* const* d_in, const int* in_sizes, int n_in, void* d_out, int out_size, void* d_ws, size_t ws_size, hipStream_t stream) {
    static int grid = 0;
    if (grid == 0) {
        if (n_in != 27 || in_sizes[0] != S_ * DM || out_size != S_ * DM || ws_size < WS_NEED) {
            fprintf(stderr, "kernel_launch: unexpected shapes (n_in %d, in0 %d, out %d, ws %zu < %zu); nothing launched\n", n_in, n_in > 0 ? in_sizes[0] : -1, out_size, ws_size, (size_t)WS_NEED); grid = -1; return; }
        int dev = 0, cus = 0, per_cu = 0;
        if (hipGetDevice(&dev) != hipSuccess || hipDeviceGetAttribute(&cus, hipDeviceAttributeMultiprocessorCount, dev) != hipSuccess) { grid = -1; return; }
        if (hipFuncSetAttribute((const void*)fwd, hipFuncAttributeMaxDynamicSharedMemorySize, LDS_BYTES) != hipSuccess) { fprintf(stderr, "kernel_launch: hipFuncSetAttribute failed\n"); grid = -1; return; }
        if (hipOccupancyMaxActiveBlocksPerMultiprocessor(&per_cu, (const void*)fwd, NTHREADS, LDS_BYTES) != hipSuccess || per_cu < 1) { fprintf(stderr, "kernel_launch: occupancy query says %d\n", per_cu); (void)hipGetLastError(); }
        grid = cus > 256 ? 256 : cus;
    }
    if (grid < 0) return;
    (void)hipMemsetAsync((char*)d_ws + WS_CTL, 0, CTL_BYTES, stream);
    Params P{};
    const float** fp = (const float**)&P;
    P.x = (const float*)d_in[0]; P.p = (const float*)d_in[1]; P.positions = (const int*)d_in[2]; P.norm1_w = (const float*)d_in[3]; P.w_in = (const float*)d_in[4];
    P.w_pool = (const float*)d_in[5]; P.pool_scale = (const float*)d_in[6]; P.q_norm_w = (const float*)d_in[7]; P.k_norm_cmp_w = (const float*)d_in[8];
    P.k_norm_slc_w = (const float*)d_in[9]; P.k_norm_win_w = (const float*)d_in[10]; P.cmp_pos_k = (const float*)d_in[11]; P.cmp_pos_v = (const float*)d_in[12];
    P.cmp_k_w1 = (const float*)d_in[13]; P.cmp_k_w2 = (const float*)d_in[14]; P.cmp_v_w1 = (const float*)d_in[15]; P.cmp_v_w2 = (const float*)d_in[16];
    P.w_o = (const float*)d_in[17]; P.norm2_w = (const float*)d_in[18]; P.w_ffn_in = (const float*)d_in[19]; P.conv_w = (const float*)d_in[20]; P.conv_b = (const float*)d_in[21];
    P.w_ffn_out = (const float*)d_in[22]; P.w_ple_proj = (const float*)d_in[23]; P.ple_norm_w = (const float*)d_in[24]; P.ple_gate_norm_w = (const float*)d_in[25]; P.w_ple_gate = (const float*)d_in[26];
    (void)fp;
    P.out = (float*)d_out; P.ws = (unsigned char*)d_ws;
#if MK_ONE_LAUNCH
    P.ph_lo = 0; P.ph_hi = N_PHASES;
    hipLaunchKernelGGL(fwd, dim3(grid), dim3(NTHREADS), LDS_BYTES, stream, P);
#else
    for (int ph = 0; ph < N_PHASES; ++ph) { P.ph_lo = ph; P.ph_hi = ph + 1; hipLaunchKernelGGL(fwd, dim3(grid), dim3(NTHREADS), LDS_BYTES, stream, P); }
#endif
    const hipError_t le = hipPeekAtLastError();
    if (le != hipSuccess) fprintf(stderr, "kernel_launch: launch failed: %s\n", hipGetErrorName(le));
}
```

```cpp
#include <hip/hip_runtime.h>
#include <cstdio>
#include <cstdint>

#ifndef PROBE_DBL
#define PROBE_DBL 0
#endif
#define REP(k) _Pragma("unroll") for (int rep_ = 0; rep_ < 1 + ((PROBE_DBL >> (k)) & 1); ++rep_)
#ifndef MK_ONE_LAUNCH
#define MK_ONE_LAUNCH 1
#endif

#define LAS __attribute__((address_space(3)))
typedef unsigned short bf16_t;
typedef short bf16x8 __attribute__((ext_vector_type(8)));
typedef short s16x4 __attribute__((ext_vector_type(4)));
typedef float f32x2 __attribute__((ext_vector_type(2)));
typedef float f32x4 __attribute__((ext_vector_type(4)));
typedef float f32x16 __attribute__((ext_vector_type(16)));
typedef unsigned u32x2 __attribute__((ext_vector_type(2)));
typedef unsigned u32x4 __attribute__((ext_vector_type(4)));

constexpr int S_ = 16384, DM = 4096, INW = 7240, LDZ = 7424, POOLW = 1024, NH = 24, NKV = 4, HPG = 6, HD = 128;
constexpr int OFF_Q = 1024, OFF_KV = 4096, OFF_G = 7168, DFF = 11008, NFI = 22016, PLE = 256, NGATE = 72;
constexpr int ZROWS = S_ + 64, XNROWS = S_ + 256, CHUNK = 8192;
constexpr float EPS = 1e-6f;
constexpr float SM_C = 0.08838834764831845f * 1.4426950408889634f;
constexpr int NWAVES = 8, NTHREADS = 512;

constexpr size_t al256(size_t x) { return (x + 255) / 256 * 256; }
constexpr size_t WS_CTL   = 0;
constexpr size_t CTL_BYTES = 262144;
constexpr size_t WS_SSQ1 = WS_CTL + 65536, WS_SSQ2 = WS_CTL + 131072;
constexpr size_t WS_WIN   = WS_CTL + CTL_BYTES;
constexpr size_t WS_WO    = WS_WIN + al256((size_t)LDZ * DM * 2);
constexpr size_t WS_WFI   = WS_WO + al256((size_t)DM * DM * 2);
constexpr size_t WS_WFO   = WS_WFI + al256((size_t)NFI * DM * 2);
constexpr size_t WS_WG    = WS_WFO + al256((size_t)DM * DFF * 2);
constexpr size_t WS_WPLE  = WS_WG + al256((size_t)DM * DM * 2);
constexpr size_t WS_WPOOL = WS_WPLE + al256((size_t)DM * PLE * 2);
constexpr size_t WS_WC1K  = WS_WPOOL + al256((size_t)1024 * 256 * 2);
constexpr size_t WS_WC1V  = WS_WC1K + al256((size_t)256 * 4096 * 2);
constexpr size_t WS_COS   = WS_WC1V + al256((size_t)256 * 4096 * 2);
constexpr size_t WS_SIN   = WS_COS + al256((size_t)S_ * 16 * 4);
constexpr size_t WS_TAB   = WS_SIN + al256((size_t)S_ * 16 * 4);
constexpr size_t WS_XNP   = WS_TAB + 4096;
constexpr size_t WS_XN    = WS_XNP + (size_t)2 * DM * 2;
constexpr size_t WS_PB    = WS_XN + al256((size_t)XNROWS * DM * 2);
constexpr size_t WS_R     = WS_PB + al256((size_t)S_ * PLE * 2);
constexpr size_t WS_Z     = WS_R;
constexpr size_t WS_M     = WS_Z + al256((size_t)ZROWS * LDZ * 2);
constexpr size_t WS_G     = WS_M + al256((size_t)S_ * POOLW * 2);
constexpr size_t WS_H1    = WS_G + al256((size_t)S_ * NGATE * 4);
constexpr size_t WS_KC    = WS_H1 + al256((size_t)8192 * 256 * 4);
constexpr size_t WS_VC    = WS_KC + al256((size_t)4 * 1024 * 128 * 2);
constexpr size_t WS_L     = WS_VC + al256((size_t)4 * 1024 * 128 * 2);
constexpr size_t WS_OACC  = WS_L + al256((size_t)S_ * NH * 4);
constexpr size_t WS_IMPP  = WS_OACC + al256((size_t)S_ * 3072 * 4);
constexpr size_t WS_IMPF  = WS_IMPP + al256((size_t)S_ * 4 * 256 * 4);
constexpr size_t WS_BM    = WS_IMPF + al256((size_t)S_ * 4 * 256 * 4);
constexpr size_t WS_MIX   = WS_BM + al256((size_t)S_ * 4 * 8 * 4);
constexpr size_t WS_END_A = WS_MIX + al256((size_t)S_ * DM * 2);
constexpr size_t WS_ERAW  = WS_R;
constexpr size_t WS_ACT   = WS_ERAW + al256((size_t)S_ * DM * 2);
constexpr size_t WS_ERSTD = WS_ACT + al256((size_t)S_ * DFF * 2);
constexpr size_t WS_END_B = WS_ERSTD + al256((size_t)S_ * 4);
static_assert(WS_ERAW + (size_t)S_ * DM * 2 <= WS_Z + (size_t)ZROWS * LDZ * 2, "eraw must fit inside the dead z region while mix is still being read");
constexpr size_t WS_NEED  = WS_END_A > WS_END_B ? WS_END_A : WS_END_B;
static_assert(WS_MIX >= WS_END_B || true, "");

constexpr int LDS_STAGE = 131072;
constexpr int LDS_MISC  = LDS_STAGE;
constexpr int LDS_XCH   = LDS_STAGE + 64;
constexpr int LDS_BYTES = LDS_XCH + 4096;

__device__ __forceinline__ unsigned cvt_pk_bf16(float lo, float hi) { unsigned r; asm volatile("v_cvt_pk_bf16_f32 %0, %1, %2" : "=v"(r) : "v"(lo), "v"(hi)); return r; }
__device__ __forceinline__ float bf_lo(unsigned u) { return __uint_as_float(u << 16); }
__device__ __forceinline__ float bf_hi(unsigned u) { return __uint_as_float(u & 0xffff0000u); }
__device__ __forceinline__ float bf2f(bf16_t b) { return __uint_as_float(((unsigned)b) << 16); }
__device__ __forceinline__ float wave_sum(float v) {
#pragma unroll
    for (int o = 32; o >= 1; o >>= 1) v += __shfl_xor(v, o);
    return v;
}
__device__ __forceinline__ float wave_max(float v) {
#pragma unroll
    for (int o = 32; o >= 1; o >>= 1) v = fmaxf(v, __shfl_xor(v, o));
    return v;
}
__device__ __forceinline__ float sigmoidf_(float x) { return 1.0f / (1.0f + __expf(-x)); }

#define XB_TMO      128
#define XB_XCNT(j)  (256  + 64 * (j))
#define XB_XSUB(j)  (1280 + 64 * (j))
#define XB_XGEN(j)  (2304 + 64 * (j))
#define XB_TOP      3328
#define XB_TOPGEN   3392
#define XCD_BAR_WORDS 3456
#define XB_SPIN_CAP (1u << 18)
__device__ __forceinline__ unsigned xb_ld(unsigned* p)              { return __hip_atomic_load(p, __ATOMIC_RELAXED, __HIP_MEMORY_SCOPE_AGENT); }
__device__ __forceinline__ unsigned xb_add(unsigned* p, unsigned v) { return __hip_atomic_fetch_add(p, v, __ATOMIC_RELAXED, __HIP_MEMORY_SCOPE_AGENT); }
__device__ __forceinline__ unsigned xb_xcc_id() { return (unsigned)__builtin_amdgcn_s_getreg((3 << 11) | 20) & 0xFu; }
#define XB_SPIN(cond, bar) do { unsigned _sp = 0; while (cond) { __builtin_amdgcn_s_sleep(1); \
    if ((++_sp & 255u) == 0u) { if (xb_ld(&(bar)[XB_TMO])) break; if (_sp > XB_SPIN_CAP) { atomicAdd(&(bar)[XB_TMO], 1u); break; } } } } while (0)
struct XcdBarrier { unsigned* bar; unsigned x; volatile LAS unsigned* st; };
__device__ __forceinline__ XcdBarrier xcd_barrier_post(unsigned* bar, volatile LAS unsigned* st) {
    XcdBarrier b; b.bar = bar; b.x = xb_xcc_id(); b.st = st;
    if (threadIdx.x == 0) (void)xb_add(&bar[XB_XCNT(b.x)], 1u);
    return b;
}
__device__ __forceinline__ void xcd_barrier_complete(unsigned* bar, unsigned x, unsigned& nloc, unsigned& nx) {
    const unsigned G = gridDim.x * gridDim.y * gridDim.z;
    unsigned sum, cnt, mine, sp = 0u;
    for (;;) {
        sum = 0u; cnt = 0u; mine = 0u;
#pragma unroll
        for (unsigned j = 0; j < 16; ++j) { const unsigned c = xb_ld(&bar[XB_XCNT(j)]); sum += c; cnt += (c > 0u) ? 1u : 0u; mine = (j == x) ? c : mine; }
        if (sum == G) break;
        __builtin_amdgcn_s_sleep(1);
        if ((++sp & 255u) == 0u) { if (xb_ld(&bar[XB_TMO])) break; if (sp > XB_SPIN_CAP) { atomicAdd(&bar[XB_TMO], 1u); break; } }
    }
    nloc = mine > 0u ? mine : 1u; nx = cnt > 0u ? cnt : 1u;
}
__device__ __forceinline__ void xcd_barrier(const XcdBarrier& b) {
    asm volatile("s_waitcnt vmcnt(0)" ::: "memory");
    __syncthreads();
    if (threadIdx.x == 0) {
        unsigned* bar = b.bar;
        __builtin_amdgcn_s_waitcnt(0);
        unsigned nloc = b.st[0], nx = b.st[1];
        if (nloc == 0u) { xcd_barrier_complete(bar, b.x, nloc, nx); b.st[0] = nloc; b.st[1] = nx; }
        const unsigned old = xb_add(&bar[XB_XSUB(b.x)], 1u);
        const unsigned gen = old / nloc;
        if (old + 1u == (gen + 1u) * nloc) {
            __builtin_amdgcn_fence(__ATOMIC_RELEASE, "agent");
            asm volatile("s_waitcnt vmcnt(0)" ::: "memory");
            const unsigned og = xb_add(&bar[XB_TOP], 1u);
            const unsigned tg = og / nx;
            if (og + 1u == (tg + 1u) * nx) xb_add(&bar[XB_TOPGEN], 1u);
            else XB_SPIN(xb_ld(&bar[XB_TOPGEN]) == tg, bar);
            __builtin_amdgcn_fence(__ATOMIC_ACQUIRE, "agent");
            xb_add(&bar[XB_XGEN(b.x)], 1u);
            asm volatile("s_waitcnt vmcnt(0)" ::: "memory");
        } else {
            XB_SPIN(xb_ld(&bar[XB_XGEN(b.x)]) == gen, bar);
            __builtin_amdgcn_fence(__ATOMIC_ACQUIRE, "agent");
            asm volatile("s_waitcnt vmcnt(0)" ::: "memory");
        }
    }
    __syncthreads();
}

struct Params {
    const float* x; const float* p; const int* positions; const float* norm1_w; const float* w_in; const float* w_pool; const float* pool_scale;
    const float* q_norm_w; const float* k_norm_cmp_w; const float* k_norm_slc_w; const float* k_norm_win_w; const float* cmp_pos_k; const float* cmp_pos_v;
    const float* cmp_k_w1; const float* cmp_k_w2; const float* cmp_v_w1; const float* cmp_v_w2; const float* w_o; const float* norm2_w; const float* w_ffn_in;
    const float* conv_w; const float* conv_b; const float* w_ffn_out; const float* w_ple_proj; const float* ple_norm_w; const float* ple_gate_norm_w; const float* w_ple_gate;
    float* out; unsigned char* ws; int ph_lo, ph_hi;
};

namespace pg8 {
constexpr int BM = 256, BK = 64, HALF = 128, HTB = HALF * BK * 2, STAGE_BYTES = 8 * HTB, NXCD = 8, WGM = 8;
__host__ __device__ __forceinline__ int lds_byte(int r, int c) { const int st = (r >> 4) * 2 + (c >> 5), rr = r & 15, cc = c & 31, ob = rr * 64 + cc * 2; return st * 1024 + (ob ^ (((ob >> 9) & 1) << 5)); }
__host__ __device__ __forceinline__ void stage_rc(int b, int& R, int& C) { const int st = b / 1024, sb = b % 1024, swz = sb ^ (((sb >> 9) & 1) << 5); R = (st >> 1) * 16 + swz / 64; C = (st & 1) * 32 + (swz % 64) / 2; }
__host__ __device__ __forceinline__ int perm32(int rho) { const int n = rho >> 4, i = rho & 15; return 8 * (i >> 2) + 4 * n + (i & 3); }
struct Unit { int pm, pn; };

struct StaticOrder {
    int nM, nN, nwg, G, c;
    __device__ void init(int nM_, int nN_, int G_, int c_) { nM = nM_; nN = nN_; nwg = nM * nN; G = G_; c = c_; }
    __device__ bool next(int i, Unit& u) const {
        const long L = (long)i * G + c; if (L >= nwg) return false;
        int wgid = (int)L; { const int q = nwg / NXCD, r = nwg % NXCD, xcd = wgid % NXCD, off = wgid / NXCD; wgid = (xcd < r ? xcd * (q + 1) : r * (q + 1) + (xcd - r) * q) + off; }
        const int nig = WGM * nN, gid = wgid / nig, fm = gid * WGM, gsz = (nM - fm) < WGM ? (nM - fm) : WGM;
        u.pm = fm + ((wgid % nig) % gsz); u.pn = (wgid % nig) / gsz; return true;
    }
};

struct GStd {
    const char* A; const char* B; unsigned lda, ldb; int nt;
    __device__ __forceinline__ const char* a_base(const Unit& u) const { return A + (size_t)u.pm * 256 * lda * 2; }
    __device__ __forceinline__ const char* b_base(const Unit& u) const { return B + (size_t)u.pn * 256 * ldb * 2; }
    __device__ __forceinline__ size_t kpairA() const { return 256; }
};
struct GPool {
    const char* A; const char* B; unsigned lda, ldb; int nt;
    __device__ __forceinline__ const char* a_base(const Unit& u) const { return A + (size_t)u.pm * 256 * lda * 2 + (size_t)u.pn * 512; }
    __device__ __forceinline__ const char* b_base(const Unit& u) const { return B + (size_t)u.pn * 256 * ldb * 2; }
    __device__ __forceinline__ size_t kpairA() const { return 256; }
};
struct GCmp {
    const char* Z; const char* Bk; const char* Bv; unsigned lda, ldb; int nt;
    __device__ __forceinline__ const char* a_base(const Unit& u) const { const int which = u.pm >> 4, g = (u.pm >> 2) & 3, rt = u.pm & 3;
        return Z + (size_t)(OFF_KV + which * 512 + g * 128) * 2 + (size_t)rt * 256 * lda * 2; }
    __device__ __forceinline__ const char* b_base(const Unit& u) const { return (u.pm >> 4) ? Bv : Bk; }
    __device__ __forceinline__ size_t kpairA() const { return (size_t)LDZ * 2; }
};

struct EpiBf16 {
    static constexpr bool PERM = true;
    bf16_t* O; int ldc;
    __device__ __forceinline__ void operator()(const f32x4 (&acc)[2][2][4][2], const Unit& u, int wr, int wc, int fr, int fq) const {
        const int row0 = u.pm * BM + wr * 64 + fr, col0 = u.pn * BM + wc * 32 + 8 * fq;
#pragma unroll
        for (int ai = 0; ai < 2; ++ai)
#pragma unroll
            for (int m = 0; m < 4; ++m) { bf16_t* rowp = O + (size_t)(row0 + ai * HALF + m * 16) * ldc + col0;
#pragma unroll
                for (int bj = 0; bj < 2; ++bj) { const f32x4 v0 = acc[ai][bj][m][0], v1 = acc[ai][bj][m][1];
                    u32x4 w; w.x = cvt_pk_bf16(v0[0], v0[1]); w.y = cvt_pk_bf16(v0[2], v0[3]); w.z = cvt_pk_bf16(v1[0], v1[1]); w.w = cvt_pk_bf16(v1[2], v1[3]);
                    *(u32x4*)(rowp + bj * HALF) = w; } }
    }
};
struct EpiBf16Scale {
    static constexpr bool PERM = true;
    bf16_t* O; int ldc; const float* colscale;
    __device__ __forceinline__ void operator()(const f32x4 (&acc)[2][2][4][2], const Unit& u, int wr, int wc, int fr, int fq) const {
        const int row0 = u.pm * BM + wr * 64 + fr, col0 = u.pn * BM + wc * 32 + 8 * fq;
#pragma unroll
        for (int bj = 0; bj < 2; ++bj) { const f32x4 s0 = *(const f32x4*)(colscale + col0 + bj * HALF), s1 = *(const f32x4*)(colscale + col0 + bj * HALF + 4);
#pragma unroll
            for (int ai = 0; ai < 2; ++ai)
#pragma unroll
                for (int m = 0; m < 4; ++m) { bf16_t* rowp = O + (size_t)(row0 + ai * HALF + m * 16) * ldc + col0;
                    const f32x4 v0 = acc[ai][bj][m][0] * s0, v1 = acc[ai][bj][m][1] * s1;
                    u32x4 w; w.x = cvt_pk_bf16(v0[0], v0[1]); w.y = cvt_pk_bf16(v0[2], v0[3]); w.z = cvt_pk_bf16(v1[0], v1[1]); w.w = cvt_pk_bf16(v1[2], v1[3]);
                    *(u32x4*)(rowp + bj * HALF) = w; } }
    }
};
struct EpiResF32 {
    static constexpr bool PERM = false;
    const float* base; float* C; int ldc; int row_off;
    __device__ __forceinline__ void operator()(const f32x4 (&acc)[2][2][4][2], const Unit& u, int wr, int wc, int fr, int fq) const {
        const int row0 = u.pm * BM + wr * 64 + fr + row_off, col0 = u.pn * BM + wc * 32 + 4 * fq;
#pragma unroll
        for (int ai = 0; ai < 2; ++ai)
#pragma unroll
            for (int m = 0; m < 4; ++m) { const size_t off = (size_t)(row0 + ai * HALF + m * 16) * ldc + col0;
#pragma unroll
                for (int bj = 0; bj < 2; ++bj)
#pragma unroll
                    for (int n = 0; n < 2; ++n) { const f32x4 b = *(const f32x4*)(base + off + bj * HALF + n * 16); *(f32x4*)(C + off + bj * HALF + n * 16) = b + acc[ai][bj][m][n]; }
                asm volatile("" ::: "memory"); }
    }
};
struct EpiResNorm {
    static constexpr bool PERM = false;
    const float* base; float* C; bf16_t* XN; const float* nw; float* ssq; int ldc;
    __device__ __forceinline__ void operator()(const f32x4 (&acc)[2][2][4][2], const Unit& u, int wr, int wc, int fr, int fq) const {
        const int row0 = u.pm * BM + wr * 64 + fr, col0 = u.pn * BM + wc * 32 + 4 * fq;
        f32x4 wv[2][2];
#pragma unroll
        for (int bj = 0; bj < 2; ++bj)
#pragma unroll
            for (int n = 0; n < 2; ++n) wv[bj][n] = *(const f32x4*)(nw + col0 + bj * HALF + n * 16);
        f32x4 bv[2][2][2];
#pragma unroll
        for (int bj = 0; bj < 2; ++bj)
#pragma unroll
            for (int n = 0; n < 2; ++n) bv[0][bj][n] = *(const f32x4*)(base + (size_t)row0 * ldc + col0 + bj * HALF + n * 16);
#pragma unroll
        for (int rg = 0; rg < 8; ++rg) { const int ai = rg >> 2, m = rg & 3; const int row = row0 + ai * HALF + m * 16; const size_t off = (size_t)row * ldc + col0;
            if (rg < 7) { const int ai2 = (rg + 1) >> 2, m2 = (rg + 1) & 3; const size_t off2 = (size_t)(row0 + ai2 * HALF + m2 * 16) * ldc + col0;
#pragma unroll
                for (int bj = 0; bj < 2; ++bj)
#pragma unroll
                    for (int n = 0; n < 2; ++n) bv[(rg + 1) & 1][bj][n] = *(const f32x4*)(base + off2 + bj * HALF + n * 16); }
            float s = 0.f;
#pragma unroll
            for (int bj = 0; bj < 2; ++bj)
#pragma unroll
                for (int n = 0; n < 2; ++n) { const f32x4 v = bv[rg & 1][bj][n] + acc[ai][bj][m][n];
                    *(f32x4*)(C + off + bj * HALF + n * 16) = v; s += v[0] * v[0] + v[1] * v[1] + v[2] * v[2] + v[3] * v[3];
                    u32x2 o; o.x = cvt_pk_bf16(v[0] * wv[bj][n][0], v[1] * wv[bj][n][1]); o.y = cvt_pk_bf16(v[2] * wv[bj][n][2], v[3] * wv[bj][n][3]);
                    *(u32x2*)(XN + off + bj * HALF + n * 16) = o; }
            s += __shfl_xor(s, 16); s += __shfl_xor(s, 32);
            if (fq == 0) unsafeAtomicAdd(ssq + row, s);
        }
    }
};
struct EpiCmpGelu {
    static constexpr bool PERM = false;
    float* H; const float* bias;
    __device__ __forceinline__ void operator()(const f32x4 (&acc)[2][2][4][2], const Unit& u, int wr, int wc, int fr, int fq) const {
        const int row0 = u.pm * BM + wr * 64 + fr, col0 = wc * 32 + 4 * fq; const float* bs = bias + (u.pm >> 4) * 256;
        f32x4 bvv[2][2];
#pragma unroll
        for (int bj = 0; bj < 2; ++bj)
#pragma unroll
            for (int n = 0; n < 2; ++n) bvv[bj][n] = *(const f32x4*)(bs + col0 + bj * HALF + n * 16);
#pragma unroll
        for (int ai = 0; ai < 2; ++ai)
#pragma unroll
            for (int m = 0; m < 4; ++m) { float* rowp = H + (size_t)(row0 + ai * HALF + m * 16) * 256 + col0;
#pragma unroll
                for (int bj = 0; bj < 2; ++bj)
#pragma unroll
                    for (int n = 0; n < 2; ++n) { f32x4 v = acc[ai][bj][m][n] + bvv[bj][n];
#pragma unroll
                        for (int j = 0; j < 4; ++j) { const float xx = v[j], uu = 0.7978845608028654f * (xx + 0.044715f * xx * xx * xx); const float th = 1.0f - 2.0f / (1.0f + __expf(2.0f * uu)); v[j] = 0.5f * xx * (1.0f + th); }
                        *(f32x4*)(rowp + bj * HALF + n * 16) = v; } }
    }
};
struct EpiGate {
    static constexpr bool PERM = false;
    float* C; const bf16_t* eraw; const float* erstd; const float* pw; const float* ssq; int ldc;
    __device__ __forceinline__ void operator()(const f32x4 (&acc)[2][2][4][2], const Unit& u, int wr, int wc, int fr, int fq) const {
        const int row0 = u.pm * BM + wr * 64 + fr, col0 = u.pn * BM + wc * 32 + 4 * fq;
        f32x4 wv[2][2];
#pragma unroll
        for (int bj = 0; bj < 2; ++bj)
#pragma unroll
            for (int n = 0; n < 2; ++n) wv[bj][n] = *(const f32x4*)(pw + col0 + bj * HALF + n * 16);
        f32x4 bv[2][2][2]; u32x2 ev[2][2][2]; float rsv[2], rgv[2];
#pragma unroll
        for (int bj = 0; bj < 2; ++bj)
#pragma unroll
            for (int n = 0; n < 2; ++n) { bv[0][bj][n] = *(const f32x4*)(C + (size_t)row0 * ldc + col0 + bj * HALF + n * 16); ev[0][bj][n] = *(const u32x2*)(eraw + (size_t)row0 * ldc + col0 + bj * HALF + n * 16); }
        rsv[0] = erstd[row0]; rgv[0] = ssq[row0];
#pragma unroll
        for (int rg = 0; rg < 8; ++rg) { const int ai = rg >> 2, m = rg & 3; const int row = row0 + ai * HALF + m * 16; const size_t off = (size_t)row * ldc + col0;
            if (rg < 7) { const int ai2 = (rg + 1) >> 2, m2 = (rg + 1) & 3; const int row2 = row0 + ai2 * HALF + m2 * 16; const size_t off2 = (size_t)row2 * ldc + col0;
#pragma unroll
                for (int bj = 0; bj < 2; ++bj)
#pragma unroll
                    for (int n = 0; n < 2; ++n) { bv[(rg + 1) & 1][bj][n] = *(const f32x4*)(C + off2 + bj * HALF + n * 16); ev[(rg + 1) & 1][bj][n] = *(const u32x2*)(eraw + off2 + bj * HALF + n * 16); }
                rsv[(rg + 1) & 1] = erstd[row2]; rgv[(rg + 1) & 1] = ssq[row2]; }
            const float rs = rsv[rg & 1], rg_ = rsqrtf(rgv[rg & 1] * (1.0f / DM) + EPS);
#pragma unroll
            for (int bj = 0; bj < 2; ++bj)
#pragma unroll
                for (int n = 0; n < 2; ++n) { const f32x4 b = bv[rg & 1][bj][n]; const u32x2 e = ev[rg & 1][bj][n]; const f32x4 a = acc[ai][bj][m][n]; f32x4 o;
                    o[0] = b[0] + bf_lo(e.x) * rs * wv[bj][n][0] * sigmoidf_(a[0] * rg_); o[1] = b[1] + bf_hi(e.x) * rs * wv[bj][n][1] * sigmoidf_(a[1] * rg_);
                    o[2] = b[2] + bf_lo(e.y) * rs * wv[bj][n][2] * sigmoidf_(a[2] * rg_); o[3] = b[3] + bf_hi(e.y) * rs * wv[bj][n][3] * sigmoidf_(a[3] * rg_);
                    *(f32x4*)(C + off + bj * HALF + n * 16) = o; }
        }
    }
};
struct GFfn {
    const char* A; const char* B; unsigned lda, ldb; int nt;
    __device__ __forceinline__ const char* a_base(const Unit& u) const { return A + ((long)u.pm * 254 - 2) * (long)lda * 2; }
    __device__ __forceinline__ const char* b_base(const Unit& u) const { return B + (size_t)u.pn * 256 * ldb * 2; }
    __device__ __forceinline__ size_t kpairA() const { return 256; }
};
template <int CTRL> __device__ __forceinline__ float dpp_f(float v) { return __int_as_float(__builtin_amdgcn_update_dpp(0, __float_as_int(v), CTRL, 0xf, 0xf, false)); }
struct EpiFfn {
    static constexpr bool PERM = true;
    bf16_t* ACT; const float* cw; const float* cb; LAS float* X; const float* ssq;
    __device__ __forceinline__ void operator()(const f32x4 (&acc)[2][2][4][2], const Unit& u, int wr, int wc, int fr, int fq) const {
        const int colw = wc * 32 + 8 * fq;
        float rsv[2][4];
#pragma unroll
        for (int ai = 0; ai < 2; ++ai)
#pragma unroll
            for (int m = 0; m < 4; ++m) { const long t = (long)u.pm * 254 - 2 + ai * HALF + wr * 64 + m * 16 + fr; rsv[ai][m] = (t >= 0 && t < S_) ? rsqrtf(ssq[t] * (1.0f / DM) + EPS) : 0.f; }
        if (fr >= 14) {
#pragma unroll
            for (int ai = 0; ai < 2; ++ai)
#pragma unroll
                for (int n = 0; n < 2; ++n) *(LAS f32x4*)(X + ((2 * ai + wr) * 2 + (fr - 14)) * 128 + colw + 4 * n) = acc[ai][0][3][n] * rsv[ai][3];
        }
        asm volatile("s_waitcnt lgkmcnt(0)" ::: "memory");
        __builtin_amdgcn_s_barrier(); asm volatile("" ::: "memory");
        __builtin_amdgcn_s_barrier(); asm volatile("" ::: "memory");
        const int f0 = u.pn * 128 + colw;
        f32x4 w0[2], w1[2], w2[2], cbv[2];
#pragma unroll
        for (int n = 0; n < 2; ++n) { w0[n] = *(const f32x4*)(cw + f0 + 4 * n); w1[n] = *(const f32x4*)(cw + DFF + f0 + 4 * n); w2[n] = *(const f32x4*)(cw + 2 * DFF + f0 + 4 * n); cbv[n] = *(const f32x4*)(cb + f0 + 4 * n); }
#pragma unroll
        for (int ai = 0; ai < 2; ++ai) {
            f32x4 pv[2];
            const int pseg = 2 * ai + wr - 1;
#pragma unroll
            for (int n = 0; n < 2; ++n) { pv[n] = (f32x4){0.f, 0.f, 0.f, 0.f}; if (pseg >= 0 && fr >= 14) pv[n] = *(const LAS f32x4*)(X + (pseg * 2 + (fr - 14)) * 128 + colw + 4 * n); }
#pragma unroll
            for (int m = 0; m < 4; ++m) {
                const int r = ai * HALF + wr * 64 + m * 16 + fr; const long t = (long)u.pm * 254 - 2 + r;
                unsigned ow[4];
#pragma unroll
                for (int n = 0; n < 2; ++n) {
                    const f32x4 cur = acc[ai][0][m][n] * rsv[ai][m], up = acc[ai][1][m][n] * rsv[ai][m]; f32x4 o;
#pragma unroll
                    for (int i = 0; i < 4; ++i) {
                        const float c1 = dpp_f<0x121>(cur[i]), p1 = dpp_f<0x121>(pv[n][i]), c2 = dpp_f<0x122>(cur[i]), p2 = dpp_f<0x122>(pv[n][i]);
                        const float x1 = fr >= 1 ? c1 : p1, x2 = fr >= 2 ? c2 : p2;
                        const float y = cbv[n][i] + w0[n][i] * x2 + w1[n][i] * x1 + w2[n][i] * cur[i];
                        o[i] = y * sigmoidf_(y) * up[i];
                    }
                    ow[2 * n] = cvt_pk_bf16(o[0], o[1]); ow[2 * n + 1] = cvt_pk_bf16(o[2], o[3]);
                    pv[n] = cur;
                }
                if (r >= 2 && t < S_) *(u32x4*)(ACT + (size_t)t * DFF + f0) = (u32x4){ow[0], ow[1], ow[2], ow[3]};
            }
        }
    }
};

template <class GD, class Epi>
__device__ __forceinline__ void gemm_phase(LAS unsigned char* lds, const GD g, const StaticOrder& S, const Epi& E) {
    const int tid = threadIdx.x, wid = __builtin_amdgcn_readfirstlane(tid >> 6), lane = tid & 63, wr = wid >> 2, wc = wid & 3, fr = lane & 15, fq = lane >> 4;
    const int nt = g.nt;
    unsigned voffA[2], voffB[2];
#pragma unroll
    for (int i = 0; i < 2; ++i) { int R, C; stage_rc(tid * 16 + i * 8192, R, C); const int Rb = Epi::PERM ? ((R & ~31) + perm32(R & 31)) : R;
        voffA[i] = (unsigned)(R * g.lda + C) * 2u; voffB[i] = (unsigned)(Rb * g.ldb + C) * 2u; }
    const size_t kpA = g.kpairA();
    const size_t hstepA = (size_t)HALF * g.lda * 2, hstepB = (size_t)HALF * g.ldb * 2;
    const unsigned ldsw = (unsigned)wid * 1024u;
    const int aoff = lds_byte(wr * 64 + fr, fq * 8), boff = lds_byte(wc * 32 + fr, fq * 8);
#define PG8_SA(b, h) (((b) * 2 + (h)) * HTB)
#define PG8_SB(b, h) ((4 + (b) * 2 + (h)) * HTB)
#define PG8_STAGE(bufoff, gbase, voff) do { _Pragma("unroll") for (int _i = 0; _i < 2; ++_i) \
        __builtin_amdgcn_global_load_lds((const unsigned*)((const char*)(gbase) + (voff)[_i]), (LAS unsigned*)(lds + (bufoff) + ldsw + _i * 8192), 16, 0, 0); } while (0)
#define PG8_LDA(dst, b, h) do { _Pragma("unroll") for (int m = 0; m < 4; ++m) _Pragma("unroll") for (int k = 0; k < 2; ++k) dst[m][k] = *(const LAS bf16x8*)(lds + PG8_SA(b, h) + aoff + m * 2048 + k * 1024); } while (0)
#define PG8_LDB(dst, b, h) do { _Pragma("unroll") for (int n = 0; n < 2; ++n) _Pragma("unroll") for (int k = 0; k < 2; ++k) dst[n][k] = *(const LAS bf16x8*)(lds + PG8_SB(b, h) + boff + n * 2048 + k * 1024); } while (0)
#define PG8_MMA(ai, bj, At, Bt) do { __builtin_amdgcn_s_setprio(1); _Pragma("unroll") for (int m = 0; m < 4; ++m) _Pragma("unroll") for (int n = 0; n < 2; ++n) _Pragma("unroll") for (int k = 0; k < 2; ++k) \
        acc[ai][bj][m][n] = __builtin_amdgcn_mfma_f32_16x16x32_bf16(Bt[n][k], At[m][k], acc[ai][bj][m][n], 0, 0, 0); __builtin_amdgcn_s_setprio(0); } while (0)
#define PG8_WAIT_V(n) asm volatile("s_waitcnt vmcnt(" #n ")" ::: "memory")
#define PG8_WAIT_L(n) asm volatile("s_waitcnt lgkmcnt(" #n ")" ::: "memory")
#define PG8_BAR __builtin_amdgcn_s_barrier()
#define PG8_SCHED __builtin_amdgcn_sched_barrier(0)
    Unit cur, nxt; int ui = 0;
    if (!S.next(0, cur)) return;
    f32x4 acc[2][2][4][2];
#pragma unroll
    for (int a = 0; a < 2; ++a)
#pragma unroll
        for (int b = 0; b < 2; ++b)
#pragma unroll
            for (int m = 0; m < 4; ++m)
#pragma unroll
                for (int n = 0; n < 2; ++n) acc[a][b][m][n] = (f32x4){0.f, 0.f, 0.f, 0.f};
    bf16x8 At[4][2], B0[2][2], B1[2][2];
    const char* cA = g.a_base(cur); const char* cB = g.b_base(cur);
    PG8_STAGE(PG8_SB(0, 0), cB, voffB); PG8_STAGE(PG8_SA(0, 0), cA, voffA); PG8_STAGE(PG8_SB(0, 1), cB + hstepB, voffB); PG8_STAGE(PG8_SA(0, 1), cA + hstepA, voffA);
    if (wr == 1) PG8_BAR;
    PG8_WAIT_V(4); PG8_BAR;
    PG8_STAGE(PG8_SB(1, 0), cB + 128, voffB); PG8_STAGE(PG8_SA(1, 0), cA + 128, voffA); PG8_STAGE(PG8_SB(1, 1), cB + hstepB + 128, voffB);
    PG8_WAIT_V(6); PG8_BAR;
    for (;;) {
        const bool has_next = S.next(ui + 1, nxt);
        const char* nA = has_next ? g.a_base(nxt) : cA; const char* nB = has_next ? g.b_base(nxt) : cB;
        for (int t = 0; t < nt; t += 2) {
            const bool last = (t == nt - 2);
            const char* a0 = cA + (size_t)(t >> 1) * kpA;
            const char* a1 = a0 + 128;
            const char* a2 = last ? nA : a0 + kpA; const char* b2 = last ? nB : cB + (size_t)(t + 2) * 128;
            const char* a3 = a2 + 128; const char* b3 = b2 + 128;
            PG8_LDB(B0, 0, 0); PG8_SCHED; PG8_LDA(At, 0, 0); PG8_STAGE(PG8_SA(1, 1), a1 + hstepA, voffA);
            PG8_WAIT_L(8); PG8_BAR; PG8_WAIT_L(0); PG8_MMA(0, 0, At, B0); PG8_BAR; PG8_SCHED;
            PG8_LDB(B1, 0, 1); PG8_STAGE(PG8_SB(0, 0), b2, voffB);
            PG8_BAR; PG8_WAIT_L(0); PG8_MMA(0, 1, At, B1); PG8_BAR;
            PG8_LDA(At, 0, 1); PG8_STAGE(PG8_SA(0, 0), a2, voffA);
            PG8_BAR; PG8_WAIT_L(0); PG8_MMA(1, 0, At, B0); PG8_BAR; PG8_SCHED;
            PG8_STAGE(PG8_SB(0, 1), b2 + hstepB, voffB);
            PG8_WAIT_V(6); PG8_BAR; PG8_MMA(1, 1, At, B1); PG8_BAR;
            PG8_LDB(B0, 1, 0); PG8_SCHED; PG8_LDA(At, 1, 0); PG8_STAGE(PG8_SA(0, 1), a2 + hstepA, voffA);
            PG8_WAIT_L(8); PG8_BAR; PG8_WAIT_L(0); PG8_MMA(0, 0, At, B0); PG8_BAR; PG8_SCHED;
            PG8_LDB(B1, 1, 1); PG8_STAGE(PG8_SB(1, 0), b3, voffB);
            PG8_BAR; PG8_WAIT_L(0); PG8_MMA(0, 1, At, B1); PG8_BAR;
            PG8_LDA(At, 1, 1); PG8_STAGE(PG8_SA(1, 0), a3, voffA);
            PG8_BAR; PG8_WAIT_L(0); PG8_MMA(1, 0, At, B0); PG8_BAR; PG8_SCHED;
            PG8_STAGE(PG8_SB(1, 1), b3 + hstepB, voffB);
            PG8_WAIT_V(6); PG8_BAR; PG8_MMA(1, 1, At, B1); PG8_BAR;
        }
        E(acc, cur, wr, wc, fr, fq);
        if (!has_next) break;
#pragma unroll
        for (int a = 0; a < 2; ++a)
#pragma unroll
            for (int b = 0; b < 2; ++b)
#pragma unroll
                for (int m = 0; m < 4; ++m)
#pragma unroll
                    for (int n = 0; n < 2; ++n) acc[a][b][m][n] = (f32x4){0.f, 0.f, 0.f, 0.f};
        cur = nxt; cA = nA; cB = nB; ++ui;
    }
    PG8_WAIT_V(0);
    if (wr == 0) PG8_BAR;
    PG8_BAR;
#undef PG8_SA
#undef PG8_SB
#undef PG8_STAGE
#undef PG8_LDA
#undef PG8_LDB
#undef PG8_MMA
#undef PG8_WAIT_V
#undef PG8_WAIT_L
#undef PG8_BAR
#undef PG8_SCHED
}
}

namespace att {
constexpr int KVBLK = 64;
constexpr int SHM_V = KVBLK * HD * 2, SHM_K = KVBLK * HD * 2, SHM_ATTN = 2 * SHM_V + 2 * SHM_K + NWAVES * 64 * 4;
#define KSWZ(row, colB) ((row) * 256 + ((colB) ^ (((row) & 7) << 4)))
#define SBAR() __builtin_amdgcn_sched_barrier(0)
__device__ __forceinline__ int crow(int r, int hi) { return (r & 3) + 8 * (r >> 2) + 4 * hi; }
__device__ __forceinline__ void qkt(f32x16& p0, f32x16& p1, const char* Ks, const bf16x8* qr, int r32, int hi) {
    p0 = f32x16{}; p1 = f32x16{};
    bf16x8 ka[2], kb[2];
    { const int cb = (hi * 8) * 2; ka[0] = *reinterpret_cast<const bf16x8*>(Ks + KSWZ(r32, cb)); kb[0] = *reinterpret_cast<const bf16x8*>(Ks + KSWZ(32 + r32, cb)); }
#pragma unroll
    for (int d0 = 0; d0 < 8; ++d0) {
        if (d0 < 7) { const int cb = ((d0 + 1) * 16 + hi * 8) * 2;
            ka[(d0 + 1) & 1] = *reinterpret_cast<const bf16x8*>(Ks + KSWZ(r32, cb)); kb[(d0 + 1) & 1] = *reinterpret_cast<const bf16x8*>(Ks + KSWZ(32 + r32, cb)); }
        SBAR();
        p0 = __builtin_amdgcn_mfma_f32_32x32x16_bf16(ka[d0 & 1], qr[d0], p0, 0, 0, 0);
        p1 = __builtin_amdgcn_mfma_f32_32x32x16_bf16(kb[d0 & 1], qr[d0], p1, 0, 0, 0);
        SBAR();
    }
}
__device__ __forceinline__ int v_st(int k, int c) { const int kk = (k & ~0xC) | ((k & 4) << 1) | ((k & 8) >> 1); return ((kk >> 3) * 4 + (c >> 5)) * 512 + ((kk & 7) * 32 + (c & 31)) * 2; }
__device__ __forceinline__ int v_rd_base(int lane) { return ((lane & 3) << 3) | (((lane >> 2) & 3) << 6) | (((lane >> 4) & 1) << 5) | (((lane >> 5) & 1) << 8); }
constexpr int v_rd_off(int d0, int ks, int half) { return d0 * 512 + ks * 4096 + half * 2048; }
__device__ __forceinline__ s16x4 tr_read(int vb, int off) { return __builtin_amdgcn_ds_read_tr16_b64_v4i16((LAS s16x4*)(unsigned long)(unsigned)(vb + off)); }
__device__ __forceinline__ void pv_d0(f32x16* o, int vb, bf16x8 pa0, bf16x8 pa1, bf16x8 pa2, bf16x8 pa3) {
    s16x4 L[2][4], H[2][4];
#pragma unroll
    for (int d0 = 0; d0 < 4; ++d0) { L[0][d0] = tr_read(vb, v_rd_off(d0, 0, 0)); H[0][d0] = tr_read(vb, v_rd_off(d0, 0, 1)); }
#pragma unroll
    for (int ks = 0; ks < 4; ++ks) {
        if (ks < 3) {
#pragma unroll
            for (int d0 = 0; d0 < 4; ++d0) { L[(ks + 1) & 1][d0] = tr_read(vb, v_rd_off(d0, ks + 1, 0)); H[(ks + 1) & 1][d0] = tr_read(vb, v_rd_off(d0, ks + 1, 1)); }
        }
        const bf16x8 pa = ks == 0 ? pa0 : (ks == 1 ? pa1 : (ks == 2 ? pa2 : pa3));
#pragma unroll
        for (int d0 = 0; d0 < 4; ++d0) { const s16x4 l = L[ks & 1][d0], h = H[ks & 1][d0];
            o[d0] = __builtin_amdgcn_mfma_f32_32x32x16_bf16(pa, (bf16x8){l[0], l[1], l[2], l[3], h[0], h[1], h[2], h[3]}, o[d0], 0, 0, 0); }
    }
}
__device__ __forceinline__ void pack_p(const f32x16& p0, const f32x16& p1, bf16x8& pa0, bf16x8& pa1, bf16x8& pa2, bf16x8& pa3) {
#define PK4(P, BASE, OUT) do { unsigned a0 = cvt_pk_bf16(P[BASE + 0], P[BASE + 1]), a1 = cvt_pk_bf16(P[BASE + 2], P[BASE + 3]);   \
    unsigned b0 = cvt_pk_bf16(P[BASE + 4], P[BASE + 5]), b1 = cvt_pk_bf16(P[BASE + 6], P[BASE + 7]);                              \
    auto r0 = __builtin_amdgcn_permlane32_swap(a0, b0, false, false); auto r1 = __builtin_amdgcn_permlane32_swap(a1, b1, false, false); \
    u32x4 w = {r0[0], r1[0], r0[1], r1[1]}; OUT = *reinterpret_cast<bf16x8*>(&w); } while (0)
    PK4(p0, 0, pa0); PK4(p0, 8, pa1); PK4(p1, 0, pa2); PK4(p1, 8, pa3);
#undef PK4
}

__device__ __forceinline__ void pack_half(const f32x16& p, bf16x8& paA, bf16x8& paB) {
#define PK4(P, BASE, OUT) do { unsigned a0 = cvt_pk_bf16(P[BASE + 0], P[BASE + 1]), a1 = cvt_pk_bf16(P[BASE + 2], P[BASE + 3]);   \
    unsigned b0 = cvt_pk_bf16(P[BASE + 4], P[BASE + 5]), b1 = cvt_pk_bf16(P[BASE + 6], P[BASE + 7]);                              \
    auto r0 = __builtin_amdgcn_permlane32_swap(a0, b0, false, false); auto r1 = __builtin_amdgcn_permlane32_swap(a1, b1, false, false); \
    u32x4 w = {r0[0], r1[0], r0[1], r1[1]}; OUT = *reinterpret_cast<bf16x8*>(&w); } while (0)
    PK4(p, 0, paA); PK4(p, 8, paB);
#undef PK4
}
template <int KS0, bool WITH_EXP>
__device__ __forceinline__ void pv_half(f32x16* o, int vb, bf16x8 paA, bf16x8 paB, f32x16& px, float off) {
    s16x4 L[2][4], H[2][4];
#pragma unroll
    for (int d0 = 0; d0 < 4; ++d0) { L[0][d0] = tr_read(vb, v_rd_off(d0, KS0, 0)); H[0][d0] = tr_read(vb, v_rd_off(d0, KS0, 1)); }
#pragma unroll
    for (int d0 = 0; d0 < 4; ++d0) { L[1][d0] = tr_read(vb, v_rd_off(d0, KS0 + 1, 0)); H[1][d0] = tr_read(vb, v_rd_off(d0, KS0 + 1, 1)); }
#pragma unroll
    for (int kk = 0; kk < 2; ++kk) {
        const bf16x8 pa = kk == 0 ? paA : paB;
#pragma unroll
        for (int d0 = 0; d0 < 4; ++d0) { const s16x4 l = L[kk][d0], h = H[kk][d0];
            if (WITH_EXP) SBAR();
            o[d0] = __builtin_amdgcn_mfma_f32_32x32x16_bf16(pa, (bf16x8){l[0], l[1], l[2], l[3], h[0], h[1], h[2], h[3]}, o[d0], 0, 0, 0);
            if (WITH_EXP) {
#pragma unroll
                for (int q = 0; q < 2; ++q) { const int r = (kk * 4 + d0) * 2 + q; px[r] = __builtin_amdgcn_exp2f(fmaf(px[r], SM_C, off)); }
                SBAR(); }
        }
    }
}
enum { MODE_CMP = 0, MODE_WIN = 1, MODE_SLC = 2 };
struct AttnArgs {
    const bf16_t* Z; const bf16_t* KC; const bf16_t* VC; const float* G; float* L; float* OACC; bf16_t* MIX; const unsigned* BM; const float* TAB;
};
template <int MODE>
__device__ __forceinline__ void attn_unit(const AttnArgs& a, LAS char* ldsL, int qt, int g, int hp) {
    char* lds = (char*)ldsL;
    const int tid = threadIdx.x, wid = __builtin_amdgcn_readfirstlane(tid >> 6), lane = tid & 63, r32 = lane & 31, hi = lane >> 5;
    float* li_l = (float*)(lds + LDS_XCH) + wid * 64;
    const int t0 = MODE == MODE_SLC ? qt * 40 : qt * 128;
    const int tq_raw = MODE == MODE_SLC ? t0 + wid * 5 + r32 / 6 : t0 + wid * 16 + (r32 & 15);
    const bool rvalid = MODE == MODE_SLC ? (r32 < 30 && tq_raw < S_) : true;
    const int tq = tq_raw < S_ ? tq_raw : S_ - 1;
    const int hq = MODE == MODE_SLC ? g * HPG + r32 % 6 : g * HPG + hp * 2 + (r32 >> 4);
    const int tlast = MODE == MODE_SLC ? ((t0 + 39) < S_ ? (t0 + 39) : S_ - 1) : t0 + 127;
    const bf16_t* Kb; const bf16_t* Vb; long ldk;
    if (MODE == MODE_CMP) { Kb = a.KC + (size_t)g * 1024 * HD; Vb = a.VC + (size_t)g * 1024 * HD; ldk = HD; }
    else if (MODE == MODE_WIN) { Kb = a.Z + OFF_KV + 4 * 512 + g * HD; Vb = a.Z + OFF_KV + 5 * 512 + g * HD; ldk = LDZ; }
    else { Kb = a.Z + OFF_KV + 2 * 512 + g * HD; Vb = a.Z + OFF_KV + 3 * 512 + g * HD; ldk = LDZ; }
    int j0, j1;
    if (MODE == MODE_CMP) { j0 = 0; j1 = (((t0 + 127 - 31) >> 4) >> 6) + 1; }
    else if (MODE == MODE_WIN) { j0 = (t0 - 511) > 0 ? ((t0 - 511) >> 6) : 0; j1 = ((t0 + 127) >> 6) + 1; }
    else { j0 = 0; j1 = (tlast >> 6) + 1; }
    int klo, khi;
    if (MODE == MODE_CMP) { klo = 0; khi = tq >= 31 ? ((tq - 31) >> 4) : -1; }
    else if (MODE == MODE_WIN) { klo = tq - 511; khi = tq; }
    else { klo = 0; khi = rvalid ? tq : -1; }
    float negBC = -a.TAB[512 + (MODE == MODE_CMP ? 0 : (MODE == MODE_SLC ? 1 : 2))];
    bf16x8 qr[8];
    { const bf16_t* Qw = a.Z + (size_t)tq * LDZ + OFF_Q + hq * HD + hi * 8;
#pragma unroll
      for (int d0 = 0; d0 < 8; ++d0) qr[d0] = *reinterpret_cast<const bf16x8*>(Qw + d0 * 16); }
    f32x16 o[4] = {}; float lsum = 0.f;
    unsigned soK[2], soV[2];
#pragma unroll
    for (int i = 0; i < 2; ++i) { const int p = (wid + 8 * i) * 64 + lane;
        { const int row = p >> 4, c = (p & 15) ^ (row & 7); soK[i] = (unsigned)(row * ldk + c * 8) * 2u; }
        { const int sub = p >> 5, within = p & 31, kk = (sub >> 2) * 8 + (within >> 2), c = (sub & 3) * 32 + (within & 3) * 8, k = (kk & ~0xC) | ((kk & 4) << 1) | ((kk & 8) >> 1);
          soV[i] = (unsigned)(k * ldk + c) * 2u; } }
    const int vb0 = (int)(uintptr_t)(LAS char*)ldsL + 16384 + v_rd_base(lane);
#define ISSUE(jt) do { const int _b = ((jt) - j0) & 3; const char* _kp = (const char*)Kb + (size_t)(jt) * KVBLK * ldk * 2; const char* _vp = (const char*)Vb + (size_t)(jt) * KVBLK * ldk * 2; \
    _Pragma("unroll") for (int _i = 0; _i < 2; ++_i) { \
        __builtin_amdgcn_global_load_lds((const unsigned*)(_kp + soK[_i]), (LAS unsigned*)(ldsL + _b * 32768 + (wid + 8 * _i) * 1024), 16, 0, 0); \
        __builtin_amdgcn_global_load_lds((const unsigned*)(_vp + soV[_i]), (LAS unsigned*)(ldsL + _b * 32768 + 16384 + (wid + 8 * _i) * 1024), 16, 0, 0); } } while (0)
    unsigned bmw = 0u;
    if (MODE == MODE_SLC) bmw = a.BM[((size_t)tq * 4 + g) * 8];
    asm volatile("s_waitcnt vmcnt(0) lgkmcnt(0)" : "+v"(bmw), "+v"(negBC), "+v"(qr[0]), "+v"(qr[1]), "+v"(qr[2]), "+v"(qr[3]), "+v"(qr[4]), "+v"(qr[5]), "+v"(qr[6]), "+v"(qr[7]) :: "memory");
    __builtin_amdgcn_s_barrier();
    asm volatile("" ::: "memory");
    ISSUE(j0); if (j0 + 1 < j1) ISSUE(j0 + 1); if (j0 + 2 < j1) ISSUE(j0 + 2);
    for (int j = j0; j < j1; ++j) {
        const int buf = (j - j0) & 3;
        if (j + 2 < j1) asm volatile("s_waitcnt vmcnt(8)" ::: "memory"); else if (j + 1 < j1) asm volatile("s_waitcnt vmcnt(4)" ::: "memory"); else asm volatile("s_waitcnt vmcnt(0)" ::: "memory");
        __builtin_amdgcn_s_barrier();
        asm volatile("" ::: "memory");
        if (j + 3 < j1) ISSUE(j + 3);
        int lhi = khi;
        if (MODE == MODE_SLC) { if (!((bmw >> (j & 31)) & 1u)) lhi = -1; }
        const int kb = j * KVBLK;
        const bool l_any = (kb + 63 >= klo) && (kb <= lhi);
        const bool l_full = (kb >= klo) && (kb + 63 <= lhi);
        if (__any(l_any)) {
            f32x16 p0, p1;
            qkt(p0, p1, lds + buf * 32768, qr, r32, hi);
            const bool uni = __all(l_full || !l_any);
            const float off = (uni && !l_any) ? -1.0e30f : negBC;
#pragma unroll
            for (int r = 0; r < 16; ++r) p0[r] = __builtin_amdgcn_exp2f(fmaf(p0[r], SM_C, off));
            if (!uni) {
#pragma unroll
                for (int r = 0; r < 16; ++r) { const int k0i = kb + crow(r, hi); p0[r] = (k0i >= klo && k0i <= lhi) ? p0[r] : 0.f; } }
            float ps = 0.f;
#pragma unroll
            for (int r = 0; r < 16; ++r) ps += p0[r];
            bf16x8 pa0, pa1, pa2, pa3; pack_half(p0, pa0, pa1);
            pv_half<0, true>(o, vb0 + buf * 32768, pa0, pa1, p1, off);
            if (!uni) {
#pragma unroll
                for (int r = 0; r < 16; ++r) { const int k1i = kb + 32 + crow(r, hi); p1[r] = (k1i >= klo && k1i <= lhi) ? p1[r] : 0.f; } }
#pragma unroll
            for (int r = 0; r < 16; ++r) ps += p1[r];
            lsum += ps;
            pack_half(p1, pa2, pa3);
            pv_half<2, false>(o, vb0 + buf * 32768, pa2, pa3, p1, off);
        }
        if (MODE == MODE_SLC) { if (((j + 1) & 31) == 0 && j + 1 < j1) { bmw = a.BM[((size_t)tq * 4 + g) * 8 + ((j + 1) >> 5)]; asm volatile("s_waitcnt vmcnt(0)" : "+v"(bmw) :: "memory"); } }
    }
#undef ISSUE
    lsum += __shfl_xor(lsum, 32);
    if (hi == 0) li_l[r32] = lsum;
    if (MODE == MODE_CMP) { if (hi == 0) a.L[(size_t)tq * NH + hq] = lsum; }
    asm volatile("s_waitcnt lgkmcnt(0)" ::: "memory");
    float gtv[16]; f32x16 pvv[4];
#pragma unroll
    for (int r = 0; r < 16; ++r) {
        const int orow = crow(r, hi); const float lv = li_l[orow]; const float rl = lv > 0.f ? 1.0f / lv : 0.f;
        const int t = MODE == MODE_SLC ? t0 + wid * 5 + orow / 6 : t0 + wid * 16 + (orow & 15);
        const int h = MODE == MODE_SLC ? g * HPG + orow % 6 : g * HPG + hp * 2 + (orow >> 4);
        const bool valid = !(MODE == MODE_SLC && (orow >= 30 || t >= S_)); const int tc = valid ? t : 0;
        gtv[r] = valid ? a.G[(size_t)tc * NGATE + h * 3 + (MODE == MODE_CMP ? 0 : (MODE == MODE_SLC ? 1 : 2))] * rl : 0.f;
        if (MODE != MODE_CMP) { const float* oa = a.OACC + (size_t)tc * 3072 + h * HD + r32;
#pragma unroll
            for (int d0 = 0; d0 < 4; ++d0) pvv[d0][r] = oa[d0 * 32]; }
    }
#pragma unroll
    for (int r = 0; r < 16; ++r) {
        const int orow = crow(r, hi);
        const int t = MODE == MODE_SLC ? t0 + wid * 5 + orow / 6 : t0 + wid * 16 + (orow & 15);
        const int h = MODE == MODE_SLC ? g * HPG + orow % 6 : g * HPG + hp * 2 + (orow >> 4);
        if (MODE == MODE_SLC && (orow >= 30 || t >= S_)) continue;
        float* oa = a.OACC + (size_t)t * 3072 + h * HD + r32;
#pragma unroll
        for (int d0 = 0; d0 < 4; ++d0) {
            const float v = o[d0][r] * gtv[r];
            if (MODE == MODE_CMP) oa[d0 * 32] = v;
            else if (MODE == MODE_WIN) oa[d0 * 32] = pvv[d0][r] + v;
            else a.MIX[(size_t)t * DM + POOLW + h * HD + d0 * 32 + r32] = (bf16_t)(cvt_pk_bf16(pvv[d0][r] + v, 0.f) & 0xffffu);
        }
    }
}

__device__ __forceinline__ void imp_task(const AttnArgs& a, float* IMPP, float* IMPF, int tqi, int g) {
    const int lane = threadIdx.x & 63, fr = lane & 15, fq = lane >> 4;
    const int t = tqi * 16 + fr;
    const int tmax = tqi * 16 + 15;
    if (tmax < 31) return;
    const int lim = t >= 31 ? ((t - 31) >> 4) : -1;
    const int nstep = ((((tmax - 31) >> 4) >> 6) + 1) * 4;
    const float negBC = -a.TAB[512];
    bf16x8 qf[HPG][4]; float rl[HPG];
#pragma unroll
    for (int h = 0; h < HPG; ++h) {
        const bf16_t* qp = a.Z + (size_t)t * LDZ + OFF_Q + (g * HPG + h) * HD + fq * 8;
#pragma unroll
        for (int ks = 0; ks < 4; ++ks) qf[h][ks] = *reinterpret_cast<const bf16x8*>(qp + ks * 32);
        const float lv = a.L[(size_t)t * NH + g * HPG + h]; rl[h] = lv > 0.f ? 1.0f / lv : 0.f;
    }
    const bf16_t* kbase = a.KC + (size_t)g * 1024 * HD + (size_t)fr * HD + fq * 8;
    bf16x8 kf[4], kn[4];
#pragma unroll
    for (int ks = 0; ks < 4; ++ks) kf[ks] = *reinterpret_cast<const bf16x8*>(kbase + ks * 32);
    float* op = IMPP + ((size_t)t * 4 + g) * 256 + fq; float* of = IMPF + ((size_t)t * 4 + g) * 256 + fq;
    for (int st = 0; st < nstep; ++st) {
        const int sn = (st + 1 < nstep) ? st + 1 : st;
#pragma unroll
        for (int ks = 0; ks < 4; ++ks) kn[ks] = *reinterpret_cast<const bf16x8*>(kbase + (size_t)sn * 16 * HD + ks * 32);
        f32x4 imp4 = {0.f, 0.f, 0.f, 0.f};
        const int n0 = st * 16 + fq * 4;
#pragma unroll
        for (int h = 0; h < HPG; ++h) {
            f32x4 acc = {0.f, 0.f, 0.f, 0.f};
#pragma unroll
            for (int ks = 0; ks < 4; ++ks) acc = __builtin_amdgcn_mfma_f32_16x16x32_bf16(kf[ks], qf[h][ks], acc, 0, 0, 0);
#pragma unroll
            for (int i = 0; i < 4; ++i) { const float e = __builtin_amdgcn_exp2f(fmaf(acc[i], SM_C, negBC)) * rl[h]; imp4[i] += (n0 + i <= lim) ? e : 0.f; }
        }
        op[st * 4] = imp4[0] + 2.0f * (imp4[1] + imp4[2] + imp4[3]);
        of[st * 4] = imp4[0];
#pragma unroll
        for (int ks = 0; ks < 4; ++ks) kf[ks] = kn[ks];
    }
}

__device__ __forceinline__ void topk_load(const float* IMPP, const float* IMPF, int t, int g, f32x4& pp, f32x4& ff) {
    const int lane = threadIdx.x & 63, cur = t >> 6, jb = lane * 4;
    pp = (f32x4){0.f, 0.f, 0.f, 0.f}; ff = pp;
    if (cur > 15 && jb <= cur) { const size_t base = ((size_t)t * 4 + g) * 256; pp = *(const f32x4*)(IMPP + base + jb); ff = *(const f32x4*)(IMPF + base + jb); }
}
__device__ __forceinline__ void topk_task(const f32x4 pp, const f32x4 ff, unsigned* BM, int t, int g) {
    const int lane = threadIdx.x & 63;
    const int cur = t >> 6;
    unsigned nib = 0u;
    if (cur <= 15) { const int jb = lane * 4;
#pragma unroll
        for (int c = 0; c < 4; ++c) if (jb + c <= cur) nib |= 1u << c; }
    else {
        const int jb = lane * 4;
        unsigned key[4];
        {
            float fnext = __shfl_down(ff[0], 1);
            if (lane == 63) fnext = 0.f;
            const float v0 = pp[0] + ff[1], v1 = pp[1] + ff[2], v2 = pp[2] + ff[3], v3 = pp[3] + fnext;
            key[0] = (jb + 0 >= 1 && jb + 0 <= cur - 2) ? __float_as_uint(fmaxf(v0, 0.f)) + 1u : 0u;
            key[1] = (jb + 1 >= 1 && jb + 1 <= cur - 2) ? __float_as_uint(fmaxf(v1, 0.f)) + 1u : 0u;
            key[2] = (jb + 2 >= 1 && jb + 2 <= cur - 2) ? __float_as_uint(fmaxf(v2, 0.f)) + 1u : 0u;
            key[3] = (jb + 3 >= 1 && jb + 3 <= cur - 2) ? __float_as_uint(fmaxf(v3, 0.f)) + 1u : 0u;
        }
        unsigned prefix = 0u; bool exact = false;
        for (int b = 30; b >= 0; --b) {
            const unsigned trial = prefix | (1u << b);
            const int cnt = __popcll(__ballot(key[0] >= trial)) + __popcll(__ballot(key[1] >= trial)) + __popcll(__ballot(key[2] >= trial)) + __popcll(__ballot(key[3] >= trial));
            if (cnt >= 13) { prefix = trial; if (cnt == 13) { exact = true; break; } }
        }
#pragma unroll
        for (int c = 0; c < 4; ++c) if (exact ? (key[c] >= prefix) : (key[c] > prefix)) nib |= 1u << c;
        if (!exact) {
            int need = 13 - (__popcll(__ballot(key[0] > prefix)) + __popcll(__ballot(key[1] > prefix)) + __popcll(__ballot(key[2] > prefix)) + __popcll(__ballot(key[3] > prefix)));
            unsigned tie = 0u;
#pragma unroll
            for (int c = 0; c < 4; ++c) if (key[c] == prefix) tie |= 1u << c;
            for (int guard = 0; need > 0 && guard < 16; ++guard) {
                const unsigned long long any = __ballot(tie != 0u);
                if (any == 0ull) break;
                const int L = __builtin_ctzll(any);
                if (lane == L) { const unsigned low = tie & (0u - tie); nib |= low; tie ^= low; }
                --need;
            }
        }
        if (lane == 0) nib |= 1u;
        if (lane == (cur >> 2)) nib |= 1u << (cur & 3);
        if (lane == ((cur - 1) >> 2)) nib |= 1u << ((cur - 1) & 3);
    }
    unsigned x = nib << (4 * (lane & 7));
    x |= __shfl_xor(x, 1); x |= __shfl_xor(x, 2); x |= __shfl_xor(x, 4);
    if ((lane & 7) == 0) BM[((size_t)t * 4 + g) * 8 + (lane >> 3)] = x;
}
#undef KSWZ
}

template <bool FFN_REMAP = false>
__device__ __forceinline__ void convT(const float* __restrict__ src, int K, int N, bf16_t* __restrict__ dst, int ldd, LAS float* tile, int bid, int nb) {
    const int tid = threadIdx.x, tk = K >> 6, tn = (N + 63) >> 6, total = tk * tn;
    const int r = tid >> 4, c4 = (tid & 15) * 4;
    f32x4 v[2] = {{0.f, 0.f, 0.f, 0.f}, {0.f, 0.f, 0.f, 0.f}}, vn[2];
    if (bid < total) { const int nti = bid % tn, kti = bid / tn, ng = nti * 64 + c4;
#pragma unroll
        for (int h = 0; h < 2; ++h) if (ng < N) v[h] = *(const f32x4*)(src + (size_t)(kti * 64 + r + h * 32) * N + ng); }
    for (int idx = bid; idx < total; idx += nb) {
        const int nti = idx % tn, kti = idx / tn;
#pragma unroll
        for (int h = 0; h < 2; ++h) { LAS float* tp = tile + (r + h * 32) * 65 + c4; tp[0] = v[h][0]; tp[1] = v[h][1]; tp[2] = v[h][2]; tp[3] = v[h][3]; }
        {
            const int nx = idx + nb; vn[0] = (f32x4){0.f, 0.f, 0.f, 0.f}; vn[1] = vn[0];
            if (nx < total) { const int nti2 = nx % tn, kti2 = nx / tn, ng2 = nti2 * 64 + c4;
#pragma unroll
                for (int h = 0; h < 2; ++h) if (ng2 < N) vn[h] = *(const f32x4*)(src + (size_t)(kti2 * 64 + r + h * 32) * N + ng2); } }
        __syncthreads();
        const int n = tid >> 3, k8 = (tid & 7) * 8, ngl = nti * 64 + n;
        float e[8];
#pragma unroll
        for (int i = 0; i < 8; ++i) e[i] = tile[(k8 + i) * 65 + n];
        if (ngl < N) { u32x4 w; w.x = cvt_pk_bf16(e[0], e[1]); w.y = cvt_pk_bf16(e[2], e[3]); w.z = cvt_pk_bf16(e[4], e[5]); w.w = cvt_pk_bf16(e[6], e[7]);
            int drow = ngl; if (FFN_REMAP) { const int up = ngl >= DFF ? 1 : 0, f = ngl - up * DFF; drow = (f >> 7) * 256 + up * 128 + (f & 127); }
            *(u32x4*)(dst + (size_t)drow * ldd + kti * 64 + k8) = w; }
        __syncthreads();
        v[0] = vn[0]; v[1] = vn[1];
    }
}
__device__ __forceinline__ void rmsnorm_rows(const float* __restrict__ src, const float* __restrict__ w, bf16_t* __restrict__ dst, int rows, int gw, int nw) {
    const int lane = threadIdx.x & 63;
    f32x4 v[16], vn[16];
    if (gw < rows) { const f32x4* sp = (const f32x4*)(src + (size_t)gw * DM);
#pragma unroll
        for (int i = 0; i < 16; ++i) v[i] = sp[lane + 64 * i]; }
    for (int row = gw; row < rows; row += nw) {
        const int nr = row + nw < rows ? row + nw : row;
        { const f32x4* sp = (const f32x4*)(src + (size_t)nr * DM);
#pragma unroll
          for (int i = 0; i < 16; ++i) vn[i] = sp[lane + 64 * i]; }
        float ss = 0.f;
#pragma unroll
        for (int i = 0; i < 16; ++i) ss += v[i][0] * v[i][0] + v[i][1] * v[i][1] + v[i][2] * v[i][2] + v[i][3] * v[i][3];
        ss = wave_sum(ss);
        const float rstd = rsqrtf(ss * (1.0f / DM) + EPS);
#pragma unroll
        for (int i = 0; i < 16; ++i) { const f32x4 ww = ((const f32x4*)w)[lane + 64 * i];
            u32x2 o; o.x = cvt_pk_bf16(v[i][0] * rstd * ww[0], v[i][1] * rstd * ww[1]); o.y = cvt_pk_bf16(v[i][2] * rstd * ww[2], v[i][3] * rstd * ww[3]);
            *(u32x2*)(dst + (size_t)row * DM + (lane + 64 * i) * 4) = o; }
#pragma unroll
        for (int i = 0; i < 16; ++i) v[i] = vn[i];
    }
}

struct Ptrs {
    bf16_t *Win, *Wo, *Wfi, *Wfo, *Wg, *Wple, *Wpool, *Wc1k, *Wc1v, *XN, *PB, *Z, *M, *KC, *VC, *MIX, *ACT, *ERAW;
    float *COS, *SIN, *TAB, *G, *H1, *L, *OACC, *IMPP, *IMPF, *ERSTD; unsigned* BM;
};

__device__ __forceinline__ void phase_prologue(const Params& P, const Ptrs& W, LAS unsigned char* lds) {
    const int bid = blockIdx.x, nb = gridDim.x, tid = threadIdx.x, lane = tid & 63, wv = tid >> 6;
    const int gw = bid * NWAVES + wv, nw = nb * NWAVES; const size_t gt = (size_t)bid * NTHREADS + tid, ntot = (size_t)nb * NTHREADS;
    LAS float* tile = (LAS float*)lds;
    rmsnorm_rows(P.x, P.norm1_w, W.XN, S_, gw, nw);
    convT(P.w_in, DM, INW, W.Win, DM, tile, bid, nb);
    for (size_t i = gt; i < (size_t)(LDZ - INW) * DM / 8; i += ntot) *(u32x4*)(W.Win + (size_t)INW * DM + i * 8) = (u32x4){0u, 0u, 0u, 0u};
    convT(P.w_o, DM, DM, W.Wo, DM, tile, bid, nb);
    convT<true>(P.w_ffn_in, DM, NFI, W.Wfi, DM, tile, bid, nb);
    for (size_t i = gt; i < (size_t)2 * DM / 8; i += ntot) *(u32x4*)(W.XN - 2 * DM + i * 8) = (u32x4){0u, 0u, 0u, 0u};
    convT(P.w_ffn_out, DFF, DM, W.Wfo, DFF, tile, bid, nb);
    convT(P.w_ple_gate, DM, DM, W.Wg, DM, tile, bid, nb);
    convT(P.w_ple_proj, PLE, DM, W.Wple, PLE, tile, bid, nb);
    for (int g = 0; g < 4; ++g) convT(P.w_pool + (size_t)g * 65536, 256, 256, W.Wpool + (size_t)g * 65536, 256, tile, bid, nb);
    convT(P.cmp_k_w1, 4096, 256, W.Wc1k, 4096, tile, bid, nb);
    convT(P.cmp_v_w1, 4096, 256, W.Wc1v, 4096, tile, bid, nb);
    for (size_t i = gt; i < (size_t)S_ * PLE / 8; i += ntot) { const f32x4 a = *(const f32x4*)(P.p + i * 8), b = *(const f32x4*)(P.p + i * 8 + 4);
        u32x4 w; w.x = cvt_pk_bf16(a[0], a[1]); w.y = cvt_pk_bf16(a[2], a[3]); w.z = cvt_pk_bf16(b[0], b[1]); w.w = cvt_pk_bf16(b[2], b[3]); *(u32x4*)(W.PB + i * 8) = w; }
    for (size_t i = gt; i < (size_t)S_ * 16; i += ntot) { const int t = (int)(i >> 4), fi = (int)(i & 15);
        const float inv = exp2f(-(float)fi * (18.931568569324174f / 16.0f)); const float ang = (float)P.positions[t] * inv;
        const double ad = (double)ang; const double kk = rint(ad * 0.15915494309189535); const float rf = (float)(ad - kk * 6.283185307179586);
        W.COS[i] = __cosf(rf); W.SIN[i] = __sinf(rf); }
    for (int o = gw; o < 512; o += nw) { const int which = o >> 8, j = o & 255; const float* pe = which ? P.cmp_pos_v : P.cmp_pos_k; const float* w1 = which ? P.cmp_v_w1 : P.cmp_k_w1;
        float s = 0.f; for (int r = lane; r < 4096; r += 64) s += pe[r] * w1[(size_t)r * 256 + j];
        s = wave_sum(s); if (lane == 0) W.TAB[o] = s; }
    if (gw == 0) { float mq = fmaxf(fabsf(P.q_norm_w[lane]), fabsf(P.q_norm_w[lane + 64])); mq = wave_max(mq);
        float mc = wave_max(fmaxf(fabsf(P.k_norm_cmp_w[lane]), fabsf(P.k_norm_cmp_w[lane + 64])));
        float ms = wave_max(fmaxf(fabsf(P.k_norm_slc_w[lane]), fabsf(P.k_norm_slc_w[lane + 64])));
        float mw = wave_max(fmaxf(fabsf(P.k_norm_win_w[lane]), fabsf(P.k_norm_win_w[lane + 64])));
        const float c = 11.313708498984761f * 1.4426950408889634f * mq * 1.01f;
        if (lane == 0) { W.TAB[512] = c * mc; W.TAB[513] = c * ms; W.TAB[514] = c * mw; } }
}

__device__ __forceinline__ void phase_postz(const Params& P, const Ptrs& W, int gw, int nw) {
    const int tid = threadIdx.x, lane = tid & 63;
    const f32x2 wq = *(const f32x2*)(P.q_norm_w + 2 * lane), wks = *(const f32x2*)(P.k_norm_slc_w + 2 * lane), wkw = *(const f32x2*)(P.k_norm_win_w + 2 * lane);
    for (int t = gw; t < S_; t += nw) {
        bf16_t* zr = W.Z + (size_t)t * LDZ;
        float cs0 = 0.f, cs1 = 0.f, sn0 = 0.f, sn1 = 0.f;
        if (lane < 16) { const int i0 = (2 * lane) & 15; cs0 = W.COS[t * 16 + i0]; cs1 = W.COS[t * 16 + i0 + 1]; sn0 = W.SIN[t * 16 + i0]; sn1 = W.SIN[t * 16 + i0 + 1]; }
        unsigned uv[32];
#pragma unroll
        for (int v = 0; v < 32; ++v) { const int col = v < 24 ? OFF_Q + v * HD : (v < 28 ? OFF_KV + 2 * 512 + (v - 24) * HD : OFF_KV + 4 * 512 + (v - 28) * HD);
            uv[v] = *((const unsigned*)(zr + col) + lane); }
        float gz0 = bf2f(zr[OFF_G + lane]), gz1 = lane < NGATE - 64 ? bf2f(zr[OFF_G + 64 + lane]) : 0.f;
#pragma unroll
        for (int v = 0; v < 32; ++v) {
            const f32x2 ww = v < 24 ? wq : (v < 28 ? wks : wkw);
            const unsigned u = uv[v]; const float x0 = bf_lo(u), x1 = bf_hi(u);
            const float ss = wave_sum(x0 * x0 + x1 * x1);
            const float rstd = rsqrtf(ss * (1.0f / HD) + EPS);
            float y0 = x0 * rstd * ww[0], y1 = x1 * rstd * ww[1];
            const float p0 = __shfl_xor(y0, 8), p1 = __shfl_xor(y1, 8);
            if (lane < 8) { y0 = y0 * cs0 - p0 * sn0; y1 = y1 * cs1 - p1 * sn1; }
            else if (lane < 16) { y0 = y0 * cs0 + p0 * sn0; y1 = y1 * cs1 + p1 * sn1; }
            uv[v] = cvt_pk_bf16(y0, y1);
        }
        {
            const int gi = lane >> 4, wlen = 2 << gi, c0 = lane * 16; const int cnt = (t + 1) < wlen ? (t + 1) : wlen;
            float s[16];
#pragma unroll
            for (int i = 0; i < 16; ++i) s[i] = 0.f;
            float cur[16];
            for (int i = 0; i < cnt; ++i) { const u32x4 a = *(const u32x4*)(W.Z + (size_t)(t - i) * LDZ + c0), b = *(const u32x4*)(W.Z + (size_t)(t - i) * LDZ + c0 + 8);
                const float e[16] = {bf_lo(a.x), bf_hi(a.x), bf_lo(a.y), bf_hi(a.y), bf_lo(a.z), bf_hi(a.z), bf_lo(a.w), bf_hi(a.w), bf_lo(b.x), bf_hi(b.x), bf_lo(b.y), bf_hi(b.y), bf_lo(b.z), bf_hi(b.z), bf_lo(b.w), bf_hi(b.w)};
#pragma unroll
                for (int q = 0; q < 16; ++q) { s[q] += e[q]; if (i == 0) cur[q] = e[q]; } }
            const float rc = 1.0f / (float)cnt;
            u32x4 o0, o1;
            o0.x = cvt_pk_bf16(s[0] * rc - cur[0], s[1] * rc - cur[1]); o0.y = cvt_pk_bf16(s[2] * rc - cur[2], s[3] * rc - cur[3]);
            o0.z = cvt_pk_bf16(s[4] * rc - cur[4], s[5] * rc - cur[5]); o0.w = cvt_pk_bf16(s[6] * rc - cur[6], s[7] * rc - cur[7]);
            o1.x = cvt_pk_bf16(s[8] * rc - cur[8], s[9] * rc - cur[9]); o1.y = cvt_pk_bf16(s[10] * rc - cur[10], s[11] * rc - cur[11]);
            o1.z = cvt_pk_bf16(s[12] * rc - cur[12], s[13] * rc - cur[13]); o1.w = cvt_pk_bf16(s[14] * rc - cur[14], s[15] * rc - cur[15]);
            *(u32x4*)(W.M + (size_t)t * POOLW + c0) = o0; *(u32x4*)(W.M + (size_t)t * POOLW + c0 + 8) = o1;
        }
#pragma unroll
        for (int v = 0; v < 32; ++v) { const int col = v < 24 ? OFF_Q + v * HD : (v < 28 ? OFF_KV + 2 * 512 + (v - 24) * HD : OFF_KV + 4 * 512 + (v - 28) * HD);
            *((unsigned*)(zr + col) + lane) = uv[v]; }
        W.G[(size_t)t * NGATE + lane] = sigmoidf_(gz0); if (lane < NGATE - 64) W.G[(size_t)t * NGATE + 64 + lane] = sigmoidf_(gz1);
    }
}

__device__ __forceinline__ void phase_cmpfin(const Params& P, const Ptrs& W) {
    const int tid = threadIdx.x, lane = tid & 63, gw = blockIdx.x * NWAVES + (tid >> 6), nw = gridDim.x * NWAVES;
    const f32x2 wk = *(const f32x2*)(P.k_norm_cmp_w + 2 * lane);
    for (int task = gw; task < 8192; task += nw) {
        const int tk = __builtin_amdgcn_readfirstlane(task);
        const int which = tk >> 12, g = (tk >> 10) & 3, n = tk & 1023;
        bf16_t* dst = (which ? W.VC : W.KC) + ((size_t)g * 1024 + n) * HD;
        if (n == 1023) { ((unsigned*)dst)[lane] = 0u; continue; }
        const float* h = W.H1 + (size_t)tk * 256; const float* w2 = which ? P.cmp_v_w2 : P.cmp_k_w2;
        float a0 = 0.f, a1 = 0.f;
        for (int j = 0; j < 256; ++j) { const float hj = h[j]; const f32x2 wv = *(const f32x2*)(w2 + j * HD + 2 * lane); a0 += hj * wv[0]; a1 += hj * wv[1]; }
        if (which == 0) {
            const float ss = wave_sum(a0 * a0 + a1 * a1); const float rstd = rsqrtf(ss * (1.0f / HD) + EPS);
            a0 = a0 * rstd * wk[0]; a1 = a1 * rstd * wk[1];
            const int tp = 16 * n + 31; const float p0 = __shfl_xor(a0, 8), p1 = __shfl_xor(a1, 8);
            if (lane < 16) { const int i0 = (2 * lane) & 15; const float cs0 = W.COS[tp * 16 + i0], cs1 = W.COS[tp * 16 + i0 + 1], sn0 = W.SIN[tp * 16 + i0], sn1 = W.SIN[tp * 16 + i0 + 1];
                if (lane < 8) { a0 = a0 * cs0 - p0 * sn0; a1 = a1 * cs1 - p1 * sn1; } else { a0 = a0 * cs0 + p0 * sn0; a1 = a1 * cs1 + p1 * sn1; } }
        }
        ((unsigned*)dst)[lane] = cvt_pk_bf16(a0, a1);
    }
}

__device__ __forceinline__ void phase_erstd(const Ptrs& W) {
    const int tid = threadIdx.x, lane = tid & 63, gw = blockIdx.x * NWAVES + (tid >> 6), nw = gridDim.x * NWAVES;
    u32x4 a[8], an[8];
    if (gw < S_) { const u32x4* sp = (const u32x4*)(W.ERAW + (size_t)gw * DM);
#pragma unroll
        for (int i = 0; i < 8; ++i) a[i] = sp[lane + 64 * i]; }
    for (int row = gw; row < S_; row += nw) {
        const int nr = row + nw < S_ ? row + nw : row;
        { const u32x4* sp = (const u32x4*)(W.ERAW + (size_t)nr * DM);
#pragma unroll
          for (int i = 0; i < 8; ++i) an[i] = sp[lane + 64 * i]; }
        float ss = 0.f;
#pragma unroll
        for (int i = 0; i < 8; ++i) {
            const float e0 = bf_lo(a[i].x), e1 = bf_hi(a[i].x), e2 = bf_lo(a[i].y), e3 = bf_hi(a[i].y), e4 = bf_lo(a[i].z), e5 = bf_hi(a[i].z), e6 = bf_lo(a[i].w), e7 = bf_hi(a[i].w);
            ss += e0 * e0 + e1 * e1 + e2 * e2 + e3 * e3 + e4 * e4 + e5 * e5 + e6 * e6 + e7 * e7; }
        ss = wave_sum(ss);
        if (lane == 0) W.ERSTD[row] = rsqrtf(ss * (1.0f / DM) + EPS);
#pragma unroll
        for (int i = 0; i < 8; ++i) a[i] = an[i];
    }
}

constexpr int N_PHASES = 11;
__device__ __forceinline__ Params kargs() {
#if defined(__HIP_DEVICE_COMPILE__)
    unsigned long long p = (unsigned long long)__builtin_amdgcn_kernarg_segment_ptr();
    asm volatile("" : "+s"(p));
    return *(const __attribute__((address_space(4))) Params*)p;
#else
    return Params{};
#endif
}
__device__ __forceinline__ Ptrs mkptrs(unsigned char* ws) {
    Ptrs W;
    W.Win = (bf16_t*)(ws + WS_WIN); W.Wo = (bf16_t*)(ws + WS_WO); W.Wfi = (bf16_t*)(ws + WS_WFI); W.Wfo = (bf16_t*)(ws + WS_WFO); W.Wg = (bf16_t*)(ws + WS_WG);
    W.Wple = (bf16_t*)(ws + WS_WPLE); W.Wpool = (bf16_t*)(ws + WS_WPOOL); W.Wc1k = (bf16_t*)(ws + WS_WC1K); W.Wc1v = (bf16_t*)(ws + WS_WC1V);
    W.XN = (bf16_t*)(ws + WS_XN); W.PB = (bf16_t*)(ws + WS_PB); W.Z = (bf16_t*)(ws + WS_Z); W.M = (bf16_t*)(ws + WS_M); W.KC = (bf16_t*)(ws + WS_KC); W.VC = (bf16_t*)(ws + WS_VC);
    W.MIX = (bf16_t*)(ws + WS_MIX); W.ACT = (bf16_t*)(ws + WS_ACT); W.ERAW = (bf16_t*)(ws + WS_ERAW);
    W.COS = (float*)(ws + WS_COS); W.SIN = (float*)(ws + WS_SIN); W.TAB = (float*)(ws + WS_TAB); W.G = (float*)(ws + WS_G); W.H1 = (float*)(ws + WS_H1); W.L = (float*)(ws + WS_L);
    W.OACC = (float*)(ws + WS_OACC); W.IMPP = (float*)(ws + WS_IMPP); W.IMPF = (float*)(ws + WS_IMPF); W.ERSTD = (float*)(ws + WS_ERSTD); W.BM = (unsigned*)(ws + WS_BM);
    return W;
}
__global__ void __launch_bounds__(NTHREADS, 2) fwd(Params Punused) {
    extern __shared__ __attribute__((aligned(16))) unsigned char lds_raw[];
    LAS unsigned char* lds = (LAS unsigned char*)lds_raw;
    const int tid = threadIdx.x;
    const int G = gridDim.x, bid = blockIdx.x;
    const int gw = bid * NWAVES + (tid >> 6), nw = G * NWAVES;

    if (tid < 16) ((LAS unsigned*)(lds + LDS_MISC))[tid] = 0u;
    __syncthreads();
    int lo, hi; XcdBarrier bar;
    { const Params P = kargs(); lo = P.ph_lo; hi = P.ph_hi;
      bar.bar = (unsigned*)(P.ws + WS_CTL); bar.x = 0; bar.st = (volatile LAS unsigned*)(lds + LDS_MISC);
      if (hi - lo > 1) bar = xcd_barrier_post((unsigned*)(P.ws + WS_CTL), (volatile LAS unsigned*)(lds + LDS_MISC)); }
#ifdef PH_MASK
#define IN(k) (((PH_MASK >> (k)) & 1) && lo <= (k) && (k) < hi)
#else
#define IN(k) (lo <= (k) && (k) < hi)
#endif
#define SEAM(k) do { if (IN(k) && IN((k) + 1)) xcd_barrier(bar); } while (0)
#define PHASE_VARS const Params P = kargs(); const Ptrs W = mkptrs(P.ws); (void)W;
#define ATT_ARGS att::AttnArgs AA{W.Z, W.KC, W.VC, W.G, W.L, W.OACC, W.MIX, W.BM, W.TAB};

    if (IN(0)) { PHASE_VARS REP(0) { phase_prologue(P, W, lds); } SEAM(0); }
    if (IN(1)) {
        PHASE_VARS
        pg8::GStd g{(const char*)W.XN, (const char*)W.Win, DM, DM, DM / 64}; pg8::StaticOrder S; S.init(S_ / 256, LDZ / 256, G, bid);
        pg8::EpiBf16 E{W.Z, LDZ};
        REP(1) { pg8::gemm_phase(lds, g, S, E); } SEAM(1);
    }
    if (IN(2)) {
        PHASE_VARS
        if (G > 64) {
            if (bid < 32) { pg8::GCmp g{(const char*)W.Z, (const char*)W.Wc1k, (const char*)W.Wc1v, 16 * LDZ, 4096, 64}; pg8::StaticOrder S; S.init(32, 1, 32, bid);
                pg8::EpiCmpGelu E{W.H1, W.TAB}; pg8::gemm_phase(lds, g, S, E); }
            else phase_postz(P, W, (bid - 32) * NWAVES + (tid >> 6), (G - 32) * NWAVES);
        } else {
            { pg8::GCmp g{(const char*)W.Z, (const char*)W.Wc1k, (const char*)W.Wc1v, 16 * LDZ, 4096, 64}; pg8::StaticOrder S; S.init(32, 1, G, bid);
              pg8::EpiCmpGelu E{W.H1, W.TAB}; pg8::gemm_phase(lds, g, S, E); }
            phase_postz(P, W, gw, nw);
        }
        SEAM(2);
    }
    if (IN(3)) {
        PHASE_VARS
        phase_cmpfin(P, W);
        { pg8::GPool g{(const char*)W.M, (const char*)W.Wpool, POOLW, 256, 4}; pg8::StaticOrder S; S.init(S_ / 256, 4, G, bid);
          pg8::EpiBf16Scale E{W.MIX, DM, P.pool_scale}; pg8::gemm_phase(lds, g, S, E); }
        SEAM(3);
    }
    if (IN(4)) {
        PHASE_VARS ATT_ARGS
        REP(4)
        for (int base = 0, rnd = 0; base < 1536; base += G, ++rnd) {
            int qt, g, hp;
            if (G == 256) { const int x = bid & 7, r = bid >> 3, qp = (rnd / 3) ? 63 - r : r; if (rnd >= 6) break; g = x & 3; qt = 2 * qp + (x >> 2); hp = rnd % 3; }
            else { const int Lu = base + ((rnd & 1) ? G - 1 - bid : bid); if (Lu >= 1536) continue; qt = Lu / 12; const int rem = Lu % 12; g = rem / 3; hp = rem % 3; }
            att::attn_unit<att::MODE_CMP>(AA, (LAS char*)lds, qt, g, hp);
            asm volatile("s_waitcnt vmcnt(0)" ::: "memory");
            att::attn_unit<att::MODE_WIN>(AA, (LAS char*)lds, qt, g, hp); }
        SEAM(4);
    }
    if (IN(5)) {
        PHASE_VARS ATT_ARGS
        for (int k = gw, r = 0; k < 4096; k += nw, ++r) { const int hiT = (r + 1) * nw < 4096 ? (r + 1) * nw : 4096;
            const int task = (r & 1) ? hiT - 1 - (k - r * nw) : k;
            att::imp_task(AA, W.IMPP, W.IMPF, task >> 2, task & 3);
            asm volatile("s_waitcnt vmcnt(0)" ::: "memory");
            { const int tb = (task >> 2) * 16, gg = task & 3; f32x4 pp, ff, pn, fn;
              att::topk_load(W.IMPP, W.IMPF, tb, gg, pp, ff);
              for (int q = 0; q < 16; ++q) { att::topk_load(W.IMPP, W.IMPF, tb + (q < 15 ? q + 1 : q), gg, pn, fn); att::topk_task(pp, ff, W.BM, tb + q, gg); pp = pn; ff = fn; } } }
        SEAM(5);
    }
    if (IN(6)) {
        PHASE_VARS ATT_ARGS
        REP(6)
        for (int base = 0, rnd = 0; base < 1640 + G; base += G, ++rnd) {
            int ut, g;
            if (G == 256) { const int x = bid & 7, r = bid >> 3, k = rnd * 32 + ((rnd & 1) ? 31 - r : r); if (k >= 205) break; g = x & 3; ut = 409 - (2 * k + (x >> 2)); }
            else { const int Lu = base + ((rnd & 1) ? G - 1 - bid : bid); if (Lu >= 1640) continue; ut = 409 - Lu / 4; g = Lu % 4; }
            att::attn_unit<att::MODE_SLC>(AA, (LAS char*)lds, ut, g, 0); }
        SEAM(6);
    }
    if (IN(7)) {
        PHASE_VARS
        { pg8::GStd g{(const char*)W.MIX, (const char*)W.Wo, DM, DM, DM / 64}; pg8::StaticOrder S; S.init(S_ / 256, DM / 256, G, bid);
          pg8::EpiResNorm E{P.x, P.out, W.XN, P.norm2_w, (float*)(P.ws + WS_SSQ1), DM}; pg8::gemm_phase(lds, g, S, E); }
        { pg8::GStd g{(const char*)W.PB, (const char*)W.Wple, PLE, PLE, PLE / 64}; pg8::StaticOrder S; S.init(S_ / 256, DM / 256, G, bid);
          pg8::EpiBf16 E{W.ERAW, DM}; pg8::gemm_phase(lds, g, S, E); }
        SEAM(7);
    }
    if (IN(8)) {
        PHASE_VARS
        phase_erstd(W);
        pg8::GFfn g{(const char*)W.XN, (const char*)W.Wfi, DM, DM, DM / 64}; pg8::StaticOrder S; S.init(65, DFF / 128, G, bid);
        pg8::EpiFfn E{W.ACT, P.conv_w, P.conv_b, (LAS float*)(lds + LDS_XCH), (const float*)(P.ws + WS_SSQ1)}; REP(8) { pg8::gemm_phase(lds, g, S, E); } SEAM(8);
    }
    if (IN(9)) {
        PHASE_VARS
        pg8::GStd g{(const char*)W.ACT, (const char*)W.Wfo, DFF, DFF, DFF / 64}; pg8::StaticOrder S; S.init(S_ / 256, DM / 256, G, bid);
        pg8::EpiResNorm E{P.out, P.out, W.XN, P.ple_gate_norm_w, (float*)(P.ws + WS_SSQ2), DM}; pg8::gemm_phase(lds, g, S, E); SEAM(9);
    }
    if (IN(10)) {
        PHASE_VARS
        pg8::GStd g{(const char*)W.XN, (const char*)W.Wg, DM, DM, DM / 64}; pg8::StaticOrder S; S.init(S_ / 256, DM / 256, G, bid);
        pg8::EpiGate E{P.out, W.ERAW, W.ERSTD, P.ple_norm_w, (const float*)(P.ws + WS_SSQ2), DM}; pg8::gemm_phase(lds, g, S, E);
    }
#undef IN
#undef SEAM
}

extern "C" void kernel_launch(void* const* d_in, const int* in_sizes, int n_in, void* d_out, int out_size, void* d_ws, size_t ws_size, hipStream_t stream) {
    static int grid = 0;
    if (grid == 0) {
        if (n_in != 27 || in_sizes[0] != S_ * DM || out_size != S_ * DM || ws_size < WS_NEED) {
            fprintf(stderr, "kernel_launch: unexpected shapes (n_in %d, in0 %d, out %d, ws %zu < %zu); nothing launched\n", n_in, n_in > 0 ? in_sizes[0] : -1, out_size, ws_size, (size_t)WS_NEED); grid = -1; return; }
        int dev = 0, cus = 0, per_cu = 0;
        if (hipGetDevice(&dev) != hipSuccess || hipDeviceGetAttribute(&cus, hipDeviceAttributeMultiprocessorCount, dev) != hipSuccess) { grid = -1; return; }
        if (hipFuncSetAttribute((const void*)fwd, hipFuncAttributeMaxDynamicSharedMemorySize, LDS_BYTES) != hipSuccess) { fprintf(stderr, "kernel_launch: hipFuncSetAttribute failed\n"); grid = -1; return; }
        if (hipOccupancyMaxActiveBlocksPerMultiprocessor(&per_cu, (const void*)fwd, NTHREADS, LDS_BYTES) != hipSuccess || per_cu < 1) { fprintf(stderr, "kernel_launch: occupancy query says %d\n", per_cu); (void)hipGetLastError(); }
        grid = cus > 256 ? 256 : cus;
    }
    if (grid < 0) return;
    (void)hipMemsetAsync((char*)d_ws + WS_CTL, 0, CTL_BYTES, stream);
    Params P{};
    const float** fp = (const float**)&P;
    P.x = (const float*)d_in[0]; P.p = (const float*)d_in[1]; P.positions = (const int*)d_in[2]; P.norm1_w = (const float*)d_in[3]; P.w_in = (const float*)d_in[4];
    P.w_pool = (const float*)d_in[5]; P.pool_scale = (const float*)d_in[6]; P.q_norm_w = (const float*)d_in[7]; P.k_norm_cmp_w = (const float*)d_in[8];
    P.k_norm_slc_w = (const float*)d_in[9]; P.k_norm_win_w = (const float*)d_in[10]; P.cmp_pos_k = (const float*)d_in[11]; P.cmp_pos_v = (const float*)d_in[12];
    P.cmp_k_w1 = (const float*)d_in[13]; P.cmp_k_w2 = (const float*)d_in[14]; P.cmp_v_w1 = (const float*)d_in[15]; P.cmp_v_w2 = (const float*)d_in[16];
    P.w_o = (const float*)d_in[17]; P.norm2_w = (const float*)d_in[18]; P.w_ffn_in = (const float*)d_in[19]; P.conv_w = (const float*)d_in[20]; P.conv_b = (const float*)d_in[21];
    P.w_ffn_out = (const float*)d_in[22]; P.w_ple_proj = (const float*)d_in[23]; P.ple_norm_w = (const float*)d_in[24]; P.ple_gate_norm_w = (const float*)d_in[25]; P.w_ple_gate = (const float*)d_in[26];
    (void)fp;
    P.out = (float*)d_out; P.ws = (unsigned char*)d_ws;
#if MK_ONE_LAUNCH
    P.ph_lo = 0; P.ph_hi = N_PHASES;
    hipLaunchKernelGGL(fwd, dim3(grid), dim3(NTHREADS), LDS_BYTES, stream, P);
#else
    for (int ph = 0; ph < N_PHASES; ++ph) { P.ph_lo = ph; P.ph_hi = ph + 1; hipLaunchKernelGGL(fwd, dim3(grid), dim3(NTHREADS), LDS_BYTES, stream, P); }
#endif
    const hipError_t le = hipPeekAtLastError();
    if (le != hipSuccess) fprintf(stderr, "kernel_launch: launch failed: %s\n", hipGetErrorName(le));
}
```

```cpp
#include <hip/hip_runtime.h>
#include <cstdio>
#include <cstdint>

#ifndef PROBE_DBL
#define PROBE_DBL 0
#endif
#define REP(k) _Pragma("unroll") for (int rep_ = 0; rep_ < 1 + ((PROBE_DBL >> (k)) & 1); ++rep_)
#ifndef MK_ONE_LAUNCH
#define MK_ONE_LAUNCH 1
#endif

#define LAS __attribute__((address_space(3)))
typedef unsigned short bf16_t;
typedef short bf16x8 __attribute__((ext_vector_type(8)));
typedef short s16x4 __attribute__((ext_vector_type(4)));
typedef float f32x2 __attribute__((ext_vector_type(2)));
typedef float f32x4 __attribute__((ext_vector_type(4)));
typedef float f32x16 __attribute__((ext_vector_type(16)));
typedef unsigned u32x2 __attribute__((ext_vector_type(2)));
typedef unsigned u32x4 __attribute__((ext_vector_type(4)));

constexpr int S_ = 16384, DM = 4096, INW = 7240, LDZ = 7424, POOLW = 1024, NH = 24, NKV = 4, HPG = 6, HD = 128;
constexpr int OFF_Q = 1024, OFF_KV = 4096, OFF_G = 7168, DFF = 11008, NFI = 22016, PLE = 256, NGATE = 72;
constexpr int ZROWS = S_ + 64, XNROWS = S_ + 256, CHUNK = 8192;
constexpr float EPS = 1e-6f;
constexpr float SM_C = 0.08838834764831845f * 1.4426950408889634f;
constexpr int NWAVES = 8, NTHREADS = 512;

constexpr size_t al256(size_t x) { return (x + 255) / 256 * 256; }
constexpr size_t WS_CTL   = 0;
constexpr size_t CTL_BYTES = 262144;
constexpr size_t WS_SSQ1 = WS_CTL + 65536, WS_SSQ2 = WS_CTL + 131072, WS_SSQ3 = WS_CTL + 196608;
constexpr size_t WS_WIN   = WS_CTL + CTL_BYTES;
constexpr size_t WS_WO    = WS_WIN + al256((size_t)LDZ * DM * 2);
constexpr size_t WS_WFI   = WS_WO + al256((size_t)DM * DM * 2);
constexpr size_t WS_WFO   = WS_WFI + al256((size_t)NFI * DM * 2);
constexpr size_t WS_WG    = WS_WFO + al256((size_t)DM * DFF * 2);
constexpr size_t WS_WPLE  = WS_WG + al256((size_t)DM * DM * 2);
constexpr size_t WS_WPOOL = WS_WPLE + al256((size_t)DM * PLE * 2);
constexpr size_t WS_WC1K  = WS_WPOOL + al256((size_t)1024 * 256 * 2);
constexpr size_t WS_WC1V  = WS_WC1K + al256((size_t)256 * 4096 * 2);
constexpr size_t WS_COS   = WS_WC1V + al256((size_t)256 * 4096 * 2);
constexpr size_t WS_SIN   = WS_COS + al256((size_t)S_ * 16 * 4);
constexpr size_t WS_TAB   = WS_SIN + al256((size_t)S_ * 16 * 4);
constexpr size_t WS_XNP   = WS_TAB + 4096;
constexpr size_t WS_XN    = WS_XNP + (size_t)2 * DM * 2;
constexpr size_t WS_PB    = WS_XN + al256((size_t)XNROWS * DM * 2);
constexpr size_t WS_R     = WS_PB + al256((size_t)S_ * PLE * 2);
constexpr size_t WS_Z     = WS_R;
constexpr size_t WS_M     = WS_Z + al256((size_t)ZROWS * LDZ * 2);
constexpr size_t WS_G     = WS_M + al256((size_t)S_ * POOLW * 2);
constexpr size_t WS_H1    = WS_G + al256((size_t)S_ * NGATE * 4);
constexpr size_t WS_KC    = WS_H1 + al256((size_t)8192 * 256 * 4);
constexpr size_t WS_VC    = WS_KC + al256((size_t)4 * 1024 * 128 * 2);
constexpr size_t WS_L     = WS_VC + al256((size_t)4 * 1024 * 128 * 2);
constexpr size_t WS_OACC  = WS_L + al256((size_t)S_ * NH * 4);
constexpr size_t WS_IMPP  = WS_OACC + al256((size_t)S_ * 3072 * 4);
constexpr size_t WS_IMPF  = WS_IMPP + al256((size_t)S_ * 4 * 256 * 4);
constexpr size_t WS_BM    = WS_IMPF + al256((size_t)S_ * 4 * 256 * 4);
constexpr size_t WS_MIX   = WS_BM + al256((size_t)S_ * 4 * 8 * 4);
constexpr size_t WS_END_A = WS_MIX + al256((size_t)S_ * DM * 2);
constexpr size_t WS_ERAW  = WS_R;
constexpr size_t WS_ACT   = WS_ERAW + al256((size_t)S_ * DM * 2);
constexpr size_t WS_ERSTD = WS_ACT + al256((size_t)S_ * DFF * 2);
constexpr size_t WS_END_B = WS_ERSTD + al256((size_t)S_ * 4);
static_assert(WS_ERAW + (size_t)S_ * DM * 2 <= WS_Z + (size_t)ZROWS * LDZ * 2, "eraw must fit inside the dead z region while mix is still being read");
constexpr size_t WS_NEED  = WS_END_A > WS_END_B ? WS_END_A : WS_END_B;
static_assert(WS_MIX >= WS_END_B || true, "");

constexpr int LDS_STAGE = 131072;
constexpr int LDS_MISC  = LDS_STAGE;
constexpr int LDS_XCH   = LDS_STAGE + 64;
constexpr int LDS_BYTES = LDS_XCH + 4096;

__device__ __forceinline__ unsigned cvt_pk_bf16(float lo, float hi) { unsigned r; asm volatile("v_cvt_pk_bf16_f32 %0, %1, %2" : "=v"(r) : "v"(lo), "v"(hi)); return r; }
__device__ __forceinline__ float bf_lo(unsigned u) { return __uint_as_float(u << 16); }
__device__ __forceinline__ float bf_hi(unsigned u) { return __uint_as_float(u & 0xffff0000u); }
__device__ __forceinline__ float bf2f(bf16_t b) { return __uint_as_float(((unsigned)b) << 16); }
__device__ __forceinline__ float wave_sum(float v) {
#pragma unroll
    for (int o = 32; o >= 1; o >>= 1) v += __shfl_xor(v, o);
    return v;
}
__device__ __forceinline__ float wave_max(float v) {
#pragma unroll
    for (int o = 32; o >= 1; o >>= 1) v = fmaxf(v, __shfl_xor(v, o));
    return v;
}
__device__ __forceinline__ float sigmoidf_(float x) { return 1.0f / (1.0f + __expf(-x)); }

#define XB_TMO      128
#define XB_XCNT(j)  (256  + 64 * (j))
#define XB_XSUB(j)  (1280 + 64 * (j))
#define XB_XGEN(j)  (2304 + 64 * (j))
#define XB_TOP      3328
#define XB_TOPGEN   3392
#define XCD_BAR_WORDS 3456
#define XB_SPIN_CAP (1u << 18)
__device__ __forceinline__ unsigned xb_ld(unsigned* p)              { return __hip_atomic_load(p, __ATOMIC_RELAXED, __HIP_MEMORY_SCOPE_AGENT); }
__device__ __forceinline__ unsigned xb_add(unsigned* p, unsigned v) { return __hip_atomic_fetch_add(p, v, __ATOMIC_RELAXED, __HIP_MEMORY_SCOPE_AGENT); }
__device__ __forceinline__ unsigned xb_xcc_id() { return (unsigned)__builtin_amdgcn_s_getreg((3 << 11) | 20) & 0xFu; }
#define XB_SPIN(cond, bar) do { unsigned _sp = 0; while (cond) { __builtin_amdgcn_s_sleep(1); \
    if ((++_sp & 255u) == 0u) { if (xb_ld(&(bar)[XB_TMO])) break; if (_sp > XB_SPIN_CAP) { atomicAdd(&(bar)[XB_TMO], 1u); break; } } } } while (0)
struct XcdBarrier { unsigned* bar; unsigned x; volatile LAS unsigned* st; };
__device__ __forceinline__ XcdBarrier xcd_barrier_post(unsigned* bar, volatile LAS unsigned* st) {
    XcdBarrier b; b.bar = bar; b.x = xb_xcc_id(); b.st = st;
    if (threadIdx.x == 0) (void)xb_add(&bar[XB_XCNT(b.x)], 1u);
    return b;
}
__device__ __forceinline__ void xcd_barrier_complete(unsigned* bar, unsigned x, unsigned& nloc, unsigned& nx) {
    const unsigned G = gridDim.x * gridDim.y * gridDim.z;
    unsigned sum, cnt, mine, sp = 0u;
    for (;;) {
        sum = 0u; cnt = 0u; mine = 0u;
#pragma unroll
        for (unsigned j = 0; j < 16; ++j) { const unsigned c = xb_ld(&bar[XB_XCNT(j)]); sum += c; cnt += (c > 0u) ? 1u : 0u; mine = (j == x) ? c : mine; }
        if (sum == G) break;
        __builtin_amdgcn_s_sleep(1);
        if ((++sp & 255u) == 0u) { if (xb_ld(&bar[XB_TMO])) break; if (sp > XB_SPIN_CAP) { atomicAdd(&bar[XB_TMO], 1u); break; } }
    }
    nloc = mine > 0u ? mine : 1u; nx = cnt > 0u ? cnt : 1u;
}
__device__ __forceinline__ void xcd_barrier(const XcdBarrier& b) {
    asm volatile("s_waitcnt vmcnt(0)" ::: "memory");
    __syncthreads();
    if (threadIdx.x == 0) {
        unsigned* bar = b.bar;
        __builtin_amdgcn_s_waitcnt(0);
        unsigned nloc = b.st[0], nx = b.st[1];
        if (nloc == 0u) { xcd_barrier_complete(bar, b.x, nloc, nx); b.st[0] = nloc; b.st[1] = nx; }
        const unsigned old = xb_add(&bar[XB_XSUB(b.x)], 1u);
        const unsigned gen = old / nloc;
        if (old + 1u == (gen + 1u) * nloc) {
            __builtin_amdgcn_fence(__ATOMIC_RELEASE, "agent");
            asm volatile("s_waitcnt vmcnt(0)" ::: "memory");
            const unsigned og = xb_add(&bar[XB_TOP], 1u);
            const unsigned tg = og / nx;
            if (og + 1u == (tg + 1u) * nx) xb_add(&bar[XB_TOPGEN], 1u);
            else XB_SPIN(xb_ld(&bar[XB_TOPGEN]) == tg, bar);
            __builtin_amdgcn_fence(__ATOMIC_ACQUIRE, "agent");
            xb_add(&bar[XB_XGEN(b.x)], 1u);
            asm volatile("s_waitcnt vmcnt(0)" ::: "memory");
        } else {
            XB_SPIN(xb_ld(&bar[XB_XGEN(b.x)]) == gen, bar);
            __builtin_amdgcn_fence(__ATOMIC_ACQUIRE, "agent");
            asm volatile("s_waitcnt vmcnt(0)" ::: "memory");
        }
    }
    __syncthreads();
}

struct Params {
    const float* x; const float* p; const int* positions; const float* norm1_w; const float* w_in; const float* w_pool; const float* pool_scale;
    const float* q_norm_w; const float* k_norm_cmp_w; const float* k_norm_slc_w; const float* k_norm_win_w; const float* cmp_pos_k; const float* cmp_pos_v;
    const float* cmp_k_w1; const float* cmp_k_w2; const float* cmp_v_w1; const float* cmp_v_w2; const float* w_o; const float* norm2_w; const float* w_ffn_in;
    const float* conv_w; const float* conv_b; const float* w_ffn_out; const float* w_ple_proj; const float* ple_norm_w; const float* ple_gate_norm_w; const float* w_ple_gate;
    float* out; unsigned char* ws; int ph_lo, ph_hi;
};

namespace pg8 {
constexpr int BM = 256, BK = 64, HALF = 128, HTB = HALF * BK * 2, STAGE_BYTES = 8 * HTB, NXCD = 8, WGM = 8;
__host__ __device__ __forceinline__ int lds_byte(int r, int c) { const int st = (r >> 4) * 2 + (c >> 5), rr = r & 15, cc = c & 31, ob = rr * 64 + cc * 2; return st * 1024 + (ob ^ (((ob >> 9) & 1) << 5)); }
__host__ __device__ __forceinline__ void stage_rc(int b, int& R, int& C) { const int st = b / 1024, sb = b % 1024, swz = sb ^ (((sb >> 9) & 1) << 5); R = (st >> 1) * 16 + swz / 64; C = (st & 1) * 32 + (swz % 64) / 2; }
__host__ __device__ __forceinline__ int perm32(int rho) { const int n = rho >> 4, i = rho & 15; return 8 * (i >> 2) + 4 * n + (i & 3); }
struct Unit { int pm, pn; };

struct StaticOrder {
    int nM, nN, nwg, G, c;
    __device__ void init(int nM_, int nN_, int G_, int c_) { nM = nM_; nN = nN_; nwg = nM * nN; G = G_; c = c_; }
    __device__ bool next(int i, Unit& u) const {
        const long L = (long)i * G + c; if (L >= nwg) return false;
        int wgid = (int)L; { const int q = nwg / NXCD, r = nwg % NXCD, xcd = wgid % NXCD, off = wgid / NXCD; wgid = (xcd < r ? xcd * (q + 1) : r * (q + 1) + (xcd - r) * q) + off; }
        const int nig = WGM * nN, gid = wgid / nig, fm = gid * WGM, gsz = (nM - fm) < WGM ? (nM - fm) : WGM;
        u.pm = fm + ((wgid % nig) % gsz); u.pn = (wgid % nig) / gsz; return true;
    }
};

struct GStd {
    const char* A; const char* B; unsigned lda, ldb; int nt;
    __device__ __forceinline__ const char* a_base(const Unit& u) const { return A + (size_t)u.pm * 256 * lda * 2; }
    __device__ __forceinline__ const char* b_base(const Unit& u) const { return B + (size_t)u.pn * 256 * ldb * 2; }
    __device__ __forceinline__ size_t kpairA() const { return 256; }
};
struct GPool {
    const char* A; const char* B; unsigned lda, ldb; int nt;
    __device__ __forceinline__ const char* a_base(const Unit& u) const { return A + (size_t)u.pm * 256 * lda * 2 + (size_t)u.pn * 512; }
    __device__ __forceinline__ const char* b_base(const Unit& u) const { return B + (size_t)u.pn * 256 * ldb * 2; }
    __device__ __forceinline__ size_t kpairA() const { return 256; }
};
struct GCmp {
    const char* Z; const char* Bk; const char* Bv; unsigned lda, ldb; int nt;
    __device__ __forceinline__ const char* a_base(const Unit& u) const { const int which = u.pm >> 4, g = (u.pm >> 2) & 3, rt = u.pm & 3;
        return Z + (size_t)(OFF_KV + which * 512 + g * 128) * 2 + (size_t)rt * 256 * lda * 2; }
    __device__ __forceinline__ const char* b_base(const Unit& u) const { return (u.pm >> 4) ? Bv : Bk; }
    __device__ __forceinline__ size_t kpairA() const { return (size_t)LDZ * 2; }
};

struct EpiBf16 {
    static constexpr bool PERM = true;
    bf16_t* O; int ldc;
    __device__ __forceinline__ void operator()(const f32x4 (&acc)[2][2][4][2], const Unit& u, int wr, int wc, int fr, int fq) const {
        const int row0 = u.pm * BM + wr * 64 + fr, col0 = u.pn * BM + wc * 32 + 8 * fq;
#pragma unroll
        for (int ai = 0; ai < 2; ++ai)
#pragma unroll
            for (int m = 0; m < 4; ++m) { bf16_t* rowp = O + (size_t)(row0 + ai * HALF + m * 16) * ldc + col0;
#pragma unroll
                for (int bj = 0; bj < 2; ++bj) { const f32x4 v0 = acc[ai][bj][m][0], v1 = acc[ai][bj][m][1];
                    u32x4 w; w.x = cvt_pk_bf16(v0[0], v0[1]); w.y = cvt_pk_bf16(v0[2], v0[3]); w.z = cvt_pk_bf16(v1[0], v1[1]); w.w = cvt_pk_bf16(v1[2], v1[3]);
                    *(u32x4*)(rowp + bj * HALF) = w; } }
    }
};
struct EpiBf16Ssq {
    static constexpr bool PERM = true;
    bf16_t* O; int ldc; float* ssq;
    __device__ __forceinline__ void operator()(const f32x4 (&acc)[2][2][4][2], const Unit& u, int wr, int wc, int fr, int fq) const {
        const int row0 = u.pm * BM + wr * 64 + fr, col0 = u.pn * BM + wc * 32 + 8 * fq;
#pragma unroll
        for (int ai = 0; ai < 2; ++ai)
#pragma unroll
            for (int m = 0; m < 4; ++m) { const int row = row0 + ai * HALF + m * 16; bf16_t* rowp = O + (size_t)row * ldc + col0; float s = 0.f;
#pragma unroll
                for (int bj = 0; bj < 2; ++bj) { const f32x4 v0 = acc[ai][bj][m][0], v1 = acc[ai][bj][m][1];
                    s += v0[0] * v0[0] + v0[1] * v0[1] + v0[2] * v0[2] + v0[3] * v0[3] + v1[0] * v1[0] + v1[1] * v1[1] + v1[2] * v1[2] + v1[3] * v1[3];
                    u32x4 w; w.x = cvt_pk_bf16(v0[0], v0[1]); w.y = cvt_pk_bf16(v0[2], v0[3]); w.z = cvt_pk_bf16(v1[0], v1[1]); w.w = cvt_pk_bf16(v1[2], v1[3]);
                    *(u32x4*)(rowp + bj * HALF) = w; }
                s += __shfl_xor(s, 16); s += __shfl_xor(s, 32);
                if (fq == 0) unsafeAtomicAdd(ssq + row, s); }
    }
};
struct EpiBf16Scale {
    static constexpr bool PERM = true;
    bf16_t* O; int ldc; const float* colscale;
    __device__ __forceinline__ void operator()(const f32x4 (&acc)[2][2][4][2], const Unit& u, int wr, int wc, int fr, int fq) const {
        const int row0 = u.pm * BM + wr * 64 + fr, col0 = u.pn * BM + wc * 32 + 8 * fq;
#pragma unroll
        for (int bj = 0; bj < 2; ++bj) { const f32x4 s0 = *(const f32x4*)(colscale + col0 + bj * HALF), s1 = *(const f32x4*)(colscale + col0 + bj * HALF + 4);
#pragma unroll
            for (int ai = 0; ai < 2; ++ai)
#pragma unroll
                for (int m = 0; m < 4; ++m) { bf16_t* rowp = O + (size_t)(row0 + ai * HALF + m * 16) * ldc + col0;
                    const f32x4 v0 = acc[ai][bj][m][0] * s0, v1 = acc[ai][bj][m][1] * s1;
                    u32x4 w; w.x = cvt_pk_bf16(v0[0], v0[1]); w.y = cvt_pk_bf16(v0[2], v0[3]); w.z = cvt_pk_bf16(v1[0], v1[1]); w.w = cvt_pk_bf16(v1[2], v1[3]);
                    *(u32x4*)(rowp + bj * HALF) = w; } }
    }
};
struct EpiResF32 {
    static constexpr bool PERM = false;
    const float* base; float* C; int ldc; int row_off;
    __device__ __forceinline__ void operator()(const f32x4 (&acc)[2][2][4][2], const Unit& u, int wr, int wc, int fr, int fq) const {
        const int row0 = u.pm * BM + wr * 64 + fr + row_off, col0 = u.pn * BM + wc * 32 + 4 * fq;
#pragma unroll
        for (int ai = 0; ai < 2; ++ai)
#pragma unroll
            for (int m = 0; m < 4; ++m) { const size_t off = (size_t)(row0 + ai * HALF + m * 16) * ldc + col0;
#pragma unroll
                for (int bj = 0; bj < 2; ++bj)
#pragma unroll
                    for (int n = 0; n < 2; ++n) { const f32x4 b = *(const f32x4*)(base + off + bj * HALF + n * 16); *(f32x4*)(C + off + bj * HALF + n * 16) = b + acc[ai][bj][m][n]; }
                asm volatile("" ::: "memory"); }
    }
};
struct EpiResNorm {
    static constexpr bool PERM = false;
    const float* base; float* C; bf16_t* XN; const float* nw; float* ssq; int ldc;
    __device__ __forceinline__ void operator()(const f32x4 (&acc)[2][2][4][2], const Unit& u, int wr, int wc, int fr, int fq) const {
        const int row0 = u.pm * BM + wr * 64 + fr, col0 = u.pn * BM + wc * 32 + 4 * fq;
        f32x4 wv[2][2];
#pragma unroll
        for (int bj = 0; bj < 2; ++bj)
#pragma unroll
            for (int n = 0; n < 2; ++n) wv[bj][n] = *(const f32x4*)(nw + col0 + bj * HALF + n * 16);
        f32x4 bv[2][2][2];
#pragma unroll
        for (int bj = 0; bj < 2; ++bj)
#pragma unroll
            for (int n = 0; n < 2; ++n) bv[0][bj][n] = *(const f32x4*)(base + (size_t)row0 * ldc + col0 + bj * HALF + n * 16);
#pragma unroll
        for (int rg = 0; rg < 8; ++rg) { const int ai = rg >> 2, m = rg & 3; const int row = row0 + ai * HALF + m * 16; const size_t off = (size_t)row * ldc + col0;
            if (rg < 7) { const int ai2 = (rg + 1) >> 2, m2 = (rg + 1) & 3; const size_t off2 = (size_t)(row0 + ai2 * HALF + m2 * 16) * ldc + col0;
#pragma unroll
                for (int bj = 0; bj < 2; ++bj)
#pragma unroll
                    for (int n = 0; n < 2; ++n) bv[(rg + 1) & 1][bj][n] = *(const f32x4*)(base + off2 + bj * HALF + n * 16); }
            float s = 0.f;
#pragma unroll
            for (int bj = 0; bj < 2; ++bj)
#pragma unroll
                for (int n = 0; n < 2; ++n) { const f32x4 v = bv[rg & 1][bj][n] + acc[ai][bj][m][n];
                    *(f32x4*)(C + off + bj * HALF + n * 16) = v; s += v[0] * v[0] + v[1] * v[1] + v[2] * v[2] + v[3] * v[3];
                    u32x2 o; o.x = cvt_pk_bf16(v[0] * wv[bj][n][0], v[1] * wv[bj][n][1]); o.y = cvt_pk_bf16(v[2] * wv[bj][n][2], v[3] * wv[bj][n][3]);
                    *(u32x2*)(XN + off + bj * HALF + n * 16) = o; }
            s += __shfl_xor(s, 16); s += __shfl_xor(s, 32);
            if (fq == 0) unsafeAtomicAdd(ssq + row, s);
        }
    }
};
struct EpiCmpGelu {
    static constexpr bool PERM = false;
    float* H; const float* bias;
    __device__ __forceinline__ void operator()(const f32x4 (&acc)[2][2][4][2], const Unit& u, int wr, int wc, int fr, int fq) const {
        const int row0 = u.pm * BM + wr * 64 + fr, col0 = wc * 32 + 4 * fq; const float* bs = bias + (u.pm >> 4) * 256;
        f32x4 bvv[2][2];
#pragma unroll
        for (int bj = 0; bj < 2; ++bj)
#pragma unroll
            for (int n = 0; n < 2; ++n) bvv[bj][n] = *(const f32x4*)(bs + col0 + bj * HALF + n * 16);
#pragma unroll
        for (int ai = 0; ai < 2; ++ai)
#pragma unroll
            for (int m = 0; m < 4; ++m) { float* rowp = H + (size_t)(row0 + ai * HALF + m * 16) * 256 + col0;
#pragma unroll
                for (int bj = 0; bj < 2; ++bj)
#pragma unroll
                    for (int n = 0; n < 2; ++n) { f32x4 v = acc[ai][bj][m][n] + bvv[bj][n];
#pragma unroll
                        for (int j = 0; j < 4; ++j) { const float xx = v[j], uu = 0.7978845608028654f * (xx + 0.044715f * xx * xx * xx); const float th = 1.0f - 2.0f / (1.0f + __expf(2.0f * uu)); v[j] = 0.5f * xx * (1.0f + th); }
                        *(f32x4*)(rowp + bj * HALF + n * 16) = v; } }
    }
};
struct EpiGate {
    static constexpr bool PERM = false;
    float* C; const bf16_t* eraw; const float* erstd; const float* pw; const float* ssq; int ldc;
    __device__ __forceinline__ void operator()(const f32x4 (&acc)[2][2][4][2], const Unit& u, int wr, int wc, int fr, int fq) const {
        const int row0 = u.pm * BM + wr * 64 + fr, col0 = u.pn * BM + wc * 32 + 4 * fq;
        f32x4 wv[2][2];
#pragma unroll
        for (int bj = 0; bj < 2; ++bj)
#pragma unroll
            for (int n = 0; n < 2; ++n) wv[bj][n] = *(const f32x4*)(pw + col0 + bj * HALF + n * 16);
        f32x4 bv[2][2][2]; u32x2 ev[2][2][2]; float rsv[2], rgv[2];
#pragma unroll
        for (int bj = 0; bj < 2; ++bj)
#pragma unroll
            for (int n = 0; n < 2; ++n) { bv[0][bj][n] = *(const f32x4*)(C + (size_t)row0 * ldc + col0 + bj * HALF + n * 16); ev[0][bj][n] = *(const u32x2*)(eraw + (size_t)row0 * ldc + col0 + bj * HALF + n * 16); }
        rsv[0] = erstd[row0]; rgv[0] = ssq[row0];
#pragma unroll
        for (int rg = 0; rg < 8; ++rg) { const int ai = rg >> 2, m = rg & 3; const int row = row0 + ai * HALF + m * 16; const size_t off = (size_t)row * ldc + col0;
            if (rg < 7) { const int ai2 = (rg + 1) >> 2, m2 = (rg + 1) & 3; const int row2 = row0 + ai2 * HALF + m2 * 16; const size_t off2 = (size_t)row2 * ldc + col0;
#pragma unroll
                for (int bj = 0; bj < 2; ++bj)
#pragma unroll
                    for (int n = 0; n < 2; ++n) { bv[(rg + 1) & 1][bj][n] = *(const f32x4*)(C + off2 + bj * HALF + n * 16); ev[(rg + 1) & 1][bj][n] = *(const u32x2*)(eraw + off2 + bj * HALF + n * 16); }
                rsv[(rg + 1) & 1] = erstd[row2]; rgv[(rg + 1) & 1] = ssq[row2]; }
            const float rs = rsqrtf(rsv[rg & 1] * (1.0f / DM) + EPS), rg_ = rsqrtf(rgv[rg & 1] * (1.0f / DM) + EPS);
#pragma unroll
            for (int bj = 0; bj < 2; ++bj)
#pragma unroll
                for (int n = 0; n < 2; ++n) { const f32x4 b = bv[rg & 1][bj][n]; const u32x2 e = ev[rg & 1][bj][n]; const f32x4 a = acc[ai][bj][m][n]; f32x4 o;
                    o[0] = b[0] + bf_lo(e.x) * rs * wv[bj][n][0] * sigmoidf_(a[0] * rg_); o[1] = b[1] + bf_hi(e.x) * rs * wv[bj][n][1] * sigmoidf_(a[1] * rg_);
                    o[2] = b[2] + bf_lo(e.y) * rs * wv[bj][n][2] * sigmoidf_(a[2] * rg_); o[3] = b[3] + bf_hi(e.y) * rs * wv[bj][n][3] * sigmoidf_(a[3] * rg_);
                    *(f32x4*)(C + off + bj * HALF + n * 16) = o; }
        }
    }
};
struct GFfn {
    const char* A; const char* B; unsigned lda, ldb; int nt;
    __device__ __forceinline__ const char* a_base(const Unit& u) const { return A + ((long)u.pm * 254 - 2) * (long)lda * 2; }
    __device__ __forceinline__ const char* b_base(const Unit& u) const { return B + (size_t)u.pn * 256 * ldb * 2; }
    __device__ __forceinline__ size_t kpairA() const { return 256; }
};
template <int CTRL> __device__ __forceinline__ float dpp_f(float v) { return __int_as_float(__builtin_amdgcn_update_dpp(0, __float_as_int(v), CTRL, 0xf, 0xf, false)); }
struct EpiFfn {
    static constexpr bool PERM = true;
    bf16_t* ACT; const float* cw; const float* cb; LAS float* X; const float* ssq;
    __device__ __forceinline__ void operator()(const f32x4 (&acc)[2][2][4][2], const Unit& u, int wr, int wc, int fr, int fq) const {
        const int colw = wc * 32 + 8 * fq;
        float rsv[2][4];
#pragma unroll
        for (int ai = 0; ai < 2; ++ai)
#pragma unroll
            for (int m = 0; m < 4; ++m) { const long t = (long)u.pm * 254 - 2 + ai * HALF + wr * 64 + m * 16 + fr; rsv[ai][m] = (t >= 0 && t < S_) ? rsqrtf(ssq[t] * (1.0f / DM) + EPS) : 0.f; }
        if (fr >= 14) {
#pragma unroll
            for (int ai = 0; ai < 2; ++ai)
#pragma unroll
                for (int n = 0; n < 2; ++n) *(LAS f32x4*)(X + ((2 * ai + wr) * 2 + (fr - 14)) * 128 + colw + 4 * n) = acc[ai][0][3][n] * rsv[ai][3];
        }
        asm volatile("s_waitcnt lgkmcnt(0)" ::: "memory");
        __builtin_amdgcn_s_barrier(); asm volatile("" ::: "memory");
        __builtin_amdgcn_s_barrier(); asm volatile("" ::: "memory");
        const int f0 = u.pn * 128 + colw;
        f32x4 w0[2], w1[2], w2[2], cbv[2];
#pragma unroll
        for (int n = 0; n < 2; ++n) { w0[n] = *(const f32x4*)(cw + f0 + 4 * n); w1[n] = *(const f32x4*)(cw + DFF + f0 + 4 * n); w2[n] = *(const f32x4*)(cw + 2 * DFF + f0 + 4 * n); cbv[n] = *(const f32x4*)(cb + f0 + 4 * n); }
#pragma unroll
        for (int ai = 0; ai < 2; ++ai) {
            f32x4 pv[2];
            const int pseg = 2 * ai + wr - 1;
#pragma unroll
            for (int n = 0; n < 2; ++n) { pv[n] = (f32x4){0.f, 0.f, 0.f, 0.f}; if (pseg >= 0 && fr >= 14) pv[n] = *(const LAS f32x4*)(X + (pseg * 2 + (fr - 14)) * 128 + colw + 4 * n); }
#pragma unroll
            for (int m = 0; m < 4; ++m) {
                const int r = ai * HALF + wr * 64 + m * 16 + fr; const long t = (long)u.pm * 254 - 2 + r;
                unsigned ow[4];
#pragma unroll
                for (int n = 0; n < 2; ++n) {
                    const f32x4 cur = acc[ai][0][m][n] * rsv[ai][m], up = acc[ai][1][m][n] * rsv[ai][m]; f32x4 o;
#pragma unroll
                    for (int i = 0; i < 4; ++i) {
                        const float c1 = dpp_f<0x121>(cur[i]), p1 = dpp_f<0x121>(pv[n][i]), c2 = dpp_f<0x122>(cur[i]), p2 = dpp_f<0x122>(pv[n][i]);
                        const float x1 = fr >= 1 ? c1 : p1, x2 = fr >= 2 ? c2 : p2;
                        const float y = cbv[n][i] + w0[n][i] * x2 + w1[n][i] * x1 + w2[n][i] * cur[i];
                        o[i] = y * sigmoidf_(y) * up[i];
                    }
                    ow[2 * n] = cvt_pk_bf16(o[0], o[1]); ow[2 * n + 1] = cvt_pk_bf16(o[2], o[3]);
                    pv[n] = cur;
                }
                if (r >= 2 && t < S_) *(u32x4*)(ACT + (size_t)t * DFF + f0) = (u32x4){ow[0], ow[1], ow[2], ow[3]};
            }
        }
    }
};

template <class GD, class Epi>
__device__ __forceinline__ void gemm_phase(LAS unsigned char* lds, const GD g, const StaticOrder& S, const Epi& E) {
    const int tid = threadIdx.x, wid = __builtin_amdgcn_readfirstlane(tid >> 6), lane = tid & 63, wr = wid >> 2, wc = wid & 3, fr = lane & 15, fq = lane >> 4;
    const int nt = g.nt;
    unsigned voffA[2], voffB[2];
#pragma unroll
    for (int i = 0; i < 2; ++i) { int R, C; stage_rc(tid * 16 + i * 8192, R, C); const int Rb = Epi::PERM ? ((R & ~31) + perm32(R & 31)) : R;
        voffA[i] = (unsigned)(R * g.lda + C) * 2u; voffB[i] = (unsigned)(Rb * g.ldb + C) * 2u; }
    const size_t kpA = g.kpairA();
    const size_t hstepA = (size_t)HALF * g.lda * 2, hstepB = (size_t)HALF * g.ldb * 2;
    const unsigned ldsw = (unsigned)wid * 1024u;
    const int aoff = lds_byte(wr * 64 + fr, fq * 8), boff = lds_byte(wc * 32 + fr, fq * 8);
#define PG8_SA(b, h) (((b) * 2 + (h)) * HTB)
#define PG8_SB(b, h) ((4 + (b) * 2 + (h)) * HTB)
#define PG8_STAGE(bufoff, gbase, voff) do { _Pragma("unroll") for (int _i = 0; _i < 2; ++_i) \
        __builtin_amdgcn_global_load_lds((const unsigned*)((const char*)(gbase) + (voff)[_i]), (LAS unsigned*)(lds + (bufoff) + ldsw + _i * 8192), 16, 0, 0); } while (0)
#define PG8_LDA(dst, b, h) do { _Pragma("unroll") for (int m = 0; m < 4; ++m) _Pragma("unroll") for (int k = 0; k < 2; ++k) dst[m][k] = *(const LAS bf16x8*)(lds + PG8_SA(b, h) + aoff + m * 2048 + k * 1024); } while (0)
#define PG8_LDB(dst, b, h) do { _Pragma("unroll") for (int n = 0; n < 2; ++n) _Pragma("unroll") for (int k = 0; k < 2; ++k) dst[n][k] = *(const LAS bf16x8*)(lds + PG8_SB(b, h) + boff + n * 2048 + k * 1024); } while (0)
#define PG8_MMA(ai, bj, At, Bt) do { __builtin_amdgcn_s_setprio(1); _Pragma("unroll") for (int m = 0; m < 4; ++m) _Pragma("unroll") for (int n = 0; n < 2; ++n) _Pragma("unroll") for (int k = 0; k < 2; ++k) \
        acc[ai][bj][m][n] = __builtin_amdgcn_mfma_f32_16x16x32_bf16(Bt[n][k], At[m][k], acc[ai][bj][m][n], 0, 0, 0); __builtin_amdgcn_s_setprio(0); } while (0)
#define PG8_WAIT_V(n) asm volatile("s_waitcnt vmcnt(" #n ")" ::: "memory")
#define PG8_WAIT_L(n) asm volatile("s_waitcnt lgkmcnt(" #n ")" ::: "memory")
#define PG8_BAR __builtin_amdgcn_s_barrier()
#define PG8_SCHED __builtin_amdgcn_sched_barrier(0)
    Unit cur, nxt; int ui = 0;
    if (!S.next(0, cur)) return;
    f32x4 acc[2][2][4][2];
#pragma unroll
    for (int a = 0; a < 2; ++a)
#pragma unroll
        for (int b = 0; b < 2; ++b)
#pragma unroll
            for (int m = 0; m < 4; ++m)
#pragma unroll
                for (int n = 0; n < 2; ++n) acc[a][b][m][n] = (f32x4){0.f, 0.f, 0.f, 0.f};
    bf16x8 At[4][2], B0[2][2], B1[2][2];
    const char* cA = g.a_base(cur); const char* cB = g.b_base(cur);
    PG8_STAGE(PG8_SB(0, 0), cB, voffB); PG8_STAGE(PG8_SA(0, 0), cA, voffA); PG8_STAGE(PG8_SB(0, 1), cB + hstepB, voffB); PG8_STAGE(PG8_SA(0, 1), cA + hstepA, voffA);
    if (wr == 1) PG8_BAR;
    PG8_WAIT_V(4); PG8_BAR;
    PG8_STAGE(PG8_SB(1, 0), cB + 128, voffB); PG8_STAGE(PG8_SA(1, 0), cA + 128, voffA); PG8_STAGE(PG8_SB(1, 1), cB + hstepB + 128, voffB);
    PG8_WAIT_V(6); PG8_BAR;
    for (;;) {
        const bool has_next = S.next(ui + 1, nxt);
        const char* nA = has_next ? g.a_base(nxt) : cA; const char* nB = has_next ? g.b_base(nxt) : cB;
        for (int t = 0; t < nt; t += 2) {
            const bool last = (t == nt - 2);
            const char* a0 = cA + (size_t)(t >> 1) * kpA;
            const char* a1 = a0 + 128;
            const char* a2 = last ? nA : a0 + kpA; const char* b2 = last ? nB : cB + (size_t)(t + 2) * 128;
            const char* a3 = a2 + 128; const char* b3 = b2 + 128;
            PG8_LDB(B0, 0, 0); PG8_SCHED; PG8_LDA(At, 0, 0); PG8_STAGE(PG8_SA(1, 1), a1 + hstepA, voffA);
            PG8_WAIT_L(8); PG8_BAR; PG8_WAIT_L(0); PG8_MMA(0, 0, At, B0); PG8_BAR; PG8_SCHED;
            PG8_LDB(B1, 0, 1); PG8_STAGE(PG8_SB(0, 0), b2, voffB);
            PG8_BAR; PG8_WAIT_L(0); PG8_MMA(0, 1, At, B1); PG8_BAR;
            PG8_LDA(At, 0, 1); PG8_STAGE(PG8_SA(0, 0), a2, voffA);
            PG8_BAR; PG8_WAIT_L(0); PG8_MMA(1, 0, At, B0); PG8_BAR; PG8_SCHED;
            PG8_STAGE(PG8_SB(0, 1), b2 + hstepB, voffB);
            PG8_WAIT_V(6); PG8_BAR; PG8_MMA(1, 1, At, B1); PG8_BAR;
            PG8_LDB(B0, 1, 0); PG8_SCHED; PG8_LDA(At, 1, 0); PG8_STAGE(PG8_SA(0, 1), a2 + hstepA, voffA);
            PG8_WAIT_L(8); PG8_BAR; PG8_WAIT_L(0); PG8_MMA(0, 0, At, B0); PG8_BAR; PG8_SCHED;
            PG8_LDB(B1, 1, 1); PG8_STAGE(PG8_SB(1, 0), b3, voffB);
            PG8_BAR; PG8_WAIT_L(0); PG8_MMA(0, 1, At, B1); PG8_BAR;
            PG8_LDA(At, 1, 1); PG8_STAGE(PG8_SA(1, 0), a3, voffA);
            PG8_BAR; PG8_WAIT_L(0); PG8_MMA(1, 0, At, B0); PG8_BAR; PG8_SCHED;
            PG8_STAGE(PG8_SB(1, 1), b3 + hstepB, voffB);
            PG8_WAIT_V(6); PG8_BAR; PG8_MMA(1, 1, At, B1); PG8_BAR;
        }
        E(acc, cur, wr, wc, fr, fq);
        if (!has_next) break;
#pragma unroll
        for (int a = 0; a < 2; ++a)
#pragma unroll
            for (int b = 0; b < 2; ++b)
#pragma unroll
                for (int m = 0; m < 4; ++m)
#pragma unroll
                    for (int n = 0; n < 2; ++n) acc[a][b][m][n] = (f32x4){0.f, 0.f, 0.f, 0.f};
        cur = nxt; cA = nA; cB = nB; ++ui;
    }
    PG8_WAIT_V(0);
    if (wr == 0) PG8_BAR;
    PG8_BAR;
#undef PG8_SA
#undef PG8_SB
#undef PG8_STAGE
#undef PG8_LDA
#undef PG8_LDB
#undef PG8_MMA
#undef PG8_WAIT_V
#undef PG8_WAIT_L
#undef PG8_BAR
#undef PG8_SCHED
}
}

namespace att {
constexpr int KVBLK = 64;
constexpr int SHM_V = KVBLK * HD * 2, SHM_K = KVBLK * HD * 2, SHM_ATTN = 2 * SHM_V + 2 * SHM_K + NWAVES * 64 * 4;
#define KSWZ(row, colB) ((row) * 256 + ((colB) ^ (((row) & 7) << 4)))
#define SBAR() __builtin_amdgcn_sched_barrier(0)
__device__ __forceinline__ int crow(int r, int hi) { return (r & 3) + 8 * (r >> 2) + 4 * hi; }
__device__ __forceinline__ void qkt(f32x16& p0, f32x16& p1, const char* Ks, const bf16x8* qr, int r32, int hi) {
    p0 = f32x16{}; p1 = f32x16{};
    bf16x8 ka[2], kb[2];
    { const int cb = (hi * 8) * 2; ka[0] = *reinterpret_cast<const bf16x8*>(Ks + KSWZ(r32, cb)); kb[0] = *reinterpret_cast<const bf16x8*>(Ks + KSWZ(32 + r32, cb)); }
#pragma unroll
    for (int d0 = 0; d0 < 8; ++d0) {
        if (d0 < 7) { const int cb = ((d0 + 1) * 16 + hi * 8) * 2;
            ka[(d0 + 1) & 1] = *reinterpret_cast<const bf16x8*>(Ks + KSWZ(r32, cb)); kb[(d0 + 1) & 1] = *reinterpret_cast<const bf16x8*>(Ks + KSWZ(32 + r32, cb)); }
        SBAR();
        p0 = __builtin_amdgcn_mfma_f32_32x32x16_bf16(ka[d0 & 1], qr[d0], p0, 0, 0, 0);
        p1 = __builtin_amdgcn_mfma_f32_32x32x16_bf16(kb[d0 & 1], qr[d0], p1, 0, 0, 0);
        SBAR();
    }
}
__device__ __forceinline__ int v_st(int k, int c) { const int kk = (k & ~0xC) | ((k & 4) << 1) | ((k & 8) >> 1); return ((kk >> 3) * 4 + (c >> 5)) * 512 + ((kk & 7) * 32 + (c & 31)) * 2; }
__device__ __forceinline__ int v_rd_base(int lane) { return ((lane & 3) << 3) | (((lane >> 2) & 3) << 6) | (((lane >> 4) & 1) << 5) | (((lane >> 5) & 1) << 8); }
constexpr int v_rd_off(int d0, int ks, int half) { return d0 * 512 + ks * 4096 + half * 2048; }
__device__ __forceinline__ s16x4 tr_read(int vb, int off) { return __builtin_amdgcn_ds_read_tr16_b64_v4i16((LAS s16x4*)(unsigned long)(unsigned)(vb + off)); }
__device__ __forceinline__ void pv_d0(f32x16* o, int vb, bf16x8 pa0, bf16x8 pa1, bf16x8 pa2, bf16x8 pa3) {
    s16x4 L[2][4], H[2][4];
#pragma unroll
    for (int d0 = 0; d0 < 4; ++d0) { L[0][d0] = tr_read(vb, v_rd_off(d0, 0, 0)); H[0][d0] = tr_read(vb, v_rd_off(d0, 0, 1)); }
#pragma unroll
    for (int ks = 0; ks < 4; ++ks) {
        if (ks < 3) {
#pragma unroll
            for (int d0 = 0; d0 < 4; ++d0) { L[(ks + 1) & 1][d0] = tr_read(vb, v_rd_off(d0, ks + 1, 0)); H[(ks + 1) & 1][d0] = tr_read(vb, v_rd_off(d0, ks + 1, 1)); }
        }
        const bf16x8 pa = ks == 0 ? pa0 : (ks == 1 ? pa1 : (ks == 2 ? pa2 : pa3));
#pragma unroll
        for (int d0 = 0; d0 < 4; ++d0) { const s16x4 l = L[ks & 1][d0], h = H[ks & 1][d0];
            o[d0] = __builtin_amdgcn_mfma_f32_32x32x16_bf16(pa, (bf16x8){l[0], l[1], l[2], l[3], h[0], h[1], h[2], h[3]}, o[d0], 0, 0, 0); }
    }
}
__device__ __forceinline__ void pack_p(const f32x16& p0, const f32x16& p1, bf16x8& pa0, bf16x8& pa1, bf16x8& pa2, bf16x8& pa3) {
#define PK4(P, BASE, OUT) do { unsigned a0 = cvt_pk_bf16(P[BASE + 0], P[BASE + 1]), a1 = cvt_pk_bf16(P[BASE + 2], P[BASE + 3]);   \
    unsigned b0 = cvt_pk_bf16(P[BASE + 4], P[BASE + 5]), b1 = cvt_pk_bf16(P[BASE + 6], P[BASE + 7]);                              \
    auto r0 = __builtin_amdgcn_permlane32_swap(a0, b0, false, false); auto r1 = __builtin_amdgcn_permlane32_swap(a1, b1, false, false); \
    u32x4 w = {r0[0], r1[0], r0[1], r1[1]}; OUT = *reinterpret_cast<bf16x8*>(&w); } while (0)
    PK4(p0, 0, pa0); PK4(p0, 8, pa1); PK4(p1, 0, pa2); PK4(p1, 8, pa3);
#undef PK4
}

__device__ __forceinline__ void pack_half(const f32x16& p, bf16x8& paA, bf16x8& paB) {
#define PK4(P, BASE, OUT) do { unsigned a0 = cvt_pk_bf16(P[BASE + 0], P[BASE + 1]), a1 = cvt_pk_bf16(P[BASE + 2], P[BASE + 3]);   \
    unsigned b0 = cvt_pk_bf16(P[BASE + 4], P[BASE + 5]), b1 = cvt_pk_bf16(P[BASE + 6], P[BASE + 7]);                              \
    auto r0 = __builtin_amdgcn_permlane32_swap(a0, b0, false, false); auto r1 = __builtin_amdgcn_permlane32_swap(a1, b1, false, false); \
    u32x4 w = {r0[0], r1[0], r0[1], r1[1]}; OUT = *reinterpret_cast<bf16x8*>(&w); } while (0)
    PK4(p, 0, paA); PK4(p, 8, paB);
#undef PK4
}
template <int KS0, bool WITH_EXP>
__device__ __forceinline__ void pv_half(f32x16* o, int vb, bf16x8 paA, bf16x8 paB, f32x16& px, float off) {
    s16x4 L[2][4], H[2][4];
#pragma unroll
    for (int d0 = 0; d0 < 4; ++d0) { L[0][d0] = tr_read(vb, v_rd_off(d0, KS0, 0)); H[0][d0] = tr_read(vb, v_rd_off(d0, KS0, 1)); }
#pragma unroll
    for (int d0 = 0; d0 < 4; ++d0) { L[1][d0] = tr_read(vb, v_rd_off(d0, KS0 + 1, 0)); H[1][d0] = tr_read(vb, v_rd_off(d0, KS0 + 1, 1)); }
#pragma unroll
    for (int kk = 0; kk < 2; ++kk) {
        const bf16x8 pa = kk == 0 ? paA : paB;
#pragma unroll
        for (int d0 = 0; d0 < 4; ++d0) { const s16x4 l = L[kk][d0], h = H[kk][d0];
            if (WITH_EXP) SBAR();
            o[d0] = __builtin_amdgcn_mfma_f32_32x32x16_bf16(pa, (bf16x8){l[0], l[1], l[2], l[3], h[0], h[1], h[2], h[3]}, o[d0], 0, 0, 0);
            if (WITH_EXP) {
#pragma unroll
                for (int q = 0; q < 2; ++q) { const int r = (kk * 4 + d0) * 2 + q; px[r] = __builtin_amdgcn_exp2f(fmaf(px[r], SM_C, off)); }
                SBAR(); }
        }
    }
}
enum { MODE_CMP = 0, MODE_WIN = 1, MODE_SLC = 2 };
struct AttnArgs {
    const bf16_t* Z; const bf16_t* KC; const bf16_t* VC; const float* G; float* L; float* OACC; bf16_t* MIX; const unsigned* BM; const float* TAB;
};
template <int MODE>
__device__ __forceinline__ void attn_unit(const AttnArgs& a, LAS char* ldsL, int qt, int g, int hp) {
    char* lds = (char*)ldsL;
    const int tid = threadIdx.x, wid = __builtin_amdgcn_readfirstlane(tid >> 6), lane = tid & 63, r32 = lane & 31, hi = lane >> 5;
    float* li_l = (float*)(lds + LDS_XCH) + wid * 64;
    const int t0 = MODE == MODE_SLC ? qt * 40 : qt * 128;
    const int tq_raw = MODE == MODE_SLC ? t0 + wid * 5 + r32 / 6 : t0 + wid * 16 + (r32 & 15);
    const bool rvalid = MODE == MODE_SLC ? (r32 < 30 && tq_raw < S_) : true;
    const int tq = tq_raw < S_ ? tq_raw : S_ - 1;
    const int hq = MODE == MODE_SLC ? g * HPG + r32 % 6 : g * HPG + hp * 2 + (r32 >> 4);
    const int tlast = MODE == MODE_SLC ? ((t0 + 39) < S_ ? (t0 + 39) : S_ - 1) : t0 + 127;
    const bf16_t* Kb; const bf16_t* Vb; long ldk;
    if (MODE == MODE_CMP) { Kb = a.KC + (size_t)g * 1024 * HD; Vb = a.VC + (size_t)g * 1024 * HD; ldk = HD; }
    else if (MODE == MODE_WIN) { Kb = a.Z + OFF_KV + 4 * 512 + g * HD; Vb = a.Z + OFF_KV + 5 * 512 + g * HD; ldk = LDZ; }
    else { Kb = a.Z + OFF_KV + 2 * 512 + g * HD; Vb = a.Z + OFF_KV + 3 * 512 + g * HD; ldk = LDZ; }
    int j0, j1;
    if (MODE == MODE_CMP) { j0 = 0; j1 = (((t0 + 127 - 31) >> 4) >> 6) + 1; }
    else if (MODE == MODE_WIN) { j0 = (t0 - 511) > 0 ? ((t0 - 511) >> 6) : 0; j1 = ((t0 + 127) >> 6) + 1; }
    else { j0 = 0; j1 = (tlast >> 6) + 1; }
    int klo, khi;
    if (MODE == MODE_CMP) { klo = 0; khi = tq >= 31 ? ((tq - 31) >> 4) : -1; }
    else if (MODE == MODE_WIN) { klo = tq - 511; khi = tq; }
    else { klo = 0; khi = rvalid ? tq : -1; }
    float negBC = -a.TAB[512 + (MODE == MODE_CMP ? 0 : (MODE == MODE_SLC ? 1 : 2))];
    bf16x8 qr[8];
    { const bf16_t* Qw = a.Z + (size_t)tq * LDZ + OFF_Q + hq * HD + hi * 8;
#pragma unroll
      for (int d0 = 0; d0 < 8; ++d0) qr[d0] = *reinterpret_cast<const bf16x8*>(Qw + d0 * 16); }
    f32x16 o[4] = {}; float lsum = 0.f;
    unsigned soK[2], soV[2];
#pragma unroll
    for (int i = 0; i < 2; ++i) { const int p = (wid + 8 * i) * 64 + lane;
        { const int row = p >> 4, c = (p & 15) ^ (row & 7); soK[i] = (unsigned)(row * ldk + c * 8) * 2u; }
        { const int sub = p >> 5, within = p & 31, kk = (sub >> 2) * 8 + (within >> 2), c = (sub & 3) * 32 + (within & 3) * 8, k = (kk & ~0xC) | ((kk & 4) << 1) | ((kk & 8) >> 1);
          soV[i] = (unsigned)(k * ldk + c) * 2u; } }
    const int vb0 = (int)(uintptr_t)(LAS char*)ldsL + 16384 + v_rd_base(lane);
#define ISSUE(jt) do { const int _b = ((jt) - j0) & 3; const char* _kp = (const char*)Kb + (size_t)(jt) * KVBLK * ldk * 2; const char* _vp = (const char*)Vb + (size_t)(jt) * KVBLK * ldk * 2; \
    _Pragma("unroll") for (int _i = 0; _i < 2; ++_i) { \
        __builtin_amdgcn_global_load_lds((const unsigned*)(_kp + soK[_i]), (LAS unsigned*)(ldsL + _b * 32768 + (wid + 8 * _i) * 1024), 16, 0, 0); \
        __builtin_amdgcn_global_load_lds((const unsigned*)(_vp + soV[_i]), (LAS unsigned*)(ldsL + _b * 32768 + 16384 + (wid + 8 * _i) * 1024), 16, 0, 0); } } while (0)
    unsigned bmw = 0u;
    if (MODE == MODE_SLC) bmw = a.BM[((size_t)tq * 4 + g) * 8];
    asm volatile("s_waitcnt lgkmcnt(0)" ::: "memory");
    __builtin_amdgcn_s_barrier();
    asm volatile("" ::: "memory");
    ISSUE(j0);
    asm volatile("s_waitcnt vmcnt(4) lgkmcnt(0)" : "+v"(bmw), "+v"(negBC), "+v"(qr[0]), "+v"(qr[1]), "+v"(qr[2]), "+v"(qr[3]), "+v"(qr[4]), "+v"(qr[5]), "+v"(qr[6]), "+v"(qr[7]) :: "memory");
    if (j0 + 1 < j1) ISSUE(j0 + 1); if (j0 + 2 < j1) ISSUE(j0 + 2);
    for (int j = j0; j < j1; ++j) {
        const int buf = (j - j0) & 3;
        if (j + 2 < j1) asm volatile("s_waitcnt vmcnt(8)" ::: "memory"); else if (j + 1 < j1) asm volatile("s_waitcnt vmcnt(4)" ::: "memory"); else asm volatile("s_waitcnt vmcnt(0)" ::: "memory");
        __builtin_amdgcn_s_barrier();
        asm volatile("" ::: "memory");
        if (j + 3 < j1) ISSUE(j + 3);
        int lhi = khi;
        if (MODE == MODE_SLC) { if (!((bmw >> (j & 31)) & 1u)) lhi = -1; }
        const int kb = j * KVBLK;
        const bool l_any = (kb + 63 >= klo) && (kb <= lhi);
        const bool l_full = (kb >= klo) && (kb + 63 <= lhi);
        if (__any(l_any)) {
            f32x16 p0, p1;
            qkt(p0, p1, lds + buf * 32768, qr, r32, hi);
            const bool uni = __all(l_full || !l_any);
            const float off = (uni && !l_any) ? -1.0e30f : negBC;
#pragma unroll
            for (int r = 0; r < 16; ++r) p0[r] = __builtin_amdgcn_exp2f(fmaf(p0[r], SM_C, off));
            if (!uni) {
#pragma unroll
                for (int r = 0; r < 16; ++r) { const int k0i = kb + crow(r, hi); p0[r] = (k0i >= klo && k0i <= lhi) ? p0[r] : 0.f; } }
            float ps = 0.f;
#pragma unroll
            for (int r = 0; r < 16; ++r) ps += p0[r];
            bf16x8 pa0, pa1, pa2, pa3; pack_half(p0, pa0, pa1);
            pv_half<0, true>(o, vb0 + buf * 32768, pa0, pa1, p1, off);
            if (!uni) {
#pragma unroll
                for (int r = 0; r < 16; ++r) { const int k1i = kb + 32 + crow(r, hi); p1[r] = (k1i >= klo && k1i <= lhi) ? p1[r] : 0.f; } }
#pragma unroll
            for (int r = 0; r < 16; ++r) ps += p1[r];
            lsum += ps;
            pack_half(p1, pa2, pa3);
            pv_half<2, false>(o, vb0 + buf * 32768, pa2, pa3, p1, off);
        }
        if (MODE == MODE_SLC) { if (((j + 1) & 31) == 0 && j + 1 < j1) { bmw = a.BM[((size_t)tq * 4 + g) * 8 + ((j + 1) >> 5)]; asm volatile("s_waitcnt vmcnt(0)" : "+v"(bmw) :: "memory"); } }
    }
#undef ISSUE
    lsum += __shfl_xor(lsum, 32);
    if (hi == 0) li_l[r32] = lsum;
    if (MODE == MODE_CMP) { if (hi == 0) a.L[(size_t)tq * NH + hq] = lsum; }
    asm volatile("s_waitcnt lgkmcnt(0)" ::: "memory");
    float gtv[16]; f32x16 pvv[4];
#pragma unroll
    for (int r = 0; r < 16; ++r) {
        const int orow = crow(r, hi); const float lv = li_l[orow]; const float rl = lv > 0.f ? 1.0f / lv : 0.f;
        const int t = MODE == MODE_SLC ? t0 + wid * 5 + orow / 6 : t0 + wid * 16 + (orow & 15);
        const int h = MODE == MODE_SLC ? g * HPG + orow % 6 : g * HPG + hp * 2 + (orow >> 4);
        const bool valid = !(MODE == MODE_SLC && (orow >= 30 || t >= S_)); const int tc = valid ? t : 0;
        gtv[r] = valid ? a.G[(size_t)tc * NGATE + h * 3 + (MODE == MODE_CMP ? 0 : (MODE == MODE_SLC ? 1 : 2))] * rl : 0.f;
        if (MODE != MODE_CMP) { const float* oa = a.OACC + (size_t)tc * 3072 + h * HD + r32;
#pragma unroll
            for (int d0 = 0; d0 < 4; ++d0) pvv[d0][r] = oa[d0 * 32]; }
    }
#pragma unroll
    for (int r = 0; r < 16; ++r) {
        const int orow = crow(r, hi);
        const int t = MODE == MODE_SLC ? t0 + wid * 5 + orow / 6 : t0 + wid * 16 + (orow & 15);
        const int h = MODE == MODE_SLC ? g * HPG + orow % 6 : g * HPG + hp * 2 + (orow >> 4);
        if (MODE == MODE_SLC && (orow >= 30 || t >= S_)) continue;
        float* oa = a.OACC + (size_t)t * 3072 + h * HD + r32;
#pragma unroll
        for (int d0 = 0; d0 < 4; ++d0) {
            const float v = o[d0][r] * gtv[r];
            if (MODE == MODE_CMP) oa[d0 * 32] = v;
            else if (MODE == MODE_WIN) oa[d0 * 32] = pvv[d0][r] + v;
            else a.MIX[(size_t)t * DM + POOLW + h * HD + d0 * 32 + r32] = (bf16_t)(cvt_pk_bf16(pvv[d0][r] + v, 0.f) & 0xffffu);
        }
    }
}

__device__ __forceinline__ void imp_task(const AttnArgs& a, float* IMPP, float* IMPF, int tqi, int g) {
    const int lane = threadIdx.x & 63, fr = lane & 15, fq = lane >> 4;
    const int t = tqi * 16 + fr;
    const int tmax = tqi * 16 + 15;
    if (tmax < 31) return;
    const int lim = t >= 31 ? ((t - 31) >> 4) : -1;
    const int nstep = ((((tmax - 31) >> 4) >> 6) + 1) * 4;
    const float negBC = -a.TAB[512];
    bf16x8 qf[HPG][4]; float rl[HPG];
#pragma unroll
    for (int h = 0; h < HPG; ++h) {
        const bf16_t* qp = a.Z + (size_t)t * LDZ + OFF_Q + (g * HPG + h) * HD + fq * 8;
#pragma unroll
        for (int ks = 0; ks < 4; ++ks) qf[h][ks] = *reinterpret_cast<const bf16x8*>(qp + ks * 32);
        const float lv = a.L[(size_t)t * NH + g * HPG + h]; rl[h] = lv > 0.f ? 1.0f / lv : 0.f;
    }
    const bf16_t* kbase = a.KC + (size_t)g * 1024 * HD + (size_t)fr * HD + fq * 8;
    bf16x8 kf[4], kn[4];
#pragma unroll
    for (int ks = 0; ks < 4; ++ks) kf[ks] = *reinterpret_cast<const bf16x8*>(kbase + ks * 32);
    float* op = IMPP + ((size_t)t * 4 + g) * 256 + fq; float* of = IMPF + ((size_t)t * 4 + g) * 256 + fq;
    for (int st = 0; st < nstep; ++st) {
        const int sn = (st + 1 < nstep) ? st + 1 : st;
#pragma unroll
        for (int ks = 0; ks < 4; ++ks) kn[ks] = *reinterpret_cast<const bf16x8*>(kbase + (size_t)sn * 16 * HD + ks * 32);
        f32x4 imp4 = {0.f, 0.f, 0.f, 0.f};
        const int n0 = st * 16 + fq * 4;
#pragma unroll
        for (int h = 0; h < HPG; ++h) {
            f32x4 acc = {0.f, 0.f, 0.f, 0.f};
#pragma unroll
            for (int ks = 0; ks < 4; ++ks) acc = __builtin_amdgcn_mfma_f32_16x16x32_bf16(kf[ks], qf[h][ks], acc, 0, 0, 0);
#pragma unroll
            for (int i = 0; i < 4; ++i) { const float e = __builtin_amdgcn_exp2f(fmaf(acc[i], SM_C, negBC)) * rl[h]; imp4[i] += (n0 + i <= lim) ? e : 0.f; }
        }
        op[st * 4] = imp4[0] + 2.0f * (imp4[1] + imp4[2] + imp4[3]);
        of[st * 4] = imp4[0];
#pragma unroll
        for (int ks = 0; ks < 4; ++ks) kf[ks] = kn[ks];
    }
}

__device__ __forceinline__ void topk_load(const float* IMPP, const float* IMPF, int t, int g, f32x4& pp, f32x4& ff) {
    const int lane = threadIdx.x & 63, cur = t >> 6, jb = lane * 4;
    pp = (f32x4){0.f, 0.f, 0.f, 0.f}; ff = pp;
    if (cur > 15 && jb <= cur) { const size_t base = ((size_t)t * 4 + g) * 256; pp = *(const f32x4*)(IMPP + base + jb); ff = *(const f32x4*)(IMPF + base + jb); }
}
__device__ __forceinline__ void topk_task(const f32x4 pp, const f32x4 ff, unsigned* BM, int t, int g) {
    const int lane = threadIdx.x & 63;
    const int cur = t >> 6;
    unsigned nib = 0u;
    if (cur <= 15) { const int jb = lane * 4;
#pragma unroll
        for (int c = 0; c < 4; ++c) if (jb + c <= cur) nib |= 1u << c; }
    else {
        const int jb = lane * 4;
        unsigned key[4];
        {
            float fnext = __shfl_down(ff[0], 1);
            if (lane == 63) fnext = 0.f;
            const float v0 = pp[0] + ff[1], v1 = pp[1] + ff[2], v2 = pp[2] + ff[3], v3 = pp[3] + fnext;
            key[0] = (jb + 0 >= 1 && jb + 0 <= cur - 2) ? __float_as_uint(fmaxf(v0, 0.f)) + 1u : 0u;
            key[1] = (jb + 1 >= 1 && jb + 1 <= cur - 2) ? __float_as_uint(fmaxf(v1, 0.f)) + 1u : 0u;
            key[2] = (jb + 2 >= 1 && jb + 2 <= cur - 2) ? __float_as_uint(fmaxf(v2, 0.f)) + 1u : 0u;
            key[3] = (jb + 3 >= 1 && jb + 3 <= cur - 2) ? __float_as_uint(fmaxf(v3, 0.f)) + 1u : 0u;
        }
        unsigned prefix = 0u; bool exact = false;
        for (int b = 30; b >= 0; --b) {
            const unsigned trial = prefix | (1u << b);
            const int cnt = __popcll(__ballot(key[0] >= trial)) + __popcll(__ballot(key[1] >= trial)) + __popcll(__ballot(key[2] >= trial)) + __popcll(__ballot(key[3] >= trial));
            if (cnt >= 13) { prefix = trial; if (cnt == 13) { exact = true; break; } }
        }
#pragma unroll
        for (int c = 0; c < 4; ++c) if (exact ? (key[c] >= prefix) : (key[c] > prefix)) nib |= 1u << c;
        if (!exact) {
            int need = 13 - (__popcll(__ballot(key[0] > prefix)) + __popcll(__ballot(key[1] > prefix)) + __popcll(__ballot(key[2] > prefix)) + __popcll(__ballot(key[3] > prefix)));
            unsigned tie = 0u;
#pragma unroll
            for (int c = 0; c < 4; ++c) if (key[c] == prefix) tie |= 1u << c;
            for (int guard = 0; need > 0 && guard < 16; ++guard) {
                const unsigned long long any = __ballot(tie != 0u);
                if (any == 0ull) break;
                const int L = __builtin_ctzll(any);
                if (lane == L) { const unsigned low = tie & (0u - tie); nib |= low; tie ^= low; }
                --need;
            }
        }
        if (lane == 0) nib |= 1u;
        if (lane == (cur >> 2)) nib |= 1u << (cur & 3);
        if (lane == ((cur - 1) >> 2)) nib |= 1u << ((cur - 1) & 3);
    }
    unsigned x = nib << (4 * (lane & 7));
    x |= __shfl_xor(x, 1); x |= __shfl_xor(x, 2); x |= __shfl_xor(x, 4);
    if ((lane & 7) == 0) BM[((size_t)t * 4 + g) * 8 + (lane >> 3)] = x;
}
#undef KSWZ
}

template <bool FFN_REMAP = false>
__device__ __forceinline__ void convT(const float* __restrict__ src, int K, int N, bf16_t* __restrict__ dst, int ldd, LAS float* tile, int bid, int nb) {
    const int tid = threadIdx.x, tk = K >> 6, tn = (N + 63) >> 6, total = tk * tn;
    const int r = tid >> 4, c4 = (tid & 15) * 4;
    f32x4 v[2] = {{0.f, 0.f, 0.f, 0.f}, {0.f, 0.f, 0.f, 0.f}}, vn[2];
    if (bid < total) { const int nti = bid % tn, kti = bid / tn, ng = nti * 64 + c4;
#pragma unroll
        for (int h = 0; h < 2; ++h) if (ng < N) v[h] = *(const f32x4*)(src + (size_t)(kti * 64 + r + h * 32) * N + ng); }
    for (int idx = bid; idx < total; idx += nb) {
        const int nti = idx % tn, kti = idx / tn;
#pragma unroll
        for (int h = 0; h < 2; ++h) { LAS float* tp = tile + (r + h * 32) * 65 + c4; tp[0] = v[h][0]; tp[1] = v[h][1]; tp[2] = v[h][2]; tp[3] = v[h][3]; }
        {
            const int nx = idx + nb; vn[0] = (f32x4){0.f, 0.f, 0.f, 0.f}; vn[1] = vn[0];
            if (nx < total) { const int nti2 = nx % tn, kti2 = nx / tn, ng2 = nti2 * 64 + c4;
#pragma unroll
                for (int h = 0; h < 2; ++h) if (ng2 < N) vn[h] = *(const f32x4*)(src + (size_t)(kti2 * 64 + r + h * 32) * N + ng2); } }
        __syncthreads();
        const int n = tid >> 3, k8 = (tid & 7) * 8, ngl = nti * 64 + n;
        float e[8];
#pragma unroll
        for (int i = 0; i < 8; ++i) e[i] = tile[(k8 + i) * 65 + n];
        if (ngl < N) { u32x4 w; w.x = cvt_pk_bf16(e[0], e[1]); w.y = cvt_pk_bf16(e[2], e[3]); w.z = cvt_pk_bf16(e[4], e[5]); w.w = cvt_pk_bf16(e[6], e[7]);
            int drow = ngl; if (FFN_REMAP) { const int up = ngl >= DFF ? 1 : 0, f = ngl - up * DFF; drow = (f >> 7) * 256 + up * 128 + (f & 127); }
            *(u32x4*)(dst + (size_t)drow * ldd + kti * 64 + k8) = w; }
        __syncthreads();
        v[0] = vn[0]; v[1] = vn[1];
    }
}
__device__ __forceinline__ void rmsnorm_rows(const float* __restrict__ src, const float* __restrict__ w, bf16_t* __restrict__ dst, int rows, int gw, int nw) {
    const int lane = threadIdx.x & 63;
    f32x4 v[16], vn[16];
    if (gw < rows) { const f32x4* sp = (const f32x4*)(src + (size_t)gw * DM);
#pragma unroll
        for (int i = 0; i < 16; ++i) v[i] = sp[lane + 64 * i]; }
    for (int row = gw; row < rows; row += nw) {
        const int nr = row + nw < rows ? row + nw : row;
        { const f32x4* sp = (const f32x4*)(src + (size_t)nr * DM);
#pragma unroll
          for (int i = 0; i < 16; ++i) vn[i] = sp[lane + 64 * i]; }
        float ss = 0.f;
#pragma unroll
        for (int i = 0; i < 16; ++i) ss += v[i][0] * v[i][0] + v[i][1] * v[i][1] + v[i][2] * v[i][2] + v[i][3] * v[i][3];
        ss = wave_sum(ss);
        const float rstd = rsqrtf(ss * (1.0f / DM) + EPS);
#pragma unroll
        for (int i = 0; i < 16; ++i) { const f32x4 ww = ((const f32x4*)w)[lane + 64 * i];
            u32x2 o; o.x = cvt_pk_bf16(v[i][0] * rstd * ww[0], v[i][1] * rstd * ww[1]); o.y = cvt_pk_bf16(v[i][2] * rstd * ww[2], v[i][3] * rstd * ww[3]);
            *(u32x2*)(dst + (size_t)row * DM + (lane + 64 * i) * 4) = o; }
#pragma unroll
        for (int i = 0; i < 16; ++i) v[i] = vn[i];
    }
}

struct Ptrs {
    bf16_t *Win, *Wo, *Wfi, *Wfo, *Wg, *Wple, *Wpool, *Wc1k, *Wc1v, *XN, *PB, *Z, *M, *KC, *VC, *MIX, *ACT, *ERAW;
    float *COS, *SIN, *TAB, *G, *H1, *L, *OACC, *IMPP, *IMPF, *ERSTD; unsigned* BM;
};

__device__ __forceinline__ void phase_prologue(const Params& P, const Ptrs& W, LAS unsigned char* lds) {
    const int bid = blockIdx.x, nb = gridDim.x, tid = threadIdx.x, lane = tid & 63, wv = tid >> 6;
    const int gw = bid * NWAVES + wv, nw = nb * NWAVES; const size_t gt = (size_t)bid * NTHREADS + tid, ntot = (size_t)nb * NTHREADS;
    LAS float* tile = (LAS float*)lds;
    rmsnorm_rows(P.x, P.norm1_w, W.XN, S_, gw, nw);
    convT(P.w_in, DM, INW, W.Win, DM, tile, bid, nb);
    for (size_t i = gt; i < (size_t)(LDZ - INW) * DM / 8; i += ntot) *(u32x4*)(W.Win + (size_t)INW * DM + i * 8) = (u32x4){0u, 0u, 0u, 0u};
    convT(P.w_o, DM, DM, W.Wo, DM, tile, bid, nb);
    convT<true>(P.w_ffn_in, DM, NFI, W.Wfi, DM, tile, bid, nb);
    for (size_t i = gt; i < (size_t)2 * DM / 8; i += ntot) *(u32x4*)(W.XN - 2 * DM + i * 8) = (u32x4){0u, 0u, 0u, 0u};
    convT(P.w_ffn_out, DFF, DM, W.Wfo, DFF, tile, bid, nb);
    convT(P.w_ple_gate, DM, DM, W.Wg, DM, tile, bid, nb);
    convT(P.w_ple_proj, PLE, DM, W.Wple, PLE, tile, bid, nb);
    for (int g = 0; g < 4; ++g) convT(P.w_pool + (size_t)g * 65536, 256, 256, W.Wpool + (size_t)g * 65536, 256, tile, bid, nb);
    convT(P.cmp_k_w1, 4096, 256, W.Wc1k, 4096, tile, bid, nb);
    convT(P.cmp_v_w1, 4096, 256, W.Wc1v, 4096, tile, bid, nb);
    for (size_t i = gt; i < (size_t)S_ * PLE / 8; i += ntot) { const f32x4 a = *(const f32x4*)(P.p + i * 8), b = *(const f32x4*)(P.p + i * 8 + 4);
        u32x4 w; w.x = cvt_pk_bf16(a[0], a[1]); w.y = cvt_pk_bf16(a[2], a[3]); w.z = cvt_pk_bf16(b[0], b[1]); w.w = cvt_pk_bf16(b[2], b[3]); *(u32x4*)(W.PB + i * 8) = w; }
    for (size_t i = gt; i < (size_t)S_ * 16; i += ntot) { const int t = (int)(i >> 4), fi = (int)(i & 15);
        const float inv = exp2f(-(float)fi * (18.931568569324174f / 16.0f)); const float ang = (float)P.positions[t] * inv;
        const double ad = (double)ang; const double kk = rint(ad * 0.15915494309189535); const float rf = (float)(ad - kk * 6.283185307179586);
        W.COS[i] = __cosf(rf); W.SIN[i] = __sinf(rf); }
    for (int o = gw; o < 512; o += nw) { const int which = o >> 8, j = o & 255; const float* pe = which ? P.cmp_pos_v : P.cmp_pos_k; const float* w1 = which ? P.cmp_v_w1 : P.cmp_k_w1;
        float s = 0.f; for (int r = lane; r < 4096; r += 64) s += pe[r] * w1[(size_t)r * 256 + j];
        s = wave_sum(s); if (lane == 0) W.TAB[o] = s; }
    if (gw == 0) { float mq = fmaxf(fabsf(P.q_norm_w[lane]), fabsf(P.q_norm_w[lane + 64])); mq = wave_max(mq);
        float mc = wave_max(fmaxf(fabsf(P.k_norm_cmp_w[lane]), fabsf(P.k_norm_cmp_w[lane + 64])));
        float ms = wave_max(fmaxf(fabsf(P.k_norm_slc_w[lane]), fabsf(P.k_norm_slc_w[lane + 64])));
        float mw = wave_max(fmaxf(fabsf(P.k_norm_win_w[lane]), fabsf(P.k_norm_win_w[lane + 64])));
        const float c = 11.313708498984761f * 1.4426950408889634f * mq * 1.01f;
        if (lane == 0) { W.TAB[512] = c * mc; W.TAB[513] = c * ms; W.TAB[514] = c * mw; } }
}

__device__ __forceinline__ void phase_postz(const Params& P, const Ptrs& W, int gw, int nw) {
    const int tid = threadIdx.x, lane = tid & 63;
    const f32x2 wq = *(const f32x2*)(P.q_norm_w + 2 * lane), wks = *(const f32x2*)(P.k_norm_slc_w + 2 * lane), wkw = *(const f32x2*)(P.k_norm_win_w + 2 * lane);
    for (int t = gw; t < S_; t += nw) {
        bf16_t* zr = W.Z + (size_t)t * LDZ;
        float cs0 = 0.f, cs1 = 0.f, sn0 = 0.f, sn1 = 0.f;
        if (lane < 16) { const int i0 = (2 * lane) & 15; cs0 = W.COS[t * 16 + i0]; cs1 = W.COS[t * 16 + i0 + 1]; sn0 = W.SIN[t * 16 + i0]; sn1 = W.SIN[t * 16 + i0 + 1]; }
        unsigned uv[32];
#pragma unroll
        for (int v = 0; v < 32; ++v) { const int col = v < 24 ? OFF_Q + v * HD : (v < 28 ? OFF_KV + 2 * 512 + (v - 24) * HD : OFF_KV + 4 * 512 + (v - 28) * HD);
            uv[v] = *((const unsigned*)(zr + col) + lane); }
#pragma unroll
        for (int v = 0; v < 32; ++v) {
            const f32x2 ww = v < 24 ? wq : (v < 28 ? wks : wkw);
            const unsigned u = uv[v]; const float x0 = bf_lo(u), x1 = bf_hi(u);
            const float ss = wave_sum(x0 * x0 + x1 * x1);
            const float rstd = rsqrtf(ss * (1.0f / HD) + EPS);
            float y0 = x0 * rstd * ww[0], y1 = x1 * rstd * ww[1];
            const float p0 = __shfl_xor(y0, 8), p1 = __shfl_xor(y1, 8);
            if (lane < 8) { y0 = y0 * cs0 - p0 * sn0; y1 = y1 * cs1 - p1 * sn1; }
            else if (lane < 16) { y0 = y0 * cs0 + p0 * sn0; y1 = y1 * cs1 + p1 * sn1; }
            uv[v] = cvt_pk_bf16(y0, y1);
        }
        {
            const int gi = lane >> 4, wlen = 2 << gi, c0 = lane * 16; const int cnt = (t + 1) < wlen ? (t + 1) : wlen;
            float s[16];
#pragma unroll
            for (int i = 0; i < 16; ++i) s[i] = 0.f;
            float cur[16];
            for (int i = 0; i < cnt; ++i) { const u32x4 a = *(const u32x4*)(W.Z + (size_t)(t - i) * LDZ + c0), b = *(const u32x4*)(W.Z + (size_t)(t - i) * LDZ + c0 + 8);
                const float e[16] = {bf_lo(a.x), bf_hi(a.x), bf_lo(a.y), bf_hi(a.y), bf_lo(a.z), bf_hi(a.z), bf_lo(a.w), bf_hi(a.w), bf_lo(b.x), bf_hi(b.x), bf_lo(b.y), bf_hi(b.y), bf_lo(b.z), bf_hi(b.z), bf_lo(b.w), bf_hi(b.w)};
#pragma unroll
                for (int q = 0; q < 16; ++q) { s[q] += e[q]; if (i == 0) cur[q] = e[q]; } }
            const float rc = 1.0f / (float)cnt;
            u32x4 o0, o1;
            o0.x = cvt_pk_bf16(s[0] * rc - cur[0], s[1] * rc - cur[1]); o0.y = cvt_pk_bf16(s[2] * rc - cur[2], s[3] * rc - cur[3]);
            o0.z = cvt_pk_bf16(s[4] * rc - cur[4], s[5] * rc - cur[5]); o0.w = cvt_pk_bf16(s[6] * rc - cur[6], s[7] * rc - cur[7]);
            o1.x = cvt_pk_bf16(s[8] * rc - cur[8], s[9] * rc - cur[9]); o1.y = cvt_pk_bf16(s[10] * rc - cur[10], s[11] * rc - cur[11]);
            o1.z = cvt_pk_bf16(s[12] * rc - cur[12], s[13] * rc - cur[13]); o1.w = cvt_pk_bf16(s[14] * rc - cur[14], s[15] * rc - cur[15]);
            *(u32x4*)(W.M + (size_t)t * POOLW + c0) = o0; *(u32x4*)(W.M + (size_t)t * POOLW + c0 + 8) = o1;
        }
#pragma unroll
        for (int v = 0; v < 32; ++v) { const int col = v < 24 ? OFF_Q + v * HD : (v < 28 ? OFF_KV + 2 * 512 + (v - 24) * HD : OFF_KV + 4 * 512 + (v - 28) * HD);
            *((unsigned*)(zr + col) + lane) = uv[v]; }

    }
}

__device__ __forceinline__ void phase_cmpfin(const Params& P, const Ptrs& W) {
    const int tid = threadIdx.x, lane = tid & 63, gw = blockIdx.x * NWAVES + (tid >> 6), nw = gridDim.x * NWAVES;
    const f32x2 wk = *(const f32x2*)(P.k_norm_cmp_w + 2 * lane);
    for (int task = gw; task < 8192; task += nw) {
        const int tk = __builtin_amdgcn_readfirstlane(task);
        const int which = tk >> 12, g = (tk >> 10) & 3, n = tk & 1023;
        bf16_t* dst = (which ? W.VC : W.KC) + ((size_t)g * 1024 + n) * HD;
        if (n == 1023) { ((unsigned*)dst)[lane] = 0u; continue; }
        const float* h = W.H1 + (size_t)tk * 256; const float* w2 = which ? P.cmp_v_w2 : P.cmp_k_w2;
        float a0 = 0.f, a1 = 0.f;
        for (int j = 0; j < 256; ++j) { const float hj = h[j]; const f32x2 wv = *(const f32x2*)(w2 + j * HD + 2 * lane); a0 += hj * wv[0]; a1 += hj * wv[1]; }
        if (which == 0) {
            const float ss = wave_sum(a0 * a0 + a1 * a1); const float rstd = rsqrtf(ss * (1.0f / HD) + EPS);
            a0 = a0 * rstd * wk[0]; a1 = a1 * rstd * wk[1];
            const int tp = 16 * n + 31; const float p0 = __shfl_xor(a0, 8), p1 = __shfl_xor(a1, 8);
            if (lane < 16) { const int i0 = (2 * lane) & 15; const float cs0 = W.COS[tp * 16 + i0], cs1 = W.COS[tp * 16 + i0 + 1], sn0 = W.SIN[tp * 16 + i0], sn1 = W.SIN[tp * 16 + i0 + 1];
                if (lane < 8) { a0 = a0 * cs0 - p0 * sn0; a1 = a1 * cs1 - p1 * sn1; } else { a0 = a0 * cs0 + p0 * sn0; a1 = a1 * cs1 + p1 * sn1; } }
        }
        ((unsigned*)dst)[lane] = cvt_pk_bf16(a0, a1);
    }
}

__device__ __forceinline__ void phase_erstd(const Ptrs& W) {
    const int tid = threadIdx.x, lane = tid & 63, gw = blockIdx.x * NWAVES + (tid >> 6), nw = gridDim.x * NWAVES;
    u32x4 a[8], an[8];
    if (gw < S_) { const u32x4* sp = (const u32x4*)(W.ERAW + (size_t)gw * DM);
#pragma unroll
        for (int i = 0; i < 8; ++i) a[i] = sp[lane + 64 * i]; }
    for (int row = gw; row < S_; row += nw) {
        const int nr = row + nw < S_ ? row + nw : row;
        { const u32x4* sp = (const u32x4*)(W.ERAW + (size_t)nr * DM);
#pragma unroll
          for (int i = 0; i < 8; ++i) an[i] = sp[lane + 64 * i]; }
        float ss = 0.f;
#pragma unroll
        for (int i = 0; i < 8; ++i) {
            const float e0 = bf_lo(a[i].x), e1 = bf_hi(a[i].x), e2 = bf_lo(a[i].y), e3 = bf_hi(a[i].y), e4 = bf_lo(a[i].z), e5 = bf_hi(a[i].z), e6 = bf_lo(a[i].w), e7 = bf_hi(a[i].w);
            ss += e0 * e0 + e1 * e1 + e2 * e2 + e3 * e3 + e4 * e4 + e5 * e5 + e6 * e6 + e7 * e7; }
        ss = wave_sum(ss);
        if (lane == 0) W.ERSTD[row] = rsqrtf(ss * (1.0f / DM) + EPS);
#pragma unroll
        for (int i = 0; i < 8; ++i) a[i] = an[i];
    }
}

constexpr int N_PHASES = 11;
__device__ __forceinline__ Params kargs() {
#if defined(__HIP_DEVICE_COMPILE__)
    unsigned long long p = (unsigned long long)__builtin_amdgcn_kernarg_segment_ptr();
    asm volatile("" : "+s"(p));
    return *(const __attribute__((address_space(4))) Params*)p;
#else
    return Params{};
#endif
}
__device__ __forceinline__ Ptrs mkptrs(unsigned char* ws) {
    Ptrs W;
    W.Win = (bf16_t*)(ws + WS_WIN); W.Wo = (bf16_t*)(ws + WS_WO); W.Wfi = (bf16_t*)(ws + WS_WFI); W.Wfo = (bf16_t*)(ws + WS_WFO); W.Wg = (bf16_t*)(ws + WS_WG);
    W.Wple = (bf16_t*)(ws + WS_WPLE); W.Wpool = (bf16_t*)(ws + WS_WPOOL); W.Wc1k = (bf16_t*)(ws + WS_WC1K); W.Wc1v = (bf16_t*)(ws + WS_WC1V);
    W.XN = (bf16_t*)(ws + WS_XN); W.PB = (bf16_t*)(ws + WS_PB); W.Z = (bf16_t*)(ws + WS_Z); W.M = (bf16_t*)(ws + WS_M); W.KC = (bf16_t*)(ws + WS_KC); W.VC = (bf16_t*)(ws + WS_VC);
    W.MIX = (bf16_t*)(ws + WS_MIX); W.ACT = (bf16_t*)(ws + WS_ACT); W.ERAW = (bf16_t*)(ws + WS_ERAW);
    W.COS = (float*)(ws + WS_COS); W.SIN = (float*)(ws + WS_SIN); W.TAB = (float*)(ws + WS_TAB); W.G = (float*)(ws + WS_G); W.H1 = (float*)(ws + WS_H1); W.L = (float*)(ws + WS_L);
    W.OACC = (float*)(ws + WS_OACC); W.IMPP = (float*)(ws + WS_IMPP); W.IMPF = (float*)(ws + WS_IMPF); W.ERSTD = (float*)(ws + WS_ERSTD); W.BM = (unsigned*)(ws + WS_BM);
    return W;
}
__global__ void __launch_bounds__(NTHREADS, 2) fwd(Params Punused) {
    extern __shared__ __attribute__((aligned(16))) unsigned char lds_raw[];
    LAS unsigned char* lds = (LAS unsigned char*)lds_raw;
    const int tid = threadIdx.x;
    const int G = gridDim.x, bid = blockIdx.x;
    const int gw = bid * NWAVES + (tid >> 6), nw = G * NWAVES;

    if (tid < 16) ((LAS unsigned*)(lds + LDS_MISC))[tid] = 0u;
    __syncthreads();
    int lo, hi; XcdBarrier bar;
    { const Params P = kargs(); lo = P.ph_lo; hi = P.ph_hi;
      bar.bar = (unsigned*)(P.ws + WS_CTL); bar.x = 0; bar.st = (volatile LAS unsigned*)(lds + LDS_MISC);
      if (hi - lo > 1) bar = xcd_barrier_post((unsigned*)(P.ws + WS_CTL), (volatile LAS unsigned*)(lds + LDS_MISC)); }
#ifdef PH_MASK
#define IN(k) (((PH_MASK >> (k)) & 1) && lo <= (k) && (k) < hi)
#else
#define IN(k) (lo <= (k) && (k) < hi)
#endif
#define SEAM(k) do { if (IN(k) && IN((k) + 1)) xcd_barrier(bar); } while (0)
#define PHASE_VARS const Params P = kargs(); const Ptrs W = mkptrs(P.ws); (void)W;
#define ATT_ARGS att::AttnArgs AA{W.Z, W.KC, W.VC, W.G, W.L, W.OACC, W.MIX, W.BM, W.TAB};

    if (IN(0)) { PHASE_VARS REP(0) { phase_prologue(P, W, lds); } SEAM(0); }
    if (IN(1)) {
        PHASE_VARS
        pg8::GStd g{(const char*)W.XN, (const char*)W.Win, DM, DM, DM / 64}; pg8::StaticOrder S; S.init(S_ / 256, OFF_G / 256, G, bid);
        pg8::EpiBf16 E{W.Z, LDZ};
        REP(1) { pg8::gemm_phase(lds, g, S, E); } SEAM(1);
    }
    if (IN(2)) {
        PHASE_VARS
        if (G > 64) {
            if (bid < 32) { pg8::GCmp g{(const char*)W.Z, (const char*)W.Wc1k, (const char*)W.Wc1v, 16 * LDZ, 4096, 64}; pg8::StaticOrder S; S.init(32, 1, 32, bid);
                pg8::EpiCmpGelu E{W.H1, W.TAB}; pg8::gemm_phase(lds, g, S, E); }
            else if (bid < 96) {
                pg8::GStd g{(const char*)W.XN, (const char*)(W.Win + (size_t)OFF_G * DM), DM, DM, DM / 64}; pg8::StaticOrder S; S.init(S_ / 256, 1, 64, bid - 32);
                pg8::EpiBf16 E{W.Z + OFF_G, LDZ}; pg8::gemm_phase(lds, g, S, E); }
            else phase_postz(P, W, (bid - 96) * NWAVES + (tid >> 6), (G - 96) * NWAVES);
        } else {
            { pg8::GStd g{(const char*)W.XN, (const char*)(W.Win + (size_t)OFF_G * DM), DM, DM, DM / 64}; pg8::StaticOrder S; S.init(S_ / 256, 1, G, bid);
              pg8::EpiBf16 E{W.Z + OFF_G, LDZ}; pg8::gemm_phase(lds, g, S, E); }
            { pg8::GCmp g{(const char*)W.Z, (const char*)W.Wc1k, (const char*)W.Wc1v, 16 * LDZ, 4096, 64}; pg8::StaticOrder S; S.init(32, 1, G, bid);
              pg8::EpiCmpGelu E{W.H1, W.TAB}; pg8::gemm_phase(lds, g, S, E); }
            phase_postz(P, W, gw, nw);
        }
        SEAM(2);
    }
    if (IN(3)) {
        PHASE_VARS
        for (size_t i = (size_t)bid * NTHREADS + tid; i < (size_t)S_ * NGATE; i += (size_t)G * NTHREADS) { const int t = (int)(i / NGATE), c = (int)(i % NGATE); W.G[i] = sigmoidf_(bf2f(W.Z[(size_t)t * LDZ + OFF_G + c])); }
        phase_cmpfin(P, W);
        { pg8::GPool g{(const char*)W.M, (const char*)W.Wpool, POOLW, 256, 4}; pg8::StaticOrder S; S.init(S_ / 256, 4, G, bid);
          pg8::EpiBf16Scale E{W.MIX, DM, P.pool_scale}; pg8::gemm_phase(lds, g, S, E); }
        SEAM(3);
    }
    if (IN(4)) {
        PHASE_VARS ATT_ARGS
        REP(4)
        for (int base = 0, rnd = 0; base < 1536; base += G, ++rnd) {
            int qt, g, hp;
            if (G == 256) { const int x = bid & 7, r = bid >> 3, qp = (rnd / 3) ? 63 - r : r; if (rnd >= 6) break; g = x & 3; qt = 2 * qp + (x >> 2); hp = rnd % 3; }
            else { const int Lu = base + ((rnd & 1) ? G - 1 - bid : bid); if (Lu >= 1536) continue; qt = Lu / 12; const int rem = Lu % 12; g = rem / 3; hp = rem % 3; }
            att::attn_unit<att::MODE_CMP>(AA, (LAS char*)lds, qt, g, hp);
            asm volatile("s_waitcnt vmcnt(0)" ::: "memory");
            att::attn_unit<att::MODE_WIN>(AA, (LAS char*)lds, qt, g, hp); }
        SEAM(4);
    }
    if (IN(5)) {
        PHASE_VARS ATT_ARGS
        for (int k = gw, r = 0; k < 4096; k += nw, ++r) { const int hiT = (r + 1) * nw < 4096 ? (r + 1) * nw : 4096;
            const int task = (r & 1) ? hiT - 1 - (k - r * nw) : k;
            att::imp_task(AA, W.IMPP, W.IMPF, task >> 2, task & 3);
            asm volatile("s_waitcnt vmcnt(0)" ::: "memory");
            { const int tb = (task >> 2) * 16, gg = task & 3; f32x4 pp, ff, pn, fn;
              att::topk_load(W.IMPP, W.IMPF, tb, gg, pp, ff);
              for (int q = 0; q < 16; ++q) { att::topk_load(W.IMPP, W.IMPF, tb + (q < 15 ? q + 1 : q), gg, pn, fn); att::topk_task(pp, ff, W.BM, tb + q, gg); pp = pn; ff = fn; } } }
        SEAM(5);
    }
    if (IN(6)) {
        PHASE_VARS ATT_ARGS
        REP(6)
        for (int base = 0, rnd = 0; base < 1640 + G; base += G, ++rnd) {
            int ut, g;
            if (G == 256) { const int x = bid & 7, r = bid >> 3, k = rnd * 32 + ((rnd & 1) ? 31 - r : r); if (k >= 205) break; g = x & 3; ut = 409 - (2 * k + (x >> 2)); }
            else { const int Lu = base + ((rnd & 1) ? G - 1 - bid : bid); if (Lu >= 1640) continue; ut = 409 - Lu / 4; g = Lu % 4; }
            att::attn_unit<att::MODE_SLC>(AA, (LAS char*)lds, ut, g, 0); }
        SEAM(6);
    }
    if (IN(7)) {
        PHASE_VARS
        { pg8::GStd g{(const char*)W.MIX, (const char*)W.Wo, DM, DM, DM / 64}; pg8::StaticOrder S; S.init(S_ / 256, DM / 256, G, bid);
          pg8::EpiResNorm E{P.x, P.out, W.XN, P.norm2_w, (float*)(P.ws + WS_SSQ1), DM}; pg8::gemm_phase(lds, g, S, E); }
        { pg8::GStd g{(const char*)W.PB, (const char*)W.Wple, PLE, PLE, PLE / 64}; pg8::StaticOrder S; S.init(S_ / 256, DM / 256, G, bid);
          pg8::EpiBf16Ssq E{W.ERAW, DM, (float*)(P.ws + WS_SSQ3)}; pg8::gemm_phase(lds, g, S, E); }
        SEAM(7);
    }
    if (IN(8)) {
        PHASE_VARS
        pg8::GFfn g{(const char*)W.XN, (const char*)W.Wfi, DM, DM, DM / 64}; pg8::StaticOrder S; S.init(65, DFF / 128, G, bid);
        pg8::EpiFfn E{W.ACT, P.conv_w, P.conv_b, (LAS float*)(lds + LDS_XCH), (const float*)(P.ws + WS_SSQ1)}; REP(8) { pg8::gemm_phase(lds, g, S, E); } SEAM(8);
    }
    if (IN(9)) {
        PHASE_VARS
        pg8::GStd g{(const char*)W.ACT, (const char*)W.Wfo, DFF, DFF, DFF / 64}; pg8::StaticOrder S; S.init(S_ / 256, DM / 256, G, bid);
        pg8::EpiResNorm E{P.out, P.out, W.XN, P.ple_gate_norm_w, (float*)(P.ws + WS_SSQ2), DM}; pg8::gemm_phase(lds, g, S, E); SEAM(9);
    }
    if (IN(10)) {
        PHASE_VARS
        pg8::GStd g{(const char*)W.XN, (const char*)W.Wg, DM, DM, DM / 64}; pg8::StaticOrder S; S.init(S_ / 256, DM / 256, G, bid);
        pg8::EpiGate E{P.out, W.ERAW, (const float*)(P.ws + WS_SSQ3), P.ple_norm_w, (const float*)(P.ws + WS_SSQ2), DM}; pg8::gemm_phase(lds, g, S, E);
    }
#undef IN
#undef SEAM
}

extern "C" void kernel_launch(void* const* d_in, const int* in_sizes, int n_in, void* d_out, int out_size, void* d_ws, size_t ws_size, hipStream_t stream) {
    static int grid = 0;
    if (grid == 0) {
        if (n_in != 27 || in_sizes[0] != S_ * DM || out_size != S_ * DM || ws_size < WS_NEED) {
            fprintf(stderr, "kernel_launch: unexpected shapes (n_in %d, in0 %d, out %d, ws %zu < %zu); nothing launched\n", n_in, n_in > 0 ? in_sizes[0] : -1, out_size, ws_size, (size_t)WS_NEED); grid = -1; return; }
        int dev = 0, cus = 0, per_cu = 0;
        if (hipGetDevice(&dev) != hipSuccess || hipDeviceGetAttribute(&cus, hipDeviceAttributeMultiprocessorCount, dev) != hipSuccess) { grid = -1; return; }
        if (hipFuncSetAttribute((const void*)fwd, hipFuncAttributeMaxDynamicSharedMemorySize, LDS_BYTES) != hipSuccess) { fprintf(stderr, "kernel_launch: hipFuncSetAttribute failed\n"); grid = -1; return; }
        if (hipOccupancyMaxActiveBlocksPerMultiprocessor(&per_cu, (const void*)fwd, NTHREADS, LDS_BYTES) != hipSuccess || per_cu < 1) { fprintf(stderr, "kernel_launch: occupancy query says %d\n", per_cu); (void)hipGetLastError(); }
        grid = cus > 256 ? 256 : cus;
    }
    if (grid < 0) return;
    (void)hipMemsetAsync((char*)d_ws + WS_CTL, 0, CTL_BYTES, stream);
    Params P{};
    const float** fp = (const float**)&P;
    P.x = (const float*)d_in[0]; P.p = (const float*)d_in[1]; P.positions = (const int*)d_in[2]; P.norm1_w = (const float*)d_in[3]; P.w_in = (const float*)d_in[4];
    P.w_pool = (const float*)d_in[5]; P.pool_scale = (const float*)d_in[6]; P.q_norm_w = (const float*)d_in[7]; P.k_norm_cmp_w = (const float*)d_in[8];
    P.k_norm_slc_w = (const float*)d_in[9]; P.k_norm_win_w = (const float*)d_in[10]; P.cmp_pos_k = (const float*)d_in[11]; P.cmp_pos_v = (const float*)d_in[12];
    P.cmp_k_w1 = (const float*)d_in[13]; P.cmp_k_w2 = (const float*)d_in[14]; P.cmp_v_w1 = (const float*)d_in[15]; P.cmp_v_w2 = (const float*)d_in[16];
    P.w_o = (const float*)d_in[17]; P.norm2_w = (const float*)d_in[18]; P.w_ffn_in = (const float*)d_in[19]; P.conv_w = (const float*)d_in[20]; P.conv_b = (const float*)d_in[21];
    P.w_ffn_out = (const float*)d_in[22]; P.w_ple_proj = (const float*)d_in[23]; P.ple_norm_w = (const float*)d_in[24]; P.ple_gate_norm_w = (const float*)d_in[25]; P.w_ple_gate = (const float*)d_in[26];
    (void)fp;
    P.out = (float*)d_out; P.ws = (unsigned char*)d_ws;
#if MK_ONE_LAUNCH
    P.ph_lo = 0; P.ph_hi = N_PHASES;
    hipLaunchKernelGGL(fwd, dim3(grid), dim3(NTHREADS), LDS_BYTES, stream, P);
#else
    for (int ph = 0; ph < N_PHASES; ++ph) { P.ph_lo = ph; P.ph_hi = ph + 1; hipLaunchKernelGGL(fwd, dim3(grid), dim3(NTHREADS), LDS_BYTES, stream, P); }
#endif
    const hipError_t le = hipPeekAtLastError();
    if (le != hipSuccess) fprintf(stderr, "kernel_launch: launch failed: %s\n", hipGetErrorName(le));
}
```

```cpp
#include <hip/hip_runtime.h>
#include <cstdio>
#include <cstdint>

#ifndef PROBE_DBL
#define PROBE_DBL 0
#endif
#define REP(k) _Pragma("unroll") for (int rep_ = 0; rep_ < 1 + ((PROBE_DBL >> (k)) & 1); ++rep_)
#ifndef MK_ONE_LAUNCH
#define MK_ONE_LAUNCH 1
#endif

#define LAS __attribute__((address_space(3)))
typedef unsigned short bf16_t;
typedef short bf16x8 __attribute__((ext_vector_type(8)));
typedef short s16x4 __attribute__((ext_vector_type(4)));
typedef float f32x2 __attribute__((ext_vector_type(2)));
typedef float f32x4 __attribute__((ext_vector_type(4)));
typedef float f32x16 __attribute__((ext_vector_type(16)));
typedef unsigned u32x2 __attribute__((ext_vector_type(2)));
typedef unsigned u32x4 __attribute__((ext_vector_type(4)));
typedef int i32x4 __attribute__((ext_vector_type(4)));
typedef int i32x8 __attribute__((ext_vector_type(8)));

constexpr int S_ = 16384, DM = 4096, INW = 7240, LDZ = 7424, POOLW = 1024, NH = 24, NKV = 4, HPG = 6, HD = 128;
constexpr int OFF_Q = 1024, OFF_KV = 4096, OFF_G = 7168, DFF = 11008, NFI = 22016, PLE = 256, NGATE = 72;
constexpr int ZROWS = S_ + 64, XNROWS = S_ + 256, CHUNK = 8192;
constexpr float EPS = 1e-6f;
constexpr float SM_C = 0.08838834764831845f * 1.4426950408889634f;
constexpr int NWAVES = 8, NTHREADS = 512;
constexpr float WG8_SCALE = 128.0f;

constexpr size_t al256(size_t x) { return (x + 255) / 256 * 256; }
constexpr size_t WS_CTL   = 0;
constexpr size_t CTL_BYTES = 262144;
constexpr size_t WS_SSQ1 = WS_CTL + 65536, WS_SSQ2 = WS_CTL + 131072, WS_SSQ3 = WS_CTL + 196608;
constexpr size_t WS_WIN   = WS_CTL + CTL_BYTES;
constexpr size_t WS_WO    = WS_WIN + al256((size_t)LDZ * DM * 2);
constexpr size_t WS_WFI   = WS_WO + al256((size_t)DM * DM * 2);
constexpr size_t WS_WFO   = WS_WFI + al256((size_t)NFI * DM * 2);
constexpr size_t WS_WG    = WS_WFO + al256((size_t)DM * DFF * 2);
constexpr size_t WS_WPLE  = WS_WG + al256((size_t)DM * DM * 2);
constexpr size_t WS_WPOOL = WS_WPLE + al256((size_t)DM * PLE * 2);
constexpr size_t WS_WC1K  = WS_WPOOL + al256((size_t)1024 * 256 * 2);
constexpr size_t WS_WC1V  = WS_WC1K + al256((size_t)256 * 4096 * 2);
constexpr size_t WS_COS   = WS_WC1V + al256((size_t)256 * 4096 * 2);
constexpr size_t WS_SIN   = WS_COS + al256((size_t)S_ * 16 * 4);
constexpr size_t WS_TAB   = WS_SIN + al256((size_t)S_ * 16 * 4);
constexpr size_t WS_XNP   = WS_TAB + 4096;
constexpr size_t WS_XN    = WS_XNP + (size_t)2 * DM * 2;
constexpr size_t WS_PB    = WS_XN + al256((size_t)XNROWS * DM * 2);
constexpr size_t WS_R     = WS_PB + al256((size_t)S_ * PLE * 2);
constexpr size_t WS_Z     = WS_R;
constexpr size_t WS_M     = WS_Z + al256((size_t)ZROWS * LDZ * 2);
constexpr size_t WS_G     = WS_M + al256((size_t)S_ * POOLW * 2);
constexpr size_t WS_H1    = WS_G + al256((size_t)S_ * NGATE * 4);
constexpr size_t WS_KC    = WS_H1 + al256((size_t)8192 * 256 * 4);
constexpr size_t WS_VC    = WS_KC + al256((size_t)4 * 1024 * 128 * 2);
constexpr size_t WS_L     = WS_VC + al256((size_t)4 * 1024 * 128 * 2);
constexpr size_t WS_OACC  = WS_L + al256((size_t)S_ * NH * 4);
constexpr size_t WS_IMPP  = WS_OACC + al256((size_t)S_ * 3072 * 4);
constexpr size_t WS_IMPF  = WS_IMPP + al256((size_t)S_ * 4 * 256 * 4);
constexpr size_t WS_BM    = WS_IMPF + al256((size_t)S_ * 4 * 256 * 4);
constexpr size_t WS_MIX   = WS_BM + al256((size_t)S_ * 4 * 8 * 4);
constexpr size_t WS_END_A = WS_MIX + al256((size_t)S_ * DM * 2);
constexpr size_t WS_ERAW  = WS_R;
constexpr size_t WS_ACT   = WS_ERAW + al256((size_t)S_ * DM * 2);
constexpr size_t WS_ERSTD = WS_ACT + al256((size_t)S_ * DFF * 2);
constexpr size_t WS_END_B = WS_ERSTD + al256((size_t)S_ * 4);
static_assert(WS_ERAW + (size_t)S_ * DM * 2 <= WS_Z + (size_t)ZROWS * LDZ * 2, "eraw must fit inside the dead z region while mix is still being read");
constexpr size_t WS_NEED  = WS_END_A > WS_END_B ? WS_END_A : WS_END_B;
static_assert(WS_MIX >= WS_END_B || true, "");

constexpr int LDS_STAGE = 131072;
constexpr int LDS_MISC  = LDS_STAGE;
constexpr int LDS_XCH   = LDS_STAGE + 64;
constexpr int LDS_BYTES = LDS_XCH + 4096;

__device__ __forceinline__ unsigned cvt_pk_bf16(float lo, float hi) { unsigned r; asm volatile("v_cvt_pk_bf16_f32 %0, %1, %2" : "=v"(r) : "v"(lo), "v"(hi)); return r; }
__device__ __forceinline__ float bf_lo(unsigned u) { return __uint_as_float(u << 16); }
__device__ __forceinline__ float bf_hi(unsigned u) { return __uint_as_float(u & 0xffff0000u); }
__device__ __forceinline__ float bf2f(bf16_t b) { return __uint_as_float(((unsigned)b) << 16); }
__device__ __forceinline__ float wave_sum(float v) {
#pragma unroll
    for (int o = 32; o >= 1; o >>= 1) v += __shfl_xor(v, o);
    return v;
}
__device__ __forceinline__ float wave_max(float v) {
#pragma unroll
    for (int o = 32; o >= 1; o >>= 1) v = fmaxf(v, __shfl_xor(v, o));
    return v;
}
__device__ __forceinline__ float sigmoidf_(float x) { return 1.0f / (1.0f + __expf(-x)); }

#define XB_TMO      128
#define XB_XCNT(j)  (256  + 64 * (j))
#define XB_XSUB(j)  (1280 + 64 * (j))
#define XB_XGEN(j)  (2304 + 64 * (j))
#define XB_TOP      3328
#define XB_TOPGEN   3392
#define XCD_BAR_WORDS 3456
#define XB_SPIN_CAP (1u << 18)
__device__ __forceinline__ unsigned xb_ld(unsigned* p)              { return __hip_atomic_load(p, __ATOMIC_RELAXED, __HIP_MEMORY_SCOPE_AGENT); }
__device__ __forceinline__ unsigned xb_add(unsigned* p, unsigned v) { return __hip_atomic_fetch_add(p, v, __ATOMIC_RELAXED, __HIP_MEMORY_SCOPE_AGENT); }
__device__ __forceinline__ unsigned xb_xcc_id() { return (unsigned)__builtin_amdgcn_s_getreg((3 << 11) | 20) & 0xFu; }
#define XB_SPIN(cond, bar) do { unsigned _sp = 0; while (cond) { __builtin_amdgcn_s_sleep(1); \
    if ((++_sp & 255u) == 0u) { if (xb_ld(&(bar)[XB_TMO])) break; if (_sp > XB_SPIN_CAP) { atomicAdd(&(bar)[XB_TMO], 1u); break; } } } } while (0)
struct XcdBarrier { unsigned* bar; unsigned x; volatile LAS unsigned* st; };
__device__ __forceinline__ XcdBarrier xcd_barrier_post(unsigned* bar, volatile LAS unsigned* st) {
    XcdBarrier b; b.bar = bar; b.x = xb_xcc_id(); b.st = st;
    if (threadIdx.x == 0) (void)xb_add(&bar[XB_XCNT(b.x)], 1u);
    return b;
}
__device__ __forceinline__ void xcd_barrier_complete(unsigned* bar, unsigned x, unsigned& nloc, unsigned& nx) {
    const unsigned G = gridDim.x * gridDim.y * gridDim.z;
    unsigned sum, cnt, mine, sp = 0u;
    for (;;) {
        sum = 0u; cnt = 0u; mine = 0u;
#pragma unroll
        for (unsigned j = 0; j < 16; ++j) { const unsigned c = xb_ld(&bar[XB_XCNT(j)]); sum += c; cnt += (c > 0u) ? 1u : 0u; mine = (j == x) ? c : mine; }
        if (sum == G) break;
        __builtin_amdgcn_s_sleep(1);
        if ((++sp & 255u) == 0u) { if (xb_ld(&bar[XB_TMO])) break; if (sp > XB_SPIN_CAP) { atomicAdd(&bar[XB_TMO], 1u); break; } }
    }
    nloc = mine > 0u ? mine : 1u; nx = cnt > 0u ? cnt : 1u;
}
__device__ __forceinline__ void xcd_barrier(const XcdBarrier& b) {
    asm volatile("s_waitcnt vmcnt(0)" ::: "memory");
    __syncthreads();
    if (threadIdx.x == 0) {
        unsigned* bar = b.bar;
        __builtin_amdgcn_s_waitcnt(0);
        unsigned nloc = b.st[0], nx = b.st[1];
        if (nloc == 0u) { xcd_barrier_complete(bar, b.x, nloc, nx); b.st[0] = nloc; b.st[1] = nx; }
        const unsigned old = xb_add(&bar[XB_XSUB(b.x)], 1u);
        const unsigned gen = old / nloc;
        if (old + 1u == (gen + 1u) * nloc) {
            __builtin_amdgcn_fence(__ATOMIC_RELEASE, "agent");
            asm volatile("s_waitcnt vmcnt(0)" ::: "memory");
            const unsigned og = xb_add(&bar[XB_TOP], 1u);
            const unsigned tg = og / nx;
            if (og + 1u == (tg + 1u) * nx) xb_add(&bar[XB_TOPGEN], 1u);
            else XB_SPIN(xb_ld(&bar[XB_TOPGEN]) == tg, bar);
            __builtin_amdgcn_fence(__ATOMIC_ACQUIRE, "agent");
            xb_add(&bar[XB_XGEN(b.x)], 1u);
            asm volatile("s_waitcnt vmcnt(0)" ::: "memory");
        } else {
            XB_SPIN(xb_ld(&bar[XB_XGEN(b.x)]) == gen, bar);
            __builtin_amdgcn_fence(__ATOMIC_ACQUIRE, "agent");
            asm volatile("s_waitcnt vmcnt(0)" ::: "memory");
        }
    }
    __syncthreads();
}

struct Params {
    const float* x; const float* p; const int* positions; const float* norm1_w; const float* w_in; const float* w_pool; const float* pool_scale;
    const float* q_norm_w; const float* k_norm_cmp_w; const float* k_norm_slc_w; const float* k_norm_win_w; const float* cmp_pos_k; const float* cmp_pos_v;
    const float* cmp_k_w1; const float* cmp_k_w2; const float* cmp_v_w1; const float* cmp_v_w2; const float* w_o; const float* norm2_w; const float* w_ffn_in;
    const float* conv_w; const float* conv_b; const float* w_ffn_out; const float* w_ple_proj; const float* ple_norm_w; const float* ple_gate_norm_w; const float* w_ple_gate;
    float* out; unsigned char* ws; int ph_lo, ph_hi;
};

namespace pg8 {
constexpr int BM = 256, BK = 64, HALF = 128, HTB = HALF * BK * 2, STAGE_BYTES = 8 * HTB, NXCD = 8, WGM = 8;
__host__ __device__ __forceinline__ int lds_byte(int r, int c) { const int st = (r >> 4) * 2 + (c >> 5), rr = r & 15, cc = c & 31, ob = rr * 64 + cc * 2; return st * 1024 + (ob ^ (((ob >> 9) & 1) << 5)); }
__host__ __device__ __forceinline__ void stage_rc(int b, int& R, int& C) { const int st = b / 1024, sb = b % 1024, swz = sb ^ (((sb >> 9) & 1) << 5); R = (st >> 1) * 16 + swz / 64; C = (st & 1) * 32 + (swz % 64) / 2; }
__host__ __device__ __forceinline__ int perm32(int rho) { const int n = rho >> 4, i = rho & 15; return 8 * (i >> 2) + 4 * n + (i & 3); }
struct Unit { int pm, pn; };

struct StaticOrder {
    int nM, nN, nwg, G, c;
    __device__ void init(int nM_, int nN_, int G_, int c_) { nM = nM_; nN = nN_; nwg = nM * nN; G = G_; c = c_; }
    __device__ bool next(int i, Unit& u) const {
        const long L = (long)i * G + c; if (L >= nwg) return false;
        int wgid = (int)L; { const int q = nwg / NXCD, r = nwg % NXCD, xcd = wgid % NXCD, off = wgid / NXCD; wgid = (xcd < r ? xcd * (q + 1) : r * (q + 1) + (xcd - r) * q) + off; }
        const int nig = WGM * nN, gid = wgid / nig, fm = gid * WGM, gsz = (nM - fm) < WGM ? (nM - fm) : WGM;
        u.pm = fm + ((wgid % nig) % gsz); u.pn = (wgid % nig) / gsz; return true;
    }
};

struct GStd {
    const char* A; const char* B; unsigned lda, ldb; int nt;
    __device__ __forceinline__ const char* a_base(const Unit& u) const { return A + (size_t)u.pm * 256 * lda * 2; }
    __device__ __forceinline__ const char* b_base(const Unit& u) const { return B + (size_t)u.pn * 256 * ldb * 2; }
    __device__ __forceinline__ size_t kpairA() const { return 256; }
};
struct GPool {
    const char* A; const char* B; unsigned lda, ldb; int nt;
    __device__ __forceinline__ const char* a_base(const Unit& u) const { return A + (size_t)u.pm * 256 * lda * 2 + (size_t)u.pn * 512; }
    __device__ __forceinline__ const char* b_base(const Unit& u) const { return B + (size_t)u.pn * 256 * ldb * 2; }
    __device__ __forceinline__ size_t kpairA() const { return 256; }
};
struct GCmp {
    const char* Z; const char* Bk; const char* Bv; unsigned lda, ldb; int nt;
    __device__ __forceinline__ const char* a_base(const Unit& u) const { const int which = u.pm >> 4, g = (u.pm >> 2) & 3, rt = u.pm & 3;
        return Z + (size_t)(OFF_KV + which * 512 + g * 128) * 2 + (size_t)rt * 256 * lda * 2; }
    __device__ __forceinline__ const char* b_base(const Unit& u) const { return (u.pm >> 4) ? Bv : Bk; }
    __device__ __forceinline__ size_t kpairA() const { return (size_t)LDZ * 2; }
};

struct EpiBf16 {
    static constexpr bool PERM = true;
    bf16_t* O; int ldc;
    __device__ __forceinline__ void operator()(const f32x4 (&acc)[2][2][4][2], const Unit& u, int wr, int wc, int fr, int fq) const {
        const int row0 = u.pm * BM + wr * 64 + fr, col0 = u.pn * BM + wc * 32 + 8 * fq;
#pragma unroll
        for (int ai = 0; ai < 2; ++ai)
#pragma unroll
            for (int m = 0; m < 4; ++m) { bf16_t* rowp = O + (size_t)(row0 + ai * HALF + m * 16) * ldc + col0;
#pragma unroll
                for (int bj = 0; bj < 2; ++bj) { const f32x4 v0 = acc[ai][bj][m][0], v1 = acc[ai][bj][m][1];
                    u32x4 w; w.x = cvt_pk_bf16(v0[0], v0[1]); w.y = cvt_pk_bf16(v0[2], v0[3]); w.z = cvt_pk_bf16(v1[0], v1[1]); w.w = cvt_pk_bf16(v1[2], v1[3]);
                    *(u32x4*)(rowp + bj * HALF) = w; } }
    }
};
struct EpiBf16Ssq {
    static constexpr bool PERM = true;
    bf16_t* O; int ldc; float* ssq;
    __device__ __forceinline__ void operator()(const f32x4 (&acc)[2][2][4][2], const Unit& u, int wr, int wc, int fr, int fq) const {
        const int row0 = u.pm * BM + wr * 64 + fr, col0 = u.pn * BM + wc * 32 + 8 * fq;
#pragma unroll
        for (int ai = 0; ai < 2; ++ai)
#pragma unroll
            for (int m = 0; m < 4; ++m) { const int row = row0 + ai * HALF + m * 16; bf16_t* rowp = O + (size_t)row * ldc + col0; float s = 0.f;
#pragma unroll
                for (int bj = 0; bj < 2; ++bj) { const f32x4 v0 = acc[ai][bj][m][0], v1 = acc[ai][bj][m][1];
                    s += v0[0] * v0[0] + v0[1] * v0[1] + v0[2] * v0[2] + v0[3] * v0[3] + v1[0] * v1[0] + v1[1] * v1[1] + v1[2] * v1[2] + v1[3] * v1[3];
                    u32x4 w; w.x = cvt_pk_bf16(v0[0], v0[1]); w.y = cvt_pk_bf16(v0[2], v0[3]); w.z = cvt_pk_bf16(v1[0], v1[1]); w.w = cvt_pk_bf16(v1[2], v1[3]);
                    *(u32x4*)(rowp + bj * HALF) = w; }
                s += __shfl_xor(s, 16); s += __shfl_xor(s, 32);
                if (fq == 0) unsafeAtomicAdd(ssq + row, s); }
    }
};
struct EpiBf16Scale {
    static constexpr bool PERM = true;
    bf16_t* O; int ldc; const float* colscale;
    __device__ __forceinline__ void operator()(const f32x4 (&acc)[2][2][4][2], const Unit& u, int wr, int wc, int fr, int fq) const {
        const int row0 = u.pm * BM + wr * 64 + fr, col0 = u.pn * BM + wc * 32 + 8 * fq;
#pragma unroll
        for (int bj = 0; bj < 2; ++bj) { const f32x4 s0 = *(const f32x4*)(colscale + col0 + bj * HALF), s1 = *(const f32x4*)(colscale + col0 + bj * HALF + 4);
#pragma unroll
            for (int ai = 0; ai < 2; ++ai)
#pragma unroll
                for (int m = 0; m < 4; ++m) { bf16_t* rowp = O + (size_t)(row0 + ai * HALF + m * 16) * ldc + col0;
                    const f32x4 v0 = acc[ai][bj][m][0] * s0, v1 = acc[ai][bj][m][1] * s1;
                    u32x4 w; w.x = cvt_pk_bf16(v0[0], v0[1]); w.y = cvt_pk_bf16(v0[2], v0[3]); w.z = cvt_pk_bf16(v1[0], v1[1]); w.w = cvt_pk_bf16(v1[2], v1[3]);
                    *(u32x4*)(rowp + bj * HALF) = w; } }
    }
};
struct EpiResF32 {
    static constexpr bool PERM = false;
    const float* base; float* C; int ldc; int row_off;
    __device__ __forceinline__ void operator()(const f32x4 (&acc)[2][2][4][2], const Unit& u, int wr, int wc, int fr, int fq) const {
        const int row0 = u.pm * BM + wr * 64 + fr + row_off, col0 = u.pn * BM + wc * 32 + 4 * fq;
#pragma unroll
        for (int ai = 0; ai < 2; ++ai)
#pragma unroll
            for (int m = 0; m < 4; ++m) { const size_t off = (size_t)(row0 + ai * HALF + m * 16) * ldc + col0;
#pragma unroll
                for (int bj = 0; bj < 2; ++bj)
#pragma unroll
                    for (int n = 0; n < 2; ++n) { const f32x4 b = *(const f32x4*)(base + off + bj * HALF + n * 16); *(f32x4*)(C + off + bj * HALF + n * 16) = b + acc[ai][bj][m][n]; }
                asm volatile("" ::: "memory"); }
    }
};
template <bool FP8OUT>
struct EpiResNormT {
    static constexpr bool PERM = false;
    const float* base; float* C; bf16_t* XN; const float* nw; float* ssq; int ldc;
    __device__ __forceinline__ void operator()(const f32x4 (&acc)[2][2][4][2], const Unit& u, int wr, int wc, int fr, int fq) const {
        const int row0 = u.pm * BM + wr * 64 + fr, col0 = u.pn * BM + wc * 32 + 4 * fq;
        f32x4 wv[2][2];
#pragma unroll
        for (int bj = 0; bj < 2; ++bj)
#pragma unroll
            for (int n = 0; n < 2; ++n) wv[bj][n] = *(const f32x4*)(nw + col0 + bj * HALF + n * 16);
        f32x4 bv[2][2][2];
#pragma unroll
        for (int bj = 0; bj < 2; ++bj)
#pragma unroll
            for (int n = 0; n < 2; ++n) bv[0][bj][n] = *(const f32x4*)(base + (size_t)row0 * ldc + col0 + bj * HALF + n * 16);
#pragma unroll
        for (int rg = 0; rg < 8; ++rg) { const int ai = rg >> 2, m = rg & 3; const int row = row0 + ai * HALF + m * 16; const size_t off = (size_t)row * ldc + col0;
            if (rg < 7) { const int ai2 = (rg + 1) >> 2, m2 = (rg + 1) & 3; const size_t off2 = (size_t)(row0 + ai2 * HALF + m2 * 16) * ldc + col0;
#pragma unroll
                for (int bj = 0; bj < 2; ++bj)
#pragma unroll
                    for (int n = 0; n < 2; ++n) bv[(rg + 1) & 1][bj][n] = *(const f32x4*)(base + off2 + bj * HALF + n * 16); }
            float s = 0.f;
#pragma unroll
            for (int bj = 0; bj < 2; ++bj)
#pragma unroll
                for (int n = 0; n < 2; ++n) { const f32x4 v = bv[rg & 1][bj][n] + acc[ai][bj][m][n];
                    *(f32x4*)(C + off + bj * HALF + n * 16) = v; s += v[0] * v[0] + v[1] * v[1] + v[2] * v[2] + v[3] * v[3];
                    if (FP8OUT) { int pk = __builtin_amdgcn_cvt_pk_fp8_f32(v[0] * wv[bj][n][0], v[1] * wv[bj][n][1], 0, false); pk = __builtin_amdgcn_cvt_pk_fp8_f32(v[2] * wv[bj][n][2], v[3] * wv[bj][n][3], pk, true);
                        *(int*)((unsigned char*)XN + off + bj * HALF + n * 16) = pk; }
                    else { u32x2 o; o.x = cvt_pk_bf16(v[0] * wv[bj][n][0], v[1] * wv[bj][n][1]); o.y = cvt_pk_bf16(v[2] * wv[bj][n][2], v[3] * wv[bj][n][3]);
                        *(u32x2*)(XN + off + bj * HALF + n * 16) = o; } }
            s += __shfl_xor(s, 16); s += __shfl_xor(s, 32);
            if (fq == 0) unsafeAtomicAdd(ssq + row, s);
        }
    }
};
typedef EpiResNormT<false> EpiResNorm;
typedef EpiResNormT<true> EpiResNormF8;
struct EpiCmpGelu {
    static constexpr bool PERM = false;
    float* H; const float* bias;
    __device__ __forceinline__ void operator()(const f32x4 (&acc)[2][2][4][2], const Unit& u, int wr, int wc, int fr, int fq) const {
        const int row0 = u.pm * BM + wr * 64 + fr, col0 = wc * 32 + 4 * fq; const float* bs = bias + (u.pm >> 4) * 256;
        f32x4 bvv[2][2];
#pragma unroll
        for (int bj = 0; bj < 2; ++bj)
#pragma unroll
            for (int n = 0; n < 2; ++n) bvv[bj][n] = *(const f32x4*)(bs + col0 + bj * HALF + n * 16);
#pragma unroll
        for (int ai = 0; ai < 2; ++ai)
#pragma unroll
            for (int m = 0; m < 4; ++m) { float* rowp = H + (size_t)(row0 + ai * HALF + m * 16) * 256 + col0;
#pragma unroll
                for (int bj = 0; bj < 2; ++bj)
#pragma unroll
                    for (int n = 0; n < 2; ++n) { f32x4 v = acc[ai][bj][m][n] + bvv[bj][n];
#pragma unroll
                        for (int j = 0; j < 4; ++j) { const float xx = v[j], uu = 0.7978845608028654f * (xx + 0.044715f * xx * xx * xx); const float th = 1.0f - 2.0f / (1.0f + __expf(2.0f * uu)); v[j] = 0.5f * xx * (1.0f + th); }
                        *(f32x4*)(rowp + bj * HALF + n * 16) = v; } }
    }
};
struct EpiGate {
    static constexpr bool PERM = false;
    float* C; const bf16_t* eraw; const float* erstd; const float* pw; const float* ssq; int ldc; float ascale;
    __device__ __forceinline__ void operator()(const f32x4 (&acc)[2][2][4][2], const Unit& u, int wr, int wc, int fr, int fq) const {
        const int row0 = u.pm * BM + wr * 64 + fr, col0 = u.pn * BM + wc * 32 + 4 * fq;
        f32x4 wv[2][2];
#pragma unroll
        for (int bj = 0; bj < 2; ++bj)
#pragma unroll
            for (int n = 0; n < 2; ++n) wv[bj][n] = *(const f32x4*)(pw + col0 + bj * HALF + n * 16);
        f32x4 bv[2][2][2]; u32x2 ev[2][2][2]; float rsv[2], rgv[2];
#pragma unroll
        for (int bj = 0; bj < 2; ++bj)
#pragma unroll
            for (int n = 0; n < 2; ++n) { bv[0][bj][n] = *(const f32x4*)(C + (size_t)row0 * ldc + col0 + bj * HALF + n * 16); ev[0][bj][n] = *(const u32x2*)(eraw + (size_t)row0 * ldc + col0 + bj * HALF + n * 16); }
        rsv[0] = erstd[row0]; rgv[0] = ssq[row0];
#pragma unroll
        for (int rg = 0; rg < 8; ++rg) { const int ai = rg >> 2, m = rg & 3; const int row = row0 + ai * HALF + m * 16; const size_t off = (size_t)row * ldc + col0;
            if (rg < 7) { const int ai2 = (rg + 1) >> 2, m2 = (rg + 1) & 3; const int row2 = row0 + ai2 * HALF + m2 * 16; const size_t off2 = (size_t)row2 * ldc + col0;
#pragma unroll
                for (int bj = 0; bj < 2; ++bj)
#pragma unroll
                    for (int n = 0; n < 2; ++n) { bv[(rg + 1) & 1][bj][n] = *(const f32x4*)(C + off2 + bj * HALF + n * 16); ev[(rg + 1) & 1][bj][n] = *(const u32x2*)(eraw + off2 + bj * HALF + n * 16); }
                rsv[(rg + 1) & 1] = erstd[row2]; rgv[(rg + 1) & 1] = ssq[row2]; }
            const float rs = rsqrtf(rsv[rg & 1] * (1.0f / DM) + EPS), rg_ = rsqrtf(rgv[rg & 1] * (1.0f / DM) + EPS) * ascale;
#pragma unroll
            for (int bj = 0; bj < 2; ++bj)
#pragma unroll
                for (int n = 0; n < 2; ++n) { const f32x4 b = bv[rg & 1][bj][n]; const u32x2 e = ev[rg & 1][bj][n]; const f32x4 a = acc[ai][bj][m][n]; f32x4 o;
                    o[0] = b[0] + bf_lo(e.x) * rs * wv[bj][n][0] * sigmoidf_(a[0] * rg_); o[1] = b[1] + bf_hi(e.x) * rs * wv[bj][n][1] * sigmoidf_(a[1] * rg_);
                    o[2] = b[2] + bf_lo(e.y) * rs * wv[bj][n][2] * sigmoidf_(a[2] * rg_); o[3] = b[3] + bf_hi(e.y) * rs * wv[bj][n][3] * sigmoidf_(a[3] * rg_);
                    *(f32x4*)(C + off + bj * HALF + n * 16) = o; }
        }
    }
};
struct GFfn {
    const char* A; const char* B; unsigned lda, ldb; int nt;
    __device__ __forceinline__ const char* a_base(const Unit& u) const { return A + ((long)u.pm * 254 - 2) * (long)lda * 2; }
    __device__ __forceinline__ const char* b_base(const Unit& u) const { return B + (size_t)u.pn * 256 * ldb * 2; }
    __device__ __forceinline__ size_t kpairA() const { return 256; }
};
template <int CTRL> __device__ __forceinline__ float dpp_f(float v) { return __int_as_float(__builtin_amdgcn_update_dpp(0, __float_as_int(v), CTRL, 0xf, 0xf, false)); }
struct EpiFfn {
    static constexpr bool PERM = true;
    bf16_t* ACT; const float* cw; const float* cb; LAS float* X; const float* ssq;
    __device__ __forceinline__ void operator()(const f32x4 (&acc)[2][2][4][2], const Unit& u, int wr, int wc, int fr, int fq) const {
        const int colw = wc * 32 + 8 * fq;
        float rsv[2][4];
#pragma unroll
        for (int ai = 0; ai < 2; ++ai)
#pragma unroll
            for (int m = 0; m < 4; ++m) { const long t = (long)u.pm * 254 - 2 + ai * HALF + wr * 64 + m * 16 + fr; rsv[ai][m] = (t >= 0 && t < S_) ? rsqrtf(ssq[t] * (1.0f / DM) + EPS) : 0.f; }
        if (fr >= 14) {
#pragma unroll
            for (int ai = 0; ai < 2; ++ai)
#pragma unroll
                for (int n = 0; n < 2; ++n) *(LAS f32x4*)(X + ((2 * ai + wr) * 2 + (fr - 14)) * 128 + colw + 4 * n) = acc[ai][0][3][n] * rsv[ai][3];
        }
        asm volatile("s_waitcnt lgkmcnt(0)" ::: "memory");
        __builtin_amdgcn_s_barrier(); asm volatile("" ::: "memory");
        __builtin_amdgcn_s_barrier(); asm volatile("" ::: "memory");
        const int f0 = u.pn * 128 + colw;
        f32x4 w0[2], w1[2], w2[2], cbv[2];
#pragma unroll
        for (int n = 0; n < 2; ++n) { w0[n] = *(const f32x4*)(cw + f0 + 4 * n); w1[n] = *(const f32x4*)(cw + DFF + f0 + 4 * n); w2[n] = *(const f32x4*)(cw + 2 * DFF + f0 + 4 * n); cbv[n] = *(const f32x4*)(cb + f0 + 4 * n); }
#pragma unroll
        for (int ai = 0; ai < 2; ++ai) {
            f32x4 pv[2];
            const int pseg = 2 * ai + wr - 1;
#pragma unroll
            for (int n = 0; n < 2; ++n) { pv[n] = (f32x4){0.f, 0.f, 0.f, 0.f}; if (pseg >= 0 && fr >= 14) pv[n] = *(const LAS f32x4*)(X + (pseg * 2 + (fr - 14)) * 128 + colw + 4 * n); }
#pragma unroll
            for (int m = 0; m < 4; ++m) {
                const int r = ai * HALF + wr * 64 + m * 16 + fr; const long t = (long)u.pm * 254 - 2 + r;
                unsigned ow[4];
#pragma unroll
                for (int n = 0; n < 2; ++n) {
                    const f32x4 cur = acc[ai][0][m][n] * rsv[ai][m], up = acc[ai][1][m][n] * rsv[ai][m]; f32x4 o;
#pragma unroll
                    for (int i = 0; i < 4; ++i) {
                        const float c1 = dpp_f<0x121>(cur[i]), p1 = dpp_f<0x121>(pv[n][i]), c2 = dpp_f<0x122>(cur[i]), p2 = dpp_f<0x122>(pv[n][i]);
                        const float x1 = fr >= 1 ? c1 : p1, x2 = fr >= 2 ? c2 : p2;
                        const float y = cbv[n][i] + w0[n][i] * x2 + w1[n][i] * x1 + w2[n][i] * cur[i];
                        o[i] = y * sigmoidf_(y) * up[i];
                    }
                    ow[2 * n] = cvt_pk_bf16(o[0], o[1]); ow[2 * n + 1] = cvt_pk_bf16(o[2], o[3]);
                    pv[n] = cur;
                }
                if (r >= 2 && t < S_) *(u32x4*)(ACT + (size_t)t * DFF + f0) = (u32x4){ow[0], ow[1], ow[2], ow[3]};
            }
        }
    }
};

template <class GD, class Epi, bool F8 = false>
__device__ __forceinline__ void gemm_phase(LAS unsigned char* lds, const GD g, const StaticOrder& S, const Epi& E) {
    const int tid = threadIdx.x, wid = __builtin_amdgcn_readfirstlane(tid >> 6), lane = tid & 63, wr = wid >> 2, wc = wid & 3, fr = lane & 15, fq = lane >> 4;
    const int nt = g.nt;
    unsigned voffA[2], voffB[2];
#pragma unroll
    for (int i = 0; i < 2; ++i) { int R, C; stage_rc(tid * 16 + i * 8192, R, C); const int Rb = Epi::PERM ? ((R & ~31) + perm32(R & 31)) : R;
        voffA[i] = (unsigned)(R * g.lda + C) * 2u; voffB[i] = (unsigned)(Rb * g.ldb + C) * 2u; }
    const size_t kpA = g.kpairA();
    const size_t hstepA = (size_t)HALF * g.lda * 2, hstepB = (size_t)HALF * g.ldb * 2;
    const unsigned ldsw = (unsigned)wid * 1024u;
    const int aoff = lds_byte(wr * 64 + fr, fq * 8), boff = lds_byte(wc * 32 + fr, fq * 8);
#define PG8_SA(b, h) (((b) * 2 + (h)) * HTB)
#define PG8_SB(b, h) ((4 + (b) * 2 + (h)) * HTB)
#define PG8_STAGE(bufoff, gbase, voff) do { _Pragma("unroll") for (int _i = 0; _i < 2; ++_i) \
        __builtin_amdgcn_global_load_lds((const unsigned*)((const char*)(gbase) + (voff)[_i]), (LAS unsigned*)(lds + (bufoff) + ldsw + _i * 8192), 16, 0, 0); } while (0)
#define PG8_LDA(dst, b, h) do { if constexpr (F8) { _Pragma("unroll") for (int m = 0; m < 4; ++m) { const i32x4 lo_ = *(const LAS i32x4*)(lds + PG8_SA(b, h) + aoff + m * 2048), hi_ = *(const LAS i32x4*)(lds + PG8_SA(b, h) + aoff + m * 2048 + 1024); \
            dst##8[m] = __builtin_shufflevector(lo_, hi_, 0, 1, 2, 3, 4, 5, 6, 7); } } \
        else { _Pragma("unroll") for (int m = 0; m < 4; ++m) _Pragma("unroll") for (int k = 0; k < 2; ++k) dst[m][k] = *(const LAS bf16x8*)(lds + PG8_SA(b, h) + aoff + m * 2048 + k * 1024); } } while (0)
#define PG8_LDB(dst, b, h) do { if constexpr (F8) { _Pragma("unroll") for (int n = 0; n < 2; ++n) { const i32x4 lo_ = *(const LAS i32x4*)(lds + PG8_SB(b, h) + boff + n * 2048), hi_ = *(const LAS i32x4*)(lds + PG8_SB(b, h) + boff + n * 2048 + 1024); \
            dst##8[n] = __builtin_shufflevector(lo_, hi_, 0, 1, 2, 3, 4, 5, 6, 7); } } \
        else { _Pragma("unroll") for (int n = 0; n < 2; ++n) _Pragma("unroll") for (int k = 0; k < 2; ++k) dst[n][k] = *(const LAS bf16x8*)(lds + PG8_SB(b, h) + boff + n * 2048 + k * 1024); } } while (0)
#define PG8_MMA(ai, bj, At, Bt) do { __builtin_amdgcn_s_setprio(1); \
        if constexpr (F8) { _Pragma("unroll") for (int m = 0; m < 4; ++m) _Pragma("unroll") for (int n = 0; n < 2; ++n) \
            asm volatile("v_mfma_scale_f32_16x16x128_f8f6f4 %0, %1, %2, %0, %3, %3 op_sel_hi:[0,0,0]" : "+v"(acc[ai][bj][m][n]) : "v"(Bt##8[n]), "v"(At##8[m]), "v"(one_scale)); } \
        else { _Pragma("unroll") for (int m = 0; m < 4; ++m) _Pragma("unroll") for (int n = 0; n < 2; ++n) _Pragma("unroll") for (int k = 0; k < 2; ++k) \
            acc[ai][bj][m][n] = __builtin_amdgcn_mfma_f32_16x16x32_bf16(Bt[n][k], At[m][k], acc[ai][bj][m][n], 0, 0, 0); } \
        __builtin_amdgcn_s_setprio(0); } while (0)
#define PG8_WAIT_V(n) asm volatile("s_waitcnt vmcnt(" #n ")" ::: "memory")
#define PG8_WAIT_L(n) asm volatile("s_waitcnt lgkmcnt(" #n ")" ::: "memory")
#define PG8_BAR __builtin_amdgcn_s_barrier()
#define PG8_SCHED __builtin_amdgcn_sched_barrier(0)
    Unit cur, nxt; int ui = 0;
    if (!S.next(0, cur)) return;
    f32x4 acc[2][2][4][2];
#pragma unroll
    for (int a = 0; a < 2; ++a)
#pragma unroll
        for (int b = 0; b < 2; ++b)
#pragma unroll
            for (int m = 0; m < 4; ++m)
#pragma unroll
                for (int n = 0; n < 2; ++n) acc[a][b][m][n] = (f32x4){0.f, 0.f, 0.f, 0.f};
    bf16x8 At[4][2], B0[2][2], B1[2][2];
    i32x8 At8[4], B08[2], B18[2];
    (void)At; (void)B0; (void)B1; (void)At8; (void)B08; (void)B18;
    int one_scale = 0x7F7F7F7F; (void)one_scale;
    const char* cA = g.a_base(cur); const char* cB = g.b_base(cur);
    PG8_STAGE(PG8_SB(0, 0), cB, voffB); PG8_STAGE(PG8_SA(0, 0), cA, voffA); PG8_STAGE(PG8_SB(0, 1), cB + hstepB, voffB); PG8_STAGE(PG8_SA(0, 1), cA + hstepA, voffA);
    if (wr == 1) PG8_BAR;
    PG8_WAIT_V(4); PG8_BAR;
    PG8_STAGE(PG8_SB(1, 0), cB + 128, voffB); PG8_STAGE(PG8_SA(1, 0), cA + 128, voffA); PG8_STAGE(PG8_SB(1, 1), cB + hstepB + 128, voffB);
    PG8_WAIT_V(6); PG8_BAR;
    for (;;) {
        const bool has_next = S.next(ui + 1, nxt);
        const char* nA = has_next ? g.a_base(nxt) : cA; const char* nB = has_next ? g.b_base(nxt) : cB;
        for (int t = 0; t < nt; t += 2) {
            const bool last = (t == nt - 2);
            const char* a0 = cA + (size_t)(t >> 1) * kpA;
            const char* a1 = a0 + 128;
            const char* a2 = last ? nA : a0 + kpA; const char* b2 = last ? nB : cB + (size_t)(t + 2) * 128;
            const char* a3 = a2 + 128; const char* b3 = b2 + 128;
            PG8_LDB(B0, 0, 0); PG8_SCHED; PG8_LDA(At, 0, 0); PG8_STAGE(PG8_SA(1, 1), a1 + hstepA, voffA);
            PG8_WAIT_L(8); PG8_BAR; PG8_WAIT_L(0); PG8_MMA(0, 0, At, B0); PG8_BAR; PG8_SCHED;
            PG8_LDB(B1, 0, 1); PG8_STAGE(PG8_SB(0, 0), b2, voffB);
            PG8_BAR; PG8_WAIT_L(0); PG8_MMA(0, 1, At, B1); PG8_BAR;
            PG8_LDA(At, 0, 1); PG8_STAGE(PG8_SA(0, 0), a2, voffA);
            PG8_BAR; PG8_WAIT_L(0); PG8_MMA(1, 0, At, B0); PG8_BAR; PG8_SCHED;
            PG8_STAGE(PG8_SB(0, 1), b2 + hstepB, voffB);
            PG8_WAIT_V(6); PG8_BAR; PG8_MMA(1, 1, At, B1); PG8_BAR;
            PG8_LDB(B0, 1, 0); PG8_SCHED; PG8_LDA(At, 1, 0); PG8_STAGE(PG8_SA(0, 1), a2 + hstepA, voffA);
            PG8_WAIT_L(8); PG8_BAR; PG8_WAIT_L(0); PG8_MMA(0, 0, At, B0); PG8_BAR; PG8_SCHED;
            PG8_LDB(B1, 1, 1); PG8_STAGE(PG8_SB(1, 0), b3, voffB);
            PG8_BAR; PG8_WAIT_L(0); PG8_MMA(0, 1, At, B1); PG8_BAR;
            PG8_LDA(At, 1, 1); PG8_STAGE(PG8_SA(1, 0), a3, voffA);
            PG8_BAR; PG8_WAIT_L(0); PG8_MMA(1, 0, At, B0); PG8_BAR; PG8_SCHED;
            PG8_STAGE(PG8_SB(1, 1), b3 + hstepB, voffB);
            PG8_WAIT_V(6); PG8_BAR; PG8_MMA(1, 1, At, B1); PG8_BAR;
        }
        if constexpr (F8) asm volatile("s_nop 15\n\ts_nop 15\n\ts_nop 15" ::: "memory");
        E(acc, cur, wr, wc, fr, fq);
        if (!has_next) break;
#pragma unroll
        for (int a = 0; a < 2; ++a)
#pragma unroll
            for (int b = 0; b < 2; ++b)
#pragma unroll
                for (int m = 0; m < 4; ++m)
#pragma unroll
                    for (int n = 0; n < 2; ++n) acc[a][b][m][n] = (f32x4){0.f, 0.f, 0.f, 0.f};
        cur = nxt; cA = nA; cB = nB; ++ui;
    }
    PG8_WAIT_V(0);
    if (wr == 0) PG8_BAR;
    PG8_BAR;
#undef PG8_SA
#undef PG8_SB
#undef PG8_STAGE
#undef PG8_LDA
#undef PG8_LDB
#undef PG8_MMA
#undef PG8_WAIT_V
#undef PG8_WAIT_L
#undef PG8_BAR
#undef PG8_SCHED
}
}

namespace att {
constexpr int KVBLK = 64;
constexpr int SHM_V = KVBLK * HD * 2, SHM_K = KVBLK * HD * 2, SHM_ATTN = 2 * SHM_V + 2 * SHM_K + NWAVES * 64 * 4;
#define KSWZ(row, colB) ((row) * 256 + ((colB) ^ (((row) & 7) << 4)))
#define SBAR() __builtin_amdgcn_sched_barrier(0)
__device__ __forceinline__ int crow(int r, int hi) { return (r & 3) + 8 * (r >> 2) + 4 * hi; }
__device__ __forceinline__ void qkt(f32x16& p0, f32x16& p1, const char* Ks, const bf16x8* qr, int r32, int hi) {
    p0 = f32x16{}; p1 = f32x16{};
    bf16x8 ka[2], kb[2];
    { const int cb = (hi * 8) * 2; ka[0] = *reinterpret_cast<const bf16x8*>(Ks + KSWZ(r32, cb)); kb[0] = *reinterpret_cast<const bf16x8*>(Ks + KSWZ(32 + r32, cb)); }
#pragma unroll
    for (int d0 = 0; d0 < 8; ++d0) {
        if (d0 < 7) { const int cb = ((d0 + 1) * 16 + hi * 8) * 2;
            ka[(d0 + 1) & 1] = *reinterpret_cast<const bf16x8*>(Ks + KSWZ(r32, cb)); kb[(d0 + 1) & 1] = *reinterpret_cast<const bf16x8*>(Ks + KSWZ(32 + r32, cb)); }
        SBAR();
        p0 = __builtin_amdgcn_mfma_f32_32x32x16_bf16(ka[d0 & 1], qr[d0], p0, 0, 0, 0);
        p1 = __builtin_amdgcn_mfma_f32_32x32x16_bf16(kb[d0 & 1], qr[d0], p1, 0, 0, 0);
        SBAR();
    }
}
__device__ __forceinline__ int v_st(int k, int c) { const int kk = (k & ~0xC) | ((k & 4) << 1) | ((k & 8) >> 1); return ((kk >> 3) * 4 + (c >> 5)) * 512 + ((kk & 7) * 32 + (c & 31)) * 2; }
__device__ __forceinline__ int v_rd_base(int lane) { return ((lane & 3) << 3) | (((lane >> 2) & 3) << 6) | (((lane >> 4) & 1) << 5) | (((lane >> 5) & 1) << 8); }
constexpr int v_rd_off(int d0, int ks, int half) { return d0 * 512 + ks * 4096 + half * 2048; }
__device__ __forceinline__ s16x4 tr_read(int vb, int off) { return __builtin_amdgcn_ds_read_tr16_b64_v4i16((LAS s16x4*)(unsigned long)(unsigned)(vb + off)); }
__device__ __forceinline__ void pv_d0(f32x16* o, int vb, bf16x8 pa0, bf16x8 pa1, bf16x8 pa2, bf16x8 pa3) {
    s16x4 L[2][4], H[2][4];
#pragma unroll
    for (int d0 = 0; d0 < 4; ++d0) { L[0][d0] = tr_read(vb, v_rd_off(d0, 0, 0)); H[0][d0] = tr_read(vb, v_rd_off(d0, 0, 1)); }
#pragma unroll
    for (int ks = 0; ks < 4; ++ks) {
        if (ks < 3) {
#pragma unroll
            for (int d0 = 0; d0 < 4; ++d0) { L[(ks + 1) & 1][d0] = tr_read(vb, v_rd_off(d0, ks + 1, 0)); H[(ks + 1) & 1][d0] = tr_read(vb, v_rd_off(d0, ks + 1, 1)); }
        }
        const bf16x8 pa = ks == 0 ? pa0 : (ks == 1 ? pa1 : (ks == 2 ? pa2 : pa3));
#pragma unroll
        for (int d0 = 0; d0 < 4; ++d0) { const s16x4 l = L[ks & 1][d0], h = H[ks & 1][d0];
            o[d0] = __builtin_amdgcn_mfma_f32_32x32x16_bf16(pa, (bf16x8){l[0], l[1], l[2], l[3], h[0], h[1], h[2], h[3]}, o[d0], 0, 0, 0); }
    }
}
__device__ __forceinline__ void pack_p(const f32x16& p0, const f32x16& p1, bf16x8& pa0, bf16x8& pa1, bf16x8& pa2, bf16x8& pa3) {
#define PK4(P, BASE, OUT) do { unsigned a0 = cvt_pk_bf16(P[BASE + 0], P[BASE + 1]), a1 = cvt_pk_bf16(P[BASE + 2], P[BASE + 3]);   \
    unsigned b0 = cvt_pk_bf16(P[BASE + 4], P[BASE + 5]), b1 = cvt_pk_bf16(P[BASE + 6], P[BASE + 7]);                              \
    auto r0 = __builtin_amdgcn_permlane32_swap(a0, b0, false, false); auto r1 = __builtin_amdgcn_permlane32_swap(a1, b1, false, false); \
    u32x4 w = {r0[0], r1[0], r0[1], r1[1]}; OUT = *reinterpret_cast<bf16x8*>(&w); } while (0)
    PK4(p0, 0, pa0); PK4(p0, 8, pa1); PK4(p1, 0, pa2); PK4(p1, 8, pa3);
#undef PK4
}

__device__ __forceinline__ void pack_half(const f32x16& p, bf16x8& paA, bf16x8& paB) {
#define PK4(P, BASE, OUT) do { unsigned a0 = cvt_pk_bf16(P[BASE + 0], P[BASE + 1]), a1 = cvt_pk_bf16(P[BASE + 2], P[BASE + 3]);   \
    unsigned b0 = cvt_pk_bf16(P[BASE + 4], P[BASE + 5]), b1 = cvt_pk_bf16(P[BASE + 6], P[BASE + 7]);                              \
    auto r0 = __builtin_amdgcn_permlane32_swap(a0, b0, false, false); auto r1 = __builtin_amdgcn_permlane32_swap(a1, b1, false, false); \
    u32x4 w = {r0[0], r1[0], r0[1], r1[1]}; OUT = *reinterpret_cast<bf16x8*>(&w); } while (0)
    PK4(p, 0, paA); PK4(p, 8, paB);
#undef PK4
}
template <int KS0, bool WITH_EXP>
__device__ __forceinline__ void pv_half(f32x16* o, int vb, bf16x8 paA, bf16x8 paB, f32x16& px, float off) {
    s16x4 L[2][4], H[2][4];
#pragma unroll
    for (int d0 = 0; d0 < 4; ++d0) { L[0][d0] = tr_read(vb, v_rd_off(d0, KS0, 0)); H[0][d0] = tr_read(vb, v_rd_off(d0, KS0, 1)); }
#pragma unroll
    for (int d0 = 0; d0 < 4; ++d0) { L[1][d0] = tr_read(vb, v_rd_off(d0, KS0 + 1, 0)); H[1][d0] = tr_read(vb, v_rd_off(d0, KS0 + 1, 1)); }
#pragma unroll
    for (int kk = 0; kk < 2; ++kk) {
        const bf16x8 pa = kk == 0 ? paA : paB;
#pragma unroll
        for (int d0 = 0; d0 < 4; ++d0) { const s16x4 l = L[kk][d0], h = H[kk][d0];
            if (WITH_EXP) SBAR();
            o[d0] = __builtin_amdgcn_mfma_f32_32x32x16_bf16(pa, (bf16x8){l[0], l[1], l[2], l[3], h[0], h[1], h[2], h[3]}, o[d0], 0, 0, 0);
            if (WITH_EXP) {
#pragma unroll
                for (int q = 0; q < 2; ++q) { const int r = (kk * 4 + d0) * 2 + q; px[r] = __builtin_amdgcn_exp2f(fmaf(px[r], SM_C, off)); }
                SBAR(); }
        }
    }
}
enum { MODE_CMP = 0, MODE_WIN = 1, MODE_SLC = 2 };
struct AttnArgs {
    const bf16_t* Z; const bf16_t* KC; const bf16_t* VC; const float* G; float* L; float* OACC; bf16_t* MIX; const unsigned* BM; const float* TAB;
};
template <int MODE>
__device__ __forceinline__ void attn_unit(const AttnArgs& a, LAS char* ldsL, int qt, int g, int hp) {
    char* lds = (char*)ldsL;
    const int tid = threadIdx.x, wid = __builtin_amdgcn_readfirstlane(tid >> 6), lane = tid & 63, r32 = lane & 31, hi = lane >> 5;
    float* li_l = (float*)(lds + LDS_XCH) + wid * 64;
    const int t0 = MODE == MODE_SLC ? qt * 40 : qt * 128;
    const int tq_raw = MODE == MODE_SLC ? t0 + wid * 5 + r32 / 6 : t0 + wid * 16 + (r32 & 15);
    const bool rvalid = MODE == MODE_SLC ? (r32 < 30 && tq_raw < S_) : true;
    const int tq = tq_raw < S_ ? tq_raw : S_ - 1;
    const int hq = MODE == MODE_SLC ? g * HPG + r32 % 6 : g * HPG + hp * 2 + (r32 >> 4);
    const int tlast = MODE == MODE_SLC ? ((t0 + 39) < S_ ? (t0 + 39) : S_ - 1) : t0 + 127;
    const bf16_t* Kb; const bf16_t* Vb; long ldk;
    if (MODE == MODE_CMP) { Kb = a.KC + (size_t)g * 1024 * HD; Vb = a.VC + (size_t)g * 1024 * HD; ldk = HD; }
    else if (MODE == MODE_WIN) { Kb = a.Z + OFF_KV + 4 * 512 + g * HD; Vb = a.Z + OFF_KV + 5 * 512 + g * HD; ldk = LDZ; }
    else { Kb = a.Z + OFF_KV + 2 * 512 + g * HD; Vb = a.Z + OFF_KV + 3 * 512 + g * HD; ldk = LDZ; }
    int j0, j1;
    if (MODE == MODE_CMP) { j0 = 0; j1 = (((t0 + 127 - 31) >> 4) >> 6) + 1; }
    else if (MODE == MODE_WIN) { j0 = (t0 - 511) > 0 ? ((t0 - 511) >> 6) : 0; j1 = ((t0 + 127) >> 6) + 1; }
    else { j0 = 0; j1 = (tlast >> 6) + 1; }
    int klo, khi;
    if (MODE == MODE_CMP) { klo = 0; khi = tq >= 31 ? ((tq - 31) >> 4) : -1; }
    else if (MODE == MODE_WIN) { klo = tq - 511; khi = tq; }
    else { klo = 0; khi = rvalid ? tq : -1; }
    float negBC = -a.TAB[512 + (MODE == MODE_CMP ? 0 : (MODE == MODE_SLC ? 1 : 2))];
    bf16x8 qr[8];
    { const bf16_t* Qw = a.Z + (size_t)tq * LDZ + OFF_Q + hq * HD + hi * 8;
#pragma unroll
      for (int d0 = 0; d0 < 8; ++d0) qr[d0] = *reinterpret_cast<const bf16x8*>(Qw + d0 * 16); }
    f32x16 o[4] = {}; float lsum = 0.f;
    unsigned soK[2], soV[2];
#pragma unroll
    for (int i = 0; i < 2; ++i) { const int p = (wid + 8 * i) * 64 + lane;
        { const int row = p >> 4, c = (p & 15) ^ (row & 7); soK[i] = (unsigned)(row * ldk + c * 8) * 2u; }
        { const int sub = p >> 5, within = p & 31, kk = (sub >> 2) * 8 + (within >> 2), c = (sub & 3) * 32 + (within & 3) * 8, k = (kk & ~0xC) | ((kk & 4) << 1) | ((kk & 8) >> 1);
          soV[i] = (unsigned)(k * ldk + c) * 2u; } }
    const int vb0 = (int)(uintptr_t)(LAS char*)ldsL + 16384 + v_rd_base(lane);
#define ISSUE(jt) do { const int _b = ((jt) - j0) & 3; const char* _kp = (const char*)Kb + (size_t)(jt) * KVBLK * ldk * 2; const char* _vp = (const char*)Vb + (size_t)(jt) * KVBLK * ldk * 2; \
    _Pragma("unroll") for (int _i = 0; _i < 2; ++_i) { \
        __builtin_amdgcn_global_load_lds((const unsigned*)(_kp + soK[_i]), (LAS unsigned*)(ldsL + _b * 32768 + (wid + 8 * _i) * 1024), 16, 0, 0); \
        __builtin_amdgcn_global_load_lds((const unsigned*)(_vp + soV[_i]), (LAS unsigned*)(ldsL + _b * 32768 + 16384 + (wid + 8 * _i) * 1024), 16, 0, 0); } } while (0)
    unsigned bmw = 0u;
    if (MODE == MODE_SLC) bmw = a.BM[((size_t)tq * 4 + g) * 8];
    asm volatile("s_waitcnt lgkmcnt(0)" ::: "memory");
    __builtin_amdgcn_s_barrier();
    asm volatile("" ::: "memory");
    ISSUE(j0);
    asm volatile("s_waitcnt vmcnt(4) lgkmcnt(0)" : "+v"(bmw), "+v"(negBC), "+v"(qr[0]), "+v"(qr[1]), "+v"(qr[2]), "+v"(qr[3]), "+v"(qr[4]), "+v"(qr[5]), "+v"(qr[6]), "+v"(qr[7]) :: "memory");
    if (j0 + 1 < j1) ISSUE(j0 + 1); if (j0 + 2 < j1) ISSUE(j0 + 2);
    for (int j = j0; j < j1; ++j) {
        const int buf = (j - j0) & 3;
        if (j + 2 < j1) asm volatile("s_waitcnt vmcnt(8)" ::: "memory"); else if (j + 1 < j1) asm volatile("s_waitcnt vmcnt(4)" ::: "memory"); else asm volatile("s_waitcnt vmcnt(0)" ::: "memory");
        __builtin_amdgcn_s_barrier();
        asm volatile("" ::: "memory");
        if (j + 3 < j1) ISSUE(j + 3);
        int lhi = khi;
        if (MODE == MODE_SLC) { if (!((bmw >> (j & 31)) & 1u)) lhi = -1; }
        const int kb = j * KVBLK;
        const bool l_any = (kb + 63 >= klo) && (kb <= lhi);
        const bool l_full = (kb >= klo) && (kb + 63 <= lhi);
        if (__any(l_any)) {
            f32x16 p0, p1;
            qkt(p0, p1, lds + buf * 32768, qr, r32, hi);
            const bool uni = __all(l_full || !l_any);
            const float off = (uni && !l_any) ? -1.0e30f : negBC;
#pragma unroll
            for (int r = 0; r < 16; ++r) p0[r] = __builtin_amdgcn_exp2f(fmaf(p0[r], SM_C, off));
            if (!uni) {
#pragma unroll
                for (int r = 0; r < 16; ++r) { const int k0i = kb + crow(r, hi); p0[r] = (k0i >= klo && k0i <= lhi) ? p0[r] : 0.f; } }
            float ps = 0.f;
#pragma unroll
            for (int r = 0; r < 16; ++r) ps += p0[r];
            bf16x8 pa0, pa1, pa2, pa3; pack_half(p0, pa0, pa1);
            pv_half<0, true>(o, vb0 + buf * 32768, pa0, pa1, p1, off);
            if (!uni) {
#pragma unroll
                for (int r = 0; r < 16; ++r) { const int k1i = kb + 32 + crow(r, hi); p1[r] = (k1i >= klo && k1i <= lhi) ? p1[r] : 0.f; } }
#pragma unroll
            for (int r = 0; r < 16; ++r) ps += p1[r];
            lsum += ps;
            pack_half(p1, pa2, pa3);
            pv_half<2, false>(o, vb0 + buf * 32768, pa2, pa3, p1, off);
        }
        if (MODE == MODE_SLC) { if (((j + 1) & 31) == 0 && j + 1 < j1) { bmw = a.BM[((size_t)tq * 4 + g) * 8 + ((j + 1) >> 5)]; asm volatile("s_waitcnt vmcnt(0)" : "+v"(bmw) :: "memory"); } }
    }
#undef ISSUE
    lsum += __shfl_xor(lsum, 32);
    if (hi == 0) li_l[r32] = lsum;
    if (MODE == MODE_CMP) { if (hi == 0) a.L[(size_t)tq * NH + hq] = lsum; }
    asm volatile("s_waitcnt lgkmcnt(0)" ::: "memory");
    float gtv[16]; f32x16 pvv[4];
#pragma unroll
    for (int r = 0; r < 16; ++r) {
        const int orow = crow(r, hi); const float lv = li_l[orow]; const float rl = lv > 0.f ? 1.0f / lv : 0.f;
        const int t = MODE == MODE_SLC ? t0 + wid * 5 + orow / 6 : t0 + wid * 16 + (orow & 15);
        const int h = MODE == MODE_SLC ? g * HPG + orow % 6 : g * HPG + hp * 2 + (orow >> 4);
        const bool valid = !(MODE == MODE_SLC && (orow >= 30 || t >= S_)); const int tc = valid ? t : 0;
        gtv[r] = valid ? a.G[(size_t)tc * NGATE + h * 3 + (MODE == MODE_CMP ? 0 : (MODE == MODE_SLC ? 1 : 2))] * rl : 0.f;
        if (MODE != MODE_CMP) { const float* oa = a.OACC + (size_t)tc * 3072 + h * HD + r32;
#pragma unroll
            for (int d0 = 0; d0 < 4; ++d0) pvv[d0][r] = oa[d0 * 32]; }
    }
#pragma unroll
    for (int r = 0; r < 16; ++r) {
        const int orow = crow(r, hi);
        const int t = MODE == MODE_SLC ? t0 + wid * 5 + orow / 6 : t0 + wid * 16 + (orow & 15);
        const int h = MODE == MODE_SLC ? g * HPG + orow % 6 : g * HPG + hp * 2 + (orow >> 4);
        if (MODE == MODE_SLC && (orow >= 30 || t >= S_)) continue;
        float* oa = a.OACC + (size_t)t * 3072 + h * HD + r32;
#pragma unroll
        for (int d0 = 0; d0 < 4; ++d0) {
            const float v = o[d0][r] * gtv[r];
            if (MODE == MODE_CMP) oa[d0 * 32] = v;
            else if (MODE == MODE_WIN) oa[d0 * 32] = pvv[d0][r] + v;
            else a.MIX[(size_t)t * DM + POOLW + h * HD + d0 * 32 + r32] = (bf16_t)(cvt_pk_bf16(pvv[d0][r] + v, 0.f) & 0xffffu);
        }
    }
}

__device__ __forceinline__ void imp_task(const AttnArgs& a, float* IMPP, float* IMPF, int tqi, int g) {
    const int lane = threadIdx.x & 63, fr = lane & 15, fq = lane >> 4;
    const int t = tqi * 16 + fr;
    const int tmax = tqi * 16 + 15;
    if (tmax < 31) return;
    const int lim = t >= 31 ? ((t - 31) >> 4) : -1;
    const int nstep = ((((tmax - 31) >> 4) >> 6) + 1) * 4;
    const float negBC = -a.TAB[512];
    bf16x8 qf[HPG][4]; float rl[HPG];
#pragma unroll
    for (int h = 0; h < HPG; ++h) {
        const bf16_t* qp = a.Z + (size_t)t * LDZ + OFF_Q + (g * HPG + h) * HD + fq * 8;
#pragma unroll
        for (int ks = 0; ks < 4; ++ks) qf[h][ks] = *reinterpret_cast<const bf16x8*>(qp + ks * 32);
        const float lv = a.L[(size_t)t * NH + g * HPG + h]; rl[h] = lv > 0.f ? 1.0f / lv : 0.f;
    }
    const bf16_t* kbase = a.KC + (size_t)g * 1024 * HD + (size_t)fr * HD + fq * 8;
    bf16x8 kf[4], kn[4];
#pragma unroll
    for (int ks = 0; ks < 4; ++ks) kf[ks] = *reinterpret_cast<const bf16x8*>(kbase + ks * 32);
    float* op = IMPP + ((size_t)t * 4 + g) * 256 + fq; float* of = IMPF + ((size_t)t * 4 + g) * 256 + fq;
    for (int st = 0; st < nstep; ++st) {
        const int sn = (st + 1 < nstep) ? st + 1 : st;
#pragma unroll
        for (int ks = 0; ks < 4; ++ks) kn[ks] = *reinterpret_cast<const bf16x8*>(kbase + (size_t)sn * 16 * HD + ks * 32);
        f32x4 imp4 = {0.f, 0.f, 0.f, 0.f};
        const int n0 = st * 16 + fq * 4;
#pragma unroll
        for (int h = 0; h < HPG; ++h) {
            f32x4 acc = {0.f, 0.f, 0.f, 0.f};
#pragma unroll
            for (int ks = 0; ks < 4; ++ks) acc = __builtin_amdgcn_mfma_f32_16x16x32_bf16(kf[ks], qf[h][ks], acc, 0, 0, 0);
#pragma unroll
            for (int i = 0; i < 4; ++i) { const float e = __builtin_amdgcn_exp2f(fmaf(acc[i], SM_C, negBC)) * rl[h]; imp4[i] += (n0 + i <= lim) ? e : 0.f; }
        }
        op[st * 4] = imp4[0] + 2.0f * (imp4[1] + imp4[2] + imp4[3]);
        of[st * 4] = imp4[0];
#pragma unroll
        for (int ks = 0; ks < 4; ++ks) kf[ks] = kn[ks];
    }
}

__device__ __forceinline__ void topk_load(const float* IMPP, const float* IMPF, int t, int g, f32x4& pp, f32x4& ff) {
    const int lane = threadIdx.x & 63, cur = t >> 6, jb = lane * 4;
    pp = (f32x4){0.f, 0.f, 0.f, 0.f}; ff = pp;
    if (cur > 15 && jb <= cur) { const size_t base = ((size_t)t * 4 + g) * 256; pp = *(const f32x4*)(IMPP + base + jb); ff = *(const f32x4*)(IMPF + base + jb); }
}
__device__ __forceinline__ void topk_task(const f32x4 pp, const f32x4 ff, unsigned* BM, int t, int g) {
    const int lane = threadIdx.x & 63;
    const int cur = t >> 6;
    unsigned nib = 0u;
    if (cur <= 15) { const int jb = lane * 4;
#pragma unroll
        for (int c = 0; c < 4; ++c) if (jb + c <= cur) nib |= 1u << c; }
    else {
        const int jb = lane * 4;
        unsigned key[4];
        {
            float fnext = __shfl_down(ff[0], 1);
            if (lane == 63) fnext = 0.f;
            const float v0 = pp[0] + ff[1], v1 = pp[1] + ff[2], v2 = pp[2] + ff[3], v3 = pp[3] + fnext;
            key[0] = (jb + 0 >= 1 && jb + 0 <= cur - 2) ? __float_as_uint(fmaxf(v0, 0.f)) + 1u : 0u;
            key[1] = (jb + 1 >= 1 && jb + 1 <= cur - 2) ? __float_as_uint(fmaxf(v1, 0.f)) + 1u : 0u;
            key[2] = (jb + 2 >= 1 && jb + 2 <= cur - 2) ? __float_as_uint(fmaxf(v2, 0.f)) + 1u : 0u;
            key[3] = (jb + 3 >= 1 && jb + 3 <= cur - 2) ? __float_as_uint(fmaxf(v3, 0.f)) + 1u : 0u;
        }
        unsigned prefix = 0u; bool exact = false;
        for (int b = 30; b >= 0; --b) {
            const unsigned trial = prefix | (1u << b);
            const int cnt = __popcll(__ballot(key[0] >= trial)) + __popcll(__ballot(key[1] >= trial)) + __popcll(__ballot(key[2] >= trial)) + __popcll(__ballot(key[3] >= trial));
            if (cnt >= 13) { prefix = trial; if (cnt == 13) { exact = true; break; } }
        }
#pragma unroll
        for (int c = 0; c < 4; ++c) if (exact ? (key[c] >= prefix) : (key[c] > prefix)) nib |= 1u << c;
        if (!exact) {
            int need = 13 - (__popcll(__ballot(key[0] > prefix)) + __popcll(__ballot(key[1] > prefix)) + __popcll(__ballot(key[2] > prefix)) + __popcll(__ballot(key[3] > prefix)));
            unsigned tie = 0u;
#pragma unroll
            for (int c = 0; c < 4; ++c) if (key[c] == prefix) tie |= 1u << c;
            for (int guard = 0; need > 0 && guard < 16; ++guard) {
                const unsigned long long any = __ballot(tie != 0u);
                if (any == 0ull) break;
                const int L = __builtin_ctzll(any);
                if (lane == L) { const unsigned low = tie & (0u - tie); nib |= low; tie ^= low; }
                --need;
            }
        }
        if (lane == 0) nib |= 1u;
        if (lane == (cur >> 2)) nib |= 1u << (cur & 3);
        if (lane == ((cur - 1) >> 2)) nib |= 1u << ((cur - 1) & 3);
    }
    unsigned x = nib << (4 * (lane & 7));
    x |= __shfl_xor(x, 1); x |= __shfl_xor(x, 2); x |= __shfl_xor(x, 4);
    if ((lane & 7) == 0) BM[((size_t)t * 4 + g) * 8 + (lane >> 3)] = x;
}
#undef KSWZ
}

template <bool FFN_REMAP = false>
__device__ __forceinline__ void convT(const float* __restrict__ src, int K, int N, bf16_t* __restrict__ dst, int ldd, LAS float* tile, int bid, int nb) {
    const int tid = threadIdx.x, tk = K >> 6, tn = (N + 63) >> 6, total = tk * tn;
    const int r = tid >> 4, c4 = (tid & 15) * 4;
    f32x4 v[2] = {{0.f, 0.f, 0.f, 0.f}, {0.f, 0.f, 0.f, 0.f}}, vn[2];
    if (bid < total) { const int nti = bid % tn, kti = bid / tn, ng = nti * 64 + c4;
#pragma unroll
        for (int h = 0; h < 2; ++h) if (ng < N) v[h] = *(const f32x4*)(src + (size_t)(kti * 64 + r + h * 32) * N + ng); }
    for (int idx = bid; idx < total; idx += nb) {
        const int nti = idx % tn, kti = idx / tn;
#pragma unroll
        for (int h = 0; h < 2; ++h) { LAS float* tp = tile + (r + h * 32) * 65 + c4; tp[0] = v[h][0]; tp[1] = v[h][1]; tp[2] = v[h][2]; tp[3] = v[h][3]; }
        {
            const int nx = idx + nb; vn[0] = (f32x4){0.f, 0.f, 0.f, 0.f}; vn[1] = vn[0];
            if (nx < total) { const int nti2 = nx % tn, kti2 = nx / tn, ng2 = nti2 * 64 + c4;
#pragma unroll
                for (int h = 0; h < 2; ++h) if (ng2 < N) vn[h] = *(const f32x4*)(src + (size_t)(kti2 * 64 + r + h * 32) * N + ng2); } }
        __syncthreads();
        const int n = tid >> 3, k8 = (tid & 7) * 8, ngl = nti * 64 + n;
        float e[8];
#pragma unroll
        for (int i = 0; i < 8; ++i) e[i] = tile[(k8 + i) * 65 + n];
        if (ngl < N) { u32x4 w; w.x = cvt_pk_bf16(e[0], e[1]); w.y = cvt_pk_bf16(e[2], e[3]); w.z = cvt_pk_bf16(e[4], e[5]); w.w = cvt_pk_bf16(e[6], e[7]);
            int drow = ngl; if (FFN_REMAP) { const int up = ngl >= DFF ? 1 : 0, f = ngl - up * DFF; drow = (f >> 7) * 256 + up * 128 + (f & 127); }
            *(u32x4*)(dst + (size_t)drow * ldd + kti * 64 + k8) = w; }
        __syncthreads();
        v[0] = vn[0]; v[1] = vn[1];
    }
}
__device__ __forceinline__ void convT8(const float* __restrict__ src, int K, int N, unsigned char* __restrict__ dst, int ldd, float scale, LAS float* tile, int bid, int nb) {
    const int tid = threadIdx.x, tk = K >> 6, tn = (N + 63) >> 6, total = tk * tn;
    const int r = tid >> 4, c4 = (tid & 15) * 4;
    f32x4 v[2] = {{0.f, 0.f, 0.f, 0.f}, {0.f, 0.f, 0.f, 0.f}}, vn[2];
    if (bid < total) { const int nti = bid % tn, kti = bid / tn, ng = nti * 64 + c4;
#pragma unroll
        for (int h = 0; h < 2; ++h) if (ng < N) v[h] = *(const f32x4*)(src + (size_t)(kti * 64 + r + h * 32) * N + ng); }
    for (int idx = bid; idx < total; idx += nb) {
        const int nti = idx % tn, kti = idx / tn;
#pragma unroll
        for (int h = 0; h < 2; ++h) { LAS float* tp = tile + (r + h * 32) * 65 + c4; tp[0] = v[h][0]; tp[1] = v[h][1]; tp[2] = v[h][2]; tp[3] = v[h][3]; }
        { const int nx = idx + nb; vn[0] = (f32x4){0.f, 0.f, 0.f, 0.f}; vn[1] = vn[0];
            if (nx < total) { const int nti2 = nx % tn, kti2 = nx / tn, ng2 = nti2 * 64 + c4;
#pragma unroll
                for (int h = 0; h < 2; ++h) if (ng2 < N) vn[h] = *(const f32x4*)(src + (size_t)(kti2 * 64 + r + h * 32) * N + ng2); } }
        __syncthreads();
        const int n = tid >> 3, k8 = (tid & 7) * 8, ngl = nti * 64 + n;
        float e[8];
#pragma unroll
        for (int i = 0; i < 8; ++i) e[i] = tile[(k8 + i) * 65 + n] * scale;
        if (ngl < N) { int p0 = __builtin_amdgcn_cvt_pk_fp8_f32(e[0], e[1], 0, false); p0 = __builtin_amdgcn_cvt_pk_fp8_f32(e[2], e[3], p0, true);
            int p1 = __builtin_amdgcn_cvt_pk_fp8_f32(e[4], e[5], 0, false); p1 = __builtin_amdgcn_cvt_pk_fp8_f32(e[6], e[7], p1, true);
            *(u32x2*)(dst + (size_t)ngl * ldd + kti * 64 + k8) = (u32x2){(unsigned)p0, (unsigned)p1}; }
        __syncthreads();
        v[0] = vn[0]; v[1] = vn[1];
    }
}
__device__ __forceinline__ void rmsnorm_rows(const float* __restrict__ src, const float* __restrict__ w, bf16_t* __restrict__ dst, int rows, int gw, int nw) {
    const int lane = threadIdx.x & 63;
    f32x4 v[16], vn[16];
    if (gw < rows) { const f32x4* sp = (const f32x4*)(src + (size_t)gw * DM);
#pragma unroll
        for (int i = 0; i < 16; ++i) v[i] = sp[lane + 64 * i]; }
    for (int row = gw; row < rows; row += nw) {
        const int nr = row + nw < rows ? row + nw : row;
        { const f32x4* sp = (const f32x4*)(src + (size_t)nr * DM);
#pragma unroll
          for (int i = 0; i < 16; ++i) vn[i] = sp[lane + 64 * i]; }
        float ss = 0.f;
#pragma unroll
        for (int i = 0; i < 16; ++i) ss += v[i][0] * v[i][0] + v[i][1] * v[i][1] + v[i][2] * v[i][2] + v[i][3] * v[i][3];
        ss = wave_sum(ss);
        const float rstd = rsqrtf(ss * (1.0f / DM) + EPS);
#pragma unroll
        for (int i = 0; i < 16; ++i) { const f32x4 ww = ((const f32x4*)w)[lane + 64 * i];
            u32x2 o; o.x = cvt_pk_bf16(v[i][0] * rstd * ww[0], v[i][1] * rstd * ww[1]); o.y = cvt_pk_bf16(v[i][2] * rstd * ww[2], v[i][3] * rstd * ww[3]);
            *(u32x2*)(dst + (size_t)row * DM + (lane + 64 * i) * 4) = o; }
#pragma unroll
        for (int i = 0; i < 16; ++i) v[i] = vn[i];
    }
}

struct Ptrs {
    bf16_t *Win, *Wo, *Wfi, *Wfo, *Wg, *Wple, *Wpool, *Wc1k, *Wc1v, *XN, *PB, *Z, *M, *KC, *VC, *MIX, *ACT, *ERAW;
    float *COS, *SIN, *TAB, *G, *H1, *L, *OACC, *IMPP, *IMPF, *ERSTD; unsigned* BM;
};

__device__ __forceinline__ void phase_prologue(const Params& P, const Ptrs& W, LAS unsigned char* lds) {
    const int bid = blockIdx.x, nb = gridDim.x, tid = threadIdx.x, lane = tid & 63, wv = tid >> 6;
    const int gw = bid * NWAVES + wv, nw = nb * NWAVES; const size_t gt = (size_t)bid * NTHREADS + tid, ntot = (size_t)nb * NTHREADS;
    LAS float* tile = (LAS float*)lds;
    rmsnorm_rows(P.x, P.norm1_w, W.XN, S_, gw, nw);
    convT(P.w_in, DM, INW, W.Win, DM, tile, bid, nb);
    for (size_t i = gt; i < (size_t)(LDZ - INW) * DM / 8; i += ntot) *(u32x4*)(W.Win + (size_t)INW * DM + i * 8) = (u32x4){0u, 0u, 0u, 0u};
    convT(P.w_o, DM, DM, W.Wo, DM, tile, bid, nb);
    convT<true>(P.w_ffn_in, DM, NFI, W.Wfi, DM, tile, bid, nb);
    for (size_t i = gt; i < (size_t)2 * DM / 8; i += ntot) *(u32x4*)(W.XN - 2 * DM + i * 8) = (u32x4){0u, 0u, 0u, 0u};
    convT(P.w_ffn_out, DFF, DM, W.Wfo, DFF, tile, bid, nb);
    convT8(P.w_ple_gate, DM, DM, (unsigned char*)W.Wg, DM, WG8_SCALE, tile, bid, nb);
    convT(P.w_ple_proj, PLE, DM, W.Wple, PLE, tile, bid, nb);
    for (int g = 0; g < 4; ++g) convT(P.w_pool + (size_t)g * 65536, 256, 256, W.Wpool + (size_t)g * 65536, 256, tile, bid, nb);
    convT(P.cmp_k_w1, 4096, 256, W.Wc1k, 4096, tile, bid, nb);
    convT(P.cmp_v_w1, 4096, 256, W.Wc1v, 4096, tile, bid, nb);
    for (size_t i = gt; i < (size_t)S_ * PLE / 8; i += ntot) { const f32x4 a = *(const f32x4*)(P.p + i * 8), b = *(const f32x4*)(P.p + i * 8 + 4);
        u32x4 w; w.x = cvt_pk_bf16(a[0], a[1]); w.y = cvt_pk_bf16(a[2], a[3]); w.z = cvt_pk_bf16(b[0], b[1]); w.w = cvt_pk_bf16(b[2], b[3]); *(u32x4*)(W.PB + i * 8) = w; }
    for (size_t i = gt; i < (size_t)S_ * 16; i += ntot) { const int t = (int)(i >> 4), fi = (int)(i & 15);
        const float inv = exp2f(-(float)fi * (18.931568569324174f / 16.0f)); const float ang = (float)P.positions[t] * inv;
        const double ad = (double)ang; const double kk = rint(ad * 0.15915494309189535); const float rf = (float)(ad - kk * 6.283185307179586);
        W.COS[i] = __cosf(rf); W.SIN[i] = __sinf(rf); }
    for (int o = gw; o < 512; o += nw) { const int which = o >> 8, j = o & 255; const float* pe = which ? P.cmp_pos_v : P.cmp_pos_k; const float* w1 = which ? P.cmp_v_w1 : P.cmp_k_w1;
        float s = 0.f; for (int r = lane; r < 4096; r += 64) s += pe[r] * w1[(size_t)r * 256 + j];
        s = wave_sum(s); if (lane == 0) W.TAB[o] = s; }
    if (gw == 0) { float mq = fmaxf(fabsf(P.q_norm_w[lane]), fabsf(P.q_norm_w[lane + 64])); mq = wave_max(mq);
        float mc = wave_max(fmaxf(fabsf(P.k_norm_cmp_w[lane]), fabsf(P.k_norm_cmp_w[lane + 64])));
        float ms = wave_max(fmaxf(fabsf(P.k_norm_slc_w[lane]), fabsf(P.k_norm_slc_w[lane + 64])));
        float mw = wave_max(fmaxf(fabsf(P.k_norm_win_w[lane]), fabsf(P.k_norm_win_w[lane + 64])));
        const float c = 11.313708498984761f * 1.4426950408889634f * mq * 1.01f;
        if (lane == 0) { W.TAB[512] = c * mc; W.TAB[513] = c * ms; W.TAB[514] = c * mw; } }
}

__device__ __forceinline__ void phase_postz(const Params& P, const Ptrs& W, int gw, int nw) {
    const int tid = threadIdx.x, lane = tid & 63;
    const f32x2 wq = *(const f32x2*)(P.q_norm_w + 2 * lane), wks = *(const f32x2*)(P.k_norm_slc_w + 2 * lane), wkw = *(const f32x2*)(P.k_norm_win_w + 2 * lane);
    for (int t = gw; t < S_; t += nw) {
        bf16_t* zr = W.Z + (size_t)t * LDZ;
        float cs0 = 0.f, cs1 = 0.f, sn0 = 0.f, sn1 = 0.f;
        if (lane < 16) { const int i0 = (2 * lane) & 15; cs0 = W.COS[t * 16 + i0]; cs1 = W.COS[t * 16 + i0 + 1]; sn0 = W.SIN[t * 16 + i0]; sn1 = W.SIN[t * 16 + i0 + 1]; }
        unsigned uv[32];
#pragma unroll
        for (int v = 0; v < 32; ++v) { const int col = v < 24 ? OFF_Q + v * HD : (v < 28 ? OFF_KV + 2 * 512 + (v - 24) * HD : OFF_KV + 4 * 512 + (v - 28) * HD);
            uv[v] = *((const unsigned*)(zr + col) + lane); }
#pragma unroll
        for (int v = 0; v < 32; ++v) {
            const f32x2 ww = v < 24 ? wq : (v < 28 ? wks : wkw);
            const unsigned u = uv[v]; const float x0 = bf_lo(u), x1 = bf_hi(u);
            const float ss = wave_sum(x0 * x0 + x1 * x1);
            const float rstd = rsqrtf(ss * (1.0f / HD) + EPS);
            float y0 = x0 * rstd * ww[0], y1 = x1 * rstd * ww[1];
            const float p0 = __shfl_xor(y0, 8), p1 = __shfl_xor(y1, 8);
            if (lane < 8) { y0 = y0 * cs0 - p0 * sn0; y1 = y1 * cs1 - p1 * sn1; }
            else if (lane < 16) { y0 = y0 * cs0 + p0 * sn0; y1 = y1 * cs1 + p1 * sn1; }
            uv[v] = cvt_pk_bf16(y0, y1);
        }
        {
            const int gi = lane >> 4, wlen = 2 << gi, c0 = lane * 16; const int cnt = (t + 1) < wlen ? (t + 1) : wlen;
            float s[16];
#pragma unroll
            for (int i = 0; i < 16; ++i) s[i] = 0.f;
            float cur[16];
            for (int i = 0; i < cnt; ++i) { const u32x4 a = *(const u32x4*)(W.Z + (size_t)(t - i) * LDZ + c0), b = *(const u32x4*)(W.Z + (size_t)(t - i) * LDZ + c0 + 8);
                const float e[16] = {bf_lo(a.x), bf_hi(a.x), bf_lo(a.y), bf_hi(a.y), bf_lo(a.z), bf_hi(a.z), bf_lo(a.w), bf_hi(a.w), bf_lo(b.x), bf_hi(b.x), bf_lo(b.y), bf_hi(b.y), bf_lo(b.z), bf_hi(b.z), bf_lo(b.w), bf_hi(b.w)};
#pragma unroll
                for (int q = 0; q < 16; ++q) { s[q] += e[q]; if (i == 0) cur[q] = e[q]; } }
            const float rc = 1.0f / (float)cnt;
            u32x4 o0, o1;
            o0.x = cvt_pk_bf16(s[0] * rc - cur[0], s[1] * rc - cur[1]); o0.y = cvt_pk_bf16(s[2] * rc - cur[2], s[3] * rc - cur[3]);
            o0.z = cvt_pk_bf16(s[4] * rc - cur[4], s[5] * rc - cur[5]); o0.w = cvt_pk_bf16(s[6] * rc - cur[6], s[7] * rc - cur[7]);
            o1.x = cvt_pk_bf16(s[8] * rc - cur[8], s[9] * rc - cur[9]); o1.y = cvt_pk_bf16(s[10] * rc - cur[10], s[11] * rc - cur[11]);
            o1.z = cvt_pk_bf16(s[12] * rc - cur[12], s[13] * rc - cur[13]); o1.w = cvt_pk_bf16(s[14] * rc - cur[14], s[15] * rc - cur[15]);
            *(u32x4*)(W.M + (size_t)t * POOLW + c0) = o0; *(u32x4*)(W.M + (size_t)t * POOLW + c0 + 8) = o1;
        }
#pragma unroll
        for (int v = 0; v < 32; ++v) { const int col = v < 24 ? OFF_Q + v * HD : (v < 28 ? OFF_KV + 2 * 512 + (v - 24) * HD : OFF_KV + 4 * 512 + (v - 28) * HD);
            *((unsigned*)(zr + col) + lane) = uv[v]; }

    }
}

__device__ __forceinline__ void phase_cmpfin(const Params& P, const Ptrs& W) {
    const int tid = threadIdx.x, lane = tid & 63, gw = blockIdx.x * NWAVES + (tid >> 6), nw = gridDim.x * NWAVES;
    const f32x2 wk = *(const f32x2*)(P.k_norm_cmp_w + 2 * lane);
    for (int task = gw; task < 8192; task += nw) {
        const int tk = __builtin_amdgcn_readfirstlane(task);
        const int which = tk >> 12, g = (tk >> 10) & 3, n = tk & 1023;
        bf16_t* dst = (which ? W.VC : W.KC) + ((size_t)g * 1024 + n) * HD;
        if (n == 1023) { ((unsigned*)dst)[lane] = 0u; continue; }
        const float* h = W.H1 + (size_t)tk * 256; const float* w2 = which ? P.cmp_v_w2 : P.cmp_k_w2;
        float a0 = 0.f, a1 = 0.f;
        for (int j = 0; j < 256; ++j) { const float hj = h[j]; const f32x2 wv = *(const f32x2*)(w2 + j * HD + 2 * lane); a0 += hj * wv[0]; a1 += hj * wv[1]; }
        if (which == 0) {
            const float ss = wave_sum(a0 * a0 + a1 * a1); const float rstd = rsqrtf(ss * (1.0f / HD) + EPS);
            a0 = a0 * rstd * wk[0]; a1 = a1 * rstd * wk[1];
            const int tp = 16 * n + 31; const float p0 = __shfl_xor(a0, 8), p1 = __shfl_xor(a1, 8);
            if (lane < 16) { const int i0 = (2 * lane) & 15; const float cs0 = W.COS[tp * 16 + i0], cs1 = W.COS[tp * 16 + i0 + 1], sn0 = W.SIN[tp * 16 + i0], sn1 = W.SIN[tp * 16 + i0 + 1];
                if (lane < 8) { a0 = a0 * cs0 - p0 * sn0; a1 = a1 * cs1 - p1 * sn1; } else { a0 = a0 * cs0 + p0 * sn0; a1 = a1 * cs1 + p1 * sn1; } }
        }
        ((unsigned*)dst)[lane] = cvt_pk_bf16(a0, a1);
    }
}

__device__ __forceinline__ void phase_erstd(const Ptrs& W) {
    const int tid = threadIdx.x, lane = tid & 63, gw = blockIdx.x * NWAVES + (tid >> 6), nw = gridDim.x * NWAVES;
    u32x4 a[8], an[8];
    if (gw < S_) { const u32x4* sp = (const u32x4*)(W.ERAW + (size_t)gw * DM);
#pragma unroll
        for (int i = 0; i < 8; ++i) a[i] = sp[lane + 64 * i]; }
    for (int row = gw; row < S_; row += nw) {
        const int nr = row + nw < S_ ? row + nw : row;
        { const u32x4* sp = (const u32x4*)(W.ERAW + (size_t)nr * DM);
#pragma unroll
          for (int i = 0; i < 8; ++i) an[i] = sp[lane + 64 * i]; }
        float ss = 0.f;
#pragma unroll
        for (int i = 0; i < 8; ++i) {
            const float e0 = bf_lo(a[i].x), e1 = bf_hi(a[i].x), e2 = bf_lo(a[i].y), e3 = bf_hi(a[i].y), e4 = bf_lo(a[i].z), e5 = bf_hi(a[i].z), e6 = bf_lo(a[i].w), e7 = bf_hi(a[i].w);
            ss += e0 * e0 + e1 * e1 + e2 * e2 + e3 * e3 + e4 * e4 + e5 * e5 + e6 * e6 + e7 * e7; }
        ss = wave_sum(ss);
        if (lane == 0) W.ERSTD[row] = rsqrtf(ss * (1.0f / DM) + EPS);
#pragma unroll
        for (int i = 0; i < 8; ++i) a[i] = an[i];
    }
}

constexpr int N_PHASES = 11;
__device__ __forceinline__ Params kargs() {
#if defined(__HIP_DEVICE_COMPILE__)
    unsigned long long p = (unsigned long long)__builtin_amdgcn_kernarg_segment_ptr();
    asm volatile("" : "+s"(p));
    return *(const __attribute__((address_space(4))) Params*)p;
#else
    return Params{};
#endif
}
__device__ __forceinline__ Ptrs mkptrs(unsigned char* ws) {
    Ptrs W;
    W.Win = (bf16_t*)(ws + WS_WIN); W.Wo = (bf16_t*)(ws + WS_WO); W.Wfi = (bf16_t*)(ws + WS_WFI); W.Wfo = (bf16_t*)(ws + WS_WFO); W.Wg = (bf16_t*)(ws + WS_WG);
    W.Wple = (bf16_t*)(ws + WS_WPLE); W.Wpool = (bf16_t*)(ws + WS_WPOOL); W.Wc1k = (bf16_t*)(ws + WS_WC1K); W.Wc1v = (bf16_t*)(ws + WS_WC1V);
    W.XN = (bf16_t*)(ws + WS_XN); W.PB = (bf16_t*)(ws + WS_PB); W.Z = (bf16_t*)(ws + WS_Z); W.M = (bf16_t*)(ws + WS_M); W.KC = (bf16_t*)(ws + WS_KC); W.VC = (bf16_t*)(ws + WS_VC);
    W.MIX = (bf16_t*)(ws + WS_MIX); W.ACT = (bf16_t*)(ws + WS_ACT); W.ERAW = (bf16_t*)(ws + WS_ERAW);
    W.COS = (float*)(ws + WS_COS); W.SIN = (float*)(ws + WS_SIN); W.TAB = (float*)(ws + WS_TAB); W.G = (float*)(ws + WS_G); W.H1 = (float*)(ws + WS_H1); W.L = (float*)(ws + WS_L);
    W.OACC = (float*)(ws + WS_OACC); W.IMPP = (float*)(ws + WS_IMPP); W.IMPF = (float*)(ws + WS_IMPF); W.ERSTD = (float*)(ws + WS_ERSTD); W.BM = (unsigned*)(ws + WS_BM);
    return W;
}
__global__ void __launch_bounds__(NTHREADS, 2) fwd(Params Punused) {
    extern __shared__ __attribute__((aligned(16))) unsigned char lds_raw[];
    LAS unsigned char* lds = (LAS unsigned char*)lds_raw;
    const int tid = threadIdx.x;
    const int G = gridDim.x, bid = blockIdx.x;
    const int gw = bid * NWAVES + (tid >> 6), nw = G * NWAVES;

    if (tid < 16) ((LAS unsigned*)(lds + LDS_MISC))[tid] = 0u;
    __syncthreads();
    int lo, hi; XcdBarrier bar;
    { const Params P = kargs(); lo = P.ph_lo; hi = P.ph_hi;
      bar.bar = (unsigned*)(P.ws + WS_CTL); bar.x = 0; bar.st = (volatile LAS unsigned*)(lds + LDS_MISC);
      if (hi - lo > 1) bar = xcd_barrier_post((unsigned*)(P.ws + WS_CTL), (volatile LAS unsigned*)(lds + LDS_MISC)); }
#ifdef PH_MASK
#define IN(k) (((PH_MASK >> (k)) & 1) && lo <= (k) && (k) < hi)
#else
#define IN(k) (lo <= (k) && (k) < hi)
#endif
#define SEAM(k) do { if (IN(k) && IN((k) + 1)) xcd_barrier(bar); } while (0)
#define PHASE_VARS const Params P = kargs(); const Ptrs W = mkptrs(P.ws); (void)W;
#define ATT_ARGS att::AttnArgs AA{W.Z, W.KC, W.VC, W.G, W.L, W.OACC, W.MIX, W.BM, W.TAB};

    if (IN(0)) { PHASE_VARS REP(0) { phase_prologue(P, W, lds); } SEAM(0); }
    if (IN(1)) {
        PHASE_VARS
        pg8::GStd g{(const char*)W.XN, (const char*)W.Win, DM, DM, DM / 64}; pg8::StaticOrder S; S.init(S_ / 256, OFF_G / 256, G, bid);
        pg8::EpiBf16 E{W.Z, LDZ};
        REP(1) { pg8::gemm_phase(lds, g, S, E); } SEAM(1);
    }
    if (IN(2)) {
        PHASE_VARS
        if (G > 64) {
            if (bid < 32) { pg8::GCmp g{(const char*)W.Z, (const char*)W.Wc1k, (const char*)W.Wc1v, 16 * LDZ, 4096, 64}; pg8::StaticOrder S; S.init(32, 1, 32, bid);
                pg8::EpiCmpGelu E{W.H1, W.TAB}; pg8::gemm_phase(lds, g, S, E); }
            else if (bid < 96) {
                pg8::GStd g{(const char*)W.XN, (const char*)(W.Win + (size_t)OFF_G * DM), DM, DM, DM / 64}; pg8::StaticOrder S; S.init(S_ / 256, 1, 64, bid - 32);
                pg8::EpiBf16 E{W.Z + OFF_G, LDZ}; pg8::gemm_phase(lds, g, S, E); }
            else phase_postz(P, W, (bid - 96) * NWAVES + (tid >> 6), (G - 96) * NWAVES);
        } else {
            { pg8::GStd g{(const char*)W.XN, (const char*)(W.Win + (size_t)OFF_G * DM), DM, DM, DM / 64}; pg8::StaticOrder S; S.init(S_ / 256, 1, G, bid);
              pg8::EpiBf16 E{W.Z + OFF_G, LDZ}; pg8::gemm_phase(lds, g, S, E); }
            { pg8::GCmp g{(const char*)W.Z, (const char*)W.Wc1k, (const char*)W.Wc1v, 16 * LDZ, 4096, 64}; pg8::StaticOrder S; S.init(32, 1, G, bid);
              pg8::EpiCmpGelu E{W.H1, W.TAB}; pg8::gemm_phase(lds, g, S, E); }
            phase_postz(P, W, gw, nw);
        }
        SEAM(2);
    }
    if (IN(3)) {
        PHASE_VARS
        for (size_t i = (size_t)bid * NTHREADS + tid; i < (size_t)S_ * NGATE; i += (size_t)G * NTHREADS) { const int t = (int)(i / NGATE), c = (int)(i % NGATE); W.G[i] = sigmoidf_(bf2f(W.Z[(size_t)t * LDZ + OFF_G + c])); }
        phase_cmpfin(P, W);
        { pg8::GPool g{(const char*)W.M, (const char*)W.Wpool, POOLW, 256, 4}; pg8::StaticOrder S; S.init(S_ / 256, 4, G, bid);
          pg8::EpiBf16Scale E{W.MIX, DM, P.pool_scale}; pg8::gemm_phase(lds, g, S, E); }
        SEAM(3);
    }
    if (IN(4)) {
        PHASE_VARS ATT_ARGS
        REP(4)
        for (int base = 0, rnd = 0; base < 1536; base += G, ++rnd) {
            int qt, g, hp;
            if (G == 256) { const int x = bid & 7, r = bid >> 3, qp = (rnd / 3) ? 63 - r : r; if (rnd >= 6) break; g = x & 3; qt = 2 * qp + (x >> 2); hp = rnd % 3; }
            else { const int Lu = base + ((rnd & 1) ? G - 1 - bid : bid); if (Lu >= 1536) continue; qt = Lu / 12; const int rem = Lu % 12; g = rem / 3; hp = rem % 3; }
            att::attn_unit<att::MODE_CMP>(AA, (LAS char*)lds, qt, g, hp);
            asm volatile("s_waitcnt vmcnt(0)" ::: "memory");
            att::attn_unit<att::MODE_WIN>(AA, (LAS char*)lds, qt, g, hp); }
        SEAM(4);
    }
    if (IN(5)) {
        PHASE_VARS ATT_ARGS
        for (int k = gw, r = 0; k < 4096; k += nw, ++r) { const int hiT = (r + 1) * nw < 4096 ? (r + 1) * nw : 4096;
            const int task = (r & 1) ? hiT - 1 - (k - r * nw) : k;
            att::imp_task(AA, W.IMPP, W.IMPF, task >> 2, task & 3);
            asm volatile("s_waitcnt vmcnt(0)" ::: "memory");
            { const int tb = (task >> 2) * 16, gg = task & 3; f32x4 pp, ff, pn, fn;
              att::topk_load(W.IMPP, W.IMPF, tb, gg, pp, ff);
              for (int q = 0; q < 16; ++q) { att::topk_load(W.IMPP, W.IMPF, tb + (q < 15 ? q + 1 : q), gg, pn, fn); att::topk_task(pp, ff, W.BM, tb + q, gg); pp = pn; ff = fn; } } }
        SEAM(5);
    }
    if (IN(6)) {
        PHASE_VARS ATT_ARGS
        REP(6)
        for (int base = 0, rnd = 0; base < 1640 + G; base += G, ++rnd) {
            int ut, g;
            if (G == 256) { const int x = bid & 7, r = bid >> 3, k = rnd * 32 + ((rnd & 1) ? 31 - r : r); if (k >= 205) break; g = x & 3; ut = 409 - (2 * k + (x >> 2)); }
            else { const int Lu = base + ((rnd & 1) ? G - 1 - bid : bid); if (Lu >= 1640) continue; ut = 409 - Lu / 4; g = Lu % 4; }
            att::attn_unit<att::MODE_SLC>(AA, (LAS char*)lds, ut, g, 0); }
        SEAM(6);
    }
    if (IN(7)) {
        PHASE_VARS
        { pg8::GStd g{(const char*)W.MIX, (const char*)W.Wo, DM, DM, DM / 64}; pg8::StaticOrder S; S.init(S_ / 256, DM / 256, G, bid);
          pg8::EpiResNorm E{P.x, P.out, W.XN, P.norm2_w, (float*)(P.ws + WS_SSQ1), DM}; pg8::gemm_phase(lds, g, S, E); }
        { pg8::GStd g{(const char*)W.PB, (const char*)W.Wple, PLE, PLE, PLE / 64}; pg8::StaticOrder S; S.init(S_ / 256, DM / 256, G, bid);
          pg8::EpiBf16Ssq E{W.ERAW, DM, (float*)(P.ws + WS_SSQ3)}; pg8::gemm_phase(lds, g, S, E); }
        SEAM(7);
    }
    if (IN(8)) {
        PHASE_VARS
        pg8::GFfn g{(const char*)W.XN, (const char*)W.Wfi, DM, DM, DM / 64}; pg8::StaticOrder S; S.init(65, DFF / 128, G, bid);
        pg8::EpiFfn E{W.ACT, P.conv_w, P.conv_b, (LAS float*)(lds + LDS_XCH), (const float*)(P.ws + WS_SSQ1)}; REP(8) { pg8::gemm_phase(lds, g, S, E); } SEAM(8);
    }
    if (IN(9)) {
        PHASE_VARS
        pg8::GStd g{(const char*)W.ACT, (const char*)W.Wfo, DFF, DFF, DFF / 64}; pg8::StaticOrder S; S.init(S_ / 256, DM / 256, G, bid);
        pg8::EpiResNormF8 E{P.out, P.out, W.XN, P.ple_gate_norm_w, (float*)(P.ws + WS_SSQ2), DM}; pg8::gemm_phase(lds, g, S, E); SEAM(9);
    }
    if (IN(10)) {
        PHASE_VARS
        pg8::GStd g{(const char*)W.XN, (const char*)W.Wg, DM / 2, DM / 2, DM / 128}; pg8::StaticOrder S; S.init(S_ / 256, DM / 256, G, bid);
        pg8::EpiGate E{P.out, W.ERAW, (const float*)(P.ws + WS_SSQ3), P.ple_norm_w, (const float*)(P.ws + WS_SSQ2), DM, 1.0f / WG8_SCALE};
        pg8::gemm_phase<pg8::GStd, pg8::EpiGate, true>(lds, g, S, E);
    }
#undef IN
#undef SEAM
}

extern "C" void kernel_launch(void* const* d_in, const int* in_sizes, int n_in, void* d_out, int out_size, void* d_ws, size_t ws_size, hipStream_t stream) {
    static int grid = 0;
    if (grid == 0) {
        if (n_in != 27 || in_sizes[0] != S_ * DM || out_size != S_ * DM || ws_size < WS_NEED) {
            fprintf(stderr, "kernel_launch: unexpected shapes (n_in %d, in0 %d, out %d, ws %zu < %zu); nothing launched\n", n_in, n_in > 0 ? in_sizes[0] : -1, out_size, ws_size, (size_t)WS_NEED); grid = -1; return; }
        int dev = 0, cus = 0, per_cu = 0;
        if (hipGetDevice(&dev) != hipSuccess || hipDeviceGetAttribute(&cus, hipDeviceAttributeMultiprocessorCount, dev) != hipSuccess) { grid = -1; return; }
        if (hipFuncSetAttribute((const void*)fwd, hipFuncAttributeMaxDynamicSharedMemorySize, LDS_BYTES) != hipSuccess) { fprintf(stderr, "kernel_launch: hipFuncSetAttribute failed\n"); grid = -1; return; }
        if (hipOccupancyMaxActiveBlocksPerMultiprocessor(&per_cu, (const void*)fwd, NTHREADS, LDS_BYTES) != hipSuccess || per_cu < 1) { fprintf(stderr, "kernel_launch: occupancy query says %d\n", per_cu); (void)hipGetLastError(); }
        grid = cus > 256 ? 256 : cus;
    }
    if (grid < 0) return;
    (void)hipMemsetAsync((char*)d_ws + WS_CTL, 0, CTL_BYTES, stream);
    Params P{};
    const float** fp = (const float**)&P;
    P.x = (const float*)d_in[0]; P.p = (const float*)d_in[1]; P.positions = (const int*)d_in[2]; P.norm1_w = (const float*)d_in[3]; P.w_in = (const float*)d_in[4];
    P.w_pool = (const float*)d_in[5]; P.pool_scale = (const float*)d_in[6]; P.q_norm_w = (const float*)d_in[7]; P.k_norm_cmp_w = (const float*)d_in[8];
    P.k_norm_slc_w = (const float*)d_in[9]; P.k_norm_win_w = (const float*)d_in[10]; P.cmp_pos_k = (const float*)d_in[11]; P.cmp_pos_v = (const float*)d_in[12];
    P.cmp_k_w1 = (const float*)d_in[13]; P.cmp_k_w2 = (const float*)d_in[14]; P.cmp_v_w1 = (const float*)d_in[15]; P.cmp_v_w2 = (const float*)d_in[16];
    P.w_o = (const float*)d_in[17]; P.norm2_w = (const float*)d_in[18]; P.w_ffn_in = (const float*)d_in[19]; P.conv_w = (const float*)d_in[20]; P.conv_b = (const float*)d_in[21];
    P.w_ffn_out = (const float*)d_in[22]; P.w_ple_proj = (const float*)d_in[23]; P.ple_norm_w = (const float*)d_in[24]; P.ple_gate_norm_w = (const float*)d_in[25]; P.w_ple_gate = (const float*)d_in[26];
    (void)fp;
    P.out = (float*)d_out; P.ws = (unsigned char*)d_ws;
#if MK_ONE_LAUNCH
    P.ph_lo = 0; P.ph_hi = N_PHASES;
    hipLaunchKernelGGL(fwd, dim3(grid), dim3(NTHREADS), LDS_BYTES, stream, P);
#else
    for (int ph = 0; ph < N_PHASES; ++ph) { P.ph_lo = ph; P.ph_hi = ph + 1; hipLaunchKernelGGL(fwd, dim3(grid), dim3(NTHREADS), LDS_BYTES, stream, P); }
#endif
    const hipError_t le = hipPeekAtLastError();
    if (le != hipSuccess) fprintf(stderr, "kernel_launch: launch failed: %s\n", hipGetErrorName(le));
}
```

```cpp
#include <hip/hip_runtime.h>
#include <cstdio>
#include <cstdint>

#ifndef PROBE_DBL
#define PROBE_DBL 0
#endif
#define REP(k) _Pragma("unroll") for (int rep_ = 0; rep_ < 1 + ((PROBE_DBL >> (k)) & 1); ++rep_)
#ifndef MK_ONE_LAUNCH
#define MK_ONE_LAUNCH 1
#endif

#define LAS __attribute__((address_space(3)))
typedef unsigned short bf16_t;
typedef short bf16x8 __attribute__((ext_vector_type(8)));
typedef short s16x4 __attribute__((ext_vector_type(4)));
typedef float f32x2 __attribute__((ext_vector_type(2)));
typedef float f32x4 __attribute__((ext_vector_type(4)));
typedef float f32x16 __attribute__((ext_vector_type(16)));
typedef unsigned u32x2 __attribute__((ext_vector_type(2)));
typedef unsigned u32x4 __attribute__((ext_vector_type(4)));
typedef int i32x4 __attribute__((ext_vector_type(4)));
typedef int i32x8 __attribute__((ext_vector_type(8)));

constexpr int S_ = 16384, DM = 4096, INW = 7240, LDZ = 7424, POOLW = 1024, NH = 24, NKV = 4, HPG = 6, HD = 128;
constexpr int OFF_Q = 1024, OFF_KV = 4096, OFF_G = 7168, DFF = 11008, NFI = 22016, PLE = 256, NGATE = 72;
constexpr int ZROWS = S_ + 64, XNROWS = S_ + 256, CHUNK = 8192;
constexpr float EPS = 1e-6f;
constexpr float SM_C = 0.08838834764831845f * 1.4426950408889634f;
constexpr int NWAVES = 8, NTHREADS = 512;
constexpr float WG8_SCALE = 128.0f;

constexpr size_t al256(size_t x) { return (x + 255) / 256 * 256; }
constexpr size_t WS_CTL   = 0;
constexpr size_t CTL_BYTES = 262144;
constexpr size_t WS_SSQ1 = WS_CTL + 65536, WS_SSQ2 = WS_CTL + 131072, WS_SSQ3 = WS_CTL + 196608;
constexpr size_t WS_WIN   = WS_CTL + CTL_BYTES;
constexpr size_t WS_WO    = WS_WIN + al256((size_t)LDZ * DM * 2);
constexpr size_t WS_WFI   = WS_WO + al256((size_t)DM * DM * 2);
constexpr size_t WS_WFO   = WS_WFI + al256((size_t)NFI * DM * 2);
constexpr size_t WS_WG    = WS_WFO + al256((size_t)DM * DFF * 2);
constexpr size_t WS_WPLE  = WS_WG + al256((size_t)DM * DM * 2);
constexpr size_t WS_WPOOL = WS_WPLE + al256((size_t)DM * PLE * 2);
constexpr size_t WS_WC1K  = WS_WPOOL + al256((size_t)1024 * 256 * 2);
constexpr size_t WS_WC1V  = WS_WC1K + al256((size_t)256 * 4096 * 2);
constexpr size_t WS_COS   = WS_WC1V + al256((size_t)256 * 4096 * 2);
constexpr size_t WS_SIN   = WS_COS + al256((size_t)S_ * 16 * 4);
constexpr size_t WS_TAB   = WS_SIN + al256((size_t)S_ * 16 * 4);
constexpr size_t WS_XNP   = WS_TAB + 4096;
constexpr size_t WS_XN    = WS_XNP + (size_t)2 * DM * 2;
constexpr size_t WS_PB    = WS_XN + al256((size_t)XNROWS * DM * 2);
constexpr size_t WS_XN8   = WS_PB + al256((size_t)S_ * PLE * 2);
constexpr size_t WS_WIN8  = WS_XN8 + al256((size_t)S_ * DM);
constexpr size_t WS_R     = WS_WIN8 + al256((size_t)(OFF_G - POOLW) * DM);
constexpr size_t WS_Z     = WS_R;
constexpr size_t WS_M     = WS_Z + al256((size_t)ZROWS * LDZ * 2);
constexpr size_t WS_G     = WS_M + al256((size_t)S_ * POOLW * 2);
constexpr size_t WS_H1    = WS_G + al256((size_t)S_ * NGATE * 4);
constexpr size_t WS_KC    = WS_H1 + al256((size_t)8192 * 256 * 4);
constexpr size_t WS_VC    = WS_KC + al256((size_t)4 * 1024 * 128 * 2);
constexpr size_t WS_L     = WS_VC + al256((size_t)4 * 1024 * 128 * 2);
constexpr size_t WS_OACC  = WS_L + al256((size_t)S_ * NH * 4);
constexpr size_t WS_IMPP  = WS_OACC + al256((size_t)S_ * 3072 * 4);
constexpr size_t WS_IMPF  = WS_IMPP + al256((size_t)S_ * 4 * 256 * 4);
constexpr size_t WS_BM    = WS_IMPF + al256((size_t)S_ * 4 * 256 * 4);
constexpr size_t WS_MIX   = WS_BM + al256((size_t)S_ * 4 * 8 * 4);
constexpr size_t WS_END_A = WS_MIX + al256((size_t)S_ * DM * 2);
constexpr size_t WS_ERAW  = WS_R;
constexpr size_t WS_ACT   = WS_ERAW + al256((size_t)S_ * DM * 2);
constexpr size_t WS_ERSTD = WS_ACT + al256((size_t)S_ * DFF * 2);
constexpr size_t WS_END_B = WS_ERSTD + al256((size_t)S_ * 4);
static_assert(WS_ERAW + (size_t)S_ * DM * 2 <= WS_Z + (size_t)ZROWS * LDZ * 2, "eraw must fit inside the dead z region while mix is still being read");
constexpr size_t WS_NEED  = WS_END_A > WS_END_B ? WS_END_A : WS_END_B;
static_assert(WS_NEED <= (size_t)1440000000, "workspace map exceeds the guaranteed 4 x largest-tensor bytes");

constexpr int LDS_STAGE = 131072;
constexpr int LDS_MISC  = LDS_STAGE;
constexpr int LDS_XCH   = LDS_STAGE + 64;
constexpr int LDS_BYTES = LDS_XCH + 4096;

__device__ __forceinline__ unsigned cvt_pk_bf16(float lo, float hi) { unsigned r; asm volatile("v_cvt_pk_bf16_f32 %0, %1, %2" : "=v"(r) : "v"(lo), "v"(hi)); return r; }
__device__ __forceinline__ float bf_lo(unsigned u) { return __uint_as_float(u << 16); }
__device__ __forceinline__ float bf_hi(unsigned u) { return __uint_as_float(u & 0xffff0000u); }
__device__ __forceinline__ float bf2f(bf16_t b) { return __uint_as_float(((unsigned)b) << 16); }
__device__ __forceinline__ float wave_sum(float v) {
#pragma unroll
    for (int o = 32; o >= 1; o >>= 1) v += __shfl_xor(v, o);
    return v;
}
__device__ __forceinline__ float wave_max(float v) {
#pragma unroll
    for (int o = 32; o >= 1; o >>= 1) v = fmaxf(v, __shfl_xor(v, o));
    return v;
}
__device__ __forceinline__ float sigmoidf_(float x) { return 1.0f / (1.0f + __expf(-x)); }

#define XB_TMO      128
#define XB_XCNT(j)  (256  + 64 * (j))
#define XB_XSUB(j)  (1280 + 64 * (j))
#define XB_XGEN(j)  (2304 + 64 * (j))
#define XB_TOP      3328
#define XB_TOPGEN   3392
#define XCD_BAR_WORDS 3456
#define XB_SPIN_CAP (1u << 18)
__device__ __forceinline__ unsigned xb_ld(unsigned* p)              { return __hip_atomic_load(p, __ATOMIC_RELAXED, __HIP_MEMORY_SCOPE_AGENT); }
__device__ __forceinline__ unsigned xb_add(unsigned* p, unsigned v) { return __hip_atomic_fetch_add(p, v, __ATOMIC_RELAXED, __HIP_MEMORY_SCOPE_AGENT); }
__device__ __forceinline__ unsigned xb_xcc_id() { return (unsigned)__builtin_amdgcn_s_getreg((3 << 11) | 20) & 0xFu; }
#define XB_SPIN(cond, bar) do { unsigned _sp = 0; while (cond) { __builtin_amdgcn_s_sleep(1); \
    if ((++_sp & 255u) == 0u) { if (xb_ld(&(bar)[XB_TMO])) break; if (_sp > XB_SPIN_CAP) { atomicAdd(&(bar)[XB_TMO], 1u); break; } } } } while (0)
struct XcdBarrier { unsigned* bar; unsigned x; volatile LAS unsigned* st; };
__device__ __forceinline__ XcdBarrier xcd_barrier_post(unsigned* bar, volatile LAS unsigned* st) {
    XcdBarrier b; b.bar = bar; b.x = xb_xcc_id(); b.st = st;
    if (threadIdx.x == 0) (void)xb_add(&bar[XB_XCNT(b.x)], 1u);
    return b;
}
__device__ __forceinline__ void xcd_barrier_complete(unsigned* bar, unsigned x, unsigned& nloc, unsigned& nx) {
    const unsigned G = gridDim.x * gridDim.y * gridDim.z;
    unsigned sum, cnt, mine, sp = 0u;
    for (;;) {
        sum = 0u; cnt = 0u; mine = 0u;
#pragma unroll
        for (unsigned j = 0; j < 16; ++j) { const unsigned c = xb_ld(&bar[XB_XCNT(j)]); sum += c; cnt += (c > 0u) ? 1u : 0u; mine = (j == x) ? c : mine; }
        if (sum == G) break;
        __builtin_amdgcn_s_sleep(1);
        if ((++sp & 255u) == 0u) { if (xb_ld(&bar[XB_TMO])) break; if (sp > XB_SPIN_CAP) { atomicAdd(&bar[XB_TMO], 1u); break; } }
    }
    nloc = mine > 0u ? mine : 1u; nx = cnt > 0u ? cnt : 1u;
}
__device__ __forceinline__ void xcd_barrier(const XcdBarrier& b) {
    asm volatile("s_waitcnt vmcnt(0)" ::: "memory");
    __syncthreads();
    if (threadIdx.x == 0) {
        unsigned* bar = b.bar;
        __builtin_amdgcn_s_waitcnt(0);
        unsigned nloc = b.st[0], nx = b.st[1];
        if (nloc == 0u) { xcd_barrier_complete(bar, b.x, nloc, nx); b.st[0] = nloc; b.st[1] = nx; }
        const unsigned old = xb_add(&bar[XB_XSUB(b.x)], 1u);
        const unsigned gen = old / nloc;
        if (old + 1u == (gen + 1u) * nloc) {
            __builtin_amdgcn_fence(__ATOMIC_RELEASE, "agent");
            asm volatile("s_waitcnt vmcnt(0)" ::: "memory");
            const unsigned og = xb_add(&bar[XB_TOP], 1u);
            const unsigned tg = og / nx;
            if (og + 1u == (tg + 1u) * nx) xb_add(&bar[XB_TOPGEN], 1u);
            else XB_SPIN(xb_ld(&bar[XB_TOPGEN]) == tg, bar);
            __builtin_amdgcn_fence(__ATOMIC_ACQUIRE, "agent");
            xb_add(&bar[XB_XGEN(b.x)], 1u);
            asm volatile("s_waitcnt vmcnt(0)" ::: "memory");
        } else {
            XB_SPIN(xb_ld(&bar[XB_XGEN(b.x)]) == gen, bar);
            __builtin_amdgcn_fence(__ATOMIC_ACQUIRE, "agent");
            asm volatile("s_waitcnt vmcnt(0)" ::: "memory");
        }
    }
    __syncthreads();
}

struct Params {
    const float* x; const float* p; const int* positions; const float* norm1_w; const float* w_in; const float* w_pool; const float* pool_scale;
    const float* q_norm_w; const float* k_norm_cmp_w; const float* k_norm_slc_w; const float* k_norm_win_w; const float* cmp_pos_k; const float* cmp_pos_v;
    const float* cmp_k_w1; const float* cmp_k_w2; const float* cmp_v_w1; const float* cmp_v_w2; const float* w_o; const float* norm2_w; const float* w_ffn_in;
    const float* conv_w; const float* conv_b; const float* w_ffn_out; const float* w_ple_proj; const float* ple_norm_w; const float* ple_gate_norm_w; const float* w_ple_gate;
    float* out; unsigned char* ws; int ph_lo, ph_hi;
};

namespace pg8 {
constexpr int BM = 256, BK = 64, HALF = 128, HTB = HALF * BK * 2, STAGE_BYTES = 8 * HTB, NXCD = 8, WGM = 8;
__host__ __device__ __forceinline__ int lds_byte(int r, int c) { const int st = (r >> 4) * 2 + (c >> 5), rr = r & 15, cc = c & 31, ob = rr * 64 + cc * 2; return st * 1024 + (ob ^ (((ob >> 9) & 1) << 5)); }
__host__ __device__ __forceinline__ void stage_rc(int b, int& R, int& C) { const int st = b / 1024, sb = b % 1024, swz = sb ^ (((sb >> 9) & 1) << 5); R = (st >> 1) * 16 + swz / 64; C = (st & 1) * 32 + (swz % 64) / 2; }
__host__ __device__ __forceinline__ int perm32(int rho) { const int n = rho >> 4, i = rho & 15; return 8 * (i >> 2) + 4 * n + (i & 3); }
struct Unit { int pm, pn; };

struct StaticOrder {
    int nM, nN, nwg, G, c;
    __device__ void init(int nM_, int nN_, int G_, int c_) { nM = nM_; nN = nN_; nwg = nM * nN; G = G_; c = c_; }
    __device__ bool next(int i, Unit& u) const {
        const long L = (long)i * G + c; if (L >= nwg) return false;
        int wgid = (int)L; { const int q = nwg / NXCD, r = nwg % NXCD, xcd = wgid % NXCD, off = wgid / NXCD; wgid = (xcd < r ? xcd * (q + 1) : r * (q + 1) + (xcd - r) * q) + off; }
        const int nig = WGM * nN, gid = wgid / nig, fm = gid * WGM, gsz = (nM - fm) < WGM ? (nM - fm) : WGM;
        u.pm = fm + ((wgid % nig) % gsz); u.pn = (wgid % nig) / gsz; return true;
    }
};

struct GStd {
    const char* A; const char* B; unsigned lda, ldb; int nt;
    __device__ __forceinline__ const char* a_base(const Unit& u) const { return A + (size_t)u.pm * 256 * lda * 2; }
    __device__ __forceinline__ const char* b_base(const Unit& u) const { return B + (size_t)u.pn * 256 * ldb * 2; }
    __device__ __forceinline__ size_t kpairA() const { return 256; }
};
struct GPool {
    const char* A; const char* B; unsigned lda, ldb; int nt;
    __device__ __forceinline__ const char* a_base(const Unit& u) const { return A + (size_t)u.pm * 256 * lda * 2 + (size_t)u.pn * 512; }
    __device__ __forceinline__ const char* b_base(const Unit& u) const { return B + (size_t)u.pn * 256 * ldb * 2; }
    __device__ __forceinline__ size_t kpairA() const { return 256; }
};
struct GCmp {
    const char* Z; const char* Bk; const char* Bv; unsigned lda, ldb; int nt;
    __device__ __forceinline__ const char* a_base(const Unit& u) const { const int which = u.pm >> 4, g = (u.pm >> 2) & 3, rt = u.pm & 3;
        return Z + (size_t)(OFF_KV + which * 512 + g * 128) * 2 + (size_t)rt * 256 * lda * 2; }
    __device__ __forceinline__ const char* b_base(const Unit& u) const { return (u.pm >> 4) ? Bv : Bk; }
    __device__ __forceinline__ size_t kpairA() const { return (size_t)LDZ * 2; }
};

struct EpiBf16 {
    static constexpr bool PERM = true;
    bf16_t* O; int ldc;
    __device__ __forceinline__ void operator()(const f32x4 (&acc)[2][2][4][2], const Unit& u, int wr, int wc, int fr, int fq) const {
        const int row0 = u.pm * BM + wr * 64 + fr, col0 = u.pn * BM + wc * 32 + 8 * fq;
#pragma unroll
        for (int ai = 0; ai < 2; ++ai)
#pragma unroll
            for (int m = 0; m < 4; ++m) { bf16_t* rowp = O + (size_t)(row0 + ai * HALF + m * 16) * ldc + col0;
#pragma unroll
                for (int bj = 0; bj < 2; ++bj) { const f32x4 v0 = acc[ai][bj][m][0], v1 = acc[ai][bj][m][1];
                    u32x4 w; w.x = cvt_pk_bf16(v0[0], v0[1]); w.y = cvt_pk_bf16(v0[2], v0[3]); w.z = cvt_pk_bf16(v1[0], v1[1]); w.w = cvt_pk_bf16(v1[2], v1[3]);
                    *(u32x4*)(rowp + bj * HALF) = w; } }
    }
};
struct EpiBf16S {
    static constexpr bool PERM = true;
    bf16_t* O; int ldc; float s;
    __device__ __forceinline__ void operator()(const f32x4 (&acc)[2][2][4][2], const Unit& u, int wr, int wc, int fr, int fq) const {
        const int row0 = u.pm * BM + wr * 64 + fr, col0 = u.pn * BM + wc * 32 + 8 * fq;
#pragma unroll
        for (int ai = 0; ai < 2; ++ai)
#pragma unroll
            for (int m = 0; m < 4; ++m) { bf16_t* rowp = O + (size_t)(row0 + ai * HALF + m * 16) * ldc + col0;
#pragma unroll
                for (int bj = 0; bj < 2; ++bj) { const f32x4 v0 = acc[ai][bj][m][0] * s, v1 = acc[ai][bj][m][1] * s;
                    u32x4 w; w.x = cvt_pk_bf16(v0[0], v0[1]); w.y = cvt_pk_bf16(v0[2], v0[3]); w.z = cvt_pk_bf16(v1[0], v1[1]); w.w = cvt_pk_bf16(v1[2], v1[3]);
                    *(u32x4*)(rowp + bj * HALF) = w; } }
    }
};
struct EpiBf16Ssq {
    static constexpr bool PERM = true;
    bf16_t* O; int ldc; float* ssq;
    __device__ __forceinline__ void operator()(const f32x4 (&acc)[2][2][4][2], const Unit& u, int wr, int wc, int fr, int fq) const {
        const int row0 = u.pm * BM + wr * 64 + fr, col0 = u.pn * BM + wc * 32 + 8 * fq;
#pragma unroll
        for (int ai = 0; ai < 2; ++ai)
#pragma unroll
            for (int m = 0; m < 4; ++m) { const int row = row0 + ai * HALF + m * 16; bf16_t* rowp = O + (size_t)row * ldc + col0; float s = 0.f;
#pragma unroll
                for (int bj = 0; bj < 2; ++bj) { const f32x4 v0 = acc[ai][bj][m][0], v1 = acc[ai][bj][m][1];
                    s += v0[0] * v0[0] + v0[1] * v0[1] + v0[2] * v0[2] + v0[3] * v0[3] + v1[0] * v1[0] + v1[1] * v1[1] + v1[2] * v1[2] + v1[3] * v1[3];
                    u32x4 w; w.x = cvt_pk_bf16(v0[0], v0[1]); w.y = cvt_pk_bf16(v0[2], v0[3]); w.z = cvt_pk_bf16(v1[0], v1[1]); w.w = cvt_pk_bf16(v1[2], v1[3]);
                    *(u32x4*)(rowp + bj * HALF) = w; }
                s += __shfl_xor(s, 16); s += __shfl_xor(s, 32);
                if (fq == 0) unsafeAtomicAdd(ssq + row, s); }
    }
};
struct EpiBf16Scale {
    static constexpr bool PERM = true;
    bf16_t* O; int ldc; const float* colscale;
    __device__ __forceinline__ void operator()(const f32x4 (&acc)[2][2][4][2], const Unit& u, int wr, int wc, int fr, int fq) const {
        const int row0 = u.pm * BM + wr * 64 + fr, col0 = u.pn * BM + wc * 32 + 8 * fq;
#pragma unroll
        for (int bj = 0; bj < 2; ++bj) { const f32x4 s0 = *(const f32x4*)(colscale + col0 + bj * HALF), s1 = *(const f32x4*)(colscale + col0 + bj * HALF + 4);
#pragma unroll
            for (int ai = 0; ai < 2; ++ai)
#pragma unroll
                for (int m = 0; m < 4; ++m) { bf16_t* rowp = O + (size_t)(row0 + ai * HALF + m * 16) * ldc + col0;
                    const f32x4 v0 = acc[ai][bj][m][0] * s0, v1 = acc[ai][bj][m][1] * s1;
                    u32x4 w; w.x = cvt_pk_bf16(v0[0], v0[1]); w.y = cvt_pk_bf16(v0[2], v0[3]); w.z = cvt_pk_bf16(v1[0], v1[1]); w.w = cvt_pk_bf16(v1[2], v1[3]);
                    *(u32x4*)(rowp + bj * HALF) = w; } }
    }
};
struct EpiResF32 {
    static constexpr bool PERM = false;
    const float* base; float* C; int ldc; int row_off;
    __device__ __forceinline__ void operator()(const f32x4 (&acc)[2][2][4][2], const Unit& u, int wr, int wc, int fr, int fq) const {
        const int row0 = u.pm * BM + wr * 64 + fr + row_off, col0 = u.pn * BM + wc * 32 + 4 * fq;
#pragma unroll
        for (int ai = 0; ai < 2; ++ai)
#pragma unroll
            for (int m = 0; m < 4; ++m) { const size_t off = (size_t)(row0 + ai * HALF + m * 16) * ldc + col0;
#pragma unroll
                for (int bj = 0; bj < 2; ++bj)
#pragma unroll
                    for (int n = 0; n < 2; ++n) { const f32x4 b = *(const f32x4*)(base + off + bj * HALF + n * 16); *(f32x4*)(C + off + bj * HALF + n * 16) = b + acc[ai][bj][m][n]; }
                asm volatile("" ::: "memory"); }
    }
};
template <bool FP8OUT>
struct EpiResNormT {
    static constexpr bool PERM = false;
    const float* base; float* C; bf16_t* XN; const float* nw; float* ssq; int ldc;
    __device__ __forceinline__ void operator()(const f32x4 (&acc)[2][2][4][2], const Unit& u, int wr, int wc, int fr, int fq) const {
        const int row0 = u.pm * BM + wr * 64 + fr, col0 = u.pn * BM + wc * 32 + 4 * fq;
        f32x4 wv[2][2];
#pragma unroll
        for (int bj = 0; bj < 2; ++bj)
#pragma unroll
            for (int n = 0; n < 2; ++n) wv[bj][n] = *(const f32x4*)(nw + col0 + bj * HALF + n * 16);
        f32x4 bv[2][2][2];
#pragma unroll
        for (int bj = 0; bj < 2; ++bj)
#pragma unroll
            for (int n = 0; n < 2; ++n) bv[0][bj][n] = *(const f32x4*)(base + (size_t)row0 * ldc + col0 + bj * HALF + n * 16);
#pragma unroll
        for (int rg = 0; rg < 8; ++rg) { const int ai = rg >> 2, m = rg & 3; const int row = row0 + ai * HALF + m * 16; const size_t off = (size_t)row * ldc + col0;
            if (rg < 7) { const int ai2 = (rg + 1) >> 2, m2 = (rg + 1) & 3; const size_t off2 = (size_t)(row0 + ai2 * HALF + m2 * 16) * ldc + col0;
#pragma unroll
                for (int bj = 0; bj < 2; ++bj)
#pragma unroll
                    for (int n = 0; n < 2; ++n) bv[(rg + 1) & 1][bj][n] = *(const f32x4*)(base + off2 + bj * HALF + n * 16); }
            float s = 0.f;
#pragma unroll
            for (int bj = 0; bj < 2; ++bj)
#pragma unroll
                for (int n = 0; n < 2; ++n) { const f32x4 v = bv[rg & 1][bj][n] + acc[ai][bj][m][n];
                    *(f32x4*)(C + off + bj * HALF + n * 16) = v; s += v[0] * v[0] + v[1] * v[1] + v[2] * v[2] + v[3] * v[3];
                    if (FP8OUT) { int pk = __builtin_amdgcn_cvt_pk_fp8_f32(v[0] * wv[bj][n][0], v[1] * wv[bj][n][1], 0, false); pk = __builtin_amdgcn_cvt_pk_fp8_f32(v[2] * wv[bj][n][2], v[3] * wv[bj][n][3], pk, true);
                        *(int*)((unsigned char*)XN + off + bj * HALF + n * 16) = pk; }
                    else { u32x2 o; o.x = cvt_pk_bf16(v[0] * wv[bj][n][0], v[1] * wv[bj][n][1]); o.y = cvt_pk_bf16(v[2] * wv[bj][n][2], v[3] * wv[bj][n][3]);
                        *(u32x2*)(XN + off + bj * HALF + n * 16) = o; } }
            s += __shfl_xor(s, 16); s += __shfl_xor(s, 32);
            if (fq == 0) unsafeAtomicAdd(ssq + row, s);
        }
    }
};
typedef EpiResNormT<false> EpiResNorm;
typedef EpiResNormT<true> EpiResNormF8;
struct EpiCmpGelu {
    static constexpr bool PERM = false;
    float* H; const float* bias;
    __device__ __forceinline__ void operator()(const f32x4 (&acc)[2][2][4][2], const Unit& u, int wr, int wc, int fr, int fq) const {
        const int row0 = u.pm * BM + wr * 64 + fr, col0 = wc * 32 + 4 * fq; const float* bs = bias + (u.pm >> 4) * 256;
        f32x4 bvv[2][2];
#pragma unroll
        for (int bj = 0; bj < 2; ++bj)
#pragma unroll
            for (int n = 0; n < 2; ++n) bvv[bj][n] = *(const f32x4*)(bs + col0 + bj * HALF + n * 16);
#pragma unroll
        for (int ai = 0; ai < 2; ++ai)
#pragma unroll
            for (int m = 0; m < 4; ++m) { float* rowp = H + (size_t)(row0 + ai * HALF + m * 16) * 256 + col0;
#pragma unroll
                for (int bj = 0; bj < 2; ++bj)
#pragma unroll
                    for (int n = 0; n < 2; ++n) { f32x4 v = acc[ai][bj][m][n] + bvv[bj][n];
#pragma unroll
                        for (int j = 0; j < 4; ++j) { const float xx = v[j], uu = 0.7978845608028654f * (xx + 0.044715f * xx * xx * xx); const float th = 1.0f - 2.0f / (1.0f + __expf(2.0f * uu)); v[j] = 0.5f * xx * (1.0f + th); }
                        *(f32x4*)(rowp + bj * HALF + n * 16) = v; } }
    }
};
struct EpiGate {
    static constexpr bool PERM = false;
    float* C; const bf16_t* eraw; const float* erstd; const float* pw; const float* ssq; int ldc; float ascale;
    __device__ __forceinline__ void operator()(const f32x4 (&acc)[2][2][4][2], const Unit& u, int wr, int wc, int fr, int fq) const {
        const int row0 = u.pm * BM + wr * 64 + fr, col0 = u.pn * BM + wc * 32 + 4 * fq;
        f32x4 wv[2][2];
#pragma unroll
        for (int bj = 0; bj < 2; ++bj)
#pragma unroll
            for (int n = 0; n < 2; ++n) wv[bj][n] = *(const f32x4*)(pw + col0 + bj * HALF + n * 16);
        f32x4 bv[2][2][2]; u32x2 ev[2][2][2]; float rsv[2], rgv[2];
#pragma unroll
        for (int bj = 0; bj < 2; ++bj)
#pragma unroll
            for (int n = 0; n < 2; ++n) { bv[0][bj][n] = *(const f32x4*)(C + (size_t)row0 * ldc + col0 + bj * HALF + n * 16); ev[0][bj][n] = *(const u32x2*)(eraw + (size_t)row0 * ldc + col0 + bj * HALF + n * 16); }
        rsv[0] = erstd[row0]; rgv[0] = ssq[row0];
#pragma unroll
        for (int rg = 0; rg < 8; ++rg) { const int ai = rg >> 2, m = rg & 3; const int row = row0 + ai * HALF + m * 16; const size_t off = (size_t)row * ldc + col0;
            if (rg < 7) { const int ai2 = (rg + 1) >> 2, m2 = (rg + 1) & 3; const int row2 = row0 + ai2 * HALF + m2 * 16; const size_t off2 = (size_t)row2 * ldc + col0;
#pragma unroll
                for (int bj = 0; bj < 2; ++bj)
#pragma unroll
                    for (int n = 0; n < 2; ++n) { bv[(rg + 1) & 1][bj][n] = *(const f32x4*)(C + off2 + bj * HALF + n * 16); ev[(rg + 1) & 1][bj][n] = *(const u32x2*)(eraw + off2 + bj * HALF + n * 16); }
                rsv[(rg + 1) & 1] = erstd[row2]; rgv[(rg + 1) & 1] = ssq[row2]; }
            const float rs = rsqrtf(rsv[rg & 1] * (1.0f / DM) + EPS), rg_ = rsqrtf(rgv[rg & 1] * (1.0f / DM) + EPS) * ascale;
#pragma unroll
            for (int bj = 0; bj < 2; ++bj)
#pragma unroll
                for (int n = 0; n < 2; ++n) { const f32x4 b = bv[rg & 1][bj][n]; const u32x2 e = ev[rg & 1][bj][n]; const f32x4 a = acc[ai][bj][m][n]; f32x4 o;
                    o[0] = b[0] + bf_lo(e.x) * rs * wv[bj][n][0] * sigmoidf_(a[0] * rg_); o[1] = b[1] + bf_hi(e.x) * rs * wv[bj][n][1] * sigmoidf_(a[1] * rg_);
                    o[2] = b[2] + bf_lo(e.y) * rs * wv[bj][n][2] * sigmoidf_(a[2] * rg_); o[3] = b[3] + bf_hi(e.y) * rs * wv[bj][n][3] * sigmoidf_(a[3] * rg_);
                    *(f32x4*)(C + off + bj * HALF + n * 16) = o; }
        }
    }
};
struct GFfn {
    const char* A; const char* B; unsigned lda, ldb; int nt;
    __device__ __forceinline__ const char* a_base(const Unit& u) const { return A + ((long)u.pm * 254 - 2) * (long)lda * 2; }
    __device__ __forceinline__ const char* b_base(const Unit& u) const { return B + (size_t)u.pn * 256 * ldb * 2; }
    __device__ __forceinline__ size_t kpairA() const { return 256; }
};
template <int CTRL> __device__ __forceinline__ float dpp_f(float v) { return __int_as_float(__builtin_amdgcn_update_dpp(0, __float_as_int(v), CTRL, 0xf, 0xf, false)); }
struct EpiFfn {
    static constexpr bool PERM = true;
    bf16_t* ACT; const float* cw; const float* cb; LAS float* X; const float* ssq;
    __device__ __forceinline__ void operator()(const f32x4 (&acc)[2][2][4][2], const Unit& u, int wr, int wc, int fr, int fq) const {
        const int colw = wc * 32 + 8 * fq;
        float rsv[2][4];
#pragma unroll
        for (int ai = 0; ai < 2; ++ai)
#pragma unroll
            for (int m = 0; m < 4; ++m) { const long t = (long)u.pm * 254 - 2 + ai * HALF + wr * 64 + m * 16 + fr; rsv[ai][m] = (t >= 0 && t < S_) ? rsqrtf(ssq[t] * (1.0f / DM) + EPS) : 0.f; }
        if (fr >= 14) {
#pragma unroll
            for (int ai = 0; ai < 2; ++ai)
#pragma unroll
                for (int n = 0; n < 2; ++n) *(LAS f32x4*)(X + ((2 * ai + wr) * 2 + (fr - 14)) * 128 + colw + 4 * n) = acc[ai][0][3][n] * rsv[ai][3];
        }
        asm volatile("s_waitcnt lgkmcnt(0)" ::: "memory");
        __builtin_amdgcn_s_barrier(); asm volatile("" ::: "memory");
        __builtin_amdgcn_s_barrier(); asm volatile("" ::: "memory");
        const int f0 = u.pn * 128 + colw;
        f32x4 w0[2], w1[2], w2[2], cbv[2];
#pragma unroll
        for (int n = 0; n < 2; ++n) { w0[n] = *(const f32x4*)(cw + f0 + 4 * n); w1[n] = *(const f32x4*)(cw + DFF + f0 + 4 * n); w2[n] = *(const f32x4*)(cw + 2 * DFF + f0 + 4 * n); cbv[n] = *(const f32x4*)(cb + f0 + 4 * n); }
#pragma unroll
        for (int ai = 0; ai < 2; ++ai) {
            f32x4 pv[2];
            const int pseg = 2 * ai + wr - 1;
#pragma unroll
            for (int n = 0; n < 2; ++n) { pv[n] = (f32x4){0.f, 0.f, 0.f, 0.f}; if (pseg >= 0 && fr >= 14) pv[n] = *(const LAS f32x4*)(X + (pseg * 2 + (fr - 14)) * 128 + colw + 4 * n); }
#pragma unroll
            for (int m = 0; m < 4; ++m) {
                const int r = ai * HALF + wr * 64 + m * 16 + fr; const long t = (long)u.pm * 254 - 2 + r;
                unsigned ow[4];
#pragma unroll
                for (int n = 0; n < 2; ++n) {
                    const f32x4 cur = acc[ai][0][m][n] * rsv[ai][m], up = acc[ai][1][m][n] * rsv[ai][m]; f32x4 o;
#pragma unroll
                    for (int i = 0; i < 4; ++i) {
                        const float c1 = dpp_f<0x121>(cur[i]), p1 = dpp_f<0x121>(pv[n][i]), c2 = dpp_f<0x122>(cur[i]), p2 = dpp_f<0x122>(pv[n][i]);
                        const float x1 = fr >= 1 ? c1 : p1, x2 = fr >= 2 ? c2 : p2;
                        const float y = cbv[n][i] + w0[n][i] * x2 + w1[n][i] * x1 + w2[n][i] * cur[i];
                        o[i] = y * sigmoidf_(y) * up[i];
                    }
                    ow[2 * n] = cvt_pk_bf16(o[0], o[1]); ow[2 * n + 1] = cvt_pk_bf16(o[2], o[3]);
                    pv[n] = cur;
                }
                if (r >= 2 && t < S_) *(u32x4*)(ACT + (size_t)t * DFF + f0) = (u32x4){ow[0], ow[1], ow[2], ow[3]};
            }
        }
    }
};

template <class GD, class Epi, bool F8 = false>
__device__ __forceinline__ void gemm_phase(LAS unsigned char* lds, const GD g, const StaticOrder& S, const Epi& E) {
    const int tid = threadIdx.x, wid = __builtin_amdgcn_readfirstlane(tid >> 6), lane = tid & 63, wr = wid >> 2, wc = wid & 3, fr = lane & 15, fq = lane >> 4;
    const int nt = g.nt;
    unsigned voffA[2], voffB[2];
#pragma unroll
    for (int i = 0; i < 2; ++i) { int R, C; stage_rc(tid * 16 + i * 8192, R, C); const int Rb = Epi::PERM ? ((R & ~31) + perm32(R & 31)) : R;
        voffA[i] = (unsigned)(R * g.lda + C) * 2u; voffB[i] = (unsigned)(Rb * g.ldb + C) * 2u; }
    const size_t kpA = g.kpairA();
    const size_t hstepA = (size_t)HALF * g.lda * 2, hstepB = (size_t)HALF * g.ldb * 2;
    const unsigned ldsw = (unsigned)wid * 1024u;
    const int aoff = lds_byte(wr * 64 + fr, fq * 8), boff = lds_byte(wc * 32 + fr, fq * 8);
#define PG8_SA(b, h) (((b) * 2 + (h)) * HTB)
#define PG8_SB(b, h) ((4 + (b) * 2 + (h)) * HTB)
#define PG8_STAGE(bufoff, gbase, voff) do { _Pragma("unroll") for (int _i = 0; _i < 2; ++_i) \
        __builtin_amdgcn_global_load_lds((const unsigned*)((const char*)(gbase) + (voff)[_i]), (LAS unsigned*)(lds + (bufoff) + ldsw + _i * 8192), 16, 0, 0); } while (0)
#define PG8_LDA(dst, b, h) do { if constexpr (F8) { _Pragma("unroll") for (int m = 0; m < 4; ++m) { const i32x4 lo_ = *(const LAS i32x4*)(lds + PG8_SA(b, h) + aoff + m * 2048), hi_ = *(const LAS i32x4*)(lds + PG8_SA(b, h) + aoff + m * 2048 + 1024); \
            dst##8[m] = __builtin_shufflevector(lo_, hi_, 0, 1, 2, 3, 4, 5, 6, 7); } } \
        else { _Pragma("unroll") for (int m = 0; m < 4; ++m) _Pragma("unroll") for (int k = 0; k < 2; ++k) dst[m][k] = *(const LAS bf16x8*)(lds + PG8_SA(b, h) + aoff + m * 2048 + k * 1024); } } while (0)
#define PG8_LDB(dst, b, h) do { if constexpr (F8) { _Pragma("unroll") for (int n = 0; n < 2; ++n) { const i32x4 lo_ = *(const LAS i32x4*)(lds + PG8_SB(b, h) + boff + n * 2048), hi_ = *(const LAS i32x4*)(lds + PG8_SB(b, h) + boff + n * 2048 + 1024); \
            dst##8[n] = __builtin_shufflevector(lo_, hi_, 0, 1, 2, 3, 4, 5, 6, 7); } } \
        else { _Pragma("unroll") for (int n = 0; n < 2; ++n) _Pragma("unroll") for (int k = 0; k < 2; ++k) dst[n][k] = *(const LAS bf16x8*)(lds + PG8_SB(b, h) + boff + n * 2048 + k * 1024); } } while (0)
#define PG8_MMA(ai, bj, At, Bt) do { __builtin_amdgcn_s_setprio(1); \
        if constexpr (F8) { _Pragma("unroll") for (int m = 0; m < 4; ++m) _Pragma("unroll") for (int n = 0; n < 2; ++n) \
            asm volatile("v_mfma_scale_f32_16x16x128_f8f6f4 %0, %1, %2, %0, %3, %3 op_sel_hi:[0,0,0]" : "+v"(acc[ai][bj][m][n]) : "v"(Bt##8[n]), "v"(At##8[m]), "v"(one_scale)); } \
        else { _Pragma("unroll") for (int m = 0; m < 4; ++m) _Pragma("unroll") for (int n = 0; n < 2; ++n) _Pragma("unroll") for (int k = 0; k < 2; ++k) \
            acc[ai][bj][m][n] = __builtin_amdgcn_mfma_f32_16x16x32_bf16(Bt[n][k], At[m][k], acc[ai][bj][m][n], 0, 0, 0); } \
        __builtin_amdgcn_s_setprio(0); } while (0)
#define PG8_WAIT_V(n) asm volatile("s_waitcnt vmcnt(" #n ")" ::: "memory")
#define PG8_WAIT_L(n) asm volatile("s_waitcnt lgkmcnt(" #n ")" ::: "memory")
#define PG8_BAR __builtin_amdgcn_s_barrier()
#define PG8_SCHED __builtin_amdgcn_sched_barrier(0)
    Unit cur, nxt; int ui = 0;
    if (!S.next(0, cur)) return;
    f32x4 acc[2][2][4][2];
#pragma unroll
    for (int a = 0; a < 2; ++a)
#pragma unroll
        for (int b = 0; b < 2; ++b)
#pragma unroll
            for (int m = 0; m < 4; ++m)
#pragma unroll
                for (int n = 0; n < 2; ++n) acc[a][b][m][n] = (f32x4){0.f, 0.f, 0.f, 0.f};
    bf16x8 At[4][2], B0[2][2], B1[2][2];
    i32x8 At8[4], B08[2], B18[2];
    (void)At; (void)B0; (void)B1; (void)At8; (void)B08; (void)B18;
    int one_scale = 0x7F7F7F7F; (void)one_scale;
    const char* cA = g.a_base(cur); const char* cB = g.b_base(cur);
    PG8_STAGE(PG8_SB(0, 0), cB, voffB); PG8_STAGE(PG8_SA(0, 0), cA, voffA); PG8_STAGE(PG8_SB(0, 1), cB + hstepB, voffB); PG8_STAGE(PG8_SA(0, 1), cA + hstepA, voffA);
    if (wr == 1) PG8_BAR;
    PG8_WAIT_V(4); PG8_BAR;
    PG8_STAGE(PG8_SB(1, 0), cB + 128, voffB); PG8_STAGE(PG8_SA(1, 0), cA + 128, voffA); PG8_STAGE(PG8_SB(1, 1), cB + hstepB + 128, voffB);
    PG8_WAIT_V(6); PG8_BAR;
    for (;;) {
        const bool has_next = S.next(ui + 1, nxt);
        const char* nA = has_next ? g.a_base(nxt) : cA; const char* nB = has_next ? g.b_base(nxt) : cB;
        for (int t = 0; t < nt; t += 2) {
            const bool last = (t == nt - 2);
            const char* a0 = cA + (size_t)(t >> 1) * kpA;
            const char* a1 = a0 + 128;
            const char* a2 = last ? nA : a0 + kpA; const char* b2 = last ? nB : cB + (size_t)(t + 2) * 128;
            const char* a3 = a2 + 128; const char* b3 = b2 + 128;
            PG8_LDB(B0, 0, 0); PG8_SCHED; PG8_LDA(At, 0, 0); PG8_STAGE(PG8_SA(1, 1), a1 + hstepA, voffA);
            PG8_WAIT_L(8); PG8_BAR; PG8_WAIT_L(0); PG8_MMA(0, 0, At, B0); PG8_BAR; PG8_SCHED;
            PG8_LDB(B1, 0, 1); PG8_STAGE(PG8_SB(0, 0), b2, voffB);
            PG8_BAR; PG8_WAIT_L(0); PG8_MMA(0, 1, At, B1); PG8_BAR;
            PG8_LDA(At, 0, 1); PG8_STAGE(PG8_SA(0, 0), a2, voffA);
            PG8_BAR; PG8_WAIT_L(0); PG8_MMA(1, 0, At, B0); PG8_BAR; PG8_SCHED;
            PG8_STAGE(PG8_SB(0, 1), b2 + hstepB, voffB);
            PG8_WAIT_V(6); PG8_BAR; PG8_MMA(1, 1, At, B1); PG8_BAR;
            PG8_LDB(B0, 1, 0); PG8_SCHED; PG8_LDA(At, 1, 0); PG8_STAGE(PG8_SA(0, 1), a2 + hstepA, voffA);
            PG8_WAIT_L(8); PG8_BAR; PG8_WAIT_L(0); PG8_MMA(0, 0, At, B0); PG8_BAR; PG8_SCHED;
            PG8_LDB(B1, 1, 1); PG8_STAGE(PG8_SB(1, 0), b3, voffB);
            PG8_BAR; PG8_WAIT_L(0); PG8_MMA(0, 1, At, B1); PG8_BAR;
            PG8_LDA(At, 1, 1); PG8_STAGE(PG8_SA(1, 0), a3, voffA);
            PG8_BAR; PG8_WAIT_L(0); PG8_MMA(1, 0, At, B0); PG8_BAR; PG8_SCHED;
            PG8_STAGE(PG8_SB(1, 1), b3 + hstepB, voffB);
            PG8_WAIT_V(6); PG8_BAR; PG8_MMA(1, 1, At, B1); PG8_BAR;
        }
        if constexpr (F8) asm volatile("s_nop 15\n\ts_nop 15\n\ts_nop 15" ::: "memory");
        E(acc, cur, wr, wc, fr, fq);
        if (!has_next) break;
#pragma unroll
        for (int a = 0; a < 2; ++a)
#pragma unroll
            for (int b = 0; b < 2; ++b)
#pragma unroll
                for (int m = 0; m < 4; ++m)
#pragma unroll
                    for (int n = 0; n < 2; ++n) acc[a][b][m][n] = (f32x4){0.f, 0.f, 0.f, 0.f};
        cur = nxt; cA = nA; cB = nB; ++ui;
    }
    PG8_WAIT_V(0);
    if (wr == 0) PG8_BAR;
    PG8_BAR;
#undef PG8_SA
#undef PG8_SB
#undef PG8_STAGE
#undef PG8_LDA
#undef PG8_LDB
#undef PG8_MMA
#undef PG8_WAIT_V
#undef PG8_WAIT_L
#undef PG8_BAR
#undef PG8_SCHED
}
}

namespace att {
constexpr int KVBLK = 64;
constexpr int SHM_V = KVBLK * HD * 2, SHM_K = KVBLK * HD * 2, SHM_ATTN = 2 * SHM_V + 2 * SHM_K + NWAVES * 64 * 4;
#define KSWZ(row, colB) ((row) * 256 + ((colB) ^ (((row) & 7) << 4)))
#define SBAR() __builtin_amdgcn_sched_barrier(0)
__device__ __forceinline__ int crow(int r, int hi) { return (r & 3) + 8 * (r >> 2) + 4 * hi; }
__device__ __forceinline__ void qkt(f32x16& p0, f32x16& p1, const char* Ks, const bf16x8* qr, int r32, int hi) {
    p0 = f32x16{}; p1 = f32x16{};
    bf16x8 ka[2], kb[2];
    { const int cb = (hi * 8) * 2; ka[0] = *reinterpret_cast<const bf16x8*>(Ks + KSWZ(r32, cb)); kb[0] = *reinterpret_cast<const bf16x8*>(Ks + KSWZ(32 + r32, cb)); }
#pragma unroll
    for (int d0 = 0; d0 < 8; ++d0) {
        if (d0 < 7) { const int cb = ((d0 + 1) * 16 + hi * 8) * 2;
            ka[(d0 + 1) & 1] = *reinterpret_cast<const bf16x8*>(Ks + KSWZ(r32, cb)); kb[(d0 + 1) & 1] = *reinterpret_cast<const bf16x8*>(Ks + KSWZ(32 + r32, cb)); }
        SBAR();
        p0 = __builtin_amdgcn_mfma_f32_32x32x16_bf16(ka[d0 & 1], qr[d0], p0, 0, 0, 0);
        p1 = __builtin_amdgcn_mfma_f32_32x32x16_bf16(kb[d0 & 1], qr[d0], p1, 0, 0, 0);
        SBAR();
    }
}
__device__ __forceinline__ int v_st(int k, int c) { const int kk = (k & ~0xC) | ((k & 4) << 1) | ((k & 8) >> 1); return ((kk >> 3) * 4 + (c >> 5)) * 512 + ((kk & 7) * 32 + (c & 31)) * 2; }
__device__ __forceinline__ int v_rd_base(int lane) { return ((lane & 3) << 3) | (((lane >> 2) & 3) << 6) | (((lane >> 4) & 1) << 5) | (((lane >> 5) & 1) << 8); }
constexpr int v_rd_off(int d0, int ks, int half) { return d0 * 512 + ks * 4096 + half * 2048; }
__device__ __forceinline__ s16x4 tr_read(int vb, int off) { return __builtin_amdgcn_ds_read_tr16_b64_v4i16((LAS s16x4*)(unsigned long)(unsigned)(vb + off)); }
__device__ __forceinline__ void pv_d0(f32x16* o, int vb, bf16x8 pa0, bf16x8 pa1, bf16x8 pa2, bf16x8 pa3) {
    s16x4 L[2][4], H[2][4];
#pragma unroll
    for (int d0 = 0; d0 < 4; ++d0) { L[0][d0] = tr_read(vb, v_rd_off(d0, 0, 0)); H[0][d0] = tr_read(vb, v_rd_off(d0, 0, 1)); }
#pragma unroll
    for (int ks = 0; ks < 4; ++ks) {
        if (ks < 3) {
#pragma unroll
            for (int d0 = 0; d0 < 4; ++d0) { L[(ks + 1) & 1][d0] = tr_read(vb, v_rd_off(d0, ks + 1, 0)); H[(ks + 1) & 1][d0] = tr_read(vb, v_rd_off(d0, ks + 1, 1)); }
        }
        const bf16x8 pa = ks == 0 ? pa0 : (ks == 1 ? pa1 : (ks == 2 ? pa2 : pa3));
#pragma unroll
        for (int d0 = 0; d0 < 4; ++d0) { const s16x4 l = L[ks & 1][d0], h = H[ks & 1][d0];
            o[d0] = __builtin_amdgcn_mfma_f32_32x32x16_bf16(pa, (bf16x8){l[0], l[1], l[2], l[3], h[0], h[1], h[2], h[3]}, o[d0], 0, 0, 0); }
    }
}
__device__ __forceinline__ void pack_p(const f32x16& p0, const f32x16& p1, bf16x8& pa0, bf16x8& pa1, bf16x8& pa2, bf16x8& pa3) {
#define PK4(P, BASE, OUT) do { unsigned a0 = cvt_pk_bf16(P[BASE + 0], P[BASE + 1]), a1 = cvt_pk_bf16(P[BASE + 2], P[BASE + 3]);   \
    unsigned b0 = cvt_pk_bf16(P[BASE + 4], P[BASE + 5]), b1 = cvt_pk_bf16(P[BASE + 6], P[BASE + 7]);                              \
    auto r0 = __builtin_amdgcn_permlane32_swap(a0, b0, false, false); auto r1 = __builtin_amdgcn_permlane32_swap(a1, b1, false, false); \
    u32x4 w = {r0[0], r1[0], r0[1], r1[1]}; OUT = *reinterpret_cast<bf16x8*>(&w); } while (0)
    PK4(p0, 0, pa0); PK4(p0, 8, pa1); PK4(p1, 0, pa2); PK4(p1, 8, pa3);
#undef PK4
}

__device__ __forceinline__ void pack_half(const f32x16& p, bf16x8& paA, bf16x8& paB) {
#define PK4(P, BASE, OUT) do { unsigned a0 = cvt_pk_bf16(P[BASE + 0], P[BASE + 1]), a1 = cvt_pk_bf16(P[BASE + 2], P[BASE + 3]);   \
    unsigned b0 = cvt_pk_bf16(P[BASE + 4], P[BASE + 5]), b1 = cvt_pk_bf16(P[BASE + 6], P[BASE + 7]);                              \
    auto r0 = __builtin_amdgcn_permlane32_swap(a0, b0, false, false); auto r1 = __builtin_amdgcn_permlane32_swap(a1, b1, false, false); \
    u32x4 w = {r0[0], r1[0], r0[1], r1[1]}; OUT = *reinterpret_cast<bf16x8*>(&w); } while (0)
    PK4(p, 0, paA); PK4(p, 8, paB);
#undef PK4
}
template <int KS0, bool WITH_EXP>
__device__ __forceinline__ void pv_half(f32x16* o, int vb, bf16x8 paA, bf16x8 paB, f32x16& px, float off) {
    s16x4 L[2][4], H[2][4];
#pragma unroll
    for (int d0 = 0; d0 < 4; ++d0) { L[0][d0] = tr_read(vb, v_rd_off(d0, KS0, 0)); H[0][d0] = tr_read(vb, v_rd_off(d0, KS0, 1)); }
#pragma unroll
    for (int d0 = 0; d0 < 4; ++d0) { L[1][d0] = tr_read(vb, v_rd_off(d0, KS0 + 1, 0)); H[1][d0] = tr_read(vb, v_rd_off(d0, KS0 + 1, 1)); }
#pragma unroll
    for (int kk = 0; kk < 2; ++kk) {
        const bf16x8 pa = kk == 0 ? paA : paB;
#pragma unroll
        for (int d0 = 0; d0 < 4; ++d0) { const s16x4 l = L[kk][d0], h = H[kk][d0];
            if (WITH_EXP) SBAR();
            o[d0] = __builtin_amdgcn_mfma_f32_32x32x16_bf16(pa, (bf16x8){l[0], l[1], l[2], l[3], h[0], h[1], h[2], h[3]}, o[d0], 0, 0, 0);
            if (WITH_EXP) {
#pragma unroll
                for (int q = 0; q < 2; ++q) { const int r = (kk * 4 + d0) * 2 + q; px[r] = __builtin_amdgcn_exp2f(fmaf(px[r], SM_C, off)); }
                SBAR(); }
        }
    }
}
enum { MODE_CMP = 0, MODE_WIN = 1, MODE_SLC = 2 };
struct AttnArgs {
    const bf16_t* Z; const bf16_t* KC; const bf16_t* VC; const float* G; float* L; float* OACC; bf16_t* MIX; const unsigned* BM; const float* TAB;
};
template <int MODE>
__device__ __forceinline__ void attn_unit(const AttnArgs& a, LAS char* ldsL, int qt, int g, int hp) {
    char* lds = (char*)ldsL;
    const int tid = threadIdx.x, wid = __builtin_amdgcn_readfirstlane(tid >> 6), lane = tid & 63, r32 = lane & 31, hi = lane >> 5;
    float* li_l = (float*)(lds + LDS_XCH) + wid * 64;
    const int t0 = MODE == MODE_SLC ? qt * 40 : qt * 128;
    const int tq_raw = MODE == MODE_SLC ? t0 + wid * 5 + r32 / 6 : t0 + wid * 16 + (r32 & 15);
    const bool rvalid = MODE == MODE_SLC ? (r32 < 30 && tq_raw < S_) : true;
    const int tq = tq_raw < S_ ? tq_raw : S_ - 1;
    const int hq = MODE == MODE_SLC ? g * HPG + r32 % 6 : g * HPG + hp * 2 + (r32 >> 4);
    const int tlast = MODE == MODE_SLC ? ((t0 + 39) < S_ ? (t0 + 39) : S_ - 1) : t0 + 127;
    const bf16_t* Kb; const bf16_t* Vb; long ldk;
    if (MODE == MODE_CMP) { Kb = a.KC + (size_t)g * 1024 * HD; Vb = a.VC + (size_t)g * 1024 * HD; ldk = HD; }
    else if (MODE == MODE_WIN) { Kb = a.Z + OFF_KV + 4 * 512 + g * HD; Vb = a.Z + OFF_KV + 5 * 512 + g * HD; ldk = LDZ; }
    else { Kb = a.Z + OFF_KV + 2 * 512 + g * HD; Vb = a.Z + OFF_KV + 3 * 512 + g * HD; ldk = LDZ; }
    int j0, j1;
    if (MODE == MODE_CMP) { j0 = 0; j1 = (((t0 + 127 - 31) >> 4) >> 6) + 1; }
    else if (MODE == MODE_WIN) { j0 = (t0 - 511) > 0 ? ((t0 - 511) >> 6) : 0; j1 = ((t0 + 127) >> 6) + 1; }
    else { j0 = 0; j1 = (tlast >> 6) + 1; }
    int klo, khi;
    if (MODE == MODE_CMP) { klo = 0; khi = tq >= 31 ? ((tq - 31) >> 4) : -1; }
    else if (MODE == MODE_WIN) { klo = tq - 511; khi = tq; }
    else { klo = 0; khi = rvalid ? tq : -1; }
    float negBC = -a.TAB[512 + (MODE == MODE_CMP ? 0 : (MODE == MODE_SLC ? 1 : 2))];
    bf16x8 qr[8];
    { const bf16_t* Qw = a.Z + (size_t)tq * LDZ + OFF_Q + hq * HD + hi * 8;
#pragma unroll
      for (int d0 = 0; d0 < 8; ++d0) qr[d0] = *reinterpret_cast<const bf16x8*>(Qw + d0 * 16); }
    f32x16 o[4] = {}; float lsum = 0.f;
    unsigned soK[2], soV[2];
#pragma unroll
    for (int i = 0; i < 2; ++i) { const int p = (wid + 8 * i) * 64 + lane;
        { const int row = p >> 4, c = (p & 15) ^ (row & 7); soK[i] = (unsigned)(row * ldk + c * 8) * 2u; }
        { const int sub = p >> 5, within = p & 31, kk = (sub >> 2) * 8 + (within >> 2), c = (sub & 3) * 32 + (within & 3) * 8, k = (kk & ~0xC) | ((kk & 4) << 1) | ((kk & 8) >> 1);
          soV[i] = (unsigned)(k * ldk + c) * 2u; } }
    const int vb0 = (int)(uintptr_t)(LAS char*)ldsL + 16384 + v_rd_base(lane);
#define ISSUE(jt) do { const int _b = ((jt) - j0) & 3; const char* _kp = (const char*)Kb + (size_t)(jt) * KVBLK * ldk * 2; const char* _vp = (const char*)Vb + (size_t)(jt) * KVBLK * ldk * 2; \
    _Pragma("unroll") for (int _i = 0; _i < 2; ++_i) { \
        __builtin_amdgcn_global_load_lds((const unsigned*)(_kp + soK[_i]), (LAS unsigned*)(ldsL + _b * 32768 + (wid + 8 * _i) * 1024), 16, 0, 0); \
        __builtin_amdgcn_global_load_lds((const unsigned*)(_vp + soV[_i]), (LAS unsigned*)(ldsL + _b * 32768 + 16384 + (wid + 8 * _i) * 1024), 16, 0, 0); } } while (0)
    unsigned bmw = 0u;
    if (MODE == MODE_SLC) bmw = a.BM[((size_t)tq * 4 + g) * 8];
    asm volatile("s_waitcnt lgkmcnt(0)" ::: "memory");
    __builtin_amdgcn_s_barrier();
    asm volatile("" ::: "memory");
    ISSUE(j0);
    asm volatile("s_waitcnt vmcnt(4) lgkmcnt(0)" : "+v"(bmw), "+v"(negBC), "+v"(qr[0]), "+v"(qr[1]), "+v"(qr[2]), "+v"(qr[3]), "+v"(qr[4]), "+v"(qr[5]), "+v"(qr[6]), "+v"(qr[7]) :: "memory");
    if (j0 + 1 < j1) ISSUE(j0 + 1); if (j0 + 2 < j1) ISSUE(j0 + 2);
    for (int j = j0; j < j1; ++j) {
        const int buf = (j - j0) & 3;
        if (j + 2 < j1) asm volatile("s_waitcnt vmcnt(8)" ::: "memory"); else if (j + 1 < j1) asm volatile("s_waitcnt vmcnt(4)" ::: "memory"); else asm volatile("s_waitcnt vmcnt(0)" ::: "memory");
        __builtin_amdgcn_s_barrier();
        asm volatile("" ::: "memory");
        if (j + 3 < j1) ISSUE(j + 3);
        int lhi = khi;
        if (MODE == MODE_SLC) { if (!((bmw >> (j & 31)) & 1u)) lhi = -1; }
        const int kb = j * KVBLK;
        const bool l_any = (kb + 63 >= klo) && (kb <= lhi);
        const bool l_full = (kb >= klo) && (kb + 63 <= lhi);
        if (__any(l_any)) {
            f32x16 p0, p1;
            qkt(p0, p1, lds + buf * 32768, qr, r32, hi);
            const bool uni = __all(l_full || !l_any);
            const float off = (uni && !l_any) ? -1.0e30f : negBC;
#pragma unroll
            for (int r = 0; r < 16; ++r) p0[r] = __builtin_amdgcn_exp2f(fmaf(p0[r], SM_C, off));
            if (!uni) {
#pragma unroll
                for (int r = 0; r < 16; ++r) { const int k0i = kb + crow(r, hi); p0[r] = (k0i >= klo && k0i <= lhi) ? p0[r] : 0.f; } }
            float ps = 0.f;
#pragma unroll
            for (int r = 0; r < 16; ++r) ps += p0[r];
            bf16x8 pa0, pa1, pa2, pa3; pack_half(p0, pa0, pa1);
            pv_half<0, true>(o, vb0 + buf * 32768, pa0, pa1, p1, off);
            if (!uni) {
#pragma unroll
                for (int r = 0; r < 16; ++r) { const int k1i = kb + 32 + crow(r, hi); p1[r] = (k1i >= klo && k1i <= lhi) ? p1[r] : 0.f; } }
#pragma unroll
            for (int r = 0; r < 16; ++r) ps += p1[r];
            lsum += ps;
            pack_half(p1, pa2, pa3);
            pv_half<2, false>(o, vb0 + buf * 32768, pa2, pa3, p1, off);
        }
        if (MODE == MODE_SLC) { if (((j + 1) & 31) == 0 && j + 1 < j1) { bmw = a.BM[((size_t)tq * 4 + g) * 8 + ((j + 1) >> 5)]; asm volatile("s_waitcnt vmcnt(0)" : "+v"(bmw) :: "memory"); } }
    }
#undef ISSUE
    lsum += __shfl_xor(lsum, 32);
    if (hi == 0) li_l[r32] = lsum;
    if (MODE == MODE_CMP) { if (hi == 0) a.L[(size_t)tq * NH + hq] = lsum; }
    asm volatile("s_waitcnt lgkmcnt(0)" ::: "memory");
    float gtv[16]; f32x16 pvv[4];
#pragma unroll
    for (int r = 0; r < 16; ++r) {
        const int orow = crow(r, hi); const float lv = li_l[orow]; const float rl = lv > 0.f ? 1.0f / lv : 0.f;
        const int t = MODE == MODE_SLC ? t0 + wid * 5 + orow / 6 : t0 + wid * 16 + (orow & 15);
        const int h = MODE == MODE_SLC ? g * HPG + orow % 6 : g * HPG + hp * 2 + (orow >> 4);
        const bool valid = !(MODE == MODE_SLC && (orow >= 30 || t >= S_)); const int tc = valid ? t : 0;
        gtv[r] = valid ? a.G[(size_t)tc * NGATE + h * 3 + (MODE == MODE_CMP ? 0 : (MODE == MODE_SLC ? 1 : 2))] * rl : 0.f;
        if (MODE != MODE_CMP) { const float* oa = a.OACC + (size_t)tc * 3072 + h * HD + r32;
#pragma unroll
            for (int d0 = 0; d0 < 4; ++d0) pvv[d0][r] = oa[d0 * 32]; }
    }
#pragma unroll
    for (int r = 0; r < 16; ++r) {
        const int orow = crow(r, hi);
        const int t = MODE == MODE_SLC ? t0 + wid * 5 + orow / 6 : t0 + wid * 16 + (orow & 15);
        const int h = MODE == MODE_SLC ? g * HPG + orow % 6 : g * HPG + hp * 2 + (orow >> 4);
        if (MODE == MODE_SLC && (orow >= 30 || t >= S_)) continue;
        float* oa = a.OACC + (size_t)t * 3072 + h * HD + r32;
#pragma unroll
        for (int d0 = 0; d0 < 4; ++d0) {
            const float v = o[d0][r] * gtv[r];
            if (MODE == MODE_CMP) oa[d0 * 32] = v;
            else if (MODE == MODE_WIN) oa[d0 * 32] = pvv[d0][r] + v;
            else a.MIX[(size_t)t * DM + POOLW + h * HD + d0 * 32 + r32] = (bf16_t)(cvt_pk_bf16(pvv[d0][r] + v, 0.f) & 0xffffu);
        }
    }
}

__device__ __forceinline__ void imp_task(const AttnArgs& a, float* IMPP, float* IMPF, int tqi, int g) {
    const int lane = threadIdx.x & 63, fr = lane & 15, fq = lane >> 4;
    const int t = tqi * 16 + fr;
    const int tmax = tqi * 16 + 15;
    if (tmax < 31) return;
    const int lim = t >= 31 ? ((t - 31) >> 4) : -1;
    const int nstep = ((((tmax - 31) >> 4) >> 6) + 1) * 4;
    const float negBC = -a.TAB[512];
    bf16x8 qf[HPG][4]; float rl[HPG];
#pragma unroll
    for (int h = 0; h < HPG; ++h) {
        const bf16_t* qp = a.Z + (size_t)t * LDZ + OFF_Q + (g * HPG + h) * HD + fq * 8;
#pragma unroll
        for (int ks = 0; ks < 4; ++ks) qf[h][ks] = *reinterpret_cast<const bf16x8*>(qp + ks * 32);
        const float lv = a.L[(size_t)t * NH + g * HPG + h]; rl[h] = lv > 0.f ? 1.0f / lv : 0.f;
    }
    const bf16_t* kbase = a.KC + (size_t)g * 1024 * HD + (size_t)fr * HD + fq * 8;
    bf16x8 kf[4], kn[4];
#pragma unroll
    for (int ks = 0; ks < 4; ++ks) kf[ks] = *reinterpret_cast<const bf16x8*>(kbase + ks * 32);
    float* op = IMPP + ((size_t)t * 4 + g) * 256 + fq; float* of = IMPF + ((size_t)t * 4 + g) * 256 + fq;
    for (int st = 0; st < nstep; ++st) {
        const int sn = (st + 1 < nstep) ? st + 1 : st;
#pragma unroll
        for (int ks = 0; ks < 4; ++ks) kn[ks] = *reinterpret_cast<const bf16x8*>(kbase + (size_t)sn * 16 * HD + ks * 32);
        f32x4 imp4 = {0.f, 0.f, 0.f, 0.f};
        const int n0 = st * 16 + fq * 4;
#pragma unroll
        for (int h = 0; h < HPG; ++h) {
            f32x4 acc = {0.f, 0.f, 0.f, 0.f};
#pragma unroll
            for (int ks = 0; ks < 4; ++ks) acc = __builtin_amdgcn_mfma_f32_16x16x32_bf16(kf[ks], qf[h][ks], acc, 0, 0, 0);
#pragma unroll
            for (int i = 0; i < 4; ++i) { const float e = __builtin_amdgcn_exp2f(fmaf(acc[i], SM_C, negBC)) * rl[h]; imp4[i] += (n0 + i <= lim) ? e : 0.f; }
        }
        op[st * 4] = imp4[0] + 2.0f * (imp4[1] + imp4[2] + imp4[3]);
        of[st * 4] = imp4[0];
#pragma unroll
        for (int ks = 0; ks < 4; ++ks) kf[ks] = kn[ks];
    }
}

__device__ __forceinline__ void topk_load(const float* IMPP, const float* IMPF, int t, int g, f32x4& pp, f32x4& ff) {
    const int lane = threadIdx.x & 63, cur = t >> 6, jb = lane * 4;
    pp = (f32x4){0.f, 0.f, 0.f, 0.f}; ff = pp;
    if (cur > 15 && jb <= cur) { const size_t base = ((size_t)t * 4 + g) * 256; pp = *(const f32x4*)(IMPP + base + jb); ff = *(const f32x4*)(IMPF + base + jb); }
}
__device__ __forceinline__ void topk_task(const f32x4 pp, const f32x4 ff, unsigned* BM, int t, int g) {
    const int lane = threadIdx.x & 63;
    const int cur = t >> 6;
    unsigned nib = 0u;
    if (cur <= 15) { const int jb = lane * 4;
#pragma unroll
        for (int c = 0; c < 4; ++c) if (jb + c <= cur) nib |= 1u << c; }
    else {
        const int jb = lane * 4;
        unsigned key[4];
        {
            float fnext = __shfl_down(ff[0], 1);
            if (lane == 63) fnext = 0.f;
            const float v0 = pp[0] + ff[1], v1 = pp[1] + ff[2], v2 = pp[2] + ff[3], v3 = pp[3] + fnext;
            key[0] = (jb + 0 >= 1 && jb + 0 <= cur - 2) ? __float_as_uint(fmaxf(v0, 0.f)) + 1u : 0u;
            key[1] = (jb + 1 >= 1 && jb + 1 <= cur - 2) ? __float_as_uint(fmaxf(v1, 0.f)) + 1u : 0u;
            key[2] = (jb + 2 >= 1 && jb + 2 <= cur - 2) ? __float_as_uint(fmaxf(v2, 0.f)) + 1u : 0u;
            key[3] = (jb + 3 >= 1 && jb + 3 <= cur - 2) ? __float_as_uint(fmaxf(v3, 0.f)) + 1u : 0u;
        }
        unsigned prefix = 0u; bool exact = false;
        for (int b = 30; b >= 0; --b) {
            const unsigned trial = prefix | (1u << b);
            const int cnt = __popcll(__ballot(key[0] >= trial)) + __popcll(__ballot(key[1] >= trial)) + __popcll(__ballot(key[2] >= trial)) + __popcll(__ballot(key[3] >= trial));
            if (cnt >= 13) { prefix = trial; if (cnt == 13) { exact = true; break; } }
        }
#pragma unroll
        for (int c = 0; c < 4; ++c) if (exact ? (key[c] >= prefix) : (key[c] > prefix)) nib |= 1u << c;
        if (!exact) {
            int need = 13 - (__popcll(__ballot(key[0] > prefix)) + __popcll(__ballot(key[1] > prefix)) + __popcll(__ballot(key[2] > prefix)) + __popcll(__ballot(key[3] > prefix)));
            unsigned tie = 0u;
#pragma unroll
            for (int c = 0; c < 4; ++c) if (key[c] == prefix) tie |= 1u << c;
            for (int guard = 0; need > 0 && guard < 16; ++guard) {
                const unsigned long long any = __ballot(tie != 0u);
                if (any == 0ull) break;
                const int L = __builtin_ctzll(any);
                if (lane == L) { const unsigned low = tie & (0u - tie); nib |= low; tie ^= low; }
                --need;
            }
        }
        if (lane == 0) nib |= 1u;
        if (lane == (cur >> 2)) nib |= 1u << (cur & 3);
        if (lane == ((cur - 1) >> 2)) nib |= 1u << ((cur - 1) & 3);
    }
    unsigned x = nib << (4 * (lane & 7));
    x |= __shfl_xor(x, 1); x |= __shfl_xor(x, 2); x |= __shfl_xor(x, 4);
    if ((lane & 7) == 0) BM[((size_t)t * 4 + g) * 8 + (lane >> 3)] = x;
}
#undef KSWZ
}

template <bool FFN_REMAP = false>
__device__ __forceinline__ void convT(const float* __restrict__ src0, int K, int N, bf16_t* __restrict__ dst, int ldd, LAS float* tile, int bid, int nb, int Nfull = 0, int n0 = 0) {
    const float* __restrict__ src = src0 + n0; if (Nfull == 0) Nfull = N;
    const int tid = threadIdx.x, tk = K >> 6, tn = (N + 63) >> 6, total = tk * tn;
    const int r = tid >> 4, c4 = (tid & 15) * 4;
    f32x4 v[2] = {{0.f, 0.f, 0.f, 0.f}, {0.f, 0.f, 0.f, 0.f}}, vn[2];
    if (bid < total) { const int nti = bid % tn, kti = bid / tn, ng = nti * 64 + c4;
#pragma unroll
        for (int h = 0; h < 2; ++h) if (ng < N) v[h] = *(const f32x4*)(src + (size_t)(kti * 64 + r + h * 32) * Nfull + ng); }
    for (int idx = bid; idx < total; idx += nb) {
        const int nti = idx % tn, kti = idx / tn;
#pragma unroll
        for (int h = 0; h < 2; ++h) { LAS float* tp = tile + (r + h * 32) * 65 + c4; tp[0] = v[h][0]; tp[1] = v[h][1]; tp[2] = v[h][2]; tp[3] = v[h][3]; }
        {
            const int nx = idx + nb; vn[0] = (f32x4){0.f, 0.f, 0.f, 0.f}; vn[1] = vn[0];
            if (nx < total) { const int nti2 = nx % tn, kti2 = nx / tn, ng2 = nti2 * 64 + c4;
#pragma unroll
                for (int h = 0; h < 2; ++h) if (ng2 < N) vn[h] = *(const f32x4*)(src + (size_t)(kti2 * 64 + r + h * 32) * Nfull + ng2); } }
        __syncthreads();
        const int n = tid >> 3, k8 = (tid & 7) * 8, ngl = nti * 64 + n;
        float e[8];
#pragma unroll
        for (int i = 0; i < 8; ++i) e[i] = tile[(k8 + i) * 65 + n];
        if (ngl < N) { u32x4 w; w.x = cvt_pk_bf16(e[0], e[1]); w.y = cvt_pk_bf16(e[2], e[3]); w.z = cvt_pk_bf16(e[4], e[5]); w.w = cvt_pk_bf16(e[6], e[7]);
            int drow = ngl; if (FFN_REMAP) { const int up = ngl >= DFF ? 1 : 0, f = ngl - up * DFF; drow = (f >> 7) * 256 + up * 128 + (f & 127); }
            *(u32x4*)(dst + (size_t)drow * ldd + kti * 64 + k8) = w; }
        __syncthreads();
        v[0] = vn[0]; v[1] = vn[1];
    }
}
__device__ __forceinline__ void convT8(const float* __restrict__ src0, int K, int N, unsigned char* __restrict__ dst, int ldd, float scale, LAS float* tile, int bid, int nb, int Nfull = 0, int n0 = 0) {
    const float* __restrict__ src = src0 + n0; if (Nfull == 0) Nfull = N;
    const int tid = threadIdx.x, tk = K >> 6, tn = (N + 63) >> 6, total = tk * tn;
    const int r = tid >> 4, c4 = (tid & 15) * 4;
    f32x4 v[2] = {{0.f, 0.f, 0.f, 0.f}, {0.f, 0.f, 0.f, 0.f}}, vn[2];
    if (bid < total) { const int nti = bid % tn, kti = bid / tn, ng = nti * 64 + c4;
#pragma unroll
        for (int h = 0; h < 2; ++h) if (ng < N) v[h] = *(const f32x4*)(src + (size_t)(kti * 64 + r + h * 32) * Nfull + ng); }
    for (int idx = bid; idx < total; idx += nb) {
        const int nti = idx % tn, kti = idx / tn;
#pragma unroll
        for (int h = 0; h < 2; ++h) { LAS float* tp = tile + (r + h * 32) * 65 + c4; tp[0] = v[h][0]; tp[1] = v[h][1]; tp[2] = v[h][2]; tp[3] = v[h][3]; }
        { const int nx = idx + nb; vn[0] = (f32x4){0.f, 0.f, 0.f, 0.f}; vn[1] = vn[0];
            if (nx < total) { const int nti2 = nx % tn, kti2 = nx / tn, ng2 = nti2 * 64 + c4;
#pragma unroll
                for (int h = 0; h < 2; ++h) if (ng2 < N) vn[h] = *(const f32x4*)(src + (size_t)(kti2 * 64 + r + h * 32) * Nfull + ng2); } }
        __syncthreads();
        const int n = tid >> 3, k8 = (tid & 7) * 8, ngl = nti * 64 + n;
        float e[8];
#pragma unroll
        for (int i = 0; i < 8; ++i) e[i] = tile[(k8 + i) * 65 + n] * scale;
        if (ngl < N) { int p0 = __builtin_amdgcn_cvt_pk_fp8_f32(e[0], e[1], 0, false); p0 = __builtin_amdgcn_cvt_pk_fp8_f32(e[2], e[3], p0, true);
            int p1 = __builtin_amdgcn_cvt_pk_fp8_f32(e[4], e[5], 0, false); p1 = __builtin_amdgcn_cvt_pk_fp8_f32(e[6], e[7], p1, true);
            *(u32x2*)(dst + (size_t)ngl * ldd + kti * 64 + k8) = (u32x2){(unsigned)p0, (unsigned)p1}; }
        __syncthreads();
        v[0] = vn[0]; v[1] = vn[1];
    }
}
__device__ __forceinline__ void rmsnorm_rows(const float* __restrict__ src, const float* __restrict__ w, bf16_t* __restrict__ dst, int rows, int gw, int nw, unsigned char* __restrict__ dst8 = nullptr) {
    const int lane = threadIdx.x & 63;
    f32x4 v[16], vn[16];
    if (gw < rows) { const f32x4* sp = (const f32x4*)(src + (size_t)gw * DM);
#pragma unroll
        for (int i = 0; i < 16; ++i) v[i] = sp[lane + 64 * i]; }
    for (int row = gw; row < rows; row += nw) {
        const int nr = row + nw < rows ? row + nw : row;
        { const f32x4* sp = (const f32x4*)(src + (size_t)nr * DM);
#pragma unroll
          for (int i = 0; i < 16; ++i) vn[i] = sp[lane + 64 * i]; }
        float ss = 0.f;
#pragma unroll
        for (int i = 0; i < 16; ++i) ss += v[i][0] * v[i][0] + v[i][1] * v[i][1] + v[i][2] * v[i][2] + v[i][3] * v[i][3];
        ss = wave_sum(ss);
        const float rstd = rsqrtf(ss * (1.0f / DM) + EPS);
#pragma unroll
        for (int i = 0; i < 16; ++i) { const f32x4 ww = ((const f32x4*)w)[lane + 64 * i];
            u32x2 o; o.x = cvt_pk_bf16(v[i][0] * rstd * ww[0], v[i][1] * rstd * ww[1]); o.y = cvt_pk_bf16(v[i][2] * rstd * ww[2], v[i][3] * rstd * ww[3]);
            *(u32x2*)(dst + (size_t)row * DM + (lane + 64 * i) * 4) = o;
            if (dst8) { int pk = __builtin_amdgcn_cvt_pk_fp8_f32(v[i][0] * rstd * ww[0], v[i][1] * rstd * ww[1], 0, false); pk = __builtin_amdgcn_cvt_pk_fp8_f32(v[i][2] * rstd * ww[2], v[i][3] * rstd * ww[3], pk, true);
                *(int*)(dst8 + (size_t)row * DM + (lane + 64 * i) * 4) = pk; } }
#pragma unroll
        for (int i = 0; i < 16; ++i) v[i] = vn[i];
    }
}

struct Ptrs {
    bf16_t *Win, *Wo, *Wfi, *Wfo, *Wg, *Wple, *Wpool, *Wc1k, *Wc1v, *XN, *PB, *Z, *M, *KC, *VC, *MIX, *ACT, *ERAW;
    float *COS, *SIN, *TAB, *G, *H1, *L, *OACC, *IMPP, *IMPF, *ERSTD; unsigned* BM;
};

__device__ __forceinline__ void phase_prologue(const Params& P, const Ptrs& W, LAS unsigned char* lds) {
    const int bid = blockIdx.x, nb = gridDim.x, tid = threadIdx.x, lane = tid & 63, wv = tid >> 6;
    const int gw = bid * NWAVES + wv, nw = nb * NWAVES; const size_t gt = (size_t)bid * NTHREADS + tid, ntot = (size_t)nb * NTHREADS;
    LAS float* tile = (LAS float*)lds;
    rmsnorm_rows(P.x, P.norm1_w, W.XN, S_, gw, nw, P.ws + WS_XN8);
    convT(P.w_in, DM, POOLW, W.Win, DM, tile, bid, nb, INW, 0);
    convT(P.w_in, DM, INW - OFF_G, W.Win + (size_t)OFF_G * DM, DM, tile, bid, nb, INW, OFF_G);
    convT8(P.w_in, DM, OFF_G - POOLW, P.ws + WS_WIN8, DM, WG8_SCALE, tile, bid, nb, INW, POOLW);
    for (size_t i = gt; i < (size_t)(LDZ - INW) * DM / 8; i += ntot) *(u32x4*)(W.Win + (size_t)INW * DM + i * 8) = (u32x4){0u, 0u, 0u, 0u};
    convT(P.w_o, DM, DM, W.Wo, DM, tile, bid, nb);
    convT<true>(P.w_ffn_in, DM, NFI, W.Wfi, DM, tile, bid, nb);
    for (size_t i = gt; i < (size_t)2 * DM / 8; i += ntot) *(u32x4*)(W.XN - 2 * DM + i * 8) = (u32x4){0u, 0u, 0u, 0u};
    convT(P.w_ffn_out, DFF, DM, W.Wfo, DFF, tile, bid, nb);
    convT8(P.w_ple_gate, DM, DM, (unsigned char*)W.Wg, DM, WG8_SCALE, tile, bid, nb);
    convT(P.w_ple_proj, PLE, DM, W.Wple, PLE, tile, bid, nb);
    for (int g = 0; g < 4; ++g) convT(P.w_pool + (size_t)g * 65536, 256, 256, W.Wpool + (size_t)g * 65536, 256, tile, bid, nb);
    convT(P.cmp_k_w1, 4096, 256, W.Wc1k, 4096, tile, bid, nb);
    convT(P.cmp_v_w1, 4096, 256, W.Wc1v, 4096, tile, bid, nb);
    for (size_t i = gt; i < (size_t)S_ * PLE / 8; i += ntot) { const f32x4 a = *(const f32x4*)(P.p + i * 8), b = *(const f32x4*)(P.p + i * 8 + 4);
        u32x4 w; w.x = cvt_pk_bf16(a[0], a[1]); w.y = cvt_pk_bf16(a[2], a[3]); w.z = cvt_pk_bf16(b[0], b[1]); w.w = cvt_pk_bf16(b[2], b[3]); *(u32x4*)(W.PB + i * 8) = w; }
    for (size_t i = gt; i < (size_t)S_ * 16; i += ntot) { const int t = (int)(i >> 4), fi = (int)(i & 15);
        const float inv = exp2f(-(float)fi * (18.931568569324174f / 16.0f)); const float ang = (float)P.positions[t] * inv;
        const double ad = (double)ang; const double kk = rint(ad * 0.15915494309189535); const float rf = (float)(ad - kk * 6.283185307179586);
        W.COS[i] = __cosf(rf); W.SIN[i] = __sinf(rf); }
    for (int o = gw; o < 512; o += nw) { const int which = o >> 8, j = o & 255; const float* pe = which ? P.cmp_pos_v : P.cmp_pos_k; const float* w1 = which ? P.cmp_v_w1 : P.cmp_k_w1;
        float s = 0.f; for (int r = lane; r < 4096; r += 64) s += pe[r] * w1[(size_t)r * 256 + j];
        s = wave_sum(s); if (lane == 0) W.TAB[o] = s; }
    if (gw == 0) { float mq = fmaxf(fabsf(P.q_norm_w[lane]), fabsf(P.q_norm_w[lane + 64])); mq = wave_max(mq);
        float mc = wave_max(fmaxf(fabsf(P.k_norm_cmp_w[lane]), fabsf(P.k_norm_cmp_w[lane + 64])));
        float ms = wave_max(fmaxf(fabsf(P.k_norm_slc_w[lane]), fabsf(P.k_norm_slc_w[lane + 64])));
        float mw = wave_max(fmaxf(fabsf(P.k_norm_win_w[lane]), fabsf(P.k_norm_win_w[lane + 64])));
        const float c = 11.313708498984761f * 1.4426950408889634f * mq * 1.01f;
        if (lane == 0) { W.TAB[512] = c * mc; W.TAB[513] = c * ms; W.TAB[514] = c * mw; } }
}

__device__ __forceinline__ void phase_postz(const Params& P, const Ptrs& W, int gw, int nw) {
    const int tid = threadIdx.x, lane = tid & 63;
    const f32x2 wq = *(const f32x2*)(P.q_norm_w + 2 * lane), wks = *(const f32x2*)(P.k_norm_slc_w + 2 * lane), wkw = *(const f32x2*)(P.k_norm_win_w + 2 * lane);
    for (int t = gw; t < S_; t += nw) {
        bf16_t* zr = W.Z + (size_t)t * LDZ;
        float cs0 = 0.f, cs1 = 0.f, sn0 = 0.f, sn1 = 0.f;
        if (lane < 16) { const int i0 = (2 * lane) & 15; cs0 = W.COS[t * 16 + i0]; cs1 = W.COS[t * 16 + i0 + 1]; sn0 = W.SIN[t * 16 + i0]; sn1 = W.SIN[t * 16 + i0 + 1]; }
        unsigned uv[32];
#pragma unroll
        for (int v = 0; v < 32; ++v) { const int col = v < 24 ? OFF_Q + v * HD : (v < 28 ? OFF_KV + 2 * 512 + (v - 24) * HD : OFF_KV + 4 * 512 + (v - 28) * HD);
            uv[v] = *((const unsigned*)(zr + col) + lane); }
#pragma unroll
        for (int v = 0; v < 32; ++v) {
            const f32x2 ww = v < 24 ? wq : (v < 28 ? wks : wkw);
            const unsigned u = uv[v]; const float x0 = bf_lo(u), x1 = bf_hi(u);
            const float ss = wave_sum(x0 * x0 + x1 * x1);
            const float rstd = rsqrtf(ss * (1.0f / HD) + EPS);
            float y0 = x0 * rstd * ww[0], y1 = x1 * rstd * ww[1];
            const float p0 = __shfl_xor(y0, 8), p1 = __shfl_xor(y1, 8);
            if (lane < 8) { y0 = y0 * cs0 - p0 * sn0; y1 = y1 * cs1 - p1 * sn1; }
            else if (lane < 16) { y0 = y0 * cs0 + p0 * sn0; y1 = y1 * cs1 + p1 * sn1; }
            uv[v] = cvt_pk_bf16(y0, y1);
        }
        {
            const int gi = lane >> 4, wlen = 2 << gi, c0 = lane * 16; const int cnt = (t + 1) < wlen ? (t + 1) : wlen;
            float s[16];
#pragma unroll
            for (int i = 0; i < 16; ++i) s[i] = 0.f;
            float cur[16];
            for (int i = 0; i < cnt; ++i) { const u32x4 a = *(const u32x4*)(W.Z + (size_t)(t - i) * LDZ + c0), b = *(const u32x4*)(W.Z + (size_t)(t - i) * LDZ + c0 + 8);
                const float e[16] = {bf_lo(a.x), bf_hi(a.x), bf_lo(a.y), bf_hi(a.y), bf_lo(a.z), bf_hi(a.z), bf_lo(a.w), bf_hi(a.w), bf_lo(b.x), bf_hi(b.x), bf_lo(b.y), bf_hi(b.y), bf_lo(b.z), bf_hi(b.z), bf_lo(b.w), bf_hi(b.w)};
#pragma unroll
                for (int q = 0; q < 16; ++q) { s[q] += e[q]; if (i == 0) cur[q] = e[q]; } }
            const float rc = 1.0f / (float)cnt;
            u32x4 o0, o1;
            o0.x = cvt_pk_bf16(s[0] * rc - cur[0], s[1] * rc - cur[1]); o0.y = cvt_pk_bf16(s[2] * rc - cur[2], s[3] * rc - cur[3]);
            o0.z = cvt_pk_bf16(s[4] * rc - cur[4], s[5] * rc - cur[5]); o0.w = cvt_pk_bf16(s[6] * rc - cur[6], s[7] * rc - cur[7]);
            o1.x = cvt_pk_bf16(s[8] * rc - cur[8], s[9] * rc - cur[9]); o1.y = cvt_pk_bf16(s[10] * rc - cur[10], s[11] * rc - cur[11]);
            o1.z = cvt_pk_bf16(s[12] * rc - cur[12], s[13] * rc - cur[13]); o1.w = cvt_pk_bf16(s[14] * rc - cur[14], s[15] * rc - cur[15]);
            *(u32x4*)(W.M + (size_t)t * POOLW + c0) = o0; *(u32x4*)(W.M + (size_t)t * POOLW + c0 + 8) = o1;
        }
#pragma unroll
        for (int v = 0; v < 32; ++v) { const int col = v < 24 ? OFF_Q + v * HD : (v < 28 ? OFF_KV + 2 * 512 + (v - 24) * HD : OFF_KV + 4 * 512 + (v - 28) * HD);
            *((unsigned*)(zr + col) + lane) = uv[v]; }

    }
}

__device__ __forceinline__ void phase_cmpfin(const Params& P, const Ptrs& W) {
    const int tid = threadIdx.x, lane = tid & 63, gw = blockIdx.x * NWAVES + (tid >> 6), nw = gridDim.x * NWAVES;
    const f32x2 wk = *(const f32x2*)(P.k_norm_cmp_w + 2 * lane);
    for (int task = gw; task < 8192; task += nw) {
        const int tk = __builtin_amdgcn_readfirstlane(task);
        const int which = tk >> 12, g = (tk >> 10) & 3, n = tk & 1023;
        bf16_t* dst = (which ? W.VC : W.KC) + ((size_t)g * 1024 + n) * HD;
        if (n == 1023) { ((unsigned*)dst)[lane] = 0u; continue; }
        const float* h = W.H1 + (size_t)tk * 256; const float* w2 = which ? P.cmp_v_w2 : P.cmp_k_w2;
        float a0 = 0.f, a1 = 0.f;
        for (int j = 0; j < 256; ++j) { const float hj = h[j]; const f32x2 wv = *(const f32x2*)(w2 + j * HD + 2 * lane); a0 += hj * wv[0]; a1 += hj * wv[1]; }
        if (which == 0) {
            const float ss = wave_sum(a0 * a0 + a1 * a1); const float rstd = rsqrtf(ss * (1.0f / HD) + EPS);
            a0 = a0 * rstd * wk[0]; a1 = a1 * rstd * wk[1];
            const int tp = 16 * n + 31; const float p0 = __shfl_xor(a0, 8), p1 = __shfl_xor(a1, 8);
            if (lane < 16) { const int i0 = (2 * lane) & 15; const float cs0 = W.COS[tp * 16 + i0], cs1 = W.COS[tp * 16 + i0 + 1], sn0 = W.SIN[tp * 16 + i0], sn1 = W.SIN[tp * 16 + i0 + 1];
                if (lane < 8) { a0 = a0 * cs0 - p0 * sn0; a1 = a1 * cs1 - p1 * sn1; } else { a0 = a0 * cs0 + p0 * sn0; a1 = a1 * cs1 + p1 * sn1; } }
        }
        ((unsigned*)dst)[lane] = cvt_pk_bf16(a0, a1);
    }
}

__device__ __forceinline__ void phase_erstd(const Ptrs& W) {
    const int tid = threadIdx.x, lane = tid & 63, gw = blockIdx.x * NWAVES + (tid >> 6), nw = gridDim.x * NWAVES;
    u32x4 a[8], an[8];
    if (gw < S_) { const u32x4* sp = (const u32x4*)(W.ERAW + (size_t)gw * DM);
#pragma unroll
        for (int i = 0; i < 8; ++i) a[i] = sp[lane + 64 * i]; }
    for (int row = gw; row < S_; row += nw) {
        const int nr = row + nw < S_ ? row + nw : row;
        { const u32x4* sp = (const u32x4*)(W.ERAW + (size_t)nr * DM);
#pragma unroll
          for (int i = 0; i < 8; ++i) an[i] = sp[lane + 64 * i]; }
        float ss = 0.f;
#pragma unroll
        for (int i = 0; i < 8; ++i) {
            const float e0 = bf_lo(a[i].x), e1 = bf_hi(a[i].x), e2 = bf_lo(a[i].y), e3 = bf_hi(a[i].y), e4 = bf_lo(a[i].z), e5 = bf_hi(a[i].z), e6 = bf_lo(a[i].w), e7 = bf_hi(a[i].w);
            ss += e0 * e0 + e1 * e1 + e2 * e2 + e3 * e3 + e4 * e4 + e5 * e5 + e6 * e6 + e7 * e7; }
        ss = wave_sum(ss);
        if (lane == 0) W.ERSTD[row] = rsqrtf(ss * (1.0f / DM) + EPS);
#pragma unroll
        for (int i = 0; i < 8; ++i) a[i] = an[i];
    }
}

constexpr int N_PHASES = 11;
__device__ __forceinline__ Params kargs() {
#if defined(__HIP_DEVICE_COMPILE__)
    unsigned long long p = (unsigned long long)__builtin_amdgcn_kernarg_segment_ptr();
    asm volatile("" : "+s"(p));
    return *(const __attribute__((address_space(4))) Params*)p;
#else
    return Params{};
#endif
}
__device__ __forceinline__ Ptrs mkptrs(unsigned char* ws) {
    Ptrs W;
    W.Win = (bf16_t*)(ws + WS_WIN); W.Wo = (bf16_t*)(ws + WS_WO); W.Wfi = (bf16_t*)(ws + WS_WFI); W.Wfo = (bf16_t*)(ws + WS_WFO); W.Wg = (bf16_t*)(ws + WS_WG);
    W.Wple = (bf16_t*)(ws + WS_WPLE); W.Wpool = (bf16_t*)(ws + WS_WPOOL); W.Wc1k = (bf16_t*)(ws + WS_WC1K); W.Wc1v = (bf16_t*)(ws + WS_WC1V);
    W.XN = (bf16_t*)(ws + WS_XN); W.PB = (bf16_t*)(ws + WS_PB); W.Z = (bf16_t*)(ws + WS_Z); W.M = (bf16_t*)(ws + WS_M); W.KC = (bf16_t*)(ws + WS_KC); W.VC = (bf16_t*)(ws + WS_VC);
    W.MIX = (bf16_t*)(ws + WS_MIX); W.ACT = (bf16_t*)(ws + WS_ACT); W.ERAW = (bf16_t*)(ws + WS_ERAW);
    W.COS = (float*)(ws + WS_COS); W.SIN = (float*)(ws + WS_SIN); W.TAB = (float*)(ws + WS_TAB); W.G = (float*)(ws + WS_G); W.H1 = (float*)(ws + WS_H1); W.L = (float*)(ws + WS_L);
    W.OACC = (float*)(ws + WS_OACC); W.IMPP = (float*)(ws + WS_IMPP); W.IMPF = (float*)(ws + WS_IMPF); W.ERSTD = (float*)(ws + WS_ERSTD); W.BM = (unsigned*)(ws + WS_BM);
    return W;
}
__global__ void __launch_bounds__(NTHREADS, 2) fwd(Params Punused) {
    extern __shared__ __attribute__((aligned(16))) unsigned char lds_raw[];
    LAS unsigned char* lds = (LAS unsigned char*)lds_raw;
    const int tid = threadIdx.x;
    const int G = gridDim.x, bid = blockIdx.x;
    const int gw = bid * NWAVES + (tid >> 6), nw = G * NWAVES;

    if (tid < 16) ((LAS unsigned*)(lds + LDS_MISC))[tid] = 0u;
    __syncthreads();
    int lo, hi; XcdBarrier bar;
    { const Params P = kargs(); lo = P.ph_lo; hi = P.ph_hi;
      bar.bar = (unsigned*)(P.ws + WS_CTL); bar.x = 0; bar.st = (volatile LAS unsigned*)(lds + LDS_MISC);
      if (hi - lo > 1) bar = xcd_barrier_post((unsigned*)(P.ws + WS_CTL), (volatile LAS unsigned*)(lds + LDS_MISC)); }
#ifdef PH_MASK
#define IN(k) (((PH_MASK >> (k)) & 1) && lo <= (k) && (k) < hi)
#else
#define IN(k) (lo <= (k) && (k) < hi)
#endif
#define SEAM(k) do { if (IN(k) && IN((k) + 1)) xcd_barrier(bar); } while (0)
#define PHASE_VARS const Params P = kargs(); const Ptrs W = mkptrs(P.ws); (void)W;
#define ATT_ARGS att::AttnArgs AA{W.Z, W.KC, W.VC, W.G, W.L, W.OACC, W.MIX, W.BM, W.TAB};

    if (IN(0)) { PHASE_VARS REP(0) { phase_prologue(P, W, lds); } SEAM(0); }
    if (IN(1)) {
        PHASE_VARS
        { pg8::GStd g{(const char*)W.XN, (const char*)W.Win, DM, DM, DM / 64}; pg8::StaticOrder S; S.init(S_ / 256, POOLW / 256, G, bid);
          pg8::EpiBf16 E{W.Z, LDZ}; pg8::gemm_phase(lds, g, S, E); }
        { pg8::GStd g{(const char*)(P.ws + WS_XN8), (const char*)(P.ws + WS_WIN8), DM / 2, DM / 2, DM / 128}; pg8::StaticOrder S; S.init(S_ / 256, (OFF_G - POOLW) / 256, G, bid);
          pg8::EpiBf16S E{W.Z + POOLW, LDZ, 1.0f / WG8_SCALE}; pg8::gemm_phase<pg8::GStd, pg8::EpiBf16S, true>(lds, g, S, E); }
        SEAM(1);
    }
    if (IN(2)) {
        PHASE_VARS
        if (G > 64) {
            if (bid < 32) { pg8::GCmp g{(const char*)W.Z, (const char*)W.Wc1k, (const char*)W.Wc1v, 16 * LDZ, 4096, 64}; pg8::StaticOrder S; S.init(32, 1, 32, bid);
                pg8::EpiCmpGelu E{W.H1, W.TAB}; pg8::gemm_phase(lds, g, S, E); }
            else if (bid < 96) {
                pg8::GStd g{(const char*)W.XN, (const char*)(W.Win + (size_t)OFF_G * DM), DM, DM, DM / 64}; pg8::StaticOrder S; S.init(S_ / 256, 1, 64, bid - 32);
                pg8::EpiBf16 E{W.Z + OFF_G, LDZ}; pg8::gemm_phase(lds, g, S, E); }
            else phase_postz(P, W, (bid - 96) * NWAVES + (tid >> 6), (G - 96) * NWAVES);
        } else {
            { pg8::GStd g{(const char*)W.XN, (const char*)(W.Win + (size_t)OFF_G * DM), DM, DM, DM / 64}; pg8::StaticOrder S; S.init(S_ / 256, 1, G, bid);
              pg8::EpiBf16 E{W.Z + OFF_G, LDZ}; pg8::gemm_phase(lds, g, S, E); }
            { pg8::GCmp g{(const char*)W.Z, (const char*)W.Wc1k, (const char*)W.Wc1v, 16 * LDZ, 4096, 64}; pg8::StaticOrder S; S.init(32, 1, G, bid);
              pg8::EpiCmpGelu E{W.H1, W.TAB}; pg8::gemm_phase(lds, g, S, E); }
            phase_postz(P, W, gw, nw);
        }
        SEAM(2);
    }
    if (IN(3)) {
        PHASE_VARS
        for (size_t i = (size_t)bid * NTHREADS + tid; i < (size_t)S_ * NGATE; i += (size_t)G * NTHREADS) { const int t = (int)(i / NGATE), c = (int)(i % NGATE); W.G[i] = sigmoidf_(bf2f(W.Z[(size_t)t * LDZ + OFF_G + c])); }
        phase_cmpfin(P, W);
        { pg8::GPool g{(const char*)W.M, (const char*)W.Wpool, POOLW, 256, 4}; pg8::StaticOrder S; S.init(S_ / 256, 4, G, bid);
          pg8::EpiBf16Scale E{W.MIX, DM, P.pool_scale}; pg8::gemm_phase(lds, g, S, E); }
        SEAM(3);
    }
    if (IN(4)) {
        PHASE_VARS ATT_ARGS
        REP(4)
        for (int base = 0, rnd = 0; base < 1536; base += G, ++rnd) {
            int qt, g, hp;
            if (G == 256) { const int x = bid & 7, r = bid >> 3, qp = (rnd / 3) ? 63 - r : r; if (rnd >= 6) break; g = x & 3; qt = 2 * qp + (x >> 2); hp = rnd % 3; }
            else { const int Lu = base + ((rnd & 1) ? G - 1 - bid : bid); if (Lu >= 1536) continue; qt = Lu / 12; const int rem = Lu % 12; g = rem / 3; hp = rem % 3; }
            att::attn_unit<att::MODE_CMP>(AA, (LAS char*)lds, qt, g, hp);
            asm volatile("s_waitcnt vmcnt(0)" ::: "memory");
            att::attn_unit<att::MODE_WIN>(AA, (LAS char*)lds, qt, g, hp); }
        SEAM(4);
    }
    if (IN(5)) {
        PHASE_VARS ATT_ARGS
        for (int k = gw, r = 0; k < 4096; k += nw, ++r) { const int hiT = (r + 1) * nw < 4096 ? (r + 1) * nw : 4096;
            const int task = (r & 1) ? hiT - 1 - (k - r * nw) : k;
            att::imp_task(AA, W.IMPP, W.IMPF, task >> 2, task & 3);
            asm volatile("s_waitcnt vmcnt(0)" ::: "memory");
            { const int tb = (task >> 2) * 16, gg = task & 3; f32x4 pp, ff, pn, fn;
              att::topk_load(W.IMPP, W.IMPF, tb, gg, pp, ff);
              for (int q = 0; q < 16; ++q) { att::topk_load(W.IMPP, W.IMPF, tb + (q < 15 ? q + 1 : q), gg, pn, fn); att::topk_task(pp, ff, W.BM, tb + q, gg); pp = pn; ff = fn; } } }
        SEAM(5);
    }
    if (IN(6)) {
        PHASE_VARS ATT_ARGS
        REP(6)
        for (int base = 0, rnd = 0; base < 1640 + G; base += G, ++rnd) {
            int ut, g;
            if (G == 256) { const int x = bid & 7, r = bid >> 3, k = rnd * 32 + ((rnd & 1) ? 31 - r : r); if (k >= 205) break; g = x & 3; ut = 409 - (2 * k + (x >> 2)); }
            else { const int Lu = base + ((rnd & 1) ? G - 1 - bid : bid); if (Lu >= 1640) continue; ut = 409 - Lu / 4; g = Lu % 4; }
            att::attn_unit<att::MODE_SLC>(AA, (LAS char*)lds, ut, g, 0); }
        SEAM(6);
    }
    if (IN(7)) {
        PHASE_VARS
        { pg8::GStd g{(const char*)W.MIX, (const char*)W.Wo, DM, DM, DM / 64}; pg8::StaticOrder S; S.init(S_ / 256, DM / 256, G, bid);
          pg8::EpiResNorm E{P.x, P.out, W.XN, P.norm2_w, (float*)(P.ws + WS_SSQ1), DM}; pg8::gemm_phase(lds, g, S, E); }
        { pg8::GStd g{(const char*)W.PB, (const char*)W.Wple, PLE, PLE, PLE / 64}; pg8::StaticOrder S; S.init(S_ / 256, DM / 256, G, bid);
          pg8::EpiBf16Ssq E{W.ERAW, DM, (float*)(P.ws + WS_SSQ3)}; pg8::gemm_phase(lds, g, S, E); }
        SEAM(7);
    }
    if (IN(8)) {
        PHASE_VARS
        pg8::GFfn g{(const char*)W.XN, (const char*)W.Wfi, DM, DM, DM / 64}; pg8::StaticOrder S; S.init(65, DFF / 128, G, bid);
        pg8::EpiFfn E{W.ACT, P.conv_w, P.conv_b, (LAS float*)(lds + LDS_XCH), (const float*)(P.ws + WS_SSQ1)}; REP(8) { pg8::gemm_phase(lds, g, S, E); } SEAM(8);
    }
    if (IN(9)) {
        PHASE_VARS
        pg8::GStd g{(const char*)W.ACT, (const char*)W.Wfo, DFF, DFF, DFF / 64}; pg8::StaticOrder S; S.init(S_ / 256, DM / 256, G, bid);
        pg8::EpiResNormF8 E{P.out, P.out, W.XN, P.ple_gate_norm_w, (float*)(P.ws + WS_SSQ2), DM}; pg8::gemm_phase(lds, g, S, E); SEAM(9);
    }
    if (IN(10)) {
        PHASE_VARS
        pg8::GStd g{(const char*)W.XN, (const char*)W.Wg, DM / 2, DM / 2, DM / 128}; pg8::StaticOrder S; S.init(S_ / 256, DM / 256, G, bid);
        pg8::EpiGate E{P.out, W.ERAW, (const float*)(P.ws + WS_SSQ3), P.ple_norm_w, (const float*)(P.ws + WS_SSQ2), DM, 1.0f / WG8_SCALE};
        pg8::gemm_phase<pg8::GStd, pg8::EpiGate, true>(lds, g, S, E);
    }
#undef IN
#undef SEAM
}

extern "C" void kernel_launch(void* const* d_in, const int* in_sizes, int n_in, void* d_out, int out_size, void* d_ws, size_t ws_size, hipStream_t stream) {
    static int grid = 0;
    if (grid == 0) {
        if (n_in != 27 || in_sizes[0] != S_ * DM || out_size != S_ * DM || ws_size < WS_NEED) {
            fprintf(stderr, "kernel_launch: unexpected shapes (n_in %d, in0 %d, out %d, ws %zu < %zu); nothing launched\n", n_in, n_in > 0 ? in_sizes[0] : -1, out_size, ws_size, (size_t)WS_NEED); grid = -1; return; }
        int dev = 0, cus = 0, per_cu = 0;
        if (hipGetDevice(&dev) != hipSuccess || hipDeviceGetAttribute(&cus, hipDeviceAttributeMultiprocessorCount, dev) != hipSuccess) { grid = -1; return; }
        if (hipFuncSetAttribute((const void*)fwd, hipFuncAttributeMaxDynamicSharedMemorySize, LDS_BYTES) != hipSuccess) { fprintf(stderr, "kernel_launch: hipFuncSetAttribute failed\n"); grid = -1; return; }
        if (hipOccupancyMaxActiveBlocksPerMultiprocessor(&per_cu, (const void*)fwd, NTHREADS, LDS_BYTES) != hipSuccess || per_cu < 1) { fprintf(stderr, "kernel_launch: occupancy query says %d\n", per_cu); (void)hipGetLastError(); }
        grid = cus > 256 ? 256 : cus;
    }
    if (grid < 0) return;
    (void)hipMemsetAsync((char*)d_ws + WS_CTL, 0, CTL_BYTES, stream);
    Params P{};
    const float** fp = (const float**)&P;
    P.x = (const float*)d_in[0]; P.p = (const float*)d_in[1]; P.positions = (const int*)d_in[2]; P.norm1_w = (const float*)d_in[3]; P.w_in = (const float*)d_in[4];
    P.w_pool = (const float*)d_in[5]; P.pool_scale = (const float*)d_in[6]; P.q_norm_w = (const float*)d_in[7]; P.k_norm_cmp_w = (const float*)d_in[8];
    P.k_norm_slc_w = (const float*)d_in[9]; P.k_norm_win_w = (const float*)d_in[10]; P.cmp_pos_k = (const float*)d_in[11]; P.cmp_pos_v = (const float*)d_in[12];
    P.cmp_k_w1 = (const float*)d_in[13]; P.cmp_k_w2 = (const float*)d_in[14]; P.cmp_v_w1 = (const float*)d_in[15]; P.cmp_v_w2 = (const float*)d_in[16];
    P.w_o = (const float*)d_in[17]; P.norm2_w = (const float*)d_in[18]; P.w_ffn_in = (const float*)d_in[19]; P.conv_w = (const float*)d_in[20]; P.conv_b = (const float*)d_in[21];
    P.w_ffn_out = (const float*)d_in[22]; P.w_ple_proj = (const float*)d_in[23]; P.ple_norm_w = (const float*)d_in[24]; P.ple_gate_norm_w = (const float*)d_in[25]; P.w_ple_gate = (const float*)d_in[26];
    (void)fp;
    P.out = (float*)d_out; P.ws = (unsigned char*)d_ws;
#if MK_ONE_LAUNCH
    P.ph_lo = 0; P.ph_hi = N_PHASES;
    hipLaunchKernelGGL(fwd, dim3(grid), dim3(NTHREADS), LDS_BYTES, stream, P);
#else
    for (int ph = 0; ph < N_PHASES; ++ph) { P.ph_lo = ph; P.ph_hi = ph + 1; hipLaunchKernelGGL(fwd, dim3(grid), dim3(NTHREADS), LDS_BYTES, stream, P); }
#endif
    const hipError_t le = hipPeekAtLastError();
    if (le != hipSuccess) fprintf(stderr, "kernel_launch: launch failed: %s\n", hipGetErrorName(le));
}
```

```cpp
#include <hip/hip_runtime.h>
#include <cstdio>
#include <cstdint>

#ifndef PROBE_DBL
#define PROBE_DBL 0
#endif
#define REP(k) _Pragma("unroll") for (int rep_ = 0; rep_ < 1 + ((PROBE_DBL >> (k)) & 1); ++rep_)
#ifndef MK_ONE_LAUNCH
#define MK_ONE_LAUNCH 1
#endif

#define LAS __attribute__((address_space(3)))
typedef unsigned short bf16_t;
typedef short bf16x8 __attribute__((ext_vector_type(8)));
typedef short s16x4 __attribute__((ext_vector_type(4)));
typedef float f32x2 __attribute__((ext_vector_type(2)));
typedef float f32x4 __attribute__((ext_vector_type(4)));
typedef float f32x16 __attribute__((ext_vector_type(16)));
typedef unsigned u32x2 __attribute__((ext_vector_type(2)));
typedef unsigned u32x4 __attribute__((ext_vector_type(4)));
typedef int i32x4 __attribute__((ext_vector_type(4)));
typedef int i32x8 __attribute__((ext_vector_type(8)));

constexpr int S_ = 16384, DM = 4096, INW = 7240, LDZ = 7424, POOLW = 1024, NH = 24, NKV = 4, HPG = 6, HD = 128;
constexpr int OFF_Q = 1024, OFF_KV = 4096, OFF_G = 7168, DFF = 11008, NFI = 22016, PLE = 256, NGATE = 72;
constexpr int ZROWS = S_ + 64, XNROWS = S_ + 256, CHUNK = 8192;
constexpr float EPS = 1e-6f;
constexpr float SM_C = 0.08838834764831845f * 1.4426950408889634f;
constexpr int NWAVES = 8, NTHREADS = 512;
constexpr float WG8_SCALE = 128.0f;

constexpr size_t al256(size_t x) { return (x + 255) / 256 * 256; }
constexpr size_t WS_CTL   = 0;
constexpr size_t CTL_BYTES = 262144;
constexpr size_t WS_SSQ1 = WS_CTL + 65536, WS_SSQ2 = WS_CTL + 131072, WS_SSQ3 = WS_CTL + 196608;
constexpr size_t WS_WIN   = WS_CTL + CTL_BYTES;
constexpr size_t WS_WO    = WS_WIN + al256((size_t)LDZ * DM * 2);
constexpr size_t WS_WFI   = WS_WO + al256((size_t)DM * DM * 2);
constexpr size_t WS_WFO   = WS_WFI + al256((size_t)NFI * DM * 2);
constexpr size_t WS_WG    = WS_WFO + al256((size_t)DM * DFF * 2);
constexpr size_t WS_WPLE  = WS_WG + al256((size_t)DM * DM * 2);
constexpr size_t WS_WPOOL = WS_WPLE + al256((size_t)DM * PLE * 2);
constexpr size_t WS_WC1K  = WS_WPOOL + al256((size_t)1024 * 256 * 2);
constexpr size_t WS_WC1V  = WS_WC1K + al256((size_t)256 * 4096 * 2);
constexpr size_t WS_COS   = WS_WC1V + al256((size_t)256 * 4096 * 2);
constexpr size_t WS_SIN   = WS_COS + al256((size_t)S_ * 16 * 4);
constexpr size_t WS_TAB   = WS_SIN + al256((size_t)S_ * 16 * 4);
constexpr size_t WS_XNP   = WS_TAB + 4096;
constexpr size_t WS_XN    = WS_XNP + (size_t)2 * DM * 2;
constexpr size_t WS_PB    = WS_XN + al256((size_t)XNROWS * DM * 2);
constexpr size_t WS_XN8   = WS_PB + al256((size_t)S_ * PLE * 2);
constexpr size_t WS_WIN8  = WS_XN8 + al256((size_t)S_ * DM);
constexpr size_t WS_R     = WS_WIN8 + al256((size_t)(OFF_G - POOLW) * DM);
constexpr size_t WS_Z     = WS_R;
constexpr size_t WS_M     = WS_Z + al256((size_t)ZROWS * LDZ * 2);
constexpr size_t WS_G     = WS_M + al256((size_t)S_ * POOLW * 2);
constexpr size_t WS_H1    = WS_G + al256((size_t)S_ * NGATE * 4);
constexpr size_t WS_KC    = WS_H1 + al256((size_t)8192 * 256 * 4);
constexpr size_t WS_VC    = WS_KC + al256((size_t)4 * 1024 * 128 * 2);
constexpr size_t WS_L     = WS_VC + al256((size_t)4 * 1024 * 128 * 2);
constexpr size_t WS_OACC  = WS_L + al256((size_t)S_ * NH * 4);
constexpr size_t WS_IMPP  = WS_OACC + al256((size_t)S_ * 3072 * 4);
constexpr size_t WS_IMPF  = WS_IMPP + al256((size_t)S_ * 4 * 256 * 4);
constexpr size_t WS_BM    = WS_IMPF + al256((size_t)S_ * 4 * 256 * 4);
constexpr size_t WS_MIX   = WS_BM + al256((size_t)S_ * 4 * 8 * 4);
constexpr size_t WS_END_A = WS_MIX + al256((size_t)S_ * DM * 2);
constexpr size_t WS_ERAW  = WS_R;
constexpr size_t WS_ACT   = WS_ERAW + al256((size_t)S_ * DM * 2);
constexpr size_t WS_ERSTD = WS_ACT + al256((size_t)S_ * DFF * 2);
constexpr size_t WS_END_B = WS_ERSTD + al256((size_t)S_ * 4);
static_assert(WS_ERAW + (size_t)S_ * DM * 2 <= WS_Z + (size_t)ZROWS * LDZ * 2, "eraw must fit inside the dead z region while mix is still being read");
constexpr size_t WS_NEED  = WS_END_A > WS_END_B ? WS_END_A : WS_END_B;
static_assert(WS_NEED <= (size_t)1440000000, "workspace map exceeds the guaranteed 4 x largest-tensor bytes");

constexpr int LDS_STAGE = 131072;
constexpr int LDS_MISC  = LDS_STAGE;
constexpr int LDS_XCH   = LDS_STAGE + 64;
constexpr int LDS_BYTES = LDS_XCH + 4096;

__device__ __forceinline__ unsigned cvt_pk_bf16(float lo, float hi) { unsigned r; asm volatile("v_cvt_pk_bf16_f32 %0, %1, %2" : "=v"(r) : "v"(lo), "v"(hi)); return r; }
__device__ __forceinline__ float bf_lo(unsigned u) { return __uint_as_float(u << 16); }
__device__ __forceinline__ float bf_hi(unsigned u) { return __uint_as_float(u & 0xffff0000u); }
__device__ __forceinline__ float bf2f(bf16_t b) { return __uint_as_float(((unsigned)b) << 16); }
__device__ __forceinline__ float wave_sum(float v) {
#pragma unroll
    for (int o = 32; o >= 1; o >>= 1) v += __shfl_xor(v, o);
    return v;
}
__device__ __forceinline__ float wave_max(float v) {
#pragma unroll
    for (int o = 32; o >= 1; o >>= 1) v = fmaxf(v, __shfl_xor(v, o));
    return v;
}
__device__ __forceinline__ float sigmoidf_(float x) { return __builtin_amdgcn_rcpf(1.0f + __expf(-x)); }

#define XB_TMO      128
#define XB_XCNT(j)  (256  + 64 * (j))
#define XB_XSUB(j)  (1280 + 64 * (j))
#define XB_XGEN(j)  (2304 + 64 * (j))
#define XB_TOP      3328
#define XB_TOPGEN   3392
#define XCD_BAR_WORDS 3456
#define XB_SPIN_CAP (1u << 18)
__device__ __forceinline__ unsigned xb_ld(unsigned* p)              { return __hip_atomic_load(p, __ATOMIC_RELAXED, __HIP_MEMORY_SCOPE_AGENT); }
__device__ __forceinline__ unsigned xb_add(unsigned* p, unsigned v) { return __hip_atomic_fetch_add(p, v, __ATOMIC_RELAXED, __HIP_MEMORY_SCOPE_AGENT); }
__device__ __forceinline__ unsigned xb_xcc_id() { return (unsigned)__builtin_amdgcn_s_getreg((3 << 11) | 20) & 0xFu; }
#define XB_SPIN(cond, bar) do { unsigned _sp = 0; while (cond) { __builtin_amdgcn_s_sleep(1); \
    if ((++_sp & 255u) == 0u) { if (xb_ld(&(bar)[XB_TMO])) break; if (_sp > XB_SPIN_CAP) { atomicAdd(&(bar)[XB_TMO], 1u); break; } } } } while (0)
struct XcdBarrier { unsigned* bar; unsigned x; volatile LAS unsigned* st; };
__device__ __forceinline__ XcdBarrier xcd_barrier_post(unsigned* bar, volatile LAS unsigned* st) {
    XcdBarrier b; b.bar = bar; b.x = xb_xcc_id(); b.st = st;
    if (threadIdx.x == 0) (void)xb_add(&bar[XB_XCNT(b.x)], 1u);
    return b;
}
__device__ __forceinline__ void xcd_barrier_complete(unsigned* bar, unsigned x, unsigned& nloc, unsigned& nx) {
    const unsigned G = gridDim.x * gridDim.y * gridDim.z;
    unsigned sum, cnt, mine, sp = 0u;
    for (;;) {
        sum = 0u; cnt = 0u; mine = 0u;
#pragma unroll
        for (unsigned j = 0; j < 16; ++j) { const unsigned c = xb_ld(&bar[XB_XCNT(j)]); sum += c; cnt += (c > 0u) ? 1u : 0u; mine = (j == x) ? c : mine; }
        if (sum == G) break;
        __builtin_amdgcn_s_sleep(1);
        if ((++sp & 255u) == 0u) { if (xb_ld(&bar[XB_TMO])) break; if (sp > XB_SPIN_CAP) { atomicAdd(&bar[XB_TMO], 1u); break; } }
    }
    nloc = mine > 0u ? mine : 1u; nx = cnt > 0u ? cnt : 1u;
}
__device__ __forceinline__ void xcd_barrier(const XcdBarrier& b) {
    asm volatile("s_waitcnt vmcnt(0)" ::: "memory");
    __syncthreads();
    if (threadIdx.x == 0) {
        unsigned* bar = b.bar;
        __builtin_amdgcn_s_waitcnt(0);
        unsigned nloc = b.st[0], nx = b.st[1];
        if (nloc == 0u) { xcd_barrier_complete(bar, b.x, nloc, nx); b.st[0] = nloc; b.st[1] = nx; }
        const unsigned old = xb_add(&bar[XB_XSUB(b.x)], 1u);
        const unsigned gen = old / nloc;
        if (old + 1u == (gen + 1u) * nloc) {
            __builtin_amdgcn_fence(__ATOMIC_RELEASE, "agent");
            asm volatile("s_waitcnt vmcnt(0)" ::: "memory");
            const unsigned og = xb_add(&bar[XB_TOP], 1u);
            const unsigned tg = og / nx;
            if (og + 1u == (tg + 1u) * nx) xb_add(&bar[XB_TOPGEN], 1u);
            else XB_SPIN(xb_ld(&bar[XB_TOPGEN]) == tg, bar);
            __builtin_amdgcn_fence(__ATOMIC_ACQUIRE, "agent");
            xb_add(&bar[XB_XGEN(b.x)], 1u);
            asm volatile("s_waitcnt vmcnt(0)" ::: "memory");
        } else {
            XB_SPIN(xb_ld(&bar[XB_XGEN(b.x)]) == gen, bar);
            __builtin_amdgcn_fence(__ATOMIC_ACQUIRE, "agent");
            asm volatile("s_waitcnt vmcnt(0)" ::: "memory");
        }
    }
    __syncthreads();
}

struct Params {
    const float* x; const float* p; const int* positions; const float* norm1_w; const float* w_in; const float* w_pool; const float* pool_scale;
    const float* q_norm_w; const float* k_norm_cmp_w; const float* k_norm_slc_w; const float* k_norm_win_w; const float* cmp_pos_k; const float* cmp_pos_v;
    const float* cmp_k_w1; const float* cmp_k_w2; const float* cmp_v_w1; const float* cmp_v_w2; const float* w_o; const float* norm2_w; const float* w_ffn_in;
    const float* conv_w; const float* conv_b; const float* w_ffn_out; const float* w_ple_proj; const float* ple_norm_w; const float* ple_gate_norm_w; const float* w_ple_gate;
    float* out; unsigned char* ws; int ph_lo, ph_hi;
};

namespace pg8 {
constexpr int BM = 256, BK = 64, HALF = 128, HTB = HALF * BK * 2, STAGE_BYTES = 8 * HTB, NXCD = 8, WGM = 8;
__host__ __device__ __forceinline__ int lds_byte(int r, int c) { const int st = (r >> 4) * 2 + (c >> 5), rr = r & 15, cc = c & 31, ob = rr * 64 + cc * 2; return st * 1024 + (ob ^ (((ob >> 9) & 1) << 5)); }
__host__ __device__ __forceinline__ void stage_rc(int b, int& R, int& C) { const int st = b / 1024, sb = b % 1024, swz = sb ^ (((sb >> 9) & 1) << 5); R = (st >> 1) * 16 + swz / 64; C = (st & 1) * 32 + (swz % 64) / 2; }
__host__ __device__ __forceinline__ int perm32(int rho) { const int n = rho >> 4, i = rho & 15; return 8 * (i >> 2) + 4 * n + (i & 3); }
struct Unit { int pm, pn; };

struct StaticOrder {
    int nM, nN, nwg, G, c;
    __device__ void init(int nM_, int nN_, int G_, int c_) { nM = nM_; nN = nN_; nwg = nM * nN; G = G_; c = c_; }
    __device__ bool next(int i, Unit& u) const {
        const long L = (long)i * G + c; if (L >= nwg) return false;
        int wgid = (int)L; { const int q = nwg / NXCD, r = nwg % NXCD, xcd = wgid % NXCD, off = wgid / NXCD; wgid = (xcd < r ? xcd * (q + 1) : r * (q + 1) + (xcd - r) * q) + off; }
        const int nig = WGM * nN, gid = wgid / nig, fm = gid * WGM, gsz = (nM - fm) < WGM ? (nM - fm) : WGM;
        u.pm = fm + ((wgid % nig) % gsz); u.pn = (wgid % nig) / gsz; return true;
    }
};

struct GStd {
    const char* A; const char* B; unsigned lda, ldb; int nt;
    __device__ __forceinline__ const char* a_base(const Unit& u) const { return A + (size_t)u.pm * 256 * lda * 2; }
    __device__ __forceinline__ const char* b_base(const Unit& u) const { return B + (size_t)u.pn * 256 * ldb * 2; }
    __device__ __forceinline__ size_t kpairA() const { return 256; }
};
struct GPool {
    const char* A; const char* B; unsigned lda, ldb; int nt;
    __device__ __forceinline__ const char* a_base(const Unit& u) const { return A + (size_t)u.pm * 256 * lda * 2 + (size_t)u.pn * 512; }
    __device__ __forceinline__ const char* b_base(const Unit& u) const { return B + (size_t)u.pn * 256 * ldb * 2; }
    __device__ __forceinline__ size_t kpairA() const { return 256; }
};
struct GCmp {
    const char* Z; const char* Bk; const char* Bv; unsigned lda, ldb; int nt;
    __device__ __forceinline__ const char* a_base(const Unit& u) const { const int which = u.pm >> 4, g = (u.pm >> 2) & 3, rt = u.pm & 3;
        return Z + (size_t)(OFF_KV + which * 512 + g * 128) * 2 + (size_t)rt * 256 * lda * 2; }
    __device__ __forceinline__ const char* b_base(const Unit& u) const { return (u.pm >> 4) ? Bv : Bk; }
    __device__ __forceinline__ size_t kpairA() const { return (size_t)LDZ * 2; }
};

struct EpiBf16 {
    static constexpr bool PERM = true;
    bf16_t* O; int ldc;
    __device__ __forceinline__ void operator()(const f32x4 (&acc)[2][2][4][2], const Unit& u, int wr, int wc, int fr, int fq) const {
        const int row0 = u.pm * BM + wr * 64 + fr, col0 = u.pn * BM + wc * 32 + 8 * fq;
#pragma unroll
        for (int ai = 0; ai < 2; ++ai)
#pragma unroll
            for (int m = 0; m < 4; ++m) { bf16_t* rowp = O + (size_t)(row0 + ai * HALF + m * 16) * ldc + col0;
#pragma unroll
                for (int bj = 0; bj < 2; ++bj) { const f32x4 v0 = acc[ai][bj][m][0], v1 = acc[ai][bj][m][1];
                    u32x4 w; w.x = cvt_pk_bf16(v0[0], v0[1]); w.y = cvt_pk_bf16(v0[2], v0[3]); w.z = cvt_pk_bf16(v1[0], v1[1]); w.w = cvt_pk_bf16(v1[2], v1[3]);
                    *(u32x4*)(rowp + bj * HALF) = w; } }
    }
};
struct EpiBf16S {
    static constexpr bool PERM = true;
    bf16_t* O; int ldc; float s;
    __device__ __forceinline__ void operator()(const f32x4 (&acc)[2][2][4][2], const Unit& u, int wr, int wc, int fr, int fq) const {
        const int row0 = u.pm * BM + wr * 64 + fr, col0 = u.pn * BM + wc * 32 + 8 * fq;
#pragma unroll
        for (int ai = 0; ai < 2; ++ai)
#pragma unroll
            for (int m = 0; m < 4; ++m) { bf16_t* rowp = O + (size_t)(row0 + ai * HALF + m * 16) * ldc + col0;
#pragma unroll
                for (int bj = 0; bj < 2; ++bj) { const f32x4 v0 = acc[ai][bj][m][0] * s, v1 = acc[ai][bj][m][1] * s;
                    u32x4 w; w.x = cvt_pk_bf16(v0[0], v0[1]); w.y = cvt_pk_bf16(v0[2], v0[3]); w.z = cvt_pk_bf16(v1[0], v1[1]); w.w = cvt_pk_bf16(v1[2], v1[3]);
                    *(u32x4*)(rowp + bj * HALF) = w; } }
    }
};
struct EpiBf16Ssq {
    static constexpr bool PERM = true;
    bf16_t* O; int ldc; float* ssq;
    __device__ __forceinline__ void operator()(const f32x4 (&acc)[2][2][4][2], const Unit& u, int wr, int wc, int fr, int fq) const {
        const int row0 = u.pm * BM + wr * 64 + fr, col0 = u.pn * BM + wc * 32 + 8 * fq;
#pragma unroll
        for (int ai = 0; ai < 2; ++ai)
#pragma unroll
            for (int m = 0; m < 4; ++m) { const int row = row0 + ai * HALF + m * 16; bf16_t* rowp = O + (size_t)row * ldc + col0; float s = 0.f;
#pragma unroll
                for (int bj = 0; bj < 2; ++bj) { const f32x4 v0 = acc[ai][bj][m][0], v1 = acc[ai][bj][m][1];
                    s += v0[0] * v0[0] + v0[1] * v0[1] + v0[2] * v0[2] + v0[3] * v0[3] + v1[0] * v1[0] + v1[1] * v1[1] + v1[2] * v1[2] + v1[3] * v1[3];
                    u32x4 w; w.x = cvt_pk_bf16(v0[0], v0[1]); w.y = cvt_pk_bf16(v0[2], v0[3]); w.z = cvt_pk_bf16(v1[0], v1[1]); w.w = cvt_pk_bf16(v1[2], v1[3]);
                    *(u32x4*)(rowp + bj * HALF) = w; }
                s += __shfl_xor(s, 16); s += __shfl_xor(s, 32);
                if (fq == 0) unsafeAtomicAdd(ssq + row, s); }
    }
};
struct EpiBf16Scale {
    static constexpr bool PERM = true;
    bf16_t* O; int ldc; const float* colscale;
    __device__ __forceinline__ void operator()(const f32x4 (&acc)[2][2][4][2], const Unit& u, int wr, int wc, int fr, int fq) const {
        const int row0 = u.pm * BM + wr * 64 + fr, col0 = u.pn * BM + wc * 32 + 8 * fq;
#pragma unroll
        for (int bj = 0; bj < 2; ++bj) { const f32x4 s0 = *(const f32x4*)(colscale + col0 + bj * HALF), s1 = *(const f32x4*)(colscale + col0 + bj * HALF + 4);
#pragma unroll
            for (int ai = 0; ai < 2; ++ai)
#pragma unroll
                for (int m = 0; m < 4; ++m) { bf16_t* rowp = O + (size_t)(row0 + ai * HALF + m * 16) * ldc + col0;
                    const f32x4 v0 = acc[ai][bj][m][0] * s0, v1 = acc[ai][bj][m][1] * s1;
                    u32x4 w; w.x = cvt_pk_bf16(v0[0], v0[1]); w.y = cvt_pk_bf16(v0[2], v0[3]); w.z = cvt_pk_bf16(v1[0], v1[1]); w.w = cvt_pk_bf16(v1[2], v1[3]);
                    *(u32x4*)(rowp + bj * HALF) = w; } }
    }
};
struct EpiResF32 {
    static constexpr bool PERM = false;
    const float* base; float* C; int ldc; int row_off;
    __device__ __forceinline__ void operator()(const f32x4 (&acc)[2][2][4][2], const Unit& u, int wr, int wc, int fr, int fq) const {
        const int row0 = u.pm * BM + wr * 64 + fr + row_off, col0 = u.pn * BM + wc * 32 + 4 * fq;
#pragma unroll
        for (int ai = 0; ai < 2; ++ai)
#pragma unroll
            for (int m = 0; m < 4; ++m) { const size_t off = (size_t)(row0 + ai * HALF + m * 16) * ldc + col0;
#pragma unroll
                for (int bj = 0; bj < 2; ++bj)
#pragma unroll
                    for (int n = 0; n < 2; ++n) { const f32x4 b = *(const f32x4*)(base + off + bj * HALF + n * 16); *(f32x4*)(C + off + bj * HALF + n * 16) = b + acc[ai][bj][m][n]; }
                asm volatile("" ::: "memory"); }
    }
};
template <bool FP8OUT>
struct EpiResNormT {
    static constexpr bool PERM = false;
    const float* base; float* C; bf16_t* XN; const float* nw; float* ssq; int ldc;
    __device__ __forceinline__ void operator()(const f32x4 (&acc)[2][2][4][2], const Unit& u, int wr, int wc, int fr, int fq) const {
        const int row0 = u.pm * BM + wr * 64 + fr, col0 = u.pn * BM + wc * 32 + 4 * fq;
        f32x4 wv[2][2];
#pragma unroll
        for (int bj = 0; bj < 2; ++bj)
#pragma unroll
            for (int n = 0; n < 2; ++n) wv[bj][n] = *(const f32x4*)(nw + col0 + bj * HALF + n * 16);
        f32x4 bv[2][2][2];
#pragma unroll
        for (int bj = 0; bj < 2; ++bj)
#pragma unroll
            for (int n = 0; n < 2; ++n) bv[0][bj][n] = *(const f32x4*)(base + (size_t)row0 * ldc + col0 + bj * HALF + n * 16);
#pragma unroll
        for (int rg = 0; rg < 8; ++rg) { const int ai = rg >> 2, m = rg & 3; const int row = row0 + ai * HALF + m * 16; const size_t off = (size_t)row * ldc + col0;
            if (rg < 7) { const int ai2 = (rg + 1) >> 2, m2 = (rg + 1) & 3; const size_t off2 = (size_t)(row0 + ai2 * HALF + m2 * 16) * ldc + col0;
#pragma unroll
                for (int bj = 0; bj < 2; ++bj)
#pragma unroll
                    for (int n = 0; n < 2; ++n) bv[(rg + 1) & 1][bj][n] = *(const f32x4*)(base + off2 + bj * HALF + n * 16); }
            float s = 0.f;
#pragma unroll
            for (int bj = 0; bj < 2; ++bj)
#pragma unroll
                for (int n = 0; n < 2; ++n) { const f32x4 v = bv[rg & 1][bj][n] + acc[ai][bj][m][n];
                    *(f32x4*)(C + off + bj * HALF + n * 16) = v; s += v[0] * v[0] + v[1] * v[1] + v[2] * v[2] + v[3] * v[3];
                    if (FP8OUT) { int pk = __builtin_amdgcn_cvt_pk_fp8_f32(v[0] * wv[bj][n][0], v[1] * wv[bj][n][1], 0, false); pk = __builtin_amdgcn_cvt_pk_fp8_f32(v[2] * wv[bj][n][2], v[3] * wv[bj][n][3], pk, true);
                        *(int*)((unsigned char*)XN + off + bj * HALF + n * 16) = pk; }
                    else { u32x2 o; o.x = cvt_pk_bf16(v[0] * wv[bj][n][0], v[1] * wv[bj][n][1]); o.y = cvt_pk_bf16(v[2] * wv[bj][n][2], v[3] * wv[bj][n][3]);
                        *(u32x2*)(XN + off + bj * HALF + n * 16) = o; } }
            s += __shfl_xor(s, 16); s += __shfl_xor(s, 32);
            if (fq == 0) unsafeAtomicAdd(ssq + row, s);
        }
    }
};
typedef EpiResNormT<false> EpiResNorm;
typedef EpiResNormT<true> EpiResNormF8;
struct EpiCmpGelu {
    static constexpr bool PERM = false;
    float* H; const float* bias;
    __device__ __forceinline__ void operator()(const f32x4 (&acc)[2][2][4][2], const Unit& u, int wr, int wc, int fr, int fq) const {
        const int row0 = u.pm * BM + wr * 64 + fr, col0 = wc * 32 + 4 * fq; const float* bs = bias + (u.pm >> 4) * 256;
        f32x4 bvv[2][2];
#pragma unroll
        for (int bj = 0; bj < 2; ++bj)
#pragma unroll
            for (int n = 0; n < 2; ++n) bvv[bj][n] = *(const f32x4*)(bs + col0 + bj * HALF + n * 16);
#pragma unroll
        for (int ai = 0; ai < 2; ++ai)
#pragma unroll
            for (int m = 0; m < 4; ++m) { float* rowp = H + (size_t)(row0 + ai * HALF + m * 16) * 256 + col0;
#pragma unroll
                for (int bj = 0; bj < 2; ++bj)
#pragma unroll
                    for (int n = 0; n < 2; ++n) { f32x4 v = acc[ai][bj][m][n] + bvv[bj][n];
#pragma unroll
                        for (int j = 0; j < 4; ++j) { const float xx = v[j], uu = 0.7978845608028654f * (xx + 0.044715f * xx * xx * xx); const float th = 1.0f - 2.0f / (1.0f + __expf(2.0f * uu)); v[j] = 0.5f * xx * (1.0f + th); }
                        *(f32x4*)(rowp + bj * HALF + n * 16) = v; } }
    }
};
struct EpiGate {
    static constexpr bool PERM = false;
    float* C; const bf16_t* eraw; const float* erstd; const float* pw; const float* ssq; int ldc; float ascale;
    __device__ __forceinline__ void operator()(const f32x4 (&acc)[2][2][4][2], const Unit& u, int wr, int wc, int fr, int fq) const {
        const int row0 = u.pm * BM + wr * 64 + fr, col0 = u.pn * BM + wc * 32 + 4 * fq;
        f32x4 wv[2][2];
#pragma unroll
        for (int bj = 0; bj < 2; ++bj)
#pragma unroll
            for (int n = 0; n < 2; ++n) wv[bj][n] = *(const f32x4*)(pw + col0 + bj * HALF + n * 16);
        f32x4 bv[2][2][2]; u32x2 ev[2][2][2]; float rsv[2], rgv[2];
#pragma unroll
        for (int bj = 0; bj < 2; ++bj)
#pragma unroll
            for (int n = 0; n < 2; ++n) { bv[0][bj][n] = *(const f32x4*)(C + (size_t)row0 * ldc + col0 + bj * HALF + n * 16); ev[0][bj][n] = *(const u32x2*)(eraw + (size_t)row0 * ldc + col0 + bj * HALF + n * 16); }
        rsv[0] = erstd[row0]; rgv[0] = ssq[row0];
#pragma unroll
        for (int rg = 0; rg < 8; ++rg) { const int ai = rg >> 2, m = rg & 3; const int row = row0 + ai * HALF + m * 16; const size_t off = (size_t)row * ldc + col0;
            if (rg < 7) { const int ai2 = (rg + 1) >> 2, m2 = (rg + 1) & 3; const int row2 = row0 + ai2 * HALF + m2 * 16; const size_t off2 = (size_t)row2 * ldc + col0;
#pragma unroll
                for (int bj = 0; bj < 2; ++bj)
#pragma unroll
                    for (int n = 0; n < 2; ++n) { bv[(rg + 1) & 1][bj][n] = *(const f32x4*)(C + off2 + bj * HALF + n * 16); ev[(rg + 1) & 1][bj][n] = *(const u32x2*)(eraw + off2 + bj * HALF + n * 16); }
                rsv[(rg + 1) & 1] = erstd[row2]; rgv[(rg + 1) & 1] = ssq[row2]; }
            const float rs = rsqrtf(rsv[rg & 1] * (1.0f / DM) + EPS), rg_ = rsqrtf(rgv[rg & 1] * (1.0f / DM) + EPS) * ascale;
#pragma unroll
            for (int bj = 0; bj < 2; ++bj)
#pragma unroll
                for (int n = 0; n < 2; ++n) { const f32x4 b = bv[rg & 1][bj][n]; const u32x2 e = ev[rg & 1][bj][n]; const f32x4 a = acc[ai][bj][m][n]; f32x4 o;
                    o[0] = b[0] + bf_lo(e.x) * rs * wv[bj][n][0] * sigmoidf_(a[0] * rg_); o[1] = b[1] + bf_hi(e.x) * rs * wv[bj][n][1] * sigmoidf_(a[1] * rg_);
                    o[2] = b[2] + bf_lo(e.y) * rs * wv[bj][n][2] * sigmoidf_(a[2] * rg_); o[3] = b[3] + bf_hi(e.y) * rs * wv[bj][n][3] * sigmoidf_(a[3] * rg_);
                    *(f32x4*)(C + off + bj * HALF + n * 16) = o; }
        }
    }
};
struct GFfn {
    const char* A; const char* B; unsigned lda, ldb; int nt;
    __device__ __forceinline__ const char* a_base(const Unit& u) const { return A + ((long)u.pm * 254 - 2) * (long)lda * 2; }
    __device__ __forceinline__ const char* b_base(const Unit& u) const { return B + (size_t)u.pn * 256 * ldb * 2; }
    __device__ __forceinline__ size_t kpairA() const { return 256; }
};
template <int CTRL> __device__ __forceinline__ float dpp_f(float v) { return __int_as_float(__builtin_amdgcn_update_dpp(0, __float_as_int(v), CTRL, 0xf, 0xf, false)); }
struct EpiFfn {
    static constexpr bool PERM = true;
    bf16_t* ACT; const float* cw; const float* cb; LAS float* X; const float* ssq;
    __device__ __forceinline__ void operator()(const f32x4 (&acc)[2][2][4][2], const Unit& u, int wr, int wc, int fr, int fq) const {
        const int colw = wc * 32 + 8 * fq;
        float rsv[2][4];
#pragma unroll
        for (int ai = 0; ai < 2; ++ai)
#pragma unroll
            for (int m = 0; m < 4; ++m) { const long t = (long)u.pm * 254 - 2 + ai * HALF + wr * 64 + m * 16 + fr; rsv[ai][m] = (t >= 0 && t < S_) ? rsqrtf(ssq[t] * (1.0f / DM) + EPS) : 0.f; }
        if (fr >= 14) {
#pragma unroll
            for (int ai = 0; ai < 2; ++ai)
#pragma unroll
                for (int n = 0; n < 2; ++n) *(LAS f32x4*)(X + ((2 * ai + wr) * 2 + (fr - 14)) * 128 + colw + 4 * n) = acc[ai][0][3][n] * rsv[ai][3];
        }
        asm volatile("s_waitcnt lgkmcnt(0)" ::: "memory");
        __builtin_amdgcn_s_barrier(); asm volatile("" ::: "memory");
        __builtin_amdgcn_s_barrier(); asm volatile("" ::: "memory");
        const int f0 = u.pn * 128 + colw;
        f32x4 w0[2], w1[2], w2[2], cbv[2];
#pragma unroll
        for (int n = 0; n < 2; ++n) { w0[n] = *(const f32x4*)(cw + f0 + 4 * n); w1[n] = *(const f32x4*)(cw + DFF + f0 + 4 * n); w2[n] = *(const f32x4*)(cw + 2 * DFF + f0 + 4 * n); cbv[n] = *(const f32x4*)(cb + f0 + 4 * n); }
#pragma unroll
        for (int ai = 0; ai < 2; ++ai) {
            f32x4 pv[2];
            const int pseg = 2 * ai + wr - 1;
#pragma unroll
            for (int n = 0; n < 2; ++n) { pv[n] = (f32x4){0.f, 0.f, 0.f, 0.f}; if (pseg >= 0 && fr >= 14) pv[n] = *(const LAS f32x4*)(X + (pseg * 2 + (fr - 14)) * 128 + colw + 4 * n); }
#pragma unroll
            for (int m = 0; m < 4; ++m) {
                const int r = ai * HALF + wr * 64 + m * 16 + fr; const long t = (long)u.pm * 254 - 2 + r;
                unsigned ow[4];
#pragma unroll
                for (int n = 0; n < 2; ++n) {
                    const f32x4 cur = acc[ai][0][m][n] * rsv[ai][m], up = acc[ai][1][m][n] * rsv[ai][m]; f32x4 o;
#pragma unroll
                    for (int i = 0; i < 4; ++i) {
                        const float c1 = dpp_f<0x121>(cur[i]), p1 = dpp_f<0x121>(pv[n][i]), c2 = dpp_f<0x122>(cur[i]), p2 = dpp_f<0x122>(pv[n][i]);
                        const float x1 = fr >= 1 ? c1 : p1, x2 = fr >= 2 ? c2 : p2;
                        const float y = cbv[n][i] + w0[n][i] * x2 + w1[n][i] * x1 + w2[n][i] * cur[i];
                        o[i] = y * sigmoidf_(y) * up[i];
                    }
                    ow[2 * n] = cvt_pk_bf16(o[0], o[1]); ow[2 * n + 1] = cvt_pk_bf16(o[2], o[3]);
                    pv[n] = cur;
                }
                if (r >= 2 && t < S_) *(u32x4*)(ACT + (size_t)t * DFF + f0) = (u32x4){ow[0], ow[1], ow[2], ow[3]};
            }
        }
    }
};

template <class GD, class Epi, bool F8 = false>
__device__ __forceinline__ void gemm_phase(LAS unsigned char* lds, const GD g, const StaticOrder& S, const Epi& E) {
    const int tid = threadIdx.x, wid = __builtin_amdgcn_readfirstlane(tid >> 6), lane = tid & 63, wr = wid >> 2, wc = wid & 3, fr = lane & 15, fq = lane >> 4;
    const int nt = g.nt;
    unsigned voffA[2], voffB[2];
#pragma unroll
    for (int i = 0; i < 2; ++i) { int R, C; stage_rc(tid * 16 + i * 8192, R, C); const int Rb = Epi::PERM ? ((R & ~31) + perm32(R & 31)) : R;
        voffA[i] = (unsigned)(R * g.lda + C) * 2u; voffB[i] = (unsigned)(Rb * g.ldb + C) * 2u; }
    const size_t kpA = g.kpairA();
    const size_t hstepA = (size_t)HALF * g.lda * 2, hstepB = (size_t)HALF * g.ldb * 2;
    const unsigned ldsw = (unsigned)wid * 1024u;
    const int aoff = lds_byte(wr * 64 + fr, fq * 8), boff = lds_byte(wc * 32 + fr, fq * 8);
#define PG8_SA(b, h) (((b) * 2 + (h)) * HTB)
#define PG8_SB(b, h) ((4 + (b) * 2 + (h)) * HTB)
#define PG8_STAGE(bufoff, gbase, voff) do { _Pragma("unroll") for (int _i = 0; _i < 2; ++_i) \
        __builtin_amdgcn_global_load_lds((const unsigned*)((const char*)(gbase) + (voff)[_i]), (LAS unsigned*)(lds + (bufoff) + ldsw + _i * 8192), 16, 0, 0); } while (0)
#define PG8_LDA(dst, b, h) do { if constexpr (F8) { _Pragma("unroll") for (int m = 0; m < 4; ++m) { const i32x4 lo_ = *(const LAS i32x4*)(lds + PG8_SA(b, h) + aoff + m * 2048), hi_ = *(const LAS i32x4*)(lds + PG8_SA(b, h) + aoff + m * 2048 + 1024); \
            dst##8[m] = __builtin_shufflevector(lo_, hi_, 0, 1, 2, 3, 4, 5, 6, 7); } } \
        else { _Pragma("unroll") for (int m = 0; m < 4; ++m) _Pragma("unroll") for (int k = 0; k < 2; ++k) dst[m][k] = *(const LAS bf16x8*)(lds + PG8_SA(b, h) + aoff + m * 2048 + k * 1024); } } while (0)
#define PG8_LDB(dst, b, h) do { if constexpr (F8) { _Pragma("unroll") for (int n = 0; n < 2; ++n) { const i32x4 lo_ = *(const LAS i32x4*)(lds + PG8_SB(b, h) + boff + n * 2048), hi_ = *(const LAS i32x4*)(lds + PG8_SB(b, h) + boff + n * 2048 + 1024); \
            dst##8[n] = __builtin_shufflevector(lo_, hi_, 0, 1, 2, 3, 4, 5, 6, 7); } } \
        else { _Pragma("unroll") for (int n = 0; n < 2; ++n) _Pragma("unroll") for (int k = 0; k < 2; ++k) dst[n][k] = *(const LAS bf16x8*)(lds + PG8_SB(b, h) + boff + n * 2048 + k * 1024); } } while (0)
#define PG8_MMA(ai, bj, At, Bt) do { __builtin_amdgcn_s_setprio(1); \
        if constexpr (F8) { _Pragma("unroll") for (int m = 0; m < 4; ++m) _Pragma("unroll") for (int n = 0; n < 2; ++n) \
            asm volatile("v_mfma_scale_f32_16x16x128_f8f6f4 %0, %1, %2, %0, %3, %3 op_sel_hi:[0,0,0]" : "+v"(acc[ai][bj][m][n]) : "v"(Bt##8[n]), "v"(At##8[m]), "v"(one_scale)); } \
        else { _Pragma("unroll") for (int m = 0; m < 4; ++m) _Pragma("unroll") for (int n = 0; n < 2; ++n) _Pragma("unroll") for (int k = 0; k < 2; ++k) \
            acc[ai][bj][m][n] = __builtin_amdgcn_mfma_f32_16x16x32_bf16(Bt[n][k], At[m][k], acc[ai][bj][m][n], 0, 0, 0); } \
        __builtin_amdgcn_s_setprio(0); } while (0)
#define PG8_WAIT_V(n) asm volatile("s_waitcnt vmcnt(" #n ")" ::: "memory")
#define PG8_WAIT_L(n) asm volatile("s_waitcnt lgkmcnt(" #n ")" ::: "memory")
#define PG8_BAR __builtin_amdgcn_s_barrier()
#define PG8_SCHED __builtin_amdgcn_sched_barrier(0)
    Unit cur, nxt; int ui = 0;
    if (!S.next(0, cur)) return;
    f32x4 acc[2][2][4][2];
#pragma unroll
    for (int a = 0; a < 2; ++a)
#pragma unroll
        for (int b = 0; b < 2; ++b)
#pragma unroll
            for (int m = 0; m < 4; ++m)
#pragma unroll
                for (int n = 0; n < 2; ++n) acc[a][b][m][n] = (f32x4){0.f, 0.f, 0.f, 0.f};
    bf16x8 At[4][2], B0[2][2], B1[2][2];
    i32x8 At8[4], B08[2], B18[2];
    (void)At; (void)B0; (void)B1; (void)At8; (void)B08; (void)B18;
    int one_scale = 0x7F7F7F7F; (void)one_scale;
    const char* cA = g.a_base(cur); const char* cB = g.b_base(cur);
    PG8_STAGE(PG8_SB(0, 0), cB, voffB); PG8_STAGE(PG8_SA(0, 0), cA, voffA); PG8_STAGE(PG8_SB(0, 1), cB + hstepB, voffB); PG8_STAGE(PG8_SA(0, 1), cA + hstepA, voffA);
    if (wr == 1) PG8_BAR;
    PG8_WAIT_V(4); PG8_BAR;
    PG8_STAGE(PG8_SB(1, 0), cB + 128, voffB); PG8_STAGE(PG8_SA(1, 0), cA + 128, voffA); PG8_STAGE(PG8_SB(1, 1), cB + hstepB + 128, voffB);
    PG8_WAIT_V(6); PG8_BAR;
    for (;;) {
        const bool has_next = S.next(ui + 1, nxt);
        const char* nA = has_next ? g.a_base(nxt) : cA; const char* nB = has_next ? g.b_base(nxt) : cB;
        for (int t = 0; t < nt; t += 2) {
            const bool last = (t == nt - 2);
            const char* a0 = cA + (size_t)(t >> 1) * kpA;
            const char* a1 = a0 + 128;
            const char* a2 = last ? nA : a0 + kpA; const char* b2 = last ? nB : cB + (size_t)(t + 2) * 128;
            const char* a3 = a2 + 128; const char* b3 = b2 + 128;
            PG8_LDB(B0, 0, 0); PG8_SCHED; PG8_LDA(At, 0, 0); PG8_STAGE(PG8_SA(1, 1), a1 + hstepA, voffA);
            PG8_WAIT_L(8); PG8_BAR; PG8_WAIT_L(0); PG8_MMA(0, 0, At, B0); PG8_BAR; PG8_SCHED;
            PG8_LDB(B1, 0, 1); PG8_STAGE(PG8_SB(0, 0), b2, voffB);
            PG8_BAR; PG8_WAIT_L(0); PG8_MMA(0, 1, At, B1); PG8_BAR;
            PG8_LDA(At, 0, 1); PG8_STAGE(PG8_SA(0, 0), a2, voffA);
            PG8_BAR; PG8_WAIT_L(0); PG8_MMA(1, 0, At, B0); PG8_BAR; PG8_SCHED;
            PG8_STAGE(PG8_SB(0, 1), b2 + hstepB, voffB);
            PG8_WAIT_V(6); PG8_BAR; PG8_MMA(1, 1, At, B1); PG8_BAR;
            PG8_LDB(B0, 1, 0); PG8_SCHED; PG8_LDA(At, 1, 0); PG8_STAGE(PG8_SA(0, 1), a2 + hstepA, voffA);
            PG8_WAIT_L(8); PG8_BAR; PG8_WAIT_L(0); PG8_MMA(0, 0, At, B0); PG8_BAR; PG8_SCHED;
            PG8_LDB(B1, 1, 1); PG8_STAGE(PG8_SB(1, 0), b3, voffB);
            PG8_BAR; PG8_WAIT_L(0); PG8_MMA(0, 1, At, B1); PG8_BAR;
            PG8_LDA(At, 1, 1); PG8_STAGE(PG8_SA(1, 0), a3, voffA);
            PG8_BAR; PG8_WAIT_L(0); PG8_MMA(1, 0, At, B0); PG8_BAR; PG8_SCHED;
            PG8_STAGE(PG8_SB(1, 1), b3 + hstepB, voffB);
            PG8_WAIT_V(6); PG8_BAR; PG8_MMA(1, 1, At, B1); PG8_BAR;
        }
        if constexpr (F8) asm volatile("s_nop 15\n\ts_nop 15\n\ts_nop 15" ::: "memory");
        E(acc, cur, wr, wc, fr, fq);
        if (!has_next) break;
#pragma unroll
        for (int a = 0; a < 2; ++a)
#pragma unroll
            for (int b = 0; b < 2; ++b)
#pragma unroll
                for (int m = 0; m < 4; ++m)
#pragma unroll
                    for (int n = 0; n < 2; ++n) acc[a][b][m][n] = (f32x4){0.f, 0.f, 0.f, 0.f};
        cur = nxt; cA = nA; cB = nB; ++ui;
    }
    PG8_WAIT_V(0);
    if (wr == 0) PG8_BAR;
    PG8_BAR;
#undef PG8_SA
#undef PG8_SB
#undef PG8_STAGE
#undef PG8_LDA
#undef PG8_LDB
#undef PG8_MMA
#undef PG8_WAIT_V
#undef PG8_WAIT_L
#undef PG8_BAR
#undef PG8_SCHED
}
}

namespace att {
constexpr int KVBLK = 64;
constexpr int SHM_V = KVBLK * HD * 2, SHM_K = KVBLK * HD * 2, SHM_ATTN = 2 * SHM_V + 2 * SHM_K + NWAVES * 64 * 4;
#define KSWZ(row, colB) ((row) * 256 + ((colB) ^ (((row) & 7) << 4)))
#define SBAR() __builtin_amdgcn_sched_barrier(0)
__device__ __forceinline__ int crow(int r, int hi) { return (r & 3) + 8 * (r >> 2) + 4 * hi; }
__device__ __forceinline__ void qkt(f32x16& p0, f32x16& p1, const char* Ks, const bf16x8* qr, int r32, int hi) {
    p0 = f32x16{}; p1 = f32x16{};
    bf16x8 ka[2], kb[2];
    { const int cb = (hi * 8) * 2; ka[0] = *reinterpret_cast<const bf16x8*>(Ks + KSWZ(r32, cb)); kb[0] = *reinterpret_cast<const bf16x8*>(Ks + KSWZ(32 + r32, cb)); }
#pragma unroll
    for (int d0 = 0; d0 < 8; ++d0) {
        if (d0 < 7) { const int cb = ((d0 + 1) * 16 + hi * 8) * 2;
            ka[(d0 + 1) & 1] = *reinterpret_cast<const bf16x8*>(Ks + KSWZ(r32, cb)); kb[(d0 + 1) & 1] = *reinterpret_cast<const bf16x8*>(Ks + KSWZ(32 + r32, cb)); }
        SBAR();
        p0 = __builtin_amdgcn_mfma_f32_32x32x16_bf16(ka[d0 & 1], qr[d0], p0, 0, 0, 0);
        p1 = __builtin_amdgcn_mfma_f32_32x32x16_bf16(kb[d0 & 1], qr[d0], p1, 0, 0, 0);
        SBAR();
    }
}
__device__ __forceinline__ int v_st(int k, int c) { const int kk = (k & ~0xC) | ((k & 4) << 1) | ((k & 8) >> 1); return ((kk >> 3) * 4 + (c >> 5)) * 512 + ((kk & 7) * 32 + (c & 31)) * 2; }
__device__ __forceinline__ int v_rd_base(int lane) { return ((lane & 3) << 3) | (((lane >> 2) & 3) << 6) | (((lane >> 4) & 1) << 5) | (((lane >> 5) & 1) << 8); }
constexpr int v_rd_off(int d0, int ks, int half) { return d0 * 512 + ks * 4096 + half * 2048; }
__device__ __forceinline__ s16x4 tr_read(int vb, int off) { return __builtin_amdgcn_ds_read_tr16_b64_v4i16((LAS s16x4*)(unsigned long)(unsigned)(vb + off)); }
__device__ __forceinline__ void pv_d0(f32x16* o, int vb, bf16x8 pa0, bf16x8 pa1, bf16x8 pa2, bf16x8 pa3) {
    s16x4 L[2][4], H[2][4];
#pragma unroll
    for (int d0 = 0; d0 < 4; ++d0) { L[0][d0] = tr_read(vb, v_rd_off(d0, 0, 0)); H[0][d0] = tr_read(vb, v_rd_off(d0, 0, 1)); }
#pragma unroll
    for (int ks = 0; ks < 4; ++ks) {
        if (ks < 3) {
#pragma unroll
            for (int d0 = 0; d0 < 4; ++d0) { L[(ks + 1) & 1][d0] = tr_read(vb, v_rd_off(d0, ks + 1, 0)); H[(ks + 1) & 1][d0] = tr_read(vb, v_rd_off(d0, ks + 1, 1)); }
        }
        const bf16x8 pa = ks == 0 ? pa0 : (ks == 1 ? pa1 : (ks == 2 ? pa2 : pa3));
#pragma unroll
        for (int d0 = 0; d0 < 4; ++d0) { const s16x4 l = L[ks & 1][d0], h = H[ks & 1][d0];
            o[d0] = __builtin_amdgcn_mfma_f32_32x32x16_bf16(pa, (bf16x8){l[0], l[1], l[2], l[3], h[0], h[1], h[2], h[3]}, o[d0], 0, 0, 0); }
    }
}
__device__ __forceinline__ void pack_p(const f32x16& p0, const f32x16& p1, bf16x8& pa0, bf16x8& pa1, bf16x8& pa2, bf16x8& pa3) {
#define PK4(P, BASE, OUT) do { unsigned a0 = cvt_pk_bf16(P[BASE + 0], P[BASE + 1]), a1 = cvt_pk_bf16(P[BASE + 2], P[BASE + 3]);   \
    unsigned b0 = cvt_pk_bf16(P[BASE + 4], P[BASE + 5]), b1 = cvt_pk_bf16(P[BASE + 6], P[BASE + 7]);                              \
    auto r0 = __builtin_amdgcn_permlane32_swap(a0, b0, false, false); auto r1 = __builtin_amdgcn_permlane32_swap(a1, b1, false, false); \
    u32x4 w = {r0[0], r1[0], r0[1], r1[1]}; OUT = *reinterpret_cast<bf16x8*>(&w); } while (0)
    PK4(p0, 0, pa0); PK4(p0, 8, pa1); PK4(p1, 0, pa2); PK4(p1, 8, pa3);
#undef PK4
}

__device__ __forceinline__ void pack_half(const f32x16& p, bf16x8& paA, bf16x8& paB) {
#define PK4(P, BASE, OUT) do { unsigned a0 = cvt_pk_bf16(P[BASE + 0], P[BASE + 1]), a1 = cvt_pk_bf16(P[BASE + 2], P[BASE + 3]);   \
    unsigned b0 = cvt_pk_bf16(P[BASE + 4], P[BASE + 5]), b1 = cvt_pk_bf16(P[BASE + 6], P[BASE + 7]);                              \
    auto r0 = __builtin_amdgcn_permlane32_swap(a0, b0, false, false); auto r1 = __builtin_amdgcn_permlane32_swap(a1, b1, false, false); \
    u32x4 w = {r0[0], r1[0], r0[1], r1[1]}; OUT = *reinterpret_cast<bf16x8*>(&w); } while (0)
    PK4(p, 0, paA); PK4(p, 8, paB);
#undef PK4
}
template <int KS0, bool WITH_EXP>
__device__ __forceinline__ void pv_half(f32x16* o, int vb, bf16x8 paA, bf16x8 paB, f32x16& px, float off) {
    s16x4 L[2][4], H[2][4];
#pragma unroll
    for (int d0 = 0; d0 < 4; ++d0) { L[0][d0] = tr_read(vb, v_rd_off(d0, KS0, 0)); H[0][d0] = tr_read(vb, v_rd_off(d0, KS0, 1)); }
#pragma unroll
    for (int d0 = 0; d0 < 4; ++d0) { L[1][d0] = tr_read(vb, v_rd_off(d0, KS0 + 1, 0)); H[1][d0] = tr_read(vb, v_rd_off(d0, KS0 + 1, 1)); }
#pragma unroll
    for (int kk = 0; kk < 2; ++kk) {
        const bf16x8 pa = kk == 0 ? paA : paB;
#pragma unroll
        for (int d0 = 0; d0 < 4; ++d0) { const s16x4 l = L[kk][d0], h = H[kk][d0];
            if (WITH_EXP) SBAR();
            o[d0] = __builtin_amdgcn_mfma_f32_32x32x16_bf16(pa, (bf16x8){l[0], l[1], l[2], l[3], h[0], h[1], h[2], h[3]}, o[d0], 0, 0, 0);
            if (WITH_EXP) {
#pragma unroll
                for (int q = 0; q < 2; ++q) { const int r = (kk * 4 + d0) * 2 + q; px[r] = __builtin_amdgcn_exp2f(fmaf(px[r], SM_C, off)); }
                SBAR(); }
        }
    }
}
enum { MODE_CMP = 0, MODE_WIN = 1, MODE_SLC = 2 };
struct AttnArgs {
    const bf16_t* Z; const bf16_t* KC; const bf16_t* VC; const float* G; float* L; float* OACC; bf16_t* MIX; const unsigned* BM; const float* TAB;
};
template <int MODE>
__device__ __forceinline__ void attn_unit(const AttnArgs& a, LAS char* ldsL, int qt, int g, int hp) {
    char* lds = (char*)ldsL;
    const int tid = threadIdx.x, wid = __builtin_amdgcn_readfirstlane(tid >> 6), lane = tid & 63, r32 = lane & 31, hi = lane >> 5;
    float* li_l = (float*)(lds + LDS_XCH) + wid * 64;
    const int t0 = MODE == MODE_SLC ? qt * 40 : qt * 128;
    const int tq_raw = MODE == MODE_SLC ? t0 + wid * 5 + r32 / 6 : t0 + wid * 16 + (r32 & 15);
    const bool rvalid = MODE == MODE_SLC ? (r32 < 30 && tq_raw < S_) : true;
    const int tq = tq_raw < S_ ? tq_raw : S_ - 1;
    const int hq = MODE == MODE_SLC ? g * HPG + r32 % 6 : g * HPG + hp * 2 + (r32 >> 4);
    const int tlast = MODE == MODE_SLC ? ((t0 + 39) < S_ ? (t0 + 39) : S_ - 1) : t0 + 127;
    const bf16_t* Kb; const bf16_t* Vb; long ldk;
    if (MODE == MODE_CMP) { Kb = a.KC + (size_t)g * 1024 * HD; Vb = a.VC + (size_t)g * 1024 * HD; ldk = HD; }
    else if (MODE == MODE_WIN) { Kb = a.Z + OFF_KV + 4 * 512 + g * HD; Vb = a.Z + OFF_KV + 5 * 512 + g * HD; ldk = LDZ; }
    else { Kb = a.Z + OFF_KV + 2 * 512 + g * HD; Vb = a.Z + OFF_KV + 3 * 512 + g * HD; ldk = LDZ; }
    int j0, j1;
    if (MODE == MODE_CMP) { j0 = 0; j1 = (((t0 + 127 - 31) >> 4) >> 6) + 1; }
    else if (MODE == MODE_WIN) { j0 = (t0 - 511) > 0 ? ((t0 - 511) >> 6) : 0; j1 = ((t0 + 127) >> 6) + 1; }
    else { j0 = 0; j1 = (tlast >> 6) + 1; }
    int klo, khi;
    if (MODE == MODE_CMP) { klo = 0; khi = tq >= 31 ? ((tq - 31) >> 4) : -1; }
    else if (MODE == MODE_WIN) { klo = tq - 511; khi = tq; }
    else { klo = 0; khi = rvalid ? tq : -1; }
    float negBC = -a.TAB[512 + (MODE == MODE_CMP ? 0 : (MODE == MODE_SLC ? 1 : 2))];
    bf16x8 qr[8];
    { const bf16_t* Qw = a.Z + (size_t)tq * LDZ + OFF_Q + hq * HD + hi * 8;
#pragma unroll
      for (int d0 = 0; d0 < 8; ++d0) qr[d0] = *reinterpret_cast<const bf16x8*>(Qw + d0 * 16); }
    f32x16 o[4] = {}; float lsum = 0.f;
    unsigned soK[2], soV[2];
#pragma unroll
    for (int i = 0; i < 2; ++i) { const int p = (wid + 8 * i) * 64 + lane;
        { const int row = p >> 4, c = (p & 15) ^ (row & 7); soK[i] = (unsigned)(row * ldk + c * 8) * 2u; }
        { const int sub = p >> 5, within = p & 31, kk = (sub >> 2) * 8 + (within >> 2), c = (sub & 3) * 32 + (within & 3) * 8, k = (kk & ~0xC) | ((kk & 4) << 1) | ((kk & 8) >> 1);
          soV[i] = (unsigned)(k * ldk + c) * 2u; } }
    const int vb0 = (int)(uintptr_t)(LAS char*)ldsL + 16384 + v_rd_base(lane);
#define ISSUE(jt) do { const int _b = ((jt) - j0) & 3; const char* _kp = (const char*)Kb + (size_t)(jt) * KVBLK * ldk * 2; const char* _vp = (const char*)Vb + (size_t)(jt) * KVBLK * ldk * 2; \
    _Pragma("unroll") for (int _i = 0; _i < 2; ++_i) { \
        __builtin_amdgcn_global_load_lds((const unsigned*)(_kp + soK[_i]), (LAS unsigned*)(ldsL + _b * 32768 + (wid + 8 * _i) * 1024), 16, 0, 0); \
        __builtin_amdgcn_global_load_lds((const unsigned*)(_vp + soV[_i]), (LAS unsigned*)(ldsL + _b * 32768 + 16384 + (wid + 8 * _i) * 1024), 16, 0, 0); } } while (0)
    unsigned bmw = 0u;
    if (MODE == MODE_SLC) bmw = a.BM[((size_t)tq * 4 + g) * 8];
    asm volatile("s_waitcnt lgkmcnt(0)" ::: "memory");
    __builtin_amdgcn_s_barrier();
    asm volatile("" ::: "memory");
    ISSUE(j0);
    asm volatile("s_waitcnt vmcnt(4) lgkmcnt(0)" : "+v"(bmw), "+v"(negBC), "+v"(qr[0]), "+v"(qr[1]), "+v"(qr[2]), "+v"(qr[3]), "+v"(qr[4]), "+v"(qr[5]), "+v"(qr[6]), "+v"(qr[7]) :: "memory");
    if (j0 + 1 < j1) ISSUE(j0 + 1); if (j0 + 2 < j1) ISSUE(j0 + 2);
    for (int j = j0; j < j1; ++j) {
        const int buf = (j - j0) & 3;
        if (j + 2 < j1) asm volatile("s_waitcnt vmcnt(8)" ::: "memory"); else if (j + 1 < j1) asm volatile("s_waitcnt vmcnt(4)" ::: "memory"); else asm volatile("s_waitcnt vmcnt(0)" ::: "memory");
        __builtin_amdgcn_s_barrier();
        asm volatile("" ::: "memory");
        if (j + 3 < j1) ISSUE(j + 3);
        int lhi = khi;
        if (MODE == MODE_SLC) { if (!((bmw >> (j & 31)) & 1u)) lhi = -1; }
        const int kb = j * KVBLK;
        const bool l_any = (kb + 63 >= klo) && (kb <= lhi);
        const bool l_full = (kb >= klo) && (kb + 63 <= lhi);
        if (__any(l_any)) {
            f32x16 p0, p1;
            qkt(p0, p1, lds + buf * 32768, qr, r32, hi);
            const bool uni = __all(l_full || !l_any);
            const float off = (uni && !l_any) ? -1.0e30f : negBC;
#pragma unroll
            for (int r = 0; r < 16; ++r) p0[r] = __builtin_amdgcn_exp2f(fmaf(p0[r], SM_C, off));
            if (!uni) {
#pragma unroll
                for (int r = 0; r < 16; ++r) { const int k0i = kb + crow(r, hi); p0[r] = (k0i >= klo && k0i <= lhi) ? p0[r] : 0.f; } }
            float ps = 0.f;
#pragma unroll
            for (int r = 0; r < 16; ++r) ps += p0[r];
            bf16x8 pa0, pa1, pa2, pa3; pack_half(p0, pa0, pa1);
            pv_half<0, true>(o, vb0 + buf * 32768, pa0, pa1, p1, off);
            if (!uni) {
#pragma unroll
                for (int r = 0; r < 16; ++r) { const int k1i = kb + 32 + crow(r, hi); p1[r] = (k1i >= klo && k1i <= lhi) ? p1[r] : 0.f; } }
#pragma unroll
            for (int r = 0; r < 16; ++r) ps += p1[r];
            lsum += ps;
            pack_half(p1, pa2, pa3);
            pv_half<2, false>(o, vb0 + buf * 32768, pa2, pa3, p1, off);
        }
        if (MODE == MODE_SLC) { if (((j + 1) & 31) == 0 && j + 1 < j1) { bmw = a.BM[((size_t)tq * 4 + g) * 8 + ((j + 1) >> 5)]; asm volatile("s_waitcnt vmcnt(0)" : "+v"(bmw) :: "memory"); } }
    }
#undef ISSUE
    lsum += __shfl_xor(lsum, 32);
    if (hi == 0) li_l[r32] = lsum;
    if (MODE == MODE_CMP) { if (hi == 0) a.L[(size_t)tq * NH + hq] = lsum; }
    asm volatile("s_waitcnt lgkmcnt(0)" ::: "memory");
    float gtv[16]; f32x16 pvv[4];
#pragma unroll
    for (int r = 0; r < 16; ++r) {
        const int orow = crow(r, hi); const float lv = li_l[orow]; const float rl = lv > 0.f ? 1.0f / lv : 0.f;
        const int t = MODE == MODE_SLC ? t0 + wid * 5 + orow / 6 : t0 + wid * 16 + (orow & 15);
        const int h = MODE == MODE_SLC ? g * HPG + orow % 6 : g * HPG + hp * 2 + (orow >> 4);
        const bool valid = !(MODE == MODE_SLC && (orow >= 30 || t >= S_)); const int tc = valid ? t : 0;
        gtv[r] = valid ? a.G[(size_t)tc * NGATE + h * 3 + (MODE == MODE_CMP ? 0 : (MODE == MODE_SLC ? 1 : 2))] * rl : 0.f;
        if (MODE != MODE_CMP) { const float* oa = a.OACC + (size_t)tc * 3072 + h * HD + r32;
#pragma unroll
            for (int d0 = 0; d0 < 4; ++d0) pvv[d0][r] = oa[d0 * 32]; }
    }
#pragma unroll
    for (int r = 0; r < 16; ++r) {
        const int orow = crow(r, hi);
        const int t = MODE == MODE_SLC ? t0 + wid * 5 + orow / 6 : t0 + wid * 16 + (orow & 15);
        const int h = MODE == MODE_SLC ? g * HPG + orow % 6 : g * HPG + hp * 2 + (orow >> 4);
        if (MODE == MODE_SLC && (orow >= 30 || t >= S_)) continue;
        float* oa = a.OACC + (size_t)t * 3072 + h * HD + r32;
#pragma unroll
        for (int d0 = 0; d0 < 4; ++d0) {
            const float v = o[d0][r] * gtv[r];
            if (MODE == MODE_CMP) oa[d0 * 32] = v;
            else if (MODE == MODE_WIN) oa[d0 * 32] = pvv[d0][r] + v;
            else a.MIX[(size_t)t * DM + POOLW + h * HD + d0 * 32 + r32] = (bf16_t)(cvt_pk_bf16(pvv[d0][r] + v, 0.f) & 0xffffu);
        }
    }
}

__device__ __forceinline__ void imp_task(const AttnArgs& a, float* IMPP, float* IMPF, int tqi, int g) {
    const int lane = threadIdx.x & 63, fr = lane & 15, fq = lane >> 4;
    const int t = tqi * 16 + fr;
    const int tmax = tqi * 16 + 15;
    if (tmax < 31) return;
    const int lim = t >= 31 ? ((t - 31) >> 4) : -1;
    const int nstep = ((((tmax - 31) >> 4) >> 6) + 1) * 4;
    const float negBC = -a.TAB[512];
    bf16x8 qf[HPG][4]; float rl[HPG];
#pragma unroll
    for (int h = 0; h < HPG; ++h) {
        const bf16_t* qp = a.Z + (size_t)t * LDZ + OFF_Q + (g * HPG + h) * HD + fq * 8;
#pragma unroll
        for (int ks = 0; ks < 4; ++ks) qf[h][ks] = *reinterpret_cast<const bf16x8*>(qp + ks * 32);
        const float lv = a.L[(size_t)t * NH + g * HPG + h]; rl[h] = lv > 0.f ? 1.0f / lv : 0.f;
    }
    const bf16_t* kbase = a.KC + (size_t)g * 1024 * HD + (size_t)fr * HD + fq * 8;
    bf16x8 kf[4], kn[4];
#pragma unroll
    for (int ks = 0; ks < 4; ++ks) kf[ks] = *reinterpret_cast<const bf16x8*>(kbase + ks * 32);
    float* op = IMPP + ((size_t)t * 4 + g) * 256 + fq; float* of = IMPF + ((size_t)t * 4 + g) * 256 + fq;
    for (int st = 0; st < nstep; ++st) {
        const int sn = (st + 1 < nstep) ? st + 1 : st;
#pragma unroll
        for (int ks = 0; ks < 4; ++ks) kn[ks] = *reinterpret_cast<const bf16x8*>(kbase + (size_t)sn * 16 * HD + ks * 32);
        f32x4 imp4 = {0.f, 0.f, 0.f, 0.f};
        const int n0 = st * 16 + fq * 4;
#pragma unroll
        for (int h = 0; h < HPG; ++h) {
            f32x4 acc = {0.f, 0.f, 0.f, 0.f};
#pragma unroll
            for (int ks = 0; ks < 4; ++ks) acc = __builtin_amdgcn_mfma_f32_16x16x32_bf16(kf[ks], qf[h][ks], acc, 0, 0, 0);
#pragma unroll
            for (int i = 0; i < 4; ++i) { const float e = __builtin_amdgcn_exp2f(fmaf(acc[i], SM_C, negBC)) * rl[h]; imp4[i] += (n0 + i <= lim) ? e : 0.f; }
        }
        op[st * 4] = imp4[0] + 2.0f * (imp4[1] + imp4[2] + imp4[3]);
        of[st * 4] = imp4[0];
#pragma unroll
        for (int ks = 0; ks < 4; ++ks) kf[ks] = kn[ks];
    }
}

__device__ __forceinline__ void topk_load(const float* IMPP, const float* IMPF, int t, int g, f32x4& pp, f32x4& ff) {
    const int lane = threadIdx.x & 63, cur = t >> 6, jb = lane * 4;
    pp = (f32x4){0.f, 0.f, 0.f, 0.f}; ff = pp;
    if (cur > 15 && jb <= cur) { const size_t base = ((size_t)t * 4 + g) * 256; pp = *(const f32x4*)(IMPP + base + jb); ff = *(const f32x4*)(IMPF + base + jb); }
}
__device__ __forceinline__ void topk_task(const f32x4 pp, const f32x4 ff, unsigned* BM, int t, int g) {
    const int lane = threadIdx.x & 63;
    const int cur = t >> 6;
    unsigned nib = 0u;
    if (cur <= 15) { const int jb = lane * 4;
#pragma unroll
        for (int c = 0; c < 4; ++c) if (jb + c <= cur) nib |= 1u << c; }
    else {
        const int jb = lane * 4;
        unsigned key[4];
        {
            float fnext = __shfl_down(ff[0], 1);
            if (lane == 63) fnext = 0.f;
            const float v0 = pp[0] + ff[1], v1 = pp[1] + ff[2], v2 = pp[2] + ff[3], v3 = pp[3] + fnext;
            key[0] = (jb + 0 >= 1 && jb + 0 <= cur - 2) ? __float_as_uint(fmaxf(v0, 0.f)) + 1u : 0u;
            key[1] = (jb + 1 >= 1 && jb + 1 <= cur - 2) ? __float_as_uint(fmaxf(v1, 0.f)) + 1u : 0u;
            key[2] = (jb + 2 >= 1 && jb + 2 <= cur - 2) ? __float_as_uint(fmaxf(v2, 0.f)) + 1u : 0u;
            key[3] = (jb + 3 >= 1 && jb + 3 <= cur - 2) ? __float_as_uint(fmaxf(v3, 0.f)) + 1u : 0u;
        }
        unsigned prefix = 0u; bool exact = false;
        for (int b = 30; b >= 0; --b) {
            const unsigned trial = prefix | (1u << b);
            const int cnt = __popcll(__ballot(key[0] >= trial)) + __popcll(__ballot(key[1] >= trial)) + __popcll(__ballot(key[2] >= trial)) + __popcll(__ballot(key[3] >= trial));
            if (cnt >= 13) { prefix = trial; if (cnt == 13) { exact = true; break; } }
        }
#pragma unroll
        for (int c = 0; c < 4; ++c) if (exact ? (key[c] >= prefix) : (key[c] > prefix)) nib |= 1u << c;
        if (!exact) {
            int need = 13 - (__popcll(__ballot(key[0] > prefix)) + __popcll(__ballot(key[1] > prefix)) + __popcll(__ballot(key[2] > prefix)) + __popcll(__ballot(key[3] > prefix)));
            unsigned tie = 0u;
#pragma unroll
            for (int c = 0; c < 4; ++c) if (key[c] == prefix) tie |= 1u << c;
            for (int guard = 0; need > 0 && guard < 16; ++guard) {
                const unsigned long long any = __ballot(tie != 0u);
                if (any == 0ull) break;
                const int L = __builtin_ctzll(any);
                if (lane == L) { const unsigned low = tie & (0u - tie); nib |= low; tie ^= low; }
                --need;
            }
        }
        if (lane == 0) nib |= 1u;
        if (lane == (cur >> 2)) nib |= 1u << (cur & 3);
        if (lane == ((cur - 1) >> 2)) nib |= 1u << ((cur - 1) & 3);
    }
    unsigned x = nib << (4 * (lane & 7));
    x |= __shfl_xor(x, 1); x |= __shfl_xor(x, 2); x |= __shfl_xor(x, 4);
    if ((lane & 7) == 0) BM[((size_t)t * 4 + g) * 8 + (lane >> 3)] = x;
}
#undef KSWZ
}

template <bool FFN_REMAP = false>
__device__ __forceinline__ void convT(const float* __restrict__ src0, int K, int N, bf16_t* __restrict__ dst, int ldd, LAS float* tile, int bid, int nb, int Nfull = 0, int n0 = 0) {
    const float* __restrict__ src = src0 + n0; if (Nfull == 0) Nfull = N;
    const int tid = threadIdx.x, tk = K >> 6, tn = (N + 63) >> 6, total = tk * tn;
    const int r = tid >> 4, c4 = (tid & 15) * 4;
    f32x4 v[2] = {{0.f, 0.f, 0.f, 0.f}, {0.f, 0.f, 0.f, 0.f}}, vn[2];
    if (bid < total) { const int nti = bid % tn, kti = bid / tn, ng = nti * 64 + c4;
#pragma unroll
        for (int h = 0; h < 2; ++h) if (ng < N) v[h] = *(const f32x4*)(src + (size_t)(kti * 64 + r + h * 32) * Nfull + ng); }
    for (int idx = bid; idx < total; idx += nb) {
        const int nti = idx % tn, kti = idx / tn;
#pragma unroll
        for (int h = 0; h < 2; ++h) { LAS float* tp = tile + (r + h * 32) * 65 + c4; tp[0] = v[h][0]; tp[1] = v[h][1]; tp[2] = v[h][2]; tp[3] = v[h][3]; }
        {
            const int nx = idx + nb; vn[0] = (f32x4){0.f, 0.f, 0.f, 0.f}; vn[1] = vn[0];
            if (nx < total) { const int nti2 = nx % tn, kti2 = nx / tn, ng2 = nti2 * 64 + c4;
#pragma unroll
                for (int h = 0; h < 2; ++h) if (ng2 < N) vn[h] = *(const f32x4*)(src + (size_t)(kti2 * 64 + r + h * 32) * Nfull + ng2); } }
        __syncthreads();
        const int n = tid >> 3, k8 = (tid & 7) * 8, ngl = nti * 64 + n;
        float e[8];
#pragma unroll
        for (int i = 0; i < 8; ++i) e[i] = tile[(k8 + i) * 65 + n];
        if (ngl < N) { u32x4 w; w.x = cvt_pk_bf16(e[0], e[1]); w.y = cvt_pk_bf16(e[2], e[3]); w.z = cvt_pk_bf16(e[4], e[5]); w.w = cvt_pk_bf16(e[6], e[7]);
            int drow = ngl; if (FFN_REMAP) { const int up = ngl >= DFF ? 1 : 0, f = ngl - up * DFF; drow = (f >> 7) * 256 + up * 128 + (f & 127); }
            *(u32x4*)(dst + (size_t)drow * ldd + kti * 64 + k8) = w; }
        __syncthreads();
        v[0] = vn[0]; v[1] = vn[1];
    }
}
__device__ __forceinline__ void convT8(const float* __restrict__ src0, int K, int N, unsigned char* __restrict__ dst, int ldd, float scale, LAS float* tile, int bid, int nb, int Nfull = 0, int n0 = 0) {
    const float* __restrict__ src = src0 + n0; if (Nfull == 0) Nfull = N;
    const int tid = threadIdx.x, tk = K >> 6, tn = (N + 63) >> 6, total = tk * tn;
    const int r = tid >> 4, c4 = (tid & 15) * 4;
    f32x4 v[2] = {{0.f, 0.f, 0.f, 0.f}, {0.f, 0.f, 0.f, 0.f}}, vn[2];
    if (bid < total) { const int nti = bid % tn, kti = bid / tn, ng = nti * 64 + c4;
#pragma unroll
        for (int h = 0; h < 2; ++h) if (ng < N) v[h] = *(const f32x4*)(src + (size_t)(kti * 64 + r + h * 32) * Nfull + ng); }
    for (int idx = bid; idx < total; idx += nb) {
        const int nti = idx % tn, kti = idx / tn;
#pragma unroll
        for (int h = 0; h < 2; ++h) { LAS float* tp = tile + (r + h * 32) * 65 + c4; tp[0] = v[h][0]; tp[1] = v[h][1]; tp[2] = v[h][2]; tp[3] = v[h][3]; }
        { const int nx = idx + nb; vn[0] = (f32x4){0.f, 0.f, 0.f, 0.f}; vn[1] = vn[0];
            if (nx < total) { const int nti2 = nx % tn, kti2 = nx / tn, ng2 = nti2 * 64 + c4;
#pragma unroll
                for (int h = 0; h < 2; ++h) if (ng2 < N) vn[h] = *(const f32x4*)(src + (size_t)(kti2 * 64 + r + h * 32) * Nfull + ng2); } }
        __syncthreads();
        const int n = tid >> 3, k8 = (tid & 7) * 8, ngl = nti * 64 + n;
        float e[8];
#pragma unroll
        for (int i = 0; i < 8; ++i) e[i] = tile[(k8 + i) * 65 + n] * scale;
        if (ngl < N) { int p0 = __builtin_amdgcn_cvt_pk_fp8_f32(e[0], e[1], 0, false); p0 = __builtin_amdgcn_cvt_pk_fp8_f32(e[2], e[3], p0, true);
            int p1 = __builtin_amdgcn_cvt_pk_fp8_f32(e[4], e[5], 0, false); p1 = __builtin_amdgcn_cvt_pk_fp8_f32(e[6], e[7], p1, true);
            *(u32x2*)(dst + (size_t)ngl * ldd + kti * 64 + k8) = (u32x2){(unsigned)p0, (unsigned)p1}; }
        __syncthreads();
        v[0] = vn[0]; v[1] = vn[1];
    }
}
__device__ __forceinline__ void rmsnorm_rows(const float* __restrict__ src, const float* __restrict__ w, bf16_t* __restrict__ dst, int rows, int gw, int nw, unsigned char* __restrict__ dst8 = nullptr) {
    const int lane = threadIdx.x & 63;
    f32x4 v[16], vn[16];
    if (gw < rows) { const f32x4* sp = (const f32x4*)(src + (size_t)gw * DM);
#pragma unroll
        for (int i = 0; i < 16; ++i) v[i] = sp[lane + 64 * i]; }
    for (int row = gw; row < rows; row += nw) {
        const int nr = row + nw < rows ? row + nw : row;
        { const f32x4* sp = (const f32x4*)(src + (size_t)nr * DM);
#pragma unroll
          for (int i = 0; i < 16; ++i) vn[i] = sp[lane + 64 * i]; }
        float ss = 0.f;
#pragma unroll
        for (int i = 0; i < 16; ++i) ss += v[i][0] * v[i][0] + v[i][1] * v[i][1] + v[i][2] * v[i][2] + v[i][3] * v[i][3];
        ss = wave_sum(ss);
        const float rstd = rsqrtf(ss * (1.0f / DM) + EPS);
#pragma unroll
        for (int i = 0; i < 16; ++i) { const f32x4 ww = ((const f32x4*)w)[lane + 64 * i];
            u32x2 o; o.x = cvt_pk_bf16(v[i][0] * rstd * ww[0], v[i][1] * rstd * ww[1]); o.y = cvt_pk_bf16(v[i][2] * rstd * ww[2], v[i][3] * rstd * ww[3]);
            *(u32x2*)(dst + (size_t)row * DM + (lane + 64 * i) * 4) = o;
            if (dst8) { int pk = __builtin_amdgcn_cvt_pk_fp8_f32(v[i][0] * rstd * ww[0], v[i][1] * rstd * ww[1], 0, false); pk = __builtin_amdgcn_cvt_pk_fp8_f32(v[i][2] * rstd * ww[2], v[i][3] * rstd * ww[3], pk, true);
                *(int*)(dst8 + (size_t)row * DM + (lane + 64 * i) * 4) = pk; } }
#pragma unroll
        for (int i = 0; i < 16; ++i) v[i] = vn[i];
    }
}

struct Ptrs {
    bf16_t *Win, *Wo, *Wfi, *Wfo, *Wg, *Wple, *Wpool, *Wc1k, *Wc1v, *XN, *PB, *Z, *M, *KC, *VC, *MIX, *ACT, *ERAW;
    float *COS, *SIN, *TAB, *G, *H1, *L, *OACC, *IMPP, *IMPF, *ERSTD; unsigned* BM;
};

__device__ __forceinline__ void phase_prologue(const Params& P, const Ptrs& W, LAS unsigned char* lds) {
    const int bid = blockIdx.x, nb = gridDim.x, tid = threadIdx.x, lane = tid & 63, wv = tid >> 6;
    const int gw = bid * NWAVES + wv, nw = nb * NWAVES; const size_t gt = (size_t)bid * NTHREADS + tid, ntot = (size_t)nb * NTHREADS;
    LAS float* tile = (LAS float*)lds;
    rmsnorm_rows(P.x, P.norm1_w, W.XN, S_, gw, nw, P.ws + WS_XN8);
    convT(P.w_in, DM, POOLW, W.Win, DM, tile, bid, nb, INW, 0);
    convT(P.w_in, DM, INW - OFF_G, W.Win + (size_t)OFF_G * DM, DM, tile, bid, nb, INW, OFF_G);
    convT8(P.w_in, DM, OFF_G - POOLW, P.ws + WS_WIN8, DM, WG8_SCALE, tile, bid, nb, INW, POOLW);
    for (size_t i = gt; i < (size_t)(LDZ - INW) * DM / 8; i += ntot) *(u32x4*)(W.Win + (size_t)INW * DM + i * 8) = (u32x4){0u, 0u, 0u, 0u};
    convT(P.w_o, DM, DM, W.Wo, DM, tile, bid, nb);
    convT<true>(P.w_ffn_in, DM, NFI, W.Wfi, DM, tile, bid, nb);
    for (size_t i = gt; i < (size_t)2 * DM / 8; i += ntot) *(u32x4*)(W.XN - 2 * DM + i * 8) = (u32x4){0u, 0u, 0u, 0u};
    convT(P.w_ffn_out, DFF, DM, W.Wfo, DFF, tile, bid, nb);
    convT8(P.w_ple_gate, DM, DM, (unsigned char*)W.Wg, DM, WG8_SCALE, tile, bid, nb);
    convT(P.w_ple_proj, PLE, DM, W.Wple, PLE, tile, bid, nb);
    for (int g = 0; g < 4; ++g) convT(P.w_pool + (size_t)g * 65536, 256, 256, W.Wpool + (size_t)g * 65536, 256, tile, bid, nb);
    convT(P.cmp_k_w1, 4096, 256, W.Wc1k, 4096, tile, bid, nb);
    convT(P.cmp_v_w1, 4096, 256, W.Wc1v, 4096, tile, bid, nb);
    for (size_t i = gt; i < (size_t)S_ * PLE / 8; i += ntot) { const f32x4 a = *(const f32x4*)(P.p + i * 8), b = *(const f32x4*)(P.p + i * 8 + 4);
        u32x4 w; w.x = cvt_pk_bf16(a[0], a[1]); w.y = cvt_pk_bf16(a[2], a[3]); w.z = cvt_pk_bf16(b[0], b[1]); w.w = cvt_pk_bf16(b[2], b[3]); *(u32x4*)(W.PB + i * 8) = w; }
    for (size_t i = gt; i < (size_t)S_ * 16; i += ntot) { const int t = (int)(i >> 4), fi = (int)(i & 15);
        const float inv = exp2f(-(float)fi * (18.931568569324174f / 16.0f)); const float ang = (float)P.positions[t] * inv;
        const double ad = (double)ang; const double kk = rint(ad * 0.15915494309189535); const float rf = (float)(ad - kk * 6.283185307179586);
        W.COS[i] = __cosf(rf); W.SIN[i] = __sinf(rf); }
    for (int o = gw; o < 512; o += nw) { const int which = o >> 8, j = o & 255; const float* pe = which ? P.cmp_pos_v : P.cmp_pos_k; const float* w1 = which ? P.cmp_v_w1 : P.cmp_k_w1;
        float s = 0.f; for (int r = lane; r < 4096; r += 64) s += pe[r] * w1[(size_t)r * 256 + j];
        s = wave_sum(s); if (lane == 0) W.TAB[o] = s; }
    if (gw == 0) { float mq = fmaxf(fabsf(P.q_norm_w[lane]), fabsf(P.q_norm_w[lane + 64])); mq = wave_max(mq);
        float mc = wave_max(fmaxf(fabsf(P.k_norm_cmp_w[lane]), fabsf(P.k_norm_cmp_w[lane + 64])));
        float ms = wave_max(fmaxf(fabsf(P.k_norm_slc_w[lane]), fabsf(P.k_norm_slc_w[lane + 64])));
        float mw = wave_max(fmaxf(fabsf(P.k_norm_win_w[lane]), fabsf(P.k_norm_win_w[lane + 64])));
        const float c = 11.313708498984761f * 1.4426950408889634f * mq * 1.01f;
        if (lane == 0) { W.TAB[512] = c * mc; W.TAB[513] = c * ms; W.TAB[514] = c * mw; } }
}

__device__ __forceinline__ void phase_postz(const Params& P, const Ptrs& W, int gw, int nw) {
    const int tid = threadIdx.x, lane = tid & 63;
    const f32x2 wq = *(const f32x2*)(P.q_norm_w + 2 * lane), wks = *(const f32x2*)(P.k_norm_slc_w + 2 * lane), wkw = *(const f32x2*)(P.k_norm_win_w + 2 * lane);
    for (int t = gw; t < S_; t += nw) {
        bf16_t* zr = W.Z + (size_t)t * LDZ;
        float cs0 = 0.f, cs1 = 0.f, sn0 = 0.f, sn1 = 0.f;
        if (lane < 16) { const int i0 = (2 * lane) & 15; cs0 = W.COS[t * 16 + i0]; cs1 = W.COS[t * 16 + i0 + 1]; sn0 = W.SIN[t * 16 + i0]; sn1 = W.SIN[t * 16 + i0 + 1]; }
        unsigned uv[32];
#pragma unroll
        for (int v = 0; v < 32; ++v) { const int col = v < 24 ? OFF_Q + v * HD : (v < 28 ? OFF_KV + 2 * 512 + (v - 24) * HD : OFF_KV + 4 * 512 + (v - 28) * HD);
            uv[v] = *((const unsigned*)(zr + col) + lane); }
#pragma unroll
        for (int v = 0; v < 32; ++v) {
            const f32x2 ww = v < 24 ? wq : (v < 28 ? wks : wkw);
            const unsigned u = uv[v]; const float x0 = bf_lo(u), x1 = bf_hi(u);
            const float ss = wave_sum(x0 * x0 + x1 * x1);
            const float rstd = rsqrtf(ss * (1.0f / HD) + EPS);
            float y0 = x0 * rstd * ww[0], y1 = x1 * rstd * ww[1];
            const float p0 = __shfl_xor(y0, 8), p1 = __shfl_xor(y1, 8);
            if (lane < 8) { y0 = y0 * cs0 - p0 * sn0; y1 = y1 * cs1 - p1 * sn1; }
            else if (lane < 16) { y0 = y0 * cs0 + p0 * sn0; y1 = y1 * cs1 + p1 * sn1; }
            uv[v] = cvt_pk_bf16(y0, y1);
        }
        {
            const int gi = lane >> 4, wlen = 2 << gi, c0 = lane * 16; const int cnt = (t + 1) < wlen ? (t + 1) : wlen;
            float s[16];
#pragma unroll
            for (int i = 0; i < 16; ++i) s[i] = 0.f;
            float cur[16];
            for (int i = 0; i < cnt; ++i) { const u32x4 a = *(const u32x4*)(W.Z + (size_t)(t - i) * LDZ + c0), b = *(const u32x4*)(W.Z + (size_t)(t - i) * LDZ + c0 + 8);
                const float e[16] = {bf_lo(a.x), bf_hi(a.x), bf_lo(a.y), bf_hi(a.y), bf_lo(a.z), bf_hi(a.z), bf_lo(a.w), bf_hi(a.w), bf_lo(b.x), bf_hi(b.x), bf_lo(b.y), bf_hi(b.y), bf_lo(b.z), bf_hi(b.z), bf_lo(b.w), bf_hi(b.w)};
#pragma unroll
                for (int q = 0; q < 16; ++q) { s[q] += e[q]; if (i == 0) cur[q] = e[q]; } }
            const float rc = 1.0f / (float)cnt;
            u32x4 o0, o1;
            o0.x = cvt_pk_bf16(s[0] * rc - cur[0], s[1] * rc - cur[1]); o0.y = cvt_pk_bf16(s[2] * rc - cur[2], s[3] * rc - cur[3]);
            o0.z = cvt_pk_bf16(s[4] * rc - cur[4], s[5] * rc - cur[5]); o0.w = cvt_pk_bf16(s[6] * rc - cur[6], s[7] * rc - cur[7]);
            o1.x = cvt_pk_bf16(s[8] * rc - cur[8], s[9] * rc - cur[9]); o1.y = cvt_pk_bf16(s[10] * rc - cur[10], s[11] * rc - cur[11]);
            o1.z = cvt_pk_bf16(s[12] * rc - cur[12], s[13] * rc - cur[13]); o1.w = cvt_pk_bf16(s[14] * rc - cur[14], s[15] * rc - cur[15]);
            *(u32x4*)(W.M + (size_t)t * POOLW + c0) = o0; *(u32x4*)(W.M + (size_t)t * POOLW + c0 + 8) = o1;
        }
#pragma unroll
        for (int v = 0; v < 32; ++v) { const int col = v < 24 ? OFF_Q + v * HD : (v < 28 ? OFF_KV + 2 * 512 + (v - 24) * HD : OFF_KV + 4 * 512 + (v - 28) * HD);
            *((unsigned*)(zr + col) + lane) = uv[v]; }

    }
}

__device__ __forceinline__ void phase_cmpfin(const Params& P, const Ptrs& W) {
    const int tid = threadIdx.x, lane = tid & 63, gw = blockIdx.x * NWAVES + (tid >> 6), nw = gridDim.x * NWAVES;
    const f32x2 wk = *(const f32x2*)(P.k_norm_cmp_w + 2 * lane);
    for (int task = gw; task < 8192; task += nw) {
        const int tk = __builtin_amdgcn_readfirstlane(task);
        const int which = tk >> 12, g = (tk >> 10) & 3, n = tk & 1023;
        bf16_t* dst = (which ? W.VC : W.KC) + ((size_t)g * 1024 + n) * HD;
        if (n == 1023) { ((unsigned*)dst)[lane] = 0u; continue; }
        const float* h = W.H1 + (size_t)tk * 256; const float* w2 = which ? P.cmp_v_w2 : P.cmp_k_w2;
        float a0 = 0.f, a1 = 0.f;
        for (int j = 0; j < 256; ++j) { const float hj = h[j]; const f32x2 wv = *(const f32x2*)(w2 + j * HD + 2 * lane); a0 += hj * wv[0]; a1 += hj * wv[1]; }
        if (which == 0) {
            const float ss = wave_sum(a0 * a0 + a1 * a1); const float rstd = rsqrtf(ss * (1.0f / HD) + EPS);
            a0 = a0 * rstd * wk[0]; a1 = a1 * rstd * wk[1];
            const int tp = 16 * n + 31; const float p0 = __shfl_xor(a0, 8), p1 = __shfl_xor(a1, 8);
            if (lane < 16) { const int i0 = (2 * lane) & 15; const float cs0 = W.COS[tp * 16 + i0], cs1 = W.COS[tp * 16 + i0 + 1], sn0 = W.SIN[tp * 16 + i0], sn1 = W.SIN[tp * 16 + i0 + 1];
                if (lane < 8) { a0 = a0 * cs0 - p0 * sn0; a1 = a1 * cs1 - p1 * sn1; } else { a0 = a0 * cs0 + p0 * sn0; a1 = a1 * cs1 + p1 * sn1; } }
        }
        ((unsigned*)dst)[lane] = cvt_pk_bf16(a0, a1);
    }
}

__device__ __forceinline__ void phase_erstd(const Ptrs& W) {
    const int tid = threadIdx.x, lane = tid & 63, gw = blockIdx.x * NWAVES + (tid >> 6), nw = gridDim.x * NWAVES;
    u32x4 a[8], an[8];
    if (gw < S_) { const u32x4* sp = (const u32x4*)(W.ERAW + (size_t)gw * DM);
#pragma unroll
        for (int i = 0; i < 8; ++i) a[i] = sp[lane + 64 * i]; }
    for (int row = gw; row < S_; row += nw) {
        const int nr = row + nw < S_ ? row + nw : row;
        { const u32x4* sp = (const u32x4*)(W.ERAW + (size_t)nr * DM);
#pragma unroll
          for (int i = 0; i < 8; ++i) an[i] = sp[lane + 64 * i]; }
        float ss = 0.f;
#pragma unroll
        for (int i = 0; i < 8; ++i) {
            const float e0 = bf_lo(a[i].x), e1 = bf_hi(a[i].x), e2 = bf_lo(a[i].y), e3 = bf_hi(a[i].y), e4 = bf_lo(a[i].z), e5 = bf_hi(a[i].z), e6 = bf_lo(a[i].w), e7 = bf_hi(a[i].w);
            ss += e0 * e0 + e1 * e1 + e2 * e2 + e3 * e3 + e4 * e4 + e5 * e5 + e6 * e6 + e7 * e7; }
        ss = wave_sum(ss);
        if (lane == 0) W.ERSTD[row] = rsqrtf(ss * (1.0f / DM) + EPS);
#pragma unroll
        for (int i = 0; i < 8; ++i) a[i] = an[i];
    }
}

constexpr int N_PHASES = 11;
__device__ __forceinline__ Params kargs() {
#if defined(__HIP_DEVICE_COMPILE__)
    unsigned long long p = (unsigned long long)__builtin_amdgcn_kernarg_segment_ptr();
    asm volatile("" : "+s"(p));
    return *(const __attribute__((address_space(4))) Params*)p;
#else
    return Params{};
#endif
}
__device__ __forceinline__ Ptrs mkptrs(unsigned char* ws) {
    Ptrs W;
    W.Win = (bf16_t*)(ws + WS_WIN); W.Wo = (bf16_t*)(ws + WS_WO); W.Wfi = (bf16_t*)(ws + WS_WFI); W.Wfo = (bf16_t*)(ws + WS_WFO); W.Wg = (bf16_t*)(ws + WS_WG);
    W.Wple = (bf16_t*)(ws + WS_WPLE); W.Wpool = (bf16_t*)(ws + WS_WPOOL); W.Wc1k = (bf16_t*)(ws + WS_WC1K); W.Wc1v = (bf16_t*)(ws + WS_WC1V);
    W.XN = (bf16_t*)(ws + WS_XN); W.PB = (bf16_t*)(ws + WS_PB); W.Z = (bf16_t*)(ws + WS_Z); W.M = (bf16_t*)(ws + WS_M); W.KC = (bf16_t*)(ws + WS_KC); W.VC = (bf16_t*)(ws + WS_VC);
    W.MIX = (bf16_t*)(ws + WS_MIX); W.ACT = (bf16_t*)(ws + WS_ACT); W.ERAW = (bf16_t*)(ws + WS_ERAW);
    W.COS = (float*)(ws + WS_COS); W.SIN = (float*)(ws + WS_SIN); W.TAB = (float*)(ws + WS_TAB); W.G = (float*)(ws + WS_G); W.H1 = (float*)(ws + WS_H1); W.L = (float*)(ws + WS_L);
    W.OACC = (float*)(ws + WS_OACC); W.IMPP = (float*)(ws + WS_IMPP); W.IMPF = (float*)(ws + WS_IMPF); W.ERSTD = (float*)(ws + WS_ERSTD); W.BM = (unsigned*)(ws + WS_BM);
    return W;
}
__global__ void __launch_bounds__(NTHREADS, 2) fwd(Params Punused) {
    extern __shared__ __attribute__((aligned(16))) unsigned char lds_raw[];
    LAS unsigned char* lds = (LAS unsigned char*)lds_raw;
    const int tid = threadIdx.x;
    const int G = gridDim.x, bid = blockIdx.x;
    const int gw = bid * NWAVES + (tid >> 6), nw = G * NWAVES;

    if (tid < 16) ((LAS unsigned*)(lds + LDS_MISC))[tid] = 0u;
    __syncthreads();
    int lo, hi; XcdBarrier bar;
    { const Params P = kargs(); lo = P.ph_lo; hi = P.ph_hi;
      bar.bar = (unsigned*)(P.ws + WS_CTL); bar.x = 0; bar.st = (volatile LAS unsigned*)(lds + LDS_MISC);
      if (hi - lo > 1) bar = xcd_barrier_post((unsigned*)(P.ws + WS_CTL), (volatile LAS unsigned*)(lds + LDS_MISC)); }
#ifdef PH_MASK
#define IN(k) (((PH_MASK >> (k)) & 1) && lo <= (k) && (k) < hi)
#else
#define IN(k) (lo <= (k) && (k) < hi)
#endif
#define SEAM(k) do { if (IN(k) && IN((k) + 1)) xcd_barrier(bar); } while (0)
#define PHASE_VARS const Params P = kargs(); const Ptrs W = mkptrs(P.ws); (void)W;
#define ATT_ARGS att::AttnArgs AA{W.Z, W.KC, W.VC, W.G, W.L, W.OACC, W.MIX, W.BM, W.TAB};

    if (IN(0)) { PHASE_VARS REP(0) { phase_prologue(P, W, lds); } SEAM(0); }
    if (IN(1)) {
        PHASE_VARS
        { pg8::GStd g{(const char*)W.XN, (const char*)W.Win, DM, DM, DM / 64}; pg8::StaticOrder S; S.init(S_ / 256, POOLW / 256, G, bid);
          pg8::EpiBf16 E{W.Z, LDZ}; pg8::gemm_phase(lds, g, S, E); }
        { pg8::GStd g{(const char*)(P.ws + WS_XN8), (const char*)(P.ws + WS_WIN8), DM / 2, DM / 2, DM / 128}; pg8::StaticOrder S; S.init(S_ / 256, (OFF_G - POOLW) / 256, G, bid);
          pg8::EpiBf16S E{W.Z + POOLW, LDZ, 1.0f / WG8_SCALE}; pg8::gemm_phase<pg8::GStd, pg8::EpiBf16S, true>(lds, g, S, E); }
        SEAM(1);
    }
    if (IN(2)) {
        PHASE_VARS
        if (G > 64) {
            if (bid < 32) { pg8::GCmp g{(const char*)W.Z, (const char*)W.Wc1k, (const char*)W.Wc1v, 16 * LDZ, 4096, 64}; pg8::StaticOrder S; S.init(32, 1, 32, bid);
                pg8::EpiCmpGelu E{W.H1, W.TAB}; pg8::gemm_phase(lds, g, S, E); }
            else if (bid < 96) {
                pg8::GStd g{(const char*)W.XN, (const char*)(W.Win + (size_t)OFF_G * DM), DM, DM, DM / 64}; pg8::StaticOrder S; S.init(S_ / 256, 1, 64, bid - 32);
                pg8::EpiBf16 E{W.Z + OFF_G, LDZ}; pg8::gemm_phase(lds, g, S, E); }
            else phase_postz(P, W, (bid - 96) * NWAVES + (tid >> 6), (G - 96) * NWAVES);
        } else {
            { pg8::GStd g{(const char*)W.XN, (const char*)(W.Win + (size_t)OFF_G * DM), DM, DM, DM / 64}; pg8::StaticOrder S; S.init(S_ / 256, 1, G, bid);
              pg8::EpiBf16 E{W.Z + OFF_G, LDZ}; pg8::gemm_phase(lds, g, S, E); }
            { pg8::GCmp g{(const char*)W.Z, (const char*)W.Wc1k, (const char*)W.Wc1v, 16 * LDZ, 4096, 64}; pg8::StaticOrder S; S.init(32, 1, G, bid);
              pg8::EpiCmpGelu E{W.H1, W.TAB}; pg8::gemm_phase(lds, g, S, E); }
            phase_postz(P, W, gw, nw);
        }
        SEAM(2);
    }
    if (IN(3)) {
        PHASE_VARS
        for (size_t i = (size_t)bid * NTHREADS + tid; i < (size_t)S_ * NGATE; i += (size_t)G * NTHREADS) { const int t = (int)(i / NGATE), c = (int)(i % NGATE); W.G[i] = sigmoidf_(bf2f(W.Z[(size_t)t * LDZ + OFF_G + c])); }
        phase_cmpfin(P, W);
        { pg8::GPool g{(const char*)W.M, (const char*)W.Wpool, POOLW, 256, 4}; pg8::StaticOrder S; S.init(S_ / 256, 4, G, bid);
          pg8::EpiBf16Scale E{W.MIX, DM, P.pool_scale}; pg8::gemm_phase(lds, g, S, E); }
        SEAM(3);
    }
    if (IN(4)) {
        PHASE_VARS ATT_ARGS
        REP(4)
        for (int base = 0, rnd = 0; base < 1536; base += G, ++rnd) {
            int qt, g, hp;
            if (G == 256) { const int x = bid & 7, r = bid >> 3, qp = (rnd / 3) ? 63 - r : r; if (rnd >= 6) break; g = x & 3; qt = 2 * qp + (x >> 2); hp = rnd % 3; }
            else { const int Lu = base + ((rnd & 1) ? G - 1 - bid : bid); if (Lu >= 1536) continue; qt = Lu / 12; const int rem = Lu % 12; g = rem / 3; hp = rem % 3; }
            att::attn_unit<att::MODE_CMP>(AA, (LAS char*)lds, qt, g, hp);
            asm volatile("s_waitcnt vmcnt(0)" ::: "memory");
            att::attn_unit<att::MODE_WIN>(AA, (LAS char*)lds, qt, g, hp); }
        SEAM(4);
    }
    if (IN(5)) {
        PHASE_VARS ATT_ARGS
        for (int k = gw, r = 0; k < 4096; k += nw, ++r) { const int hiT = (r + 1) * nw < 4096 ? (r + 1) * nw : 4096;
            const int task = (r & 1) ? hiT - 1 - (k - r * nw) : k;
            att::imp_task(AA, W.IMPP, W.IMPF, task >> 2, task & 3);
            asm volatile("s_waitcnt vmcnt(0)" ::: "memory");
            { const int tb = (task >> 2) * 16, gg = task & 3; f32x4 pp, ff, pn, fn;
              att::topk_load(W.IMPP, W.IMPF, tb, gg, pp, ff);
              for (int q = 0; q < 16; ++q) { att::topk_load(W.IMPP, W.IMPF, tb + (q < 15 ? q + 1 : q), gg, pn, fn); att::topk_task(pp, ff, W.BM, tb + q, gg); pp = pn; ff = fn; } } }
        SEAM(5);
    }
    if (IN(6)) {
        PHASE_VARS ATT_ARGS
        REP(6)
        for (int base = 0, rnd = 0; base < 1640 + G; base += G, ++rnd) {
            int ut, g;
            if (G == 256) { const int x = bid & 7, r = bid >> 3, k = rnd * 32 + ((rnd & 1) ? 31 - r : r); if (k >= 205) break; g = x & 3; ut = 409 - (2 * k + (x >> 2)); }
            else { const int Lu = base + ((rnd & 1) ? G - 1 - bid : bid); if (Lu >= 1640) continue; ut = 409 - Lu / 4; g = Lu % 4; }
            att::attn_unit<att::MODE_SLC>(AA, (LAS char*)lds, ut, g, 0); }
        SEAM(6);
    }
    if (IN(7)) {
        PHASE_VARS
        { pg8::GStd g{(const char*)W.MIX, (const char*)W.Wo, DM, DM, DM / 64}; pg8::StaticOrder S; S.init(S_ / 256, DM / 256, G, bid);
          pg8::EpiResNorm E{P.x, P.out, W.XN, P.norm2_w, (float*)(P.ws + WS_SSQ1), DM}; pg8::gemm_phase(lds, g, S, E); }
        { pg8::GStd g{(const char*)W.PB, (const char*)W.Wple, PLE, PLE, PLE / 64}; pg8::StaticOrder S; S.init(S_ / 256, DM / 256, G, bid);
          pg8::EpiBf16Ssq E{W.ERAW, DM, (float*)(P.ws + WS_SSQ3)}; pg8::gemm_phase(lds, g, S, E); }
        SEAM(7);
    }
    if (IN(8)) {
        PHASE_VARS
        pg8::GFfn g{(const char*)W.XN, (const char*)W.Wfi, DM, DM, DM / 64}; pg8::StaticOrder S; S.init(65, DFF / 128, G, bid);
        pg8::EpiFfn E{W.ACT, P.conv_w, P.conv_b, (LAS float*)(lds + LDS_XCH), (const float*)(P.ws + WS_SSQ1)}; REP(8) { pg8::gemm_phase(lds, g, S, E); } SEAM(8);
    }
    if (IN(9)) {
        PHASE_VARS
        pg8::GStd g{(const char*)W.ACT, (const char*)W.Wfo, DFF, DFF, DFF / 64}; pg8::StaticOrder S; S.init(S_ / 256, DM / 256, G, bid);
        pg8::EpiResNormF8 E{P.out, P.out, W.XN, P.ple_gate_norm_w, (float*)(P.ws + WS_SSQ2), DM}; pg8::gemm_phase(lds, g, S, E); SEAM(9);
    }
    if (IN(10)) {
        PHASE_VARS
        pg8::GStd g{(const char*)W.XN, (const char*)W.Wg, DM / 2, DM / 2, DM / 128}; pg8::StaticOrder S; S.init(S_ / 256, DM / 256, G, bid);
        pg8::EpiGate E{P.out, W.ERAW, (const float*)(P.ws + WS_SSQ3), P.ple_norm_w, (const float*)(P.ws + WS_SSQ2), DM, 1.0f / WG8_SCALE};
        pg8::gemm_phase<pg8::GStd, pg8::EpiGate, true>(lds, g, S, E);
    }
#undef IN
#undef SEAM
}

extern "C" void kernel_launch(void* const* d_in, const int* in_sizes, int n_in, void* d_out, int out_size, void* d_ws, size_t ws_size, hipStream_t stream) {
    static int grid = 0;
    if (grid == 0) {
        if (n_in != 27 || in_sizes[0] != S_ * DM || out_size != S_ * DM || ws_size < WS_NEED) {
            fprintf(stderr, "kernel_launch: unexpected shapes (n_in %d, in0 %d, out %d, ws %zu < %zu); nothing launched\n", n_in, n_in > 0 ? in_sizes[0] : -1, out_size, ws_size, (size_t)WS_NEED); grid = -1; return; }
        int dev = 0, cus = 0, per_cu = 0;
        if (hipGetDevice(&dev) != hipSuccess || hipDeviceGetAttribute(&cus, hipDeviceAttributeMultiprocessorCount, dev) != hipSuccess) { grid = -1; return; }
        if (hipFuncSetAttribute((const void*)fwd, hipFuncAttributeMaxDynamicSharedMemorySize, LDS_BYTES) != hipSuccess) { fprintf(stderr, "kernel_launch: hipFuncSetAttribute failed\n"); grid = -1; return; }
        if (hipOccupancyMaxActiveBlocksPerMultiprocessor(&per_cu, (const void*)fwd, NTHREADS, LDS_BYTES) != hipSuccess || per_cu < 1) { fprintf(stderr, "kernel_launch: occupancy query says %d\n", per_cu); (void)hipGetLastError(); }
        grid = cus > 256 ? 256 : cus;
    }
    if (grid < 0) return;
    (void)hipMemsetAsync((char*)d_ws + WS_CTL, 0, CTL_BYTES, stream);
    Params P{};
    const float** fp = (const float**)&P;
    P.x = (const float*)d_in[0]; P.p = (const float*)d_in[1]; P.positions = (const int*)d_in[2]; P.norm1_w = (const float*)d_in[3]; P.w_in = (const float*)d_in[4];
    P.w_pool = (const float*)d_in[5]; P.pool_scale = (const float*)d_in[6]; P.q_norm_w = (const float*)d_in[7]; P.k_norm_cmp_w = (const float*)d_in[8];
    P.k_norm_slc_w = (const float*)d_in[9]; P.k_norm_win_w = (const float*)d_in[10]; P.cmp_pos_k = (const float*)d_in[11]; P.cmp_pos_v = (const float*)d_in[12];
    P.cmp_k_w1 = (const float*)d_in[13]; P.cmp_k_w2 = (const float*)d_in[14]; P.cmp_v_w1 = (const float*)d_in[15]; P.cmp_v_w2 = (const float*)d_in[16];
    P.w_o = (const float*)d_in[17]; P.norm2_w = (const float*)d_in[18]; P.w_ffn_in = (const float*)d_in[19]; P.conv_w = (const float*)d_in[20]; P.conv_b = (const float*)d_in[21];
    P.w_ffn_out = (const float*)d_in[22]; P.w_ple_proj = (const float*)d_in[23]; P.ple_norm_w = (const float*)d_in[24]; P.ple_gate_norm_w = (const float*)d_in[25]; P.w_ple_gate = (const float*)d_in[26];
    (void)fp;
    P.out = (float*)d_out; P.ws = (unsigned char*)d_ws;
#if MK_ONE_LAUNCH
    P.ph_lo = 0; P.ph_hi = N_PHASES;
    hipLaunchKernelGGL(fwd, dim3(grid), dim3(NTHREADS), LDS_BYTES, stream, P);
#else
    for (int ph = 0; ph < N_PHASES; ++ph) { P.ph_lo = ph; P.ph_hi = ph + 1; hipLaunchKernelGGL(fwd, dim3(grid), dim3(NTHREADS), LDS_BYTES, stream, P); }
#endif
    const hipError_t le = hipPeekAtLastError();
    if (le != hipSuccess) fprintf(stderr, "kernel_launch: launch failed: %s\n", hipGetErrorName(le));
}
```

```cpp
#include <hip/hip_runtime.h>
#include <cstdio>
#include <cstdint>

#ifndef PROBE_DBL
#define PROBE_DBL 0
#endif
#define REP(k) _Pragma("unroll") for (int rep_ = 0; rep_ < 1 + ((PROBE_DBL >> (k)) & 1); ++rep_)
#ifndef MK_ONE_LAUNCH
#define MK_ONE_LAUNCH 1
#endif

#define LAS __attribute__((address_space(3)))
typedef unsigned short bf16_t;
typedef short bf16x8 __attribute__((ext_vector_type(8)));
typedef short s16x4 __attribute__((ext_vector_type(4)));
typedef float f32x2 __attribute__((ext_vector_type(2)));
typedef float f32x4 __attribute__((ext_vector_type(4)));
typedef float f32x16 __attribute__((ext_vector_type(16)));
typedef unsigned u32x2 __attribute__((ext_vector_type(2)));
typedef unsigned u32x4 __attribute__((ext_vector_type(4)));
typedef int i32x4 __attribute__((ext_vector_type(4)));
typedef int i32x8 __attribute__((ext_vector_type(8)));

constexpr int S_ = 16384, DM = 4096, INW = 7240, LDZ = 7424, POOLW = 1024, NH = 24, NKV = 4, HPG = 6, HD = 128;
constexpr int OFF_Q = 1024, OFF_KV = 4096, OFF_G = 7168, DFF = 11008, NFI = 22016, PLE = 256, NGATE = 72;
constexpr int ZROWS = S_ + 64, XNROWS = S_ + 256, CHUNK = 8192;
constexpr float EPS = 1e-6f;
constexpr float SM_C = 0.08838834764831845f * 1.4426950408889634f;
constexpr int NWAVES = 8, NTHREADS = 512;
constexpr float WG8_SCALE = 128.0f;

constexpr size_t al256(size_t x) { return (x + 255) / 256 * 256; }
constexpr size_t WS_CTL   = 0;
constexpr size_t CTL_BYTES = 262144;
constexpr size_t WS_SSQ1 = WS_CTL + 65536, WS_SSQ2 = WS_CTL + 131072, WS_SSQ3 = WS_CTL + 196608;
constexpr size_t WS_WIN   = WS_CTL + CTL_BYTES;
constexpr size_t WS_WO    = WS_WIN + al256((size_t)LDZ * DM * 2);
constexpr size_t WS_WFI   = WS_WO + al256((size_t)DM * DM * 2);
constexpr size_t WS_WFO   = WS_WFI + al256((size_t)NFI * DM * 2);
constexpr size_t WS_WG    = WS_WFO + al256((size_t)DM * DFF * 2);
constexpr size_t WS_WPLE  = WS_WG + al256((size_t)DM * DM * 2);
constexpr size_t WS_WPOOL = WS_WPLE + al256((size_t)DM * PLE * 2);
constexpr size_t WS_WC1K  = WS_WPOOL + al256((size_t)1024 * 256 * 2);
constexpr size_t WS_WC1V  = WS_WC1K + al256((size_t)256 * 4096 * 2);
constexpr size_t WS_COS   = WS_WC1V + al256((size_t)256 * 4096 * 2);
constexpr size_t WS_SIN   = WS_COS + al256((size_t)S_ * 16 * 4);
constexpr size_t WS_TAB   = WS_SIN + al256((size_t)S_ * 16 * 4);
constexpr size_t WS_XNP   = WS_TAB + 4096;
constexpr size_t WS_XN    = WS_XNP + (size_t)2 * DM * 2;
constexpr size_t WS_PB    = WS_XN + al256((size_t)XNROWS * DM * 2);
constexpr size_t WS_XN8   = WS_PB + al256((size_t)S_ * PLE * 2);
constexpr size_t WS_WIN8  = WS_XN8 + al256((size_t)S_ * DM);
constexpr size_t WS_R     = WS_WIN8 + al256((size_t)(OFF_G - POOLW) * DM);
constexpr size_t WS_Z     = WS_R;
constexpr size_t WS_M     = WS_Z + al256((size_t)ZROWS * LDZ * 2);
constexpr size_t WS_G     = WS_M + al256((size_t)S_ * POOLW * 2);
constexpr size_t WS_H1    = WS_G + al256((size_t)S_ * NGATE * 4);
constexpr size_t WS_KC    = WS_H1 + al256((size_t)8192 * 256 * 4);
constexpr size_t WS_VC    = WS_KC + al256((size_t)4 * 1024 * 128 * 2);
constexpr size_t WS_L     = WS_VC + al256((size_t)4 * 1024 * 128 * 2);
constexpr size_t WS_OACC  = WS_L + al256((size_t)S_ * NH * 4);
constexpr size_t WS_IMPP  = WS_OACC + al256((size_t)S_ * 3072 * 4);
constexpr size_t WS_IMPF  = WS_IMPP + al256((size_t)S_ * 4 * 256 * 4);
constexpr size_t WS_BM    = WS_IMPF + al256((size_t)S_ * 4 * 256 * 4);
constexpr size_t WS_MIX   = WS_BM + al256((size_t)S_ * 4 * 8 * 4);
constexpr size_t WS_END_A = WS_MIX + al256((size_t)S_ * DM * 2);
constexpr size_t WS_ERAW  = WS_R;
constexpr size_t WS_ACT   = WS_ERAW + al256((size_t)S_ * DM * 2);
constexpr size_t WS_ERSTD = WS_ACT + al256((size_t)S_ * DFF * 2);
constexpr size_t WS_END_B = WS_ERSTD + al256((size_t)S_ * 4);
static_assert(WS_ERAW + (size_t)S_ * DM * 2 <= WS_Z + (size_t)ZROWS * LDZ * 2, "eraw must fit inside the dead z region while mix is still being read");
constexpr size_t WS_NEED  = WS_END_A > WS_END_B ? WS_END_A : WS_END_B;
static_assert(WS_NEED <= (size_t)1440000000, "workspace map exceeds the guaranteed 4 x largest-tensor bytes");

constexpr int LDS_STAGE = 131072;
constexpr int LDS_MISC  = LDS_STAGE;
constexpr int LDS_XCH   = LDS_STAGE + 64;
constexpr int LDS_BYTES = LDS_XCH + 4096;

__device__ __forceinline__ unsigned cvt_pk_bf16(float lo, float hi) { unsigned r; asm volatile("v_cvt_pk_bf16_f32 %0, %1, %2" : "=v"(r) : "v"(lo), "v"(hi)); return r; }
__device__ __forceinline__ float bf_lo(unsigned u) { return __uint_as_float(u << 16); }
__device__ __forceinline__ float bf_hi(unsigned u) { return __uint_as_float(u & 0xffff0000u); }
__device__ __forceinline__ float bf2f(bf16_t b) { return __uint_as_float(((unsigned)b) << 16); }
__device__ __forceinline__ float wave_sum(float v) {
#pragma unroll
    for (int o = 32; o >= 1; o >>= 1) v += __shfl_xor(v, o);
    return v;
}
__device__ __forceinline__ float wave_max(float v) {
#pragma unroll
    for (int o = 32; o >= 1; o >>= 1) v = fmaxf(v, __shfl_xor(v, o));
    return v;
}
__device__ __forceinline__ float sigmoidf_(float x) { return __builtin_amdgcn_rcpf(1.0f + __expf(-x)); }

#define XB_TMO      128
#define XB_XCNT(j)  (256  + 64 * (j))
#define XB_XSUB(j)  (1280 + 64 * (j))
#define XB_XGEN(j)  (2304 + 64 * (j))
#define XB_TOP      3328
#define XB_TOPGEN   3392
#define XCD_BAR_WORDS 3456
#define XB_SPIN_CAP (1u << 18)
__device__ __forceinline__ unsigned xb_ld(unsigned* p)              { return __hip_atomic_load(p, __ATOMIC_RELAXED, __HIP_MEMORY_SCOPE_AGENT); }
__device__ __forceinline__ unsigned xb_add(unsigned* p, unsigned v) { return __hip_atomic_fetch_add(p, v, __ATOMIC_RELAXED, __HIP_MEMORY_SCOPE_AGENT); }
__device__ __forceinline__ unsigned xb_xcc_id() { return (unsigned)__builtin_amdgcn_s_getreg((3 << 11) | 20) & 0xFu; }
#define XB_SPIN(cond, bar) do { unsigned _sp = 0; while (cond) { __builtin_amdgcn_s_sleep(1); \
    if ((++_sp & 255u) == 0u) { if (xb_ld(&(bar)[XB_TMO])) break; if (_sp > XB_SPIN_CAP) { atomicAdd(&(bar)[XB_TMO], 1u); break; } } } } while (0)
struct XcdBarrier { unsigned* bar; unsigned x; volatile LAS unsigned* st; };
__device__ __forceinline__ XcdBarrier xcd_barrier_post(unsigned* bar, volatile LAS unsigned* st) {
    XcdBarrier b; b.bar = bar; b.x = xb_xcc_id(); b.st = st;
    if (threadIdx.x == 0) (void)xb_add(&bar[XB_XCNT(b.x)], 1u);
    return b;
}
__device__ __forceinline__ void xcd_barrier_complete(unsigned* bar, unsigned x, unsigned& nloc, unsigned& nx) {
    const unsigned G = gridDim.x * gridDim.y * gridDim.z;
    unsigned sum, cnt, mine, sp = 0u;
    for (;;) {
        sum = 0u; cnt = 0u; mine = 0u;
#pragma unroll
        for (unsigned j = 0; j < 16; ++j) { const unsigned c = xb_ld(&bar[XB_XCNT(j)]); sum += c; cnt += (c > 0u) ? 1u : 0u; mine = (j == x) ? c : mine; }
        if (sum == G) break;
        __builtin_amdgcn_s_sleep(1);
        if ((++sp & 255u) == 0u) { if (xb_ld(&bar[XB_TMO])) break; if (sp > XB_SPIN_CAP) { atomicAdd(&bar[XB_TMO], 1u); break; } }
    }
    nloc = mine > 0u ? mine : 1u; nx = cnt > 0u ? cnt : 1u;
}
__device__ __forceinline__ void xcd_barrier(const XcdBarrier& b) {
    asm volatile("s_waitcnt vmcnt(0)" ::: "memory");
    __syncthreads();
    if (threadIdx.x == 0) {
        unsigned* bar = b.bar;
        __builtin_amdgcn_s_waitcnt(0);
        unsigned nloc = b.st[0], nx = b.st[1];
        if (nloc == 0u) { xcd_barrier_complete(bar, b.x, nloc, nx); b.st[0] = nloc; b.st[1] = nx; }
        const unsigned old = xb_add(&bar[XB_XSUB(b.x)], 1u);
        const unsigned gen = old / nloc;
        if (old + 1u == (gen + 1u) * nloc) {
            __builtin_amdgcn_fence(__ATOMIC_RELEASE, "agent");
            asm volatile("s_waitcnt vmcnt(0)" ::: "memory");
            const unsigned og = xb_add(&bar[XB_TOP], 1u);
            const unsigned tg = og / nx;
            if (og + 1u == (tg + 1u) * nx) xb_add(&bar[XB_TOPGEN], 1u);
            else XB_SPIN(xb_ld(&bar[XB_TOPGEN]) == tg, bar);
            __builtin_amdgcn_fence(__ATOMIC_ACQUIRE, "agent");
            xb_add(&bar[XB_XGEN(b.x)], 1u);
            asm volatile("s_waitcnt vmcnt(0)" ::: "memory");
        } else {
            XB_SPIN(xb_ld(&bar[XB_XGEN(b.x)]) == gen, bar);
            __builtin_amdgcn_fence(__ATOMIC_ACQUIRE, "agent");
            asm volatile("s_waitcnt vmcnt(0)" ::: "memory");
        }
    }
    __syncthreads();
}

struct Params {
    const float* x; const float* p; const int* positions; const float* norm1_w; const float* w_in; const float* w_pool; const float* pool_scale;
    const float* q_norm_w; const float* k_norm_cmp_w; const float* k_norm_slc_w; const float* k_norm_win_w; const float* cmp_pos_k; const float* cmp_pos_v;
    const float* cmp_k_w1; const float* cmp_k_w2; const float* cmp_v_w1; const float* cmp_v_w2; const float* w_o; const float* norm2_w; const float* w_ffn_in;
    const float* conv_w; const float* conv_b; const float* w_ffn_out; const float* w_ple_proj; const float* ple_norm_w; const float* ple_gate_norm_w; const float* w_ple_gate;
    float* out; unsigned char* ws; int ph_lo, ph_hi;
};

namespace pg8 {
constexpr int BM = 256, BK = 64, HALF = 128, HTB = HALF * BK * 2, STAGE_BYTES = 8 * HTB, NXCD = 8, WGM = 8;
__host__ __device__ __forceinline__ int lds_byte(int r, int c) { const int st = (r >> 4) * 2 + (c >> 5), rr = r & 15, cc = c & 31, ob = rr * 64 + cc * 2; return st * 1024 + (ob ^ (((ob >> 9) & 1) << 5)); }
__host__ __device__ __forceinline__ void stage_rc(int b, int& R, int& C) { const int st = b / 1024, sb = b % 1024, swz = sb ^ (((sb >> 9) & 1) << 5); R = (st >> 1) * 16 + swz / 64; C = (st & 1) * 32 + (swz % 64) / 2; }
__host__ __device__ __forceinline__ int perm32(int rho) { const int n = rho >> 4, i = rho & 15; return 8 * (i >> 2) + 4 * n + (i & 3); }
struct Unit { int pm, pn; };

struct StaticOrder {
    int nM, nN, nwg, G, c;
    __device__ void init(int nM_, int nN_, int G_, int c_) { nM = nM_; nN = nN_; nwg = nM * nN; G = G_; c = c_; }
    __device__ bool next(int i, Unit& u) const {
        const long L = (long)i * G + c; if (L >= nwg) return false;
        int wgid = (int)L; { const int q = nwg / NXCD, r = nwg % NXCD, xcd = wgid % NXCD, off = wgid / NXCD; wgid = (xcd < r ? xcd * (q + 1) : r * (q + 1) + (xcd - r) * q) + off; }
        const int nig = WGM * nN, gid = wgid / nig, fm = gid * WGM, gsz = (nM - fm) < WGM ? (nM - fm) : WGM;
        u.pm = fm + ((wgid % nig) % gsz); u.pn = (wgid % nig) / gsz; return true;
    }
};

struct GStd {
    const char* A; const char* B; unsigned lda, ldb; int nt;
    __device__ __forceinline__ const char* a_base(const Unit& u) const { return A + (size_t)u.pm * 256 * lda * 2; }
    __device__ __forceinline__ const char* b_base(const Unit& u) const { return B + (size_t)u.pn * 256 * ldb * 2; }
    __device__ __forceinline__ size_t kpairA() const { return 256; }
};
struct GPool {
    const char* A; const char* B; unsigned lda, ldb; int nt;
    __device__ __forceinline__ const char* a_base(const Unit& u) const { return A + (size_t)u.pm * 256 * lda * 2 + (size_t)u.pn * 512; }
    __device__ __forceinline__ const char* b_base(const Unit& u) const { return B + (size_t)u.pn * 256 * ldb * 2; }
    __device__ __forceinline__ size_t kpairA() const { return 256; }
};
struct GCmp {
    const char* Z; const char* Bk; const char* Bv; unsigned lda, ldb; int nt;
    __device__ __forceinline__ const char* a_base(const Unit& u) const { const int which = u.pm >> 4, g = (u.pm >> 2) & 3, rt = u.pm & 3;
        return Z + (size_t)(OFF_KV + which * 512 + g * 128) * 2 + (size_t)rt * 256 * lda * 2; }
    __device__ __forceinline__ const char* b_base(const Unit& u) const { return (u.pm >> 4) ? Bv : Bk; }
    __device__ __forceinline__ size_t kpairA() const { return (size_t)LDZ * 2; }
};

struct EpiBf16 {
    static constexpr bool PERM = true;
    bf16_t* O; int ldc;
    __device__ __forceinline__ void operator()(const f32x4 (&acc)[2][2][4][2], const Unit& u, int wr, int wc, int fr, int fq) const {
        const int row0 = u.pm * BM + wr * 64 + fr, col0 = u.pn * BM + wc * 32 + 8 * fq;
#pragma unroll
        for (int ai = 0; ai < 2; ++ai)
#pragma unroll
            for (int m = 0; m < 4; ++m) { bf16_t* rowp = O + (size_t)(row0 + ai * HALF + m * 16) * ldc + col0;
#pragma unroll
                for (int bj = 0; bj < 2; ++bj) { const f32x4 v0 = acc[ai][bj][m][0], v1 = acc[ai][bj][m][1];
                    u32x4 w; w.x = cvt_pk_bf16(v0[0], v0[1]); w.y = cvt_pk_bf16(v0[2], v0[3]); w.z = cvt_pk_bf16(v1[0], v1[1]); w.w = cvt_pk_bf16(v1[2], v1[3]);
                    *(u32x4*)(rowp + bj * HALF) = w; } }
    }
};
struct EpiBf16S {
    static constexpr bool PERM = true;
    bf16_t* O; int ldc; float s;
    __device__ __forceinline__ void operator()(const f32x4 (&acc)[2][2][4][2], const Unit& u, int wr, int wc, int fr, int fq) const {
        const int row0 = u.pm * BM + wr * 64 + fr, col0 = u.pn * BM + wc * 32 + 8 * fq;
#pragma unroll
        for (int ai = 0; ai < 2; ++ai)
#pragma unroll
            for (int m = 0; m < 4; ++m) { bf16_t* rowp = O + (size_t)(row0 + ai * HALF + m * 16) * ldc + col0;
#pragma unroll
                for (int bj = 0; bj < 2; ++bj) { const f32x4 v0 = acc[ai][bj][m][0] * s, v1 = acc[ai][bj][m][1] * s;
                    u32x4 w; w.x = cvt_pk_bf16(v0[0], v0[1]); w.y = cvt_pk_bf16(v0[2], v0[3]); w.z = cvt_pk_bf16(v1[0], v1[1]); w.w = cvt_pk_bf16(v1[2], v1[3]);
                    *(u32x4*)(rowp + bj * HALF) = w; } }
    }
};
struct EpiBf16Ssq {
    static constexpr bool PERM = true;
    bf16_t* O; int ldc; float* ssq;
    __device__ __forceinline__ void operator()(const f32x4 (&acc)[2][2][4][2], const Unit& u, int wr, int wc, int fr, int fq) const {
        const int row0 = u.pm * BM + wr * 64 + fr, col0 = u.pn * BM + wc * 32 + 8 * fq;
#pragma unroll
        for (int ai = 0; ai < 2; ++ai)
#pragma unroll
            for (int m = 0; m < 4; ++m) { const int row = row0 + ai * HALF + m * 16; bf16_t* rowp = O + (size_t)row * ldc + col0; float s = 0.f;
#pragma unroll
                for (int bj = 0; bj < 2; ++bj) { const f32x4 v0 = acc[ai][bj][m][0], v1 = acc[ai][bj][m][1];
                    s += v0[0] * v0[0] + v0[1] * v0[1] + v0[2] * v0[2] + v0[3] * v0[3] + v1[0] * v1[0] + v1[1] * v1[1] + v1[2] * v1[2] + v1[3] * v1[3];
                    u32x4 w; w.x = cvt_pk_bf16(v0[0], v0[1]); w.y = cvt_pk_bf16(v0[2], v0[3]); w.z = cvt_pk_bf16(v1[0], v1[1]); w.w = cvt_pk_bf16(v1[2], v1[3]);
                    *(u32x4*)(rowp + bj * HALF) = w; }
                s += __shfl_xor(s, 16); s += __shfl_xor(s, 32);
                if (fq == 0) unsafeAtomicAdd(ssq + row, s); }
    }
};
struct EpiBf16Scale {
    static constexpr bool PERM = true;
    bf16_t* O; int ldc; const float* colscale;
    __device__ __forceinline__ void operator()(const f32x4 (&acc)[2][2][4][2], const Unit& u, int wr, int wc, int fr, int fq) const {
        const int row0 = u.pm * BM + wr * 64 + fr, col0 = u.pn * BM + wc * 32 + 8 * fq;
#pragma unroll
        for (int bj = 0; bj < 2; ++bj) { const f32x4 s0 = *(const f32x4*)(colscale + col0 + bj * HALF), s1 = *(const f32x4*)(colscale + col0 + bj * HALF + 4);
#pragma unroll
            for (int ai = 0; ai < 2; ++ai)
#pragma unroll
                for (int m = 0; m < 4; ++m) { bf16_t* rowp = O + (size_t)(row0 + ai * HALF + m * 16) * ldc + col0;
                    const f32x4 v0 = acc[ai][bj][m][0] * s0, v1 = acc[ai][bj][m][1] * s1;
                    u32x4 w; w.x = cvt_pk_bf16(v0[0], v0[1]); w.y = cvt_pk_bf16(v0[2], v0[3]); w.z = cvt_pk_bf16(v1[0], v1[1]); w.w = cvt_pk_bf16(v1[2], v1[3]);
                    *(u32x4*)(rowp + bj * HALF) = w; } }
    }
};
struct EpiResF32 {
    static constexpr bool PERM = false;
    const float* base; float* C; int ldc; int row_off;
    __device__ __forceinline__ void operator()(const f32x4 (&acc)[2][2][4][2], const Unit& u, int wr, int wc, int fr, int fq) const {
        const int row0 = u.pm * BM + wr * 64 + fr + row_off, col0 = u.pn * BM + wc * 32 + 4 * fq;
#pragma unroll
        for (int ai = 0; ai < 2; ++ai)
#pragma unroll
            for (int m = 0; m < 4; ++m) { const size_t off = (size_t)(row0 + ai * HALF + m * 16) * ldc + col0;
#pragma unroll
                for (int bj = 0; bj < 2; ++bj)
#pragma unroll
                    for (int n = 0; n < 2; ++n) { const f32x4 b = *(const f32x4*)(base + off + bj * HALF + n * 16); *(f32x4*)(C + off + bj * HALF + n * 16) = b + acc[ai][bj][m][n]; }
                asm volatile("" ::: "memory"); }
    }
};
template <bool FP8OUT>
struct EpiResNormT {
    static constexpr bool PERM = false;
    const float* base; float* C; bf16_t* XN; const float* nw; float* ssq; int ldc;
    __device__ __forceinline__ void operator()(const f32x4 (&acc)[2][2][4][2], const Unit& u, int wr, int wc, int fr, int fq) const {
        const int row0 = u.pm * BM + wr * 64 + fr, col0 = u.pn * BM + wc * 32 + 4 * fq;
        f32x4 wv[2][2];
#pragma unroll
        for (int bj = 0; bj < 2; ++bj)
#pragma unroll
            for (int n = 0; n < 2; ++n) wv[bj][n] = *(const f32x4*)(nw + col0 + bj * HALF + n * 16);
        f32x4 bv[2][2][2];
#pragma unroll
        for (int bj = 0; bj < 2; ++bj)
#pragma unroll
            for (int n = 0; n < 2; ++n) bv[0][bj][n] = *(const f32x4*)(base + (size_t)row0 * ldc + col0 + bj * HALF + n * 16);
#pragma unroll
        for (int rg = 0; rg < 8; ++rg) { const int ai = rg >> 2, m = rg & 3; const int row = row0 + ai * HALF + m * 16; const size_t off = (size_t)row * ldc + col0;
            if (rg < 7) { const int ai2 = (rg + 1) >> 2, m2 = (rg + 1) & 3; const size_t off2 = (size_t)(row0 + ai2 * HALF + m2 * 16) * ldc + col0;
#pragma unroll
                for (int bj = 0; bj < 2; ++bj)
#pragma unroll
                    for (int n = 0; n < 2; ++n) bv[(rg + 1) & 1][bj][n] = *(const f32x4*)(base + off2 + bj * HALF + n * 16); }
            float s = 0.f;
#pragma unroll
            for (int bj = 0; bj < 2; ++bj)
#pragma unroll
                for (int n = 0; n < 2; ++n) { const f32x4 v = bv[rg & 1][bj][n] + acc[ai][bj][m][n];
                    *(f32x4*)(C + off + bj * HALF + n * 16) = v; s += v[0] * v[0] + v[1] * v[1] + v[2] * v[2] + v[3] * v[3];
                    if (FP8OUT) { int pk = __builtin_amdgcn_cvt_pk_fp8_f32(v[0] * wv[bj][n][0], v[1] * wv[bj][n][1], 0, false); pk = __builtin_amdgcn_cvt_pk_fp8_f32(v[2] * wv[bj][n][2], v[3] * wv[bj][n][3], pk, true);
                        *(int*)((unsigned char*)XN + off + bj * HALF + n * 16) = pk; }
                    else { u32x2 o; o.x = cvt_pk_bf16(v[0] * wv[bj][n][0], v[1] * wv[bj][n][1]); o.y = cvt_pk_bf16(v[2] * wv[bj][n][2], v[3] * wv[bj][n][3]);
                        *(u32x2*)(XN + off + bj * HALF + n * 16) = o; } }
            s += __shfl_xor(s, 16); s += __shfl_xor(s, 32);
            if (fq == 0) unsafeAtomicAdd(ssq + row, s);
        }
    }
};
typedef EpiResNormT<false> EpiResNorm;
typedef EpiResNormT<true> EpiResNormF8;
struct EpiCmpGelu {
    static constexpr bool PERM = false;
    float* H; const float* bias;
    __device__ __forceinline__ void operator()(const f32x4 (&acc)[2][2][4][2], const Unit& u, int wr, int wc, int fr, int fq) const {
        const int row0 = u.pm * BM + wr * 64 + fr, col0 = wc * 32 + 4 * fq; const float* bs = bias + (u.pm >> 4) * 256;
        f32x4 bvv[2][2];
#pragma unroll
        for (int bj = 0; bj < 2; ++bj)
#pragma unroll
            for (int n = 0; n < 2; ++n) bvv[bj][n] = *(const f32x4*)(bs + col0 + bj * HALF + n * 16);
#pragma unroll
        for (int ai = 0; ai < 2; ++ai)
#pragma unroll
            for (int m = 0; m < 4; ++m) { float* rowp = H + (size_t)(row0 + ai * HALF + m * 16) * 256 + col0;
#pragma unroll
                for (int bj = 0; bj < 2; ++bj)
#pragma unroll
                    for (int n = 0; n < 2; ++n) { f32x4 v = acc[ai][bj][m][n] + bvv[bj][n];
#pragma unroll
                        for (int j = 0; j < 4; ++j) { const float xx = v[j], uu = 0.7978845608028654f * (xx + 0.044715f * xx * xx * xx); const float th = 1.0f - 2.0f / (1.0f + __expf(2.0f * uu)); v[j] = 0.5f * xx * (1.0f + th); }
                        *(f32x4*)(rowp + bj * HALF + n * 16) = v; } }
    }
};
struct EpiGate {
    static constexpr bool PERM = false;
    float* C; const bf16_t* eraw; const float* erstd; const float* pw; const float* ssq; int ldc; float ascale;
    __device__ __forceinline__ void operator()(const f32x4 (&acc)[2][2][4][2], const Unit& u, int wr, int wc, int fr, int fq) const {
        const int row0 = u.pm * BM + wr * 64 + fr, col0 = u.pn * BM + wc * 32 + 4 * fq;
        f32x4 wv[2][2];
#pragma unroll
        for (int bj = 0; bj < 2; ++bj)
#pragma unroll
            for (int n = 0; n < 2; ++n) wv[bj][n] = *(const f32x4*)(pw + col0 + bj * HALF + n * 16);
        f32x4 bv[2][2][2]; u32x2 ev[2][2][2]; float rsv[2], rgv[2];
#pragma unroll
        for (int bj = 0; bj < 2; ++bj)
#pragma unroll
            for (int n = 0; n < 2; ++n) { bv[0][bj][n] = *(const f32x4*)(C + (size_t)row0 * ldc + col0 + bj * HALF + n * 16); ev[0][bj][n] = *(const u32x2*)(eraw + (size_t)row0 * ldc + col0 + bj * HALF + n * 16); }
        rsv[0] = erstd[row0]; rgv[0] = ssq[row0];
#pragma unroll
        for (int rg = 0; rg < 8; ++rg) { const int ai = rg >> 2, m = rg & 3; const int row = row0 + ai * HALF + m * 16; const size_t off = (size_t)row * ldc + col0;
            if (rg < 7) { const int ai2 = (rg + 1) >> 2, m2 = (rg + 1) & 3; const int row2 = row0 + ai2 * HALF + m2 * 16; const size_t off2 = (size_t)row2 * ldc + col0;
#pragma unroll
                for (int bj = 0; bj < 2; ++bj)
#pragma unroll
                    for (int n = 0; n < 2; ++n) { bv[(rg + 1) & 1][bj][n] = *(const f32x4*)(C + off2 + bj * HALF + n * 16); ev[(rg + 1) & 1][bj][n] = *(const u32x2*)(eraw + off2 + bj * HALF + n * 16); }
                rsv[(rg + 1) & 1] = erstd[row2]; rgv[(rg + 1) & 1] = ssq[row2]; }
            const float rs = rsqrtf(rsv[rg & 1] * (1.0f / DM) + EPS), rg_ = rsqrtf(rgv[rg & 1] * (1.0f / DM) + EPS) * ascale;
#pragma unroll
            for (int bj = 0; bj < 2; ++bj)
#pragma unroll
                for (int n = 0; n < 2; ++n) { const f32x4 b = bv[rg & 1][bj][n]; const u32x2 e = ev[rg & 1][bj][n]; const f32x4 a = acc[ai][bj][m][n]; f32x4 o;
                    o[0] = b[0] + bf_lo(e.x) * rs * wv[bj][n][0] * sigmoidf_(a[0] * rg_); o[1] = b[1] + bf_hi(e.x) * rs * wv[bj][n][1] * sigmoidf_(a[1] * rg_);
                    o[2] = b[2] + bf_lo(e.y) * rs * wv[bj][n][2] * sigmoidf_(a[2] * rg_); o[3] = b[3] + bf_hi(e.y) * rs * wv[bj][n][3] * sigmoidf_(a[3] * rg_);
                    *(f32x4*)(C + off + bj * HALF + n * 16) = o; }
        }
    }
};
struct GFfn {
    const char* A; const char* B; unsigned lda, ldb; int nt;
    __device__ __forceinline__ const char* a_base(const Unit& u) const { return A + ((long)u.pm * 254 - 2) * (long)lda * 2; }
    __device__ __forceinline__ const char* b_base(const Unit& u) const { return B + (size_t)u.pn * 256 * ldb * 2; }
    __device__ __forceinline__ size_t kpairA() const { return 256; }
};
template <int CTRL> __device__ __forceinline__ float dpp_f(float v) { return __int_as_float(__builtin_amdgcn_update_dpp(0, __float_as_int(v), CTRL, 0xf, 0xf, false)); }
struct EpiFfn {
    static constexpr bool PERM = true;
    bf16_t* ACT; const float* cw; const float* cb; LAS float* X; const float* ssq;
    __device__ __forceinline__ void operator()(const f32x4 (&acc)[2][2][4][2], const Unit& u, int wr, int wc, int fr, int fq) const {
        const int colw = wc * 32 + 8 * fq;
        const int f0 = u.pn * 128 + colw;
        f32x4 w0[2], w1[2], w2[2], cbv[2];
#pragma unroll
        for (int n = 0; n < 2; ++n) { w0[n] = *(const f32x4*)(cw + f0 + 4 * n); w1[n] = *(const f32x4*)(cw + DFF + f0 + 4 * n); w2[n] = *(const f32x4*)(cw + 2 * DFF + f0 + 4 * n); cbv[n] = *(const f32x4*)(cb + f0 + 4 * n); }
        float rsv[2][4];
#pragma unroll
        for (int ai = 0; ai < 2; ++ai)
#pragma unroll
            for (int m = 0; m < 4; ++m) { const long t = (long)u.pm * 254 - 2 + ai * HALF + wr * 64 + m * 16 + fr; rsv[ai][m] = (t >= 0 && t < S_) ? ssq[t] : 0.f; }
#pragma unroll
        for (int ai = 0; ai < 2; ++ai)
#pragma unroll
            for (int m = 0; m < 4; ++m) { const long t = (long)u.pm * 254 - 2 + ai * HALF + wr * 64 + m * 16 + fr; rsv[ai][m] = (t >= 0 && t < S_) ? rsqrtf(rsv[ai][m] * (1.0f / DM) + EPS) : 0.f; }
        if (fr >= 14) {
#pragma unroll
            for (int ai = 0; ai < 2; ++ai)
#pragma unroll
                for (int n = 0; n < 2; ++n) *(LAS f32x4*)(X + ((2 * ai + wr) * 2 + (fr - 14)) * 128 + colw + 4 * n) = acc[ai][0][3][n] * rsv[ai][3];
        }
        asm volatile("s_waitcnt lgkmcnt(0)" ::: "memory");
        __builtin_amdgcn_s_barrier(); asm volatile("" ::: "memory");
        __builtin_amdgcn_s_barrier(); asm volatile("" ::: "memory");
        const bool sel1 = fr == 15, sel2 = fr >= 14;
#pragma unroll
        for (int ai = 0; ai < 2; ++ai) {
            f32x4 pv[2];
            const int pseg = 2 * ai + wr - 1;
#pragma unroll
            for (int n = 0; n < 2; ++n) { pv[n] = (f32x4){0.f, 0.f, 0.f, 0.f}; if (pseg >= 0 && fr >= 14) pv[n] = *(const LAS f32x4*)(X + (pseg * 2 + (fr - 14)) * 128 + colw + 4 * n); }
#pragma unroll
            for (int m = 0; m < 4; ++m) {
                const int r = ai * HALF + wr * 64 + m * 16 + fr; const long t = (long)u.pm * 254 - 2 + r;
                unsigned ow[4];
#pragma unroll
                for (int n = 0; n < 2; ++n) {
                    const f32x4 cur = acc[ai][0][m][n] * rsv[ai][m], up = acc[ai][1][m][n] * rsv[ai][m];
                    f32x4 x1, x2;
#pragma unroll
                    for (int i = 0; i < 4; ++i) { x1[i] = dpp_f<0x121>(sel1 ? pv[n][i] : cur[i]); x2[i] = dpp_f<0x122>(sel2 ? pv[n][i] : cur[i]); }
                    const f32x4 y = cbv[n] + w0[n] * x2 + w1[n] * x1 + w2[n] * cur;
                    f32x4 sg;
#pragma unroll
                    for (int i = 0; i < 4; ++i) sg[i] = sigmoidf_(y[i]);
                    const f32x4 o = y * sg * up;
                    ow[2 * n] = cvt_pk_bf16(o[0], o[1]); ow[2 * n + 1] = cvt_pk_bf16(o[2], o[3]);
                    pv[n] = cur;
                }
                if (r >= 2 && t < S_) *(u32x4*)(ACT + (size_t)t * DFF + f0) = (u32x4){ow[0], ow[1], ow[2], ow[3]};
            }
        }
    }
};

template <class GD, class Epi, bool F8 = false>
__device__ __forceinline__ void gemm_phase(LAS unsigned char* lds, const GD g, const StaticOrder& S, const Epi& E) {
    const int tid = threadIdx.x, wid = __builtin_amdgcn_readfirstlane(tid >> 6), lane = tid & 63, wr = wid >> 2, wc = wid & 3, fr = lane & 15, fq = lane >> 4;
    const int nt = g.nt;
    unsigned voffA[2], voffB[2];
#pragma unroll
    for (int i = 0; i < 2; ++i) { int R, C; stage_rc(tid * 16 + i * 8192, R, C); const int Rb = Epi::PERM ? ((R & ~31) + perm32(R & 31)) : R;
        voffA[i] = (unsigned)(R * g.lda + C) * 2u; voffB[i] = (unsigned)(Rb * g.ldb + C) * 2u; }
    const size_t kpA = g.kpairA();
    const size_t hstepA = (size_t)HALF * g.lda * 2, hstepB = (size_t)HALF * g.ldb * 2;
    const unsigned ldsw = (unsigned)wid * 1024u;
    const int aoff = lds_byte(wr * 64 + fr, fq * 8), boff = lds_byte(wc * 32 + fr, fq * 8);
#define PG8_SA(b, h) (((b) * 2 + (h)) * HTB)
#define PG8_SB(b, h) ((4 + (b) * 2 + (h)) * HTB)
#define PG8_STAGE(bufoff, gbase, voff) do { _Pragma("unroll") for (int _i = 0; _i < 2; ++_i) \
        __builtin_amdgcn_global_load_lds((const unsigned*)((const char*)(gbase) + (voff)[_i]), (LAS unsigned*)(lds + (bufoff) + ldsw + _i * 8192), 16, 0, 0); } while (0)
#define PG8_LDA(dst, b, h) do { if constexpr (F8) { _Pragma("unroll") for (int m = 0; m < 4; ++m) { const i32x4 lo_ = *(const LAS i32x4*)(lds + PG8_SA(b, h) + aoff + m * 2048), hi_ = *(const LAS i32x4*)(lds + PG8_SA(b, h) + aoff + m * 2048 + 1024); \
            dst##8[m] = __builtin_shufflevector(lo_, hi_, 0, 1, 2, 3, 4, 5, 6, 7); } } \
        else { _Pragma("unroll") for (int m = 0; m < 4; ++m) _Pragma("unroll") for (int k = 0; k < 2; ++k) dst[m][k] = *(const LAS bf16x8*)(lds + PG8_SA(b, h) + aoff + m * 2048 + k * 1024); } } while (0)
#define PG8_LDB(dst, b, h) do { if constexpr (F8) { _Pragma("unroll") for (int n = 0; n < 2; ++n) { const i32x4 lo_ = *(const LAS i32x4*)(lds + PG8_SB(b, h) + boff + n * 2048), hi_ = *(const LAS i32x4*)(lds + PG8_SB(b, h) + boff + n * 2048 + 1024); \
            dst##8[n] = __builtin_shufflevector(lo_, hi_, 0, 1, 2, 3, 4, 5, 6, 7); } } \
        else { _Pragma("unroll") for (int n = 0; n < 2; ++n) _Pragma("unroll") for (int k = 0; k < 2; ++k) dst[n][k] = *(const LAS bf16x8*)(lds + PG8_SB(b, h) + boff + n * 2048 + k * 1024); } } while (0)
#define PG8_MMA(ai, bj, At, Bt) do { __builtin_amdgcn_s_setprio(1); \
        if constexpr (F8) { _Pragma("unroll") for (int m = 0; m < 4; ++m) _Pragma("unroll") for (int n = 0; n < 2; ++n) \
            asm volatile("v_mfma_scale_f32_16x16x128_f8f6f4 %0, %1, %2, %0, %3, %3 op_sel_hi:[0,0,0]" : "+v"(acc[ai][bj][m][n]) : "v"(Bt##8[n]), "v"(At##8[m]), "v"(one_scale)); } \
        else { _Pragma("unroll") for (int m = 0; m < 4; ++m) _Pragma("unroll") for (int n = 0; n < 2; ++n) _Pragma("unroll") for (int k = 0; k < 2; ++k) \
            acc[ai][bj][m][n] = __builtin_amdgcn_mfma_f32_16x16x32_bf16(Bt[n][k], At[m][k], acc[ai][bj][m][n], 0, 0, 0); } \
        __builtin_amdgcn_s_setprio(0); } while (0)
#define PG8_WAIT_V(n) asm volatile("s_waitcnt vmcnt(" #n ")" ::: "memory")
#define PG8_WAIT_L(n) asm volatile("s_waitcnt lgkmcnt(" #n ")" ::: "memory")
#define PG8_BAR __builtin_amdgcn_s_barrier()
#define PG8_SCHED __builtin_amdgcn_sched_barrier(0)
    Unit cur, nxt; int ui = 0;
    if (!S.next(0, cur)) return;
    f32x4 acc[2][2][4][2];
#pragma unroll
    for (int a = 0; a < 2; ++a)
#pragma unroll
        for (int b = 0; b < 2; ++b)
#pragma unroll
            for (int m = 0; m < 4; ++m)
#pragma unroll
                for (int n = 0; n < 2; ++n) acc[a][b][m][n] = (f32x4){0.f, 0.f, 0.f, 0.f};
    bf16x8 At[4][2], B0[2][2], B1[2][2];
    i32x8 At8[4], B08[2], B18[2];
    (void)At; (void)B0; (void)B1; (void)At8; (void)B08; (void)B18;
    int one_scale = 0x7F7F7F7F; (void)one_scale;
    const char* cA = g.a_base(cur); const char* cB = g.b_base(cur);
    PG8_STAGE(PG8_SB(0, 0), cB, voffB); PG8_STAGE(PG8_SA(0, 0), cA, voffA); PG8_STAGE(PG8_SB(0, 1), cB + hstepB, voffB); PG8_STAGE(PG8_SA(0, 1), cA + hstepA, voffA);
    if (wr == 1) PG8_BAR;
    PG8_WAIT_V(4); PG8_BAR;
    PG8_STAGE(PG8_SB(1, 0), cB + 128, voffB); PG8_STAGE(PG8_SA(1, 0), cA + 128, voffA); PG8_STAGE(PG8_SB(1, 1), cB + hstepB + 128, voffB);
    PG8_WAIT_V(6); PG8_BAR;
    for (;;) {
        const bool has_next = S.next(ui + 1, nxt);
        const char* nA = has_next ? g.a_base(nxt) : cA; const char* nB = has_next ? g.b_base(nxt) : cB;
        for (int t = 0; t < nt; t += 2) {
            const bool last = (t == nt - 2);
            const char* a0 = cA + (size_t)(t >> 1) * kpA;
            const char* a1 = a0 + 128;
            const char* a2 = last ? nA : a0 + kpA; const char* b2 = last ? nB : cB + (size_t)(t + 2) * 128;
            const char* a3 = a2 + 128; const char* b3 = b2 + 128;
            PG8_LDB(B0, 0, 0); PG8_SCHED; PG8_LDA(At, 0, 0); PG8_STAGE(PG8_SA(1, 1), a1 + hstepA, voffA);
            PG8_WAIT_L(8); PG8_BAR; PG8_WAIT_L(0); PG8_MMA(0, 0, At, B0); PG8_BAR; PG8_SCHED;
            PG8_LDB(B1, 0, 1); PG8_STAGE(PG8_SB(0, 0), b2, voffB);
            PG8_BAR; PG8_WAIT_L(0); PG8_MMA(0, 1, At, B1); PG8_BAR;
            PG8_LDA(At, 0, 1); PG8_STAGE(PG8_SA(0, 0), a2, voffA);
            PG8_BAR; PG8_WAIT_L(0); PG8_MMA(1, 0, At, B0); PG8_BAR; PG8_SCHED;
            PG8_STAGE(PG8_SB(0, 1), b2 + hstepB, voffB);
            PG8_WAIT_V(6); PG8_BAR; PG8_MMA(1, 1, At, B1); PG8_BAR;
            PG8_LDB(B0, 1, 0); PG8_SCHED; PG8_LDA(At, 1, 0); PG8_STAGE(PG8_SA(0, 1), a2 + hstepA, voffA);
            PG8_WAIT_L(8); PG8_BAR; PG8_WAIT_L(0); PG8_MMA(0, 0, At, B0); PG8_BAR; PG8_SCHED;
            PG8_LDB(B1, 1, 1); PG8_STAGE(PG8_SB(1, 0), b3, voffB);
            PG8_BAR; PG8_WAIT_L(0); PG8_MMA(0, 1, At, B1); PG8_BAR;
            PG8_LDA(At, 1, 1); PG8_STAGE(PG8_SA(1, 0), a3, voffA);
            PG8_BAR; PG8_WAIT_L(0); PG8_MMA(1, 0, At, B0); PG8_BAR; PG8_SCHED;
            PG8_STAGE(PG8_SB(1, 1), b3 + hstepB, voffB);
            PG8_WAIT_V(6); PG8_BAR; PG8_MMA(1, 1, At, B1); PG8_BAR;
        }
        if constexpr (F8) asm volatile("s_nop 15\n\ts_nop 15\n\ts_nop 15" ::: "memory");
        E(acc, cur, wr, wc, fr, fq);
        if (!has_next) break;
#pragma unroll
        for (int a = 0; a < 2; ++a)
#pragma unroll
            for (int b = 0; b < 2; ++b)
#pragma unroll
                for (int m = 0; m < 4; ++m)
#pragma unroll
                    for (int n = 0; n < 2; ++n) acc[a][b][m][n] = (f32x4){0.f, 0.f, 0.f, 0.f};
        cur = nxt; cA = nA; cB = nB; ++ui;
    }
    PG8_WAIT_V(0);
    if (wr == 0) PG8_BAR;
    PG8_BAR;
#undef PG8_SA
#undef PG8_SB
#undef PG8_STAGE
#undef PG8_LDA
#undef PG8_LDB
#undef PG8_MMA
#undef PG8_WAIT_V
#undef PG8_WAIT_L
#undef PG8_BAR
#undef PG8_SCHED
}
}

namespace att {
constexpr int KVBLK = 64;
constexpr int SHM_V = KVBLK * HD * 2, SHM_K = KVBLK * HD * 2, SHM_ATTN = 2 * SHM_V + 2 * SHM_K + NWAVES * 64 * 4;
#define KSWZ(row, colB) ((row) * 256 + ((colB) ^ (((row) & 7) << 4)))
#define SBAR() __builtin_amdgcn_sched_barrier(0)
__device__ __forceinline__ int crow(int r, int hi) { return (r & 3) + 8 * (r >> 2) + 4 * hi; }
__device__ __forceinline__ void qkt(f32x16& p0, f32x16& p1, const char* Ks, const bf16x8* qr, int r32, int hi) {
    p0 = f32x16{}; p1 = f32x16{};
    bf16x8 ka[2], kb[2];
    { const int cb = (hi * 8) * 2; ka[0] = *reinterpret_cast<const bf16x8*>(Ks + KSWZ(r32, cb)); kb[0] = *reinterpret_cast<const bf16x8*>(Ks + KSWZ(32 + r32, cb)); }
#pragma unroll
    for (int d0 = 0; d0 < 8; ++d0) {
        if (d0 < 7) { const int cb = ((d0 + 1) * 16 + hi * 8) * 2;
            ka[(d0 + 1) & 1] = *reinterpret_cast<const bf16x8*>(Ks + KSWZ(r32, cb)); kb[(d0 + 1) & 1] = *reinterpret_cast<const bf16x8*>(Ks + KSWZ(32 + r32, cb)); }
        SBAR();
        p0 = __builtin_amdgcn_mfma_f32_32x32x16_bf16(ka[d0 & 1], qr[d0], p0, 0, 0, 0);
        p1 = __builtin_amdgcn_mfma_f32_32x32x16_bf16(kb[d0 & 1], qr[d0], p1, 0, 0, 0);
        SBAR();
    }
}
__device__ __forceinline__ int v_st(int k, int c) { const int kk = (k & ~0xC) | ((k & 4) << 1) | ((k & 8) >> 1); return ((kk >> 3) * 4 + (c >> 5)) * 512 + ((kk & 7) * 32 + (c & 31)) * 2; }
__device__ __forceinline__ int v_rd_base(int lane) { return ((lane & 3) << 3) | (((lane >> 2) & 3) << 6) | (((lane >> 4) & 1) << 5) | (((lane >> 5) & 1) << 8); }
constexpr int v_rd_off(int d0, int ks, int half) { return d0 * 512 + ks * 4096 + half * 2048; }
__device__ __forceinline__ s16x4 tr_read(int vb, int off) { return __builtin_amdgcn_ds_read_tr16_b64_v4i16((LAS s16x4*)(unsigned long)(unsigned)(vb + off)); }
__device__ __forceinline__ void pv_d0(f32x16* o, int vb, bf16x8 pa0, bf16x8 pa1, bf16x8 pa2, bf16x8 pa3) {
    s16x4 L[2][4], H[2][4];
#pragma unroll
    for (int d0 = 0; d0 < 4; ++d0) { L[0][d0] = tr_read(vb, v_rd_off(d0, 0, 0)); H[0][d0] = tr_read(vb, v_rd_off(d0, 0, 1)); }
#pragma unroll
    for (int ks = 0; ks < 4; ++ks) {
        if (ks < 3) {
#pragma unroll
            for (int d0 = 0; d0 < 4; ++d0) { L[(ks + 1) & 1][d0] = tr_read(vb, v_rd_off(d0, ks + 1, 0)); H[(ks + 1) & 1][d0] = tr_read(vb, v_rd_off(d0, ks + 1, 1)); }
        }
        const bf16x8 pa = ks == 0 ? pa0 : (ks == 1 ? pa1 : (ks == 2 ? pa2 : pa3));
#pragma unroll
        for (int d0 = 0; d0 < 4; ++d0) { const s16x4 l = L[ks & 1][d0], h = H[ks & 1][d0];
            o[d0] = __builtin_amdgcn_mfma_f32_32x32x16_bf16(pa, (bf16x8){l[0], l[1], l[2], l[3], h[0], h[1], h[2], h[3]}, o[d0], 0, 0, 0); }
    }
}
__device__ __forceinline__ void pack_p(const f32x16& p0, const f32x16& p1, bf16x8& pa0, bf16x8& pa1, bf16x8& pa2, bf16x8& pa3) {
#define PK4(P, BASE, OUT) do { unsigned a0 = cvt_pk_bf16(P[BASE + 0], P[BASE + 1]), a1 = cvt_pk_bf16(P[BASE + 2], P[BASE + 3]);   \
    unsigned b0 = cvt_pk_bf16(P[BASE + 4], P[BASE + 5]), b1 = cvt_pk_bf16(P[BASE + 6], P[BASE + 7]);                              \
    auto r0 = __builtin_amdgcn_permlane32_swap(a0, b0, false, false); auto r1 = __builtin_amdgcn_permlane32_swap(a1, b1, false, false); \
    u32x4 w = {r0[0], r1[0], r0[1], r1[1]}; OUT = *reinterpret_cast<bf16x8*>(&w); } while (0)
    PK4(p0, 0, pa0); PK4(p0, 8, pa1); PK4(p1, 0, pa2); PK4(p1, 8, pa3);
#undef PK4
}

__device__ __forceinline__ void pack_half(const f32x16& p, bf16x8& paA, bf16x8& paB) {
#define PK4(P, BASE, OUT) do { unsigned a0 = cvt_pk_bf16(P[BASE + 0], P[BASE + 1]), a1 = cvt_pk_bf16(P[BASE + 2], P[BASE + 3]);   \
    unsigned b0 = cvt_pk_bf16(P[BASE + 4], P[BASE + 5]), b1 = cvt_pk_bf16(P[BASE + 6], P[BASE + 7]);                              \
    auto r0 = __builtin_amdgcn_permlane32_swap(a0, b0, false, false); auto r1 = __builtin_amdgcn_permlane32_swap(a1, b1, false, false); \
    u32x4 w = {r0[0], r1[0], r0[1], r1[1]}; OUT = *reinterpret_cast<bf16x8*>(&w); } while (0)
    PK4(p, 0, paA); PK4(p, 8, paB);
#undef PK4
}
template <int KS0, bool WITH_EXP>
__device__ __forceinline__ void pv_half(f32x16* o, int vb, bf16x8 paA, bf16x8 paB, f32x16& px, float off) {
    s16x4 L[2][4], H[2][4];
#pragma unroll
    for (int d0 = 0; d0 < 4; ++d0) { L[0][d0] = tr_read(vb, v_rd_off(d0, KS0, 0)); H[0][d0] = tr_read(vb, v_rd_off(d0, KS0, 1)); }
#pragma unroll
    for (int d0 = 0; d0 < 4; ++d0) { L[1][d0] = tr_read(vb, v_rd_off(d0, KS0 + 1, 0)); H[1][d0] = tr_read(vb, v_rd_off(d0, KS0 + 1, 1)); }
#pragma unroll
    for (int kk = 0; kk < 2; ++kk) {
        const bf16x8 pa = kk == 0 ? paA : paB;
#pragma unroll
        for (int d0 = 0; d0 < 4; ++d0) { const s16x4 l = L[kk][d0], h = H[kk][d0];
            if (WITH_EXP) SBAR();
            o[d0] = __builtin_amdgcn_mfma_f32_32x32x16_bf16(pa, (bf16x8){l[0], l[1], l[2], l[3], h[0], h[1], h[2], h[3]}, o[d0], 0, 0, 0);
            if (WITH_EXP) {
#pragma unroll
                for (int q = 0; q < 2; ++q) { const int r = (kk * 4 + d0) * 2 + q; px[r] = __builtin_amdgcn_exp2f(fmaf(px[r], SM_C, off)); }
                SBAR(); }
        }
    }
}
enum { MODE_CMP = 0, MODE_WIN = 1, MODE_SLC = 2 };
struct AttnArgs {
    const bf16_t* Z; const bf16_t* KC; const bf16_t* VC; const float* G; float* L; float* OACC; bf16_t* MIX; const unsigned* BM; const float* TAB;
};
template <int MODE>
__device__ __forceinline__ void attn_unit(const AttnArgs& a, LAS char* ldsL, int qt, int g, int hp) {
    char* lds = (char*)ldsL;
    const int tid = threadIdx.x, wid = __builtin_amdgcn_readfirstlane(tid >> 6), lane = tid & 63, r32 = lane & 31, hi = lane >> 5;
    float* li_l = (float*)(lds + LDS_XCH) + wid * 64;
    const int t0 = MODE == MODE_SLC ? qt * 40 : qt * 128;
    const int tq_raw = MODE == MODE_SLC ? t0 + wid * 5 + r32 / 6 : t0 + wid * 16 + (r32 & 15);
    const bool rvalid = MODE == MODE_SLC ? (r32 < 30 && tq_raw < S_) : true;
    const int tq = tq_raw < S_ ? tq_raw : S_ - 1;
    const int hq = MODE == MODE_SLC ? g * HPG + r32 % 6 : g * HPG + hp * 2 + (r32 >> 4);
    const int tlast = MODE == MODE_SLC ? ((t0 + 39) < S_ ? (t0 + 39) : S_ - 1) : t0 + 127;
    const bf16_t* Kb; const bf16_t* Vb; long ldk;
    if (MODE == MODE_CMP) { Kb = a.KC + (size_t)g * 1024 * HD; Vb = a.VC + (size_t)g * 1024 * HD; ldk = HD; }
    else if (MODE == MODE_WIN) { Kb = a.Z + OFF_KV + 4 * 512 + g * HD; Vb = a.Z + OFF_KV + 5 * 512 + g * HD; ldk = LDZ; }
    else { Kb = a.Z + OFF_KV + 2 * 512 + g * HD; Vb = a.Z + OFF_KV + 3 * 512 + g * HD; ldk = LDZ; }
    int j0, j1;
    if (MODE == MODE_CMP) { j0 = 0; j1 = (((t0 + 127 - 31) >> 4) >> 6) + 1; }
    else if (MODE == MODE_WIN) { j0 = (t0 - 511) > 0 ? ((t0 - 511) >> 6) : 0; j1 = ((t0 + 127) >> 6) + 1; }
    else { j0 = 0; j1 = (tlast >> 6) + 1; }
    int klo, khi;
    if (MODE == MODE_CMP) { klo = 0; khi = tq >= 31 ? ((tq - 31) >> 4) : -1; }
    else if (MODE == MODE_WIN) { klo = tq - 511; khi = tq; }
    else { klo = 0; khi = rvalid ? tq : -1; }
    float negBC = -a.TAB[512 + (MODE == MODE_CMP ? 0 : (MODE == MODE_SLC ? 1 : 2))];
    bf16x8 qr[8];
    { const bf16_t* Qw = a.Z + (size_t)tq * LDZ + OFF_Q + hq * HD + hi * 8;
#pragma unroll
      for (int d0 = 0; d0 < 8; ++d0) qr[d0] = *reinterpret_cast<const bf16x8*>(Qw + d0 * 16); }
    f32x16 o[4] = {}; float lsum = 0.f;
    unsigned soK[2], soV[2];
#pragma unroll
    for (int i = 0; i < 2; ++i) { const int p = (wid + 8 * i) * 64 + lane;
        { const int row = p >> 4, c = (p & 15) ^ (row & 7); soK[i] = (unsigned)(row * ldk + c * 8) * 2u; }
        { const int sub = p >> 5, within = p & 31, kk = (sub >> 2) * 8 + (within >> 2), c = (sub & 3) * 32 + (within & 3) * 8, k = (kk & ~0xC) | ((kk & 4) << 1) | ((kk & 8) >> 1);
          soV[i] = (unsigned)(k * ldk + c) * 2u; } }
    const int vb0 = (int)(uintptr_t)(LAS char*)ldsL + 16384 + v_rd_base(lane);
#define ISSUE(jt) do { const int _b = ((jt) - j0) & 3; const char* _kp = (const char*)Kb + (size_t)(jt) * KVBLK * ldk * 2; const char* _vp = (const char*)Vb + (size_t)(jt) * KVBLK * ldk * 2; \
    _Pragma("unroll") for (int _i = 0; _i < 2; ++_i) { \
        __builtin_amdgcn_global_load_lds((const unsigned*)(_kp + soK[_i]), (LAS unsigned*)(ldsL + _b * 32768 + (wid + 8 * _i) * 1024), 16, 0, 0); \
        __builtin_amdgcn_global_load_lds((const unsigned*)(_vp + soV[_i]), (LAS unsigned*)(ldsL + _b * 32768 + 16384 + (wid + 8 * _i) * 1024), 16, 0, 0); } } while (0)
    unsigned bmw = 0u;
    if (MODE == MODE_SLC) bmw = a.BM[((size_t)tq * 4 + g) * 8];
    asm volatile("s_waitcnt lgkmcnt(0)" ::: "memory");
    __builtin_amdgcn_s_barrier();
    asm volatile("" ::: "memory");
    ISSUE(j0);
    asm volatile("s_waitcnt vmcnt(4) lgkmcnt(0)" : "+v"(bmw), "+v"(negBC), "+v"(qr[0]), "+v"(qr[1]), "+v"(qr[2]), "+v"(qr[3]), "+v"(qr[4]), "+v"(qr[5]), "+v"(qr[6]), "+v"(qr[7]) :: "memory");
    if (j0 + 1 < j1) ISSUE(j0 + 1); if (j0 + 2 < j1) ISSUE(j0 + 2);
    for (int j = j0; j < j1; ++j) {
        const int buf = (j - j0) & 3;
        if (j + 2 < j1) asm volatile("s_waitcnt vmcnt(8)" ::: "memory"); else if (j + 1 < j1) asm volatile("s_waitcnt vmcnt(4)" ::: "memory"); else asm volatile("s_waitcnt vmcnt(0)" ::: "memory");
        __builtin_amdgcn_s_barrier();
        asm volatile("" ::: "memory");
        if (j + 3 < j1) ISSUE(j + 3);
        int lhi = khi;
        if (MODE == MODE_SLC) { if (!((bmw >> (j & 31)) & 1u)) lhi = -1; }
        const int kb = j * KVBLK;
        const bool l_any = (kb + 63 >= klo) && (kb <= lhi);
        const bool l_full = (kb >= klo) && (kb + 63 <= lhi);
        if (__any(l_any)) {
            f32x16 p0, p1;
            qkt(p0, p1, lds + buf * 32768, qr, r32, hi);
            const bool uni = __all(l_full || !l_any);
            const float off = (uni && !l_any) ? -1.0e30f : negBC;
#pragma unroll
            for (int r = 0; r < 16; ++r) p0[r] = __builtin_amdgcn_exp2f(fmaf(p0[r], SM_C, off));
            if (!uni) {
#pragma unroll
                for (int r = 0; r < 16; ++r) { const int k0i = kb + crow(r, hi); p0[r] = (k0i >= klo && k0i <= lhi) ? p0[r] : 0.f; } }
            float ps = 0.f;
#pragma unroll
            for (int r = 0; r < 16; ++r) ps += p0[r];
            bf16x8 pa0, pa1, pa2, pa3; pack_half(p0, pa0, pa1);
            pv_half<0, true>(o, vb0 + buf * 32768, pa0, pa1, p1, off);
            if (!uni) {
#pragma unroll
                for (int r = 0; r < 16; ++r) { const int k1i = kb + 32 + crow(r, hi); p1[r] = (k1i >= klo && k1i <= lhi) ? p1[r] : 0.f; } }
#pragma unroll
            for (int r = 0; r < 16; ++r) ps += p1[r];
            lsum += ps;
            pack_half(p1, pa2, pa3);
            pv_half<2, false>(o, vb0 + buf * 32768, pa2, pa3, p1, off);
        }
        if (MODE == MODE_SLC) { if (((j + 1) & 31) == 0 && j + 1 < j1) { bmw = a.BM[((size_t)tq * 4 + g) * 8 + ((j + 1) >> 5)]; asm volatile("s_waitcnt vmcnt(0)" : "+v"(bmw) :: "memory"); } }
    }
#undef ISSUE
    lsum += __shfl_xor(lsum, 32);
    if (hi == 0) li_l[r32] = lsum;
    if (MODE == MODE_CMP) { if (hi == 0) a.L[(size_t)tq * NH + hq] = lsum; }
    asm volatile("s_waitcnt lgkmcnt(0)" ::: "memory");
    float gtv[16]; f32x16 pvv[4];
#pragma unroll
    for (int r = 0; r < 16; ++r) {
        const int orow = crow(r, hi); const float lv = li_l[orow]; const float rl = lv > 0.f ? 1.0f / lv : 0.f;
        const int t = MODE == MODE_SLC ? t0 + wid * 5 + orow / 6 : t0 + wid * 16 + (orow & 15);
        const int h = MODE == MODE_SLC ? g * HPG + orow % 6 : g * HPG + hp * 2 + (orow >> 4);
        const bool valid = !(MODE == MODE_SLC && (orow >= 30 || t >= S_)); const int tc = valid ? t : 0;
        gtv[r] = valid ? a.G[(size_t)tc * NGATE + h * 3 + (MODE == MODE_CMP ? 0 : (MODE == MODE_SLC ? 1 : 2))] * rl : 0.f;
        if (MODE != MODE_CMP) { const float* oa = a.OACC + (size_t)tc * 3072 + h * HD + r32;
#pragma unroll
            for (int d0 = 0; d0 < 4; ++d0) pvv[d0][r] = oa[d0 * 32]; }
    }
#pragma unroll
    for (int r = 0; r < 16; ++r) {
        const int orow = crow(r, hi);
        const int t = MODE == MODE_SLC ? t0 + wid * 5 + orow / 6 : t0 + wid * 16 + (orow & 15);
        const int h = MODE == MODE_SLC ? g * HPG + orow % 6 : g * HPG + hp * 2 + (orow >> 4);
        if (MODE == MODE_SLC && (orow >= 30 || t >= S_)) continue;
        float* oa = a.OACC + (size_t)t * 3072 + h * HD + r32;
#pragma unroll
        for (int d0 = 0; d0 < 4; ++d0) {
            const float v = o[d0][r] * gtv[r];
            if (MODE == MODE_CMP) oa[d0 * 32] = v;
            else if (MODE == MODE_WIN) oa[d0 * 32] = pvv[d0][r] + v;
            else a.MIX[(size_t)t * DM + POOLW + h * HD + d0 * 32 + r32] = (bf16_t)(cvt_pk_bf16(pvv[d0][r] + v, 0.f) & 0xffffu);
        }
    }
}

__device__ __forceinline__ void imp_task(const AttnArgs& a, float* IMPP, float* IMPF, int tqi, int g) {
    const int lane = threadIdx.x & 63, fr = lane & 15, fq = lane >> 4;
    const int t = tqi * 16 + fr;
    const int tmax = tqi * 16 + 15;
    if (tmax < 31) return;
    const int lim = t >= 31 ? ((t - 31) >> 4) : -1;
    const int nstep = ((((tmax - 31) >> 4) >> 6) + 1) * 4;
    const float negBC = -a.TAB[512];
    bf16x8 qf[HPG][4]; float rl[HPG];
#pragma unroll
    for (int h = 0; h < HPG; ++h) {
        const bf16_t* qp = a.Z + (size_t)t * LDZ + OFF_Q + (g * HPG + h) * HD + fq * 8;
#pragma unroll
        for (int ks = 0; ks < 4; ++ks) qf[h][ks] = *reinterpret_cast<const bf16x8*>(qp + ks * 32);
        const float lv = a.L[(size_t)t * NH + g * HPG + h]; rl[h] = lv > 0.f ? 1.0f / lv : 0.f;
    }
    const bf16_t* kbase = a.KC + (size_t)g * 1024 * HD + (size_t)fr * HD + fq * 8;
    bf16x8 kf[4], kn[4];
#pragma unroll
    for (int ks = 0; ks < 4; ++ks) kf[ks] = *reinterpret_cast<const bf16x8*>(kbase + ks * 32);
    float* op = IMPP + ((size_t)t * 4 + g) * 256 + fq; float* of = IMPF + ((size_t)t * 4 + g) * 256 + fq;
    for (int st = 0; st < nstep; ++st) {
        const int sn = (st + 1 < nstep) ? st + 1 : st;
#pragma unroll
        for (int ks = 0; ks < 4; ++ks) kn[ks] = *reinterpret_cast<const bf16x8*>(kbase + (size_t)sn * 16 * HD + ks * 32);
        f32x4 imp4 = {0.f, 0.f, 0.f, 0.f};
        const int n0 = st * 16 + fq * 4;
#pragma unroll
        for (int h = 0; h < HPG; ++h) {
            f32x4 acc = {0.f, 0.f, 0.f, 0.f};
#pragma unroll
            for (int ks = 0; ks < 4; ++ks) acc = __builtin_amdgcn_mfma_f32_16x16x32_bf16(kf[ks], qf[h][ks], acc, 0, 0, 0);
#pragma unroll
            for (int i = 0; i < 4; ++i) { const float e = __builtin_amdgcn_exp2f(fmaf(acc[i], SM_C, negBC)) * rl[h]; imp4[i] += (n0 + i <= lim) ? e : 0.f; }
        }
        op[st * 4] = imp4[0] + 2.0f * (imp4[1] + imp4[2] + imp4[3]);
        of[st * 4] = imp4[0];
#pragma unroll
        for (int ks = 0; ks < 4; ++ks) kf[ks] = kn[ks];
    }
}

__device__ __forceinline__ void topk_load(const float* IMPP, const float* IMPF, int t, int g, f32x4& pp, f32x4& ff) {
    const int lane = threadIdx.x & 63, cur = t >> 6, jb = lane * 4;
    pp = (f32x4){0.f, 0.f, 0.f, 0.f}; ff = pp;
    if (cur > 15 && jb <= cur) { const size_t base = ((size_t)t * 4 + g) * 256; pp = *(const f32x4*)(IMPP + base + jb); ff = *(const f32x4*)(IMPF + base + jb); }
}
__device__ __forceinline__ void topk_task(const f32x4 pp, const f32x4 ff, unsigned* BM, int t, int g) {
    const int lane = threadIdx.x & 63;
    const int cur = t >> 6;
    unsigned nib = 0u;
    if (cur <= 15) { const int jb = lane * 4;
#pragma unroll
        for (int c = 0; c < 4; ++c) if (jb + c <= cur) nib |= 1u << c; }
    else {
        const int jb = lane * 4;
        unsigned key[4];
        {
            float fnext = __shfl_down(ff[0], 1);
            if (lane == 63) fnext = 0.f;
            const float v0 = pp[0] + ff[1], v1 = pp[1] + ff[2], v2 = pp[2] + ff[3], v3 = pp[3] + fnext;
            key[0] = (jb + 0 >= 1 && jb + 0 <= cur - 2) ? __float_as_uint(fmaxf(v0, 0.f)) + 1u : 0u;
            key[1] = (jb + 1 >= 1 && jb + 1 <= cur - 2) ? __float_as_uint(fmaxf(v1, 0.f)) + 1u : 0u;
            key[2] = (jb + 2 >= 1 && jb + 2 <= cur - 2) ? __float_as_uint(fmaxf(v2, 0.f)) + 1u : 0u;
            key[3] = (jb + 3 >= 1 && jb + 3 <= cur - 2) ? __float_as_uint(fmaxf(v3, 0.f)) + 1u : 0u;
        }
        unsigned prefix = 0u; bool exact = false;
        for (int b = 30; b >= 0; --b) {
            const unsigned trial = prefix | (1u << b);
            const int cnt = __popcll(__ballot(key[0] >= trial)) + __popcll(__ballot(key[1] >= trial)) + __popcll(__ballot(key[2] >= trial)) + __popcll(__ballot(key[3] >= trial));
            if (cnt >= 13) { prefix = trial; if (cnt == 13) { exact = true; break; } }
        }
#pragma unroll
        for (int c = 0; c < 4; ++c) if (exact ? (key[c] >= prefix) : (key[c] > prefix)) nib |= 1u << c;
        if (!exact) {
            int need = 13 - (__popcll(__ballot(key[0] > prefix)) + __popcll(__ballot(key[1] > prefix)) + __popcll(__ballot(key[2] > prefix)) + __popcll(__ballot(key[3] > prefix)));
            unsigned tie = 0u;
#pragma unroll
            for (int c = 0; c < 4; ++c) if (key[c] == prefix) tie |= 1u << c;
            for (int guard = 0; need > 0 && guard < 16; ++guard) {
                const unsigned long long any = __ballot(tie != 0u);
                if (any == 0ull) break;
                const int L = __builtin_ctzll(any);
                if (lane == L) { const unsigned low = tie & (0u - tie); nib |= low; tie ^= low; }
                --need;
            }
        }
        if (lane == 0) nib |= 1u;
        if (lane == (cur >> 2)) nib |= 1u << (cur & 3);
        if (lane == ((cur - 1) >> 2)) nib |= 1u << ((cur - 1) & 3);
    }
    unsigned x = nib << (4 * (lane & 7));
    x |= __shfl_xor(x, 1); x |= __shfl_xor(x, 2); x |= __shfl_xor(x, 4);
    if ((lane & 7) == 0) BM[((size_t)t * 4 + g) * 8 + (lane >> 3)] = x;
}
#undef KSWZ
}

template <bool FFN_REMAP = false>
__device__ __forceinline__ void convT(const float* __restrict__ src0, int K, int N, bf16_t* __restrict__ dst, int ldd, LAS float* tile, int bid, int nb, int Nfull = 0, int n0 = 0) {
    const float* __restrict__ src = src0 + n0; if (Nfull == 0) Nfull = N;
    const int tid = threadIdx.x, tk = K >> 6, tn = (N + 63) >> 6, total = tk * tn;
    const int r = tid >> 4, c4 = (tid & 15) * 4;
    f32x4 v[2] = {{0.f, 0.f, 0.f, 0.f}, {0.f, 0.f, 0.f, 0.f}}, vn[2];
    if (bid < total) { const int nti = bid % tn, kti = bid / tn, ng = nti * 64 + c4;
#pragma unroll
        for (int h = 0; h < 2; ++h) if (ng < N) v[h] = *(const f32x4*)(src + (size_t)(kti * 64 + r + h * 32) * Nfull + ng); }
    for (int idx = bid; idx < total; idx += nb) {
        const int nti = idx % tn, kti = idx / tn;
#pragma unroll
        for (int h = 0; h < 2; ++h) { LAS float* tp = tile + (r + h * 32) * 65 + c4; tp[0] = v[h][0]; tp[1] = v[h][1]; tp[2] = v[h][2]; tp[3] = v[h][3]; }
        {
            const int nx = idx + nb; vn[0] = (f32x4){0.f, 0.f, 0.f, 0.f}; vn[1] = vn[0];
            if (nx < total) { const int nti2 = nx % tn, kti2 = nx / tn, ng2 = nti2 * 64 + c4;
#pragma unroll
                for (int h = 0; h < 2; ++h) if (ng2 < N) vn[h] = *(const f32x4*)(src + (size_t)(kti2 * 64 + r + h * 32) * Nfull + ng2); } }
        __syncthreads();
        const int n = tid >> 3, k8 = (tid & 7) * 8, ngl = nti * 64 + n;
        float e[8];
#pragma unroll
        for (int i = 0; i < 8; ++i) e[i] = tile[(k8 + i) * 65 + n];
        if (ngl < N) { u32x4 w; w.x = cvt_pk_bf16(e[0], e[1]); w.y = cvt_pk_bf16(e[2], e[3]); w.z = cvt_pk_bf16(e[4], e[5]); w.w = cvt_pk_bf16(e[6], e[7]);
            int drow = ngl; if (FFN_REMAP) { const int up = ngl >= DFF ? 1 : 0, f = ngl - up * DFF; drow = (f >> 7) * 256 + up * 128 + (f & 127); }
            *(u32x4*)(dst + (size_t)drow * ldd + kti * 64 + k8) = w; }
        __syncthreads();
        v[0] = vn[0]; v[1] = vn[1];
    }
}
__device__ __forceinline__ void convT8(const float* __restrict__ src0, int K, int N, unsigned char* __restrict__ dst, int ldd, float scale, LAS float* tile, int bid, int nb, int Nfull = 0, int n0 = 0) {
    const float* __restrict__ src = src0 + n0; if (Nfull == 0) Nfull = N;
    const int tid = threadIdx.x, tk = K >> 6, tn = (N + 63) >> 6, total = tk * tn;
    const int r = tid >> 4, c4 = (tid & 15) * 4;
    f32x4 v[2] = {{0.f, 0.f, 0.f, 0.f}, {0.f, 0.f, 0.f, 0.f}}, vn[2];
    if (bid < total) { const int nti = bid % tn, kti = bid / tn, ng = nti * 64 + c4;
#pragma unroll
        for (int h = 0; h < 2; ++h) if (ng < N) v[h] = *(const f32x4*)(src + (size_t)(kti * 64 + r + h * 32) * Nfull + ng); }
    for (int idx = bid; idx < total; idx += nb) {
        const int nti = idx % tn, kti = idx / tn;
#pragma unroll
        for (int h = 0; h < 2; ++h) { LAS float* tp = tile + (r + h * 32) * 65 + c4; tp[0] = v[h][0]; tp[1] = v[h][1]; tp[2] = v[h][2]; tp[3] = v[h][3]; }
        { const int nx = idx + nb; vn[0] = (f32x4){0.f, 0.f, 0.f, 0.f}; vn[1] = vn[0];
            if (nx < total) { const int nti2 = nx % tn, kti2 = nx / tn, ng2 = nti2 * 64 + c4;
#pragma unroll
                for (int h = 0; h < 2; ++h) if (ng2 < N) vn[h] = *(const f32x4*)(src + (size_t)(kti2 * 64 + r + h * 32) * Nfull + ng2); } }
        __syncthreads();
        const int n = tid >> 3, k8 = (tid & 7) * 8, ngl = nti * 64 + n;
        float e[8];
#pragma unroll
        for (int i = 0; i < 8; ++i) e[i] = tile[(k8 + i) * 65 + n] * scale;
        if (ngl < N) { int p0 = __builtin_amdgcn_cvt_pk_fp8_f32(e[0], e[1], 0, false); p0 = __builtin_amdgcn_cvt_pk_fp8_f32(e[2], e[3], p0, true);
            int p1 = __builtin_amdgcn_cvt_pk_fp8_f32(e[4], e[5], 0, false); p1 = __builtin_amdgcn_cvt_pk_fp8_f32(e[6], e[7], p1, true);
            *(u32x2*)(dst + (size_t)ngl * ldd + kti * 64 + k8) = (u32x2){(unsigned)p0, (unsigned)p1}; }
        __syncthreads();
        v[0] = vn[0]; v[1] = vn[1];
    }
}
__device__ __forceinline__ void rmsnorm_rows(const float* __restrict__ src, const float* __restrict__ w, bf16_t* __restrict__ dst, int rows, int gw, int nw, unsigned char* __restrict__ dst8 = nullptr) {
    const int lane = threadIdx.x & 63;
    f32x4 v[16], vn[16];
    if (gw < rows) { const f32x4* sp = (const f32x4*)(src + (size_t)gw * DM);
#pragma unroll
        for (int i = 0; i < 16; ++i) v[i] = sp[lane + 64 * i]; }
    for (int row = gw; row < rows; row += nw) {
        const int nr = row + nw < rows ? row + nw : row;
        { const f32x4* sp = (const f32x4*)(src + (size_t)nr * DM);
#pragma unroll
          for (int i = 0; i < 16; ++i) vn[i] = sp[lane + 64 * i]; }
        float ss = 0.f;
#pragma unroll
        for (int i = 0; i < 16; ++i) ss += v[i][0] * v[i][0] + v[i][1] * v[i][1] + v[i][2] * v[i][2] + v[i][3] * v[i][3];
        ss = wave_sum(ss);
        const float rstd = rsqrtf(ss * (1.0f / DM) + EPS);
#pragma unroll
        for (int i = 0; i < 16; ++i) { const f32x4 ww = ((const f32x4*)w)[lane + 64 * i];
            u32x2 o; o.x = cvt_pk_bf16(v[i][0] * rstd * ww[0], v[i][1] * rstd * ww[1]); o.y = cvt_pk_bf16(v[i][2] * rstd * ww[2], v[i][3] * rstd * ww[3]);
            *(u32x2*)(dst + (size_t)row * DM + (lane + 64 * i) * 4) = o;
            if (dst8) { int pk = __builtin_amdgcn_cvt_pk_fp8_f32(v[i][0] * rstd * ww[0], v[i][1] * rstd * ww[1], 0, false); pk = __builtin_amdgcn_cvt_pk_fp8_f32(v[i][2] * rstd * ww[2], v[i][3] * rstd * ww[3], pk, true);
                *(int*)(dst8 + (size_t)row * DM + (lane + 64 * i) * 4) = pk; } }
#pragma unroll
        for (int i = 0; i < 16; ++i) v[i] = vn[i];
    }
}

struct Ptrs {
    bf16_t *Win, *Wo, *Wfi, *Wfo, *Wg, *Wple, *Wpool, *Wc1k, *Wc1v, *XN, *PB, *Z, *M, *KC, *VC, *MIX, *ACT, *ERAW;
    float *COS, *SIN, *TAB, *G, *H1, *L, *OACC, *IMPP, *IMPF, *ERSTD; unsigned* BM;
};

__device__ __forceinline__ void phase_prologue(const Params& P, const Ptrs& W, LAS unsigned char* lds) {
    const int bid = blockIdx.x, nb = gridDim.x, tid = threadIdx.x, lane = tid & 63, wv = tid >> 6;
    const int gw = bid * NWAVES + wv, nw = nb * NWAVES; const size_t gt = (size_t)bid * NTHREADS + tid, ntot = (size_t)nb * NTHREADS;
    LAS float* tile = (LAS float*)lds;
    rmsnorm_rows(P.x, P.norm1_w, W.XN, S_, gw, nw, P.ws + WS_XN8);
    convT(P.w_in, DM, POOLW, W.Win, DM, tile, bid, nb, INW, 0);
    convT(P.w_in, DM, INW - OFF_G, W.Win + (size_t)OFF_G * DM, DM, tile, bid, nb, INW, OFF_G);
    convT8(P.w_in, DM, OFF_G - POOLW, P.ws + WS_WIN8, DM, WG8_SCALE, tile, bid, nb, INW, POOLW);
    for (size_t i = gt; i < (size_t)(LDZ - INW) * DM / 8; i += ntot) *(u32x4*)(W.Win + (size_t)INW * DM + i * 8) = (u32x4){0u, 0u, 0u, 0u};
    convT(P.w_o, DM, DM, W.Wo, DM, tile, bid, nb);
    convT<true>(P.w_ffn_in, DM, NFI, W.Wfi, DM, tile, bid, nb);
    for (size_t i = gt; i < (size_t)2 * DM / 8; i += ntot) *(u32x4*)(W.XN - 2 * DM + i * 8) = (u32x4){0u, 0u, 0u, 0u};
    convT(P.w_ffn_out, DFF, DM, W.Wfo, DFF, tile, bid, nb);
    convT8(P.w_ple_gate, DM, DM, (unsigned char*)W.Wg, DM, WG8_SCALE, tile, bid, nb);
    convT(P.w_ple_proj, PLE, DM, W.Wple, PLE, tile, bid, nb);
    for (int g = 0; g < 4; ++g) convT(P.w_pool + (size_t)g * 65536, 256, 256, W.Wpool + (size_t)g * 65536, 256, tile, bid, nb);
    convT(P.cmp_k_w1, 4096, 256, W.Wc1k, 4096, tile, bid, nb);
    convT(P.cmp_v_w1, 4096, 256, W.Wc1v, 4096, tile, bid, nb);
    for (size_t i = gt; i < (size_t)S_ * PLE / 8; i += ntot) { const f32x4 a = *(const f32x4*)(P.p + i * 8), b = *(const f32x4*)(P.p + i * 8 + 4);
        u32x4 w; w.x = cvt_pk_bf16(a[0], a[1]); w.y = cvt_pk_bf16(a[2], a[3]); w.z = cvt_pk_bf16(b[0], b[1]); w.w = cvt_pk_bf16(b[2], b[3]); *(u32x4*)(W.PB + i * 8) = w; }
    for (size_t i = gt; i < (size_t)S_ * 16; i += ntot) { const int t = (int)(i >> 4), fi = (int)(i & 15);
        const float inv = exp2f(-(float)fi * (18.931568569324174f / 16.0f)); const float ang = (float)P.positions[t] * inv;
        const double ad = (double)ang; const double kk = rint(ad * 0.15915494309189535); const float rf = (float)(ad - kk * 6.283185307179586);
        W.COS[i] = __cosf(rf); W.SIN[i] = __sinf(rf); }
    for (int o = gw; o < 512; o += nw) { const int which = o >> 8, j = o & 255; const float* pe = which ? P.cmp_pos_v : P.cmp_pos_k; const float* w1 = which ? P.cmp_v_w1 : P.cmp_k_w1;
        float s = 0.f; for (int r = lane; r < 4096; r += 64) s += pe[r] * w1[(size_t)r * 256 + j];
        s = wave_sum(s); if (lane == 0) W.TAB[o] = s; }
    if (gw == 0) { float mq = fmaxf(fabsf(P.q_norm_w[lane]), fabsf(P.q_norm_w[lane + 64])); mq = wave_max(mq);
        float mc = wave_max(fmaxf(fabsf(P.k_norm_cmp_w[lane]), fabsf(P.k_norm_cmp_w[lane + 64])));
        float ms = wave_max(fmaxf(fabsf(P.k_norm_slc_w[lane]), fabsf(P.k_norm_slc_w[lane + 64])));
        float mw = wave_max(fmaxf(fabsf(P.k_norm_win_w[lane]), fabsf(P.k_norm_win_w[lane + 64])));
        const float c = 11.313708498984761f * 1.4426950408889634f * mq * 1.01f;
        if (lane == 0) { W.TAB[512] = c * mc; W.TAB[513] = c * ms; W.TAB[514] = c * mw; } }
}

__device__ __forceinline__ void phase_postz(const Params& P, const Ptrs& W, int gw, int nw) {
    const int tid = threadIdx.x, lane = tid & 63;
    const f32x2 wq = *(const f32x2*)(P.q_norm_w + 2 * lane), wks = *(const f32x2*)(P.k_norm_slc_w + 2 * lane), wkw = *(const f32x2*)(P.k_norm_win_w + 2 * lane);
    for (int t = gw; t < S_; t += nw) {
        bf16_t* zr = W.Z + (size_t)t * LDZ;
        float cs0 = 0.f, cs1 = 0.f, sn0 = 0.f, sn1 = 0.f;
        if (lane < 16) { const int i0 = (2 * lane) & 15; cs0 = W.COS[t * 16 + i0]; cs1 = W.COS[t * 16 + i0 + 1]; sn0 = W.SIN[t * 16 + i0]; sn1 = W.SIN[t * 16 + i0 + 1]; }
        unsigned uv[32];
#pragma unroll
        for (int v = 0; v < 32; ++v) { const int col = v < 24 ? OFF_Q + v * HD : (v < 28 ? OFF_KV + 2 * 512 + (v - 24) * HD : OFF_KV + 4 * 512 + (v - 28) * HD);
            uv[v] = *((const unsigned*)(zr + col) + lane); }
#pragma unroll
        for (int v = 0; v < 32; ++v) {
            const f32x2 ww = v < 24 ? wq : (v < 28 ? wks : wkw);
            const unsigned u = uv[v]; const float x0 = bf_lo(u), x1 = bf_hi(u);
            const float ss = wave_sum(x0 * x0 + x1 * x1);
            const float rstd = rsqrtf(ss * (1.0f / HD) + EPS);
            float y0 = x0 * rstd * ww[0], y1 = x1 * rstd * ww[1];
            const float p0 = __shfl_xor(y0, 8), p1 = __shfl_xor(y1, 8);
            if (lane < 8) { y0 = y0 * cs0 - p0 * sn0; y1 = y1 * cs1 - p1 * sn1; }
            else if (lane < 16) { y0 = y0 * cs0 + p0 * sn0; y1 = y1 * cs1 + p1 * sn1; }
            uv[v] = cvt_pk_bf16(y0, y1);
        }
        {
            const int gi = lane >> 4, wlen = 2 << gi, c0 = lane * 16; const int cnt = (t + 1) < wlen ? (t + 1) : wlen;
            float s[16];
#pragma unroll
            for (int i = 0; i < 16; ++i) s[i] = 0.f;
            float cur[16];
            for (int i = 0; i < cnt; ++i) { const u32x4 a = *(const u32x4*)(W.Z + (size_t)(t - i) * LDZ + c0), b = *(const u32x4*)(W.Z + (size_t)(t - i) * LDZ + c0 + 8);
                const float e[16] = {bf_lo(a.x), bf_hi(a.x), bf_lo(a.y), bf_hi(a.y), bf_lo(a.z), bf_hi(a.z), bf_lo(a.w), bf_hi(a.w), bf_lo(b.x), bf_hi(b.x), bf_lo(b.y), bf_hi(b.y), bf_lo(b.z), bf_hi(b.z), bf_lo(b.w), bf_hi(b.w)};
#pragma unroll
                for (int q = 0; q < 16; ++q) { s[q] += e[q]; if (i == 0) cur[q] = e[q]; } }
            const float rc = 1.0f / (float)cnt;
            u32x4 o0, o1;
            o0.x = cvt_pk_bf16(s[0] * rc - cur[0], s[1] * rc - cur[1]); o0.y = cvt_pk_bf16(s[2] * rc - cur[2], s[3] * rc - cur[3]);
            o0.z = cvt_pk_bf16(s[4] * rc - cur[4], s[5] * rc - cur[5]); o0.w = cvt_pk_bf16(s[6] * rc - cur[6], s[7] * rc - cur[7]);
            o1.x = cvt_pk_bf16(s[8] * rc - cur[8], s[9] * rc - cur[9]); o1.y = cvt_pk_bf16(s[10] * rc - cur[10], s[11] * rc - cur[11]);
            o1.z = cvt_pk_bf16(s[12] * rc - cur[12], s[13] * rc - cur[13]); o1.w = cvt_pk_bf16(s[14] * rc - cur[14], s[15] * rc - cur[15]);
            *(u32x4*)(W.M + (size_t)t * POOLW + c0) = o0; *(u32x4*)(W.M + (size_t)t * POOLW + c0 + 8) = o1;
        }
#pragma unroll
        for (int v = 0; v < 32; ++v) { const int col = v < 24 ? OFF_Q + v * HD : (v < 28 ? OFF_KV + 2 * 512 + (v - 24) * HD : OFF_KV + 4 * 512 + (v - 28) * HD);
            *((unsigned*)(zr + col) + lane) = uv[v]; }

    }
}

__device__ __forceinline__ void phase_cmpfin(const Params& P, const Ptrs& W) {
    const int tid = threadIdx.x, lane = tid & 63, gw = blockIdx.x * NWAVES + (tid >> 6), nw = gridDim.x * NWAVES;
    const f32x2 wk = *(const f32x2*)(P.k_norm_cmp_w + 2 * lane);
    for (int task = gw; task < 8192; task += nw) {
        const int tk = __builtin_amdgcn_readfirstlane(task);
        const int which = tk >> 12, g = (tk >> 10) & 3, n = tk & 1023;
        bf16_t* dst = (which ? W.VC : W.KC) + ((size_t)g * 1024 + n) * HD;
        if (n == 1023) { ((unsigned*)dst)[lane] = 0u; continue; }
        const float* h = W.H1 + (size_t)tk * 256; const float* w2 = which ? P.cmp_v_w2 : P.cmp_k_w2;
        float a0 = 0.f, a1 = 0.f;
        for (int j = 0; j < 256; ++j) { const float hj = h[j]; const f32x2 wv = *(const f32x2*)(w2 + j * HD + 2 * lane); a0 += hj * wv[0]; a1 += hj * wv[1]; }
        if (which == 0) {
            const float ss = wave_sum(a0 * a0 + a1 * a1); const float rstd = rsqrtf(ss * (1.0f / HD) + EPS);
            a0 = a0 * rstd * wk[0]; a1 = a1 * rstd * wk[1];
            const int tp = 16 * n + 31; const float p0 = __shfl_xor(a0, 8), p1 = __shfl_xor(a1, 8);
            if (lane < 16) { const int i0 = (2 * lane) & 15; const float cs0 = W.COS[tp * 16 + i0], cs1 = W.COS[tp * 16 + i0 + 1], sn0 = W.SIN[tp * 16 + i0], sn1 = W.SIN[tp * 16 + i0 + 1];
                if (lane < 8) { a0 = a0 * cs0 - p0 * sn0; a1 = a1 * cs1 - p1 * sn1; } else { a0 = a0 * cs0 + p0 * sn0; a1 = a1 * cs1 + p1 * sn1; } }
        }
        ((unsigned*)dst)[lane] = cvt_pk_bf16(a0, a1);
    }
}

__device__ __forceinline__ void phase_erstd(const Ptrs& W) {
    const int tid = threadIdx.x, lane = tid & 63, gw = blockIdx.x * NWAVES + (tid >> 6), nw = gridDim.x * NWAVES;
    u32x4 a[8], an[8];
    if (gw < S_) { const u32x4* sp = (const u32x4*)(W.ERAW + (size_t)gw * DM);
#pragma unroll
        for (int i = 0; i < 8; ++i) a[i] = sp[lane + 64 * i]; }
    for (int row = gw; row < S_; row += nw) {
        const int nr = row + nw < S_ ? row + nw : row;
        { const u32x4* sp = (const u32x4*)(W.ERAW + (size_t)nr * DM);
#pragma unroll
          for (int i = 0; i < 8; ++i) an[i] = sp[lane + 64 * i]; }
        float ss = 0.f;
#pragma unroll
        for (int i = 0; i < 8; ++i) {
            const float e0 = bf_lo(a[i].x), e1 = bf_hi(a[i].x), e2 = bf_lo(a[i].y), e3 = bf_hi(a[i].y), e4 = bf_lo(a[i].z), e5 = bf_hi(a[i].z), e6 = bf_lo(a[i].w), e7 = bf_hi(a[i].w);
            ss += e0 * e0 + e1 * e1 + e2 * e2 + e3 * e3 + e4 * e4 + e5 * e5 + e6 * e6 + e7 * e7; }
        ss = wave_sum(ss);
        if (lane == 0) W.ERSTD[row] = rsqrtf(ss * (1.0f / DM) + EPS);
#pragma unroll
        for (int i = 0; i < 8; ++i) a[i] = an[i];
    }
}

constexpr int N_PHASES = 11;
__device__ __forceinline__ Params kargs() {
#if defined(__HIP_DEVICE_COMPILE__)
    unsigned long long p = (unsigned long long)__builtin_amdgcn_kernarg_segment_ptr();
    asm volatile("" : "+s"(p));
    return *(const __attribute__((address_space(4))) Params*)p;
#else
    return Params{};
#endif
}
__device__ __forceinline__ Ptrs mkptrs(unsigned char* ws) {
    Ptrs W;
    W.Win = (bf16_t*)(ws + WS_WIN); W.Wo = (bf16_t*)(ws + WS_WO); W.Wfi = (bf16_t*)(ws + WS_WFI); W.Wfo = (bf16_t*)(ws + WS_WFO); W.Wg = (bf16_t*)(ws + WS_WG);
    W.Wple = (bf16_t*)(ws + WS_WPLE); W.Wpool = (bf16_t*)(ws + WS_WPOOL); W.Wc1k = (bf16_t*)(ws + WS_WC1K); W.Wc1v = (bf16_t*)(ws + WS_WC1V);
    W.XN = (bf16_t*)(ws + WS_XN); W.PB = (bf16_t*)(ws + WS_PB); W.Z = (bf16_t*)(ws + WS_Z); W.M = (bf16_t*)(ws + WS_M); W.KC = (bf16_t*)(ws + WS_KC); W.VC = (bf16_t*)(ws + WS_VC);
    W.MIX = (bf16_t*)(ws + WS_MIX); W.ACT = (bf16_t*)(ws + WS_ACT); W.ERAW = (bf16_t*)(ws + WS_ERAW);
    W.COS = (float*)(ws + WS_COS); W.SIN = (float*)(ws + WS_SIN); W.TAB = (float*)(ws + WS_TAB); W.G = (float*)(ws + WS_G); W.H1 = (float*)(ws + WS_H1); W.L = (float*)(ws + WS_L);
    W.OACC = (float*)(ws + WS_OACC); W.IMPP = (float*)(ws + WS_IMPP); W.IMPF = (float*)(ws + WS_IMPF); W.ERSTD = (float*)(ws + WS_ERSTD); W.BM = (unsigned*)(ws + WS_BM);
    return W;
}
__global__ void __launch_bounds__(NTHREADS, 2) fwd(Params Punused) {
    extern __shared__ __attribute__((aligned(16))) unsigned char lds_raw[];
    LAS unsigned char* lds = (LAS unsigned char*)lds_raw;
    const int tid = threadIdx.x;
    const int G = gridDim.x, bid = blockIdx.x;
    const int gw = bid * NWAVES + (tid >> 6), nw = G * NWAVES;

    if (tid < 16) ((LAS unsigned*)(lds + LDS_MISC))[tid] = 0u;
    __syncthreads();
    int lo, hi; XcdBarrier bar;
    { const Params P = kargs(); lo = P.ph_lo; hi = P.ph_hi;
      bar.bar = (unsigned*)(P.ws + WS_CTL); bar.x = 0; bar.st = (volatile LAS unsigned*)(lds + LDS_MISC);
      if (hi - lo > 1) bar = xcd_barrier_post((unsigned*)(P.ws + WS_CTL), (volatile LAS unsigned*)(lds + LDS_MISC)); }
#ifdef PH_MASK
#define IN(k) (((PH_MASK >> (k)) & 1) && lo <= (k) && (k) < hi)
#else
#define IN(k) (lo <= (k) && (k) < hi)
#endif
#define SEAM(k) do { if (IN(k) && IN((k) + 1)) xcd_barrier(bar); } while (0)
#define PHASE_VARS const Params P = kargs(); const Ptrs W = mkptrs(P.ws); (void)W;
#define ATT_ARGS att::AttnArgs AA{W.Z, W.KC, W.VC, W.G, W.L, W.OACC, W.MIX, W.BM, W.TAB};

    if (IN(0)) { PHASE_VARS REP(0) { phase_prologue(P, W, lds); } SEAM(0); }
    if (IN(1)) {
        PHASE_VARS
        { pg8::GStd g{(const char*)W.XN, (const char*)W.Win, DM, DM, DM / 64}; pg8::StaticOrder S; S.init(S_ / 256, POOLW / 256, G, bid);
          pg8::EpiBf16 E{W.Z, LDZ}; pg8::gemm_phase(lds, g, S, E); }
        { pg8::GStd g{(const char*)(P.ws + WS_XN8), (const char*)(P.ws + WS_WIN8), DM / 2, DM / 2, DM / 128}; pg8::StaticOrder S; S.init(S_ / 256, (OFF_G - POOLW) / 256, G, bid);
          pg8::EpiBf16S E{W.Z + POOLW, LDZ, 1.0f / WG8_SCALE}; pg8::gemm_phase<pg8::GStd, pg8::EpiBf16S, true>(lds, g, S, E); }
        SEAM(1);
    }
    if (IN(2)) {
        PHASE_VARS
        if (G > 64) {
            if (bid < 32) { pg8::GCmp g{(const char*)W.Z, (const char*)W.Wc1k, (const char*)W.Wc1v, 16 * LDZ, 4096, 64}; pg8::StaticOrder S; S.init(32, 1, 32, bid);
                pg8::EpiCmpGelu E{W.H1, W.TAB}; pg8::gemm_phase(lds, g, S, E); }
            else if (bid < 96) {
                pg8::GStd g{(const char*)W.XN, (const char*)(W.Win + (size_t)OFF_G * DM), DM, DM, DM / 64}; pg8::StaticOrder S; S.init(S_ / 256, 1, 64, bid - 32);
                pg8::EpiBf16 E{W.Z + OFF_G, LDZ}; pg8::gemm_phase(lds, g, S, E); }
            else phase_postz(P, W, (bid - 96) * NWAVES + (tid >> 6), (G - 96) * NWAVES);
        } else {
            { pg8::GStd g{(const char*)W.XN, (const char*)(W.Win + (size_t)OFF_G * DM), DM, DM, DM / 64}; pg8::StaticOrder S; S.init(S_ / 256, 1, G, bid);
              pg8::EpiBf16 E{W.Z + OFF_G, LDZ}; pg8::gemm_phase(lds, g, S, E); }
            { pg8::GCmp g{(const char*)W.Z, (const char*)W.Wc1k, (const char*)W.Wc1v, 16 * LDZ, 4096, 64}; pg8::StaticOrder S; S.init(32, 1, G, bid);
              pg8::EpiCmpGelu E{W.H1, W.TAB}; pg8::gemm_phase(lds, g, S, E); }
            phase_postz(P, W, gw, nw);
        }
        SEAM(2);
    }
    if (IN(3)) {
        PHASE_VARS
        for (size_t i = (size_t)bid * NTHREADS + tid; i < (size_t)S_ * NGATE; i += (size_t)G * NTHREADS) { const int t = (int)(i / NGATE), c = (int)(i % NGATE); W.G[i] = sigmoidf_(bf2f(W.Z[(size_t)t * LDZ + OFF_G + c])); }
        phase_cmpfin(P, W);
        { pg8::GPool g{(const char*)W.M, (const char*)W.Wpool, POOLW, 256, 4}; pg8::StaticOrder S; S.init(S_ / 256, 4, G, bid);
          pg8::EpiBf16Scale E{W.MIX, DM, P.pool_scale}; pg8::gemm_phase(lds, g, S, E); }
        SEAM(3);
    }
    if (IN(4)) {
        PHASE_VARS ATT_ARGS
        REP(4)
        for (int base = 0, rnd = 0; base < 1536; base += G, ++rnd) {
            int qt, g, hp;
            if (G == 256) { const int x = bid & 7, r = bid >> 3, qp = (rnd / 3) ? 63 - r : r; if (rnd >= 6) break; g = x & 3; qt = 2 * qp + (x >> 2); hp = rnd % 3; }
            else { const int Lu = base + ((rnd & 1) ? G - 1 - bid : bid); if (Lu >= 1536) continue; qt = Lu / 12; const int rem = Lu % 12; g = rem / 3; hp = rem % 3; }
            att::attn_unit<att::MODE_CMP>(AA, (LAS char*)lds, qt, g, hp);
            asm volatile("s_waitcnt vmcnt(0)" ::: "memory");
            att::attn_unit<att::MODE_WIN>(AA, (LAS char*)lds, qt, g, hp);
            if (G == 256 && hp == 2) {
                asm volatile("s_waitcnt vmcnt(0)" ::: "memory");
                const int tqi = qt * 8 + (tid >> 6);
                att::imp_task(AA, W.IMPP, W.IMPF, tqi, g);
                asm volatile("s_waitcnt vmcnt(0)" ::: "memory");
                f32x4 pp, ff, pn, fn; att::topk_load(W.IMPP, W.IMPF, tqi * 16, g, pp, ff);
                for (int q = 0; q < 16; ++q) { att::topk_load(W.IMPP, W.IMPF, tqi * 16 + (q < 15 ? q + 1 : q), g, pn, fn); att::topk_task(pp, ff, W.BM, tqi * 16 + q, g); pp = pn; ff = fn; } } }
        if (G != 256) SEAM(4);
    }
    if (IN(5)) {
        PHASE_VARS ATT_ARGS
        if (G != 256)
        for (int k = gw, r = 0; k < 4096; k += nw, ++r) { const int hiT = (r + 1) * nw < 4096 ? (r + 1) * nw : 4096;
            const int task = (r & 1) ? hiT - 1 - (k - r * nw) : k;
            att::imp_task(AA, W.IMPP, W.IMPF, task >> 2, task & 3);
            asm volatile("s_waitcnt vmcnt(0)" ::: "memory");
            { const int tb = (task >> 2) * 16, gg = task & 3; f32x4 pp, ff, pn, fn;
              att::topk_load(W.IMPP, W.IMPF, tb, gg, pp, ff);
              for (int q = 0; q < 16; ++q) { att::topk_load(W.IMPP, W.IMPF, tb + (q < 15 ? q + 1 : q), gg, pn, fn); att::topk_task(pp, ff, W.BM, tb + q, gg); pp = pn; ff = fn; } } }
        SEAM(5);
    }
    if (IN(6)) {
        PHASE_VARS ATT_ARGS
        REP(6)
        for (int base = 0, rnd = 0; base < 1640 + G; base += G, ++rnd) {
            int ut, g;
            if (G == 256) { const int x = bid & 7, r = bid >> 3, k = rnd * 32 + ((rnd & 1) ? 31 - r : r); if (k >= 205) break; g = x & 3; ut = 409 - (2 * k + (x >> 2)); }
            else { const int Lu = base + ((rnd & 1) ? G - 1 - bid : bid); if (Lu >= 1640) continue; ut = 409 - Lu / 4; g = Lu % 4; }
            att::attn_unit<att::MODE_SLC>(AA, (LAS char*)lds, ut, g, 0); }
        SEAM(6);
    }
    if (IN(7)) {
        PHASE_VARS
        { pg8::GStd g{(const char*)W.MIX, (const char*)W.Wo, DM, DM, DM / 64}; pg8::StaticOrder S; S.init(S_ / 256, DM / 256, G, bid);
          pg8::EpiResNorm E{P.x, P.out, W.XN, P.norm2_w, (float*)(P.ws + WS_SSQ1), DM}; pg8::gemm_phase(lds, g, S, E); }
        { pg8::GStd g{(const char*)W.PB, (const char*)W.Wple, PLE, PLE, PLE / 64}; pg8::StaticOrder S; S.init(S_ / 256, DM / 256, G, bid);
          pg8::EpiBf16Ssq E{W.ERAW, DM, (float*)(P.ws + WS_SSQ3)}; pg8::gemm_phase(lds, g, S, E); }
        SEAM(7);
    }
    if (IN(8)) {
        PHASE_VARS
        pg8::GFfn g{(const char*)W.XN, (const char*)W.Wfi, DM, DM, DM / 64}; pg8::StaticOrder S; S.init(65, DFF / 128, G, bid);
        pg8::EpiFfn E{W.ACT, P.conv_w, P.conv_b, (LAS float*)(lds + LDS_XCH), (const float*)(P.ws + WS_SSQ1)}; REP(8) { pg8::gemm_phase(lds, g, S, E); } SEAM(8);
    }
    if (IN(9)) {
        PHASE_VARS
        pg8::GStd g{(const char*)W.ACT, (const char*)W.Wfo, DFF, DFF, DFF / 64}; pg8::StaticOrder S; S.init(S_ / 256, DM / 256, G, bid);
        pg8::EpiResNormF8 E{P.out, P.out, W.XN, P.ple_gate_norm_w, (float*)(P.ws + WS_SSQ2), DM}; pg8::gemm_phase(lds, g, S, E); SEAM(9);
    }
    if (IN(10)) {
        PHASE_VARS
        pg8::GStd g{(const char*)W.XN, (const char*)W.Wg, DM / 2, DM / 2, DM / 128}; pg8::StaticOrder S; S.init(S_ / 256, DM / 256, G, bid);
        pg8::EpiGate E{P.out, W.ERAW, (const float*)(P.ws + WS_SSQ3), P.ple_norm_w, (const float*)(P.ws + WS_SSQ2), DM, 1.0f / WG8_SCALE};
        pg8::gemm_phase<pg8::GStd, pg8::EpiGate, true>(lds, g, S, E);
    }
#undef IN
#undef SEAM
}

extern "C" void kernel_launch(void* const* d_in, const int* in_sizes, int n_in, void* d_out, int out_size, void* d_ws, size_t ws_size, hipStream_t stream) {
    static int grid = 0;
    if (grid == 0) {
        if (n_in != 27 || in_sizes[0] != S_ * DM || out_size != S_ * DM || ws_size < WS_NEED) {
            fprintf(stderr, "kernel_launch: unexpected shapes (n_in %d, in0 %d, out %d, ws %zu < %zu); nothing launched\n", n_in, n_in > 0 ? in_sizes[0] : -1, out_size, ws_size, (size_t)WS_NEED); grid = -1; return; }
        int dev = 0, cus = 0, per_cu = 0;
        if (hipGetDevice(&dev) != hipSuccess || hipDeviceGetAttribute(&cus, hipDeviceAttributeMultiprocessorCount, dev) != hipSuccess) { grid = -1; return; }
        if (hipFuncSetAttribute((const void*)fwd, hipFuncAttributeMaxDynamicSharedMemorySize, LDS_BYTES) != hipSuccess) { fprintf(stderr, "kernel_launch: hipFuncSetAttribute failed\n"); grid = -1; return; }
        if (hipOccupancyMaxActiveBlocksPerMultiprocessor(&per_cu, (const void*)fwd, NTHREADS, LDS_BYTES) != hipSuccess || per_cu < 1) { fprintf(stderr, "kernel_launch: occupancy query says %d\n", per_cu); (void)hipGetLastError(); }
        grid = cus > 256 ? 256 : cus;
    }
    if (grid < 0) return;
    (void)hipMemsetAsync((char*)d_ws + WS_CTL, 0, CTL_BYTES, stream);
    Params P{};
    const float** fp = (const float**)&P;
    P.x = (const float*)d_in[0]; P.p = (const float*)d_in[1]; P.positions = (const int*)d_in[2]; P.norm1_w = (const float*)d_in[3]; P.w_in = (const float*)d_in[4];
    P.w_pool = (const float*)d_in[5]; P.pool_scale = (const float*)d_in[6]; P.q_norm_w = (const float*)d_in[7]; P.k_norm_cmp_w = (const float*)d_in[8];
    P.k_norm_slc_w = (const float*)d_in[9]; P.k_norm_win_w = (const float*)d_in[10]; P.cmp_pos_k = (const float*)d_in[11]; P.cmp_pos_v = (const float*)d_in[12];
    P.cmp_k_w1 = (const float*)d_in[13]; P.cmp_k_w2 = (const float*)d_in[14]; P.cmp_v_w1 = (const float*)d_in[15]; P.cmp_v_w2 = (const float*)d_in[16];
    P.w_o = (const float*)d_in[17]; P.norm2_w = (const float*)d_in[18]; P.w_ffn_in = (const float*)d_in[19]; P.conv_w = (const float*)d_in[20]; P.conv_b = (const float*)d_in[21];
    P.w_ffn_out = (const float*)d_in[22]; P.w_ple_proj = (const float*)d_in[23]; P.ple_norm_w = (const float*)d_in[24]; P.ple_gate_norm_w = (const float*)d_in[25]; P.w_ple_gate = (const float*)d_in[26];
    (void)fp;
    P.out = (float*)d_out; P.ws = (unsigned char*)d_ws;
#if MK_ONE_LAUNCH
    P.ph_lo = 0; P.ph_hi = N_PHASES;
    hipLaunchKernelGGL(fwd, dim3(grid), dim3(NTHREADS), LDS_BYTES, stream, P);
#else
    for (int ph = 0; ph < N_PHASES; ++ph) { P.ph_lo = ph; P.ph_hi = ph + 1; hipLaunchKernelGGL(fwd, dim3(grid), dim3(NTHREADS), LDS_BYTES, stream, P); }
#endif
    const hipError_t le = hipPeekAtLastError();
    if (le != hipSuccess) fprintf(stderr, "kernel_launch: launch failed: %s\n", hipGetErrorName(le));
}
```

```cpp
#include <hip/hip_runtime.h>
#include <cstdio>
#include <cstdint>

#ifndef PROBE_DBL
#define PROBE_DBL 0
#endif
#define REP(k) _Pragma("unroll") for (int rep_ = 0; rep_ < 1 + ((PROBE_DBL >> (k)) & 1); ++rep_)
#ifndef MK_ONE_LAUNCH
#define MK_ONE_LAUNCH 1
#endif

#define LAS __attribute__((address_space(3)))
typedef unsigned short bf16_t;
typedef short bf16x8 __attribute__((ext_vector_type(8)));
typedef short s16x4 __attribute__((ext_vector_type(4)));
typedef float f32x2 __attribute__((ext_vector_type(2)));
typedef float f32x4 __attribute__((ext_vector_type(4)));
typedef float f32x16 __attribute__((ext_vector_type(16)));
typedef unsigned u32x2 __attribute__((ext_vector_type(2)));
typedef unsigned u32x4 __attribute__((ext_vector_type(4)));
typedef int i32x4 __attribute__((ext_vector_type(4)));
typedef int i32x8 __attribute__((ext_vector_type(8)));

constexpr int S_ = 16384, DM = 4096, INW = 7240, LDZ = 7424, POOLW = 1024, NH = 24, NKV = 4, HPG = 6, HD = 128;
constexpr int OFF_Q = 1024, OFF_KV = 4096, OFF_G = 7168, DFF = 11008, NFI = 22016, PLE = 256, NGATE = 72;
constexpr int ZROWS = S_ + 64, XNROWS = S_ + 256, CHUNK = 8192;
constexpr float EPS = 1e-6f;
constexpr float SM_C = 0.08838834764831845f * 1.4426950408889634f;
constexpr int NWAVES = 8, NTHREADS = 512;
constexpr float WG8_SCALE = 128.0f;

constexpr size_t al256(size_t x) { return (x + 255) / 256 * 256; }
constexpr size_t WS_CTL   = 0;
constexpr size_t CTL_BYTES = 262144;
constexpr size_t WS_SSQ1 = WS_CTL + 65536, WS_SSQ2 = WS_CTL + 131072, WS_SSQ3 = WS_CTL + 196608;
constexpr size_t WS_WIN   = WS_CTL + CTL_BYTES;
constexpr size_t WS_WO    = WS_WIN + al256((size_t)LDZ * DM * 2);
constexpr size_t WS_WFI   = WS_WO + al256((size_t)DM * DM * 2);
constexpr size_t WS_WFO   = WS_WFI + al256((size_t)NFI * DM * 2);
constexpr size_t WS_WG    = WS_WFO + al256((size_t)DM * DFF * 2);
constexpr size_t WS_WPLE  = WS_WG + al256((size_t)DM * DM * 2);
constexpr size_t WS_WPOOL = WS_WPLE + al256((size_t)DM * PLE * 2);
constexpr size_t WS_WC1K  = WS_WPOOL + al256((size_t)1024 * 256 * 2);
constexpr size_t WS_WC1V  = WS_WC1K + al256((size_t)256 * 4096 * 2);
constexpr size_t WS_COS   = WS_WC1V + al256((size_t)256 * 4096 * 2);
constexpr size_t WS_SIN   = WS_COS + al256((size_t)S_ * 16 * 4);
constexpr size_t WS_TAB   = WS_SIN + al256((size_t)S_ * 16 * 4);
constexpr size_t WS_XNP   = WS_TAB + 4096;
constexpr size_t WS_XN    = WS_XNP + (size_t)2 * DM * 2;
constexpr size_t WS_PB    = WS_XN + al256((size_t)XNROWS * DM * 2);
constexpr size_t WS_XN8   = WS_PB + al256((size_t)S_ * PLE * 2);
constexpr size_t WS_WIN8  = WS_XN8 + al256((size_t)S_ * DM);
constexpr size_t WS_R     = WS_WIN8 + al256((size_t)(OFF_G - POOLW) * DM);
constexpr size_t WS_Z     = WS_R;
constexpr size_t WS_M     = WS_Z + al256((size_t)ZROWS * LDZ * 2);
constexpr size_t WS_G     = WS_M + al256((size_t)S_ * POOLW * 2);
constexpr size_t WS_H1    = WS_G + al256((size_t)S_ * NGATE * 4);
constexpr size_t WS_KC    = WS_H1 + al256((size_t)8192 * 256 * 4);
constexpr size_t WS_VC    = WS_KC + al256((size_t)4 * 1024 * 128 * 2);
constexpr size_t WS_L     = WS_VC + al256((size_t)4 * 1024 * 128 * 2);
constexpr size_t WS_OACC  = WS_L + al256((size_t)S_ * NH * 4);
constexpr size_t WS_IMPP  = WS_OACC + al256((size_t)S_ * 3072 * 4);
constexpr size_t WS_IMPF  = WS_IMPP + al256((size_t)S_ * 4 * 256 * 4);
constexpr size_t WS_BM    = WS_IMPF + al256((size_t)S_ * 4 * 256 * 4);
constexpr size_t WS_MIX   = WS_BM + al256((size_t)S_ * 4 * 8 * 4);
constexpr size_t WS_END_A = WS_MIX + al256((size_t)S_ * DM * 2);
constexpr size_t WS_ERAW  = WS_R;
constexpr size_t WS_ACT   = WS_ERAW + al256((size_t)S_ * DM * 2);
constexpr size_t WS_ERSTD = WS_ACT + al256((size_t)S_ * DFF * 2);
constexpr size_t WS_END_B = WS_ERSTD + al256((size_t)S_ * 4);
static_assert(WS_ERAW + (size_t)S_ * DM * 2 <= WS_Z + (size_t)ZROWS * LDZ * 2, "eraw must fit inside the dead z region while mix is still being read");
constexpr size_t WS_NEED  = WS_END_A > WS_END_B ? WS_END_A : WS_END_B;
static_assert(WS_NEED <= (size_t)1440000000, "workspace map exceeds the guaranteed 4 x largest-tensor bytes");

constexpr int LDS_STAGE = 131072;
constexpr int LDS_MISC  = LDS_STAGE;
constexpr int LDS_XCH   = LDS_STAGE + 64;
constexpr int LDS_BYTES = LDS_XCH + 4096;

__device__ __forceinline__ unsigned cvt_pk_bf16(float lo, float hi) { unsigned r; asm volatile("v_cvt_pk_bf16_f32 %0, %1, %2" : "=v"(r) : "v"(lo), "v"(hi)); return r; }
__device__ __forceinline__ float bf_lo(unsigned u) { return __uint_as_float(u << 16); }
__device__ __forceinline__ float bf_hi(unsigned u) { return __uint_as_float(u & 0xffff0000u); }
__device__ __forceinline__ float bf2f(bf16_t b) { return __uint_as_float(((unsigned)b) << 16); }
__device__ __forceinline__ float wave_sum(float v) {
#pragma unroll
    for (int o = 32; o >= 1; o >>= 1) v += __shfl_xor(v, o);
    return v;
}
__device__ __forceinline__ float wave_max(float v) {
#pragma unroll
    for (int o = 32; o >= 1; o >>= 1) v = fmaxf(v, __shfl_xor(v, o));
    return v;
}
__device__ __forceinline__ float sigmoidf_(float x) { return __builtin_amdgcn_rcpf(1.0f + __expf(-x)); }

#define XB_TMO      128
#define XB_XCNT(j)  (256  + 64 * (j))
#define XB_XSUB(j)  (1280 + 64 * (j))
#define XB_XGEN(j)  (2304 + 64 * (j))
#define XB_TOP      3328
#define XB_TOPGEN   3392
#define XCD_BAR_WORDS 3456
#define XB_SPIN_CAP (1u << 18)
__device__ __forceinline__ unsigned xb_ld(unsigned* p)              { return __hip_atomic_load(p, __ATOMIC_RELAXED, __HIP_MEMORY_SCOPE_AGENT); }
__device__ __forceinline__ unsigned xb_add(unsigned* p, unsigned v) { return __hip_atomic_fetch_add(p, v, __ATOMIC_RELAXED, __HIP_MEMORY_SCOPE_AGENT); }
__device__ __forceinline__ unsigned xb_xcc_id() { return (unsigned)__builtin_amdgcn_s_getreg((3 << 11) | 20) & 0xFu; }
#define XB_SPIN(cond, bar) do { unsigned _sp = 0; while (cond) { __builtin_amdgcn_s_sleep(1); \
    if ((++_sp & 255u) == 0u) { if (xb_ld(&(bar)[XB_TMO])) break; if (_sp > XB_SPIN_CAP) { atomicAdd(&(bar)[XB_TMO], 1u); break; } } } } while (0)
struct XcdBarrier { unsigned* bar; unsigned x; volatile LAS unsigned* st; };
__device__ __forceinline__ XcdBarrier xcd_barrier_post(unsigned* bar, volatile LAS unsigned* st) {
    XcdBarrier b; b.bar = bar; b.x = xb_xcc_id(); b.st = st;
    if (threadIdx.x == 0) (void)xb_add(&bar[XB_XCNT(b.x)], 1u);
    return b;
}
__device__ __forceinline__ void xcd_barrier_complete(unsigned* bar, unsigned x, unsigned& nloc, unsigned& nx) {
    const unsigned G = gridDim.x * gridDim.y * gridDim.z;
    unsigned sum, cnt, mine, sp = 0u;
    for (;;) {
        sum = 0u; cnt = 0u; mine = 0u;
#pragma unroll
        for (unsigned j = 0; j < 16; ++j) { const unsigned c = xb_ld(&bar[XB_XCNT(j)]); sum += c; cnt += (c > 0u) ? 1u : 0u; mine = (j == x) ? c : mine; }
        if (sum == G) break;
        __builtin_amdgcn_s_sleep(1);
        if ((++sp & 255u) == 0u) { if (xb_ld(&bar[XB_TMO])) break; if (sp > XB_SPIN_CAP) { atomicAdd(&bar[XB_TMO], 1u); break; } }
    }
    nloc = mine > 0u ? mine : 1u; nx = cnt > 0u ? cnt : 1u;
}
__device__ __forceinline__ void xcd_barrier(const XcdBarrier& b) {
    asm volatile("s_waitcnt vmcnt(0)" ::: "memory");
    __syncthreads();
    if (threadIdx.x == 0) {
        unsigned* bar = b.bar;
        __builtin_amdgcn_s_waitcnt(0);
        unsigned nloc = b.st[0], nx = b.st[1];
        if (nloc == 0u) { xcd_barrier_complete(bar, b.x, nloc, nx); b.st[0] = nloc; b.st[1] = nx; }
        const unsigned old = xb_add(&bar[XB_XSUB(b.x)], 1u);
        const unsigned gen = old / nloc;
        if (old + 1u == (gen + 1u) * nloc) {
            __builtin_amdgcn_fence(__ATOMIC_RELEASE, "agent");
            asm volatile("s_waitcnt vmcnt(0)" ::: "memory");
            const unsigned og = xb_add(&bar[XB_TOP], 1u);
            const unsigned tg = og / nx;
            if (og + 1u == (tg + 1u) * nx) xb_add(&bar[XB_TOPGEN], 1u);
            else XB_SPIN(xb_ld(&bar[XB_TOPGEN]) == tg, bar);
            __builtin_amdgcn_fence(__ATOMIC_ACQUIRE, "agent");
            xb_add(&bar[XB_XGEN(b.x)], 1u);
            asm volatile("s_waitcnt vmcnt(0)" ::: "memory");
        } else {
            XB_SPIN(xb_ld(&bar[XB_XGEN(b.x)]) == gen, bar);
            __builtin_amdgcn_fence(__ATOMIC_ACQUIRE, "agent");
            asm volatile("s_waitcnt vmcnt(0)" ::: "memory");
        }
    }
    __syncthreads();
}

struct Params {
    const float* x; const float* p; const int* positions; const float* norm1_w; const float* w_in; const float* w_pool; const float* pool_scale;
    const float* q_norm_w; const float* k_norm_cmp_w; const float* k_norm_slc_w; const float* k_norm_win_w; const float* cmp_pos_k; const float* cmp_pos_v;
    const float* cmp_k_w1; const float* cmp_k_w2; const float* cmp_v_w1; const float* cmp_v_w2; const float* w_o; const float* norm2_w; const float* w_ffn_in;
    const float* conv_w; const float* conv_b; const float* w_ffn_out; const float* w_ple_proj; const float* ple_norm_w; const float* ple_gate_norm_w; const float* w_ple_gate;
    float* out; unsigned char* ws; int ph_lo, ph_hi;
};

namespace pg8 {
constexpr int BM = 256, BK = 64, HALF = 128, HTB = HALF * BK * 2, STAGE_BYTES = 8 * HTB, NXCD = 8, WGM = 8;
__host__ __device__ __forceinline__ int lds_byte(int r, int c) { const int st = (r >> 4) * 2 + (c >> 5), rr = r & 15, cc = c & 31, ob = rr * 64 + cc * 2; return st * 1024 + (ob ^ (((ob >> 9) & 1) << 5)); }
__host__ __device__ __forceinline__ void stage_rc(int b, int& R, int& C) { const int st = b / 1024, sb = b % 1024, swz = sb ^ (((sb >> 9) & 1) << 5); R = (st >> 1) * 16 + swz / 64; C = (st & 1) * 32 + (swz % 64) / 2; }
__host__ __device__ __forceinline__ int perm32(int rho) { const int n = rho >> 4, i = rho & 15; return 8 * (i >> 2) + 4 * n + (i & 3); }
struct Unit { int pm, pn; };

struct StaticOrder {
    int nM, nN, nwg, G, c;
    __device__ void init(int nM_, int nN_, int G_, int c_) { nM = nM_; nN = nN_; nwg = nM * nN; G = G_; c = c_; }
    __device__ bool next(int i, Unit& u) const {
        const long L = (long)i * G + c; if (L >= nwg) return false;
        int wgid = (int)L; { const int q = nwg / NXCD, r = nwg % NXCD, xcd = wgid % NXCD, off = wgid / NXCD; wgid = (xcd < r ? xcd * (q + 1) : r * (q + 1) + (xcd - r) * q) + off; }
        const int nig = WGM * nN, gid = wgid / nig, fm = gid * WGM, gsz = (nM - fm) < WGM ? (nM - fm) : WGM;
        u.pm = fm + ((wgid % nig) % gsz); u.pn = (wgid % nig) / gsz; return true;
    }
};

struct GStd {
    const char* A; const char* B; unsigned lda, ldb; int nt;
    __device__ __forceinline__ const char* a_base(const Unit& u) const { return A + (size_t)u.pm * 256 * lda * 2; }
    __device__ __forceinline__ const char* b_base(const Unit& u) const { return B + (size_t)u.pn * 256 * ldb * 2; }
    __device__ __forceinline__ size_t kpairA() const { return 256; }
};
struct GPool {
    const char* A; const char* B; unsigned lda, ldb; int nt;
    __device__ __forceinline__ const char* a_base(const Unit& u) const { return A + (size_t)u.pm * 256 * lda * 2 + (size_t)u.pn * 512; }
    __device__ __forceinline__ const char* b_base(const Unit& u) const { return B + (size_t)u.pn * 256 * ldb * 2; }
    __device__ __forceinline__ size_t kpairA() const { return 256; }
};
struct GCmp {
    const char* Z; const char* Bk; const char* Bv; unsigned lda, ldb; int nt;
    __device__ __forceinline__ const char* a_base(const Unit& u) const { const int which = u.pm >> 4, g = (u.pm >> 2) & 3, rt = u.pm & 3;
        return Z + (size_t)(OFF_KV + which * 512 + g * 128) * 2 + (size_t)rt * 256 * lda * 2; }
    __device__ __forceinline__ const char* b_base(const Unit& u) const { return (u.pm >> 4) ? Bv : Bk; }
    __device__ __forceinline__ size_t kpairA() const { return (size_t)LDZ * 2; }
};

struct EpiBf16 {
    static constexpr bool PERM = true;
    bf16_t* O; int ldc;
    __device__ __forceinline__ void operator()(const f32x4 (&acc)[2][2][4][2], const Unit& u, int wr, int wc, int fr, int fq) const {
        const int row0 = u.pm * BM + wr * 64 + fr, col0 = u.pn * BM + wc * 32 + 8 * fq;
#pragma unroll
        for (int ai = 0; ai < 2; ++ai)
#pragma unroll
            for (int m = 0; m < 4; ++m) { bf16_t* rowp = O + (size_t)(row0 + ai * HALF + m * 16) * ldc + col0;
#pragma unroll
                for (int bj = 0; bj < 2; ++bj) { const f32x4 v0 = acc[ai][bj][m][0], v1 = acc[ai][bj][m][1];
                    u32x4 w; w.x = cvt_pk_bf16(v0[0], v0[1]); w.y = cvt_pk_bf16(v0[2], v0[3]); w.z = cvt_pk_bf16(v1[0], v1[1]); w.w = cvt_pk_bf16(v1[2], v1[3]);
                    *(u32x4*)(rowp + bj * HALF) = w; } }
    }
};
struct EpiBf16S {
    static constexpr bool PERM = true;
    bf16_t* O; int ldc; float s;
    __device__ __forceinline__ void operator()(const f32x4 (&acc)[2][2][4][2], const Unit& u, int wr, int wc, int fr, int fq) const {
        const int row0 = u.pm * BM + wr * 64 + fr, col0 = u.pn * BM + wc * 32 + 8 * fq;
#pragma unroll
        for (int ai = 0; ai < 2; ++ai)
#pragma unroll
            for (int m = 0; m < 4; ++m) { bf16_t* rowp = O + (size_t)(row0 + ai * HALF + m * 16) * ldc + col0;
#pragma unroll
                for (int bj = 0; bj < 2; ++bj) { const f32x4 v0 = acc[ai][bj][m][0] * s, v1 = acc[ai][bj][m][1] * s;
                    u32x4 w; w.x = cvt_pk_bf16(v0[0], v0[1]); w.y = cvt_pk_bf16(v0[2], v0[3]); w.z = cvt_pk_bf16(v1[0], v1[1]); w.w = cvt_pk_bf16(v1[2], v1[3]);
                    *(u32x4*)(rowp + bj * HALF) = w; } }
    }
};
struct EpiBf16Ssq {
    static constexpr bool PERM = true;
    bf16_t* O; int ldc; float* ssq;
    __device__ __forceinline__ void operator()(const f32x4 (&acc)[2][2][4][2], const Unit& u, int wr, int wc, int fr, int fq) const {
        const int row0 = u.pm * BM + wr * 64 + fr, col0 = u.pn * BM + wc * 32 + 8 * fq;
#pragma unroll
        for (int ai = 0; ai < 2; ++ai)
#pragma unroll
            for (int m = 0; m < 4; ++m) { const int row = row0 + ai * HALF + m * 16; bf16_t* rowp = O + (size_t)row * ldc + col0; float s = 0.f;
#pragma unroll
                for (int bj = 0; bj < 2; ++bj) { const f32x4 v0 = acc[ai][bj][m][0], v1 = acc[ai][bj][m][1];
                    s += v0[0] * v0[0] + v0[1] * v0[1] + v0[2] * v0[2] + v0[3] * v0[3] + v1[0] * v1[0] + v1[1] * v1[1] + v1[2] * v1[2] + v1[3] * v1[3];
                    u32x4 w; w.x = cvt_pk_bf16(v0[0], v0[1]); w.y = cvt_pk_bf16(v0[2], v0[3]); w.z = cvt_pk_bf16(v1[0], v1[1]); w.w = cvt_pk_bf16(v1[2], v1[3]);
                    *(u32x4*)(rowp + bj * HALF) = w; }
                s += __shfl_xor(s, 16); s += __shfl_xor(s, 32);
                if (fq == 0) unsafeAtomicAdd(ssq + row, s); }
    }
};
struct EpiBf16Scale {
    static constexpr bool PERM = true;
    bf16_t* O; int ldc; const float* colscale;
    __device__ __forceinline__ void operator()(const f32x4 (&acc)[2][2][4][2], const Unit& u, int wr, int wc, int fr, int fq) const {
        const int row0 = u.pm * BM + wr * 64 + fr, col0 = u.pn * BM + wc * 32 + 8 * fq;
#pragma unroll
        for (int bj = 0; bj < 2; ++bj) { const f32x4 s0 = *(const f32x4*)(colscale + col0 + bj * HALF), s1 = *(const f32x4*)(colscale + col0 + bj * HALF + 4);
#pragma unroll
            for (int ai = 0; ai < 2; ++ai)
#pragma unroll
                for (int m = 0; m < 4; ++m) { bf16_t* rowp = O + (size_t)(row0 + ai * HALF + m * 16) * ldc + col0;
                    const f32x4 v0 = acc[ai][bj][m][0] * s0, v1 = acc[ai][bj][m][1] * s1;
                    u32x4 w; w.x = cvt_pk_bf16(v0[0], v0[1]); w.y = cvt_pk_bf16(v0[2], v0[3]); w.z = cvt_pk_bf16(v1[0], v1[1]); w.w = cvt_pk_bf16(v1[2], v1[3]);
                    *(u32x4*)(rowp + bj * HALF) = w; } }
    }
};
struct EpiResF32 {
    static constexpr bool PERM = false;
    const float* base; float* C; int ldc; int row_off;
    __device__ __forceinline__ void operator()(const f32x4 (&acc)[2][2][4][2], const Unit& u, int wr, int wc, int fr, int fq) const {
        const int row0 = u.pm * BM + wr * 64 + fr + row_off, col0 = u.pn * BM + wc * 32 + 4 * fq;
#pragma unroll
        for (int ai = 0; ai < 2; ++ai)
#pragma unroll
            for (int m = 0; m < 4; ++m) { const size_t off = (size_t)(row0 + ai * HALF + m * 16) * ldc + col0;
#pragma unroll
                for (int bj = 0; bj < 2; ++bj)
#pragma unroll
                    for (int n = 0; n < 2; ++n) { const f32x4 b = *(const f32x4*)(base + off + bj * HALF + n * 16); *(f32x4*)(C + off + bj * HALF + n * 16) = b + acc[ai][bj][m][n]; }
                asm volatile("" ::: "memory"); }
    }
};
template <bool FP8OUT>
struct EpiResNormT {
    static constexpr bool PERM = false;
    const float* base; float* C; bf16_t* XN; const float* nw; float* ssq; int ldc;
    __device__ __forceinline__ void operator()(const f32x4 (&acc)[2][2][4][2], const Unit& u, int wr, int wc, int fr, int fq) const {
        const int row0 = u.pm * BM + wr * 64 + fr, col0 = u.pn * BM + wc * 32 + 4 * fq;
        f32x4 wv[2][2];
#pragma unroll
        for (int bj = 0; bj < 2; ++bj)
#pragma unroll
            for (int n = 0; n < 2; ++n) wv[bj][n] = *(const f32x4*)(nw + col0 + bj * HALF + n * 16);
        f32x4 bv[2][2][2];
#pragma unroll
        for (int bj = 0; bj < 2; ++bj)
#pragma unroll
            for (int n = 0; n < 2; ++n) bv[0][bj][n] = *(const f32x4*)(base + (size_t)row0 * ldc + col0 + bj * HALF + n * 16);
#pragma unroll
        for (int rg = 0; rg < 8; ++rg) { const int ai = rg >> 2, m = rg & 3; const int row = row0 + ai * HALF + m * 16; const size_t off = (size_t)row * ldc + col0;
            if (rg < 7) { const int ai2 = (rg + 1) >> 2, m2 = (rg + 1) & 3; const size_t off2 = (size_t)(row0 + ai2 * HALF + m2 * 16) * ldc + col0;
#pragma unroll
                for (int bj = 0; bj < 2; ++bj)
#pragma unroll
                    for (int n = 0; n < 2; ++n) bv[(rg + 1) & 1][bj][n] = *(const f32x4*)(base + off2 + bj * HALF + n * 16); }
            float s = 0.f;
#pragma unroll
            for (int bj = 0; bj < 2; ++bj)
#pragma unroll
                for (int n = 0; n < 2; ++n) { const f32x4 v = bv[rg & 1][bj][n] + acc[ai][bj][m][n];
                    *(f32x4*)(C + off + bj * HALF + n * 16) = v; s += v[0] * v[0] + v[1] * v[1] + v[2] * v[2] + v[3] * v[3];
                    if (FP8OUT) { int pk = __builtin_amdgcn_cvt_pk_fp8_f32(v[0] * wv[bj][n][0], v[1] * wv[bj][n][1], 0, false); pk = __builtin_amdgcn_cvt_pk_fp8_f32(v[2] * wv[bj][n][2], v[3] * wv[bj][n][3], pk, true);
                        *(int*)((unsigned char*)XN + off + bj * HALF + n * 16) = pk; }
                    else { u32x2 o; o.x = cvt_pk_bf16(v[0] * wv[bj][n][0], v[1] * wv[bj][n][1]); o.y = cvt_pk_bf16(v[2] * wv[bj][n][2], v[3] * wv[bj][n][3]);
                        *(u32x2*)(XN + off + bj * HALF + n * 16) = o; } }
            s += __shfl_xor(s, 16); s += __shfl_xor(s, 32);
            if (fq == 0) unsafeAtomicAdd(ssq + row, s);
        }
    }
};
typedef EpiResNormT<false> EpiResNorm;
typedef EpiResNormT<true> EpiResNormF8;
struct EpiCmpGelu {
    static constexpr bool PERM = false;
    float* H; const float* bias;
    __device__ __forceinline__ void operator()(const f32x4 (&acc)[2][2][4][2], const Unit& u, int wr, int wc, int fr, int fq) const {
        const int row0 = u.pm * BM + wr * 64 + fr, col0 = wc * 32 + 4 * fq; const float* bs = bias + (u.pm >> 4) * 256;
        f32x4 bvv[2][2];
#pragma unroll
        for (int bj = 0; bj < 2; ++bj)
#pragma unroll
            for (int n = 0; n < 2; ++n) bvv[bj][n] = *(const f32x4*)(bs + col0 + bj * HALF + n * 16);
#pragma unroll
        for (int ai = 0; ai < 2; ++ai)
#pragma unroll
            for (int m = 0; m < 4; ++m) { float* rowp = H + (size_t)(row0 + ai * HALF + m * 16) * 256 + col0;
#pragma unroll
                for (int bj = 0; bj < 2; ++bj)
#pragma unroll
                    for (int n = 0; n < 2; ++n) { f32x4 v = acc[ai][bj][m][n] + bvv[bj][n];
#pragma unroll
                        for (int j = 0; j < 4; ++j) { const float xx = v[j], uu = 0.7978845608028654f * (xx + 0.044715f * xx * xx * xx); const float th = 1.0f - 2.0f / (1.0f + __expf(2.0f * uu)); v[j] = 0.5f * xx * (1.0f + th); }
                        *(f32x4*)(rowp + bj * HALF + n * 16) = v; } }
    }
};
struct EpiGate {
    static constexpr bool PERM = false;
    float* C; const bf16_t* eraw; const float* erstd; const float* pw; const float* ssq; int ldc; float ascale;
    __device__ __forceinline__ void operator()(const f32x4 (&acc)[2][2][4][2], const Unit& u, int wr, int wc, int fr, int fq) const {
        const int row0 = u.pm * BM + wr * 64 + fr, col0 = u.pn * BM + wc * 32 + 4 * fq;
        f32x4 wv[2][2];
#pragma unroll
        for (int bj = 0; bj < 2; ++bj)
#pragma unroll
            for (int n = 0; n < 2; ++n) wv[bj][n] = *(const f32x4*)(pw + col0 + bj * HALF + n * 16);
        f32x4 bv[2][2][2]; u32x2 ev[2][2][2]; float rsv[2], rgv[2];
#pragma unroll
        for (int bj = 0; bj < 2; ++bj)
#pragma unroll
            for (int n = 0; n < 2; ++n) { bv[0][bj][n] = *(const f32x4*)(C + (size_t)row0 * ldc + col0 + bj * HALF + n * 16); ev[0][bj][n] = *(const u32x2*)(eraw + (size_t)row0 * ldc + col0 + bj * HALF + n * 16); }
        rsv[0] = erstd[row0]; rgv[0] = ssq[row0];
#pragma unroll
        for (int rg = 0; rg < 8; ++rg) { const int ai = rg >> 2, m = rg & 3; const int row = row0 + ai * HALF + m * 16; const size_t off = (size_t)row * ldc + col0;
            if (rg < 7) { const int ai2 = (rg + 1) >> 2, m2 = (rg + 1) & 3; const int row2 = row0 + ai2 * HALF + m2 * 16; const size_t off2 = (size_t)row2 * ldc + col0;
#pragma unroll
                for (int bj = 0; bj < 2; ++bj)
#pragma unroll
                    for (int n = 0; n < 2; ++n) { bv[(rg + 1) & 1][bj][n] = *(const f32x4*)(C + off2 + bj * HALF + n * 16); ev[(rg + 1) & 1][bj][n] = *(const u32x2*)(eraw + off2 + bj * HALF + n * 16); }
                rsv[(rg + 1) & 1] = erstd[row2]; rgv[(rg + 1) & 1] = ssq[row2]; }
            const float rs = rsqrtf(rsv[rg & 1] * (1.0f / DM) + EPS), rg_ = rsqrtf(rgv[rg & 1] * (1.0f / DM) + EPS) * ascale;
#pragma unroll
            for (int bj = 0; bj < 2; ++bj)
#pragma unroll
                for (int n = 0; n < 2; ++n) { const f32x4 b = bv[rg & 1][bj][n]; const u32x2 e = ev[rg & 1][bj][n]; const f32x4 a = acc[ai][bj][m][n]; f32x4 o;
                    o[0] = b[0] + bf_lo(e.x) * rs * wv[bj][n][0] * sigmoidf_(a[0] * rg_); o[1] = b[1] + bf_hi(e.x) * rs * wv[bj][n][1] * sigmoidf_(a[1] * rg_);
                    o[2] = b[2] + bf_lo(e.y) * rs * wv[bj][n][2] * sigmoidf_(a[2] * rg_); o[3] = b[3] + bf_hi(e.y) * rs * wv[bj][n][3] * sigmoidf_(a[3] * rg_);
                    *(f32x4*)(C + off + bj * HALF + n * 16) = o; }
        }
    }
};
struct GFfn {
    const char* A; const char* B; unsigned lda, ldb; int nt;
    __device__ __forceinline__ const char* a_base(const Unit& u) const { return A + ((long)u.pm * 254 - 2) * (long)lda * 2; }
    __device__ __forceinline__ const char* b_base(const Unit& u) const { return B + (size_t)u.pn * 256 * ldb * 2; }
    __device__ __forceinline__ size_t kpairA() const { return 256; }
};
template <int CTRL> __device__ __forceinline__ float dpp_f(float v) { return __int_as_float(__builtin_amdgcn_update_dpp(0, __float_as_int(v), CTRL, 0xf, 0xf, false)); }
struct EpiFfn {
    static constexpr bool PERM = true;
    bf16_t* ACT; const float* cw; const float* cb; LAS float* X; const float* ssq;
    __device__ __forceinline__ void operator()(const f32x4 (&acc)[2][2][4][2], const Unit& u, int wr, int wc, int fr, int fq) const {
        const int colw = wc * 32 + 8 * fq;
        const int f0 = u.pn * 128 + colw;
        f32x4 w0[2], w1[2], w2[2], cbv[2];
#pragma unroll
        for (int n = 0; n < 2; ++n) { w0[n] = *(const f32x4*)(cw + f0 + 4 * n); w1[n] = *(const f32x4*)(cw + DFF + f0 + 4 * n); w2[n] = *(const f32x4*)(cw + 2 * DFF + f0 + 4 * n); cbv[n] = *(const f32x4*)(cb + f0 + 4 * n); }
        float rsv[2][4];
#pragma unroll
        for (int ai = 0; ai < 2; ++ai)
#pragma unroll
            for (int m = 0; m < 4; ++m) { const long t = (long)u.pm * 254 - 2 + ai * HALF + wr * 64 + m * 16 + fr; rsv[ai][m] = ssq[t < 0 ? 0 : (t >= S_ ? S_ - 1 : t)]; }
#pragma unroll
        for (int ai = 0; ai < 2; ++ai)
#pragma unroll
            for (int m = 0; m < 4; ++m) { const long t = (long)u.pm * 254 - 2 + ai * HALF + wr * 64 + m * 16 + fr; rsv[ai][m] = (t >= 0 && t < S_) ? rsqrtf(rsv[ai][m] * (1.0f / DM) + EPS) : 0.f; }
        if (fr >= 14) {
#pragma unroll
            for (int ai = 0; ai < 2; ++ai)
#pragma unroll
                for (int n = 0; n < 2; ++n) *(LAS f32x4*)(X + ((2 * ai + wr) * 2 + (fr - 14)) * 128 + colw + 4 * n) = acc[ai][0][3][n] * rsv[ai][3];
        }
        asm volatile("s_waitcnt lgkmcnt(0)" ::: "memory");
        __builtin_amdgcn_s_barrier(); asm volatile("" ::: "memory");
        __builtin_amdgcn_s_barrier(); asm volatile("" ::: "memory");
        const bool sel1 = fr == 15, sel2 = fr >= 14;
#pragma unroll
        for (int ai = 0; ai < 2; ++ai) {
            f32x4 pv[2];
            const int pseg = 2 * ai + wr - 1;
#pragma unroll
            for (int n = 0; n < 2; ++n) { pv[n] = (f32x4){0.f, 0.f, 0.f, 0.f}; if (pseg >= 0 && fr >= 14) pv[n] = *(const LAS f32x4*)(X + (pseg * 2 + (fr - 14)) * 128 + colw + 4 * n); }
#pragma unroll
            for (int m = 0; m < 4; ++m) {
                const int r = ai * HALF + wr * 64 + m * 16 + fr; const long t = (long)u.pm * 254 - 2 + r;
                unsigned ow[4];
#pragma unroll
                for (int n = 0; n < 2; ++n) {
                    const f32x4 cur = acc[ai][0][m][n] * rsv[ai][m], up = acc[ai][1][m][n] * rsv[ai][m];
                    f32x4 x1, x2;
#pragma unroll
                    for (int i = 0; i < 4; ++i) { x1[i] = dpp_f<0x121>(sel1 ? pv[n][i] : cur[i]); x2[i] = dpp_f<0x122>(sel2 ? pv[n][i] : cur[i]); }
                    const f32x4 y = cbv[n] + w0[n] * x2 + w1[n] * x1 + w2[n] * cur;
                    f32x4 sg;
#pragma unroll
                    for (int i = 0; i < 4; ++i) sg[i] = sigmoidf_(y[i]);
                    const f32x4 o = y * sg * up;
                    ow[2 * n] = cvt_pk_bf16(o[0], o[1]); ow[2 * n + 1] = cvt_pk_bf16(o[2], o[3]);
                    pv[n] = cur;
                }
                if (r >= 2 && t < S_) *(u32x4*)(ACT + (size_t)t * DFF + f0) = (u32x4){ow[0], ow[1], ow[2], ow[3]};
            }
        }
    }
};

template <class GD, class Epi, bool F8 = false>
__device__ __forceinline__ void gemm_phase(LAS unsigned char* lds, const GD g, const StaticOrder& S, const Epi& E) {
    const int tid = threadIdx.x, wid = __builtin_amdgcn_readfirstlane(tid >> 6), lane = tid & 63, wr = wid >> 2, wc = wid & 3, fr = lane & 15, fq = lane >> 4;
    const int nt = g.nt;
    unsigned voffA[2], voffB[2];
#pragma unroll
    for (int i = 0; i < 2; ++i) { int R, C; stage_rc(tid * 16 + i * 8192, R, C); const int Rb = Epi::PERM ? ((R & ~31) + perm32(R & 31)) : R;
        voffA[i] = (unsigned)(R * g.lda + C) * 2u; voffB[i] = (unsigned)(Rb * g.ldb + C) * 2u; }
    const size_t kpA = g.kpairA();
    const size_t hstepA = (size_t)HALF * g.lda * 2, hstepB = (size_t)HALF * g.ldb * 2;
    const unsigned ldsw = (unsigned)wid * 1024u;
    const int aoff = lds_byte(wr * 64 + fr, fq * 8), boff = lds_byte(wc * 32 + fr, fq * 8);
#define PG8_SA(b, h) (((b) * 2 + (h)) * HTB)
#define PG8_SB(b, h) ((4 + (b) * 2 + (h)) * HTB)
#define PG8_STAGE(bufoff, gbase, voff) do { _Pragma("unroll") for (int _i = 0; _i < 2; ++_i) \
        __builtin_amdgcn_global_load_lds((const unsigned*)((const char*)(gbase) + (voff)[_i]), (LAS unsigned*)(lds + (bufoff) + ldsw + _i * 8192), 16, 0, 0); } while (0)
#define PG8_LDA(dst, b, h) do { if constexpr (F8) { _Pragma("unroll") for (int m = 0; m < 4; ++m) { const i32x4 lo_ = *(const LAS i32x4*)(lds + PG8_SA(b, h) + aoff + m * 2048), hi_ = *(const LAS i32x4*)(lds + PG8_SA(b, h) + aoff + m * 2048 + 1024); \
            dst##8[m] = __builtin_shufflevector(lo_, hi_, 0, 1, 2, 3, 4, 5, 6, 7); } } \
        else { _Pragma("unroll") for (int m = 0; m < 4; ++m) _Pragma("unroll") for (int k = 0; k < 2; ++k) dst[m][k] = *(const LAS bf16x8*)(lds + PG8_SA(b, h) + aoff + m * 2048 + k * 1024); } } while (0)
#define PG8_LDB(dst, b, h) do { if constexpr (F8) { _Pragma("unroll") for (int n = 0; n < 2; ++n) { const i32x4 lo_ = *(const LAS i32x4*)(lds + PG8_SB(b, h) + boff + n * 2048), hi_ = *(const LAS i32x4*)(lds + PG8_SB(b, h) + boff + n * 2048 + 1024); \
            dst##8[n] = __builtin_shufflevector(lo_, hi_, 0, 1, 2, 3, 4, 5, 6, 7); } } \
        else { _Pragma("unroll") for (int n = 0; n < 2; ++n) _Pragma("unroll") for (int k = 0; k < 2; ++k) dst[n][k] = *(const LAS bf16x8*)(lds + PG8_SB(b, h) + boff + n * 2048 + k * 1024); } } while (0)
#define PG8_MMA(ai, bj, At, Bt) do { __builtin_amdgcn_s_setprio(1); \
        if constexpr (F8) { _Pragma("unroll") for (int m = 0; m < 4; ++m) _Pragma("unroll") for (int n = 0; n < 2; ++n) \
            asm volatile("v_mfma_scale_f32_16x16x128_f8f6f4 %0, %1, %2, %0, %3, %3 op_sel_hi:[0,0,0]" : "+v"(acc[ai][bj][m][n]) : "v"(Bt##8[n]), "v"(At##8[m]), "v"(one_scale)); } \
        else { _Pragma("unroll") for (int m = 0; m < 4; ++m) _Pragma("unroll") for (int n = 0; n < 2; ++n) _Pragma("unroll") for (int k = 0; k < 2; ++k) \
            acc[ai][bj][m][n] = __builtin_amdgcn_mfma_f32_16x16x32_bf16(Bt[n][k], At[m][k], acc[ai][bj][m][n], 0, 0, 0); } \
        __builtin_amdgcn_s_setprio(0); } while (0)
#define PG8_WAIT_V(n) asm volatile("s_waitcnt vmcnt(" #n ")" ::: "memory")
#define PG8_WAIT_L(n) asm volatile("s_waitcnt lgkmcnt(" #n ")" ::: "memory")
#define PG8_BAR __builtin_amdgcn_s_barrier()
#define PG8_SCHED __builtin_amdgcn_sched_barrier(0)
    Unit cur, nxt; int ui = 0;
    if (!S.next(0, cur)) return;
    f32x4 acc[2][2][4][2];
#pragma unroll
    for (int a = 0; a < 2; ++a)
#pragma unroll
        for (int b = 0; b < 2; ++b)
#pragma unroll
            for (int m = 0; m < 4; ++m)
#pragma unroll
                for (int n = 0; n < 2; ++n) acc[a][b][m][n] = (f32x4){0.f, 0.f, 0.f, 0.f};
    bf16x8 At[4][2], B0[2][2], B1[2][2];
    i32x8 At8[4], B08[2], B18[2];
    (void)At; (void)B0; (void)B1; (void)At8; (void)B08; (void)B18;
    int one_scale = 0x7F7F7F7F; (void)one_scale;
    const char* cA = g.a_base(cur); const char* cB = g.b_base(cur);
    PG8_STAGE(PG8_SB(0, 0), cB, voffB); PG8_STAGE(PG8_SA(0, 0), cA, voffA); PG8_STAGE(PG8_SB(0, 1), cB + hstepB, voffB); PG8_STAGE(PG8_SA(0, 1), cA + hstepA, voffA);
    if (wr == 1) PG8_BAR;
    PG8_WAIT_V(4); PG8_BAR;
    PG8_STAGE(PG8_SB(1, 0), cB + 128, voffB); PG8_STAGE(PG8_SA(1, 0), cA + 128, voffA); PG8_STAGE(PG8_SB(1, 1), cB + hstepB + 128, voffB);
    PG8_WAIT_V(6); PG8_BAR;
    for (;;) {
        const bool has_next = S.next(ui + 1, nxt);
        const char* nA = has_next ? g.a_base(nxt) : cA; const char* nB = has_next ? g.b_base(nxt) : cB;
        for (int t = 0; t < nt; t += 2) {
            const bool last = (t == nt - 2);
            const char* a0 = cA + (size_t)(t >> 1) * kpA;
            const char* a1 = a0 + 128;
            const char* a2 = last ? nA : a0 + kpA; const char* b2 = last ? nB : cB + (size_t)(t + 2) * 128;
            const char* a3 = a2 + 128; const char* b3 = b2 + 128;
            PG8_LDB(B0, 0, 0); PG8_SCHED; PG8_LDA(At, 0, 0); PG8_STAGE(PG8_SA(1, 1), a1 + hstepA, voffA);
            PG8_WAIT_L(8); PG8_BAR; PG8_WAIT_L(0); PG8_MMA(0, 0, At, B0); PG8_BAR; PG8_SCHED;
            PG8_LDB(B1, 0, 1); PG8_STAGE(PG8_SB(0, 0), b2, voffB);
            PG8_BAR; PG8_WAIT_L(0); PG8_MMA(0, 1, At, B1); PG8_BAR;
            PG8_LDA(At, 0, 1); PG8_STAGE(PG8_SA(0, 0), a2, voffA);
            PG8_BAR; PG8_WAIT_L(0); PG8_MMA(1, 0, At, B0); PG8_BAR; PG8_SCHED;
            PG8_STAGE(PG8_SB(0, 1), b2 + hstepB, voffB);
            PG8_WAIT_V(6); PG8_BAR; PG8_MMA(1, 1, At, B1); PG8_BAR;
            PG8_LDB(B0, 1, 0); PG8_SCHED; PG8_LDA(At, 1, 0); PG8_STAGE(PG8_SA(0, 1), a2 + hstepA, voffA);
            PG8_WAIT_L(8); PG8_BAR; PG8_WAIT_L(0); PG8_MMA(0, 0, At, B0); PG8_BAR; PG8_SCHED;
            PG8_LDB(B1, 1, 1); PG8_STAGE(PG8_SB(1, 0), b3, voffB);
            PG8_BAR; PG8_WAIT_L(0); PG8_MMA(0, 1, At, B1); PG8_BAR;
            PG8_LDA(At, 1, 1); PG8_STAGE(PG8_SA(1, 0), a3, voffA);
            PG8_BAR; PG8_WAIT_L(0); PG8_MMA(1, 0, At, B0); PG8_BAR; PG8_SCHED;
            PG8_STAGE(PG8_SB(1, 1), b3 + hstepB, voffB);
            PG8_WAIT_V(6); PG8_BAR; PG8_MMA(1, 1, At, B1); PG8_BAR;
        }
        if constexpr (F8) asm volatile("s_nop 15\n\ts_nop 15\n\ts_nop 15" ::: "memory");
        E(acc, cur, wr, wc, fr, fq);
        if (!has_next) break;
#pragma unroll
        for (int a = 0; a < 2; ++a)
#pragma unroll
            for (int b = 0; b < 2; ++b)
#pragma unroll
                for (int m = 0; m < 4; ++m)
#pragma unroll
                    for (int n = 0; n < 2; ++n) acc[a][b][m][n] = (f32x4){0.f, 0.f, 0.f, 0.f};
        cur = nxt; cA = nA; cB = nB; ++ui;
    }
    PG8_WAIT_V(0);
    if (wr == 0) PG8_BAR;
    PG8_BAR;
#undef PG8_SA
#undef PG8_SB
#undef PG8_STAGE
#undef PG8_LDA
#undef PG8_LDB
#undef PG8_MMA
#undef PG8_WAIT_V
#undef PG8_WAIT_L
#undef PG8_BAR
#undef PG8_SCHED
}
}

namespace att {
constexpr int KVBLK = 64;
constexpr int SHM_V = KVBLK * HD * 2, SHM_K = KVBLK * HD * 2, SHM_ATTN = 2 * SHM_V + 2 * SHM_K + NWAVES * 64 * 4;
#define KSWZ(row, colB) ((row) * 256 + ((colB) ^ (((row) & 7) << 4)))
#define SBAR() __builtin_amdgcn_sched_barrier(0)
__device__ __forceinline__ int crow(int r, int hi) { return (r & 3) + 8 * (r >> 2) + 4 * hi; }
__device__ __forceinline__ void qkt(f32x16& p0, f32x16& p1, const char* Ks, const bf16x8* qr, int r32, int hi) {
    p0 = f32x16{}; p1 = f32x16{};
    bf16x8 ka[2], kb[2];
    { const int cb = (hi * 8) * 2; ka[0] = *reinterpret_cast<const bf16x8*>(Ks + KSWZ(r32, cb)); kb[0] = *reinterpret_cast<const bf16x8*>(Ks + KSWZ(32 + r32, cb)); }
#pragma unroll
    for (int d0 = 0; d0 < 8; ++d0) {
        if (d0 < 7) { const int cb = ((d0 + 1) * 16 + hi * 8) * 2;
            ka[(d0 + 1) & 1] = *reinterpret_cast<const bf16x8*>(Ks + KSWZ(r32, cb)); kb[(d0 + 1) & 1] = *reinterpret_cast<const bf16x8*>(Ks + KSWZ(32 + r32, cb)); }
        SBAR();
        p0 = __builtin_amdgcn_mfma_f32_32x32x16_bf16(ka[d0 & 1], qr[d0], p0, 0, 0, 0);
        p1 = __builtin_amdgcn_mfma_f32_32x32x16_bf16(kb[d0 & 1], qr[d0], p1, 0, 0, 0);
        SBAR();
    }
}
__device__ __forceinline__ int v_st(int k, int c) { const int kk = (k & ~0xC) | ((k & 4) << 1) | ((k & 8) >> 1); return ((kk >> 3) * 4 + (c >> 5)) * 512 + ((kk & 7) * 32 + (c & 31)) * 2; }
__device__ __forceinline__ int v_rd_base(int lane) { return ((lane & 3) << 3) | (((lane >> 2) & 3) << 6) | (((lane >> 4) & 1) << 5) | (((lane >> 5) & 1) << 8); }
constexpr int v_rd_off(int d0, int ks, int half) { return d0 * 512 + ks * 4096 + half * 2048; }
__device__ __forceinline__ s16x4 tr_read(int vb, int off) { return __builtin_amdgcn_ds_read_tr16_b64_v4i16((LAS s16x4*)(unsigned long)(unsigned)(vb + off)); }
__device__ __forceinline__ void pv_d0(f32x16* o, int vb, bf16x8 pa0, bf16x8 pa1, bf16x8 pa2, bf16x8 pa3) {
    s16x4 L[2][4], H[2][4];
#pragma unroll
    for (int d0 = 0; d0 < 4; ++d0) { L[0][d0] = tr_read(vb, v_rd_off(d0, 0, 0)); H[0][d0] = tr_read(vb, v_rd_off(d0, 0, 1)); }
#pragma unroll
    for (int ks = 0; ks < 4; ++ks) {
        if (ks < 3) {
#pragma unroll
            for (int d0 = 0; d0 < 4; ++d0) { L[(ks + 1) & 1][d0] = tr_read(vb, v_rd_off(d0, ks + 1, 0)); H[(ks + 1) & 1][d0] = tr_read(vb, v_rd_off(d0, ks + 1, 1)); }
        }
        const bf16x8 pa = ks == 0 ? pa0 : (ks == 1 ? pa1 : (ks == 2 ? pa2 : pa3));
#pragma unroll
        for (int d0 = 0; d0 < 4; ++d0) { const s16x4 l = L[ks & 1][d0], h = H[ks & 1][d0];
            o[d0] = __builtin_amdgcn_mfma_f32_32x32x16_bf16(pa, (bf16x8){l[0], l[1], l[2], l[3], h[0], h[1], h[2], h[3]}, o[d0], 0, 0, 0); }
    }
}
__device__ __forceinline__ void pack_p(const f32x16& p0, const f32x16& p1, bf16x8& pa0, bf16x8& pa1, bf16x8& pa2, bf16x8& pa3) {
#define PK4(P, BASE, OUT) do { unsigned a0 = cvt_pk_bf16(P[BASE + 0], P[BASE + 1]), a1 = cvt_pk_bf16(P[BASE + 2], P[BASE + 3]);   \
    unsigned b0 = cvt_pk_bf16(P[BASE + 4], P[BASE + 5]), b1 = cvt_pk_bf16(P[BASE + 6], P[BASE + 7]);                              \
    auto r0 = __builtin_amdgcn_permlane32_swap(a0, b0, false, false); auto r1 = __builtin_amdgcn_permlane32_swap(a1, b1, false, false); \
    u32x4 w = {r0[0], r1[0], r0[1], r1[1]}; OUT = *reinterpret_cast<bf16x8*>(&w); } while (0)
    PK4(p0, 0, pa0); PK4(p0, 8, pa1); PK4(p1, 0, pa2); PK4(p1, 8, pa3);
#undef PK4
}

__device__ __forceinline__ void pack_half(const f32x16& p, bf16x8& paA, bf16x8& paB) {
#define PK4(P, BASE, OUT) do { unsigned a0 = cvt_pk_bf16(P[BASE + 0], P[BASE + 1]), a1 = cvt_pk_bf16(P[BASE + 2], P[BASE + 3]);   \
    unsigned b0 = cvt_pk_bf16(P[BASE + 4], P[BASE + 5]), b1 = cvt_pk_bf16(P[BASE + 6], P[BASE + 7]);                              \
    auto r0 = __builtin_amdgcn_permlane32_swap(a0, b0, false, false); auto r1 = __builtin_amdgcn_permlane32_swap(a1, b1, false, false); \
    u32x4 w = {r0[0], r1[0], r0[1], r1[1]}; OUT = *reinterpret_cast<bf16x8*>(&w); } while (0)
    PK4(p, 0, paA); PK4(p, 8, paB);
#undef PK4
}
template <int KS0, bool WITH_EXP>
__device__ __forceinline__ void pv_half(f32x16* o, int vb, bf16x8 paA, bf16x8 paB, f32x16& px, float off) {
    s16x4 L[2][4], H[2][4];
#pragma unroll
    for (int d0 = 0; d0 < 4; ++d0) { L[0][d0] = tr_read(vb, v_rd_off(d0, KS0, 0)); H[0][d0] = tr_read(vb, v_rd_off(d0, KS0, 1)); }
#pragma unroll
    for (int d0 = 0; d0 < 4; ++d0) { L[1][d0] = tr_read(vb, v_rd_off(d0, KS0 + 1, 0)); H[1][d0] = tr_read(vb, v_rd_off(d0, KS0 + 1, 1)); }
#pragma unroll
    for (int kk = 0; kk < 2; ++kk) {
        const bf16x8 pa = kk == 0 ? paA : paB;
#pragma unroll
        for (int d0 = 0; d0 < 4; ++d0) { const s16x4 l = L[kk][d0], h = H[kk][d0];
            if (WITH_EXP) SBAR();
            o[d0] = __builtin_amdgcn_mfma_f32_32x32x16_bf16(pa, (bf16x8){l[0], l[1], l[2], l[3], h[0], h[1], h[2], h[3]}, o[d0], 0, 0, 0);
            if (WITH_EXP) {
#pragma unroll
                for (int q = 0; q < 2; ++q) { const int r = (kk * 4 + d0) * 2 + q; px[r] = __builtin_amdgcn_exp2f(fmaf(px[r], SM_C, off)); }
                SBAR(); }
        }
    }
}
enum { MODE_CMP = 0, MODE_WIN = 1, MODE_SLC = 2 };
struct AttnArgs {
    const bf16_t* Z; const bf16_t* KC; const bf16_t* VC; const float* G; float* L; float* OACC; bf16_t* MIX; const unsigned* BM; const float* TAB;
};
template <int MODE>
__device__ __forceinline__ void attn_unit(const AttnArgs& a, LAS char* ldsL, int qt, int g, int hp) {
    char* lds = (char*)ldsL;
    const int tid = threadIdx.x, wid = __builtin_amdgcn_readfirstlane(tid >> 6), lane = tid & 63, r32 = lane & 31, hi = lane >> 5;
    float* li_l = (float*)(lds + LDS_XCH) + wid * 64;
    const int t0 = MODE == MODE_SLC ? qt * 40 : qt * 128;
    const int tq_raw = MODE == MODE_SLC ? t0 + wid * 5 + r32 / 6 : t0 + wid * 16 + (r32 & 15);
    const bool rvalid = MODE == MODE_SLC ? (r32 < 30 && tq_raw < S_) : true;
    const int tq = tq_raw < S_ ? tq_raw : S_ - 1;
    const int hq = MODE == MODE_SLC ? g * HPG + r32 % 6 : g * HPG + hp * 2 + (r32 >> 4);
    const int tlast = MODE == MODE_SLC ? ((t0 + 39) < S_ ? (t0 + 39) : S_ - 1) : t0 + 127;
    const bf16_t* Kb; const bf16_t* Vb; long ldk;
    if (MODE == MODE_CMP) { Kb = a.KC + (size_t)g * 1024 * HD; Vb = a.VC + (size_t)g * 1024 * HD; ldk = HD; }
    else if (MODE == MODE_WIN) { Kb = a.Z + OFF_KV + 4 * 512 + g * HD; Vb = a.Z + OFF_KV + 5 * 512 + g * HD; ldk = LDZ; }
    else { Kb = a.Z + OFF_KV + 2 * 512 + g * HD; Vb = a.Z + OFF_KV + 3 * 512 + g * HD; ldk = LDZ; }
    int j0, j1;
    if (MODE == MODE_CMP) { j0 = 0; j1 = (((t0 + 127 - 31) >> 4) >> 6) + 1; }
    else if (MODE == MODE_WIN) { j0 = (t0 - 511) > 0 ? ((t0 - 511) >> 6) : 0; j1 = ((t0 + 127) >> 6) + 1; }
    else { j0 = 0; j1 = (tlast >> 6) + 1; }
    int klo, khi;
    if (MODE == MODE_CMP) { klo = 0; khi = tq >= 31 ? ((tq - 31) >> 4) : -1; }
    else if (MODE == MODE_WIN) { klo = tq - 511; khi = tq; }
    else { klo = 0; khi = rvalid ? tq : -1; }
    float negBC = -a.TAB[512 + (MODE == MODE_CMP ? 0 : (MODE == MODE_SLC ? 1 : 2))];
    bf16x8 qr[8];
    { const bf16_t* Qw = a.Z + (size_t)tq * LDZ + OFF_Q + hq * HD + hi * 8;
#pragma unroll
      for (int d0 = 0; d0 < 8; ++d0) qr[d0] = *reinterpret_cast<const bf16x8*>(Qw + d0 * 16); }
    f32x16 o[4] = {}; float lsum = 0.f;
    unsigned soK[2], soV[2];
#pragma unroll
    for (int i = 0; i < 2; ++i) { const int p = (wid + 8 * i) * 64 + lane;
        { const int row = p >> 4, c = (p & 15) ^ (row & 7); soK[i] = (unsigned)(row * ldk + c * 8) * 2u; }
        { const int sub = p >> 5, within = p & 31, kk = (sub >> 2) * 8 + (within >> 2), c = (sub & 3) * 32 + (within & 3) * 8, k = (kk & ~0xC) | ((kk & 4) << 1) | ((kk & 8) >> 1);
          soV[i] = (unsigned)(k * ldk + c) * 2u; } }
    const int vb0 = (int)(uintptr_t)(LAS char*)ldsL + 16384 + v_rd_base(lane);
#define ISSUE(jt) do { const int _b = ((jt) - j0) & 3; const char* _kp = (const char*)Kb + (size_t)(jt) * KVBLK * ldk * 2; const char* _vp = (const char*)Vb + (size_t)(jt) * KVBLK * ldk * 2; \
    _Pragma("unroll") for (int _i = 0; _i < 2; ++_i) { \
        __builtin_amdgcn_global_load_lds((const unsigned*)(_kp + soK[_i]), (LAS unsigned*)(ldsL + _b * 32768 + (wid + 8 * _i) * 1024), 16, 0, 0); \
        __builtin_amdgcn_global_load_lds((const unsigned*)(_vp + soV[_i]), (LAS unsigned*)(ldsL + _b * 32768 + 16384 + (wid + 8 * _i) * 1024), 16, 0, 0); } } while (0)
    unsigned bmw = 0u;
    if (MODE == MODE_SLC) bmw = a.BM[((size_t)tq * 4 + g) * 8];
    asm volatile("s_waitcnt lgkmcnt(0)" ::: "memory");
    __builtin_amdgcn_s_barrier();
    asm volatile("" ::: "memory");
    ISSUE(j0);
    asm volatile("s_waitcnt vmcnt(4) lgkmcnt(0)" : "+v"(bmw), "+v"(negBC), "+v"(qr[0]), "+v"(qr[1]), "+v"(qr[2]), "+v"(qr[3]), "+v"(qr[4]), "+v"(qr[5]), "+v"(qr[6]), "+v"(qr[7]) :: "memory");
    if (j0 + 1 < j1) ISSUE(j0 + 1); if (j0 + 2 < j1) ISSUE(j0 + 2);
    for (int j = j0; j < j1; ++j) {
        const int buf = (j - j0) & 3;
        if (j + 2 < j1) asm volatile("s_waitcnt vmcnt(8)" ::: "memory"); else if (j + 1 < j1) asm volatile("s_waitcnt vmcnt(4)" ::: "memory"); else asm volatile("s_waitcnt vmcnt(0)" ::: "memory");
        __builtin_amdgcn_s_barrier();
        asm volatile("" ::: "memory");
        if (j + 3 < j1) ISSUE(j + 3);
        int lhi = khi;
        if (MODE == MODE_SLC) { if (!((bmw >> (j & 31)) & 1u)) lhi = -1; }
        const int kb = j * KVBLK;
        const bool l_any = (kb + 63 >= klo) && (kb <= lhi);
        const bool l_full = (kb >= klo) && (kb + 63 <= lhi);
        if (__any(l_any)) {
            f32x16 p0, p1;
            qkt(p0, p1, lds + buf * 32768, qr, r32, hi);
            const bool uni = __all(l_full || !l_any);
            const float off = (uni && !l_any) ? -1.0e30f : negBC;
#pragma unroll
            for (int r = 0; r < 16; ++r) p0[r] = __builtin_amdgcn_exp2f(fmaf(p0[r], SM_C, off));
            if (!uni) {
#pragma unroll
                for (int r = 0; r < 16; ++r) { const int k0i = kb + crow(r, hi); p0[r] = (k0i >= klo && k0i <= lhi) ? p0[r] : 0.f; } }
            float ps = 0.f;
#pragma unroll
            for (int r = 0; r < 16; ++r) ps += p0[r];
            bf16x8 pa0, pa1, pa2, pa3; pack_half(p0, pa0, pa1);
            pv_half<0, true>(o, vb0 + buf * 32768, pa0, pa1, p1, off);
            if (!uni) {
#pragma unroll
                for (int r = 0; r < 16; ++r) { const int k1i = kb + 32 + crow(r, hi); p1[r] = (k1i >= klo && k1i <= lhi) ? p1[r] : 0.f; } }
#pragma unroll
            for (int r = 0; r < 16; ++r) ps += p1[r];
            lsum += ps;
            pack_half(p1, pa2, pa3);
            pv_half<2, false>(o, vb0 + buf * 32768, pa2, pa3, p1, off);
        }
        if (MODE == MODE_SLC) { if (((j + 1) & 31) == 0 && j + 1 < j1) { bmw = a.BM[((size_t)tq * 4 + g) * 8 + ((j + 1) >> 5)]; asm volatile("s_waitcnt vmcnt(0)" : "+v"(bmw) :: "memory"); } }
    }
#undef ISSUE
    lsum += __shfl_xor(lsum, 32);
    const float grow = a.G[(size_t)tq * NGATE + hq * 3 + (MODE == MODE_CMP ? 0 : (MODE == MODE_SLC ? 1 : 2))];
    if (hi == 0) { li_l[r32] = lsum; li_l[32 + r32] = rvalid ? grow : 0.f; }
    if (MODE == MODE_CMP) { if (hi == 0) a.L[(size_t)tq * NH + hq] = lsum; }
    asm volatile("s_waitcnt lgkmcnt(0)" ::: "memory");
#pragma unroll
    for (int hf = 0; hf < 2; ++hf) {
        float gtv[8]; float pvv[8][4];
#pragma unroll
        for (int rr = 0; rr < 8; ++rr) { const int r = hf * 8 + rr;
            const int orow = crow(r, hi); const float lv = li_l[orow]; const float rl = lv > 0.f ? __builtin_amdgcn_rcpf(lv) : 0.f;
            const int t = MODE == MODE_SLC ? t0 + wid * 5 + orow / 6 : t0 + wid * 16 + (orow & 15);
            const int h = MODE == MODE_SLC ? g * HPG + orow % 6 : g * HPG + hp * 2 + (orow >> 4);
            const bool valid = !(MODE == MODE_SLC && (orow >= 30 || t >= S_)); const int tc = valid ? t : 0;
            gtv[rr] = li_l[32 + orow] * rl;
            if (MODE != MODE_CMP) { const float* oa = a.OACC + (size_t)tc * 3072 + h * HD + r32;
#pragma unroll
                for (int d0 = 0; d0 < 4; ++d0) pvv[rr][d0] = oa[d0 * 32]; }
        }
#pragma unroll
        for (int rr = 0; rr < 8; ++rr) { const int r = hf * 8 + rr;
            const int orow = crow(r, hi);
            const int t = MODE == MODE_SLC ? t0 + wid * 5 + orow / 6 : t0 + wid * 16 + (orow & 15);
            const int h = MODE == MODE_SLC ? g * HPG + orow % 6 : g * HPG + hp * 2 + (orow >> 4);
            if (MODE == MODE_SLC && (orow >= 30 || t >= S_)) continue;
            float* oa = a.OACC + (size_t)t * 3072 + h * HD + r32;
#pragma unroll
            for (int d0 = 0; d0 < 4; ++d0) {
                const float v = o[d0][r] * gtv[rr];
                if (MODE == MODE_CMP) oa[d0 * 32] = v;
                else if (MODE == MODE_WIN) oa[d0 * 32] = pvv[rr][d0] + v;
                else a.MIX[(size_t)t * DM + POOLW + h * HD + d0 * 32 + r32] = (bf16_t)(cvt_pk_bf16(pvv[rr][d0] + v, 0.f) & 0xffffu);
            }
        }
    }
}

__device__ __forceinline__ void imp_task(const AttnArgs& a, float* IMPP, float* IMPF, int tqi, int g) {
    const int lane = threadIdx.x & 63, fr = lane & 15, fq = lane >> 4;
    const int t = tqi * 16 + fr;
    const int tmax = tqi * 16 + 15;
    if (tmax < 31) return;
    const int lim = t >= 31 ? ((t - 31) >> 4) : -1;
    const int nstep = ((((tmax - 31) >> 4) >> 6) + 1) * 4;
    const float negBC = -a.TAB[512];
    bf16x8 qf[HPG][4]; float rl[HPG];
#pragma unroll
    for (int h = 0; h < HPG; ++h) {
        const bf16_t* qp = a.Z + (size_t)t * LDZ + OFF_Q + (g * HPG + h) * HD + fq * 8;
#pragma unroll
        for (int ks = 0; ks < 4; ++ks) qf[h][ks] = *reinterpret_cast<const bf16x8*>(qp + ks * 32);
        const float lv = a.L[(size_t)t * NH + g * HPG + h]; rl[h] = lv > 0.f ? 1.0f / lv : 0.f;
    }
    const bf16_t* kbase = a.KC + (size_t)g * 1024 * HD + (size_t)fr * HD + fq * 8;
    bf16x8 kf[4], kn[4];
#pragma unroll
    for (int ks = 0; ks < 4; ++ks) kf[ks] = *reinterpret_cast<const bf16x8*>(kbase + ks * 32);
    float* op = IMPP + ((size_t)t * 4 + g) * 256 + fq; float* of = IMPF + ((size_t)t * 4 + g) * 256 + fq;
    for (int st = 0; st < nstep; ++st) {
        const int sn = (st + 1 < nstep) ? st + 1 : st;
#pragma unroll
        for (int ks = 0; ks < 4; ++ks) kn[ks] = *reinterpret_cast<const bf16x8*>(kbase + (size_t)sn * 16 * HD + ks * 32);
        f32x4 imp4 = {0.f, 0.f, 0.f, 0.f};
        const int n0 = st * 16 + fq * 4;
#pragma unroll
        for (int h = 0; h < HPG; ++h) {
            f32x4 acc = {0.f, 0.f, 0.f, 0.f};
#pragma unroll
            for (int ks = 0; ks < 4; ++ks) acc = __builtin_amdgcn_mfma_f32_16x16x32_bf16(kf[ks], qf[h][ks], acc, 0, 0, 0);
#pragma unroll
            for (int i = 0; i < 4; ++i) { const float e = __builtin_amdgcn_exp2f(fmaf(acc[i], SM_C, negBC)) * rl[h]; imp4[i] += (n0 + i <= lim) ? e : 0.f; }
        }
        op[st * 4] = imp4[0] + 2.0f * (imp4[1] + imp4[2] + imp4[3]);
        of[st * 4] = imp4[0];
#pragma unroll
        for (int ks = 0; ks < 4; ++ks) kf[ks] = kn[ks];
    }
}

__device__ __forceinline__ void topk_load(const float* IMPP, const float* IMPF, int t, int g, f32x4& pp, f32x4& ff) {
    const int lane = threadIdx.x & 63, cur = t >> 6, jb = lane * 4;
    pp = (f32x4){0.f, 0.f, 0.f, 0.f}; ff = pp;
    if (cur > 15 && jb <= cur) { const size_t base = ((size_t)t * 4 + g) * 256; pp = *(const f32x4*)(IMPP + base + jb); ff = *(const f32x4*)(IMPF + base + jb); }
}
__device__ __forceinline__ void topk_task(const f32x4 pp, const f32x4 ff, unsigned* BM, int t, int g) {
    const int lane = threadIdx.x & 63;
    const int cur = t >> 6;
    unsigned nib = 0u;
    if (cur <= 15) { const int jb = lane * 4;
#pragma unroll
        for (int c = 0; c < 4; ++c) if (jb + c <= cur) nib |= 1u << c; }
    else {
        const int jb = lane * 4;
        unsigned key[4];
        {
            float fnext = __shfl_down(ff[0], 1);
            if (lane == 63) fnext = 0.f;
            const float v0 = pp[0] + ff[1], v1 = pp[1] + ff[2], v2 = pp[2] + ff[3], v3 = pp[3] + fnext;
            key[0] = (jb + 0 >= 1 && jb + 0 <= cur - 2) ? __float_as_uint(fmaxf(v0, 0.f)) + 1u : 0u;
            key[1] = (jb + 1 >= 1 && jb + 1 <= cur - 2) ? __float_as_uint(fmaxf(v1, 0.f)) + 1u : 0u;
            key[2] = (jb + 2 >= 1 && jb + 2 <= cur - 2) ? __float_as_uint(fmaxf(v2, 0.f)) + 1u : 0u;
            key[3] = (jb + 3 >= 1 && jb + 3 <= cur - 2) ? __float_as_uint(fmaxf(v3, 0.f)) + 1u : 0u;
        }
        unsigned prefix = 0u; bool exact = false;
        for (int b = 30; b >= 0; --b) {
            const unsigned trial = prefix | (1u << b);
            const int cnt = __popcll(__ballot(key[0] >= trial)) + __popcll(__ballot(key[1] >= trial)) + __popcll(__ballot(key[2] >= trial)) + __popcll(__ballot(key[3] >= trial));
            if (cnt >= 13) { prefix = trial; if (cnt == 13) { exact = true; break; } }
        }
#pragma unroll
        for (int c = 0; c < 4; ++c) if (exact ? (key[c] >= prefix) : (key[c] > prefix)) nib |= 1u << c;
        if (!exact) {
            int need = 13 - (__popcll(__ballot(key[0] > prefix)) + __popcll(__ballot(key[1] > prefix)) + __popcll(__ballot(key[2] > prefix)) + __popcll(__ballot(key[3] > prefix)));
            unsigned tie = 0u;
#pragma unroll
            for (int c = 0; c < 4; ++c) if (key[c] == prefix) tie |= 1u << c;
            for (int guard = 0; need > 0 && guard < 16; ++guard) {
                const unsigned long long any = __ballot(tie != 0u);
                if (any == 0ull) break;
                const int L = __builtin_ctzll(any);
                if (lane == L) { const unsigned low = tie & (0u - tie); nib |= low; tie ^= low; }
                --need;
            }
        }
        if (lane == 0) nib |= 1u;
        if (lane == (cur >> 2)) nib |= 1u << (cur & 3);
        if (lane == ((cur - 1) >> 2)) nib |= 1u << ((cur - 1) & 3);
    }
    unsigned x = nib << (4 * (lane & 7));
    x |= __shfl_xor(x, 1); x |= __shfl_xor(x, 2); x |= __shfl_xor(x, 4);
    if ((lane & 7) == 0) BM[((size_t)t * 4 + g) * 8 + (lane >> 3)] = x;
}
#undef KSWZ
}

template <bool FFN_REMAP = false>
__device__ __forceinline__ void convT(const float* __restrict__ src0, int K, int N, bf16_t* __restrict__ dst, int ldd, LAS float* tile, int bid, int nb, int Nfull = 0, int n0 = 0) {
    const float* __restrict__ src = src0 + n0; if (Nfull == 0) Nfull = N;
    const int tid = threadIdx.x, tk = K >> 6, tn = (N + 63) >> 6, total = tk * tn;
    const int r = tid >> 4, c4 = (tid & 15) * 4;
    f32x4 v[2] = {{0.f, 0.f, 0.f, 0.f}, {0.f, 0.f, 0.f, 0.f}}, vn[2];
    if (bid < total) { const int nti = bid % tn, kti = bid / tn, ng = nti * 64 + c4;
#pragma unroll
        for (int h = 0; h < 2; ++h) if (ng < N) v[h] = *(const f32x4*)(src + (size_t)(kti * 64 + r + h * 32) * Nfull + ng); }
    for (int idx = bid; idx < total; idx += nb) {
        const int nti = idx % tn, kti = idx / tn;
#pragma unroll
        for (int h = 0; h < 2; ++h) { LAS float* tp = tile + (r + h * 32) * 65 + c4; tp[0] = v[h][0]; tp[1] = v[h][1]; tp[2] = v[h][2]; tp[3] = v[h][3]; }
        {
            const int nx = idx + nb; vn[0] = (f32x4){0.f, 0.f, 0.f, 0.f}; vn[1] = vn[0];
            if (nx < total) { const int nti2 = nx % tn, kti2 = nx / tn, ng2 = nti2 * 64 + c4;
#pragma unroll
                for (int h = 0; h < 2; ++h) if (ng2 < N) vn[h] = *(const f32x4*)(src + (size_t)(kti2 * 64 + r + h * 32) * Nfull + ng2); } }
        __syncthreads();
        const int n = tid >> 3, k8 = (tid & 7) * 8, ngl = nti * 64 + n;
        float e[8];
#pragma unroll
        for (int i = 0; i < 8; ++i) e[i] = tile[(k8 + i) * 65 + n];
        if (ngl < N) { u32x4 w; w.x = cvt_pk_bf16(e[0], e[1]); w.y = cvt_pk_bf16(e[2], e[3]); w.z = cvt_pk_bf16(e[4], e[5]); w.w = cvt_pk_bf16(e[6], e[7]);
            int drow = ngl; if (FFN_REMAP) { const int up = ngl >= DFF ? 1 : 0, f = ngl - up * DFF; drow = (f >> 7) * 256 + up * 128 + (f & 127); }
            *(u32x4*)(dst + (size_t)drow * ldd + kti * 64 + k8) = w; }
        __syncthreads();
        v[0] = vn[0]; v[1] = vn[1];
    }
}
__device__ __forceinline__ void convT8(const float* __restrict__ src0, int K, int N, unsigned char* __restrict__ dst, int ldd, float scale, LAS float* tile, int bid, int nb, int Nfull = 0, int n0 = 0) {
    const float* __restrict__ src = src0 + n0; if (Nfull == 0) Nfull = N;
    const int tid = threadIdx.x, tk = K >> 6, tn = (N + 63) >> 6, total = tk * tn;
    const int r = tid >> 4, c4 = (tid & 15) * 4;
    f32x4 v[2] = {{0.f, 0.f, 0.f, 0.f}, {0.f, 0.f, 0.f, 0.f}}, vn[2];
    if (bid < total) { const int nti = bid % tn, kti = bid / tn, ng = nti * 64 + c4;
#pragma unroll
        for (int h = 0; h < 2; ++h) if (ng < N) v[h] = *(const f32x4*)(src + (size_t)(kti * 64 + r + h * 32) * Nfull + ng); }
    for (int idx = bid; idx < total; idx += nb) {
        const int nti = idx % tn, kti = idx / tn;
#pragma unroll
        for (int h = 0; h < 2; ++h) { LAS float* tp = tile + (r + h * 32) * 65 + c4; tp[0] = v[h][0]; tp[1] = v[h][1]; tp[2] = v[h][2]; tp[3] = v[h][3]; }
        { const int nx = idx + nb; vn[0] = (f32x4){0.f, 0.f, 0.f, 0.f}; vn[1] = vn[0];
            if (nx < total) { const int nti2 = nx % tn, kti2 = nx / tn, ng2 = nti2 * 64 + c4;
#pragma unroll
                for (int h = 0; h < 2; ++h) if (ng2 < N) vn[h] = *(const f32x4*)(src + (size_t)(kti2 * 64 + r + h * 32) * Nfull + ng2); } }
        __syncthreads();
        const int n = tid >> 3, k8 = (tid & 7) * 8, ngl = nti * 64 + n;
        float e[8];
#pragma unroll
        for (int i = 0; i < 8; ++i) e[i] = tile[(k8 + i) * 65 + n] * scale;
        if (ngl < N) { int p0 = __builtin_amdgcn_cvt_pk_fp8_f32(e[0], e[1], 0, false); p0 = __builtin_amdgcn_cvt_pk_fp8_f32(e[2], e[3], p0, true);
            int p1 = __builtin_amdgcn_cvt_pk_fp8_f32(e[4], e[5], 0, false); p1 = __builtin_amdgcn_cvt_pk_fp8_f32(e[6], e[7], p1, true);
            *(u32x2*)(dst + (size_t)ngl * ldd + kti * 64 + k8) = (u32x2){(unsigned)p0, (unsigned)p1}; }
        __syncthreads();
        v[0] = vn[0]; v[1] = vn[1];
    }
}
__device__ __forceinline__ void rmsnorm_rows(const float* __restrict__ src, const float* __restrict__ w, bf16_t* __restrict__ dst, int rows, int gw, int nw, unsigned char* __restrict__ dst8 = nullptr) {
    const int lane = threadIdx.x & 63;
    f32x4 v[16], vn[16];
    if (gw < rows) { const f32x4* sp = (const f32x4*)(src + (size_t)gw * DM);
#pragma unroll
        for (int i = 0; i < 16; ++i) v[i] = sp[lane + 64 * i]; }
    for (int row = gw; row < rows; row += nw) {
        const int nr = row + nw < rows ? row + nw : row;
        { const f32x4* sp = (const f32x4*)(src + (size_t)nr * DM);
#pragma unroll
          for (int i = 0; i < 16; ++i) vn[i] = sp[lane + 64 * i]; }
        float ss = 0.f;
#pragma unroll
        for (int i = 0; i < 16; ++i) ss += v[i][0] * v[i][0] + v[i][1] * v[i][1] + v[i][2] * v[i][2] + v[i][3] * v[i][3];
        ss = wave_sum(ss);
        const float rstd = rsqrtf(ss * (1.0f / DM) + EPS);
#pragma unroll
        for (int i = 0; i < 16; ++i) { const f32x4 ww = ((const f32x4*)w)[lane + 64 * i];
            u32x2 o; o.x = cvt_pk_bf16(v[i][0] * rstd * ww[0], v[i][1] * rstd * ww[1]); o.y = cvt_pk_bf16(v[i][2] * rstd * ww[2], v[i][3] * rstd * ww[3]);
            *(u32x2*)(dst + (size_t)row * DM + (lane + 64 * i) * 4) = o;
            if (dst8) { int pk = __builtin_amdgcn_cvt_pk_fp8_f32(v[i][0] * rstd * ww[0], v[i][1] * rstd * ww[1], 0, false); pk = __builtin_amdgcn_cvt_pk_fp8_f32(v[i][2] * rstd * ww[2], v[i][3] * rstd * ww[3], pk, true);
                *(int*)(dst8 + (size_t)row * DM + (lane + 64 * i) * 4) = pk; } }
#pragma unroll
        for (int i = 0; i < 16; ++i) v[i] = vn[i];
    }
}

struct Ptrs {
    bf16_t *Win, *Wo, *Wfi, *Wfo, *Wg, *Wple, *Wpool, *Wc1k, *Wc1v, *XN, *PB, *Z, *M, *KC, *VC, *MIX, *ACT, *ERAW;
    float *COS, *SIN, *TAB, *G, *H1, *L, *OACC, *IMPP, *IMPF, *ERSTD; unsigned* BM;
};

__device__ __forceinline__ void phase_prologue(const Params& P, const Ptrs& W, LAS unsigned char* lds) {
    const int bid = blockIdx.x, nb = gridDim.x, tid = threadIdx.x, lane = tid & 63, wv = tid >> 6;
    const int gw = bid * NWAVES + wv, nw = nb * NWAVES; const size_t gt = (size_t)bid * NTHREADS + tid, ntot = (size_t)nb * NTHREADS;
    LAS float* tile = (LAS float*)lds;
    rmsnorm_rows(P.x, P.norm1_w, W.XN, S_, gw, nw, P.ws + WS_XN8);
    convT(P.w_in, DM, POOLW, W.Win, DM, tile, bid, nb, INW, 0);
    convT(P.w_in, DM, INW - OFF_G, W.Win + (size_t)OFF_G * DM, DM, tile, bid, nb, INW, OFF_G);
    convT8(P.w_in, DM, OFF_G - POOLW, P.ws + WS_WIN8, DM, WG8_SCALE, tile, bid, nb, INW, POOLW);
    for (size_t i = gt; i < (size_t)(LDZ - INW) * DM / 8; i += ntot) *(u32x4*)(W.Win + (size_t)INW * DM + i * 8) = (u32x4){0u, 0u, 0u, 0u};
    convT(P.w_o, DM, DM, W.Wo, DM, tile, bid, nb);
    convT<true>(P.w_ffn_in, DM, NFI, W.Wfi, DM, tile, bid, nb);
    for (size_t i = gt; i < (size_t)2 * DM / 8; i += ntot) *(u32x4*)(W.XN - 2 * DM + i * 8) = (u32x4){0u, 0u, 0u, 0u};
    convT(P.w_ffn_out, DFF, DM, W.Wfo, DFF, tile, bid, nb);
    convT8(P.w_ple_gate, DM, DM, (unsigned char*)W.Wg, DM, WG8_SCALE, tile, bid, nb);
    convT(P.w_ple_proj, PLE, DM, W.Wple, PLE, tile, bid, nb);
    for (int g = 0; g < 4; ++g) convT(P.w_pool + (size_t)g * 65536, 256, 256, W.Wpool + (size_t)g * 65536, 256, tile, bid, nb);
    convT(P.cmp_k_w1, 4096, 256, W.Wc1k, 4096, tile, bid, nb);
    convT(P.cmp_v_w1, 4096, 256, W.Wc1v, 4096, tile, bid, nb);
    for (size_t i = gt; i < (size_t)S_ * PLE / 8; i += ntot) { const f32x4 a = *(const f32x4*)(P.p + i * 8), b = *(const f32x4*)(P.p + i * 8 + 4);
        u32x4 w; w.x = cvt_pk_bf16(a[0], a[1]); w.y = cvt_pk_bf16(a[2], a[3]); w.z = cvt_pk_bf16(b[0], b[1]); w.w = cvt_pk_bf16(b[2], b[3]); *(u32x4*)(W.PB + i * 8) = w; }
    for (size_t i = gt; i < (size_t)S_ * 16; i += ntot) { const int t = (int)(i >> 4), fi = (int)(i & 15);
        const float inv = exp2f(-(float)fi * (18.931568569324174f / 16.0f)); const float ang = (float)P.positions[t] * inv;
        const double ad = (double)ang; const double kk = rint(ad * 0.15915494309189535); const float rf = (float)(ad - kk * 6.283185307179586);
        W.COS[i] = __cosf(rf); W.SIN[i] = __sinf(rf); }
    for (int o = gw; o < 512; o += nw) { const int which = o >> 8, j = o & 255; const float* pe = which ? P.cmp_pos_v : P.cmp_pos_k; const float* w1 = which ? P.cmp_v_w1 : P.cmp_k_w1;
        float s = 0.f; for (int r = lane; r < 4096; r += 64) s += pe[r] * w1[(size_t)r * 256 + j];
        s = wave_sum(s); if (lane == 0) W.TAB[o] = s; }
    if (gw == 0) { float mq = fmaxf(fabsf(P.q_norm_w[lane]), fabsf(P.q_norm_w[lane + 64])); mq = wave_max(mq);
        float mc = wave_max(fmaxf(fabsf(P.k_norm_cmp_w[lane]), fabsf(P.k_norm_cmp_w[lane + 64])));
        float ms = wave_max(fmaxf(fabsf(P.k_norm_slc_w[lane]), fabsf(P.k_norm_slc_w[lane + 64])));
        float mw = wave_max(fmaxf(fabsf(P.k_norm_win_w[lane]), fabsf(P.k_norm_win_w[lane + 64])));
        const float c = 11.313708498984761f * 1.4426950408889634f * mq * 1.01f;
        if (lane == 0) { W.TAB[512] = c * mc; W.TAB[513] = c * ms; W.TAB[514] = c * mw; } }
}

__device__ __forceinline__ void phase_postz(const Params& P, const Ptrs& W, int gw, int nw) {
    const int tid = threadIdx.x, lane = tid & 63;
    const f32x2 wq = *(const f32x2*)(P.q_norm_w + 2 * lane), wks = *(const f32x2*)(P.k_norm_slc_w + 2 * lane), wkw = *(const f32x2*)(P.k_norm_win_w + 2 * lane);
    for (int t = gw; t < S_; t += nw) {
        bf16_t* zr = W.Z + (size_t)t * LDZ;
        float cs0 = 0.f, cs1 = 0.f, sn0 = 0.f, sn1 = 0.f;
        if (lane < 16) { const int i0 = (2 * lane) & 15; cs0 = W.COS[t * 16 + i0]; cs1 = W.COS[t * 16 + i0 + 1]; sn0 = W.SIN[t * 16 + i0]; sn1 = W.SIN[t * 16 + i0 + 1]; }
        unsigned uv[32];
#pragma unroll
        for (int v = 0; v < 32; ++v) { const int col = v < 24 ? OFF_Q + v * HD : (v < 28 ? OFF_KV + 2 * 512 + (v - 24) * HD : OFF_KV + 4 * 512 + (v - 28) * HD);
            uv[v] = *((const unsigned*)(zr + col) + lane); }
#pragma unroll
        for (int v = 0; v < 32; ++v) {
            const f32x2 ww = v < 24 ? wq : (v < 28 ? wks : wkw);
            const unsigned u = uv[v]; const float x0 = bf_lo(u), x1 = bf_hi(u);
            const float ss = wave_sum(x0 * x0 + x1 * x1);
            const float rstd = rsqrtf(ss * (1.0f / HD) + EPS);
            float y0 = x0 * rstd * ww[0], y1 = x1 * rstd * ww[1];
            const float p0 = __shfl_xor(y0, 8), p1 = __shfl_xor(y1, 8);
            if (lane < 8) { y0 = y0 * cs0 - p0 * sn0; y1 = y1 * cs1 - p1 * sn1; }
            else if (lane < 16) { y0 = y0 * cs0 + p0 * sn0; y1 = y1 * cs1 + p1 * sn1; }
            uv[v] = cvt_pk_bf16(y0, y1);
        }
        {
            const int gi = lane >> 4, wlen = 2 << gi, c0 = lane * 16; const int cnt = (t + 1) < wlen ? (t + 1) : wlen;
            float s[16];
#pragma unroll
            for (int i = 0; i < 16; ++i) s[i] = 0.f;
            float cur[16];
            for (int i = 0; i < cnt; ++i) { const u32x4 a = *(const u32x4*)(W.Z + (size_t)(t - i) * LDZ + c0), b = *(const u32x4*)(W.Z + (size_t)(t - i) * LDZ + c0 + 8);
                const float e[16] = {bf_lo(a.x), bf_hi(a.x), bf_lo(a.y), bf_hi(a.y), bf_lo(a.z), bf_hi(a.z), bf_lo(a.w), bf_hi(a.w), bf_lo(b.x), bf_hi(b.x), bf_lo(b.y), bf_hi(b.y), bf_lo(b.z), bf_hi(b.z), bf_lo(b.w), bf_hi(b.w)};
#pragma unroll
                for (int q = 0; q < 16; ++q) { s[q] += e[q]; if (i == 0) cur[q] = e[q]; } }
            const float rc = 1.0f / (float)cnt;
            u32x4 o0, o1;
            o0.x = cvt_pk_bf16(s[0] * rc - cur[0], s[1] * rc - cur[1]); o0.y = cvt_pk_bf16(s[2] * rc - cur[2], s[3] * rc - cur[3]);
            o0.z = cvt_pk_bf16(s[4] * rc - cur[4], s[5] * rc - cur[5]); o0.w = cvt_pk_bf16(s[6] * rc - cur[6], s[7] * rc - cur[7]);
            o1.x = cvt_pk_bf16(s[8] * rc - cur[8], s[9] * rc - cur[9]); o1.y = cvt_pk_bf16(s[10] * rc - cur[10], s[11] * rc - cur[11]);
            o1.z = cvt_pk_bf16(s[12] * rc - cur[12], s[13] * rc - cur[13]); o1.w = cvt_pk_bf16(s[14] * rc - cur[14], s[15] * rc - cur[15]);
            *(u32x4*)(W.M + (size_t)t * POOLW + c0) = o0; *(u32x4*)(W.M + (size_t)t * POOLW + c0 + 8) = o1;
        }
#pragma unroll
        for (int v = 0; v < 32; ++v) { const int col = v < 24 ? OFF_Q + v * HD : (v < 28 ? OFF_KV + 2 * 512 + (v - 24) * HD : OFF_KV + 4 * 512 + (v - 28) * HD);
            *((unsigned*)(zr + col) + lane) = uv[v]; }

    }
}

__device__ __forceinline__ void phase_cmpfin(const Params& P, const Ptrs& W) {
    const int tid = threadIdx.x, lane = tid & 63, gw = blockIdx.x * NWAVES + (tid >> 6), nw = gridDim.x * NWAVES;
    const f32x2 wk = *(const f32x2*)(P.k_norm_cmp_w + 2 * lane);
    for (int task = gw; task < 8192; task += nw) {
        const int tk = __builtin_amdgcn_readfirstlane(task);
        const int which = tk >> 12, g = (tk >> 10) & 3, n = tk & 1023;
        bf16_t* dst = (which ? W.VC : W.KC) + ((size_t)g * 1024 + n) * HD;
        if (n == 1023) { ((unsigned*)dst)[lane] = 0u; continue; }
        const float* h = W.H1 + (size_t)tk * 256; const float* w2 = which ? P.cmp_v_w2 : P.cmp_k_w2;
        float a0 = 0.f, a1 = 0.f;
        for (int j = 0; j < 256; ++j) { const float hj = h[j]; const f32x2 wv = *(const f32x2*)(w2 + j * HD + 2 * lane); a0 += hj * wv[0]; a1 += hj * wv[1]; }
        if (which == 0) {
            const float ss = wave_sum(a0 * a0 + a1 * a1); const float rstd = rsqrtf(ss * (1.0f / HD) + EPS);
            a0 = a0 * rstd * wk[0]; a1 = a1 * rstd * wk[1];
            const int tp = 16 * n + 31; const float p0 = __shfl_xor(a0, 8), p1 = __shfl_xor(a1, 8);
            if (lane < 16) { const int i0 = (2 * lane) & 15; const float cs0 = W.COS[tp * 16 + i0], cs1 = W.COS[tp * 16 + i0 + 1], sn0 = W.SIN[tp * 16 + i0], sn1 = W.SIN[tp * 16 + i0 + 1];
                if (lane < 8) { a0 = a0 * cs0 - p0 * sn0; a1 = a1 * cs1 - p1 * sn1; } else { a0 = a0 * cs0 + p0 * sn0; a1 = a1 * cs1 + p1 * sn1; } }
        }
        ((unsigned*)dst)[lane] = cvt_pk_bf16(a0, a1);
    }
}

__device__ __forceinline__ void phase_erstd(const Ptrs& W) {
    const int tid = threadIdx.x, lane = tid & 63, gw = blockIdx.x * NWAVES + (tid >> 6), nw = gridDim.x * NWAVES;
    u32x4 a[8], an[8];
    if (gw < S_) { const u32x4* sp = (const u32x4*)(W.ERAW + (size_t)gw * DM);
#pragma unroll
        for (int i = 0; i < 8; ++i) a[i] = sp[lane + 64 * i]; }
    for (int row = gw; row < S_; row += nw) {
        const int nr = row + nw < S_ ? row + nw : row;
        { const u32x4* sp = (const u32x4*)(W.ERAW + (size_t)nr * DM);
#pragma unroll
          for (int i = 0; i < 8; ++i) an[i] = sp[lane + 64 * i]; }
        float ss = 0.f;
#pragma unroll
        for (int i = 0; i < 8; ++i) {
            const float e0 = bf_lo(a[i].x), e1 = bf_hi(a[i].x), e2 = bf_lo(a[i].y), e3 = bf_hi(a[i].y), e4 = bf_lo(a[i].z), e5 = bf_hi(a[i].z), e6 = bf_lo(a[i].w), e7 = bf_hi(a[i].w);
            ss += e0 * e0 + e1 * e1 + e2 * e2 + e3 * e3 + e4 * e4 + e5 * e5 + e6 * e6 + e7 * e7; }
        ss = wave_sum(ss);
        if (lane == 0) W.ERSTD[row] = rsqrtf(ss * (1.0f / DM) + EPS);
#pragma unroll
        for (int i = 0; i < 8; ++i) a[i] = an[i];
    }
}

constexpr int N_PHASES = 11;
__device__ __forceinline__ Params kargs() {
#if defined(__HIP_DEVICE_COMPILE__)
    unsigned long long p = (unsigned long long)__builtin_amdgcn_kernarg_segment_ptr();
    asm volatile("" : "+s"(p));
    return *(const __attribute__((address_space(4))) Params*)p;
#else
    return Params{};
#endif
}
__device__ __forceinline__ Ptrs mkptrs(unsigned char* ws) {
    Ptrs W;
    W.Win = (bf16_t*)(ws + WS_WIN); W.Wo = (bf16_t*)(ws + WS_WO); W.Wfi = (bf16_t*)(ws + WS_WFI); W.Wfo = (bf16_t*)(ws + WS_WFO); W.Wg = (bf16_t*)(ws + WS_WG);
    W.Wple = (bf16_t*)(ws + WS_WPLE); W.Wpool = (bf16_t*)(ws + WS_WPOOL); W.Wc1k = (bf16_t*)(ws + WS_WC1K); W.Wc1v = (bf16_t*)(ws + WS_WC1V);
    W.XN = (bf16_t*)(ws + WS_XN); W.PB = (bf16_t*)(ws + WS_PB); W.Z = (bf16_t*)(ws + WS_Z); W.M = (bf16_t*)(ws + WS_M); W.KC = (bf16_t*)(ws + WS_KC); W.VC = (bf16_t*)(ws + WS_VC);
    W.MIX = (bf16_t*)(ws + WS_MIX); W.ACT = (bf16_t*)(ws + WS_ACT); W.ERAW = (bf16_t*)(ws + WS_ERAW);
    W.COS = (float*)(ws + WS_COS); W.SIN = (float*)(ws + WS_SIN); W.TAB = (float*)(ws + WS_TAB); W.G = (float*)(ws + WS_G); W.H1 = (float*)(ws + WS_H1); W.L = (float*)(ws + WS_L);
    W.OACC = (float*)(ws + WS_OACC); W.IMPP = (float*)(ws + WS_IMPP); W.IMPF = (float*)(ws + WS_IMPF); W.ERSTD = (float*)(ws + WS_ERSTD); W.BM = (unsigned*)(ws + WS_BM);
    return W;
}
__global__ void __launch_bounds__(NTHREADS, 2) fwd(Params Punused) {
    extern __shared__ __attribute__((aligned(16))) unsigned char lds_raw[];
    LAS unsigned char* lds = (LAS unsigned char*)lds_raw;
    const int tid = threadIdx.x;
    const int G = gridDim.x, bid = blockIdx.x;
    const int gw = bid * NWAVES + (tid >> 6), nw = G * NWAVES;

    if (tid < 16) ((LAS unsigned*)(lds + LDS_MISC))[tid] = 0u;
    __syncthreads();
    int lo, hi; XcdBarrier bar;
    { const Params P = kargs(); lo = P.ph_lo; hi = P.ph_hi;
      bar.bar = (unsigned*)(P.ws + WS_CTL); bar.x = 0; bar.st = (volatile LAS unsigned*)(lds + LDS_MISC);
      if (hi - lo > 1) bar = xcd_barrier_post((unsigned*)(P.ws + WS_CTL), (volatile LAS unsigned*)(lds + LDS_MISC)); }
#ifdef PH_MASK
#define IN(k) (((PH_MASK >> (k)) & 1) && lo <= (k) && (k) < hi)
#else
#define IN(k) (lo <= (k) && (k) < hi)
#endif
#define SEAM(k) do { if (IN(k) && IN((k) + 1)) xcd_barrier(bar); } while (0)
#define PHASE_VARS const Params P = kargs(); const Ptrs W = mkptrs(P.ws); (void)W;
#define ATT_ARGS att::AttnArgs AA{W.Z, W.KC, W.VC, W.G, W.L, W.OACC, W.MIX, W.BM, W.TAB};

    if (IN(0)) { PHASE_VARS REP(0) { phase_prologue(P, W, lds); } SEAM(0); }
    if (IN(1)) {
        PHASE_VARS
        { pg8::GStd g{(const char*)W.XN, (const char*)W.Win, DM, DM, DM / 64}; pg8::StaticOrder S; S.init(S_ / 256, POOLW / 256, G, bid);
          pg8::EpiBf16 E{W.Z, LDZ}; pg8::gemm_phase(lds, g, S, E); }
        { pg8::GStd g{(const char*)(P.ws + WS_XN8), (const char*)(P.ws + WS_WIN8), DM / 2, DM / 2, DM / 128}; pg8::StaticOrder S; S.init(S_ / 256, (OFF_G - POOLW) / 256, G, bid);
          pg8::EpiBf16S E{W.Z + POOLW, LDZ, 1.0f / WG8_SCALE}; pg8::gemm_phase<pg8::GStd, pg8::EpiBf16S, true>(lds, g, S, E); }
        SEAM(1);
    }
    if (IN(2)) {
        PHASE_VARS
        if (G > 64) {
            if (bid < 32) { pg8::GCmp g{(const char*)W.Z, (const char*)W.Wc1k, (const char*)W.Wc1v, 16 * LDZ, 4096, 64}; pg8::StaticOrder S; S.init(32, 1, 32, bid);
                pg8::EpiCmpGelu E{W.H1, W.TAB}; pg8::gemm_phase(lds, g, S, E); }
            else if (bid < 96) {
                pg8::GStd g{(const char*)W.XN, (const char*)(W.Win + (size_t)OFF_G * DM), DM, DM, DM / 64}; pg8::StaticOrder S; S.init(S_ / 256, 1, 64, bid - 32);
                pg8::EpiBf16 E{W.Z + OFF_G, LDZ}; pg8::gemm_phase(lds, g, S, E); }
            else phase_postz(P, W, (bid - 96) * NWAVES + (tid >> 6), (G - 96) * NWAVES);
        } else {
            { pg8::GStd g{(const char*)W.XN, (const char*)(W.Win + (size_t)OFF_G * DM), DM, DM, DM / 64}; pg8::StaticOrder S; S.init(S_ / 256, 1, G, bid);
              pg8::EpiBf16 E{W.Z + OFF_G, LDZ}; pg8::gemm_phase(lds, g, S, E); }
            { pg8::GCmp g{(const char*)W.Z, (const char*)W.Wc1k, (const char*)W.Wc1v, 16 * LDZ, 4096, 64}; pg8::StaticOrder S; S.init(32, 1, G, bid);
              pg8::EpiCmpGelu E{W.H1, W.TAB}; pg8::gemm_phase(lds, g, S, E); }
            phase_postz(P, W, gw, nw);
        }
        SEAM(2);
    }
    if (IN(3)) {
        PHASE_VARS
        for (size_t i = (size_t)bid * NTHREADS + tid; i < (size_t)S_ * NGATE; i += (size_t)G * NTHREADS) { const int t = (int)(i / NGATE), c = (int)(i % NGATE); W.G[i] = sigmoidf_(bf2f(W.Z[(size_t)t * LDZ + OFF_G + c])); }
        phase_cmpfin(P, W);
        { pg8::GPool g{(const char*)W.M, (const char*)W.Wpool, POOLW, 256, 4}; pg8::StaticOrder S; S.init(S_ / 256, 4, G, bid);
          pg8::EpiBf16Scale E{W.MIX, DM, P.pool_scale}; pg8::gemm_phase(lds, g, S, E); }
        SEAM(3);
    }
    if (IN(4)) {
        PHASE_VARS ATT_ARGS
        REP(4)
        for (int base = 0, rnd = 0; base < 1536; base += G, ++rnd) {
            int qt, g, hp;
            if (G == 256) { const int x = bid & 7, r = bid >> 3, qp = (rnd / 3) ? 63 - r : r; if (rnd >= 6) break; g = x & 3; qt = 2 * qp + (x >> 2); hp = rnd % 3; }
            else { const int Lu = base + ((rnd & 1) ? G - 1 - bid : bid); if (Lu >= 1536) continue; qt = Lu / 12; const int rem = Lu % 12; g = rem / 3; hp = rem % 3; }
            att::attn_unit<att::MODE_CMP>(AA, (LAS char*)lds, qt, g, hp);
            asm volatile("s_waitcnt vmcnt(0)" ::: "memory");
            att::attn_unit<att::MODE_WIN>(AA, (LAS char*)lds, qt, g, hp);
            if (G == 256 && hp == 2) {
                asm volatile("s_waitcnt vmcnt(0)" ::: "memory");
                const int tqi = qt * 8 + (tid >> 6);
                att::imp_task(AA, W.IMPP, W.IMPF, tqi, g);
                asm volatile("s_waitcnt vmcnt(0)" ::: "memory");
                f32x4 pp, ff, pn, fn; att::topk_load(W.IMPP, W.IMPF, tqi * 16, g, pp, ff);
                for (int q = 0; q < 16; ++q) { att::topk_load(W.IMPP, W.IMPF, tqi * 16 + (q < 15 ? q + 1 : q), g, pn, fn); att::topk_task(pp, ff, W.BM, tqi * 16 + q, g); pp = pn; ff = fn; } } }
        if (G != 256) SEAM(4);
    }
    if (IN(5)) {
        PHASE_VARS ATT_ARGS
        if (G != 256)
        for (int k = gw, r = 0; k < 4096; k += nw, ++r) { const int hiT = (r + 1) * nw < 4096 ? (r + 1) * nw : 4096;
            const int task = (r & 1) ? hiT - 1 - (k - r * nw) : k;
            att::imp_task(AA, W.IMPP, W.IMPF, task >> 2, task & 3);
            asm volatile("s_waitcnt vmcnt(0)" ::: "memory");
            { const int tb = (task >> 2) * 16, gg = task & 3; f32x4 pp, ff, pn, fn;
              att::topk_load(W.IMPP, W.IMPF, tb, gg, pp, ff);
              for (int q = 0; q < 16; ++q) { att::topk_load(W.IMPP, W.IMPF, tb + (q < 15 ? q + 1 : q), gg, pn, fn); att::topk_task(pp, ff, W.BM, tb + q, gg); pp = pn; ff = fn; } } }
        SEAM(5);
    }
    if (IN(6)) {
        PHASE_VARS ATT_ARGS
        REP(6)
        for (int base = 0, rnd = 0; base < 1640 + G; base += G, ++rnd) {
            int ut, g;
            if (G == 256) { const int x = bid & 7, r = bid >> 3, k = rnd * 32 + ((rnd & 1) ? 31 - r : r); if (k >= 205) break; g = x & 3; ut = 409 - (2 * k + (x >> 2)); }
            else { const int Lu = base + ((rnd & 1) ? G - 1 - bid : bid); if (Lu >= 1640) continue; ut = 409 - Lu / 4; g = Lu % 4; }
            att::attn_unit<att::MODE_SLC>(AA, (LAS char*)lds, ut, g, 0); }
        SEAM(6);
    }
    if (IN(7)) {
        PHASE_VARS
        { pg8::GStd g{(const char*)W.MIX, (const char*)W.Wo, DM, DM, DM / 64}; pg8::StaticOrder S; S.init(S_ / 256, DM / 256, G, bid);
          pg8::EpiResNorm E{P.x, P.out, W.XN, P.norm2_w, (float*)(P.ws + WS_SSQ1), DM}; pg8::gemm_phase(lds, g, S, E); }
        { pg8::GStd g{(const char*)W.PB, (const char*)W.Wple, PLE, PLE, PLE / 64}; pg8::StaticOrder S; S.init(S_ / 256, DM / 256, G, bid);
          pg8::EpiBf16Ssq E{W.ERAW, DM, (float*)(P.ws + WS_SSQ3)}; pg8::gemm_phase(lds, g, S, E); }
        SEAM(7);
    }
    if (IN(8)) {
        PHASE_VARS
        pg8::GFfn g{(const char*)W.XN, (const char*)W.Wfi, DM, DM, DM / 64}; pg8::StaticOrder S; S.init(65, DFF / 128, G, bid);
        pg8::EpiFfn E{W.ACT, P.conv_w, P.conv_b, (LAS float*)(lds + LDS_XCH), (const float*)(P.ws + WS_SSQ1)}; REP(8) { pg8::gemm_phase(lds, g, S, E); } SEAM(8);
    }
    if (IN(9)) {
        PHASE_VARS
        pg8::GStd g{(const char*)W.ACT, (const char*)W.Wfo, DFF, DFF, DFF / 64}; pg8::StaticOrder S; S.init(S_ / 256, DM / 256, G, bid);
        pg8::EpiResNormF8 E{P.out, P.out, W.XN, P.ple_gate_norm_w, (float*)(P.ws + WS_SSQ2), DM}; pg8::gemm_phase(lds, g, S, E); SEAM(9);
    }
    if (IN(10)) {
        PHASE_VARS
        pg8::GStd g{(const char*)W.XN, (const char*)W.Wg, DM / 2, DM / 2, DM / 128}; pg8::StaticOrder S; S.init(S_ / 256, DM / 256, G, bid);
        pg8::EpiGate E{P.out, W.ERAW, (const float*)(P.ws + WS_SSQ3), P.ple_norm_w, (const float*)(P.ws + WS_SSQ2), DM, 1.0f / WG8_SCALE};
        pg8::gemm_phase<pg8::GStd, pg8::EpiGate, true>(lds, g, S, E);
    }
#undef IN
#undef SEAM
}

extern "C" void kernel_launch(void* const* d_in, const int* in_sizes, int n_in, void* d_out, int out_size, void* d_ws, size_t ws_size, hipStream_t stream) {
    static int grid = 0;
    if (grid == 0) {
        if (n_in != 27 || in_sizes[0] != S_ * DM || out_size != S_ * DM || ws_size < WS_NEED) {
            fprintf(stderr, "kernel_launch: unexpected shapes (n_in %d, in0 %d, out %d, ws %zu < %zu); nothing launched\n", n_in, n_in > 0 ? in_sizes[0] : -1, out_size, ws_size, (size_t)WS_NEED); grid = -1; return; }
        int dev = 0, cus = 0, per_cu = 0;
        if (hipGetDevice(&dev) != hipSuccess || hipDeviceGetAttribute(&cus, hipDeviceAttributeMultiprocessorCount, dev) != hipSuccess) { grid = -1; return; }
        if (hipFuncSetAttribute((const void*)fwd, hipFuncAttributeMaxDynamicSharedMemorySize, LDS_BYTES) != hipSuccess) { fprintf(stderr, "kernel_launch: hipFuncSetAttribute failed\n"); grid = -1; return; }
        if (hipOccupancyMaxActiveBlocksPerMultiprocessor(&per_cu, (const void*)fwd, NTHREADS, LDS_BYTES) != hipSuccess || per_cu < 1) { fprintf(stderr, "kernel_launch: occupancy query says %d\n", per_cu); (void)hipGetLastError(); }
        grid = cus > 256 ? 256 : cus;
    }
    if (grid < 0) return;
    (void)hipMemsetAsync((char*)d_ws + WS_CTL, 0, CTL_BYTES, stream);
    Params P{};
    const float** fp = (const float**)&P;
    P.x = (const float*)d_in[0]; P.p = (const float*)d_in[1]; P.positions = (const int*)d_in[2]; P.norm1_w = (const float*)d_in[3]; P.w_in = (const float*)d_in[4];
    P.w_pool = (const float*)d_in[5]; P.pool_scale = (const float*)d_in[6]; P.q_norm_w = (const float*)d_in[7]; P.k_norm_cmp_w = (const float*)d_in[8];
    P.k_norm_slc_w = (const float*)d_in[9]; P.k_norm_win_w = (const float*)d_in[10]; P.cmp_pos_k = (const float*)d_in[11]; P.cmp_pos_v = (const float*)d_in[12];
    P.cmp_k_w1 = (const float*)d_in[13]; P.cmp_k_w2 = (const float*)d_in[14]; P.cmp_v_w1 = (const float*)d_in[15]; P.cmp_v_w2 = (const float*)d_in[16];
    P.w_o = (const float*)d_in[17]; P.norm2_w = (const float*)d_in[18]; P.w_ffn_in = (const float*)d_in[19]; P.conv_w = (const float*)d_in[20]; P.conv_b = (const float*)d_in[21];
    P.w_ffn_out = (const float*)d_in[22]; P.w_ple_proj = (const float*)d_in[23]; P.ple_norm_w = (const float*)d_in[24]; P.ple_gate_norm_w = (const float*)d_in[25]; P.w_ple_gate = (const float*)d_in[26];
    (void)fp;
    P.out = (float*)d_out; P.ws = (unsigned char*)d_ws;
#if MK_ONE_LAUNCH
    P.ph_lo = 0; P.ph_hi = N_PHASES;
    hipLaunchKernelGGL(fwd, dim3(grid), dim3(NTHREADS), LDS_BYTES, stream, P);
#else
    for (int ph = 0; ph < N_PHASES; ++ph) { P.ph_lo = ph; P.ph_hi = ph + 1; hipLaunchKernelGGL(fwd, dim3(grid), dim3(NTHREADS), LDS_BYTES, stream, P); }
#endif
    const hipError_t le = hipPeekAtLastError();
    if (le != hipSuccess) fprintf(stderr, "kernel_launch: launch failed: %s\n", hipGetErrorName(le));
}
```

```cpp
#include <hip/hip_runtime.h>
#include <cstdio>
#include <cstdint>

#ifndef PROBE_DBL
#define PROBE_DBL 0
#endif
#define REP(k) _Pragma("unroll") for (int rep_ = 0; rep_ < 1 + ((PROBE_DBL >> (k)) & 1); ++rep_)
#ifndef MK_ONE_LAUNCH
#define MK_ONE_LAUNCH 1
#endif

#define LAS __attribute__((address_space(3)))
typedef unsigned short bf16_t;
typedef short bf16x8 __attribute__((ext_vector_type(8)));
typedef short s16x4 __attribute__((ext_vector_type(4)));
typedef float f32x2 __attribute__((ext_vector_type(2)));
typedef float f32x4 __attribute__((ext_vector_type(4)));
typedef float f32x16 __attribute__((ext_vector_type(16)));
typedef unsigned u32x2 __attribute__((ext_vector_type(2)));
typedef unsigned u32x4 __attribute__((ext_vector_type(4)));
typedef int i32x4 __attribute__((ext_vector_type(4)));
typedef int i32x8 __attribute__((ext_vector_type(8)));

constexpr int S_ = 16384, DM = 4096, INW = 7240, LDZ = 7424, POOLW = 1024, NH = 24, NKV = 4, HPG = 6, HD = 128;
constexpr int OFF_Q = 1024, OFF_KV = 4096, OFF_G = 7168, DFF = 11008, NFI = 22016, PLE = 256, NGATE = 72;
constexpr int ZROWS = S_ + 64, XNROWS = S_ + 256, CHUNK = 8192;
constexpr float EPS = 1e-6f;
constexpr float SM_C = 0.08838834764831845f * 1.4426950408889634f;
constexpr int NWAVES = 8, NTHREADS = 512;
constexpr float WG8_SCALE = 128.0f;

constexpr size_t al256(size_t x) { return (x + 255) / 256 * 256; }
constexpr size_t WS_CTL   = 0;
constexpr size_t CTL_BYTES = 262144;
constexpr size_t WS_CBIAS = WS_CTL + 32768;
constexpr size_t WS_SSQ1 = WS_CTL + 65536, WS_SSQ2 = WS_CTL + 131072, WS_SSQ3 = WS_CTL + 196608;
constexpr size_t WS_WIN   = WS_CTL + CTL_BYTES;
constexpr size_t WS_WO    = WS_WIN + al256((size_t)LDZ * DM * 2);
constexpr size_t WS_WFI   = WS_WO + al256((size_t)DM * DM * 2);
constexpr size_t WS_WFO   = WS_WFI + al256((size_t)NFI * DM * 2);
constexpr size_t WS_WG    = WS_WFO + al256((size_t)DM * DFF * 2);
constexpr size_t WS_WPLE  = WS_WG + al256((size_t)DM * DM * 2);
constexpr size_t WS_WPOOL = WS_WPLE + al256((size_t)DM * PLE * 2);
constexpr size_t WS_WC1K  = WS_WPOOL + al256((size_t)1024 * 256 * 2);
constexpr size_t WS_WC1V  = WS_WC1K + al256((size_t)256 * 4096 * 2);
constexpr size_t WS_COS   = WS_WC1V + al256((size_t)256 * 4096 * 2);
constexpr size_t WS_SIN   = WS_COS + al256((size_t)S_ * 16 * 4);
constexpr size_t WS_TAB   = WS_SIN + al256((size_t)S_ * 16 * 4);
constexpr size_t WS_XNP   = WS_TAB + 4096;
constexpr size_t WS_XN    = WS_XNP + (size_t)2 * DM * 2;
constexpr size_t WS_PB    = WS_XN + al256((size_t)XNROWS * DM * 2);
constexpr size_t WS_XN8   = WS_PB + al256((size_t)S_ * PLE * 2);
constexpr size_t WS_WIN8  = WS_XN8 + al256((size_t)S_ * DM);
constexpr size_t WS_R     = WS_WIN8 + al256((size_t)(OFF_G - POOLW) * DM);
constexpr size_t WS_Z     = WS_R;
constexpr size_t WS_M     = WS_Z + al256((size_t)ZROWS * LDZ * 2);
constexpr size_t WS_G     = WS_M + al256((size_t)S_ * POOLW * 2);
constexpr size_t WS_H1    = WS_G + al256((size_t)S_ * NGATE * 4);
constexpr size_t WS_KC    = WS_H1 + al256((size_t)8192 * 256 * 4);
constexpr size_t WS_VC    = WS_KC + al256((size_t)4 * 1024 * 128 * 2);
constexpr size_t WS_L     = WS_VC + al256((size_t)4 * 1024 * 128 * 2);
constexpr size_t WS_OACC  = WS_L + al256((size_t)S_ * NH * 4);
constexpr size_t WS_IMPP  = WS_OACC + al256((size_t)S_ * 3072 * 4);
constexpr size_t WS_IMPF  = WS_IMPP + al256((size_t)S_ * 4 * 256 * 4);
constexpr size_t WS_BM    = WS_IMPF + al256((size_t)S_ * 4 * 256 * 4);
constexpr size_t WS_MIX   = WS_BM + al256((size_t)S_ * 4 * 8 * 4);
constexpr size_t WS_END_A = WS_MIX + al256((size_t)S_ * DM * 2);
constexpr size_t WS_ERAW  = WS_R;
constexpr size_t WS_ACT   = WS_ERAW + al256((size_t)S_ * DM * 2);
constexpr size_t WS_ERSTD = WS_ACT + al256((size_t)S_ * DFF * 2);
constexpr size_t WS_END_B = WS_ERSTD + al256((size_t)S_ * 4);
static_assert(WS_ERAW + (size_t)S_ * DM * 2 <= WS_Z + (size_t)ZROWS * LDZ * 2, "eraw must fit inside the dead z region while mix is still being read");
constexpr size_t WS_NEED  = WS_END_A > WS_END_B ? WS_END_A : WS_END_B;
static_assert(WS_NEED <= (size_t)1440000000, "workspace map exceeds the guaranteed 4 x largest-tensor bytes");

constexpr int LDS_STAGE = 131072;
constexpr int LDS_MISC  = LDS_STAGE;
constexpr int LDS_XCH   = LDS_STAGE + 64;
constexpr int LDS_BYTES = LDS_XCH + 4096;

__device__ __forceinline__ unsigned cvt_pk_bf16(float lo, float hi) { unsigned r; asm volatile("v_cvt_pk_bf16_f32 %0, %1, %2" : "=v"(r) : "v"(lo), "v"(hi)); return r; }
__device__ __forceinline__ float bf_lo(unsigned u) { return __uint_as_float(u << 16); }
__device__ __forceinline__ float bf_hi(unsigned u) { return __uint_as_float(u & 0xffff0000u); }
__device__ __forceinline__ float bf2f(bf16_t b) { return __uint_as_float(((unsigned)b) << 16); }
__device__ __forceinline__ float wave_sum(float v) {
#pragma unroll
    for (int o = 32; o >= 1; o >>= 1) v += __shfl_xor(v, o);
    return v;
}
__device__ __forceinline__ float wave_max(float v) {
#pragma unroll
    for (int o = 32; o >= 1; o >>= 1) v = fmaxf(v, __shfl_xor(v, o));
    return v;
}
__device__ __forceinline__ float sigmoidf_(float x) { return __builtin_amdgcn_rcpf(1.0f + __expf(-x)); }

#define XB_TMO      128
#define XB_XCNT(j)  (256  + 64 * (j))
#define XB_XSUB(j)  (1280 + 64 * (j))
#define XB_XGEN(j)  (2304 + 64 * (j))
#define XB_TOP      3328
#define XB_TOPGEN   3392
#define XCD_BAR_WORDS 3456
#define XB_SPIN_CAP (1u << 18)
__device__ __forceinline__ unsigned xb_ld(unsigned* p)              { return __hip_atomic_load(p, __ATOMIC_RELAXED, __HIP_MEMORY_SCOPE_AGENT); }
__device__ __forceinline__ unsigned xb_add(unsigned* p, unsigned v) { return __hip_atomic_fetch_add(p, v, __ATOMIC_RELAXED, __HIP_MEMORY_SCOPE_AGENT); }
__device__ __forceinline__ unsigned xb_xcc_id() { return (unsigned)__builtin_amdgcn_s_getreg((3 << 11) | 20) & 0xFu; }
#define XB_SPIN(cond, bar) do { unsigned _sp = 0; while (cond) { __builtin_amdgcn_s_sleep(1); \
    if ((++_sp & 255u) == 0u) { if (xb_ld(&(bar)[XB_TMO])) break; if (_sp > XB_SPIN_CAP) { atomicAdd(&(bar)[XB_TMO], 1u); break; } } } } while (0)
struct XcdBarrier { unsigned* bar; unsigned x; volatile LAS unsigned* st; };
__device__ __forceinline__ XcdBarrier xcd_barrier_post(unsigned* bar, volatile LAS unsigned* st) {
    XcdBarrier b; b.bar = bar; b.x = xb_xcc_id(); b.st = st;
    if (threadIdx.x == 0) (void)xb_add(&bar[XB_XCNT(b.x)], 1u);
    return b;
}
__device__ __forceinline__ void xcd_barrier_complete(unsigned* bar, unsigned x, unsigned& nloc, unsigned& nx) {
    const unsigned G = gridDim.x * gridDim.y * gridDim.z;
    unsigned sum, cnt, mine, sp = 0u;
    for (;;) {
        sum = 0u; cnt = 0u; mine = 0u;
#pragma unroll
        for (unsigned j = 0; j < 16; ++j) { const unsigned c = xb_ld(&bar[XB_XCNT(j)]); sum += c; cnt += (c > 0u) ? 1u : 0u; mine = (j == x) ? c : mine; }
        if (sum == G) break;
        __builtin_amdgcn_s_sleep(1);
        if ((++sp & 255u) == 0u) { if (xb_ld(&bar[XB_TMO])) break; if (sp > XB_SPIN_CAP) { atomicAdd(&bar[XB_TMO], 1u); break; } }
    }
    nloc = mine > 0u ? mine : 1u; nx = cnt > 0u ? cnt : 1u;
}
__device__ __forceinline__ void xcd_barrier(const XcdBarrier& b) {
    asm volatile("s_waitcnt vmcnt(0)" ::: "memory");
    __syncthreads();
    if (threadIdx.x == 0) {
        unsigned* bar = b.bar;
        __builtin_amdgcn_s_waitcnt(0);
        unsigned nloc = b.st[0], nx = b.st[1];
        if (nloc == 0u) { xcd_barrier_complete(bar, b.x, nloc, nx); b.st[0] = nloc; b.st[1] = nx; }
        const unsigned old = xb_add(&bar[XB_XSUB(b.x)], 1u);
        const unsigned gen = old / nloc;
        if (old + 1u == (gen + 1u) * nloc) {
            __builtin_amdgcn_fence(__ATOMIC_RELEASE, "agent");
            asm volatile("s_waitcnt vmcnt(0)" ::: "memory");
            const unsigned og = xb_add(&bar[XB_TOP], 1u);
            const unsigned tg = og / nx;
            if (og + 1u == (tg + 1u) * nx) xb_add(&bar[XB_TOPGEN], 1u);
            else XB_SPIN(xb_ld(&bar[XB_TOPGEN]) == tg, bar);
            __builtin_amdgcn_fence(__ATOMIC_ACQUIRE, "agent");
            xb_add(&bar[XB_XGEN(b.x)], 1u);
            asm volatile("s_waitcnt vmcnt(0)" ::: "memory");
        } else {
            XB_SPIN(xb_ld(&bar[XB_XGEN(b.x)]) == gen, bar);
            __builtin_amdgcn_fence(__ATOMIC_ACQUIRE, "agent");
            asm volatile("s_waitcnt vmcnt(0)" ::: "memory");
        }
    }
    __syncthreads();
}

struct Params {
    const float* x; const float* p; const int* positions; const float* norm1_w; const float* w_in; const float* w_pool; const float* pool_scale;
    const float* q_norm_w; const float* k_norm_cmp_w; const float* k_norm_slc_w; const float* k_norm_win_w; const float* cmp_pos_k; const float* cmp_pos_v;
    const float* cmp_k_w1; const float* cmp_k_w2; const float* cmp_v_w1; const float* cmp_v_w2; const float* w_o; const float* norm2_w; const float* w_ffn_in;
    const float* conv_w; const float* conv_b; const float* w_ffn_out; const float* w_ple_proj; const float* ple_norm_w; const float* ple_gate_norm_w; const float* w_ple_gate;
    float* out; unsigned char* ws; int ph_lo, ph_hi;
};

namespace pg8 {
constexpr int BM = 256, BK = 64, HALF = 128, HTB = HALF * BK * 2, STAGE_BYTES = 8 * HTB, NXCD = 8, WGM = 8;
__host__ __device__ __forceinline__ int lds_byte(int r, int c) { const int st = (r >> 4) * 2 + (c >> 5), rr = r & 15, cc = c & 31, ob = rr * 64 + cc * 2; return st * 1024 + (ob ^ (((ob >> 9) & 1) << 5)); }
__host__ __device__ __forceinline__ void stage_rc(int b, int& R, int& C) { const int st = b / 1024, sb = b % 1024, swz = sb ^ (((sb >> 9) & 1) << 5); R = (st >> 1) * 16 + swz / 64; C = (st & 1) * 32 + (swz % 64) / 2; }
__host__ __device__ __forceinline__ int perm32(int rho) { const int n = rho >> 4, i = rho & 15; return 8 * (i >> 2) + 4 * n + (i & 3); }
struct Unit { int pm, pn; };

struct StaticOrder {
    int nM, nN, nwg, G, c;
    __device__ void init(int nM_, int nN_, int G_, int c_) { nM = nM_; nN = nN_; nwg = nM * nN; G = G_; c = c_; }
    __device__ bool next(int i, Unit& u) const {
        const long L = (long)i * G + c; if (L >= nwg) return false;
        int wgid = (int)L; { const int q = nwg / NXCD, r = nwg % NXCD, xcd = wgid % NXCD, off = wgid / NXCD; wgid = (xcd < r ? xcd * (q + 1) : r * (q + 1) + (xcd - r) * q) + off; }
        const int nig = WGM * nN, gid = wgid / nig, fm = gid * WGM, gsz = (nM - fm) < WGM ? (nM - fm) : WGM;
        u.pm = fm + ((wgid % nig) % gsz); u.pn = (wgid % nig) / gsz; return true;
    }
};

struct GStd {
    const char* A; const char* B; unsigned lda, ldb; int nt;
    __device__ __forceinline__ const char* a_base(const Unit& u) const { return A + (size_t)u.pm * 256 * lda * 2; }
    __device__ __forceinline__ const char* b_base(const Unit& u) const { return B + (size_t)u.pn * 256 * ldb * 2; }
    __device__ __forceinline__ size_t kpairA() const { return 256; }
};
struct GPool {
    const char* A; const char* B; unsigned lda, ldb; int nt;
    __device__ __forceinline__ const char* a_base(const Unit& u) const { return A + (size_t)u.pm * 256 * lda * 2 + (size_t)u.pn * 512; }
    __device__ __forceinline__ const char* b_base(const Unit& u) const { return B + (size_t)u.pn * 256 * ldb * 2; }
    __device__ __forceinline__ size_t kpairA() const { return 256; }
};
struct GCmp {
    const char* Z; const char* Bk; const char* Bv; unsigned lda, ldb; int nt;
    __device__ __forceinline__ const char* a_base(const Unit& u) const { const int which = u.pm >> 4, g = (u.pm >> 2) & 3, rt = u.pm & 3;
        return Z + (size_t)(OFF_KV + which * 512 + g * 128) * 2 + (size_t)rt * 256 * lda * 2; }
    __device__ __forceinline__ const char* b_base(const Unit& u) const { return (u.pm >> 4) ? Bv : Bk; }
    __device__ __forceinline__ size_t kpairA() const { return (size_t)LDZ * 2; }
};

struct EpiBf16 {
    static constexpr bool PERM = true;
    bf16_t* O; int ldc;
    __device__ __forceinline__ void operator()(const f32x4 (&acc)[2][2][4][2], const Unit& u, int wr, int wc, int fr, int fq) const {
        const int row0 = u.pm * BM + wr * 64 + fr, col0 = u.pn * BM + wc * 32 + 8 * fq;
#pragma unroll
        for (int ai = 0; ai < 2; ++ai)
#pragma unroll
            for (int m = 0; m < 4; ++m) { bf16_t* rowp = O + (size_t)(row0 + ai * HALF + m * 16) * ldc + col0;
#pragma unroll
                for (int bj = 0; bj < 2; ++bj) { const f32x4 v0 = acc[ai][bj][m][0], v1 = acc[ai][bj][m][1];
                    u32x4 w; w.x = cvt_pk_bf16(v0[0], v0[1]); w.y = cvt_pk_bf16(v0[2], v0[3]); w.z = cvt_pk_bf16(v1[0], v1[1]); w.w = cvt_pk_bf16(v1[2], v1[3]);
                    *(u32x4*)(rowp + bj * HALF) = w; } }
    }
};
struct EpiBf16S {
    static constexpr bool PERM = true;
    bf16_t* O; int ldc; float s;
    __device__ __forceinline__ void operator()(const f32x4 (&acc)[2][2][4][2], const Unit& u, int wr, int wc, int fr, int fq) const {
        const int row0 = u.pm * BM + wr * 64 + fr, col0 = u.pn * BM + wc * 32 + 8 * fq;
#pragma unroll
        for (int ai = 0; ai < 2; ++ai)
#pragma unroll
            for (int m = 0; m < 4; ++m) { bf16_t* rowp = O + (size_t)(row0 + ai * HALF + m * 16) * ldc + col0;
#pragma unroll
                for (int bj = 0; bj < 2; ++bj) { const f32x4 v0 = acc[ai][bj][m][0] * s, v1 = acc[ai][bj][m][1] * s;
                    u32x4 w; w.x = cvt_pk_bf16(v0[0], v0[1]); w.y = cvt_pk_bf16(v0[2], v0[3]); w.z = cvt_pk_bf16(v1[0], v1[1]); w.w = cvt_pk_bf16(v1[2], v1[3]);
                    *(u32x4*)(rowp + bj * HALF) = w; } }
    }
};
struct EpiBf16Ssq {
    static constexpr bool PERM = true;
    bf16_t* O; int ldc; float* ssq;
    __device__ __forceinline__ void operator()(const f32x4 (&acc)[2][2][4][2], const Unit& u, int wr, int wc, int fr, int fq) const {
        const int row0 = u.pm * BM + wr * 64 + fr, col0 = u.pn * BM + wc * 32 + 8 * fq;
#pragma unroll
        for (int ai = 0; ai < 2; ++ai)
#pragma unroll
            for (int m = 0; m < 4; ++m) { const int row = row0 + ai * HALF + m * 16; bf16_t* rowp = O + (size_t)row * ldc + col0; float s = 0.f;
#pragma unroll
                for (int bj = 0; bj < 2; ++bj) { const f32x4 v0 = acc[ai][bj][m][0], v1 = acc[ai][bj][m][1];
                    s += v0[0] * v0[0] + v0[1] * v0[1] + v0[2] * v0[2] + v0[3] * v0[3] + v1[0] * v1[0] + v1[1] * v1[1] + v1[2] * v1[2] + v1[3] * v1[3];
                    u32x4 w; w.x = cvt_pk_bf16(v0[0], v0[1]); w.y = cvt_pk_bf16(v0[2], v0[3]); w.z = cvt_pk_bf16(v1[0], v1[1]); w.w = cvt_pk_bf16(v1[2], v1[3]);
                    *(u32x4*)(rowp + bj * HALF) = w; }
                s += __shfl_xor(s, 16); s += __shfl_xor(s, 32);
                if (fq == 0) unsafeAtomicAdd(ssq + row, s); }
    }
};
struct EpiBf16Scale {
    static constexpr bool PERM = true;
    bf16_t* O; int ldc; const float* colscale;
    __device__ __forceinline__ void operator()(const f32x4 (&acc)[2][2][4][2], const Unit& u, int wr, int wc, int fr, int fq) const {
        const int row0 = u.pm * BM + wr * 64 + fr, col0 = u.pn * BM + wc * 32 + 8 * fq;
#pragma unroll
        for (int bj = 0; bj < 2; ++bj) { const f32x4 s0 = *(const f32x4*)(colscale + col0 + bj * HALF), s1 = *(const f32x4*)(colscale + col0 + bj * HALF + 4);
#pragma unroll
            for (int ai = 0; ai < 2; ++ai)
#pragma unroll
                for (int m = 0; m < 4; ++m) { bf16_t* rowp = O + (size_t)(row0 + ai * HALF + m * 16) * ldc + col0;
                    const f32x4 v0 = acc[ai][bj][m][0] * s0, v1 = acc[ai][bj][m][1] * s1;
                    u32x4 w; w.x = cvt_pk_bf16(v0[0], v0[1]); w.y = cvt_pk_bf16(v0[2], v0[3]); w.z = cvt_pk_bf16(v1[0], v1[1]); w.w = cvt_pk_bf16(v1[2], v1[3]);
                    *(u32x4*)(rowp + bj * HALF) = w; } }
    }
};
struct EpiResF32 {
    static constexpr bool PERM = false;
    const float* base; float* C; int ldc; int row_off;
    __device__ __forceinline__ void operator()(const f32x4 (&acc)[2][2][4][2], const Unit& u, int wr, int wc, int fr, int fq) const {
        const int row0 = u.pm * BM + wr * 64 + fr + row_off, col0 = u.pn * BM + wc * 32 + 4 * fq;
#pragma unroll
        for (int ai = 0; ai < 2; ++ai)
#pragma unroll
            for (int m = 0; m < 4; ++m) { const size_t off = (size_t)(row0 + ai * HALF + m * 16) * ldc + col0;
#pragma unroll
                for (int bj = 0; bj < 2; ++bj)
#pragma unroll
                    for (int n = 0; n < 2; ++n) { const f32x4 b = *(const f32x4*)(base + off + bj * HALF + n * 16); *(f32x4*)(C + off + bj * HALF + n * 16) = b + acc[ai][bj][m][n]; }
                asm volatile("" ::: "memory"); }
    }
};
template <bool FP8OUT>
struct EpiResNormT {
    static constexpr bool PERM = false;
    const float* base; float* C; bf16_t* XN; const float* nw; float* ssq; int ldc;
    __device__ __forceinline__ void operator()(const f32x4 (&acc)[2][2][4][2], const Unit& u, int wr, int wc, int fr, int fq) const {
        const int row0 = u.pm * BM + wr * 64 + fr, col0 = u.pn * BM + wc * 32 + 4 * fq;
        f32x4 wv[2][2];
#pragma unroll
        for (int bj = 0; bj < 2; ++bj)
#pragma unroll
            for (int n = 0; n < 2; ++n) wv[bj][n] = *(const f32x4*)(nw + col0 + bj * HALF + n * 16);
        f32x4 bv[2][2][2];
#pragma unroll
        for (int bj = 0; bj < 2; ++bj)
#pragma unroll
            for (int n = 0; n < 2; ++n) bv[0][bj][n] = *(const f32x4*)(base + (size_t)row0 * ldc + col0 + bj * HALF + n * 16);
#pragma unroll
        for (int rg = 0; rg < 8; ++rg) { const int ai = rg >> 2, m = rg & 3; const int row = row0 + ai * HALF + m * 16; const size_t off = (size_t)row * ldc + col0;
            if (rg < 7) { const int ai2 = (rg + 1) >> 2, m2 = (rg + 1) & 3; const size_t off2 = (size_t)(row0 + ai2 * HALF + m2 * 16) * ldc + col0;
#pragma unroll
                for (int bj = 0; bj < 2; ++bj)
#pragma unroll
                    for (int n = 0; n < 2; ++n) bv[(rg + 1) & 1][bj][n] = *(const f32x4*)(base + off2 + bj * HALF + n * 16); }
            float s = 0.f;
#pragma unroll
            for (int bj = 0; bj < 2; ++bj)
#pragma unroll
                for (int n = 0; n < 2; ++n) { const f32x4 v = bv[rg & 1][bj][n] + acc[ai][bj][m][n];
                    *(f32x4*)(C + off + bj * HALF + n * 16) = v; s += v[0] * v[0] + v[1] * v[1] + v[2] * v[2] + v[3] * v[3];
                    if (FP8OUT) { int pk = __builtin_amdgcn_cvt_pk_fp8_f32(v[0] * wv[bj][n][0], v[1] * wv[bj][n][1], 0, false); pk = __builtin_amdgcn_cvt_pk_fp8_f32(v[2] * wv[bj][n][2], v[3] * wv[bj][n][3], pk, true);
                        *(int*)((unsigned char*)XN + off + bj * HALF + n * 16) = pk; }
                    else { u32x2 o; o.x = cvt_pk_bf16(v[0] * wv[bj][n][0], v[1] * wv[bj][n][1]); o.y = cvt_pk_bf16(v[2] * wv[bj][n][2], v[3] * wv[bj][n][3]);
                        *(u32x2*)(XN + off + bj * HALF + n * 16) = o; } }
            s += __shfl_xor(s, 16); s += __shfl_xor(s, 32);
            if (fq == 0) unsafeAtomicAdd(ssq + row, s);
        }
    }
};
typedef EpiResNormT<false> EpiResNorm;
typedef EpiResNormT<true> EpiResNormF8;
struct EpiCmpGelu {
    static constexpr bool PERM = false;
    float* H; const float* bias;
    __device__ __forceinline__ void operator()(const f32x4 (&acc)[2][2][4][2], const Unit& u, int wr, int wc, int fr, int fq) const {
        const int row0 = u.pm * BM + wr * 64 + fr, col0 = wc * 32 + 4 * fq; const float* bs = bias + (u.pm >> 4) * 256;
        f32x4 bvv[2][2];
#pragma unroll
        for (int bj = 0; bj < 2; ++bj)
#pragma unroll
            for (int n = 0; n < 2; ++n) bvv[bj][n] = *(const f32x4*)(bs + col0 + bj * HALF + n * 16);
#pragma unroll
        for (int ai = 0; ai < 2; ++ai)
#pragma unroll
            for (int m = 0; m < 4; ++m) { float* rowp = H + (size_t)(row0 + ai * HALF + m * 16) * 256 + col0;
#pragma unroll
                for (int bj = 0; bj < 2; ++bj)
#pragma unroll
                    for (int n = 0; n < 2; ++n) { f32x4 v = acc[ai][bj][m][n] + bvv[bj][n];
#pragma unroll
                        for (int j = 0; j < 4; ++j) { const float xx = v[j], uu = 0.7978845608028654f * (xx + 0.044715f * xx * xx * xx); const float th = 1.0f - 2.0f / (1.0f + __expf(2.0f * uu)); v[j] = 0.5f * xx * (1.0f + th); }
                        *(f32x4*)(rowp + bj * HALF + n * 16) = v; } }
    }
};
struct EpiGate {
    static constexpr bool PERM = false;
    float* C; const bf16_t* eraw; const float* erstd; const float* pw; const float* ssq; int ldc; float ascale;
    __device__ __forceinline__ void operator()(const f32x4 (&acc)[2][2][4][2], const Unit& u, int wr, int wc, int fr, int fq) const {
        const int row0 = u.pm * BM + wr * 64 + fr, col0 = u.pn * BM + wc * 32 + 4 * fq;
        f32x4 wv[2][2];
#pragma unroll
        for (int bj = 0; bj < 2; ++bj)
#pragma unroll
            for (int n = 0; n < 2; ++n) wv[bj][n] = *(const f32x4*)(pw + col0 + bj * HALF + n * 16);
        f32x4 bv[2][2][2]; u32x2 ev[2][2][2]; float rsv[2], rgv[2];
#pragma unroll
        for (int bj = 0; bj < 2; ++bj)
#pragma unroll
            for (int n = 0; n < 2; ++n) { bv[0][bj][n] = *(const f32x4*)(C + (size_t)row0 * ldc + col0 + bj * HALF + n * 16); ev[0][bj][n] = *(const u32x2*)(eraw + (size_t)row0 * ldc + col0 + bj * HALF + n * 16); }
        rsv[0] = erstd[row0]; rgv[0] = ssq[row0];
#pragma unroll
        for (int rg = 0; rg < 8; ++rg) { const int ai = rg >> 2, m = rg & 3; const int row = row0 + ai * HALF + m * 16; const size_t off = (size_t)row * ldc + col0;
            if (rg < 7) { const int ai2 = (rg + 1) >> 2, m2 = (rg + 1) & 3; const int row2 = row0 + ai2 * HALF + m2 * 16; const size_t off2 = (size_t)row2 * ldc + col0;
#pragma unroll
                for (int bj = 0; bj < 2; ++bj)
#pragma unroll
                    for (int n = 0; n < 2; ++n) { bv[(rg + 1) & 1][bj][n] = *(const f32x4*)(C + off2 + bj * HALF + n * 16); ev[(rg + 1) & 1][bj][n] = *(const u32x2*)(eraw + off2 + bj * HALF + n * 16); }
                rsv[(rg + 1) & 1] = erstd[row2]; rgv[(rg + 1) & 1] = ssq[row2]; }
            const float rs = rsqrtf(rsv[rg & 1] * (1.0f / DM) + EPS), rg_ = rsqrtf(rgv[rg & 1] * (1.0f / DM) + EPS) * ascale;
#pragma unroll
            for (int bj = 0; bj < 2; ++bj)
#pragma unroll
                for (int n = 0; n < 2; ++n) { const f32x4 b = bv[rg & 1][bj][n]; const u32x2 e = ev[rg & 1][bj][n]; const f32x4 a = acc[ai][bj][m][n]; f32x4 o;
                    o[0] = b[0] + bf_lo(e.x) * rs * wv[bj][n][0] * sigmoidf_(a[0] * rg_); o[1] = b[1] + bf_hi(e.x) * rs * wv[bj][n][1] * sigmoidf_(a[1] * rg_);
                    o[2] = b[2] + bf_lo(e.y) * rs * wv[bj][n][2] * sigmoidf_(a[2] * rg_); o[3] = b[3] + bf_hi(e.y) * rs * wv[bj][n][3] * sigmoidf_(a[3] * rg_);
                    *(f32x4*)(C + off + bj * HALF + n * 16) = o; }
        }
    }
};
struct GFfn {
    const char* A; const char* B; unsigned lda, ldb; int nt;
    __device__ __forceinline__ const char* a_base(const Unit& u) const { return A + ((long)u.pm * 254 - 2) * (long)lda * 2; }
    __device__ __forceinline__ const char* b_base(const Unit& u) const { return B + (size_t)u.pn * 256 * ldb * 2; }
    __device__ __forceinline__ size_t kpairA() const { return 256; }
};
template <int CTRL> __device__ __forceinline__ float dpp_f(float v) { return __int_as_float(__builtin_amdgcn_update_dpp(0, __float_as_int(v), CTRL, 0xf, 0xf, false)); }
struct EpiFfn {
    static constexpr bool PERM = true;
    bf16_t* ACT; const float* cw; const float* cb; LAS float* X; const float* ssq;
    __device__ __forceinline__ void operator()(const f32x4 (&acc)[2][2][4][2], const Unit& u, int wr, int wc, int fr, int fq) const {
        const int colw = wc * 32 + 8 * fq;
        const int f0 = u.pn * 128 + colw;
        f32x4 w0[2], w1[2], w2[2], cbv[2];
#pragma unroll
        for (int n = 0; n < 2; ++n) { w0[n] = *(const f32x4*)(cw + f0 + 4 * n); w1[n] = *(const f32x4*)(cw + DFF + f0 + 4 * n); w2[n] = *(const f32x4*)(cw + 2 * DFF + f0 + 4 * n); cbv[n] = *(const f32x4*)(cb + f0 + 4 * n); }
        float rsv[2][4];
#pragma unroll
        for (int ai = 0; ai < 2; ++ai)
#pragma unroll
            for (int m = 0; m < 4; ++m) { const long t = (long)u.pm * 254 - 2 + ai * HALF + wr * 64 + m * 16 + fr; rsv[ai][m] = ssq[t < 0 ? 0 : (t >= S_ ? S_ - 1 : t)]; }
#pragma unroll
        for (int ai = 0; ai < 2; ++ai)
#pragma unroll
            for (int m = 0; m < 4; ++m) { const long t = (long)u.pm * 254 - 2 + ai * HALF + wr * 64 + m * 16 + fr; rsv[ai][m] = (t >= 0 && t < S_) ? rsqrtf(rsv[ai][m] * (1.0f / DM) + EPS) : 0.f; }
        if (fr >= 14) {
#pragma unroll
            for (int ai = 0; ai < 2; ++ai)
#pragma unroll
                for (int n = 0; n < 2; ++n) *(LAS f32x4*)(X + ((2 * ai + wr) * 2 + (fr - 14)) * 128 + colw + 4 * n) = acc[ai][0][3][n] * rsv[ai][3];
        }
        asm volatile("s_waitcnt lgkmcnt(0)" ::: "memory");
        __builtin_amdgcn_s_barrier(); asm volatile("" ::: "memory");
        __builtin_amdgcn_s_barrier(); asm volatile("" ::: "memory");
        const bool sel1 = fr == 15, sel2 = fr >= 14;
#pragma unroll
        for (int ai = 0; ai < 2; ++ai) {
            f32x4 pv[2];
            const int pseg = 2 * ai + wr - 1;
#pragma unroll
            for (int n = 0; n < 2; ++n) { pv[n] = (f32x4){0.f, 0.f, 0.f, 0.f}; if (pseg >= 0 && fr >= 14) pv[n] = *(const LAS f32x4*)(X + (pseg * 2 + (fr - 14)) * 128 + colw + 4 * n); }
#pragma unroll
            for (int m = 0; m < 4; ++m) {
                const int r = ai * HALF + wr * 64 + m * 16 + fr; const long t = (long)u.pm * 254 - 2 + r;
                unsigned ow[4];
#pragma unroll
                for (int n = 0; n < 2; ++n) {
                    const f32x4 cur = acc[ai][0][m][n] * rsv[ai][m], up = acc[ai][1][m][n] * rsv[ai][m];
                    f32x4 x1, x2;
#pragma unroll
                    for (int i = 0; i < 4; ++i) { x1[i] = dpp_f<0x121>(sel1 ? pv[n][i] : cur[i]); x2[i] = dpp_f<0x122>(sel2 ? pv[n][i] : cur[i]); }
                    const f32x4 y = cbv[n] + w0[n] * x2 + w1[n] * x1 + w2[n] * cur;
                    f32x4 sg;
#pragma unroll
                    for (int i = 0; i < 4; ++i) sg[i] = sigmoidf_(y[i]);
                    const f32x4 o = y * sg * up;
                    ow[2 * n] = cvt_pk_bf16(o[0], o[1]); ow[2 * n + 1] = cvt_pk_bf16(o[2], o[3]);
                    pv[n] = cur;
                }
                if (r >= 2 && t < S_) *(u32x4*)(ACT + (size_t)t * DFF + f0) = (u32x4){ow[0], ow[1], ow[2], ow[3]};
            }
        }
    }
};

template <class GD, class Epi, bool F8 = false>
__device__ __forceinline__ void gemm_phase(LAS unsigned char* lds, const GD g, const StaticOrder& S, const Epi& E) {
    const int tid = threadIdx.x, wid = __builtin_amdgcn_readfirstlane(tid >> 6), lane = tid & 63, wr = wid >> 2, wc = wid & 3, fr = lane & 15, fq = lane >> 4;
    const int nt = g.nt;
    unsigned voffA[2], voffB[2];
#pragma unroll
    for (int i = 0; i < 2; ++i) { int R, C; stage_rc(tid * 16 + i * 8192, R, C); const int Rb = Epi::PERM ? ((R & ~31) + perm32(R & 31)) : R;
        voffA[i] = (unsigned)(R * g.lda + C) * 2u; voffB[i] = (unsigned)(Rb * g.ldb + C) * 2u; }
    const size_t kpA = g.kpairA();
    const size_t hstepA = (size_t)HALF * g.lda * 2, hstepB = (size_t)HALF * g.ldb * 2;
    const unsigned ldsw = (unsigned)wid * 1024u;
    const int aoff = lds_byte(wr * 64 + fr, fq * 8), boff = lds_byte(wc * 32 + fr, fq * 8);
#define PG8_SA(b, h) (((b) * 2 + (h)) * HTB)
#define PG8_SB(b, h) ((4 + (b) * 2 + (h)) * HTB)
#define PG8_STAGE(bufoff, gbase, voff) do { _Pragma("unroll") for (int _i = 0; _i < 2; ++_i) \
        __builtin_amdgcn_global_load_lds((const unsigned*)((const char*)(gbase) + (voff)[_i]), (LAS unsigned*)(lds + (bufoff) + ldsw + _i * 8192), 16, 0, 0); } while (0)
#define PG8_LDA(dst, b, h) do { if constexpr (F8) { _Pragma("unroll") for (int m = 0; m < 4; ++m) { const i32x4 lo_ = *(const LAS i32x4*)(lds + PG8_SA(b, h) + aoff + m * 2048), hi_ = *(const LAS i32x4*)(lds + PG8_SA(b, h) + aoff + m * 2048 + 1024); \
            dst##8[m] = __builtin_shufflevector(lo_, hi_, 0, 1, 2, 3, 4, 5, 6, 7); } } \
        else { _Pragma("unroll") for (int m = 0; m < 4; ++m) _Pragma("unroll") for (int k = 0; k < 2; ++k) dst[m][k] = *(const LAS bf16x8*)(lds + PG8_SA(b, h) + aoff + m * 2048 + k * 1024); } } while (0)
#define PG8_LDB(dst, b, h) do { if constexpr (F8) { _Pragma("unroll") for (int n = 0; n < 2; ++n) { const i32x4 lo_ = *(const LAS i32x4*)(lds + PG8_SB(b, h) + boff + n * 2048), hi_ = *(const LAS i32x4*)(lds + PG8_SB(b, h) + boff + n * 2048 + 1024); \
            dst##8[n] = __builtin_shufflevector(lo_, hi_, 0, 1, 2, 3, 4, 5, 6, 7); } } \
        else { _Pragma("unroll") for (int n = 0; n < 2; ++n) _Pragma("unroll") for (int k = 0; k < 2; ++k) dst[n][k] = *(const LAS bf16x8*)(lds + PG8_SB(b, h) + boff + n * 2048 + k * 1024); } } while (0)
#define PG8_MMA(ai, bj, At, Bt) do { __builtin_amdgcn_s_setprio(1); \
        if constexpr (F8) { _Pragma("unroll") for (int m = 0; m < 4; ++m) _Pragma("unroll") for (int n = 0; n < 2; ++n) \
            asm volatile("v_mfma_scale_f32_16x16x128_f8f6f4 %0, %1, %2, %0, %3, %3 op_sel_hi:[0,0,0]" : "+v"(acc[ai][bj][m][n]) : "v"(Bt##8[n]), "v"(At##8[m]), "v"(one_scale)); } \
        else { _Pragma("unroll") for (int m = 0; m < 4; ++m) _Pragma("unroll") for (int n = 0; n < 2; ++n) _Pragma("unroll") for (int k = 0; k < 2; ++k) \
            acc[ai][bj][m][n] = __builtin_amdgcn_mfma_f32_16x16x32_bf16(Bt[n][k], At[m][k], acc[ai][bj][m][n], 0, 0, 0); } \
        __builtin_amdgcn_s_setprio(0); } while (0)
#define PG8_WAIT_V(n) asm volatile("s_waitcnt vmcnt(" #n ")" ::: "memory")
#define PG8_WAIT_L(n) asm volatile("s_waitcnt lgkmcnt(" #n ")" ::: "memory")
#define PG8_BAR __builtin_amdgcn_s_barrier()
#define PG8_SCHED __builtin_amdgcn_sched_barrier(0)
    Unit cur, nxt; int ui = 0;
    if (!S.next(0, cur)) return;
    f32x4 acc[2][2][4][2];
#pragma unroll
    for (int a = 0; a < 2; ++a)
#pragma unroll
        for (int b = 0; b < 2; ++b)
#pragma unroll
            for (int m = 0; m < 4; ++m)
#pragma unroll
                for (int n = 0; n < 2; ++n) acc[a][b][m][n] = (f32x4){0.f, 0.f, 0.f, 0.f};
    bf16x8 At[4][2], B0[2][2], B1[2][2];
    i32x8 At8[4], B08[2], B18[2];
    (void)At; (void)B0; (void)B1; (void)At8; (void)B08; (void)B18;
    int one_scale = 0x7F7F7F7F; (void)one_scale;
    const char* cA = g.a_base(cur); const char* cB = g.b_base(cur);
    PG8_STAGE(PG8_SB(0, 0), cB, voffB); PG8_STAGE(PG8_SA(0, 0), cA, voffA); PG8_STAGE(PG8_SB(0, 1), cB + hstepB, voffB); PG8_STAGE(PG8_SA(0, 1), cA + hstepA, voffA);
    if (wr == 1) PG8_BAR;
    PG8_WAIT_V(4); PG8_BAR;
    PG8_STAGE(PG8_SB(1, 0), cB + 128, voffB); PG8_STAGE(PG8_SA(1, 0), cA + 128, voffA); PG8_STAGE(PG8_SB(1, 1), cB + hstepB + 128, voffB);
    PG8_WAIT_V(6); PG8_BAR;
    for (;;) {
        const bool has_next = S.next(ui + 1, nxt);
        const char* nA = has_next ? g.a_base(nxt) : cA; const char* nB = has_next ? g.b_base(nxt) : cB;
        for (int t = 0; t < nt; t += 2) {
            const bool last = (t == nt - 2);
            const char* a0 = cA + (size_t)(t >> 1) * kpA;
            const char* a1 = a0 + 128;
            const char* a2 = last ? nA : a0 + kpA; const char* b2 = last ? nB : cB + (size_t)(t + 2) * 128;
            const char* a3 = a2 + 128; const char* b3 = b2 + 128;
            PG8_LDB(B0, 0, 0); PG8_SCHED; PG8_LDA(At, 0, 0); PG8_STAGE(PG8_SA(1, 1), a1 + hstepA, voffA);
            PG8_WAIT_L(8); PG8_BAR; PG8_WAIT_L(0); PG8_MMA(0, 0, At, B0); PG8_BAR; PG8_SCHED;
            PG8_LDB(B1, 0, 1); PG8_STAGE(PG8_SB(0, 0), b2, voffB);
            PG8_BAR; PG8_WAIT_L(0); PG8_MMA(0, 1, At, B1); PG8_BAR;
            PG8_LDA(At, 0, 1); PG8_STAGE(PG8_SA(0, 0), a2, voffA);
            PG8_BAR; PG8_WAIT_L(0); PG8_MMA(1, 0, At, B0); PG8_BAR; PG8_SCHED;
            PG8_STAGE(PG8_SB(0, 1), b2 + hstepB, voffB);
            PG8_WAIT_V(6); PG8_BAR; PG8_MMA(1, 1, At, B1); PG8_BAR;
            PG8_LDB(B0, 1, 0); PG8_SCHED; PG8_LDA(At, 1, 0); PG8_STAGE(PG8_SA(0, 1), a2 + hstepA, voffA);
            PG8_WAIT_L(8); PG8_BAR; PG8_WAIT_L(0); PG8_MMA(0, 0, At, B0); PG8_BAR; PG8_SCHED;
            PG8_LDB(B1, 1, 1); PG8_STAGE(PG8_SB(1, 0), b3, voffB);
            PG8_BAR; PG8_WAIT_L(0); PG8_MMA(0, 1, At, B1); PG8_BAR;
            PG8_LDA(At, 1, 1); PG8_STAGE(PG8_SA(1, 0), a3, voffA);
            PG8_BAR; PG8_WAIT_L(0); PG8_MMA(1, 0, At, B0); PG8_BAR; PG8_SCHED;
            PG8_STAGE(PG8_SB(1, 1), b3 + hstepB, voffB);
            PG8_WAIT_V(6); PG8_BAR; PG8_MMA(1, 1, At, B1); PG8_BAR;
        }
        if constexpr (F8) asm volatile("s_nop 15\n\ts_nop 15\n\ts_nop 15" ::: "memory");
        E(acc, cur, wr, wc, fr, fq);
        if (!has_next) break;
#pragma unroll
        for (int a = 0; a < 2; ++a)
#pragma unroll
            for (int b = 0; b < 2; ++b)
#pragma unroll
                for (int m = 0; m < 4; ++m)
#pragma unroll
                    for (int n = 0; n < 2; ++n) acc[a][b][m][n] = (f32x4){0.f, 0.f, 0.f, 0.f};
        cur = nxt; cA = nA; cB = nB; ++ui;
    }
    PG8_WAIT_V(0);
    if (wr == 0) PG8_BAR;
    PG8_BAR;
#undef PG8_SA
#undef PG8_SB
#undef PG8_STAGE
#undef PG8_LDA
#undef PG8_LDB
#undef PG8_MMA
#undef PG8_WAIT_V
#undef PG8_WAIT_L
#undef PG8_BAR
#undef PG8_SCHED
}
}

namespace att {
constexpr int KVBLK = 64;
constexpr int SHM_V = KVBLK * HD * 2, SHM_K = KVBLK * HD * 2, SHM_ATTN = 2 * SHM_V + 2 * SHM_K + NWAVES * 64 * 4;
#define KSWZ(row, colB) ((row) * 256 + ((colB) ^ (((row) & 7) << 4)))
#define SBAR() __builtin_amdgcn_sched_barrier(0)
__device__ __forceinline__ int crow(int r, int hi) { return (r & 3) + 8 * (r >> 2) + 4 * hi; }
__device__ __forceinline__ void qkt(f32x16& p0, f32x16& p1, const char* Ks, const bf16x8* qr, int r32, int hi) {
    p0 = f32x16{}; p1 = f32x16{};
    bf16x8 ka[2], kb[2];
    { const int cb = (hi * 8) * 2; ka[0] = *reinterpret_cast<const bf16x8*>(Ks + KSWZ(r32, cb)); kb[0] = *reinterpret_cast<const bf16x8*>(Ks + KSWZ(32 + r32, cb)); }
#pragma unroll
    for (int d0 = 0; d0 < 8; ++d0) {
        if (d0 < 7) { const int cb = ((d0 + 1) * 16 + hi * 8) * 2;
            ka[(d0 + 1) & 1] = *reinterpret_cast<const bf16x8*>(Ks + KSWZ(r32, cb)); kb[(d0 + 1) & 1] = *reinterpret_cast<const bf16x8*>(Ks + KSWZ(32 + r32, cb)); }
        SBAR();
        p0 = __builtin_amdgcn_mfma_f32_32x32x16_bf16(ka[d0 & 1], qr[d0], p0, 0, 0, 0);
        p1 = __builtin_amdgcn_mfma_f32_32x32x16_bf16(kb[d0 & 1], qr[d0], p1, 0, 0, 0);
        SBAR();
    }
}
__device__ __forceinline__ int v_st(int k, int c) { const int kk = (k & ~0xC) | ((k & 4) << 1) | ((k & 8) >> 1); return ((kk >> 3) * 4 + (c >> 5)) * 512 + ((kk & 7) * 32 + (c & 31)) * 2; }
__device__ __forceinline__ int v_rd_base(int lane) { return ((lane & 3) << 3) | (((lane >> 2) & 3) << 6) | (((lane >> 4) & 1) << 5) | (((lane >> 5) & 1) << 8); }
constexpr int v_rd_off(int d0, int ks, int half) { return d0 * 512 + ks * 4096 + half * 2048; }
__device__ __forceinline__ s16x4 tr_read(int vb, int off) { return __builtin_amdgcn_ds_read_tr16_b64_v4i16((LAS s16x4*)(unsigned long)(unsigned)(vb + off)); }
__device__ __forceinline__ void pv_d0(f32x16* o, int vb, bf16x8 pa0, bf16x8 pa1, bf16x8 pa2, bf16x8 pa3) {
    s16x4 L[2][4], H[2][4];
#pragma unroll
    for (int d0 = 0; d0 < 4; ++d0) { L[0][d0] = tr_read(vb, v_rd_off(d0, 0, 0)); H[0][d0] = tr_read(vb, v_rd_off(d0, 0, 1)); }
#pragma unroll
    for (int ks = 0; ks < 4; ++ks) {
        if (ks < 3) {
#pragma unroll
            for (int d0 = 0; d0 < 4; ++d0) { L[(ks + 1) & 1][d0] = tr_read(vb, v_rd_off(d0, ks + 1, 0)); H[(ks + 1) & 1][d0] = tr_read(vb, v_rd_off(d0, ks + 1, 1)); }
        }
        const bf16x8 pa = ks == 0 ? pa0 : (ks == 1 ? pa1 : (ks == 2 ? pa2 : pa3));
#pragma unroll
        for (int d0 = 0; d0 < 4; ++d0) { const s16x4 l = L[ks & 1][d0], h = H[ks & 1][d0];
            o[d0] = __builtin_amdgcn_mfma_f32_32x32x16_bf16(pa, (bf16x8){l[0], l[1], l[2], l[3], h[0], h[1], h[2], h[3]}, o[d0], 0, 0, 0); }
    }
}
__device__ __forceinline__ void pack_p(const f32x16& p0, const f32x16& p1, bf16x8& pa0, bf16x8& pa1, bf16x8& pa2, bf16x8& pa3) {
#define PK4(P, BASE, OUT) do { unsigned a0 = cvt_pk_bf16(P[BASE + 0], P[BASE + 1]), a1 = cvt_pk_bf16(P[BASE + 2], P[BASE + 3]);   \
    unsigned b0 = cvt_pk_bf16(P[BASE + 4], P[BASE + 5]), b1 = cvt_pk_bf16(P[BASE + 6], P[BASE + 7]);                              \
    auto r0 = __builtin_amdgcn_permlane32_swap(a0, b0, false, false); auto r1 = __builtin_amdgcn_permlane32_swap(a1, b1, false, false); \
    u32x4 w = {r0[0], r1[0], r0[1], r1[1]}; OUT = *reinterpret_cast<bf16x8*>(&w); } while (0)
    PK4(p0, 0, pa0); PK4(p0, 8, pa1); PK4(p1, 0, pa2); PK4(p1, 8, pa3);
#undef PK4
}

__device__ __forceinline__ void pack_half(const f32x16& p, bf16x8& paA, bf16x8& paB) {
#define PK4(P, BASE, OUT) do { unsigned a0 = cvt_pk_bf16(P[BASE + 0], P[BASE + 1]), a1 = cvt_pk_bf16(P[BASE + 2], P[BASE + 3]);   \
    unsigned b0 = cvt_pk_bf16(P[BASE + 4], P[BASE + 5]), b1 = cvt_pk_bf16(P[BASE + 6], P[BASE + 7]);                              \
    auto r0 = __builtin_amdgcn_permlane32_swap(a0, b0, false, false); auto r1 = __builtin_amdgcn_permlane32_swap(a1, b1, false, false); \
    u32x4 w = {r0[0], r1[0], r0[1], r1[1]}; OUT = *reinterpret_cast<bf16x8*>(&w); } while (0)
    PK4(p, 0, paA); PK4(p, 8, paB);
#undef PK4
}
template <int KS0, bool WITH_EXP>
__device__ __forceinline__ void pv_half(f32x16* o, int vb, bf16x8 paA, bf16x8 paB, f32x16& px, float off) {
    s16x4 L[2][4], H[2][4];
#pragma unroll
    for (int d0 = 0; d0 < 4; ++d0) { L[0][d0] = tr_read(vb, v_rd_off(d0, KS0, 0)); H[0][d0] = tr_read(vb, v_rd_off(d0, KS0, 1)); }
#pragma unroll
    for (int d0 = 0; d0 < 4; ++d0) { L[1][d0] = tr_read(vb, v_rd_off(d0, KS0 + 1, 0)); H[1][d0] = tr_read(vb, v_rd_off(d0, KS0 + 1, 1)); }
#pragma unroll
    for (int kk = 0; kk < 2; ++kk) {
        const bf16x8 pa = kk == 0 ? paA : paB;
#pragma unroll
        for (int d0 = 0; d0 < 4; ++d0) { const s16x4 l = L[kk][d0], h = H[kk][d0];
            if (WITH_EXP) SBAR();
            o[d0] = __builtin_amdgcn_mfma_f32_32x32x16_bf16(pa, (bf16x8){l[0], l[1], l[2], l[3], h[0], h[1], h[2], h[3]}, o[d0], 0, 0, 0);
            if (WITH_EXP) {
#pragma unroll
                for (int q = 0; q < 2; ++q) { const int r = (kk * 4 + d0) * 2 + q; px[r] = __builtin_amdgcn_exp2f(fmaf(px[r], SM_C, off)); }
                SBAR(); }
        }
    }
}
enum { MODE_CMP = 0, MODE_WIN = 1, MODE_SLC = 2 };
struct AttnArgs {
    const bf16_t* Z; const bf16_t* KC; const bf16_t* VC; const float* G; float* L; float* OACC; bf16_t* MIX; const unsigned* BM; const float* TAB;
};
template <int MODE>
__device__ __forceinline__ void attn_unit(const AttnArgs& a, LAS char* ldsL, int qt, int g, int hp) {
    char* lds = (char*)ldsL;
    const int tid = threadIdx.x, wid = __builtin_amdgcn_readfirstlane(tid >> 6), lane = tid & 63, r32 = lane & 31, hi = lane >> 5;
    float* li_l = (float*)(lds + LDS_XCH) + wid * 64;
    const int t0 = MODE == MODE_SLC ? qt * 40 : qt * 128;
    const int tq_raw = MODE == MODE_SLC ? t0 + wid * 5 + r32 / 6 : t0 + wid * 16 + (r32 & 15);
    const bool rvalid = MODE == MODE_SLC ? (r32 < 30 && tq_raw < S_) : true;
    const int tq = tq_raw < S_ ? tq_raw : S_ - 1;
    const int hq = MODE == MODE_SLC ? g * HPG + r32 % 6 : g * HPG + hp * 2 + (r32 >> 4);
    const int tlast = MODE == MODE_SLC ? ((t0 + 39) < S_ ? (t0 + 39) : S_ - 1) : t0 + 127;
    const bf16_t* Kb; const bf16_t* Vb; long ldk;
    if (MODE == MODE_CMP) { Kb = a.KC + (size_t)g * 1024 * HD; Vb = a.VC + (size_t)g * 1024 * HD; ldk = HD; }
    else if (MODE == MODE_WIN) { Kb = a.Z + OFF_KV + 4 * 512 + g * HD; Vb = a.Z + OFF_KV + 5 * 512 + g * HD; ldk = LDZ; }
    else { Kb = a.Z + OFF_KV + 2 * 512 + g * HD; Vb = a.Z + OFF_KV + 3 * 512 + g * HD; ldk = LDZ; }
    int j0, j1;
    if (MODE == MODE_CMP) { j0 = 0; j1 = (((t0 + 127 - 31) >> 4) >> 6) + 1; }
    else if (MODE == MODE_WIN) { j0 = (t0 - 511) > 0 ? ((t0 - 511) >> 6) : 0; j1 = ((t0 + 127) >> 6) + 1; }
    else { j0 = 0; j1 = (tlast >> 6) + 1; }
    int klo, khi;
    if (MODE == MODE_CMP) { klo = 0; khi = tq >= 31 ? ((tq - 31) >> 4) : -1; }
    else if (MODE == MODE_WIN) { klo = tq - 511; khi = tq; }
    else { klo = 0; khi = rvalid ? tq : -1; }
    float negBC = -a.TAB[512 + (MODE == MODE_CMP ? 0 : (MODE == MODE_SLC ? 1 : 2))];
    bf16x8 qr[8];
    { const bf16_t* Qw = a.Z + (size_t)tq * LDZ + OFF_Q + hq * HD + hi * 8;
#pragma unroll
      for (int d0 = 0; d0 < 8; ++d0) qr[d0] = *reinterpret_cast<const bf16x8*>(Qw + d0 * 16); }
    f32x16 o[4] = {}; float lsum = 0.f;
    unsigned soK[2], soV[2];
#pragma unroll
    for (int i = 0; i < 2; ++i) { const int p = (wid + 8 * i) * 64 + lane;
        { const int row = p >> 4, c = (p & 15) ^ (row & 7); soK[i] = (unsigned)(row * ldk + c * 8) * 2u; }
        { const int sub = p >> 5, within = p & 31, kk = (sub >> 2) * 8 + (within >> 2), c = (sub & 3) * 32 + (within & 3) * 8, k = (kk & ~0xC) | ((kk & 4) << 1) | ((kk & 8) >> 1);
          soV[i] = (unsigned)(k * ldk + c) * 2u; } }
    const int vb0 = (int)(uintptr_t)(LAS char*)ldsL + 16384 + v_rd_base(lane);
#define ISSUE(jt) do { const int _b = ((jt) - j0) & 3; const char* _kp = (const char*)Kb + (size_t)(jt) * KVBLK * ldk * 2; const char* _vp = (const char*)Vb + (size_t)(jt) * KVBLK * ldk * 2; \
    _Pragma("unroll") for (int _i = 0; _i < 2; ++_i) { \
        __builtin_amdgcn_global_load_lds((const unsigned*)(_kp + soK[_i]), (LAS unsigned*)(ldsL + _b * 32768 + (wid + 8 * _i) * 1024), 16, 0, 0); \
        __builtin_amdgcn_global_load_lds((const unsigned*)(_vp + soV[_i]), (LAS unsigned*)(ldsL + _b * 32768 + 16384 + (wid + 8 * _i) * 1024), 16, 0, 0); } } while (0)
    unsigned bmw = 0u;
    if (MODE == MODE_SLC) bmw = a.BM[((size_t)tq * 4 + g) * 8];
    asm volatile("s_waitcnt lgkmcnt(0)" ::: "memory");
    __builtin_amdgcn_s_barrier();
    asm volatile("" ::: "memory");
    ISSUE(j0);
    asm volatile("s_waitcnt vmcnt(4) lgkmcnt(0)" : "+v"(bmw), "+v"(negBC), "+v"(qr[0]), "+v"(qr[1]), "+v"(qr[2]), "+v"(qr[3]), "+v"(qr[4]), "+v"(qr[5]), "+v"(qr[6]), "+v"(qr[7]) :: "memory");
    if (j0 + 1 < j1) ISSUE(j0 + 1); if (j0 + 2 < j1) ISSUE(j0 + 2);
    for (int j = j0; j < j1; ++j) {
        const int buf = (j - j0) & 3;
        if (j + 2 < j1) asm volatile("s_waitcnt vmcnt(8)" ::: "memory"); else if (j + 1 < j1) asm volatile("s_waitcnt vmcnt(4)" ::: "memory"); else asm volatile("s_waitcnt vmcnt(0)" ::: "memory");
        __builtin_amdgcn_s_barrier();
        asm volatile("" ::: "memory");
        if (j + 3 < j1) ISSUE(j + 3);
        int lhi = khi;
        if (MODE == MODE_SLC) { if (!((bmw >> (j & 31)) & 1u)) lhi = -1; }
        const int kb = j * KVBLK;
        const bool l_any = (kb + 63 >= klo) && (kb <= lhi);
        const bool l_full = (kb >= klo) && (kb + 63 <= lhi);
        if (__any(l_any)) {
            f32x16 p0, p1;
            qkt(p0, p1, lds + buf * 32768, qr, r32, hi);
            const bool uni = __all(l_full || !l_any);
            const float off = (uni && !l_any) ? -1.0e30f : negBC;
#pragma unroll
            for (int r = 0; r < 16; ++r) p0[r] = __builtin_amdgcn_exp2f(fmaf(p0[r], SM_C, off));
            if (!uni) {
#pragma unroll
                for (int r = 0; r < 16; ++r) { const int k0i = kb + crow(r, hi); p0[r] = (k0i >= klo && k0i <= lhi) ? p0[r] : 0.f; } }
            float ps = 0.f;
#pragma unroll
            for (int r = 0; r < 16; ++r) ps += p0[r];
            bf16x8 pa0, pa1, pa2, pa3; pack_half(p0, pa0, pa1);
            pv_half<0, true>(o, vb0 + buf * 32768, pa0, pa1, p1, off);
            if (!uni) {
#pragma unroll
                for (int r = 0; r < 16; ++r) { const int k1i = kb + 32 + crow(r, hi); p1[r] = (k1i >= klo && k1i <= lhi) ? p1[r] : 0.f; } }
#pragma unroll
            for (int r = 0; r < 16; ++r) ps += p1[r];
            lsum += ps;
            pack_half(p1, pa2, pa3);
            pv_half<2, false>(o, vb0 + buf * 32768, pa2, pa3, p1, off);
        }
        if (MODE == MODE_SLC) { if (((j + 1) & 31) == 0 && j + 1 < j1) { bmw = a.BM[((size_t)tq * 4 + g) * 8 + ((j + 1) >> 5)]; asm volatile("s_waitcnt vmcnt(0)" : "+v"(bmw) :: "memory"); } }
    }
#undef ISSUE
    lsum += __shfl_xor(lsum, 32);
    const float grow = a.G[(size_t)tq * NGATE + hq * 3 + (MODE == MODE_CMP ? 0 : (MODE == MODE_SLC ? 1 : 2))];
    if (hi == 0) { li_l[r32] = lsum; li_l[32 + r32] = rvalid ? grow : 0.f; }
    if (MODE == MODE_CMP) { if (hi == 0) a.L[(size_t)tq * NH + hq] = lsum; }
    asm volatile("s_waitcnt lgkmcnt(0)" ::: "memory");
#pragma unroll
    for (int hf = 0; hf < 2; ++hf) {
        float gtv[8]; float pvv[8][4];
#pragma unroll
        for (int rr = 0; rr < 8; ++rr) { const int r = hf * 8 + rr;
            const int orow = crow(r, hi); const float lv = li_l[orow]; const float rl = lv > 0.f ? __builtin_amdgcn_rcpf(lv) : 0.f;
            const int t = MODE == MODE_SLC ? t0 + wid * 5 + orow / 6 : t0 + wid * 16 + (orow & 15);
            const int h = MODE == MODE_SLC ? g * HPG + orow % 6 : g * HPG + hp * 2 + (orow >> 4);
            const bool valid = !(MODE == MODE_SLC && (orow >= 30 || t >= S_)); const int tc = valid ? t : 0;
            gtv[rr] = li_l[32 + orow] * rl;
            if (MODE != MODE_CMP) { const float* oa = a.OACC + (size_t)tc * 3072 + h * HD + r32;
#pragma unroll
                for (int d0 = 0; d0 < 4; ++d0) pvv[rr][d0] = oa[d0 * 32]; }
        }
#pragma unroll
        for (int rr = 0; rr < 8; ++rr) { const int r = hf * 8 + rr;
            const int orow = crow(r, hi);
            const int t = MODE == MODE_SLC ? t0 + wid * 5 + orow / 6 : t0 + wid * 16 + (orow & 15);
            const int h = MODE == MODE_SLC ? g * HPG + orow % 6 : g * HPG + hp * 2 + (orow >> 4);
            if (MODE == MODE_SLC && (orow >= 30 || t >= S_)) continue;
            float* oa = a.OACC + (size_t)t * 3072 + h * HD + r32;
#pragma unroll
            for (int d0 = 0; d0 < 4; ++d0) {
                const float v = o[d0][r] * gtv[rr];
                if (MODE == MODE_CMP) oa[d0 * 32] = v;
                else if (MODE == MODE_WIN) oa[d0 * 32] = pvv[rr][d0] + v;
                else a.MIX[(size_t)t * DM + POOLW + h * HD + d0 * 32 + r32] = (bf16_t)(cvt_pk_bf16(pvv[rr][d0] + v, 0.f) & 0xffffu);
            }
        }
    }
}

__device__ __forceinline__ void imp_task(const AttnArgs& a, float* IMPP, float* IMPF, int tqi, int g) {
    const int lane = threadIdx.x & 63, fr = lane & 15, fq = lane >> 4;
    const int t = tqi * 16 + fr;
    const int tmax = tqi * 16 + 15;
    if (tmax < 31) return;
    const int lim = t >= 31 ? ((t - 31) >> 4) : -1;
    const int nstep = ((((tmax - 31) >> 4) >> 6) + 1) * 4;
    const float negBC = -a.TAB[512];
    bf16x8 qf[HPG][4]; float rl[HPG];
#pragma unroll
    for (int h = 0; h < HPG; ++h) {
        const bf16_t* qp = a.Z + (size_t)t * LDZ + OFF_Q + (g * HPG + h) * HD + fq * 8;
#pragma unroll
        for (int ks = 0; ks < 4; ++ks) qf[h][ks] = *reinterpret_cast<const bf16x8*>(qp + ks * 32);
        const float lv = a.L[(size_t)t * NH + g * HPG + h]; rl[h] = lv > 0.f ? 1.0f / lv : 0.f;
    }
    const bf16_t* kbase = a.KC + (size_t)g * 1024 * HD + (size_t)fr * HD + fq * 8;
    bf16x8 kf[4], kn[4];
#pragma unroll
    for (int ks = 0; ks < 4; ++ks) kf[ks] = *reinterpret_cast<const bf16x8*>(kbase + ks * 32);
    float* op = IMPP + ((size_t)t * 4 + g) * 256 + fq; float* of = IMPF + ((size_t)t * 4 + g) * 256 + fq;
    for (int st = 0; st < nstep; ++st) {
        const int sn = (st + 1 < nstep) ? st + 1 : st;
#pragma unroll
        for (int ks = 0; ks < 4; ++ks) kn[ks] = *reinterpret_cast<const bf16x8*>(kbase + (size_t)sn * 16 * HD + ks * 32);
        f32x4 imp4 = {0.f, 0.f, 0.f, 0.f};
        const int n0 = st * 16 + fq * 4;
#pragma unroll
        for (int h = 0; h < HPG; ++h) {
            f32x4 acc = {0.f, 0.f, 0.f, 0.f};
#pragma unroll
            for (int ks = 0; ks < 4; ++ks) acc = __builtin_amdgcn_mfma_f32_16x16x32_bf16(kf[ks], qf[h][ks], acc, 0, 0, 0);
#pragma unroll
            for (int i = 0; i < 4; ++i) { const float e = __builtin_amdgcn_exp2f(fmaf(acc[i], SM_C, negBC)) * rl[h]; imp4[i] += (n0 + i <= lim) ? e : 0.f; }
        }
        op[st * 4] = imp4[0] + 2.0f * (imp4[1] + imp4[2] + imp4[3]);
        of[st * 4] = imp4[0];
#pragma unroll
        for (int ks = 0; ks < 4; ++ks) kf[ks] = kn[ks];
    }
}

__device__ __forceinline__ void topk_load(const float* IMPP, const float* IMPF, int t, int g, f32x4& pp, f32x4& ff) {
    const int lane = threadIdx.x & 63, cur = t >> 6, jb = lane * 4;
    pp = (f32x4){0.f, 0.f, 0.f, 0.f}; ff = pp;
    if (cur > 15 && jb <= cur) { const size_t base = ((size_t)t * 4 + g) * 256; pp = *(const f32x4*)(IMPP + base + jb); ff = *(const f32x4*)(IMPF + base + jb); }
}
__device__ __forceinline__ void topk_task(const f32x4 pp, const f32x4 ff, unsigned* BM, int t, int g) {
    const int lane = threadIdx.x & 63;
    const int cur = t >> 6;
    unsigned nib = 0u;
    if (cur <= 15) { const int jb = lane * 4;
#pragma unroll
        for (int c = 0; c < 4; ++c) if (jb + c <= cur) nib |= 1u << c; }
    else {
        const int jb = lane * 4;
        unsigned key[4];
        {
            float fnext = __shfl_down(ff[0], 1);
            if (lane == 63) fnext = 0.f;
            const float v0 = pp[0] + ff[1], v1 = pp[1] + ff[2], v2 = pp[2] + ff[3], v3 = pp[3] + fnext;
            key[0] = (jb + 0 >= 1 && jb + 0 <= cur - 2) ? __float_as_uint(fmaxf(v0, 0.f)) + 1u : 0u;
            key[1] = (jb + 1 >= 1 && jb + 1 <= cur - 2) ? __float_as_uint(fmaxf(v1, 0.f)) + 1u : 0u;
            key[2] = (jb + 2 >= 1 && jb + 2 <= cur - 2) ? __float_as_uint(fmaxf(v2, 0.f)) + 1u : 0u;
            key[3] = (jb + 3 >= 1 && jb + 3 <= cur - 2) ? __float_as_uint(fmaxf(v3, 0.f)) + 1u : 0u;
        }
        unsigned prefix = 0u; bool exact = false;
        for (int b = 30; b >= 0; --b) {
            const unsigned trial = prefix | (1u << b);
            const int cnt = __popcll(__ballot(key[0] >= trial)) + __popcll(__ballot(key[1] >= trial)) + __popcll(__ballot(key[2] >= trial)) + __popcll(__ballot(key[3] >= trial));
            if (cnt >= 13) { prefix = trial; if (cnt == 13) { exact = true; break; } }
        }
#pragma unroll
        for (int c = 0; c < 4; ++c) if (exact ? (key[c] >= prefix) : (key[c] > prefix)) nib |= 1u << c;
        if (!exact) {
            int need = 13 - (__popcll(__ballot(key[0] > prefix)) + __popcll(__ballot(key[1] > prefix)) + __popcll(__ballot(key[2] > prefix)) + __popcll(__ballot(key[3] > prefix)));
            unsigned tie = 0u;
#pragma unroll
            for (int c = 0; c < 4; ++c) if (key[c] == prefix) tie |= 1u << c;
            for (int guard = 0; need > 0 && guard < 16; ++guard) {
                const unsigned long long any = __ballot(tie != 0u);
                if (any == 0ull) break;
                const int L = __builtin_ctzll(any);
                if (lane == L) { const unsigned low = tie & (0u - tie); nib |= low; tie ^= low; }
                --need;
            }
        }
        if (lane == 0) nib |= 1u;
        if (lane == (cur >> 2)) nib |= 1u << (cur & 3);
        if (lane == ((cur - 1) >> 2)) nib |= 1u << ((cur - 1) & 3);
    }
    unsigned x = nib << (4 * (lane & 7));
    x |= __shfl_xor(x, 1); x |= __shfl_xor(x, 2); x |= __shfl_xor(x, 4);
    if ((lane & 7) == 0) BM[((size_t)t * 4 + g) * 8 + (lane >> 3)] = x;
}
#undef KSWZ
}

template <bool FFN_REMAP = false>
__device__ __forceinline__ void convT(const float* __restrict__ src0, int K, int N, bf16_t* __restrict__ dst, int ldd, LAS float* tile, int bid, int nb, int Nfull = 0, int n0 = 0) {
    const float* __restrict__ src = src0 + n0; if (Nfull == 0) Nfull = N;
    const int tid = threadIdx.x, tk = K >> 6, tn = (N + 63) >> 6, total = tk * tn;
    const int r = tid >> 4, c4 = (tid & 15) * 4;
    f32x4 v[2] = {{0.f, 0.f, 0.f, 0.f}, {0.f, 0.f, 0.f, 0.f}}, vn[2];
    if (bid < total) { const int nti = bid % tn, kti = bid / tn, ng = nti * 64 + c4;
#pragma unroll
        for (int h = 0; h < 2; ++h) if (ng < N) v[h] = *(const f32x4*)(src + (size_t)(kti * 64 + r + h * 32) * Nfull + ng); }
    for (int idx = bid; idx < total; idx += nb) {
        const int nti = idx % tn, kti = idx / tn;
#pragma unroll
        for (int h = 0; h < 2; ++h) { LAS float* tp = tile + (r + h * 32) * 65 + c4; tp[0] = v[h][0]; tp[1] = v[h][1]; tp[2] = v[h][2]; tp[3] = v[h][3]; }
        {
            const int nx = idx + nb; vn[0] = (f32x4){0.f, 0.f, 0.f, 0.f}; vn[1] = vn[0];
            if (nx < total) { const int nti2 = nx % tn, kti2 = nx / tn, ng2 = nti2 * 64 + c4;
#pragma unroll
                for (int h = 0; h < 2; ++h) if (ng2 < N) vn[h] = *(const f32x4*)(src + (size_t)(kti2 * 64 + r + h * 32) * Nfull + ng2); } }
        __syncthreads();
        const int n = tid >> 3, k8 = (tid & 7) * 8, ngl = nti * 64 + n;
        float e[8];
#pragma unroll
        for (int i = 0; i < 8; ++i) e[i] = tile[(k8 + i) * 65 + n];
        if (ngl < N) { u32x4 w; w.x = cvt_pk_bf16(e[0], e[1]); w.y = cvt_pk_bf16(e[2], e[3]); w.z = cvt_pk_bf16(e[4], e[5]); w.w = cvt_pk_bf16(e[6], e[7]);
            int drow = ngl; if (FFN_REMAP) { const int up = ngl >= DFF ? 1 : 0, f = ngl - up * DFF; drow = (f >> 7) * 256 + up * 128 + (f & 127); }
            *(u32x4*)(dst + (size_t)drow * ldd + kti * 64 + k8) = w; }
        __syncthreads();
        v[0] = vn[0]; v[1] = vn[1];
    }
}
__device__ __forceinline__ void convT8(const float* __restrict__ src0, int K, int N, unsigned char* __restrict__ dst, int ldd, float scale, LAS float* tile, int bid, int nb, int Nfull = 0, int n0 = 0) {
    const float* __restrict__ src = src0 + n0; if (Nfull == 0) Nfull = N;
    const int tid = threadIdx.x, tk = K >> 6, tn = (N + 63) >> 6, total = tk * tn;
    const int r = tid >> 4, c4 = (tid & 15) * 4;
    f32x4 v[2] = {{0.f, 0.f, 0.f, 0.f}, {0.f, 0.f, 0.f, 0.f}}, vn[2];
    if (bid < total) { const int nti = bid % tn, kti = bid / tn, ng = nti * 64 + c4;
#pragma unroll
        for (int h = 0; h < 2; ++h) if (ng < N) v[h] = *(const f32x4*)(src + (size_t)(kti * 64 + r + h * 32) * Nfull + ng); }
    for (int idx = bid; idx < total; idx += nb) {
        const int nti = idx % tn, kti = idx / tn;
#pragma unroll
        for (int h = 0; h < 2; ++h) { LAS float* tp = tile + (r + h * 32) * 65 + c4; tp[0] = v[h][0]; tp[1] = v[h][1]; tp[2] = v[h][2]; tp[3] = v[h][3]; }
        { const int nx = idx + nb; vn[0] = (f32x4){0.f, 0.f, 0.f, 0.f}; vn[1] = vn[0];
            if (nx < total) { const int nti2 = nx % tn, kti2 = nx / tn, ng2 = nti2 * 64 + c4;
#pragma unroll
                for (int h = 0; h < 2; ++h) if (ng2 < N) vn[h] = *(const f32x4*)(src + (size_t)(kti2 * 64 + r + h * 32) * Nfull + ng2); } }
        __syncthreads();
        const int n = tid >> 3, k8 = (tid & 7) * 8, ngl = nti * 64 + n;
        float e[8];
#pragma unroll
        for (int i = 0; i < 8; ++i) e[i] = tile[(k8 + i) * 65 + n] * scale;
        if (ngl < N) { int p0 = __builtin_amdgcn_cvt_pk_fp8_f32(e[0], e[1], 0, false); p0 = __builtin_amdgcn_cvt_pk_fp8_f32(e[2], e[3], p0, true);
            int p1 = __builtin_amdgcn_cvt_pk_fp8_f32(e[4], e[5], 0, false); p1 = __builtin_amdgcn_cvt_pk_fp8_f32(e[6], e[7], p1, true);
            *(u32x2*)(dst + (size_t)ngl * ldd + kti * 64 + k8) = (u32x2){(unsigned)p0, (unsigned)p1}; }
        __syncthreads();
        v[0] = vn[0]; v[1] = vn[1];
    }
}
__device__ __forceinline__ void rmsnorm_rows(const float* __restrict__ src, const float* __restrict__ w, bf16_t* __restrict__ dst, int rows, int gw, int nw, unsigned char* __restrict__ dst8 = nullptr) {
    const int lane = threadIdx.x & 63;
    f32x4 v[16], vn[16];
    if (gw < rows) { const f32x4* sp = (const f32x4*)(src + (size_t)gw * DM);
#pragma unroll
        for (int i = 0; i < 16; ++i) v[i] = sp[lane + 64 * i]; }
    for (int row = gw; row < rows; row += nw) {
        const int nr = row + nw < rows ? row + nw : row;
        { const f32x4* sp = (const f32x4*)(src + (size_t)nr * DM);
#pragma unroll
          for (int i = 0; i < 16; ++i) vn[i] = sp[lane + 64 * i]; }
        float ss = 0.f;
#pragma unroll
        for (int i = 0; i < 16; ++i) ss += v[i][0] * v[i][0] + v[i][1] * v[i][1] + v[i][2] * v[i][2] + v[i][3] * v[i][3];
        ss = wave_sum(ss);
        const float rstd = rsqrtf(ss * (1.0f / DM) + EPS);
#pragma unroll
        for (int i = 0; i < 16; ++i) { const f32x4 ww = ((const f32x4*)w)[lane + 64 * i];
            u32x2 o; o.x = cvt_pk_bf16(v[i][0] * rstd * ww[0], v[i][1] * rstd * ww[1]); o.y = cvt_pk_bf16(v[i][2] * rstd * ww[2], v[i][3] * rstd * ww[3]);
            *(u32x2*)(dst + (size_t)row * DM + (lane + 64 * i) * 4) = o;
            if (dst8) { int pk = __builtin_amdgcn_cvt_pk_fp8_f32(v[i][0] * rstd * ww[0], v[i][1] * rstd * ww[1], 0, false); pk = __builtin_amdgcn_cvt_pk_fp8_f32(v[i][2] * rstd * ww[2], v[i][3] * rstd * ww[3], pk, true);
                *(int*)(dst8 + (size_t)row * DM + (lane + 64 * i) * 4) = pk; } }
#pragma unroll
        for (int i = 0; i < 16; ++i) v[i] = vn[i];
    }
}

struct Ptrs {
    bf16_t *Win, *Wo, *Wfi, *Wfo, *Wg, *Wple, *Wpool, *Wc1k, *Wc1v, *XN, *PB, *Z, *M, *KC, *VC, *MIX, *ACT, *ERAW;
    float *COS, *SIN, *TAB, *G, *H1, *L, *OACC, *IMPP, *IMPF, *ERSTD; unsigned* BM;
};

__device__ __forceinline__ void phase_prologue(const Params& P, const Ptrs& W, LAS unsigned char* lds) {
    const int bid = blockIdx.x, nb = gridDim.x, tid = threadIdx.x, lane = tid & 63, wv = tid >> 6;
    const int gw = bid * NWAVES + wv, nw = nb * NWAVES; const size_t gt = (size_t)bid * NTHREADS + tid, ntot = (size_t)nb * NTHREADS;
    LAS float* tile = (LAS float*)lds;
    rmsnorm_rows(P.x, P.norm1_w, W.XN, S_, gw, nw, P.ws + WS_XN8);
    convT(P.w_in, DM, POOLW, W.Win, DM, tile, bid, nb, INW, 0);
    convT(P.w_in, DM, INW - OFF_G, W.Win + (size_t)OFF_G * DM, DM, tile, bid, nb, INW, OFF_G);
    convT8(P.w_in, DM, OFF_G - POOLW, P.ws + WS_WIN8, DM, WG8_SCALE, tile, bid, nb, INW, POOLW);
    for (size_t i = gt; i < (size_t)(LDZ - INW) * DM / 8; i += ntot) *(u32x4*)(W.Win + (size_t)INW * DM + i * 8) = (u32x4){0u, 0u, 0u, 0u};
    convT(P.w_o, DM, DM, W.Wo, DM, tile, bid, nb);
    convT<true>(P.w_ffn_in, DM, NFI, W.Wfi, DM, tile, bid, nb);
    for (size_t i = gt; i < (size_t)2 * DM / 8; i += ntot) *(u32x4*)(W.XN - 2 * DM + i * 8) = (u32x4){0u, 0u, 0u, 0u};
    convT(P.w_ffn_out, DFF, DM, W.Wfo, DFF, tile, bid, nb);
    convT8(P.w_ple_gate, DM, DM, (unsigned char*)W.Wg, DM, WG8_SCALE, tile, bid, nb);
    convT(P.w_ple_proj, PLE, DM, W.Wple, PLE, tile, bid, nb);
    for (int g = 0; g < 4; ++g) convT(P.w_pool + (size_t)g * 65536, 256, 256, W.Wpool + (size_t)g * 65536, 256, tile, bid, nb);
    convT(P.cmp_k_w1, 4096, 256, W.Wc1k, 4096, tile, bid, nb);
    convT(P.cmp_v_w1, 4096, 256, W.Wc1v, 4096, tile, bid, nb);
    { constexpr size_t NP8 = (size_t)S_ * PLE / 8;
      for (size_t ib = gt; ib < NP8; ib += 4 * ntot) { f32x4 av[4], bv[4];
#pragma unroll
          for (int k = 0; k < 4; ++k) { size_t i = ib + k * ntot; if (i >= NP8) i = NP8 - 1; av[k] = *(const f32x4*)(P.p + i * 8); bv[k] = *(const f32x4*)(P.p + i * 8 + 4); }
#pragma unroll
          for (int k = 0; k < 4; ++k) { const size_t i = ib + k * ntot; if (i < NP8) { u32x4 w; w.x = cvt_pk_bf16(av[k][0], av[k][1]); w.y = cvt_pk_bf16(av[k][2], av[k][3]); w.z = cvt_pk_bf16(bv[k][0], bv[k][1]); w.w = cvt_pk_bf16(bv[k][2], bv[k][3]); *(u32x4*)(W.PB + i * 8) = w; } } } }
    for (size_t i = gt; i < (size_t)S_ * 16; i += ntot) { const int t = (int)(i >> 4), fi = (int)(i & 15);
        const float inv = exp2f(-(float)fi * (18.931568569324174f / 16.0f)); const float ang = (float)P.positions[t] * inv;
        const double ad = (double)ang; const double kk = rint(ad * 0.15915494309189535); const float rf = (float)(ad - kk * 6.283185307179586);
        W.COS[i] = __cosf(rf); W.SIN[i] = __sinf(rf); }
    for (int task = gw; task < 128; task += nw) { const int which = task >> 6, r0 = (task & 63) * 64; const float* pe = which ? P.cmp_pos_v : P.cmp_pos_k; const float* w1 = which ? P.cmp_v_w1 : P.cmp_k_w1;
        f32x4 s = {0.f, 0.f, 0.f, 0.f};
#pragma unroll 8
        for (int r = 0; r < 64; ++r) { const f32x4 wv = *(const f32x4*)(w1 + (size_t)(r0 + r) * 256 + lane * 4); s += wv * pe[r0 + r]; }
        float* cbp = (float*)(P.ws + WS_CBIAS) + which * 256 + lane * 4;
        unsafeAtomicAdd(cbp + 0, s[0]); unsafeAtomicAdd(cbp + 1, s[1]); unsafeAtomicAdd(cbp + 2, s[2]); unsafeAtomicAdd(cbp + 3, s[3]); }
    if (gw == 0) { float mq = fmaxf(fabsf(P.q_norm_w[lane]), fabsf(P.q_norm_w[lane + 64])); mq = wave_max(mq);
        float mc = wave_max(fmaxf(fabsf(P.k_norm_cmp_w[lane]), fabsf(P.k_norm_cmp_w[lane + 64])));
        float ms = wave_max(fmaxf(fabsf(P.k_norm_slc_w[lane]), fabsf(P.k_norm_slc_w[lane + 64])));
        float mw = wave_max(fmaxf(fabsf(P.k_norm_win_w[lane]), fabsf(P.k_norm_win_w[lane + 64])));
        const float c = 11.313708498984761f * 1.4426950408889634f * mq * 1.01f;
        if (lane == 0) { W.TAB[512] = c * mc; W.TAB[513] = c * ms; W.TAB[514] = c * mw; } }
}

__device__ __forceinline__ void phase_postz(const Params& P, const Ptrs& W, int gw, int nw) {
    const int tid = threadIdx.x, lane = tid & 63;
    const f32x2 wq = *(const f32x2*)(P.q_norm_w + 2 * lane), wks = *(const f32x2*)(P.k_norm_slc_w + 2 * lane), wkw = *(const f32x2*)(P.k_norm_win_w + 2 * lane);
    for (int t = gw; t < S_; t += nw) {
        bf16_t* zr = W.Z + (size_t)t * LDZ;
        float cs0 = 0.f, cs1 = 0.f, sn0 = 0.f, sn1 = 0.f;
        if (lane < 16) { const int i0 = (2 * lane) & 15; cs0 = W.COS[t * 16 + i0]; cs1 = W.COS[t * 16 + i0 + 1]; sn0 = W.SIN[t * 16 + i0]; sn1 = W.SIN[t * 16 + i0 + 1]; }
        unsigned uv[32];
#pragma unroll
        for (int v = 0; v < 32; ++v) { const int col = v < 24 ? OFF_Q + v * HD : (v < 28 ? OFF_KV + 2 * 512 + (v - 24) * HD : OFF_KV + 4 * 512 + (v - 28) * HD);
            uv[v] = *((const unsigned*)(zr + col) + lane); }
#pragma unroll
        for (int v = 0; v < 32; ++v) {
            const f32x2 ww = v < 24 ? wq : (v < 28 ? wks : wkw);
            const unsigned u = uv[v]; const float x0 = bf_lo(u), x1 = bf_hi(u);
            const float ss = wave_sum(x0 * x0 + x1 * x1);
            const float rstd = rsqrtf(ss * (1.0f / HD) + EPS);
            float y0 = x0 * rstd * ww[0], y1 = x1 * rstd * ww[1];
            const float p0 = __shfl_xor(y0, 8), p1 = __shfl_xor(y1, 8);
            if (lane < 8) { y0 = y0 * cs0 - p0 * sn0; y1 = y1 * cs1 - p1 * sn1; }
            else if (lane < 16) { y0 = y0 * cs0 + p0 * sn0; y1 = y1 * cs1 + p1 * sn1; }
            uv[v] = cvt_pk_bf16(y0, y1);
        }
        {
            const int gi = lane >> 4, wlen = 2 << gi, c0 = lane * 16; const int cnt = (t + 1) < wlen ? (t + 1) : wlen;
            float s[16];
#pragma unroll
            for (int i = 0; i < 16; ++i) s[i] = 0.f;
            float cur[16];
#pragma unroll
            for (int bt = 0; bt < 2; ++bt) {
                u32x4 ra[8], rb[8];
#pragma unroll
                for (int i = 0; i < 8; ++i) { const int ii = bt * 8 + i; const size_t row = (size_t)(ii < cnt ? t - ii : t);
                    ra[i] = *(const u32x4*)(W.Z + row * LDZ + c0); rb[i] = *(const u32x4*)(W.Z + row * LDZ + c0 + 8); }
#pragma unroll
                for (int i = 0; i < 8; ++i) { const int ii = bt * 8 + i; const float mk = ii < cnt ? 1.0f : 0.0f; const u32x4 a = ra[i], b = rb[i];
                    const float ev[16] = {bf_lo(a.x), bf_hi(a.x), bf_lo(a.y), bf_hi(a.y), bf_lo(a.z), bf_hi(a.z), bf_lo(a.w), bf_hi(a.w), bf_lo(b.x), bf_hi(b.x), bf_lo(b.y), bf_hi(b.y), bf_lo(b.z), bf_hi(b.z), bf_lo(b.w), bf_hi(b.w)};
#pragma unroll
                    for (int q = 0; q < 16; ++q) { s[q] += ev[q] * mk; if (ii == 0) cur[q] = ev[q]; } }
                if (bt == 0 && __all(cnt <= 8)) break;
            }
            const float rc = 1.0f / (float)cnt;
            u32x4 o0, o1;
            o0.x = cvt_pk_bf16(s[0] * rc - cur[0], s[1] * rc - cur[1]); o0.y = cvt_pk_bf16(s[2] * rc - cur[2], s[3] * rc - cur[3]);
            o0.z = cvt_pk_bf16(s[4] * rc - cur[4], s[5] * rc - cur[5]); o0.w = cvt_pk_bf16(s[6] * rc - cur[6], s[7] * rc - cur[7]);
            o1.x = cvt_pk_bf16(s[8] * rc - cur[8], s[9] * rc - cur[9]); o1.y = cvt_pk_bf16(s[10] * rc - cur[10], s[11] * rc - cur[11]);
            o1.z = cvt_pk_bf16(s[12] * rc - cur[12], s[13] * rc - cur[13]); o1.w = cvt_pk_bf16(s[14] * rc - cur[14], s[15] * rc - cur[15]);
            *(u32x4*)(W.M + (size_t)t * POOLW + c0) = o0; *(u32x4*)(W.M + (size_t)t * POOLW + c0 + 8) = o1;
        }
#pragma unroll
        for (int v = 0; v < 32; ++v) { const int col = v < 24 ? OFF_Q + v * HD : (v < 28 ? OFF_KV + 2 * 512 + (v - 24) * HD : OFF_KV + 4 * 512 + (v - 28) * HD);
            *((unsigned*)(zr + col) + lane) = uv[v]; }

    }
}

__device__ __forceinline__ void phase_cmpfin(const Params& P, const Ptrs& W) {
    const int tid = threadIdx.x, lane = tid & 63, gw = blockIdx.x * NWAVES + (tid >> 6), nw = gridDim.x * NWAVES;
    const f32x2 wk = *(const f32x2*)(P.k_norm_cmp_w + 2 * lane);
    for (int task = gw; task < 8192; task += nw) {
        const int tk = __builtin_amdgcn_readfirstlane(task);
        const int which = tk >> 12, g = (tk >> 10) & 3, n = tk & 1023;
        bf16_t* dst = (which ? W.VC : W.KC) + ((size_t)g * 1024 + n) * HD;
        if (n == 1023) { ((unsigned*)dst)[lane] = 0u; continue; }
        const float* h = W.H1 + (size_t)tk * 256; const float* w2 = which ? P.cmp_v_w2 : P.cmp_k_w2;
        float a0 = 0.f, a1 = 0.f;
        for (int j = 0; j < 256; ++j) { const float hj = h[j]; const f32x2 wv = *(const f32x2*)(w2 + j * HD + 2 * lane); a0 += hj * wv[0]; a1 += hj * wv[1]; }
        if (which == 0) {
            const float ss = wave_sum(a0 * a0 + a1 * a1); const float rstd = rsqrtf(ss * (1.0f / HD) + EPS);
            a0 = a0 * rstd * wk[0]; a1 = a1 * rstd * wk[1];
            const int tp = 16 * n + 31; const float p0 = __shfl_xor(a0, 8), p1 = __shfl_xor(a1, 8);
            if (lane < 16) { const int i0 = (2 * lane) & 15; const float cs0 = W.COS[tp * 16 + i0], cs1 = W.COS[tp * 16 + i0 + 1], sn0 = W.SIN[tp * 16 + i0], sn1 = W.SIN[tp * 16 + i0 + 1];
                if (lane < 8) { a0 = a0 * cs0 - p0 * sn0; a1 = a1 * cs1 - p1 * sn1; } else { a0 = a0 * cs0 + p0 * sn0; a1 = a1 * cs1 + p1 * sn1; } }
        }
        ((unsigned*)dst)[lane] = cvt_pk_bf16(a0, a1);
    }
}

__device__ __forceinline__ void phase_erstd(const Ptrs& W) {
    const int tid = threadIdx.x, lane = tid & 63, gw = blockIdx.x * NWAVES + (tid >> 6), nw = gridDim.x * NWAVES;
    u32x4 a[8], an[8];
    if (gw < S_) { const u32x4* sp = (const u32x4*)(W.ERAW + (size_t)gw * DM);
#pragma unroll
        for (int i = 0; i < 8; ++i) a[i] = sp[lane + 64 * i]; }
    for (int row = gw; row < S_; row += nw) {
        const int nr = row + nw < S_ ? row + nw : row;
        { const u32x4* sp = (const u32x4*)(W.ERAW + (size_t)nr * DM);
#pragma unroll
          for (int i = 0; i < 8; ++i) an[i] = sp[lane + 64 * i]; }
        float ss = 0.f;
#pragma unroll
        for (int i = 0; i < 8; ++i) {
            const float e0 = bf_lo(a[i].x), e1 = bf_hi(a[i].x), e2 = bf_lo(a[i].y), e3 = bf_hi(a[i].y), e4 = bf_lo(a[i].z), e5 = bf_hi(a[i].z), e6 = bf_lo(a[i].w), e7 = bf_hi(a[i].w);
            ss += e0 * e0 + e1 * e1 + e2 * e2 + e3 * e3 + e4 * e4 + e5 * e5 + e6 * e6 + e7 * e7; }
        ss = wave_sum(ss);
        if (lane == 0) W.ERSTD[row] = rsqrtf(ss * (1.0f / DM) + EPS);
#pragma unroll
        for (int i = 0; i < 8; ++i) a[i] = an[i];
    }
}

constexpr int N_PHASES = 11;
__device__ __forceinline__ Params kargs() {
#if defined(__HIP_DEVICE_COMPILE__)
    unsigned long long p = (unsigned long long)__builtin_amdgcn_kernarg_segment_ptr();
    asm volatile("" : "+s"(p));
    return *(const __attribute__((address_space(4))) Params*)p;
#else
    return Params{};
#endif
}
__device__ __forceinline__ Ptrs mkptrs(unsigned char* ws) {
    Ptrs W;
    W.Win = (bf16_t*)(ws + WS_WIN); W.Wo = (bf16_t*)(ws + WS_WO); W.Wfi = (bf16_t*)(ws + WS_WFI); W.Wfo = (bf16_t*)(ws + WS_WFO); W.Wg = (bf16_t*)(ws + WS_WG);
    W.Wple = (bf16_t*)(ws + WS_WPLE); W.Wpool = (bf16_t*)(ws + WS_WPOOL); W.Wc1k = (bf16_t*)(ws + WS_WC1K); W.Wc1v = (bf16_t*)(ws + WS_WC1V);
    W.XN = (bf16_t*)(ws + WS_XN); W.PB = (bf16_t*)(ws + WS_PB); W.Z = (bf16_t*)(ws + WS_Z); W.M = (bf16_t*)(ws + WS_M); W.KC = (bf16_t*)(ws + WS_KC); W.VC = (bf16_t*)(ws + WS_VC);
    W.MIX = (bf16_t*)(ws + WS_MIX); W.ACT = (bf16_t*)(ws + WS_ACT); W.ERAW = (bf16_t*)(ws + WS_ERAW);
    W.COS = (float*)(ws + WS_COS); W.SIN = (float*)(ws + WS_SIN); W.TAB = (float*)(ws + WS_TAB); W.G = (float*)(ws + WS_G); W.H1 = (float*)(ws + WS_H1); W.L = (float*)(ws + WS_L);
    W.OACC = (float*)(ws + WS_OACC); W.IMPP = (float*)(ws + WS_IMPP); W.IMPF = (float*)(ws + WS_IMPF); W.ERSTD = (float*)(ws + WS_ERSTD); W.BM = (unsigned*)(ws + WS_BM);
    return W;
}
__global__ void __launch_bounds__(NTHREADS, 2) fwd(Params Punused) {
    extern __shared__ __attribute__((aligned(16))) unsigned char lds_raw[];
    LAS unsigned char* lds = (LAS unsigned char*)lds_raw;
    const int tid = threadIdx.x;
    const int G = gridDim.x, bid = blockIdx.x;
    const int gw = bid * NWAVES + (tid >> 6), nw = G * NWAVES;

    if (tid < 16) ((LAS unsigned*)(lds + LDS_MISC))[tid] = 0u;
    __syncthreads();
    int lo, hi; XcdBarrier bar;
    { const Params P = kargs(); lo = P.ph_lo; hi = P.ph_hi;
      bar.bar = (unsigned*)(P.ws + WS_CTL); bar.x = 0; bar.st = (volatile LAS unsigned*)(lds + LDS_MISC);
      if (hi - lo > 1) bar = xcd_barrier_post((unsigned*)(P.ws + WS_CTL), (volatile LAS unsigned*)(lds + LDS_MISC)); }
#ifdef PH_MASK
#define IN(k) (((PH_MASK >> (k)) & 1) && lo <= (k) && (k) < hi)
#else
#define IN(k) (lo <= (k) && (k) < hi)
#endif
#define SEAM(k) do { if (IN(k) && IN((k) + 1)) xcd_barrier(bar); } while (0)
#define PHASE_VARS const Params P = kargs(); const Ptrs W = mkptrs(P.ws); (void)W;
#define ATT_ARGS att::AttnArgs AA{W.Z, W.KC, W.VC, W.G, W.L, W.OACC, W.MIX, W.BM, W.TAB};

    if (IN(0)) { PHASE_VARS REP(0) { phase_prologue(P, W, lds); } SEAM(0); }
    if (IN(1)) {
        PHASE_VARS
        { pg8::GStd g{(const char*)W.XN, (const char*)W.Win, DM, DM, DM / 64}; pg8::StaticOrder S; S.init(S_ / 256, POOLW / 256, G, bid);
          pg8::EpiBf16 E{W.Z, LDZ}; pg8::gemm_phase(lds, g, S, E); }
        { pg8::GStd g{(const char*)(P.ws + WS_XN8), (const char*)(P.ws + WS_WIN8), DM / 2, DM / 2, DM / 128}; pg8::StaticOrder S; S.init(S_ / 256, (OFF_G - POOLW) / 256, G, bid);
          pg8::EpiBf16S E{W.Z + POOLW, LDZ, 1.0f / WG8_SCALE}; pg8::gemm_phase<pg8::GStd, pg8::EpiBf16S, true>(lds, g, S, E); }
        SEAM(1);
    }
    if (IN(2)) {
        PHASE_VARS
        if (G > 64) {
            if (bid < 32) { pg8::GCmp g{(const char*)W.Z, (const char*)W.Wc1k, (const char*)W.Wc1v, 16 * LDZ, 4096, 64}; pg8::StaticOrder S; S.init(32, 1, 32, bid);
                pg8::EpiCmpGelu E{W.H1, (const float*)(P.ws + WS_CBIAS)}; pg8::gemm_phase(lds, g, S, E); }
            else if (bid < 96) {
                pg8::GStd g{(const char*)W.XN, (const char*)(W.Win + (size_t)OFF_G * DM), DM, DM, DM / 64}; pg8::StaticOrder S; S.init(S_ / 256, 1, 64, bid - 32);
                pg8::EpiBf16 E{W.Z + OFF_G, LDZ}; pg8::gemm_phase(lds, g, S, E); }
            else phase_postz(P, W, (bid - 96) * NWAVES + (tid >> 6), (G - 96) * NWAVES);
        } else {
            { pg8::GStd g{(const char*)W.XN, (const char*)(W.Win + (size_t)OFF_G * DM), DM, DM, DM / 64}; pg8::StaticOrder S; S.init(S_ / 256, 1, G, bid);
              pg8::EpiBf16 E{W.Z + OFF_G, LDZ}; pg8::gemm_phase(lds, g, S, E); }
            { pg8::GCmp g{(const char*)W.Z, (const char*)W.Wc1k, (const char*)W.Wc1v, 16 * LDZ, 4096, 64}; pg8::StaticOrder S; S.init(32, 1, G, bid);
              pg8::EpiCmpGelu E{W.H1, (const float*)(P.ws + WS_CBIAS)}; pg8::gemm_phase(lds, g, S, E); }
            phase_postz(P, W, gw, nw);
        }
        SEAM(2);
    }
    if (IN(3)) {
        PHASE_VARS
        {
            const size_t i0 = (size_t)bid * NTHREADS + tid, st = (size_t)G * NTHREADS, NG = (size_t)S_ * NGATE;
            for (size_t ib = i0; ib < NG; ib += 9 * st) { float zv[9];
#pragma unroll
                for (int k = 0; k < 9; ++k) { size_t i = ib + k * st; if (i >= NG) i = NG - 1; const int t = (int)(i / NGATE), c = (int)(i % NGATE); zv[k] = bf2f(W.Z[(size_t)t * LDZ + OFF_G + c]); }
#pragma unroll
                for (int k = 0; k < 9; ++k) { const size_t i = ib + k * st; if (i < NG) W.G[i] = sigmoidf_(zv[k]); } } }
        phase_cmpfin(P, W);
        { pg8::GPool g{(const char*)W.M, (const char*)W.Wpool, POOLW, 256, 4}; pg8::StaticOrder S; S.init(S_ / 256, 4, G, bid);
          pg8::EpiBf16Scale E{W.MIX, DM, P.pool_scale}; pg8::gemm_phase(lds, g, S, E); }
        SEAM(3);
    }
    if (IN(4)) {
        PHASE_VARS ATT_ARGS
        REP(4)
        for (int base = 0, rnd = 0; base < 1536; base += G, ++rnd) {
            int qt, g, hp;
            if (G == 256) { const int x = bid & 7, r = bid >> 3, qp = (rnd / 3) ? 63 - r : r; if (rnd >= 6) break; g = x & 3; qt = 2 * qp + (x >> 2); hp = rnd % 3; }
            else { const int Lu = base + ((rnd & 1) ? G - 1 - bid : bid); if (Lu >= 1536) continue; qt = Lu / 12; const int rem = Lu % 12; g = rem / 3; hp = rem % 3; }
            att::attn_unit<att::MODE_CMP>(AA, (LAS char*)lds, qt, g, hp);
            asm volatile("s_waitcnt vmcnt(0)" ::: "memory");
            att::attn_unit<att::MODE_WIN>(AA, (LAS char*)lds, qt, g, hp);
            if (G == 256 && hp == 2) {
                asm volatile("s_waitcnt vmcnt(0)" ::: "memory");
                const int tqi = qt * 8 + (tid >> 6);
                att::imp_task(AA, W.IMPP, W.IMPF, tqi, g);
                asm volatile("s_waitcnt vmcnt(0)" ::: "memory");
                f32x4 pp, ff, pn, fn; att::topk_load(W.IMPP, W.IMPF, tqi * 16, g, pp, ff);
                for (int q = 0; q < 16; ++q) { att::topk_load(W.IMPP, W.IMPF, tqi * 16 + (q < 15 ? q + 1 : q), g, pn, fn); att::topk_task(pp, ff, W.BM, tqi * 16 + q, g); pp = pn; ff = fn; } } }
        if (G != 256) SEAM(4);
    }
    if (IN(5)) {
        PHASE_VARS ATT_ARGS
        if (G != 256)
        for (int k = gw, r = 0; k < 4096; k += nw, ++r) { const int hiT = (r + 1) * nw < 4096 ? (r + 1) * nw : 4096;
            const int task = (r & 1) ? hiT - 1 - (k - r * nw) : k;
            att::imp_task(AA, W.IMPP, W.IMPF, task >> 2, task & 3);
            asm volatile("s_waitcnt vmcnt(0)" ::: "memory");
            { const int tb = (task >> 2) * 16, gg = task & 3; f32x4 pp, ff, pn, fn;
              att::topk_load(W.IMPP, W.IMPF, tb, gg, pp, ff);
              for (int q = 0; q < 16; ++q) { att::topk_load(W.IMPP, W.IMPF, tb + (q < 15 ? q + 1 : q), gg, pn, fn); att::topk_task(pp, ff, W.BM, tb + q, gg); pp = pn; ff = fn; } } }
        SEAM(5);
    }
    if (IN(6)) {
        PHASE_VARS ATT_ARGS
        REP(6)
        for (int base = 0, rnd = 0; base < 1640 + G; base += G, ++rnd) {
            int ut, g;
            if (G == 256) { const int x = bid & 7, r = bid >> 3, k = rnd * 32 + ((rnd & 1) ? 31 - r : r); if (k >= 205) break; g = x & 3; ut = 409 - (2 * k + (x >> 2)); }
            else { const int Lu = base + ((rnd & 1) ? G - 1 - bid : bid); if (Lu >= 1640) continue; ut = 409 - Lu / 4; g = Lu % 4; }
            att::attn_unit<att::MODE_SLC>(AA, (LAS char*)lds, ut, g, 0); }
        SEAM(6);
    }
    if (IN(7)) {
        PHASE_VARS
        { pg8::GStd g{(const char*)W.MIX, (const char*)W.Wo, DM, DM, DM / 64}; pg8::StaticOrder S; S.init(S_ / 256, DM / 256, G, bid);
          pg8::EpiResNorm E{P.x, P.out, W.XN, P.norm2_w, (float*)(P.ws + WS_SSQ1), DM}; pg8::gemm_phase(lds, g, S, E); }
        { pg8::GStd g{(const char*)W.PB, (const char*)W.Wple, PLE, PLE, PLE / 64}; pg8::StaticOrder S; S.init(S_ / 256, DM / 256, G, bid);
          pg8::EpiBf16Ssq E{W.ERAW, DM, (float*)(P.ws + WS_SSQ3)}; pg8::gemm_phase(lds, g, S, E); }
        SEAM(7);
    }
    if (IN(8)) {
        PHASE_VARS
        pg8::GFfn g{(const char*)W.XN, (const char*)W.Wfi, DM, DM, DM / 64}; pg8::StaticOrder S; S.init(65, DFF / 128, G, bid);
        pg8::EpiFfn E{W.ACT, P.conv_w, P.conv_b, (LAS float*)(lds + LDS_XCH), (const float*)(P.ws + WS_SSQ1)}; REP(8) { pg8::gemm_phase(lds, g, S, E); } SEAM(8);
    }
    if (IN(9)) {
        PHASE_VARS
        pg8::GStd g{(const char*)W.ACT, (const char*)W.Wfo, DFF, DFF, DFF / 64}; pg8::StaticOrder S; S.init(S_ / 256, DM / 256, G, bid);
        pg8::EpiResNormF8 E{P.out, P.out, W.XN, P.ple_gate_norm_w, (float*)(P.ws + WS_SSQ2), DM}; pg8::gemm_phase(lds, g, S, E); SEAM(9);
    }
    if (IN(10)) {
        PHASE_VARS
        pg8::GStd g{(const char*)W.XN, (const char*)W.Wg, DM / 2, DM / 2, DM / 128}; pg8::StaticOrder S; S.init(S_ / 256, DM / 256, G, bid);
        pg8::EpiGate E{P.out, W.ERAW, (const float*)(P.ws + WS_SSQ3), P.ple_norm_w, (const float*)(P.ws + WS_SSQ2), DM, 1.0f / WG8_SCALE};
        pg8::gemm_phase<pg8::GStd, pg8::EpiGate, true>(lds, g, S, E);
    }
#undef IN
#undef SEAM
}

extern "C" void kernel_launch(void* const* d_in, const int* in_sizes, int n_in, void* d_out, int out_size, void* d_ws, size_t ws_size, hipStream_t stream) {
    static int grid = 0;
    if (grid == 0) {
        if (n_in != 27 || in_sizes[0] != S_ * DM || out_size != S_ * DM || ws_size < WS_NEED) {
            fprintf(stderr, "kernel_launch: unexpected shapes (n_in %d, in0 %d, out %d, ws %zu < %zu); nothing launched\n", n_in, n_in > 0 ? in_sizes[0] : -1, out_size, ws_size, (size_t)WS_NEED); grid = -1; return; }
        int dev = 0, cus = 0, per_cu = 0;
        if (hipGetDevice(&dev) != hipSuccess || hipDeviceGetAttribute(&cus, hipDeviceAttributeMultiprocessorCount, dev) != hipSuccess) { grid = -1; return; }
        if (hipFuncSetAttribute((const void*)fwd, hipFuncAttributeMaxDynamicSharedMemorySize, LDS_BYTES) != hipSuccess) { fprintf(stderr, "kernel_launch: hipFuncSetAttribute failed\n"); grid = -1; return; }
        if (hipOccupancyMaxActiveBlocksPerMultiprocessor(&per_cu, (const void*)fwd, NTHREADS, LDS_BYTES) != hipSuccess || per_cu < 1) { fprintf(stderr, "kernel_launch: occupancy query says %d\n", per_cu); (void)hipGetLastError(); }
        grid = cus > 256 ? 256 : cus;
    }
    if (grid < 0) return;
    (void)hipMemsetAsync((char*)d_ws + WS_CTL, 0, CTL_BYTES, stream);
    Params P{};
    const float** fp = (const float**)&P;
    P.x = (const float*)d_in[0]; P.p = (const float*)d_in[1]; P.positions = (const int*)d_in[2]; P.norm1_w = (const float*)d_in[3]; P.w_in = (const float*)d_in[4];
    P.w_pool = (const float*)d_in[5]; P.pool_scale = (const float*)d_in[6]; P.q_norm_w = (const float*)d_in[7]; P.k_norm_cmp_w = (const float*)d_in[8];
    P.k_norm_slc_w = (const float*)d_in[9]; P.k_norm_win_w = (const float*)d_in[10]; P.cmp_pos_k = (const float*)d_in[11]; P.cmp_pos_v = (const float*)d_in[12];
    P.cmp_k_w1 = (const float*)d_in[13]; P.cmp_k_w2 = (const float*)d_in[14]; P.cmp_v_w1 = (const float*)d_in[15]; P.cmp_v_w2 = (const float*)d_in[16];
    P.w_o = (const float*)d_in[17]; P.norm2_w = (const float*)d_in[18]; P.w_ffn_in = (const float*)d_in[19]; P.conv_w = (const float*)d_in[20]; P.conv_b = (const float*)d_in[21];
    P.w_ffn_out = (const float*)d_in[22]; P.w_ple_proj = (const float*)d_in[23]; P.ple_norm_w = (const float*)d_in[24]; P.ple_gate_norm_w = (const float*)d_in[25]; P.w_ple_gate = (const float*)d_in[26];
    (void)fp;
    P.out = (float*)d_out; P.ws = (unsigned char*)d_ws;
#if MK_ONE_LAUNCH
    P.ph_lo = 0; P.ph_hi = N_PHASES;
    hipLaunchKernelGGL(fwd, dim3(grid), dim3(NTHREADS), LDS_BYTES, stream, P);
#else
    for (int ph = 0; ph < N_PHASES; ++ph) { P.ph_lo = ph; P.ph_hi = ph + 1; hipLaunchKernelGGL(fwd, dim3(grid), dim3(NTHREADS), LDS_BYTES, stream, P); }
#endif
    const hipError_t le = hipPeekAtLastError();
    if (le != hipSuccess) fprintf(stderr, "kernel_launch: launch failed: %s\n", hipGetErrorName(le));
}
```

```cpp
#include <hip/hip_runtime.h>
#include <cstdio>
#include <cstdint>

#ifndef PROBE_DBL
#define PROBE_DBL 0
#endif
#define REP(k) _Pragma("unroll") for (int rep_ = 0; rep_ < 1 + ((PROBE_DBL >> (k)) & 1); ++rep_)
#ifndef MK_ONE_LAUNCH
#define MK_ONE_LAUNCH 1
#endif

#define LAS __attribute__((address_space(3)))
typedef unsigned short bf16_t;
typedef short bf16x8 __attribute__((ext_vector_type(8)));
typedef short s16x4 __attribute__((ext_vector_type(4)));
typedef float f32x2 __attribute__((ext_vector_type(2)));
typedef float f32x4 __attribute__((ext_vector_type(4)));
typedef float f32x16 __attribute__((ext_vector_type(16)));
typedef unsigned u32x2 __attribute__((ext_vector_type(2)));
typedef unsigned u32x4 __attribute__((ext_vector_type(4)));
typedef int i32x4 __attribute__((ext_vector_type(4)));
typedef int i32x8 __attribute__((ext_vector_type(8)));

constexpr int S_ = 16384, DM = 4096, INW = 7240, LDZ = 7424, POOLW = 1024, NH = 24, NKV = 4, HPG = 6, HD = 128;
constexpr int OFF_Q = 1024, OFF_KV = 4096, OFF_G = 7168, DFF = 11008, NFI = 22016, PLE = 256, NGATE = 72;
constexpr int ZROWS = S_ + 64, XNROWS = S_ + 256, CHUNK = 8192;
constexpr float EPS = 1e-6f;
constexpr float SM_C = 0.08838834764831845f * 1.4426950408889634f;
constexpr int NWAVES = 8, NTHREADS = 512;
constexpr float WG8_SCALE = 128.0f;

constexpr size_t al256(size_t x) { return (x + 255) / 256 * 256; }
constexpr size_t WS_CTL   = 0;
constexpr size_t CTL_BYTES = 262144;
constexpr size_t WS_CBIAS = WS_CTL + 32768;
constexpr size_t WS_SSQ1 = WS_CTL + 65536, WS_SSQ2 = WS_CTL + 131072, WS_SSQ3 = WS_CTL + 196608;
constexpr size_t WS_WIN   = WS_CTL + CTL_BYTES;
constexpr size_t WS_WO    = WS_WIN + al256((size_t)LDZ * DM * 2);
constexpr size_t WS_WFI   = WS_WO + al256((size_t)DM * DM * 2);
constexpr size_t WS_WFO   = WS_WFI + al256((size_t)NFI * DM * 2);
constexpr size_t WS_WG    = WS_WFO + al256((size_t)DM * DFF * 2);
constexpr size_t WS_WPLE  = WS_WG + al256((size_t)DM * DM * 2);
constexpr size_t WS_WPOOL = WS_WPLE + al256((size_t)DM * PLE * 2);
constexpr size_t WS_WC1K  = WS_WPOOL + al256((size_t)1024 * 256 * 2);
constexpr size_t WS_WC1V  = WS_WC1K + al256((size_t)256 * 4096 * 2);
constexpr size_t WS_COS   = WS_WC1V + al256((size_t)256 * 4096 * 2);
constexpr size_t WS_SIN   = WS_COS + al256((size_t)S_ * 16 * 4);
constexpr size_t WS_TAB   = WS_SIN + al256((size_t)S_ * 16 * 4);
constexpr size_t WS_XNP   = WS_TAB + 4096;
constexpr size_t WS_XN    = WS_XNP + (size_t)2 * DM * 2;
constexpr size_t WS_PB    = WS_XN + al256((size_t)XNROWS * DM * 2);
constexpr size_t WS_XN8   = WS_PB + al256((size_t)S_ * PLE * 2);
constexpr size_t WS_WIN8  = WS_XN8 + al256((size_t)S_ * DM);
constexpr size_t WS_R     = WS_WIN8 + al256((size_t)(OFF_G - POOLW) * DM);
constexpr size_t WS_Z     = WS_R;
constexpr size_t WS_M     = WS_Z + al256((size_t)ZROWS * LDZ * 2);
constexpr size_t WS_G     = WS_M + al256((size_t)S_ * POOLW * 2);
constexpr size_t WS_H1    = WS_G + al256((size_t)S_ * NGATE * 4);
constexpr size_t WS_KC    = WS_H1 + al256((size_t)8192 * 256 * 4);
constexpr size_t WS_VC    = WS_KC + al256((size_t)4 * 1024 * 128 * 2);
constexpr size_t WS_L     = WS_VC + al256((size_t)4 * 1024 * 128 * 2);
constexpr size_t WS_OACC  = WS_L + al256((size_t)S_ * NH * 4);
constexpr size_t WS_IMPP  = WS_OACC + al256((size_t)S_ * 3072 * 4);
constexpr size_t WS_IMPF  = WS_IMPP + al256((size_t)S_ * 4 * 256 * 4);
constexpr size_t WS_BM    = WS_IMPF + al256((size_t)S_ * 4 * 256 * 4);
constexpr size_t WS_MIX   = WS_BM + al256((size_t)S_ * 4 * 8 * 4);
constexpr size_t WS_END_A = WS_MIX + al256((size_t)S_ * DM * 2);
constexpr size_t WS_ERAW  = WS_R;
constexpr size_t WS_ACT   = WS_ERAW + al256((size_t)S_ * DM * 2);
constexpr size_t WS_ERSTD = WS_ACT + al256((size_t)S_ * DFF * 2);
constexpr size_t WS_END_B = WS_ERSTD + al256((size_t)S_ * 4);
static_assert(WS_ERAW + (size_t)S_ * DM * 2 <= WS_Z + (size_t)ZROWS * LDZ * 2, "eraw must fit inside the dead z region while mix is still being read");
constexpr size_t WS_NEED  = WS_END_A > WS_END_B ? WS_END_A : WS_END_B;
static_assert(WS_NEED <= (size_t)1440000000, "workspace map exceeds the guaranteed 4 x largest-tensor bytes");

constexpr int LDS_STAGE = 131072;
constexpr int LDS_MISC  = LDS_STAGE;
constexpr int LDS_XCH   = LDS_STAGE + 64;
constexpr int LDS_BYTES = LDS_XCH + 4096;

__device__ __forceinline__ unsigned cvt_pk_bf16(float lo, float hi) { unsigned r; asm volatile("v_cvt_pk_bf16_f32 %0, %1, %2" : "=v"(r) : "v"(lo), "v"(hi)); return r; }
__device__ __forceinline__ float bf_lo(unsigned u) { return __uint_as_float(u << 16); }
__device__ __forceinline__ float bf_hi(unsigned u) { return __uint_as_float(u & 0xffff0000u); }
__device__ __forceinline__ float bf2f(bf16_t b) { return __uint_as_float(((unsigned)b) << 16); }
__device__ __forceinline__ float wave_sum(float v) {
#pragma unroll
    for (int o = 32; o >= 1; o >>= 1) v += __shfl_xor(v, o);
    return v;
}
__device__ __forceinline__ float wave_max(float v) {
#pragma unroll
    for (int o = 32; o >= 1; o >>= 1) v = fmaxf(v, __shfl_xor(v, o));
    return v;
}
__device__ __forceinline__ float sigmoidf_(float x) { return __builtin_amdgcn_rcpf(1.0f + __expf(-x)); }

#define XB_TMO      128
#define XB_XCNT(j)  (256  + 64 * (j))
#define XB_XSUB(j)  (1280 + 64 * (j))
#define XB_XGEN(j)  (2304 + 64 * (j))
#define XB_TOP      3328
#define XB_TOPGEN   3392
#define XCD_BAR_WORDS 3456
#define XB_SPIN_CAP (1u << 18)
__device__ __forceinline__ unsigned xb_ld(unsigned* p)              { return __hip_atomic_load(p, __ATOMIC_RELAXED, __HIP_MEMORY_SCOPE_AGENT); }
__device__ __forceinline__ unsigned xb_add(unsigned* p, unsigned v) { return __hip_atomic_fetch_add(p, v, __ATOMIC_RELAXED, __HIP_MEMORY_SCOPE_AGENT); }
__device__ __forceinline__ unsigned xb_xcc_id() { return (unsigned)__builtin_amdgcn_s_getreg((3 << 11) | 20) & 0xFu; }
#define XB_SPIN(cond, bar) do { unsigned _sp = 0; while (cond) { __builtin_amdgcn_s_sleep(1); \
    if ((++_sp & 255u) == 0u) { if (xb_ld(&(bar)[XB_TMO])) break; if (_sp > XB_SPIN_CAP) { atomicAdd(&(bar)[XB_TMO], 1u); break; } } } } while (0)
struct XcdBarrier { unsigned* bar; unsigned x; volatile LAS unsigned* st; };
__device__ __forceinline__ XcdBarrier xcd_barrier_post(unsigned* bar, volatile LAS unsigned* st) {
    XcdBarrier b; b.bar = bar; b.x = xb_xcc_id(); b.st = st;
    if (threadIdx.x == 0) (void)xb_add(&bar[XB_XCNT(b.x)], 1u);
    return b;
}
__device__ __forceinline__ void xcd_barrier_complete(unsigned* bar, unsigned x, unsigned& nloc, unsigned& nx) {
    const unsigned G = gridDim.x * gridDim.y * gridDim.z;
    unsigned sum, cnt, mine, sp = 0u;
    for (;;) {
        sum = 0u; cnt = 0u; mine = 0u;
#pragma unroll
        for (unsigned j = 0; j < 16; ++j) { const unsigned c = xb_ld(&bar[XB_XCNT(j)]); sum += c; cnt += (c > 0u) ? 1u : 0u; mine = (j == x) ? c : mine; }
        if (sum == G) break;
        __builtin_amdgcn_s_sleep(1);
        if ((++sp & 255u) == 0u) { if (xb_ld(&bar[XB_TMO])) break; if (sp > XB_SPIN_CAP) { atomicAdd(&bar[XB_TMO], 1u); break; } }
    }
    nloc = mine > 0u ? mine : 1u; nx = cnt > 0u ? cnt : 1u;
}
__device__ __forceinline__ void xcd_barrier(const XcdBarrier& b) {
    asm volatile("s_waitcnt vmcnt(0)" ::: "memory");
    __syncthreads();
    if (threadIdx.x == 0) {
        unsigned* bar = b.bar;
        __builtin_amdgcn_s_waitcnt(0);
        unsigned nloc = b.st[0], nx = b.st[1];
        if (nloc == 0u) { xcd_barrier_complete(bar, b.x, nloc, nx); b.st[0] = nloc; b.st[1] = nx; }
        const unsigned old = xb_add(&bar[XB_XSUB(b.x)], 1u);
        const unsigned gen = old / nloc;
        if (old + 1u == (gen + 1u) * nloc) {
            __builtin_amdgcn_fence(__ATOMIC_RELEASE, "agent");
            asm volatile("s_waitcnt vmcnt(0)" ::: "memory");
            const unsigned og = xb_add(&bar[XB_TOP], 1u);
            const unsigned tg = og / nx;
            if (og + 1u == (tg + 1u) * nx) xb_add(&bar[XB_TOPGEN], 1u);
            else XB_SPIN(xb_ld(&bar[XB_TOPGEN]) == tg, bar);
            __builtin_amdgcn_fence(__ATOMIC_ACQUIRE, "agent");
            xb_add(&bar[XB_XGEN(b.x)], 1u);
            asm volatile("s_waitcnt vmcnt(0)" ::: "memory");
        } else {
            XB_SPIN(xb_ld(&bar[XB_XGEN(b.x)]) == gen, bar);
            __builtin_amdgcn_fence(__ATOMIC_ACQUIRE, "agent");
            asm volatile("s_waitcnt vmcnt(0)" ::: "memory");
        }
    }
    __syncthreads();
}

struct Params {
    const float* x; const float* p; const int* positions; const float* norm1_w; const float* w_in; const float* w_pool; const float* pool_scale;
    const float* q_norm_w; const float* k_norm_cmp_w; const float* k_norm_slc_w; const float* k_norm_win_w; const float* cmp_pos_k; const float* cmp_pos_v;
    const float* cmp_k_w1; const float* cmp_k_w2; const float* cmp_v_w1; const float* cmp_v_w2; const float* w_o; const float* norm2_w; const float* w_ffn_in;
    const float* conv_w; const float* conv_b; const float* w_ffn_out; const float* w_ple_proj; const float* ple_norm_w; const float* ple_gate_norm_w; const float* w_ple_gate;
    float* out; unsigned char* ws; int ph_lo, ph_hi;
};

namespace pg8 {
constexpr int BM = 256, BK = 64, HALF = 128, HTB = HALF * BK * 2, STAGE_BYTES = 8 * HTB, NXCD = 8, WGM = 8;
__host__ __device__ __forceinline__ int lds_byte(int r, int c) { const int st = (r >> 4) * 2 + (c >> 5), rr = r & 15, cc = c & 31, ob = rr * 64 + cc * 2; return st * 1024 + (ob ^ (((ob >> 9) & 1) << 5)); }
__host__ __device__ __forceinline__ void stage_rc(int b, int& R, int& C) { const int st = b / 1024, sb = b % 1024, swz = sb ^ (((sb >> 9) & 1) << 5); R = (st >> 1) * 16 + swz / 64; C = (st & 1) * 32 + (swz % 64) / 2; }
__host__ __device__ __forceinline__ int perm32(int rho) { const int n = rho >> 4, i = rho & 15; return 8 * (i >> 2) + 4 * n + (i & 3); }
struct Unit { int pm, pn; };

struct StaticOrder {
    int nM, nN, nwg, G, c;
    __device__ void init(int nM_, int nN_, int G_, int c_) { nM = nM_; nN = nN_; nwg = nM * nN; G = G_; c = c_; }
    __device__ bool next(int i, Unit& u) const {
        const long L = (long)i * G + c; if (L >= nwg) return false;
        int wgid = (int)L; { const int q = nwg / NXCD, r = nwg % NXCD, xcd = wgid % NXCD, off = wgid / NXCD; wgid = (xcd < r ? xcd * (q + 1) : r * (q + 1) + (xcd - r) * q) + off; }
        const int nig = WGM * nN, gid = wgid / nig, fm = gid * WGM, gsz = (nM - fm) < WGM ? (nM - fm) : WGM;
        u.pm = fm + ((wgid % nig) % gsz); u.pn = (wgid % nig) / gsz; return true;
    }
};

struct GStd {
    const char* A; const char* B; unsigned lda, ldb; int nt;
    __device__ __forceinline__ const char* a_base(const Unit& u) const { return A + (size_t)u.pm * 256 * lda * 2; }
    __device__ __forceinline__ const char* b_base(const Unit& u) const { return B + (size_t)u.pn * 256 * ldb * 2; }
    __device__ __forceinline__ size_t kpairA() const { return 256; }
};
struct GPool {
    const char* A; const char* B; unsigned lda, ldb; int nt;
    __device__ __forceinline__ const char* a_base(const Unit& u) const { return A + (size_t)u.pm * 256 * lda * 2 + (size_t)u.pn * 512; }
    __device__ __forceinline__ const char* b_base(const Unit& u) const { return B + (size_t)u.pn * 256 * ldb * 2; }
    __device__ __forceinline__ size_t kpairA() const { return 256; }
};
struct GCmp {
    const char* Z; const char* Bk; const char* Bv; unsigned lda, ldb; int nt;
    __device__ __forceinline__ const char* a_base(const Unit& u) const { const int which = u.pm >> 4, g = (u.pm >> 2) & 3, rt = u.pm & 3;
        return Z + (size_t)(OFF_KV + which * 512 + g * 128) * 2 + (size_t)rt * 256 * lda * 2; }
    __device__ __forceinline__ const char* b_base(const Unit& u) const { return (u.pm >> 4) ? Bv : Bk; }
    __device__ __forceinline__ size_t kpairA() const { return (size_t)LDZ * 2; }
};

struct EpiBf16 {
    static constexpr bool PERM = true;
    bf16_t* O; int ldc;
    __device__ __forceinline__ void operator()(const f32x4 (&acc)[2][2][4][2], const Unit& u, int wr, int wc, int fr, int fq) const {
        const int row0 = u.pm * BM + wr * 64 + fr, col0 = u.pn * BM + wc * 32 + 8 * fq;
#pragma unroll
        for (int ai = 0; ai < 2; ++ai)
#pragma unroll
            for (int m = 0; m < 4; ++m) { bf16_t* rowp = O + (size_t)(row0 + ai * HALF + m * 16) * ldc + col0;
#pragma unroll
                for (int bj = 0; bj < 2; ++bj) { const f32x4 v0 = acc[ai][bj][m][0], v1 = acc[ai][bj][m][1];
                    u32x4 w; w.x = cvt_pk_bf16(v0[0], v0[1]); w.y = cvt_pk_bf16(v0[2], v0[3]); w.z = cvt_pk_bf16(v1[0], v1[1]); w.w = cvt_pk_bf16(v1[2], v1[3]);
                    *(u32x4*)(rowp + bj * HALF) = w; } }
    }
};
struct EpiBf16S {
    static constexpr bool PERM = true;
    bf16_t* O; int ldc; float s;
    __device__ __forceinline__ void operator()(const f32x4 (&acc)[2][2][4][2], const Unit& u, int wr, int wc, int fr, int fq) const {
        const int row0 = u.pm * BM + wr * 64 + fr, col0 = u.pn * BM + wc * 32 + 8 * fq;
#pragma unroll
        for (int ai = 0; ai < 2; ++ai)
#pragma unroll
            for (int m = 0; m < 4; ++m) { bf16_t* rowp = O + (size_t)(row0 + ai * HALF + m * 16) * ldc + col0;
#pragma unroll
                for (int bj = 0; bj < 2; ++bj) { const f32x4 v0 = acc[ai][bj][m][0] * s, v1 = acc[ai][bj][m][1] * s;
                    u32x4 w; w.x = cvt_pk_bf16(v0[0], v0[1]); w.y = cvt_pk_bf16(v0[2], v0[3]); w.z = cvt_pk_bf16(v1[0], v1[1]); w.w = cvt_pk_bf16(v1[2], v1[3]);
                    *(u32x4*)(rowp + bj * HALF) = w; } }
    }
};
struct EpiBf16Ssq {
    static constexpr bool PERM = true;
    bf16_t* O; int ldc; float* ssq;
    __device__ __forceinline__ void operator()(const f32x4 (&acc)[2][2][4][2], const Unit& u, int wr, int wc, int fr, int fq) const {
        const int row0 = u.pm * BM + wr * 64 + fr, col0 = u.pn * BM + wc * 32 + 8 * fq;
#pragma unroll
        for (int ai = 0; ai < 2; ++ai)
#pragma unroll
            for (int m = 0; m < 4; ++m) { const int row = row0 + ai * HALF + m * 16; bf16_t* rowp = O + (size_t)row * ldc + col0; float s = 0.f;
#pragma unroll
                for (int bj = 0; bj < 2; ++bj) { const f32x4 v0 = acc[ai][bj][m][0], v1 = acc[ai][bj][m][1];
                    s += v0[0] * v0[0] + v0[1] * v0[1] + v0[2] * v0[2] + v0[3] * v0[3] + v1[0] * v1[0] + v1[1] * v1[1] + v1[2] * v1[2] + v1[3] * v1[3];
                    u32x4 w; w.x = cvt_pk_bf16(v0[0], v0[1]); w.y = cvt_pk_bf16(v0[2], v0[3]); w.z = cvt_pk_bf16(v1[0], v1[1]); w.w = cvt_pk_bf16(v1[2], v1[3]);
                    *(u32x4*)(rowp + bj * HALF) = w; }
                s += __shfl_xor(s, 16); s += __shfl_xor(s, 32);
                if (fq == 0) unsafeAtomicAdd(ssq + row, s); }
    }
};
struct EpiBf16Scale {
    static constexpr bool PERM = true;
    bf16_t* O; int ldc; const float* colscale;
    __device__ __forceinline__ void operator()(const f32x4 (&acc)[2][2][4][2], const Unit& u, int wr, int wc, int fr, int fq) const {
        const int row0 = u.pm * BM + wr * 64 + fr, col0 = u.pn * BM + wc * 32 + 8 * fq;
#pragma unroll
        for (int bj = 0; bj < 2; ++bj) { const f32x4 s0 = *(const f32x4*)(colscale + col0 + bj * HALF), s1 = *(const f32x4*)(colscale + col0 + bj * HALF + 4);
#pragma unroll
            for (int ai = 0; ai < 2; ++ai)
#pragma unroll
                for (int m = 0; m < 4; ++m) { bf16_t* rowp = O + (size_t)(row0 + ai * HALF + m * 16) * ldc + col0;
                    const f32x4 v0 = acc[ai][bj][m][0] * s0, v1 = acc[ai][bj][m][1] * s1;
                    u32x4 w; w.x = cvt_pk_bf16(v0[0], v0[1]); w.y = cvt_pk_bf16(v0[2], v0[3]); w.z = cvt_pk_bf16(v1[0], v1[1]); w.w = cvt_pk_bf16(v1[2], v1[3]);
                    *(u32x4*)(rowp + bj * HALF) = w; } }
    }
};
struct EpiResF32 {
    static constexpr bool PERM = false;
    const float* base; float* C; int ldc; int row_off;
    __device__ __forceinline__ void operator()(const f32x4 (&acc)[2][2][4][2], const Unit& u, int wr, int wc, int fr, int fq) const {
        const int row0 = u.pm * BM + wr * 64 + fr + row_off, col0 = u.pn * BM + wc * 32 + 4 * fq;
#pragma unroll
        for (int ai = 0; ai < 2; ++ai)
#pragma unroll
            for (int m = 0; m < 4; ++m) { const size_t off = (size_t)(row0 + ai * HALF + m * 16) * ldc + col0;
#pragma unroll
                for (int bj = 0; bj < 2; ++bj)
#pragma unroll
                    for (int n = 0; n < 2; ++n) { const f32x4 b = *(const f32x4*)(base + off + bj * HALF + n * 16); *(f32x4*)(C + off + bj * HALF + n * 16) = b + acc[ai][bj][m][n]; }
                asm volatile("" ::: "memory"); }
    }
};
template <bool FP8OUT>
struct EpiResNormT {
    static constexpr bool PERM = false;
    const float* base; float* C; bf16_t* XN; const float* nw; float* ssq; int ldc;
    __device__ __forceinline__ void operator()(const f32x4 (&acc)[2][2][4][2], const Unit& u, int wr, int wc, int fr, int fq) const {
        const int row0 = u.pm * BM + wr * 64 + fr, col0 = u.pn * BM + wc * 32 + 4 * fq;
        f32x4 wv[2][2];
#pragma unroll
        for (int bj = 0; bj < 2; ++bj)
#pragma unroll
            for (int n = 0; n < 2; ++n) wv[bj][n] = *(const f32x4*)(nw + col0 + bj * HALF + n * 16);
        f32x4 bv[2][2][2];
#pragma unroll
        for (int bj = 0; bj < 2; ++bj)
#pragma unroll
            for (int n = 0; n < 2; ++n) bv[0][bj][n] = *(const f32x4*)(base + (size_t)row0 * ldc + col0 + bj * HALF + n * 16);
#pragma unroll
        for (int rg = 0; rg < 8; ++rg) { const int ai = rg >> 2, m = rg & 3; const int row = row0 + ai * HALF + m * 16; const size_t off = (size_t)row * ldc + col0;
            if (rg < 7) { const int ai2 = (rg + 1) >> 2, m2 = (rg + 1) & 3; const size_t off2 = (size_t)(row0 + ai2 * HALF + m2 * 16) * ldc + col0;
#pragma unroll
                for (int bj = 0; bj < 2; ++bj)
#pragma unroll
                    for (int n = 0; n < 2; ++n) bv[(rg + 1) & 1][bj][n] = *(const f32x4*)(base + off2 + bj * HALF + n * 16); }
            float s = 0.f;
#pragma unroll
            for (int bj = 0; bj < 2; ++bj)
#pragma unroll
                for (int n = 0; n < 2; ++n) { const f32x4 v = bv[rg & 1][bj][n] + acc[ai][bj][m][n];
                    *(f32x4*)(C + off + bj * HALF + n * 16) = v; s += v[0] * v[0] + v[1] * v[1] + v[2] * v[2] + v[3] * v[3];
                    if (FP8OUT) { int pk = __builtin_amdgcn_cvt_pk_fp8_f32(v[0] * wv[bj][n][0], v[1] * wv[bj][n][1], 0, false); pk = __builtin_amdgcn_cvt_pk_fp8_f32(v[2] * wv[bj][n][2], v[3] * wv[bj][n][3], pk, true);
                        *(int*)((unsigned char*)XN + off + bj * HALF + n * 16) = pk; }
                    else { u32x2 o; o.x = cvt_pk_bf16(v[0] * wv[bj][n][0], v[1] * wv[bj][n][1]); o.y = cvt_pk_bf16(v[2] * wv[bj][n][2], v[3] * wv[bj][n][3]);
                        *(u32x2*)(XN + off + bj * HALF + n * 16) = o; } }
            s += __shfl_xor(s, 16); s += __shfl_xor(s, 32);
            if (fq == 0) unsafeAtomicAdd(ssq + row, s);
        }
    }
};
typedef EpiResNormT<false> EpiResNorm;
typedef EpiResNormT<true> EpiResNormF8;
struct EpiCmpGelu {
    static constexpr bool PERM = false;
    float* H; const float* bias;
    __device__ __forceinline__ void operator()(const f32x4 (&acc)[2][2][4][2], const Unit& u, int wr, int wc, int fr, int fq) const {
        const int row0 = u.pm * BM + wr * 64 + fr, col0 = wc * 32 + 4 * fq; const float* bs = bias + (u.pm >> 4) * 256;
        f32x4 bvv[2][2];
#pragma unroll
        for (int bj = 0; bj < 2; ++bj)
#pragma unroll
            for (int n = 0; n < 2; ++n) bvv[bj][n] = *(const f32x4*)(bs + col0 + bj * HALF + n * 16);
#pragma unroll
        for (int ai = 0; ai < 2; ++ai)
#pragma unroll
            for (int m = 0; m < 4; ++m) { float* rowp = H + (size_t)(row0 + ai * HALF + m * 16) * 256 + col0;
#pragma unroll
                for (int bj = 0; bj < 2; ++bj)
#pragma unroll
                    for (int n = 0; n < 2; ++n) { f32x4 v = acc[ai][bj][m][n] + bvv[bj][n];
#pragma unroll
                        for (int j = 0; j < 4; ++j) { const float xx = v[j], uu = 0.7978845608028654f * (xx + 0.044715f * xx * xx * xx); const float th = 1.0f - 2.0f / (1.0f + __expf(2.0f * uu)); v[j] = 0.5f * xx * (1.0f + th); }
                        *(f32x4*)(rowp + bj * HALF + n * 16) = v; } }
    }
};
struct EpiGate {
    static constexpr bool PERM = false;
    float* C; const bf16_t* eraw; const float* erstd; const float* pw; const float* ssq; int ldc; float ascale;
    __device__ __forceinline__ void operator()(const f32x4 (&acc)[2][2][4][2], const Unit& u, int wr, int wc, int fr, int fq) const {
        const int row0 = u.pm * BM + wr * 64 + fr, col0 = u.pn * BM + wc * 32 + 4 * fq;
        f32x4 wv[2][2];
#pragma unroll
        for (int bj = 0; bj < 2; ++bj)
#pragma unroll
            for (int n = 0; n < 2; ++n) wv[bj][n] = *(const f32x4*)(pw + col0 + bj * HALF + n * 16);
        f32x4 bv[2][2][2]; u32x2 ev[2][2][2]; float rsv[2], rgv[2];
#pragma unroll
        for (int bj = 0; bj < 2; ++bj)
#pragma unroll
            for (int n = 0; n < 2; ++n) { bv[0][bj][n] = *(const f32x4*)(C + (size_t)row0 * ldc + col0 + bj * HALF + n * 16); ev[0][bj][n] = *(const u32x2*)(eraw + (size_t)row0 * ldc + col0 + bj * HALF + n * 16); }
        rsv[0] = erstd[row0]; rgv[0] = ssq[row0];
#pragma unroll
        for (int rg = 0; rg < 8; ++rg) { const int ai = rg >> 2, m = rg & 3; const int row = row0 + ai * HALF + m * 16; const size_t off = (size_t)row * ldc + col0;
            if (rg < 7) { const int ai2 = (rg + 1) >> 2, m2 = (rg + 1) & 3; const int row2 = row0 + ai2 * HALF + m2 * 16; const size_t off2 = (size_t)row2 * ldc + col0;
#pragma unroll
                for (int bj = 0; bj < 2; ++bj)
#pragma unroll
                    for (int n = 0; n < 2; ++n) { bv[(rg + 1) & 1][bj][n] = *(const f32x4*)(C + off2 + bj * HALF + n * 16); ev[(rg + 1) & 1][bj][n] = *(const u32x2*)(eraw + off2 + bj * HALF + n * 16); }
                rsv[(rg + 1) & 1] = erstd[row2]; rgv[(rg + 1) & 1] = ssq[row2]; }
            const float rs = rsqrtf(rsv[rg & 1] * (1.0f / DM) + EPS), rg_ = rsqrtf(rgv[rg & 1] * (1.0f / DM) + EPS) * ascale;
#pragma unroll
            for (int bj = 0; bj < 2; ++bj)
#pragma unroll
                for (int n = 0; n < 2; ++n) { const f32x4 b = bv[rg & 1][bj][n]; const u32x2 e = ev[rg & 1][bj][n]; const f32x4 a = acc[ai][bj][m][n]; f32x4 o;
                    o[0] = b[0] + bf_lo(e.x) * rs * wv[bj][n][0] * sigmoidf_(a[0] * rg_); o[1] = b[1] + bf_hi(e.x) * rs * wv[bj][n][1] * sigmoidf_(a[1] * rg_);
                    o[2] = b[2] + bf_lo(e.y) * rs * wv[bj][n][2] * sigmoidf_(a[2] * rg_); o[3] = b[3] + bf_hi(e.y) * rs * wv[bj][n][3] * sigmoidf_(a[3] * rg_);
                    *(f32x4*)(C + off + bj * HALF + n * 16) = o; }
        }
    }
};
struct GFfn {
    const char* A; const char* B; unsigned lda, ldb; int nt;
    __device__ __forceinline__ const char* a_base(const Unit& u) const { return A + ((long)u.pm * 254 - 2) * (long)lda * 2; }
    __device__ __forceinline__ const char* b_base(const Unit& u) const { return B + (size_t)u.pn * 256 * ldb * 2; }
    __device__ __forceinline__ size_t kpairA() const { return 256; }
};
template <int CTRL> __device__ __forceinline__ float dpp_f(float v) { return __int_as_float(__builtin_amdgcn_update_dpp(0, __float_as_int(v), CTRL, 0xf, 0xf, false)); }
struct EpiFfn {
    static constexpr bool PERM = true;
    bf16_t* ACT; const float* cw; const float* cb; LAS float* X; const float* ssq;
    __device__ __forceinline__ void operator()(const f32x4 (&acc)[2][2][4][2], const Unit& u, int wr, int wc, int fr, int fq) const {
        const int colw = wc * 32 + 8 * fq;
        const int f0 = u.pn * 128 + colw;
        f32x4 w0[2], w1[2], w2[2], cbv[2];
#pragma unroll
        for (int n = 0; n < 2; ++n) { w0[n] = *(const f32x4*)(cw + f0 + 4 * n); w1[n] = *(const f32x4*)(cw + DFF + f0 + 4 * n); w2[n] = *(const f32x4*)(cw + 2 * DFF + f0 + 4 * n); cbv[n] = *(const f32x4*)(cb + f0 + 4 * n); }
        float rsv[2][4];
#pragma unroll
        for (int ai = 0; ai < 2; ++ai)
#pragma unroll
            for (int m = 0; m < 4; ++m) { const long t = (long)u.pm * 254 - 2 + ai * HALF + wr * 64 + m * 16 + fr; rsv[ai][m] = ssq[t < 0 ? 0 : (t >= S_ ? S_ - 1 : t)]; }
#pragma unroll
        for (int ai = 0; ai < 2; ++ai)
#pragma unroll
            for (int m = 0; m < 4; ++m) { const long t = (long)u.pm * 254 - 2 + ai * HALF + wr * 64 + m * 16 + fr; rsv[ai][m] = (t >= 0 && t < S_) ? rsqrtf(rsv[ai][m] * (1.0f / DM) + EPS) : 0.f; }
        if (fr >= 14) {
#pragma unroll
            for (int ai = 0; ai < 2; ++ai)
#pragma unroll
                for (int n = 0; n < 2; ++n) *(LAS f32x4*)(X + ((2 * ai + wr) * 2 + (fr - 14)) * 128 + colw + 4 * n) = acc[ai][0][3][n] * rsv[ai][3];
        }
        asm volatile("s_waitcnt lgkmcnt(0)" ::: "memory");
        __builtin_amdgcn_s_barrier(); asm volatile("" ::: "memory");
        __builtin_amdgcn_s_barrier(); asm volatile("" ::: "memory");
        const bool sel1 = fr == 15, sel2 = fr >= 14;
#pragma unroll
        for (int ai = 0; ai < 2; ++ai) {
            f32x4 pv[2];
            const int pseg = 2 * ai + wr - 1;
#pragma unroll
            for (int n = 0; n < 2; ++n) { pv[n] = (f32x4){0.f, 0.f, 0.f, 0.f}; if (pseg >= 0 && fr >= 14) pv[n] = *(const LAS f32x4*)(X + (pseg * 2 + (fr - 14)) * 128 + colw + 4 * n); }
#pragma unroll
            for (int m = 0; m < 4; ++m) {
                const int r = ai * HALF + wr * 64 + m * 16 + fr; const long t = (long)u.pm * 254 - 2 + r;
                unsigned ow[4];
#pragma unroll
                for (int n = 0; n < 2; ++n) {
                    const f32x4 cur = acc[ai][0][m][n] * rsv[ai][m], up = acc[ai][1][m][n] * rsv[ai][m];
                    f32x4 x1, x2;
#pragma unroll
                    for (int i = 0; i < 4; ++i) { x1[i] = dpp_f<0x121>(sel1 ? pv[n][i] : cur[i]); x2[i] = dpp_f<0x122>(sel2 ? pv[n][i] : cur[i]); }
                    const f32x4 y = cbv[n] + w0[n] * x2 + w1[n] * x1 + w2[n] * cur;
                    f32x4 sg;
#pragma unroll
                    for (int i = 0; i < 4; ++i) sg[i] = sigmoidf_(y[i]);
                    const f32x4 o = y * sg * up;
                    ow[2 * n] = cvt_pk_bf16(o[0], o[1]); ow[2 * n + 1] = cvt_pk_bf16(o[2], o[3]);
                    pv[n] = cur;
                }
                if (r >= 2 && t < S_) *(u32x4*)(ACT + (size_t)t * DFF + f0) = (u32x4){ow[0], ow[1], ow[2], ow[3]};
            }
        }
    }
};

template <class GD, class Epi, bool F8 = false>
__device__ __forceinline__ void gemm_phase(LAS unsigned char* lds, const GD g, const StaticOrder& S, const Epi& E) {
    const int tid = threadIdx.x, wid = __builtin_amdgcn_readfirstlane(tid >> 6), lane = tid & 63, wr = wid >> 2, wc = wid & 3, fr = lane & 15, fq = lane >> 4;
    const int nt = g.nt;
    unsigned voffA[2], voffB[2];
#pragma unroll
    for (int i = 0; i < 2; ++i) { int R, C; stage_rc(tid * 16 + i * 8192, R, C); const int Rb = Epi::PERM ? ((R & ~31) + perm32(R & 31)) : R;
        voffA[i] = (unsigned)(R * g.lda + C) * 2u; voffB[i] = (unsigned)(Rb * g.ldb + C) * 2u; }
    const size_t kpA = g.kpairA();
    const size_t hstepA = (size_t)HALF * g.lda * 2, hstepB = (size_t)HALF * g.ldb * 2;
    const unsigned ldsw = (unsigned)wid * 1024u;
    const int aoff = lds_byte(wr * 64 + fr, fq * 8), boff = lds_byte(wc * 32 + fr, fq * 8);
#define PG8_SA(b, h) (((b) * 2 + (h)) * HTB)
#define PG8_SB(b, h) ((4 + (b) * 2 + (h)) * HTB)
#define PG8_STAGE(bufoff, gbase, voff) do { _Pragma("unroll") for (int _i = 0; _i < 2; ++_i) \
        __builtin_amdgcn_global_load_lds((const unsigned*)((const char*)(gbase) + (voff)[_i]), (LAS unsigned*)(lds + (bufoff) + ldsw + _i * 8192), 16, 0, 0); } while (0)
#define PG8_LDA(dst, b, h) do { if constexpr (F8) { _Pragma("unroll") for (int m = 0; m < 4; ++m) { const i32x4 lo_ = *(const LAS i32x4*)(lds + PG8_SA(b, h) + aoff + m * 2048), hi_ = *(const LAS i32x4*)(lds + PG8_SA(b, h) + aoff + m * 2048 + 1024); \
            dst##8[m] = __builtin_shufflevector(lo_, hi_, 0, 1, 2, 3, 4, 5, 6, 7); } } \
        else { _Pragma("unroll") for (int m = 0; m < 4; ++m) _Pragma("unroll") for (int k = 0; k < 2; ++k) dst[m][k] = *(const LAS bf16x8*)(lds + PG8_SA(b, h) + aoff + m * 2048 + k * 1024); } } while (0)
#define PG8_LDB(dst, b, h) do { if constexpr (F8) { _Pragma("unroll") for (int n = 0; n < 2; ++n) { const i32x4 lo_ = *(const LAS i32x4*)(lds + PG8_SB(b, h) + boff + n * 2048), hi_ = *(const LAS i32x4*)(lds + PG8_SB(b, h) + boff + n * 2048 + 1024); \
            dst##8[n] = __builtin_shufflevector(lo_, hi_, 0, 1, 2, 3, 4, 5, 6, 7); } } \
        else { _Pragma("unroll") for (int n = 0; n < 2; ++n) _Pragma("unroll") for (int k = 0; k < 2; ++k) dst[n][k] = *(const LAS bf16x8*)(lds + PG8_SB(b, h) + boff + n * 2048 + k * 1024); } } while (0)
#define PG8_MMA(ai, bj, At, Bt) do { __builtin_amdgcn_s_setprio(1); \
        if constexpr (F8) { _Pragma("unroll") for (int m = 0; m < 4; ++m) _Pragma("unroll") for (int n = 0; n < 2; ++n) \
            asm volatile("v_mfma_scale_f32_16x16x128_f8f6f4 %0, %1, %2, %0, %3, %3 op_sel_hi:[0,0,0]" : "+v"(acc[ai][bj][m][n]) : "v"(Bt##8[n]), "v"(At##8[m]), "v"(one_scale)); } \
        else { _Pragma("unroll") for (int m = 0; m < 4; ++m) _Pragma("unroll") for (int n = 0; n < 2; ++n) _Pragma("unroll") for (int k = 0; k < 2; ++k) \
            acc[ai][bj][m][n] = __builtin_amdgcn_mfma_f32_16x16x32_bf16(Bt[n][k], At[m][k], acc[ai][bj][m][n], 0, 0, 0); } \
        __builtin_amdgcn_s_setprio(0); } while (0)
#define PG8_WAIT_V(n) asm volatile("s_waitcnt vmcnt(" #n ")" ::: "memory")
#define PG8_WAIT_L(n) asm volatile("s_waitcnt lgkmcnt(" #n ")" ::: "memory")
#define PG8_BAR __builtin_amdgcn_s_barrier()
#define PG8_SCHED __builtin_amdgcn_sched_barrier(0)
    Unit cur, nxt; int ui = 0;
    if (!S.next(0, cur)) return;
    f32x4 acc[2][2][4][2];
#pragma unroll
    for (int a = 0; a < 2; ++a)
#pragma unroll
        for (int b = 0; b < 2; ++b)
#pragma unroll
            for (int m = 0; m < 4; ++m)
#pragma unroll
                for (int n = 0; n < 2; ++n) acc[a][b][m][n] = (f32x4){0.f, 0.f, 0.f, 0.f};
    bf16x8 At[4][2], B0[2][2], B1[2][2];
    i32x8 At8[4], B08[2], B18[2];
    (void)At; (void)B0; (void)B1; (void)At8; (void)B08; (void)B18;
    int one_scale = 0x7F7F7F7F; (void)one_scale;
    const char* cA = g.a_base(cur); const char* cB = g.b_base(cur);
    PG8_STAGE(PG8_SB(0, 0), cB, voffB); PG8_STAGE(PG8_SA(0, 0), cA, voffA); PG8_STAGE(PG8_SB(0, 1), cB + hstepB, voffB); PG8_STAGE(PG8_SA(0, 1), cA + hstepA, voffA);
    if (wr == 1) PG8_BAR;
    PG8_WAIT_V(4); PG8_BAR;
    PG8_STAGE(PG8_SB(1, 0), cB + 128, voffB); PG8_STAGE(PG8_SA(1, 0), cA + 128, voffA); PG8_STAGE(PG8_SB(1, 1), cB + hstepB + 128, voffB);
    PG8_WAIT_V(6); PG8_BAR;
    for (;;) {
        const bool has_next = S.next(ui + 1, nxt);
        const char* nA = has_next ? g.a_base(nxt) : cA; const char* nB = has_next ? g.b_base(nxt) : cB;
        for (int t = 0; t < nt; t += 2) {
            const bool last = (t == nt - 2);
            const char* a0 = cA + (size_t)(t >> 1) * kpA;
            const char* a1 = a0 + 128;
            const char* a2 = last ? nA : a0 + kpA; const char* b2 = last ? nB : cB + (size_t)(t + 2) * 128;
            const char* a3 = a2 + 128; const char* b3 = b2 + 128;
            PG8_LDB(B0, 0, 0); PG8_SCHED; PG8_LDA(At, 0, 0); PG8_STAGE(PG8_SA(1, 1), a1 + hstepA, voffA);
            PG8_WAIT_L(8); PG8_BAR; PG8_WAIT_L(0); PG8_MMA(0, 0, At, B0); PG8_BAR; PG8_SCHED;
            PG8_LDB(B1, 0, 1); PG8_STAGE(PG8_SB(0, 0), b2, voffB);
            PG8_BAR; PG8_WAIT_L(0); PG8_MMA(0, 1, At, B1); PG8_BAR;
            PG8_LDA(At, 0, 1); PG8_STAGE(PG8_SA(0, 0), a2, voffA);
            PG8_BAR; PG8_WAIT_L(0); PG8_MMA(1, 0, At, B0); PG8_BAR; PG8_SCHED;
            PG8_STAGE(PG8_SB(0, 1), b2 + hstepB, voffB);
            PG8_WAIT_V(6); PG8_BAR; PG8_MMA(1, 1, At, B1); PG8_BAR;
            PG8_LDB(B0, 1, 0); PG8_SCHED; PG8_LDA(At, 1, 0); PG8_STAGE(PG8_SA(0, 1), a2 + hstepA, voffA);
            PG8_WAIT_L(8); PG8_BAR; PG8_WAIT_L(0); PG8_MMA(0, 0, At, B0); PG8_BAR; PG8_SCHED;
            PG8_LDB(B1, 1, 1); PG8_STAGE(PG8_SB(1, 0), b3, voffB);
            PG8_BAR; PG8_WAIT_L(0); PG8_MMA(0, 1, At, B1); PG8_BAR;
            PG8_LDA(At, 1, 1); PG8_STAGE(PG8_SA(1, 0), a3, voffA);
            PG8_BAR; PG8_WAIT_L(0); PG8_MMA(1, 0, At, B0); PG8_BAR; PG8_SCHED;
            PG8_STAGE(PG8_SB(1, 1), b3 + hstepB, voffB);
            PG8_WAIT_V(6); PG8_BAR; PG8_MMA(1, 1, At, B1); PG8_BAR;
        }
        if constexpr (F8) asm volatile("s_nop 15\n\ts_nop 15\n\ts_nop 15" ::: "memory");
        E(acc, cur, wr, wc, fr, fq);
        if (!has_next) break;
#pragma unroll
        for (int a = 0; a < 2; ++a)
#pragma unroll
            for (int b = 0; b < 2; ++b)
#pragma unroll
                for (int m = 0; m < 4; ++m)
#pragma unroll
                    for (int n = 0; n < 2; ++n) acc[a][b][m][n] = (f32x4){0.f, 0.f, 0.f, 0.f};
        cur = nxt; cA = nA; cB = nB; ++ui;
    }
    PG8_WAIT_V(0);
    if (wr == 0) PG8_BAR;
    PG8_BAR;
#undef PG8_SA
#undef PG8_SB
#undef PG8_STAGE
#undef PG8_LDA
#undef PG8_LDB
#undef PG8_MMA
#undef PG8_WAIT_V
#undef PG8_WAIT_L
#undef PG8_BAR
#undef PG8_SCHED
}
}

namespace att {
constexpr int KVBLK = 64;
constexpr int SHM_V = KVBLK * HD * 2, SHM_K = KVBLK * HD * 2, SHM_ATTN = 2 * SHM_V + 2 * SHM_K + NWAVES * 64 * 4;
#define KSWZ(row, colB) ((row) * 256 + ((colB) ^ (((row) & 7) << 4)))
#define SBAR() __builtin_amdgcn_sched_barrier(0)
__device__ __forceinline__ int crow(int r, int hi) { return (r & 3) + 8 * (r >> 2) + 4 * hi; }
__device__ __forceinline__ void qkt(f32x16& p0, f32x16& p1, const char* Ks, const bf16x8* qr, int r32, int hi) {
    p0 = f32x16{}; p1 = f32x16{};
    bf16x8 ka[2], kb[2];
    { const int cb = (hi * 8) * 2; ka[0] = *reinterpret_cast<const bf16x8*>(Ks + KSWZ(r32, cb)); kb[0] = *reinterpret_cast<const bf16x8*>(Ks + KSWZ(32 + r32, cb)); }
#pragma unroll
    for (int d0 = 0; d0 < 8; ++d0) {
        if (d0 < 7) { const int cb = ((d0 + 1) * 16 + hi * 8) * 2;
            ka[(d0 + 1) & 1] = *reinterpret_cast<const bf16x8*>(Ks + KSWZ(r32, cb)); kb[(d0 + 1) & 1] = *reinterpret_cast<const bf16x8*>(Ks + KSWZ(32 + r32, cb)); }
        SBAR();
        p0 = __builtin_amdgcn_mfma_f32_32x32x16_bf16(ka[d0 & 1], qr[d0], p0, 0, 0, 0);
        p1 = __builtin_amdgcn_mfma_f32_32x32x16_bf16(kb[d0 & 1], qr[d0], p1, 0, 0, 0);
        SBAR();
    }
}
__device__ __forceinline__ int v_st(int k, int c) { const int kk = (k & ~0xC) | ((k & 4) << 1) | ((k & 8) >> 1); return ((kk >> 3) * 4 + (c >> 5)) * 512 + ((kk & 7) * 32 + (c & 31)) * 2; }
__device__ __forceinline__ int v_rd_base(int lane) { return ((lane & 3) << 3) | (((lane >> 2) & 3) << 6) | (((lane >> 4) & 1) << 5) | (((lane >> 5) & 1) << 8); }
constexpr int v_rd_off(int d0, int ks, int half) { return d0 * 512 + ks * 4096 + half * 2048; }
__device__ __forceinline__ s16x4 tr_read(int vb, int off) { return __builtin_amdgcn_ds_read_tr16_b64_v4i16((LAS s16x4*)(unsigned long)(unsigned)(vb + off)); }
__device__ __forceinline__ void pv_d0(f32x16* o, int vb, bf16x8 pa0, bf16x8 pa1, bf16x8 pa2, bf16x8 pa3) {
    s16x4 L[2][4], H[2][4];
#pragma unroll
    for (int d0 = 0; d0 < 4; ++d0) { L[0][d0] = tr_read(vb, v_rd_off(d0, 0, 0)); H[0][d0] = tr_read(vb, v_rd_off(d0, 0, 1)); }
#pragma unroll
    for (int ks = 0; ks < 4; ++ks) {
        if (ks < 3) {
#pragma unroll
            for (int d0 = 0; d0 < 4; ++d0) { L[(ks + 1) & 1][d0] = tr_read(vb, v_rd_off(d0, ks + 1, 0)); H[(ks + 1) & 1][d0] = tr_read(vb, v_rd_off(d0, ks + 1, 1)); }
        }
        const bf16x8 pa = ks == 0 ? pa0 : (ks == 1 ? pa1 : (ks == 2 ? pa2 : pa3));
#pragma unroll
        for (int d0 = 0; d0 < 4; ++d0) { const s16x4 l = L[ks & 1][d0], h = H[ks & 1][d0];
            o[d0] = __builtin_amdgcn_mfma_f32_32x32x16_bf16(pa, (bf16x8){l[0], l[1], l[2], l[3], h[0], h[1], h[2], h[3]}, o[d0], 0, 0, 0); }
    }
}
__device__ __forceinline__ void pack_p(const f32x16& p0, const f32x16& p1, bf16x8& pa0, bf16x8& pa1, bf16x8& pa2, bf16x8& pa3) {
#define PK4(P, BASE, OUT) do { unsigned a0 = cvt_pk_bf16(P[BASE + 0], P[BASE + 1]), a1 = cvt_pk_bf16(P[BASE + 2], P[BASE + 3]);   \
    unsigned b0 = cvt_pk_bf16(P[BASE + 4], P[BASE + 5]), b1 = cvt_pk_bf16(P[BASE + 6], P[BASE + 7]);                              \
    auto r0 = __builtin_amdgcn_permlane32_swap(a0, b0, false, false); auto r1 = __builtin_amdgcn_permlane32_swap(a1, b1, false, false); \
    u32x4 w = {r0[0], r1[0], r0[1], r1[1]}; OUT = *reinterpret_cast<bf16x8*>(&w); } while (0)
    PK4(p0, 0, pa0); PK4(p0, 8, pa1); PK4(p1, 0, pa2); PK4(p1, 8, pa3);
#undef PK4
}

__device__ __forceinline__ void pack_half(const f32x16& p, bf16x8& paA, bf16x8& paB) {
#define PK4(P, BASE, OUT) do { unsigned a0 = cvt_pk_bf16(P[BASE + 0], P[BASE + 1]), a1 = cvt_pk_bf16(P[BASE + 2], P[BASE + 3]);   \
    unsigned b0 = cvt_pk_bf16(P[BASE + 4], P[BASE + 5]), b1 = cvt_pk_bf16(P[BASE + 6], P[BASE + 7]);                              \
    auto r0 = __builtin_amdgcn_permlane32_swap(a0, b0, false, false); auto r1 = __builtin_amdgcn_permlane32_swap(a1, b1, false, false); \
    u32x4 w = {r0[0], r1[0], r0[1], r1[1]}; OUT = *reinterpret_cast<bf16x8*>(&w); } while (0)
    PK4(p, 0, paA); PK4(p, 8, paB);
#undef PK4
}
template <int KS0, bool WITH_EXP>
__device__ __forceinline__ void pv_half(f32x16* o, int vb, bf16x8 paA, bf16x8 paB, f32x16& px, float off) {
    s16x4 L[2][4], H[2][4];
#pragma unroll
    for (int d0 = 0; d0 < 4; ++d0) { L[0][d0] = tr_read(vb, v_rd_off(d0, KS0, 0)); H[0][d0] = tr_read(vb, v_rd_off(d0, KS0, 1)); }
#pragma unroll
    for (int d0 = 0; d0 < 4; ++d0) { L[1][d0] = tr_read(vb, v_rd_off(d0, KS0 + 1, 0)); H[1][d0] = tr_read(vb, v_rd_off(d0, KS0 + 1, 1)); }
#pragma unroll
    for (int kk = 0; kk < 2; ++kk) {
        const bf16x8 pa = kk == 0 ? paA : paB;
#pragma unroll
        for (int d0 = 0; d0 < 4; ++d0) { const s16x4 l = L[kk][d0], h = H[kk][d0];
            if (WITH_EXP) SBAR();
            o[d0] = __builtin_amdgcn_mfma_f32_32x32x16_bf16(pa, (bf16x8){l[0], l[1], l[2], l[3], h[0], h[1], h[2], h[3]}, o[d0], 0, 0, 0);
            if (WITH_EXP) {
#pragma unroll
                for (int q = 0; q < 2; ++q) { const int r = (kk * 4 + d0) * 2 + q; px[r] = __builtin_amdgcn_exp2f(fmaf(px[r], SM_C, off)); }
                SBAR(); }
        }
    }
}
enum { MODE_CMP = 0, MODE_WIN = 1, MODE_SLC = 2 };
struct AttnArgs {
    const bf16_t* Z; const bf16_t* KC; const bf16_t* VC; const float* G; float* L; float* OACC; bf16_t* MIX; const unsigned* BM; const float* TAB;
};
template <int MODE>
__device__ __forceinline__ void attn_unit(const AttnArgs& a, LAS char* ldsL, int qt, int g, int hp) {
    char* lds = (char*)ldsL;
    const int tid = threadIdx.x, wid = __builtin_amdgcn_readfirstlane(tid >> 6), lane = tid & 63, r32 = lane & 31, hi = lane >> 5;
    float* li_l = (float*)(lds + LDS_XCH) + wid * 64;
    const int t0 = MODE == MODE_SLC ? qt * 40 : qt * 128;
    const int tq_raw = MODE == MODE_SLC ? t0 + wid * 5 + r32 / 6 : t0 + wid * 16 + (r32 & 15);
    const bool rvalid = MODE == MODE_SLC ? (r32 < 30 && tq_raw < S_) : true;
    const int tq = tq_raw < S_ ? tq_raw : S_ - 1;
    const int hq = MODE == MODE_SLC ? g * HPG + r32 % 6 : g * HPG + hp * 2 + (r32 >> 4);
    const int tlast = MODE == MODE_SLC ? ((t0 + 39) < S_ ? (t0 + 39) : S_ - 1) : t0 + 127;
    const bf16_t* Kb; const bf16_t* Vb; long ldk;
    if (MODE == MODE_CMP) { Kb = a.KC + (size_t)g * 1024 * HD; Vb = a.VC + (size_t)g * 1024 * HD; ldk = HD; }
    else if (MODE == MODE_WIN) { Kb = a.Z + OFF_KV + 4 * 512 + g * HD; Vb = a.Z + OFF_KV + 5 * 512 + g * HD; ldk = LDZ; }
    else { Kb = a.Z + OFF_KV + 2 * 512 + g * HD; Vb = a.Z + OFF_KV + 3 * 512 + g * HD; ldk = LDZ; }
    int j0, j1;
    if (MODE == MODE_CMP) { j0 = 0; j1 = (((t0 + 127 - 31) >> 4) >> 6) + 1; }
    else if (MODE == MODE_WIN) { j0 = (t0 - 511) > 0 ? ((t0 - 511) >> 6) : 0; j1 = ((t0 + 127) >> 6) + 1; }
    else { j0 = 0; j1 = (tlast >> 6) + 1; }
    int klo, khi;
    if (MODE == MODE_CMP) { klo = 0; khi = tq >= 31 ? ((tq - 31) >> 4) : -1; }
    else if (MODE == MODE_WIN) { klo = tq - 511; khi = tq; }
    else { klo = 0; khi = rvalid ? tq : -1; }
    float negBC = -a.TAB[512 + (MODE == MODE_CMP ? 0 : (MODE == MODE_SLC ? 1 : 2))];
    bf16x8 qr[8];
    { const bf16_t* Qw = a.Z + (size_t)tq * LDZ + OFF_Q + hq * HD + hi * 8;
#pragma unroll
      for (int d0 = 0; d0 < 8; ++d0) qr[d0] = *reinterpret_cast<const bf16x8*>(Qw + d0 * 16); }
    f32x16 o[4] = {}; float lsum = 0.f;
    unsigned soK[2], soV[2];
#pragma unroll
    for (int i = 0; i < 2; ++i) { const int p = (wid + 8 * i) * 64 + lane;
        { const int row = p >> 4, c = (p & 15) ^ (row & 7); soK[i] = (unsigned)(row * ldk + c * 8) * 2u; }
        { const int sub = p >> 5, within = p & 31, kk = (sub >> 2) * 8 + (within >> 2), c = (sub & 3) * 32 + (within & 3) * 8, k = (kk & ~0xC) | ((kk & 4) << 1) | ((kk & 8) >> 1);
          soV[i] = (unsigned)(k * ldk + c) * 2u; } }
    const int vb0 = (int)(uintptr_t)(LAS char*)ldsL + 16384 + v_rd_base(lane);
#define ISSUE(jt) do { const int _b = ((jt) - j0) & 3; const char* _kp = (const char*)Kb + (size_t)(jt) * KVBLK * ldk * 2; const char* _vp = (const char*)Vb + (size_t)(jt) * KVBLK * ldk * 2; \
    _Pragma("unroll") for (int _i = 0; _i < 2; ++_i) { \
        __builtin_amdgcn_global_load_lds((const unsigned*)(_kp + soK[_i]), (LAS unsigned*)(ldsL + _b * 32768 + (wid + 8 * _i) * 1024), 16, 0, 0); \
        __builtin_amdgcn_global_load_lds((const unsigned*)(_vp + soV[_i]), (LAS unsigned*)(ldsL + _b * 32768 + 16384 + (wid + 8 * _i) * 1024), 16, 0, 0); } } while (0)
    unsigned bmw = 0u;
    if (MODE == MODE_SLC) bmw = a.BM[((size_t)tq * 4 + g) * 8];
    asm volatile("s_waitcnt lgkmcnt(0)" ::: "memory");
    __builtin_amdgcn_s_barrier();
    asm volatile("" ::: "memory");
    ISSUE(j0);
    asm volatile("s_waitcnt vmcnt(4) lgkmcnt(0)" : "+v"(bmw), "+v"(negBC), "+v"(qr[0]), "+v"(qr[1]), "+v"(qr[2]), "+v"(qr[3]), "+v"(qr[4]), "+v"(qr[5]), "+v"(qr[6]), "+v"(qr[7]) :: "memory");
    if (j0 + 1 < j1) ISSUE(j0 + 1); if (j0 + 2 < j1) ISSUE(j0 + 2);
    for (int j = j0; j < j1; ++j) {
        const int buf = (j - j0) & 3;
        if (j + 2 < j1) asm volatile("s_waitcnt vmcnt(8)" ::: "memory"); else if (j + 1 < j1) asm volatile("s_waitcnt vmcnt(4)" ::: "memory"); else asm volatile("s_waitcnt vmcnt(0)" ::: "memory");
        __builtin_amdgcn_s_barrier();
        asm volatile("" ::: "memory");
        if (j + 3 < j1) ISSUE(j + 3);
        int lhi = khi;
        if (MODE == MODE_SLC) { if (!((bmw >> (j & 31)) & 1u)) lhi = -1; }
        const int kb = j * KVBLK;
        const bool l_any = (kb + 63 >= klo) && (kb <= lhi);
        const bool l_full = (kb >= klo) && (kb + 63 <= lhi);
        if (__any(l_any)) {
            f32x16 p0, p1;
            qkt(p0, p1, lds + buf * 32768, qr, r32, hi);
            const bool uni = __all(l_full || !l_any);
            const float off = (uni && !l_any) ? -1.0e30f : negBC;
#pragma unroll
            for (int r = 0; r < 16; ++r) p0[r] = __builtin_amdgcn_exp2f(fmaf(p0[r], SM_C, off));
            if (!uni) {
#pragma unroll
                for (int r = 0; r < 16; ++r) { const int k0i = kb + crow(r, hi); p0[r] = (k0i >= klo && k0i <= lhi) ? p0[r] : 0.f; } }
            float ps = 0.f;
#pragma unroll
            for (int r = 0; r < 16; ++r) ps += p0[r];
            bf16x8 pa0, pa1, pa2, pa3; pack_half(p0, pa0, pa1);
            pv_half<0, true>(o, vb0 + buf * 32768, pa0, pa1, p1, off);
            if (!uni) {
#pragma unroll
                for (int r = 0; r < 16; ++r) { const int k1i = kb + 32 + crow(r, hi); p1[r] = (k1i >= klo && k1i <= lhi) ? p1[r] : 0.f; } }
#pragma unroll
            for (int r = 0; r < 16; ++r) ps += p1[r];
            lsum += ps;
            pack_half(p1, pa2, pa3);
            pv_half<2, false>(o, vb0 + buf * 32768, pa2, pa3, p1, off);
        }
        if (MODE == MODE_SLC) { if (((j + 1) & 31) == 0 && j + 1 < j1) { bmw = a.BM[((size_t)tq * 4 + g) * 8 + ((j + 1) >> 5)]; asm volatile("s_waitcnt vmcnt(0)" : "+v"(bmw) :: "memory"); } }
    }
#undef ISSUE
    lsum += __shfl_xor(lsum, 32);
    const float grow = a.G[(size_t)tq * NGATE + hq * 3 + (MODE == MODE_CMP ? 0 : (MODE == MODE_SLC ? 1 : 2))];
    if (hi == 0) { li_l[r32] = lsum; li_l[32 + r32] = rvalid ? grow : 0.f; }
    if (MODE == MODE_CMP) { if (hi == 0) a.L[(size_t)tq * NH + hq] = lsum; }
    asm volatile("s_waitcnt lgkmcnt(0)" ::: "memory");
#pragma unroll
    for (int hf = 0; hf < 2; ++hf) {
        float gtv[8]; float pvv[8][4];
#pragma unroll
        for (int rr = 0; rr < 8; ++rr) { const int r = hf * 8 + rr;
            const int orow = crow(r, hi); const float lv = li_l[orow]; const float rl = lv > 0.f ? __builtin_amdgcn_rcpf(lv) : 0.f;
            const int t = MODE == MODE_SLC ? t0 + wid * 5 + orow / 6 : t0 + wid * 16 + (orow & 15);
            const int h = MODE == MODE_SLC ? g * HPG + orow % 6 : g * HPG + hp * 2 + (orow >> 4);
            const bool valid = !(MODE == MODE_SLC && (orow >= 30 || t >= S_)); const int tc = valid ? t : 0;
            gtv[rr] = li_l[32 + orow] * rl;
            if (MODE != MODE_CMP) { const float* oa = a.OACC + (size_t)tc * 3072 + h * HD + r32;
#pragma unroll
                for (int d0 = 0; d0 < 4; ++d0) pvv[rr][d0] = oa[d0 * 32]; }
        }
#pragma unroll
        for (int rr = 0; rr < 8; ++rr) { const int r = hf * 8 + rr;
            const int orow = crow(r, hi);
            const int t = MODE == MODE_SLC ? t0 + wid * 5 + orow / 6 : t0 + wid * 16 + (orow & 15);
            const int h = MODE == MODE_SLC ? g * HPG + orow % 6 : g * HPG + hp * 2 + (orow >> 4);
            if (MODE == MODE_SLC && (orow >= 30 || t >= S_)) continue;
            float* oa = a.OACC + (size_t)t * 3072 + h * HD + r32;
#pragma unroll
            for (int d0 = 0; d0 < 4; ++d0) {
                const float v = o[d0][r] * gtv[rr];
                if (MODE == MODE_CMP) oa[d0 * 32] = v;
                else if (MODE == MODE_WIN) oa[d0 * 32] = pvv[rr][d0] + v;
                else a.MIX[(size_t)t * DM + POOLW + h * HD + d0 * 32 + r32] = (bf16_t)(cvt_pk_bf16(pvv[rr][d0] + v, 0.f) & 0xffffu);
            }
        }
    }
}

__device__ __forceinline__ void imp_task(const AttnArgs& a, float* IMPP, float* IMPF, int tqi, int g) {
    const int lane = threadIdx.x & 63, fr = lane & 15, fq = lane >> 4;
    const int t = tqi * 16 + fr;
    const int tmax = tqi * 16 + 15;
    if (tmax < 31) return;
    const int lim = t >= 31 ? ((t - 31) >> 4) : -1;
    const int nstep = ((((tmax - 31) >> 4) >> 6) + 1) * 4;
    const float negBC = -a.TAB[512];
    bf16x8 qf[HPG][4]; float rl[HPG];
#pragma unroll
    for (int h = 0; h < HPG; ++h) {
        const bf16_t* qp = a.Z + (size_t)t * LDZ + OFF_Q + (g * HPG + h) * HD + fq * 8;
#pragma unroll
        for (int ks = 0; ks < 4; ++ks) qf[h][ks] = *reinterpret_cast<const bf16x8*>(qp + ks * 32);
        const float lv = a.L[(size_t)t * NH + g * HPG + h]; rl[h] = lv > 0.f ? 1.0f / lv : 0.f;
    }
    const bf16_t* kbase = a.KC + (size_t)g * 1024 * HD + (size_t)fr * HD + fq * 8;
    bf16x8 kf[4], kn[4], kn2[4];
#pragma unroll
    for (int ks = 0; ks < 4; ++ks) { kf[ks] = *reinterpret_cast<const bf16x8*>(kbase + ks * 32); kn[ks] = *reinterpret_cast<const bf16x8*>(kbase + (size_t)(nstep > 1 ? 1 : 0) * 16 * HD + ks * 32); }
    float* op = IMPP + ((size_t)t * 4 + g) * 256 + fq; float* of = IMPF + ((size_t)t * 4 + g) * 256 + fq;
    for (int st = 0; st < nstep; ++st) {
        const int sn = (st + 2 < nstep) ? st + 2 : nstep - 1;
#pragma unroll
        for (int ks = 0; ks < 4; ++ks) kn2[ks] = *reinterpret_cast<const bf16x8*>(kbase + (size_t)sn * 16 * HD + ks * 32);
        f32x4 imp4 = {0.f, 0.f, 0.f, 0.f};
        const int n0 = st * 16 + fq * 4;
#pragma unroll
        for (int h = 0; h < HPG; ++h) {
            f32x4 acc = {0.f, 0.f, 0.f, 0.f};
#pragma unroll
            for (int ks = 0; ks < 4; ++ks) acc = __builtin_amdgcn_mfma_f32_16x16x32_bf16(kf[ks], qf[h][ks], acc, 0, 0, 0);
#pragma unroll
            for (int i = 0; i < 4; ++i) { const float e = __builtin_amdgcn_exp2f(fmaf(acc[i], SM_C, negBC)) * rl[h]; imp4[i] += (n0 + i <= lim) ? e : 0.f; }
        }
        op[st * 4] = imp4[0] + 2.0f * (imp4[1] + imp4[2] + imp4[3]);
        of[st * 4] = imp4[0];
#pragma unroll
        for (int ks = 0; ks < 4; ++ks) { kf[ks] = kn[ks]; kn[ks] = kn2[ks]; }
    }
}

__device__ __forceinline__ void topk_load(const float* IMPP, const float* IMPF, int t, int g, f32x4& pp, f32x4& ff) {
    const int lane = threadIdx.x & 63, cur = t >> 6, jb = lane * 4;
    pp = (f32x4){0.f, 0.f, 0.f, 0.f}; ff = pp;
    if (cur > 15 && jb <= cur) { const size_t base = ((size_t)t * 4 + g) * 256; pp = *(const f32x4*)(IMPP + base + jb); ff = *(const f32x4*)(IMPF + base + jb); }
}
__device__ __forceinline__ void topk_task(const f32x4 pp, const f32x4 ff, unsigned* BM, int t, int g) {
    const int lane = threadIdx.x & 63;
    const int cur = t >> 6;
    unsigned nib = 0u;
    if (cur <= 15) { const int jb = lane * 4;
#pragma unroll
        for (int c = 0; c < 4; ++c) if (jb + c <= cur) nib |= 1u << c; }
    else {
        const int jb = lane * 4;
        unsigned key[4];
        {
            float fnext = __shfl_down(ff[0], 1);
            if (lane == 63) fnext = 0.f;
            const float v0 = pp[0] + ff[1], v1 = pp[1] + ff[2], v2 = pp[2] + ff[3], v3 = pp[3] + fnext;
            key[0] = (jb + 0 >= 1 && jb + 0 <= cur - 2) ? __float_as_uint(fmaxf(v0, 0.f)) + 1u : 0u;
            key[1] = (jb + 1 >= 1 && jb + 1 <= cur - 2) ? __float_as_uint(fmaxf(v1, 0.f)) + 1u : 0u;
            key[2] = (jb + 2 >= 1 && jb + 2 <= cur - 2) ? __float_as_uint(fmaxf(v2, 0.f)) + 1u : 0u;
            key[3] = (jb + 3 >= 1 && jb + 3 <= cur - 2) ? __float_as_uint(fmaxf(v3, 0.f)) + 1u : 0u;
        }
        unsigned prefix = 0u; bool exact = false;
        for (int b = 30; b >= 0; --b) {
            const unsigned trial = prefix | (1u << b);
            const int cnt = __popcll(__ballot(key[0] >= trial)) + __popcll(__ballot(key[1] >= trial)) + __popcll(__ballot(key[2] >= trial)) + __popcll(__ballot(key[3] >= trial));
            if (cnt >= 13) { prefix = trial; if (cnt == 13) { exact = true; break; } }
        }
#pragma unroll
        for (int c = 0; c < 4; ++c) if (exact ? (key[c] >= prefix) : (key[c] > prefix)) nib |= 1u << c;
        if (!exact) {
            int need = 13 - (__popcll(__ballot(key[0] > prefix)) + __popcll(__ballot(key[1] > prefix)) + __popcll(__ballot(key[2] > prefix)) + __popcll(__ballot(key[3] > prefix)));
            unsigned tie = 0u;
#pragma unroll
            for (int c = 0; c < 4; ++c) if (key[c] == prefix) tie |= 1u << c;
            for (int guard = 0; need > 0 && guard < 16; ++guard) {
                const unsigned long long any = __ballot(tie != 0u);
                if (any == 0ull) break;
                const int L = __builtin_ctzll(any);
                if (lane == L) { const unsigned low = tie & (0u - tie); nib |= low; tie ^= low; }
                --need;
            }
        }
        if (lane == 0) nib |= 1u;
        if (lane == (cur >> 2)) nib |= 1u << (cur & 3);
        if (lane == ((cur - 1) >> 2)) nib |= 1u << ((cur - 1) & 3);
    }
    unsigned x = nib << (4 * (lane & 7));
    x |= __shfl_xor(x, 1); x |= __shfl_xor(x, 2); x |= __shfl_xor(x, 4);
    if ((lane & 7) == 0) BM[((size_t)t * 4 + g) * 8 + (lane >> 3)] = x;
}
#undef KSWZ
}

template <bool FFN_REMAP = false>
__device__ __forceinline__ void convT(const float* __restrict__ src0, int K, int N, bf16_t* __restrict__ dst, int ldd, LAS float* tile, int bid, int nb, int Nfull = 0, int n0 = 0) {
    const float* __restrict__ src = src0 + n0; if (Nfull == 0) Nfull = N;
    const int tid = threadIdx.x, tk = K >> 6, tn = (N + 63) >> 6, total = tk * tn;
    const int r = tid >> 4, c4 = (tid & 15) * 4;
    f32x4 v[2] = {{0.f, 0.f, 0.f, 0.f}, {0.f, 0.f, 0.f, 0.f}}, vn[2];
    if (bid < total) { const int nti = bid % tn, kti = bid / tn, ng = nti * 64 + c4;
#pragma unroll
        for (int h = 0; h < 2; ++h) if (ng < N) v[h] = *(const f32x4*)(src + (size_t)(kti * 64 + r + h * 32) * Nfull + ng); }
    for (int idx = bid; idx < total; idx += nb) {
        const int nti = idx % tn, kti = idx / tn;
#pragma unroll
        for (int h = 0; h < 2; ++h) { LAS float* tp = tile + (r + h * 32) * 65 + c4; tp[0] = v[h][0]; tp[1] = v[h][1]; tp[2] = v[h][2]; tp[3] = v[h][3]; }
        {
            const int nx = idx + nb; vn[0] = (f32x4){0.f, 0.f, 0.f, 0.f}; vn[1] = vn[0];
            if (nx < total) { const int nti2 = nx % tn, kti2 = nx / tn, ng2 = nti2 * 64 + c4;
#pragma unroll
                for (int h = 0; h < 2; ++h) if (ng2 < N) vn[h] = *(const f32x4*)(src + (size_t)(kti2 * 64 + r + h * 32) * Nfull + ng2); } }
        __syncthreads();
        const int n = tid >> 3, k8 = (tid & 7) * 8, ngl = nti * 64 + n;
        float e[8];
#pragma unroll
        for (int i = 0; i < 8; ++i) e[i] = tile[(k8 + i) * 65 + n];
        if (ngl < N) { u32x4 w; w.x = cvt_pk_bf16(e[0], e[1]); w.y = cvt_pk_bf16(e[2], e[3]); w.z = cvt_pk_bf16(e[4], e[5]); w.w = cvt_pk_bf16(e[6], e[7]);
            int drow = ngl; if (FFN_REMAP) { const int up = ngl >= DFF ? 1 : 0, f = ngl - up * DFF; drow = (f >> 7) * 256 + up * 128 + (f & 127); }
            *(u32x4*)(dst + (size_t)drow * ldd + kti * 64 + k8) = w; }
        __syncthreads();
        v[0] = vn[0]; v[1] = vn[1];
    }
}
__device__ __forceinline__ void convT8(const float* __restrict__ src0, int K, int N, unsigned char* __restrict__ dst, int ldd, float scale, LAS float* tile, int bid, int nb, int Nfull = 0, int n0 = 0) {
    const float* __restrict__ src = src0 + n0; if (Nfull == 0) Nfull = N;
    const int tid = threadIdx.x, tk = K >> 6, tn = (N + 63) >> 6, total = tk * tn;
    const int r = tid >> 4, c4 = (tid & 15) * 4;
    f32x4 v[2] = {{0.f, 0.f, 0.f, 0.f}, {0.f, 0.f, 0.f, 0.f}}, vn[2];
    if (bid < total) { const int nti = bid % tn, kti = bid / tn, ng = nti * 64 + c4;
#pragma unroll
        for (int h = 0; h < 2; ++h) if (ng < N) v[h] = *(const f32x4*)(src + (size_t)(kti * 64 + r + h * 32) * Nfull + ng); }
    for (int idx = bid; idx < total; idx += nb) {
        const int nti = idx % tn, kti = idx / tn;
#pragma unroll
        for (int h = 0; h < 2; ++h) { LAS float* tp = tile + (r + h * 32) * 65 + c4; tp[0] = v[h][0]; tp[1] = v[h][1]; tp[2] = v[h][2]; tp[3] = v[h][3]; }
        { const int nx = idx + nb; vn[0] = (f32x4){0.f, 0.f, 0.f, 0.f}; vn[1] = vn[0];
            if (nx < total) { const int nti2 = nx % tn, kti2 = nx / tn, ng2 = nti2 * 64 + c4;
#pragma unroll
                for (int h = 0; h < 2; ++h) if (ng2 < N) vn[h] = *(const f32x4*)(src + (size_t)(kti2 * 64 + r + h * 32) * Nfull + ng2); } }
        __syncthreads();
        const int n = tid >> 3, k8 = (tid & 7) * 8, ngl = nti * 64 + n;
        float e[8];
#pragma unroll
        for (int i = 0; i < 8; ++i) e[i] = tile[(k8 + i) * 65 + n] * scale;
        if (ngl < N) { int p0 = __builtin_amdgcn_cvt_pk_fp8_f32(e[0], e[1], 0, false); p0 = __builtin_amdgcn_cvt_pk_fp8_f32(e[2], e[3], p0, true);
            int p1 = __builtin_amdgcn_cvt_pk_fp8_f32(e[4], e[5], 0, false); p1 = __builtin_amdgcn_cvt_pk_fp8_f32(e[6], e[7], p1, true);
            *(u32x2*)(dst + (size_t)ngl * ldd + kti * 64 + k8) = (u32x2){(unsigned)p0, (unsigned)p1}; }
        __syncthreads();
        v[0] = vn[0]; v[1] = vn[1];
    }
}
__device__ __forceinline__ void rmsnorm_rows(const float* __restrict__ src, const float* __restrict__ w, bf16_t* __restrict__ dst, int rows, int gw, int nw, unsigned char* __restrict__ dst8 = nullptr) {
    const int lane = threadIdx.x & 63;
    f32x4 v[16], vn[16];
    if (gw < rows) { const f32x4* sp = (const f32x4*)(src + (size_t)gw * DM);
#pragma unroll
        for (int i = 0; i < 16; ++i) v[i] = sp[lane + 64 * i]; }
    for (int row = gw; row < rows; row += nw) {
        const int nr = row + nw < rows ? row + nw : row;
        { const f32x4* sp = (const f32x4*)(src + (size_t)nr * DM);
#pragma unroll
          for (int i = 0; i < 16; ++i) vn[i] = sp[lane + 64 * i]; }
        float ss = 0.f;
#pragma unroll
        for (int i = 0; i < 16; ++i) ss += v[i][0] * v[i][0] + v[i][1] * v[i][1] + v[i][2] * v[i][2] + v[i][3] * v[i][3];
        ss = wave_sum(ss);
        const float rstd = rsqrtf(ss * (1.0f / DM) + EPS);
#pragma unroll
        for (int i = 0; i < 16; ++i) { const f32x4 ww = ((const f32x4*)w)[lane + 64 * i];
            u32x2 o; o.x = cvt_pk_bf16(v[i][0] * rstd * ww[0], v[i][1] * rstd * ww[1]); o.y = cvt_pk_bf16(v[i][2] * rstd * ww[2], v[i][3] * rstd * ww[3]);
            *(u32x2*)(dst + (size_t)row * DM + (lane + 64 * i) * 4) = o;
            if (dst8) { int pk = __builtin_amdgcn_cvt_pk_fp8_f32(v[i][0] * rstd * ww[0], v[i][1] * rstd * ww[1], 0, false); pk = __builtin_amdgcn_cvt_pk_fp8_f32(v[i][2] * rstd * ww[2], v[i][3] * rstd * ww[3], pk, true);
                *(int*)(dst8 + (size_t)row * DM + (lane + 64 * i) * 4) = pk; } }
#pragma unroll
        for (int i = 0; i < 16; ++i) v[i] = vn[i];
    }
}

struct Ptrs {
    bf16_t *Win, *Wo, *Wfi, *Wfo, *Wg, *Wple, *Wpool, *Wc1k, *Wc1v, *XN, *PB, *Z, *M, *KC, *VC, *MIX, *ACT, *ERAW;
    float *COS, *SIN, *TAB, *G, *H1, *L, *OACC, *IMPP, *IMPF, *ERSTD; unsigned* BM;
};

__device__ __forceinline__ void phase_prologue(const Params& P, const Ptrs& W, LAS unsigned char* lds) {
    const int bid = blockIdx.x, nb = gridDim.x, tid = threadIdx.x, lane = tid & 63, wv = tid >> 6;
    const int gw = bid * NWAVES + wv, nw = nb * NWAVES; const size_t gt = (size_t)bid * NTHREADS + tid, ntot = (size_t)nb * NTHREADS;
    LAS float* tile = (LAS float*)lds;
    rmsnorm_rows(P.x, P.norm1_w, W.XN, S_, gw, nw, P.ws + WS_XN8);
    convT(P.w_in, DM, POOLW, W.Win, DM, tile, bid, nb, INW, 0);
    convT(P.w_in, DM, INW - OFF_G, W.Win + (size_t)OFF_G * DM, DM, tile, bid, nb, INW, OFF_G);
    convT8(P.w_in, DM, OFF_G - POOLW, P.ws + WS_WIN8, DM, WG8_SCALE, tile, bid, nb, INW, POOLW);
    for (size_t i = gt; i < (size_t)(LDZ - INW) * DM / 8; i += ntot) *(u32x4*)(W.Win + (size_t)INW * DM + i * 8) = (u32x4){0u, 0u, 0u, 0u};
    convT(P.w_o, DM, DM, W.Wo, DM, tile, bid, nb);
    convT<true>(P.w_ffn_in, DM, NFI, W.Wfi, DM, tile, bid, nb);
    for (size_t i = gt; i < (size_t)2 * DM / 8; i += ntot) *(u32x4*)(W.XN - 2 * DM + i * 8) = (u32x4){0u, 0u, 0u, 0u};
    convT(P.w_ffn_out, DFF, DM, W.Wfo, DFF, tile, bid, nb);
    convT8(P.w_ple_gate, DM, DM, (unsigned char*)W.Wg, DM, WG8_SCALE, tile, bid, nb);
    convT(P.w_ple_proj, PLE, DM, W.Wple, PLE, tile, bid, nb);
    for (int g = 0; g < 4; ++g) convT(P.w_pool + (size_t)g * 65536, 256, 256, W.Wpool + (size_t)g * 65536, 256, tile, bid, nb);
    convT(P.cmp_k_w1, 4096, 256, W.Wc1k, 4096, tile, bid, nb);
    convT(P.cmp_v_w1, 4096, 256, W.Wc1v, 4096, tile, bid, nb);
    { constexpr size_t NP8 = (size_t)S_ * PLE / 8;
      for (size_t ib = gt; ib < NP8; ib += 4 * ntot) { f32x4 av[4], bv[4];
#pragma unroll
          for (int k = 0; k < 4; ++k) { size_t i = ib + k * ntot; if (i >= NP8) i = NP8 - 1; av[k] = *(const f32x4*)(P.p + i * 8); bv[k] = *(const f32x4*)(P.p + i * 8 + 4); }
#pragma unroll
          for (int k = 0; k < 4; ++k) { const size_t i = ib + k * ntot; if (i < NP8) { u32x4 w; w.x = cvt_pk_bf16(av[k][0], av[k][1]); w.y = cvt_pk_bf16(av[k][2], av[k][3]); w.z = cvt_pk_bf16(bv[k][0], bv[k][1]); w.w = cvt_pk_bf16(bv[k][2], bv[k][3]); *(u32x4*)(W.PB + i * 8) = w; } } } }
    for (size_t i = gt; i < (size_t)S_ * 16; i += ntot) { const int t = (int)(i >> 4), fi = (int)(i & 15);
        const float inv = exp2f(-(float)fi * (18.931568569324174f / 16.0f)); const float ang = (float)P.positions[t] * inv;
        const double ad = (double)ang; const double kk = rint(ad * 0.15915494309189535); const float rf = (float)(ad - kk * 6.283185307179586);
        W.COS[i] = __cosf(rf); W.SIN[i] = __sinf(rf); }
    for (int task = gw; task < 128; task += nw) { const int which = task >> 6, r0 = (task & 63) * 64; const float* pe = which ? P.cmp_pos_v : P.cmp_pos_k; const float* w1 = which ? P.cmp_v_w1 : P.cmp_k_w1;
        f32x4 s = {0.f, 0.f, 0.f, 0.f};
#pragma unroll 8
        for (int r = 0; r < 64; ++r) { const f32x4 wv = *(const f32x4*)(w1 + (size_t)(r0 + r) * 256 + lane * 4); s += wv * pe[r0 + r]; }
        float* cbp = (float*)(P.ws + WS_CBIAS) + which * 256 + lane * 4;
        unsafeAtomicAdd(cbp + 0, s[0]); unsafeAtomicAdd(cbp + 1, s[1]); unsafeAtomicAdd(cbp + 2, s[2]); unsafeAtomicAdd(cbp + 3, s[3]); }
    if (gw == 0) { float mq = fmaxf(fabsf(P.q_norm_w[lane]), fabsf(P.q_norm_w[lane + 64])); mq = wave_max(mq);
        float mc = wave_max(fmaxf(fabsf(P.k_norm_cmp_w[lane]), fabsf(P.k_norm_cmp_w[lane + 64])));
        float ms = wave_max(fmaxf(fabsf(P.k_norm_slc_w[lane]), fabsf(P.k_norm_slc_w[lane + 64])));
        float mw = wave_max(fmaxf(fabsf(P.k_norm_win_w[lane]), fabsf(P.k_norm_win_w[lane + 64])));
        const float c = 11.313708498984761f * 1.4426950408889634f * mq * 1.01f;
        if (lane == 0) { W.TAB[512] = c * mc; W.TAB[513] = c * ms; W.TAB[514] = c * mw; } }
}

__device__ __forceinline__ void phase_postz(const Params& P, const Ptrs& W, int gw, int nw) {
    const int tid = threadIdx.x, lane = tid & 63;
    const f32x2 wq = *(const f32x2*)(P.q_norm_w + 2 * lane), wks = *(const f32x2*)(P.k_norm_slc_w + 2 * lane), wkw = *(const f32x2*)(P.k_norm_win_w + 2 * lane);
    for (int t = gw; t < S_; t += nw) {
        bf16_t* zr = W.Z + (size_t)t * LDZ;
        float cs0 = 0.f, cs1 = 0.f, sn0 = 0.f, sn1 = 0.f;
        if (lane < 16) { const int i0 = (2 * lane) & 15; cs0 = W.COS[t * 16 + i0]; cs1 = W.COS[t * 16 + i0 + 1]; sn0 = W.SIN[t * 16 + i0]; sn1 = W.SIN[t * 16 + i0 + 1]; }
        unsigned uv[32];
#pragma unroll
        for (int v = 0; v < 32; ++v) { const int col = v < 24 ? OFF_Q + v * HD : (v < 28 ? OFF_KV + 2 * 512 + (v - 24) * HD : OFF_KV + 4 * 512 + (v - 28) * HD);
            uv[v] = *((const unsigned*)(zr + col) + lane); }
#pragma unroll
        for (int v = 0; v < 32; ++v) {
            const f32x2 ww = v < 24 ? wq : (v < 28 ? wks : wkw);
            const unsigned u = uv[v]; const float x0 = bf_lo(u), x1 = bf_hi(u);
            const float ss = wave_sum(x0 * x0 + x1 * x1);
            const float rstd = rsqrtf(ss * (1.0f / HD) + EPS);
            float y0 = x0 * rstd * ww[0], y1 = x1 * rstd * ww[1];
            const float p0 = __shfl_xor(y0, 8), p1 = __shfl_xor(y1, 8);
            if (lane < 8) { y0 = y0 * cs0 - p0 * sn0; y1 = y1 * cs1 - p1 * sn1; }
            else if (lane < 16) { y0 = y0 * cs0 + p0 * sn0; y1 = y1 * cs1 + p1 * sn1; }
            uv[v] = cvt_pk_bf16(y0, y1);
        }
        {
            const int gi = lane >> 4, wlen = 2 << gi, c0 = lane * 16; const int cnt = (t + 1) < wlen ? (t + 1) : wlen;
            float s[16];
#pragma unroll
            for (int i = 0; i < 16; ++i) s[i] = 0.f;
            float cur[16];
#pragma unroll
            for (int bt = 0; bt < 2; ++bt) {
                u32x4 ra[8], rb[8];
#pragma unroll
                for (int i = 0; i < 8; ++i) { const int ii = bt * 8 + i; const size_t row = (size_t)(ii < cnt ? t - ii : t);
                    ra[i] = *(const u32x4*)(W.Z + row * LDZ + c0); rb[i] = *(const u32x4*)(W.Z + row * LDZ + c0 + 8); }
#pragma unroll
                for (int i = 0; i < 8; ++i) { const int ii = bt * 8 + i; const float mk = ii < cnt ? 1.0f : 0.0f; const u32x4 a = ra[i], b = rb[i];
                    const float ev[16] = {bf_lo(a.x), bf_hi(a.x), bf_lo(a.y), bf_hi(a.y), bf_lo(a.z), bf_hi(a.z), bf_lo(a.w), bf_hi(a.w), bf_lo(b.x), bf_hi(b.x), bf_lo(b.y), bf_hi(b.y), bf_lo(b.z), bf_hi(b.z), bf_lo(b.w), bf_hi(b.w)};
#pragma unroll
                    for (int q = 0; q < 16; ++q) { s[q] += ev[q] * mk; if (ii == 0) cur[q] = ev[q]; } }
                if (bt == 0 && __all(cnt <= 8)) break;
            }
            const float rc = 1.0f / (float)cnt;
            u32x4 o0, o1;
            o0.x = cvt_pk_bf16(s[0] * rc - cur[0], s[1] * rc - cur[1]); o0.y = cvt_pk_bf16(s[2] * rc - cur[2], s[3] * rc - cur[3]);
            o0.z = cvt_pk_bf16(s[4] * rc - cur[4], s[5] * rc - cur[5]); o0.w = cvt_pk_bf16(s[6] * rc - cur[6], s[7] * rc - cur[7]);
            o1.x = cvt_pk_bf16(s[8] * rc - cur[8], s[9] * rc - cur[9]); o1.y = cvt_pk_bf16(s[10] * rc - cur[10], s[11] * rc - cur[11]);
            o1.z = cvt_pk_bf16(s[12] * rc - cur[12], s[13] * rc - cur[13]); o1.w = cvt_pk_bf16(s[14] * rc - cur[14], s[15] * rc - cur[15]);
            *(u32x4*)(W.M + (size_t)t * POOLW + c0) = o0; *(u32x4*)(W.M + (size_t)t * POOLW + c0 + 8) = o1;
        }
#pragma unroll
        for (int v = 0; v < 32; ++v) { const int col = v < 24 ? OFF_Q + v * HD : (v < 28 ? OFF_KV + 2 * 512 + (v - 24) * HD : OFF_KV + 4 * 512 + (v - 28) * HD);
            *((unsigned*)(zr + col) + lane) = uv[v]; }

    }
}

__device__ __forceinline__ void phase_cmpfin(const Params& P, const Ptrs& W) {
    const int tid = threadIdx.x, lane = tid & 63, gw = blockIdx.x * NWAVES + (tid >> 6), nw = gridDim.x * NWAVES;
    const f32x2 wk = *(const f32x2*)(P.k_norm_cmp_w + 2 * lane);
    for (int task = gw; task < 8192; task += nw) {
        const int tk = __builtin_amdgcn_readfirstlane(task);
        const int which = tk >> 12, g = (tk >> 10) & 3, n = tk & 1023;
        bf16_t* dst = (which ? W.VC : W.KC) + ((size_t)g * 1024 + n) * HD;
        if (n == 1023) { ((unsigned*)dst)[lane] = 0u; continue; }
        const float* h = W.H1 + (size_t)tk * 256; const float* w2 = which ? P.cmp_v_w2 : P.cmp_k_w2;
        float a0 = 0.f, a1 = 0.f;
        for (int j = 0; j < 256; ++j) { const float hj = h[j]; const f32x2 wv = *(const f32x2*)(w2 + j * HD + 2 * lane); a0 += hj * wv[0]; a1 += hj * wv[1]; }
        if (which == 0) {
            const float ss = wave_sum(a0 * a0 + a1 * a1); const float rstd = rsqrtf(ss * (1.0f / HD) + EPS);
            a0 = a0 * rstd * wk[0]; a1 = a1 * rstd * wk[1];
            const int tp = 16 * n + 31; const float p0 = __shfl_xor(a0, 8), p1 = __shfl_xor(a1, 8);
            if (lane < 16) { const int i0 = (2 * lane) & 15; const float cs0 = W.COS[tp * 16 + i0], cs1 = W.COS[tp * 16 + i0 + 1], sn0 = W.SIN[tp * 16 + i0], sn1 = W.SIN[tp * 16 + i0 + 1];
                if (lane < 8) { a0 = a0 * cs0 - p0 * sn0; a1 = a1 * cs1 - p1 * sn1; } else { a0 = a0 * cs0 + p0 * sn0; a1 = a1 * cs1 + p1 * sn1; } }
        }
        ((unsigned*)dst)[lane] = cvt_pk_bf16(a0, a1);
    }
}

__device__ __forceinline__ void phase_erstd(const Ptrs& W) {
    const int tid = threadIdx.x, lane = tid & 63, gw = blockIdx.x * NWAVES + (tid >> 6), nw = gridDim.x * NWAVES;
    u32x4 a[8], an[8];
    if (gw < S_) { const u32x4* sp = (const u32x4*)(W.ERAW + (size_t)gw * DM);
#pragma unroll
        for (int i = 0; i < 8; ++i) a[i] = sp[lane + 64 * i]; }
    for (int row = gw; row < S_; row += nw) {
        const int nr = row + nw < S_ ? row + nw : row;
        { const u32x4* sp = (const u32x4*)(W.ERAW + (size_t)nr * DM);
#pragma unroll
          for (int i = 0; i < 8; ++i) an[i] = sp[lane + 64 * i]; }
        float ss = 0.f;
#pragma unroll
        for (int i = 0; i < 8; ++i) {
            const float e0 = bf_lo(a[i].x), e1 = bf_hi(a[i].x), e2 = bf_lo(a[i].y), e3 = bf_hi(a[i].y), e4 = bf_lo(a[i].z), e5 = bf_hi(a[i].z), e6 = bf_lo(a[i].w), e7 = bf_hi(a[i].w);
            ss += e0 * e0 + e1 * e1 + e2 * e2 + e3 * e3 + e4 * e4 + e5 * e5 + e6 * e6 + e7 * e7; }
        ss = wave_sum(ss);
        if (lane == 0) W.ERSTD[row] = rsqrtf(ss * (1.0f / DM) + EPS);
#pragma unroll
        for (int i = 0; i < 8; ++i) a[i] = an[i];
    }
}

constexpr int N_PHASES = 11;
__device__ __forceinline__ Params kargs() {
#if defined(__HIP_DEVICE_COMPILE__)
    unsigned long long p = (unsigned long long)__builtin_amdgcn_kernarg_segment_ptr();
    asm volatile("" : "+s"(p));
    return *(const __attribute__((address_space(4))) Params*)p;
#else
    return Params{};
#endif
}
__device__ __forceinline__ Ptrs mkptrs(unsigned char* ws) {
    Ptrs W;
    W.Win = (bf16_t*)(ws + WS_WIN); W.Wo = (bf16_t*)(ws + WS_WO); W.Wfi = (bf16_t*)(ws + WS_WFI); W.Wfo = (bf16_t*)(ws + WS_WFO); W.Wg = (bf16_t*)(ws + WS_WG);
    W.Wple = (bf16_t*)(ws + WS_WPLE); W.Wpool = (bf16_t*)(ws + WS_WPOOL); W.Wc1k = (bf16_t*)(ws + WS_WC1K); W.Wc1v = (bf16_t*)(ws + WS_WC1V);
    W.XN = (bf16_t*)(ws + WS_XN); W.PB = (bf16_t*)(ws + WS_PB); W.Z = (bf16_t*)(ws + WS_Z); W.M = (bf16_t*)(ws + WS_M); W.KC = (bf16_t*)(ws + WS_KC); W.VC = (bf16_t*)(ws + WS_VC);
    W.MIX = (bf16_t*)(ws + WS_MIX); W.ACT = (bf16_t*)(ws + WS_ACT); W.ERAW = (bf16_t*)(ws + WS_ERAW);
    W.COS = (float*)(ws + WS_COS); W.SIN = (float*)(ws + WS_SIN); W.TAB = (float*)(ws + WS_TAB); W.G = (float*)(ws + WS_G); W.H1 = (float*)(ws + WS_H1); W.L = (float*)(ws + WS_L);
    W.OACC = (float*)(ws + WS_OACC); W.IMPP = (float*)(ws + WS_IMPP); W.IMPF = (float*)(ws + WS_IMPF); W.ERSTD = (float*)(ws + WS_ERSTD); W.BM = (unsigned*)(ws + WS_BM);
    return W;
}
__global__ void __launch_bounds__(NTHREADS, 2) fwd(Params Punused) {
    extern __shared__ __attribute__((aligned(16))) unsigned char lds_raw[];
    LAS unsigned char* lds = (LAS unsigned char*)lds_raw;
    const int tid = threadIdx.x;
    const int G = gridDim.x, bid = blockIdx.x;
    const int gw = bid * NWAVES + (tid >> 6), nw = G * NWAVES;

    if (tid < 16) ((LAS unsigned*)(lds + LDS_MISC))[tid] = 0u;
    __syncthreads();
    int lo, hi; XcdBarrier bar;
    { const Params P = kargs(); lo = P.ph_lo; hi = P.ph_hi;
      bar.bar = (unsigned*)(P.ws + WS_CTL); bar.x = 0; bar.st = (volatile LAS unsigned*)(lds + LDS_MISC);
      if (hi - lo > 1) bar = xcd_barrier_post((unsigned*)(P.ws + WS_CTL), (volatile LAS unsigned*)(lds + LDS_MISC)); }
#ifdef PH_MASK
#define IN(k) (((PH_MASK >> (k)) & 1) && lo <= (k) && (k) < hi)
#else
#define IN(k) (lo <= (k) && (k) < hi)
#endif
#define SEAM(k) do { if (IN(k) && IN((k) + 1)) xcd_barrier(bar); } while (0)
#define PHASE_VARS const Params P = kargs(); const Ptrs W = mkptrs(P.ws); (void)W;
#define ATT_ARGS att::AttnArgs AA{W.Z, W.KC, W.VC, W.G, W.L, W.OACC, W.MIX, W.BM, W.TAB};

    if (IN(0)) { PHASE_VARS REP(0) { phase_prologue(P, W, lds); } SEAM(0); }
    if (IN(1)) {
        PHASE_VARS
        { pg8::GStd g{(const char*)W.XN, (const char*)W.Win, DM, DM, DM / 64}; pg8::StaticOrder S; S.init(S_ / 256, POOLW / 256, G, bid);
          pg8::EpiBf16 E{W.Z, LDZ}; pg8::gemm_phase(lds, g, S, E); }
        { pg8::GStd g{(const char*)(P.ws + WS_XN8), (const char*)(P.ws + WS_WIN8), DM / 2, DM / 2, DM / 128}; pg8::StaticOrder S; S.init(S_ / 256, (OFF_G - POOLW) / 256, G, bid);
          pg8::EpiBf16S E{W.Z + POOLW, LDZ, 1.0f / WG8_SCALE}; pg8::gemm_phase<pg8::GStd, pg8::EpiBf16S, true>(lds, g, S, E); }
        SEAM(1);
    }
    if (IN(2)) {
        PHASE_VARS
        if (G > 64) {
            if (bid < 32) { pg8::GCmp g{(const char*)W.Z, (const char*)W.Wc1k, (const char*)W.Wc1v, 16 * LDZ, 4096, 64}; pg8::StaticOrder S; S.init(32, 1, 32, bid);
                pg8::EpiCmpGelu E{W.H1, (const float*)(P.ws + WS_CBIAS)}; pg8::gemm_phase(lds, g, S, E); }
            else if (bid < 96) {
                pg8::GStd g{(const char*)W.XN, (const char*)(W.Win + (size_t)OFF_G * DM), DM, DM, DM / 64}; pg8::StaticOrder S; S.init(S_ / 256, 1, 64, bid - 32);
                pg8::EpiBf16 E{W.Z + OFF_G, LDZ}; pg8::gemm_phase(lds, g, S, E); }
            else phase_postz(P, W, (bid - 96) * NWAVES + (tid >> 6), (G - 96) * NWAVES);
        } else {
            { pg8::GStd g{(const char*)W.XN, (const char*)(W.Win + (size_t)OFF_G * DM), DM, DM, DM / 64}; pg8::StaticOrder S; S.init(S_ / 256, 1, G, bid);
              pg8::EpiBf16 E{W.Z + OFF_G, LDZ}; pg8::gemm_phase(lds, g, S, E); }
            { pg8::GCmp g{(const char*)W.Z, (const char*)W.Wc1k, (const char*)W.Wc1v, 16 * LDZ, 4096, 64}; pg8::StaticOrder S; S.init(32, 1, G, bid);
              pg8::EpiCmpGelu E{W.H1, (const float*)(P.ws + WS_CBIAS)}; pg8::gemm_phase(lds, g, S, E); }
            phase_postz(P, W, gw, nw);
        }
        SEAM(2);
    }
    if (IN(3)) {
        PHASE_VARS
        {
            const size_t i0 = (size_t)bid * NTHREADS + tid, st = (size_t)G * NTHREADS, NG = (size_t)S_ * NGATE;
            for (size_t ib = i0; ib < NG; ib += 9 * st) { float zv[9];
#pragma unroll
                for (int k = 0; k < 9; ++k) { size_t i = ib + k * st; if (i >= NG) i = NG - 1; const int t = (int)(i / NGATE), c = (int)(i % NGATE); zv[k] = bf2f(W.Z[(size_t)t * LDZ + OFF_G + c]); }
#pragma unroll
                for (int k = 0; k < 9; ++k) { const size_t i = ib + k * st; if (i < NG) W.G[i] = sigmoidf_(zv[k]); } } }
        phase_cmpfin(P, W);
        { pg8::GPool g{(const char*)W.M, (const char*)W.Wpool, POOLW, 256, 4}; pg8::StaticOrder S; S.init(S_ / 256, 4, G, bid);
          pg8::EpiBf16Scale E{W.MIX, DM, P.pool_scale}; pg8::gemm_phase(lds, g, S, E); }
        SEAM(3);
    }
    if (IN(4)) {
        PHASE_VARS ATT_ARGS
        REP(4)
        for (int base = 0, rnd = 0; base < 1536; base += G, ++rnd) {
            int qt, g, hp;
            if (G == 256) { const int x = bid & 7, r = bid >> 3, qp = (rnd / 3) ? 63 - r : r; if (rnd >= 6) break; g = x & 3; qt = 2 * qp + (x >> 2); hp = rnd % 3; }
            else { const int Lu = base + ((rnd & 1) ? G - 1 - bid : bid); if (Lu >= 1536) continue; qt = Lu / 12; const int rem = Lu % 12; g = rem / 3; hp = rem % 3; }
            att::attn_unit<att::MODE_CMP>(AA, (LAS char*)lds, qt, g, hp);
            asm volatile("s_waitcnt vmcnt(0)" ::: "memory");
            att::attn_unit<att::MODE_WIN>(AA, (LAS char*)lds, qt, g, hp);
            if (G == 256 && hp == 2) {
                asm volatile("s_waitcnt vmcnt(0)" ::: "memory");
                const int tqi = qt * 8 + (tid >> 6);
                att::imp_task(AA, W.IMPP, W.IMPF, tqi, g);
                asm volatile("s_waitcnt vmcnt(0)" ::: "memory");
                f32x4 pp, ff, pn, fn; att::topk_load(W.IMPP, W.IMPF, tqi * 16, g, pp, ff);
                for (int q = 0; q < 16; ++q) { att::topk_load(W.IMPP, W.IMPF, tqi * 16 + (q < 15 ? q + 1 : q), g, pn, fn); att::topk_task(pp, ff, W.BM, tqi * 16 + q, g); pp = pn; ff = fn; } } }
        if (G != 256) SEAM(4);
    }
    if (IN(5)) {
        PHASE_VARS ATT_ARGS
        if (G != 256)
        for (int k = gw, r = 0; k < 4096; k += nw, ++r) { const int hiT = (r + 1) * nw < 4096 ? (r + 1) * nw : 4096;
            const int task = (r & 1) ? hiT - 1 - (k - r * nw) : k;
            att::imp_task(AA, W.IMPP, W.IMPF, task >> 2, task & 3);
            asm volatile("s_waitcnt vmcnt(0)" ::: "memory");
            { const int tb = (task >> 2) * 16, gg = task & 3; f32x4 pp, ff, pn, fn;
              att::topk_load(W.IMPP, W.IMPF, tb, gg, pp, ff);
              for (int q = 0; q < 16; ++q) { att::topk_load(W.IMPP, W.IMPF, tb + (q < 15 ? q + 1 : q), gg, pn, fn); att::topk_task(pp, ff, W.BM, tb + q, gg); pp = pn; ff = fn; } } }
        SEAM(5);
    }
    if (IN(6)) {
        PHASE_VARS ATT_ARGS
        REP(6)
        for (int base = 0, rnd = 0; base < 1640 + G; base += G, ++rnd) {
            int ut, g;
            if (G == 256) { const int x = bid & 7, r = bid >> 3, k = rnd * 32 + ((rnd & 1) ? 31 - r : r); if (k >= 205) break; g = x & 3; ut = 409 - (2 * k + (x >> 2)); }
            else { const int Lu = base + ((rnd & 1) ? G - 1 - bid : bid); if (Lu >= 1640) continue; ut = 409 - Lu / 4; g = Lu % 4; }
            att::attn_unit<att::MODE_SLC>(AA, (LAS char*)lds, ut, g, 0); }
        SEAM(6);
    }
    if (IN(7)) {
        PHASE_VARS
        { pg8::GStd g{(const char*)W.MIX, (const char*)W.Wo, DM, DM, DM / 64}; pg8::StaticOrder S; S.init(S_ / 256, DM / 256, G, bid);
          pg8::EpiResNorm E{P.x, P.out, W.XN, P.norm2_w, (float*)(P.ws + WS_SSQ1), DM}; pg8::gemm_phase(lds, g, S, E); }
        { pg8::GStd g{(const char*)W.PB, (const char*)W.Wple, PLE, PLE, PLE / 64}; pg8::StaticOrder S; S.init(S_ / 256, DM / 256, G, bid);
          pg8::EpiBf16Ssq E{W.ERAW, DM, (float*)(P.ws + WS_SSQ3)}; pg8::gemm_phase(lds, g, S, E); }
        SEAM(7);
    }
    if (IN(8)) {
        PHASE_VARS
        pg8::GFfn g{(const char*)W.XN, (const char*)W.Wfi, DM, DM, DM / 64}; pg8::StaticOrder S; S.init(65, DFF / 128, G, bid);
        pg8::EpiFfn E{W.ACT, P.conv_w, P.conv_b, (LAS float*)(lds + LDS_XCH), (const float*)(P.ws + WS_SSQ1)}; REP(8) { pg8::gemm_phase(lds, g, S, E); } SEAM(8);
    }
    if (IN(9)) {
        PHASE_VARS
        pg8::GStd g{(const char*)W.ACT, (const char*)W.Wfo, DFF, DFF, DFF / 64}; pg8::StaticOrder S; S.init(S_ / 256, DM / 256, G, bid);
        pg8::EpiResNormF8 E{P.out, P.out, W.XN, P.ple_gate_norm_w, (float*)(P.ws + WS_SSQ2), DM}; pg8::gemm_phase(lds, g, S, E); SEAM(9);
    }
    if (IN(10)) {
        PHASE_VARS
        pg8::GStd g{(const char*)W.XN, (const char*)W.Wg, DM / 2, DM / 2, DM / 128}; pg8::StaticOrder S; S.init(S_ / 256, DM / 256, G, bid);
        pg8::EpiGate E{P.out, W.ERAW, (const float*)(P.ws + WS_SSQ3), P.ple_norm_w, (const float*)(P.ws + WS_SSQ2), DM, 1.0f / WG8_SCALE};
        pg8::gemm_phase<pg8::GStd, pg8::EpiGate, true>(lds, g, S, E);
    }
#undef IN
#undef SEAM
}

extern "C" void kernel_launch(void* const* d_in, const int* in_sizes, int n_in, void* d_out, int out_size, void* d_ws, size_t ws_size, hipStream_t stream) {
    static int grid = 0;
    if (grid == 0) {
        if (n_in != 27 || in_sizes[0] != S_ * DM || out_size != S_ * DM || ws_size < WS_NEED) {
            fprintf(stderr, "kernel_launch: unexpected shapes (n_in %d, in0 %d, out %d, ws %zu < %zu); nothing launched\n", n_in, n_in > 0 ? in_sizes[0] : -1, out_size, ws_size, (size_t)WS_NEED); grid = -1; return; }
        int dev = 0, cus = 0, per_cu = 0;
        if (hipGetDevice(&dev) != hipSuccess || hipDeviceGetAttribute(&cus, hipDeviceAttributeMultiprocessorCount, dev) != hipSuccess) { grid = -1; return; }
        if (hipFuncSetAttribute((const void*)fwd, hipFuncAttributeMaxDynamicSharedMemorySize, LDS_BYTES) != hipSuccess) { fprintf(stderr, "kernel_launch: hipFuncSetAttribute failed\n"); grid = -1; return; }
        if (hipOccupancyMaxActiveBlocksPerMultiprocessor(&per_cu, (const void*)fwd, NTHREADS, LDS_BYTES) != hipSuccess || per_cu < 1) { fprintf(stderr, "kernel_launch: occupancy query says %d\n", per_cu); (void)hipGetLastError(); }
        grid = cus > 256 ? 256 : cus;
    }
    if (grid < 0) return;
    (void)hipMemsetAsync((char*)d_ws + WS_CTL, 0, CTL_BYTES, stream);
    Params P{};
    const float** fp = (const float**)&P;
    P.x = (const float*)d_in[0]; P.p = (const float*)d_in[1]; P.positions = (const int*)d_in[2]; P.norm1_w = (const float*)d_in[3]; P.w_in = (const float*)d_in[4];
    P.w_pool = (const float*)d_in[5]; P.pool_scale = (const float*)d_in[6]; P.q_norm_w = (const float*)d_in[7]; P.k_norm_cmp_w = (const float*)d_in[8];
    P.k_norm_slc_w = (const float*)d_in[9]; P.k_norm_win_w = (const float*)d_in[10]; P.cmp_pos_k = (const float*)d_in[11]; P.cmp_pos_v = (const float*)d_in[12];
    P.cmp_k_w1 = (const float*)d_in[13]; P.cmp_k_w2 = (const float*)d_in[14]; P.cmp_v_w1 = (const float*)d_in[15]; P.cmp_v_w2 = (const float*)d_in[16];
    P.w_o = (const float*)d_in[17]; P.norm2_w = (const float*)d_in[18]; P.w_ffn_in = (const float*)d_in[19]; P.conv_w = (const float*)d_in[20]; P.conv_b = (const float*)d_in[21];
    P.w_ffn_out = (const float*)d_in[22]; P.w_ple_proj = (const float*)d_in[23]; P.ple_norm_w = (const float*)d_in[24]; P.ple_gate_norm_w = (const float*)d_in[25]; P.w_ple_gate = (const float*)d_in[26];
    (void)fp;
    P.out = (float*)d_out; P.ws = (unsigned char*)d_ws;
#if MK_ONE_LAUNCH
    P.ph_lo = 0; P.ph_hi = N_PHASES;
    hipLaunchKernelGGL(fwd, dim3(grid), dim3(NTHREADS), LDS_BYTES, stream, P);
#else
    for (int ph = 0; ph < N_PHASES; ++ph) { P.ph_lo = ph; P.ph_hi = ph + 1; hipLaunchKernelGGL(fwd, dim3(grid), dim3(NTHREADS), LDS_BYTES, stream, P); }
#endif
    const hipError_t le = hipPeekAtLastError();
    if (le != hipSuccess) fprintf(stderr, "kernel_launch: launch failed: %s\n", hipGetErrorName(le));
}
```

```cpp
#include <hip/hip_runtime.h>
#include <cstdio>
#include <cstdint>

#ifndef PROBE_DBL
#define PROBE_DBL 0
#endif
#define REP(k) _Pragma("unroll") for (int rep_ = 0; rep_ < 1 + ((PROBE_DBL >> (k)) & 1); ++rep_)
#ifndef SLC16
#define SLC16 1
#endif
#ifndef MK_ONE_LAUNCH
#define MK_ONE_LAUNCH 1
#endif

#define LAS __attribute__((address_space(3)))
typedef unsigned short bf16_t;
typedef short bf16x8 __attribute__((ext_vector_type(8)));
typedef short s16x4 __attribute__((ext_vector_type(4)));
typedef float f32x2 __attribute__((ext_vector_type(2)));
typedef float f32x4 __attribute__((ext_vector_type(4)));
typedef float f32x16 __attribute__((ext_vector_type(16)));
typedef unsigned u32x2 __attribute__((ext_vector_type(2)));
typedef unsigned u32x4 __attribute__((ext_vector_type(4)));
typedef int i32x4 __attribute__((ext_vector_type(4)));
typedef int i32x8 __attribute__((ext_vector_type(8)));

constexpr int S_ = 16384, DM = 4096, INW = 7240, LDZ = 7424, POOLW = 1024, NH = 24, NKV = 4, HPG = 6, HD = 128;
constexpr int OFF_Q = 1024, OFF_KV = 4096, OFF_G = 7168, DFF = 11008, NFI = 22016, PLE = 256, NGATE = 72;
constexpr int ZROWS = S_ + 64, XNROWS = S_ + 256, CHUNK = 8192;
constexpr float EPS = 1e-6f;
constexpr float SM_C = 0.08838834764831845f * 1.4426950408889634f;
constexpr int NWAVES = 8, NTHREADS = 512;
constexpr float WG8_SCALE = 128.0f;

constexpr size_t al256(size_t x) { return (x + 255) / 256 * 256; }
constexpr size_t WS_CTL   = 0;
constexpr size_t CTL_BYTES = 262144;
constexpr size_t WS_CBIAS = WS_CTL + 32768;
constexpr size_t WS_SSQ1 = WS_CTL + 65536, WS_SSQ2 = WS_CTL + 131072, WS_SSQ3 = WS_CTL + 196608;
constexpr size_t WS_WIN   = WS_CTL + CTL_BYTES;
constexpr size_t WS_WO    = WS_WIN + al256((size_t)LDZ * DM * 2);
constexpr size_t WS_WFI   = WS_WO + al256((size_t)DM * DM * 2);
constexpr size_t WS_WFO   = WS_WFI + al256((size_t)NFI * DM * 2);
constexpr size_t WS_WG    = WS_WFO + al256((size_t)DM * DFF * 2);
constexpr size_t WS_WPLE  = WS_WG + al256((size_t)DM * DM * 2);
constexpr size_t WS_WPOOL = WS_WPLE + al256((size_t)DM * PLE * 2);
constexpr size_t WS_WC1K  = WS_WPOOL + al256((size_t)1024 * 256 * 2);
constexpr size_t WS_WC1V  = WS_WC1K + al256((size_t)256 * 4096 * 2);
constexpr size_t WS_COS   = WS_WC1V + al256((size_t)256 * 4096 * 2);
constexpr size_t WS_SIN   = WS_COS + al256((size_t)S_ * 16 * 4);
constexpr size_t WS_TAB   = WS_SIN + al256((size_t)S_ * 16 * 4);
constexpr size_t WS_XNP   = WS_TAB + 4096;
constexpr size_t WS_XN    = WS_XNP + (size_t)2 * DM * 2;
constexpr size_t WS_PB    = WS_XN + al256((size_t)XNROWS * DM * 2);
constexpr size_t WS_XN8   = WS_PB + al256((size_t)S_ * PLE * 2);
constexpr size_t WS_WIN8  = WS_XN8 + al256((size_t)S_ * DM);
constexpr size_t WS_R     = WS_WIN8 + al256((size_t)(OFF_G - POOLW) * DM);
constexpr size_t WS_Z     = WS_R;
constexpr size_t WS_M     = WS_Z + al256((size_t)ZROWS * LDZ * 2);
constexpr size_t WS_G     = WS_M + al256((size_t)S_ * POOLW * 2);
constexpr size_t WS_H1    = WS_G + al256((size_t)S_ * NGATE * 4);
constexpr size_t WS_KC    = WS_H1 + al256((size_t)8192 * 256 * 4);
constexpr size_t WS_VC    = WS_KC + al256((size_t)4 * 1024 * 128 * 2);
constexpr size_t WS_L     = WS_VC + al256((size_t)4 * 1024 * 128 * 2);
constexpr size_t WS_OACC  = WS_L + al256((size_t)S_ * NH * 4);
constexpr size_t WS_IMPP  = WS_OACC + al256((size_t)S_ * 3072 * 4);
constexpr size_t WS_IMPF  = WS_IMPP + al256((size_t)S_ * 4 * 256 * 4);
constexpr size_t WS_BM    = WS_IMPF + al256((size_t)S_ * 4 * 256 * 4);
constexpr size_t WS_MIX   = WS_BM + al256((size_t)S_ * 4 * 8 * 4);
constexpr size_t WS_END_A = WS_MIX + al256((size_t)S_ * DM * 2);
constexpr size_t WS_ERAW  = WS_R;
constexpr size_t WS_ACT   = WS_ERAW + al256((size_t)S_ * DM * 2);
constexpr size_t WS_ERSTD = WS_ACT + al256((size_t)S_ * DFF * 2);
constexpr size_t WS_END_B = WS_ERSTD + al256((size_t)S_ * 4);
static_assert(WS_ERAW + (size_t)S_ * DM * 2 <= WS_Z + (size_t)ZROWS * LDZ * 2, "eraw must fit inside the dead z region while mix is still being read");
constexpr size_t WS_NEED  = WS_END_A > WS_END_B ? WS_END_A : WS_END_B;
static_assert(WS_NEED <= (size_t)1440000000, "workspace map exceeds the guaranteed 4 x largest-tensor bytes");

constexpr int LDS_STAGE = 131072;
constexpr int LDS_XCH   = LDS_STAGE + 64;
constexpr int LDS_MISC  = 147456;
constexpr int LDS_BYTES = LDS_MISC + 64;

__device__ __forceinline__ unsigned cvt_pk_bf16(float lo, float hi) { unsigned r; asm volatile("v_cvt_pk_bf16_f32 %0, %1, %2" : "=v"(r) : "v"(lo), "v"(hi)); return r; }
__device__ __forceinline__ float bf_lo(unsigned u) { return __uint_as_float(u << 16); }
__device__ __forceinline__ float bf_hi(unsigned u) { return __uint_as_float(u & 0xffff0000u); }
__device__ __forceinline__ float bf2f(bf16_t b) { return __uint_as_float(((unsigned)b) << 16); }
__device__ __forceinline__ float wave_sum(float v) {
#pragma unroll
    for (int o = 32; o >= 1; o >>= 1) v += __shfl_xor(v, o);
    return v;
}
__device__ __forceinline__ float wave_max(float v) {
#pragma unroll
    for (int o = 32; o >= 1; o >>= 1) v = fmaxf(v, __shfl_xor(v, o));
    return v;
}
__device__ __forceinline__ float sigmoidf_(float x) { return __builtin_amdgcn_rcpf(1.0f + __expf(-x)); }

#define XB_TMO      128
#define XB_XCNT(j)  (256  + 64 * (j))
#define XB_XSUB(j)  (1280 + 64 * (j))
#define XB_XGEN(j)  (2304 + 64 * (j))
#define XB_TOP      3328
#define XB_TOPGEN   3392
#define XCD_BAR_WORDS 3456
#define XB_SPIN_CAP (1u << 18)
__device__ __forceinline__ unsigned xb_ld(unsigned* p)              { return __hip_atomic_load(p, __ATOMIC_RELAXED, __HIP_MEMORY_SCOPE_AGENT); }
__device__ __forceinline__ unsigned xb_add(unsigned* p, unsigned v) { return __hip_atomic_fetch_add(p, v, __ATOMIC_RELAXED, __HIP_MEMORY_SCOPE_AGENT); }
__device__ __forceinline__ unsigned xb_xcc_id() { return (unsigned)__builtin_amdgcn_s_getreg((3 << 11) | 20) & 0xFu; }
#define XB_SPIN(cond, bar) do { unsigned _sp = 0; while (cond) { __builtin_amdgcn_s_sleep(1); \
    if ((++_sp & 255u) == 0u) { if (xb_ld(&(bar)[XB_TMO])) break; if (_sp > XB_SPIN_CAP) { atomicAdd(&(bar)[XB_TMO], 1u); break; } } } } while (0)
struct XcdBarrier { unsigned* bar; unsigned x; volatile LAS unsigned* st; };
__device__ __forceinline__ XcdBarrier xcd_barrier_post(unsigned* bar, volatile LAS unsigned* st) {
    XcdBarrier b; b.bar = bar; b.x = xb_xcc_id(); b.st = st;
    if (threadIdx.x == 0) (void)xb_add(&bar[XB_XCNT(b.x)], 1u);
    return b;
}
__device__ __forceinline__ void xcd_barrier_complete(unsigned* bar, unsigned x, unsigned& nloc, unsigned& nx) {
    const unsigned G = gridDim.x * gridDim.y * gridDim.z;
    unsigned sum, cnt, mine, sp = 0u;
    for (;;) {
        sum = 0u; cnt = 0u; mine = 0u;
#pragma unroll
        for (unsigned j = 0; j < 16; ++j) { const unsigned c = xb_ld(&bar[XB_XCNT(j)]); sum += c; cnt += (c > 0u) ? 1u : 0u; mine = (j == x) ? c : mine; }
        if (sum == G) break;
        __builtin_amdgcn_s_sleep(1);
        if ((++sp & 255u) == 0u) { if (xb_ld(&bar[XB_TMO])) break; if (sp > XB_SPIN_CAP) { atomicAdd(&bar[XB_TMO], 1u); break; } }
    }
    nloc = mine > 0u ? mine : 1u; nx = cnt > 0u ? cnt : 1u;
}
__device__ __forceinline__ void xcd_barrier(const XcdBarrier& b) {
    asm volatile("s_waitcnt vmcnt(0)" ::: "memory");
    __syncthreads();
    if (threadIdx.x == 0) {
        unsigned* bar = b.bar;
        __builtin_amdgcn_s_waitcnt(0);
        unsigned nloc = b.st[0], nx = b.st[1];
        if (nloc == 0u) { xcd_barrier_complete(bar, b.x, nloc, nx); b.st[0] = nloc; b.st[1] = nx; }
        const unsigned old = xb_add(&bar[XB_XSUB(b.x)], 1u);
        const unsigned gen = old / nloc;
        if (old + 1u == (gen + 1u) * nloc) {
            __builtin_amdgcn_fence(__ATOMIC_RELEASE, "agent");
            asm volatile("s_waitcnt vmcnt(0)" ::: "memory");
            const unsigned og = xb_add(&bar[XB_TOP], 1u);
            const unsigned tg = og / nx;
            if (og + 1u == (tg + 1u) * nx) xb_add(&bar[XB_TOPGEN], 1u);
            else XB_SPIN(xb_ld(&bar[XB_TOPGEN]) == tg, bar);
            __builtin_amdgcn_fence(__ATOMIC_ACQUIRE, "agent");
            xb_add(&bar[XB_XGEN(b.x)], 1u);
            asm volatile("s_waitcnt vmcnt(0)" ::: "memory");
        } else {
            XB_SPIN(xb_ld(&bar[XB_XGEN(b.x)]) == gen, bar);
            __builtin_amdgcn_fence(__ATOMIC_ACQUIRE, "agent");
            asm volatile("s_waitcnt vmcnt(0)" ::: "memory");
        }
    }
    __syncthreads();
}

struct Params {
    const float* x; const float* p; const int* positions; const float* norm1_w; const float* w_in; const float* w_pool; const float* pool_scale;
    const float* q_norm_w; const float* k_norm_cmp_w; const float* k_norm_slc_w; const float* k_norm_win_w; const float* cmp_pos_k; const float* cmp_pos_v;
    const float* cmp_k_w1; const float* cmp_k_w2; const float* cmp_v_w1; const float* cmp_v_w2; const float* w_o; const float* norm2_w; const float* w_ffn_in;
    const float* conv_w; const float* conv_b; const float* w_ffn_out; const float* w_ple_proj; const float* ple_norm_w; const float* ple_gate_norm_w; const float* w_ple_gate;
    float* out; unsigned char* ws; int ph_lo, ph_hi;
};

namespace pg8 {
constexpr int BM = 256, BK = 64, HALF = 128, HTB = HALF * BK * 2, STAGE_BYTES = 8 * HTB, NXCD = 8, WGM = 8;
__host__ __device__ __forceinline__ int lds_byte(int r, int c) { const int st = (r >> 4) * 2 + (c >> 5), rr = r & 15, cc = c & 31, ob = rr * 64 + cc * 2; return st * 1024 + (ob ^ (((ob >> 9) & 1) << 5)); }
__host__ __device__ __forceinline__ void stage_rc(int b, int& R, int& C) { const int st = b / 1024, sb = b % 1024, swz = sb ^ (((sb >> 9) & 1) << 5); R = (st >> 1) * 16 + swz / 64; C = (st & 1) * 32 + (swz % 64) / 2; }
__host__ __device__ __forceinline__ int perm32(int rho) { const int n = rho >> 4, i = rho & 15; return 8 * (i >> 2) + 4 * n + (i & 3); }
struct Unit { int pm, pn; };

struct StaticOrder {
    int nM, nN, nwg, G, c;
    __device__ void init(int nM_, int nN_, int G_, int c_) { nM = nM_; nN = nN_; nwg = nM * nN; G = G_; c = c_; }
    __device__ bool next(int i, Unit& u) const {
        const long L = (long)i * G + c; if (L >= nwg) return false;
        int wgid = (int)L; { const int q = nwg / NXCD, r = nwg % NXCD, xcd = wgid % NXCD, off = wgid / NXCD; wgid = (xcd < r ? xcd * (q + 1) : r * (q + 1) + (xcd - r) * q) + off; }
        const int nig = WGM * nN, gid = wgid / nig, fm = gid * WGM, gsz = (nM - fm) < WGM ? (nM - fm) : WGM;
        u.pm = fm + ((wgid % nig) % gsz); u.pn = (wgid % nig) / gsz; return true;
    }
};

struct GStd {
    const char* A; const char* B; unsigned lda, ldb; int nt;
    __device__ __forceinline__ const char* a_base(const Unit& u) const { return A + (size_t)u.pm * 256 * lda * 2; }
    __device__ __forceinline__ const char* b_base(const Unit& u) const { return B + (size_t)u.pn * 256 * ldb * 2; }
    __device__ __forceinline__ size_t kpairA() const { return 256; }
};
struct GPool {
    const char* A; const char* B; unsigned lda, ldb; int nt;
    __device__ __forceinline__ const char* a_base(const Unit& u) const { return A + (size_t)u.pm * 256 * lda * 2 + (size_t)u.pn * 512; }
    __device__ __forceinline__ const char* b_base(const Unit& u) const { return B + (size_t)u.pn * 256 * ldb * 2; }
    __device__ __forceinline__ size_t kpairA() const { return 256; }
};
struct GCmp {
    const char* Z; const char* Bk; const char* Bv; unsigned lda, ldb; int nt;
    __device__ __forceinline__ const char* a_base(const Unit& u) const { const int which = u.pm >> 4, g = (u.pm >> 2) & 3, rt = u.pm & 3;
        return Z + (size_t)(OFF_KV + which * 512 + g * 128) * 2 + (size_t)rt * 256 * lda * 2; }
    __device__ __forceinline__ const char* b_base(const Unit& u) const { return (u.pm >> 4) ? Bv : Bk; }
    __device__ __forceinline__ size_t kpairA() const { return (size_t)LDZ * 2; }
};

struct EpiBf16 {
    static constexpr bool PERM = true;
    bf16_t* O; int ldc;
    __device__ __forceinline__ void operator()(const f32x4 (&acc)[2][2][4][2], const Unit& u, int wr, int wc, int fr, int fq) const {
        const int row0 = u.pm * BM + wr * 64 + fr, col0 = u.pn * BM + wc * 32 + 8 * fq;
#pragma unroll
        for (int ai = 0; ai < 2; ++ai)
#pragma unroll
            for (int m = 0; m < 4; ++m) { bf16_t* rowp = O + (size_t)(row0 + ai * HALF + m * 16) * ldc + col0;
#pragma unroll
                for (int bj = 0; bj < 2; ++bj) { const f32x4 v0 = acc[ai][bj][m][0], v1 = acc[ai][bj][m][1];
                    u32x4 w; w.x = cvt_pk_bf16(v0[0], v0[1]); w.y = cvt_pk_bf16(v0[2], v0[3]); w.z = cvt_pk_bf16(v1[0], v1[1]); w.w = cvt_pk_bf16(v1[2], v1[3]);
                    *(u32x4*)(rowp + bj * HALF) = w; } }
    }
};
struct EpiBf16S {
    static constexpr bool PERM = true;
    bf16_t* O; int ldc; float s;
    __device__ __forceinline__ void operator()(const f32x4 (&acc)[2][2][4][2], const Unit& u, int wr, int wc, int fr, int fq) const {
        const int row0 = u.pm * BM + wr * 64 + fr, col0 = u.pn * BM + wc * 32 + 8 * fq;
#pragma unroll
        for (int ai = 0; ai < 2; ++ai)
#pragma unroll
            for (int m = 0; m < 4; ++m) { bf16_t* rowp = O + (size_t)(row0 + ai * HALF + m * 16) * ldc + col0;
#pragma unroll
                for (int bj = 0; bj < 2; ++bj) { const f32x4 v0 = acc[ai][bj][m][0] * s, v1 = acc[ai][bj][m][1] * s;
                    u32x4 w; w.x = cvt_pk_bf16(v0[0], v0[1]); w.y = cvt_pk_bf16(v0[2], v0[3]); w.z = cvt_pk_bf16(v1[0], v1[1]); w.w = cvt_pk_bf16(v1[2], v1[3]);
                    *(u32x4*)(rowp + bj * HALF) = w; } }
    }
};
struct EpiBf16Ssq {
    static constexpr bool PERM = true;
    bf16_t* O; int ldc; float* ssq;
    __device__ __forceinline__ void operator()(const f32x4 (&acc)[2][2][4][2], const Unit& u, int wr, int wc, int fr, int fq) const {
        const int row0 = u.pm * BM + wr * 64 + fr, col0 = u.pn * BM + wc * 32 + 8 * fq;
#pragma unroll
        for (int ai = 0; ai < 2; ++ai)
#pragma unroll
            for (int m = 0; m < 4; ++m) { const int row = row0 + ai * HALF + m * 16; bf16_t* rowp = O + (size_t)row * ldc + col0; float s = 0.f;
#pragma unroll
                for (int bj = 0; bj < 2; ++bj) { const f32x4 v0 = acc[ai][bj][m][0], v1 = acc[ai][bj][m][1];
                    s += v0[0] * v0[0] + v0[1] * v0[1] + v0[2] * v0[2] + v0[3] * v0[3] + v1[0] * v1[0] + v1[1] * v1[1] + v1[2] * v1[2] + v1[3] * v1[3];
                    u32x4 w; w.x = cvt_pk_bf16(v0[0], v0[1]); w.y = cvt_pk_bf16(v0[2], v0[3]); w.z = cvt_pk_bf16(v1[0], v1[1]); w.w = cvt_pk_bf16(v1[2], v1[3]);
                    *(u32x4*)(rowp + bj * HALF) = w; }
                s += __shfl_xor(s, 16); s += __shfl_xor(s, 32);
                if (fq == 0) unsafeAtomicAdd(ssq + row, s); }
    }
};
struct EpiBf16Scale {
    static constexpr bool PERM = true;
    bf16_t* O; int ldc; const float* colscale;
    __device__ __forceinline__ void operator()(const f32x4 (&acc)[2][2][4][2], const Unit& u, int wr, int wc, int fr, int fq) const {
        const int row0 = u.pm * BM + wr * 64 + fr, col0 = u.pn * BM + wc * 32 + 8 * fq;
#pragma unroll
        for (int bj = 0; bj < 2; ++bj) { const f32x4 s0 = *(const f32x4*)(colscale + col0 + bj * HALF), s1 = *(const f32x4*)(colscale + col0 + bj * HALF + 4);
#pragma unroll
            for (int ai = 0; ai < 2; ++ai)
#pragma unroll
                for (int m = 0; m < 4; ++m) { bf16_t* rowp = O + (size_t)(row0 + ai * HALF + m * 16) * ldc + col0;
                    const f32x4 v0 = acc[ai][bj][m][0] * s0, v1 = acc[ai][bj][m][1] * s1;
                    u32x4 w; w.x = cvt_pk_bf16(v0[0], v0[1]); w.y = cvt_pk_bf16(v0[2], v0[3]); w.z = cvt_pk_bf16(v1[0], v1[1]); w.w = cvt_pk_bf16(v1[2], v1[3]);
                    *(u32x4*)(rowp + bj * HALF) = w; } }
    }
};
struct EpiResF32 {
    static constexpr bool PERM = false;
    const float* base; float* C; int ldc; int row_off;
    __device__ __forceinline__ void operator()(const f32x4 (&acc)[2][2][4][2], const Unit& u, int wr, int wc, int fr, int fq) const {
        const int row0 = u.pm * BM + wr * 64 + fr + row_off, col0 = u.pn * BM + wc * 32 + 4 * fq;
#pragma unroll
        for (int ai = 0; ai < 2; ++ai)
#pragma unroll
            for (int m = 0; m < 4; ++m) { const size_t off = (size_t)(row0 + ai * HALF + m * 16) * ldc + col0;
#pragma unroll
                for (int bj = 0; bj < 2; ++bj)
#pragma unroll
                    for (int n = 0; n < 2; ++n) { const f32x4 b = *(const f32x4*)(base + off + bj * HALF + n * 16); *(f32x4*)(C + off + bj * HALF + n * 16) = b + acc[ai][bj][m][n]; }
                asm volatile("" ::: "memory"); }
    }
};
template <bool FP8OUT>
struct EpiResNormT {
    static constexpr bool PERM = false;
    const float* base; float* C; bf16_t* XN; const float* nw; float* ssq; int ldc;
    __device__ __forceinline__ void operator()(const f32x4 (&acc)[2][2][4][2], const Unit& u, int wr, int wc, int fr, int fq) const {
        const int row0 = u.pm * BM + wr * 64 + fr, col0 = u.pn * BM + wc * 32 + 4 * fq;
        f32x4 wv[2][2];
#pragma unroll
        for (int bj = 0; bj < 2; ++bj)
#pragma unroll
            for (int n = 0; n < 2; ++n) wv[bj][n] = *(const f32x4*)(nw + col0 + bj * HALF + n * 16);
        f32x4 bv[2][2][2];
#pragma unroll
        for (int bj = 0; bj < 2; ++bj)
#pragma unroll
            for (int n = 0; n < 2; ++n) bv[0][bj][n] = *(const f32x4*)(base + (size_t)row0 * ldc + col0 + bj * HALF + n * 16);
#pragma unroll
        for (int rg = 0; rg < 8; ++rg) { const int ai = rg >> 2, m = rg & 3; const int row = row0 + ai * HALF + m * 16; const size_t off = (size_t)row * ldc + col0;
            if (rg < 7) { const int ai2 = (rg + 1) >> 2, m2 = (rg + 1) & 3; const size_t off2 = (size_t)(row0 + ai2 * HALF + m2 * 16) * ldc + col0;
#pragma unroll
                for (int bj = 0; bj < 2; ++bj)
#pragma unroll
                    for (int n = 0; n < 2; ++n) bv[(rg + 1) & 1][bj][n] = *(const f32x4*)(base + off2 + bj * HALF + n * 16); }
            float s = 0.f;
#pragma unroll
            for (int bj = 0; bj < 2; ++bj)
#pragma unroll
                for (int n = 0; n < 2; ++n) { const f32x4 v = bv[rg & 1][bj][n] + acc[ai][bj][m][n];
                    *(f32x4*)(C + off + bj * HALF + n * 16) = v; s += v[0] * v[0] + v[1] * v[1] + v[2] * v[2] + v[3] * v[3];
                    if (FP8OUT) { int pk = __builtin_amdgcn_cvt_pk_fp8_f32(v[0] * wv[bj][n][0], v[1] * wv[bj][n][1], 0, false); pk = __builtin_amdgcn_cvt_pk_fp8_f32(v[2] * wv[bj][n][2], v[3] * wv[bj][n][3], pk, true);
                        *(int*)((unsigned char*)XN + off + bj * HALF + n * 16) = pk; }
                    else { u32x2 o; o.x = cvt_pk_bf16(v[0] * wv[bj][n][0], v[1] * wv[bj][n][1]); o.y = cvt_pk_bf16(v[2] * wv[bj][n][2], v[3] * wv[bj][n][3]);
                        *(u32x2*)(XN + off + bj * HALF + n * 16) = o; } }
            s += __shfl_xor(s, 16); s += __shfl_xor(s, 32);
            if (fq == 0) unsafeAtomicAdd(ssq + row, s);
        }
    }
};
typedef EpiResNormT<false> EpiResNorm;
typedef EpiResNormT<true> EpiResNormF8;
struct EpiCmpGelu {
    static constexpr bool PERM = false;
    float* H; const float* bias;
    __device__ __forceinline__ void operator()(const f32x4 (&acc)[2][2][4][2], const Unit& u, int wr, int wc, int fr, int fq) const {
        const int row0 = u.pm * BM + wr * 64 + fr, col0 = wc * 32 + 4 * fq; const float* bs = bias + (u.pm >> 4) * 256;
        f32x4 bvv[2][2];
#pragma unroll
        for (int bj = 0; bj < 2; ++bj)
#pragma unroll
            for (int n = 0; n < 2; ++n) bvv[bj][n] = *(const f32x4*)(bs + col0 + bj * HALF + n * 16);
#pragma unroll
        for (int ai = 0; ai < 2; ++ai)
#pragma unroll
            for (int m = 0; m < 4; ++m) { float* rowp = H + (size_t)(row0 + ai * HALF + m * 16) * 256 + col0;
#pragma unroll
                for (int bj = 0; bj < 2; ++bj)
#pragma unroll
                    for (int n = 0; n < 2; ++n) { f32x4 v = acc[ai][bj][m][n] + bvv[bj][n];
#pragma unroll
                        for (int j = 0; j < 4; ++j) { const float xx = v[j], uu = 0.7978845608028654f * (xx + 0.044715f * xx * xx * xx); const float th = 1.0f - 2.0f / (1.0f + __expf(2.0f * uu)); v[j] = 0.5f * xx * (1.0f + th); }
                        *(f32x4*)(rowp + bj * HALF + n * 16) = v; } }
    }
};
struct EpiGate {
    static constexpr bool PERM = false;
    float* C; const bf16_t* eraw; const float* erstd; const float* pw; const float* ssq; int ldc; float ascale;
    __device__ __forceinline__ void operator()(const f32x4 (&acc)[2][2][4][2], const Unit& u, int wr, int wc, int fr, int fq) const {
        const int row0 = u.pm * BM + wr * 64 + fr, col0 = u.pn * BM + wc * 32 + 4 * fq;
        f32x4 wv[2][2];
#pragma unroll
        for (int bj = 0; bj < 2; ++bj)
#pragma unroll
            for (int n = 0; n < 2; ++n) wv[bj][n] = *(const f32x4*)(pw + col0 + bj * HALF + n * 16);
        f32x4 bv[2][2][2]; u32x2 ev[2][2][2]; float rsv[2], rgv[2];
#pragma unroll
        for (int bj = 0; bj < 2; ++bj)
#pragma unroll
            for (int n = 0; n < 2; ++n) { bv[0][bj][n] = *(const f32x4*)(C + (size_t)row0 * ldc + col0 + bj * HALF + n * 16); ev[0][bj][n] = *(const u32x2*)(eraw + (size_t)row0 * ldc + col0 + bj * HALF + n * 16); }
        rsv[0] = erstd[row0]; rgv[0] = ssq[row0];
#pragma unroll
        for (int rg = 0; rg < 8; ++rg) { const int ai = rg >> 2, m = rg & 3; const int row = row0 + ai * HALF + m * 16; const size_t off = (size_t)row * ldc + col0;
            if (rg < 7) { const int ai2 = (rg + 1) >> 2, m2 = (rg + 1) & 3; const int row2 = row0 + ai2 * HALF + m2 * 16; const size_t off2 = (size_t)row2 * ldc + col0;
#pragma unroll
                for (int bj = 0; bj < 2; ++bj)
#pragma unroll
                    for (int n = 0; n < 2; ++n) { bv[(rg + 1) & 1][bj][n] = *(const f32x4*)(C + off2 + bj * HALF + n * 16); ev[(rg + 1) & 1][bj][n] = *(const u32x2*)(eraw + off2 + bj * HALF + n * 16); }
                rsv[(rg + 1) & 1] = erstd[row2]; rgv[(rg + 1) & 1] = ssq[row2]; }
            const float rs = rsqrtf(rsv[rg & 1] * (1.0f / DM) + EPS), rg_ = rsqrtf(rgv[rg & 1] * (1.0f / DM) + EPS) * ascale;
#pragma unroll
            for (int bj = 0; bj < 2; ++bj)
#pragma unroll
                for (int n = 0; n < 2; ++n) { const f32x4 b = bv[rg & 1][bj][n]; const u32x2 e = ev[rg & 1][bj][n]; const f32x4 a = acc[ai][bj][m][n]; f32x4 o;
                    o[0] = b[0] + bf_lo(e.x) * rs * wv[bj][n][0] * sigmoidf_(a[0] * rg_); o[1] = b[1] + bf_hi(e.x) * rs * wv[bj][n][1] * sigmoidf_(a[1] * rg_);
                    o[2] = b[2] + bf_lo(e.y) * rs * wv[bj][n][2] * sigmoidf_(a[2] * rg_); o[3] = b[3] + bf_hi(e.y) * rs * wv[bj][n][3] * sigmoidf_(a[3] * rg_);
                    *(f32x4*)(C + off + bj * HALF + n * 16) = o; }
        }
    }
};
struct GFfn {
    const char* A; const char* B; unsigned lda, ldb; int nt;
    __device__ __forceinline__ const char* a_base(const Unit& u) const { return A + ((long)u.pm * 254 - 2) * (long)lda * 2; }
    __device__ __forceinline__ const char* b_base(const Unit& u) const { return B + (size_t)u.pn * 256 * ldb * 2; }
    __device__ __forceinline__ size_t kpairA() const { return 256; }
};
template <int CTRL> __device__ __forceinline__ float dpp_f(float v) { return __int_as_float(__builtin_amdgcn_update_dpp(0, __float_as_int(v), CTRL, 0xf, 0xf, false)); }
struct EpiFfn {
    static constexpr bool PERM = true;
    bf16_t* ACT; const float* cw; const float* cb; LAS float* X; const float* ssq;
    __device__ __forceinline__ void operator()(const f32x4 (&acc)[2][2][4][2], const Unit& u, int wr, int wc, int fr, int fq) const {
        const int colw = wc * 32 + 8 * fq;
        const int f0 = u.pn * 128 + colw;
        f32x4 w0[2], w1[2], w2[2], cbv[2];
#pragma unroll
        for (int n = 0; n < 2; ++n) { w0[n] = *(const f32x4*)(cw + f0 + 4 * n); w1[n] = *(const f32x4*)(cw + DFF + f0 + 4 * n); w2[n] = *(const f32x4*)(cw + 2 * DFF + f0 + 4 * n); cbv[n] = *(const f32x4*)(cb + f0 + 4 * n); }
        float rsv[2][4];
#pragma unroll
        for (int ai = 0; ai < 2; ++ai)
#pragma unroll
            for (int m = 0; m < 4; ++m) { const long t = (long)u.pm * 254 - 2 + ai * HALF + wr * 64 + m * 16 + fr; rsv[ai][m] = ssq[t < 0 ? 0 : (t >= S_ ? S_ - 1 : t)]; }
#pragma unroll
        for (int ai = 0; ai < 2; ++ai)
#pragma unroll
            for (int m = 0; m < 4; ++m) { const long t = (long)u.pm * 254 - 2 + ai * HALF + wr * 64 + m * 16 + fr; rsv[ai][m] = (t >= 0 && t < S_) ? rsqrtf(rsv[ai][m] * (1.0f / DM) + EPS) : 0.f; }
        if (fr >= 14) {
#pragma unroll
            for (int ai = 0; ai < 2; ++ai)
#pragma unroll
                for (int n = 0; n < 2; ++n) *(LAS f32x4*)(X + ((2 * ai + wr) * 2 + (fr - 14)) * 128 + colw + 4 * n) = acc[ai][0][3][n] * rsv[ai][3];
        }
        asm volatile("s_waitcnt lgkmcnt(0)" ::: "memory");
        __builtin_amdgcn_s_barrier(); asm volatile("" ::: "memory");
        __builtin_amdgcn_s_barrier(); asm volatile("" ::: "memory");
        const bool sel1 = fr == 15, sel2 = fr >= 14;
#pragma unroll
        for (int ai = 0; ai < 2; ++ai) {
            f32x4 pv[2];
            const int pseg = 2 * ai + wr - 1;
#pragma unroll
            for (int n = 0; n < 2; ++n) { pv[n] = (f32x4){0.f, 0.f, 0.f, 0.f}; if (pseg >= 0 && fr >= 14) pv[n] = *(const LAS f32x4*)(X + (pseg * 2 + (fr - 14)) * 128 + colw + 4 * n); }
#pragma unroll
            for (int m = 0; m < 4; ++m) {
                const int r = ai * HALF + wr * 64 + m * 16 + fr; const long t = (long)u.pm * 254 - 2 + r;
                unsigned ow[4];
#pragma unroll
                for (int n = 0; n < 2; ++n) {
                    const f32x4 cur = acc[ai][0][m][n] * rsv[ai][m], up = acc[ai][1][m][n] * rsv[ai][m];
                    f32x4 x1, x2;
#pragma unroll
                    for (int i = 0; i < 4; ++i) { x1[i] = dpp_f<0x121>(sel1 ? pv[n][i] : cur[i]); x2[i] = dpp_f<0x122>(sel2 ? pv[n][i] : cur[i]); }
                    const f32x4 y = cbv[n] + w0[n] * x2 + w1[n] * x1 + w2[n] * cur;
                    f32x4 sg;
#pragma unroll
                    for (int i = 0; i < 4; ++i) sg[i] = sigmoidf_(y[i]);
                    const f32x4 o = y * sg * up;
                    ow[2 * n] = cvt_pk_bf16(o[0], o[1]); ow[2 * n + 1] = cvt_pk_bf16(o[2], o[3]);
                    pv[n] = cur;
                }
                if (r >= 2 && t < S_) *(u32x4*)(ACT + (size_t)t * DFF + f0) = (u32x4){ow[0], ow[1], ow[2], ow[3]};
            }
        }
    }
};

template <class GD, class Epi, bool F8 = false>
__device__ __forceinline__ void gemm_phase(LAS unsigned char* lds, const GD g, const StaticOrder& S, const Epi& E) {
    const int tid = threadIdx.x, wid = __builtin_amdgcn_readfirstlane(tid >> 6), lane = tid & 63, wr = wid >> 2, wc = wid & 3, fr = lane & 15, fq = lane >> 4;
    const int nt = g.nt;
    unsigned voffA[2], voffB[2];
#pragma unroll
    for (int i = 0; i < 2; ++i) { int R, C; stage_rc(tid * 16 + i * 8192, R, C); const int Rb = Epi::PERM ? ((R & ~31) + perm32(R & 31)) : R;
        voffA[i] = (unsigned)(R * g.lda + C) * 2u; voffB[i] = (unsigned)(Rb * g.ldb + C) * 2u; }
    const size_t kpA = g.kpairA();
    const size_t hstepA = (size_t)HALF * g.lda * 2, hstepB = (size_t)HALF * g.ldb * 2;
    const unsigned ldsw = (unsigned)wid * 1024u;
    const int aoff = lds_byte(wr * 64 + fr, fq * 8), boff = lds_byte(wc * 32 + fr, fq * 8);
#define PG8_SA(b, h) (((b) * 2 + (h)) * HTB)
#define PG8_SB(b, h) ((4 + (b) * 2 + (h)) * HTB)
#define PG8_STAGE(bufoff, gbase, voff) do { _Pragma("unroll") for (int _i = 0; _i < 2; ++_i) \
        __builtin_amdgcn_global_load_lds((const unsigned*)((const char*)(gbase) + (voff)[_i]), (LAS unsigned*)(lds + (bufoff) + ldsw + _i * 8192), 16, 0, 0); } while (0)
#define PG8_LDA(dst, b, h) do { if constexpr (F8) { _Pragma("unroll") for (int m = 0; m < 4; ++m) { const i32x4 lo_ = *(const LAS i32x4*)(lds + PG8_SA(b, h) + aoff + m * 2048), hi_ = *(const LAS i32x4*)(lds + PG8_SA(b, h) + aoff + m * 2048 + 1024); \
            dst##8[m] = __builtin_shufflevector(lo_, hi_, 0, 1, 2, 3, 4, 5, 6, 7); } } \
        else { _Pragma("unroll") for (int m = 0; m < 4; ++m) _Pragma("unroll") for (int k = 0; k < 2; ++k) dst[m][k] = *(const LAS bf16x8*)(lds + PG8_SA(b, h) + aoff + m * 2048 + k * 1024); } } while (0)
#define PG8_LDB(dst, b, h) do { if constexpr (F8) { _Pragma("unroll") for (int n = 0; n < 2; ++n) { const i32x4 lo_ = *(const LAS i32x4*)(lds + PG8_SB(b, h) + boff + n * 2048), hi_ = *(const LAS i32x4*)(lds + PG8_SB(b, h) + boff + n * 2048 + 1024); \
            dst##8[n] = __builtin_shufflevector(lo_, hi_, 0, 1, 2, 3, 4, 5, 6, 7); } } \
        else { _Pragma("unroll") for (int n = 0; n < 2; ++n) _Pragma("unroll") for (int k = 0; k < 2; ++k) dst[n][k] = *(const LAS bf16x8*)(lds + PG8_SB(b, h) + boff + n * 2048 + k * 1024); } } while (0)
#define PG8_MMA(ai, bj, At, Bt) do { __builtin_amdgcn_s_setprio(1); \
        if constexpr (F8) { _Pragma("unroll") for (int m = 0; m < 4; ++m) _Pragma("unroll") for (int n = 0; n < 2; ++n) \
            asm volatile("v_mfma_scale_f32_16x16x128_f8f6f4 %0, %1, %2, %0, %3, %3 op_sel_hi:[0,0,0]" : "+v"(acc[ai][bj][m][n]) : "v"(Bt##8[n]), "v"(At##8[m]), "v"(one_scale)); } \
        else { _Pragma("unroll") for (int m = 0; m < 4; ++m) _Pragma("unroll") for (int n = 0; n < 2; ++n) _Pragma("unroll") for (int k = 0; k < 2; ++k) \
            acc[ai][bj][m][n] = __builtin_amdgcn_mfma_f32_16x16x32_bf16(Bt[n][k], At[m][k], acc[ai][bj][m][n], 0, 0, 0); } \
        __builtin_amdgcn_s_setprio(0); } while (0)
#define PG8_WAIT_V(n) asm volatile("s_waitcnt vmcnt(" #n ")" ::: "memory")
#define PG8_WAIT_L(n) asm volatile("s_waitcnt lgkmcnt(" #n ")" ::: "memory")
#define PG8_BAR __builtin_amdgcn_s_barrier()
#define PG8_SCHED __builtin_amdgcn_sched_barrier(0)
    Unit cur, nxt; int ui = 0;
    if (!S.next(0, cur)) return;
    f32x4 acc[2][2][4][2];
#pragma unroll
    for (int a = 0; a < 2; ++a)
#pragma unroll
        for (int b = 0; b < 2; ++b)
#pragma unroll
            for (int m = 0; m < 4; ++m)
#pragma unroll
                for (int n = 0; n < 2; ++n) acc[a][b][m][n] = (f32x4){0.f, 0.f, 0.f, 0.f};
    bf16x8 At[4][2], B0[2][2], B1[2][2];
    i32x8 At8[4], B08[2], B18[2];
    (void)At; (void)B0; (void)B1; (void)At8; (void)B08; (void)B18;
    int one_scale = 0x7F7F7F7F; (void)one_scale;
    const char* cA = g.a_base(cur); const char* cB = g.b_base(cur);
    PG8_STAGE(PG8_SB(0, 0), cB, voffB); PG8_STAGE(PG8_SA(0, 0), cA, voffA); PG8_STAGE(PG8_SB(0, 1), cB + hstepB, voffB); PG8_STAGE(PG8_SA(0, 1), cA + hstepA, voffA);
    if (wr == 1) PG8_BAR;
    PG8_WAIT_V(4); PG8_BAR;
    PG8_STAGE(PG8_SB(1, 0), cB + 128, voffB); PG8_STAGE(PG8_SA(1, 0), cA + 128, voffA); PG8_STAGE(PG8_SB(1, 1), cB + hstepB + 128, voffB);
    PG8_WAIT_V(6); PG8_BAR;
    for (;;) {
        const bool has_next = S.next(ui + 1, nxt);
        const char* nA = has_next ? g.a_base(nxt) : cA; const char* nB = has_next ? g.b_base(nxt) : cB;
        for (int t = 0; t < nt; t += 2) {
            const bool last = (t == nt - 2);
            const char* a0 = cA + (size_t)(t >> 1) * kpA;
            const char* a1 = a0 + 128;
            const char* a2 = last ? nA : a0 + kpA; const char* b2 = last ? nB : cB + (size_t)(t + 2) * 128;
            const char* a3 = a2 + 128; const char* b3 = b2 + 128;
            PG8_LDB(B0, 0, 0); PG8_SCHED; PG8_LDA(At, 0, 0); PG8_STAGE(PG8_SA(1, 1), a1 + hstepA, voffA);
            PG8_WAIT_L(8); PG8_BAR; PG8_WAIT_L(0); PG8_MMA(0, 0, At, B0); PG8_BAR; PG8_SCHED;
            PG8_LDB(B1, 0, 1); PG8_STAGE(PG8_SB(0, 0), b2, voffB);
            PG8_BAR; PG8_WAIT_L(0); PG8_MMA(0, 1, At, B1); PG8_BAR;
            PG8_LDA(At, 0, 1); PG8_STAGE(PG8_SA(0, 0), a2, voffA);
            PG8_BAR; PG8_WAIT_L(0); PG8_MMA(1, 0, At, B0); PG8_BAR; PG8_SCHED;
            PG8_STAGE(PG8_SB(0, 1), b2 + hstepB, voffB);
            PG8_WAIT_V(6); PG8_BAR; PG8_MMA(1, 1, At, B1); PG8_BAR;
            PG8_LDB(B0, 1, 0); PG8_SCHED; PG8_LDA(At, 1, 0); PG8_STAGE(PG8_SA(0, 1), a2 + hstepA, voffA);
            PG8_WAIT_L(8); PG8_BAR; PG8_WAIT_L(0); PG8_MMA(0, 0, At, B0); PG8_BAR; PG8_SCHED;
            PG8_LDB(B1, 1, 1); PG8_STAGE(PG8_SB(1, 0), b3, voffB);
            PG8_BAR; PG8_WAIT_L(0); PG8_MMA(0, 1, At, B1); PG8_BAR;
            PG8_LDA(At, 1, 1); PG8_STAGE(PG8_SA(1, 0), a3, voffA);
            PG8_BAR; PG8_WAIT_L(0); PG8_MMA(1, 0, At, B0); PG8_BAR; PG8_SCHED;
            PG8_STAGE(PG8_SB(1, 1), b3 + hstepB, voffB);
            PG8_WAIT_V(6); PG8_BAR; PG8_MMA(1, 1, At, B1); PG8_BAR;
        }
        if constexpr (F8) asm volatile("s_nop 15\n\ts_nop 15\n\ts_nop 15" ::: "memory");
        E(acc, cur, wr, wc, fr, fq);
        if (!has_next) break;
#pragma unroll
        for (int a = 0; a < 2; ++a)
#pragma unroll
            for (int b = 0; b < 2; ++b)
#pragma unroll
                for (int m = 0; m < 4; ++m)
#pragma unroll
                    for (int n = 0; n < 2; ++n) acc[a][b][m][n] = (f32x4){0.f, 0.f, 0.f, 0.f};
        cur = nxt; cA = nA; cB = nB; ++ui;
    }
    PG8_WAIT_V(0);
    if (wr == 0) PG8_BAR;
    PG8_BAR;
#undef PG8_SA
#undef PG8_SB
#undef PG8_STAGE
#undef PG8_LDA
#undef PG8_LDB
#undef PG8_MMA
#undef PG8_WAIT_V
#undef PG8_WAIT_L
#undef PG8_BAR
#undef PG8_SCHED
}
}

namespace att {
constexpr int KVBLK = 64;
constexpr int SHM_V = KVBLK * HD * 2, SHM_K = KVBLK * HD * 2, SHM_ATTN = 2 * SHM_V + 2 * SHM_K + NWAVES * 64 * 4;
#define KSWZ(row, colB) ((row) * 256 + ((colB) ^ (((row) & 7) << 4)))
#define SBAR() __builtin_amdgcn_sched_barrier(0)
__device__ __forceinline__ int crow(int r, int hi) { return (r & 3) + 8 * (r >> 2) + 4 * hi; }
__device__ __forceinline__ void qkt(f32x16& p0, f32x16& p1, const char* Ks, const bf16x8* qr, int r32, int hi) {
    p0 = f32x16{}; p1 = f32x16{};
    bf16x8 ka[2], kb[2];
    { const int cb = (hi * 8) * 2; ka[0] = *reinterpret_cast<const bf16x8*>(Ks + KSWZ(r32, cb)); kb[0] = *reinterpret_cast<const bf16x8*>(Ks + KSWZ(32 + r32, cb)); }
#pragma unroll
    for (int d0 = 0; d0 < 8; ++d0) {
        if (d0 < 7) { const int cb = ((d0 + 1) * 16 + hi * 8) * 2;
            ka[(d0 + 1) & 1] = *reinterpret_cast<const bf16x8*>(Ks + KSWZ(r32, cb)); kb[(d0 + 1) & 1] = *reinterpret_cast<const bf16x8*>(Ks + KSWZ(32 + r32, cb)); }
        SBAR();
        p0 = __builtin_amdgcn_mfma_f32_32x32x16_bf16(ka[d0 & 1], qr[d0], p0, 0, 0, 0);
        p1 = __builtin_amdgcn_mfma_f32_32x32x16_bf16(kb[d0 & 1], qr[d0], p1, 0, 0, 0);
        SBAR();
    }
}
__device__ __forceinline__ int v_st(int k, int c) { const int kk = (k & ~0xC) | ((k & 4) << 1) | ((k & 8) >> 1); return ((kk >> 3) * 4 + (c >> 5)) * 512 + ((kk & 7) * 32 + (c & 31)) * 2; }
__device__ __forceinline__ int v_rd_base(int lane) { return ((lane & 3) << 3) | (((lane >> 2) & 3) << 6) | (((lane >> 4) & 1) << 5) | (((lane >> 5) & 1) << 8); }
constexpr int v_rd_off(int d0, int ks, int half) { return d0 * 512 + ks * 4096 + half * 2048; }
__device__ __forceinline__ s16x4 tr_read(int vb, int off) { return __builtin_amdgcn_ds_read_tr16_b64_v4i16((LAS s16x4*)(unsigned long)(unsigned)(vb + off)); }
__device__ __forceinline__ void pv_d0(f32x16* o, int vb, bf16x8 pa0, bf16x8 pa1, bf16x8 pa2, bf16x8 pa3) {
    s16x4 L[2][4], H[2][4];
#pragma unroll
    for (int d0 = 0; d0 < 4; ++d0) { L[0][d0] = tr_read(vb, v_rd_off(d0, 0, 0)); H[0][d0] = tr_read(vb, v_rd_off(d0, 0, 1)); }
#pragma unroll
    for (int ks = 0; ks < 4; ++ks) {
        if (ks < 3) {
#pragma unroll
            for (int d0 = 0; d0 < 4; ++d0) { L[(ks + 1) & 1][d0] = tr_read(vb, v_rd_off(d0, ks + 1, 0)); H[(ks + 1) & 1][d0] = tr_read(vb, v_rd_off(d0, ks + 1, 1)); }
        }
        const bf16x8 pa = ks == 0 ? pa0 : (ks == 1 ? pa1 : (ks == 2 ? pa2 : pa3));
#pragma unroll
        for (int d0 = 0; d0 < 4; ++d0) { const s16x4 l = L[ks & 1][d0], h = H[ks & 1][d0];
            o[d0] = __builtin_amdgcn_mfma_f32_32x32x16_bf16(pa, (bf16x8){l[0], l[1], l[2], l[3], h[0], h[1], h[2], h[3]}, o[d0], 0, 0, 0); }
    }
}
__device__ __forceinline__ void pack_p(const f32x16& p0, const f32x16& p1, bf16x8& pa0, bf16x8& pa1, bf16x8& pa2, bf16x8& pa3) {
#define PK4(P, BASE, OUT) do { unsigned a0 = cvt_pk_bf16(P[BASE + 0], P[BASE + 1]), a1 = cvt_pk_bf16(P[BASE + 2], P[BASE + 3]);   \
    unsigned b0 = cvt_pk_bf16(P[BASE + 4], P[BASE + 5]), b1 = cvt_pk_bf16(P[BASE + 6], P[BASE + 7]);                              \
    auto r0 = __builtin_amdgcn_permlane32_swap(a0, b0, false, false); auto r1 = __builtin_amdgcn_permlane32_swap(a1, b1, false, false); \
    u32x4 w = {r0[0], r1[0], r0[1], r1[1]}; OUT = *reinterpret_cast<bf16x8*>(&w); } while (0)
    PK4(p0, 0, pa0); PK4(p0, 8, pa1); PK4(p1, 0, pa2); PK4(p1, 8, pa3);
#undef PK4
}

__device__ __forceinline__ void pack_half(const f32x16& p, bf16x8& paA, bf16x8& paB) {
#define PK4(P, BASE, OUT) do { unsigned a0 = cvt_pk_bf16(P[BASE + 0], P[BASE + 1]), a1 = cvt_pk_bf16(P[BASE + 2], P[BASE + 3]);   \
    unsigned b0 = cvt_pk_bf16(P[BASE + 4], P[BASE + 5]), b1 = cvt_pk_bf16(P[BASE + 6], P[BASE + 7]);                              \
    auto r0 = __builtin_amdgcn_permlane32_swap(a0, b0, false, false); auto r1 = __builtin_amdgcn_permlane32_swap(a1, b1, false, false); \
    u32x4 w = {r0[0], r1[0], r0[1], r1[1]}; OUT = *reinterpret_cast<bf16x8*>(&w); } while (0)
    PK4(p, 0, paA); PK4(p, 8, paB);
#undef PK4
}
template <int KS0, bool WITH_EXP>
__device__ __forceinline__ void pv_half(f32x16* o, int vb, bf16x8 paA, bf16x8 paB, f32x16& px, float off) {
    s16x4 L[2][4], H[2][4];
#pragma unroll
    for (int d0 = 0; d0 < 4; ++d0) { L[0][d0] = tr_read(vb, v_rd_off(d0, KS0, 0)); H[0][d0] = tr_read(vb, v_rd_off(d0, KS0, 1)); }
#pragma unroll
    for (int d0 = 0; d0 < 4; ++d0) { L[1][d0] = tr_read(vb, v_rd_off(d0, KS0 + 1, 0)); H[1][d0] = tr_read(vb, v_rd_off(d0, KS0 + 1, 1)); }
#pragma unroll
    for (int kk = 0; kk < 2; ++kk) {
        const bf16x8 pa = kk == 0 ? paA : paB;
#pragma unroll
        for (int d0 = 0; d0 < 4; ++d0) { const s16x4 l = L[kk][d0], h = H[kk][d0];
            if (WITH_EXP) SBAR();
            o[d0] = __builtin_amdgcn_mfma_f32_32x32x16_bf16(pa, (bf16x8){l[0], l[1], l[2], l[3], h[0], h[1], h[2], h[3]}, o[d0], 0, 0, 0);
            if (WITH_EXP) {
#pragma unroll
                for (int q = 0; q < 2; ++q) { const int r = (kk * 4 + d0) * 2 + q; px[r] = __builtin_amdgcn_exp2f(fmaf(px[r], SM_C, off)); }
                SBAR(); }
        }
    }
}
enum { MODE_CMP = 0, MODE_WIN = 1, MODE_SLC = 2 };
struct AttnArgs {
    const bf16_t* Z; const bf16_t* KC; const bf16_t* VC; const float* G; float* L; float* OACC; bf16_t* MIX; const unsigned* BM; const float* TAB;
};
template <int MODE>
__device__ __forceinline__ void attn_unit(const AttnArgs& a, LAS char* ldsL, int qt, int g, int hp) {
    char* lds = (char*)ldsL;
    const int tid = threadIdx.x, wid = __builtin_amdgcn_readfirstlane(tid >> 6), lane = tid & 63, r32 = lane & 31, hi = lane >> 5;
    float* li_l = (float*)(lds + LDS_XCH) + wid * 64;
    const int t0 = MODE == MODE_SLC ? qt * 40 : qt * 128;
    const int tq_raw = MODE == MODE_SLC ? t0 + wid * 5 + r32 / 6 : t0 + wid * 16 + (r32 & 15);
    const bool rvalid = MODE == MODE_SLC ? (r32 < 30 && tq_raw < S_) : true;
    const int tq = tq_raw < S_ ? tq_raw : S_ - 1;
    const int hq = MODE == MODE_SLC ? g * HPG + r32 % 6 : g * HPG + hp * 2 + (r32 >> 4);
    const int tlast = MODE == MODE_SLC ? ((t0 + 39) < S_ ? (t0 + 39) : S_ - 1) : t0 + 127;
    const bf16_t* Kb; const bf16_t* Vb; long ldk;
    if (MODE == MODE_CMP) { Kb = a.KC + (size_t)g * 1024 * HD; Vb = a.VC + (size_t)g * 1024 * HD; ldk = HD; }
    else if (MODE == MODE_WIN) { Kb = a.Z + OFF_KV + 4 * 512 + g * HD; Vb = a.Z + OFF_KV + 5 * 512 + g * HD; ldk = LDZ; }
    else { Kb = a.Z + OFF_KV + 2 * 512 + g * HD; Vb = a.Z + OFF_KV + 3 * 512 + g * HD; ldk = LDZ; }
    int j0, j1;
    if (MODE == MODE_CMP) { j0 = 0; j1 = (((t0 + 127 - 31) >> 4) >> 6) + 1; }
    else if (MODE == MODE_WIN) { j0 = (t0 - 511) > 0 ? ((t0 - 511) >> 6) : 0; j1 = ((t0 + 127) >> 6) + 1; }
    else { j0 = 0; j1 = (tlast >> 6) + 1; }
    int klo, khi;
    if (MODE == MODE_CMP) { klo = 0; khi = tq >= 31 ? ((tq - 31) >> 4) : -1; }
    else if (MODE == MODE_WIN) { klo = tq - 511; khi = tq; }
    else { klo = 0; khi = rvalid ? tq : -1; }
    float negBC = -a.TAB[512 + (MODE == MODE_CMP ? 0 : (MODE == MODE_SLC ? 1 : 2))];
    bf16x8 qr[8];
    { const bf16_t* Qw = a.Z + (size_t)tq * LDZ + OFF_Q + hq * HD + hi * 8;
#pragma unroll
      for (int d0 = 0; d0 < 8; ++d0) qr[d0] = *reinterpret_cast<const bf16x8*>(Qw + d0 * 16); }
    f32x16 o[4] = {}; float lsum = 0.f;
    unsigned soK[2], soV[2];
#pragma unroll
    for (int i = 0; i < 2; ++i) { const int p = (wid + 8 * i) * 64 + lane;
        { const int row = p >> 4, c = (p & 15) ^ (row & 7); soK[i] = (unsigned)(row * ldk + c * 8) * 2u; }
        { const int sub = p >> 5, within = p & 31, kk = (sub >> 2) * 8 + (within >> 2), c = (sub & 3) * 32 + (within & 3) * 8, k = (kk & ~0xC) | ((kk & 4) << 1) | ((kk & 8) >> 1);
          soV[i] = (unsigned)(k * ldk + c) * 2u; } }
    const int vb0 = (int)(uintptr_t)(LAS char*)ldsL + 16384 + v_rd_base(lane);
#define ISSUE(jt) do { const int _b = ((jt) - j0) & 3; const char* _kp = (const char*)Kb + (size_t)(jt) * KVBLK * ldk * 2; const char* _vp = (const char*)Vb + (size_t)(jt) * KVBLK * ldk * 2; \
    _Pragma("unroll") for (int _i = 0; _i < 2; ++_i) { \
        __builtin_amdgcn_global_load_lds((const unsigned*)(_kp + soK[_i]), (LAS unsigned*)(ldsL + _b * 32768 + (wid + 8 * _i) * 1024), 16, 0, 0); \
        __builtin_amdgcn_global_load_lds((const unsigned*)(_vp + soV[_i]), (LAS unsigned*)(ldsL + _b * 32768 + 16384 + (wid + 8 * _i) * 1024), 16, 0, 0); } } while (0)
    unsigned bmw = 0u;
    if (MODE == MODE_SLC) bmw = a.BM[((size_t)tq * 4 + g) * 8];
    asm volatile("s_waitcnt lgkmcnt(0)" ::: "memory");
    __builtin_amdgcn_s_barrier();
    asm volatile("" ::: "memory");
    ISSUE(j0);
    asm volatile("s_waitcnt vmcnt(4) lgkmcnt(0)" : "+v"(bmw), "+v"(negBC), "+v"(qr[0]), "+v"(qr[1]), "+v"(qr[2]), "+v"(qr[3]), "+v"(qr[4]), "+v"(qr[5]), "+v"(qr[6]), "+v"(qr[7]) :: "memory");
    if (j0 + 1 < j1) ISSUE(j0 + 1); if (j0 + 2 < j1) ISSUE(j0 + 2);
    for (int j = j0; j < j1; ++j) {
        const int buf = (j - j0) & 3;
        if (j + 2 < j1) asm volatile("s_waitcnt vmcnt(8)" ::: "memory"); else if (j + 1 < j1) asm volatile("s_waitcnt vmcnt(4)" ::: "memory"); else asm volatile("s_waitcnt vmcnt(0)" ::: "memory");
        __builtin_amdgcn_s_barrier();
        asm volatile("" ::: "memory");
        if (j + 3 < j1) ISSUE(j + 3);
        int lhi = khi;
        if (MODE == MODE_SLC) { if (!((bmw >> (j & 31)) & 1u)) lhi = -1; }
        const int kb = j * KVBLK;
        const bool l_any = (kb + 63 >= klo) && (kb <= lhi);
        const bool l_full = (kb >= klo) && (kb + 63 <= lhi);
        if (__any(l_any)) {
            f32x16 p0, p1;
            qkt(p0, p1, lds + buf * 32768, qr, r32, hi);
            const bool uni = __all(l_full || !l_any);
            const float off = (uni && !l_any) ? -1.0e30f : negBC;
#pragma unroll
            for (int r = 0; r < 16; ++r) p0[r] = __builtin_amdgcn_exp2f(fmaf(p0[r], SM_C, off));
            if (!uni) {
#pragma unroll
                for (int r = 0; r < 16; ++r) { const int k0i = kb + crow(r, hi); p0[r] = (k0i >= klo && k0i <= lhi) ? p0[r] : 0.f; } }
            float ps = 0.f;
#pragma unroll
            for (int r = 0; r < 16; ++r) ps += p0[r];
            bf16x8 pa0, pa1, pa2, pa3; pack_half(p0, pa0, pa1);
            pv_half<0, true>(o, vb0 + buf * 32768, pa0, pa1, p1, off);
            if (!uni) {
#pragma unroll
                for (int r = 0; r < 16; ++r) { const int k1i = kb + 32 + crow(r, hi); p1[r] = (k1i >= klo && k1i <= lhi) ? p1[r] : 0.f; } }
#pragma unroll
            for (int r = 0; r < 16; ++r) ps += p1[r];
            lsum += ps;
            pack_half(p1, pa2, pa3);
            pv_half<2, false>(o, vb0 + buf * 32768, pa2, pa3, p1, off);
        }
        if (MODE == MODE_SLC) { if (((j + 1) & 31) == 0 && j + 1 < j1) { bmw = a.BM[((size_t)tq * 4 + g) * 8 + ((j + 1) >> 5)]; asm volatile("s_waitcnt vmcnt(0)" : "+v"(bmw) :: "memory"); } }
    }
#undef ISSUE
    lsum += __shfl_xor(lsum, 32);
    const float grow = a.G[(size_t)tq * NGATE + hq * 3 + (MODE == MODE_CMP ? 0 : (MODE == MODE_SLC ? 1 : 2))];
    if (hi == 0) { li_l[r32] = lsum; li_l[32 + r32] = rvalid ? grow : 0.f; }
    if (MODE == MODE_CMP) { if (hi == 0) a.L[(size_t)tq * NH + hq] = lsum; }
    asm volatile("s_waitcnt lgkmcnt(0)" ::: "memory");
#pragma unroll
    for (int hf = 0; hf < 2; ++hf) {
        float gtv[8]; float pvv[8][4];
#pragma unroll
        for (int rr = 0; rr < 8; ++rr) { const int r = hf * 8 + rr;
            const int orow = crow(r, hi); const float lv = li_l[orow]; const float rl = lv > 0.f ? __builtin_amdgcn_rcpf(lv) : 0.f;
            const int t = MODE == MODE_SLC ? t0 + wid * 5 + orow / 6 : t0 + wid * 16 + (orow & 15);
            const int h = MODE == MODE_SLC ? g * HPG + orow % 6 : g * HPG + hp * 2 + (orow >> 4);
            const bool valid = !(MODE == MODE_SLC && (orow >= 30 || t >= S_)); const int tc = valid ? t : 0;
            gtv[rr] = li_l[32 + orow] * rl;
            if (MODE != MODE_CMP) { const float* oa = a.OACC + (size_t)tc * 3072 + h * HD + r32;
#pragma unroll
                for (int d0 = 0; d0 < 4; ++d0) pvv[rr][d0] = oa[d0 * 32]; }
        }
#pragma unroll
        for (int rr = 0; rr < 8; ++rr) { const int r = hf * 8 + rr;
            const int orow = crow(r, hi);
            const int t = MODE == MODE_SLC ? t0 + wid * 5 + orow / 6 : t0 + wid * 16 + (orow & 15);
            const int h = MODE == MODE_SLC ? g * HPG + orow % 6 : g * HPG + hp * 2 + (orow >> 4);
            if (MODE == MODE_SLC && (orow >= 30 || t >= S_)) continue;
            float* oa = a.OACC + (size_t)t * 3072 + h * HD + r32;
#pragma unroll
            for (int d0 = 0; d0 < 4; ++d0) {
                const float v = o[d0][r] * gtv[rr];
                if (MODE == MODE_CMP) oa[d0 * 32] = v;
                else if (MODE == MODE_WIN) oa[d0 * 32] = pvv[rr][d0] + v;
                else a.MIX[(size_t)t * DM + POOLW + h * HD + d0 * 32 + r32] = (bf16_t)(cvt_pk_bf16(pvv[rr][d0] + v, 0.f) & 0xffffu);
            }
        }
    }
}

constexpr int SLC_KIMG = 64 * 272, SLC_BUF = SLC_KIMG + 64 * 288, LDS_SLCX = 4 * SLC_BUF;
static_assert(LDS_SLCX + 3072 <= LDS_MISC, "slc ring overlaps the barrier words");
__device__ __forceinline__ bf16x8 lds_b128(int adr) { return *reinterpret_cast<const LAS bf16x8*>((LAS char*)(unsigned long)(unsigned)adr); }
__device__ __forceinline__ void slc16_unit(const AttnArgs& a, LAS char* ldsL, int ut, int g) {
    char* lds = (char*)ldsL;
    const int tid = threadIdx.x, wid = __builtin_amdgcn_readfirstlane(tid >> 6), lane = tid & 63, fr = lane & 15, fq = lane >> 4;
    float* li_l = (float*)(lds + LDS_SLCX) + wid * 96;
    const int t0 = ut * 48, tlast = (t0 + 47) < S_ ? (t0 + 47) : S_ - 1, j0 = 0, j1 = (tlast >> 6) + 1;
    const bf16_t* Kb = a.Z + OFF_KV + 2 * 512 + g * HD; const long ldk = LDZ;
    int tqb[3]; bool rv[3];
#pragma unroll
    for (int b = 0; b < 3; ++b) { const int tr = t0 + wid * 6 + 2 * b + fr / 6; rv[b] = fr < 12 && tr < S_; tqb[b] = tr < S_ ? tr : S_ - 1; }
    const int hq = g * HPG + fr % 6;
    float negBC = -a.TAB[513];
    bf16x8 qf[3][4];
#pragma unroll
    for (int b = 0; b < 3; ++b) { const bf16_t* qp = a.Z + (size_t)tqb[b] * LDZ + OFF_Q + hq * HD + fq * 8;
#pragma unroll
        for (int ks = 0; ks < 4; ++ks) qf[b][ks] = *reinterpret_cast<const bf16x8*>(qp + ks * 32); }
    f32x4 o[3][8]; float lsum[3];
#pragma unroll
    for (int b = 0; b < 3; ++b) { lsum[b] = 0.f;
#pragma unroll
        for (int c = 0; c < 8; ++c) o[b][c] = (f32x4){0.f, 0.f, 0.f, 0.f}; }
    const int q4 = fr >> 2, p4 = fr & 3, lbase = (int)(uintptr_t)ldsL;
    const int kaddr0 = lbase + fr * 272 + fq * 16;
    const int vaddr0 = lbase + SLC_KIMG + (4 * fq + q4) * 288 + (p4 >> 1) * 16 + (p4 & 1) * 8;
    unsigned so[5]; int ldst[5];
#pragma unroll
    for (int i = 0; i < 5; ++i) { int Pc = wid + 8 * i; if (Pc >= 35) Pc -= 35; const bool isv = Pc >= 17; const int p = (isv ? Pc - 17 : Pc) * 64 + lane;
        int row, ch; if (isv) { row = p / 18; ch = p % 18; } else { row = p / 17; ch = p % 17; } if (ch >= 16) ch = 0;
        so[i] = (unsigned)(row * ldk + ch * 8) * 2u + (isv ? 1024u : 0u);
        ldst[i] = __builtin_amdgcn_readfirstlane(isv ? SLC_KIMG + (Pc - 17) * 1024 : Pc * 1024); }
#define ISSUE16(jt) do { const int _b = ((jt) - j0) & 3; const char* _kp = (const char*)Kb + (size_t)(jt) * KVBLK * ldk * 2; \
    _Pragma("unroll") for (int _i = 0; _i < 5; ++_i) { asm volatile("" : "+v"(so[_i])); \
        __builtin_amdgcn_global_load_lds((const unsigned*)(_kp + so[_i]), (LAS unsigned*)(ldsL + _b * SLC_BUF + ldst[_i]), 16, 0, 0); } } while (0)
    unsigned bmw[3];
#pragma unroll
    for (int b = 0; b < 3; ++b) bmw[b] = a.BM[((size_t)tqb[b] * 4 + g) * 8];
    asm volatile("s_waitcnt lgkmcnt(0)" ::: "memory");
    __builtin_amdgcn_s_barrier();
    asm volatile("" ::: "memory");
    ISSUE16(j0);
    asm volatile("s_waitcnt vmcnt(5) lgkmcnt(0)" : "+v"(bmw[0]), "+v"(bmw[1]), "+v"(bmw[2]), "+v"(negBC), "+v"(qf[0][0]), "+v"(qf[0][1]), "+v"(qf[0][2]), "+v"(qf[0][3]),
                 "+v"(qf[1][0]), "+v"(qf[1][1]), "+v"(qf[1][2]), "+v"(qf[1][3]), "+v"(qf[2][0]), "+v"(qf[2][1]), "+v"(qf[2][2]), "+v"(qf[2][3]) :: "memory");
    if (j0 + 1 < j1) ISSUE16(j0 + 1); if (j0 + 2 < j1) ISSUE16(j0 + 2);
    int kadr = kaddr0, vadr = vaddr0;
    for (int j = j0; j < j1; ++j) {
        const int buf = (j - j0) & 3;
        if (j + 2 < j1) asm volatile("s_waitcnt vmcnt(10)" ::: "memory"); else if (j + 1 < j1) asm volatile("s_waitcnt vmcnt(5)" ::: "memory"); else asm volatile("s_waitcnt vmcnt(0)" ::: "memory");
        __builtin_amdgcn_s_barrier();
        asm volatile("" ::: "memory");
        if (j + 3 < j1) ISSUE16(j + 3);
        const int kb = j * KVBLK;
#define KF16(ks, mt) lds_b128(kadr + 64 * (ks) + 4352 * (mt))
#define TRA(dst, off) asm volatile("ds_read_b64_tr_b16 %0, %1 offset:%2" : "=v"(dst) : "v"(vadr), "n"(off))
#define VLOAD(dst, s, h) _Pragma("unroll") for (int _c = 0; _c < 4; ++_c) { TRA(dst[_c][0], 32 * (4 * (h) + _c) + 9216 * (s)); TRA(dst[_c][1], 32 * (4 * (h) + _c) + 9216 * (s) + 4608); }
#define VWAIT(n, d) asm volatile("s_waitcnt lgkmcnt(" #n ")" : "+v"(d[0][0]), "+v"(d[0][1]), "+v"(d[1][0]), "+v"(d[1][1]), "+v"(d[2][0]), "+v"(d[2][1]), "+v"(d[3][0]), "+v"(d[3][1]))
#define PVMMA(src, pa, h) _Pragma("unroll") for (int _c = 0; _c < 4; ++_c) o[b][4 * (h) + _c] = __builtin_amdgcn_mfma_f32_16x16x32_bf16(pa, \
            (bf16x8){src[_c][0][0], src[_c][0][1], src[_c][0][2], src[_c][0][3], src[_c][1][0], src[_c][1][1], src[_c][1][2], src[_c][1][3]}, o[b][4 * (h) + _c], 0, 0, 0);
#define EXPH(h, pw) { if (uni) { _Pragma("unroll") for (int mt = 2 * (h); mt < 2 * (h) + 2; ++mt) _Pragma("unroll") for (int i = 0; i < 4; ++i) { \
                            const float e_ = __builtin_amdgcn_exp2f(fmaf(acc[mt][i], SM_C, off)); acc[mt][i] = e_; ps += e_; } } \
                      else { asm volatile("" ::: "memory"); _Pragma("unroll") for (int mt = 2 * (h); mt < 2 * (h) + 2; ++mt) _Pragma("unroll") for (int i = 0; i < 4; ++i) { \
                            float e_ = __builtin_amdgcn_exp2f(fmaf(acc[mt][i], SM_C, off)); e_ = (16 * mt + i <= lim4) ? e_ : 0.f; acc[mt][i] = e_; ps += e_; } } \
                      pw.x = cvt_pk_bf16(acc[2 * (h)][0], acc[2 * (h)][1]); pw.y = cvt_pk_bf16(acc[2 * (h)][2], acc[2 * (h)][3]); \
                      pw.z = cvt_pk_bf16(acc[2 * (h) + 1][0], acc[2 * (h) + 1][1]); pw.w = cvt_pk_bf16(acc[2 * (h) + 1][2], acc[2 * (h) + 1][3]); }
#pragma unroll
        for (int b = 0; b < 3; ++b) {
            const bool sel = rv[b] && ((bmw[b] >> (j & 31)) & 1u);
            const int lim = tqb[b] - kb;
            const bool l_any = sel && lim >= 0, l_full = sel && lim >= 63;
            if (__any(l_any)) {
                f32x4 acc[4]; bf16x8 ka[4], kc[4]; s16x4 va[4][2], vc[4][2];
#pragma unroll
                for (int mt = 0; mt < 4; ++mt) ka[mt] = KF16(0, mt);
#pragma unroll
                for (int mt = 0; mt < 4; ++mt) kc[mt] = KF16(1, mt);
                __builtin_amdgcn_sched_barrier(0);
#pragma unroll
                for (int mt = 0; mt < 4; ++mt) acc[mt] = __builtin_amdgcn_mfma_f32_16x16x32_bf16(ka[mt], qf[b][0], (f32x4){0.f, 0.f, 0.f, 0.f}, 0, 0, 0);
#pragma unroll
                for (int mt = 0; mt < 4; ++mt) ka[mt] = KF16(2, mt);
                __builtin_amdgcn_sched_barrier(0);
#pragma unroll
                for (int mt = 0; mt < 4; ++mt) acc[mt] = __builtin_amdgcn_mfma_f32_16x16x32_bf16(kc[mt], qf[b][1], acc[mt], 0, 0, 0);
#pragma unroll
                for (int mt = 0; mt < 4; ++mt) kc[mt] = KF16(3, mt);
                __builtin_amdgcn_sched_barrier(0);
#pragma unroll
                for (int mt = 0; mt < 4; ++mt) acc[mt] = __builtin_amdgcn_mfma_f32_16x16x32_bf16(ka[mt], qf[b][2], acc[mt], 0, 0, 0);
                __builtin_amdgcn_sched_barrier(0);
#pragma unroll
                for (int mt = 0; mt < 4; ++mt) acc[mt] = __builtin_amdgcn_mfma_f32_16x16x32_bf16(kc[mt], qf[b][3], acc[mt], 0, 0, 0);
                __builtin_amdgcn_sched_barrier(0);
                VLOAD(va, 0, 0)
                VLOAD(vc, 0, 1)
                const bool uni = __all(l_full || !l_any);
                const float off = (uni && !l_any) ? -1.0e30f : negBC;
                const int lim4 = l_any ? lim - 4 * fq : -1;
                float ps = 0.f;
                u32x4 pw0, pw1;
                EXPH(0, pw0)
                const bf16x8 pa0 = *reinterpret_cast<bf16x8*>(&pw0);
                __builtin_amdgcn_sched_barrier(0);
                VWAIT(8, va);
                PVMMA(va, pa0, 0)
                __builtin_amdgcn_sched_barrier(0);
                VLOAD(va, 1, 0)
                VWAIT(8, vc);
                PVMMA(vc, pa0, 1)
                __builtin_amdgcn_sched_barrier(0);
                VLOAD(vc, 1, 1)
                EXPH(1, pw1)
                const bf16x8 pa1 = *reinterpret_cast<bf16x8*>(&pw1);
                lsum[b] += ps;
                __builtin_amdgcn_sched_barrier(0);
                VWAIT(8, va);
                PVMMA(va, pa1, 0)
                __builtin_amdgcn_sched_barrier(0);
                VWAIT(0, vc);
                PVMMA(vc, pa1, 1)
                __builtin_amdgcn_sched_barrier(0);
            }
        }
#undef TRA
#undef VWAIT
#undef EXPH
#undef KF16
#undef VLOAD
#undef PVMMA
        if (((j + 1) & 31) == 0 && j + 1 < j1) {
#pragma unroll
            for (int b = 0; b < 3; ++b) bmw[b] = a.BM[((size_t)tqb[b] * 4 + g) * 8 + ((j + 1) >> 5)];
            asm volatile("s_waitcnt vmcnt(0)" : "+v"(bmw[0]), "+v"(bmw[1]), "+v"(bmw[2]) :: "memory"); }
        { const int step = buf == 3 ? -3 * SLC_BUF : SLC_BUF; kadr += step; vadr += step; asm volatile("" : "+v"(kadr), "+v"(vadr)); }
    }
#undef ISSUE16
    float grow[3];
#pragma unroll
    for (int b = 0; b < 3; ++b) grow[b] = a.G[(size_t)tqb[b] * NGATE + hq * 3 + 1];
#pragma unroll
    for (int b = 0; b < 3; ++b) { float ls = lsum[b]; ls += __shfl_xor(ls, 16); ls += __shfl_xor(ls, 32);
        if (fq == 0) { li_l[b * 32 + fr] = ls; li_l[b * 32 + 16 + fr] = rv[b] ? grow[b] : 0.f; } }
    asm volatile("s_waitcnt lgkmcnt(0)" ::: "memory");
#pragma unroll
    for (int b = 0; b < 3; ++b) {
        float pv_[4][8]; float gtv[4];
#pragma unroll
        for (int i = 0; i < 4; ++i) { const int q = 4 * fq + i; const float lv = li_l[b * 32 + q]; gtv[i] = li_l[b * 32 + 16 + q] * (lv > 0.f ? __builtin_amdgcn_rcpf(lv) : 0.f);
            const int t = t0 + wid * 6 + 2 * b + q / 6, h = g * HPG + q % 6; const bool valid = q < 12 && t < S_; const int tc = valid ? t : 0;
            const float* oa = a.OACC + (size_t)tc * 3072 + h * HD + fr;
#pragma unroll
            for (int c = 0; c < 8; ++c) pv_[i][c] = oa[c * 16]; }
#pragma unroll
        for (int i = 0; i < 4; ++i) { const int q = 4 * fq + i; const int t = t0 + wid * 6 + 2 * b + q / 6, h = g * HPG + q % 6;
            if (q >= 12 || t >= S_) continue;
            bf16_t* mp = a.MIX + (size_t)t * DM + POOLW + h * HD + fr;
#pragma unroll
            for (int c = 0; c < 8; ++c) mp[c * 16] = (bf16_t)(cvt_pk_bf16(pv_[i][c] + o[b][c][i] * gtv[i], 0.f) & 0xffffu); }
    }
}

__device__ __forceinline__ void imp_task(const AttnArgs& a, float* IMPP, float* IMPF, int tqi, int g) {
    const int lane = threadIdx.x & 63, fr = lane & 15, fq = lane >> 4;
    const int t = tqi * 16 + fr;
    const int tmax = tqi * 16 + 15;
    if (tmax < 31) return;
    const int lim = t >= 31 ? ((t - 31) >> 4) : -1;
    const int nstep = ((((tmax - 31) >> 4) >> 6) + 1) * 4;
    const float negBC = -a.TAB[512];
    bf16x8 qf[HPG][4]; float rl[HPG];
#pragma unroll
    for (int h = 0; h < HPG; ++h) {
        const bf16_t* qp = a.Z + (size_t)t * LDZ + OFF_Q + (g * HPG + h) * HD + fq * 8;
#pragma unroll
        for (int ks = 0; ks < 4; ++ks) qf[h][ks] = *reinterpret_cast<const bf16x8*>(qp + ks * 32);
        const float lv = a.L[(size_t)t * NH + g * HPG + h]; rl[h] = lv > 0.f ? 1.0f / lv : 0.f;
    }
    const bf16_t* kbase = a.KC + (size_t)g * 1024 * HD + (size_t)fr * HD + fq * 8;
    bf16x8 kf[4], kn[4], kn2[4];
#pragma unroll
    for (int ks = 0; ks < 4; ++ks) { kf[ks] = *reinterpret_cast<const bf16x8*>(kbase + ks * 32); kn[ks] = *reinterpret_cast<const bf16x8*>(kbase + (size_t)(nstep > 1 ? 1 : 0) * 16 * HD + ks * 32); }
    float* op = IMPP + ((size_t)t * 4 + g) * 256 + fq; float* of = IMPF + ((size_t)t * 4 + g) * 256 + fq;
    for (int st = 0; st < nstep; ++st) {
        const int sn = (st + 2 < nstep) ? st + 2 : nstep - 1;
#pragma unroll
        for (int ks = 0; ks < 4; ++ks) kn2[ks] = *reinterpret_cast<const bf16x8*>(kbase + (size_t)sn * 16 * HD + ks * 32);
        f32x4 imp4 = {0.f, 0.f, 0.f, 0.f};
        const int n0 = st * 16 + fq * 4;
#pragma unroll
        for (int h = 0; h < HPG; ++h) {
            f32x4 acc = {0.f, 0.f, 0.f, 0.f};
#pragma unroll
            for (int ks = 0; ks < 4; ++ks) acc = __builtin_amdgcn_mfma_f32_16x16x32_bf16(kf[ks], qf[h][ks], acc, 0, 0, 0);
#pragma unroll
            for (int i = 0; i < 4; ++i) { const float e = __builtin_amdgcn_exp2f(fmaf(acc[i], SM_C, negBC)) * rl[h]; imp4[i] += (n0 + i <= lim) ? e : 0.f; }
        }
        op[st * 4] = imp4[0] + 2.0f * (imp4[1] + imp4[2] + imp4[3]);
        of[st * 4] = imp4[0];
#pragma unroll
        for (int ks = 0; ks < 4; ++ks) { kf[ks] = kn[ks]; kn[ks] = kn2[ks]; }
    }
}

__device__ __forceinline__ void topk_load(const float* IMPP, const float* IMPF, int t, int g, f32x4& pp, f32x4& ff) {
    const int lane = threadIdx.x & 63, cur = t >> 6, jb = lane * 4;
    pp = (f32x4){0.f, 0.f, 0.f, 0.f}; ff = pp;
    if (cur > 15 && jb <= cur) { const size_t base = ((size_t)t * 4 + g) * 256; pp = *(const f32x4*)(IMPP + base + jb); ff = *(const f32x4*)(IMPF + base + jb); }
}
__device__ __forceinline__ void topk_task(const f32x4 pp, const f32x4 ff, unsigned* BM, int t, int g) {
    const int lane = threadIdx.x & 63;
    const int cur = t >> 6;
    unsigned nib = 0u;
    if (cur <= 15) { const int jb = lane * 4;
#pragma unroll
        for (int c = 0; c < 4; ++c) if (jb + c <= cur) nib |= 1u << c; }
    else {
        const int jb = lane * 4;
        unsigned key[4];
        {
            float fnext = __shfl_down(ff[0], 1);
            if (lane == 63) fnext = 0.f;
            const float v0 = pp[0] + ff[1], v1 = pp[1] + ff[2], v2 = pp[2] + ff[3], v3 = pp[3] + fnext;
            key[0] = (jb + 0 >= 1 && jb + 0 <= cur - 2) ? __float_as_uint(fmaxf(v0, 0.f)) + 1u : 0u;
            key[1] = (jb + 1 >= 1 && jb + 1 <= cur - 2) ? __float_as_uint(fmaxf(v1, 0.f)) + 1u : 0u;
            key[2] = (jb + 2 >= 1 && jb + 2 <= cur - 2) ? __float_as_uint(fmaxf(v2, 0.f)) + 1u : 0u;
            key[3] = (jb + 3 >= 1 && jb + 3 <= cur - 2) ? __float_as_uint(fmaxf(v3, 0.f)) + 1u : 0u;
        }
        unsigned prefix = 0u; bool exact = false;
        for (int b = 30; b >= 0; --b) {
            const unsigned trial = prefix | (1u << b);
            const int cnt = __popcll(__ballot(key[0] >= trial)) + __popcll(__ballot(key[1] >= trial)) + __popcll(__ballot(key[2] >= trial)) + __popcll(__ballot(key[3] >= trial));
            if (cnt >= 13) { prefix = trial; if (cnt == 13) { exact = true; break; } }
        }
#pragma unroll
        for (int c = 0; c < 4; ++c) if (exact ? (key[c] >= prefix) : (key[c] > prefix)) nib |= 1u << c;
        if (!exact) {
            int need = 13 - (__popcll(__ballot(key[0] > prefix)) + __popcll(__ballot(key[1] > prefix)) + __popcll(__ballot(key[2] > prefix)) + __popcll(__ballot(key[3] > prefix)));
            unsigned tie = 0u;
#pragma unroll
            for (int c = 0; c < 4; ++c) if (key[c] == prefix) tie |= 1u << c;
            for (int guard = 0; need > 0 && guard < 16; ++guard) {
                const unsigned long long any = __ballot(tie != 0u);
                if (any == 0ull) break;
                const int L = __builtin_ctzll(any);
                if (lane == L) { const unsigned low = tie & (0u - tie); nib |= low; tie ^= low; }
                --need;
            }
        }
        if (lane == 0) nib |= 1u;
        if (lane == (cur >> 2)) nib |= 1u << (cur & 3);
        if (lane == ((cur - 1) >> 2)) nib |= 1u << ((cur - 1) & 3);
    }
    unsigned x = nib << (4 * (lane & 7));
    x |= __shfl_xor(x, 1); x |= __shfl_xor(x, 2); x |= __shfl_xor(x, 4);
    if ((lane & 7) == 0) BM[((size_t)t * 4 + g) * 8 + (lane >> 3)] = x;
}
#undef KSWZ
}

template <bool FFN_REMAP = false>
__device__ __forceinline__ void convT(const float* __restrict__ src0, int K, int N, bf16_t* __restrict__ dst, int ldd, LAS float* tile, int bid, int nb, int Nfull = 0, int n0 = 0) {
    const float* __restrict__ src = src0 + n0; if (Nfull == 0) Nfull = N;
    const int tid = threadIdx.x, tk = K >> 6, tn = (N + 63) >> 6, total = tk * tn;
    const int r = tid >> 4, c4 = (tid & 15) * 4;
    f32x4 v[2] = {{0.f, 0.f, 0.f, 0.f}, {0.f, 0.f, 0.f, 0.f}}, vn[2];
    if (bid < total) { const int nti = bid % tn, kti = bid / tn, ng = nti * 64 + c4;
#pragma unroll
        for (int h = 0; h < 2; ++h) if (ng < N) v[h] = *(const f32x4*)(src + (size_t)(kti * 64 + r + h * 32) * Nfull + ng); }
    for (int idx = bid; idx < total; idx += nb) {
        const int nti = idx % tn, kti = idx / tn;
#pragma unroll
        for (int h = 0; h < 2; ++h) { LAS float* tp = tile + (r + h * 32) * 65 + c4; tp[0] = v[h][0]; tp[1] = v[h][1]; tp[2] = v[h][2]; tp[3] = v[h][3]; }
        {
            const int nx = idx + nb; vn[0] = (f32x4){0.f, 0.f, 0.f, 0.f}; vn[1] = vn[0];
            if (nx < total) { const int nti2 = nx % tn, kti2 = nx / tn, ng2 = nti2 * 64 + c4;
#pragma unroll
                for (int h = 0; h < 2; ++h) if (ng2 < N) vn[h] = *(const f32x4*)(src + (size_t)(kti2 * 64 + r + h * 32) * Nfull + ng2); } }
        __syncthreads();
        const int n = tid >> 3, k8 = (tid & 7) * 8, ngl = nti * 64 + n;
        float e[8];
#pragma unroll
        for (int i = 0; i < 8; ++i) e[i] = tile[(k8 + i) * 65 + n];
        if (ngl < N) { u32x4 w; w.x = cvt_pk_bf16(e[0], e[1]); w.y = cvt_pk_bf16(e[2], e[3]); w.z = cvt_pk_bf16(e[4], e[5]); w.w = cvt_pk_bf16(e[6], e[7]);
            int drow = ngl; if (FFN_REMAP) { const int up = ngl >= DFF ? 1 : 0, f = ngl - up * DFF; drow = (f >> 7) * 256 + up * 128 + (f & 127); }
            *(u32x4*)(dst + (size_t)drow * ldd + kti * 64 + k8) = w; }
        __syncthreads();
        v[0] = vn[0]; v[1] = vn[1];
    }
}
__device__ __forceinline__ void convT8(const float* __restrict__ src0, int K, int N, unsigned char* __restrict__ dst, int ldd, float scale, LAS float* tile, int bid, int nb, int Nfull = 0, int n0 = 0) {
    const float* __restrict__ src = src0 + n0; if (Nfull == 0) Nfull = N;
    const int tid = threadIdx.x, tk = K >> 6, tn = (N + 63) >> 6, total = tk * tn;
    const int r = tid >> 4, c4 = (tid & 15) * 4;
    f32x4 v[2] = {{0.f, 0.f, 0.f, 0.f}, {0.f, 0.f, 0.f, 0.f}}, vn[2];
    if (bid < total) { const int nti = bid % tn, kti = bid / tn, ng = nti * 64 + c4;
#pragma unroll
        for (int h = 0; h < 2; ++h) if (ng < N) v[h] = *(const f32x4*)(src + (size_t)(kti * 64 + r + h * 32) * Nfull + ng); }
    for (int idx = bid; idx < total; idx += nb) {
        const int nti = idx % tn, kti = idx / tn;
#pragma unroll
        for (int h = 0; h < 2; ++h) { LAS float* tp = tile + (r + h * 32) * 65 + c4; tp[0] = v[h][0]; tp[1] = v[h][1]; tp[2] = v[h][2]; tp[3] = v[h][3]; }
        { const int nx = idx + nb; vn[0] = (f32x4){0.f, 0.f, 0.f, 0.f}; vn[1] = vn[0];
            if (nx < total) { const int nti2 = nx % tn, kti2 = nx / tn, ng2 = nti2 * 64 + c4;
#pragma unroll
                for (int h = 0; h < 2; ++h) if (ng2 < N) vn[h] = *(const f32x4*)(src + (size_t)(kti2 * 64 + r + h * 32) * Nfull + ng2); } }
        __syncthreads();
        const int n = tid >> 3, k8 = (tid & 7) * 8, ngl = nti * 64 + n;
        float e[8];
#pragma unroll
        for (int i = 0; i < 8; ++i) e[i] = tile[(k8 + i) * 65 + n] * scale;
        if (ngl < N) { int p0 = __builtin_amdgcn_cvt_pk_fp8_f32(e[0], e[1], 0, false); p0 = __builtin_amdgcn_cvt_pk_fp8_f32(e[2], e[3], p0, true);
            int p1 = __builtin_amdgcn_cvt_pk_fp8_f32(e[4], e[5], 0, false); p1 = __builtin_amdgcn_cvt_pk_fp8_f32(e[6], e[7], p1, true);
            *(u32x2*)(dst + (size_t)ngl * ldd + kti * 64 + k8) = (u32x2){(unsigned)p0, (unsigned)p1}; }
        __syncthreads();
        v[0] = vn[0]; v[1] = vn[1];
    }
}
__device__ __forceinline__ void rmsnorm_rows(const float* __restrict__ src, const float* __restrict__ w, bf16_t* __restrict__ dst, int rows, int gw, int nw, unsigned char* __restrict__ dst8 = nullptr) {
    const int lane = threadIdx.x & 63;
    f32x4 v[16], vn[16];
    if (gw < rows) { const f32x4* sp = (const f32x4*)(src + (size_t)gw * DM);
#pragma unroll
        for (int i = 0; i < 16; ++i) v[i] = sp[lane + 64 * i]; }
    for (int row = gw; row < rows; row += nw) {
        const int nr = row + nw < rows ? row + nw : row;
        { const f32x4* sp = (const f32x4*)(src + (size_t)nr * DM);
#pragma unroll
          for (int i = 0; i < 16; ++i) vn[i] = sp[lane + 64 * i]; }
        float ss = 0.f;
#pragma unroll
        for (int i = 0; i < 16; ++i) ss += v[i][0] * v[i][0] + v[i][1] * v[i][1] + v[i][2] * v[i][2] + v[i][3] * v[i][3];
        ss = wave_sum(ss);
        const float rstd = rsqrtf(ss * (1.0f / DM) + EPS);
#pragma unroll
        for (int i = 0; i < 16; ++i) { const f32x4 ww = ((const f32x4*)w)[lane + 64 * i];
            u32x2 o; o.x = cvt_pk_bf16(v[i][0] * rstd * ww[0], v[i][1] * rstd * ww[1]); o.y = cvt_pk_bf16(v[i][2] * rstd * ww[2], v[i][3] * rstd * ww[3]);
            *(u32x2*)(dst + (size_t)row * DM + (lane + 64 * i) * 4) = o;
            if (dst8) { int pk = __builtin_amdgcn_cvt_pk_fp8_f32(v[i][0] * rstd * ww[0], v[i][1] * rstd * ww[1], 0, false); pk = __builtin_amdgcn_cvt_pk_fp8_f32(v[i][2] * rstd * ww[2], v[i][3] * rstd * ww[3], pk, true);
                *(int*)(dst8 + (size_t)row * DM + (lane + 64 * i) * 4) = pk; } }
#pragma unroll
        for (int i = 0; i < 16; ++i) v[i] = vn[i];
    }
}

struct Ptrs {
    bf16_t *Win, *Wo, *Wfi, *Wfo, *Wg, *Wple, *Wpool, *Wc1k, *Wc1v, *XN, *PB, *Z, *M, *KC, *VC, *MIX, *ACT, *ERAW;
    float *COS, *SIN, *TAB, *G, *H1, *L, *OACC, *IMPP, *IMPF, *ERSTD; unsigned* BM;
};

__device__ __forceinline__ void phase_prologue(const Params& P, const Ptrs& W, LAS unsigned char* lds) {
    const int bid = blockIdx.x, nb = gridDim.x, tid = threadIdx.x, lane = tid & 63, wv = tid >> 6;
    const int gw = bid * NWAVES + wv, nw = nb * NWAVES; const size_t gt = (size_t)bid * NTHREADS + tid, ntot = (size_t)nb * NTHREADS;
    LAS float* tile = (LAS float*)lds;
    rmsnorm_rows(P.x, P.norm1_w, W.XN, S_, gw, nw, P.ws + WS_XN8);
    convT(P.w_in, DM, POOLW, W.Win, DM, tile, bid, nb, INW, 0);
    convT(P.w_in, DM, INW - OFF_G, W.Win + (size_t)OFF_G * DM, DM, tile, bid, nb, INW, OFF_G);
    convT8(P.w_in, DM, OFF_G - POOLW, P.ws + WS_WIN8, DM, WG8_SCALE, tile, bid, nb, INW, POOLW);
    for (size_t i = gt; i < (size_t)(LDZ - INW) * DM / 8; i += ntot) *(u32x4*)(W.Win + (size_t)INW * DM + i * 8) = (u32x4){0u, 0u, 0u, 0u};
    convT(P.w_o, DM, DM, W.Wo, DM, tile, bid, nb);
    convT<true>(P.w_ffn_in, DM, NFI, W.Wfi, DM, tile, bid, nb);
    for (size_t i = gt; i < (size_t)2 * DM / 8; i += ntot) *(u32x4*)(W.XN - 2 * DM + i * 8) = (u32x4){0u, 0u, 0u, 0u};
    convT(P.w_ffn_out, DFF, DM, W.Wfo, DFF, tile, bid, nb);
    convT8(P.w_ple_gate, DM, DM, (unsigned char*)W.Wg, DM, WG8_SCALE, tile, bid, nb);
    convT(P.w_ple_proj, PLE, DM, W.Wple, PLE, tile, bid, nb);
    for (int g = 0; g < 4; ++g) convT(P.w_pool + (size_t)g * 65536, 256, 256, W.Wpool + (size_t)g * 65536, 256, tile, bid, nb);
    convT(P.cmp_k_w1, 4096, 256, W.Wc1k, 4096, tile, bid, nb);
    convT(P.cmp_v_w1, 4096, 256, W.Wc1v, 4096, tile, bid, nb);
    { constexpr size_t NP8 = (size_t)S_ * PLE / 8;
      for (size_t ib = gt; ib < NP8; ib += 4 * ntot) { f32x4 av[4], bv[4];
#pragma unroll
          for (int k = 0; k < 4; ++k) { size_t i = ib + k * ntot; if (i >= NP8) i = NP8 - 1; av[k] = *(const f32x4*)(P.p + i * 8); bv[k] = *(const f32x4*)(P.p + i * 8 + 4); }
#pragma unroll
          for (int k = 0; k < 4; ++k) { const size_t i = ib + k * ntot; if (i < NP8) { u32x4 w; w.x = cvt_pk_bf16(av[k][0], av[k][1]); w.y = cvt_pk_bf16(av[k][2], av[k][3]); w.z = cvt_pk_bf16(bv[k][0], bv[k][1]); w.w = cvt_pk_bf16(bv[k][2], bv[k][3]); *(u32x4*)(W.PB + i * 8) = w; } } } }
    for (size_t i = gt; i < (size_t)S_ * 16; i += ntot) { const int t = (int)(i >> 4), fi = (int)(i & 15);
        const float inv = exp2f(-(float)fi * (18.931568569324174f / 16.0f)); const float ang = (float)P.positions[t] * inv;
        const double ad = (double)ang; const double kk = rint(ad * 0.15915494309189535); const float rf = (float)(ad - kk * 6.283185307179586);
        W.COS[i] = __cosf(rf); W.SIN[i] = __sinf(rf); }
    for (int task = gw; task < 128; task += nw) { const int which = task >> 6, r0 = (task & 63) * 64; const float* pe = which ? P.cmp_pos_v : P.cmp_pos_k; const float* w1 = which ? P.cmp_v_w1 : P.cmp_k_w1;
        f32x4 s = {0.f, 0.f, 0.f, 0.f};
#pragma unroll 8
        for (int r = 0; r < 64; ++r) { const f32x4 wv = *(const f32x4*)(w1 + (size_t)(r0 + r) * 256 + lane * 4); s += wv * pe[r0 + r]; }
        float* cbp = (float*)(P.ws + WS_CBIAS) + which * 256 + lane * 4;
        unsafeAtomicAdd(cbp + 0, s[0]); unsafeAtomicAdd(cbp + 1, s[1]); unsafeAtomicAdd(cbp + 2, s[2]); unsafeAtomicAdd(cbp + 3, s[3]); }
    if (gw == 0) { float mq = fmaxf(fabsf(P.q_norm_w[lane]), fabsf(P.q_norm_w[lane + 64])); mq = wave_max(mq);
        float mc = wave_max(fmaxf(fabsf(P.k_norm_cmp_w[lane]), fabsf(P.k_norm_cmp_w[lane + 64])));
        float ms = wave_max(fmaxf(fabsf(P.k_norm_slc_w[lane]), fabsf(P.k_norm_slc_w[lane + 64])));
        float mw = wave_max(fmaxf(fabsf(P.k_norm_win_w[lane]), fabsf(P.k_norm_win_w[lane + 64])));
        const float c = 11.313708498984761f * 1.4426950408889634f * mq * 1.01f;
        if (lane == 0) { W.TAB[512] = c * mc; W.TAB[513] = c * ms; W.TAB[514] = c * mw; } }
}

__device__ __forceinline__ void phase_postz(const Params& P, const Ptrs& W, int gw, int nw) {
    const int tid = threadIdx.x, lane = tid & 63;
    const f32x2 wq = *(const f32x2*)(P.q_norm_w + 2 * lane), wks = *(const f32x2*)(P.k_norm_slc_w + 2 * lane), wkw = *(const f32x2*)(P.k_norm_win_w + 2 * lane);
    for (int t = gw; t < S_; t += nw) {
        bf16_t* zr = W.Z + (size_t)t * LDZ;
        float cs0 = 0.f, cs1 = 0.f, sn0 = 0.f, sn1 = 0.f;
        if (lane < 16) { const int i0 = (2 * lane) & 15; cs0 = W.COS[t * 16 + i0]; cs1 = W.COS[t * 16 + i0 + 1]; sn0 = W.SIN[t * 16 + i0]; sn1 = W.SIN[t * 16 + i0 + 1]; }
        unsigned uv[32];
#pragma unroll
        for (int v = 0; v < 32; ++v) { const int col = v < 24 ? OFF_Q + v * HD : (v < 28 ? OFF_KV + 2 * 512 + (v - 24) * HD : OFF_KV + 4 * 512 + (v - 28) * HD);
            uv[v] = *((const unsigned*)(zr + col) + lane); }
#pragma unroll
        for (int v = 0; v < 32; ++v) {
            const f32x2 ww = v < 24 ? wq : (v < 28 ? wks : wkw);
            const unsigned u = uv[v]; const float x0 = bf_lo(u), x1 = bf_hi(u);
            const float ss = wave_sum(x0 * x0 + x1 * x1);
            const float rstd = rsqrtf(ss * (1.0f / HD) + EPS);
            float y0 = x0 * rstd * ww[0], y1 = x1 * rstd * ww[1];
            const float p0 = __shfl_xor(y0, 8), p1 = __shfl_xor(y1, 8);
            if (lane < 8) { y0 = y0 * cs0 - p0 * sn0; y1 = y1 * cs1 - p1 * sn1; }
            else if (lane < 16) { y0 = y0 * cs0 + p0 * sn0; y1 = y1 * cs1 + p1 * sn1; }
            uv[v] = cvt_pk_bf16(y0, y1);
        }
        {
            const int gi = lane >> 4, wlen = 2 << gi, c0 = lane * 16; const int cnt = (t + 1) < wlen ? (t + 1) : wlen;
            float s[16];
#pragma unroll
            for (int i = 0; i < 16; ++i) s[i] = 0.f;
            float cur[16];
#pragma unroll
            for (int bt = 0; bt < 2; ++bt) {
                u32x4 ra[8], rb[8];
#pragma unroll
                for (int i = 0; i < 8; ++i) { const int ii = bt * 8 + i; const size_t row = (size_t)(ii < cnt ? t - ii : t);
                    ra[i] = *(const u32x4*)(W.Z + row * LDZ + c0); rb[i] = *(const u32x4*)(W.Z + row * LDZ + c0 + 8); }
#pragma unroll
                for (int i = 0; i < 8; ++i) { const int ii = bt * 8 + i; const float mk = ii < cnt ? 1.0f : 0.0f; const u32x4 a = ra[i], b = rb[i];
                    const float ev[16] = {bf_lo(a.x), bf_hi(a.x), bf_lo(a.y), bf_hi(a.y), bf_lo(a.z), bf_hi(a.z), bf_lo(a.w), bf_hi(a.w), bf_lo(b.x), bf_hi(b.x), bf_lo(b.y), bf_hi(b.y), bf_lo(b.z), bf_hi(b.z), bf_lo(b.w), bf_hi(b.w)};
#pragma unroll
                    for (int q = 0; q < 16; ++q) { s[q] += ev[q] * mk; if (ii == 0) cur[q] = ev[q]; } }
                if (bt == 0 && __all(cnt <= 8)) break;
            }
            const float rc = 1.0f / (float)cnt;
            u32x4 o0, o1;
            o0.x = cvt_pk_bf16(s[0] * rc - cur[0], s[1] * rc - cur[1]); o0.y = cvt_pk_bf16(s[2] * rc - cur[2], s[3] * rc - cur[3]);
            o0.z = cvt_pk_bf16(s[4] * rc - cur[4], s[5] * rc - cur[5]); o0.w = cvt_pk_bf16(s[6] * rc - cur[6], s[7] * rc - cur[7]);
            o1.x = cvt_pk_bf16(s[8] * rc - cur[8], s[9] * rc - cur[9]); o1.y = cvt_pk_bf16(s[10] * rc - cur[10], s[11] * rc - cur[11]);
            o1.z = cvt_pk_bf16(s[12] * rc - cur[12], s[13] * rc - cur[13]); o1.w = cvt_pk_bf16(s[14] * rc - cur[14], s[15] * rc - cur[15]);
            *(u32x4*)(W.M + (size_t)t * POOLW + c0) = o0; *(u32x4*)(W.M + (size_t)t * POOLW + c0 + 8) = o1;
        }
#pragma unroll
        for (int v = 0; v < 32; ++v) { const int col = v < 24 ? OFF_Q + v * HD : (v < 28 ? OFF_KV + 2 * 512 + (v - 24) * HD : OFF_KV + 4 * 512 + (v - 28) * HD);
            *((unsigned*)(zr + col) + lane) = uv[v]; }

    }
}

__device__ __forceinline__ void phase_cmpfin(const Params& P, const Ptrs& W) {
    const int tid = threadIdx.x, lane = tid & 63, gw = blockIdx.x * NWAVES + (tid >> 6), nw = gridDim.x * NWAVES;
    const f32x2 wk = *(const f32x2*)(P.k_norm_cmp_w + 2 * lane);
    for (int task = gw; task < 8192; task += nw) {
        const int tk = __builtin_amdgcn_readfirstlane(task);
        const int which = tk >> 12, g = (tk >> 10) & 3, n = tk & 1023;
        bf16_t* dst = (which ? W.VC : W.KC) + ((size_t)g * 1024 + n) * HD;
        if (n == 1023) { ((unsigned*)dst)[lane] = 0u; continue; }
        const float* h = W.H1 + (size_t)tk * 256; const float* w2 = which ? P.cmp_v_w2 : P.cmp_k_w2;
        float a0 = 0.f, a1 = 0.f;
        for (int j = 0; j < 256; ++j) { const float hj = h[j]; const f32x2 wv = *(const f32x2*)(w2 + j * HD + 2 * lane); a0 += hj * wv[0]; a1 += hj * wv[1]; }
        if (which == 0) {
            const float ss = wave_sum(a0 * a0 + a1 * a1); const float rstd = rsqrtf(ss * (1.0f / HD) + EPS);
            a0 = a0 * rstd * wk[0]; a1 = a1 * rstd * wk[1];
            const int tp = 16 * n + 31; const float p0 = __shfl_xor(a0, 8), p1 = __shfl_xor(a1, 8);
            if (lane < 16) { const int i0 = (2 * lane) & 15; const float cs0 = W.COS[tp * 16 + i0], cs1 = W.COS[tp * 16 + i0 + 1], sn0 = W.SIN[tp * 16 + i0], sn1 = W.SIN[tp * 16 + i0 + 1];
                if (lane < 8) { a0 = a0 * cs0 - p0 * sn0; a1 = a1 * cs1 - p1 * sn1; } else { a0 = a0 * cs0 + p0 * sn0; a1 = a1 * cs1 + p1 * sn1; } }
        }
        ((unsigned*)dst)[lane] = cvt_pk_bf16(a0, a1);
    }
}

__device__ __forceinline__ void phase_erstd(const Ptrs& W) {
    const int tid = threadIdx.x, lane = tid & 63, gw = blockIdx.x * NWAVES + (tid >> 6), nw = gridDim.x * NWAVES;
    u32x4 a[8], an[8];
    if (gw < S_) { const u32x4* sp = (const u32x4*)(W.ERAW + (size_t)gw * DM);
#pragma unroll
        for (int i = 0; i < 8; ++i) a[i] = sp[lane + 64 * i]; }
    for (int row = gw; row < S_; row += nw) {
        const int nr = row + nw < S_ ? row + nw : row;
        { const u32x4* sp = (const u32x4*)(W.ERAW + (size_t)nr * DM);
#pragma unroll
          for (int i = 0; i < 8; ++i) an[i] = sp[lane + 64 * i]; }
        float ss = 0.f;
#pragma unroll
        for (int i = 0; i < 8; ++i) {
            const float e0 = bf_lo(a[i].x), e1 = bf_hi(a[i].x), e2 = bf_lo(a[i].y), e3 = bf_hi(a[i].y), e4 = bf_lo(a[i].z), e5 = bf_hi(a[i].z), e6 = bf_lo(a[i].w), e7 = bf_hi(a[i].w);
            ss += e0 * e0 + e1 * e1 + e2 * e2 + e3 * e3 + e4 * e4 + e5 * e5 + e6 * e6 + e7 * e7; }
        ss = wave_sum(ss);
        if (lane == 0) W.ERSTD[row] = rsqrtf(ss * (1.0f / DM) + EPS);
#pragma unroll
        for (int i = 0; i < 8; ++i) a[i] = an[i];
    }
}

constexpr int N_PHASES = 11;
__device__ __forceinline__ Params kargs() {
#if defined(__HIP_DEVICE_COMPILE__)
    unsigned long long p = (unsigned long long)__builtin_amdgcn_kernarg_segment_ptr();
    asm volatile("" : "+s"(p));
    return *(const __attribute__((address_space(4))) Params*)p;
#else
    return Params{};
#endif
}
__device__ __forceinline__ Ptrs mkptrs(unsigned char* ws) {
    Ptrs W;
    W.Win = (bf16_t*)(ws + WS_WIN); W.Wo = (bf16_t*)(ws + WS_WO); W.Wfi = (bf16_t*)(ws + WS_WFI); W.Wfo = (bf16_t*)(ws + WS_WFO); W.Wg = (bf16_t*)(ws + WS_WG);
    W.Wple = (bf16_t*)(ws + WS_WPLE); W.Wpool = (bf16_t*)(ws + WS_WPOOL); W.Wc1k = (bf16_t*)(ws + WS_WC1K); W.Wc1v = (bf16_t*)(ws + WS_WC1V);
    W.XN = (bf16_t*)(ws + WS_XN); W.PB = (bf16_t*)(ws + WS_PB); W.Z = (bf16_t*)(ws + WS_Z); W.M = (bf16_t*)(ws + WS_M); W.KC = (bf16_t*)(ws + WS_KC); W.VC = (bf16_t*)(ws + WS_VC);
    W.MIX = (bf16_t*)(ws + WS_MIX); W.ACT = (bf16_t*)(ws + WS_ACT); W.ERAW = (bf16_t*)(ws + WS_ERAW);
    W.COS = (float*)(ws + WS_COS); W.SIN = (float*)(ws + WS_SIN); W.TAB = (float*)(ws + WS_TAB); W.G = (float*)(ws + WS_G); W.H1 = (float*)(ws + WS_H1); W.L = (float*)(ws + WS_L);
    W.OACC = (float*)(ws + WS_OACC); W.IMPP = (float*)(ws + WS_IMPP); W.IMPF = (float*)(ws + WS_IMPF); W.ERSTD = (float*)(ws + WS_ERSTD); W.BM = (unsigned*)(ws + WS_BM);
    return W;
}
__global__ void __launch_bounds__(NTHREADS, 2) fwd(Params Punused) {
    extern __shared__ __attribute__((aligned(16))) unsigned char lds_raw[];
    LAS unsigned char* lds = (LAS unsigned char*)lds_raw;
    const int tid = threadIdx.x;
    const int G = gridDim.x, bid = blockIdx.x;
    const int gw = bid * NWAVES + (tid >> 6), nw = G * NWAVES;

    if (tid < 16) ((LAS unsigned*)(lds + LDS_MISC))[tid] = 0u;
    __syncthreads();
    int lo, hi; XcdBarrier bar;
    { const Params P = kargs(); lo = P.ph_lo; hi = P.ph_hi;
      bar.bar = (unsigned*)(P.ws + WS_CTL); bar.x = 0; bar.st = (volatile LAS unsigned*)(lds + LDS_MISC);
      if (hi - lo > 1) bar = xcd_barrier_post((unsigned*)(P.ws + WS_CTL), (volatile LAS unsigned*)(lds + LDS_MISC)); }
#ifdef PH_MASK
#define IN(k) (((PH_MASK >> (k)) & 1) && lo <= (k) && (k) < hi)
#else
#define IN(k) (lo <= (k) && (k) < hi)
#endif
#define SEAM(k) do { if (IN(k) && IN((k) + 1)) xcd_barrier(bar); } while (0)
#define PHASE_VARS const Params P = kargs(); const Ptrs W = mkptrs(P.ws); (void)W;
#define ATT_ARGS att::AttnArgs AA{W.Z, W.KC, W.VC, W.G, W.L, W.OACC, W.MIX, W.BM, W.TAB};

    if (IN(0)) { PHASE_VARS REP(0) { phase_prologue(P, W, lds); } SEAM(0); }
    if (IN(1)) {
        PHASE_VARS
        { pg8::GStd g{(const char*)W.XN, (const char*)W.Win, DM, DM, DM / 64}; pg8::StaticOrder S; S.init(S_ / 256, POOLW / 256, G, bid);
          pg8::EpiBf16 E{W.Z, LDZ}; pg8::gemm_phase(lds, g, S, E); }
        { pg8::GStd g{(const char*)(P.ws + WS_XN8), (const char*)(P.ws + WS_WIN8), DM / 2, DM / 2, DM / 128}; pg8::StaticOrder S; S.init(S_ / 256, (OFF_G - POOLW) / 256, G, bid);
          pg8::EpiBf16S E{W.Z + POOLW, LDZ, 1.0f / WG8_SCALE}; pg8::gemm_phase<pg8::GStd, pg8::EpiBf16S, true>(lds, g, S, E); }
        SEAM(1);
    }
    if (IN(2)) {
        PHASE_VARS
        if (G > 64) {
            if (bid < 32) { pg8::GCmp g{(const char*)W.Z, (const char*)W.Wc1k, (const char*)W.Wc1v, 16 * LDZ, 4096, 64}; pg8::StaticOrder S; S.init(32, 1, 32, bid);
                pg8::EpiCmpGelu E{W.H1, (const float*)(P.ws + WS_CBIAS)}; pg8::gemm_phase(lds, g, S, E); }
            else if (bid < 96) {
                pg8::GStd g{(const char*)W.XN, (const char*)(W.Win + (size_t)OFF_G * DM), DM, DM, DM / 64}; pg8::StaticOrder S; S.init(S_ / 256, 1, 64, bid - 32);
                pg8::EpiBf16 E{W.Z + OFF_G, LDZ}; pg8::gemm_phase(lds, g, S, E); }
            else phase_postz(P, W, (bid - 96) * NWAVES + (tid >> 6), (G - 96) * NWAVES);
        } else {
            { pg8::GStd g{(const char*)W.XN, (const char*)(W.Win + (size_t)OFF_G * DM), DM, DM, DM / 64}; pg8::StaticOrder S; S.init(S_ / 256, 1, G, bid);
              pg8::EpiBf16 E{W.Z + OFF_G, LDZ}; pg8::gemm_phase(lds, g, S, E); }
            { pg8::GCmp g{(const char*)W.Z, (const char*)W.Wc1k, (const char*)W.Wc1v, 16 * LDZ, 4096, 64}; pg8::StaticOrder S; S.init(32, 1, G, bid);
              pg8::EpiCmpGelu E{W.H1, (const float*)(P.ws + WS_CBIAS)}; pg8::gemm_phase(lds, g, S, E); }
            phase_postz(P, W, gw, nw);
        }
        SEAM(2);
    }
    if (IN(3)) {
        PHASE_VARS
        {
            const size_t i0 = (size_t)bid * NTHREADS + tid, st = (size_t)G * NTHREADS, NG = (size_t)S_ * NGATE;
            for (size_t ib = i0; ib < NG; ib += 9 * st) { float zv[9];
#pragma unroll
                for (int k = 0; k < 9; ++k) { size_t i = ib + k * st; if (i >= NG) i = NG - 1; const int t = (int)(i / NGATE), c = (int)(i % NGATE); zv[k] = bf2f(W.Z[(size_t)t * LDZ + OFF_G + c]); }
#pragma unroll
                for (int k = 0; k < 9; ++k) { const size_t i = ib + k * st; if (i < NG) W.G[i] = sigmoidf_(zv[k]); } } }
        phase_cmpfin(P, W);
        { pg8::GPool g{(const char*)W.M, (const char*)W.Wpool, POOLW, 256, 4}; pg8::StaticOrder S; S.init(S_ / 256, 4, G, bid);
          pg8::EpiBf16Scale E{W.MIX, DM, P.pool_scale}; pg8::gemm_phase(lds, g, S, E); }
        SEAM(3);
    }
    if (IN(4)) {
        PHASE_VARS ATT_ARGS
        REP(4)
        for (int base = 0, rnd = 0; base < 1536; base += G, ++rnd) {
            int qt, g, hp;
            if (G == 256) { const int x = bid & 7, r = bid >> 3, qp = (rnd / 3) ? 63 - r : r; if (rnd >= 6) break; g = x & 3; qt = 2 * qp + (x >> 2); hp = rnd % 3; }
            else { const int Lu = base + ((rnd & 1) ? G - 1 - bid : bid); if (Lu >= 1536) continue; qt = Lu / 12; const int rem = Lu % 12; g = rem / 3; hp = rem % 3; }
            att::attn_unit<att::MODE_CMP>(AA, (LAS char*)lds, qt, g, hp);
            asm volatile("s_waitcnt vmcnt(0)" ::: "memory");
            att::attn_unit<att::MODE_WIN>(AA, (LAS char*)lds, qt, g, hp);
            if (G == 256 && hp == 2) {
                asm volatile("s_waitcnt vmcnt(0)" ::: "memory");
                const int tqi = qt * 8 + (tid >> 6);
                att::imp_task(AA, W.IMPP, W.IMPF, tqi, g);
                asm volatile("s_waitcnt vmcnt(0)" ::: "memory");
                f32x4 pp, ff, pn, fn; att::topk_load(W.IMPP, W.IMPF, tqi * 16, g, pp, ff);
                for (int q = 0; q < 16; ++q) { att::topk_load(W.IMPP, W.IMPF, tqi * 16 + (q < 15 ? q + 1 : q), g, pn, fn); att::topk_task(pp, ff, W.BM, tqi * 16 + q, g); pp = pn; ff = fn; } } }
        if (G != 256) SEAM(4);
    }
    if (IN(5)) {
        PHASE_VARS ATT_ARGS
        if (G != 256)
        for (int k = gw, r = 0; k < 4096; k += nw, ++r) { const int hiT = (r + 1) * nw < 4096 ? (r + 1) * nw : 4096;
            const int task = (r & 1) ? hiT - 1 - (k - r * nw) : k;
            att::imp_task(AA, W.IMPP, W.IMPF, task >> 2, task & 3);
            asm volatile("s_waitcnt vmcnt(0)" ::: "memory");
            { const int tb = (task >> 2) * 16, gg = task & 3; f32x4 pp, ff, pn, fn;
              att::topk_load(W.IMPP, W.IMPF, tb, gg, pp, ff);
              for (int q = 0; q < 16; ++q) { att::topk_load(W.IMPP, W.IMPF, tb + (q < 15 ? q + 1 : q), gg, pn, fn); att::topk_task(pp, ff, W.BM, tb + q, gg); pp = pn; ff = fn; } } }
        SEAM(5);
    }
    if (IN(6)) {
        PHASE_VARS ATT_ARGS
#if SLC16
        for (int base = 0, rnd = 0; base < 1368 + G; base += G, ++rnd) {
            int ut, g;
            if (G == 256) { const int x = bid & 7, r = bid >> 3, k = rnd * 32 + ((rnd & 1) ? 31 - r : r); if (k >= 171) break; g = x & 3; ut = 341 - (2 * k + (x >> 2)); }
            else { const int Lu = base + ((rnd & 1) ? G - 1 - bid : bid); if (Lu >= 1368) continue; ut = 341 - Lu / 4; g = Lu % 4; }
            att::slc16_unit(AA, (LAS char*)lds, ut, g); }
#else
        REP(6)
        for (int base = 0, rnd = 0; base < 1640 + G; base += G, ++rnd) {
            int ut, g;
            if (G == 256) { const int x = bid & 7, r = bid >> 3, k = rnd * 32 + ((rnd & 1) ? 31 - r : r); if (k >= 205) break; g = x & 3; ut = 409 - (2 * k + (x >> 2)); }
            else { const int Lu = base + ((rnd & 1) ? G - 1 - bid : bid); if (Lu >= 1640) continue; ut = 409 - Lu / 4; g = Lu % 4; }
            att::attn_unit<att::MODE_SLC>(AA, (LAS char*)lds, ut, g, 0); }
#endif
        SEAM(6);
    }
    if (IN(7)) {
        PHASE_VARS
        { pg8::GStd g{(const char*)W.MIX, (const char*)W.Wo, DM, DM, DM / 64}; pg8::StaticOrder S; S.init(S_ / 256, DM / 256, G, bid);
          pg8::EpiResNorm E{P.x, P.out, W.XN, P.norm2_w, (float*)(P.ws + WS_SSQ1), DM}; pg8::gemm_phase(lds, g, S, E); }
        { pg8::GStd g{(const char*)W.PB, (const char*)W.Wple, PLE, PLE, PLE / 64}; pg8::StaticOrder S; S.init(S_ / 256, DM / 256, G, bid);
          pg8::EpiBf16Ssq E{W.ERAW, DM, (float*)(P.ws + WS_SSQ3)}; pg8::gemm_phase(lds, g, S, E); }
        SEAM(7);
    }
    if (IN(8)) {
        PHASE_VARS
        pg8::GFfn g{(const char*)W.XN, (const char*)W.Wfi, DM, DM, DM / 64}; pg8::StaticOrder S; S.init(65, DFF / 128, G, bid);
        pg8::EpiFfn E{W.ACT, P.conv_w, P.conv_b, (LAS float*)(lds + LDS_XCH), (const float*)(P.ws + WS_SSQ1)}; REP(8) { pg8::gemm_phase(lds, g, S, E); } SEAM(8);
    }
    if (IN(9)) {
        PHASE_VARS
        pg8::GStd g{(const char*)W.ACT, (const char*)W.Wfo, DFF, DFF, DFF / 64}; pg8::StaticOrder S; S.init(S_ / 256, DM / 256, G, bid);
        pg8::EpiResNormF8 E{P.out, P.out, W.XN, P.ple_gate_norm_w, (float*)(P.ws + WS_SSQ2), DM}; pg8::gemm_phase(lds, g, S, E); SEAM(9);
    }
    if (IN(10)) {
        PHASE_VARS
        pg8::GStd g{(const char*)W.XN, (const char*)W.Wg, DM / 2, DM / 2, DM / 128}; pg8::StaticOrder S; S.init(S_ / 256, DM / 256, G, bid);
        pg8::EpiGate E{P.out, W.ERAW, (const float*)(P.ws + WS_SSQ3), P.ple_norm_w, (const float*)(P.ws + WS_SSQ2), DM, 1.0f / WG8_SCALE};
        pg8::gemm_phase<pg8::GStd, pg8::EpiGate, true>(lds, g, S, E);
    }
#undef IN
#undef SEAM
}

extern "C" void kernel_launch(void* const* d_in, const int* in_sizes, int n_in, void* d_out, int out_size, void* d_ws, size_t ws_size, hipStream_t stream) {
    static int grid = 0;
    if (grid == 0) {
        if (n_in != 27 || in_sizes[0] != S_ * DM || out_size != S_ * DM || ws_size < WS_NEED) {
            fprintf(stderr, "kernel_launch: unexpected shapes (n_in %d, in0 %d, out %d, ws %zu < %zu); nothing launched\n", n_in, n_in > 0 ? in_sizes[0] : -1, out_size, ws_size, (size_t)WS_NEED); grid = -1; return; }
        int dev = 0, cus = 0, per_cu = 0;
        if (hipGetDevice(&dev) != hipSuccess || hipDeviceGetAttribute(&cus, hipDeviceAttributeMultiprocessorCount, dev) != hipSuccess) { grid = -1; return; }
        if (hipFuncSetAttribute((const void*)fwd, hipFuncAttributeMaxDynamicSharedMemorySize, LDS_BYTES) != hipSuccess) { fprintf(stderr, "kernel_launch: hipFuncSetAttribute failed\n"); grid = -1; return; }
        if (hipOccupancyMaxActiveBlocksPerMultiprocessor(&per_cu, (const void*)fwd, NTHREADS, LDS_BYTES) != hipSuccess || per_cu < 1) { fprintf(stderr, "kernel_launch: occupancy query says %d\n", per_cu); (void)hipGetLastError(); }
        grid = cus > 256 ? 256 : cus;
    }
    if (grid < 0) return;
    (void)hipMemsetAsync((char*)d_ws + WS_CTL, 0, CTL_BYTES, stream);
    Params P{};
    const float** fp = (const float**)&P;
    P.x = (const float*)d_in[0]; P.p = (const float*)d_in[1]; P.positions = (const int*)d_in[2]; P.norm1_w = (const float*)d_in[3]; P.w_in = (const float*)d_in[4];
    P.w_pool = (const float*)d_in[5]; P.pool_scale = (const float*)d_in[6]; P.q_norm_w = (const float*)d_in[7]; P.k_norm_cmp_w = (const float*)d_in[8];
    P.k_norm_slc_w = (const float*)d_in[9]; P.k_norm_win_w = (const float*)d_in[10]; P.cmp_pos_k = (const float*)d_in[11]; P.cmp_pos_v = (const float*)d_in[12];
    P.cmp_k_w1 = (const float*)d_in[13]; P.cmp_k_w2 = (const float*)d_in[14]; P.cmp_v_w1 = (const float*)d_in[15]; P.cmp_v_w2 = (const float*)d_in[16];
    P.w_o = (const float*)d_in[17]; P.norm2_w = (const float*)d_in[18]; P.w_ffn_in = (const float*)d_in[19]; P.conv_w = (const float*)d_in[20]; P.conv_b = (const float*)d_in[21];
    P.w_ffn_out = (const float*)d_in[22]; P.w_ple_proj = (const float*)d_in[23]; P.ple_norm_w = (const float*)d_in[24]; P.ple_gate_norm_w = (const float*)d_in[25]; P.w_ple_gate = (const float*)d_in[26];
    (void)fp;
    P.out = (float*)d_out; P.ws = (unsigned char*)d_ws;
#if MK_ONE_LAUNCH
    P.ph_lo = 0; P.ph_hi = N_PHASES;
    hipLaunchKernelGGL(fwd, dim3(grid), dim3(NTHREADS), LDS_BYTES, stream, P);
#else
    for (int ph = 0; ph < N_PHASES; ++ph) { P.ph_lo = ph; P.ph_hi = ph + 1; hipLaunchKernelGGL(fwd, dim3(grid), dim3(NTHREADS), LDS_BYTES, stream, P); }
#endif
    const hipError_t le = hipPeekAtLastError();
    if (le != hipSuccess) fprintf(stderr, "kernel_launch: launch failed: %s\n", hipGetErrorName(le));
}
```

```cpp
#include <hip/hip_runtime.h>
#include <cstdio>
#include <cstdint>

#ifndef PROBE_DBL
#define PROBE_DBL 0
#endif
#define REP(k) _Pragma("unroll") for (int rep_ = 0; rep_ < 1 + ((PROBE_DBL >> (k)) & 1); ++rep_)
#ifndef SLC16
#define SLC16 1
#endif
#ifndef MK_ONE_LAUNCH
#define MK_ONE_LAUNCH 1
#endif

#define LAS __attribute__((address_space(3)))
typedef unsigned short bf16_t;
typedef short bf16x8 __attribute__((ext_vector_type(8)));
typedef short s16x4 __attribute__((ext_vector_type(4)));
typedef float f32x2 __attribute__((ext_vector_type(2)));
typedef float f32x4 __attribute__((ext_vector_type(4)));
typedef float f32x16 __attribute__((ext_vector_type(16)));
typedef unsigned u32x2 __attribute__((ext_vector_type(2)));
typedef unsigned u32x4 __attribute__((ext_vector_type(4)));
typedef int i32x4 __attribute__((ext_vector_type(4)));
typedef int i32x8 __attribute__((ext_vector_type(8)));

constexpr int S_ = 16384, DM = 4096, INW = 7240, LDZ = 7424, POOLW = 1024, NH = 24, NKV = 4, HPG = 6, HD = 128;
constexpr int OFF_Q = 1024, OFF_KV = 4096, OFF_G = 7168, DFF = 11008, NFI = 22016, PLE = 256, NGATE = 72;
constexpr int ZROWS = S_ + 64, XNROWS = S_ + 256, CHUNK = 8192;
constexpr float EPS = 1e-6f;
constexpr float SM_C = 0.08838834764831845f * 1.4426950408889634f;
constexpr int NWAVES = 8, NTHREADS = 512;
constexpr float WG8_SCALE = 128.0f;

constexpr size_t al256(size_t x) { return (x + 255) / 256 * 256; }
constexpr size_t WS_CTL   = 0;
constexpr size_t CTL_BYTES = 262144;
constexpr size_t WS_CBIAS = WS_CTL + 32768;
constexpr size_t WS_SSQ1 = WS_CTL + 65536, WS_SSQ2 = WS_CTL + 131072, WS_SSQ3 = WS_CTL + 196608;
constexpr size_t WS_WIN   = WS_CTL + CTL_BYTES;
constexpr size_t WS_WO    = WS_WIN + al256((size_t)LDZ * DM * 2);
constexpr size_t WS_WFI   = WS_WO + al256((size_t)DM * DM * 2);
constexpr size_t WS_WFO   = WS_WFI + al256((size_t)NFI * DM * 2);
constexpr size_t WS_WG    = WS_WFO + al256((size_t)DM * DFF * 2);
constexpr size_t WS_WPLE  = WS_WG + al256((size_t)DM * DM * 2);
constexpr size_t WS_WPOOL = WS_WPLE + al256((size_t)DM * PLE * 2);
constexpr size_t WS_WC1K  = WS_WPOOL + al256((size_t)1024 * 256 * 2);
constexpr size_t WS_WC1V  = WS_WC1K + al256((size_t)256 * 4096 * 2);
constexpr size_t WS_COS   = WS_WC1V + al256((size_t)256 * 4096 * 2);
constexpr size_t WS_SIN   = WS_COS + al256((size_t)S_ * 16 * 4);
constexpr size_t WS_TAB   = WS_SIN + al256((size_t)S_ * 16 * 4);
constexpr size_t WS_XNP   = WS_TAB + 4096;
constexpr size_t WS_XN    = WS_XNP + (size_t)2 * DM * 2;
constexpr size_t WS_PB    = WS_XN + al256((size_t)XNROWS * DM * 2);
constexpr size_t WS_XN8   = WS_PB + al256((size_t)S_ * PLE * 2);
constexpr size_t WS_WIN8  = WS_XN8 + al256((size_t)S_ * DM);
constexpr size_t WS_R     = WS_WIN8 + al256((size_t)(OFF_G - POOLW) * DM);
constexpr size_t WS_Z     = WS_R;
constexpr size_t WS_M     = WS_Z + al256((size_t)ZROWS * LDZ * 2);
constexpr size_t WS_G     = WS_M + al256((size_t)S_ * POOLW * 2);
constexpr size_t WS_H1    = WS_G + al256((size_t)S_ * NGATE * 4);
constexpr size_t WS_KC    = WS_H1 + al256((size_t)8192 * 256 * 4);
constexpr size_t WS_VC    = WS_KC + al256((size_t)4 * 1024 * 128 * 2);
constexpr size_t WS_L     = WS_VC + al256((size_t)4 * 1024 * 128 * 2);
constexpr size_t WS_OACC  = WS_L + al256((size_t)S_ * NH * 4);
constexpr size_t WS_IMPP  = WS_OACC + al256((size_t)S_ * 3072 * 4);
constexpr size_t WS_IMPF  = WS_IMPP + al256((size_t)S_ * 4 * 256 * 4);
constexpr size_t WS_BM    = WS_IMPF + al256((size_t)S_ * 4 * 256 * 4);
constexpr size_t WS_MIX   = WS_BM + al256((size_t)S_ * 4 * 8 * 4);
constexpr size_t WS_END_A = WS_MIX + al256((size_t)S_ * DM * 2);
constexpr size_t WS_ERAW  = WS_R;
constexpr size_t WS_ACT   = WS_ERAW + al256((size_t)S_ * DM * 2);
constexpr size_t WS_ERSTD = WS_ACT + al256((size_t)S_ * DFF * 2);
constexpr size_t WS_END_B = WS_ERSTD + al256((size_t)S_ * 4);
static_assert(WS_ERAW + (size_t)S_ * DM * 2 <= WS_Z + (size_t)ZROWS * LDZ * 2, "eraw must fit inside the dead z region while mix is still being read");
constexpr size_t WS_NEED  = WS_END_A > WS_END_B ? WS_END_A : WS_END_B;
static_assert(WS_NEED <= (size_t)1440000000, "workspace map exceeds the guaranteed 4 x largest-tensor bytes");

constexpr int LDS_STAGE = 131072;
constexpr int LDS_XCH   = LDS_STAGE + 64;
constexpr int LDS_MISC  = 147456;
constexpr int LDS_BYTES = LDS_MISC + 64;

__device__ __forceinline__ unsigned cvt_pk_bf16(float lo, float hi) { unsigned r; asm volatile("v_cvt_pk_bf16_f32 %0, %1, %2" : "=v"(r) : "v"(lo), "v"(hi)); return r; }
__device__ __forceinline__ float bf_lo(unsigned u) { return __uint_as_float(u << 16); }
__device__ __forceinline__ float bf_hi(unsigned u) { return __uint_as_float(u & 0xffff0000u); }
__device__ __forceinline__ float bf2f(bf16_t b) { return __uint_as_float(((unsigned)b) << 16); }
__device__ __forceinline__ float wave_sum(float v) {
#pragma unroll
    for (int o = 32; o >= 1; o >>= 1) v += __shfl_xor(v, o);
    return v;
}
__device__ __forceinline__ float wave_max(float v) {
#pragma unroll
    for (int o = 32; o >= 1; o >>= 1) v = fmaxf(v, __shfl_xor(v, o));
    return v;
}
__device__ __forceinline__ float sigmoidf_(float x) { return __builtin_amdgcn_rcpf(1.0f + __expf(-x)); }

#define XB_TMO      128
#define XB_XCNT(j)  (256  + 64 * (j))
#define XB_XSUB(j)  (1280 + 64 * (j))
#define XB_XGEN(j)  (2304 + 64 * (j))
#define XB_TOP      3328
#define XB_TOPGEN   3392
#define XCD_BAR_WORDS 3456
#define XB_SPIN_CAP (1u << 18)
__device__ __forceinline__ unsigned xb_ld(unsigned* p)              { return __hip_atomic_load(p, __ATOMIC_RELAXED, __HIP_MEMORY_SCOPE_AGENT); }
__device__ __forceinline__ unsigned xb_add(unsigned* p, unsigned v) { return __hip_atomic_fetch_add(p, v, __ATOMIC_RELAXED, __HIP_MEMORY_SCOPE_AGENT); }
__device__ __forceinline__ unsigned xb_xcc_id() { return (unsigned)__builtin_amdgcn_s_getreg((3 << 11) | 20) & 0xFu; }
#define XB_SPIN(cond, bar) do { unsigned _sp = 0; while (cond) { __builtin_amdgcn_s_sleep(1); \
    if ((++_sp & 255u) == 0u) { if (xb_ld(&(bar)[XB_TMO])) break; if (_sp > XB_SPIN_CAP) { atomicAdd(&(bar)[XB_TMO], 1u); break; } } } } while (0)
struct XcdBarrier { unsigned* bar; unsigned x; volatile LAS unsigned* st; };
__device__ __forceinline__ XcdBarrier xcd_barrier_post(unsigned* bar, volatile LAS unsigned* st) {
    XcdBarrier b; b.bar = bar; b.x = xb_xcc_id(); b.st = st;
    if (threadIdx.x == 0) (void)xb_add(&bar[XB_XCNT(b.x)], 1u);
    return b;
}
__device__ __forceinline__ void xcd_barrier_complete(unsigned* bar, unsigned x, unsigned& nloc, unsigned& nx) {
    const unsigned G = gridDim.x * gridDim.y * gridDim.z;
    unsigned sum, cnt, mine, sp = 0u;
    for (;;) {
        sum = 0u; cnt = 0u; mine = 0u;
#pragma unroll
        for (unsigned j = 0; j < 16; ++j) { const unsigned c = xb_ld(&bar[XB_XCNT(j)]); sum += c; cnt += (c > 0u) ? 1u : 0u; mine = (j == x) ? c : mine; }
        if (sum == G) break;
        __builtin_amdgcn_s_sleep(1);
        if ((++sp & 255u) == 0u) { if (xb_ld(&bar[XB_TMO])) break; if (sp > XB_SPIN_CAP) { atomicAdd(&bar[XB_TMO], 1u); break; } }
    }
    nloc = mine > 0u ? mine : 1u; nx = cnt > 0u ? cnt : 1u;
}
__device__ __forceinline__ void xcd_barrier(const XcdBarrier& b) {
    asm volatile("s_waitcnt vmcnt(0)" ::: "memory");
    __syncthreads();
    if (threadIdx.x == 0) {
        unsigned* bar = b.bar;
        __builtin_amdgcn_s_waitcnt(0);
        unsigned nloc = b.st[0], nx = b.st[1];
        if (nloc == 0u) { xcd_barrier_complete(bar, b.x, nloc, nx); b.st[0] = nloc; b.st[1] = nx; }
        const unsigned old = xb_add(&bar[XB_XSUB(b.x)], 1u);
        const unsigned gen = old / nloc;
        if (old + 1u == (gen + 1u) * nloc) {
            __builtin_amdgcn_fence(__ATOMIC_RELEASE, "agent");
            asm volatile("s_waitcnt vmcnt(0)" ::: "memory");
            const unsigned og = xb_add(&bar[XB_TOP], 1u);
            const unsigned tg = og / nx;
            if (og + 1u == (tg + 1u) * nx) xb_add(&bar[XB_TOPGEN], 1u);
            else XB_SPIN(xb_ld(&bar[XB_TOPGEN]) == tg, bar);
            __builtin_amdgcn_fence(__ATOMIC_ACQUIRE, "agent");
            xb_add(&bar[XB_XGEN(b.x)], 1u);
            asm volatile("s_waitcnt vmcnt(0)" ::: "memory");
        } else {
            XB_SPIN(xb_ld(&bar[XB_XGEN(b.x)]) == gen, bar);
            __builtin_amdgcn_fence(__ATOMIC_ACQUIRE, "agent");
            asm volatile("s_waitcnt vmcnt(0)" ::: "memory");
        }
    }
    __syncthreads();
}

struct Params {
    const float* x; const float* p; const int* positions; const float* norm1_w; const float* w_in; const float* w_pool; const float* pool_scale;
    const float* q_norm_w; const float* k_norm_cmp_w; const float* k_norm_slc_w; const float* k_norm_win_w; const float* cmp_pos_k; const float* cmp_pos_v;
    const float* cmp_k_w1; const float* cmp_k_w2; const float* cmp_v_w1; const float* cmp_v_w2; const float* w_o; const float* norm2_w; const float* w_ffn_in;
    const float* conv_w; const float* conv_b; const float* w_ffn_out; const float* w_ple_proj; const float* ple_norm_w; const float* ple_gate_norm_w; const float* w_ple_gate;
    float* out; unsigned char* ws; int ph_lo, ph_hi;
};

namespace pg8 {
constexpr int BM = 256, BK = 64, HALF = 128, HTB = HALF * BK * 2, STAGE_BYTES = 8 * HTB, NXCD = 8, WGM = 8;
__host__ __device__ __forceinline__ int lds_byte(int r, int c) { const int st = (r >> 4) * 2 + (c >> 5), rr = r & 15, cc = c & 31, ob = rr * 64 + cc * 2; return st * 1024 + (ob ^ (((ob >> 9) & 1) << 5)); }
__host__ __device__ __forceinline__ void stage_rc(int b, int& R, int& C) { const int st = b / 1024, sb = b % 1024, swz = sb ^ (((sb >> 9) & 1) << 5); R = (st >> 1) * 16 + swz / 64; C = (st & 1) * 32 + (swz % 64) / 2; }
__host__ __device__ __forceinline__ int perm32(int rho) { const int n = rho >> 4, i = rho & 15; return 8 * (i >> 2) + 4 * n + (i & 3); }
struct Unit { int pm, pn; };

struct StaticOrder {
    int nM, nN, nwg, G, c;
    __device__ void init(int nM_, int nN_, int G_, int c_) { nM = nM_; nN = nN_; nwg = nM * nN; G = G_; c = c_; }
    __device__ bool next(int i, Unit& u) const {
        const long L = (long)i * G + c; if (L >= nwg) return false;
        int wgid = (int)L; { const int q = nwg / NXCD, r = nwg % NXCD, xcd = wgid % NXCD, off = wgid / NXCD; wgid = (xcd < r ? xcd * (q + 1) : r * (q + 1) + (xcd - r) * q) + off; }
        const int nig = WGM * nN, gid = wgid / nig, fm = gid * WGM, gsz = (nM - fm) < WGM ? (nM - fm) : WGM;
        u.pm = fm + ((wgid % nig) % gsz); u.pn = (wgid % nig) / gsz; return true;
    }
};

struct GStd {
    const char* A; const char* B; unsigned lda, ldb; int nt;
    __device__ __forceinline__ const char* a_base(const Unit& u) const { return A + (size_t)u.pm * 256 * lda * 2; }
    __device__ __forceinline__ const char* b_base(const Unit& u) const { return B + (size_t)u.pn * 256 * ldb * 2; }
    __device__ __forceinline__ size_t kpairA() const { return 256; }
};
struct GPool {
    const char* A; const char* B; unsigned lda, ldb; int nt;
    __device__ __forceinline__ const char* a_base(const Unit& u) const { return A + (size_t)u.pm * 256 * lda * 2 + (size_t)u.pn * 512; }
    __device__ __forceinline__ const char* b_base(const Unit& u) const { return B + (size_t)u.pn * 256 * ldb * 2; }
    __device__ __forceinline__ size_t kpairA() const { return 256; }
};
struct GCmp {
    const char* Z; const char* Bk; const char* Bv; unsigned lda, ldb; int nt;
    __device__ __forceinline__ const char* a_base(const Unit& u) const { const int which = u.pm >> 4, g = (u.pm >> 2) & 3, rt = u.pm & 3;
        return Z + (size_t)(OFF_KV + which * 512 + g * 128) * 2 + (size_t)rt * 256 * lda * 2; }
    __device__ __forceinline__ const char* b_base(const Unit& u) const { return (u.pm >> 4) ? Bv : Bk; }
    __device__ __forceinline__ size_t kpairA() const { return (size_t)LDZ * 2; }
};

struct EpiBf16 {
    static constexpr bool PERM = true;
    bf16_t* O; int ldc;
    __device__ __forceinline__ void operator()(const f32x4 (&acc)[2][2][4][2], const Unit& u, int wr, int wc, int fr, int fq) const {
        const int row0 = u.pm * BM + wr * 64 + fr, col0 = u.pn * BM + wc * 32 + 8 * fq;
#pragma unroll
        for (int ai = 0; ai < 2; ++ai)
#pragma unroll
            for (int m = 0; m < 4; ++m) { bf16_t* rowp = O + (size_t)(row0 + ai * HALF + m * 16) * ldc + col0;
#pragma unroll
                for (int bj = 0; bj < 2; ++bj) { const f32x4 v0 = acc[ai][bj][m][0], v1 = acc[ai][bj][m][1];
                    u32x4 w; w.x = cvt_pk_bf16(v0[0], v0[1]); w.y = cvt_pk_bf16(v0[2], v0[3]); w.z = cvt_pk_bf16(v1[0], v1[1]); w.w = cvt_pk_bf16(v1[2], v1[3]);
                    *(u32x4*)(rowp + bj * HALF) = w; } }
    }
};
struct EpiBf16S {
    static constexpr bool PERM = true;
    bf16_t* O; int ldc; float s;
    __device__ __forceinline__ void operator()(const f32x4 (&acc)[2][2][4][2], const Unit& u, int wr, int wc, int fr, int fq) const {
        const int row0 = u.pm * BM + wr * 64 + fr, col0 = u.pn * BM + wc * 32 + 8 * fq;
#pragma unroll
        for (int ai = 0; ai < 2; ++ai)
#pragma unroll
            for (int m = 0; m < 4; ++m) { bf16_t* rowp = O + (size_t)(row0 + ai * HALF + m * 16) * ldc + col0;
#pragma unroll
                for (int bj = 0; bj < 2; ++bj) { const f32x4 v0 = acc[ai][bj][m][0] * s, v1 = acc[ai][bj][m][1] * s;
                    u32x4 w; w.x = cvt_pk_bf16(v0[0], v0[1]); w.y = cvt_pk_bf16(v0[2], v0[3]); w.z = cvt_pk_bf16(v1[0], v1[1]); w.w = cvt_pk_bf16(v1[2], v1[3]);
                    *(u32x4*)(rowp + bj * HALF) = w; } }
    }
};
struct EpiBf16Ssq {
    static constexpr bool PERM = true;
    bf16_t* O; int ldc; float* ssq;
    __device__ __forceinline__ void operator()(const f32x4 (&acc)[2][2][4][2], const Unit& u, int wr, int wc, int fr, int fq) const {
        const int row0 = u.pm * BM + wr * 64 + fr, col0 = u.pn * BM + wc * 32 + 8 * fq;
#pragma unroll
        for (int ai = 0; ai < 2; ++ai)
#pragma unroll
            for (int m = 0; m < 4; ++m) { const int row = row0 + ai * HALF + m * 16; bf16_t* rowp = O + (size_t)row * ldc + col0; float s = 0.f;
#pragma unroll
                for (int bj = 0; bj < 2; ++bj) { const f32x4 v0 = acc[ai][bj][m][0], v1 = acc[ai][bj][m][1];
                    s += v0[0] * v0[0] + v0[1] * v0[1] + v0[2] * v0[2] + v0[3] * v0[3] + v1[0] * v1[0] + v1[1] * v1[1] + v1[2] * v1[2] + v1[3] * v1[3];
                    u32x4 w; w.x = cvt_pk_bf16(v0[0], v0[1]); w.y = cvt_pk_bf16(v0[2], v0[3]); w.z = cvt_pk_bf16(v1[0], v1[1]); w.w = cvt_pk_bf16(v1[2], v1[3]);
                    *(u32x4*)(rowp + bj * HALF) = w; }
                s += __shfl_xor(s, 16); s += __shfl_xor(s, 32);
                if (fq == 0) unsafeAtomicAdd(ssq + row, s); }
    }
};
struct EpiBf16Scale {
    static constexpr bool PERM = true;
    bf16_t* O; int ldc; const float* colscale;
    __device__ __forceinline__ void operator()(const f32x4 (&acc)[2][2][4][2], const Unit& u, int wr, int wc, int fr, int fq) const {
        const int row0 = u.pm * BM + wr * 64 + fr, col0 = u.pn * BM + wc * 32 + 8 * fq;
#pragma unroll
        for (int bj = 0; bj < 2; ++bj) { const f32x4 s0 = *(const f32x4*)(colscale + col0 + bj * HALF), s1 = *(const f32x4*)(colscale + col0 + bj * HALF + 4);
#pragma unroll
            for (int ai = 0; ai < 2; ++ai)
#pragma unroll
                for (int m = 0; m < 4; ++m) { bf16_t* rowp = O + (size_t)(row0 + ai * HALF + m * 16) * ldc + col0;
                    const f32x4 v0 = acc[ai][bj][m][0] * s0, v1 = acc[ai][bj][m][1] * s1;
                    u32x4 w; w.x = cvt_pk_bf16(v0[0], v0[1]); w.y = cvt_pk_bf16(v0[2], v0[3]); w.z = cvt_pk_bf16(v1[0], v1[1]); w.w = cvt_pk_bf16(v1[2], v1[3]);
                    *(u32x4*)(rowp + bj * HALF) = w; } }
    }
};
struct EpiResF32 {
    static constexpr bool PERM = false;
    const float* base; float* C; int ldc; int row_off;
    __device__ __forceinline__ void operator()(const f32x4 (&acc)[2][2][4][2], const Unit& u, int wr, int wc, int fr, int fq) const {
        const int row0 = u.pm * BM + wr * 64 + fr + row_off, col0 = u.pn * BM + wc * 32 + 4 * fq;
#pragma unroll
        for (int ai = 0; ai < 2; ++ai)
#pragma unroll
            for (int m = 0; m < 4; ++m) { const size_t off = (size_t)(row0 + ai * HALF + m * 16) * ldc + col0;
#pragma unroll
                for (int bj = 0; bj < 2; ++bj)
#pragma unroll
                    for (int n = 0; n < 2; ++n) { const f32x4 b = *(const f32x4*)(base + off + bj * HALF + n * 16); *(f32x4*)(C + off + bj * HALF + n * 16) = b + acc[ai][bj][m][n]; }
                asm volatile("" ::: "memory"); }
    }
};
template <bool FP8OUT>
struct EpiResNormT {
    static constexpr bool PERM = false;
    const float* base; float* C; bf16_t* XN; const float* nw; float* ssq; int ldc;
    __device__ __forceinline__ void operator()(const f32x4 (&acc)[2][2][4][2], const Unit& u, int wr, int wc, int fr, int fq) const {
        const int row0 = u.pm * BM + wr * 64 + fr, col0 = u.pn * BM + wc * 32 + 4 * fq;
        f32x4 wv[2][2];
#pragma unroll
        for (int bj = 0; bj < 2; ++bj)
#pragma unroll
            for (int n = 0; n < 2; ++n) wv[bj][n] = *(const f32x4*)(nw + col0 + bj * HALF + n * 16);
        f32x4 bv[2][2][2];
#pragma unroll
        for (int bj = 0; bj < 2; ++bj)
#pragma unroll
            for (int n = 0; n < 2; ++n) bv[0][bj][n] = *(const f32x4*)(base + (size_t)row0 * ldc + col0 + bj * HALF + n * 16);
#pragma unroll
        for (int rg = 0; rg < 8; ++rg) { const int ai = rg >> 2, m = rg & 3; const int row = row0 + ai * HALF + m * 16; const size_t off = (size_t)row * ldc + col0;
            if (rg < 7) { const int ai2 = (rg + 1) >> 2, m2 = (rg + 1) & 3; const size_t off2 = (size_t)(row0 + ai2 * HALF + m2 * 16) * ldc + col0;
#pragma unroll
                for (int bj = 0; bj < 2; ++bj)
#pragma unroll
                    for (int n = 0; n < 2; ++n) bv[(rg + 1) & 1][bj][n] = *(const f32x4*)(base + off2 + bj * HALF + n * 16); }
            float s = 0.f;
#pragma unroll
            for (int bj = 0; bj < 2; ++bj)
#pragma unroll
                for (int n = 0; n < 2; ++n) { const f32x4 v = bv[rg & 1][bj][n] + acc[ai][bj][m][n];
                    *(f32x4*)(C + off + bj * HALF + n * 16) = v; s += v[0] * v[0] + v[1] * v[1] + v[2] * v[2] + v[3] * v[3];
                    if (FP8OUT) { int pk = __builtin_amdgcn_cvt_pk_fp8_f32(v[0] * wv[bj][n][0], v[1] * wv[bj][n][1], 0, false); pk = __builtin_amdgcn_cvt_pk_fp8_f32(v[2] * wv[bj][n][2], v[3] * wv[bj][n][3], pk, true);
                        *(int*)((unsigned char*)XN + off + bj * HALF + n * 16) = pk; }
                    else { u32x2 o; o.x = cvt_pk_bf16(v[0] * wv[bj][n][0], v[1] * wv[bj][n][1]); o.y = cvt_pk_bf16(v[2] * wv[bj][n][2], v[3] * wv[bj][n][3]);
                        *(u32x2*)(XN + off + bj * HALF + n * 16) = o; } }
            s += __shfl_xor(s, 16); s += __shfl_xor(s, 32);
            if (fq == 0) unsafeAtomicAdd(ssq + row, s);
        }
    }
};
typedef EpiResNormT<false> EpiResNorm;
typedef EpiResNormT<true> EpiResNormF8;
struct EpiCmpGelu {
    static constexpr bool PERM = false;
    float* H; const float* bias;
    __device__ __forceinline__ void operator()(const f32x4 (&acc)[2][2][4][2], const Unit& u, int wr, int wc, int fr, int fq) const {
        const int row0 = u.pm * BM + wr * 64 + fr, col0 = wc * 32 + 4 * fq; const float* bs = bias + (u.pm >> 4) * 256;
        f32x4 bvv[2][2];
#pragma unroll
        for (int bj = 0; bj < 2; ++bj)
#pragma unroll
            for (int n = 0; n < 2; ++n) bvv[bj][n] = *(const f32x4*)(bs + col0 + bj * HALF + n * 16);
#pragma unroll
        for (int ai = 0; ai < 2; ++ai)
#pragma unroll
            for (int m = 0; m < 4; ++m) { float* rowp = H + (size_t)(row0 + ai * HALF + m * 16) * 256 + col0;
#pragma unroll
                for (int bj = 0; bj < 2; ++bj)
#pragma unroll
                    for (int n = 0; n < 2; ++n) { f32x4 v = acc[ai][bj][m][n] + bvv[bj][n];
#pragma unroll
                        for (int j = 0; j < 4; ++j) { const float xx = v[j], uu = 0.7978845608028654f * (xx + 0.044715f * xx * xx * xx); const float th = 1.0f - 2.0f / (1.0f + __expf(2.0f * uu)); v[j] = 0.5f * xx * (1.0f + th); }
                        *(f32x4*)(rowp + bj * HALF + n * 16) = v; } }
    }
};
struct EpiGate {
    static constexpr bool PERM = false;
    float* C; const bf16_t* eraw; const float* erstd; const float* pw; const float* ssq; int ldc; float ascale;
    __device__ __forceinline__ void operator()(const f32x4 (&acc)[2][2][4][2], const Unit& u, int wr, int wc, int fr, int fq) const {
        const int row0 = u.pm * BM + wr * 64 + fr, col0 = u.pn * BM + wc * 32 + 4 * fq;
        f32x4 wv[2][2];
#pragma unroll
        for (int bj = 0; bj < 2; ++bj)
#pragma unroll
            for (int n = 0; n < 2; ++n) wv[bj][n] = *(const f32x4*)(pw + col0 + bj * HALF + n * 16);
        f32x4 bv[2][2][2]; u32x2 ev[2][2][2]; float rsv[2], rgv[2];
#pragma unroll
        for (int bj = 0; bj < 2; ++bj)
#pragma unroll
            for (int n = 0; n < 2; ++n) { bv[0][bj][n] = *(const f32x4*)(C + (size_t)row0 * ldc + col0 + bj * HALF + n * 16); ev[0][bj][n] = *(const u32x2*)(eraw + (size_t)row0 * ldc + col0 + bj * HALF + n * 16); }
        rsv[0] = erstd[row0]; rgv[0] = ssq[row0];
#pragma unroll
        for (int rg = 0; rg < 8; ++rg) { const int ai = rg >> 2, m = rg & 3; const int row = row0 + ai * HALF + m * 16; const size_t off = (size_t)row * ldc + col0;
            if (rg < 7) { const int ai2 = (rg + 1) >> 2, m2 = (rg + 1) & 3; const int row2 = row0 + ai2 * HALF + m2 * 16; const size_t off2 = (size_t)row2 * ldc + col0;
#pragma unroll
                for (int bj = 0; bj < 2; ++bj)
#pragma unroll
                    for (int n = 0; n < 2; ++n) { bv[(rg + 1) & 1][bj][n] = *(const f32x4*)(C + off2 + bj * HALF + n * 16); ev[(rg + 1) & 1][bj][n] = *(const u32x2*)(eraw + off2 + bj * HALF + n * 16); }
                rsv[(rg + 1) & 1] = erstd[row2]; rgv[(rg + 1) & 1] = ssq[row2]; }
            const float rs = rsqrtf(rsv[rg & 1] * (1.0f / DM) + EPS), rg_ = rsqrtf(rgv[rg & 1] * (1.0f / DM) + EPS) * ascale;
#pragma unroll
            for (int bj = 0; bj < 2; ++bj)
#pragma unroll
                for (int n = 0; n < 2; ++n) { const f32x4 b = bv[rg & 1][bj][n]; const u32x2 e = ev[rg & 1][bj][n]; const f32x4 a = acc[ai][bj][m][n]; f32x4 o;
                    o[0] = b[0] + bf_lo(e.x) * rs * wv[bj][n][0] * sigmoidf_(a[0] * rg_); o[1] = b[1] + bf_hi(e.x) * rs * wv[bj][n][1] * sigmoidf_(a[1] * rg_);
                    o[2] = b[2] + bf_lo(e.y) * rs * wv[bj][n][2] * sigmoidf_(a[2] * rg_); o[3] = b[3] + bf_hi(e.y) * rs * wv[bj][n][3] * sigmoidf_(a[3] * rg_);
                    *(f32x4*)(C + off + bj * HALF + n * 16) = o; }
        }
    }
};
struct GFfn {
    const char* A; const char* B; unsigned lda, ldb; int nt;
    __device__ __forceinline__ const char* a_base(const Unit& u) const { return A + ((long)u.pm * 254 - 2) * (long)lda * 2; }
    __device__ __forceinline__ const char* b_base(const Unit& u) const { return B + (size_t)u.pn * 256 * ldb * 2; }
    __device__ __forceinline__ size_t kpairA() const { return 256; }
};
template <int CTRL> __device__ __forceinline__ float dpp_f(float v) { return __int_as_float(__builtin_amdgcn_update_dpp(0, __float_as_int(v), CTRL, 0xf, 0xf, false)); }
struct EpiFfn {
    static constexpr bool PERM = true;
    bf16_t* ACT; const float* cw; const float* cb; LAS float* X; const float* ssq;
    __device__ __forceinline__ void operator()(const f32x4 (&acc)[2][2][4][2], const Unit& u, int wr, int wc, int fr, int fq) const {
        const int colw = wc * 32 + 8 * fq;
        const int f0 = u.pn * 128 + colw;
        f32x4 w0[2], w1[2], w2[2], cbv[2];
#pragma unroll
        for (int n = 0; n < 2; ++n) { w0[n] = *(const f32x4*)(cw + f0 + 4 * n); w1[n] = *(const f32x4*)(cw + DFF + f0 + 4 * n); w2[n] = *(const f32x4*)(cw + 2 * DFF + f0 + 4 * n); cbv[n] = *(const f32x4*)(cb + f0 + 4 * n); }
        float rsv[2][4];
#pragma unroll
        for (int ai = 0; ai < 2; ++ai)
#pragma unroll
            for (int m = 0; m < 4; ++m) { const long t = (long)u.pm * 254 - 2 + ai * HALF + wr * 64 + m * 16 + fr; rsv[ai][m] = ssq[t < 0 ? 0 : (t >= S_ ? S_ - 1 : t)]; }
#pragma unroll
        for (int ai = 0; ai < 2; ++ai)
#pragma unroll
            for (int m = 0; m < 4; ++m) { const long t = (long)u.pm * 254 - 2 + ai * HALF + wr * 64 + m * 16 + fr; rsv[ai][m] = (t >= 0 && t < S_) ? rsqrtf(rsv[ai][m] * (1.0f / DM) + EPS) : 0.f; }
        if (fr >= 14) {
#pragma unroll
            for (int ai = 0; ai < 2; ++ai)
#pragma unroll
                for (int n = 0; n < 2; ++n) *(LAS f32x4*)(X + ((2 * ai + wr) * 2 + (fr - 14)) * 128 + colw + 4 * n) = acc[ai][0][3][n] * rsv[ai][3];
        }
        asm volatile("s_waitcnt lgkmcnt(0)" ::: "memory");
        __builtin_amdgcn_s_barrier(); asm volatile("" ::: "memory");
        __builtin_amdgcn_s_barrier(); asm volatile("" ::: "memory");
        const bool sel1 = fr == 15, sel2 = fr >= 14;
#pragma unroll
        for (int ai = 0; ai < 2; ++ai) {
            f32x4 pv[2];
            const int pseg = 2 * ai + wr - 1;
#pragma unroll
            for (int n = 0; n < 2; ++n) { pv[n] = (f32x4){0.f, 0.f, 0.f, 0.f}; if (pseg >= 0 && fr >= 14) pv[n] = *(const LAS f32x4*)(X + (pseg * 2 + (fr - 14)) * 128 + colw + 4 * n); }
#pragma unroll
            for (int m = 0; m < 4; ++m) {
                const int r = ai * HALF + wr * 64 + m * 16 + fr; const long t = (long)u.pm * 254 - 2 + r;
                unsigned ow[4];
#pragma unroll
                for (int n = 0; n < 2; ++n) {
                    const f32x4 cur = acc[ai][0][m][n] * rsv[ai][m], up = acc[ai][1][m][n] * rsv[ai][m];
                    f32x4 x1, x2;
#pragma unroll
                    for (int i = 0; i < 4; ++i) { x1[i] = dpp_f<0x121>(sel1 ? pv[n][i] : cur[i]); x2[i] = dpp_f<0x122>(sel2 ? pv[n][i] : cur[i]); }
                    const f32x4 y = cbv[n] + w0[n] * x2 + w1[n] * x1 + w2[n] * cur;
                    f32x4 sg;
#pragma unroll
                    for (int i = 0; i < 4; ++i) sg[i] = sigmoidf_(y[i]);
                    const f32x4 o = y * sg * up;
                    ow[2 * n] = cvt_pk_bf16(o[0], o[1]); ow[2 * n + 1] = cvt_pk_bf16(o[2], o[3]);
                    pv[n] = cur;
                }
                if (r >= 2 && t < S_) *(u32x4*)(ACT + (size_t)t * DFF + f0) = (u32x4){ow[0], ow[1], ow[2], ow[3]};
            }
        }
    }
};

template <class GD, class Epi, bool F8 = false>
__device__ __forceinline__ void gemm_phase(LAS unsigned char* lds, const GD g, const StaticOrder& S, const Epi& E) {
    const int tid = threadIdx.x, wid = __builtin_amdgcn_readfirstlane(tid >> 6), lane = tid & 63, wr = wid >> 2, wc = wid & 3, fr = lane & 15, fq = lane >> 4;
    const int nt = g.nt;
    unsigned voffA[2], voffB[2];
#pragma unroll
    for (int i = 0; i < 2; ++i) { int R, C; stage_rc(tid * 16 + i * 8192, R, C); const int Rb = Epi::PERM ? ((R & ~31) + perm32(R & 31)) : R;
        voffA[i] = (unsigned)(R * g.lda + C) * 2u; voffB[i] = (unsigned)(Rb * g.ldb + C) * 2u; }
    const size_t kpA = g.kpairA();
    const size_t hstepA = (size_t)HALF * g.lda * 2, hstepB = (size_t)HALF * g.ldb * 2;
    const unsigned ldsw = (unsigned)wid * 1024u;
    const int aoff = lds_byte(wr * 64 + fr, fq * 8), boff = lds_byte(wc * 32 + fr, fq * 8);
#define PG8_SA(b, h) (((b) * 2 + (h)) * HTB)
#define PG8_SB(b, h) ((4 + (b) * 2 + (h)) * HTB)
#define PG8_STAGE(bufoff, gbase, voff) do { _Pragma("unroll") for (int _i = 0; _i < 2; ++_i) \
        __builtin_amdgcn_global_load_lds((const unsigned*)((const char*)(gbase) + (voff)[_i]), (LAS unsigned*)(lds + (bufoff) + ldsw + _i * 8192), 16, 0, 0); } while (0)
#define PG8_LDA(dst, b, h) do { if constexpr (F8) { _Pragma("unroll") for (int m = 0; m < 4; ++m) { const i32x4 lo_ = *(const LAS i32x4*)(lds + PG8_SA(b, h) + aoff + m * 2048), hi_ = *(const LAS i32x4*)(lds + PG8_SA(b, h) + aoff + m * 2048 + 1024); \
            dst##8[m] = __builtin_shufflevector(lo_, hi_, 0, 1, 2, 3, 4, 5, 6, 7); } } \
        else { _Pragma("unroll") for (int m = 0; m < 4; ++m) _Pragma("unroll") for (int k = 0; k < 2; ++k) dst[m][k] = *(const LAS bf16x8*)(lds + PG8_SA(b, h) + aoff + m * 2048 + k * 1024); } } while (0)
#define PG8_LDB(dst, b, h) do { if constexpr (F8) { _Pragma("unroll") for (int n = 0; n < 2; ++n) { const i32x4 lo_ = *(const LAS i32x4*)(lds + PG8_SB(b, h) + boff + n * 2048), hi_ = *(const LAS i32x4*)(lds + PG8_SB(b, h) + boff + n * 2048 + 1024); \
            dst##8[n] = __builtin_shufflevector(lo_, hi_, 0, 1, 2, 3, 4, 5, 6, 7); } } \
        else { _Pragma("unroll") for (int n = 0; n < 2; ++n) _Pragma("unroll") for (int k = 0; k < 2; ++k) dst[n][k] = *(const LAS bf16x8*)(lds + PG8_SB(b, h) + boff + n * 2048 + k * 1024); } } while (0)
#define PG8_MMA(ai, bj, At, Bt) do { __builtin_amdgcn_s_setprio(1); \
        if constexpr (F8) { _Pragma("unroll") for (int m = 0; m < 4; ++m) _Pragma("unroll") for (int n = 0; n < 2; ++n) \
            asm volatile("v_mfma_scale_f32_16x16x128_f8f6f4 %0, %1, %2, %0, %3, %3 op_sel_hi:[0,0,0]" : "+v"(acc[ai][bj][m][n]) : "v"(Bt##8[n]), "v"(At##8[m]), "v"(one_scale)); } \
        else { _Pragma("unroll") for (int m = 0; m < 4; ++m) _Pragma("unroll") for (int n = 0; n < 2; ++n) _Pragma("unroll") for (int k = 0; k < 2; ++k) \
            acc[ai][bj][m][n] = __builtin_amdgcn_mfma_f32_16x16x32_bf16(Bt[n][k], At[m][k], acc[ai][bj][m][n], 0, 0, 0); } \
        __builtin_amdgcn_s_setprio(0); } while (0)
#define PG8_WAIT_V(n) asm volatile("s_waitcnt vmcnt(" #n ")" ::: "memory")
#define PG8_WAIT_L(n) asm volatile("s_waitcnt lgkmcnt(" #n ")" ::: "memory")
#define PG8_BAR __builtin_amdgcn_s_barrier()
#define PG8_SCHED __builtin_amdgcn_sched_barrier(0)
    Unit cur, nxt; int ui = 0;
    if (!S.next(0, cur)) return;
    f32x4 acc[2][2][4][2];
#pragma unroll
    for (int a = 0; a < 2; ++a)
#pragma unroll
        for (int b = 0; b < 2; ++b)
#pragma unroll
            for (int m = 0; m < 4; ++m)
#pragma unroll
                for (int n = 0; n < 2; ++n) acc[a][b][m][n] = (f32x4){0.f, 0.f, 0.f, 0.f};
    bf16x8 At[4][2], B0[2][2], B1[2][2];
    i32x8 At8[4], B08[2], B18[2];
    (void)At; (void)B0; (void)B1; (void)At8; (void)B08; (void)B18;
    int one_scale = 0x7F7F7F7F; (void)one_scale;
    const char* cA = g.a_base(cur); const char* cB = g.b_base(cur);
    PG8_STAGE(PG8_SB(0, 0), cB, voffB); PG8_STAGE(PG8_SA(0, 0), cA, voffA); PG8_STAGE(PG8_SB(0, 1), cB + hstepB, voffB); PG8_STAGE(PG8_SA(0, 1), cA + hstepA, voffA);
    if (wr == 1) PG8_BAR;
    PG8_WAIT_V(4); PG8_BAR;
    PG8_STAGE(PG8_SB(1, 0), cB + 128, voffB); PG8_STAGE(PG8_SA(1, 0), cA + 128, voffA); PG8_STAGE(PG8_SB(1, 1), cB + hstepB + 128, voffB);
    PG8_WAIT_V(6); PG8_BAR;
    for (;;) {
        const bool has_next = S.next(ui + 1, nxt);
        const char* nA = has_next ? g.a_base(nxt) : cA; const char* nB = has_next ? g.b_base(nxt) : cB;
        for (int t = 0; t < nt; t += 2) {
            const bool last = (t == nt - 2);
            const char* a0 = cA + (size_t)(t >> 1) * kpA;
            const char* a1 = a0 + 128;
            const char* a2 = last ? nA : a0 + kpA; const char* b2 = last ? nB : cB + (size_t)(t + 2) * 128;
            const char* a3 = a2 + 128; const char* b3 = b2 + 128;
            PG8_LDB(B0, 0, 0); PG8_SCHED; PG8_LDA(At, 0, 0); PG8_STAGE(PG8_SA(1, 1), a1 + hstepA, voffA);
            PG8_WAIT_L(8); PG8_BAR; PG8_WAIT_L(0); PG8_MMA(0, 0, At, B0); PG8_BAR; PG8_SCHED;
            PG8_LDB(B1, 0, 1); PG8_STAGE(PG8_SB(0, 0), b2, voffB);
            PG8_BAR; PG8_WAIT_L(0); PG8_MMA(0, 1, At, B1); PG8_BAR;
            PG8_LDA(At, 0, 1); PG8_STAGE(PG8_SA(0, 0), a2, voffA);
            PG8_BAR; PG8_WAIT_L(0); PG8_MMA(1, 0, At, B0); PG8_BAR; PG8_SCHED;
            PG8_STAGE(PG8_SB(0, 1), b2 + hstepB, voffB);
            PG8_WAIT_V(6); PG8_BAR; PG8_MMA(1, 1, At, B1); PG8_BAR;
            PG8_LDB(B0, 1, 0); PG8_SCHED; PG8_LDA(At, 1, 0); PG8_STAGE(PG8_SA(0, 1), a2 + hstepA, voffA);
            PG8_WAIT_L(8); PG8_BAR; PG8_WAIT_L(0); PG8_MMA(0, 0, At, B0); PG8_BAR; PG8_SCHED;
            PG8_LDB(B1, 1, 1); PG8_STAGE(PG8_SB(1, 0), b3, voffB);
            PG8_BAR; PG8_WAIT_L(0); PG8_MMA(0, 1, At, B1); PG8_BAR;
            PG8_LDA(At, 1, 1); PG8_STAGE(PG8_SA(1, 0), a3, voffA);
            PG8_BAR; PG8_WAIT_L(0); PG8_MMA(1, 0, At, B0); PG8_BAR; PG8_SCHED;
            PG8_STAGE(PG8_SB(1, 1), b3 + hstepB, voffB);
            PG8_WAIT_V(6); PG8_BAR; PG8_MMA(1, 1, At, B1); PG8_BAR;
        }
        if constexpr (F8) asm volatile("s_nop 15\n\ts_nop 15\n\ts_nop 15" ::: "memory");
        E(acc, cur, wr, wc, fr, fq);
        if (!has_next) break;
#pragma unroll
        for (int a = 0; a < 2; ++a)
#pragma unroll
            for (int b = 0; b < 2; ++b)
#pragma unroll
                for (int m = 0; m < 4; ++m)
#pragma unroll
                    for (int n = 0; n < 2; ++n) acc[a][b][m][n] = (f32x4){0.f, 0.f, 0.f, 0.f};
        cur = nxt; cA = nA; cB = nB; ++ui;
    }
    PG8_WAIT_V(0);
    if (wr == 0) PG8_BAR;
    PG8_BAR;
#undef PG8_SA
#undef PG8_SB
#undef PG8_STAGE
#undef PG8_LDA
#undef PG8_LDB
#undef PG8_MMA
#undef PG8_WAIT_V
#undef PG8_WAIT_L
#undef PG8_BAR
#undef PG8_SCHED
}
}

namespace att {
constexpr int KVBLK = 64;
constexpr int SHM_V = KVBLK * HD * 2, SHM_K = KVBLK * HD * 2, SHM_ATTN = 2 * SHM_V + 2 * SHM_K + NWAVES * 64 * 4;
#define KSWZ(row, colB) ((row) * 256 + ((colB) ^ (((row) & 7) << 4)))
#define SBAR() __builtin_amdgcn_sched_barrier(0)
__device__ __forceinline__ int crow(int r, int hi) { return (r & 3) + 8 * (r >> 2) + 4 * hi; }
__device__ __forceinline__ void qkt(f32x16& p0, f32x16& p1, const char* Ks, const bf16x8* qr, int r32, int hi) {
    p0 = f32x16{}; p1 = f32x16{};
    bf16x8 ka[2], kb[2];
    { const int cb = (hi * 8) * 2; ka[0] = *reinterpret_cast<const bf16x8*>(Ks + KSWZ(r32, cb)); kb[0] = *reinterpret_cast<const bf16x8*>(Ks + KSWZ(32 + r32, cb)); }
#pragma unroll
    for (int d0 = 0; d0 < 8; ++d0) {
        if (d0 < 7) { const int cb = ((d0 + 1) * 16 + hi * 8) * 2;
            ka[(d0 + 1) & 1] = *reinterpret_cast<const bf16x8*>(Ks + KSWZ(r32, cb)); kb[(d0 + 1) & 1] = *reinterpret_cast<const bf16x8*>(Ks + KSWZ(32 + r32, cb)); }
        SBAR();
        p0 = __builtin_amdgcn_mfma_f32_32x32x16_bf16(ka[d0 & 1], qr[d0], p0, 0, 0, 0);
        p1 = __builtin_amdgcn_mfma_f32_32x32x16_bf16(kb[d0 & 1], qr[d0], p1, 0, 0, 0);
        SBAR();
    }
}
__device__ __forceinline__ int v_st(int k, int c) { const int kk = (k & ~0xC) | ((k & 4) << 1) | ((k & 8) >> 1); return ((kk >> 3) * 4 + (c >> 5)) * 512 + ((kk & 7) * 32 + (c & 31)) * 2; }
__device__ __forceinline__ int v_rd_base(int lane) { return ((lane & 3) << 3) | (((lane >> 2) & 3) << 6) | (((lane >> 4) & 1) << 5) | (((lane >> 5) & 1) << 8); }
constexpr int v_rd_off(int d0, int ks, int half) { return d0 * 512 + ks * 4096 + half * 2048; }
__device__ __forceinline__ s16x4 tr_read(int vb, int off) { return __builtin_amdgcn_ds_read_tr16_b64_v4i16((LAS s16x4*)(unsigned long)(unsigned)(vb + off)); }
__device__ __forceinline__ void pv_d0(f32x16* o, int vb, bf16x8 pa0, bf16x8 pa1, bf16x8 pa2, bf16x8 pa3) {
    s16x4 L[2][4], H[2][4];
#pragma unroll
    for (int d0 = 0; d0 < 4; ++d0) { L[0][d0] = tr_read(vb, v_rd_off(d0, 0, 0)); H[0][d0] = tr_read(vb, v_rd_off(d0, 0, 1)); }
#pragma unroll
    for (int ks = 0; ks < 4; ++ks) {
        if (ks < 3) {
#pragma unroll
            for (int d0 = 0; d0 < 4; ++d0) { L[(ks + 1) & 1][d0] = tr_read(vb, v_rd_off(d0, ks + 1, 0)); H[(ks + 1) & 1][d0] = tr_read(vb, v_rd_off(d0, ks + 1, 1)); }
        }
        const bf16x8 pa = ks == 0 ? pa0 : (ks == 1 ? pa1 : (ks == 2 ? pa2 : pa3));
#pragma unroll
        for (int d0 = 0; d0 < 4; ++d0) { const s16x4 l = L[ks & 1][d0], h = H[ks & 1][d0];
            o[d0] = __builtin_amdgcn_mfma_f32_32x32x16_bf16(pa, (bf16x8){l[0], l[1], l[2], l[3], h[0], h[1], h[2], h[3]}, o[d0], 0, 0, 0); }
    }
}
__device__ __forceinline__ void pack_p(const f32x16& p0, const f32x16& p1, bf16x8& pa0, bf16x8& pa1, bf16x8& pa2, bf16x8& pa3) {
#define PK4(P, BASE, OUT) do { unsigned a0 = cvt_pk_bf16(P[BASE + 0], P[BASE + 1]), a1 = cvt_pk_bf16(P[BASE + 2], P[BASE + 3]);   \
    unsigned b0 = cvt_pk_bf16(P[BASE + 4], P[BASE + 5]), b1 = cvt_pk_bf16(P[BASE + 6], P[BASE + 7]);                              \
    auto r0 = __builtin_amdgcn_permlane32_swap(a0, b0, false, false); auto r1 = __builtin_amdgcn_permlane32_swap(a1, b1, false, false); \
    u32x4 w = {r0[0], r1[0], r0[1], r1[1]}; OUT = *reinterpret_cast<bf16x8*>(&w); } while (0)
    PK4(p0, 0, pa0); PK4(p0, 8, pa1); PK4(p1, 0, pa2); PK4(p1, 8, pa3);
#undef PK4
}

__device__ __forceinline__ void pack_half(const f32x16& p, bf16x8& paA, bf16x8& paB) {
#define PK4(P, BASE, OUT) do { unsigned a0 = cvt_pk_bf16(P[BASE + 0], P[BASE + 1]), a1 = cvt_pk_bf16(P[BASE + 2], P[BASE + 3]);   \
    unsigned b0 = cvt_pk_bf16(P[BASE + 4], P[BASE + 5]), b1 = cvt_pk_bf16(P[BASE + 6], P[BASE + 7]);                              \
    auto r0 = __builtin_amdgcn_permlane32_swap(a0, b0, false, false); auto r1 = __builtin_amdgcn_permlane32_swap(a1, b1, false, false); \
    u32x4 w = {r0[0], r1[0], r0[1], r1[1]}; OUT = *reinterpret_cast<bf16x8*>(&w); } while (0)
    PK4(p, 0, paA); PK4(p, 8, paB);
#undef PK4
}
template <int KS0, bool WITH_EXP>
__device__ __forceinline__ void pv_half(f32x16* o, int vb, bf16x8 paA, bf16x8 paB, f32x16& px, float off) {
    s16x4 L[2][4], H[2][4];
#pragma unroll
    for (int d0 = 0; d0 < 4; ++d0) { L[0][d0] = tr_read(vb, v_rd_off(d0, KS0, 0)); H[0][d0] = tr_read(vb, v_rd_off(d0, KS0, 1)); }
#pragma unroll
    for (int d0 = 0; d0 < 4; ++d0) { L[1][d0] = tr_read(vb, v_rd_off(d0, KS0 + 1, 0)); H[1][d0] = tr_read(vb, v_rd_off(d0, KS0 + 1, 1)); }
#pragma unroll
    for (int kk = 0; kk < 2; ++kk) {
        const bf16x8 pa = kk == 0 ? paA : paB;
#pragma unroll
        for (int d0 = 0; d0 < 4; ++d0) { const s16x4 l = L[kk][d0], h = H[kk][d0];
            if (WITH_EXP) SBAR();
            o[d0] = __builtin_amdgcn_mfma_f32_32x32x16_bf16(pa, (bf16x8){l[0], l[1], l[2], l[3], h[0], h[1], h[2], h[3]}, o[d0], 0, 0, 0);
            if (WITH_EXP) {
#pragma unroll
                for (int q = 0; q < 2; ++q) { const int r = (kk * 4 + d0) * 2 + q; px[r] = __builtin_amdgcn_exp2f(fmaf(px[r], SM_C, off)); }
                SBAR(); }
        }
    }
}
enum { MODE_CMP = 0, MODE_WIN = 1, MODE_SLC = 2 };
struct AttnArgs {
    const bf16_t* Z; const bf16_t* KC; const bf16_t* VC; const float* G; float* L; float* OACC; bf16_t* MIX; const unsigned* BM; const float* TAB;
};
template <int MODE>
__device__ __forceinline__ void attn_unit(const AttnArgs& a, LAS char* ldsL, int qt, int g, int hp) {
    char* lds = (char*)ldsL;
    const int tid = threadIdx.x, wid = __builtin_amdgcn_readfirstlane(tid >> 6), lane = tid & 63, r32 = lane & 31, hi = lane >> 5;
    float* li_l = (float*)(lds + LDS_XCH) + wid * 64;
    const int t0 = MODE == MODE_SLC ? qt * 40 : qt * 128;
    const int tq_raw = MODE == MODE_SLC ? t0 + wid * 5 + r32 / 6 : t0 + wid * 16 + (r32 & 15);
    const bool rvalid = MODE == MODE_SLC ? (r32 < 30 && tq_raw < S_) : true;
    const int tq = tq_raw < S_ ? tq_raw : S_ - 1;
    const int hq = MODE == MODE_SLC ? g * HPG + r32 % 6 : g * HPG + hp * 2 + (r32 >> 4);
    const int tlast = MODE == MODE_SLC ? ((t0 + 39) < S_ ? (t0 + 39) : S_ - 1) : t0 + 127;
    const bf16_t* Kb; const bf16_t* Vb; long ldk;
    if (MODE == MODE_CMP) { Kb = a.KC + (size_t)g * 1024 * HD; Vb = a.VC + (size_t)g * 1024 * HD; ldk = HD; }
    else if (MODE == MODE_WIN) { Kb = a.Z + OFF_KV + 4 * 512 + g * HD; Vb = a.Z + OFF_KV + 5 * 512 + g * HD; ldk = LDZ; }
    else { Kb = a.Z + OFF_KV + 2 * 512 + g * HD; Vb = a.Z + OFF_KV + 3 * 512 + g * HD; ldk = LDZ; }
    int j0, j1;
    if (MODE == MODE_CMP) { j0 = 0; j1 = (((t0 + 127 - 31) >> 4) >> 6) + 1; }
    else if (MODE == MODE_WIN) { j0 = (t0 - 511) > 0 ? ((t0 - 511) >> 6) : 0; j1 = ((t0 + 127) >> 6) + 1; }
    else { j0 = 0; j1 = (tlast >> 6) + 1; }
    int klo, khi;
    if (MODE == MODE_CMP) { klo = 0; khi = tq >= 31 ? ((tq - 31) >> 4) : -1; }
    else if (MODE == MODE_WIN) { klo = tq - 511; khi = tq; }
    else { klo = 0; khi = rvalid ? tq : -1; }
    float negBC = -a.TAB[512 + (MODE == MODE_CMP ? 0 : (MODE == MODE_SLC ? 1 : 2))];
    bf16x8 qr[8];
    { const bf16_t* Qw = a.Z + (size_t)tq * LDZ + OFF_Q + hq * HD + hi * 8;
#pragma unroll
      for (int d0 = 0; d0 < 8; ++d0) qr[d0] = *reinterpret_cast<const bf16x8*>(Qw + d0 * 16); }
    f32x16 o[4] = {}; float lsum = 0.f;
    unsigned soK[2], soV[2];
#pragma unroll
    for (int i = 0; i < 2; ++i) { const int p = (wid + 8 * i) * 64 + lane;
        { const int row = p >> 4, c = (p & 15) ^ (row & 7); soK[i] = (unsigned)(row * ldk + c * 8) * 2u; }
        { const int sub = p >> 5, within = p & 31, kk = (sub >> 2) * 8 + (within >> 2), c = (sub & 3) * 32 + (within & 3) * 8, k = (kk & ~0xC) | ((kk & 4) << 1) | ((kk & 8) >> 1);
          soV[i] = (unsigned)(k * ldk + c) * 2u; } }
    const int vb0 = (int)(uintptr_t)(LAS char*)ldsL + 16384 + v_rd_base(lane);
#define ISSUE(jt) do { const int _b = ((jt) - j0) & 3; const char* _kp = (const char*)Kb + (size_t)(jt) * KVBLK * ldk * 2; const char* _vp = (const char*)Vb + (size_t)(jt) * KVBLK * ldk * 2; \
    _Pragma("unroll") for (int _i = 0; _i < 2; ++_i) { \
        __builtin_amdgcn_global_load_lds((const unsigned*)(_kp + soK[_i]), (LAS unsigned*)(ldsL + _b * 32768 + (wid + 8 * _i) * 1024), 16, 0, 0); \
        __builtin_amdgcn_global_load_lds((const unsigned*)(_vp + soV[_i]), (LAS unsigned*)(ldsL + _b * 32768 + 16384 + (wid + 8 * _i) * 1024), 16, 0, 0); } } while (0)
    unsigned bmw = 0u;
    if (MODE == MODE_SLC) bmw = a.BM[((size_t)tq * 4 + g) * 8];
    asm volatile("s_waitcnt lgkmcnt(0)" ::: "memory");
    __builtin_amdgcn_s_barrier();
    asm volatile("" ::: "memory");
    ISSUE(j0);
    asm volatile("s_waitcnt vmcnt(4) lgkmcnt(0)" : "+v"(bmw), "+v"(negBC), "+v"(qr[0]), "+v"(qr[1]), "+v"(qr[2]), "+v"(qr[3]), "+v"(qr[4]), "+v"(qr[5]), "+v"(qr[6]), "+v"(qr[7]) :: "memory");
    if (j0 + 1 < j1) ISSUE(j0 + 1); if (j0 + 2 < j1) ISSUE(j0 + 2);
    for (int j = j0; j < j1; ++j) {
        const int buf = (j - j0) & 3;
        if (j + 2 < j1) asm volatile("s_waitcnt vmcnt(8)" ::: "memory"); else if (j + 1 < j1) asm volatile("s_waitcnt vmcnt(4)" ::: "memory"); else asm volatile("s_waitcnt vmcnt(0)" ::: "memory");
        __builtin_amdgcn_s_barrier();
        asm volatile("" ::: "memory");
        if (j + 3 < j1) ISSUE(j + 3);
        int lhi = khi;
        if (MODE == MODE_SLC) { if (!((bmw >> (j & 31)) & 1u)) lhi = -1; }
        const int kb = j * KVBLK;
        const bool l_any = (kb + 63 >= klo) && (kb <= lhi);
        const bool l_full = (kb >= klo) && (kb + 63 <= lhi);
        if (__any(l_any)) {
            f32x16 p0, p1;
            qkt(p0, p1, lds + buf * 32768, qr, r32, hi);
            const bool uni = __all(l_full || !l_any);
            const float off = (uni && !l_any) ? -1.0e30f : negBC;
#pragma unroll
            for (int r = 0; r < 16; ++r) p0[r] = __builtin_amdgcn_exp2f(fmaf(p0[r], SM_C, off));
            if (!uni) {
#pragma unroll
                for (int r = 0; r < 16; ++r) { const int k0i = kb + crow(r, hi); p0[r] = (k0i >= klo && k0i <= lhi) ? p0[r] : 0.f; } }
            float ps = 0.f;
#pragma unroll
            for (int r = 0; r < 16; ++r) ps += p0[r];
            bf16x8 pa0, pa1, pa2, pa3; pack_half(p0, pa0, pa1);
            pv_half<0, true>(o, vb0 + buf * 32768, pa0, pa1, p1, off);
            if (!uni) {
#pragma unroll
                for (int r = 0; r < 16; ++r) { const int k1i = kb + 32 + crow(r, hi); p1[r] = (k1i >= klo && k1i <= lhi) ? p1[r] : 0.f; } }
#pragma unroll
            for (int r = 0; r < 16; ++r) ps += p1[r];
            lsum += ps;
            pack_half(p1, pa2, pa3);
            pv_half<2, false>(o, vb0 + buf * 32768, pa2, pa3, p1, off);
        }
        if (MODE == MODE_SLC) { if (((j + 1) & 31) == 0 && j + 1 < j1) { bmw = a.BM[((size_t)tq * 4 + g) * 8 + ((j + 1) >> 5)]; asm volatile("s_waitcnt vmcnt(0)" : "+v"(bmw) :: "memory"); } }
    }
#undef ISSUE
    lsum += __shfl_xor(lsum, 32);
    const float grow = a.G[(size_t)tq * NGATE + hq * 3 + (MODE == MODE_CMP ? 0 : (MODE == MODE_SLC ? 1 : 2))];
    if (hi == 0) { li_l[r32] = lsum; li_l[32 + r32] = rvalid ? grow : 0.f; }
    if (MODE == MODE_CMP) { if (hi == 0) a.L[(size_t)tq * NH + hq] = lsum; }
    asm volatile("s_waitcnt lgkmcnt(0)" ::: "memory");
#pragma unroll
    for (int hf = 0; hf < 2; ++hf) {
        float gtv[8]; float pvv[8][4];
#pragma unroll
        for (int rr = 0; rr < 8; ++rr) { const int r = hf * 8 + rr;
            const int orow = crow(r, hi); const float lv = li_l[orow]; const float rl = lv > 0.f ? __builtin_amdgcn_rcpf(lv) : 0.f;
            const int t = MODE == MODE_SLC ? t0 + wid * 5 + orow / 6 : t0 + wid * 16 + (orow & 15);
            const int h = MODE == MODE_SLC ? g * HPG + orow % 6 : g * HPG + hp * 2 + (orow >> 4);
            const bool valid = !(MODE == MODE_SLC && (orow >= 30 || t >= S_)); const int tc = valid ? t : 0;
            gtv[rr] = li_l[32 + orow] * rl;
            if (MODE != MODE_CMP) { const float* oa = a.OACC + (size_t)tc * 3072 + h * HD + r32;
#pragma unroll
                for (int d0 = 0; d0 < 4; ++d0) pvv[rr][d0] = oa[d0 * 32]; }
        }
#pragma unroll
        for (int rr = 0; rr < 8; ++rr) { const int r = hf * 8 + rr;
            const int orow = crow(r, hi);
            const int t = MODE == MODE_SLC ? t0 + wid * 5 + orow / 6 : t0 + wid * 16 + (orow & 15);
            const int h = MODE == MODE_SLC ? g * HPG + orow % 6 : g * HPG + hp * 2 + (orow >> 4);
            if (MODE == MODE_SLC && (orow >= 30 || t >= S_)) continue;
            float* oa = a.OACC + (size_t)t * 3072 + h * HD + r32;
#pragma unroll
            for (int d0 = 0; d0 < 4; ++d0) {
                const float v = o[d0][r] * gtv[rr];
                if (MODE == MODE_CMP) oa[d0 * 32] = v;
                else if (MODE == MODE_WIN) oa[d0 * 32] = pvv[rr][d0] + v;
                else a.MIX[(size_t)t * DM + POOLW + h * HD + d0 * 32 + r32] = (bf16_t)(cvt_pk_bf16(pvv[rr][d0] + v, 0.f) & 0xffffu);
            }
        }
    }
}

constexpr int SLC_KPS = 1040, SLC_VPS = 1056, SLC_KIMG = 16 * SLC_KPS, SLC_BUF = SLC_KIMG + 16 * SLC_VPS, LDS_SLCX = 4 * SLC_BUF;
static_assert(LDS_SLCX + 3072 <= LDS_MISC, "slc ring overlaps the barrier words");
__device__ __forceinline__ bf16x8 lds_b128(int adr) { return *reinterpret_cast<const LAS bf16x8*>((LAS char*)(unsigned long)(unsigned)adr); }
__device__ __forceinline__ void slc16_unit(const AttnArgs& a, LAS char* ldsL, int ut, int g) {
    char* lds = (char*)ldsL;
    const int tid = threadIdx.x, wid = __builtin_amdgcn_readfirstlane(tid >> 6), lane = tid & 63, fr = lane & 15, fq = lane >> 4;
    float* li_l = (float*)(lds + LDS_SLCX) + wid * 96;
    const int t0 = ut * 48, tlast = (t0 + 47) < S_ ? (t0 + 47) : S_ - 1, j0 = 0, j1 = (tlast >> 6) + 1;
    const bf16_t* Kb = a.Z + OFF_KV + 2 * 512 + g * HD; const long ldk = LDZ;
    const int tq0 = t0 + wid * 6 + fr / 6;
    bool rv[3];
#pragma unroll
    for (int b = 0; b < 3; ++b) rv[b] = fr < 12 && tq0 + 2 * b < S_;
#define TQC(b) ((tq0 + 2 * (b)) < S_ ? (tq0 + 2 * (b)) : S_ - 1)
    const int hq = g * HPG + fr % 6;
    float negBC = -a.TAB[513];
    bf16x8 qf[3][4];
#pragma unroll
    for (int b = 0; b < 3; ++b) { const bf16_t* qp = a.Z + (size_t)TQC(b) * LDZ + OFF_Q + hq * HD + fq * 8;
#pragma unroll
        for (int ks = 0; ks < 4; ++ks) qf[b][ks] = *reinterpret_cast<const bf16x8*>(qp + ks * 32); }
    f32x4 o[3][8]; float lsum[3];
#pragma unroll
    for (int b = 0; b < 3; ++b) { lsum[b] = 0.f;
#pragma unroll
        for (int c = 0; c < 8; ++c) o[b][c] = (f32x4){0.f, 0.f, 0.f, 0.f}; }
    const int q4 = fr >> 2, p4 = fr & 3, lbase = (int)(uintptr_t)ldsL;
    const int kaddr0 = lbase + fr * SLC_KPS + fq * 16;
    const int vaddr0 = lbase + SLC_KIMG + (4 * fq + q4) * SLC_VPS + (p4 >> 1) * 16 + (p4 & 1) * 8;
    unsigned so0 = (unsigned)((wid + 16 * (lane >> 4)) * ldk + (lane & 15) * 8) * 2u;
#define ISSUE16(jt) do { const int _b = ((jt) - j0) & 3; const char* _kp = (const char*)Kb + (size_t)(jt) * KVBLK * ldk * 2; asm volatile("" : "+v"(so0)); \
    _Pragma("unroll") for (int _i = 0; _i < 4; ++_i) \
        __builtin_amdgcn_global_load_lds((const unsigned*)(_kp + (_i >> 1) * 1024 + (_i & 1) * (8 * ldk * 2) + so0), \
            (LAS unsigned*)(ldsL + _b * SLC_BUF + ((_i >> 1) ? SLC_KIMG + (wid + 8 * (_i & 1)) * SLC_VPS : (wid + 8 * (_i & 1)) * SLC_KPS)), 16, 0, 0); } while (0)
    unsigned bmw[3];
#pragma unroll
    for (int b = 0; b < 3; ++b) bmw[b] = a.BM[((size_t)TQC(b) * 4 + g) * 8];
    asm volatile("s_waitcnt lgkmcnt(0)" ::: "memory");
    __builtin_amdgcn_s_barrier();
    asm volatile("" ::: "memory");
    ISSUE16(j0); if (j0 + 1 < j1) ISSUE16(j0 + 1);
    asm volatile("s_waitcnt vmcnt(0) lgkmcnt(0)" : "+v"(bmw[0]), "+v"(bmw[1]), "+v"(bmw[2]), "+v"(negBC), "+v"(qf[0][0]), "+v"(qf[0][1]), "+v"(qf[0][2]), "+v"(qf[0][3]),
                 "+v"(qf[1][0]), "+v"(qf[1][1]), "+v"(qf[1][2]), "+v"(qf[1][3]), "+v"(qf[2][0]), "+v"(qf[2][1]), "+v"(qf[2][2]), "+v"(qf[2][3]) :: "memory");
    int kadr = kaddr0, vadr = vaddr0;
    for (int j = j0; j < j1; ++j) {
        const int buf = (j - j0) & 3;
        if ((j & 1) == 0) {
            asm volatile("s_waitcnt vmcnt(0)" ::: "memory");
            __builtin_amdgcn_s_barrier();
            asm volatile("" ::: "memory");
            if (j + 2 < j1) ISSUE16(j + 2); if (j + 3 < j1) ISSUE16(j + 3); }
        const int kb = j * KVBLK;
#define KF16(ks, mt) lds_b128(kadr + 64 * (ks) + 256 * (mt))
#define TRA(dst, off) asm volatile("ds_read_b64_tr_b16 %0, %1 offset:%2" : "=v"(dst) : "v"(vadr), "n"(off))
#define VLOAD(dst, s, h) _Pragma("unroll") for (int _c = 0; _c < 4; ++_c) { TRA(dst[_c][0], 32 * (4 * (h) + _c) + 512 * (s)); TRA(dst[_c][1], 32 * (4 * (h) + _c) + 512 * (s) + 256); }
#define VWAIT(n, d) asm volatile("s_waitcnt lgkmcnt(" #n ")" : "+v"(d[0][0]), "+v"(d[0][1]), "+v"(d[1][0]), "+v"(d[1][1]), "+v"(d[2][0]), "+v"(d[2][1]), "+v"(d[3][0]), "+v"(d[3][1]))
#define PVMMA(src, pa, h) _Pragma("unroll") for (int _c = 0; _c < 4; ++_c) o[b][4 * (h) + _c] = __builtin_amdgcn_mfma_f32_16x16x32_bf16(pa, \
            (bf16x8){src[_c][0][0], src[_c][0][1], src[_c][0][2], src[_c][0][3], src[_c][1][0], src[_c][1][1], src[_c][1][2], src[_c][1][3]}, o[b][4 * (h) + _c], 0, 0, 0);
#define EXPH(h, pw) { if (uni) { _Pragma("unroll") for (int mt = 2 * (h); mt < 2 * (h) + 2; ++mt) _Pragma("unroll") for (int i = 0; i < 4; ++i) { \
                            const float e_ = __builtin_amdgcn_exp2f(fmaf(acc[mt][i], SM_C, off)); acc[mt][i] = e_; ps += e_; } } \
                      else { asm volatile("" ::: "memory"); _Pragma("unroll") for (int mt = 2 * (h); mt < 2 * (h) + 2; ++mt) _Pragma("unroll") for (int i = 0; i < 4; ++i) { \
                            float e_ = __builtin_amdgcn_exp2f(fmaf(acc[mt][i], SM_C, off)); e_ = (16 * mt + i <= lim4) ? e_ : 0.f; acc[mt][i] = e_; ps += e_; } } \
                      pw.x = cvt_pk_bf16(acc[2 * (h)][0], acc[2 * (h)][1]); pw.y = cvt_pk_bf16(acc[2 * (h)][2], acc[2 * (h)][3]); \
                      pw.z = cvt_pk_bf16(acc[2 * (h) + 1][0], acc[2 * (h) + 1][1]); pw.w = cvt_pk_bf16(acc[2 * (h) + 1][2], acc[2 * (h) + 1][3]); }
#pragma unroll
        for (int b = 0; b < 3; ++b) {
            const bool sel = rv[b] && ((bmw[b] >> (j & 31)) & 1u);
            const int lim = tq0 + 2 * b - kb;
            const bool l_any = sel && lim >= 0, l_full = sel && lim >= 63;
            if (__any(l_any)) {
                f32x4 acc[4]; bf16x8 ka[4], kc[4]; s16x4 va[4][2], vc[4][2];
#pragma unroll
                for (int mt = 0; mt < 4; ++mt) ka[mt] = KF16(0, mt);
#pragma unroll
                for (int mt = 0; mt < 4; ++mt) kc[mt] = KF16(1, mt);
                __builtin_amdgcn_sched_barrier(0);
#pragma unroll
                for (int mt = 0; mt < 4; ++mt) acc[mt] = __builtin_amdgcn_mfma_f32_16x16x32_bf16(ka[mt], qf[b][0], (f32x4){0.f, 0.f, 0.f, 0.f}, 0, 0, 0);
#pragma unroll
                for (int mt = 0; mt < 4; ++mt) ka[mt] = KF16(2, mt);
                __builtin_amdgcn_sched_barrier(0);
#pragma unroll
                for (int mt = 0; mt < 4; ++mt) acc[mt] = __builtin_amdgcn_mfma_f32_16x16x32_bf16(kc[mt], qf[b][1], acc[mt], 0, 0, 0);
#pragma unroll
                for (int mt = 0; mt < 4; ++mt) kc[mt] = KF16(3, mt);
                __builtin_amdgcn_sched_barrier(0);
#pragma unroll
                for (int mt = 0; mt < 4; ++mt) acc[mt] = __builtin_amdgcn_mfma_f32_16x16x32_bf16(ka[mt], qf[b][2], acc[mt], 0, 0, 0);
                __builtin_amdgcn_sched_barrier(0);
#pragma unroll
                for (int mt = 0; mt < 4; ++mt) acc[mt] = __builtin_amdgcn_mfma_f32_16x16x32_bf16(kc[mt], qf[b][3], acc[mt], 0, 0, 0);
                __builtin_amdgcn_sched_barrier(0);
                VLOAD(va, 0, 0)
                VLOAD(vc, 0, 1)
                const bool uni = __all(l_full || !l_any);
                const float off = (uni && !l_any) ? -1.0e30f : negBC;
                const int lim4 = l_any ? lim - 4 * fq : -1;
                float ps = 0.f;
                u32x4 pw0, pw1;
                EXPH(0, pw0)
                const bf16x8 pa0 = *reinterpret_cast<bf16x8*>(&pw0);
                __builtin_amdgcn_sched_barrier(0);
                VWAIT(8, va);
                PVMMA(va, pa0, 0)
                __builtin_amdgcn_sched_barrier(0);
                VLOAD(va, 1, 0)
                VWAIT(8, vc);
                PVMMA(vc, pa0, 1)
                __builtin_amdgcn_sched_barrier(0);
                VLOAD(vc, 1, 1)
                EXPH(1, pw1)
                const bf16x8 pa1 = *reinterpret_cast<bf16x8*>(&pw1);
                lsum[b] += ps;
                __builtin_amdgcn_sched_barrier(0);
                VWAIT(8, va);
                PVMMA(va, pa1, 0)
                __builtin_amdgcn_sched_barrier(0);
                VWAIT(0, vc);
                PVMMA(vc, pa1, 1)
                __builtin_amdgcn_sched_barrier(0);
            }
        }
#undef TRA
#undef VWAIT
#undef EXPH
#undef KF16
#undef VLOAD
#undef PVMMA
        if (((j + 1) & 31) == 0 && j + 1 < j1) {
#pragma unroll
            for (int b = 0; b < 3; ++b) bmw[b] = a.BM[((size_t)TQC(b) * 4 + g) * 8 + ((j + 1) >> 5)];
            asm volatile("s_waitcnt vmcnt(0)" : "+v"(bmw[0]), "+v"(bmw[1]), "+v"(bmw[2]) :: "memory"); }
        { const int step = buf == 3 ? -3 * SLC_BUF : SLC_BUF; kadr += step; vadr += step; asm volatile("" : "+v"(kadr), "+v"(vadr)); }
    }
#undef ISSUE16
    float grow[3];
#pragma unroll
    for (int b = 0; b < 3; ++b) grow[b] = a.G[(size_t)TQC(b) * NGATE + hq * 3 + 1];
#pragma unroll
    for (int b = 0; b < 3; ++b) { float ls = lsum[b]; ls += __shfl_xor(ls, 16); ls += __shfl_xor(ls, 32);
        if (fq == 0) { li_l[b * 32 + fr] = ls; li_l[b * 32 + 16 + fr] = rv[b] ? grow[b] : 0.f; } }
    asm volatile("s_waitcnt lgkmcnt(0)" ::: "memory");
#pragma unroll
    for (int b = 0; b < 3; ++b) {
        float pv_[4][8]; float gtv[4];
#pragma unroll
        for (int i = 0; i < 4; ++i) { const int q = 4 * fq + i; const float lv = li_l[b * 32 + q]; gtv[i] = li_l[b * 32 + 16 + q] * (lv > 0.f ? __builtin_amdgcn_rcpf(lv) : 0.f);
            const int t = t0 + wid * 6 + 2 * b + q / 6, h = g * HPG + q % 6; const bool valid = q < 12 && t < S_; const int tc = valid ? t : 0;
            const float* oa = a.OACC + (size_t)tc * 3072 + h * HD + fr;
#pragma unroll
            for (int c = 0; c < 8; ++c) pv_[i][c] = oa[c * 16]; }
#pragma unroll
        for (int i = 0; i < 4; ++i) { const int q = 4 * fq + i; const int t = t0 + wid * 6 + 2 * b + q / 6, h = g * HPG + q % 6;
            if (q >= 12 || t >= S_) continue;
            bf16_t* mp = a.MIX + (size_t)t * DM + POOLW + h * HD + fr;
#pragma unroll
            for (int c = 0; c < 8; ++c) mp[c * 16] = (bf16_t)(cvt_pk_bf16(pv_[i][c] + o[b][c][i] * gtv[i], 0.f) & 0xffffu); }
    }
}

__device__ __forceinline__ void imp_task(const AttnArgs& a, float* IMPP, float* IMPF, int tqi, int g) {
    const int lane = threadIdx.x & 63, fr = lane & 15, fq = lane >> 4;
    const int t = tqi * 16 + fr;
    const int tmax = tqi * 16 + 15;
    if (tmax < 31) return;
    const int lim = t >= 31 ? ((t - 31) >> 4) : -1;
    const int nstep = ((((tmax - 31) >> 4) >> 6) + 1) * 4;
    const float negBC = -a.TAB[512];
    bf16x8 qf[HPG][4]; float rl[HPG];
#pragma unroll
    for (int h = 0; h < HPG; ++h) {
        const bf16_t* qp = a.Z + (size_t)t * LDZ + OFF_Q + (g * HPG + h) * HD + fq * 8;
#pragma unroll
        for (int ks = 0; ks < 4; ++ks) qf[h][ks] = *reinterpret_cast<const bf16x8*>(qp + ks * 32);
        const float lv = a.L[(size_t)t * NH + g * HPG + h]; rl[h] = lv > 0.f ? 1.0f / lv : 0.f;
    }
    const bf16_t* kbase = a.KC + (size_t)g * 1024 * HD + (size_t)fr * HD + fq * 8;
    bf16x8 kf[4], kn[4], kn2[4];
#pragma unroll
    for (int ks = 0; ks < 4; ++ks) { kf[ks] = *reinterpret_cast<const bf16x8*>(kbase + ks * 32); kn[ks] = *reinterpret_cast<const bf16x8*>(kbase + (size_t)(nstep > 1 ? 1 : 0) * 16 * HD + ks * 32); }
    float* op = IMPP + ((size_t)t * 4 + g) * 256 + fq; float* of = IMPF + ((size_t)t * 4 + g) * 256 + fq;
    for (int st = 0; st < nstep; ++st) {
        const int sn = (st + 2 < nstep) ? st + 2 : nstep - 1;
#pragma unroll
        for (int ks = 0; ks < 4; ++ks) kn2[ks] = *reinterpret_cast<const bf16x8*>(kbase + (size_t)sn * 16 * HD + ks * 32);
        f32x4 imp4 = {0.f, 0.f, 0.f, 0.f};
        const int n0 = st * 16 + fq * 4;
#pragma unroll
        for (int h = 0; h < HPG; ++h) {
            f32x4 acc = {0.f, 0.f, 0.f, 0.f};
#pragma unroll
            for (int ks = 0; ks < 4; ++ks) acc = __builtin_amdgcn_mfma_f32_16x16x32_bf16(kf[ks], qf[h][ks], acc, 0, 0, 0);
#pragma unroll
            for (int i = 0; i < 4; ++i) { const float e = __builtin_amdgcn_exp2f(fmaf(acc[i], SM_C, negBC)) * rl[h]; imp4[i] += (n0 + i <= lim) ? e : 0.f; }
        }
        op[st * 4] = imp4[0] + 2.0f * (imp4[1] + imp4[2] + imp4[3]);
        of[st * 4] = imp4[0];
#pragma unroll
        for (int ks = 0; ks < 4; ++ks) { kf[ks] = kn[ks]; kn[ks] = kn2[ks]; }
    }
}

__device__ __forceinline__ void topk_load(const float* IMPP, const float* IMPF, int t, int g, f32x4& pp, f32x4& ff) {
    const int lane = threadIdx.x & 63, cur = t >> 6, jb = lane * 4;
    pp = (f32x4){0.f, 0.f, 0.f, 0.f}; ff = pp;
    if (cur > 15 && jb <= cur) { const size_t base = ((size_t)t * 4 + g) * 256; pp = *(const f32x4*)(IMPP + base + jb); ff = *(const f32x4*)(IMPF + base + jb); }
}
__device__ __forceinline__ void topk_task(const f32x4 pp, const f32x4 ff, unsigned* BM, int t, int g) {
    const int lane = threadIdx.x & 63;
    const int cur = t >> 6;
    unsigned nib = 0u;
    if (cur <= 15) { const int jb = lane * 4;
#pragma unroll
        for (int c = 0; c < 4; ++c) if (jb + c <= cur) nib |= 1u << c; }
    else {
        const int jb = lane * 4;
        unsigned key[4];
        {
            float fnext = __shfl_down(ff[0], 1);
            if (lane == 63) fnext = 0.f;
            const float v0 = pp[0] + ff[1], v1 = pp[1] + ff[2], v2 = pp[2] + ff[3], v3 = pp[3] + fnext;
            key[0] = (jb + 0 >= 1 && jb + 0 <= cur - 2) ? __float_as_uint(fmaxf(v0, 0.f)) + 1u : 0u;
            key[1] = (jb + 1 >= 1 && jb + 1 <= cur - 2) ? __float_as_uint(fmaxf(v1, 0.f)) + 1u : 0u;
            key[2] = (jb + 2 >= 1 && jb + 2 <= cur - 2) ? __float_as_uint(fmaxf(v2, 0.f)) + 1u : 0u;
            key[3] = (jb + 3 >= 1 && jb + 3 <= cur - 2) ? __float_as_uint(fmaxf(v3, 0.f)) + 1u : 0u;
        }
        unsigned prefix = 0u; bool exact = false;
        for (int b = 30; b >= 0; --b) {
            const unsigned trial = prefix | (1u << b);
            const int cnt = __popcll(__ballot(key[0] >= trial)) + __popcll(__ballot(key[1] >= trial)) + __popcll(__ballot(key[2] >= trial)) + __popcll(__ballot(key[3] >= trial));
            if (cnt >= 13) { prefix = trial; if (cnt == 13) { exact = true; break; } }
        }
#pragma unroll
        for (int c = 0; c < 4; ++c) if (exact ? (key[c] >= prefix) : (key[c] > prefix)) nib |= 1u << c;
        if (!exact) {
            int need = 13 - (__popcll(__ballot(key[0] > prefix)) + __popcll(__ballot(key[1] > prefix)) + __popcll(__ballot(key[2] > prefix)) + __popcll(__ballot(key[3] > prefix)));
            unsigned tie = 0u;
#pragma unroll
            for (int c = 0; c < 4; ++c) if (key[c] == prefix) tie |= 1u << c;
            for (int guard = 0; need > 0 && guard < 16; ++guard) {
                const unsigned long long any = __ballot(tie != 0u);
                if (any == 0ull) break;
                const int L = __builtin_ctzll(any);
                if (lane == L) { const unsigned low = tie & (0u - tie); nib |= low; tie ^= low; }
                --need;
            }
        }
        if (lane == 0) nib |= 1u;
        if (lane == (cur >> 2)) nib |= 1u << (cur & 3);
        if (lane == ((cur - 1) >> 2)) nib |= 1u << ((cur - 1) & 3);
    }
    unsigned x = nib << (4 * (lane & 7));
    x |= __shfl_xor(x, 1); x |= __shfl_xor(x, 2); x |= __shfl_xor(x, 4);
    if ((lane & 7) == 0) BM[((size_t)t * 4 + g) * 8 + (lane >> 3)] = x;
}
#undef KSWZ
}

template <bool FFN_REMAP = false>
__device__ __forceinline__ void convT(const float* __restrict__ src0, int K, int N, bf16_t* __restrict__ dst, int ldd, LAS float* tile, int bid, int nb, int Nfull = 0, int n0 = 0) {
    const float* __restrict__ src = src0 + n0; if (Nfull == 0) Nfull = N;
    const int tid = threadIdx.x, tk = K >> 6, tn = (N + 63) >> 6, total = tk * tn;
    const int r = tid >> 4, c4 = (tid & 15) * 4;
    f32x4 v[2] = {{0.f, 0.f, 0.f, 0.f}, {0.f, 0.f, 0.f, 0.f}}, vn[2];
    if (bid < total) { const int nti = bid % tn, kti = bid / tn, ng = nti * 64 + c4;
#pragma unroll
        for (int h = 0; h < 2; ++h) if (ng < N) v[h] = *(const f32x4*)(src + (size_t)(kti * 64 + r + h * 32) * Nfull + ng); }
    for (int idx = bid; idx < total; idx += nb) {
        const int nti = idx % tn, kti = idx / tn;
#pragma unroll
        for (int h = 0; h < 2; ++h) { LAS float* tp = tile + (r + h * 32) * 65 + c4; tp[0] = v[h][0]; tp[1] = v[h][1]; tp[2] = v[h][2]; tp[3] = v[h][3]; }
        {
            const int nx = idx + nb; vn[0] = (f32x4){0.f, 0.f, 0.f, 0.f}; vn[1] = vn[0];
            if (nx < total) { const int nti2 = nx % tn, kti2 = nx / tn, ng2 = nti2 * 64 + c4;
#pragma unroll
                for (int h = 0; h < 2; ++h) if (ng2 < N) vn[h] = *(const f32x4*)(src + (size_t)(kti2 * 64 + r + h * 32) * Nfull + ng2); } }
        __syncthreads();
        const int n = tid >> 3, k8 = (tid & 7) * 8, ngl = nti * 64 + n;
        float e[8];
#pragma unroll
        for (int i = 0; i < 8; ++i) e[i] = tile[(k8 + i) * 65 + n];
        if (ngl < N) { u32x4 w; w.x = cvt_pk_bf16(e[0], e[1]); w.y = cvt_pk_bf16(e[2], e[3]); w.z = cvt_pk_bf16(e[4], e[5]); w.w = cvt_pk_bf16(e[6], e[7]);
            int drow = ngl; if (FFN_REMAP) { const int up = ngl >= DFF ? 1 : 0, f = ngl - up * DFF; drow = (f >> 7) * 256 + up * 128 + (f & 127); }
            *(u32x4*)(dst + (size_t)drow * ldd + kti * 64 + k8) = w; }
        __syncthreads();
        v[0] = vn[0]; v[1] = vn[1];
    }
}
__device__ __forceinline__ void convT8(const float* __restrict__ src0, int K, int N, unsigned char* __restrict__ dst, int ldd, float scale, LAS float* tile, int bid, int nb, int Nfull = 0, int n0 = 0) {
    const float* __restrict__ src = src0 + n0; if (Nfull == 0) Nfull = N;
    const int tid = threadIdx.x, tk = K >> 6, tn = (N + 63) >> 6, total = tk * tn;
    const int r = tid >> 4, c4 = (tid & 15) * 4;
    f32x4 v[2] = {{0.f, 0.f, 0.f, 0.f}, {0.f, 0.f, 0.f, 0.f}}, vn[2];
    if (bid < total) { const int nti = bid % tn, kti = bid / tn, ng = nti * 64 + c4;
#pragma unroll
        for (int h = 0; h < 2; ++h) if (ng < N) v[h] = *(const f32x4*)(src + (size_t)(kti * 64 + r + h * 32) * Nfull + ng); }
    for (int idx = bid; idx < total; idx += nb) {
        const int nti = idx % tn, kti = idx / tn;
#pragma unroll
        for (int h = 0; h < 2; ++h) { LAS float* tp = tile + (r + h * 32) * 65 + c4; tp[0] = v[h][0]; tp[1] = v[h][1]; tp[2] = v[h][2]; tp[3] = v[h][3]; }
        { const int nx = idx + nb; vn[0] = (f32x4){0.f, 0.f, 0.f, 0.f}; vn[1] = vn[0];
            if (nx < total) { const int nti2 = nx % tn, kti2 = nx / tn, ng2 = nti2 * 64 + c4;
#pragma unroll
                for (int h = 0; h < 2; ++h) if (ng2 < N) vn[h] = *(const f32x4*)(src + (size_t)(kti2 * 64 + r + h * 32) * Nfull + ng2); } }
        __syncthreads();
        const int n = tid >> 3, k8 = (tid & 7) * 8, ngl = nti * 64 + n;
        float e[8];
#pragma unroll
        for (int i = 0; i < 8; ++i) e[i] = tile[(k8 + i) * 65 + n] * scale;
        if (ngl < N) { int p0 = __builtin_amdgcn_cvt_pk_fp8_f32(e[0], e[1], 0, false); p0 = __builtin_amdgcn_cvt_pk_fp8_f32(e[2], e[3], p0, true);
            int p1 = __builtin_amdgcn_cvt_pk_fp8_f32(e[4], e[5], 0, false); p1 = __builtin_amdgcn_cvt_pk_fp8_f32(e[6], e[7], p1, true);
            *(u32x2*)(dst + (size_t)ngl * ldd + kti * 64 + k8) = (u32x2){(unsigned)p0, (unsigned)p1}; }
        __syncthreads();
        v[0] = vn[0]; v[1] = vn[1];
    }
}
__device__ __forceinline__ void rmsnorm_rows(const float* __restrict__ src, const float* __restrict__ w, bf16_t* __restrict__ dst, int rows, int gw, int nw, unsigned char* __restrict__ dst8 = nullptr) {
    const int lane = threadIdx.x & 63;
    f32x4 v[16], vn[16];
    if (gw < rows) { const f32x4* sp = (const f32x4*)(src + (size_t)gw * DM);
#pragma unroll
        for (int i = 0; i < 16; ++i) v[i] = sp[lane + 64 * i]; }
    for (int row = gw; row < rows; row += nw) {
        const int nr = row + nw < rows ? row + nw : row;
        { const f32x4* sp = (const f32x4*)(src + (size_t)nr * DM);
#pragma unroll
          for (int i = 0; i < 16; ++i) vn[i] = sp[lane + 64 * i]; }
        float ss = 0.f;
#pragma unroll
        for (int i = 0; i < 16; ++i) ss += v[i][0] * v[i][0] + v[i][1] * v[i][1] + v[i][2] * v[i][2] + v[i][3] * v[i][3];
        ss = wave_sum(ss);
        const float rstd = rsqrtf(ss * (1.0f / DM) + EPS);
#pragma unroll
        for (int i = 0; i < 16; ++i) { const f32x4 ww = ((const f32x4*)w)[lane + 64 * i];
            u32x2 o; o.x = cvt_pk_bf16(v[i][0] * rstd * ww[0], v[i][1] * rstd * ww[1]); o.y = cvt_pk_bf16(v[i][2] * rstd * ww[2], v[i][3] * rstd * ww[3]);
            *(u32x2*)(dst + (size_t)row * DM + (lane + 64 * i) * 4) = o;
            if (dst8) { int pk = __builtin_amdgcn_cvt_pk_fp8_f32(v[i][0] * rstd * ww[0], v[i][1] * rstd * ww[1], 0, false); pk = __builtin_amdgcn_cvt_pk_fp8_f32(v[i][2] * rstd * ww[2], v[i][3] * rstd * ww[3], pk, true);
                *(int*)(dst8 + (size_t)row * DM + (lane + 64 * i) * 4) = pk; } }
#pragma unroll
        for (int i = 0; i < 16; ++i) v[i] = vn[i];
    }
}

struct Ptrs {
    bf16_t *Win, *Wo, *Wfi, *Wfo, *Wg, *Wple, *Wpool, *Wc1k, *Wc1v, *XN, *PB, *Z, *M, *KC, *VC, *MIX, *ACT, *ERAW;
    float *COS, *SIN, *TAB, *G, *H1, *L, *OACC, *IMPP, *IMPF, *ERSTD; unsigned* BM;
};

__device__ __forceinline__ void phase_prologue(const Params& P, const Ptrs& W, LAS unsigned char* lds) {
    const int bid = blockIdx.x, nb = gridDim.x, tid = threadIdx.x, lane = tid & 63, wv = tid >> 6;
    const int gw = bid * NWAVES + wv, nw = nb * NWAVES; const size_t gt = (size_t)bid * NTHREADS + tid, ntot = (size_t)nb * NTHREADS;
    LAS float* tile = (LAS float*)lds;
    rmsnorm_rows(P.x, P.norm1_w, W.XN, S_, gw, nw, P.ws + WS_XN8);
    convT(P.w_in, DM, POOLW, W.Win, DM, tile, bid, nb, INW, 0);
    convT(P.w_in, DM, INW - OFF_G, W.Win + (size_t)OFF_G * DM, DM, tile, bid, nb, INW, OFF_G);
    convT8(P.w_in, DM, OFF_G - POOLW, P.ws + WS_WIN8, DM, WG8_SCALE, tile, bid, nb, INW, POOLW);
    for (size_t i = gt; i < (size_t)(LDZ - INW) * DM / 8; i += ntot) *(u32x4*)(W.Win + (size_t)INW * DM + i * 8) = (u32x4){0u, 0u, 0u, 0u};
    convT(P.w_o, DM, DM, W.Wo, DM, tile, bid, nb);
    convT<true>(P.w_ffn_in, DM, NFI, W.Wfi, DM, tile, bid, nb);
    for (size_t i = gt; i < (size_t)2 * DM / 8; i += ntot) *(u32x4*)(W.XN - 2 * DM + i * 8) = (u32x4){0u, 0u, 0u, 0u};
    convT(P.w_ffn_out, DFF, DM, W.Wfo, DFF, tile, bid, nb);
    convT8(P.w_ple_gate, DM, DM, (unsigned char*)W.Wg, DM, WG8_SCALE, tile, bid, nb);
    convT(P.w_ple_proj, PLE, DM, W.Wple, PLE, tile, bid, nb);
    for (int g = 0; g < 4; ++g) convT(P.w_pool + (size_t)g * 65536, 256, 256, W.Wpool + (size_t)g * 65536, 256, tile, bid, nb);
    convT(P.cmp_k_w1, 4096, 256, W.Wc1k, 4096, tile, bid, nb);
    convT(P.cmp_v_w1, 4096, 256, W.Wc1v, 4096, tile, bid, nb);
    { constexpr size_t NP8 = (size_t)S_ * PLE / 8;
      for (size_t ib = gt; ib < NP8; ib += 4 * ntot) { f32x4 av[4], bv[4];
#pragma unroll
          for (int k = 0; k < 4; ++k) { size_t i = ib + k * ntot; if (i >= NP8) i = NP8 - 1; av[k] = *(const f32x4*)(P.p + i * 8); bv[k] = *(const f32x4*)(P.p + i * 8 + 4); }
#pragma unroll
          for (int k = 0; k < 4; ++k) { const size_t i = ib + k * ntot; if (i < NP8) { u32x4 w; w.x = cvt_pk_bf16(av[k][0], av[k][1]); w.y = cvt_pk_bf16(av[k][2], av[k][3]); w.z = cvt_pk_bf16(bv[k][0], bv[k][1]); w.w = cvt_pk_bf16(bv[k][2], bv[k][3]); *(u32x4*)(W.PB + i * 8) = w; } } } }
    for (size_t i = gt; i < (size_t)S_ * 16; i += ntot) { const int t = (int)(i >> 4), fi = (int)(i & 15);
        const float inv = exp2f(-(float)fi * (18.931568569324174f / 16.0f)); const float ang = (float)P.positions[t] * inv;
        const double ad = (double)ang; const double kk = rint(ad * 0.15915494309189535); const float rf = (float)(ad - kk * 6.283185307179586);
        W.COS[i] = __cosf(rf); W.SIN[i] = __sinf(rf); }
    for (int task = gw; task < 128; task += nw) { const int which = task >> 6, r0 = (task & 63) * 64; const float* pe = which ? P.cmp_pos_v : P.cmp_pos_k; const float* w1 = which ? P.cmp_v_w1 : P.cmp_k_w1;
        f32x4 s = {0.f, 0.f, 0.f, 0.f};
#pragma unroll 8
        for (int r = 0; r < 64; ++r) { const f32x4 wv = *(const f32x4*)(w1 + (size_t)(r0 + r) * 256 + lane * 4); s += wv * pe[r0 + r]; }
        float* cbp = (float*)(P.ws + WS_CBIAS) + which * 256 + lane * 4;
        unsafeAtomicAdd(cbp + 0, s[0]); unsafeAtomicAdd(cbp + 1, s[1]); unsafeAtomicAdd(cbp + 2, s[2]); unsafeAtomicAdd(cbp + 3, s[3]); }
    if (gw == 0) { float mq = fmaxf(fabsf(P.q_norm_w[lane]), fabsf(P.q_norm_w[lane + 64])); mq = wave_max(mq);
        float mc = wave_max(fmaxf(fabsf(P.k_norm_cmp_w[lane]), fabsf(P.k_norm_cmp_w[lane + 64])));
        float ms = wave_max(fmaxf(fabsf(P.k_norm_slc_w[lane]), fabsf(P.k_norm_slc_w[lane + 64])));
        float mw = wave_max(fmaxf(fabsf(P.k_norm_win_w[lane]), fabsf(P.k_norm_win_w[lane + 64])));
        const float c = 11.313708498984761f * 1.4426950408889634f * mq * 1.01f;
        if (lane == 0) { W.TAB[512] = c * mc; W.TAB[513] = c * ms; W.TAB[514] = c * mw; } }
}

__device__ __forceinline__ void phase_postz(const Params& P, const Ptrs& W, int gw, int nw) {
    const int tid = threadIdx.x, lane = tid & 63;
    const f32x2 wq = *(const f32x2*)(P.q_norm_w + 2 * lane), wks = *(const f32x2*)(P.k_norm_slc_w + 2 * lane), wkw = *(const f32x2*)(P.k_norm_win_w + 2 * lane);
    for (int t = gw; t < S_; t += nw) {
        bf16_t* zr = W.Z + (size_t)t * LDZ;
        float cs0 = 0.f, cs1 = 0.f, sn0 = 0.f, sn1 = 0.f;
        if (lane < 16) { const int i0 = (2 * lane) & 15; cs0 = W.COS[t * 16 + i0]; cs1 = W.COS[t * 16 + i0 + 1]; sn0 = W.SIN[t * 16 + i0]; sn1 = W.SIN[t * 16 + i0 + 1]; }
        unsigned uv[32];
#pragma unroll
        for (int v = 0; v < 32; ++v) { const int col = v < 24 ? OFF_Q + v * HD : (v < 28 ? OFF_KV + 2 * 512 + (v - 24) * HD : OFF_KV + 4 * 512 + (v - 28) * HD);
            uv[v] = *((const unsigned*)(zr + col) + lane); }
#pragma unroll
        for (int v = 0; v < 32; ++v) {
            const f32x2 ww = v < 24 ? wq : (v < 28 ? wks : wkw);
            const unsigned u = uv[v]; const float x0 = bf_lo(u), x1 = bf_hi(u);
            const float ss = wave_sum(x0 * x0 + x1 * x1);
            const float rstd = rsqrtf(ss * (1.0f / HD) + EPS);
            float y0 = x0 * rstd * ww[0], y1 = x1 * rstd * ww[1];
            const float p0 = __shfl_xor(y0, 8), p1 = __shfl_xor(y1, 8);
            if (lane < 8) { y0 = y0 * cs0 - p0 * sn0; y1 = y1 * cs1 - p1 * sn1; }
            else if (lane < 16) { y0 = y0 * cs0 + p0 * sn0; y1 = y1 * cs1 + p1 * sn1; }
            uv[v] = cvt_pk_bf16(y0, y1);
        }
        {
            const int gi = lane >> 4, wlen = 2 << gi, c0 = lane * 16; const int cnt = (t + 1) < wlen ? (t + 1) : wlen;
            float s[16];
#pragma unroll
            for (int i = 0; i < 16; ++i) s[i] = 0.f;
            float cur[16];
#pragma unroll
            for (int bt = 0; bt < 2; ++bt) {
                u32x4 ra[8], rb[8];
#pragma unroll
                for (int i = 0; i < 8; ++i) { const int ii = bt * 8 + i; const size_t row = (size_t)(ii < cnt ? t - ii : t);
                    ra[i] = *(const u32x4*)(W.Z + row * LDZ + c0); rb[i] = *(const u32x4*)(W.Z + row * LDZ + c0 + 8); }
#pragma unroll
                for (int i = 0; i < 8; ++i) { const int ii = bt * 8 + i; const float mk = ii < cnt ? 1.0f : 0.0f; const u32x4 a = ra[i], b = rb[i];
                    const float ev[16] = {bf_lo(a.x), bf_hi(a.x), bf_lo(a.y), bf_hi(a.y), bf_lo(a.z), bf_hi(a.z), bf_lo(a.w), bf_hi(a.w), bf_lo(b.x), bf_hi(b.x), bf_lo(b.y), bf_hi(b.y), bf_lo(b.z), bf_hi(b.z), bf_lo(b.w), bf_hi(b.w)};
#pragma unroll
                    for (int q = 0; q < 16; ++q) { s[q] += ev[q] * mk; if (ii == 0) cur[q] = ev[q]; } }
                if (bt == 0 && __all(cnt <= 8)) break;
            }
            const float rc = 1.0f / (float)cnt;
            u32x4 o0, o1;
            o0.x = cvt_pk_bf16(s[0] * rc - cur[0], s[1] * rc - cur[1]); o0.y = cvt_pk_bf16(s[2] * rc - cur[2], s[3] * rc - cur[3]);
            o0.z = cvt_pk_bf16(s[4] * rc - cur[4], s[5] * rc - cur[5]); o0.w = cvt_pk_bf16(s[6] * rc - cur[6], s[7] * rc - cur[7]);
            o1.x = cvt_pk_bf16(s[8] * rc - cur[8], s[9] * rc - cur[9]); o1.y = cvt_pk_bf16(s[10] * rc - cur[10], s[11] * rc - cur[11]);
            o1.z = cvt_pk_bf16(s[12] * rc - cur[12], s[13] * rc - cur[13]); o1.w = cvt_pk_bf16(s[14] * rc - cur[14], s[15] * rc - cur[15]);
            *(u32x4*)(W.M + (size_t)t * POOLW + c0) = o0; *(u32x4*)(W.M + (size_t)t * POOLW + c0 + 8) = o1;
        }
#pragma unroll
        for (int v = 0; v < 32; ++v) { const int col = v < 24 ? OFF_Q + v * HD : (v < 28 ? OFF_KV + 2 * 512 + (v - 24) * HD : OFF_KV + 4 * 512 + (v - 28) * HD);
            *((unsigned*)(zr + col) + lane) = uv[v]; }

    }
}

__device__ __forceinline__ void phase_cmpfin(const Params& P, const Ptrs& W) {
    const int tid = threadIdx.x, lane = tid & 63, gw = blockIdx.x * NWAVES + (tid >> 6), nw = gridDim.x * NWAVES;
    const f32x2 wk = *(const f32x2*)(P.k_norm_cmp_w + 2 * lane);
    for (int task = gw; task < 8192; task += nw) {
        const int tk = __builtin_amdgcn_readfirstlane(task);
        const int which = tk >> 12, g = (tk >> 10) & 3, n = tk & 1023;
        bf16_t* dst = (which ? W.VC : W.KC) + ((size_t)g * 1024 + n) * HD;
        if (n == 1023) { ((unsigned*)dst)[lane] = 0u; continue; }
        const float* h = W.H1 + (size_t)tk * 256; const float* w2 = which ? P.cmp_v_w2 : P.cmp_k_w2;
        float a0 = 0.f, a1 = 0.f;
        for (int j = 0; j < 256; ++j) { const float hj = h[j]; const f32x2 wv = *(const f32x2*)(w2 + j * HD + 2 * lane); a0 += hj * wv[0]; a1 += hj * wv[1]; }
        if (which == 0) {
            const float ss = wave_sum(a0 * a0 + a1 * a1); const float rstd = rsqrtf(ss * (1.0f / HD) + EPS);
            a0 = a0 * rstd * wk[0]; a1 = a1 * rstd * wk[1];
            const int tp = 16 * n + 31; const float p0 = __shfl_xor(a0, 8), p1 = __shfl_xor(a1, 8);
            if (lane < 16) { const int i0 = (2 * lane) & 15; const float cs0 = W.COS[tp * 16 + i0], cs1 = W.COS[tp * 16 + i0 + 1], sn0 = W.SIN[tp * 16 + i0], sn1 = W.SIN[tp * 16 + i0 + 1];
                if (lane < 8) { a0 = a0 * cs0 - p0 * sn0; a1 = a1 * cs1 - p1 * sn1; } else { a0 = a0 * cs0 + p0 * sn0; a1 = a1 * cs1 + p1 * sn1; } }
        }
        ((unsigned*)dst)[lane] = cvt_pk_bf16(a0, a1);
    }
}

__device__ __forceinline__ void phase_erstd(const Ptrs& W) {
    const int tid = threadIdx.x, lane = tid & 63, gw = blockIdx.x * NWAVES + (tid >> 6), nw = gridDim.x * NWAVES;
    u32x4 a[8], an[8];
    if (gw < S_) { const u32x4* sp = (const u32x4*)(W.ERAW + (size_t)gw * DM);
#pragma unroll
        for (int i = 0; i < 8; ++i) a[i] = sp[lane + 64 * i]; }
    for (int row = gw; row < S_; row += nw) {
        const int nr = row + nw < S_ ? row + nw : row;
        { const u32x4* sp = (const u32x4*)(W.ERAW + (size_t)nr * DM);
#pragma unroll
          for (int i = 0; i < 8; ++i) an[i] = sp[lane + 64 * i]; }
        float ss = 0.f;
#pragma unroll
        for (int i = 0; i < 8; ++i) {
            const float e0 = bf_lo(a[i].x), e1 = bf_hi(a[i].x), e2 = bf_lo(a[i].y), e3 = bf_hi(a[i].y), e4 = bf_lo(a[i].z), e5 = bf_hi(a[i].z), e6 = bf_lo(a[i].w), e7 = bf_hi(a[i].w);
            ss += e0 * e0 + e1 * e1 + e2 * e2 + e3 * e3 + e4 * e4 + e5 * e5 + e6 * e6 + e7 * e7; }
        ss = wave_sum(ss);
        if (lane == 0) W.ERSTD[row] = rsqrtf(ss * (1.0f / DM) + EPS);
#pragma unroll
        for (int i = 0; i < 8; ++i) a[i] = an[i];
    }
}

constexpr int N_PHASES = 11;
__device__ __forceinline__ Params kargs() {
#if defined(__HIP_DEVICE_COMPILE__)
    unsigned long long p = (unsigned long long)__builtin_amdgcn_kernarg_segment_ptr();
    asm volatile("" : "+s"(p));
    return *(const __attribute__((address_space(4))) Params*)p;
#else
    return Params{};
#endif
}
__device__ __forceinline__ Ptrs mkptrs(unsigned char* ws) {
    Ptrs W;
    W.Win = (bf16_t*)(ws + WS_WIN); W.Wo = (bf16_t*)(ws + WS_WO); W.Wfi = (bf16_t*)(ws + WS_WFI); W.Wfo = (bf16_t*)(ws + WS_WFO); W.Wg = (bf16_t*)(ws + WS_WG);
    W.Wple = (bf16_t*)(ws + WS_WPLE); W.Wpool = (bf16_t*)(ws + WS_WPOOL); W.Wc1k = (bf16_t*)(ws + WS_WC1K); W.Wc1v = (bf16_t*)(ws + WS_WC1V);
    W.XN = (bf16_t*)(ws + WS_XN); W.PB = (bf16_t*)(ws + WS_PB); W.Z = (bf16_t*)(ws + WS_Z); W.M = (bf16_t*)(ws + WS_M); W.KC = (bf16_t*)(ws + WS_KC); W.VC = (bf16_t*)(ws + WS_VC);
    W.MIX = (bf16_t*)(ws + WS_MIX); W.ACT = (bf16_t*)(ws + WS_ACT); W.ERAW = (bf16_t*)(ws + WS_ERAW);
    W.COS = (float*)(ws + WS_COS); W.SIN = (float*)(ws + WS_SIN); W.TAB = (float*)(ws + WS_TAB); W.G = (float*)(ws + WS_G); W.H1 = (float*)(ws + WS_H1); W.L = (float*)(ws + WS_L);
    W.OACC = (float*)(ws + WS_OACC); W.IMPP = (float*)(ws + WS_IMPP); W.IMPF = (float*)(ws + WS_IMPF); W.ERSTD = (float*)(ws + WS_ERSTD); W.BM = (unsigned*)(ws + WS_BM);
    return W;
}
__global__ void __launch_bounds__(NTHREADS, 2) fwd(Params Punused) {
    extern __shared__ __attribute__((aligned(16))) unsigned char lds_raw[];
    LAS unsigned char* lds = (LAS unsigned char*)lds_raw;
    const int tid = threadIdx.x;
    const int G = gridDim.x, bid = blockIdx.x;
    const int gw = bid * NWAVES + (tid >> 6), nw = G * NWAVES;

    if (tid < 16) ((LAS unsigned*)(lds + LDS_MISC))[tid] = 0u;
    __syncthreads();
    int lo, hi; XcdBarrier bar;
    { const Params P = kargs(); lo = P.ph_lo; hi = P.ph_hi;
      bar.bar = (unsigned*)(P.ws + WS_CTL); bar.x = 0; bar.st = (volatile LAS unsigned*)(lds + LDS_MISC);
      if (hi - lo > 1) bar = xcd_barrier_post((unsigned*)(P.ws + WS_CTL), (volatile LAS unsigned*)(lds + LDS_MISC)); }
#ifdef PH_MASK
#define IN(k) (((PH_MASK >> (k)) & 1) && lo <= (k) && (k) < hi)
#else
#define IN(k) (lo <= (k) && (k) < hi)
#endif
#define SEAM(k) do { if (IN(k) && IN((k) + 1)) xcd_barrier(bar); } while (0)
#define PHASE_VARS const Params P = kargs(); const Ptrs W = mkptrs(P.ws); (void)W;
#define ATT_ARGS att::AttnArgs AA{W.Z, W.KC, W.VC, W.G, W.L, W.OACC, W.MIX, W.BM, W.TAB};

    if (IN(0)) { PHASE_VARS REP(0) { phase_prologue(P, W, lds); } SEAM(0); }
    if (IN(1)) {
        PHASE_VARS
        { pg8::GStd g{(const char*)W.XN, (const char*)W.Win, DM, DM, DM / 64}; pg8::StaticOrder S; S.init(S_ / 256, POOLW / 256, G, bid);
          pg8::EpiBf16 E{W.Z, LDZ}; pg8::gemm_phase(lds, g, S, E); }
        { pg8::GStd g{(const char*)(P.ws + WS_XN8), (const char*)(P.ws + WS_WIN8), DM / 2, DM / 2, DM / 128}; pg8::StaticOrder S; S.init(S_ / 256, (OFF_G - POOLW) / 256, G, bid);
          pg8::EpiBf16S E{W.Z + POOLW, LDZ, 1.0f / WG8_SCALE}; pg8::gemm_phase<pg8::GStd, pg8::EpiBf16S, true>(lds, g, S, E); }
        SEAM(1);
    }
    if (IN(2)) {
        PHASE_VARS
        if (G > 64) {
            if (bid < 32) { pg8::GCmp g{(const char*)W.Z, (const char*)W.Wc1k, (const char*)W.Wc1v, 16 * LDZ, 4096, 64}; pg8::StaticOrder S; S.init(32, 1, 32, bid);
                pg8::EpiCmpGelu E{W.H1, (const float*)(P.ws + WS_CBIAS)}; pg8::gemm_phase(lds, g, S, E); }
            else if (bid < 96) {
                pg8::GStd g{(const char*)W.XN, (const char*)(W.Win + (size_t)OFF_G * DM), DM, DM, DM / 64}; pg8::StaticOrder S; S.init(S_ / 256, 1, 64, bid - 32);
                pg8::EpiBf16 E{W.Z + OFF_G, LDZ}; pg8::gemm_phase(lds, g, S, E); }
            else phase_postz(P, W, (bid - 96) * NWAVES + (tid >> 6), (G - 96) * NWAVES);
        } else {
            { pg8::GStd g{(const char*)W.XN, (const char*)(W.Win + (size_t)OFF_G * DM), DM, DM, DM / 64}; pg8::StaticOrder S; S.init(S_ / 256, 1, G, bid);
              pg8::EpiBf16 E{W.Z + OFF_G, LDZ}; pg8::gemm_phase(lds, g, S, E); }
            { pg8::GCmp g{(const char*)W.Z, (const char*)W.Wc1k, (const char*)W.Wc1v, 16 * LDZ, 4096, 64}; pg8::StaticOrder S; S.init(32, 1, G, bid);
              pg8::EpiCmpGelu E{W.H1, (const float*)(P.ws + WS_CBIAS)}; pg8::gemm_phase(lds, g, S, E); }
            phase_postz(P, W, gw, nw);
        }
        SEAM(2);
    }
    if (IN(3)) {
        PHASE_VARS
        {
            const size_t i0 = (size_t)bid * NTHREADS + tid, st = (size_t)G * NTHREADS, NG = (size_t)S_ * NGATE;
            for (size_t ib = i0; ib < NG; ib += 9 * st) { float zv[9];
#pragma unroll
                for (int k = 0; k < 9; ++k) { size_t i = ib + k * st; if (i >= NG) i = NG - 1; const int t = (int)(i / NGATE), c = (int)(i % NGATE); zv[k] = bf2f(W.Z[(size_t)t * LDZ + OFF_G + c]); }
#pragma unroll
                for (int k = 0; k < 9; ++k) { const size_t i = ib + k * st; if (i < NG) W.G[i] = sigmoidf_(zv[k]); } } }
        phase_cmpfin(P, W);
        { pg8::GPool g{(const char*)W.M, (const char*)W.Wpool, POOLW, 256, 4}; pg8::StaticOrder S; S.init(S_ / 256, 4, G, bid);
          pg8::EpiBf16Scale E{W.MIX, DM, P.pool_scale}; pg8::gemm_phase(lds, g, S, E); }
        SEAM(3);
    }
    if (IN(4)) {
        PHASE_VARS ATT_ARGS
        REP(4)
        for (int base = 0, rnd = 0; base < 1536; base += G, ++rnd) {
            int qt, g, hp;
            if (G == 256) { const int x = bid & 7, r = bid >> 3, qp = (rnd / 3) ? 63 - r : r; if (rnd >= 6) break; g = x & 3; qt = 2 * qp + (x >> 2); hp = rnd % 3; }
            else { const int Lu = base + ((rnd & 1) ? G - 1 - bid : bid); if (Lu >= 1536) continue; qt = Lu / 12; const int rem = Lu % 12; g = rem / 3; hp = rem % 3; }
            att::attn_unit<att::MODE_CMP>(AA, (LAS char*)lds, qt, g, hp);
            asm volatile("s_waitcnt vmcnt(0)" ::: "memory");
            att::attn_unit<att::MODE_WIN>(AA, (LAS char*)lds, qt, g, hp);
            if (G == 256 && hp == 2) {
                asm volatile("s_waitcnt vmcnt(0)" ::: "memory");
                const int tqi = qt * 8 + (tid >> 6);
                att::imp_task(AA, W.IMPP, W.IMPF, tqi, g);
                asm volatile("s_waitcnt vmcnt(0)" ::: "memory");
                f32x4 pp, ff, pn, fn; att::topk_load(W.IMPP, W.IMPF, tqi * 16, g, pp, ff);
                for (int q = 0; q < 16; ++q) { att::topk_load(W.IMPP, W.IMPF, tqi * 16 + (q < 15 ? q + 1 : q), g, pn, fn); att::topk_task(pp, ff, W.BM, tqi * 16 + q, g); pp = pn; ff = fn; } } }
        if (G != 256) SEAM(4);
    }
    if (IN(5)) {
        PHASE_VARS ATT_ARGS
        if (G != 256)
        for (int k = gw, r = 0; k < 4096; k += nw, ++r) { const int hiT = (r + 1) * nw < 4096 ? (r + 1) * nw : 4096;
            const int task = (r & 1) ? hiT - 1 - (k - r * nw) : k;
            att::imp_task(AA, W.IMPP, W.IMPF, task >> 2, task & 3);
            asm volatile("s_waitcnt vmcnt(0)" ::: "memory");
            { const int tb = (task >> 2) * 16, gg = task & 3; f32x4 pp, ff, pn, fn;
              att::topk_load(W.IMPP, W.IMPF, tb, gg, pp, ff);
              for (int q = 0; q < 16; ++q) { att::topk_load(W.IMPP, W.IMPF, tb + (q < 15 ? q + 1 : q), gg, pn, fn); att::topk_task(pp, ff, W.BM, tb + q, gg); pp = pn; ff = fn; } } }
        SEAM(5);
    }
    if (IN(6)) {
        PHASE_VARS ATT_ARGS
#if SLC16
        for (int base = 0, rnd = 0; base < 1368 + G; base += G, ++rnd) {
            int ut, g;
            if (G == 256) { const int x = bid & 7, r = bid >> 3, k = rnd * 32 + ((rnd & 1) ? 31 - r : r); if (k >= 171) break; g = x & 3; ut = 341 - (2 * k + (x >> 2)); }
            else { const int Lu = base + ((rnd & 1) ? G - 1 - bid : bid); if (Lu >= 1368) continue; ut = 341 - Lu / 4; g = Lu % 4; }
            att::slc16_unit(AA, (LAS char*)lds, ut, g); }
#else
        REP(6)
        for (int base = 0, rnd = 0; base < 1640 + G; base += G, ++rnd) {
            int ut, g;
            if (G == 256) { const int x = bid & 7, r = bid >> 3, k = rnd * 32 + ((rnd & 1) ? 31 - r : r); if (k >= 205) break; g = x & 3; ut = 409 - (2 * k + (x >> 2)); }
            else { const int Lu = base + ((rnd & 1) ? G - 1 - bid : bid); if (Lu >= 1640) continue; ut = 409 - Lu / 4; g = Lu % 4; }
            att::attn_unit<att::MODE_SLC>(AA, (LAS char*)lds, ut, g, 0); }
#endif
        SEAM(6);
    }
    if (IN(7)) {
        PHASE_VARS
        { pg8::GStd g{(const char*)W.MIX, (const char*)W.Wo, DM, DM, DM / 64}; pg8::StaticOrder S; S.init(S_ / 256, DM / 256, G, bid);
          pg8::EpiResNorm E{P.x, P.out, W.XN, P.norm2_w, (float*)(P.ws + WS_SSQ1), DM}; pg8::gemm_phase(lds, g, S, E); }
        { pg8::GStd g{(const char*)W.PB, (const char*)W.Wple, PLE, PLE, PLE / 64}; pg8::StaticOrder S; S.init(S_ / 256, DM / 256, G, bid);
          pg8::EpiBf16Ssq E{W.ERAW, DM, (float*)(P.ws + WS_SSQ3)}; pg8::gemm_phase(lds, g, S, E); }
        SEAM(7);
    }
    if (IN(8)) {
        PHASE_VARS
        pg8::GFfn g{(const char*)W.XN, (const char*)W.Wfi, DM, DM, DM / 64}; pg8::StaticOrder S; S.init(65, DFF / 128, G, bid);
        pg8::EpiFfn E{W.ACT, P.conv_w, P.conv_b, (LAS float*)(lds + LDS_XCH), (const float*)(P.ws + WS_SSQ1)}; REP(8) { pg8::gemm_phase(lds, g, S, E); } SEAM(8);
    }
    if (IN(9)) {
        PHASE_VARS
        pg8::GStd g{(const char*)W.ACT, (const char*)W.Wfo, DFF, DFF, DFF / 64}; pg8::StaticOrder S; S.init(S_ / 256, DM / 256, G, bid);
        pg8::EpiResNormF8 E{P.out, P.out, W.XN, P.ple_gate_norm_w, (float*)(P.ws + WS_SSQ2), DM}; pg8::gemm_phase(lds, g, S, E); SEAM(9);
    }
    if (IN(10)) {
        PHASE_VARS
        pg8::GStd g{(const char*)W.XN, (const char*)W.Wg, DM / 2, DM / 2, DM / 128}; pg8::StaticOrder S; S.init(S_ / 256, DM / 256, G, bid);
        pg8::EpiGate E{P.out, W.ERAW, (const float*)(P.ws + WS_SSQ3), P.ple_norm_w, (const float*)(P.ws + WS_SSQ2), DM, 1.0f / WG8_SCALE};
        pg8::gemm_phase<pg8::GStd, pg8::EpiGate, true>(lds, g, S, E);
    }
#undef IN
#undef SEAM
}

extern "C" void kernel_launch(void* const* d_in, const int* in_sizes, int n_in, void* d_out, int out_size, void* d_ws, size_t ws_size, hipStream_t stream) {
    static int grid = 0;
    if (grid == 0) {
        if (n_in != 27 || in_sizes[0] != S_ * DM || out_size != S_ * DM || ws_size < WS_NEED) {
            fprintf(stderr, "kernel_launch: unexpected shapes (n_in %d, in0 %d, out %d, ws %zu < %zu); nothing launched\n", n_in, n_in > 0 ? in_sizes[0] : -1, out_size, ws_size, (size_t)WS_NEED); grid = -1; return; }
        int dev = 0, cus = 0, per_cu = 0;
        if (hipGetDevice(&dev) != hipSuccess || hipDeviceGetAttribute(&cus, hipDeviceAttributeMultiprocessorCount, dev) != hipSuccess) { grid = -1; return; }
        if (hipFuncSetAttribute((const void*)fwd, hipFuncAttributeMaxDynamicSharedMemorySize, LDS_BYTES) != hipSuccess) { fprintf(stderr, "kernel_launch: hipFuncSetAttribute failed\n"); grid = -1; return; }
        if (hipOccupancyMaxActiveBlocksPerMultiprocessor(&per_cu, (const void*)fwd, NTHREADS, LDS_BYTES) != hipSuccess || per_cu < 1) { fprintf(stderr, "kernel_launch: occupancy query says %d\n", per_cu); (void)hipGetLastError(); }
        grid = cus > 256 ? 256 : cus;
    }
    if (grid < 0) return;
    (void)hipMemsetAsync((char*)d_ws + WS_CTL, 0, CTL_BYTES, stream);
    Params P{};
    const float** fp = (const float**)&P;
    P.x = (const float*)d_in[0]; P.p = (const float*)d_in[1]; P.positions = (const int*)d_in[2]; P.norm1_w = (const float*)d_in[3]; P.w_in = (const float*)d_in[4];
    P.w_pool = (const float*)d_in[5]; P.pool_scale = (const float*)d_in[6]; P.q_norm_w = (const float*)d_in[7]; P.k_norm_cmp_w = (const float*)d_in[8];
    P.k_norm_slc_w = (const float*)d_in[9]; P.k_norm_win_w = (const float*)d_in[10]; P.cmp_pos_k = (const float*)d_in[11]; P.cmp_pos_v = (const float*)d_in[12];
    P.cmp_k_w1 = (const float*)d_in[13]; P.cmp_k_w2 = (const float*)d_in[14]; P.cmp_v_w1 = (const float*)d_in[15]; P.cmp_v_w2 = (const float*)d_in[16];
    P.w_o = (const float*)d_in[17]; P.norm2_w = (const float*)d_in[18]; P.w_ffn_in = (const float*)d_in[19]; P.conv_w = (const float*)d_in[20]; P.conv_b = (const float*)d_in[21];
    P.w_ffn_out = (const float*)d_in[22]; P.w_ple_proj = (const float*)d_in[23]; P.ple_norm_w = (const float*)d_in[24]; P.ple_gate_norm_w = (const float*)d_in[25]; P.w_ple_gate = (const float*)d_in[26];
    (void)fp;
    P.out = (float*)d_out; P.ws = (unsigned char*)d_ws;
#if MK_ONE_LAUNCH
    P.ph_lo = 0; P.ph_hi = N_PHASES;
    hipLaunchKernelGGL(fwd, dim3(grid), dim3(NTHREADS), LDS_BYTES, stream, P);
#else
    for (int ph = 0; ph < N_PHASES; ++ph) { P.ph_lo = ph; P.ph_hi = ph + 1; hipLaunchKernelGGL(fwd, dim3(grid), dim3(NTHREADS), LDS_BYTES, stream, P); }
#endif
    const hipError_t le = hipPeekAtLastError();
    if (le != hipSuccess) fprintf(stderr, "kernel_launch: launch failed: %s\n", hipGetErrorName(le));
}
```

```cpp
#include <hip/hip_runtime.h>
#include <cstdio>
#include <cstdint>

#ifndef PROBE_DBL
#define PROBE_DBL 0
#endif
#define REP(k) _Pragma("unroll") for (int rep_ = 0; rep_ < 1 + ((PROBE_DBL >> (k)) & 1); ++rep_)
#ifndef SLC16
#define SLC16 1
#endif
#ifndef MK_ONE_LAUNCH
#define MK_ONE_LAUNCH 1
#endif

#define LAS __attribute__((address_space(3)))
typedef unsigned short bf16_t;
typedef short bf16x8 __attribute__((ext_vector_type(8)));
typedef short s16x4 __attribute__((ext_vector_type(4)));
typedef float f32x2 __attribute__((ext_vector_type(2)));
typedef float f32x4 __attribute__((ext_vector_type(4)));
typedef float f32x16 __attribute__((ext_vector_type(16)));
typedef unsigned u32x2 __attribute__((ext_vector_type(2)));
typedef unsigned u32x4 __attribute__((ext_vector_type(4)));
typedef int i32x4 __attribute__((ext_vector_type(4)));
typedef int i32x8 __attribute__((ext_vector_type(8)));

constexpr int S_ = 16384, DM = 4096, INW = 7240, LDZ = 7424, POOLW = 1024, NH = 24, NKV = 4, HPG = 6, HD = 128;
constexpr int OFF_Q = 1024, OFF_KV = 4096, OFF_G = 7168, DFF = 11008, NFI = 22016, PLE = 256, NGATE = 72;
constexpr int ZROWS = S_ + 64, XNROWS = S_ + 256, CHUNK = 8192;
constexpr float EPS = 1e-6f;
constexpr float SM_C = 0.08838834764831845f * 1.4426950408889634f;
constexpr int NWAVES = 8, NTHREADS = 512;
constexpr float WG8_SCALE = 128.0f;

constexpr size_t al256(size_t x) { return (x + 255) / 256 * 256; }
constexpr size_t WS_CTL   = 0;
constexpr size_t CTL_BYTES = 262144;
constexpr size_t WS_CBIAS = WS_CTL + 32768;
constexpr size_t WS_SSQ1 = WS_CTL + 65536, WS_SSQ2 = WS_CTL + 131072, WS_SSQ3 = WS_CTL + 196608;
constexpr size_t WS_WIN   = WS_CTL + CTL_BYTES;
constexpr size_t WS_WO    = WS_WIN + al256((size_t)LDZ * DM * 2);
constexpr size_t WS_WFI   = WS_WO + al256((size_t)DM * DM * 2);
constexpr size_t WS_WFO   = WS_WFI + al256((size_t)NFI * DM * 2);
constexpr size_t WS_WG    = WS_WFO + al256((size_t)DM * DFF * 2);
constexpr size_t WS_WPLE  = WS_WG + al256((size_t)DM * DM * 2);
constexpr size_t WS_WPOOL = WS_WPLE + al256((size_t)DM * PLE * 2);
constexpr size_t WS_WC1K  = WS_WPOOL + al256((size_t)1024 * 256 * 2);
constexpr size_t WS_WC1V  = WS_WC1K + al256((size_t)256 * 4096 * 2);
constexpr size_t WS_COS   = WS_WC1V + al256((size_t)256 * 4096 * 2);
constexpr size_t WS_SIN   = WS_COS + al256((size_t)S_ * 16 * 4);
constexpr size_t WS_TAB   = WS_SIN + al256((size_t)S_ * 16 * 4);
constexpr size_t WS_XNP   = WS_TAB + 4096;
constexpr size_t WS_XN    = WS_XNP + (size_t)2 * DM * 2;
constexpr size_t WS_PB    = WS_XN + al256((size_t)XNROWS * DM * 2);
constexpr size_t WS_XN8   = WS_PB + al256((size_t)S_ * PLE * 2);
constexpr size_t WS_WIN8  = WS_XN8 + al256((size_t)S_ * DM);
constexpr size_t WS_R     = WS_WIN8 + al256((size_t)(OFF_G - POOLW) * DM);
constexpr size_t WS_Z     = WS_R;
constexpr size_t WS_M     = WS_Z + al256((size_t)ZROWS * LDZ * 2);
constexpr size_t WS_G     = WS_M + al256((size_t)S_ * POOLW * 2);
constexpr size_t WS_H1    = WS_G + al256((size_t)S_ * NGATE * 4);
constexpr size_t WS_KC    = WS_H1 + al256((size_t)8192 * 256 * 4);
constexpr size_t WS_VC    = WS_KC + al256((size_t)4 * 1024 * 128 * 2);
constexpr size_t WS_L     = WS_VC + al256((size_t)4 * 1024 * 128 * 2);
constexpr size_t WS_OACC  = WS_L + al256((size_t)S_ * NH * 4);
constexpr size_t WS_IMPP  = WS_OACC + al256((size_t)S_ * 3072 * 4);
constexpr size_t WS_IMPF  = WS_IMPP + al256((size_t)S_ * 4 * 256 * 4);
constexpr size_t WS_BM    = WS_IMPF + al256((size_t)S_ * 4 * 256 * 4);
constexpr size_t WS_MIX   = WS_BM + al256((size_t)S_ * 4 * 8 * 4);
constexpr size_t WS_END_A = WS_MIX + al256((size_t)S_ * DM * 2);
constexpr size_t WS_ERAW  = WS_R;
constexpr size_t WS_ACT   = WS_ERAW + al256((size_t)S_ * DM * 2);
constexpr size_t WS_ERSTD = WS_ACT + al256((size_t)S_ * DFF * 2);
constexpr size_t WS_END_B = WS_ERSTD + al256((size_t)S_ * 4);
static_assert(WS_ERAW + (size_t)S_ * DM * 2 <= WS_Z + (size_t)ZROWS * LDZ * 2, "eraw must fit inside the dead z region while mix is still being read");
constexpr size_t WS_NEED  = WS_END_A > WS_END_B ? WS_END_A : WS_END_B;
static_assert(WS_NEED <= (size_t)1440000000, "workspace map exceeds the guaranteed 4 x largest-tensor bytes");

constexpr int LDS_STAGE = 131072;
constexpr int LDS_XCH   = LDS_STAGE + 64;
constexpr int LDS_MISC  = 147456;
constexpr int LDS_BYTES = LDS_MISC + 64;

__device__ __forceinline__ unsigned cvt_pk_bf16(float lo, float hi) { unsigned r; asm volatile("v_cvt_pk_bf16_f32 %0, %1, %2" : "=v"(r) : "v"(lo), "v"(hi)); return r; }
__device__ __forceinline__ float bf_lo(unsigned u) { return __uint_as_float(u << 16); }
__device__ __forceinline__ float bf_hi(unsigned u) { return __uint_as_float(u & 0xffff0000u); }
__device__ __forceinline__ float bf2f(bf16_t b) { return __uint_as_float(((unsigned)b) << 16); }
__device__ __forceinline__ float wave_sum(float v) {
#pragma unroll
    for (int o = 32; o >= 1; o >>= 1) v += __shfl_xor(v, o);
    return v;
}
__device__ __forceinline__ float wave_max(float v) {
#pragma unroll
    for (int o = 32; o >= 1; o >>= 1) v = fmaxf(v, __shfl_xor(v, o));
    return v;
}
__device__ __forceinline__ float sigmoidf_(float x) { return __builtin_amdgcn_rcpf(1.0f + __expf(-x)); }

#define XB_TMO      128
#define XB_XCNT(j)  (256  + 64 * (j))
#define XB_XSUB(j)  (1280 + 64 * (j))
#define XB_XGEN(j)  (2304 + 64 * (j))
#define XB_TOP      3328
#define XB_TOPGEN   3392
#define XCD_BAR_WORDS 3456
#define XB_SPIN_CAP (1u << 18)
__device__ __forceinline__ unsigned xb_ld(unsigned* p)              { return __hip_atomic_load(p, __ATOMIC_RELAXED, __HIP_MEMORY_SCOPE_AGENT); }
__device__ __forceinline__ unsigned xb_add(unsigned* p, unsigned v) { return __hip_atomic_fetch_add(p, v, __ATOMIC_RELAXED, __HIP_MEMORY_SCOPE_AGENT); }
__device__ __forceinline__ unsigned xb_xcc_id() { return (unsigned)__builtin_amdgcn_s_getreg((3 << 11) | 20) & 0xFu; }
#define XB_SPIN(cond, bar) do { unsigned _sp = 0; while (cond) { __builtin_amdgcn_s_sleep(1); \
    if ((++_sp & 255u) == 0u) { if (xb_ld(&(bar)[XB_TMO])) break; if (_sp > XB_SPIN_CAP) { atomicAdd(&(bar)[XB_TMO], 1u); break; } } } } while (0)
struct XcdBarrier { unsigned* bar; unsigned x; volatile LAS unsigned* st; };
__device__ __forceinline__ XcdBarrier xcd_barrier_post(unsigned* bar, volatile LAS unsigned* st) {
    XcdBarrier b; b.bar = bar; b.x = xb_xcc_id(); b.st = st;
    if (threadIdx.x == 0) (void)xb_add(&bar[XB_XCNT(b.x)], 1u);
    return b;
}
__device__ __forceinline__ void xcd_barrier_complete(unsigned* bar, unsigned x, unsigned& nloc, unsigned& nx) {
    const unsigned G = gridDim.x * gridDim.y * gridDim.z;
    unsigned sum, cnt, mine, sp = 0u;
    for (;;) {
        sum = 0u; cnt = 0u; mine = 0u;
#pragma unroll
        for (unsigned j = 0; j < 16; ++j) { const unsigned c = xb_ld(&bar[XB_XCNT(j)]); sum += c; cnt += (c > 0u) ? 1u : 0u; mine = (j == x) ? c : mine; }
        if (sum == G) break;
        __builtin_amdgcn_s_sleep(1);
        if ((++sp & 255u) == 0u) { if (xb_ld(&bar[XB_TMO])) break; if (sp > XB_SPIN_CAP) { atomicAdd(&bar[XB_TMO], 1u); break; } }
    }
    nloc = mine > 0u ? mine : 1u; nx = cnt > 0u ? cnt : 1u;
}
__device__ __forceinline__ void xcd_barrier(const XcdBarrier& b) {
    asm volatile("s_waitcnt vmcnt(0)" ::: "memory");
    __syncthreads();
    if (threadIdx.x == 0) {
        unsigned* bar = b.bar;
        __builtin_amdgcn_s_waitcnt(0);
        unsigned nloc = b.st[0], nx = b.st[1];
        if (nloc == 0u) { xcd_barrier_complete(bar, b.x, nloc, nx); b.st[0] = nloc; b.st[1] = nx; }
        const unsigned old = xb_add(&bar[XB_XSUB(b.x)], 1u);
        const unsigned gen = old / nloc;
        if (old + 1u == (gen + 1u) * nloc) {
            __builtin_amdgcn_fence(__ATOMIC_RELEASE, "agent");
            asm volatile("s_waitcnt vmcnt(0)" ::: "memory");
            const unsigned og = xb_add(&bar[XB_TOP], 1u);
            const unsigned tg = og / nx;
            if (og + 1u == (tg + 1u) * nx) xb_add(&bar[XB_TOPGEN], 1u);
            else XB_SPIN(xb_ld(&bar[XB_TOPGEN]) == tg, bar);
            __builtin_amdgcn_fence(__ATOMIC_ACQUIRE, "agent");
            xb_add(&bar[XB_XGEN(b.x)], 1u);
            asm volatile("s_waitcnt vmcnt(0)" ::: "memory");
        } else {
            XB_SPIN(xb_ld(&bar[XB_XGEN(b.x)]) == gen, bar);
            __builtin_amdgcn_fence(__ATOMIC_ACQUIRE, "agent");
            asm volatile("s_waitcnt vmcnt(0)" ::: "memory");
        }
    }
    __syncthreads();
}

struct Params {
    const float* x; const float* p; const int* positions; const float* norm1_w; const float* w_in; const float* w_pool; const float* pool_scale;
    const float* q_norm_w; const float* k_norm_cmp_w; const float* k_norm_slc_w; const float* k_norm_win_w; const float* cmp_pos_k; const float* cmp_pos_v;
    const float* cmp_k_w1; const float* cmp_k_w2; const float* cmp_v_w1; const float* cmp_v_w2; const float* w_o; const float* norm2_w; const float* w_ffn_in;
    const float* conv_w; const float* conv_b; const float* w_ffn_out; const float* w_ple_proj; const float* ple_norm_w; const float* ple_gate_norm_w; const float* w_ple_gate;
    float* out; unsigned char* ws; int ph_lo, ph_hi;
};

namespace pg8 {
constexpr int BM = 256, BK = 64, HALF = 128, HTB = HALF * BK * 2, STAGE_BYTES = 8 * HTB, NXCD = 8, WGM = 8;
__host__ __device__ __forceinline__ int lds_byte(int r, int c) { const int st = (r >> 4) * 2 + (c >> 5), rr = r & 15, cc = c & 31, ob = rr * 64 + cc * 2; return st * 1024 + (ob ^ (((ob >> 9) & 1) << 5)); }
__host__ __device__ __forceinline__ void stage_rc(int b, int& R, int& C) { const int st = b / 1024, sb = b % 1024, swz = sb ^ (((sb >> 9) & 1) << 5); R = (st >> 1) * 16 + swz / 64; C = (st & 1) * 32 + (swz % 64) / 2; }
__host__ __device__ __forceinline__ int perm32(int rho) { const int n = rho >> 4, i = rho & 15; return 8 * (i >> 2) + 4 * n + (i & 3); }
struct Unit { int pm, pn; };

struct StaticOrder {
    int nM, nN, nwg, G, c;
    __device__ void init(int nM_, int nN_, int G_, int c_) { nM = nM_; nN = nN_; nwg = nM * nN; G = G_; c = c_; }
    __device__ bool next(int i, Unit& u) const {
        const long L = (long)i * G + c; if (L >= nwg) return false;
        int wgid = (int)L; { const int q = nwg / NXCD, r = nwg % NXCD, xcd = wgid % NXCD, off = wgid / NXCD; wgid = (xcd < r ? xcd * (q + 1) : r * (q + 1) + (xcd - r) * q) + off; }
        const int nig = WGM * nN, gid = wgid / nig, fm = gid * WGM, gsz = (nM - fm) < WGM ? (nM - fm) : WGM;
        u.pm = fm + ((wgid % nig) % gsz); u.pn = (wgid % nig) / gsz; return true;
    }
};

struct GStd {
    const char* A; const char* B; unsigned lda, ldb; int nt;
    __device__ __forceinline__ const char* a_base(const Unit& u) const { return A + (size_t)u.pm * 256 * lda * 2; }
    __device__ __forceinline__ const char* b_base(const Unit& u) const { return B + (size_t)u.pn * 256 * ldb * 2; }
    __device__ __forceinline__ size_t kpairA() const { return 256; }
};
struct GPool {
    const char* A; const char* B; unsigned lda, ldb; int nt;
    __device__ __forceinline__ const char* a_base(const Unit& u) const { return A + (size_t)u.pm * 256 * lda * 2 + (size_t)u.pn * 512; }
    __device__ __forceinline__ const char* b_base(const Unit& u) const { return B + (size_t)u.pn * 256 * ldb * 2; }
    __device__ __forceinline__ size_t kpairA() const { return 256; }
};
struct GCmp {
    const char* Z; const char* Bk; const char* Bv; unsigned lda, ldb; int nt;
    __device__ __forceinline__ const char* a_base(const Unit& u) const { const int which = u.pm >> 4, g = (u.pm >> 2) & 3, rt = u.pm & 3;
        return Z + (size_t)(OFF_KV + which * 512 + g * 128) * 2 + (size_t)rt * 256 * lda * 2; }
    __device__ __forceinline__ const char* b_base(const Unit& u) const { return (u.pm >> 4) ? Bv : Bk; }
    __device__ __forceinline__ size_t kpairA() const { return (size_t)LDZ * 2; }
};

struct EpiBf16 {
    static constexpr bool PERM = true;
    bf16_t* O; int ldc;
    __device__ __forceinline__ void operator()(const f32x4 (&acc)[2][2][4][2], const Unit& u, int wr, int wc, int fr, int fq) const {
        const int row0 = u.pm * BM + wr * 64 + fr, col0 = u.pn * BM + wc * 32 + 8 * fq;
#pragma unroll
        for (int ai = 0; ai < 2; ++ai)
#pragma unroll
            for (int m = 0; m < 4; ++m) { bf16_t* rowp = O + (size_t)(row0 + ai * HALF + m * 16) * ldc + col0;
#pragma unroll
                for (int bj = 0; bj < 2; ++bj) { const f32x4 v0 = acc[ai][bj][m][0], v1 = acc[ai][bj][m][1];
                    u32x4 w; w.x = cvt_pk_bf16(v0[0], v0[1]); w.y = cvt_pk_bf16(v0[2], v0[3]); w.z = cvt_pk_bf16(v1[0], v1[1]); w.w = cvt_pk_bf16(v1[2], v1[3]);
                    *(u32x4*)(rowp + bj * HALF) = w; } }
    }
};
struct EpiBf16S {
    static constexpr bool PERM = true;
    bf16_t* O; int ldc; float s;
    __device__ __forceinline__ void operator()(const f32x4 (&acc)[2][2][4][2], const Unit& u, int wr, int wc, int fr, int fq) const {
        const int row0 = u.pm * BM + wr * 64 + fr, col0 = u.pn * BM + wc * 32 + 8 * fq;
#pragma unroll
        for (int ai = 0; ai < 2; ++ai)
#pragma unroll
            for (int m = 0; m < 4; ++m) { bf16_t* rowp = O + (size_t)(row0 + ai * HALF + m * 16) * ldc + col0;
#pragma unroll
                for (int bj = 0; bj < 2; ++bj) { const f32x4 v0 = acc[ai][bj][m][0] * s, v1 = acc[ai][bj][m][1] * s;
                    u32x4 w; w.x = cvt_pk_bf16(v0[0], v0[1]); w.y = cvt_pk_bf16(v0[2], v0[3]); w.z = cvt_pk_bf16(v1[0], v1[1]); w.w = cvt_pk_bf16(v1[2], v1[3]);
                    *(u32x4*)(rowp + bj * HALF) = w; } }
    }
};
struct EpiBf16Ssq {
    static constexpr bool PERM = true;
    bf16_t* O; int ldc; float* ssq;
    __device__ __forceinline__ void operator()(const f32x4 (&acc)[2][2][4][2], const Unit& u, int wr, int wc, int fr, int fq) const {
        const int row0 = u.pm * BM + wr * 64 + fr, col0 = u.pn * BM + wc * 32 + 8 * fq;
#pragma unroll
        for (int ai = 0; ai < 2; ++ai)
#pragma unroll
            for (int m = 0; m < 4; ++m) { const int row = row0 + ai * HALF + m * 16; bf16_t* rowp = O + (size_t)row * ldc + col0; float s = 0.f;
#pragma unroll
                for (int bj = 0; bj < 2; ++bj) { const f32x4 v0 = acc[ai][bj][m][0], v1 = acc[ai][bj][m][1];
                    s += v0[0] * v0[0] + v0[1] * v0[1] + v0[2] * v0[2] + v0[3] * v0[3] + v1[0] * v1[0] + v1[1] * v1[1] + v1[2] * v1[2] + v1[3] * v1[3];
                    u32x4 w; w.x = cvt_pk_bf16(v0[0], v0[1]); w.y = cvt_pk_bf16(v0[2], v0[3]); w.z = cvt_pk_bf16(v1[0], v1[1]); w.w = cvt_pk_bf16(v1[2], v1[3]);
                    *(u32x4*)(rowp + bj * HALF) = w; }
                s += __shfl_xor(s, 16); s += __shfl_xor(s, 32);
                if (fq == 0) unsafeAtomicAdd(ssq + row, s); }
    }
};
struct EpiBf16Scale {
    static constexpr bool PERM = true;
    bf16_t* O; int ldc; const float* colscale;
    __device__ __forceinline__ void operator()(const f32x4 (&acc)[2][2][4][2], const Unit& u, int wr, int wc, int fr, int fq) const {
        const int row0 = u.pm * BM + wr * 64 + fr, col0 = u.pn * BM + wc * 32 + 8 * fq;
#pragma unroll
        for (int bj = 0; bj < 2; ++bj) { const f32x4 s0 = *(const f32x4*)(colscale + col0 + bj * HALF), s1 = *(const f32x4*)(colscale + col0 + bj * HALF + 4);
#pragma unroll
            for (int ai = 0; ai < 2; ++ai)
#pragma unroll
                for (int m = 0; m < 4; ++m) { bf16_t* rowp = O + (size_t)(row0 + ai * HALF + m * 16) * ldc + col0;
                    const f32x4 v0 = acc[ai][bj][m][0] * s0, v1 = acc[ai][bj][m][1] * s1;
                    u32x4 w; w.x = cvt_pk_bf16(v0[0], v0[1]); w.y = cvt_pk_bf16(v0[2], v0[3]); w.z = cvt_pk_bf16(v1[0], v1[1]); w.w = cvt_pk_bf16(v1[2], v1[3]);
                    *(u32x4*)(rowp + bj * HALF) = w; } }
    }
};
struct EpiResF32 {
    static constexpr bool PERM = false;
    const float* base; float* C; int ldc; int row_off;
    __device__ __forceinline__ void operator()(const f32x4 (&acc)[2][2][4][2], const Unit& u, int wr, int wc, int fr, int fq) const {
        const int row0 = u.pm * BM + wr * 64 + fr + row_off, col0 = u.pn * BM + wc * 32 + 4 * fq;
#pragma unroll
        for (int ai = 0; ai < 2; ++ai)
#pragma unroll
            for (int m = 0; m < 4; ++m) { const size_t off = (size_t)(row0 + ai * HALF + m * 16) * ldc + col0;
#pragma unroll
                for (int bj = 0; bj < 2; ++bj)
#pragma unroll
                    for (int n = 0; n < 2; ++n) { const f32x4 b = *(const f32x4*)(base + off + bj * HALF + n * 16); *(f32x4*)(C + off + bj * HALF + n * 16) = b + acc[ai][bj][m][n]; }
                asm volatile("" ::: "memory"); }
    }
};
template <bool FP8OUT>
struct EpiResNormT {
    static constexpr bool PERM = false;
    const float* base; float* C; bf16_t* XN; const float* nw; float* ssq; int ldc;
    __device__ __forceinline__ void operator()(const f32x4 (&acc)[2][2][4][2], const Unit& u, int wr, int wc, int fr, int fq) const {
        const int row0 = u.pm * BM + wr * 64 + fr, col0 = u.pn * BM + wc * 32 + 4 * fq;
        f32x4 wv[2][2];
#pragma unroll
        for (int bj = 0; bj < 2; ++bj)
#pragma unroll
            for (int n = 0; n < 2; ++n) wv[bj][n] = *(const f32x4*)(nw + col0 + bj * HALF + n * 16);
        f32x4 bv[2][2][2];
#pragma unroll
        for (int bj = 0; bj < 2; ++bj)
#pragma unroll
            for (int n = 0; n < 2; ++n) bv[0][bj][n] = *(const f32x4*)(base + (size_t)row0 * ldc + col0 + bj * HALF + n * 16);
#pragma unroll
        for (int rg = 0; rg < 8; ++rg) { const int ai = rg >> 2, m = rg & 3; const int row = row0 + ai * HALF + m * 16; const size_t off = (size_t)row * ldc + col0;
            if (rg < 7) { const int ai2 = (rg + 1) >> 2, m2 = (rg + 1) & 3; const size_t off2 = (size_t)(row0 + ai2 * HALF + m2 * 16) * ldc + col0;
#pragma unroll
                for (int bj = 0; bj < 2; ++bj)
#pragma unroll
                    for (int n = 0; n < 2; ++n) bv[(rg + 1) & 1][bj][n] = *(const f32x4*)(base + off2 + bj * HALF + n * 16); }
            float s = 0.f;
#pragma unroll
            for (int bj = 0; bj < 2; ++bj)
#pragma unroll
                for (int n = 0; n < 2; ++n) { const f32x4 v = bv[rg & 1][bj][n] + acc[ai][bj][m][n];
                    *(f32x4*)(C + off + bj * HALF + n * 16) = v; s += v[0] * v[0] + v[1] * v[1] + v[2] * v[2] + v[3] * v[3];
                    if (FP8OUT) { int pk = __builtin_amdgcn_cvt_pk_fp8_f32(v[0] * wv[bj][n][0], v[1] * wv[bj][n][1], 0, false); pk = __builtin_amdgcn_cvt_pk_fp8_f32(v[2] * wv[bj][n][2], v[3] * wv[bj][n][3], pk, true);
                        *(int*)((unsigned char*)XN + off + bj * HALF + n * 16) = pk; }
                    else { u32x2 o; o.x = cvt_pk_bf16(v[0] * wv[bj][n][0], v[1] * wv[bj][n][1]); o.y = cvt_pk_bf16(v[2] * wv[bj][n][2], v[3] * wv[bj][n][3]);
                        *(u32x2*)(XN + off + bj * HALF + n * 16) = o; } }
            s += __shfl_xor(s, 16); s += __shfl_xor(s, 32);
            if (fq == 0) unsafeAtomicAdd(ssq + row, s);
        }
    }
};
typedef EpiResNormT<false> EpiResNorm;
typedef EpiResNormT<true> EpiResNormF8;
struct EpiCmpGelu {
    static constexpr bool PERM = false;
    float* H; const float* bias;
    __device__ __forceinline__ void operator()(const f32x4 (&acc)[2][2][4][2], const Unit& u, int wr, int wc, int fr, int fq) const {
        const int row0 = u.pm * BM + wr * 64 + fr, col0 = wc * 32 + 4 * fq; const float* bs = bias + (u.pm >> 4) * 256;
        f32x4 bvv[2][2];
#pragma unroll
        for (int bj = 0; bj < 2; ++bj)
#pragma unroll
            for (int n = 0; n < 2; ++n) bvv[bj][n] = *(const f32x4*)(bs + col0 + bj * HALF + n * 16);
#pragma unroll
        for (int ai = 0; ai < 2; ++ai)
#pragma unroll
            for (int m = 0; m < 4; ++m) { float* rowp = H + (size_t)(row0 + ai * HALF + m * 16) * 256 + col0;
#pragma unroll
                for (int bj = 0; bj < 2; ++bj)
#pragma unroll
                    for (int n = 0; n < 2; ++n) { f32x4 v = acc[ai][bj][m][n] + bvv[bj][n];
#pragma unroll
                        for (int j = 0; j < 4; ++j) { const float xx = v[j], uu = 0.7978845608028654f * (xx + 0.044715f * xx * xx * xx); const float th = 1.0f - 2.0f / (1.0f + __expf(2.0f * uu)); v[j] = 0.5f * xx * (1.0f + th); }
                        *(f32x4*)(rowp + bj * HALF + n * 16) = v; } }
    }
};
struct EpiGate {
    static constexpr bool PERM = false;
    float* C; const bf16_t* eraw; const float* erstd; const float* pw; const float* ssq; int ldc; float ascale;
    __device__ __forceinline__ void operator()(const f32x4 (&acc)[2][2][4][2], const Unit& u, int wr, int wc, int fr, int fq) const {
        const int row0 = u.pm * BM + wr * 64 + fr, col0 = u.pn * BM + wc * 32 + 4 * fq;
        f32x4 wv[2][2];
#pragma unroll
        for (int bj = 0; bj < 2; ++bj)
#pragma unroll
            for (int n = 0; n < 2; ++n) wv[bj][n] = *(const f32x4*)(pw + col0 + bj * HALF + n * 16);
        f32x4 bv[2][2][2]; u32x2 ev[2][2][2]; float rsv[2], rgv[2];
#pragma unroll
        for (int bj = 0; bj < 2; ++bj)
#pragma unroll
            for (int n = 0; n < 2; ++n) { bv[0][bj][n] = *(const f32x4*)(C + (size_t)row0 * ldc + col0 + bj * HALF + n * 16); ev[0][bj][n] = *(const u32x2*)(eraw + (size_t)row0 * ldc + col0 + bj * HALF + n * 16); }
        rsv[0] = erstd[row0]; rgv[0] = ssq[row0];
#pragma unroll
        for (int rg = 0; rg < 8; ++rg) { const int ai = rg >> 2, m = rg & 3; const int row = row0 + ai * HALF + m * 16; const size_t off = (size_t)row * ldc + col0;
            if (rg < 7) { const int ai2 = (rg + 1) >> 2, m2 = (rg + 1) & 3; const int row2 = row0 + ai2 * HALF + m2 * 16; const size_t off2 = (size_t)row2 * ldc + col0;
#pragma unroll
                for (int bj = 0; bj < 2; ++bj)
#pragma unroll
                    for (int n = 0; n < 2; ++n) { bv[(rg + 1) & 1][bj][n] = *(const f32x4*)(C + off2 + bj * HALF + n * 16); ev[(rg + 1) & 1][bj][n] = *(const u32x2*)(eraw + off2 + bj * HALF + n * 16); }
                rsv[(rg + 1) & 1] = erstd[row2]; rgv[(rg + 1) & 1] = ssq[row2]; }
            const float rs = rsqrtf(rsv[rg & 1] * (1.0f / DM) + EPS), rg_ = rsqrtf(rgv[rg & 1] * (1.0f / DM) + EPS) * ascale;
#pragma unroll
            for (int bj = 0; bj < 2; ++bj)
#pragma unroll
                for (int n = 0; n < 2; ++n) { const f32x4 b = bv[rg & 1][bj][n]; const u32x2 e = ev[rg & 1][bj][n]; const f32x4 a = acc[ai][bj][m][n]; f32x4 o;
                    o[0] = b[0] + bf_lo(e.x) * rs * wv[bj][n][0] * sigmoidf_(a[0] * rg_); o[1] = b[1] + bf_hi(e.x) * rs * wv[bj][n][1] * sigmoidf_(a[1] * rg_);
                    o[2] = b[2] + bf_lo(e.y) * rs * wv[bj][n][2] * sigmoidf_(a[2] * rg_); o[3] = b[3] + bf_hi(e.y) * rs * wv[bj][n][3] * sigmoidf_(a[3] * rg_);
                    *(f32x4*)(C + off + bj * HALF + n * 16) = o; }
        }
    }
};
struct GFfn {
    const char* A; const char* B; unsigned lda, ldb; int nt;
    __device__ __forceinline__ const char* a_base(const Unit& u) const { return A + ((long)u.pm * 254 - 2) * (long)lda * 2; }
    __device__ __forceinline__ const char* b_base(const Unit& u) const { return B + (size_t)u.pn * 256 * ldb * 2; }
    __device__ __forceinline__ size_t kpairA() const { return 256; }
};
template <int CTRL> __device__ __forceinline__ float dpp_f(float v) { return __int_as_float(__builtin_amdgcn_update_dpp(0, __float_as_int(v), CTRL, 0xf, 0xf, false)); }
struct EpiFfn {
    static constexpr bool PERM = true;
    bf16_t* ACT; const float* cw; const float* cb; LAS float* X; const float* ssq;
    __device__ __forceinline__ void operator()(const f32x4 (&acc)[2][2][4][2], const Unit& u, int wr, int wc, int fr, int fq) const {
        const int colw = wc * 32 + 8 * fq;
        const int f0 = u.pn * 128 + colw;
        f32x4 w0[2], w1[2], w2[2], cbv[2];
#pragma unroll
        for (int n = 0; n < 2; ++n) { w0[n] = *(const f32x4*)(cw + f0 + 4 * n); w1[n] = *(const f32x4*)(cw + DFF + f0 + 4 * n); w2[n] = *(const f32x4*)(cw + 2 * DFF + f0 + 4 * n); cbv[n] = *(const f32x4*)(cb + f0 + 4 * n); }
        float rsv[2][4];
#pragma unroll
        for (int ai = 0; ai < 2; ++ai)
#pragma unroll
            for (int m = 0; m < 4; ++m) { const long t = (long)u.pm * 254 - 2 + ai * HALF + wr * 64 + m * 16 + fr; rsv[ai][m] = ssq[t < 0 ? 0 : (t >= S_ ? S_ - 1 : t)]; }
#pragma unroll
        for (int ai = 0; ai < 2; ++ai)
#pragma unroll
            for (int m = 0; m < 4; ++m) { const long t = (long)u.pm * 254 - 2 + ai * HALF + wr * 64 + m * 16 + fr; rsv[ai][m] = (t >= 0 && t < S_) ? rsqrtf(rsv[ai][m] * (1.0f / DM) + EPS) : 0.f; }
        if (fr >= 14) {
#pragma unroll
            for (int ai = 0; ai < 2; ++ai)
#pragma unroll
                for (int n = 0; n < 2; ++n) *(LAS f32x4*)(X + ((2 * ai + wr) * 2 + (fr - 14)) * 128 + colw + 4 * n) = acc[ai][0][3][n] * rsv[ai][3];
        }
        asm volatile("s_waitcnt lgkmcnt(0)" ::: "memory");
        __builtin_amdgcn_s_barrier(); asm volatile("" ::: "memory");
        __builtin_amdgcn_s_barrier(); asm volatile("" ::: "memory");
        const bool sel1 = fr == 15, sel2 = fr >= 14;
#pragma unroll
        for (int ai = 0; ai < 2; ++ai) {
            f32x4 pv[2];
            const int pseg = 2 * ai + wr - 1;
#pragma unroll
            for (int n = 0; n < 2; ++n) { pv[n] = (f32x4){0.f, 0.f, 0.f, 0.f}; if (pseg >= 0 && fr >= 14) pv[n] = *(const LAS f32x4*)(X + (pseg * 2 + (fr - 14)) * 128 + colw + 4 * n); }
#pragma unroll
            for (int m = 0; m < 4; ++m) {
                const int r = ai * HALF + wr * 64 + m * 16 + fr; const long t = (long)u.pm * 254 - 2 + r;
                unsigned ow[4];
#pragma unroll
                for (int n = 0; n < 2; ++n) {
                    const f32x4 cur = acc[ai][0][m][n] * rsv[ai][m], up = acc[ai][1][m][n] * rsv[ai][m];
                    f32x4 x1, x2;
#pragma unroll
                    for (int i = 0; i < 4; ++i) { x1[i] = dpp_f<0x121>(sel1 ? pv[n][i] : cur[i]); x2[i] = dpp_f<0x122>(sel2 ? pv[n][i] : cur[i]); }
                    const f32x4 y = cbv[n] + w0[n] * x2 + w1[n] * x1 + w2[n] * cur;
                    f32x4 sg;
#pragma unroll
                    for (int i = 0; i < 4; ++i) sg[i] = sigmoidf_(y[i]);
                    const f32x4 o = y * sg * up;
                    ow[2 * n] = cvt_pk_bf16(o[0], o[1]); ow[2 * n + 1] = cvt_pk_bf16(o[2], o[3]);
                    pv[n] = cur;
                }
                if (r >= 2 && t < S_) *(u32x4*)(ACT + (size_t)t * DFF + f0) = (u32x4){ow[0], ow[1], ow[2], ow[3]};
            }
        }
    }
};

template <class GD, class Epi, bool F8 = false>
__device__ __forceinline__ void gemm_phase(LAS unsigned char* lds, const GD g, const StaticOrder& S, const Epi& E) {
    const int tid = threadIdx.x, wid = __builtin_amdgcn_readfirstlane(tid >> 6), lane = tid & 63, wr = wid >> 2, wc = wid & 3, fr = lane & 15, fq = lane >> 4;
    const int nt = g.nt;
    unsigned voffA[2], voffB[2];
#pragma unroll
    for (int i = 0; i < 2; ++i) { int R, C; stage_rc(tid * 16 + i * 8192, R, C); const int Rb = Epi::PERM ? ((R & ~31) + perm32(R & 31)) : R;
        voffA[i] = (unsigned)(R * g.lda + C) * 2u; voffB[i] = (unsigned)(Rb * g.ldb + C) * 2u; }
    const size_t kpA = g.kpairA();
    const size_t hstepA = (size_t)HALF * g.lda * 2, hstepB = (size_t)HALF * g.ldb * 2;
    const unsigned ldsw = (unsigned)wid * 1024u;
    const int aoff = lds_byte(wr * 64 + fr, fq * 8), boff = lds_byte(wc * 32 + fr, fq * 8);
#define PG8_SA(b, h) (((b) * 2 + (h)) * HTB)
#define PG8_SB(b, h) ((4 + (b) * 2 + (h)) * HTB)
#define PG8_STAGE(bufoff, gbase, voff) do { _Pragma("unroll") for (int _i = 0; _i < 2; ++_i) \
        __builtin_amdgcn_global_load_lds((const unsigned*)((const char*)(gbase) + (voff)[_i]), (LAS unsigned*)(lds + (bufoff) + ldsw + _i * 8192), 16, 0, 0); } while (0)
#define PG8_LDA(dst, b, h) do { if constexpr (F8) { _Pragma("unroll") for (int m = 0; m < 4; ++m) { const i32x4 lo_ = *(const LAS i32x4*)(lds + PG8_SA(b, h) + aoff + m * 2048), hi_ = *(const LAS i32x4*)(lds + PG8_SA(b, h) + aoff + m * 2048 + 1024); \
            dst##8[m] = __builtin_shufflevector(lo_, hi_, 0, 1, 2, 3, 4, 5, 6, 7); } } \
        else { _Pragma("unroll") for (int m = 0; m < 4; ++m) _Pragma("unroll") for (int k = 0; k < 2; ++k) dst[m][k] = *(const LAS bf16x8*)(lds + PG8_SA(b, h) + aoff + m * 2048 + k * 1024); } } while (0)
#define PG8_LDB(dst, b, h) do { if constexpr (F8) { _Pragma("unroll") for (int n = 0; n < 2; ++n) { const i32x4 lo_ = *(const LAS i32x4*)(lds + PG8_SB(b, h) + boff + n * 2048), hi_ = *(const LAS i32x4*)(lds + PG8_SB(b, h) + boff + n * 2048 + 1024); \
            dst##8[n] = __builtin_shufflevector(lo_, hi_, 0, 1, 2, 3, 4, 5, 6, 7); } } \
        else { _Pragma("unroll") for (int n = 0; n < 2; ++n) _Pragma("unroll") for (int k = 0; k < 2; ++k) dst[n][k] = *(const LAS bf16x8*)(lds + PG8_SB(b, h) + boff + n * 2048 + k * 1024); } } while (0)
#define PG8_MMA(ai, bj, At, Bt) do { __builtin_amdgcn_s_setprio(1); \
        if constexpr (F8) { _Pragma("unroll") for (int m = 0; m < 4; ++m) _Pragma("unroll") for (int n = 0; n < 2; ++n) \
            asm volatile("v_mfma_scale_f32_16x16x128_f8f6f4 %0, %1, %2, %0, %3, %3 op_sel_hi:[0,0,0]" : "+v"(acc[ai][bj][m][n]) : "v"(Bt##8[n]), "v"(At##8[m]), "v"(one_scale)); } \
        else { _Pragma("unroll") for (int m = 0; m < 4; ++m) _Pragma("unroll") for (int n = 0; n < 2; ++n) _Pragma("unroll") for (int k = 0; k < 2; ++k) \
            acc[ai][bj][m][n] = __builtin_amdgcn_mfma_f32_16x16x32_bf16(Bt[n][k], At[m][k], acc[ai][bj][m][n], 0, 0, 0); } \
        __builtin_amdgcn_s_setprio(0); } while (0)
#define PG8_WAIT_V(n) asm volatile("s_waitcnt vmcnt(" #n ")" ::: "memory")
#define PG8_WAIT_L(n) asm volatile("s_waitcnt lgkmcnt(" #n ")" ::: "memory")
#define PG8_BAR __builtin_amdgcn_s_barrier()
#define PG8_SCHED __builtin_amdgcn_sched_barrier(0)
    Unit cur, nxt; int ui = 0;
    if (!S.next(0, cur)) return;
    f32x4 acc[2][2][4][2];
#pragma unroll
    for (int a = 0; a < 2; ++a)
#pragma unroll
        for (int b = 0; b < 2; ++b)
#pragma unroll
            for (int m = 0; m < 4; ++m)
#pragma unroll
                for (int n = 0; n < 2; ++n) acc[a][b][m][n] = (f32x4){0.f, 0.f, 0.f, 0.f};
    bf16x8 At[4][2], B0[2][2], B1[2][2];
    i32x8 At8[4], B08[2], B18[2];
    (void)At; (void)B0; (void)B1; (void)At8; (void)B08; (void)B18;
    int one_scale = 0x7F7F7F7F; (void)one_scale;
    const char* cA = g.a_base(cur); const char* cB = g.b_base(cur);
    PG8_STAGE(PG8_SB(0, 0), cB, voffB); PG8_STAGE(PG8_SA(0, 0), cA, voffA); PG8_STAGE(PG8_SB(0, 1), cB + hstepB, voffB); PG8_STAGE(PG8_SA(0, 1), cA + hstepA, voffA);
    if (wr == 1) PG8_BAR;
    PG8_WAIT_V(4); PG8_BAR;
    PG8_STAGE(PG8_SB(1, 0), cB + 128, voffB); PG8_STAGE(PG8_SA(1, 0), cA + 128, voffA); PG8_STAGE(PG8_SB(1, 1), cB + hstepB + 128, voffB);
    PG8_WAIT_V(6); PG8_BAR;
    for (;;) {
        const bool has_next = S.next(ui + 1, nxt);
        const char* nA = has_next ? g.a_base(nxt) : cA; const char* nB = has_next ? g.b_base(nxt) : cB;
        for (int t = 0; t < nt; t += 2) {
            const bool last = (t == nt - 2);
            const char* a0 = cA + (size_t)(t >> 1) * kpA;
            const char* a1 = a0 + 128;
            const char* a2 = last ? nA : a0 + kpA; const char* b2 = last ? nB : cB + (size_t)(t + 2) * 128;
            const char* a3 = a2 + 128; const char* b3 = b2 + 128;
            PG8_LDB(B0, 0, 0); PG8_SCHED; PG8_LDA(At, 0, 0); PG8_STAGE(PG8_SA(1, 1), a1 + hstepA, voffA);
            PG8_WAIT_L(8); PG8_BAR; PG8_WAIT_L(0); PG8_MMA(0, 0, At, B0); PG8_BAR; PG8_SCHED;
            PG8_LDB(B1, 0, 1); PG8_STAGE(PG8_SB(0, 0), b2, voffB);
            PG8_BAR; PG8_WAIT_L(0); PG8_MMA(0, 1, At, B1); PG8_BAR;
            PG8_LDA(At, 0, 1); PG8_STAGE(PG8_SA(0, 0), a2, voffA);
            PG8_BAR; PG8_WAIT_L(0); PG8_MMA(1, 0, At, B0); PG8_BAR; PG8_SCHED;
            PG8_STAGE(PG8_SB(0, 1), b2 + hstepB, voffB);
            PG8_WAIT_V(6); PG8_BAR; PG8_MMA(1, 1, At, B1); PG8_BAR;
            PG8_LDB(B0, 1, 0); PG8_SCHED; PG8_LDA(At, 1, 0); PG8_STAGE(PG8_SA(0, 1), a2 + hstepA, voffA);
            PG8_WAIT_L(8); PG8_BAR; PG8_WAIT_L(0); PG8_MMA(0, 0, At, B0); PG8_BAR; PG8_SCHED;
            PG8_LDB(B1, 1, 1); PG8_STAGE(PG8_SB(1, 0), b3, voffB);
            PG8_BAR; PG8_WAIT_L(0); PG8_MMA(0, 1, At, B1); PG8_BAR;
            PG8_LDA(At, 1, 1); PG8_STAGE(PG8_SA(1, 0), a3, voffA);
            PG8_BAR; PG8_WAIT_L(0); PG8_MMA(1, 0, At, B0); PG8_BAR; PG8_SCHED;
            PG8_STAGE(PG8_SB(1, 1), b3 + hstepB, voffB);
            PG8_WAIT_V(6); PG8_BAR; PG8_MMA(1, 1, At, B1); PG8_BAR;
        }
        if constexpr (F8) asm volatile("s_nop 15\n\ts_nop 15\n\ts_nop 15" ::: "memory");
        E(acc, cur, wr, wc, fr, fq);
        if (!has_next) break;
#pragma unroll
        for (int a = 0; a < 2; ++a)
#pragma unroll
            for (int b = 0; b < 2; ++b)
#pragma unroll
                for (int m = 0; m < 4; ++m)
#pragma unroll
                    for (int n = 0; n < 2; ++n) acc[a][b][m][n] = (f32x4){0.f, 0.f, 0.f, 0.f};
        cur = nxt; cA = nA; cB = nB; ++ui;
    }
    PG8_WAIT_V(0);
    if (wr == 0) PG8_BAR;
    PG8_BAR;
#undef PG8_SA
#undef PG8_SB
#undef PG8_STAGE
#undef PG8_LDA
#undef PG8_LDB
#undef PG8_MMA
#undef PG8_WAIT_V
#undef PG8_WAIT_L
#undef PG8_BAR
#undef PG8_SCHED
}
}

namespace att {
constexpr int KVBLK = 64;
constexpr int SHM_V = KVBLK * HD * 2, SHM_K = KVBLK * HD * 2, SHM_ATTN = 2 * SHM_V + 2 * SHM_K + NWAVES * 64 * 4;
#define KSWZ(row, colB) ((row) * 256 + ((colB) ^ (((row) & 7) << 4)))
#define SBAR() __builtin_amdgcn_sched_barrier(0)
__device__ __forceinline__ int crow(int r, int hi) { return (r & 3) + 8 * (r >> 2) + 4 * hi; }
__device__ __forceinline__ void qkt(f32x16& p0, f32x16& p1, const char* Ks, const bf16x8* qr, int r32, int hi) {
    p0 = f32x16{}; p1 = f32x16{};
    bf16x8 ka[2], kb[2];
    { const int cb = (hi * 8) * 2; ka[0] = *reinterpret_cast<const bf16x8*>(Ks + KSWZ(r32, cb)); kb[0] = *reinterpret_cast<const bf16x8*>(Ks + KSWZ(32 + r32, cb)); }
#pragma unroll
    for (int d0 = 0; d0 < 8; ++d0) {
        if (d0 < 7) { const int cb = ((d0 + 1) * 16 + hi * 8) * 2;
            ka[(d0 + 1) & 1] = *reinterpret_cast<const bf16x8*>(Ks + KSWZ(r32, cb)); kb[(d0 + 1) & 1] = *reinterpret_cast<const bf16x8*>(Ks + KSWZ(32 + r32, cb)); }
        SBAR();
        p0 = __builtin_amdgcn_mfma_f32_32x32x16_bf16(ka[d0 & 1], qr[d0], p0, 0, 0, 0);
        p1 = __builtin_amdgcn_mfma_f32_32x32x16_bf16(kb[d0 & 1], qr[d0], p1, 0, 0, 0);
        SBAR();
    }
}
__device__ __forceinline__ int v_st(int k, int c) { const int kk = (k & ~0xC) | ((k & 4) << 1) | ((k & 8) >> 1); return ((kk >> 3) * 4 + (c >> 5)) * 512 + ((kk & 7) * 32 + (c & 31)) * 2; }
__device__ __forceinline__ int v_rd_base(int lane) { return ((lane & 3) << 3) | (((lane >> 2) & 3) << 6) | (((lane >> 4) & 1) << 5) | (((lane >> 5) & 1) << 8); }
constexpr int v_rd_off(int d0, int ks, int half) { return d0 * 512 + ks * 4096 + half * 2048; }
__device__ __forceinline__ s16x4 tr_read(int vb, int off) { return __builtin_amdgcn_ds_read_tr16_b64_v4i16((LAS s16x4*)(unsigned long)(unsigned)(vb + off)); }
__device__ __forceinline__ void pv_d0(f32x16* o, int vb, bf16x8 pa0, bf16x8 pa1, bf16x8 pa2, bf16x8 pa3) {
    s16x4 L[2][4], H[2][4];
#pragma unroll
    for (int d0 = 0; d0 < 4; ++d0) { L[0][d0] = tr_read(vb, v_rd_off(d0, 0, 0)); H[0][d0] = tr_read(vb, v_rd_off(d0, 0, 1)); }
#pragma unroll
    for (int ks = 0; ks < 4; ++ks) {
        if (ks < 3) {
#pragma unroll
            for (int d0 = 0; d0 < 4; ++d0) { L[(ks + 1) & 1][d0] = tr_read(vb, v_rd_off(d0, ks + 1, 0)); H[(ks + 1) & 1][d0] = tr_read(vb, v_rd_off(d0, ks + 1, 1)); }
        }
        const bf16x8 pa = ks == 0 ? pa0 : (ks == 1 ? pa1 : (ks == 2 ? pa2 : pa3));
#pragma unroll
        for (int d0 = 0; d0 < 4; ++d0) { const s16x4 l = L[ks & 1][d0], h = H[ks & 1][d0];
            o[d0] = __builtin_amdgcn_mfma_f32_32x32x16_bf16(pa, (bf16x8){l[0], l[1], l[2], l[3], h[0], h[1], h[2], h[3]}, o[d0], 0, 0, 0); }
    }
}
__device__ __forceinline__ void pack_p(const f32x16& p0, const f32x16& p1, bf16x8& pa0, bf16x8& pa1, bf16x8& pa2, bf16x8& pa3) {
#define PK4(P, BASE, OUT) do { unsigned a0 = cvt_pk_bf16(P[BASE + 0], P[BASE + 1]), a1 = cvt_pk_bf16(P[BASE + 2], P[BASE + 3]);   \
    unsigned b0 = cvt_pk_bf16(P[BASE + 4], P[BASE + 5]), b1 = cvt_pk_bf16(P[BASE + 6], P[BASE + 7]);                              \
    auto r0 = __builtin_amdgcn_permlane32_swap(a0, b0, false, false); auto r1 = __builtin_amdgcn_permlane32_swap(a1, b1, false, false); \
    u32x4 w = {r0[0], r1[0], r0[1], r1[1]}; OUT = *reinterpret_cast<bf16x8*>(&w); } while (0)
    PK4(p0, 0, pa0); PK4(p0, 8, pa1); PK4(p1, 0, pa2); PK4(p1, 8, pa3);
#undef PK4
}

__device__ __forceinline__ void pack_half(const f32x16& p, bf16x8& paA, bf16x8& paB) {
#define PK4(P, BASE, OUT) do { unsigned a0 = cvt_pk_bf16(P[BASE + 0], P[BASE + 1]), a1 = cvt_pk_bf16(P[BASE + 2], P[BASE + 3]);   \
    unsigned b0 = cvt_pk_bf16(P[BASE + 4], P[BASE + 5]), b1 = cvt_pk_bf16(P[BASE + 6], P[BASE + 7]);                              \
    auto r0 = __builtin_amdgcn_permlane32_swap(a0, b0, false, false); auto r1 = __builtin_amdgcn_permlane32_swap(a1, b1, false, false); \
    u32x4 w = {r0[0], r1[0], r0[1], r1[1]}; OUT = *reinterpret_cast<bf16x8*>(&w); } while (0)
    PK4(p, 0, paA); PK4(p, 8, paB);
#undef PK4
}
template <int KS0, bool WITH_EXP>
__device__ __forceinline__ void pv_half(f32x16* o, int vb, bf16x8 paA, bf16x8 paB, f32x16& px, float off) {
    s16x4 L[2][4], H[2][4];
#pragma unroll
    for (int d0 = 0; d0 < 4; ++d0) { L[0][d0] = tr_read(vb, v_rd_off(d0, KS0, 0)); H[0][d0] = tr_read(vb, v_rd_off(d0, KS0, 1)); }
#pragma unroll
    for (int d0 = 0; d0 < 4; ++d0) { L[1][d0] = tr_read(vb, v_rd_off(d0, KS0 + 1, 0)); H[1][d0] = tr_read(vb, v_rd_off(d0, KS0 + 1, 1)); }
#pragma unroll
    for (int kk = 0; kk < 2; ++kk) {
        const bf16x8 pa = kk == 0 ? paA : paB;
#pragma unroll
        for (int d0 = 0; d0 < 4; ++d0) { const s16x4 l = L[kk][d0], h = H[kk][d0];
            if (WITH_EXP) SBAR();
            o[d0] = __builtin_amdgcn_mfma_f32_32x32x16_bf16(pa, (bf16x8){l[0], l[1], l[2], l[3], h[0], h[1], h[2], h[3]}, o[d0], 0, 0, 0);
            if (WITH_EXP) {
#pragma unroll
                for (int q = 0; q < 2; ++q) { const int r = (kk * 4 + d0) * 2 + q; px[r] = __builtin_amdgcn_exp2f(fmaf(px[r], SM_C, off)); }
                SBAR(); }
        }
    }
}
enum { MODE_CMP = 0, MODE_WIN = 1, MODE_SLC = 2 };
struct AttnArgs {
    const bf16_t* Z; const bf16_t* KC; const bf16_t* VC; const float* G; float* L; float* OACC; bf16_t* MIX; const unsigned* BM; const float* TAB;
};
template <int MODE>
__device__ __forceinline__ void attn_unit(const AttnArgs& a, LAS char* ldsL, int qt, int g, int hp) {
    char* lds = (char*)ldsL;
    const int tid = threadIdx.x, wid = __builtin_amdgcn_readfirstlane(tid >> 6), lane = tid & 63, r32 = lane & 31, hi = lane >> 5;
    float* li_l = (float*)(lds + LDS_XCH) + wid * 64;
    const int t0 = MODE == MODE_SLC ? qt * 40 : qt * 128;
    const int tq_raw = MODE == MODE_SLC ? t0 + wid * 5 + r32 / 6 : t0 + wid * 16 + (r32 & 15);
    const bool rvalid = MODE == MODE_SLC ? (r32 < 30 && tq_raw < S_) : true;
    const int tq = tq_raw < S_ ? tq_raw : S_ - 1;
    const int hq = MODE == MODE_SLC ? g * HPG + r32 % 6 : g * HPG + hp * 2 + (r32 >> 4);
    const int tlast = MODE == MODE_SLC ? ((t0 + 39) < S_ ? (t0 + 39) : S_ - 1) : t0 + 127;
    const bf16_t* Kb; const bf16_t* Vb; long ldk;
    if (MODE == MODE_CMP) { Kb = a.KC + (size_t)g * 1024 * HD; Vb = a.VC + (size_t)g * 1024 * HD; ldk = HD; }
    else if (MODE == MODE_WIN) { Kb = a.Z + OFF_KV + 4 * 512 + g * HD; Vb = a.Z + OFF_KV + 5 * 512 + g * HD; ldk = LDZ; }
    else { Kb = a.Z + OFF_KV + 2 * 512 + g * HD; Vb = a.Z + OFF_KV + 3 * 512 + g * HD; ldk = LDZ; }
    int j0, j1;
    if (MODE == MODE_CMP) { j0 = 0; j1 = (((t0 + 127 - 31) >> 4) >> 6) + 1; }
    else if (MODE == MODE_WIN) { j0 = (t0 - 511) > 0 ? ((t0 - 511) >> 6) : 0; j1 = ((t0 + 127) >> 6) + 1; }
    else { j0 = 0; j1 = (tlast >> 6) + 1; }
    int klo, khi;
    if (MODE == MODE_CMP) { klo = 0; khi = tq >= 31 ? ((tq - 31) >> 4) : -1; }
    else if (MODE == MODE_WIN) { klo = tq - 511; khi = tq; }
    else { klo = 0; khi = rvalid ? tq : -1; }
    float negBC = -a.TAB[512 + (MODE == MODE_CMP ? 0 : (MODE == MODE_SLC ? 1 : 2))];
    bf16x8 qr[8];
    { const bf16_t* Qw = a.Z + (size_t)tq * LDZ + OFF_Q + hq * HD + hi * 8;
#pragma unroll
      for (int d0 = 0; d0 < 8; ++d0) qr[d0] = *reinterpret_cast<const bf16x8*>(Qw + d0 * 16); }
    f32x16 o[4] = {}; float lsum = 0.f;
    unsigned soK[2], soV[2];
#pragma unroll
    for (int i = 0; i < 2; ++i) { const int p = (wid + 8 * i) * 64 + lane;
        { const int row = p >> 4, c = (p & 15) ^ (row & 7); soK[i] = (unsigned)(row * ldk + c * 8) * 2u; }
        { const int sub = p >> 5, within = p & 31, kk = (sub >> 2) * 8 + (within >> 2), c = (sub & 3) * 32 + (within & 3) * 8, k = (kk & ~0xC) | ((kk & 4) << 1) | ((kk & 8) >> 1);
          soV[i] = (unsigned)(k * ldk + c) * 2u; } }
    const int vb0 = (int)(uintptr_t)(LAS char*)ldsL + 16384 + v_rd_base(lane);
#define ISSUE(jt) do { const int _b = ((jt) - j0) & 3; const char* _kp = (const char*)Kb + (size_t)(jt) * KVBLK * ldk * 2; const char* _vp = (const char*)Vb + (size_t)(jt) * KVBLK * ldk * 2; \
    _Pragma("unroll") for (int _i = 0; _i < 2; ++_i) { \
        __builtin_amdgcn_global_load_lds((const unsigned*)(_kp + soK[_i]), (LAS unsigned*)(ldsL + _b * 32768 + (wid + 8 * _i) * 1024), 16, 0, 0); \
        __builtin_amdgcn_global_load_lds((const unsigned*)(_vp + soV[_i]), (LAS unsigned*)(ldsL + _b * 32768 + 16384 + (wid + 8 * _i) * 1024), 16, 0, 0); } } while (0)
    unsigned bmw = 0u;
    if (MODE == MODE_SLC) bmw = a.BM[((size_t)tq * 4 + g) * 8];
    asm volatile("s_waitcnt lgkmcnt(0)" ::: "memory");
    __builtin_amdgcn_s_barrier();
    asm volatile("" ::: "memory");
    ISSUE(j0);
    asm volatile("s_waitcnt vmcnt(4) lgkmcnt(0)" : "+v"(bmw), "+v"(negBC), "+v"(qr[0]), "+v"(qr[1]), "+v"(qr[2]), "+v"(qr[3]), "+v"(qr[4]), "+v"(qr[5]), "+v"(qr[6]), "+v"(qr[7]) :: "memory");
    if (j0 + 1 < j1) ISSUE(j0 + 1); if (j0 + 2 < j1) ISSUE(j0 + 2);
    for (int j = j0; j < j1; ++j) {
        const int buf = (j - j0) & 3;
        if (j + 2 < j1) asm volatile("s_waitcnt vmcnt(8)" ::: "memory"); else if (j + 1 < j1) asm volatile("s_waitcnt vmcnt(4)" ::: "memory"); else asm volatile("s_waitcnt vmcnt(0)" ::: "memory");
        __builtin_amdgcn_s_barrier();
        asm volatile("" ::: "memory");
        if (j + 3 < j1) ISSUE(j + 3);
        int lhi = khi;
        if (MODE == MODE_SLC) { if (!((bmw >> (j & 31)) & 1u)) lhi = -1; }
        const int kb = j * KVBLK;
        const bool l_any = (kb + 63 >= klo) && (kb <= lhi);
        const bool l_full = (kb >= klo) && (kb + 63 <= lhi);
        if (__any(l_any)) {
            f32x16 p0, p1;
            qkt(p0, p1, lds + buf * 32768, qr, r32, hi);
            const bool uni = __all(l_full || !l_any);
            const float off = (uni && !l_any) ? -1.0e30f : negBC;
#pragma unroll
            for (int r = 0; r < 16; ++r) p0[r] = __builtin_amdgcn_exp2f(fmaf(p0[r], SM_C, off));
            if (!uni) {
#pragma unroll
                for (int r = 0; r < 16; ++r) { const int k0i = kb + crow(r, hi); p0[r] = (k0i >= klo && k0i <= lhi) ? p0[r] : 0.f; } }
            float ps = 0.f;
#pragma unroll
            for (int r = 0; r < 16; ++r) ps += p0[r];
            bf16x8 pa0, pa1, pa2, pa3; pack_half(p0, pa0, pa1);
            pv_half<0, true>(o, vb0 + buf * 32768, pa0, pa1, p1, off);
            if (!uni) {
#pragma unroll
                for (int r = 0; r < 16; ++r) { const int k1i = kb + 32 + crow(r, hi); p1[r] = (k1i >= klo && k1i <= lhi) ? p1[r] : 0.f; } }
#pragma unroll
            for (int r = 0; r < 16; ++r) ps += p1[r];
            lsum += ps;
            pack_half(p1, pa2, pa3);
            pv_half<2, false>(o, vb0 + buf * 32768, pa2, pa3, p1, off);
        }
        if (MODE == MODE_SLC) { if (((j + 1) & 31) == 0 && j + 1 < j1) { bmw = a.BM[((size_t)tq * 4 + g) * 8 + ((j + 1) >> 5)]; asm volatile("s_waitcnt vmcnt(0)" : "+v"(bmw) :: "memory"); } }
    }
#undef ISSUE
    lsum += __shfl_xor(lsum, 32);
    const float grow = a.G[(size_t)tq * NGATE + hq * 3 + (MODE == MODE_CMP ? 0 : (MODE == MODE_SLC ? 1 : 2))];
    if (hi == 0) { li_l[r32] = lsum; li_l[32 + r32] = rvalid ? grow : 0.f; }
    if (MODE == MODE_CMP) { if (hi == 0) a.L[(size_t)tq * NH + hq] = lsum; }
    asm volatile("s_waitcnt lgkmcnt(0)" ::: "memory");
#pragma unroll
    for (int hf = 0; hf < 2; ++hf) {
        float gtv[8]; float pvv[8][4];
#pragma unroll
        for (int rr = 0; rr < 8; ++rr) { const int r = hf * 8 + rr;
            const int orow = crow(r, hi); const float lv = li_l[orow]; const float rl = lv > 0.f ? __builtin_amdgcn_rcpf(lv) : 0.f;
            const int t = MODE == MODE_SLC ? t0 + wid * 5 + orow / 6 : t0 + wid * 16 + (orow & 15);
            const int h = MODE == MODE_SLC ? g * HPG + orow % 6 : g * HPG + hp * 2 + (orow >> 4);
            const bool valid = !(MODE == MODE_SLC && (orow >= 30 || t >= S_)); const int tc = valid ? t : 0;
            gtv[rr] = li_l[32 + orow] * rl;
            if (MODE != MODE_CMP) { const float* oa = a.OACC + (size_t)tc * 3072 + h * HD + r32;
#pragma unroll
                for (int d0 = 0; d0 < 4; ++d0) pvv[rr][d0] = oa[d0 * 32]; }
        }
#pragma unroll
        for (int rr = 0; rr < 8; ++rr) { const int r = hf * 8 + rr;
            const int orow = crow(r, hi);
            const int t = MODE == MODE_SLC ? t0 + wid * 5 + orow / 6 : t0 + wid * 16 + (orow & 15);
            const int h = MODE == MODE_SLC ? g * HPG + orow % 6 : g * HPG + hp * 2 + (orow >> 4);
            if (MODE == MODE_SLC && (orow >= 30 || t >= S_)) continue;
            float* oa = a.OACC + (size_t)t * 3072 + h * HD + r32;
#pragma unroll
            for (int d0 = 0; d0 < 4; ++d0) {
                const float v = o[d0][r] * gtv[rr];
                if (MODE == MODE_CMP) oa[d0 * 32] = v;
                else if (MODE == MODE_WIN) oa[d0 * 32] = pvv[rr][d0] + v;
                else a.MIX[(size_t)t * DM + POOLW + h * HD + d0 * 32 + r32] = (bf16_t)(cvt_pk_bf16(pvv[rr][d0] + v, 0.f) & 0xffffu);
            }
        }
    }
}

constexpr int SLC_KPS = 1040, SLC_VPS = 1056, SLC_KIMG = 16 * SLC_KPS, SLC_BUF = SLC_KIMG + 16 * SLC_VPS, LDS_SLCX = 4 * SLC_BUF;
static_assert(LDS_SLCX + 3072 <= LDS_MISC, "slc ring overlaps the barrier words");
__device__ __forceinline__ bf16x8 lds_b128(int adr) { return *reinterpret_cast<const LAS bf16x8*>((LAS char*)(unsigned long)(unsigned)adr); }
__device__ __forceinline__ void slc16_unit(const AttnArgs& a, LAS char* ldsL, int ut, int g) {
    char* lds = (char*)ldsL;
    const int tid = threadIdx.x, wid = __builtin_amdgcn_readfirstlane(tid >> 6), lane = tid & 63, fr = lane & 15, fq = lane >> 4;
    float* li_l = (float*)(lds + LDS_SLCX) + wid * 96;
    const int t0 = ut * 64, j0 = 0, j1 = ut + 1;
    const bf16_t* Kb = a.Z + OFF_KV + 2 * 512 + g * HD; const long ldk = LDZ;
    int tqv[3];
#pragma unroll
    for (int b = 0; b < 3; ++b) tqv[b] = t0 + wid * 8 + (16 * b + fr) / 6;
#define TQC(b) tqv[b]
#define HQ(b) (g * HPG + (16 * (b) + fr) % 6)
    float negBC = -a.TAB[513];
    bf16x8 qf[3][4];
#pragma unroll
    for (int b = 0; b < 3; ++b) { const bf16_t* qp = a.Z + (size_t)TQC(b) * LDZ + OFF_Q + HQ(b) * HD + fq * 8;
#pragma unroll
        for (int ks = 0; ks < 4; ++ks) qf[b][ks] = *reinterpret_cast<const bf16x8*>(qp + ks * 32); }
    f32x4 o[3][8]; float lsum[3];
#pragma unroll
    for (int b = 0; b < 3; ++b) { lsum[b] = 0.f;
#pragma unroll
        for (int c = 0; c < 8; ++c) o[b][c] = (f32x4){0.f, 0.f, 0.f, 0.f}; }
    const int q4 = fr >> 2, p4 = fr & 3, lbase = (int)(uintptr_t)ldsL;
    const int kaddr0 = lbase + fr * SLC_KPS + fq * 16;
    const int vaddr0 = lbase + SLC_KIMG + (4 * fq + q4) * SLC_VPS + (p4 >> 1) * 16 + (p4 & 1) * 8;
    unsigned so0 = (unsigned)((wid + 16 * (lane >> 4)) * ldk + (lane & 15) * 8) * 2u;
#define ISSUE16(jt) do { const int _b = ((jt) - j0) & 3; const char* _kp = (const char*)Kb + (size_t)(jt) * KVBLK * ldk * 2; asm volatile("" : "+v"(so0)); \
    _Pragma("unroll") for (int _i = 0; _i < 4; ++_i) \
        __builtin_amdgcn_global_load_lds((const unsigned*)(_kp + (_i >> 1) * 1024 + (_i & 1) * (8 * ldk * 2) + so0), \
            (LAS unsigned*)(ldsL + _b * SLC_BUF + ((_i >> 1) ? SLC_KIMG + (wid + 8 * (_i & 1)) * SLC_VPS : (wid + 8 * (_i & 1)) * SLC_KPS)), 16, 0, 0); } while (0)
    unsigned bmw[3];
#pragma unroll
    for (int b = 0; b < 3; ++b) bmw[b] = a.BM[((size_t)TQC(b) * 4 + g) * 8];
    asm volatile("s_waitcnt lgkmcnt(0)" ::: "memory");
    __builtin_amdgcn_s_barrier();
    asm volatile("" ::: "memory");
    ISSUE16(j0); if (j0 + 1 < j1) ISSUE16(j0 + 1);
    asm volatile("s_waitcnt vmcnt(0) lgkmcnt(0)" : "+v"(bmw[0]), "+v"(bmw[1]), "+v"(bmw[2]), "+v"(negBC), "+v"(qf[0][0]), "+v"(qf[0][1]), "+v"(qf[0][2]), "+v"(qf[0][3]),
                 "+v"(qf[1][0]), "+v"(qf[1][1]), "+v"(qf[1][2]), "+v"(qf[1][3]), "+v"(qf[2][0]), "+v"(qf[2][1]), "+v"(qf[2][2]), "+v"(qf[2][3]) :: "memory");
    int kadr = kaddr0, vadr = vaddr0;
    for (int j = j0; j < j1; ++j) {
        const int buf = (j - j0) & 3;
        if ((j & 1) == 0) {
            asm volatile("s_waitcnt vmcnt(0)" ::: "memory");
            __builtin_amdgcn_s_barrier();
            asm volatile("" ::: "memory");
            if (j + 2 < j1) ISSUE16(j + 2); if (j + 3 < j1) ISSUE16(j + 3); }
        const int kb = j * KVBLK;
#define KF16(ks, mt) lds_b128(kadr + 64 * (ks) + 256 * (mt))
#define TRA(dst, off) asm volatile("ds_read_b64_tr_b16 %0, %1 offset:%2" : "=v"(dst) : "v"(vadr), "n"(off))
#define VLOAD(dst, s, h) _Pragma("unroll") for (int _c = 0; _c < 4; ++_c) { TRA(dst[_c][0], 32 * (4 * (h) + _c) + 512 * (s)); TRA(dst[_c][1], 32 * (4 * (h) + _c) + 512 * (s) + 256); }
#define VWAIT(n, d) asm volatile("s_waitcnt lgkmcnt(" #n ")" : "+v"(d[0][0]), "+v"(d[0][1]), "+v"(d[1][0]), "+v"(d[1][1]), "+v"(d[2][0]), "+v"(d[2][1]), "+v"(d[3][0]), "+v"(d[3][1]))
#define PVMMA(src, pa, h) _Pragma("unroll") for (int _c = 0; _c < 4; ++_c) o[b][4 * (h) + _c] = __builtin_amdgcn_mfma_f32_16x16x32_bf16(pa, \
            (bf16x8){src[_c][0][0], src[_c][0][1], src[_c][0][2], src[_c][0][3], src[_c][1][0], src[_c][1][1], src[_c][1][2], src[_c][1][3]}, o[b][4 * (h) + _c], 0, 0, 0);
#define EXPH(h, pw) { if (uni) { _Pragma("unroll") for (int mt = 2 * (h); mt < 2 * (h) + 2; ++mt) _Pragma("unroll") for (int i = 0; i < 4; ++i) { \
                            const float e_ = __builtin_amdgcn_exp2f(fmaf(acc[mt][i], SM_C, off)); acc[mt][i] = e_; ps += e_; } } \
                      else { asm volatile("" ::: "memory"); _Pragma("unroll") for (int mt = 2 * (h); mt < 2 * (h) + 2; ++mt) _Pragma("unroll") for (int i = 0; i < 4; ++i) { \
                            float e_ = __builtin_amdgcn_exp2f(fmaf(acc[mt][i], SM_C, off)); e_ = (16 * mt + i <= lim4) ? e_ : 0.f; acc[mt][i] = e_; ps += e_; } } \
                      pw.x = cvt_pk_bf16(acc[2 * (h)][0], acc[2 * (h)][1]); pw.y = cvt_pk_bf16(acc[2 * (h)][2], acc[2 * (h)][3]); \
                      pw.z = cvt_pk_bf16(acc[2 * (h) + 1][0], acc[2 * (h) + 1][1]); pw.w = cvt_pk_bf16(acc[2 * (h) + 1][2], acc[2 * (h) + 1][3]); }
#pragma unroll
        for (int b = 0; b < 3; ++b) {
            const bool sel = (bmw[b] >> (j & 31)) & 1u;
            const int lim = tqv[b] - kb;
            const bool l_any = sel && lim >= 0, l_full = sel && lim >= 63;
            if (__any(l_any)) {
                f32x4 acc[4]; bf16x8 ka[4], kc[4]; s16x4 va[4][2], vc[4][2];
#pragma unroll
                for (int mt = 0; mt < 4; ++mt) ka[mt] = KF16(0, mt);
#pragma unroll
                for (int mt = 0; mt < 4; ++mt) kc[mt] = KF16(1, mt);
                __builtin_amdgcn_sched_barrier(0);
#pragma unroll
                for (int mt = 0; mt < 4; ++mt) acc[mt] = __builtin_amdgcn_mfma_f32_16x16x32_bf16(ka[mt], qf[b][0], (f32x4){0.f, 0.f, 0.f, 0.f}, 0, 0, 0);
#pragma unroll
                for (int mt = 0; mt < 4; ++mt) ka[mt] = KF16(2, mt);
                __builtin_amdgcn_sched_barrier(0);
#pragma unroll
                for (int mt = 0; mt < 4; ++mt) acc[mt] = __builtin_amdgcn_mfma_f32_16x16x32_bf16(kc[mt], qf[b][1], acc[mt], 0, 0, 0);
#pragma unroll
                for (int mt = 0; mt < 4; ++mt) kc[mt] = KF16(3, mt);
                __builtin_amdgcn_sched_barrier(0);
#pragma unroll
                for (int mt = 0; mt < 4; ++mt) acc[mt] = __builtin_amdgcn_mfma_f32_16x16x32_bf16(ka[mt], qf[b][2], acc[mt], 0, 0, 0);
                __builtin_amdgcn_sched_barrier(0);
#pragma unroll
                for (int mt = 0; mt < 4; ++mt) acc[mt] = __builtin_amdgcn_mfma_f32_16x16x32_bf16(kc[mt], qf[b][3], acc[mt], 0, 0, 0);
                __builtin_amdgcn_sched_barrier(0);
                VLOAD(va, 0, 0)
                VLOAD(vc, 0, 1)
                const bool uni = __all(l_full || !l_any);
                const float off = (uni && !l_any) ? -1.0e30f : negBC;
                const int lim4 = l_any ? lim - 4 * fq : -1;
                float ps = 0.f;
                u32x4 pw0, pw1;
                EXPH(0, pw0)
                const bf16x8 pa0 = *reinterpret_cast<bf16x8*>(&pw0);
                __builtin_amdgcn_sched_barrier(0);
                VWAIT(8, va);
                PVMMA(va, pa0, 0)
                __builtin_amdgcn_sched_barrier(0);
                VLOAD(va, 1, 0)
                VWAIT(8, vc);
                PVMMA(vc, pa0, 1)
                __builtin_amdgcn_sched_barrier(0);
                VLOAD(vc, 1, 1)
                EXPH(1, pw1)
                const bf16x8 pa1 = *reinterpret_cast<bf16x8*>(&pw1);
                lsum[b] += ps;
                __builtin_amdgcn_sched_barrier(0);
                VWAIT(8, va);
                PVMMA(va, pa1, 0)
                __builtin_amdgcn_sched_barrier(0);
                VWAIT(0, vc);
                PVMMA(vc, pa1, 1)
                __builtin_amdgcn_sched_barrier(0);
            }
        }
#undef TRA
#undef VWAIT
#undef EXPH
#undef KF16
#undef VLOAD
#undef PVMMA
        if (((j + 1) & 31) == 0 && j + 1 < j1) {
#pragma unroll
            for (int b = 0; b < 3; ++b) bmw[b] = a.BM[((size_t)TQC(b) * 4 + g) * 8 + ((j + 1) >> 5)];
            asm volatile("s_waitcnt vmcnt(0)" : "+v"(bmw[0]), "+v"(bmw[1]), "+v"(bmw[2]) :: "memory"); }
        { const int step = buf == 3 ? -3 * SLC_BUF : SLC_BUF; kadr += step; vadr += step; asm volatile("" : "+v"(kadr), "+v"(vadr)); }
    }
#undef ISSUE16
    int fqe = fq, fre = fr; asm volatile("" : "+v"(fqe), "+v"(fre));
    float grow[3];
#pragma unroll
    for (int b = 0; b < 3; ++b) grow[b] = a.G[(size_t)TQC(b) * NGATE + (g * HPG + (16 * b + fre) % 6) * 3 + 1];
#pragma unroll
    for (int b = 0; b < 3; ++b) { float ls = lsum[b]; ls += __shfl_xor(ls, 16); ls += __shfl_xor(ls, 32);
        if (fqe == 0) { li_l[b * 32 + fre] = ls; li_l[b * 32 + 16 + fre] = grow[b]; } }
    asm volatile("s_waitcnt lgkmcnt(0)" ::: "memory");
#pragma unroll
    for (int b = 0; b < 3; ++b) {
        float pv_[4][8]; float gtv[4];
#pragma unroll
        for (int i = 0; i < 4; ++i) { const int q = 4 * fqe + i, R = 16 * b + q; const float lv = li_l[b * 32 + q]; gtv[i] = li_l[b * 32 + 16 + q] * (lv > 0.f ? __builtin_amdgcn_rcpf(lv) : 0.f);
            const int t = t0 + wid * 8 + R / 6, h = g * HPG + R % 6;
            const float* oa = a.OACC + (size_t)t * 3072 + h * HD + fre;
#pragma unroll
            for (int c = 0; c < 8; ++c) pv_[i][c] = oa[c * 16]; }
#pragma unroll
        for (int i = 0; i < 4; ++i) { const int R = 16 * b + 4 * fqe + i; const int t = t0 + wid * 8 + R / 6, h = g * HPG + R % 6;
            bf16_t* mp = a.MIX + (size_t)t * DM + POOLW + h * HD + fre;
#pragma unroll
            for (int c = 0; c < 8; ++c) mp[c * 16] = (bf16_t)(cvt_pk_bf16(pv_[i][c] + o[b][c][i] * gtv[i], 0.f) & 0xffffu); }
    }
#undef TQC
#undef HQ
}

__device__ __forceinline__ void imp_task(const AttnArgs& a, float* IMPP, float* IMPF, int tqi, int g) {
    const int lane = threadIdx.x & 63, fr = lane & 15, fq = lane >> 4;
    const int t = tqi * 16 + fr;
    const int tmax = tqi * 16 + 15;
    if (tmax < 31) return;
    const int lim = t >= 31 ? ((t - 31) >> 4) : -1;
    const int nstep = ((((tmax - 31) >> 4) >> 6) + 1) * 4;
    const float negBC = -a.TAB[512];
    bf16x8 qf[HPG][4]; float rl[HPG];
#pragma unroll
    for (int h = 0; h < HPG; ++h) {
        const bf16_t* qp = a.Z + (size_t)t * LDZ + OFF_Q + (g * HPG + h) * HD + fq * 8;
#pragma unroll
        for (int ks = 0; ks < 4; ++ks) qf[h][ks] = *reinterpret_cast<const bf16x8*>(qp + ks * 32);
        const float lv = a.L[(size_t)t * NH + g * HPG + h]; rl[h] = lv > 0.f ? 1.0f / lv : 0.f;
    }
    const bf16_t* kbase = a.KC + (size_t)g * 1024 * HD + (size_t)fr * HD + fq * 8;
    bf16x8 kf[4], kn[4], kn2[4];
#pragma unroll
    for (int ks = 0; ks < 4; ++ks) { kf[ks] = *reinterpret_cast<const bf16x8*>(kbase + ks * 32); kn[ks] = *reinterpret_cast<const bf16x8*>(kbase + (size_t)(nstep > 1 ? 1 : 0) * 16 * HD + ks * 32); }
    float* op = IMPP + ((size_t)t * 4 + g) * 256 + fq; float* of = IMPF + ((size_t)t * 4 + g) * 256 + fq;
    for (int st = 0; st < nstep; ++st) {
        const int sn = (st + 2 < nstep) ? st + 2 : nstep - 1;
#pragma unroll
        for (int ks = 0; ks < 4; ++ks) kn2[ks] = *reinterpret_cast<const bf16x8*>(kbase + (size_t)sn * 16 * HD + ks * 32);
        f32x4 imp4 = {0.f, 0.f, 0.f, 0.f};
        const int n0 = st * 16 + fq * 4;
#pragma unroll
        for (int h = 0; h < HPG; ++h) {
            f32x4 acc = {0.f, 0.f, 0.f, 0.f};
#pragma unroll
            for (int ks = 0; ks < 4; ++ks) acc = __builtin_amdgcn_mfma_f32_16x16x32_bf16(kf[ks], qf[h][ks], acc, 0, 0, 0);
#pragma unroll
            for (int i = 0; i < 4; ++i) { const float e = __builtin_amdgcn_exp2f(fmaf(acc[i], SM_C, negBC)) * rl[h]; imp4[i] += (n0 + i <= lim) ? e : 0.f; }
        }
        op[st * 4] = imp4[0] + 2.0f * (imp4[1] + imp4[2] + imp4[3]);
        of[st * 4] = imp4[0];
#pragma unroll
        for (int ks = 0; ks < 4; ++ks) { kf[ks] = kn[ks]; kn[ks] = kn2[ks]; }
    }
}

__device__ __forceinline__ void topk_load(const float* IMPP, const float* IMPF, int t, int g, f32x4& pp, f32x4& ff) {
    const int lane = threadIdx.x & 63, cur = t >> 6, jb = lane * 4;
    pp = (f32x4){0.f, 0.f, 0.f, 0.f}; ff = pp;
    if (cur > 15 && jb <= cur) { const size_t base = ((size_t)t * 4 + g) * 256; pp = *(const f32x4*)(IMPP + base + jb); ff = *(const f32x4*)(IMPF + base + jb); }
}
__device__ __forceinline__ void topk_task(const f32x4 pp, const f32x4 ff, unsigned* BM, int t, int g) {
    const int lane = threadIdx.x & 63;
    const int cur = t >> 6;
    unsigned nib = 0u;
    if (cur <= 15) { const int jb = lane * 4;
#pragma unroll
        for (int c = 0; c < 4; ++c) if (jb + c <= cur) nib |= 1u << c; }
    else {
        const int jb = lane * 4;
        unsigned key[4];
        {
            float fnext = __shfl_down(ff[0], 1);
            if (lane == 63) fnext = 0.f;
            const float v0 = pp[0] + ff[1], v1 = pp[1] + ff[2], v2 = pp[2] + ff[3], v3 = pp[3] + fnext;
            key[0] = (jb + 0 >= 1 && jb + 0 <= cur - 2) ? __float_as_uint(fmaxf(v0, 0.f)) + 1u : 0u;
            key[1] = (jb + 1 >= 1 && jb + 1 <= cur - 2) ? __float_as_uint(fmaxf(v1, 0.f)) + 1u : 0u;
            key[2] = (jb + 2 >= 1 && jb + 2 <= cur - 2) ? __float_as_uint(fmaxf(v2, 0.f)) + 1u : 0u;
            key[3] = (jb + 3 >= 1 && jb + 3 <= cur - 2) ? __float_as_uint(fmaxf(v3, 0.f)) + 1u : 0u;
        }
        unsigned prefix = 0u; bool exact = false;
        for (int b = 30; b >= 0; --b) {
            const unsigned trial = prefix | (1u << b);
            const int cnt = __popcll(__ballot(key[0] >= trial)) + __popcll(__ballot(key[1] >= trial)) + __popcll(__ballot(key[2] >= trial)) + __popcll(__ballot(key[3] >= trial));
            if (cnt >= 13) { prefix = trial; if (cnt == 13) { exact = true; break; } }
        }
#pragma unroll
        for (int c = 0; c < 4; ++c) if (exact ? (key[c] >= prefix) : (key[c] > prefix)) nib |= 1u << c;
        if (!exact) {
            int need = 13 - (__popcll(__ballot(key[0] > prefix)) + __popcll(__ballot(key[1] > prefix)) + __popcll(__ballot(key[2] > prefix)) + __popcll(__ballot(key[3] > prefix)));
            unsigned tie = 0u;
#pragma unroll
            for (int c = 0; c < 4; ++c) if (key[c] == prefix) tie |= 1u << c;
            for (int guard = 0; need > 0 && guard < 16; ++guard) {
                const unsigned long long any = __ballot(tie != 0u);
                if (any == 0ull) break;
                const int L = __builtin_ctzll(any);
                if (lane == L) { const unsigned low = tie & (0u - tie); nib |= low; tie ^= low; }
                --need;
            }
        }
        if (lane == 0) nib |= 1u;
        if (lane == (cur >> 2)) nib |= 1u << (cur & 3);
        if (lane == ((cur - 1) >> 2)) nib |= 1u << ((cur - 1) & 3);
    }
    unsigned x = nib << (4 * (lane & 7));
    x |= __shfl_xor(x, 1); x |= __shfl_xor(x, 2); x |= __shfl_xor(x, 4);
    if ((lane & 7) == 0) BM[((size_t)t * 4 + g) * 8 + (lane >> 3)] = x;
}
#undef KSWZ
}

template <bool FFN_REMAP = false>
__device__ __forceinline__ void convT(const float* __restrict__ src0, int K, int N, bf16_t* __restrict__ dst, int ldd, LAS float* tile, int bid, int nb, int Nfull = 0, int n0 = 0) {
    const float* __restrict__ src = src0 + n0; if (Nfull == 0) Nfull = N;
    const int tid = threadIdx.x, tk = K >> 6, tn = (N + 63) >> 6, total = tk * tn;
    const int r = tid >> 4, c4 = (tid & 15) * 4;
    f32x4 v[2] = {{0.f, 0.f, 0.f, 0.f}, {0.f, 0.f, 0.f, 0.f}}, vn[2];
    if (bid < total) { const int nti = bid % tn, kti = bid / tn, ng = nti * 64 + c4;
#pragma unroll
        for (int h = 0; h < 2; ++h) if (ng < N) v[h] = *(const f32x4*)(src + (size_t)(kti * 64 + r + h * 32) * Nfull + ng); }
    for (int idx = bid; idx < total; idx += nb) {
        const int nti = idx % tn, kti = idx / tn;
#pragma unroll
        for (int h = 0; h < 2; ++h) { LAS float* tp = tile + (r + h * 32) * 65 + c4; tp[0] = v[h][0]; tp[1] = v[h][1]; tp[2] = v[h][2]; tp[3] = v[h][3]; }
        {
            const int nx = idx + nb; vn[0] = (f32x4){0.f, 0.f, 0.f, 0.f}; vn[1] = vn[0];
            if (nx < total) { const int nti2 = nx % tn, kti2 = nx / tn, ng2 = nti2 * 64 + c4;
#pragma unroll
                for (int h = 0; h < 2; ++h) if (ng2 < N) vn[h] = *(const f32x4*)(src + (size_t)(kti2 * 64 + r + h * 32) * Nfull + ng2); } }
        __syncthreads();
        const int n = tid >> 3, k8 = (tid & 7) * 8, ngl = nti * 64 + n;
        float e[8];
#pragma unroll
        for (int i = 0; i < 8; ++i) e[i] = tile[(k8 + i) * 65 + n];
        if (ngl < N) { u32x4 w; w.x = cvt_pk_bf16(e[0], e[1]); w.y = cvt_pk_bf16(e[2], e[3]); w.z = cvt_pk_bf16(e[4], e[5]); w.w = cvt_pk_bf16(e[6], e[7]);
            int drow = ngl; if (FFN_REMAP) { const int up = ngl >= DFF ? 1 : 0, f = ngl - up * DFF; drow = (f >> 7) * 256 + up * 128 + (f & 127); }
            *(u32x4*)(dst + (size_t)drow * ldd + kti * 64 + k8) = w; }
        __syncthreads();
        v[0] = vn[0]; v[1] = vn[1];
    }
}
__device__ __forceinline__ void convT8(const float* __restrict__ src0, int K, int N, unsigned char* __restrict__ dst, int ldd, float scale, LAS float* tile, int bid, int nb, int Nfull = 0, int n0 = 0) {
    const float* __restrict__ src = src0 + n0; if (Nfull == 0) Nfull = N;
    const int tid = threadIdx.x, tk = K >> 6, tn = (N + 63) >> 6, total = tk * tn;
    const int r = tid >> 4, c4 = (tid & 15) * 4;
    f32x4 v[2] = {{0.f, 0.f, 0.f, 0.f}, {0.f, 0.f, 0.f, 0.f}}, vn[2];
    if (bid < total) { const int nti = bid % tn, kti = bid / tn, ng = nti * 64 + c4;
#pragma unroll
        for (int h = 0; h < 2; ++h) if (ng < N) v[h] = *(const f32x4*)(src + (size_t)(kti * 64 + r + h * 32) * Nfull + ng); }
    for (int idx = bid; idx < total; idx += nb) {
        const int nti = idx % tn, kti = idx / tn;
#pragma unroll
        for (int h = 0; h < 2; ++h) { LAS float* tp = tile + (r + h * 32) * 65 + c4; tp[0] = v[h][0]; tp[1] = v[h][1]; tp[2] = v[h][2]; tp[3] = v[h][3]; }
        { const int nx = idx + nb; vn[0] = (f32x4){0.f, 0.f, 0.f, 0.f}; vn[1] = vn[0];
            if (nx < total) { const int nti2 = nx % tn, kti2 = nx / tn, ng2 = nti2 * 64 + c4;
#pragma unroll
                for (int h = 0; h < 2; ++h) if (ng2 < N) vn[h] = *(const f32x4*)(src + (size_t)(kti2 * 64 + r + h * 32) * Nfull + ng2); } }
        __syncthreads();
        const int n = tid >> 3, k8 = (tid & 7) * 8, ngl = nti * 64 + n;
        float e[8];
#pragma unroll
        for (int i = 0; i < 8; ++i) e[i] = tile[(k8 + i) * 65 + n] * scale;
        if (ngl < N) { int p0 = __builtin_amdgcn_cvt_pk_fp8_f32(e[0], e[1], 0, false); p0 = __builtin_amdgcn_cvt_pk_fp8_f32(e[2], e[3], p0, true);
            int p1 = __builtin_amdgcn_cvt_pk_fp8_f32(e[4], e[5], 0, false); p1 = __builtin_amdgcn_cvt_pk_fp8_f32(e[6], e[7], p1, true);
            *(u32x2*)(dst + (size_t)ngl * ldd + kti * 64 + k8) = (u32x2){(unsigned)p0, (unsigned)p1}; }
        __syncthreads();
        v[0] = vn[0]; v[1] = vn[1];
    }
}
__device__ __forceinline__ void rmsnorm_rows(const float* __restrict__ src, const float* __restrict__ w, bf16_t* __restrict__ dst, int rows, int gw, int nw, unsigned char* __restrict__ dst8 = nullptr) {
    const int lane = threadIdx.x & 63;
    f32x4 v[16], vn[16];
    if (gw < rows) { const f32x4* sp = (const f32x4*)(src + (size_t)gw * DM);
#pragma unroll
        for (int i = 0; i < 16; ++i) v[i] = sp[lane + 64 * i]; }
    for (int row = gw; row < rows; row += nw) {
        const int nr = row + nw < rows ? row + nw : row;
        { const f32x4* sp = (const f32x4*)(src + (size_t)nr * DM);
#pragma unroll
          for (int i = 0; i < 16; ++i) vn[i] = sp[lane + 64 * i]; }
        float ss = 0.f;
#pragma unroll
        for (int i = 0; i < 16; ++i) ss += v[i][0] * v[i][0] + v[i][1] * v[i][1] + v[i][2] * v[i][2] + v[i][3] * v[i][3];
        ss = wave_sum(ss);
        const float rstd = rsqrtf(ss * (1.0f / DM) + EPS);
#pragma unroll
        for (int i = 0; i < 16; ++i) { const f32x4 ww = ((const f32x4*)w)[lane + 64 * i];
            u32x2 o; o.x = cvt_pk_bf16(v[i][0] * rstd * ww[0], v[i][1] * rstd * ww[1]); o.y = cvt_pk_bf16(v[i][2] * rstd * ww[2], v[i][3] * rstd * ww[3]);
            *(u32x2*)(dst + (size_t)row * DM + (lane + 64 * i) * 4) = o;
            if (dst8) { int pk = __builtin_amdgcn_cvt_pk_fp8_f32(v[i][0] * rstd * ww[0], v[i][1] * rstd * ww[1], 0, false); pk = __builtin_amdgcn_cvt_pk_fp8_f32(v[i][2] * rstd * ww[2], v[i][3] * rstd * ww[3], pk, true);
                *(int*)(dst8 + (size_t)row * DM + (lane + 64 * i) * 4) = pk; } }
#pragma unroll
        for (int i = 0; i < 16; ++i) v[i] = vn[i];
    }
}

struct Ptrs {
    bf16_t *Win, *Wo, *Wfi, *Wfo, *Wg, *Wple, *Wpool, *Wc1k, *Wc1v, *XN, *PB, *Z, *M, *KC, *VC, *MIX, *ACT, *ERAW;
    float *COS, *SIN, *TAB, *G, *H1, *L, *OACC, *IMPP, *IMPF, *ERSTD; unsigned* BM;
};

__device__ __forceinline__ void phase_prologue(const Params& P, const Ptrs& W, LAS unsigned char* lds) {
    const int bid = blockIdx.x, nb = gridDim.x, tid = threadIdx.x, lane = tid & 63, wv = tid >> 6;
    const int gw = bid * NWAVES + wv, nw = nb * NWAVES; const size_t gt = (size_t)bid * NTHREADS + tid, ntot = (size_t)nb * NTHREADS;
    LAS float* tile = (LAS float*)lds;
    rmsnorm_rows(P.x, P.norm1_w, W.XN, S_, gw, nw, P.ws + WS_XN8);
    convT(P.w_in, DM, POOLW, W.Win, DM, tile, bid, nb, INW, 0);
    convT(P.w_in, DM, INW - OFF_G, W.Win + (size_t)OFF_G * DM, DM, tile, bid, nb, INW, OFF_G);
    convT8(P.w_in, DM, OFF_G - POOLW, P.ws + WS_WIN8, DM, WG8_SCALE, tile, bid, nb, INW, POOLW);
    for (size_t i = gt; i < (size_t)(LDZ - INW) * DM / 8; i += ntot) *(u32x4*)(W.Win + (size_t)INW * DM + i * 8) = (u32x4){0u, 0u, 0u, 0u};
    convT(P.w_o, DM, DM, W.Wo, DM, tile, bid, nb);
    convT<true>(P.w_ffn_in, DM, NFI, W.Wfi, DM, tile, bid, nb);
    for (size_t i = gt; i < (size_t)2 * DM / 8; i += ntot) *(u32x4*)(W.XN - 2 * DM + i * 8) = (u32x4){0u, 0u, 0u, 0u};
    convT(P.w_ffn_out, DFF, DM, W.Wfo, DFF, tile, bid, nb);
    convT8(P.w_ple_gate, DM, DM, (unsigned char*)W.Wg, DM, WG8_SCALE, tile, bid, nb);
    convT(P.w_ple_proj, PLE, DM, W.Wple, PLE, tile, bid, nb);
    for (int g = 0; g < 4; ++g) convT(P.w_pool + (size_t)g * 65536, 256, 256, W.Wpool + (size_t)g * 65536, 256, tile, bid, nb);
    convT(P.cmp_k_w1, 4096, 256, W.Wc1k, 4096, tile, bid, nb);
    convT(P.cmp_v_w1, 4096, 256, W.Wc1v, 4096, tile, bid, nb);
    { constexpr size_t NP8 = (size_t)S_ * PLE / 8;
      for (size_t ib = gt; ib < NP8; ib += 4 * ntot) { f32x4 av[4], bv[4];
#pragma unroll
          for (int k = 0; k < 4; ++k) { size_t i = ib + k * ntot; if (i >= NP8) i = NP8 - 1; av[k] = *(const f32x4*)(P.p + i * 8); bv[k] = *(const f32x4*)(P.p + i * 8 + 4); }
#pragma unroll
          for (int k = 0; k < 4; ++k) { const size_t i = ib + k * ntot; if (i < NP8) { u32x4 w; w.x = cvt_pk_bf16(av[k][0], av[k][1]); w.y = cvt_pk_bf16(av[k][2], av[k][3]); w.z = cvt_pk_bf16(bv[k][0], bv[k][1]); w.w = cvt_pk_bf16(bv[k][2], bv[k][3]); *(u32x4*)(W.PB + i * 8) = w; } } } }
    for (size_t i = gt; i < (size_t)S_ * 16; i += ntot) { const int t = (int)(i >> 4), fi = (int)(i & 15);
        const float inv = exp2f(-(float)fi * (18.931568569324174f / 16.0f)); const float ang = (float)P.positions[t] * inv;
        const double ad = (double)ang; const double kk = rint(ad * 0.15915494309189535); const float rf = (float)(ad - kk * 6.283185307179586);
        W.COS[i] = __cosf(rf); W.SIN[i] = __sinf(rf); }
    for (int task = gw; task < 128; task += nw) { const int which = task >> 6, r0 = (task & 63) * 64; const float* pe = which ? P.cmp_pos_v : P.cmp_pos_k; const float* w1 = which ? P.cmp_v_w1 : P.cmp_k_w1;
        f32x4 s = {0.f, 0.f, 0.f, 0.f};
#pragma unroll 8
        for (int r = 0; r < 64; ++r) { const f32x4 wv = *(const f32x4*)(w1 + (size_t)(r0 + r) * 256 + lane * 4); s += wv * pe[r0 + r]; }
        float* cbp = (float*)(P.ws + WS_CBIAS) + which * 256 + lane * 4;
        unsafeAtomicAdd(cbp + 0, s[0]); unsafeAtomicAdd(cbp + 1, s[1]); unsafeAtomicAdd(cbp + 2, s[2]); unsafeAtomicAdd(cbp + 3, s[3]); }
    if (gw == 0) { float mq = fmaxf(fabsf(P.q_norm_w[lane]), fabsf(P.q_norm_w[lane + 64])); mq = wave_max(mq);
        float mc = wave_max(fmaxf(fabsf(P.k_norm_cmp_w[lane]), fabsf(P.k_norm_cmp_w[lane + 64])));
        float ms = wave_max(fmaxf(fabsf(P.k_norm_slc_w[lane]), fabsf(P.k_norm_slc_w[lane + 64])));
        float mw = wave_max(fmaxf(fabsf(P.k_norm_win_w[lane]), fabsf(P.k_norm_win_w[lane + 64])));
        const float c = 11.313708498984761f * 1.4426950408889634f * mq * 1.01f;
        if (lane == 0) { W.TAB[512] = c * mc; W.TAB[513] = c * ms; W.TAB[514] = c * mw; } }
}

__device__ __forceinline__ void phase_postz(const Params& P, const Ptrs& W, int gw, int nw) {
    const int tid = threadIdx.x, lane = tid & 63;
    const f32x2 wq = *(const f32x2*)(P.q_norm_w + 2 * lane), wks = *(const f32x2*)(P.k_norm_slc_w + 2 * lane), wkw = *(const f32x2*)(P.k_norm_win_w + 2 * lane);
    for (int t = gw; t < S_; t += nw) {
        bf16_t* zr = W.Z + (size_t)t * LDZ;
        float cs0 = 0.f, cs1 = 0.f, sn0 = 0.f, sn1 = 0.f;
        if (lane < 16) { const int i0 = (2 * lane) & 15; cs0 = W.COS[t * 16 + i0]; cs1 = W.COS[t * 16 + i0 + 1]; sn0 = W.SIN[t * 16 + i0]; sn1 = W.SIN[t * 16 + i0 + 1]; }
        unsigned uv[32];
#pragma unroll
        for (int v = 0; v < 32; ++v) { const int col = v < 24 ? OFF_Q + v * HD : (v < 28 ? OFF_KV + 2 * 512 + (v - 24) * HD : OFF_KV + 4 * 512 + (v - 28) * HD);
            uv[v] = *((const unsigned*)(zr + col) + lane); }
#pragma unroll
        for (int v = 0; v < 32; ++v) {
            const f32x2 ww = v < 24 ? wq : (v < 28 ? wks : wkw);
            const unsigned u = uv[v]; const float x0 = bf_lo(u), x1 = bf_hi(u);
            const float ss = wave_sum(x0 * x0 + x1 * x1);
            const float rstd = rsqrtf(ss * (1.0f / HD) + EPS);
            float y0 = x0 * rstd * ww[0], y1 = x1 * rstd * ww[1];
            const float p0 = __shfl_xor(y0, 8), p1 = __shfl_xor(y1, 8);
            if (lane < 8) { y0 = y0 * cs0 - p0 * sn0; y1 = y1 * cs1 - p1 * sn1; }
            else if (lane < 16) { y0 = y0 * cs0 + p0 * sn0; y1 = y1 * cs1 + p1 * sn1; }
            uv[v] = cvt_pk_bf16(y0, y1);
        }
        {
            const int gi = lane >> 4, wlen = 2 << gi, c0 = lane * 16; const int cnt = (t + 1) < wlen ? (t + 1) : wlen;
            float s[16];
#pragma unroll
            for (int i = 0; i < 16; ++i) s[i] = 0.f;
            float cur[16];
#pragma unroll
            for (int bt = 0; bt < 2; ++bt) {
                u32x4 ra[8], rb[8];
#pragma unroll
                for (int i = 0; i < 8; ++i) { const int ii = bt * 8 + i; const size_t row = (size_t)(ii < cnt ? t - ii : t);
                    ra[i] = *(const u32x4*)(W.Z + row * LDZ + c0); rb[i] = *(const u32x4*)(W.Z + row * LDZ + c0 + 8); }
#pragma unroll
                for (int i = 0; i < 8; ++i) { const int ii = bt * 8 + i; const float mk = ii < cnt ? 1.0f : 0.0f; const u32x4 a = ra[i], b = rb[i];
                    const float ev[16] = {bf_lo(a.x), bf_hi(a.x), bf_lo(a.y), bf_hi(a.y), bf_lo(a.z), bf_hi(a.z), bf_lo(a.w), bf_hi(a.w), bf_lo(b.x), bf_hi(b.x), bf_lo(b.y), bf_hi(b.y), bf_lo(b.z), bf_hi(b.z), bf_lo(b.w), bf_hi(b.w)};
#pragma unroll
                    for (int q = 0; q < 16; ++q) { s[q] += ev[q] * mk; if (ii == 0) cur[q] = ev[q]; } }
                if (bt == 0 && __all(cnt <= 8)) break;
            }
            const float rc = 1.0f / (float)cnt;
            u32x4 o0, o1;
            o0.x = cvt_pk_bf16(s[0] * rc - cur[0], s[1] * rc - cur[1]); o0.y = cvt_pk_bf16(s[2] * rc - cur[2], s[3] * rc - cur[3]);
            o0.z = cvt_pk_bf16(s[4] * rc - cur[4], s[5] * rc - cur[5]); o0.w = cvt_pk_bf16(s[6] * rc - cur[6], s[7] * rc - cur[7]);
            o1.x = cvt_pk_bf16(s[8] * rc - cur[8], s[9] * rc - cur[9]); o1.y = cvt_pk_bf16(s[10] * rc - cur[10], s[11] * rc - cur[11]);
            o1.z = cvt_pk_bf16(s[12] * rc - cur[12], s[13] * rc - cur[13]); o1.w = cvt_pk_bf16(s[14] * rc - cur[14], s[15] * rc - cur[15]);
            *(u32x4*)(W.M + (size_t)t * POOLW + c0) = o0; *(u32x4*)(W.M + (size_t)t * POOLW + c0 + 8) = o1;
        }
#pragma unroll
        for (int v = 0; v < 32; ++v) { const int col = v < 24 ? OFF_Q + v * HD : (v < 28 ? OFF_KV + 2 * 512 + (v - 24) * HD : OFF_KV + 4 * 512 + (v - 28) * HD);
            *((unsigned*)(zr + col) + lane) = uv[v]; }

    }
}

__device__ __forceinline__ void phase_cmpfin(const Params& P, const Ptrs& W) {
    const int tid = threadIdx.x, lane = tid & 63, gw = blockIdx.x * NWAVES + (tid >> 6), nw = gridDim.x * NWAVES;
    const f32x2 wk = *(const f32x2*)(P.k_norm_cmp_w + 2 * lane);
    for (int task = gw; task < 8192; task += nw) {
        const int tk = __builtin_amdgcn_readfirstlane(task);
        const int which = tk >> 12, g = (tk >> 10) & 3, n = tk & 1023;
        bf16_t* dst = (which ? W.VC : W.KC) + ((size_t)g * 1024 + n) * HD;
        if (n == 1023) { ((unsigned*)dst)[lane] = 0u; continue; }
        const float* h = W.H1 + (size_t)tk * 256; const float* w2 = which ? P.cmp_v_w2 : P.cmp_k_w2;
        float a0 = 0.f, a1 = 0.f;
        for (int j = 0; j < 256; ++j) { const float hj = h[j]; const f32x2 wv = *(const f32x2*)(w2 + j * HD + 2 * lane); a0 += hj * wv[0]; a1 += hj * wv[1]; }
        if (which == 0) {
            const float ss = wave_sum(a0 * a0 + a1 * a1); const float rstd = rsqrtf(ss * (1.0f / HD) + EPS);
            a0 = a0 * rstd * wk[0]; a1 = a1 * rstd * wk[1];
            const int tp = 16 * n + 31; const float p0 = __shfl_xor(a0, 8), p1 = __shfl_xor(a1, 8);
            if (lane < 16) { const int i0 = (2 * lane) & 15; const float cs0 = W.COS[tp * 16 + i0], cs1 = W.COS[tp * 16 + i0 + 1], sn0 = W.SIN[tp * 16 + i0], sn1 = W.SIN[tp * 16 + i0 + 1];
                if (lane < 8) { a0 = a0 * cs0 - p0 * sn0; a1 = a1 * cs1 - p1 * sn1; } else { a0 = a0 * cs0 + p0 * sn0; a1 = a1 * cs1 + p1 * sn1; } }
        }
        ((unsigned*)dst)[lane] = cvt_pk_bf16(a0, a1);
    }
}

__device__ __forceinline__ void phase_erstd(const Ptrs& W) {
    const int tid = threadIdx.x, lane = tid & 63, gw = blockIdx.x * NWAVES + (tid >> 6), nw = gridDim.x * NWAVES;
    u32x4 a[8], an[8];
    if (gw < S_) { const u32x4* sp = (const u32x4*)(W.ERAW + (size_t)gw * DM);
#pragma unroll
        for (int i = 0; i < 8; ++i) a[i] = sp[lane + 64 * i]; }
    for (int row = gw; row < S_; row += nw) {
        const int nr = row + nw < S_ ? row + nw : row;
        { const u32x4* sp = (const u32x4*)(W.ERAW + (size_t)nr * DM);
#pragma unroll
          for (int i = 0; i < 8; ++i) an[i] = sp[lane + 64 * i]; }
        float ss = 0.f;
#pragma unroll
        for (int i = 0; i < 8; ++i) {
            const float e0 = bf_lo(a[i].x), e1 = bf_hi(a[i].x), e2 = bf_lo(a[i].y), e3 = bf_hi(a[i].y), e4 = bf_lo(a[i].z), e5 = bf_hi(a[i].z), e6 = bf_lo(a[i].w), e7 = bf_hi(a[i].w);
            ss += e0 * e0 + e1 * e1 + e2 * e2 + e3 * e3 + e4 * e4 + e5 * e5 + e6 * e6 + e7 * e7; }
        ss = wave_sum(ss);
        if (lane == 0) W.ERSTD[row] = rsqrtf(ss * (1.0f / DM) + EPS);
#pragma unroll
        for (int i = 0; i < 8; ++i) a[i] = an[i];
    }
}

constexpr int N_PHASES = 11;
__device__ __forceinline__ Params kargs() {
#if defined(__HIP_DEVICE_COMPILE__)
    unsigned long long p = (unsigned long long)__builtin_amdgcn_kernarg_segment_ptr();
    asm volatile("" : "+s"(p));
    return *(const __attribute__((address_space(4))) Params*)p;
#else
    return Params{};
#endif
}
__device__ __forceinline__ Ptrs mkptrs(unsigned char* ws) {
    Ptrs W;
    W.Win = (bf16_t*)(ws + WS_WIN); W.Wo = (bf16_t*)(ws + WS_WO); W.Wfi = (bf16_t*)(ws + WS_WFI); W.Wfo = (bf16_t*)(ws + WS_WFO); W.Wg = (bf16_t*)(ws + WS_WG);
    W.Wple = (bf16_t*)(ws + WS_WPLE); W.Wpool = (bf16_t*)(ws + WS_WPOOL); W.Wc1k = (bf16_t*)(ws + WS_WC1K); W.Wc1v = (bf16_t*)(ws + WS_WC1V);
    W.XN = (bf16_t*)(ws + WS_XN); W.PB = (bf16_t*)(ws + WS_PB); W.Z = (bf16_t*)(ws + WS_Z); W.M = (bf16_t*)(ws + WS_M); W.KC = (bf16_t*)(ws + WS_KC); W.VC = (bf16_t*)(ws + WS_VC);
    W.MIX = (bf16_t*)(ws + WS_MIX); W.ACT = (bf16_t*)(ws + WS_ACT); W.ERAW = (bf16_t*)(ws + WS_ERAW);
    W.COS = (float*)(ws + WS_COS); W.SIN = (float*)(ws + WS_SIN); W.TAB = (float*)(ws + WS_TAB); W.G = (float*)(ws + WS_G); W.H1 = (float*)(ws + WS_H1); W.L = (float*)(ws + WS_L);
    W.OACC = (float*)(ws + WS_OACC); W.IMPP = (float*)(ws + WS_IMPP); W.IMPF = (float*)(ws + WS_IMPF); W.ERSTD = (float*)(ws + WS_ERSTD); W.BM = (unsigned*)(ws + WS_BM);
    return W;
}
__global__ void __launch_bounds__(NTHREADS, 2) fwd(Params Punused) {
    extern __shared__ __attribute__((aligned(16))) unsigned char lds_raw[];
    LAS unsigned char* lds = (LAS unsigned char*)lds_raw;
    const int tid = threadIdx.x;
    const int G = gridDim.x, bid = blockIdx.x;
    const int gw = bid * NWAVES + (tid >> 6), nw = G * NWAVES;

    if (tid < 16) ((LAS unsigned*)(lds + LDS_MISC))[tid] = 0u;
    __syncthreads();
    int lo, hi; XcdBarrier bar;
    { const Params P = kargs(); lo = P.ph_lo; hi = P.ph_hi;
      bar.bar = (unsigned*)(P.ws + WS_CTL); bar.x = 0; bar.st = (volatile LAS unsigned*)(lds + LDS_MISC);
      if (hi - lo > 1) bar = xcd_barrier_post((unsigned*)(P.ws + WS_CTL), (volatile LAS unsigned*)(lds + LDS_MISC)); }
#ifdef PH_MASK
#define IN(k) (((PH_MASK >> (k)) & 1) && lo <= (k) && (k) < hi)
#else
#define IN(k) (lo <= (k) && (k) < hi)
#endif
#define SEAM(k) do { if (IN(k) && IN((k) + 1)) xcd_barrier(bar); } while (0)
#define PHASE_VARS const Params P = kargs(); const Ptrs W = mkptrs(P.ws); (void)W;
#define ATT_ARGS att::AttnArgs AA{W.Z, W.KC, W.VC, W.G, W.L, W.OACC, W.MIX, W.BM, W.TAB};

    if (IN(0)) { PHASE_VARS REP(0) { phase_prologue(P, W, lds); } SEAM(0); }
    if (IN(1)) {
        PHASE_VARS
        { pg8::GStd g{(const char*)W.XN, (const char*)W.Win, DM, DM, DM / 64}; pg8::StaticOrder S; S.init(S_ / 256, POOLW / 256, G, bid);
          pg8::EpiBf16 E{W.Z, LDZ}; pg8::gemm_phase(lds, g, S, E); }
        { pg8::GStd g{(const char*)(P.ws + WS_XN8), (const char*)(P.ws + WS_WIN8), DM / 2, DM / 2, DM / 128}; pg8::StaticOrder S; S.init(S_ / 256, (OFF_G - POOLW) / 256, G, bid);
          pg8::EpiBf16S E{W.Z + POOLW, LDZ, 1.0f / WG8_SCALE}; pg8::gemm_phase<pg8::GStd, pg8::EpiBf16S, true>(lds, g, S, E); }
        SEAM(1);
    }
    if (IN(2)) {
        PHASE_VARS
        if (G > 64) {
            if (bid < 32) { pg8::GCmp g{(const char*)W.Z, (const char*)W.Wc1k, (const char*)W.Wc1v, 16 * LDZ, 4096, 64}; pg8::StaticOrder S; S.init(32, 1, 32, bid);
                pg8::EpiCmpGelu E{W.H1, (const float*)(P.ws + WS_CBIAS)}; pg8::gemm_phase(lds, g, S, E); }
            else if (bid < 96) {
                pg8::GStd g{(const char*)W.XN, (const char*)(W.Win + (size_t)OFF_G * DM), DM, DM, DM / 64}; pg8::StaticOrder S; S.init(S_ / 256, 1, 64, bid - 32);
                pg8::EpiBf16 E{W.Z + OFF_G, LDZ}; pg8::gemm_phase(lds, g, S, E); }
            else phase_postz(P, W, (bid - 96) * NWAVES + (tid >> 6), (G - 96) * NWAVES);
        } else {
            { pg8::GStd g{(const char*)W.XN, (const char*)(W.Win + (size_t)OFF_G * DM), DM, DM, DM / 64}; pg8::StaticOrder S; S.init(S_ / 256, 1, G, bid);
              pg8::EpiBf16 E{W.Z + OFF_G, LDZ}; pg8::gemm_phase(lds, g, S, E); }
            { pg8::GCmp g{(const char*)W.Z, (const char*)W.Wc1k, (const char*)W.Wc1v, 16 * LDZ, 4096, 64}; pg8::StaticOrder S; S.init(32, 1, G, bid);
              pg8::EpiCmpGelu E{W.H1, (const float*)(P.ws + WS_CBIAS)}; pg8::gemm_phase(lds, g, S, E); }
            phase_postz(P, W, gw, nw);
        }
        SEAM(2);
    }
    if (IN(3)) {
        PHASE_VARS
        {
            const size_t i0 = (size_t)bid * NTHREADS + tid, st = (size_t)G * NTHREADS, NG = (size_t)S_ * NGATE;
            for (size_t ib = i0; ib < NG; ib += 9 * st) { float zv[9];
#pragma unroll
                for (int k = 0; k < 9; ++k) { size_t i = ib + k * st; if (i >= NG) i = NG - 1; const int t = (int)(i / NGATE), c = (int)(i % NGATE); zv[k] = bf2f(W.Z[(size_t)t * LDZ + OFF_G + c]); }
#pragma unroll
                for (int k = 0; k < 9; ++k) { const size_t i = ib + k * st; if (i < NG) W.G[i] = sigmoidf_(zv[k]); } } }
        phase_cmpfin(P, W);
        { pg8::GPool g{(const char*)W.M, (const char*)W.Wpool, POOLW, 256, 4}; pg8::StaticOrder S; S.init(S_ / 256, 4, G, bid);
          pg8::EpiBf16Scale E{W.MIX, DM, P.pool_scale}; pg8::gemm_phase(lds, g, S, E); }
        SEAM(3);
    }
    if (IN(4)) {
        PHASE_VARS ATT_ARGS
        REP(4)
        for (int base = 0, rnd = 0; base < 1536; base += G, ++rnd) {
            int qt, g, hp;
            if (G == 256) { const int x = bid & 7, r = bid >> 3, qp = (rnd / 3) ? 63 - r : r; if (rnd >= 6) break; g = x & 3; qt = 2 * qp + (x >> 2); hp = rnd % 3; }
            else { const int Lu = base + ((rnd & 1) ? G - 1 - bid : bid); if (Lu >= 1536) continue; qt = Lu / 12; const int rem = Lu % 12; g = rem / 3; hp = rem % 3; }
            att::attn_unit<att::MODE_CMP>(AA, (LAS char*)lds, qt, g, hp);
            asm volatile("s_waitcnt vmcnt(0)" ::: "memory");
            att::attn_unit<att::MODE_WIN>(AA, (LAS char*)lds, qt, g, hp);
            if (G == 256 && hp == 2) {
                asm volatile("s_waitcnt vmcnt(0)" ::: "memory");
                const int tqi = qt * 8 + (tid >> 6);
                att::imp_task(AA, W.IMPP, W.IMPF, tqi, g);
                asm volatile("s_waitcnt vmcnt(0)" ::: "memory");
                f32x4 pp, ff, pn, fn; att::topk_load(W.IMPP, W.IMPF, tqi * 16, g, pp, ff);
                for (int q = 0; q < 16; ++q) { att::topk_load(W.IMPP, W.IMPF, tqi * 16 + (q < 15 ? q + 1 : q), g, pn, fn); att::topk_task(pp, ff, W.BM, tqi * 16 + q, g); pp = pn; ff = fn; } } }
        if (G != 256) SEAM(4);
    }
    if (IN(5)) {
        PHASE_VARS ATT_ARGS
        if (G != 256)
        for (int k = gw, r = 0; k < 4096; k += nw, ++r) { const int hiT = (r + 1) * nw < 4096 ? (r + 1) * nw : 4096;
            const int task = (r & 1) ? hiT - 1 - (k - r * nw) : k;
            att::imp_task(AA, W.IMPP, W.IMPF, task >> 2, task & 3);
            asm volatile("s_waitcnt vmcnt(0)" ::: "memory");
            { const int tb = (task >> 2) * 16, gg = task & 3; f32x4 pp, ff, pn, fn;
              att::topk_load(W.IMPP, W.IMPF, tb, gg, pp, ff);
              for (int q = 0; q < 16; ++q) { att::topk_load(W.IMPP, W.IMPF, tb + (q < 15 ? q + 1 : q), gg, pn, fn); att::topk_task(pp, ff, W.BM, tb + q, gg); pp = pn; ff = fn; } } }
        SEAM(5);
    }
    if (IN(6)) {
        PHASE_VARS ATT_ARGS
#if SLC16
        for (int base = 0, rnd = 0; base < 1024 + G; base += G, ++rnd) {
            int ut, g;
            if (G == 256) { const int x = bid & 7, r = bid >> 3, k = rnd * 32 + ((rnd & 1) ? 31 - r : r); if (k >= 128) break; g = x & 3; ut = 255 - (2 * k + (x >> 2)); }
            else { const int Lu = base + ((rnd & 1) ? G - 1 - bid : bid); if (Lu >= 1024) continue; ut = 255 - Lu / 4; g = Lu % 4; }
            att::slc16_unit(AA, (LAS char*)lds, ut, g); }
#else
        REP(6)
        for (int base = 0, rnd = 0; base < 1640 + G; base += G, ++rnd) {
            int ut, g;
            if (G == 256) { const int x = bid & 7, r = bid >> 3, k = rnd * 32 + ((rnd & 1) ? 31 - r : r); if (k >= 205) break; g = x & 3; ut = 409 - (2 * k + (x >> 2)); }
            else { const int Lu = base + ((rnd & 1) ? G - 1 - bid : bid); if (Lu >= 1640) continue; ut = 409 - Lu / 4; g = Lu % 4; }
            att::attn_unit<att::MODE_SLC>(AA, (LAS char*)lds, ut, g, 0); }
#endif
        SEAM(6);
    }
    if (IN(7)) {
        PHASE_VARS
        { pg8::GStd g{(const char*)W.MIX, (const char*)W.Wo, DM, DM, DM / 64}; pg8::StaticOrder S; S.init(S_ / 256, DM / 256, G, bid);
          pg8::EpiResNorm E{P.x, P.out, W.XN, P.norm2_w, (float*)(P.ws + WS_SSQ1), DM}; pg8::gemm_phase(lds, g, S, E); }
        { pg8::GStd g{(const char*)W.PB, (const char*)W.Wple, PLE, PLE, PLE / 64}; pg8::StaticOrder S; S.init(S_ / 256, DM / 256, G, bid);
          pg8::EpiBf16Ssq E{W.ERAW, DM, (float*)(P.ws + WS_SSQ3)}; pg8::gemm_phase(lds, g, S, E); }
        SEAM(7);
    }
    if (IN(8)) {
        PHASE_VARS
        pg8::GFfn g{(const char*)W.XN, (const char*)W.Wfi, DM, DM, DM / 64}; pg8::StaticOrder S; S.init(65, DFF / 128, G, bid);
        pg8::EpiFfn E{W.ACT, P.conv_w, P.conv_b, (LAS float*)(lds + LDS_XCH), (const float*)(P.ws + WS_SSQ1)}; REP(8) { pg8::gemm_phase(lds, g, S, E); } SEAM(8);
    }
    if (IN(9)) {
        PHASE_VARS
        pg8::GStd g{(const char*)W.ACT, (const char*)W.Wfo, DFF, DFF, DFF / 64}; pg8::StaticOrder S; S.init(S_ / 256, DM / 256, G, bid);
        pg8::EpiResNormF8 E{P.out, P.out, W.XN, P.ple_gate_norm_w, (float*)(P.ws + WS_SSQ2), DM}; pg8::gemm_phase(lds, g, S, E); SEAM(9);
    }
    if (IN(10)) {
        PHASE_VARS
        pg8::GStd g{(const char*)W.XN, (const char*)W.Wg, DM / 2, DM / 2, DM / 128}; pg8::StaticOrder S; S.init(S_ / 256, DM / 256, G, bid);
        pg8::EpiGate E{P.out, W.ERAW, (const float*)(P.ws + WS_SSQ3), P.ple_norm_w, (const float*)(P.ws + WS_SSQ2), DM, 1.0f / WG8_SCALE};
        pg8::gemm_phase<pg8::GStd, pg8::EpiGate, true>(lds, g, S, E);
    }
#undef IN
#undef SEAM
}

extern "C" void kernel_launch(void* const* d_in, const int* in_sizes, int n_in, void* d_out, int out_size, void* d_ws, size_t ws_size, hipStream_t stream) {
    static int grid = 0;
    if (grid == 0) {
        if (n_in != 27 || in_sizes[0] != S_ * DM || out_size != S_ * DM || ws_size < WS_NEED) {
            fprintf(stderr, "kernel_launch: unexpected shapes (n_in %d, in0 %d, out %d, ws %zu < %zu); nothing launched\n", n_in, n_in > 0 ? in_sizes[0] : -1, out_size, ws_size, (size_t)WS_NEED); grid = -1; return; }
        int dev = 0, cus = 0, per_cu = 0;
        if (hipGetDevice(&dev) != hipSuccess || hipDeviceGetAttribute(&cus, hipDeviceAttributeMultiprocessorCount, dev) != hipSuccess) { grid = -1; return; }
        if (hipFuncSetAttribute((const void*)fwd, hipFuncAttributeMaxDynamicSharedMemorySize, LDS_BYTES) != hipSuccess) { fprintf(stderr, "kernel_launch: hipFuncSetAttribute failed\n"); grid = -1; return; }
        if (hipOccupancyMaxActiveBlocksPerMultiprocessor(&per_cu, (const void*)fwd, NTHREADS, LDS_BYTES) != hipSuccess || per_cu < 1) { fprintf(stderr, "kernel_launch: occupancy query says %d\n", per_cu); (void)hipGetLastError(); }
        grid = cus > 256 ? 256 : cus;
    }
    if (grid < 0) return;
    (void)hipMemsetAsync((char*)d_ws + WS_CTL, 0, CTL_BYTES, stream);
    Params P{};
    const float** fp = (const float**)&P;
    P.x = (const float*)d_in[0]; P.p = (const float*)d_in[1]; P.positions = (const int*)d_in[2]; P.norm1_w = (const float*)d_in[3]; P.w_in = (const float*)d_in[4];
    P.w_pool = (const float*)d_in[5]; P.pool_scale = (const float*)d_in[6]; P.q_norm_w = (const float*)d_in[7]; P.k_norm_cmp_w = (const float*)d_in[8];
    P.k_norm_slc_w = (const float*)d_in[9]; P.k_norm_win_w = (const float*)d_in[10]; P.cmp_pos_k = (const float*)d_in[11]; P.cmp_pos_v = (const float*)d_in[12];
    P.cmp_k_w1 = (const float*)d_in[13]; P.cmp_k_w2 = (const float*)d_in[14]; P.cmp_v_w1 = (const float*)d_in[15]; P.cmp_v_w2 = (const float*)d_in[16];
    P.w_o = (const float*)d_in[17]; P.norm2_w = (const float*)d_in[18]; P.w_ffn_in = (const float*)d_in[19]; P.conv_w = (const float*)d_in[20]; P.conv_b = (const float*)d_in[21];
    P.w_ffn_out = (const float*)d_in[22]; P.w_ple_proj = (const float*)d_in[23]; P.ple_norm_w = (const float*)d_in[24]; P.ple_gate_norm_w = (const float*)d_in[25]; P.w_ple_gate = (const float*)d_in[26];
    (void)fp;
    P.out = (float*)d_out; P.ws = (unsigned char*)d_ws;
#if MK_ONE_LAUNCH
    P.ph_lo = 0; P.ph_hi = N_PHASES;
    hipLaunchKernelGGL(fwd, dim3(grid), dim3(NTHREADS), LDS_BYTES, stream, P);
#else
    for (int ph = 0; ph < N_PHASES; ++ph) { P.ph_lo = ph; P.ph_hi = ph + 1; hipLaunchKernelGGL(fwd, dim3(grid), dim3(NTHREADS), LDS_BYTES, stream, P); }
#endif
    const hipError_t le = hipPeekAtLastError();
    if (le != hipSuccess) fprintf(stderr, "kernel_launch: launch failed: %s\n", hipGetErrorName(le));
}
```

```cpp
#include <hip/hip_runtime.h>
#include <cstdio>
#include <cstdint>

#ifndef PROBE_DBL
#define PROBE_DBL 0
#endif
#define REP(k) _Pragma("unroll") for (int rep_ = 0; rep_ < 1 + ((PROBE_DBL >> (k)) & 1); ++rep_)
#ifndef SLC16
#define SLC16 1
#endif
#ifndef MK_ONE_LAUNCH
#define MK_ONE_LAUNCH 1
#endif

#define LAS __attribute__((address_space(3)))
typedef unsigned short bf16_t;
typedef short bf16x8 __attribute__((ext_vector_type(8)));
typedef short s16x4 __attribute__((ext_vector_type(4)));
typedef float f32x2 __attribute__((ext_vector_type(2)));
typedef float f32x4 __attribute__((ext_vector_type(4)));
typedef float f32x16 __attribute__((ext_vector_type(16)));
typedef unsigned u32x2 __attribute__((ext_vector_type(2)));
typedef unsigned u32x4 __attribute__((ext_vector_type(4)));
typedef int i32x4 __attribute__((ext_vector_type(4)));
typedef int i32x8 __attribute__((ext_vector_type(8)));

constexpr int S_ = 16384, DM = 4096, INW = 7240, LDZ = 7424, POOLW = 1024, NH = 24, NKV = 4, HPG = 6, HD = 128;
constexpr int OFF_Q = 1024, OFF_KV = 4096, OFF_G = 7168, DFF = 11008, NFI = 22016, PLE = 256, NGATE = 72;
constexpr int ZROWS = S_ + 64, XNROWS = S_ + 256, CHUNK = 8192;
constexpr float EPS = 1e-6f;
constexpr float SM_C = 0.08838834764831845f * 1.4426950408889634f;
constexpr int NWAVES = 8, NTHREADS = 512;
constexpr float WG8_SCALE = 128.0f;

constexpr size_t al256(size_t x) { return (x + 255) / 256 * 256; }
constexpr size_t WS_CTL   = 0;
constexpr size_t CTL_BYTES = 262144;
constexpr size_t WS_CBIAS = WS_CTL + 32768;
constexpr size_t WS_SSQ1 = WS_CTL + 65536, WS_SSQ2 = WS_CTL + 131072, WS_SSQ3 = WS_CTL + 196608;
constexpr size_t WS_WIN   = WS_CTL + CTL_BYTES;
constexpr size_t WS_WO    = WS_WIN + al256((size_t)LDZ * DM * 2);
constexpr size_t WS_WFI   = WS_WO + al256((size_t)DM * DM * 2);
constexpr size_t WS_WFO   = WS_WFI + al256((size_t)NFI * DM * 2);
constexpr size_t WS_WG    = WS_WFO + al256((size_t)DM * DFF * 2);
constexpr size_t WS_WPLE  = WS_WG + al256((size_t)DM * DM * 2);
constexpr size_t WS_WPOOL = WS_WPLE + al256((size_t)DM * PLE * 2);
constexpr size_t WS_WC1K  = WS_WPOOL + al256((size_t)1024 * 256 * 2);
constexpr size_t WS_WC1V  = WS_WC1K + al256((size_t)256 * 4096 * 2);
constexpr size_t WS_COS   = WS_WC1V + al256((size_t)256 * 4096 * 2);
constexpr size_t WS_SIN   = WS_COS + al256((size_t)S_ * 16 * 4);
constexpr size_t WS_TAB   = WS_SIN + al256((size_t)S_ * 16 * 4);
constexpr size_t WS_XNP   = WS_TAB + 4096;
constexpr size_t WS_XN    = WS_XNP + (size_t)2 * DM * 2;
constexpr size_t WS_PB    = WS_XN + al256((size_t)XNROWS * DM * 2);
constexpr size_t WS_XN8   = WS_PB + al256((size_t)S_ * PLE * 2);
constexpr size_t WS_WIN8  = WS_XN8 + al256((size_t)S_ * DM);
constexpr size_t WS_R     = WS_WIN8 + al256((size_t)(OFF_G - POOLW) * DM);
constexpr size_t WS_Z     = WS_R;
constexpr size_t WS_M     = WS_Z + al256((size_t)ZROWS * LDZ * 2);
constexpr size_t WS_G     = WS_M + al256((size_t)S_ * POOLW * 2);
constexpr size_t WS_H1    = WS_G + al256((size_t)S_ * NGATE * 4);
constexpr size_t WS_KC    = WS_H1 + al256((size_t)8192 * 256 * 4);
constexpr size_t WS_VC    = WS_KC + al256((size_t)4 * 1024 * 128 * 2);
constexpr size_t WS_L     = WS_VC + al256((size_t)4 * 1024 * 128 * 2);
constexpr size_t WS_OACC  = WS_L + al256((size_t)S_ * NH * 4);
constexpr size_t WS_IMPP  = WS_OACC + al256((size_t)S_ * 3072 * 4);
constexpr size_t WS_IMPF  = WS_IMPP + al256((size_t)S_ * 4 * 256 * 4);
constexpr size_t WS_BM    = WS_IMPF + al256((size_t)S_ * 4 * 256 * 4);
constexpr size_t WS_MIX   = WS_BM + al256((size_t)S_ * 4 * 8 * 4);
constexpr size_t WS_END_A = WS_MIX + al256((size_t)S_ * DM * 2);
constexpr size_t WS_ERAW  = WS_R;
constexpr size_t WS_ACT   = WS_ERAW + al256((size_t)S_ * DM * 2);
constexpr size_t WS_ERSTD = WS_ACT + al256((size_t)S_ * DFF * 2);
constexpr size_t WS_END_B = WS_ERSTD + al256((size_t)S_ * 4);
static_assert(WS_ERAW + (size_t)S_ * DM * 2 <= WS_Z + (size_t)ZROWS * LDZ * 2, "eraw must fit inside the dead z region while mix is still being read");
constexpr size_t WS_NEED  = WS_END_A > WS_END_B ? WS_END_A : WS_END_B;
static_assert(WS_NEED <= (size_t)1440000000, "workspace map exceeds the guaranteed 4 x largest-tensor bytes");

constexpr int LDS_STAGE = 131072;
constexpr int LDS_XCH   = LDS_STAGE + 64;
constexpr int LDS_MISC  = 147456;
constexpr int LDS_BYTES = LDS_MISC + 64;

__device__ __forceinline__ unsigned cvt_pk_bf16(float lo, float hi) { unsigned r; asm volatile("v_cvt_pk_bf16_f32 %0, %1, %2" : "=v"(r) : "v"(lo), "v"(hi)); return r; }
__device__ __forceinline__ float bf_lo(unsigned u) { return __uint_as_float(u << 16); }
__device__ __forceinline__ float bf_hi(unsigned u) { return __uint_as_float(u & 0xffff0000u); }
__device__ __forceinline__ float bf2f(bf16_t b) { return __uint_as_float(((unsigned)b) << 16); }
__device__ __forceinline__ float wave_sum(float v) {
#pragma unroll
    for (int o = 32; o >= 1; o >>= 1) v += __shfl_xor(v, o);
    return v;
}
__device__ __forceinline__ float wave_max(float v) {
#pragma unroll
    for (int o = 32; o >= 1; o >>= 1) v = fmaxf(v, __shfl_xor(v, o));
    return v;
}
__device__ __forceinline__ float sigmoidf_(float x) { return __builtin_amdgcn_rcpf(1.0f + __expf(-x)); }

#define XB_TMO      128
#define XB_XCNT(j)  (256  + 64 * (j))
#define XB_XSUB(j)  (1280 + 64 * (j))
#define XB_XGEN(j)  (2304 + 64 * (j))
#define XB_TOP      3328
#define XB_TOPGEN   3392
#define XCD_BAR_WORDS 3456
#define XB_SPIN_CAP (1u << 18)
__device__ __forceinline__ unsigned xb_ld(unsigned* p)              { return __hip_atomic_load(p, __ATOMIC_RELAXED, __HIP_MEMORY_SCOPE_AGENT); }
__device__ __forceinline__ unsigned xb_add(unsigned* p, unsigned v) { return __hip_atomic_fetch_add(p, v, __ATOMIC_RELAXED, __HIP_MEMORY_SCOPE_AGENT); }
__device__ __forceinline__ unsigned xb_xcc_id() { return (unsigned)__builtin_amdgcn_s_getreg((3 << 11) | 20) & 0xFu; }
#define XB_SPIN(cond, bar) do { unsigned _sp = 0; while (cond) { __builtin_amdgcn_s_sleep(1); \
    if ((++_sp & 255u) == 0u) { if (xb_ld(&(bar)[XB_TMO])) break; if (_sp > XB_SPIN_CAP) { atomicAdd(&(bar)[XB_TMO], 1u); break; } } } } while (0)
struct XcdBarrier { unsigned* bar; unsigned x; volatile LAS unsigned* st; };
__device__ __forceinline__ XcdBarrier xcd_barrier_post(unsigned* bar, volatile LAS unsigned* st) {
    XcdBarrier b; b.bar = bar; b.x = xb_xcc_id(); b.st = st;
    if (threadIdx.x == 0) (void)xb_add(&bar[XB_XCNT(b.x)], 1u);
    return b;
}
__device__ __forceinline__ void xcd_barrier_complete(unsigned* bar, unsigned x, unsigned& nloc, unsigned& nx) {
    const unsigned G = gridDim.x * gridDim.y * gridDim.z;
    unsigned sum, cnt, mine, sp = 0u;
    for (;;) {
        sum = 0u; cnt = 0u; mine = 0u;
#pragma unroll
        for (unsigned j = 0; j < 16; ++j) { const unsigned c = xb_ld(&bar[XB_XCNT(j)]); sum += c; cnt += (c > 0u) ? 1u : 0u; mine = (j == x) ? c : mine; }
        if (sum == G) break;
        __builtin_amdgcn_s_sleep(1);
        if ((++sp & 255u) == 0u) { if (xb_ld(&bar[XB_TMO])) break; if (sp > XB_SPIN_CAP) { atomicAdd(&bar[XB_TMO], 1u); break; } }
    }
    nloc = mine > 0u ? mine : 1u; nx = cnt > 0u ? cnt : 1u;
}
__device__ __forceinline__ void xcd_barrier(const XcdBarrier& b) {
    asm volatile("s_waitcnt vmcnt(0)" ::: "memory");
    __syncthreads();
    if (threadIdx.x == 0) {
        unsigned* bar = b.bar;
        __builtin_amdgcn_s_waitcnt(0);
        unsigned nloc = b.st[0], nx = b.st[1];
        if (nloc == 0u) { xcd_barrier_complete(bar, b.x, nloc, nx); b.st[0] = nloc; b.st[1] = nx; }
        const unsigned old = xb_add(&bar[XB_XSUB(b.x)], 1u);
        const unsigned gen = old / nloc;
        if (old + 1u == (gen + 1u) * nloc) {
            __builtin_amdgcn_fence(__ATOMIC_RELEASE, "agent");
            asm volatile("s_waitcnt vmcnt(0)" ::: "memory");
            const unsigned og = xb_add(&bar[XB_TOP], 1u);
            const unsigned tg = og / nx;
            if (og + 1u == (tg + 1u) * nx) xb_add(&bar[XB_TOPGEN], 1u);
            else XB_SPIN(xb_ld(&bar[XB_TOPGEN]) == tg, bar);
            __builtin_amdgcn_fence(__ATOMIC_ACQUIRE, "agent");
            xb_add(&bar[XB_XGEN(b.x)], 1u);
            asm volatile("s_waitcnt vmcnt(0)" ::: "memory");
        } else {
            XB_SPIN(xb_ld(&bar[XB_XGEN(b.x)]) == gen, bar);
            __builtin_amdgcn_fence(__ATOMIC_ACQUIRE, "agent");
            asm volatile("s_waitcnt vmcnt(0)" ::: "memory");
        }
    }
    __syncthreads();
}

struct Params {
    const float* x; const float* p; const int* positions; const float* norm1_w; const float* w_in; const float* w_pool; const float* pool_scale;
    const float* q_norm_w; const float* k_norm_cmp_w; const float* k_norm_slc_w; const float* k_norm_win_w; const float* cmp_pos_k; const float* cmp_pos_v;
    const float* cmp_k_w1; const float* cmp_k_w2; const float* cmp_v_w1; const float* cmp_v_w2; const float* w_o; const float* norm2_w; const float* w_ffn_in;
    const float* conv_w; const float* conv_b; const float* w_ffn_out; const float* w_ple_proj; const float* ple_norm_w; const float* ple_gate_norm_w; const float* w_ple_gate;
    float* out; unsigned char* ws; int ph_lo, ph_hi;
};

namespace pg8 {
constexpr int BM = 256, BK = 64, HALF = 128, HTB = HALF * BK * 2, STAGE_BYTES = 8 * HTB, NXCD = 8, WGM = 8;
__host__ __device__ __forceinline__ int lds_byte(int r, int c) { const int st = (r >> 4) * 2 + (c >> 5), rr = r & 15, cc = c & 31, ob = rr * 64 + cc * 2; return st * 1024 + (ob ^ (((ob >> 9) & 1) << 5)); }
__host__ __device__ __forceinline__ void stage_rc(int b, int& R, int& C) { const int st = b / 1024, sb = b % 1024, swz = sb ^ (((sb >> 9) & 1) << 5); R = (st >> 1) * 16 + swz / 64; C = (st & 1) * 32 + (swz % 64) / 2; }
__host__ __device__ __forceinline__ int perm32(int rho) { const int n = rho >> 4, i = rho & 15; return 8 * (i >> 2) + 4 * n + (i & 3); }
struct Unit { int pm, pn; };

struct StaticOrder {
    int nM, nN, nwg, G, c;
    __device__ void init(int nM_, int nN_, int G_, int c_) { nM = nM_; nN = nN_; nwg = nM * nN; G = G_; c = c_; }
    __device__ bool next(int i, Unit& u) const {
        const long L = (long)i * G + c; if (L >= nwg) return false;
        int wgid = (int)L; { const int q = nwg / NXCD, r = nwg % NXCD, xcd = wgid % NXCD, off = wgid / NXCD; wgid = (xcd < r ? xcd * (q + 1) : r * (q + 1) + (xcd - r) * q) + off; }
        const int nig = WGM * nN, gid = wgid / nig, fm = gid * WGM, gsz = (nM - fm) < WGM ? (nM - fm) : WGM;
        u.pm = fm + ((wgid % nig) % gsz); u.pn = (wgid % nig) / gsz; return true;
    }
};

struct GStd {
    const char* A; const char* B; unsigned lda, ldb; int nt;
    __device__ __forceinline__ const char* a_base(const Unit& u) const { return A + (size_t)u.pm * 256 * lda * 2; }
    __device__ __forceinline__ const char* b_base(const Unit& u) const { return B + (size_t)u.pn * 256 * ldb * 2; }
    __device__ __forceinline__ size_t kpairA() const { return 256; }
};
struct GPool {
    const char* A; const char* B; unsigned lda, ldb; int nt;
    __device__ __forceinline__ const char* a_base(const Unit& u) const { return A + (size_t)u.pm * 256 * lda * 2 + (size_t)u.pn * 512; }
    __device__ __forceinline__ const char* b_base(const Unit& u) const { return B + (size_t)u.pn * 256 * ldb * 2; }
    __device__ __forceinline__ size_t kpairA() const { return 256; }
};
struct GCmp {
    const char* Z; const char* Bk; const char* Bv; unsigned lda, ldb; int nt;
    __device__ __forceinline__ const char* a_base(const Unit& u) const { const int which = u.pm >> 4, g = (u.pm >> 2) & 3, rt = u.pm & 3;
        return Z + (size_t)(OFF_KV + which * 512 + g * 128) * 2 + (size_t)rt * 256 * lda * 2; }
    __device__ __forceinline__ const char* b_base(const Unit& u) const { return (u.pm >> 4) ? Bv : Bk; }
    __device__ __forceinline__ size_t kpairA() const { return (size_t)LDZ * 2; }
};

struct EpiBf16 {
    static constexpr bool PERM = true;
    bf16_t* O; int ldc;
    __device__ __forceinline__ void operator()(const f32x4 (&acc)[2][2][4][2], const Unit& u, int wr, int wc, int fr, int fq) const {
        const int row0 = u.pm * BM + wr * 64 + fr, col0 = u.pn * BM + wc * 32 + 8 * fq;
#pragma unroll
        for (int ai = 0; ai < 2; ++ai)
#pragma unroll
            for (int m = 0; m < 4; ++m) { bf16_t* rowp = O + (size_t)(row0 + ai * HALF + m * 16) * ldc + col0;
#pragma unroll
                for (int bj = 0; bj < 2; ++bj) { const f32x4 v0 = acc[ai][bj][m][0], v1 = acc[ai][bj][m][1];
                    u32x4 w; w.x = cvt_pk_bf16(v0[0], v0[1]); w.y = cvt_pk_bf16(v0[2], v0[3]); w.z = cvt_pk_bf16(v1[0], v1[1]); w.w = cvt_pk_bf16(v1[2], v1[3]);
                    *(u32x4*)(rowp + bj * HALF) = w; } }
    }
};
struct EpiBf16S {
    static constexpr bool PERM = true;
    bf16_t* O; int ldc; float s;
    __device__ __forceinline__ void operator()(const f32x4 (&acc)[2][2][4][2], const Unit& u, int wr, int wc, int fr, int fq) const {
        const int row0 = u.pm * BM + wr * 64 + fr, col0 = u.pn * BM + wc * 32 + 8 * fq;
#pragma unroll
        for (int ai = 0; ai < 2; ++ai)
#pragma unroll
            for (int m = 0; m < 4; ++m) { bf16_t* rowp = O + (size_t)(row0 + ai * HALF + m * 16) * ldc + col0;
#pragma unroll
                for (int bj = 0; bj < 2; ++bj) { const f32x4 v0 = acc[ai][bj][m][0] * s, v1 = acc[ai][bj][m][1] * s;
                    u32x4 w; w.x = cvt_pk_bf16(v0[0], v0[1]); w.y = cvt_pk_bf16(v0[2], v0[3]); w.z = cvt_pk_bf16(v1[0], v1[1]); w.w = cvt_pk_bf16(v1[2], v1[3]);
                    *(u32x4*)(rowp + bj * HALF) = w; } }
    }
};
struct EpiBf16Ssq {
    static constexpr bool PERM = true;
    bf16_t* O; int ldc; float* ssq;
    __device__ __forceinline__ void operator()(const f32x4 (&acc)[2][2][4][2], const Unit& u, int wr, int wc, int fr, int fq) const {
        const int row0 = u.pm * BM + wr * 64 + fr, col0 = u.pn * BM + wc * 32 + 8 * fq;
#pragma unroll
        for (int ai = 0; ai < 2; ++ai)
#pragma unroll
            for (int m = 0; m < 4; ++m) { const int row = row0 + ai * HALF + m * 16; bf16_t* rowp = O + (size_t)row * ldc + col0; float s = 0.f;
#pragma unroll
                for (int bj = 0; bj < 2; ++bj) { const f32x4 v0 = acc[ai][bj][m][0], v1 = acc[ai][bj][m][1];
                    s += v0[0] * v0[0] + v0[1] * v0[1] + v0[2] * v0[2] + v0[3] * v0[3] + v1[0] * v1[0] + v1[1] * v1[1] + v1[2] * v1[2] + v1[3] * v1[3];
                    u32x4 w; w.x = cvt_pk_bf16(v0[0], v0[1]); w.y = cvt_pk_bf16(v0[2], v0[3]); w.z = cvt_pk_bf16(v1[0], v1[1]); w.w = cvt_pk_bf16(v1[2], v1[3]);
                    *(u32x4*)(rowp + bj * HALF) = w; }
                s += __shfl_xor(s, 16); s += __shfl_xor(s, 32);
                if (fq == 0) unsafeAtomicAdd(ssq + row, s); }
    }
};
struct EpiBf16Scale {
    static constexpr bool PERM = true;
    bf16_t* O; int ldc; const float* colscale;
    __device__ __forceinline__ void operator()(const f32x4 (&acc)[2][2][4][2], const Unit& u, int wr, int wc, int fr, int fq) const {
        const int row0 = u.pm * BM + wr * 64 + fr, col0 = u.pn * BM + wc * 32 + 8 * fq;
#pragma unroll
        for (int bj = 0; bj < 2; ++bj) { const f32x4 s0 = *(const f32x4*)(colscale + col0 + bj * HALF), s1 = *(const f32x4*)(colscale + col0 + bj * HALF + 4);
#pragma unroll
            for (int ai = 0; ai < 2; ++ai)
#pragma unroll
                for (int m = 0; m < 4; ++m) { bf16_t* rowp = O + (size_t)(row0 + ai * HALF + m * 16) * ldc + col0;
                    const f32x4 v0 = acc[ai][bj][m][0] * s0, v1 = acc[ai][bj][m][1] * s1;
                    u32x4 w; w.x = cvt_pk_bf16(v0[0], v0[1]); w.y = cvt_pk_bf16(v0[2], v0[3]); w.z = cvt_pk_bf16(v1[0], v1[1]); w.w = cvt_pk_bf16(v1[2], v1[3]);
                    *(u32x4*)(rowp + bj * HALF) = w; } }
    }
};
struct EpiResF32 {
    static constexpr bool PERM = false;
    const float* base; float* C; int ldc; int row_off;
    __device__ __forceinline__ void operator()(const f32x4 (&acc)[2][2][4][2], const Unit& u, int wr, int wc, int fr, int fq) const {
        const int row0 = u.pm * BM + wr * 64 + fr + row_off, col0 = u.pn * BM + wc * 32 + 4 * fq;
#pragma unroll
        for (int ai = 0; ai < 2; ++ai)
#pragma unroll
            for (int m = 0; m < 4; ++m) { const size_t off = (size_t)(row0 + ai * HALF + m * 16) * ldc + col0;
#pragma unroll
                for (int bj = 0; bj < 2; ++bj)
#pragma unroll
                    for (int n = 0; n < 2; ++n) { const f32x4 b = *(const f32x4*)(base + off + bj * HALF + n * 16); *(f32x4*)(C + off + bj * HALF + n * 16) = b + acc[ai][bj][m][n]; }
                asm volatile("" ::: "memory"); }
    }
};
template <bool FP8OUT>
struct EpiResNormT {
    static constexpr bool PERM = false;
    const float* base; float* C; bf16_t* XN; const float* nw; float* ssq; int ldc;
    __device__ __forceinline__ void operator()(const f32x4 (&acc)[2][2][4][2], const Unit& u, int wr, int wc, int fr, int fq) const {
        const int row0 = u.pm * BM + wr * 64 + fr, col0 = u.pn * BM + wc * 32 + 4 * fq;
        f32x4 wv[2][2];
#pragma unroll
        for (int bj = 0; bj < 2; ++bj)
#pragma unroll
            for (int n = 0; n < 2; ++n) wv[bj][n] = *(const f32x4*)(nw + col0 + bj * HALF + n * 16);
        f32x4 bv[2][2][2];
#pragma unroll
        for (int bj = 0; bj < 2; ++bj)
#pragma unroll
            for (int n = 0; n < 2; ++n) bv[0][bj][n] = *(const f32x4*)(base + (size_t)row0 * ldc + col0 + bj * HALF + n * 16);
#pragma unroll
        for (int rg = 0; rg < 8; ++rg) { const int ai = rg >> 2, m = rg & 3; const int row = row0 + ai * HALF + m * 16; const size_t off = (size_t)row * ldc + col0;
            if (rg < 7) { const int ai2 = (rg + 1) >> 2, m2 = (rg + 1) & 3; const size_t off2 = (size_t)(row0 + ai2 * HALF + m2 * 16) * ldc + col0;
#pragma unroll
                for (int bj = 0; bj < 2; ++bj)
#pragma unroll
                    for (int n = 0; n < 2; ++n) bv[(rg + 1) & 1][bj][n] = *(const f32x4*)(base + off2 + bj * HALF + n * 16); }
            float s = 0.f;
#pragma unroll
            for (int bj = 0; bj < 2; ++bj)
#pragma unroll
                for (int n = 0; n < 2; ++n) { const f32x4 v = bv[rg & 1][bj][n] + acc[ai][bj][m][n];
                    *(f32x4*)(C + off + bj * HALF + n * 16) = v; s += v[0] * v[0] + v[1] * v[1] + v[2] * v[2] + v[3] * v[3];
                    if (FP8OUT) { int pk = __builtin_amdgcn_cvt_pk_fp8_f32(v[0] * wv[bj][n][0], v[1] * wv[bj][n][1], 0, false); pk = __builtin_amdgcn_cvt_pk_fp8_f32(v[2] * wv[bj][n][2], v[3] * wv[bj][n][3], pk, true);
                        *(int*)((unsigned char*)XN + off + bj * HALF + n * 16) = pk; }
                    else { u32x2 o; o.x = cvt_pk_bf16(v[0] * wv[bj][n][0], v[1] * wv[bj][n][1]); o.y = cvt_pk_bf16(v[2] * wv[bj][n][2], v[3] * wv[bj][n][3]);
                        *(u32x2*)(XN + off + bj * HALF + n * 16) = o; } }
            s += __shfl_xor(s, 16); s += __shfl_xor(s, 32);
            if (fq == 0) unsafeAtomicAdd(ssq + row, s);
        }
    }
};
typedef EpiResNormT<false> EpiResNorm;
typedef EpiResNormT<true> EpiResNormF8;
struct EpiCmpGelu {
    static constexpr bool PERM = false;
    float* H; const float* bias;
    __device__ __forceinline__ void operator()(const f32x4 (&acc)[2][2][4][2], const Unit& u, int wr, int wc, int fr, int fq) const {
        const int row0 = u.pm * BM + wr * 64 + fr, col0 = wc * 32 + 4 * fq; const float* bs = bias + (u.pm >> 4) * 256;
        f32x4 bvv[2][2];
#pragma unroll
        for (int bj = 0; bj < 2; ++bj)
#pragma unroll
            for (int n = 0; n < 2; ++n) bvv[bj][n] = *(const f32x4*)(bs + col0 + bj * HALF + n * 16);
#pragma unroll
        for (int ai = 0; ai < 2; ++ai)
#pragma unroll
            for (int m = 0; m < 4; ++m) { float* rowp = H + (size_t)(row0 + ai * HALF + m * 16) * 256 + col0;
#pragma unroll
                for (int bj = 0; bj < 2; ++bj)
#pragma unroll
                    for (int n = 0; n < 2; ++n) { f32x4 v = acc[ai][bj][m][n] + bvv[bj][n];
#pragma unroll
                        for (int j = 0; j < 4; ++j) { const float xx = v[j], uu = 0.7978845608028654f * (xx + 0.044715f * xx * xx * xx); const float th = 1.0f - 2.0f / (1.0f + __expf(2.0f * uu)); v[j] = 0.5f * xx * (1.0f + th); }
                        *(f32x4*)(rowp + bj * HALF + n * 16) = v; } }
    }
};
struct EpiGate {
    static constexpr bool PERM = false;
    float* C; const bf16_t* eraw; const float* erstd; const float* pw; const float* ssq; int ldc; float ascale;
    __device__ __forceinline__ void operator()(const f32x4 (&acc)[2][2][4][2], const Unit& u, int wr, int wc, int fr, int fq) const {
        const int row0 = u.pm * BM + wr * 64 + fr, col0 = u.pn * BM + wc * 32 + 4 * fq;
        f32x4 wv[2][2];
#pragma unroll
        for (int bj = 0; bj < 2; ++bj)
#pragma unroll
            for (int n = 0; n < 2; ++n) wv[bj][n] = *(const f32x4*)(pw + col0 + bj * HALF + n * 16);
        f32x4 bv[2][2][2]; u32x2 ev[2][2][2]; float rsv[2], rgv[2];
#pragma unroll
        for (int bj = 0; bj < 2; ++bj)
#pragma unroll
            for (int n = 0; n < 2; ++n) { bv[0][bj][n] = *(const f32x4*)(C + (size_t)row0 * ldc + col0 + bj * HALF + n * 16); ev[0][bj][n] = *(const u32x2*)(eraw + (size_t)row0 * ldc + col0 + bj * HALF + n * 16); }
        rsv[0] = erstd[row0]; rgv[0] = ssq[row0];
#pragma unroll
        for (int rg = 0; rg < 8; ++rg) { const int ai = rg >> 2, m = rg & 3; const int row = row0 + ai * HALF + m * 16; const size_t off = (size_t)row * ldc + col0;
            if (rg < 7) { const int ai2 = (rg + 1) >> 2, m2 = (rg + 1) & 3; const int row2 = row0 + ai2 * HALF + m2 * 16; const size_t off2 = (size_t)row2 * ldc + col0;
#pragma unroll
                for (int bj = 0; bj < 2; ++bj)
#pragma unroll
                    for (int n = 0; n < 2; ++n) { bv[(rg + 1) & 1][bj][n] = *(const f32x4*)(C + off2 + bj * HALF + n * 16); ev[(rg + 1) & 1][bj][n] = *(const u32x2*)(eraw + off2 + bj * HALF + n * 16); }
                rsv[(rg + 1) & 1] = erstd[row2]; rgv[(rg + 1) & 1] = ssq[row2]; }
            const float rs = rsqrtf(rsv[rg & 1] * (1.0f / DM) + EPS), rg_ = rsqrtf(rgv[rg & 1] * (1.0f / DM) + EPS) * ascale;
#pragma unroll
            for (int bj = 0; bj < 2; ++bj)
#pragma unroll
                for (int n = 0; n < 2; ++n) { const f32x4 b = bv[rg & 1][bj][n]; const u32x2 e = ev[rg & 1][bj][n]; const f32x4 a = acc[ai][bj][m][n]; f32x4 o;
                    o[0] = b[0] + bf_lo(e.x) * rs * wv[bj][n][0] * sigmoidf_(a[0] * rg_); o[1] = b[1] + bf_hi(e.x) * rs * wv[bj][n][1] * sigmoidf_(a[1] * rg_);
                    o[2] = b[2] + bf_lo(e.y) * rs * wv[bj][n][2] * sigmoidf_(a[2] * rg_); o[3] = b[3] + bf_hi(e.y) * rs * wv[bj][n][3] * sigmoidf_(a[3] * rg_);
                    *(f32x4*)(C + off + bj * HALF + n * 16) = o; }
        }
    }
};
struct GFfn {
    const char* A; const char* B; unsigned lda, ldb; int nt;
    __device__ __forceinline__ const char* a_base(const Unit& u) const { return A + ((long)u.pm * 254 - 2) * (long)lda * 2; }
    __device__ __forceinline__ const char* b_base(const Unit& u) const { return B + (size_t)u.pn * 256 * ldb * 2; }
    __device__ __forceinline__ size_t kpairA() const { return 256; }
};
template <int CTRL> __device__ __forceinline__ float dpp_f(float v) { return __int_as_float(__builtin_amdgcn_update_dpp(0, __float_as_int(v), CTRL, 0xf, 0xf, false)); }
struct EpiFfn {
    static constexpr bool PERM = true;
    bf16_t* ACT; const float* cw; const float* cb; LAS float* X; const float* ssq;
    __device__ __forceinline__ void operator()(const f32x4 (&acc)[2][2][4][2], const Unit& u, int wr, int wc, int fr, int fq) const {
        const int colw = wc * 32 + 8 * fq;
        const int f0 = u.pn * 128 + colw;
        f32x4 w0[2], w1[2], w2[2], cbv[2];
#pragma unroll
        for (int n = 0; n < 2; ++n) { w0[n] = *(const f32x4*)(cw + f0 + 4 * n); w1[n] = *(const f32x4*)(cw + DFF + f0 + 4 * n); w2[n] = *(const f32x4*)(cw + 2 * DFF + f0 + 4 * n); cbv[n] = *(const f32x4*)(cb + f0 + 4 * n); }
        float rsv[2][4];
#pragma unroll
        for (int ai = 0; ai < 2; ++ai)
#pragma unroll
            for (int m = 0; m < 4; ++m) { const long t = (long)u.pm * 254 - 2 + ai * HALF + wr * 64 + m * 16 + fr; rsv[ai][m] = ssq[t < 0 ? 0 : (t >= S_ ? S_ - 1 : t)]; }
#pragma unroll
        for (int ai = 0; ai < 2; ++ai)
#pragma unroll
            for (int m = 0; m < 4; ++m) { const long t = (long)u.pm * 254 - 2 + ai * HALF + wr * 64 + m * 16 + fr; rsv[ai][m] = (t >= 0 && t < S_) ? rsqrtf(rsv[ai][m] * (1.0f / DM) + EPS) : 0.f; }
        if (fr >= 14) {
#pragma unroll
            for (int ai = 0; ai < 2; ++ai)
#pragma unroll
                for (int n = 0; n < 2; ++n) *(LAS f32x4*)(X + ((2 * ai + wr) * 2 + (fr - 14)) * 128 + colw + 4 * n) = acc[ai][0][3][n] * rsv[ai][3];
        }
        asm volatile("s_waitcnt lgkmcnt(0)" ::: "memory");
        __builtin_amdgcn_s_barrier(); asm volatile("" ::: "memory");
        __builtin_amdgcn_s_barrier(); asm volatile("" ::: "memory");
        const bool sel1 = fr == 15, sel2 = fr >= 14;
#pragma unroll
        for (int ai = 0; ai < 2; ++ai) {
            f32x4 pv[2];
            const int pseg = 2 * ai + wr - 1;
#pragma unroll
            for (int n = 0; n < 2; ++n) { pv[n] = (f32x4){0.f, 0.f, 0.f, 0.f}; if (pseg >= 0 && fr >= 14) pv[n] = *(const LAS f32x4*)(X + (pseg * 2 + (fr - 14)) * 128 + colw + 4 * n); }
#pragma unroll
            for (int m = 0; m < 4; ++m) {
                const int r = ai * HALF + wr * 64 + m * 16 + fr; const long t = (long)u.pm * 254 - 2 + r;
                unsigned ow[4];
#pragma unroll
                for (int n = 0; n < 2; ++n) {
                    const f32x4 cur = acc[ai][0][m][n] * rsv[ai][m], up = acc[ai][1][m][n] * rsv[ai][m];
                    f32x4 x1, x2;
#pragma unroll
                    for (int i = 0; i < 4; ++i) { x1[i] = dpp_f<0x121>(sel1 ? pv[n][i] : cur[i]); x2[i] = dpp_f<0x122>(sel2 ? pv[n][i] : cur[i]); }
                    const f32x4 y = cbv[n] + w0[n] * x2 + w1[n] * x1 + w2[n] * cur;
                    f32x4 sg;
#pragma unroll
                    for (int i = 0; i < 4; ++i) sg[i] = sigmoidf_(y[i]);
                    const f32x4 o = y * sg * up;
                    ow[2 * n] = cvt_pk_bf16(o[0], o[1]); ow[2 * n + 1] = cvt_pk_bf16(o[2], o[3]);
                    pv[n] = cur;
                }
                if (r >= 2 && t < S_) *(u32x4*)(ACT + (size_t)t * DFF + f0) = (u32x4){ow[0], ow[1], ow[2], ow[3]};
            }
        }
    }
};

template <class GD, class Epi, bool F8 = false>
__device__ __forceinline__ void gemm_phase(LAS unsigned char* lds, const GD g, const StaticOrder& S, const Epi& E) {
    const int tid = threadIdx.x, wid = __builtin_amdgcn_readfirstlane(tid >> 6), lane = tid & 63, wr = wid >> 2, wc = wid & 3, fr = lane & 15, fq = lane >> 4;
    const int nt = g.nt;
    unsigned voffA[2], voffB[2];
#pragma unroll
    for (int i = 0; i < 2; ++i) { int R, C; stage_rc(tid * 16 + i * 8192, R, C); const int Rb = Epi::PERM ? ((R & ~31) + perm32(R & 31)) : R;
        voffA[i] = (unsigned)(R * g.lda + C) * 2u; voffB[i] = (unsigned)(Rb * g.ldb + C) * 2u; }
    const size_t kpA = g.kpairA();
    const size_t hstepA = (size_t)HALF * g.lda * 2, hstepB = (size_t)HALF * g.ldb * 2;
    const unsigned ldsw = (unsigned)wid * 1024u;
    const int aoff = lds_byte(wr * 64 + fr, fq * 8), boff = lds_byte(wc * 32 + fr, fq * 8);
#define PG8_SA(b, h) (((b) * 2 + (h)) * HTB)
#define PG8_SB(b, h) ((4 + (b) * 2 + (h)) * HTB)
#define PG8_STAGE(bufoff, gbase, voff) do { _Pragma("unroll") for (int _i = 0; _i < 2; ++_i) \
        __builtin_amdgcn_global_load_lds((const unsigned*)((const char*)(gbase) + (voff)[_i]), (LAS unsigned*)(lds + (bufoff) + ldsw + _i * 8192), 16, 0, 0); } while (0)
#define PG8_LDA(dst, b, h) do { if constexpr (F8) { _Pragma("unroll") for (int m = 0; m < 4; ++m) { const i32x4 lo_ = *(const LAS i32x4*)(lds + PG8_SA(b, h) + aoff + m * 2048), hi_ = *(const LAS i32x4*)(lds + PG8_SA(b, h) + aoff + m * 2048 + 1024); \
            dst##8[m] = __builtin_shufflevector(lo_, hi_, 0, 1, 2, 3, 4, 5, 6, 7); } } \
        else { _Pragma("unroll") for (int m = 0; m < 4; ++m) _Pragma("unroll") for (int k = 0; k < 2; ++k) dst[m][k] = *(const LAS bf16x8*)(lds + PG8_SA(b, h) + aoff + m * 2048 + k * 1024); } } while (0)
#define PG8_LDB(dst, b, h) do { if constexpr (F8) { _Pragma("unroll") for (int n = 0; n < 2; ++n) { const i32x4 lo_ = *(const LAS i32x4*)(lds + PG8_SB(b, h) + boff + n * 2048), hi_ = *(const LAS i32x4*)(lds + PG8_SB(b, h) + boff + n * 2048 + 1024); \
            dst##8[n] = __builtin_shufflevector(lo_, hi_, 0, 1, 2, 3, 4, 5, 6, 7); } } \
        else { _Pragma("unroll") for (int n = 0; n < 2; ++n) _Pragma("unroll") for (int k = 0; k < 2; ++k) dst[n][k] = *(const LAS bf16x8*)(lds + PG8_SB(b, h) + boff + n * 2048 + k * 1024); } } while (0)
#define PG8_MMA(ai, bj, At, Bt) do { __builtin_amdgcn_s_setprio(1); \
        if constexpr (F8) { _Pragma("unroll") for (int m = 0; m < 4; ++m) _Pragma("unroll") for (int n = 0; n < 2; ++n) \
            asm volatile("v_mfma_scale_f32_16x16x128_f8f6f4 %0, %1, %2, %0, %3, %3 op_sel_hi:[0,0,0]" : "+v"(acc[ai][bj][m][n]) : "v"(Bt##8[n]), "v"(At##8[m]), "v"(one_scale)); } \
        else { _Pragma("unroll") for (int m = 0; m < 4; ++m) _Pragma("unroll") for (int n = 0; n < 2; ++n) _Pragma("unroll") for (int k = 0; k < 2; ++k) \
            acc[ai][bj][m][n] = __builtin_amdgcn_mfma_f32_16x16x32_bf16(Bt[n][k], At[m][k], acc[ai][bj][m][n], 0, 0, 0); } \
        __builtin_amdgcn_s_setprio(0); } while (0)
#define PG8_WAIT_V(n) asm volatile("s_waitcnt vmcnt(" #n ")" ::: "memory")
#define PG8_WAIT_L(n) asm volatile("s_waitcnt lgkmcnt(" #n ")" ::: "memory")
#define PG8_BAR __builtin_amdgcn_s_barrier()
#define PG8_SCHED __builtin_amdgcn_sched_barrier(0)
    Unit cur, nxt; int ui = 0;
    if (!S.next(0, cur)) return;
    f32x4 acc[2][2][4][2];
#pragma unroll
    for (int a = 0; a < 2; ++a)
#pragma unroll
        for (int b = 0; b < 2; ++b)
#pragma unroll
            for (int m = 0; m < 4; ++m)
#pragma unroll
                for (int n = 0; n < 2; ++n) acc[a][b][m][n] = (f32x4){0.f, 0.f, 0.f, 0.f};
    bf16x8 At[4][2], B0[2][2], B1[2][2];
    i32x8 At8[4], B08[2], B18[2];
    (void)At; (void)B0; (void)B1; (void)At8; (void)B08; (void)B18;
    int one_scale = 0x7F7F7F7F; (void)one_scale;
    const char* cA = g.a_base(cur); const char* cB = g.b_base(cur);
    PG8_STAGE(PG8_SB(0, 0), cB, voffB); PG8_STAGE(PG8_SA(0, 0), cA, voffA); PG8_STAGE(PG8_SB(0, 1), cB + hstepB, voffB); PG8_STAGE(PG8_SA(0, 1), cA + hstepA, voffA);
    if (wr == 1) PG8_BAR;
    PG8_WAIT_V(4); PG8_BAR;
    PG8_STAGE(PG8_SB(1, 0), cB + 128, voffB); PG8_STAGE(PG8_SA(1, 0), cA + 128, voffA); PG8_STAGE(PG8_SB(1, 1), cB + hstepB + 128, voffB);
    PG8_WAIT_V(6); PG8_BAR;
    for (;;) {
        const bool has_next = S.next(ui + 1, nxt);
        const char* nA = has_next ? g.a_base(nxt) : cA; const char* nB = has_next ? g.b_base(nxt) : cB;
        for (int t = 0; t < nt; t += 2) {
            const bool last = (t == nt - 2);
            const char* a0 = cA + (size_t)(t >> 1) * kpA;
            const char* a1 = a0 + 128;
            const char* a2 = last ? nA : a0 + kpA; const char* b2 = last ? nB : cB + (size_t)(t + 2) * 128;
            const char* a3 = a2 + 128; const char* b3 = b2 + 128;
            PG8_LDB(B0, 0, 0); PG8_SCHED; PG8_LDA(At, 0, 0); PG8_STAGE(PG8_SA(1, 1), a1 + hstepA, voffA);
            PG8_WAIT_L(8); PG8_BAR; PG8_WAIT_L(0); PG8_MMA(0, 0, At, B0); PG8_BAR; PG8_SCHED;
            PG8_LDB(B1, 0, 1); PG8_STAGE(PG8_SB(0, 0), b2, voffB);
            PG8_BAR; PG8_WAIT_L(0); PG8_MMA(0, 1, At, B1); PG8_BAR;
            PG8_LDA(At, 0, 1); PG8_STAGE(PG8_SA(0, 0), a2, voffA);
            PG8_BAR; PG8_WAIT_L(0); PG8_MMA(1, 0, At, B0); PG8_BAR; PG8_SCHED;
            PG8_STAGE(PG8_SB(0, 1), b2 + hstepB, voffB);
            PG8_WAIT_V(6); PG8_BAR; PG8_MMA(1, 1, At, B1); PG8_BAR;
            PG8_LDB(B0, 1, 0); PG8_SCHED; PG8_LDA(At, 1, 0); PG8_STAGE(PG8_SA(0, 1), a2 + hstepA, voffA);
            PG8_WAIT_L(8); PG8_BAR; PG8_WAIT_L(0); PG8_MMA(0, 0, At, B0); PG8_BAR; PG8_SCHED;
            PG8_LDB(B1, 1, 1); PG8_STAGE(PG8_SB(1, 0), b3, voffB);
            PG8_BAR; PG8_WAIT_L(0); PG8_MMA(0, 1, At, B1); PG8_BAR;
            PG8_LDA(At, 1, 1); PG8_STAGE(PG8_SA(1, 0), a3, voffA);
            PG8_BAR; PG8_WAIT_L(0); PG8_MMA(1, 0, At, B0); PG8_BAR; PG8_SCHED;
            PG8_STAGE(PG8_SB(1, 1), b3 + hstepB, voffB);
            PG8_WAIT_V(6); PG8_BAR; PG8_MMA(1, 1, At, B1); PG8_BAR;
        }
        if constexpr (F8) asm volatile("s_nop 15\n\ts_nop 15\n\ts_nop 15" ::: "memory");
        E(acc, cur, wr, wc, fr, fq);
        if (!has_next) break;
#pragma unroll
        for (int a = 0; a < 2; ++a)
#pragma unroll
            for (int b = 0; b < 2; ++b)
#pragma unroll
                for (int m = 0; m < 4; ++m)
#pragma unroll
                    for (int n = 0; n < 2; ++n) acc[a][b][m][n] = (f32x4){0.f, 0.f, 0.f, 0.f};
        cur = nxt; cA = nA; cB = nB; ++ui;
    }
    PG8_WAIT_V(0);
    if (wr == 0) PG8_BAR;
    PG8_BAR;
#undef PG8_SA
#undef PG8_SB
#undef PG8_STAGE
#undef PG8_LDA
#undef PG8_LDB
#undef PG8_MMA
#undef PG8_WAIT_V
#undef PG8_WAIT_L
#undef PG8_BAR
#undef PG8_SCHED
}
}

namespace att {
constexpr int KVBLK = 64;
constexpr int SHM_V = KVBLK * HD * 2, SHM_K = KVBLK * HD * 2, SHM_ATTN = 2 * SHM_V + 2 * SHM_K + NWAVES * 64 * 4;
#define KSWZ(row, colB) ((row) * 256 + ((colB) ^ (((row) & 7) << 4)))
#define SBAR() __builtin_amdgcn_sched_barrier(0)
__device__ __forceinline__ int crow(int r, int hi) { return (r & 3) + 8 * (r >> 2) + 4 * hi; }
__device__ __forceinline__ void qkt(f32x16& p0, f32x16& p1, const char* Ks, const bf16x8* qr, int r32, int hi) {
    p0 = f32x16{}; p1 = f32x16{};
    bf16x8 ka[2], kb[2];
    { const int cb = (hi * 8) * 2; ka[0] = *reinterpret_cast<const bf16x8*>(Ks + KSWZ(r32, cb)); kb[0] = *reinterpret_cast<const bf16x8*>(Ks + KSWZ(32 + r32, cb)); }
#pragma unroll
    for (int d0 = 0; d0 < 8; ++d0) {
        if (d0 < 7) { const int cb = ((d0 + 1) * 16 + hi * 8) * 2;
            ka[(d0 + 1) & 1] = *reinterpret_cast<const bf16x8*>(Ks + KSWZ(r32, cb)); kb[(d0 + 1) & 1] = *reinterpret_cast<const bf16x8*>(Ks + KSWZ(32 + r32, cb)); }
        SBAR();
        p0 = __builtin_amdgcn_mfma_f32_32x32x16_bf16(ka[d0 & 1], qr[d0], p0, 0, 0, 0);
        p1 = __builtin_amdgcn_mfma_f32_32x32x16_bf16(kb[d0 & 1], qr[d0], p1, 0, 0, 0);
        SBAR();
    }
}
__device__ __forceinline__ int v_st(int k, int c) { const int kk = (k & ~0xC) | ((k & 4) << 1) | ((k & 8) >> 1); return ((kk >> 3) * 4 + (c >> 5)) * 512 + ((kk & 7) * 32 + (c & 31)) * 2; }
__device__ __forceinline__ int v_rd_base(int lane) { return ((lane & 3) << 3) | (((lane >> 2) & 3) << 6) | (((lane >> 4) & 1) << 5) | (((lane >> 5) & 1) << 8); }
constexpr int v_rd_off(int d0, int ks, int half) { return d0 * 512 + ks * 4096 + half * 2048; }
__device__ __forceinline__ s16x4 tr_read(int vb, int off) { return __builtin_amdgcn_ds_read_tr16_b64_v4i16((LAS s16x4*)(unsigned long)(unsigned)(vb + off)); }
__device__ __forceinline__ void pv_d0(f32x16* o, int vb, bf16x8 pa0, bf16x8 pa1, bf16x8 pa2, bf16x8 pa3) {
    s16x4 L[2][4], H[2][4];
#pragma unroll
    for (int d0 = 0; d0 < 4; ++d0) { L[0][d0] = tr_read(vb, v_rd_off(d0, 0, 0)); H[0][d0] = tr_read(vb, v_rd_off(d0, 0, 1)); }
#pragma unroll
    for (int ks = 0; ks < 4; ++ks) {
        if (ks < 3) {
#pragma unroll
            for (int d0 = 0; d0 < 4; ++d0) { L[(ks + 1) & 1][d0] = tr_read(vb, v_rd_off(d0, ks + 1, 0)); H[(ks + 1) & 1][d0] = tr_read(vb, v_rd_off(d0, ks + 1, 1)); }
        }
        const bf16x8 pa = ks == 0 ? pa0 : (ks == 1 ? pa1 : (ks == 2 ? pa2 : pa3));
#pragma unroll
        for (int d0 = 0; d0 < 4; ++d0) { const s16x4 l = L[ks & 1][d0], h = H[ks & 1][d0];
            o[d0] = __builtin_amdgcn_mfma_f32_32x32x16_bf16(pa, (bf16x8){l[0], l[1], l[2], l[3], h[0], h[1], h[2], h[3]}, o[d0], 0, 0, 0); }
    }
}
__device__ __forceinline__ void pack_p(const f32x16& p0, const f32x16& p1, bf16x8& pa0, bf16x8& pa1, bf16x8& pa2, bf16x8& pa3) {
#define PK4(P, BASE, OUT) do { unsigned a0 = cvt_pk_bf16(P[BASE + 0], P[BASE + 1]), a1 = cvt_pk_bf16(P[BASE + 2], P[BASE + 3]);   \
    unsigned b0 = cvt_pk_bf16(P[BASE + 4], P[BASE + 5]), b1 = cvt_pk_bf16(P[BASE + 6], P[BASE + 7]);                              \
    auto r0 = __builtin_amdgcn_permlane32_swap(a0, b0, false, false); auto r1 = __builtin_amdgcn_permlane32_swap(a1, b1, false, false); \
    u32x4 w = {r0[0], r1[0], r0[1], r1[1]}; OUT = *reinterpret_cast<bf16x8*>(&w); } while (0)
    PK4(p0, 0, pa0); PK4(p0, 8, pa1); PK4(p1, 0, pa2); PK4(p1, 8, pa3);
#undef PK4
}

__device__ __forceinline__ void pack_half(const f32x16& p, bf16x8& paA, bf16x8& paB) {
#define PK4(P, BASE, OUT) do { unsigned a0 = cvt_pk_bf16(P[BASE + 0], P[BASE + 1]), a1 = cvt_pk_bf16(P[BASE + 2], P[BASE + 3]);   \
    unsigned b0 = cvt_pk_bf16(P[BASE + 4], P[BASE + 5]), b1 = cvt_pk_bf16(P[BASE + 6], P[BASE + 7]);                              \
    auto r0 = __builtin_amdgcn_permlane32_swap(a0, b0, false, false); auto r1 = __builtin_amdgcn_permlane32_swap(a1, b1, false, false); \
    u32x4 w = {r0[0], r1[0], r0[1], r1[1]}; OUT = *reinterpret_cast<bf16x8*>(&w); } while (0)
    PK4(p, 0, paA); PK4(p, 8, paB);
#undef PK4
}
template <int KS0, bool WITH_EXP>
__device__ __forceinline__ void pv_half(f32x16* o, int vb, bf16x8 paA, bf16x8 paB, f32x16& px, float off) {
    s16x4 L[2][4], H[2][4];
#pragma unroll
    for (int d0 = 0; d0 < 4; ++d0) { L[0][d0] = tr_read(vb, v_rd_off(d0, KS0, 0)); H[0][d0] = tr_read(vb, v_rd_off(d0, KS0, 1)); }
#pragma unroll
    for (int d0 = 0; d0 < 4; ++d0) { L[1][d0] = tr_read(vb, v_rd_off(d0, KS0 + 1, 0)); H[1][d0] = tr_read(vb, v_rd_off(d0, KS0 + 1, 1)); }
#pragma unroll
    for (int kk = 0; kk < 2; ++kk) {
        const bf16x8 pa = kk == 0 ? paA : paB;
#pragma unroll
        for (int d0 = 0; d0 < 4; ++d0) { const s16x4 l = L[kk][d0], h = H[kk][d0];
            if (WITH_EXP) SBAR();
            o[d0] = __builtin_amdgcn_mfma_f32_32x32x16_bf16(pa, (bf16x8){l[0], l[1], l[2], l[3], h[0], h[1], h[2], h[3]}, o[d0], 0, 0, 0);
            if (WITH_EXP) {
#pragma unroll
                for (int q = 0; q < 2; ++q) { const int r = (kk * 4 + d0) * 2 + q; px[r] = __builtin_amdgcn_exp2f(fmaf(px[r], SM_C, off)); }
                SBAR(); }
        }
    }
}
enum { MODE_CMP = 0, MODE_WIN = 1, MODE_SLC = 2 };
struct AttnArgs {
    const bf16_t* Z; const bf16_t* KC; const bf16_t* VC; const float* G; float* L; float* OACC; bf16_t* MIX; const unsigned* BM; const float* TAB;
};
template <int MODE>
__device__ __forceinline__ void attn_unit(const AttnArgs& a, LAS char* ldsL, int qt, int g, int hp) {
    char* lds = (char*)ldsL;
    const int tid = threadIdx.x, wid = __builtin_amdgcn_readfirstlane(tid >> 6), lane = tid & 63, r32 = lane & 31, hi = lane >> 5;
    float* li_l = (float*)(lds + LDS_XCH) + wid * 64;
    const int t0 = MODE == MODE_SLC ? qt * 40 : qt * 128;
    const int tq_raw = MODE == MODE_SLC ? t0 + wid * 5 + r32 / 6 : t0 + wid * 16 + (r32 & 15);
    const bool rvalid = MODE == MODE_SLC ? (r32 < 30 && tq_raw < S_) : true;
    const int tq = tq_raw < S_ ? tq_raw : S_ - 1;
    const int hq = MODE == MODE_SLC ? g * HPG + r32 % 6 : g * HPG + hp * 2 + (r32 >> 4);
    const int tlast = MODE == MODE_SLC ? ((t0 + 39) < S_ ? (t0 + 39) : S_ - 1) : t0 + 127;
    const bf16_t* Kb; const bf16_t* Vb; long ldk;
    if (MODE == MODE_CMP) { Kb = a.KC + (size_t)g * 1024 * HD; Vb = a.VC + (size_t)g * 1024 * HD; ldk = HD; }
    else if (MODE == MODE_WIN) { Kb = a.Z + OFF_KV + 4 * 512 + g * HD; Vb = a.Z + OFF_KV + 5 * 512 + g * HD; ldk = LDZ; }
    else { Kb = a.Z + OFF_KV + 2 * 512 + g * HD; Vb = a.Z + OFF_KV + 3 * 512 + g * HD; ldk = LDZ; }
    int j0, j1;
    if (MODE == MODE_CMP) { j0 = 0; j1 = (((t0 + 127 - 31) >> 4) >> 6) + 1; }
    else if (MODE == MODE_WIN) { j0 = (t0 - 511) > 0 ? ((t0 - 511) >> 6) : 0; j1 = ((t0 + 127) >> 6) + 1; }
    else { j0 = 0; j1 = (tlast >> 6) + 1; }
    int klo, khi;
    if (MODE == MODE_CMP) { klo = 0; khi = tq >= 31 ? ((tq - 31) >> 4) : -1; }
    else if (MODE == MODE_WIN) { klo = tq - 511; khi = tq; }
    else { klo = 0; khi = rvalid ? tq : -1; }
    float negBC = -a.TAB[512 + (MODE == MODE_CMP ? 0 : (MODE == MODE_SLC ? 1 : 2))];
    bf16x8 qr[8];
    { const bf16_t* Qw = a.Z + (size_t)tq * LDZ + OFF_Q + hq * HD + hi * 8;
#pragma unroll
      for (int d0 = 0; d0 < 8; ++d0) qr[d0] = *reinterpret_cast<const bf16x8*>(Qw + d0 * 16); }
    f32x16 o[4] = {}; float lsum = 0.f;
    unsigned soK[2], soV[2];
#pragma unroll
    for (int i = 0; i < 2; ++i) { const int p = (wid + 8 * i) * 64 + lane;
        { const int row = p >> 4, c = (p & 15) ^ (row & 7); soK[i] = (unsigned)(row * ldk + c * 8) * 2u; }
        { const int sub = p >> 5, within = p & 31, kk = (sub >> 2) * 8 + (within >> 2), c = (sub & 3) * 32 + (within & 3) * 8, k = (kk & ~0xC) | ((kk & 4) << 1) | ((kk & 8) >> 1);
          soV[i] = (unsigned)(k * ldk + c) * 2u; } }
    const int vb0 = (int)(uintptr_t)(LAS char*)ldsL + 16384 + v_rd_base(lane);
#define ISSUE(jt) do { const int _b = ((jt) - j0) & 3; const char* _kp = (const char*)Kb + (size_t)(jt) * KVBLK * ldk * 2; const char* _vp = (const char*)Vb + (size_t)(jt) * KVBLK * ldk * 2; \
    _Pragma("unroll") for (int _i = 0; _i < 2; ++_i) { \
        __builtin_amdgcn_global_load_lds((const unsigned*)(_kp + soK[_i]), (LAS unsigned*)(ldsL + _b * 32768 + (wid + 8 * _i) * 1024), 16, 0, 0); \
        __builtin_amdgcn_global_load_lds((const unsigned*)(_vp + soV[_i]), (LAS unsigned*)(ldsL + _b * 32768 + 16384 + (wid + 8 * _i) * 1024), 16, 0, 0); } } while (0)
    unsigned bmw = 0u;
    if (MODE == MODE_SLC) bmw = a.BM[((size_t)tq * 4 + g) * 8];
    asm volatile("s_waitcnt lgkmcnt(0)" ::: "memory");
    __builtin_amdgcn_s_barrier();
    asm volatile("" ::: "memory");
    ISSUE(j0);
    asm volatile("s_waitcnt vmcnt(4) lgkmcnt(0)" : "+v"(bmw), "+v"(negBC), "+v"(qr[0]), "+v"(qr[1]), "+v"(qr[2]), "+v"(qr[3]), "+v"(qr[4]), "+v"(qr[5]), "+v"(qr[6]), "+v"(qr[7]) :: "memory");
    if (j0 + 1 < j1) ISSUE(j0 + 1); if (j0 + 2 < j1) ISSUE(j0 + 2);
    for (int j = j0; j < j1; ++j) {
        const int buf = (j - j0) & 3;
        if (j + 2 < j1) asm volatile("s_waitcnt vmcnt(8)" ::: "memory"); else if (j + 1 < j1) asm volatile("s_waitcnt vmcnt(4)" ::: "memory"); else asm volatile("s_waitcnt vmcnt(0)" ::: "memory");
        __builtin_amdgcn_s_barrier();
        asm volatile("" ::: "memory");
        if (j + 3 < j1) ISSUE(j + 3);
        int lhi = khi;
        if (MODE == MODE_SLC) { if (!((bmw >> (j & 31)) & 1u)) lhi = -1; }
        const int kb = j * KVBLK;
        const bool l_any = (kb + 63 >= klo) && (kb <= lhi);
        const bool l_full = (kb >= klo) && (kb + 63 <= lhi);
        if (__any(l_any)) {
            f32x16 p0, p1;
            qkt(p0, p1, lds + buf * 32768, qr, r32, hi);
            const bool uni = __all(l_full || !l_any);
            const float off = (uni && !l_any) ? -1.0e30f : negBC;
#pragma unroll
            for (int r = 0; r < 16; ++r) p0[r] = __builtin_amdgcn_exp2f(fmaf(p0[r], SM_C, off));
            if (!uni) {
#pragma unroll
                for (int r = 0; r < 16; ++r) { const int k0i = kb + crow(r, hi); p0[r] = (k0i >= klo && k0i <= lhi) ? p0[r] : 0.f; } }
            float ps = 0.f;
#pragma unroll
            for (int r = 0; r < 16; ++r) ps += p0[r];
            bf16x8 pa0, pa1, pa2, pa3; pack_half(p0, pa0, pa1);
            pv_half<0, true>(o, vb0 + buf * 32768, pa0, pa1, p1, off);
            if (!uni) {
#pragma unroll
                for (int r = 0; r < 16; ++r) { const int k1i = kb + 32 + crow(r, hi); p1[r] = (k1i >= klo && k1i <= lhi) ? p1[r] : 0.f; } }
#pragma unroll
            for (int r = 0; r < 16; ++r) ps += p1[r];
            lsum += ps;
            pack_half(p1, pa2, pa3);
            pv_half<2, false>(o, vb0 + buf * 32768, pa2, pa3, p1, off);
        }
        if (MODE == MODE_SLC) { if (((j + 1) & 31) == 0 && j + 1 < j1) { bmw = a.BM[((size_t)tq * 4 + g) * 8 + ((j + 1) >> 5)]; asm volatile("s_waitcnt vmcnt(0)" : "+v"(bmw) :: "memory"); } }
    }
#undef ISSUE
    lsum += __shfl_xor(lsum, 32);
    const float grow = a.G[(size_t)tq * NGATE + hq * 3 + (MODE == MODE_CMP ? 0 : (MODE == MODE_SLC ? 1 : 2))];
    if (hi == 0) { li_l[r32] = lsum; li_l[32 + r32] = rvalid ? grow : 0.f; }
    if (MODE == MODE_CMP) { if (hi == 0) a.L[(size_t)tq * NH + hq] = lsum; }
    asm volatile("s_waitcnt lgkmcnt(0)" ::: "memory");
#pragma unroll
    for (int hf = 0; hf < 2; ++hf) {
        float gtv[8]; float pvv[8][4];
#pragma unroll
        for (int rr = 0; rr < 8; ++rr) { const int r = hf * 8 + rr;
            const int orow = crow(r, hi); const float lv = li_l[orow]; const float rl = lv > 0.f ? __builtin_amdgcn_rcpf(lv) : 0.f;
            const int t = MODE == MODE_SLC ? t0 + wid * 5 + orow / 6 : t0 + wid * 16 + (orow & 15);
            const int h = MODE == MODE_SLC ? g * HPG + orow % 6 : g * HPG + hp * 2 + (orow >> 4);
            const bool valid = !(MODE == MODE_SLC && (orow >= 30 || t >= S_)); const int tc = valid ? t : 0;
            gtv[rr] = li_l[32 + orow] * rl;
            if (MODE != MODE_CMP) { const float* oa = a.OACC + (size_t)tc * 3072 + h * HD + r32;
#pragma unroll
                for (int d0 = 0; d0 < 4; ++d0) pvv[rr][d0] = oa[d0 * 32]; }
        }
#pragma unroll
        for (int rr = 0; rr < 8; ++rr) { const int r = hf * 8 + rr;
            const int orow = crow(r, hi);
            const int t = MODE == MODE_SLC ? t0 + wid * 5 + orow / 6 : t0 + wid * 16 + (orow & 15);
            const int h = MODE == MODE_SLC ? g * HPG + orow % 6 : g * HPG + hp * 2 + (orow >> 4);
            if (MODE == MODE_SLC && (orow >= 30 || t >= S_)) continue;
            float* oa = a.OACC + (size_t)t * 3072 + h * HD + r32;
#pragma unroll
            for (int d0 = 0; d0 < 4; ++d0) {
                const float v = o[d0][r] * gtv[rr];
                if (MODE == MODE_CMP) oa[d0 * 32] = v;
                else if (MODE == MODE_WIN) oa[d0 * 32] = pvv[rr][d0] + v;
                else a.MIX[(size_t)t * DM + POOLW + h * HD + d0 * 32 + r32] = (bf16_t)(cvt_pk_bf16(pvv[rr][d0] + v, 0.f) & 0xffffu);
            }
        }
    }
}

constexpr int SLC_KPS = 1040, SLC_VPS = 1056, SLC_KIMG = 16 * SLC_KPS, SLC_BUF = SLC_KIMG + 16 * SLC_VPS, LDS_SLCX = 4 * SLC_BUF;
static_assert(LDS_SLCX + 3072 <= LDS_MISC, "slc ring overlaps the barrier words");
__device__ __forceinline__ bf16x8 lds_b128(int adr) { return *reinterpret_cast<const LAS bf16x8*>((LAS char*)(unsigned long)(unsigned)adr); }
__device__ __forceinline__ void slc16_unit(const AttnArgs& a, LAS char* ldsL, int ut, int g) {
    char* lds = (char*)ldsL;
    const int tid = threadIdx.x, wid = __builtin_amdgcn_readfirstlane(tid >> 6), lane = tid & 63, fr = lane & 15, fq = lane >> 4;
    float* li_l = (float*)(lds + LDS_SLCX) + wid * 96;
    const int t0 = ut * 64, j0 = 0, j1 = ut + 1;
    const bf16_t* Kb = a.Z + OFF_KV + 2 * 512 + g * HD; const long ldk = LDZ;
    int tqv[3];
#pragma unroll
    for (int b = 0; b < 3; ++b) tqv[b] = t0 + wid * 8 + (16 * b + fr) / 6;
#define TQC(b) tqv[b]
#define HQ(b) (g * HPG + (16 * (b) + fr) % 6)
    float negBC = -a.TAB[513];
    bf16x8 qf[3][4];
#pragma unroll
    for (int b = 0; b < 3; ++b) { const bf16_t* qp = a.Z + (size_t)TQC(b) * LDZ + OFF_Q + HQ(b) * HD + fq * 8;
#pragma unroll
        for (int ks = 0; ks < 4; ++ks) qf[b][ks] = *reinterpret_cast<const bf16x8*>(qp + ks * 32); }
    f32x4 o[3][8]; float lsum[3];
#pragma unroll
    for (int b = 0; b < 3; ++b) { lsum[b] = 0.f;
#pragma unroll
        for (int c = 0; c < 8; ++c) o[b][c] = (f32x4){0.f, 0.f, 0.f, 0.f}; }
    const int q4 = fr >> 2, p4 = fr & 3, lbase = (int)(uintptr_t)ldsL;
    const int kaddr0 = lbase + fr * SLC_KPS + fq * 16;
    const int vaddr0 = lbase + SLC_KIMG + (4 * fq + q4) * SLC_VPS + (p4 >> 1) * 16 + (p4 & 1) * 8;
    unsigned so0 = (unsigned)((wid + 16 * (lane >> 4)) * ldk + (lane & 15) * 8) * 2u;
#define ISSUE16(jt) do { const int _b = ((jt) - j0) & 3; const char* _kp = (const char*)Kb + (size_t)(jt) * KVBLK * ldk * 2; asm volatile("" : "+v"(so0)); \
    _Pragma("unroll") for (int _i = 0; _i < 4; ++_i) \
        __builtin_amdgcn_global_load_lds((const unsigned*)(_kp + (_i >> 1) * 1024 + (_i & 1) * (8 * ldk * 2) + so0), \
            (LAS unsigned*)(ldsL + _b * SLC_BUF + ((_i >> 1) ? SLC_KIMG + (wid + 8 * (_i & 1)) * SLC_VPS : (wid + 8 * (_i & 1)) * SLC_KPS)), 16, 0, 0); } while (0)
    unsigned bmw[3];
#pragma unroll
    for (int b = 0; b < 3; ++b) bmw[b] = a.BM[((size_t)TQC(b) * 4 + g) * 8];
    asm volatile("s_waitcnt lgkmcnt(0)" ::: "memory");
    __builtin_amdgcn_s_barrier();
    asm volatile("" ::: "memory");
    ISSUE16(j0); if (j0 + 1 < j1) ISSUE16(j0 + 1);
    asm volatile("s_waitcnt vmcnt(0) lgkmcnt(0)" : "+v"(bmw[0]), "+v"(bmw[1]), "+v"(bmw[2]), "+v"(negBC), "+v"(qf[0][0]), "+v"(qf[0][1]), "+v"(qf[0][2]), "+v"(qf[0][3]),
                 "+v"(qf[1][0]), "+v"(qf[1][1]), "+v"(qf[1][2]), "+v"(qf[1][3]), "+v"(qf[2][0]), "+v"(qf[2][1]), "+v"(qf[2][2]), "+v"(qf[2][3]) :: "memory");
    int kadr = kaddr0, vadr = vaddr0;
    for (int j = j0; j < j1; ++j) {
        const int buf = (j - j0) & 3;
        if ((j & 1) == 0) {
            asm volatile("s_waitcnt vmcnt(0)" ::: "memory");
            __builtin_amdgcn_s_barrier();
            asm volatile("" ::: "memory");
            if (j + 2 < j1) ISSUE16(j + 2); if (j + 3 < j1) ISSUE16(j + 3); }
        const int kb = j * KVBLK;
#define KF16(ks, mt) lds_b128(kadr + 64 * (ks) + 256 * (mt))
#define TRA(dst, off) asm volatile("ds_read_b64_tr_b16 %0, %1 offset:%2" : "=v"(dst) : "v"(vadr), "n"(off))
#define VLOAD(dst, s, h) _Pragma("unroll") for (int _c = 0; _c < 4; ++_c) { TRA(dst[_c][0], 32 * (4 * (h) + _c) + 512 * (s)); TRA(dst[_c][1], 32 * (4 * (h) + _c) + 512 * (s) + 256); }
#define VWAIT(n, d) asm volatile("s_waitcnt lgkmcnt(" #n ")" : "+v"(d[0][0]), "+v"(d[0][1]), "+v"(d[1][0]), "+v"(d[1][1]), "+v"(d[2][0]), "+v"(d[2][1]), "+v"(d[3][0]), "+v"(d[3][1]))
#define PVMMA(src, pa, h) _Pragma("unroll") for (int _c = 0; _c < 4; ++_c) o[b][4 * (h) + _c] = __builtin_amdgcn_mfma_f32_16x16x32_bf16(pa, \
            (bf16x8){src[_c][0][0], src[_c][0][1], src[_c][0][2], src[_c][0][3], src[_c][1][0], src[_c][1][1], src[_c][1][2], src[_c][1][3]}, o[b][4 * (h) + _c], 0, 0, 0);
#define EXPH(h, pw) { if (uni) { _Pragma("unroll") for (int mt = 2 * (h); mt < 2 * (h) + 2; ++mt) _Pragma("unroll") for (int i = 0; i < 4; ++i) { \
                            const float e_ = __builtin_amdgcn_exp2f(fmaf(acc[mt][i], SM_C, off)); acc[mt][i] = e_; ps += e_; } } \
                      else { asm volatile("" ::: "memory"); _Pragma("unroll") for (int mt = 2 * (h); mt < 2 * (h) + 2; ++mt) _Pragma("unroll") for (int i = 0; i < 4; ++i) { \
                            float e_ = __builtin_amdgcn_exp2f(fmaf(acc[mt][i], SM_C, off)); e_ = (16 * mt + i <= lim4) ? e_ : 0.f; acc[mt][i] = e_; ps += e_; } } \
                      pw.x = cvt_pk_bf16(acc[2 * (h)][0], acc[2 * (h)][1]); pw.y = cvt_pk_bf16(acc[2 * (h)][2], acc[2 * (h)][3]); \
                      pw.z = cvt_pk_bf16(acc[2 * (h) + 1][0], acc[2 * (h) + 1][1]); pw.w = cvt_pk_bf16(acc[2 * (h) + 1][2], acc[2 * (h) + 1][3]); }
#pragma unroll
        for (int b = 0; b < 3; ++b) {
            const bool sel = (bmw[b] >> (j & 31)) & 1u;
            const int lim = tqv[b] - kb;
            const bool l_any = sel && lim >= 0, l_full = sel && lim >= 63;
            if (__any(l_any)) {
                f32x4 acc[4]; bf16x8 kr[8]; s16x4 va[4][2], vc[4][2];
#define KRD(i) asm volatile("ds_read_b128 %0, %1 offset:%2" : "=v"(kr[(i) & 7]) : "v"(kadr), "n"(64 * ((i) >> 2) + 256 * ((i) & 3)))
#define KWT(n, i) asm volatile("s_waitcnt lgkmcnt(" #n ")" : "+v"(kr[(i) & 7]))
#define KMM(i) acc[(i) & 3] = __builtin_amdgcn_mfma_f32_16x16x32_bf16(kr[(i) & 7], qf[b][(i) >> 2], (i) < 4 ? (f32x4){0.f, 0.f, 0.f, 0.f} : acc[(i) & 3], 0, 0, 0)
                KRD(0); KRD(1); KRD(2); KRD(3); KRD(4); KRD(5); KRD(6); KRD(7);
#define SB_ __builtin_amdgcn_sched_barrier(0)
                SB_; KWT(7, 0); KMM(0); SB_; KRD(8);  KWT(7, 1); KMM(1); SB_; KRD(9);  KWT(7, 2); KMM(2); SB_; KRD(10); KWT(7, 3); KMM(3); SB_; KRD(11);
                KWT(7, 4); KMM(4); SB_; KRD(12); KWT(7, 5); KMM(5); SB_; KRD(13); KWT(7, 6); KMM(6); SB_; KRD(14); KWT(7, 7); KMM(7); SB_; KRD(15);
                KWT(7, 8); KMM(8); SB_; KWT(6, 9); KMM(9); SB_; KWT(5, 10); KMM(10); SB_; KWT(4, 11); KMM(11); SB_; KWT(3, 12); KMM(12); SB_; KWT(2, 13); KMM(13); SB_; KWT(1, 14); KMM(14); SB_; KWT(0, 15); KMM(15);
#undef SB_
                __builtin_amdgcn_sched_barrier(0);
#undef KRD
#undef KWT
#undef KMM
                VLOAD(va, 0, 0)
                VLOAD(vc, 0, 1)
                const bool uni = __all(l_full || !l_any);
                const float off = (uni && !l_any) ? -1.0e30f : negBC;
                const int lim4 = l_any ? lim - 4 * fq : -1;
                float ps = 0.f;
                u32x4 pw0, pw1;
                EXPH(0, pw0)
                const bf16x8 pa0 = *reinterpret_cast<bf16x8*>(&pw0);
                __builtin_amdgcn_sched_barrier(0);
                VWAIT(8, va);
                PVMMA(va, pa0, 0)
                __builtin_amdgcn_sched_barrier(0);
                VLOAD(va, 1, 0)
                VWAIT(8, vc);
                PVMMA(vc, pa0, 1)
                __builtin_amdgcn_sched_barrier(0);
                VLOAD(vc, 1, 1)
                EXPH(1, pw1)
                const bf16x8 pa1 = *reinterpret_cast<bf16x8*>(&pw1);
                lsum[b] += ps;
                __builtin_amdgcn_sched_barrier(0);
                VWAIT(8, va);
                PVMMA(va, pa1, 0)
                __builtin_amdgcn_sched_barrier(0);
                VWAIT(0, vc);
                PVMMA(vc, pa1, 1)
                __builtin_amdgcn_sched_barrier(0);
            }
        }
#undef TRA
#undef VWAIT
#undef EXPH
#undef KF16
#undef VLOAD
#undef PVMMA
        if (((j + 1) & 31) == 0 && j + 1 < j1) {
#pragma unroll
            for (int b = 0; b < 3; ++b) bmw[b] = a.BM[((size_t)TQC(b) * 4 + g) * 8 + ((j + 1) >> 5)];
            asm volatile("s_waitcnt vmcnt(0)" : "+v"(bmw[0]), "+v"(bmw[1]), "+v"(bmw[2]) :: "memory"); }
        { const int step = buf == 3 ? -3 * SLC_BUF : SLC_BUF; kadr += step; vadr += step; asm volatile("" : "+v"(kadr), "+v"(vadr)); }
    }
#undef ISSUE16
    int fqe = fq, fre = fr; asm volatile("" : "+v"(fqe), "+v"(fre));
    float grow[3];
#pragma unroll
    for (int b = 0; b < 3; ++b) grow[b] = a.G[(size_t)TQC(b) * NGATE + (g * HPG + (16 * b + fre) % 6) * 3 + 1];
#pragma unroll
    for (int b = 0; b < 3; ++b) { float ls = lsum[b]; ls += __shfl_xor(ls, 16); ls += __shfl_xor(ls, 32);
        if (fqe == 0) { li_l[b * 32 + fre] = ls; li_l[b * 32 + 16 + fre] = grow[b]; } }
    asm volatile("s_waitcnt lgkmcnt(0)" ::: "memory");
#pragma unroll
    for (int b = 0; b < 3; ++b) {
        float pv_[4][8]; float gtv[4];
#pragma unroll
        for (int i = 0; i < 4; ++i) { const int q = 4 * fqe + i, R = 16 * b + q; const float lv = li_l[b * 32 + q]; gtv[i] = li_l[b * 32 + 16 + q] * (lv > 0.f ? __builtin_amdgcn_rcpf(lv) : 0.f);
            const int t = t0 + wid * 8 + R / 6, h = g * HPG + R % 6;
            const float* oa = a.OACC + (size_t)t * 3072 + h * HD + fre;
#pragma unroll
            for (int c = 0; c < 8; ++c) pv_[i][c] = oa[c * 16]; }
#pragma unroll
        for (int i = 0; i < 4; ++i) { const int R = 16 * b + 4 * fqe + i; const int t = t0 + wid * 8 + R / 6, h = g * HPG + R % 6;
            bf16_t* mp = a.MIX + (size_t)t * DM + POOLW + h * HD + fre;
#pragma unroll
            for (int c = 0; c < 8; ++c) mp[c * 16] = (bf16_t)(cvt_pk_bf16(pv_[i][c] + o[b][c][i] * gtv[i], 0.f) & 0xffffu); }
    }
#undef TQC
#undef HQ
}

__device__ __forceinline__ void imp_task(const AttnArgs& a, float* IMPP, float* IMPF, int tqi, int g) {
    const int lane = threadIdx.x & 63, fr = lane & 15, fq = lane >> 4;
    const int t = tqi * 16 + fr;
    const int tmax = tqi * 16 + 15;
    if (tmax < 31) return;
    const int lim = t >= 31 ? ((t - 31) >> 4) : -1;
    const int nstep = ((((tmax - 31) >> 4) >> 6) + 1) * 4;
    const float negBC = -a.TAB[512];
    bf16x8 qf[HPG][4]; float rl[HPG];
#pragma unroll
    for (int h = 0; h < HPG; ++h) {
        const bf16_t* qp = a.Z + (size_t)t * LDZ + OFF_Q + (g * HPG + h) * HD + fq * 8;
#pragma unroll
        for (int ks = 0; ks < 4; ++ks) qf[h][ks] = *reinterpret_cast<const bf16x8*>(qp + ks * 32);
        const float lv = a.L[(size_t)t * NH + g * HPG + h]; rl[h] = lv > 0.f ? 1.0f / lv : 0.f;
    }
    const bf16_t* kbase = a.KC + (size_t)g * 1024 * HD + (size_t)fr * HD + fq * 8;
    bf16x8 kf[4], kn[4], kn2[4];
#pragma unroll
    for (int ks = 0; ks < 4; ++ks) { kf[ks] = *reinterpret_cast<const bf16x8*>(kbase + ks * 32); kn[ks] = *reinterpret_cast<const bf16x8*>(kbase + (size_t)(nstep > 1 ? 1 : 0) * 16 * HD + ks * 32); }
    float* op = IMPP + ((size_t)t * 4 + g) * 256 + fq; float* of = IMPF + ((size_t)t * 4 + g) * 256 + fq;
    for (int st = 0; st < nstep; ++st) {
        const int sn = (st + 2 < nstep) ? st + 2 : nstep - 1;
#pragma unroll
        for (int ks = 0; ks < 4; ++ks) kn2[ks] = *reinterpret_cast<const bf16x8*>(kbase + (size_t)sn * 16 * HD + ks * 32);
        f32x4 imp4 = {0.f, 0.f, 0.f, 0.f};
        const int n0 = st * 16 + fq * 4;
#pragma unroll
        for (int h = 0; h < HPG; ++h) {
            f32x4 acc = {0.f, 0.f, 0.f, 0.f};
#pragma unroll
            for (int ks = 0; ks < 4; ++ks) acc = __builtin_amdgcn_mfma_f32_16x16x32_bf16(kf[ks], qf[h][ks], acc, 0, 0, 0);
#pragma unroll
            for (int i = 0; i < 4; ++i) { const float e = __builtin_amdgcn_exp2f(fmaf(acc[i], SM_C, negBC)) * rl[h]; imp4[i] += (n0 + i <= lim) ? e : 0.f; }
        }
        op[st * 4] = imp4[0] + 2.0f * (imp4[1] + imp4[2] + imp4[3]);
        of[st * 4] = imp4[0];
#pragma unroll
        for (int ks = 0; ks < 4; ++ks) { kf[ks] = kn[ks]; kn[ks] = kn2[ks]; }
    }
}

__device__ __forceinline__ void topk_load(const float* IMPP, const float* IMPF, int t, int g, f32x4& pp, f32x4& ff) {
    const int lane = threadIdx.x & 63, cur = t >> 6, jb = lane * 4;
    pp = (f32x4){0.f, 0.f, 0.f, 0.f}; ff = pp;
    if (cur > 15 && jb <= cur) { const size_t base = ((size_t)t * 4 + g) * 256; pp = *(const f32x4*)(IMPP + base + jb); ff = *(const f32x4*)(IMPF + base + jb); }
}
__device__ __forceinline__ void topk_task(const f32x4 pp, const f32x4 ff, unsigned* BM, int t, int g) {
    const int lane = threadIdx.x & 63;
    const int cur = t >> 6;
    unsigned nib = 0u;
    if (cur <= 15) { const int jb = lane * 4;
#pragma unroll
        for (int c = 0; c < 4; ++c) if (jb + c <= cur) nib |= 1u << c; }
    else {
        const int jb = lane * 4;
        unsigned key[4];
        {
            float fnext = __shfl_down(ff[0], 1);
            if (lane == 63) fnext = 0.f;
            const float v0 = pp[0] + ff[1], v1 = pp[1] + ff[2], v2 = pp[2] + ff[3], v3 = pp[3] + fnext;
            key[0] = (jb + 0 >= 1 && jb + 0 <= cur - 2) ? __float_as_uint(fmaxf(v0, 0.f)) + 1u : 0u;
            key[1] = (jb + 1 >= 1 && jb + 1 <= cur - 2) ? __float_as_uint(fmaxf(v1, 0.f)) + 1u : 0u;
            key[2] = (jb + 2 >= 1 && jb + 2 <= cur - 2) ? __float_as_uint(fmaxf(v2, 0.f)) + 1u : 0u;
            key[3] = (jb + 3 >= 1 && jb + 3 <= cur - 2) ? __float_as_uint(fmaxf(v3, 0.f)) + 1u : 0u;
        }
        unsigned prefix = 0u; bool exact = false;
        for (int b = 30; b >= 0; --b) {
            const unsigned trial = prefix | (1u << b);
            const int cnt = __popcll(__ballot(key[0] >= trial)) + __popcll(__ballot(key[1] >= trial)) + __popcll(__ballot(key[2] >= trial)) + __popcll(__ballot(key[3] >= trial));
            if (cnt >= 13) { prefix = trial; if (cnt == 13) { exact = true; break; } }
        }
#pragma unroll
        for (int c = 0; c < 4; ++c) if (exact ? (key[c] >= prefix) : (key[c] > prefix)) nib |= 1u << c;
        if (!exact) {
            int need = 13 - (__popcll(__ballot(key[0] > prefix)) + __popcll(__ballot(key[1] > prefix)) + __popcll(__ballot(key[2] > prefix)) + __popcll(__ballot(key[3] > prefix)));
            unsigned tie = 0u;
#pragma unroll
            for (int c = 0; c < 4; ++c) if (key[c] == prefix) tie |= 1u << c;
            for (int guard = 0; need > 0 && guard < 16; ++guard) {
                const unsigned long long any = __ballot(tie != 0u);
                if (any == 0ull) break;
                const int L = __builtin_ctzll(any);
                if (lane == L) { const unsigned low = tie & (0u - tie); nib |= low; tie ^= low; }
                --need;
            }
        }
        if (lane == 0) nib |= 1u;
        if (lane == (cur >> 2)) nib |= 1u << (cur & 3);
        if (lane == ((cur - 1) >> 2)) nib |= 1u << ((cur - 1) & 3);
    }
    unsigned x = nib << (4 * (lane & 7));
    x |= __shfl_xor(x, 1); x |= __shfl_xor(x, 2); x |= __shfl_xor(x, 4);
    if ((lane & 7) == 0) BM[((size_t)t * 4 + g) * 8 + (lane >> 3)] = x;
}
#undef KSWZ
}

template <bool FFN_REMAP = false>
__device__ __forceinline__ void convT(const float* __restrict__ src0, int K, int N, bf16_t* __restrict__ dst, int ldd, LAS float* tile, int bid, int nb, int Nfull = 0, int n0 = 0) {
    const float* __restrict__ src = src0 + n0; if (Nfull == 0) Nfull = N;
    const int tid = threadIdx.x, tk = K >> 6, tn = (N + 63) >> 6, total = tk * tn;
    const int r = tid >> 4, c4 = (tid & 15) * 4;
    f32x4 v[2] = {{0.f, 0.f, 0.f, 0.f}, {0.f, 0.f, 0.f, 0.f}}, vn[2];
    if (bid < total) { const int nti = bid % tn, kti = bid / tn, ng = nti * 64 + c4;
#pragma unroll
        for (int h = 0; h < 2; ++h) if (ng < N) v[h] = *(const f32x4*)(src + (size_t)(kti * 64 + r + h * 32) * Nfull + ng); }
    for (int idx = bid; idx < total; idx += nb) {
        const int nti = idx % tn, kti = idx / tn;
#pragma unroll
        for (int h = 0; h < 2; ++h) { LAS float* tp = tile + (r + h * 32) * 65 + c4; tp[0] = v[h][0]; tp[1] = v[h][1]; tp[2] = v[h][2]; tp[3] = v[h][3]; }
        {
            const int nx = idx + nb; vn[0] = (f32x4){0.f, 0.f, 0.f, 0.f}; vn[1] = vn[0];
            if (nx < total) { const int nti2 = nx % tn, kti2 = nx / tn, ng2 = nti2 * 64 + c4;
#pragma unroll
                for (int h = 0; h < 2; ++h) if (ng2 < N) vn[h] = *(const f32x4*)(src + (size_t)(kti2 * 64 + r + h * 32) * Nfull + ng2); } }
        __syncthreads();
        const int n = tid >> 3, k8 = (tid & 7) * 8, ngl = nti * 64 + n;
        float e[8];
#pragma unroll
        for (int i = 0; i < 8; ++i) e[i] = tile[(k8 + i) * 65 + n];
        if (ngl < N) { u32x4 w; w.x = cvt_pk_bf16(e[0], e[1]); w.y = cvt_pk_bf16(e[2], e[3]); w.z = cvt_pk_bf16(e[4], e[5]); w.w = cvt_pk_bf16(e[6], e[7]);
            int drow = ngl; if (FFN_REMAP) { const int up = ngl >= DFF ? 1 : 0, f = ngl - up * DFF; drow = (f >> 7) * 256 + up * 128 + (f & 127); }
            *(u32x4*)(dst + (size_t)drow * ldd + kti * 64 + k8) = w; }
        __syncthreads();
        v[0] = vn[0]; v[1] = vn[1];
    }
}
__device__ __forceinline__ void convT8(const float* __restrict__ src0, int K, int N, unsigned char* __restrict__ dst, int ldd, float scale, LAS float* tile, int bid, int nb, int Nfull = 0, int n0 = 0) {
    const float* __restrict__ src = src0 + n0; if (Nfull == 0) Nfull = N;
    const int tid = threadIdx.x, tk = K >> 6, tn = (N + 63) >> 6, total = tk * tn;
    const int r = tid >> 4, c4 = (tid & 15) * 4;
    f32x4 v[2] = {{0.f, 0.f, 0.f, 0.f}, {0.f, 0.f, 0.f, 0.f}}, vn[2];
    if (bid < total) { const int nti = bid % tn, kti = bid / tn, ng = nti * 64 + c4;
#pragma unroll
        for (int h = 0; h < 2; ++h) if (ng < N) v[h] = *(const f32x4*)(src + (size_t)(kti * 64 + r + h * 32) * Nfull + ng); }
    for (int idx = bid; idx < total; idx += nb) {
        const int nti = idx % tn, kti = idx / tn;
#pragma unroll
        for (int h = 0; h < 2; ++h) { LAS float* tp = tile + (r + h * 32) * 65 + c4; tp[0] = v[h][0]; tp[1] = v[h][1]; tp[2] = v[h][2]; tp[3] = v[h][3]; }
        { const int nx = idx + nb; vn[0] = (f32x4){0.f, 0.f, 0.f, 0.f}; vn[1] = vn[0];
            if (nx < total) { const int nti2 = nx % tn, kti2 = nx / tn, ng2 = nti2 * 64 + c4;
#pragma unroll
                for (int h = 0; h < 2; ++h) if (ng2 < N) vn[h] = *(const f32x4*)(src + (size_t)(kti2 * 64 + r + h * 32) * Nfull + ng2); } }
        __syncthreads();
        const int n = tid >> 3, k8 = (tid & 7) * 8, ngl = nti * 64 + n;
        float e[8];
#pragma unroll
        for (int i = 0; i < 8; ++i) e[i] = tile[(k8 + i) * 65 + n] * scale;
        if (ngl < N) { int p0 = __builtin_amdgcn_cvt_pk_fp8_f32(e[0], e[1], 0, false); p0 = __builtin_amdgcn_cvt_pk_fp8_f32(e[2], e[3], p0, true);
            int p1 = __builtin_amdgcn_cvt_pk_fp8_f32(e[4], e[5], 0, false); p1 = __builtin_amdgcn_cvt_pk_fp8_f32(e[6], e[7], p1, true);
            *(u32x2*)(dst + (size_t)ngl * ldd + kti * 64 + k8) = (u32x2){(unsigned)p0, (unsigned)p1}; }
        __syncthreads();
        v[0] = vn[0]; v[1] = vn[1];
    }
}
__device__ __forceinline__ void rmsnorm_rows(const float* __restrict__ src, const float* __restrict__ w, bf16_t* __restrict__ dst, int rows, int gw, int nw, unsigned char* __restrict__ dst8 = nullptr) {
    const int lane = threadIdx.x & 63;
    f32x4 v[16], vn[16];
    if (gw < rows) { const f32x4* sp = (const f32x4*)(src + (size_t)gw * DM);
#pragma unroll
        for (int i = 0; i < 16; ++i) v[i] = sp[lane + 64 * i]; }
    for (int row = gw; row < rows; row += nw) {
        const int nr = row + nw < rows ? row + nw : row;
        { const f32x4* sp = (const f32x4*)(src + (size_t)nr * DM);
#pragma unroll
          for (int i = 0; i < 16; ++i) vn[i] = sp[lane + 64 * i]; }
        float ss = 0.f;
#pragma unroll
        for (int i = 0; i < 16; ++i) ss += v[i][0] * v[i][0] + v[i][1] * v[i][1] + v[i][2] * v[i][2] + v[i][3] * v[i][3];
        ss = wave_sum(ss);
        const float rstd = rsqrtf(ss * (1.0f / DM) + EPS);
#pragma unroll
        for (int i = 0; i < 16; ++i) { const f32x4 ww = ((const f32x4*)w)[lane + 64 * i];
            u32x2 o; o.x = cvt_pk_bf16(v[i][0] * rstd * ww[0], v[i][1] * rstd * ww[1]); o.y = cvt_pk_bf16(v[i][2] * rstd * ww[2], v[i][3] * rstd * ww[3]);
            *(u32x2*)(dst + (size_t)row * DM + (lane + 64 * i) * 4) = o;
            if (dst8) { int pk = __builtin_amdgcn_cvt_pk_fp8_f32(v[i][0] * rstd * ww[0], v[i][1] * rstd * ww[1], 0, false); pk = __builtin_amdgcn_cvt_pk_fp8_f32(v[i][2] * rstd * ww[2], v[i][3] * rstd * ww[3], pk, true);
                *(int*)(dst8 + (size_t)row * DM + (lane + 64 * i) * 4) = pk; } }
#pragma unroll
        for (int i = 0; i < 16; ++i) v[i] = vn[i];
    }
}

struct Ptrs {
    bf16_t *Win, *Wo, *Wfi, *Wfo, *Wg, *Wple, *Wpool, *Wc1k, *Wc1v, *XN, *PB, *Z, *M, *KC, *VC, *MIX, *ACT, *ERAW;
    float *COS, *SIN, *TAB, *G, *H1, *L, *OACC, *IMPP, *IMPF, *ERSTD; unsigned* BM;
};

__device__ __forceinline__ void phase_prologue(const Params& P, const Ptrs& W, LAS unsigned char* lds) {
    const int bid = blockIdx.x, nb = gridDim.x, tid = threadIdx.x, lane = tid & 63, wv = tid >> 6;
    const int gw = bid * NWAVES + wv, nw = nb * NWAVES; const size_t gt = (size_t)bid * NTHREADS + tid, ntot = (size_t)nb * NTHREADS;
    LAS float* tile = (LAS float*)lds;
    rmsnorm_rows(P.x, P.norm1_w, W.XN, S_, gw, nw, P.ws + WS_XN8);
    convT(P.w_in, DM, POOLW, W.Win, DM, tile, bid, nb, INW, 0);
    convT(P.w_in, DM, INW - OFF_G, W.Win + (size_t)OFF_G * DM, DM, tile, bid, nb, INW, OFF_G);
    convT8(P.w_in, DM, OFF_G - POOLW, P.ws + WS_WIN8, DM, WG8_SCALE, tile, bid, nb, INW, POOLW);
    for (size_t i = gt; i < (size_t)(LDZ - INW) * DM / 8; i += ntot) *(u32x4*)(W.Win + (size_t)INW * DM + i * 8) = (u32x4){0u, 0u, 0u, 0u};
    convT(P.w_o, DM, DM, W.Wo, DM, tile, bid, nb);
    convT<true>(P.w_ffn_in, DM, NFI, W.Wfi, DM, tile, bid, nb);
    for (size_t i = gt; i < (size_t)2 * DM / 8; i += ntot) *(u32x4*)(W.XN - 2 * DM + i * 8) = (u32x4){0u, 0u, 0u, 0u};
    convT(P.w_ffn_out, DFF, DM, W.Wfo, DFF, tile, bid, nb);
    convT8(P.w_ple_gate, DM, DM, (unsigned char*)W.Wg, DM, WG8_SCALE, tile, bid, nb);
    convT(P.w_ple_proj, PLE, DM, W.Wple, PLE, tile, bid, nb);
    for (int g = 0; g < 4; ++g) convT(P.w_pool + (size_t)g * 65536, 256, 256, W.Wpool + (size_t)g * 65536, 256, tile, bid, nb);
    convT(P.cmp_k_w1, 4096, 256, W.Wc1k, 4096, tile, bid, nb);
    convT(P.cmp_v_w1, 4096, 256, W.Wc1v, 4096, tile, bid, nb);
    { constexpr size_t NP8 = (size_t)S_ * PLE / 8;
      for (size_t ib = gt; ib < NP8; ib += 4 * ntot) { f32x4 av[4], bv[4];
#pragma unroll
          for (int k = 0; k < 4; ++k) { size_t i = ib + k * ntot; if (i >= NP8) i = NP8 - 1; av[k] = *(const f32x4*)(P.p + i * 8); bv[k] = *(const f32x4*)(P.p + i * 8 + 4); }
#pragma unroll
          for (int k = 0; k < 4; ++k) { const size_t i = ib + k * ntot; if (i < NP8) { u32x4 w; w.x = cvt_pk_bf16(av[k][0], av[k][1]); w.y = cvt_pk_bf16(av[k][2], av[k][3]); w.z = cvt_pk_bf16(bv[k][0], bv[k][1]); w.w = cvt_pk_bf16(bv[k][2], bv[k][3]); *(u32x4*)(W.PB + i * 8) = w; } } } }
    for (size_t i = gt; i < (size_t)S_ * 16; i += ntot) { const int t = (int)(i >> 4), fi = (int)(i & 15);
        const float inv = exp2f(-(float)fi * (18.931568569324174f / 16.0f)); const float ang = (float)P.positions[t] * inv;
        const double ad = (double)ang; const double kk = rint(ad * 0.15915494309189535); const float rf = (float)(ad - kk * 6.283185307179586);
        W.COS[i] = __cosf(rf); W.SIN[i] = __sinf(rf); }
    for (int task = gw; task < 128; task += nw) { const int which = task >> 6, r0 = (task & 63) * 64; const float* pe = which ? P.cmp_pos_v : P.cmp_pos_k; const float* w1 = which ? P.cmp_v_w1 : P.cmp_k_w1;
        f32x4 s = {0.f, 0.f, 0.f, 0.f};
#pragma unroll 8
        for (int r = 0; r < 64; ++r) { const f32x4 wv = *(const f32x4*)(w1 + (size_t)(r0 + r) * 256 + lane * 4); s += wv * pe[r0 + r]; }
        float* cbp = (float*)(P.ws + WS_CBIAS) + which * 256 + lane * 4;
        unsafeAtomicAdd(cbp + 0, s[0]); unsafeAtomicAdd(cbp + 1, s[1]); unsafeAtomicAdd(cbp + 2, s[2]); unsafeAtomicAdd(cbp + 3, s[3]); }
    if (gw == 0) { float mq = fmaxf(fabsf(P.q_norm_w[lane]), fabsf(P.q_norm_w[lane + 64])); mq = wave_max(mq);
        float mc = wave_max(fmaxf(fabsf(P.k_norm_cmp_w[lane]), fabsf(P.k_norm_cmp_w[lane + 64])));
        float ms = wave_max(fmaxf(fabsf(P.k_norm_slc_w[lane]), fabsf(P.k_norm_slc_w[lane + 64])));
        float mw = wave_max(fmaxf(fabsf(P.k_norm_win_w[lane]), fabsf(P.k_norm_win_w[lane + 64])));
        const float c = 11.313708498984761f * 1.4426950408889634f * mq * 1.01f;
        if (lane == 0) { W.TAB[512] = c * mc; W.TAB[513] = c * ms; W.TAB[514] = c * mw; } }
}

__device__ __forceinline__ void phase_postz(const Params& P, const Ptrs& W, int gw, int nw) {
    const int tid = threadIdx.x, lane = tid & 63;
    const f32x2 wq = *(const f32x2*)(P.q_norm_w + 2 * lane), wks = *(const f32x2*)(P.k_norm_slc_w + 2 * lane), wkw = *(const f32x2*)(P.k_norm_win_w + 2 * lane);
    for (int t = gw; t < S_; t += nw) {
        bf16_t* zr = W.Z + (size_t)t * LDZ;
        float cs0 = 0.f, cs1 = 0.f, sn0 = 0.f, sn1 = 0.f;
        if (lane < 16) { const int i0 = (2 * lane) & 15; cs0 = W.COS[t * 16 + i0]; cs1 = W.COS[t * 16 + i0 + 1]; sn0 = W.SIN[t * 16 + i0]; sn1 = W.SIN[t * 16 + i0 + 1]; }
        unsigned uv[32];
#pragma unroll
        for (int v = 0; v < 32; ++v) { const int col = v < 24 ? OFF_Q + v * HD : (v < 28 ? OFF_KV + 2 * 512 + (v - 24) * HD : OFF_KV + 4 * 512 + (v - 28) * HD);
            uv[v] = *((const unsigned*)(zr + col) + lane); }
#pragma unroll
        for (int v = 0; v < 32; ++v) {
            const f32x2 ww = v < 24 ? wq : (v < 28 ? wks : wkw);
            const unsigned u = uv[v]; const float x0 = bf_lo(u), x1 = bf_hi(u);
            const float ss = wave_sum(x0 * x0 + x1 * x1);
            const float rstd = rsqrtf(ss * (1.0f / HD) + EPS);
            float y0 = x0 * rstd * ww[0], y1 = x1 * rstd * ww[1];
            const float p0 = __shfl_xor(y0, 8), p1 = __shfl_xor(y1, 8);
            if (lane < 8) { y0 = y0 * cs0 - p0 * sn0; y1 = y1 * cs1 - p1 * sn1; }
            else if (lane < 16) { y0 = y0 * cs0 + p0 * sn0; y1 = y1 * cs1 + p1 * sn1; }
            uv[v] = cvt_pk_bf16(y0, y1);
        }
        {
            const int gi = lane >> 4, wlen = 2 << gi, c0 = lane * 16; const int cnt = (t + 1) < wlen ? (t + 1) : wlen;
            float s[16];
#pragma unroll
            for (int i = 0; i < 16; ++i) s[i] = 0.f;
            float cur[16];
#pragma unroll
            for (int bt = 0; bt < 2; ++bt) {
                u32x4 ra[8], rb[8];
#pragma unroll
                for (int i = 0; i < 8; ++i) { const int ii = bt * 8 + i; const size_t row = (size_t)(ii < cnt ? t - ii : t);
                    ra[i] = *(const u32x4*)(W.Z + row * LDZ + c0); rb[i] = *(const u32x4*)(W.Z + row * LDZ + c0 + 8); }
#pragma unroll
                for (int i = 0; i < 8; ++i) { const int ii = bt * 8 + i; const float mk = ii < cnt ? 1.0f : 0.0f; const u32x4 a = ra[i], b = rb[i];
                    const float ev[16] = {bf_lo(a.x), bf_hi(a.x), bf_lo(a.y), bf_hi(a.y), bf_lo(a.z), bf_hi(a.z), bf_lo(a.w), bf_hi(a.w), bf_lo(b.x), bf_hi(b.x), bf_lo(b.y), bf_hi(b.y), bf_lo(b.z), bf_hi(b.z), bf_lo(b.w), bf_hi(b.w)};
#pragma unroll
                    for (int q = 0; q < 16; ++q) { s[q] += ev[q] * mk; if (ii == 0) cur[q] = ev[q]; } }
                if (bt == 0 && __all(cnt <= 8)) break;
            }
            const float rc = 1.0f / (float)cnt;
            u32x4 o0, o1;
            o0.x = cvt_pk_bf16(s[0] * rc - cur[0], s[1] * rc - cur[1]); o0.y = cvt_pk_bf16(s[2] * rc - cur[2], s[3] * rc - cur[3]);
            o0.z = cvt_pk_bf16(s[4] * rc - cur[4], s[5] * rc - cur[5]); o0.w = cvt_pk_bf16(s[6] * rc - cur[6], s[7] * rc - cur[7]);
            o1.x = cvt_pk_bf16(s[8] * rc - cur[8], s[9] * rc - cur[9]); o1.y = cvt_pk_bf16(s[10] * rc - cur[10], s[11] * rc - cur[11]);
            o1.z = cvt_pk_bf16(s[12] * rc - cur[12], s[13] * rc - cur[13]); o1.w = cvt_pk_bf16(s[14] * rc - cur[14], s[15] * rc - cur[15]);
            *(u32x4*)(W.M + (size_t)t * POOLW + c0) = o0; *(u32x4*)(W.M + (size_t)t * POOLW + c0 + 8) = o1;
        }
#pragma unroll
        for (int v = 0; v < 32; ++v) { const int col = v < 24 ? OFF_Q + v * HD : (v < 28 ? OFF_KV + 2 * 512 + (v - 24) * HD : OFF_KV + 4 * 512 + (v - 28) * HD);
            *((unsigned*)(zr + col) + lane) = uv[v]; }

    }
}

__device__ __forceinline__ void phase_cmpfin(const Params& P, const Ptrs& W) {
    const int tid = threadIdx.x, lane = tid & 63, gw = blockIdx.x * NWAVES + (tid >> 6), nw = gridDim.x * NWAVES;
    const f32x2 wk = *(const f32x2*)(P.k_norm_cmp_w + 2 * lane);
    for (int task = gw; task < 8192; task += nw) {
        const int tk = __builtin_amdgcn_readfirstlane(task);
        const int which = tk >> 12, g = (tk >> 10) & 3, n = tk & 1023;
        bf16_t* dst = (which ? W.VC : W.KC) + ((size_t)g * 1024 + n) * HD;
        if (n == 1023) { ((unsigned*)dst)[lane] = 0u; continue; }
        const float* h = W.H1 + (size_t)tk * 256; const float* w2 = which ? P.cmp_v_w2 : P.cmp_k_w2;
        float a0 = 0.f, a1 = 0.f;
        for (int j = 0; j < 256; ++j) { const float hj = h[j]; const f32x2 wv = *(const f32x2*)(w2 + j * HD + 2 * lane); a0 += hj * wv[0]; a1 += hj * wv[1]; }
        if (which == 0) {
            const float ss = wave_sum(a0 * a0 + a1 * a1); const float rstd = rsqrtf(ss * (1.0f / HD) + EPS);
            a0 = a0 * rstd * wk[0]; a1 = a1 * rstd * wk[1];
            const int tp = 16 * n + 31; const float p0 = __shfl_xor(a0, 8), p1 = __shfl_xor(a1, 8);
            if (lane < 16) { const int i0 = (2 * lane) & 15; const float cs0 = W.COS[tp * 16 + i0], cs1 = W.COS[tp * 16 + i0 + 1], sn0 = W.SIN[tp * 16 + i0], sn1 = W.SIN[tp * 16 + i0 + 1];
                if (lane < 8) { a0 = a0 * cs0 - p0 * sn0; a1 = a1 * cs1 - p1 * sn1; } else { a0 = a0 * cs0 + p0 * sn0; a1 = a1 * cs1 + p1 * sn1; } }
        }
        ((unsigned*)dst)[lane] = cvt_pk_bf16(a0, a1);
    }
}

__device__ __forceinline__ void phase_erstd(const Ptrs& W) {
    const int tid = threadIdx.x, lane = tid & 63, gw = blockIdx.x * NWAVES + (tid >> 6), nw = gridDim.x * NWAVES;
    u32x4 a[8], an[8];
    if (gw < S_) { const u32x4* sp = (const u32x4*)(W.ERAW + (size_t)gw * DM);
#pragma unroll
        for (int i = 0; i < 8; ++i) a[i] = sp[lane + 64 * i]; }
    for (int row = gw; row < S_; row += nw) {
        const int nr = row + nw < S_ ? row + nw : row;
        { const u32x4* sp = (const u32x4*)(W.ERAW + (size_t)nr * DM);
#pragma unroll
          for (int i = 0; i < 8; ++i) an[i] = sp[lane + 64 * i]; }
        float ss = 0.f;
#pragma unroll
        for (int i = 0; i < 8; ++i) {
            const float e0 = bf_lo(a[i].x), e1 = bf_hi(a[i].x), e2 = bf_lo(a[i].y), e3 = bf_hi(a[i].y), e4 = bf_lo(a[i].z), e5 = bf_hi(a[i].z), e6 = bf_lo(a[i].w), e7 = bf_hi(a[i].w);
            ss += e0 * e0 + e1 * e1 + e2 * e2 + e3 * e3 + e4 * e4 + e5 * e5 + e6 * e6 + e7 * e7; }
        ss = wave_sum(ss);
        if (lane == 0) W.ERSTD[row] = rsqrtf(ss * (1.0f / DM) + EPS);
#pragma unroll
        for (int i = 0; i < 8; ++i) a[i] = an[i];
    }
}

constexpr int N_PHASES = 11;
__device__ __forceinline__ Params kargs() {
#if defined(__HIP_DEVICE_COMPILE__)
    unsigned long long p = (unsigned long long)__builtin_amdgcn_kernarg_segment_ptr();
    asm volatile("" : "+s"(p));
    return *(const __attribute__((address_space(4))) Params*)p;
#else
    return Params{};
#endif
}
__device__ __forceinline__ Ptrs mkptrs(unsigned char* ws) {
    Ptrs W;
    W.Win = (bf16_t*)(ws + WS_WIN); W.Wo = (bf16_t*)(ws + WS_WO); W.Wfi = (bf16_t*)(ws + WS_WFI); W.Wfo = (bf16_t*)(ws + WS_WFO); W.Wg = (bf16_t*)(ws + WS_WG);
    W.Wple = (bf16_t*)(ws + WS_WPLE); W.Wpool = (bf16_t*)(ws + WS_WPOOL); W.Wc1k = (bf16_t*)(ws + WS_WC1K); W.Wc1v = (bf16_t*)(ws + WS_WC1V);
    W.XN = (bf16_t*)(ws + WS_XN); W.PB = (bf16_t*)(ws + WS_PB); W.Z = (bf16_t*)(ws + WS_Z); W.M = (bf16_t*)(ws + WS_M); W.KC = (bf16_t*)(ws + WS_KC); W.VC = (bf16_t*)(ws + WS_VC);
    W.MIX = (bf16_t*)(ws + WS_MIX); W.ACT = (bf16_t*)(ws + WS_ACT); W.ERAW = (bf16_t*)(ws + WS_ERAW);
    W.COS = (float*)(ws + WS_COS); W.SIN = (float*)(ws + WS_SIN); W.TAB = (float*)(ws + WS_TAB); W.G = (float*)(ws + WS_G); W.H1 = (float*)(ws + WS_H1); W.L = (float*)(ws + WS_L);
    W.OACC = (float*)(ws + WS_OACC); W.IMPP = (float*)(ws + WS_IMPP); W.IMPF = (float*)(ws + WS_IMPF); W.ERSTD = (float*)(ws + WS_ERSTD); W.BM = (unsigned*)(ws + WS_BM);
    return W;
}
__global__ void __launch_bounds__(NTHREADS, 2) fwd(Params Punused) {
    extern __shared__ __attribute__((aligned(16))) unsigned char lds_raw[];
    LAS unsigned char* lds = (LAS unsigned char*)lds_raw;
    const int tid = threadIdx.x;
    const int G = gridDim.x, bid = blockIdx.x;
    const int gw = bid * NWAVES + (tid >> 6), nw = G * NWAVES;

    if (tid < 16) ((LAS unsigned*)(lds + LDS_MISC))[tid] = 0u;
    __syncthreads();
    int lo, hi; XcdBarrier bar;
    { const Params P = kargs(); lo = P.ph_lo; hi = P.ph_hi;
      bar.bar = (unsigned*)(P.ws + WS_CTL); bar.x = 0; bar.st = (volatile LAS unsigned*)(lds + LDS_MISC);
      if (hi - lo > 1) bar = xcd_barrier_post((unsigned*)(P.ws + WS_CTL), (volatile LAS unsigned*)(lds + LDS_MISC)); }
#ifdef PH_MASK
#define IN(k) (((PH_MASK >> (k)) & 1) && lo <= (k) && (k) < hi)
#else
#define IN(k) (lo <= (k) && (k) < hi)
#endif
#define SEAM(k) do { if (IN(k) && IN((k) + 1)) xcd_barrier(bar); } while (0)
#define PHASE_VARS const Params P = kargs(); const Ptrs W = mkptrs(P.ws); (void)W;
#define ATT_ARGS att::AttnArgs AA{W.Z, W.KC, W.VC, W.G, W.L, W.OACC, W.MIX, W.BM, W.TAB};

    if (IN(0)) { PHASE_VARS REP(0) { phase_prologue(P, W, lds); } SEAM(0); }
    if (IN(1)) {
        PHASE_VARS
        { pg8::GStd g{(const char*)W.XN, (const char*)W.Win, DM, DM, DM / 64}; pg8::StaticOrder S; S.init(S_ / 256, POOLW / 256, G, bid);
          pg8::EpiBf16 E{W.Z, LDZ}; pg8::gemm_phase(lds, g, S, E); }
        { pg8::GStd g{(const char*)(P.ws + WS_XN8), (const char*)(P.ws + WS_WIN8), DM / 2, DM / 2, DM / 128}; pg8::StaticOrder S; S.init(S_ / 256, (OFF_G - POOLW) / 256, G, bid);
          pg8::EpiBf16S E{W.Z + POOLW, LDZ, 1.0f / WG8_SCALE}; pg8::gemm_phase<pg8::GStd, pg8::EpiBf16S, true>(lds, g, S, E); }
        SEAM(1);
    }
    if (IN(2)) {
        PHASE_VARS
        if (G > 64) {
            if (bid < 32) { pg8::GCmp g{(const char*)W.Z, (const char*)W.Wc1k, (const char*)W.Wc1v, 16 * LDZ, 4096, 64}; pg8::StaticOrder S; S.init(32, 1, 32, bid);
                pg8::EpiCmpGelu E{W.H1, (const float*)(P.ws + WS_CBIAS)}; pg8::gemm_phase(lds, g, S, E); }
            else if (bid < 96) {
                pg8::GStd g{(const char*)W.XN, (const char*)(W.Win + (size_t)OFF_G * DM), DM, DM, DM / 64}; pg8::StaticOrder S; S.init(S_ / 256, 1, 64, bid - 32);
                pg8::EpiBf16 E{W.Z + OFF_G, LDZ}; pg8::gemm_phase(lds, g, S, E); }
            else phase_postz(P, W, (bid - 96) * NWAVES + (tid >> 6), (G - 96) * NWAVES);
        } else {
            { pg8::GStd g{(const char*)W.XN, (const char*)(W.Win + (size_t)OFF_G * DM), DM, DM, DM / 64}; pg8::StaticOrder S; S.init(S_ / 256, 1, G, bid);
              pg8::EpiBf16 E{W.Z + OFF_G, LDZ}; pg8::gemm_phase(lds, g, S, E); }
            { pg8::GCmp g{(const char*)W.Z, (const char*)W.Wc1k, (const char*)W.Wc1v, 16 * LDZ, 4096, 64}; pg8::StaticOrder S; S.init(32, 1, G, bid);
              pg8::EpiCmpGelu E{W.H1, (const float*)(P.ws + WS_CBIAS)}; pg8::gemm_phase(lds, g, S, E); }
            phase_postz(P, W, gw, nw);
        }
        SEAM(2);
    }
    if (IN(3)) {
        PHASE_VARS
        {
            const size_t i0 = (size_t)bid * NTHREADS + tid, st = (size_t)G * NTHREADS, NG = (size_t)S_ * NGATE;
            for (size_t ib = i0; ib < NG; ib += 9 * st) { float zv[9];
#pragma unroll
                for (int k = 0; k < 9; ++k) { size_t i = ib + k * st; if (i >= NG) i = NG - 1; const int t = (int)(i / NGATE), c = (int)(i % NGATE); zv[k] = bf2f(W.Z[(size_t)t * LDZ + OFF_G + c]); }
#pragma unroll
                for (int k = 0; k < 9; ++k) { const size_t i = ib + k * st; if (i < NG) W.G[i] = sigmoidf_(zv[k]); } } }
        phase_cmpfin(P, W);
        { pg8::GPool g{(const char*)W.M, (const char*)W.Wpool, POOLW, 256, 4}; pg8::StaticOrder S; S.init(S_ / 256, 4, G, bid);
          pg8::EpiBf16Scale E{W.MIX, DM, P.pool_scale}; pg8::gemm_phase(lds, g, S, E); }
        SEAM(3);
    }
    if (IN(4)) {
        PHASE_VARS ATT_ARGS
        REP(4)
        for (int base = 0, rnd = 0; base < 1536; base += G, ++rnd) {
            int qt, g, hp;
            if (G == 256) { const int x = bid & 7, r = bid >> 3, qp = (rnd / 3) ? 63 - r : r; if (rnd >= 6) break; g = x & 3; qt = 2 * qp + (x >> 2); hp = rnd % 3; }
            else { const int Lu = base + ((rnd & 1) ? G - 1 - bid : bid); if (Lu >= 1536) continue; qt = Lu / 12; const int rem = Lu % 12; g = rem / 3; hp = rem % 3; }
            att::attn_unit<att::MODE_CMP>(AA, (LAS char*)lds, qt, g, hp);
            asm volatile("s_waitcnt vmcnt(0)" ::: "memory");
            att::attn_unit<att::MODE_WIN>(AA, (LAS char*)lds, qt, g, hp);
            if (G == 256 && hp == 2) {
                asm volatile("s_waitcnt vmcnt(0)" ::: "memory");
                const int tqi = qt * 8 + (tid >> 6);
                att::imp_task(AA, W.IMPP, W.IMPF, tqi, g);
                asm volatile("s_waitcnt vmcnt(0)" ::: "memory");
                f32x4 pp, ff, pn, fn; att::topk_load(W.IMPP, W.IMPF, tqi * 16, g, pp, ff);
                for (int q = 0; q < 16; ++q) { att::topk_load(W.IMPP, W.IMPF, tqi * 16 + (q < 15 ? q + 1 : q), g, pn, fn); att::topk_task(pp, ff, W.BM, tqi * 16 + q, g); pp = pn; ff = fn; } } }
        if (G != 256) SEAM(4);
    }
    if (IN(5)) {
        PHASE_VARS ATT_ARGS
        if (G != 256)
        for (int k = gw, r = 0; k < 4096; k += nw, ++r) { const int hiT = (r + 1) * nw < 4096 ? (r + 1) * nw : 4096;
            const int task = (r & 1) ? hiT - 1 - (k - r * nw) : k;
            att::imp_task(AA, W.IMPP, W.IMPF, task >> 2, task & 3);
            asm volatile("s_waitcnt vmcnt(0)" ::: "memory");
            { const int tb = (task >> 2) * 16, gg = task & 3; f32x4 pp, ff, pn, fn;
              att::topk_load(W.IMPP, W.IMPF, tb, gg, pp, ff);
              for (int q = 0; q < 16; ++q) { att::topk_load(W.IMPP, W.IMPF, tb + (q < 15 ? q + 1 : q), gg, pn, fn); att::topk_task(pp, ff, W.BM, tb + q, gg); pp = pn; ff = fn; } } }
        SEAM(5);
    }
    if (IN(6)) {
        PHASE_VARS ATT_ARGS
#if SLC16
        for (int base = 0, rnd = 0; base < 1024 + G; base += G, ++rnd) {
            int ut, g;
            if (G == 256) { const int x = bid & 7, r = bid >> 3, k = rnd * 32 + ((rnd & 1) ? 31 - r : r); if (k >= 128) break; g = x & 3; ut = 255 - (2 * k + (x >> 2)); }
            else { const int Lu = base + ((rnd & 1) ? G - 1 - bid : bid); if (Lu >= 1024) continue; ut = 255 - Lu / 4; g = Lu % 4; }
            att::slc16_unit(AA, (LAS char*)lds, ut, g); }
#else
        REP(6)
        for (int base = 0, rnd = 0; base < 1640 + G; base += G, ++rnd) {
            int ut, g;
            if (G == 256) { const int x = bid & 7, r = bid >> 3, k = rnd * 32 + ((rnd & 1) ? 31 - r : r); if (k >= 205) break; g = x & 3; ut = 409 - (2 * k + (x >> 2)); }
            else { const int Lu = base + ((rnd & 1) ? G - 1 - bid : bid); if (Lu >= 1640) continue; ut = 409 - Lu / 4; g = Lu % 4; }
            att::attn_unit<att::MODE_SLC>(AA, (LAS char*)lds, ut, g, 0); }
#endif
        SEAM(6);
    }
    if (IN(7)) {
        PHASE_VARS
        { pg8::GStd g{(const char*)W.MIX, (const char*)W.Wo, DM, DM, DM / 64}; pg8::StaticOrder S; S.init(S_ / 256, DM / 256, G, bid);
          pg8::EpiResNorm E{P.x, P.out, W.XN, P.norm2_w, (float*)(P.ws + WS_SSQ1), DM}; pg8::gemm_phase(lds, g, S, E); }
        { pg8::GStd g{(const char*)W.PB, (const char*)W.Wple, PLE, PLE, PLE / 64}; pg8::StaticOrder S; S.init(S_ / 256, DM / 256, G, bid);
          pg8::EpiBf16Ssq E{W.ERAW, DM, (float*)(P.ws + WS_SSQ3)}; pg8::gemm_phase(lds, g, S, E); }
        SEAM(7);
    }
    if (IN(8)) {
        PHASE_VARS
        pg8::GFfn g{(const char*)W.XN, (const char*)W.Wfi, DM, DM, DM / 64}; pg8::StaticOrder S; S.init(65, DFF / 128, G, bid);
        pg8::EpiFfn E{W.ACT, P.conv_w, P.conv_b, (LAS float*)(lds + LDS_XCH), (const float*)(P.ws + WS_SSQ1)}; REP(8) { pg8::gemm_phase(lds, g, S, E); } SEAM(8);
    }
    if (IN(9)) {
        PHASE_VARS
        pg8::GStd g{(const char*)W.ACT, (const char*)W.Wfo, DFF, DFF, DFF / 64}; pg8::StaticOrder S; S.init(S_ / 256, DM / 256, G, bid);
        pg8::EpiResNormF8 E{P.out, P.out, W.XN, P.ple_gate_norm_w, (float*)(P.ws + WS_SSQ2), DM}; pg8::gemm_phase(lds, g, S, E); SEAM(9);
    }
    if (IN(10)) {
        PHASE_VARS
        pg8::GStd g{(const char*)W.XN, (const char*)W.Wg, DM / 2, DM / 2, DM / 128}; pg8::StaticOrder S; S.init(S_ / 256, DM / 256, G, bid);
        pg8::EpiGate E{P.out, W.ERAW, (const float*)(P.ws + WS_SSQ3), P.ple_norm_w, (const float*)(P.ws + WS_SSQ2), DM, 1.0f / WG8_SCALE};
        pg8::gemm_phase<pg8::GStd, pg8::EpiGate, true>(lds, g, S, E);
    }
#undef IN
#undef SEAM
}

extern "C" void kernel_launch(void* const* d_in, const int* in_sizes, int n_in, void* d_out, int out_size, void* d_ws, size_t ws_size, hipStream_t stream) {
    static int grid = 0;
    if (grid == 0) {
        if (n_in != 27 || in_sizes[0] != S_ * DM || out_size != S_ * DM || ws_size < WS_NEED) {
            fprintf(stderr, "kernel_launch: unexpected shapes (n_in %d, in0 %d, out %d, ws %zu < %zu); nothing launched\n", n_in, n_in > 0 ? in_sizes[0] : -1, out_size, ws_size, (size_t)WS_NEED); grid = -1; return; }
        int dev = 0, cus = 0, per_cu = 0;
        if (hipGetDevice(&dev) != hipSuccess || hipDeviceGetAttribute(&cus, hipDeviceAttributeMultiprocessorCount, dev) != hipSuccess) { grid = -1; return; }
        if (hipFuncSetAttribute((const void*)fwd, hipFuncAttributeMaxDynamicSharedMemorySize, LDS_BYTES) != hipSuccess) { fprintf(stderr, "kernel_launch: hipFuncSetAttribute failed\n"); grid = -1; return; }
        if (hipOccupancyMaxActiveBlocksPerMultiprocessor(&per_cu, (const void*)fwd, NTHREADS, LDS_BYTES) != hipSuccess || per_cu < 1) { fprintf(stderr, "kernel_launch: occupancy query says %d\n", per_cu); (void)hipGetLastError(); }
        grid = cus > 256 ? 256 : cus;
    }
    if (grid < 0) return;
    (void)hipMemsetAsync((char*)d_ws + WS_CTL, 0, CTL_BYTES, stream);
    Params P{};
    const float** fp = (const float**)&P;
    P.x = (const float*)d_in[0]; P.p = (const float*)d_in[1]; P.positions = (const int*)d_in[2]; P.norm1_w = (const float*)d_in[3]; P.w_in = (const float*)d_in[4];
    P.w_pool = (const float*)d_in[5]; P.pool_scale = (const float*)d_in[6]; P.q_norm_w = (const float*)d_in[7]; P.k_norm_cmp_w = (const float*)d_in[8];
    P.k_norm_slc_w = (const float*)d_in[9]; P.k_norm_win_w = (const float*)d_in[10]; P.cmp_pos_k = (const float*)d_in[11]; P.cmp_pos_v = (const float*)d_in[12];
    P.cmp_k_w1 = (const float*)d_in[13]; P.cmp_k_w2 = (const float*)d_in[14]; P.cmp_v_w1 = (const float*)d_in[15]; P.cmp_v_w2 = (const float*)d_in[16];
    P.w_o = (const float*)d_in[17]; P.norm2_w = (const float*)d_in[18]; P.w_ffn_in = (const float*)d_in[19]; P.conv_w = (const float*)d_in[20]; P.conv_b = (const float*)d_in[21];
    P.w_ffn_out = (const float*)d_in[22]; P.w_ple_proj = (const float*)d_in[23]; P.ple_norm_w = (const float*)d_in[24]; P.ple_gate_norm_w = (const float*)d_in[25]; P.w_ple_gate = (const float*)d_in[26];
    (void)fp;
    P.out = (float*)d_out; P.ws = (unsigned char*)d_ws;
#if MK_ONE_LAUNCH
    P.ph_lo = 0; P.ph_hi = N_PHASES;
    hipLaunchKernelGGL(fwd, dim3(grid), dim3(NTHREADS), LDS_BYTES, stream, P);
#else
    for (int ph = 0; ph < N_PHASES; ++ph) { P.ph_lo = ph; P.ph_hi = ph + 1; hipLaunchKernelGGL(fwd, dim3(grid), dim3(NTHREADS), LDS_BYTES, stream, P); }
#endif
    const hipError_t le = hipPeekAtLastError();
    if (le != hipSuccess) fprintf(stderr, "kernel_launch: launch failed: %s\n", hipGetErrorName(le));
}
```

```cpp
#include <hip/hip_runtime.h>
#include <cstdio>
#include <cstdint>

#ifndef PROBE_DBL
#define PROBE_DBL 0
#endif
#define REP(k) _Pragma("unroll") for (int rep_ = 0; rep_ < 1 + ((PROBE_DBL >> (k)) & 1); ++rep_)
#ifndef SLC16
#define SLC16 1
#endif
#ifndef MK_ONE_LAUNCH
#define MK_ONE_LAUNCH 1
#endif

#define LAS __attribute__((address_space(3)))
typedef unsigned short bf16_t;
typedef short bf16x8 __attribute__((ext_vector_type(8)));
typedef short s16x4 __attribute__((ext_vector_type(4)));
typedef float f32x2 __attribute__((ext_vector_type(2)));
typedef float f32x4 __attribute__((ext_vector_type(4)));
typedef float f32x16 __attribute__((ext_vector_type(16)));
typedef unsigned u32x2 __attribute__((ext_vector_type(2)));
typedef unsigned u32x4 __attribute__((ext_vector_type(4)));
typedef int i32x4 __attribute__((ext_vector_type(4)));
typedef int i32x8 __attribute__((ext_vector_type(8)));

constexpr int S_ = 16384, DM = 4096, INW = 7240, LDZ = 7424, POOLW = 1024, NH = 24, NKV = 4, HPG = 6, HD = 128;
constexpr int OFF_Q = 1024, OFF_KV = 4096, OFF_G = 7168, DFF = 11008, NFI = 22016, PLE = 256, NGATE = 72;
constexpr int ZROWS = S_ + 64, XNROWS = S_ + 256, CHUNK = 8192;
constexpr float EPS = 1e-6f;
constexpr float SM_C = 0.08838834764831845f * 1.4426950408889634f;
constexpr int NWAVES = 8, NTHREADS = 512;
constexpr float WG8_SCALE = 128.0f;

constexpr size_t al256(size_t x) { return (x + 255) / 256 * 256; }
constexpr size_t WS_CTL   = 0;
constexpr size_t CTL_BYTES = 262144;
constexpr size_t WS_CBIAS = WS_CTL + 32768;
constexpr size_t WS_SSQ1 = WS_CTL + 65536, WS_SSQ2 = WS_CTL + 131072, WS_SSQ3 = WS_CTL + 196608;
constexpr size_t WS_WIN   = WS_CTL + CTL_BYTES;
constexpr size_t WS_WO    = WS_WIN + al256((size_t)LDZ * DM * 2);
constexpr size_t WS_WFI   = WS_WO + al256((size_t)DM * DM * 2);
constexpr size_t WS_WFO   = WS_WFI + al256((size_t)NFI * DM * 2);
constexpr size_t WS_WG    = WS_WFO + al256((size_t)DM * DFF * 2);
constexpr size_t WS_WPLE  = WS_WG + al256((size_t)DM * DM * 2);
constexpr size_t WS_WPOOL = WS_WPLE + al256((size_t)DM * PLE * 2);
constexpr size_t WS_WC1K  = WS_WPOOL + al256((size_t)1024 * 256 * 2);
constexpr size_t WS_WC1V  = WS_WC1K + al256((size_t)256 * 4096 * 2);
constexpr size_t WS_COS   = WS_WC1V + al256((size_t)256 * 4096 * 2);
constexpr size_t WS_SIN   = WS_COS + al256((size_t)S_ * 16 * 4);
constexpr size_t WS_TAB   = WS_SIN + al256((size_t)S_ * 16 * 4);
constexpr size_t WS_XNP   = WS_TAB + 4096;
constexpr size_t WS_XN    = WS_XNP + (size_t)2 * DM * 2;
constexpr size_t WS_PB    = WS_XN + al256((size_t)XNROWS * DM * 2);
constexpr size_t WS_XN8   = WS_PB + al256((size_t)S_ * PLE * 2);
constexpr size_t WS_WIN8  = WS_XN8 + al256((size_t)S_ * DM);
constexpr size_t WS_R     = WS_WIN8 + al256((size_t)(OFF_G - POOLW) * DM);
constexpr size_t WS_Z     = WS_R;
constexpr size_t WS_M     = WS_Z + al256((size_t)ZROWS * LDZ * 2);
constexpr size_t WS_G     = WS_M + al256((size_t)S_ * POOLW * 2);
constexpr size_t WS_H1    = WS_G + al256((size_t)S_ * NGATE * 4);
constexpr size_t WS_KC    = WS_H1 + al256((size_t)8192 * 256 * 4);
constexpr size_t WS_VC    = WS_KC + al256((size_t)4 * 1024 * 128 * 2);
constexpr size_t WS_L     = WS_VC + al256((size_t)4 * 1024 * 128 * 2);
constexpr size_t WS_OACC  = WS_L + al256((size_t)S_ * NH * 4);
constexpr size_t WS_IMPP  = WS_OACC + al256((size_t)S_ * 3072 * 4);
constexpr size_t WS_IMPF  = WS_IMPP + al256((size_t)S_ * 4 * 256 * 4);
constexpr size_t WS_BM    = WS_IMPF + al256((size_t)S_ * 4 * 256 * 4);
constexpr size_t WS_MIX   = WS_BM + al256((size_t)S_ * 4 * 8 * 4);
constexpr size_t WS_END_A = WS_MIX + al256((size_t)S_ * DM * 2);
constexpr size_t WS_ERAW  = WS_R;
constexpr size_t WS_ACT   = WS_ERAW + al256((size_t)S_ * DM * 2);
constexpr size_t WS_ERSTD = WS_ACT + al256((size_t)S_ * DFF * 2);
constexpr size_t WS_END_B = WS_ERSTD + al256((size_t)S_ * 4);
static_assert(WS_ERAW + (size_t)S_ * DM * 2 <= WS_Z + (size_t)ZROWS * LDZ * 2, "eraw must fit inside the dead z region while mix is still being read");
constexpr size_t WS_NEED  = WS_END_A > WS_END_B ? WS_END_A : WS_END_B;
static_assert(WS_NEED <= (size_t)1440000000, "workspace map exceeds the guaranteed 4 x largest-tensor bytes");

constexpr int LDS_STAGE = 131072;
constexpr int LDS_XCH   = LDS_STAGE + 64;
constexpr int LDS_MISC  = 147456;
constexpr int LDS_BYTES = LDS_MISC + 64;

__device__ __forceinline__ unsigned cvt_pk_bf16(float lo, float hi) { unsigned r; asm volatile("v_cvt_pk_bf16_f32 %0, %1, %2" : "=v"(r) : "v"(lo), "v"(hi)); return r; }
__device__ __forceinline__ float bf_lo(unsigned u) { return __uint_as_float(u << 16); }
__device__ __forceinline__ float bf_hi(unsigned u) { return __uint_as_float(u & 0xffff0000u); }
__device__ __forceinline__ float bf2f(bf16_t b) { return __uint_as_float(((unsigned)b) << 16); }
__device__ __forceinline__ float wave_sum(float v) {
#pragma unroll
    for (int o = 32; o >= 1; o >>= 1) v += __shfl_xor(v, o);
    return v;
}
__device__ __forceinline__ float wave_max(float v) {
#pragma unroll
    for (int o = 32; o >= 1; o >>= 1) v = fmaxf(v, __shfl_xor(v, o));
    return v;
}
__device__ __forceinline__ float sigmoidf_(float x) { return __builtin_amdgcn_rcpf(1.0f + __expf(-x)); }

#define XB_TMO      128
#define XB_XCNT(j)  (256  + 64 * (j))
#define XB_XSUB(j)  (1280 + 64 * (j))
#define XB_XGEN(j)  (2304 + 64 * (j))
#define XB_TOP      3328
#define XB_TOPGEN   3392
#define XCD_BAR_WORDS 3456
#define XB_SPIN_CAP (1u << 18)
__device__ __forceinline__ unsigned xb_ld(unsigned* p)              { return __hip_atomic_load(p, __ATOMIC_RELAXED, __HIP_MEMORY_SCOPE_AGENT); }
__device__ __forceinline__ unsigned xb_add(unsigned* p, unsigned v) { return __hip_atomic_fetch_add(p, v, __ATOMIC_RELAXED, __HIP_MEMORY_SCOPE_AGENT); }
__device__ __forceinline__ unsigned xb_xcc_id() { return (unsigned)__builtin_amdgcn_s_getreg((3 << 11) | 20) & 0xFu; }
#define XB_SPIN(cond, bar) do { unsigned _sp = 0; while (cond) { __builtin_amdgcn_s_sleep(1); \
    if ((++_sp & 255u) == 0u) { if (xb_ld(&(bar)[XB_TMO])) break; if (_sp > XB_SPIN_CAP) { atomicAdd(&(bar)[XB_TMO], 1u); break; } } } } while (0)
struct XcdBarrier { unsigned* bar; unsigned x; volatile LAS unsigned* st; };
__device__ __forceinline__ XcdBarrier xcd_barrier_post(unsigned* bar, volatile LAS unsigned* st) {
    XcdBarrier b; b.bar = bar; b.x = xb_xcc_id(); b.st = st;
    if (threadIdx.x == 0) (void)xb_add(&bar[XB_XCNT(b.x)], 1u);
    return b;
}
__device__ __forceinline__ void xcd_barrier_complete(unsigned* bar, unsigned x, unsigned& nloc, unsigned& nx) {
    const unsigned G = gridDim.x * gridDim.y * gridDim.z;
    unsigned sum, cnt, mine, sp = 0u;
    for (;;) {
        sum = 0u; cnt = 0u; mine = 0u;
#pragma unroll
        for (unsigned j = 0; j < 16; ++j) { const unsigned c = xb_ld(&bar[XB_XCNT(j)]); sum += c; cnt += (c > 0u) ? 1u : 0u; mine = (j == x) ? c : mine; }
        if (sum == G) break;
        __builtin_amdgcn_s_sleep(1);
        if ((++sp & 255u) == 0u) { if (xb_ld(&bar[XB_TMO])) break; if (sp > XB_SPIN_CAP) { atomicAdd(&bar[XB_TMO], 1u); break; } }
    }
    nloc = mine > 0u ? mine : 1u; nx = cnt > 0u ? cnt : 1u;
}
__device__ __forceinline__ void xcd_barrier(const XcdBarrier& b) {
    asm volatile("s_waitcnt vmcnt(0)" ::: "memory");
    __syncthreads();
    if (threadIdx.x == 0) {
        unsigned* bar = b.bar;
        __builtin_amdgcn_s_waitcnt(0);
        unsigned nloc = b.st[0], nx = b.st[1];
        if (nloc == 0u) { xcd_barrier_complete(bar, b.x, nloc, nx); b.st[0] = nloc; b.st[1] = nx; }
        const unsigned old = xb_add(&bar[XB_XSUB(b.x)], 1u);
        const unsigned gen = old / nloc;
        if (old + 1u == (gen + 1u) * nloc) {
            __builtin_amdgcn_fence(__ATOMIC_RELEASE, "agent");
            asm volatile("s_waitcnt vmcnt(0)" ::: "memory");
            const unsigned og = xb_add(&bar[XB_TOP], 1u);
            const unsigned tg = og / nx;
            if (og + 1u == (tg + 1u) * nx) xb_add(&bar[XB_TOPGEN], 1u);
            else XB_SPIN(xb_ld(&bar[XB_TOPGEN]) == tg, bar);
            __builtin_amdgcn_fence(__ATOMIC_ACQUIRE, "agent");
            xb_add(&bar[XB_XGEN(b.x)], 1u);
            asm volatile("s_waitcnt vmcnt(0)" ::: "memory");
        } else {
            XB_SPIN(xb_ld(&bar[XB_XGEN(b.x)]) == gen, bar);
            __builtin_amdgcn_fence(__ATOMIC_ACQUIRE, "agent");
            asm volatile("s_waitcnt vmcnt(0)" ::: "memory");
        }
    }
    __syncthreads();
}

struct Params {
    const float* x; const float* p; const int* positions; const float* norm1_w; const float* w_in; const float* w_pool; const float* pool_scale;
    const float* q_norm_w; const float* k_norm_cmp_w; const float* k_norm_slc_w; const float* k_norm_win_w; const float* cmp_pos_k; const float* cmp_pos_v;
    const float* cmp_k_w1; const float* cmp_k_w2; const float* cmp_v_w1; const float* cmp_v_w2; const float* w_o; const float* norm2_w; const float* w_ffn_in;
    const float* conv_w; const float* conv_b; const float* w_ffn_out; const float* w_ple_proj; const float* ple_norm_w; const float* ple_gate_norm_w; const float* w_ple_gate;
    float* out; unsigned char* ws; int ph_lo, ph_hi;
};

namespace pg8 {
constexpr int BM = 256, BK = 64, HALF = 128, HTB = HALF * BK * 2, STAGE_BYTES = 8 * HTB, NXCD = 8, WGM = 8;
__host__ __device__ __forceinline__ int lds_byte(int r, int c) { const int st = (r >> 4) * 2 + (c >> 5), rr = r & 15, cc = c & 31, ob = rr * 64 + cc * 2; return st * 1024 + (ob ^ (((ob >> 9) & 1) << 5)); }
__host__ __device__ __forceinline__ void stage_rc(int b, int& R, int& C) { const int st = b / 1024, sb = b % 1024, swz = sb ^ (((sb >> 9) & 1) << 5); R = (st >> 1) * 16 + swz / 64; C = (st & 1) * 32 + (swz % 64) / 2; }
__host__ __device__ __forceinline__ int perm32(int rho) { const int n = rho >> 4, i = rho & 15; return 8 * (i >> 2) + 4 * n + (i & 3); }
struct Unit { int pm, pn; };

struct StaticOrder {
    int nM, nN, nwg, G, c;
    __device__ void init(int nM_, int nN_, int G_, int c_) { nM = nM_; nN = nN_; nwg = nM * nN; G = G_; c = c_; }
    __device__ bool next(int i, Unit& u) const {
        const long L = (long)i * G + c; if (L >= nwg) return false;
        int wgid = (int)L; { const int q = nwg / NXCD, r = nwg % NXCD, xcd = wgid % NXCD, off = wgid / NXCD; wgid = (xcd < r ? xcd * (q + 1) : r * (q + 1) + (xcd - r) * q) + off; }
        const int nig = WGM * nN, gid = wgid / nig, fm = gid * WGM, gsz = (nM - fm) < WGM ? (nM - fm) : WGM;
        u.pm = fm + ((wgid % nig) % gsz); u.pn = (wgid % nig) / gsz; return true;
    }
};

struct GStd {
    const char* A; const char* B; unsigned lda, ldb; int nt;
    __device__ __forceinline__ const char* a_base(const Unit& u) const { return A + (size_t)u.pm * 256 * lda * 2; }
    __device__ __forceinline__ const char* b_base(const Unit& u) const { return B + (size_t)u.pn * 256 * ldb * 2; }
    __device__ __forceinline__ size_t kpairA() const { return 256; }
};
struct GPool {
    const char* A; const char* B; unsigned lda, ldb; int nt;
    __device__ __forceinline__ const char* a_base(const Unit& u) const { return A + (size_t)u.pm * 256 * lda * 2 + (size_t)u.pn * 512; }
    __device__ __forceinline__ const char* b_base(const Unit& u) const { return B + (size_t)u.pn * 256 * ldb * 2; }
    __device__ __forceinline__ size_t kpairA() const { return 256; }
};
struct GCmp {
    const char* Z; const char* Bk; const char* Bv; unsigned lda, ldb; int nt;
    __device__ __forceinline__ const char* a_base(const Unit& u) const { const int which = u.pm >> 4, g = (u.pm >> 2) & 3, rt = u.pm & 3;
        return Z + (size_t)(OFF_KV + which * 512 + g * 128) * 2 + (size_t)rt * 256 * lda * 2; }
    __device__ __forceinline__ const char* b_base(const Unit& u) const { return (u.pm >> 4) ? Bv : Bk; }
    __device__ __forceinline__ size_t kpairA() const { return (size_t)LDZ * 2; }
};

struct EpiBf16 {
    static constexpr bool PERM = true;
    bf16_t* O; int ldc;
    __device__ __forceinline__ void operator()(const f32x4 (&acc)[2][2][4][2], const Unit& u, int wr, int wc, int fr, int fq) const {
        const int row0 = u.pm * BM + wr * 64 + fr, col0 = u.pn * BM + wc * 32 + 8 * fq;
#pragma unroll
        for (int ai = 0; ai < 2; ++ai)
#pragma unroll
            for (int m = 0; m < 4; ++m) { bf16_t* rowp = O + (size_t)(row0 + ai * HALF + m * 16) * ldc + col0;
#pragma unroll
                for (int bj = 0; bj < 2; ++bj) { const f32x4 v0 = acc[ai][bj][m][0], v1 = acc[ai][bj][m][1];
                    u32x4 w; w.x = cvt_pk_bf16(v0[0], v0[1]); w.y = cvt_pk_bf16(v0[2], v0[3]); w.z = cvt_pk_bf16(v1[0], v1[1]); w.w = cvt_pk_bf16(v1[2], v1[3]);
                    *(u32x4*)(rowp + bj * HALF) = w; } }
    }
};
struct EpiBf16S {
    static constexpr bool PERM = true;
    bf16_t* O; int ldc; float s;
    __device__ __forceinline__ void operator()(const f32x4 (&acc)[2][2][4][2], const Unit& u, int wr, int wc, int fr, int fq) const {
        const int row0 = u.pm * BM + wr * 64 + fr, col0 = u.pn * BM + wc * 32 + 8 * fq;
#pragma unroll
        for (int ai = 0; ai < 2; ++ai)
#pragma unroll
            for (int m = 0; m < 4; ++m) { bf16_t* rowp = O + (size_t)(row0 + ai * HALF + m * 16) * ldc + col0;
#pragma unroll
                for (int bj = 0; bj < 2; ++bj) { const f32x4 v0 = acc[ai][bj][m][0] * s, v1 = acc[ai][bj][m][1] * s;
                    u32x4 w; w.x = cvt_pk_bf16(v0[0], v0[1]); w.y = cvt_pk_bf16(v0[2], v0[3]); w.z = cvt_pk_bf16(v1[0], v1[1]); w.w = cvt_pk_bf16(v1[2], v1[3]);
                    *(u32x4*)(rowp + bj * HALF) = w; } }
    }
};
struct EpiBf16Ssq {
    static constexpr bool PERM = true;
    bf16_t* O; int ldc; float* ssq;
    __device__ __forceinline__ void operator()(const f32x4 (&acc)[2][2][4][2], const Unit& u, int wr, int wc, int fr, int fq) const {
        const int row0 = u.pm * BM + wr * 64 + fr, col0 = u.pn * BM + wc * 32 + 8 * fq;
#pragma unroll
        for (int ai = 0; ai < 2; ++ai)
#pragma unroll
            for (int m = 0; m < 4; ++m) { const int row = row0 + ai * HALF + m * 16; bf16_t* rowp = O + (size_t)row * ldc + col0; float s = 0.f;
#pragma unroll
                for (int bj = 0; bj < 2; ++bj) { const f32x4 v0 = acc[ai][bj][m][0], v1 = acc[ai][bj][m][1];
                    s += v0[0] * v0[0] + v0[1] * v0[1] + v0[2] * v0[2] + v0[3] * v0[3] + v1[0] * v1[0] + v1[1] * v1[1] + v1[2] * v1[2] + v1[3] * v1[3];
                    u32x4 w; w.x = cvt_pk_bf16(v0[0], v0[1]); w.y = cvt_pk_bf16(v0[2], v0[3]); w.z = cvt_pk_bf16(v1[0], v1[1]); w.w = cvt_pk_bf16(v1[2], v1[3]);
                    *(u32x4*)(rowp + bj * HALF) = w; }
                s += __shfl_xor(s, 16); s += __shfl_xor(s, 32);
                if (fq == 0) unsafeAtomicAdd(ssq + row, s); }
    }
};
struct EpiBf16Scale {
    static constexpr bool PERM = true;
    bf16_t* O; int ldc; const float* colscale;
    __device__ __forceinline__ void operator()(const f32x4 (&acc)[2][2][4][2], const Unit& u, int wr, int wc, int fr, int fq) const {
        const int row0 = u.pm * BM + wr * 64 + fr, col0 = u.pn * BM + wc * 32 + 8 * fq;
#pragma unroll
        for (int bj = 0; bj < 2; ++bj) { const f32x4 s0 = *(const f32x4*)(colscale + col0 + bj * HALF), s1 = *(const f32x4*)(colscale + col0 + bj * HALF + 4);
#pragma unroll
            for (int ai = 0; ai < 2; ++ai)
#pragma unroll
                for (int m = 0; m < 4; ++m) { bf16_t* rowp = O + (size_t)(row0 + ai * HALF + m * 16) * ldc + col0;
                    const f32x4 v0 = acc[ai][bj][m][0] * s0, v1 = acc[ai][bj][m][1] * s1;
                    u32x4 w; w.x = cvt_pk_bf16(v0[0], v0[1]); w.y = cvt_pk_bf16(v0[2], v0[3]); w.z = cvt_pk_bf16(v1[0], v1[1]); w.w = cvt_pk_bf16(v1[2], v1[3]);
                    *(u32x4*)(rowp + bj * HALF) = w; } }
    }
};
struct EpiResF32 {
    static constexpr bool PERM = false;
    const float* base; float* C; int ldc; int row_off;
    __device__ __forceinline__ void operator()(const f32x4 (&acc)[2][2][4][2], const Unit& u, int wr, int wc, int fr, int fq) const {
        const int row0 = u.pm * BM + wr * 64 + fr + row_off, col0 = u.pn * BM + wc * 32 + 4 * fq;
#pragma unroll
        for (int ai = 0; ai < 2; ++ai)
#pragma unroll
            for (int m = 0; m < 4; ++m) { const size_t off = (size_t)(row0 + ai * HALF + m * 16) * ldc + col0;
#pragma unroll
                for (int bj = 0; bj < 2; ++bj)
#pragma unroll
                    for (int n = 0; n < 2; ++n) { const f32x4 b = *(const f32x4*)(base + off + bj * HALF + n * 16); *(f32x4*)(C + off + bj * HALF + n * 16) = b + acc[ai][bj][m][n]; }
                asm volatile("" ::: "memory"); }
    }
};
template <bool FP8OUT>
struct EpiResNormT {
    static constexpr bool PERM = false;
    const float* base; float* C; bf16_t* XN; const float* nw; float* ssq; int ldc;
    __device__ __forceinline__ void operator()(const f32x4 (&acc)[2][2][4][2], const Unit& u, int wr, int wc, int fr, int fq) const {
        const int row0 = u.pm * BM + wr * 64 + fr, col0 = u.pn * BM + wc * 32 + 4 * fq;
        f32x4 wv[2][2];
#pragma unroll
        for (int bj = 0; bj < 2; ++bj)
#pragma unroll
            for (int n = 0; n < 2; ++n) wv[bj][n] = *(const f32x4*)(nw + col0 + bj * HALF + n * 16);
        f32x4 bv[2][2][2];
#pragma unroll
        for (int bj = 0; bj < 2; ++bj)
#pragma unroll
            for (int n = 0; n < 2; ++n) bv[0][bj][n] = *(const f32x4*)(base + (size_t)row0 * ldc + col0 + bj * HALF + n * 16);
#pragma unroll
        for (int rg = 0; rg < 8; ++rg) { const int ai = rg >> 2, m = rg & 3; const int row = row0 + ai * HALF + m * 16; const size_t off = (size_t)row * ldc + col0;
            if (rg < 7) { const int ai2 = (rg + 1) >> 2, m2 = (rg + 1) & 3; const size_t off2 = (size_t)(row0 + ai2 * HALF + m2 * 16) * ldc + col0;
#pragma unroll
                for (int bj = 0; bj < 2; ++bj)
#pragma unroll
                    for (int n = 0; n < 2; ++n) bv[(rg + 1) & 1][bj][n] = *(const f32x4*)(base + off2 + bj * HALF + n * 16); }
            float s = 0.f;
#pragma unroll
            for (int bj = 0; bj < 2; ++bj)
#pragma unroll
                for (int n = 0; n < 2; ++n) { const f32x4 v = bv[rg & 1][bj][n] + acc[ai][bj][m][n];
                    *(f32x4*)(C + off + bj * HALF + n * 16) = v; s += v[0] * v[0] + v[1] * v[1] + v[2] * v[2] + v[3] * v[3];
                    if (FP8OUT) { int pk = __builtin_amdgcn_cvt_pk_fp8_f32(v[0] * wv[bj][n][0], v[1] * wv[bj][n][1], 0, false); pk = __builtin_amdgcn_cvt_pk_fp8_f32(v[2] * wv[bj][n][2], v[3] * wv[bj][n][3], pk, true);
                        *(int*)((unsigned char*)XN + off + bj * HALF + n * 16) = pk; }
                    else { u32x2 o; o.x = cvt_pk_bf16(v[0] * wv[bj][n][0], v[1] * wv[bj][n][1]); o.y = cvt_pk_bf16(v[2] * wv[bj][n][2], v[3] * wv[bj][n][3]);
                        *(u32x2*)(XN + off + bj * HALF + n * 16) = o; } }
            s += __shfl_xor(s, 16); s += __shfl_xor(s, 32);
            if (fq == 0) unsafeAtomicAdd(ssq + row, s);
        }
    }
};
typedef EpiResNormT<false> EpiResNorm;
typedef EpiResNormT<true> EpiResNormF8;
struct EpiCmpGelu {
    static constexpr bool PERM = false;
    float* H; const float* bias;
    __device__ __forceinline__ void operator()(const f32x4 (&acc)[2][2][4][2], const Unit& u, int wr, int wc, int fr, int fq) const {
        const int row0 = u.pm * BM + wr * 64 + fr, col0 = wc * 32 + 4 * fq; const float* bs = bias + (u.pm >> 4) * 256;
        f32x4 bvv[2][2];
#pragma unroll
        for (int bj = 0; bj < 2; ++bj)
#pragma unroll
            for (int n = 0; n < 2; ++n) bvv[bj][n] = *(const f32x4*)(bs + col0 + bj * HALF + n * 16);
#pragma unroll
        for (int ai = 0; ai < 2; ++ai)
#pragma unroll
            for (int m = 0; m < 4; ++m) { float* rowp = H + (size_t)(row0 + ai * HALF + m * 16) * 256 + col0;
#pragma unroll
                for (int bj = 0; bj < 2; ++bj)
#pragma unroll
                    for (int n = 0; n < 2; ++n) { f32x4 v = acc[ai][bj][m][n] + bvv[bj][n];
#pragma unroll
                        for (int j = 0; j < 4; ++j) { const float xx = v[j], uu = 0.7978845608028654f * (xx + 0.044715f * xx * xx * xx); const float th = 1.0f - 2.0f / (1.0f + __expf(2.0f * uu)); v[j] = 0.5f * xx * (1.0f + th); }
                        *(f32x4*)(rowp + bj * HALF + n * 16) = v; } }
    }
};
struct EpiGate {
    static constexpr bool PERM = false;
    float* C; const bf16_t* eraw; const float* erstd; const float* pw; const float* ssq; int ldc; float ascale;
    __device__ __forceinline__ void operator()(const f32x4 (&acc)[2][2][4][2], const Unit& u, int wr, int wc, int fr, int fq) const {
        const int row0 = u.pm * BM + wr * 64 + fr, col0 = u.pn * BM + wc * 32 + 4 * fq;
        f32x4 wv[2][2];
#pragma unroll
        for (int bj = 0; bj < 2; ++bj)
#pragma unroll
            for (int n = 0; n < 2; ++n) wv[bj][n] = *(const f32x4*)(pw + col0 + bj * HALF + n * 16);
        f32x4 bv[2][2][2]; u32x2 ev[2][2][2]; float rsv[2], rgv[2];
#pragma unroll
        for (int bj = 0; bj < 2; ++bj)
#pragma unroll
            for (int n = 0; n < 2; ++n) { bv[0][bj][n] = *(const f32x4*)(C + (size_t)row0 * ldc + col0 + bj * HALF + n * 16); ev[0][bj][n] = *(const u32x2*)(eraw + (size_t)row0 * ldc + col0 + bj * HALF + n * 16); }
        rsv[0] = erstd[row0]; rgv[0] = ssq[row0];
#pragma unroll
        for (int rg = 0; rg < 8; ++rg) { const int ai = rg >> 2, m = rg & 3; const int row = row0 + ai * HALF + m * 16; const size_t off = (size_t)row * ldc + col0;
            if (rg < 7) { const int ai2 = (rg + 1) >> 2, m2 = (rg + 1) & 3; const int row2 = row0 + ai2 * HALF + m2 * 16; const size_t off2 = (size_t)row2 * ldc + col0;
#pragma unroll
                for (int bj = 0; bj < 2; ++bj)
#pragma unroll
                    for (int n = 0; n < 2; ++n) { bv[(rg + 1) & 1][bj][n] = *(const f32x4*)(C + off2 + bj * HALF + n * 16); ev[(rg + 1) & 1][bj][n] = *(const u32x2*)(eraw + off2 + bj * HALF + n * 16); }
                rsv[(rg + 1) & 1] = erstd[row2]; rgv[(rg + 1) & 1] = ssq[row2]; }
            const float rs = rsqrtf(rsv[rg & 1] * (1.0f / DM) + EPS), rg_ = rsqrtf(rgv[rg & 1] * (1.0f / DM) + EPS) * ascale;
#pragma unroll
            for (int bj = 0; bj < 2; ++bj)
#pragma unroll
                for (int n = 0; n < 2; ++n) { const f32x4 b = bv[rg & 1][bj][n]; const u32x2 e = ev[rg & 1][bj][n]; const f32x4 a = acc[ai][bj][m][n]; f32x4 o;
                    o[0] = b[0] + bf_lo(e.x) * rs * wv[bj][n][0] * sigmoidf_(a[0] * rg_); o[1] = b[1] + bf_hi(e.x) * rs * wv[bj][n][1] * sigmoidf_(a[1] * rg_);
                    o[2] = b[2] + bf_lo(e.y) * rs * wv[bj][n][2] * sigmoidf_(a[2] * rg_); o[3] = b[3] + bf_hi(e.y) * rs * wv[bj][n][3] * sigmoidf_(a[3] * rg_);
                    *(f32x4*)(C + off + bj * HALF + n * 16) = o; }
        }
    }
};
struct GFfn {
    const char* A; const char* B; unsigned lda, ldb; int nt;
    __device__ __forceinline__ const char* a_base(const Unit& u) const { return A + ((long)u.pm * 254 - 2) * (long)lda * 2; }
    __device__ __forceinline__ const char* b_base(const Unit& u) const { return B + (size_t)u.pn * 256 * ldb * 2; }
    __device__ __forceinline__ size_t kpairA() const { return 256; }
};
template <int CTRL> __device__ __forceinline__ float dpp_f(float v) { return __int_as_float(__builtin_amdgcn_update_dpp(0, __float_as_int(v), CTRL, 0xf, 0xf, false)); }
struct EpiFfn {
    static constexpr bool PERM = true;
    bf16_t* ACT; const float* cw; const float* cb; LAS float* X; const float* ssq;
    __device__ __forceinline__ void operator()(const f32x4 (&acc)[2][2][4][2], const Unit& u, int wr, int wc, int fr, int fq) const {
        const int colw = wc * 32 + 8 * fq;
        const int f0 = u.pn * 128 + colw;
        f32x4 w0[2], w1[2], w2[2], cbv[2];
#pragma unroll
        for (int n = 0; n < 2; ++n) { w0[n] = *(const f32x4*)(cw + f0 + 4 * n); w1[n] = *(const f32x4*)(cw + DFF + f0 + 4 * n); w2[n] = *(const f32x4*)(cw + 2 * DFF + f0 + 4 * n); cbv[n] = *(const f32x4*)(cb + f0 + 4 * n); }
        float rsv[2][4];
#pragma unroll
        for (int ai = 0; ai < 2; ++ai)
#pragma unroll
            for (int m = 0; m < 4; ++m) { const long t = (long)u.pm * 254 - 2 + ai * HALF + wr * 64 + m * 16 + fr; rsv[ai][m] = ssq[t < 0 ? 0 : (t >= S_ ? S_ - 1 : t)]; }
#pragma unroll
        for (int ai = 0; ai < 2; ++ai)
#pragma unroll
            for (int m = 0; m < 4; ++m) { const long t = (long)u.pm * 254 - 2 + ai * HALF + wr * 64 + m * 16 + fr; rsv[ai][m] = (t >= 0 && t < S_) ? rsqrtf(rsv[ai][m] * (1.0f / DM) + EPS) : 0.f; }
        if (fr >= 14) {
#pragma unroll
            for (int ai = 0; ai < 2; ++ai)
#pragma unroll
                for (int n = 0; n < 2; ++n) *(LAS f32x4*)(X + ((2 * ai + wr) * 2 + (fr - 14)) * 128 + colw + 4 * n) = acc[ai][0][3][n] * rsv[ai][3];
        }
        asm volatile("s_waitcnt lgkmcnt(0)" ::: "memory");
        __builtin_amdgcn_s_barrier(); asm volatile("" ::: "memory");
        __builtin_amdgcn_s_barrier(); asm volatile("" ::: "memory");
        const bool sel1 = fr == 15, sel2 = fr >= 14;
#pragma unroll
        for (int ai = 0; ai < 2; ++ai) {
            f32x4 pv[2];
            const int pseg = 2 * ai + wr - 1;
#pragma unroll
            for (int n = 0; n < 2; ++n) { pv[n] = (f32x4){0.f, 0.f, 0.f, 0.f}; if (pseg >= 0 && fr >= 14) pv[n] = *(const LAS f32x4*)(X + (pseg * 2 + (fr - 14)) * 128 + colw + 4 * n); }
#pragma unroll
            for (int m = 0; m < 4; ++m) {
                const int r = ai * HALF + wr * 64 + m * 16 + fr; const long t = (long)u.pm * 254 - 2 + r;
                unsigned ow[4];
#pragma unroll
                for (int n = 0; n < 2; ++n) {
                    const f32x4 cur = acc[ai][0][m][n] * rsv[ai][m], up = acc[ai][1][m][n] * rsv[ai][m];
                    f32x4 x1, x2;
#pragma unroll
                    for (int i = 0; i < 4; ++i) { x1[i] = dpp_f<0x121>(sel1 ? pv[n][i] : cur[i]); x2[i] = dpp_f<0x122>(sel2 ? pv[n][i] : cur[i]); }
                    const f32x4 y = cbv[n] + w0[n] * x2 + w1[n] * x1 + w2[n] * cur;
                    f32x4 sg;
#pragma unroll
                    for (int i = 0; i < 4; ++i) sg[i] = sigmoidf_(y[i]);
                    const f32x4 o = y * sg * up;
                    ow[2 * n] = cvt_pk_bf16(o[0], o[1]); ow[2 * n + 1] = cvt_pk_bf16(o[2], o[3]);
                    pv[n] = cur;
                }
                if (r >= 2 && t < S_) *(u32x4*)(ACT + (size_t)t * DFF + f0) = (u32x4){ow[0], ow[1], ow[2], ow[3]};
            }
        }
    }
};

template <class GD, class Epi, bool F8 = false>
__device__ __forceinline__ void gemm_phase(LAS unsigned char* lds, const GD g, const StaticOrder& S, const Epi& E) {
    const int tid = threadIdx.x, wid = __builtin_amdgcn_readfirstlane(tid >> 6), lane = tid & 63, wr = wid >> 2, wc = wid & 3, fr = lane & 15, fq = lane >> 4;
    const int nt = g.nt;
    unsigned voffA[2], voffB[2];
#pragma unroll
    for (int i = 0; i < 2; ++i) { int R, C; stage_rc(tid * 16 + i * 8192, R, C); const int Rb = Epi::PERM ? ((R & ~31) + perm32(R & 31)) : R;
        voffA[i] = (unsigned)(R * g.lda + C) * 2u; voffB[i] = (unsigned)(Rb * g.ldb + C) * 2u; }
    const size_t kpA = g.kpairA();
    const size_t hstepA = (size_t)HALF * g.lda * 2, hstepB = (size_t)HALF * g.ldb * 2;
    const unsigned ldsw = (unsigned)wid * 1024u;
    const int aoff = lds_byte(wr * 64 + fr, fq * 8), boff = lds_byte(wc * 32 + fr, fq * 8);
#define PG8_SA(b, h) (((b) * 2 + (h)) * HTB)
#define PG8_SB(b, h) ((4 + (b) * 2 + (h)) * HTB)
#define PG8_STAGE(bufoff, gbase, voff) do { _Pragma("unroll") for (int _i = 0; _i < 2; ++_i) \
        __builtin_amdgcn_global_load_lds((const unsigned*)((const char*)(gbase) + (voff)[_i]), (LAS unsigned*)(lds + (bufoff) + ldsw + _i * 8192), 16, 0, 0); } while (0)
#define PG8_LDA(dst, b, h) do { if constexpr (F8) { _Pragma("unroll") for (int m = 0; m < 4; ++m) { const i32x4 lo_ = *(const LAS i32x4*)(lds + PG8_SA(b, h) + aoff + m * 2048), hi_ = *(const LAS i32x4*)(lds + PG8_SA(b, h) + aoff + m * 2048 + 1024); \
            dst##8[m] = __builtin_shufflevector(lo_, hi_, 0, 1, 2, 3, 4, 5, 6, 7); } } \
        else { _Pragma("unroll") for (int m = 0; m < 4; ++m) _Pragma("unroll") for (int k = 0; k < 2; ++k) dst[m][k] = *(const LAS bf16x8*)(lds + PG8_SA(b, h) + aoff + m * 2048 + k * 1024); } } while (0)
#define PG8_LDB(dst, b, h) do { if constexpr (F8) { _Pragma("unroll") for (int n = 0; n < 2; ++n) { const i32x4 lo_ = *(const LAS i32x4*)(lds + PG8_SB(b, h) + boff + n * 2048), hi_ = *(const LAS i32x4*)(lds + PG8_SB(b, h) + boff + n * 2048 + 1024); \
            dst##8[n] = __builtin_shufflevector(lo_, hi_, 0, 1, 2, 3, 4, 5, 6, 7); } } \
        else { _Pragma("unroll") for (int n = 0; n < 2; ++n) _Pragma("unroll") for (int k = 0; k < 2; ++k) dst[n][k] = *(const LAS bf16x8*)(lds + PG8_SB(b, h) + boff + n * 2048 + k * 1024); } } while (0)
#define PG8_MMA(ai, bj, At, Bt) do { __builtin_amdgcn_s_setprio(1); \
        if constexpr (F8) { _Pragma("unroll") for (int m = 0; m < 4; ++m) _Pragma("unroll") for (int n = 0; n < 2; ++n) \
            asm volatile("v_mfma_scale_f32_16x16x128_f8f6f4 %0, %1, %2, %0, %3, %3 op_sel_hi:[0,0,0]" : "+v"(acc[ai][bj][m][n]) : "v"(Bt##8[n]), "v"(At##8[m]), "v"(one_scale)); } \
        else { _Pragma("unroll") for (int m = 0; m < 4; ++m) _Pragma("unroll") for (int n = 0; n < 2; ++n) _Pragma("unroll") for (int k = 0; k < 2; ++k) \
            acc[ai][bj][m][n] = __builtin_amdgcn_mfma_f32_16x16x32_bf16(Bt[n][k], At[m][k], acc[ai][bj][m][n], 0, 0, 0); } \
        __builtin_amdgcn_s_setprio(0); } while (0)
#define PG8_WAIT_V(n) asm volatile("s_waitcnt vmcnt(" #n ")" ::: "memory")
#define PG8_WAIT_L(n) asm volatile("s_waitcnt lgkmcnt(" #n ")" ::: "memory")
#define PG8_BAR __builtin_amdgcn_s_barrier()
#define PG8_SCHED __builtin_amdgcn_sched_barrier(0)
    Unit cur, nxt; int ui = 0;
    if (!S.next(0, cur)) return;
    f32x4 acc[2][2][4][2];
#pragma unroll
    for (int a = 0; a < 2; ++a)
#pragma unroll
        for (int b = 0; b < 2; ++b)
#pragma unroll
            for (int m = 0; m < 4; ++m)
#pragma unroll
                for (int n = 0; n < 2; ++n) acc[a][b][m][n] = (f32x4){0.f, 0.f, 0.f, 0.f};
    bf16x8 At[4][2], B0[2][2], B1[2][2];
    i32x8 At8[4], B08[2], B18[2];
    (void)At; (void)B0; (void)B1; (void)At8; (void)B08; (void)B18;
    int one_scale = 0x7F7F7F7F; (void)one_scale;
    const char* cA = g.a_base(cur); const char* cB = g.b_base(cur);
    PG8_STAGE(PG8_SB(0, 0), cB, voffB); PG8_STAGE(PG8_SA(0, 0), cA, voffA); PG8_STAGE(PG8_SB(0, 1), cB + hstepB, voffB); PG8_STAGE(PG8_SA(0, 1), cA + hstepA, voffA);
    if (wr == 1) PG8_BAR;
    PG8_WAIT_V(4); PG8_BAR;
    PG8_STAGE(PG8_SB(1, 0), cB + 128, voffB); PG8_STAGE(PG8_SA(1, 0), cA + 128, voffA); PG8_STAGE(PG8_SB(1, 1), cB + hstepB + 128, voffB);
    PG8_WAIT_V(6); PG8_BAR;
    for (;;) {
        const bool has_next = S.next(ui + 1, nxt);
        const char* nA = has_next ? g.a_base(nxt) : cA; const char* nB = has_next ? g.b_base(nxt) : cB;
        for (int t = 0; t < nt; t += 2) {
            const bool last = (t == nt - 2);
            const char* a0 = cA + (size_t)(t >> 1) * kpA;
            const char* a1 = a0 + 128;
            const char* a2 = last ? nA : a0 + kpA; const char* b2 = last ? nB : cB + (size_t)(t + 2) * 128;
            const char* a3 = a2 + 128; const char* b3 = b2 + 128;
            PG8_LDB(B0, 0, 0); PG8_SCHED; PG8_LDA(At, 0, 0); PG8_STAGE(PG8_SA(1, 1), a1 + hstepA, voffA);
            PG8_WAIT_L(8); PG8_BAR; PG8_WAIT_L(0); PG8_MMA(0, 0, At, B0); PG8_BAR; PG8_SCHED;
            PG8_LDB(B1, 0, 1); PG8_STAGE(PG8_SB(0, 0), b2, voffB);
            PG8_BAR; PG8_WAIT_L(0); PG8_MMA(0, 1, At, B1); PG8_BAR;
            PG8_LDA(At, 0, 1); PG8_STAGE(PG8_SA(0, 0), a2, voffA);
            PG8_BAR; PG8_WAIT_L(0); PG8_MMA(1, 0, At, B0); PG8_BAR; PG8_SCHED;
            PG8_STAGE(PG8_SB(0, 1), b2 + hstepB, voffB);
            PG8_WAIT_V(6); PG8_BAR; PG8_MMA(1, 1, At, B1); PG8_BAR;
            PG8_LDB(B0, 1, 0); PG8_SCHED; PG8_LDA(At, 1, 0); PG8_STAGE(PG8_SA(0, 1), a2 + hstepA, voffA);
            PG8_WAIT_L(8); PG8_BAR; PG8_WAIT_L(0); PG8_MMA(0, 0, At, B0); PG8_BAR; PG8_SCHED;
            PG8_LDB(B1, 1, 1); PG8_STAGE(PG8_SB(1, 0), b3, voffB);
            PG8_BAR; PG8_WAIT_L(0); PG8_MMA(0, 1, At, B1); PG8_BAR;
            PG8_LDA(At, 1, 1); PG8_STAGE(PG8_SA(1, 0), a3, voffA);
            PG8_BAR; PG8_WAIT_L(0); PG8_MMA(1, 0, At, B0); PG8_BAR; PG8_SCHED;
            PG8_STAGE(PG8_SB(1, 1), b3 + hstepB, voffB);
            PG8_WAIT_V(6); PG8_BAR; PG8_MMA(1, 1, At, B1); PG8_BAR;
        }
        if constexpr (F8) asm volatile("s_nop 15\n\ts_nop 15\n\ts_nop 15" ::: "memory");
        E(acc, cur, wr, wc, fr, fq);
        if (!has_next) break;
#pragma unroll
        for (int a = 0; a < 2; ++a)
#pragma unroll
            for (int b = 0; b < 2; ++b)
#pragma unroll
                for (int m = 0; m < 4; ++m)
#pragma unroll
                    for (int n = 0; n < 2; ++n) acc[a][b][m][n] = (f32x4){0.f, 0.f, 0.f, 0.f};
        cur = nxt; cA = nA; cB = nB; ++ui;
    }
    PG8_WAIT_V(0);
    if (wr == 0) PG8_BAR;
    PG8_BAR;
#undef PG8_SA
#undef PG8_SB
#undef PG8_STAGE
#undef PG8_LDA
#undef PG8_LDB
#undef PG8_MMA
#undef PG8_WAIT_V
#undef PG8_WAIT_L
#undef PG8_BAR
#undef PG8_SCHED
}
}

namespace att {
constexpr int KVBLK = 64;
constexpr int SHM_V = KVBLK * HD * 2, SHM_K = KVBLK * HD * 2, SHM_ATTN = 2 * SHM_V + 2 * SHM_K + NWAVES * 64 * 4;
#define KSWZ(row, colB) ((row) * 256 + ((colB) ^ (((row) & 7) << 4)))
#define SBAR() __builtin_amdgcn_sched_barrier(0)
__device__ __forceinline__ int crow(int r, int hi) { return (r & 3) + 8 * (r >> 2) + 4 * hi; }
__device__ __forceinline__ void qkt(f32x16& p0, f32x16& p1, const char* Ks, const bf16x8* qr, int r32, int hi) {
    p0 = f32x16{}; p1 = f32x16{};
    bf16x8 ka[2], kb[2];
    { const int cb = (hi * 8) * 2; ka[0] = *reinterpret_cast<const bf16x8*>(Ks + KSWZ(r32, cb)); kb[0] = *reinterpret_cast<const bf16x8*>(Ks + KSWZ(32 + r32, cb)); }
#pragma unroll
    for (int d0 = 0; d0 < 8; ++d0) {
        if (d0 < 7) { const int cb = ((d0 + 1) * 16 + hi * 8) * 2;
            ka[(d0 + 1) & 1] = *reinterpret_cast<const bf16x8*>(Ks + KSWZ(r32, cb)); kb[(d0 + 1) & 1] = *reinterpret_cast<const bf16x8*>(Ks + KSWZ(32 + r32, cb)); }
        SBAR();
        p0 = __builtin_amdgcn_mfma_f32_32x32x16_bf16(ka[d0 & 1], qr[d0], p0, 0, 0, 0);
        p1 = __builtin_amdgcn_mfma_f32_32x32x16_bf16(kb[d0 & 1], qr[d0], p1, 0, 0, 0);
        SBAR();
    }
}
__device__ __forceinline__ int v_st(int k, int c) { const int kk = (k & ~0xC) | ((k & 4) << 1) | ((k & 8) >> 1); return ((kk >> 3) * 4 + (c >> 5)) * 512 + ((kk & 7) * 32 + (c & 31)) * 2; }
__device__ __forceinline__ int v_rd_base(int lane) { return ((lane & 3) << 3) | (((lane >> 2) & 3) << 6) | (((lane >> 4) & 1) << 5) | (((lane >> 5) & 1) << 8); }
constexpr int v_rd_off(int d0, int ks, int half) { return d0 * 512 + ks * 4096 + half * 2048; }
__device__ __forceinline__ s16x4 tr_read(int vb, int off) { return __builtin_amdgcn_ds_read_tr16_b64_v4i16((LAS s16x4*)(unsigned long)(unsigned)(vb + off)); }
__device__ __forceinline__ void pv_d0(f32x16* o, int vb, bf16x8 pa0, bf16x8 pa1, bf16x8 pa2, bf16x8 pa3) {
    s16x4 L[2][4], H[2][4];
#pragma unroll
    for (int d0 = 0; d0 < 4; ++d0) { L[0][d0] = tr_read(vb, v_rd_off(d0, 0, 0)); H[0][d0] = tr_read(vb, v_rd_off(d0, 0, 1)); }
#pragma unroll
    for (int ks = 0; ks < 4; ++ks) {
        if (ks < 3) {
#pragma unroll
            for (int d0 = 0; d0 < 4; ++d0) { L[(ks + 1) & 1][d0] = tr_read(vb, v_rd_off(d0, ks + 1, 0)); H[(ks + 1) & 1][d0] = tr_read(vb, v_rd_off(d0, ks + 1, 1)); }
        }
        const bf16x8 pa = ks == 0 ? pa0 : (ks == 1 ? pa1 : (ks == 2 ? pa2 : pa3));
#pragma unroll
        for (int d0 = 0; d0 < 4; ++d0) { const s16x4 l = L[ks & 1][d0], h = H[ks & 1][d0];
            o[d0] = __builtin_amdgcn_mfma_f32_32x32x16_bf16(pa, (bf16x8){l[0], l[1], l[2], l[3], h[0], h[1], h[2], h[3]}, o[d0], 0, 0, 0); }
    }
}
__device__ __forceinline__ void pack_p(const f32x16& p0, const f32x16& p1, bf16x8& pa0, bf16x8& pa1, bf16x8& pa2, bf16x8& pa3) {
#define PK4(P, BASE, OUT) do { unsigned a0 = cvt_pk_bf16(P[BASE + 0], P[BASE + 1]), a1 = cvt_pk_bf16(P[BASE + 2], P[BASE + 3]);   \
    unsigned b0 = cvt_pk_bf16(P[BASE + 4], P[BASE + 5]), b1 = cvt_pk_bf16(P[BASE + 6], P[BASE + 7]);                              \
    auto r0 = __builtin_amdgcn_permlane32_swap(a0, b0, false, false); auto r1 = __builtin_amdgcn_permlane32_swap(a1, b1, false, false); \
    u32x4 w = {r0[0], r1[0], r0[1], r1[1]}; OUT = *reinterpret_cast<bf16x8*>(&w); } while (0)
    PK4(p0, 0, pa0); PK4(p0, 8, pa1); PK4(p1, 0, pa2); PK4(p1, 8, pa3);
#undef PK4
}

__device__ __forceinline__ void pack_half(const f32x16& p, bf16x8& paA, bf16x8& paB) {
#define PK4(P, BASE, OUT) do { unsigned a0 = cvt_pk_bf16(P[BASE + 0], P[BASE + 1]), a1 = cvt_pk_bf16(P[BASE + 2], P[BASE + 3]);   \
    unsigned b0 = cvt_pk_bf16(P[BASE + 4], P[BASE + 5]), b1 = cvt_pk_bf16(P[BASE + 6], P[BASE + 7]);                              \
    auto r0 = __builtin_amdgcn_permlane32_swap(a0, b0, false, false); auto r1 = __builtin_amdgcn_permlane32_swap(a1, b1, false, false); \
    u32x4 w = {r0[0], r1[0], r0[1], r1[1]}; OUT = *reinterpret_cast<bf16x8*>(&w); } while (0)
    PK4(p, 0, paA); PK4(p, 8, paB);
#undef PK4
}
template <int KS0, bool WITH_EXP>
__device__ __forceinline__ void pv_half(f32x16* o, int vb, bf16x8 paA, bf16x8 paB, f32x16& px, float off) {
    s16x4 L[2][4], H[2][4];
#pragma unroll
    for (int d0 = 0; d0 < 4; ++d0) { L[0][d0] = tr_read(vb, v_rd_off(d0, KS0, 0)); H[0][d0] = tr_read(vb, v_rd_off(d0, KS0, 1)); }
#pragma unroll
    for (int d0 = 0; d0 < 4; ++d0) { L[1][d0] = tr_read(vb, v_rd_off(d0, KS0 + 1, 0)); H[1][d0] = tr_read(vb, v_rd_off(d0, KS0 + 1, 1)); }
#pragma unroll
    for (int kk = 0; kk < 2; ++kk) {
        const bf16x8 pa = kk == 0 ? paA : paB;
#pragma unroll
        for (int d0 = 0; d0 < 4; ++d0) { const s16x4 l = L[kk][d0], h = H[kk][d0];
            if (WITH_EXP) SBAR();
            o[d0] = __builtin_amdgcn_mfma_f32_32x32x16_bf16(pa, (bf16x8){l[0], l[1], l[2], l[3], h[0], h[1], h[2], h[3]}, o[d0], 0, 0, 0);
            if (WITH_EXP) {
#pragma unroll
                for (int q = 0; q < 2; ++q) { const int r = (kk * 4 + d0) * 2 + q; px[r] = __builtin_amdgcn_exp2f(fmaf(px[r], SM_C, off)); }
                SBAR(); }
        }
    }
}
enum { MODE_CMP = 0, MODE_WIN = 1, MODE_SLC = 2 };
struct AttnArgs {
    const bf16_t* Z; const bf16_t* KC; const bf16_t* VC; const float* G; float* L; float* OACC; bf16_t* MIX; const unsigned* BM; const float* TAB;
};
template <int MODE>
__device__ __forceinline__ void attn_unit(const AttnArgs& a, LAS char* ldsL, int qt, int g, int hp) {
    char* lds = (char*)ldsL;
    const int tid = threadIdx.x, wid = __builtin_amdgcn_readfirstlane(tid >> 6), lane = tid & 63, r32 = lane & 31, hi = lane >> 5;
    float* li_l = (float*)(lds + LDS_XCH) + wid * 64;
    const int t0 = MODE == MODE_SLC ? qt * 40 : qt * 128;
    const int tq_raw = MODE == MODE_SLC ? t0 + wid * 5 + r32 / 6 : t0 + wid * 16 + (r32 & 15);
    const bool rvalid = MODE == MODE_SLC ? (r32 < 30 && tq_raw < S_) : true;
    const int tq = tq_raw < S_ ? tq_raw : S_ - 1;
    const int hq = MODE == MODE_SLC ? g * HPG + r32 % 6 : g * HPG + hp * 2 + (r32 >> 4);
    const int tlast = MODE == MODE_SLC ? ((t0 + 39) < S_ ? (t0 + 39) : S_ - 1) : t0 + 127;
    const bf16_t* Kb; const bf16_t* Vb; long ldk;
    if (MODE == MODE_CMP) { Kb = a.KC + (size_t)g * 1024 * HD; Vb = a.VC + (size_t)g * 1024 * HD; ldk = HD; }
    else if (MODE == MODE_WIN) { Kb = a.Z + OFF_KV + 4 * 512 + g * HD; Vb = a.Z + OFF_KV + 5 * 512 + g * HD; ldk = LDZ; }
    else { Kb = a.Z + OFF_KV + 2 * 512 + g * HD; Vb = a.Z + OFF_KV + 3 * 512 + g * HD; ldk = LDZ; }
    int j0, j1;
    if (MODE == MODE_CMP) { j0 = 0; j1 = (((t0 + 127 - 31) >> 4) >> 6) + 1; }
    else if (MODE == MODE_WIN) { j0 = (t0 - 511) > 0 ? ((t0 - 511) >> 6) : 0; j1 = ((t0 + 127) >> 6) + 1; }
    else { j0 = 0; j1 = (tlast >> 6) + 1; }
    int klo, khi;
    if (MODE == MODE_CMP) { klo = 0; khi = tq >= 31 ? ((tq - 31) >> 4) : -1; }
    else if (MODE == MODE_WIN) { klo = tq - 511; khi = tq; }
    else { klo = 0; khi = rvalid ? tq : -1; }
    float negBC = -a.TAB[512 + (MODE == MODE_CMP ? 0 : (MODE == MODE_SLC ? 1 : 2))];
    bf16x8 qr[8];
    { const bf16_t* Qw = a.Z + (size_t)tq * LDZ + OFF_Q + hq * HD + hi * 8;
#pragma unroll
      for (int d0 = 0; d0 < 8; ++d0) qr[d0] = *reinterpret_cast<const bf16x8*>(Qw + d0 * 16); }
    f32x16 o[4] = {}; float lsum = 0.f;
    unsigned soK[2], soV[2];
#pragma unroll
    for (int i = 0; i < 2; ++i) { const int p = (wid + 8 * i) * 64 + lane;
        { const int row = p >> 4, c = (p & 15) ^ (row & 7); soK[i] = (unsigned)(row * ldk + c * 8) * 2u; }
        { const int sub = p >> 5, within = p & 31, kk = (sub >> 2) * 8 + (within >> 2), c = (sub & 3) * 32 + (within & 3) * 8, k = (kk & ~0xC) | ((kk & 4) << 1) | ((kk & 8) >> 1);
          soV[i] = (unsigned)(k * ldk + c) * 2u; } }
    const int vb0 = (int)(uintptr_t)(LAS char*)ldsL + 16384 + v_rd_base(lane);
#define ISSUE(jt) do { const int _b = ((jt) - j0) & 3; const char* _kp = (const char*)Kb + (size_t)(jt) * KVBLK * ldk * 2; const char* _vp = (const char*)Vb + (size_t)(jt) * KVBLK * ldk * 2; \
    _Pragma("unroll") for (int _i = 0; _i < 2; ++_i) { \
        __builtin_amdgcn_global_load_lds((const unsigned*)(_kp + soK[_i]), (LAS unsigned*)(ldsL + _b * 32768 + (wid + 8 * _i) * 1024), 16, 0, 0); \
        __builtin_amdgcn_global_load_lds((const unsigned*)(_vp + soV[_i]), (LAS unsigned*)(ldsL + _b * 32768 + 16384 + (wid + 8 * _i) * 1024), 16, 0, 0); } } while (0)
    unsigned bmw = 0u;
    if (MODE == MODE_SLC) bmw = a.BM[((size_t)tq * 4 + g) * 8];
    asm volatile("s_waitcnt lgkmcnt(0)" ::: "memory");
    __builtin_amdgcn_s_barrier();
    asm volatile("" ::: "memory");
    ISSUE(j0);
    asm volatile("s_waitcnt vmcnt(4) lgkmcnt(0)" : "+v"(bmw), "+v"(negBC), "+v"(qr[0]), "+v"(qr[1]), "+v"(qr[2]), "+v"(qr[3]), "+v"(qr[4]), "+v"(qr[5]), "+v"(qr[6]), "+v"(qr[7]) :: "memory");
    if (j0 + 1 < j1) ISSUE(j0 + 1); if (j0 + 2 < j1) ISSUE(j0 + 2);
    for (int j = j0; j < j1; ++j) {
        const int buf = (j - j0) & 3;
        if (j + 2 < j1) asm volatile("s_waitcnt vmcnt(8)" ::: "memory"); else if (j + 1 < j1) asm volatile("s_waitcnt vmcnt(4)" ::: "memory"); else asm volatile("s_waitcnt vmcnt(0)" ::: "memory");
        __builtin_amdgcn_s_barrier();
        asm volatile("" ::: "memory");
        if (j + 3 < j1) ISSUE(j + 3);
        int lhi = khi;
        if (MODE == MODE_SLC) { if (!((bmw >> (j & 31)) & 1u)) lhi = -1; }
        const int kb = j * KVBLK;
        const bool l_any = (kb + 63 >= klo) && (kb <= lhi);
        const bool l_full = (kb >= klo) && (kb + 63 <= lhi);
        if (__any(l_any)) {
            f32x16 p0, p1;
            qkt(p0, p1, lds + buf * 32768, qr, r32, hi);
            const bool uni = __all(l_full || !l_any);
            const float off = (uni && !l_any) ? -1.0e30f : negBC;
#pragma unroll
            for (int r = 0; r < 16; ++r) p0[r] = __builtin_amdgcn_exp2f(fmaf(p0[r], SM_C, off));
            if (!uni) {
#pragma unroll
                for (int r = 0; r < 16; ++r) { const int k0i = kb + crow(r, hi); p0[r] = (k0i >= klo && k0i <= lhi) ? p0[r] : 0.f; } }
            float ps = 0.f;
#pragma unroll
            for (int r = 0; r < 16; ++r) ps += p0[r];
            bf16x8 pa0, pa1, pa2, pa3; pack_half(p0, pa0, pa1);
            pv_half<0, true>(o, vb0 + buf * 32768, pa0, pa1, p1, off);
            if (!uni) {
#pragma unroll
                for (int r = 0; r < 16; ++r) { const int k1i = kb + 32 + crow(r, hi); p1[r] = (k1i >= klo && k1i <= lhi) ? p1[r] : 0.f; } }
#pragma unroll
            for (int r = 0; r < 16; ++r) ps += p1[r];
            lsum += ps;
            pack_half(p1, pa2, pa3);
            pv_half<2, false>(o, vb0 + buf * 32768, pa2, pa3, p1, off);
        }
        if (MODE == MODE_SLC) { if (((j + 1) & 31) == 0 && j + 1 < j1) { bmw = a.BM[((size_t)tq * 4 + g) * 8 + ((j + 1) >> 5)]; asm volatile("s_waitcnt vmcnt(0)" : "+v"(bmw) :: "memory"); } }
    }
#undef ISSUE
    lsum += __shfl_xor(lsum, 32);
    const float grow = a.G[(size_t)tq * NGATE + hq * 3 + (MODE == MODE_CMP ? 0 : (MODE == MODE_SLC ? 1 : 2))];
    if (hi == 0) { li_l[r32] = lsum; li_l[32 + r32] = rvalid ? grow : 0.f; }
    if (MODE == MODE_CMP) { if (hi == 0) a.L[(size_t)tq * NH + hq] = lsum; }
    asm volatile("s_waitcnt lgkmcnt(0)" ::: "memory");
#pragma unroll
    for (int hf = 0; hf < 2; ++hf) {
        float gtv[8]; float pvv[8][4];
#pragma unroll
        for (int rr = 0; rr < 8; ++rr) { const int r = hf * 8 + rr;
            const int orow = crow(r, hi); const float lv = li_l[orow]; const float rl = lv > 0.f ? __builtin_amdgcn_rcpf(lv) : 0.f;
            const int t = MODE == MODE_SLC ? t0 + wid * 5 + orow / 6 : t0 + wid * 16 + (orow & 15);
            const int h = MODE == MODE_SLC ? g * HPG + orow % 6 : g * HPG + hp * 2 + (orow >> 4);
            const bool valid = !(MODE == MODE_SLC && (orow >= 30 || t >= S_)); const int tc = valid ? t : 0;
            gtv[rr] = li_l[32 + orow] * rl;
            if (MODE == MODE_SLC) { const bf16_t* oc = (const bf16_t*)a.OACC + (size_t)tc * 3072 + h * HD + r32; const bf16_t* ow = oc + (size_t)S_ * 3072;
#pragma unroll
                for (int d0 = 0; d0 < 4; ++d0) pvv[rr][d0] = bf2f(oc[d0 * 32]) + bf2f(ow[d0 * 32]); }
        }
#pragma unroll
        for (int rr = 0; rr < 8; ++rr) { const int r = hf * 8 + rr;
            const int orow = crow(r, hi);
            const int t = MODE == MODE_SLC ? t0 + wid * 5 + orow / 6 : t0 + wid * 16 + (orow & 15);
            const int h = MODE == MODE_SLC ? g * HPG + orow % 6 : g * HPG + hp * 2 + (orow >> 4);
            if (MODE == MODE_SLC && (orow >= 30 || t >= S_)) continue;
            bf16_t* oa = (bf16_t*)a.OACC + (MODE == MODE_WIN ? (size_t)S_ * 3072 : 0) + (size_t)t * 3072 + h * HD + r32;
#pragma unroll
            for (int d0 = 0; d0 < 4; ++d0) {
                const float v = o[d0][r] * gtv[rr];
                if (MODE != MODE_SLC) oa[d0 * 32] = (bf16_t)(cvt_pk_bf16(v, 0.f) & 0xffffu);
                else a.MIX[(size_t)t * DM + POOLW + h * HD + d0 * 32 + r32] = (bf16_t)(cvt_pk_bf16(pvv[rr][d0] + v, 0.f) & 0xffffu);
            }
        }
    }
}

constexpr int SLC_KPS = 1040, SLC_VPS = 1056, SLC_KIMG = 16 * SLC_KPS, SLC_BUF = SLC_KIMG + 16 * SLC_VPS, LDS_SLCX = 4 * SLC_BUF;
static_assert(LDS_SLCX + 3072 <= LDS_MISC, "slc ring overlaps the barrier words");
__device__ __forceinline__ bf16x8 lds_b128(int adr) { return *reinterpret_cast<const LAS bf16x8*>((LAS char*)(unsigned long)(unsigned)adr); }
__device__ __forceinline__ void slc16_unit(const AttnArgs& a, LAS char* ldsL, int ut, int g) {
    char* lds = (char*)ldsL;
    const int tid = threadIdx.x, wid = __builtin_amdgcn_readfirstlane(tid >> 6), lane = tid & 63, fr = lane & 15, fq = lane >> 4;
    float* li_l = (float*)(lds + LDS_SLCX) + wid * 96;
    const int t0 = ut * 64, j0 = 0, j1 = ut + 1;
    const bf16_t* Kb = a.Z + OFF_KV + 2 * 512 + g * HD; const long ldk = LDZ;
    int tqv[3];
#pragma unroll
    for (int b = 0; b < 3; ++b) tqv[b] = t0 + wid * 8 + (16 * b + fr) / 6;
#define TQC(b) tqv[b]
#define HQ(b) (g * HPG + (16 * (b) + fr) % 6)
    float negBC = -a.TAB[513];
    bf16x8 qf[3][4];
#pragma unroll
    for (int b = 0; b < 3; ++b) { const bf16_t* qp = a.Z + (size_t)TQC(b) * LDZ + OFF_Q + HQ(b) * HD + fq * 8;
#pragma unroll
        for (int ks = 0; ks < 4; ++ks) qf[b][ks] = *reinterpret_cast<const bf16x8*>(qp + ks * 32); }
    f32x4 o[3][8]; float lsum[3];
#pragma unroll
    for (int b = 0; b < 3; ++b) { lsum[b] = 0.f;
#pragma unroll
        for (int c = 0; c < 8; ++c) o[b][c] = (f32x4){0.f, 0.f, 0.f, 0.f}; }
    const int q4 = fr >> 2, p4 = fr & 3, lbase = (int)(uintptr_t)ldsL;
    const int kaddr0 = lbase + fr * SLC_KPS + fq * 16;
    const int vaddr0 = lbase + SLC_KIMG + (4 * fq + q4) * SLC_VPS + (p4 >> 1) * 16 + (p4 & 1) * 8;
    unsigned so0 = (unsigned)((wid + 16 * (lane >> 4)) * ldk + (lane & 15) * 8) * 2u;
#define ISSUE16(jt) do { const int _b = ((jt) - j0) & 3; const char* _kp = (const char*)Kb + (size_t)(jt) * KVBLK * ldk * 2; asm volatile("" : "+v"(so0)); \
    _Pragma("unroll") for (int _i = 0; _i < 4; ++_i) \
        __builtin_amdgcn_global_load_lds((const unsigned*)(_kp + (_i >> 1) * 1024 + (_i & 1) * (8 * ldk * 2) + so0), \
            (LAS unsigned*)(ldsL + _b * SLC_BUF + ((_i >> 1) ? SLC_KIMG + (wid + 8 * (_i & 1)) * SLC_VPS : (wid + 8 * (_i & 1)) * SLC_KPS)), 16, 0, 0); } while (0)
    unsigned bmw[3];
#pragma unroll
    for (int b = 0; b < 3; ++b) bmw[b] = a.BM[((size_t)TQC(b) * 4 + g) * 8];
    asm volatile("s_waitcnt lgkmcnt(0)" ::: "memory");
    __builtin_amdgcn_s_barrier();
    asm volatile("" ::: "memory");
    ISSUE16(j0); if (j0 + 1 < j1) ISSUE16(j0 + 1);
    asm volatile("s_waitcnt vmcnt(0) lgkmcnt(0)" : "+v"(bmw[0]), "+v"(bmw[1]), "+v"(bmw[2]), "+v"(negBC), "+v"(qf[0][0]), "+v"(qf[0][1]), "+v"(qf[0][2]), "+v"(qf[0][3]),
                 "+v"(qf[1][0]), "+v"(qf[1][1]), "+v"(qf[1][2]), "+v"(qf[1][3]), "+v"(qf[2][0]), "+v"(qf[2][1]), "+v"(qf[2][2]), "+v"(qf[2][3]) :: "memory");
    int kadr = kaddr0, vadr = vaddr0;
    for (int j = j0; j < j1; ++j) {
        const int buf = (j - j0) & 3;
        if ((j & 1) == 0) {
            asm volatile("s_waitcnt vmcnt(0)" ::: "memory");
            __builtin_amdgcn_s_barrier();
            asm volatile("" ::: "memory");
            if (j + 2 < j1) ISSUE16(j + 2); if (j + 3 < j1) ISSUE16(j + 3); }
        const int kb = j * KVBLK;
#define KF16(ks, mt) lds_b128(kadr + 64 * (ks) + 256 * (mt))
#define TRA(dst, off) asm volatile("ds_read_b64_tr_b16 %0, %1 offset:%2" : "=v"(dst) : "v"(vadr), "n"(off))
#define VLOAD(dst, s, h) _Pragma("unroll") for (int _c = 0; _c < 4; ++_c) { TRA(dst[_c][0], 32 * (4 * (h) + _c) + 512 * (s)); TRA(dst[_c][1], 32 * (4 * (h) + _c) + 512 * (s) + 256); }
#define VWAIT(n, d) asm volatile("s_waitcnt lgkmcnt(" #n ")" : "+v"(d[0][0]), "+v"(d[0][1]), "+v"(d[1][0]), "+v"(d[1][1]), "+v"(d[2][0]), "+v"(d[2][1]), "+v"(d[3][0]), "+v"(d[3][1]))
#define PVMMA(src, pa, h) _Pragma("unroll") for (int _c = 0; _c < 4; ++_c) o[b][4 * (h) + _c] = __builtin_amdgcn_mfma_f32_16x16x32_bf16(pa, \
            (bf16x8){src[_c][0][0], src[_c][0][1], src[_c][0][2], src[_c][0][3], src[_c][1][0], src[_c][1][1], src[_c][1][2], src[_c][1][3]}, o[b][4 * (h) + _c], 0, 0, 0);
#define EXPH(h, pw) { if (uni) { _Pragma("unroll") for (int mt = 2 * (h); mt < 2 * (h) + 2; ++mt) _Pragma("unroll") for (int i = 0; i < 4; ++i) { \
                            const float e_ = __builtin_amdgcn_exp2f(fmaf(acc[mt][i], SM_C, off)); acc[mt][i] = e_; ps += e_; } } \
                      else { asm volatile("" ::: "memory"); _Pragma("unroll") for (int mt = 2 * (h); mt < 2 * (h) + 2; ++mt) _Pragma("unroll") for (int i = 0; i < 4; ++i) { \
                            float e_ = __builtin_amdgcn_exp2f(fmaf(acc[mt][i], SM_C, off)); e_ = (16 * mt + i <= lim4) ? e_ : 0.f; acc[mt][i] = e_; ps += e_; } } \
                      pw.x = cvt_pk_bf16(acc[2 * (h)][0], acc[2 * (h)][1]); pw.y = cvt_pk_bf16(acc[2 * (h)][2], acc[2 * (h)][3]); \
                      pw.z = cvt_pk_bf16(acc[2 * (h) + 1][0], acc[2 * (h) + 1][1]); pw.w = cvt_pk_bf16(acc[2 * (h) + 1][2], acc[2 * (h) + 1][3]); }
#pragma unroll
        for (int b = 0; b < 3; ++b) {
            const bool sel = (bmw[b] >> (j & 31)) & 1u;
            const int lim = tqv[b] - kb;
            const bool l_any = sel && lim >= 0, l_full = sel && lim >= 63;
            if (__any(l_any)) {
                f32x4 acc[4]; bf16x8 kr[8]; s16x4 va[4][2], vc[4][2];
#define KRD(i) asm volatile("ds_read_b128 %0, %1 offset:%2" : "=v"(kr[(i) & 7]) : "v"(kadr), "n"(64 * ((i) >> 2) + 256 * ((i) & 3)))
#define KWT(n, i) asm volatile("s_waitcnt lgkmcnt(" #n ")" : "+v"(kr[(i) & 7]))
#define KMM(i) acc[(i) & 3] = __builtin_amdgcn_mfma_f32_16x16x32_bf16(kr[(i) & 7], qf[b][(i) >> 2], (i) < 4 ? (f32x4){0.f, 0.f, 0.f, 0.f} : acc[(i) & 3], 0, 0, 0)
                KRD(0); KRD(1); KRD(2); KRD(3); KRD(4); KRD(5); KRD(6); KRD(7);
#define SB_ __builtin_amdgcn_sched_barrier(0)
                SB_; KWT(7, 0); KMM(0); SB_; KRD(8);  KWT(7, 1); KMM(1); SB_; KRD(9);  KWT(7, 2); KMM(2); SB_; KRD(10); KWT(7, 3); KMM(3); SB_; KRD(11);
                KWT(7, 4); KMM(4); SB_; KRD(12); KWT(7, 5); KMM(5); SB_; KRD(13); KWT(7, 6); KMM(6); SB_; KRD(14); KWT(7, 7); KMM(7); SB_; KRD(15);
                KWT(7, 8); KMM(8); SB_; KWT(6, 9); KMM(9); SB_; KWT(5, 10); KMM(10); SB_; KWT(4, 11); KMM(11); SB_; KWT(3, 12); KMM(12); SB_; KWT(2, 13); KMM(13); SB_; KWT(1, 14); KMM(14); SB_; KWT(0, 15); KMM(15);
#undef SB_
                __builtin_amdgcn_sched_barrier(0);
#undef KRD
#undef KWT
#undef KMM
                VLOAD(va, 0, 0)
                VLOAD(vc, 0, 1)
                const bool uni = __all(l_full || !l_any);
                const float off = (uni && !l_any) ? -1.0e30f : negBC;
                const int lim4 = l_any ? lim - 4 * fq : -1;
                float ps = 0.f;
                u32x4 pw0, pw1;
                EXPH(0, pw0)
                const bf16x8 pa0 = *reinterpret_cast<bf16x8*>(&pw0);
                __builtin_amdgcn_sched_barrier(0);
                VWAIT(8, va);
                PVMMA(va, pa0, 0)
                __builtin_amdgcn_sched_barrier(0);
                VLOAD(va, 1, 0)
                VWAIT(8, vc);
                PVMMA(vc, pa0, 1)
                __builtin_amdgcn_sched_barrier(0);
                VLOAD(vc, 1, 1)
                EXPH(1, pw1)
                const bf16x8 pa1 = *reinterpret_cast<bf16x8*>(&pw1);
                lsum[b] += ps;
                __builtin_amdgcn_sched_barrier(0);
                VWAIT(8, va);
                PVMMA(va, pa1, 0)
                __builtin_amdgcn_sched_barrier(0);
                VWAIT(0, vc);
                PVMMA(vc, pa1, 1)
                __builtin_amdgcn_sched_barrier(0);
            }
        }
#undef TRA
#undef VWAIT
#undef EXPH
#undef KF16
#undef VLOAD
#undef PVMMA
        if (((j + 1) & 31) == 0 && j + 1 < j1) {
#pragma unroll
            for (int b = 0; b < 3; ++b) bmw[b] = a.BM[((size_t)TQC(b) * 4 + g) * 8 + ((j + 1) >> 5)];
            asm volatile("s_waitcnt vmcnt(0)" : "+v"(bmw[0]), "+v"(bmw[1]), "+v"(bmw[2]) :: "memory"); }
        { const int step = buf == 3 ? -3 * SLC_BUF : SLC_BUF; kadr += step; vadr += step; asm volatile("" : "+v"(kadr), "+v"(vadr)); }
    }
#undef ISSUE16
    int fqe = fq, fre = fr; asm volatile("" : "+v"(fqe), "+v"(fre));
    float grow[3];
#pragma unroll
    for (int b = 0; b < 3; ++b) grow[b] = a.G[(size_t)TQC(b) * NGATE + (g * HPG + (16 * b + fre) % 6) * 3 + 1];
#pragma unroll
    for (int b = 0; b < 3; ++b) { float ls = lsum[b]; ls += __shfl_xor(ls, 16); ls += __shfl_xor(ls, 32);
        if (fqe == 0) { li_l[b * 32 + fre] = ls; li_l[b * 32 + 16 + fre] = grow[b]; } }
    asm volatile("s_waitcnt lgkmcnt(0)" ::: "memory");
#pragma unroll
    for (int b = 0; b < 3; ++b) {
        float pv_[4][8]; float gtv[4];
#pragma unroll
        for (int i = 0; i < 4; ++i) { const int q = 4 * fqe + i, R = 16 * b + q; const float lv = li_l[b * 32 + q]; gtv[i] = li_l[b * 32 + 16 + q] * (lv > 0.f ? __builtin_amdgcn_rcpf(lv) : 0.f);
            const int t = t0 + wid * 8 + R / 6, h = g * HPG + R % 6;
            const bf16_t* oc = (const bf16_t*)a.OACC + (size_t)t * 3072 + h * HD + fre; const bf16_t* ow = oc + (size_t)S_ * 3072;
            bf16_t c_[8], w_[8];
#pragma unroll
            for (int c = 0; c < 8; ++c) { c_[c] = oc[c * 16]; w_[c] = ow[c * 16]; }
#pragma unroll
            for (int c = 0; c < 8; ++c) pv_[i][c] = bf2f(c_[c]) + bf2f(w_[c]); }
#pragma unroll
        for (int i = 0; i < 4; ++i) { const int R = 16 * b + 4 * fqe + i; const int t = t0 + wid * 8 + R / 6, h = g * HPG + R % 6;
            bf16_t* mp = a.MIX + (size_t)t * DM + POOLW + h * HD + fre;
#pragma unroll
            for (int c = 0; c < 8; ++c) mp[c * 16] = (bf16_t)(cvt_pk_bf16(pv_[i][c] + o[b][c][i] * gtv[i], 0.f) & 0xffffu); }
    }
#undef TQC
#undef HQ
}

__device__ __forceinline__ void imp_task(const AttnArgs& a, float* IMPP, float* IMPF, int tqi, int g) {
    const int lane = threadIdx.x & 63, fr = lane & 15, fq = lane >> 4;
    const int t = tqi * 16 + fr;
    const int tmax = tqi * 16 + 15;
    if (tmax < 31) return;
    const int lim = t >= 31 ? ((t - 31) >> 4) : -1;
    const int nstep = ((((tmax - 31) >> 4) >> 6) + 1) * 4;
    const float negBC = -a.TAB[512];
    bf16x8 qf[HPG][4]; float rl[HPG];
#pragma unroll
    for (int h = 0; h < HPG; ++h) {
        const bf16_t* qp = a.Z + (size_t)t * LDZ + OFF_Q + (g * HPG + h) * HD + fq * 8;
#pragma unroll
        for (int ks = 0; ks < 4; ++ks) qf[h][ks] = *reinterpret_cast<const bf16x8*>(qp + ks * 32);
        const float lv = a.L[(size_t)t * NH + g * HPG + h]; rl[h] = lv > 0.f ? 1.0f / lv : 0.f;
    }
    const bf16_t* kbase = a.KC + (size_t)g * 1024 * HD + (size_t)fr * HD + fq * 8;
    bf16x8 kf[4], kn[4], kn2[4];
#pragma unroll
    for (int ks = 0; ks < 4; ++ks) { kf[ks] = *reinterpret_cast<const bf16x8*>(kbase + ks * 32); kn[ks] = *reinterpret_cast<const bf16x8*>(kbase + (size_t)(nstep > 1 ? 1 : 0) * 16 * HD + ks * 32); }
    float* op = IMPP + ((size_t)t * 4 + g) * 256 + fq; float* of = IMPF + ((size_t)t * 4 + g) * 256 + fq;
    for (int st = 0; st < nstep; ++st) {
        const int sn = (st + 2 < nstep) ? st + 2 : nstep - 1;
#pragma unroll
        for (int ks = 0; ks < 4; ++ks) kn2[ks] = *reinterpret_cast<const bf16x8*>(kbase + (size_t)sn * 16 * HD + ks * 32);
        f32x4 imp4 = {0.f, 0.f, 0.f, 0.f};
        const int n0 = st * 16 + fq * 4;
#pragma unroll
        for (int h = 0; h < HPG; ++h) {
            f32x4 acc = {0.f, 0.f, 0.f, 0.f};
#pragma unroll
            for (int ks = 0; ks < 4; ++ks) acc = __builtin_amdgcn_mfma_f32_16x16x32_bf16(kf[ks], qf[h][ks], acc, 0, 0, 0);
#pragma unroll
            for (int i = 0; i < 4; ++i) { const float e = __builtin_amdgcn_exp2f(fmaf(acc[i], SM_C, negBC)) * rl[h]; imp4[i] += (n0 + i <= lim) ? e : 0.f; }
        }
        op[st * 4] = imp4[0] + 2.0f * (imp4[1] + imp4[2] + imp4[3]);
        of[st * 4] = imp4[0];
#pragma unroll
        for (int ks = 0; ks < 4; ++ks) { kf[ks] = kn[ks]; kn[ks] = kn2[ks]; }
    }
}

__device__ __forceinline__ void topk_load(const float* IMPP, const float* IMPF, int t, int g, f32x4& pp, f32x4& ff) {
    const int lane = threadIdx.x & 63, cur = t >> 6, jb = lane * 4;
    pp = (f32x4){0.f, 0.f, 0.f, 0.f}; ff = pp;
    if (cur > 15 && jb <= cur) { const size_t base = ((size_t)t * 4 + g) * 256; pp = *(const f32x4*)(IMPP + base + jb); ff = *(const f32x4*)(IMPF + base + jb); }
}
__device__ __forceinline__ void topk_task(const f32x4 pp, const f32x4 ff, unsigned* BM, int t, int g) {
    const int lane = threadIdx.x & 63;
    const int cur = t >> 6;
    unsigned nib = 0u;
    if (cur <= 15) { const int jb = lane * 4;
#pragma unroll
        for (int c = 0; c < 4; ++c) if (jb + c <= cur) nib |= 1u << c; }
    else {
        const int jb = lane * 4;
        unsigned key[4];
        {
            float fnext = __shfl_down(ff[0], 1);
            if (lane == 63) fnext = 0.f;
            const float v0 = pp[0] + ff[1], v1 = pp[1] + ff[2], v2 = pp[2] + ff[3], v3 = pp[3] + fnext;
            key[0] = (jb + 0 >= 1 && jb + 0 <= cur - 2) ? __float_as_uint(fmaxf(v0, 0.f)) + 1u : 0u;
            key[1] = (jb + 1 >= 1 && jb + 1 <= cur - 2) ? __float_as_uint(fmaxf(v1, 0.f)) + 1u : 0u;
            key[2] = (jb + 2 >= 1 && jb + 2 <= cur - 2) ? __float_as_uint(fmaxf(v2, 0.f)) + 1u : 0u;
            key[3] = (jb + 3 >= 1 && jb + 3 <= cur - 2) ? __float_as_uint(fmaxf(v3, 0.f)) + 1u : 0u;
        }
        unsigned prefix = 0u; bool exact = false;
        for (int b = 30; b >= 0; --b) {
            const unsigned trial = prefix | (1u << b);
            const int cnt = __popcll(__ballot(key[0] >= trial)) + __popcll(__ballot(key[1] >= trial)) + __popcll(__ballot(key[2] >= trial)) + __popcll(__ballot(key[3] >= trial));
            if (cnt >= 13) { prefix = trial; if (cnt == 13) { exact = true; break; } }
        }
#pragma unroll
        for (int c = 0; c < 4; ++c) if (exact ? (key[c] >= prefix) : (key[c] > prefix)) nib |= 1u << c;
        if (!exact) {
            int need = 13 - (__popcll(__ballot(key[0] > prefix)) + __popcll(__ballot(key[1] > prefix)) + __popcll(__ballot(key[2] > prefix)) + __popcll(__ballot(key[3] > prefix)));
            unsigned tie = 0u;
#pragma unroll
            for (int c = 0; c < 4; ++c) if (key[c] == prefix) tie |= 1u << c;
            for (int guard = 0; need > 0 && guard < 16; ++guard) {
                const unsigned long long any = __ballot(tie != 0u);
                if (any == 0ull) break;
                const int L = __builtin_ctzll(any);
                if (lane == L) { const unsigned low = tie & (0u - tie); nib |= low; tie ^= low; }
                --need;
            }
        }
        if (lane == 0) nib |= 1u;
        if (lane == (cur >> 2)) nib |= 1u << (cur & 3);
        if (lane == ((cur - 1) >> 2)) nib |= 1u << ((cur - 1) & 3);
    }
    unsigned x = nib << (4 * (lane & 7));
    x |= __shfl_xor(x, 1); x |= __shfl_xor(x, 2); x |= __shfl_xor(x, 4);
    if ((lane & 7) == 0) BM[((size_t)t * 4 + g) * 8 + (lane >> 3)] = x;
}
#undef KSWZ
}

template <bool FFN_REMAP = false>
__device__ __forceinline__ void convT(const float* __restrict__ src0, int K, int N, bf16_t* __restrict__ dst, int ldd, LAS float* tile, int bid, int nb, int Nfull = 0, int n0 = 0) {
    const float* __restrict__ src = src0 + n0; if (Nfull == 0) Nfull = N;
    const int tid = threadIdx.x, tk = K >> 6, tn = (N + 63) >> 6, total = tk * tn;
    const int r = tid >> 4, c4 = (tid & 15) * 4;
    f32x4 v[2] = {{0.f, 0.f, 0.f, 0.f}, {0.f, 0.f, 0.f, 0.f}}, vn[2];
    if (bid < total) { const int nti = bid % tn, kti = bid / tn, ng = nti * 64 + c4;
#pragma unroll
        for (int h = 0; h < 2; ++h) if (ng < N) v[h] = *(const f32x4*)(src + (size_t)(kti * 64 + r + h * 32) * Nfull + ng); }
    for (int idx = bid; idx < total; idx += nb) {
        const int nti = idx % tn, kti = idx / tn;
#pragma unroll
        for (int h = 0; h < 2; ++h) { LAS float* tp = tile + (r + h * 32) * 65 + c4; tp[0] = v[h][0]; tp[1] = v[h][1]; tp[2] = v[h][2]; tp[3] = v[h][3]; }
        {
            const int nx = idx + nb; vn[0] = (f32x4){0.f, 0.f, 0.f, 0.f}; vn[1] = vn[0];
            if (nx < total) { const int nti2 = nx % tn, kti2 = nx / tn, ng2 = nti2 * 64 + c4;
#pragma unroll
                for (int h = 0; h < 2; ++h) if (ng2 < N) vn[h] = *(const f32x4*)(src + (size_t)(kti2 * 64 + r + h * 32) * Nfull + ng2); } }
        __syncthreads();
        const int n = tid >> 3, k8 = (tid & 7) * 8, ngl = nti * 64 + n;
        float e[8];
#pragma unroll
        for (int i = 0; i < 8; ++i) e[i] = tile[(k8 + i) * 65 + n];
        if (ngl < N) { u32x4 w; w.x = cvt_pk_bf16(e[0], e[1]); w.y = cvt_pk_bf16(e[2], e[3]); w.z = cvt_pk_bf16(e[4], e[5]); w.w = cvt_pk_bf16(e[6], e[7]);
            int drow = ngl; if (FFN_REMAP) { const int up = ngl >= DFF ? 1 : 0, f = ngl - up * DFF; drow = (f >> 7) * 256 + up * 128 + (f & 127); }
            *(u32x4*)(dst + (size_t)drow * ldd + kti * 64 + k8) = w; }
        __syncthreads();
        v[0] = vn[0]; v[1] = vn[1];
    }
}
__device__ __forceinline__ void convT8(const float* __restrict__ src0, int K, int N, unsigned char* __restrict__ dst, int ldd, float scale, LAS float* tile, int bid, int nb, int Nfull = 0, int n0 = 0) {
    const float* __restrict__ src = src0 + n0; if (Nfull == 0) Nfull = N;
    const int tid = threadIdx.x, tk = K >> 6, tn = (N + 63) >> 6, total = tk * tn;
    const int r = tid >> 4, c4 = (tid & 15) * 4;
    f32x4 v[2] = {{0.f, 0.f, 0.f, 0.f}, {0.f, 0.f, 0.f, 0.f}}, vn[2];
    if (bid < total) { const int nti = bid % tn, kti = bid / tn, ng = nti * 64 + c4;
#pragma unroll
        for (int h = 0; h < 2; ++h) if (ng < N) v[h] = *(const f32x4*)(src + (size_t)(kti * 64 + r + h * 32) * Nfull + ng); }
    for (int idx = bid; idx < total; idx += nb) {
        const int nti = idx % tn, kti = idx / tn;
#pragma unroll
        for (int h = 0; h < 2; ++h) { LAS float* tp = tile + (r + h * 32) * 65 + c4; tp[0] = v[h][0]; tp[1] = v[h][1]; tp[2] = v[h][2]; tp[3] = v[h][3]; }
        { const int nx = idx + nb; vn[0] = (f32x4){0.f, 0.f, 0.f, 0.f}; vn[1] = vn[0];
            if (nx < total) { const int nti2 = nx % tn, kti2 = nx / tn, ng2 = nti2 * 64 + c4;
#pragma unroll
                for (int h = 0; h < 2; ++h) if (ng2 < N) vn[h] = *(const f32x4*)(src + (size_t)(kti2 * 64 + r + h * 32) * Nfull + ng2); } }
        __syncthreads();
        const int n = tid >> 3, k8 = (tid & 7) * 8, ngl = nti * 64 + n;
        float e[8];
#pragma unroll
        for (int i = 0; i < 8; ++i) e[i] = tile[(k8 + i) * 65 + n] * scale;
        if (ngl < N) { int p0 = __builtin_amdgcn_cvt_pk_fp8_f32(e[0], e[1], 0, false); p0 = __builtin_amdgcn_cvt_pk_fp8_f32(e[2], e[3], p0, true);
            int p1 = __builtin_amdgcn_cvt_pk_fp8_f32(e[4], e[5], 0, false); p1 = __builtin_amdgcn_cvt_pk_fp8_f32(e[6], e[7], p1, true);
            *(u32x2*)(dst + (size_t)ngl * ldd + kti * 64 + k8) = (u32x2){(unsigned)p0, (unsigned)p1}; }
        __syncthreads();
        v[0] = vn[0]; v[1] = vn[1];
    }
}
__device__ __forceinline__ void rmsnorm_rows(const float* __restrict__ src, const float* __restrict__ w, bf16_t* __restrict__ dst, int rows, int gw, int nw, unsigned char* __restrict__ dst8 = nullptr) {
    const int lane = threadIdx.x & 63;
    f32x4 v[16], vn[16];
    if (gw < rows) { const f32x4* sp = (const f32x4*)(src + (size_t)gw * DM);
#pragma unroll
        for (int i = 0; i < 16; ++i) v[i] = sp[lane + 64 * i]; }
    for (int row = gw; row < rows; row += nw) {
        const int nr = row + nw < rows ? row + nw : row;
        { const f32x4* sp = (const f32x4*)(src + (size_t)nr * DM);
#pragma unroll
          for (int i = 0; i < 16; ++i) vn[i] = sp[lane + 64 * i]; }
        float ss = 0.f;
#pragma unroll
        for (int i = 0; i < 16; ++i) ss += v[i][0] * v[i][0] + v[i][1] * v[i][1] + v[i][2] * v[i][2] + v[i][3] * v[i][3];
        ss = wave_sum(ss);
        const float rstd = rsqrtf(ss * (1.0f / DM) + EPS);
#pragma unroll
        for (int i = 0; i < 16; ++i) { const f32x4 ww = ((const f32x4*)w)[lane + 64 * i];
            u32x2 o; o.x = cvt_pk_bf16(v[i][0] * rstd * ww[0], v[i][1] * rstd * ww[1]); o.y = cvt_pk_bf16(v[i][2] * rstd * ww[2], v[i][3] * rstd * ww[3]);
            *(u32x2*)(dst + (size_t)row * DM + (lane + 64 * i) * 4) = o;
            if (dst8) { int pk = __builtin_amdgcn_cvt_pk_fp8_f32(v[i][0] * rstd * ww[0], v[i][1] * rstd * ww[1], 0, false); pk = __builtin_amdgcn_cvt_pk_fp8_f32(v[i][2] * rstd * ww[2], v[i][3] * rstd * ww[3], pk, true);
                *(int*)(dst8 + (size_t)row * DM + (lane + 64 * i) * 4) = pk; } }
#pragma unroll
        for (int i = 0; i < 16; ++i) v[i] = vn[i];
    }
}

struct Ptrs {
    bf16_t *Win, *Wo, *Wfi, *Wfo, *Wg, *Wple, *Wpool, *Wc1k, *Wc1v, *XN, *PB, *Z, *M, *KC, *VC, *MIX, *ACT, *ERAW;
    float *COS, *SIN, *TAB, *G, *H1, *L, *OACC, *IMPP, *IMPF, *ERSTD; unsigned* BM;
};

__device__ __forceinline__ void phase_prologue(const Params& P, const Ptrs& W, LAS unsigned char* lds) {
    const int bid = blockIdx.x, nb = gridDim.x, tid = threadIdx.x, lane = tid & 63, wv = tid >> 6;
    const int gw = bid * NWAVES + wv, nw = nb * NWAVES; const size_t gt = (size_t)bid * NTHREADS + tid, ntot = (size_t)nb * NTHREADS;
    LAS float* tile = (LAS float*)lds;
    rmsnorm_rows(P.x, P.norm1_w, W.XN, S_, gw, nw, P.ws + WS_XN8);
    convT(P.w_in, DM, POOLW, W.Win, DM, tile, bid, nb, INW, 0);
    convT(P.w_in, DM, INW - OFF_G, W.Win + (size_t)OFF_G * DM, DM, tile, bid, nb, INW, OFF_G);
    convT8(P.w_in, DM, OFF_G - POOLW, P.ws + WS_WIN8, DM, WG8_SCALE, tile, bid, nb, INW, POOLW);
    for (size_t i = gt; i < (size_t)(LDZ - INW) * DM / 8; i += ntot) *(u32x4*)(W.Win + (size_t)INW * DM + i * 8) = (u32x4){0u, 0u, 0u, 0u};
    convT(P.w_o, DM, DM, W.Wo, DM, tile, bid, nb);
    convT<true>(P.w_ffn_in, DM, NFI, W.Wfi, DM, tile, bid, nb);
    for (size_t i = gt; i < (size_t)2 * DM / 8; i += ntot) *(u32x4*)(W.XN - 2 * DM + i * 8) = (u32x4){0u, 0u, 0u, 0u};
    convT(P.w_ffn_out, DFF, DM, W.Wfo, DFF, tile, bid, nb);
    convT8(P.w_ple_gate, DM, DM, (unsigned char*)W.Wg, DM, WG8_SCALE, tile, bid, nb);
    convT(P.w_ple_proj, PLE, DM, W.Wple, PLE, tile, bid, nb);
    for (int g = 0; g < 4; ++g) convT(P.w_pool + (size_t)g * 65536, 256, 256, W.Wpool + (size_t)g * 65536, 256, tile, bid, nb);
    convT(P.cmp_k_w1, 4096, 256, W.Wc1k, 4096, tile, bid, nb);
    convT(P.cmp_v_w1, 4096, 256, W.Wc1v, 4096, tile, bid, nb);
    { constexpr size_t NP8 = (size_t)S_ * PLE / 8;
      for (size_t ib = gt; ib < NP8; ib += 4 * ntot) { f32x4 av[4], bv[4];
#pragma unroll
          for (int k = 0; k < 4; ++k) { size_t i = ib + k * ntot; if (i >= NP8) i = NP8 - 1; av[k] = *(const f32x4*)(P.p + i * 8); bv[k] = *(const f32x4*)(P.p + i * 8 + 4); }
#pragma unroll
          for (int k = 0; k < 4; ++k) { const size_t i = ib + k * ntot; if (i < NP8) { u32x4 w; w.x = cvt_pk_bf16(av[k][0], av[k][1]); w.y = cvt_pk_bf16(av[k][2], av[k][3]); w.z = cvt_pk_bf16(bv[k][0], bv[k][1]); w.w = cvt_pk_bf16(bv[k][2], bv[k][3]); *(u32x4*)(W.PB + i * 8) = w; } } } }
    for (size_t i = gt; i < (size_t)S_ * 16; i += ntot) { const int t = (int)(i >> 4), fi = (int)(i & 15);
        const float inv = exp2f(-(float)fi * (18.931568569324174f / 16.0f)); const float ang = (float)P.positions[t] * inv;
        const double ad = (double)ang; const double kk = rint(ad * 0.15915494309189535); const float rf = (float)(ad - kk * 6.283185307179586);
        W.COS[i] = __cosf(rf); W.SIN[i] = __sinf(rf); }
    for (int task = gw; task < 128; task += nw) { const int which = task >> 6, r0 = (task & 63) * 64; const float* pe = which ? P.cmp_pos_v : P.cmp_pos_k; const float* w1 = which ? P.cmp_v_w1 : P.cmp_k_w1;
        f32x4 s = {0.f, 0.f, 0.f, 0.f};
#pragma unroll 8
        for (int r = 0; r < 64; ++r) { const f32x4 wv = *(const f32x4*)(w1 + (size_t)(r0 + r) * 256 + lane * 4); s += wv * pe[r0 + r]; }
        float* cbp = (float*)(P.ws + WS_CBIAS) + which * 256 + lane * 4;
        unsafeAtomicAdd(cbp + 0, s[0]); unsafeAtomicAdd(cbp + 1, s[1]); unsafeAtomicAdd(cbp + 2, s[2]); unsafeAtomicAdd(cbp + 3, s[3]); }
    if (gw == 0) { float mq = fmaxf(fabsf(P.q_norm_w[lane]), fabsf(P.q_norm_w[lane + 64])); mq = wave_max(mq);
        float mc = wave_max(fmaxf(fabsf(P.k_norm_cmp_w[lane]), fabsf(P.k_norm_cmp_w[lane + 64])));
        float ms = wave_max(fmaxf(fabsf(P.k_norm_slc_w[lane]), fabsf(P.k_norm_slc_w[lane + 64])));
        float mw = wave_max(fmaxf(fabsf(P.k_norm_win_w[lane]), fabsf(P.k_norm_win_w[lane + 64])));
        const float c = 11.313708498984761f * 1.4426950408889634f * mq * 1.01f;
        if (lane == 0) { W.TAB[512] = c * mc; W.TAB[513] = c * ms; W.TAB[514] = c * mw; } }
}

__device__ __forceinline__ void phase_postz(const Params& P, const Ptrs& W, int gw, int nw) {
    const int tid = threadIdx.x, lane = tid & 63;
    const f32x2 wq = *(const f32x2*)(P.q_norm_w + 2 * lane), wks = *(const f32x2*)(P.k_norm_slc_w + 2 * lane), wkw = *(const f32x2*)(P.k_norm_win_w + 2 * lane);
    for (int t = gw; t < S_; t += nw) {
        bf16_t* zr = W.Z + (size_t)t * LDZ;
        float cs0 = 0.f, cs1 = 0.f, sn0 = 0.f, sn1 = 0.f;
        if (lane < 16) { const int i0 = (2 * lane) & 15; cs0 = W.COS[t * 16 + i0]; cs1 = W.COS[t * 16 + i0 + 1]; sn0 = W.SIN[t * 16 + i0]; sn1 = W.SIN[t * 16 + i0 + 1]; }
        unsigned uv[32];
#pragma unroll
        for (int v = 0; v < 32; ++v) { const int col = v < 24 ? OFF_Q + v * HD : (v < 28 ? OFF_KV + 2 * 512 + (v - 24) * HD : OFF_KV + 4 * 512 + (v - 28) * HD);
            uv[v] = *((const unsigned*)(zr + col) + lane); }
#pragma unroll
        for (int v = 0; v < 32; ++v) {
            const f32x2 ww = v < 24 ? wq : (v < 28 ? wks : wkw);
            const unsigned u = uv[v]; const float x0 = bf_lo(u), x1 = bf_hi(u);
            const float ss = wave_sum(x0 * x0 + x1 * x1);
            const float rstd = rsqrtf(ss * (1.0f / HD) + EPS);
            float y0 = x0 * rstd * ww[0], y1 = x1 * rstd * ww[1];
            const float p0 = __shfl_xor(y0, 8), p1 = __shfl_xor(y1, 8);
            if (lane < 8) { y0 = y0 * cs0 - p0 * sn0; y1 = y1 * cs1 - p1 * sn1; }
            else if (lane < 16) { y0 = y0 * cs0 + p0 * sn0; y1 = y1 * cs1 + p1 * sn1; }
            uv[v] = cvt_pk_bf16(y0, y1);
        }
        {
            const int gi = lane >> 4, wlen = 2 << gi, c0 = lane * 16; const int cnt = (t + 1) < wlen ? (t + 1) : wlen;
            float s[16];
#pragma unroll
            for (int i = 0; i < 16; ++i) s[i] = 0.f;
            float cur[16];
#pragma unroll
            for (int bt = 0; bt < 2; ++bt) {
                u32x4 ra[8], rb[8];
#pragma unroll
                for (int i = 0; i < 8; ++i) { const int ii = bt * 8 + i; const size_t row = (size_t)(ii < cnt ? t - ii : t);
                    ra[i] = *(const u32x4*)(W.Z + row * LDZ + c0); rb[i] = *(const u32x4*)(W.Z + row * LDZ + c0 + 8); }
#pragma unroll
                for (int i = 0; i < 8; ++i) { const int ii = bt * 8 + i; const float mk = ii < cnt ? 1.0f : 0.0f; const u32x4 a = ra[i], b = rb[i];
                    const float ev[16] = {bf_lo(a.x), bf_hi(a.x), bf_lo(a.y), bf_hi(a.y), bf_lo(a.z), bf_hi(a.z), bf_lo(a.w), bf_hi(a.w), bf_lo(b.x), bf_hi(b.x), bf_lo(b.y), bf_hi(b.y), bf_lo(b.z), bf_hi(b.z), bf_lo(b.w), bf_hi(b.w)};
#pragma unroll
                    for (int q = 0; q < 16; ++q) { s[q] += ev[q] * mk; if (ii == 0) cur[q] = ev[q]; } }
                if (bt == 0 && __all(cnt <= 8)) break;
            }
            const float rc = 1.0f / (float)cnt;
            u32x4 o0, o1;
            o0.x = cvt_pk_bf16(s[0] * rc - cur[0], s[1] * rc - cur[1]); o0.y = cvt_pk_bf16(s[2] * rc - cur[2], s[3] * rc - cur[3]);
            o0.z = cvt_pk_bf16(s[4] * rc - cur[4], s[5] * rc - cur[5]); o0.w = cvt_pk_bf16(s[6] * rc - cur[6], s[7] * rc - cur[7]);
            o1.x = cvt_pk_bf16(s[8] * rc - cur[8], s[9] * rc - cur[9]); o1.y = cvt_pk_bf16(s[10] * rc - cur[10], s[11] * rc - cur[11]);
            o1.z = cvt_pk_bf16(s[12] * rc - cur[12], s[13] * rc - cur[13]); o1.w = cvt_pk_bf16(s[14] * rc - cur[14], s[15] * rc - cur[15]);
            *(u32x4*)(W.M + (size_t)t * POOLW + c0) = o0; *(u32x4*)(W.M + (size_t)t * POOLW + c0 + 8) = o1;
        }
#pragma unroll
        for (int v = 0; v < 32; ++v) { const int col = v < 24 ? OFF_Q + v * HD : (v < 28 ? OFF_KV + 2 * 512 + (v - 24) * HD : OFF_KV + 4 * 512 + (v - 28) * HD);
            *((unsigned*)(zr + col) + lane) = uv[v]; }

    }
}

__device__ __forceinline__ void phase_cmpfin(const Params& P, const Ptrs& W) {
    const int tid = threadIdx.x, lane = tid & 63, gw = blockIdx.x * NWAVES + (tid >> 6), nw = gridDim.x * NWAVES;
    const f32x2 wk = *(const f32x2*)(P.k_norm_cmp_w + 2 * lane);
    for (int task = gw; task < 8192; task += nw) {
        const int tk = __builtin_amdgcn_readfirstlane(task);
        const int which = tk >> 12, g = (tk >> 10) & 3, n = tk & 1023;
        bf16_t* dst = (which ? W.VC : W.KC) + ((size_t)g * 1024 + n) * HD;
        if (n == 1023) { ((unsigned*)dst)[lane] = 0u; continue; }
        const float* h = W.H1 + (size_t)tk * 256; const float* w2 = which ? P.cmp_v_w2 : P.cmp_k_w2;
        float a0 = 0.f, a1 = 0.f;
        for (int j = 0; j < 256; ++j) { const float hj = h[j]; const f32x2 wv = *(const f32x2*)(w2 + j * HD + 2 * lane); a0 += hj * wv[0]; a1 += hj * wv[1]; }
        if (which == 0) {
            const float ss = wave_sum(a0 * a0 + a1 * a1); const float rstd = rsqrtf(ss * (1.0f / HD) + EPS);
            a0 = a0 * rstd * wk[0]; a1 = a1 * rstd * wk[1];
            const int tp = 16 * n + 31; const float p0 = __shfl_xor(a0, 8), p1 = __shfl_xor(a1, 8);
            if (lane < 16) { const int i0 = (2 * lane) & 15; const float cs0 = W.COS[tp * 16 + i0], cs1 = W.COS[tp * 16 + i0 + 1], sn0 = W.SIN[tp * 16 + i0], sn1 = W.SIN[tp * 16 + i0 + 1];
                if (lane < 8) { a0 = a0 * cs0 - p0 * sn0; a1 = a1 * cs1 - p1 * sn1; } else { a0 = a0 * cs0 + p0 * sn0; a1 = a1 * cs1 + p1 * sn1; } }
        }
        ((unsigned*)dst)[lane] = cvt_pk_bf16(a0, a1);
    }
}

__device__ __forceinline__ void phase_erstd(const Ptrs& W) {
    const int tid = threadIdx.x, lane = tid & 63, gw = blockIdx.x * NWAVES + (tid >> 6), nw = gridDim.x * NWAVES;
    u32x4 a[8], an[8];
    if (gw < S_) { const u32x4* sp = (const u32x4*)(W.ERAW + (size_t)gw * DM);
#pragma unroll
        for (int i = 0; i < 8; ++i) a[i] = sp[lane + 64 * i]; }
    for (int row = gw; row < S_; row += nw) {
        const int nr = row + nw < S_ ? row + nw : row;
        { const u32x4* sp = (const u32x4*)(W.ERAW + (size_t)nr * DM);
#pragma unroll
          for (int i = 0; i < 8; ++i) an[i] = sp[lane + 64 * i]; }
        float ss = 0.f;
#pragma unroll
        for (int i = 0; i < 8; ++i) {
            const float e0 = bf_lo(a[i].x), e1 = bf_hi(a[i].x), e2 = bf_lo(a[i].y), e3 = bf_hi(a[i].y), e4 = bf_lo(a[i].z), e5 = bf_hi(a[i].z), e6 = bf_lo(a[i].w), e7 = bf_hi(a[i].w);
            ss += e0 * e0 + e1 * e1 + e2 * e2 + e3 * e3 + e4 * e4 + e5 * e5 + e6 * e6 + e7 * e7; }
        ss = wave_sum(ss);
        if (lane == 0) W.ERSTD[row] = rsqrtf(ss * (1.0f / DM) + EPS);
#pragma unroll
        for (int i = 0; i < 8; ++i) a[i] = an[i];
    }
}

constexpr int N_PHASES = 11;
__device__ __forceinline__ Params kargs() {
#if defined(__HIP_DEVICE_COMPILE__)
    unsigned long long p = (unsigned long long)__builtin_amdgcn_kernarg_segment_ptr();
    asm volatile("" : "+s"(p));
    return *(const __attribute__((address_space(4))) Params*)p;
#else
    return Params{};
#endif
}
__device__ __forceinline__ Ptrs mkptrs(unsigned char* ws) {
    Ptrs W;
    W.Win = (bf16_t*)(ws + WS_WIN); W.Wo = (bf16_t*)(ws + WS_WO); W.Wfi = (bf16_t*)(ws + WS_WFI); W.Wfo = (bf16_t*)(ws + WS_WFO); W.Wg = (bf16_t*)(ws + WS_WG);
    W.Wple = (bf16_t*)(ws + WS_WPLE); W.Wpool = (bf16_t*)(ws + WS_WPOOL); W.Wc1k = (bf16_t*)(ws + WS_WC1K); W.Wc1v = (bf16_t*)(ws + WS_WC1V);
    W.XN = (bf16_t*)(ws + WS_XN); W.PB = (bf16_t*)(ws + WS_PB); W.Z = (bf16_t*)(ws + WS_Z); W.M = (bf16_t*)(ws + WS_M); W.KC = (bf16_t*)(ws + WS_KC); W.VC = (bf16_t*)(ws + WS_VC);
    W.MIX = (bf16_t*)(ws + WS_MIX); W.ACT = (bf16_t*)(ws + WS_ACT); W.ERAW = (bf16_t*)(ws + WS_ERAW);
    W.COS = (float*)(ws + WS_COS); W.SIN = (float*)(ws + WS_SIN); W.TAB = (float*)(ws + WS_TAB); W.G = (float*)(ws + WS_G); W.H1 = (float*)(ws + WS_H1); W.L = (float*)(ws + WS_L);
    W.OACC = (float*)(ws + WS_OACC); W.IMPP = (float*)(ws + WS_IMPP); W.IMPF = (float*)(ws + WS_IMPF); W.ERSTD = (float*)(ws + WS_ERSTD); W.BM = (unsigned*)(ws + WS_BM);
    return W;
}
__global__ void __launch_bounds__(NTHREADS, 2) fwd(Params Punused) {
    extern __shared__ __attribute__((aligned(16))) unsigned char lds_raw[];
    LAS unsigned char* lds = (LAS unsigned char*)lds_raw;
    const int tid = threadIdx.x;
    const int G = gridDim.x, bid = blockIdx.x;
    const int gw = bid * NWAVES + (tid >> 6), nw = G * NWAVES;

    if (tid < 16) ((LAS unsigned*)(lds + LDS_MISC))[tid] = 0u;
    __syncthreads();
    int lo, hi; XcdBarrier bar;
    { const Params P = kargs(); lo = P.ph_lo; hi = P.ph_hi;
      bar.bar = (unsigned*)(P.ws + WS_CTL); bar.x = 0; bar.st = (volatile LAS unsigned*)(lds + LDS_MISC);
      if (hi - lo > 1) bar = xcd_barrier_post((unsigned*)(P.ws + WS_CTL), (volatile LAS unsigned*)(lds + LDS_MISC)); }
#ifdef PH_MASK
#define IN(k) (((PH_MASK >> (k)) & 1) && lo <= (k) && (k) < hi)
#else
#define IN(k) (lo <= (k) && (k) < hi)
#endif
#define SEAM(k) do { if (IN(k) && IN((k) + 1)) xcd_barrier(bar); } while (0)
#define PHASE_VARS const Params P = kargs(); const Ptrs W = mkptrs(P.ws); (void)W;
#define ATT_ARGS att::AttnArgs AA{W.Z, W.KC, W.VC, W.G, W.L, W.OACC, W.MIX, W.BM, W.TAB};

    if (IN(0)) { PHASE_VARS REP(0) { phase_prologue(P, W, lds); } SEAM(0); }
    if (IN(1)) {
        PHASE_VARS
        { pg8::GStd g{(const char*)W.XN, (const char*)W.Win, DM, DM, DM / 64}; pg8::StaticOrder S; S.init(S_ / 256, POOLW / 256, G, bid);
          pg8::EpiBf16 E{W.Z, LDZ}; pg8::gemm_phase(lds, g, S, E); }
        { pg8::GStd g{(const char*)(P.ws + WS_XN8), (const char*)(P.ws + WS_WIN8), DM / 2, DM / 2, DM / 128}; pg8::StaticOrder S; S.init(S_ / 256, (OFF_G - POOLW) / 256, G, bid);
          pg8::EpiBf16S E{W.Z + POOLW, LDZ, 1.0f / WG8_SCALE}; pg8::gemm_phase<pg8::GStd, pg8::EpiBf16S, true>(lds, g, S, E); }
        SEAM(1);
    }
    if (IN(2)) {
        PHASE_VARS
        if (G > 64) {
            if (bid < 32) { pg8::GCmp g{(const char*)W.Z, (const char*)W.Wc1k, (const char*)W.Wc1v, 16 * LDZ, 4096, 64}; pg8::StaticOrder S; S.init(32, 1, 32, bid);
                pg8::EpiCmpGelu E{W.H1, (const float*)(P.ws + WS_CBIAS)}; pg8::gemm_phase(lds, g, S, E); }
            else if (bid < 96) {
                pg8::GStd g{(const char*)W.XN, (const char*)(W.Win + (size_t)OFF_G * DM), DM, DM, DM / 64}; pg8::StaticOrder S; S.init(S_ / 256, 1, 64, bid - 32);
                pg8::EpiBf16 E{W.Z + OFF_G, LDZ}; pg8::gemm_phase(lds, g, S, E); }
            else phase_postz(P, W, (bid - 96) * NWAVES + (tid >> 6), (G - 96) * NWAVES);
        } else {
            { pg8::GStd g{(const char*)W.XN, (const char*)(W.Win + (size_t)OFF_G * DM), DM, DM, DM / 64}; pg8::StaticOrder S; S.init(S_ / 256, 1, G, bid);
              pg8::EpiBf16 E{W.Z + OFF_G, LDZ}; pg8::gemm_phase(lds, g, S, E); }
            { pg8::GCmp g{(const char*)W.Z, (const char*)W.Wc1k, (const char*)W.Wc1v, 16 * LDZ, 4096, 64}; pg8::StaticOrder S; S.init(32, 1, G, bid);
              pg8::EpiCmpGelu E{W.H1, (const float*)(P.ws + WS_CBIAS)}; pg8::gemm_phase(lds, g, S, E); }
            phase_postz(P, W, gw, nw);
        }
        SEAM(2);
    }
    if (IN(3)) {
        PHASE_VARS
        {
            const size_t i0 = (size_t)bid * NTHREADS + tid, st = (size_t)G * NTHREADS, NG = (size_t)S_ * NGATE;
            for (size_t ib = i0; ib < NG; ib += 9 * st) { float zv[9];
#pragma unroll
                for (int k = 0; k < 9; ++k) { size_t i = ib + k * st; if (i >= NG) i = NG - 1; const int t = (int)(i / NGATE), c = (int)(i % NGATE); zv[k] = bf2f(W.Z[(size_t)t * LDZ + OFF_G + c]); }
#pragma unroll
                for (int k = 0; k < 9; ++k) { const size_t i = ib + k * st; if (i < NG) W.G[i] = sigmoidf_(zv[k]); } } }
        phase_cmpfin(P, W);
        { pg8::GPool g{(const char*)W.M, (const char*)W.Wpool, POOLW, 256, 4}; pg8::StaticOrder S; S.init(S_ / 256, 4, G, bid);
          pg8::EpiBf16Scale E{W.MIX, DM, P.pool_scale}; pg8::gemm_phase(lds, g, S, E); }
        SEAM(3);
    }
    if (IN(4)) {
        PHASE_VARS ATT_ARGS
        if ((tid >> 6) < 4) __builtin_amdgcn_s_setprio(2);
        REP(4)
        for (int base = 0, rnd = 0; base < 1536; base += G, ++rnd) {
            int qt, g, hp;
            if (G == 256) { const int x = bid & 7, r = bid >> 3, qp = (rnd / 3) ? 63 - r : r; if (rnd >= 6) break; g = x & 3; qt = 2 * qp + (x >> 2); hp = rnd % 3; }
            else { const int Lu = base + ((rnd & 1) ? G - 1 - bid : bid); if (Lu >= 1536) continue; qt = Lu / 12; const int rem = Lu % 12; g = rem / 3; hp = rem % 3; }
            att::attn_unit<att::MODE_CMP>(AA, (LAS char*)lds, qt, g, hp);
            asm volatile("s_waitcnt vmcnt(0)" ::: "memory");
            att::attn_unit<att::MODE_WIN>(AA, (LAS char*)lds, qt, g, hp);
            if (G == 256 && hp == 2) {
                asm volatile("s_waitcnt vmcnt(0)" ::: "memory");
                const int tqi = qt * 8 + (tid >> 6);
                att::imp_task(AA, W.IMPP, W.IMPF, tqi, g);
                asm volatile("s_waitcnt vmcnt(0)" ::: "memory");
                f32x4 pp, ff, pn, fn; att::topk_load(W.IMPP, W.IMPF, tqi * 16, g, pp, ff);
                for (int q = 0; q < 16; ++q) { att::topk_load(W.IMPP, W.IMPF, tqi * 16 + (q < 15 ? q + 1 : q), g, pn, fn); att::topk_task(pp, ff, W.BM, tqi * 16 + q, g); pp = pn; ff = fn; } } }
        __builtin_amdgcn_s_setprio(0);
        if (G != 256) SEAM(4);
    }
    if (IN(5)) {
        PHASE_VARS ATT_ARGS
        if (G != 256)
        for (int k = gw, r = 0; k < 4096; k += nw, ++r) { const int hiT = (r + 1) * nw < 4096 ? (r + 1) * nw : 4096;
            const int task = (r & 1) ? hiT - 1 - (k - r * nw) : k;
            att::imp_task(AA, W.IMPP, W.IMPF, task >> 2, task & 3);
            asm volatile("s_waitcnt vmcnt(0)" ::: "memory");
            { const int tb = (task >> 2) * 16, gg = task & 3; f32x4 pp, ff, pn, fn;
              att::topk_load(W.IMPP, W.IMPF, tb, gg, pp, ff);
              for (int q = 0; q < 16; ++q) { att::topk_load(W.IMPP, W.IMPF, tb + (q < 15 ? q + 1 : q), gg, pn, fn); att::topk_task(pp, ff, W.BM, tb + q, gg); pp = pn; ff = fn; } } }
        SEAM(5);
    }
    if (IN(6)) {
        PHASE_VARS ATT_ARGS
#if SLC16
        for (int base = 0, rnd = 0; base < 1024 + G; base += G, ++rnd) {
            int ut, g;
            if (G == 256) { const int x = bid & 7, r = bid >> 3, k = rnd * 32 + ((rnd & 1) ? 31 - r : r); if (k >= 128) break; g = x & 3; ut = 255 - (2 * k + (x >> 2)); }
            else { const int Lu = base + ((rnd & 1) ? G - 1 - bid : bid); if (Lu >= 1024) continue; ut = 255 - Lu / 4; g = Lu % 4; }
            att::slc16_unit(AA, (LAS char*)lds, ut, g); }
#else
        REP(6)
        for (int base = 0, rnd = 0; base < 1640 + G; base += G, ++rnd) {
            int ut, g;
            if (G == 256) { const int x = bid & 7, r = bid >> 3, k = rnd * 32 + ((rnd & 1) ? 31 - r : r); if (k >= 205) break; g = x & 3; ut = 409 - (2 * k + (x >> 2)); }
            else { const int Lu = base + ((rnd & 1) ? G - 1 - bid : bid); if (Lu >= 1640) continue; ut = 409 - Lu / 4; g = Lu % 4; }
            att::attn_unit<att::MODE_SLC>(AA, (LAS char*)lds, ut, g, 0); }
#endif
        SEAM(6);
    }
    if (IN(7)) {
        PHASE_VARS
        { pg8::GStd g{(const char*)W.MIX, (const char*)W.Wo, DM, DM, DM / 64}; pg8::StaticOrder S; S.init(S_ / 256, DM / 256, G, bid);
          pg8::EpiResNorm E{P.x, P.out, W.XN, P.norm2_w, (float*)(P.ws + WS_SSQ1), DM}; pg8::gemm_phase(lds, g, S, E); }
        { pg8::GStd g{(const char*)W.PB, (const char*)W.Wple, PLE, PLE, PLE / 64}; pg8::StaticOrder S; S.init(S_ / 256, DM / 256, G, bid);
          pg8::EpiBf16Ssq E{W.ERAW, DM, (float*)(P.ws + WS_SSQ3)}; pg8::gemm_phase(lds, g, S, E); }
        SEAM(7);
    }
    if (IN(8)) {
        PHASE_VARS
        pg8::GFfn g{(const char*)W.XN, (const char*)W.Wfi, DM, DM, DM / 64}; pg8::StaticOrder S; S.init(65, DFF / 128, G, bid);
        pg8::EpiFfn E{W.ACT, P.conv_w, P.conv_b, (LAS float*)(lds + LDS_XCH), (const float*)(P.ws + WS_SSQ1)}; REP(8) { pg8::gemm_phase(lds, g, S, E); } SEAM(8);
    }
    if (IN(9)) {
        PHASE_VARS
        pg8::GStd g{(const char*)W.ACT, (const char*)W.Wfo, DFF, DFF, DFF / 64}; pg8::StaticOrder S; S.init(S_ / 256, DM / 256, G, bid);
        pg8::EpiResNormF8 E{P.out, P.out, W.XN, P.ple_gate_norm_w, (float*)(P.ws + WS_SSQ2), DM}; pg8::gemm_phase(lds, g, S, E); SEAM(9);
    }
    if (IN(10)) {
        PHASE_VARS
        pg8::GStd g{(const char*)W.XN, (const char*)W.Wg, DM / 2, DM / 2, DM / 128}; pg8::StaticOrder S; S.init(S_ / 256, DM / 256, G, bid);
        pg8::EpiGate E{P.out, W.ERAW, (const float*)(P.ws + WS_SSQ3), P.ple_norm_w, (const float*)(P.ws + WS_SSQ2), DM, 1.0f / WG8_SCALE};
        pg8::gemm_phase<pg8::GStd, pg8::EpiGate, true>(lds, g, S, E);
    }
#undef IN
#undef SEAM
}

extern "C" void kernel_launch(void* const* d_in, const int* in_sizes, int n_in, void* d_out, int out_size, void* d_ws, size_t ws_size, hipStream_t stream) {
    static int grid = 0;
    if (grid == 0) {
        if (n_in != 27 || in_sizes[0] != S_ * DM || out_size != S_ * DM || ws_size < WS_NEED) {
            fprintf(stderr, "kernel_launch: unexpected shapes (n_in %d, in0 %d, out %d, ws %zu < %zu); nothing launched\n", n_in, n_in > 0 ? in_sizes[0] : -1, out_size, ws_size, (size_t)WS_NEED); grid = -1; return; }
        int dev = 0, cus = 0, per_cu = 0;
        if (hipGetDevice(&dev) != hipSuccess || hipDeviceGetAttribute(&cus, hipDeviceAttributeMultiprocessorCount, dev) != hipSuccess) { grid = -1; return; }
        if (hipFuncSetAttribute((const void*)fwd, hipFuncAttributeMaxDynamicSharedMemorySize, LDS_BYTES) != hipSuccess) { fprintf(stderr, "kernel_launch: hipFuncSetAttribute failed\n"); grid = -1; return; }
        if (hipOccupancyMaxActiveBlocksPerMultiprocessor(&per_cu, (const void*)fwd, NTHREADS, LDS_BYTES) != hipSuccess || per_cu < 1) { fprintf(stderr, "kernel_launch: occupancy query says %d\n", per_cu); (void)hipGetLastError(); }
        grid = cus > 256 ? 256 : cus;
    }
    if (grid < 0) return;
    (void)hipMemsetAsync((char*)d_ws + WS_CTL, 0, CTL_BYTES, stream);
    Params P{};
    const float** fp = (const float**)&P;
    P.x = (const float*)d_in[0]; P.p = (const float*)d_in[1]; P.positions = (const int*)d_in[2]; P.norm1_w = (const float*)d_in[3]; P.w_in = (const float*)d_in[4];
    P.w_pool = (const float*)d_in[5]; P.pool_scale = (const float*)d_in[6]; P.q_norm_w = (const float*)d_in[7]; P.k_norm_cmp_w = (const float*)d_in[8];
    P.k_norm_slc_w = (const float*)d_in[9]; P.k_norm_win_w = (const float*)d_in[10]; P.cmp_pos_k = (const float*)d_in[11]; P.cmp_pos_v = (const float*)d_in[12];
    P.cmp_k_w1 = (const float*)d_in[13]; P.cmp_k_w2 = (const float*)d_in[14]; P.cmp_v_w1 = (const float*)d_in[15]; P.cmp_v_w2 = (const float*)d_in[16];
    P.w_o = (const float*)d_in[17]; P.norm2_w = (const float*)d_in[18]; P.w_ffn_in = (const float*)d_in[19]; P.conv_w = (const float*)d_in[20]; P.conv_b = (const float*)d_in[21];
    P.w_ffn_out = (const float*)d_in[22]; P.w_ple_proj = (const float*)d_in[23]; P.ple_norm_w = (const float*)d_in[24]; P.ple_gate_norm_w = (const float*)d_in[25]; P.w_ple_gate = (const float*)d_in[26];
    (void)fp;
    P.out = (float*)d_out; P.ws = (unsigned char*)d_ws;
#if MK_ONE_LAUNCH
    P.ph_lo = 0; P.ph_hi = N_PHASES;
    hipLaunchKernelGGL(fwd, dim3(grid), dim3(NTHREADS), LDS_BYTES, stream, P);
#else
    for (int ph = 0; ph < N_PHASES; ++ph) { P.ph_lo = ph; P.ph_hi = ph + 1; hipLaunchKernelGGL(fwd, dim3(grid), dim3(NTHREADS), LDS_BYTES, stream, P); }
#endif
    const hipError_t le = hipPeekAtLastError();
    if (le != hipSuccess) fprintf(stderr, "kernel_launch: launch failed: %s\n", hipGetErrorName(le));
}
```

```cpp
#include <hip/hip_runtime.h>
#include <cstdio>
#include <cstdint>

#ifndef PROBE_DBL
#define PROBE_DBL 0
#endif
#define REP(k) _Pragma("unroll") for (int rep_ = 0; rep_ < 1 + ((PROBE_DBL >> (k)) & 1); ++rep_)
#ifndef SLC16
#define SLC16 1
#endif
#ifndef MK_ONE_LAUNCH
#define MK_ONE_LAUNCH 1
#endif

#define LAS __attribute__((address_space(3)))
typedef unsigned short bf16_t;
typedef short bf16x8 __attribute__((ext_vector_type(8)));
typedef short s16x4 __attribute__((ext_vector_type(4)));
typedef float f32x2 __attribute__((ext_vector_type(2)));
typedef float f32x4 __attribute__((ext_vector_type(4)));
typedef float f32x16 __attribute__((ext_vector_type(16)));
typedef unsigned u32x2 __attribute__((ext_vector_type(2)));
typedef unsigned u32x4 __attribute__((ext_vector_type(4)));
typedef int i32x4 __attribute__((ext_vector_type(4)));
typedef int i32x8 __attribute__((ext_vector_type(8)));

constexpr int S_ = 16384, DM = 4096, INW = 7240, LDZ = 7424, POOLW = 1024, NH = 24, NKV = 4, HPG = 6, HD = 128;
constexpr int OFF_Q = 1024, OFF_KV = 4096, OFF_G = 7168, DFF = 11008, NFI = 22016, PLE = 256, NGATE = 72;
constexpr int ZROWS = S_ + 64, XNROWS = S_ + 256, CHUNK = 8192;
constexpr float EPS = 1e-6f;
constexpr float SM_C = 0.08838834764831845f * 1.4426950408889634f;
constexpr int NWAVES = 8, NTHREADS = 512;
constexpr float WG8_SCALE = 128.0f;

constexpr size_t al256(size_t x) { return (x + 255) / 256 * 256; }
constexpr size_t WS_CTL   = 0;
constexpr size_t CTL_BYTES = 262144;
constexpr size_t WS_CBIAS = WS_CTL + 32768;
constexpr size_t WS_SSQ1 = WS_CTL + 65536, WS_SSQ2 = WS_CTL + 131072, WS_SSQ3 = WS_CTL + 196608;
constexpr size_t WS_WIN   = WS_CTL + CTL_BYTES;
constexpr size_t WS_WO    = WS_WIN + al256((size_t)LDZ * DM * 2);
constexpr size_t WS_WFI   = WS_WO + al256((size_t)DM * DM * 2);
constexpr size_t WS_WFO   = WS_WFI + al256((size_t)NFI * DM * 2);
constexpr size_t WS_WG    = WS_WFO + al256((size_t)DM * DFF * 2);
constexpr size_t WS_WPLE  = WS_WG + al256((size_t)DM * DM * 2);
constexpr size_t WS_WPOOL = WS_WPLE + al256((size_t)DM * PLE * 2);
constexpr size_t WS_WC1K  = WS_WPOOL + al256((size_t)1024 * 256 * 2);
constexpr size_t WS_WC1V  = WS_WC1K + al256((size_t)256 * 4096 * 2);
constexpr size_t WS_COS   = WS_WC1V + al256((size_t)256 * 4096 * 2);
constexpr size_t WS_SIN   = WS_COS + al256((size_t)S_ * 16 * 4);
constexpr size_t WS_TAB   = WS_SIN + al256((size_t)S_ * 16 * 4);
constexpr size_t WS_XNP   = WS_TAB + 4096;
constexpr size_t WS_XN    = WS_XNP + (size_t)2 * DM * 2;
constexpr size_t WS_PB    = WS_XN + al256((size_t)XNROWS * DM * 2);
constexpr size_t WS_XN8   = WS_PB + al256((size_t)S_ * PLE * 2);
constexpr size_t WS_WIN8  = WS_XN8 + al256((size_t)S_ * DM);
constexpr size_t WS_R     = WS_WIN8 + al256((size_t)(OFF_G - POOLW) * DM);
constexpr size_t WS_Z     = WS_R;
constexpr size_t WS_M     = WS_Z + al256((size_t)ZROWS * LDZ * 2);
constexpr size_t WS_G     = WS_M + al256((size_t)S_ * POOLW * 2);
constexpr size_t WS_H1    = WS_G + al256((size_t)S_ * NGATE * 4);
constexpr size_t WS_KC    = WS_H1 + al256((size_t)8192 * 256 * 4);
constexpr size_t WS_VC    = WS_KC + al256((size_t)4 * 1024 * 128 * 2);
constexpr size_t WS_L     = WS_VC + al256((size_t)4 * 1024 * 128 * 2);
constexpr size_t WS_OACC  = WS_L + al256((size_t)S_ * NH * 4);
constexpr size_t WS_IMPP  = WS_OACC + al256((size_t)S_ * 3072 * 4);
constexpr size_t WS_IMPF  = WS_IMPP + al256((size_t)S_ * 4 * 256 * 4);
constexpr size_t WS_BM    = WS_IMPF + al256((size_t)S_ * 4 * 256 * 4);
constexpr size_t WS_MIX   = WS_BM + al256((size_t)S_ * 4 * 8 * 4);
constexpr size_t WS_END_A = WS_MIX + al256((size_t)S_ * DM * 2);
constexpr size_t WS_ERAW  = WS_R;
constexpr size_t WS_ACT   = WS_ERAW + al256((size_t)S_ * DM * 2);
constexpr size_t WS_ERSTD = WS_ACT + al256((size_t)S_ * DFF * 2);
constexpr size_t WS_END_B = WS_ERSTD + al256((size_t)S_ * 4);
constexpr size_t WS_HRES  = WS_IMPP;
static_assert(WS_HRES >= WS_END_B && WS_HRES + (size_t)S_ * DM * 2 <= WS_BM, "residual stream must sit in the dead importance buffers, clear of act / mix");
static_assert(WS_ERAW + (size_t)S_ * DM * 2 <= WS_Z + (size_t)ZROWS * LDZ * 2, "eraw must fit inside the dead z region while mix is still being read");
constexpr size_t WS_NEED  = WS_END_A > WS_END_B ? WS_END_A : WS_END_B;
static_assert(WS_NEED <= (size_t)1440000000, "workspace map exceeds the guaranteed 4 x largest-tensor bytes");

constexpr int LDS_STAGE = 131072;
constexpr int LDS_XCH   = LDS_STAGE + 64;
constexpr int LDS_MISC  = 147456;
constexpr int LDS_BYTES = LDS_MISC + 64;

__device__ __forceinline__ unsigned cvt_pk_bf16(float lo, float hi) { unsigned r; asm volatile("v_cvt_pk_bf16_f32 %0, %1, %2" : "=v"(r) : "v"(lo), "v"(hi)); return r; }
__device__ __forceinline__ float bf_lo(unsigned u) { return __uint_as_float(u << 16); }
__device__ __forceinline__ float bf_hi(unsigned u) { return __uint_as_float(u & 0xffff0000u); }
__device__ __forceinline__ float bf2f(bf16_t b) { return __uint_as_float(((unsigned)b) << 16); }
__device__ __forceinline__ float wave_sum(float v) {
#pragma unroll
    for (int o = 32; o >= 1; o >>= 1) v += __shfl_xor(v, o);
    return v;
}
__device__ __forceinline__ float wave_max(float v) {
#pragma unroll
    for (int o = 32; o >= 1; o >>= 1) v = fmaxf(v, __shfl_xor(v, o));
    return v;
}
__device__ __forceinline__ float sigmoidf_(float x) { return __builtin_amdgcn_rcpf(1.0f + __expf(-x)); }

#define XB_TMO      128
#define XB_XCNT(j)  (256  + 64 * (j))
#define XB_XSUB(j)  (1280 + 64 * (j))
#define XB_XGEN(j)  (2304 + 64 * (j))
#define XB_TOP      3328
#define XB_TOPGEN   3392
#define XCD_BAR_WORDS 3456
#define XB_SPIN_CAP (1u << 18)
__device__ __forceinline__ unsigned xb_ld(unsigned* p)              { return __hip_atomic_load(p, __ATOMIC_RELAXED, __HIP_MEMORY_SCOPE_AGENT); }
__device__ __forceinline__ unsigned xb_add(unsigned* p, unsigned v) { return __hip_atomic_fetch_add(p, v, __ATOMIC_RELAXED, __HIP_MEMORY_SCOPE_AGENT); }
__device__ __forceinline__ unsigned xb_xcc_id() { return (unsigned)__builtin_amdgcn_s_getreg((3 << 11) | 20) & 0xFu; }
#define XB_SPIN(cond, bar) do { unsigned _sp = 0; while (cond) { __builtin_amdgcn_s_sleep(1); \
    if ((++_sp & 255u) == 0u) { if (xb_ld(&(bar)[XB_TMO])) break; if (_sp > XB_SPIN_CAP) { atomicAdd(&(bar)[XB_TMO], 1u); break; } } } } while (0)
struct XcdBarrier { unsigned* bar; unsigned x; volatile LAS unsigned* st; };
__device__ __forceinline__ XcdBarrier xcd_barrier_post(unsigned* bar, volatile LAS unsigned* st) {
    XcdBarrier b; b.bar = bar; b.x = xb_xcc_id(); b.st = st;
    if (threadIdx.x == 0) (void)xb_add(&bar[XB_XCNT(b.x)], 1u);
    return b;
}
__device__ __forceinline__ void xcd_barrier_complete(unsigned* bar, unsigned x, unsigned& nloc, unsigned& nx) {
    const unsigned G = gridDim.x * gridDim.y * gridDim.z;
    unsigned sum, cnt, mine, sp = 0u;
    for (;;) {
        sum = 0u; cnt = 0u; mine = 0u;
#pragma unroll
        for (unsigned j = 0; j < 16; ++j) { const unsigned c = xb_ld(&bar[XB_XCNT(j)]); sum += c; cnt += (c > 0u) ? 1u : 0u; mine = (j == x) ? c : mine; }
        if (sum == G) break;
        __builtin_amdgcn_s_sleep(1);
        if ((++sp & 255u) == 0u) { if (xb_ld(&bar[XB_TMO])) break; if (sp > XB_SPIN_CAP) { atomicAdd(&bar[XB_TMO], 1u); break; } }
    }
    nloc = mine > 0u ? mine : 1u; nx = cnt > 0u ? cnt : 1u;
}
__device__ __forceinline__ void xcd_barrier(const XcdBarrier& b) {
    asm volatile("s_waitcnt vmcnt(0)" ::: "memory");
    __syncthreads();
    if (threadIdx.x == 0) {
        unsigned* bar = b.bar;
        __builtin_amdgcn_s_waitcnt(0);
        unsigned nloc = b.st[0], nx = b.st[1];
        if (nloc == 0u) { xcd_barrier_complete(bar, b.x, nloc, nx); b.st[0] = nloc; b.st[1] = nx; }
        const unsigned old = xb_add(&bar[XB_XSUB(b.x)], 1u);
        const unsigned gen = old / nloc;
        if (old + 1u == (gen + 1u) * nloc) {
            __builtin_amdgcn_fence(__ATOMIC_RELEASE, "agent");
            asm volatile("s_waitcnt vmcnt(0)" ::: "memory");
            const unsigned og = xb_add(&bar[XB_TOP], 1u);
            const unsigned tg = og / nx;
            if (og + 1u == (tg + 1u) * nx) xb_add(&bar[XB_TOPGEN], 1u);
            else XB_SPIN(xb_ld(&bar[XB_TOPGEN]) == tg, bar);
            __builtin_amdgcn_fence(__ATOMIC_ACQUIRE, "agent");
            xb_add(&bar[XB_XGEN(b.x)], 1u);
            asm volatile("s_waitcnt vmcnt(0)" ::: "memory");
        } else {
            XB_SPIN(xb_ld(&bar[XB_XGEN(b.x)]) == gen, bar);
            __builtin_amdgcn_fence(__ATOMIC_ACQUIRE, "agent");
            asm volatile("s_waitcnt vmcnt(0)" ::: "memory");
        }
    }
    __syncthreads();
}

struct Params {
    const float* x; const float* p; const int* positions; const float* norm1_w; const float* w_in; const float* w_pool; const float* pool_scale;
    const float* q_norm_w; const float* k_norm_cmp_w; const float* k_norm_slc_w; const float* k_norm_win_w; const float* cmp_pos_k; const float* cmp_pos_v;
    const float* cmp_k_w1; const float* cmp_k_w2; const float* cmp_v_w1; const float* cmp_v_w2; const float* w_o; const float* norm2_w; const float* w_ffn_in;
    const float* conv_w; const float* conv_b; const float* w_ffn_out; const float* w_ple_proj; const float* ple_norm_w; const float* ple_gate_norm_w; const float* w_ple_gate;
    float* out; unsigned char* ws; int ph_lo, ph_hi;
};

namespace pg8 {
constexpr int BM = 256, BK = 64, HALF = 128, HTB = HALF * BK * 2, STAGE_BYTES = 8 * HTB, NXCD = 8, WGM = 8;
__host__ __device__ __forceinline__ int lds_byte(int r, int c) { const int st = (r >> 4) * 2 + (c >> 5), rr = r & 15, cc = c & 31, ob = rr * 64 + cc * 2; return st * 1024 + (ob ^ (((ob >> 9) & 1) << 5)); }
__host__ __device__ __forceinline__ void stage_rc(int b, int& R, int& C) { const int st = b / 1024, sb = b % 1024, swz = sb ^ (((sb >> 9) & 1) << 5); R = (st >> 1) * 16 + swz / 64; C = (st & 1) * 32 + (swz % 64) / 2; }
__host__ __device__ __forceinline__ int perm32(int rho) { const int n = rho >> 4, i = rho & 15; return 8 * (i >> 2) + 4 * n + (i & 3); }
struct Unit { int pm, pn; };

struct StaticOrder {
    int nM, nN, nwg, G, c;
    __device__ void init(int nM_, int nN_, int G_, int c_) { nM = nM_; nN = nN_; nwg = nM * nN; G = G_; c = c_; }
    __device__ bool next(int i, Unit& u) const {
        const long L = (long)i * G + c; if (L >= nwg) return false;
        int wgid = (int)L; { const int q = nwg / NXCD, r = nwg % NXCD, xcd = wgid % NXCD, off = wgid / NXCD; wgid = (xcd < r ? xcd * (q + 1) : r * (q + 1) + (xcd - r) * q) + off; }
        const int nig = WGM * nN, gid = wgid / nig, fm = gid * WGM, gsz = (nM - fm) < WGM ? (nM - fm) : WGM;
        u.pm = fm + ((wgid % nig) % gsz); u.pn = (wgid % nig) / gsz; return true;
    }
};

struct GStd {
    const char* A; const char* B; unsigned lda, ldb; int nt;
    __device__ __forceinline__ const char* a_base(const Unit& u) const { return A + (size_t)u.pm * 256 * lda * 2; }
    __device__ __forceinline__ const char* b_base(const Unit& u) const { return B + (size_t)u.pn * 256 * ldb * 2; }
    __device__ __forceinline__ size_t kpairA() const { return 256; }
};
struct GPool {
    const char* A; const char* B; unsigned lda, ldb; int nt;
    __device__ __forceinline__ const char* a_base(const Unit& u) const { return A + (size_t)u.pm * 256 * lda * 2 + (size_t)u.pn * 512; }
    __device__ __forceinline__ const char* b_base(const Unit& u) const { return B + (size_t)u.pn * 256 * ldb * 2; }
    __device__ __forceinline__ size_t kpairA() const { return 256; }
};
struct GCmp {
    const char* Z; const char* Bk; const char* Bv; unsigned lda, ldb; int nt;
    __device__ __forceinline__ const char* a_base(const Unit& u) const { const int which = u.pm >> 4, g = (u.pm >> 2) & 3, rt = u.pm & 3;
        return Z + (size_t)(OFF_KV + which * 512 + g * 128) * 2 + (size_t)rt * 256 * lda * 2; }
    __device__ __forceinline__ const char* b_base(const Unit& u) const { return (u.pm >> 4) ? Bv : Bk; }
    __device__ __forceinline__ size_t kpairA() const { return (size_t)LDZ * 2; }
};

struct EpiBf16 {
    static constexpr bool PERM = true;
    bf16_t* O; int ldc;
    __device__ __forceinline__ void operator()(const f32x4 (&acc)[2][2][4][2], const Unit& u, int wr, int wc, int fr, int fq) const {
        const int row0 = u.pm * BM + wr * 64 + fr, col0 = u.pn * BM + wc * 32 + 8 * fq;
#pragma unroll
        for (int ai = 0; ai < 2; ++ai)
#pragma unroll
            for (int m = 0; m < 4; ++m) { bf16_t* rowp = O + (size_t)(row0 + ai * HALF + m * 16) * ldc + col0;
#pragma unroll
                for (int bj = 0; bj < 2; ++bj) { const f32x4 v0 = acc[ai][bj][m][0], v1 = acc[ai][bj][m][1];
                    u32x4 w; w.x = cvt_pk_bf16(v0[0], v0[1]); w.y = cvt_pk_bf16(v0[2], v0[3]); w.z = cvt_pk_bf16(v1[0], v1[1]); w.w = cvt_pk_bf16(v1[2], v1[3]);
                    *(u32x4*)(rowp + bj * HALF) = w; } }
    }
};
struct EpiBf16S {
    static constexpr bool PERM = true;
    bf16_t* O; int ldc; float s;
    __device__ __forceinline__ void operator()(const f32x4 (&acc)[2][2][4][2], const Unit& u, int wr, int wc, int fr, int fq) const {
        const int row0 = u.pm * BM + wr * 64 + fr, col0 = u.pn * BM + wc * 32 + 8 * fq;
#pragma unroll
        for (int ai = 0; ai < 2; ++ai)
#pragma unroll
            for (int m = 0; m < 4; ++m) { bf16_t* rowp = O + (size_t)(row0 + ai * HALF + m * 16) * ldc + col0;
#pragma unroll
                for (int bj = 0; bj < 2; ++bj) { const f32x4 v0 = acc[ai][bj][m][0] * s, v1 = acc[ai][bj][m][1] * s;
                    u32x4 w; w.x = cvt_pk_bf16(v0[0], v0[1]); w.y = cvt_pk_bf16(v0[2], v0[3]); w.z = cvt_pk_bf16(v1[0], v1[1]); w.w = cvt_pk_bf16(v1[2], v1[3]);
                    *(u32x4*)(rowp + bj * HALF) = w; } }
    }
};
struct EpiBf16Ssq {
    static constexpr bool PERM = true;
    bf16_t* O; int ldc; float* ssq;
    __device__ __forceinline__ void operator()(const f32x4 (&acc)[2][2][4][2], const Unit& u, int wr, int wc, int fr, int fq) const {
        const int row0 = u.pm * BM + wr * 64 + fr, col0 = u.pn * BM + wc * 32 + 8 * fq;
#pragma unroll
        for (int ai = 0; ai < 2; ++ai)
#pragma unroll
            for (int m = 0; m < 4; ++m) { const int row = row0 + ai * HALF + m * 16; bf16_t* rowp = O + (size_t)row * ldc + col0; float s = 0.f;
#pragma unroll
                for (int bj = 0; bj < 2; ++bj) { const f32x4 v0 = acc[ai][bj][m][0], v1 = acc[ai][bj][m][1];
                    s += v0[0] * v0[0] + v0[1] * v0[1] + v0[2] * v0[2] + v0[3] * v0[3] + v1[0] * v1[0] + v1[1] * v1[1] + v1[2] * v1[2] + v1[3] * v1[3];
                    u32x4 w; w.x = cvt_pk_bf16(v0[0], v0[1]); w.y = cvt_pk_bf16(v0[2], v0[3]); w.z = cvt_pk_bf16(v1[0], v1[1]); w.w = cvt_pk_bf16(v1[2], v1[3]);
                    *(u32x4*)(rowp + bj * HALF) = w; }
                s += __shfl_xor(s, 16); s += __shfl_xor(s, 32);
                if (fq == 0) unsafeAtomicAdd(ssq + row, s); }
    }
};
struct EpiBf16Scale {
    static constexpr bool PERM = true;
    bf16_t* O; int ldc; const float* colscale;
    __device__ __forceinline__ void operator()(const f32x4 (&acc)[2][2][4][2], const Unit& u, int wr, int wc, int fr, int fq) const {
        const int row0 = u.pm * BM + wr * 64 + fr, col0 = u.pn * BM + wc * 32 + 8 * fq;
#pragma unroll
        for (int bj = 0; bj < 2; ++bj) { const f32x4 s0 = *(const f32x4*)(colscale + col0 + bj * HALF), s1 = *(const f32x4*)(colscale + col0 + bj * HALF + 4);
#pragma unroll
            for (int ai = 0; ai < 2; ++ai)
#pragma unroll
                for (int m = 0; m < 4; ++m) { bf16_t* rowp = O + (size_t)(row0 + ai * HALF + m * 16) * ldc + col0;
                    const f32x4 v0 = acc[ai][bj][m][0] * s0, v1 = acc[ai][bj][m][1] * s1;
                    u32x4 w; w.x = cvt_pk_bf16(v0[0], v0[1]); w.y = cvt_pk_bf16(v0[2], v0[3]); w.z = cvt_pk_bf16(v1[0], v1[1]); w.w = cvt_pk_bf16(v1[2], v1[3]);
                    *(u32x4*)(rowp + bj * HALF) = w; } }
    }
};
struct EpiResF32 {
    static constexpr bool PERM = false;
    const float* base; float* C; int ldc; int row_off;
    __device__ __forceinline__ void operator()(const f32x4 (&acc)[2][2][4][2], const Unit& u, int wr, int wc, int fr, int fq) const {
        const int row0 = u.pm * BM + wr * 64 + fr + row_off, col0 = u.pn * BM + wc * 32 + 4 * fq;
#pragma unroll
        for (int ai = 0; ai < 2; ++ai)
#pragma unroll
            for (int m = 0; m < 4; ++m) { const size_t off = (size_t)(row0 + ai * HALF + m * 16) * ldc + col0;
#pragma unroll
                for (int bj = 0; bj < 2; ++bj)
#pragma unroll
                    for (int n = 0; n < 2; ++n) { const f32x4 b = *(const f32x4*)(base + off + bj * HALF + n * 16); *(f32x4*)(C + off + bj * HALF + n * 16) = b + acc[ai][bj][m][n]; }
                asm volatile("" ::: "memory"); }
    }
};
template <bool FP8OUT, bool BASEBF>
struct EpiResNormT {
    static constexpr bool PERM = false;
    const void* base; bf16_t* C; bf16_t* XN; const float* nw; float* ssq; int ldc;
    typedef typename std::conditional<BASEBF, u32x2, f32x4>::type RawT;
    __device__ __forceinline__ RawT ldb(size_t idx) const { if constexpr (BASEBF) return *(const u32x2*)((const bf16_t*)base + idx); else return *(const f32x4*)((const float*)base + idx); }
    static __device__ __forceinline__ f32x4 cv(const RawT& r) { if constexpr (BASEBF) return (f32x4){bf_lo(r.x), bf_hi(r.x), bf_lo(r.y), bf_hi(r.y)}; else return r; }
    __device__ __forceinline__ void operator()(const f32x4 (&acc)[2][2][4][2], const Unit& u, int wr, int wc, int fr, int fq) const {
        const int row0 = u.pm * BM + wr * 64 + fr, col0 = u.pn * BM + wc * 32 + 4 * fq;
        f32x4 wv[2][2];
#pragma unroll
        for (int bj = 0; bj < 2; ++bj)
#pragma unroll
            for (int n = 0; n < 2; ++n) wv[bj][n] = *(const f32x4*)(nw + col0 + bj * HALF + n * 16);
        RawT bv[2][2][2];
#pragma unroll
        for (int bj = 0; bj < 2; ++bj)
#pragma unroll
            for (int n = 0; n < 2; ++n) bv[0][bj][n] = ldb((size_t)row0 * ldc + col0 + bj * HALF + n * 16);
#pragma unroll
        for (int rg = 0; rg < 8; ++rg) { const int ai = rg >> 2, m = rg & 3; const int row = row0 + ai * HALF + m * 16; const size_t off = (size_t)row * ldc + col0;
            if (rg < 7) { const int ai2 = (rg + 1) >> 2, m2 = (rg + 1) & 3; const size_t off2 = (size_t)(row0 + ai2 * HALF + m2 * 16) * ldc + col0;
#pragma unroll
                for (int bj = 0; bj < 2; ++bj)
#pragma unroll
                    for (int n = 0; n < 2; ++n) bv[(rg + 1) & 1][bj][n] = ldb(off2 + bj * HALF + n * 16); }
            float s = 0.f;
#pragma unroll
            for (int bj = 0; bj < 2; ++bj)
#pragma unroll
                for (int n = 0; n < 2; ++n) { const f32x4 v = cv(bv[rg & 1][bj][n]) + acc[ai][bj][m][n];
                    { u32x2 c; c.x = cvt_pk_bf16(v[0], v[1]); c.y = cvt_pk_bf16(v[2], v[3]); *(u32x2*)(C + off + bj * HALF + n * 16) = c; }
                    s += v[0] * v[0] + v[1] * v[1] + v[2] * v[2] + v[3] * v[3];
                    if (FP8OUT) { int pk = __builtin_amdgcn_cvt_pk_fp8_f32(v[0] * wv[bj][n][0], v[1] * wv[bj][n][1], 0, false); pk = __builtin_amdgcn_cvt_pk_fp8_f32(v[2] * wv[bj][n][2], v[3] * wv[bj][n][3], pk, true);
                        *(int*)((unsigned char*)XN + off + bj * HALF + n * 16) = pk; }
                    else { u32x2 o; o.x = cvt_pk_bf16(v[0] * wv[bj][n][0], v[1] * wv[bj][n][1]); o.y = cvt_pk_bf16(v[2] * wv[bj][n][2], v[3] * wv[bj][n][3]);
                        *(u32x2*)(XN + off + bj * HALF + n * 16) = o; } }
            s += __shfl_xor(s, 16); s += __shfl_xor(s, 32);
            if (fq == 0) unsafeAtomicAdd(ssq + row, s);
        }
    }
};
typedef EpiResNormT<false, false> EpiResNorm;
typedef EpiResNormT<true, true> EpiResNormF8;
struct EpiCmpGelu {
    static constexpr bool PERM = false;
    float* H; const float* bias;
    __device__ __forceinline__ void operator()(const f32x4 (&acc)[2][2][4][2], const Unit& u, int wr, int wc, int fr, int fq) const {
        const int row0 = u.pm * BM + wr * 64 + fr, col0 = wc * 32 + 4 * fq; const float* bs = bias + (u.pm >> 4) * 256;
        f32x4 bvv[2][2];
#pragma unroll
        for (int bj = 0; bj < 2; ++bj)
#pragma unroll
            for (int n = 0; n < 2; ++n) bvv[bj][n] = *(const f32x4*)(bs + col0 + bj * HALF + n * 16);
#pragma unroll
        for (int ai = 0; ai < 2; ++ai)
#pragma unroll
            for (int m = 0; m < 4; ++m) { float* rowp = H + (size_t)(row0 + ai * HALF + m * 16) * 256 + col0;
#pragma unroll
                for (int bj = 0; bj < 2; ++bj)
#pragma unroll
                    for (int n = 0; n < 2; ++n) { f32x4 v = acc[ai][bj][m][n] + bvv[bj][n];
#pragma unroll
                        for (int j = 0; j < 4; ++j) { const float xx = v[j], uu = 0.7978845608028654f * (xx + 0.044715f * xx * xx * xx); const float th = 1.0f - 2.0f / (1.0f + __expf(2.0f * uu)); v[j] = 0.5f * xx * (1.0f + th); }
                        *(f32x4*)(rowp + bj * HALF + n * 16) = v; } }
    }
};
struct EpiGate {
    static constexpr bool PERM = false;
    float* C; const bf16_t* H; const bf16_t* eraw; const float* erstd; const float* pw; const float* ssq; int ldc; float ascale;
    __device__ __forceinline__ void operator()(const f32x4 (&acc)[2][2][4][2], const Unit& u, int wr, int wc, int fr, int fq) const {
        const int row0 = u.pm * BM + wr * 64 + fr, col0 = u.pn * BM + wc * 32 + 4 * fq;
        f32x4 wv[2][2];
#pragma unroll
        for (int bj = 0; bj < 2; ++bj)
#pragma unroll
            for (int n = 0; n < 2; ++n) wv[bj][n] = *(const f32x4*)(pw + col0 + bj * HALF + n * 16);
        u32x2 bv[2][2][2]; u32x2 ev[2][2][2]; float rsv[2], rgv[2];
#pragma unroll
        for (int bj = 0; bj < 2; ++bj)
#pragma unroll
            for (int n = 0; n < 2; ++n) { bv[0][bj][n] = *(const u32x2*)(H + (size_t)row0 * ldc + col0 + bj * HALF + n * 16); ev[0][bj][n] = *(const u32x2*)(eraw + (size_t)row0 * ldc + col0 + bj * HALF + n * 16); }
        rsv[0] = erstd[row0]; rgv[0] = ssq[row0];
#pragma unroll
        for (int rg = 0; rg < 8; ++rg) { const int ai = rg >> 2, m = rg & 3; const int row = row0 + ai * HALF + m * 16; const size_t off = (size_t)row * ldc + col0;
            if (rg < 7) { const int ai2 = (rg + 1) >> 2, m2 = (rg + 1) & 3; const int row2 = row0 + ai2 * HALF + m2 * 16; const size_t off2 = (size_t)row2 * ldc + col0;
#pragma unroll
                for (int bj = 0; bj < 2; ++bj)
#pragma unroll
                    for (int n = 0; n < 2; ++n) { bv[(rg + 1) & 1][bj][n] = *(const u32x2*)(H + off2 + bj * HALF + n * 16); ev[(rg + 1) & 1][bj][n] = *(const u32x2*)(eraw + off2 + bj * HALF + n * 16); }
                rsv[(rg + 1) & 1] = erstd[row2]; rgv[(rg + 1) & 1] = ssq[row2]; }
            const float rs = rsqrtf(rsv[rg & 1] * (1.0f / DM) + EPS), rg_ = rsqrtf(rgv[rg & 1] * (1.0f / DM) + EPS) * ascale;
#pragma unroll
            for (int bj = 0; bj < 2; ++bj)
#pragma unroll
                for (int n = 0; n < 2; ++n) { const u32x2 br = bv[rg & 1][bj][n]; const f32x4 b = {bf_lo(br.x), bf_hi(br.x), bf_lo(br.y), bf_hi(br.y)}; const u32x2 e = ev[rg & 1][bj][n]; const f32x4 a = acc[ai][bj][m][n]; f32x4 o;
                    o[0] = b[0] + bf_lo(e.x) * rs * wv[bj][n][0] * sigmoidf_(a[0] * rg_); o[1] = b[1] + bf_hi(e.x) * rs * wv[bj][n][1] * sigmoidf_(a[1] * rg_);
                    o[2] = b[2] + bf_lo(e.y) * rs * wv[bj][n][2] * sigmoidf_(a[2] * rg_); o[3] = b[3] + bf_hi(e.y) * rs * wv[bj][n][3] * sigmoidf_(a[3] * rg_);
                    *(f32x4*)(C + off + bj * HALF + n * 16) = o; }
        }
    }
};
struct GFfn {
    const char* A; const char* B; unsigned lda, ldb; int nt;
    __device__ __forceinline__ const char* a_base(const Unit& u) const { return A + ((long)u.pm * 254 - 2) * (long)lda * 2; }
    __device__ __forceinline__ const char* b_base(const Unit& u) const { return B + (size_t)u.pn * 256 * ldb * 2; }
    __device__ __forceinline__ size_t kpairA() const { return 256; }
};
template <int CTRL> __device__ __forceinline__ float dpp_f(float v) { return __int_as_float(__builtin_amdgcn_update_dpp(0, __float_as_int(v), CTRL, 0xf, 0xf, false)); }
struct EpiFfn {
    static constexpr bool PERM = true;
    bf16_t* ACT; const float* cw; const float* cb; LAS float* X; const float* ssq;
    __device__ __forceinline__ void operator()(const f32x4 (&acc)[2][2][4][2], const Unit& u, int wr, int wc, int fr, int fq) const {
        const int colw = wc * 32 + 8 * fq;
        const int f0 = u.pn * 128 + colw;
        f32x4 w0[2], w1[2], w2[2], cbv[2];
#pragma unroll
        for (int n = 0; n < 2; ++n) { w0[n] = *(const f32x4*)(cw + f0 + 4 * n); w1[n] = *(const f32x4*)(cw + DFF + f0 + 4 * n); w2[n] = *(const f32x4*)(cw + 2 * DFF + f0 + 4 * n); cbv[n] = *(const f32x4*)(cb + f0 + 4 * n); }
        float rsv[2][4];
#pragma unroll
        for (int ai = 0; ai < 2; ++ai)
#pragma unroll
            for (int m = 0; m < 4; ++m) { const long t = (long)u.pm * 254 - 2 + ai * HALF + wr * 64 + m * 16 + fr; rsv[ai][m] = ssq[t < 0 ? 0 : (t >= S_ ? S_ - 1 : t)]; }
#pragma unroll
        for (int ai = 0; ai < 2; ++ai)
#pragma unroll
            for (int m = 0; m < 4; ++m) { const long t = (long)u.pm * 254 - 2 + ai * HALF + wr * 64 + m * 16 + fr; rsv[ai][m] = (t >= 0 && t < S_) ? rsqrtf(rsv[ai][m] * (1.0f / DM) + EPS) : 0.f; }
        if (fr >= 14) {
#pragma unroll
            for (int ai = 0; ai < 2; ++ai)
#pragma unroll
                for (int n = 0; n < 2; ++n) *(LAS f32x4*)(X + ((2 * ai + wr) * 2 + (fr - 14)) * 128 + colw + 4 * n) = acc[ai][0][3][n] * rsv[ai][3];
        }
        asm volatile("s_waitcnt lgkmcnt(0)" ::: "memory");
        __builtin_amdgcn_s_barrier(); asm volatile("" ::: "memory");
        __builtin_amdgcn_s_barrier(); asm volatile("" ::: "memory");
        const bool sel1 = fr == 15, sel2 = fr >= 14;
#pragma unroll
        for (int ai = 0; ai < 2; ++ai) {
            f32x4 pv[2];
            const int pseg = 2 * ai + wr - 1;
#pragma unroll
            for (int n = 0; n < 2; ++n) { pv[n] = (f32x4){0.f, 0.f, 0.f, 0.f}; if (pseg >= 0 && fr >= 14) pv[n] = *(const LAS f32x4*)(X + (pseg * 2 + (fr - 14)) * 128 + colw + 4 * n); }
#pragma unroll
            for (int m = 0; m < 4; ++m) {
                const int r = ai * HALF + wr * 64 + m * 16 + fr; const long t = (long)u.pm * 254 - 2 + r;
                unsigned ow[4];
#pragma unroll
                for (int n = 0; n < 2; ++n) {
                    const f32x4 cur = acc[ai][0][m][n] * rsv[ai][m], up = acc[ai][1][m][n] * rsv[ai][m];
                    f32x4 x1, x2;
#pragma unroll
                    for (int i = 0; i < 4; ++i) { x1[i] = dpp_f<0x121>(sel1 ? pv[n][i] : cur[i]); x2[i] = dpp_f<0x122>(sel2 ? pv[n][i] : cur[i]); }
                    const f32x4 y = cbv[n] + w0[n] * x2 + w1[n] * x1 + w2[n] * cur;
                    f32x4 sg;
#pragma unroll
                    for (int i = 0; i < 4; ++i) sg[i] = sigmoidf_(y[i]);
                    const f32x4 o = y * sg * up;
                    ow[2 * n] = cvt_pk_bf16(o[0], o[1]); ow[2 * n + 1] = cvt_pk_bf16(o[2], o[3]);
                    pv[n] = cur;
                }
                if (r >= 2 && t < S_) *(u32x4*)(ACT + (size_t)t * DFF + f0) = (u32x4){ow[0], ow[1], ow[2], ow[3]};
            }
        }
    }
};

template <class GD, class Epi, bool F8 = false>
__device__ __forceinline__ void gemm_phase(LAS unsigned char* lds, const GD g, const StaticOrder& S, const Epi& E) {
    const int tid = threadIdx.x, wid = __builtin_amdgcn_readfirstlane(tid >> 6), lane = tid & 63, wr = wid >> 2, wc = wid & 3, fr = lane & 15, fq = lane >> 4;
    const int nt = g.nt;
    unsigned voffA[2], voffB[2];
#pragma unroll
    for (int i = 0; i < 2; ++i) { int R, C; stage_rc(tid * 16 + i * 8192, R, C); const int Rb = Epi::PERM ? ((R & ~31) + perm32(R & 31)) : R;
        voffA[i] = (unsigned)(R * g.lda + C) * 2u; voffB[i] = (unsigned)(Rb * g.ldb + C) * 2u; }
    const size_t kpA = g.kpairA();
    const size_t hstepA = (size_t)HALF * g.lda * 2, hstepB = (size_t)HALF * g.ldb * 2;
    const unsigned ldsw = (unsigned)wid * 1024u;
    const int aoff = lds_byte(wr * 64 + fr, fq * 8), boff = lds_byte(wc * 32 + fr, fq * 8);
#define PG8_SA(b, h) (((b) * 2 + (h)) * HTB)
#define PG8_SB(b, h) ((4 + (b) * 2 + (h)) * HTB)
#define PG8_STAGE(bufoff, gbase, voff) do { _Pragma("unroll") for (int _i = 0; _i < 2; ++_i) \
        __builtin_amdgcn_global_load_lds((const unsigned*)((const char*)(gbase) + (voff)[_i]), (LAS unsigned*)(lds + (bufoff) + ldsw + _i * 8192), 16, 0, 0); } while (0)
#define PG8_LDA(dst, b, h) do { if constexpr (F8) { _Pragma("unroll") for (int m = 0; m < 4; ++m) { const i32x4 lo_ = *(const LAS i32x4*)(lds + PG8_SA(b, h) + aoff + m * 2048), hi_ = *(const LAS i32x4*)(lds + PG8_SA(b, h) + aoff + m * 2048 + 1024); \
            dst##8[m] = __builtin_shufflevector(lo_, hi_, 0, 1, 2, 3, 4, 5, 6, 7); } } \
        else { _Pragma("unroll") for (int m = 0; m < 4; ++m) _Pragma("unroll") for (int k = 0; k < 2; ++k) dst[m][k] = *(const LAS bf16x8*)(lds + PG8_SA(b, h) + aoff + m * 2048 + k * 1024); } } while (0)
#define PG8_LDB(dst, b, h) do { if constexpr (F8) { _Pragma("unroll") for (int n = 0; n < 2; ++n) { const i32x4 lo_ = *(const LAS i32x4*)(lds + PG8_SB(b, h) + boff + n * 2048), hi_ = *(const LAS i32x4*)(lds + PG8_SB(b, h) + boff + n * 2048 + 1024); \
            dst##8[n] = __builtin_shufflevector(lo_, hi_, 0, 1, 2, 3, 4, 5, 6, 7); } } \
        else { _Pragma("unroll") for (int n = 0; n < 2; ++n) _Pragma("unroll") for (int k = 0; k < 2; ++k) dst[n][k] = *(const LAS bf16x8*)(lds + PG8_SB(b, h) + boff + n * 2048 + k * 1024); } } while (0)
#define PG8_MMA(ai, bj, At, Bt) do { __builtin_amdgcn_s_setprio(1); \
        if constexpr (F8) { _Pragma("unroll") for (int m = 0; m < 4; ++m) _Pragma("unroll") for (int n = 0; n < 2; ++n) \
            asm volatile("v_mfma_scale_f32_16x16x128_f8f6f4 %0, %1, %2, %0, %3, %3 op_sel_hi:[0,0,0]" : "+v"(acc[ai][bj][m][n]) : "v"(Bt##8[n]), "v"(At##8[m]), "v"(one_scale)); } \
        else { _Pragma("unroll") for (int m = 0; m < 4; ++m) _Pragma("unroll") for (int n = 0; n < 2; ++n) _Pragma("unroll") for (int k = 0; k < 2; ++k) \
            acc[ai][bj][m][n] = __builtin_amdgcn_mfma_f32_16x16x32_bf16(Bt[n][k], At[m][k], acc[ai][bj][m][n], 0, 0, 0); } \
        __builtin_amdgcn_s_setprio(0); } while (0)
#define PG8_WAIT_V(n) asm volatile("s_waitcnt vmcnt(" #n ")" ::: "memory")
#define PG8_WAIT_L(n) asm volatile("s_waitcnt lgkmcnt(" #n ")" ::: "memory")
#define PG8_BAR __builtin_amdgcn_s_barrier()
#define PG8_SCHED __builtin_amdgcn_sched_barrier(0)
    Unit cur, nxt; int ui = 0;
    if (!S.next(0, cur)) return;
    f32x4 acc[2][2][4][2];
#pragma unroll
    for (int a = 0; a < 2; ++a)
#pragma unroll
        for (int b = 0; b < 2; ++b)
#pragma unroll
            for (int m = 0; m < 4; ++m)
#pragma unroll
                for (int n = 0; n < 2; ++n) acc[a][b][m][n] = (f32x4){0.f, 0.f, 0.f, 0.f};
    bf16x8 At[4][2], B0[2][2], B1[2][2];
    i32x8 At8[4], B08[2], B18[2];
    (void)At; (void)B0; (void)B1; (void)At8; (void)B08; (void)B18;
    int one_scale = 0x7F7F7F7F; (void)one_scale;
    const char* cA = g.a_base(cur); const char* cB = g.b_base(cur);
    PG8_STAGE(PG8_SB(0, 0), cB, voffB); PG8_STAGE(PG8_SA(0, 0), cA, voffA); PG8_STAGE(PG8_SB(0, 1), cB + hstepB, voffB); PG8_STAGE(PG8_SA(0, 1), cA + hstepA, voffA);
    if (wr == 1) PG8_BAR;
    PG8_WAIT_V(4); PG8_BAR;
    PG8_STAGE(PG8_SB(1, 0), cB + 128, voffB); PG8_STAGE(PG8_SA(1, 0), cA + 128, voffA); PG8_STAGE(PG8_SB(1, 1), cB + hstepB + 128, voffB);
    PG8_WAIT_V(6); PG8_BAR;
    for (;;) {
        const bool has_next = S.next(ui + 1, nxt);
        const char* nA = has_next ? g.a_base(nxt) : cA; const char* nB = has_next ? g.b_base(nxt) : cB;
        for (int t = 0; t < nt; t += 2) {
            const bool last = (t == nt - 2);
            const char* a0 = cA + (size_t)(t >> 1) * kpA;
            const char* a1 = a0 + 128;
            const char* a2 = last ? nA : a0 + kpA; const char* b2 = last ? nB : cB + (size_t)(t + 2) * 128;
            const char* a3 = a2 + 128; const char* b3 = b2 + 128;
            PG8_LDB(B0, 0, 0); PG8_SCHED; PG8_LDA(At, 0, 0); PG8_STAGE(PG8_SA(1, 1), a1 + hstepA, voffA);
            PG8_WAIT_L(8); PG8_BAR; PG8_WAIT_L(0); PG8_MMA(0, 0, At, B0); PG8_BAR; PG8_SCHED;
            PG8_LDB(B1, 0, 1); PG8_STAGE(PG8_SB(0, 0), b2, voffB);
            PG8_BAR; PG8_WAIT_L(0); PG8_MMA(0, 1, At, B1); PG8_BAR;
            PG8_LDA(At, 0, 1); PG8_STAGE(PG8_SA(0, 0), a2, voffA);
            PG8_BAR; PG8_WAIT_L(0); PG8_MMA(1, 0, At, B0); PG8_BAR; PG8_SCHED;
            PG8_STAGE(PG8_SB(0, 1), b2 + hstepB, voffB);
            PG8_WAIT_V(6); PG8_BAR; PG8_MMA(1, 1, At, B1); PG8_BAR;
            PG8_LDB(B0, 1, 0); PG8_SCHED; PG8_LDA(At, 1, 0); PG8_STAGE(PG8_SA(0, 1), a2 + hstepA, voffA);
            PG8_WAIT_L(8); PG8_BAR; PG8_WAIT_L(0); PG8_MMA(0, 0, At, B0); PG8_BAR; PG8_SCHED;
            PG8_LDB(B1, 1, 1); PG8_STAGE(PG8_SB(1, 0), b3, voffB);
            PG8_BAR; PG8_WAIT_L(0); PG8_MMA(0, 1, At, B1); PG8_BAR;
            PG8_LDA(At, 1, 1); PG8_STAGE(PG8_SA(1, 0), a3, voffA);
            PG8_BAR; PG8_WAIT_L(0); PG8_MMA(1, 0, At, B0); PG8_BAR; PG8_SCHED;
            PG8_STAGE(PG8_SB(1, 1), b3 + hstepB, voffB);
            PG8_WAIT_V(6); PG8_BAR; PG8_MMA(1, 1, At, B1); PG8_BAR;
        }
        if constexpr (F8) asm volatile("s_nop 15\n\ts_nop 15\n\ts_nop 15" ::: "memory");
        E(acc, cur, wr, wc, fr, fq);
        if (!has_next) break;
#pragma unroll
        for (int a = 0; a < 2; ++a)
#pragma unroll
            for (int b = 0; b < 2; ++b)
#pragma unroll
                for (int m = 0; m < 4; ++m)
#pragma unroll
                    for (int n = 0; n < 2; ++n) acc[a][b][m][n] = (f32x4){0.f, 0.f, 0.f, 0.f};
        cur = nxt; cA = nA; cB = nB; ++ui;
    }
    PG8_WAIT_V(0);
    if (wr == 0) PG8_BAR;
    PG8_BAR;
#undef PG8_SA
#undef PG8_SB
#undef PG8_STAGE
#undef PG8_LDA
#undef PG8_LDB
#undef PG8_MMA
#undef PG8_WAIT_V
#undef PG8_WAIT_L
#undef PG8_BAR
#undef PG8_SCHED
}
}

namespace att {
constexpr int KVBLK = 64;
constexpr int SHM_V = KVBLK * HD * 2, SHM_K = KVBLK * HD * 2, SHM_ATTN = 2 * SHM_V + 2 * SHM_K + NWAVES * 64 * 4;
#define KSWZ(row, colB) ((row) * 256 + ((colB) ^ (((row) & 7) << 4)))
#define SBAR() __builtin_amdgcn_sched_barrier(0)
__device__ __forceinline__ int crow(int r, int hi) { return (r & 3) + 8 * (r >> 2) + 4 * hi; }
__device__ __forceinline__ void qkt(f32x16& p0, f32x16& p1, const char* Ks, const bf16x8* qr, int r32, int hi) {
    p0 = f32x16{}; p1 = f32x16{};
    bf16x8 ka[2], kb[2];
    { const int cb = (hi * 8) * 2; ka[0] = *reinterpret_cast<const bf16x8*>(Ks + KSWZ(r32, cb)); kb[0] = *reinterpret_cast<const bf16x8*>(Ks + KSWZ(32 + r32, cb)); }
#pragma unroll
    for (int d0 = 0; d0 < 8; ++d0) {
        if (d0 < 7) { const int cb = ((d0 + 1) * 16 + hi * 8) * 2;
            ka[(d0 + 1) & 1] = *reinterpret_cast<const bf16x8*>(Ks + KSWZ(r32, cb)); kb[(d0 + 1) & 1] = *reinterpret_cast<const bf16x8*>(Ks + KSWZ(32 + r32, cb)); }
        SBAR();
        p0 = __builtin_amdgcn_mfma_f32_32x32x16_bf16(ka[d0 & 1], qr[d0], p0, 0, 0, 0);
        p1 = __builtin_amdgcn_mfma_f32_32x32x16_bf16(kb[d0 & 1], qr[d0], p1, 0, 0, 0);
        SBAR();
    }
}
__device__ __forceinline__ int v_st(int k, int c) { const int kk = (k & ~0xC) | ((k & 4) << 1) | ((k & 8) >> 1); return ((kk >> 3) * 4 + (c >> 5)) * 512 + ((kk & 7) * 32 + (c & 31)) * 2; }
__device__ __forceinline__ int v_rd_base(int lane) { return ((lane & 3) << 3) | (((lane >> 2) & 3) << 6) | (((lane >> 4) & 1) << 5) | (((lane >> 5) & 1) << 8); }
constexpr int v_rd_off(int d0, int ks, int half) { return d0 * 512 + ks * 4096 + half * 2048; }
__device__ __forceinline__ s16x4 tr_read(int vb, int off) { return __builtin_amdgcn_ds_read_tr16_b64_v4i16((LAS s16x4*)(unsigned long)(unsigned)(vb + off)); }
__device__ __forceinline__ void pv_d0(f32x16* o, int vb, bf16x8 pa0, bf16x8 pa1, bf16x8 pa2, bf16x8 pa3) {
    s16x4 L[2][4], H[2][4];
#pragma unroll
    for (int d0 = 0; d0 < 4; ++d0) { L[0][d0] = tr_read(vb, v_rd_off(d0, 0, 0)); H[0][d0] = tr_read(vb, v_rd_off(d0, 0, 1)); }
#pragma unroll
    for (int ks = 0; ks < 4; ++ks) {
        if (ks < 3) {
#pragma unroll
            for (int d0 = 0; d0 < 4; ++d0) { L[(ks + 1) & 1][d0] = tr_read(vb, v_rd_off(d0, ks + 1, 0)); H[(ks + 1) & 1][d0] = tr_read(vb, v_rd_off(d0, ks + 1, 1)); }
        }
        const bf16x8 pa = ks == 0 ? pa0 : (ks == 1 ? pa1 : (ks == 2 ? pa2 : pa3));
#pragma unroll
        for (int d0 = 0; d0 < 4; ++d0) { const s16x4 l = L[ks & 1][d0], h = H[ks & 1][d0];
            o[d0] = __builtin_amdgcn_mfma_f32_32x32x16_bf16(pa, (bf16x8){l[0], l[1], l[2], l[3], h[0], h[1], h[2], h[3]}, o[d0], 0, 0, 0); }
    }
}
__device__ __forceinline__ void pack_p(const f32x16& p0, const f32x16& p1, bf16x8& pa0, bf16x8& pa1, bf16x8& pa2, bf16x8& pa3) {
#define PK4(P, BASE, OUT) do { unsigned a0 = cvt_pk_bf16(P[BASE + 0], P[BASE + 1]), a1 = cvt_pk_bf16(P[BASE + 2], P[BASE + 3]);   \
    unsigned b0 = cvt_pk_bf16(P[BASE + 4], P[BASE + 5]), b1 = cvt_pk_bf16(P[BASE + 6], P[BASE + 7]);                              \
    auto r0 = __builtin_amdgcn_permlane32_swap(a0, b0, false, false); auto r1 = __builtin_amdgcn_permlane32_swap(a1, b1, false, false); \
    u32x4 w = {r0[0], r1[0], r0[1], r1[1]}; OUT = *reinterpret_cast<bf16x8*>(&w); } while (0)
    PK4(p0, 0, pa0); PK4(p0, 8, pa1); PK4(p1, 0, pa2); PK4(p1, 8, pa3);
#undef PK4
}

__device__ __forceinline__ void pack_half(const f32x16& p, bf16x8& paA, bf16x8& paB) {
#define PK4(P, BASE, OUT) do { unsigned a0 = cvt_pk_bf16(P[BASE + 0], P[BASE + 1]), a1 = cvt_pk_bf16(P[BASE + 2], P[BASE + 3]);   \
    unsigned b0 = cvt_pk_bf16(P[BASE + 4], P[BASE + 5]), b1 = cvt_pk_bf16(P[BASE + 6], P[BASE + 7]);                              \
    auto r0 = __builtin_amdgcn_permlane32_swap(a0, b0, false, false); auto r1 = __builtin_amdgcn_permlane32_swap(a1, b1, false, false); \
    u32x4 w = {r0[0], r1[0], r0[1], r1[1]}; OUT = *reinterpret_cast<bf16x8*>(&w); } while (0)
    PK4(p, 0, paA); PK4(p, 8, paB);
#undef PK4
}
template <int KS0, bool WITH_EXP>
__device__ __forceinline__ void pv_half(f32x16* o, int vb, bf16x8 paA, bf16x8 paB, f32x16& px, float off) {
    s16x4 L[2][4], H[2][4];
#pragma unroll
    for (int d0 = 0; d0 < 4; ++d0) { L[0][d0] = tr_read(vb, v_rd_off(d0, KS0, 0)); H[0][d0] = tr_read(vb, v_rd_off(d0, KS0, 1)); }
#pragma unroll
    for (int d0 = 0; d0 < 4; ++d0) { L[1][d0] = tr_read(vb, v_rd_off(d0, KS0 + 1, 0)); H[1][d0] = tr_read(vb, v_rd_off(d0, KS0 + 1, 1)); }
#pragma unroll
    for (int kk = 0; kk < 2; ++kk) {
        const bf16x8 pa = kk == 0 ? paA : paB;
#pragma unroll
        for (int d0 = 0; d0 < 4; ++d0) { const s16x4 l = L[kk][d0], h = H[kk][d0];
            if (WITH_EXP) SBAR();
            o[d0] = __builtin_amdgcn_mfma_f32_32x32x16_bf16(pa, (bf16x8){l[0], l[1], l[2], l[3], h[0], h[1], h[2], h[3]}, o[d0], 0, 0, 0);
            if (WITH_EXP) {
#pragma unroll
                for (int q = 0; q < 2; ++q) { const int r = (kk * 4 + d0) * 2 + q; px[r] = __builtin_amdgcn_exp2f(fmaf(px[r], SM_C, off)); }
                SBAR(); }
        }
    }
}
enum { MODE_CMP = 0, MODE_WIN = 1, MODE_SLC = 2 };
struct AttnArgs {
    const bf16_t* Z; const bf16_t* KC; const bf16_t* VC; const float* G; float* L; float* OACC; bf16_t* MIX; const unsigned* BM; const float* TAB;
};
template <int MODE>
__device__ __forceinline__ void attn_unit(const AttnArgs& a, LAS char* ldsL, int qt, int g, int hp) {
    char* lds = (char*)ldsL;
    const int tid = threadIdx.x, wid = __builtin_amdgcn_readfirstlane(tid >> 6), lane = tid & 63, r32 = lane & 31, hi = lane >> 5;
    float* li_l = (float*)(lds + LDS_XCH) + wid * 64;
    const int t0 = MODE == MODE_SLC ? qt * 40 : qt * 128;
    const int tq_raw = MODE == MODE_SLC ? t0 + wid * 5 + r32 / 6 : t0 + wid * 16 + (r32 & 15);
    const bool rvalid = MODE == MODE_SLC ? (r32 < 30 && tq_raw < S_) : true;
    const int tq = tq_raw < S_ ? tq_raw : S_ - 1;
    const int hq = MODE == MODE_SLC ? g * HPG + r32 % 6 : g * HPG + hp * 2 + (r32 >> 4);
    const int tlast = MODE == MODE_SLC ? ((t0 + 39) < S_ ? (t0 + 39) : S_ - 1) : t0 + 127;
    const bf16_t* Kb; const bf16_t* Vb; long ldk;
    if (MODE == MODE_CMP) { Kb = a.KC + (size_t)g * 1024 * HD; Vb = a.VC + (size_t)g * 1024 * HD; ldk = HD; }
    else if (MODE == MODE_WIN) { Kb = a.Z + OFF_KV + 4 * 512 + g * HD; Vb = a.Z + OFF_KV + 5 * 512 + g * HD; ldk = LDZ; }
    else { Kb = a.Z + OFF_KV + 2 * 512 + g * HD; Vb = a.Z + OFF_KV + 3 * 512 + g * HD; ldk = LDZ; }
    int j0, j1;
    if (MODE == MODE_CMP) { j0 = 0; j1 = (((t0 + 127 - 31) >> 4) >> 6) + 1; }
    else if (MODE == MODE_WIN) { j0 = (t0 - 511) > 0 ? ((t0 - 511) >> 6) : 0; j1 = ((t0 + 127) >> 6) + 1; }
    else { j0 = 0; j1 = (tlast >> 6) + 1; }
    int klo, khi;
    if (MODE == MODE_CMP) { klo = 0; khi = tq >= 31 ? ((tq - 31) >> 4) : -1; }
    else if (MODE == MODE_WIN) { klo = tq - 511; khi = tq; }
    else { klo = 0; khi = rvalid ? tq : -1; }
    float negBC = -a.TAB[512 + (MODE == MODE_CMP ? 0 : (MODE == MODE_SLC ? 1 : 2))];
    bf16x8 qr[8];
    { const bf16_t* Qw = a.Z + (size_t)tq * LDZ + OFF_Q + hq * HD + hi * 8;
#pragma unroll
      for (int d0 = 0; d0 < 8; ++d0) qr[d0] = *reinterpret_cast<const bf16x8*>(Qw + d0 * 16); }
    f32x16 o[4] = {}; float lsum = 0.f;
    unsigned soK[2], soV[2];
#pragma unroll
    for (int i = 0; i < 2; ++i) { const int p = (wid + 8 * i) * 64 + lane;
        { const int row = p >> 4, c = (p & 15) ^ (row & 7); soK[i] = (unsigned)(row * ldk + c * 8) * 2u; }
        { const int sub = p >> 5, within = p & 31, kk = (sub >> 2) * 8 + (within >> 2), c = (sub & 3) * 32 + (within & 3) * 8, k = (kk & ~0xC) | ((kk & 4) << 1) | ((kk & 8) >> 1);
          soV[i] = (unsigned)(k * ldk + c) * 2u; } }
    const int vb0 = (int)(uintptr_t)(LAS char*)ldsL + 16384 + v_rd_base(lane);
#define ISSUE(jt) do { const int _b = ((jt) - j0) & 3; const char* _kp = (const char*)Kb + (size_t)(jt) * KVBLK * ldk * 2; const char* _vp = (const char*)Vb + (size_t)(jt) * KVBLK * ldk * 2; \
    _Pragma("unroll") for (int _i = 0; _i < 2; ++_i) { \
        __builtin_amdgcn_global_load_lds((const unsigned*)(_kp + soK[_i]), (LAS unsigned*)(ldsL + _b * 32768 + (wid + 8 * _i) * 1024), 16, 0, 0); \
        __builtin_amdgcn_global_load_lds((const unsigned*)(_vp + soV[_i]), (LAS unsigned*)(ldsL + _b * 32768 + 16384 + (wid + 8 * _i) * 1024), 16, 0, 0); } } while (0)
    unsigned bmw = 0u;
    if (MODE == MODE_SLC) bmw = a.BM[((size_t)tq * 4 + g) * 8];
    asm volatile("s_waitcnt lgkmcnt(0)" ::: "memory");
    __builtin_amdgcn_s_barrier();
    asm volatile("" ::: "memory");
    ISSUE(j0);
    asm volatile("s_waitcnt vmcnt(4) lgkmcnt(0)" : "+v"(bmw), "+v"(negBC), "+v"(qr[0]), "+v"(qr[1]), "+v"(qr[2]), "+v"(qr[3]), "+v"(qr[4]), "+v"(qr[5]), "+v"(qr[6]), "+v"(qr[7]) :: "memory");
    if (j0 + 1 < j1) ISSUE(j0 + 1); if (j0 + 2 < j1) ISSUE(j0 + 2);
    for (int j = j0; j < j1; ++j) {
        const int buf = (j - j0) & 3;
        if (j + 2 < j1) asm volatile("s_waitcnt vmcnt(8)" ::: "memory"); else if (j + 1 < j1) asm volatile("s_waitcnt vmcnt(4)" ::: "memory"); else asm volatile("s_waitcnt vmcnt(0)" ::: "memory");
        __builtin_amdgcn_s_barrier();
        asm volatile("" ::: "memory");
        if (j + 3 < j1) ISSUE(j + 3);
        int lhi = khi;
        if (MODE == MODE_SLC) { if (!((bmw >> (j & 31)) & 1u)) lhi = -1; }
        const int kb = j * KVBLK;
        const bool l_any = (kb + 63 >= klo) && (kb <= lhi);
        const bool l_full = (kb >= klo) && (kb + 63 <= lhi);
        if (__any(l_any)) {
            f32x16 p0, p1;
            qkt(p0, p1, lds + buf * 32768, qr, r32, hi);
            const bool uni = __all(l_full || !l_any);
            const float off = (uni && !l_any) ? -1.0e30f : negBC;
#pragma unroll
            for (int r = 0; r < 16; ++r) p0[r] = __builtin_amdgcn_exp2f(fmaf(p0[r], SM_C, off));
            if (!uni) {
#pragma unroll
                for (int r = 0; r < 16; ++r) { const int k0i = kb + crow(r, hi); p0[r] = (k0i >= klo && k0i <= lhi) ? p0[r] : 0.f; } }
            float ps = 0.f;
#pragma unroll
            for (int r = 0; r < 16; ++r) ps += p0[r];
            bf16x8 pa0, pa1, pa2, pa3; pack_half(p0, pa0, pa1);
            pv_half<0, true>(o, vb0 + buf * 32768, pa0, pa1, p1, off);
            if (!uni) {
#pragma unroll
                for (int r = 0; r < 16; ++r) { const int k1i = kb + 32 + crow(r, hi); p1[r] = (k1i >= klo && k1i <= lhi) ? p1[r] : 0.f; } }
#pragma unroll
            for (int r = 0; r < 16; ++r) ps += p1[r];
            lsum += ps;
            pack_half(p1, pa2, pa3);
            pv_half<2, false>(o, vb0 + buf * 32768, pa2, pa3, p1, off);
        }
        if (MODE == MODE_SLC) { if (((j + 1) & 31) == 0 && j + 1 < j1) { bmw = a.BM[((size_t)tq * 4 + g) * 8 + ((j + 1) >> 5)]; asm volatile("s_waitcnt vmcnt(0)" : "+v"(bmw) :: "memory"); } }
    }
#undef ISSUE
    lsum += __shfl_xor(lsum, 32);
    const float grow = a.G[(size_t)tq * NGATE + hq * 3 + (MODE == MODE_CMP ? 0 : (MODE == MODE_SLC ? 1 : 2))];
    if (hi == 0) { li_l[r32] = lsum; li_l[32 + r32] = rvalid ? grow : 0.f; }
    if (MODE == MODE_CMP) { if (hi == 0) a.L[(size_t)tq * NH + hq] = lsum; }
    asm volatile("s_waitcnt lgkmcnt(0)" ::: "memory");
#pragma unroll
    for (int hf = 0; hf < 2; ++hf) {
        float gtv[8]; float pvv[8][4];
#pragma unroll
        for (int rr = 0; rr < 8; ++rr) { const int r = hf * 8 + rr;
            const int orow = crow(r, hi); const float lv = li_l[orow]; const float rl = lv > 0.f ? __builtin_amdgcn_rcpf(lv) : 0.f;
            const int t = MODE == MODE_SLC ? t0 + wid * 5 + orow / 6 : t0 + wid * 16 + (orow & 15);
            const int h = MODE == MODE_SLC ? g * HPG + orow % 6 : g * HPG + hp * 2 + (orow >> 4);
            const bool valid = !(MODE == MODE_SLC && (orow >= 30 || t >= S_)); const int tc = valid ? t : 0;
            gtv[rr] = li_l[32 + orow] * rl;
            if (MODE == MODE_SLC) { const bf16_t* oc = (const bf16_t*)a.OACC + (size_t)tc * 3072 + h * HD + r32; const bf16_t* ow = oc + (size_t)S_ * 3072;
#pragma unroll
                for (int d0 = 0; d0 < 4; ++d0) pvv[rr][d0] = bf2f(oc[d0 * 32]) + bf2f(ow[d0 * 32]); }
        }
#pragma unroll
        for (int rr = 0; rr < 8; ++rr) { const int r = hf * 8 + rr;
            const int orow = crow(r, hi);
            const int t = MODE == MODE_SLC ? t0 + wid * 5 + orow / 6 : t0 + wid * 16 + (orow & 15);
            const int h = MODE == MODE_SLC ? g * HPG + orow % 6 : g * HPG + hp * 2 + (orow >> 4);
            if (MODE == MODE_SLC && (orow >= 30 || t >= S_)) continue;
            bf16_t* oa = (bf16_t*)a.OACC + (MODE == MODE_WIN ? (size_t)S_ * 3072 : 0) + (size_t)t * 3072 + h * HD + r32;
#pragma unroll
            for (int d0 = 0; d0 < 4; ++d0) {
                const float v = o[d0][r] * gtv[rr];
                if (MODE != MODE_SLC) oa[d0 * 32] = (bf16_t)(cvt_pk_bf16(v, 0.f) & 0xffffu);
                else a.MIX[(size_t)t * DM + POOLW + h * HD + d0 * 32 + r32] = (bf16_t)(cvt_pk_bf16(pvv[rr][d0] + v, 0.f) & 0xffffu);
            }
        }
    }
}

constexpr int SLC_KPS = 1040, SLC_VPS = 1056, SLC_KIMG = 16 * SLC_KPS, SLC_BUF = SLC_KIMG + 16 * SLC_VPS, LDS_SLCX = 4 * SLC_BUF;
static_assert(LDS_SLCX + 3072 <= LDS_MISC, "slc ring overlaps the barrier words");
__device__ __forceinline__ bf16x8 lds_b128(int adr) { return *reinterpret_cast<const LAS bf16x8*>((LAS char*)(unsigned long)(unsigned)adr); }
__device__ __forceinline__ void slc16_unit(const AttnArgs& a, LAS char* ldsL, int ut, int g) {
    char* lds = (char*)ldsL;
    const int tid = threadIdx.x, wid = __builtin_amdgcn_readfirstlane(tid >> 6), lane = tid & 63, fr = lane & 15, fq = lane >> 4;
    float* li_l = (float*)(lds + LDS_SLCX) + wid * 96;
    const int t0 = ut * 64, j0 = 0, j1 = ut + 1;
    const bf16_t* Kb = a.Z + OFF_KV + 2 * 512 + g * HD; const long ldk = LDZ;
    int tqv[3];
#pragma unroll
    for (int b = 0; b < 3; ++b) tqv[b] = t0 + wid * 8 + (16 * b + fr) / 6;
#define TQC(b) tqv[b]
#define HQ(b) (g * HPG + (16 * (b) + fr) % 6)
    float negBC = -a.TAB[513];
    bf16x8 qf[3][4];
#pragma unroll
    for (int b = 0; b < 3; ++b) { const bf16_t* qp = a.Z + (size_t)TQC(b) * LDZ + OFF_Q + HQ(b) * HD + fq * 8;
#pragma unroll
        for (int ks = 0; ks < 4; ++ks) qf[b][ks] = *reinterpret_cast<const bf16x8*>(qp + ks * 32); }
    f32x4 o[3][8]; float lsum[3];
#pragma unroll
    for (int b = 0; b < 3; ++b) { lsum[b] = 0.f;
#pragma unroll
        for (int c = 0; c < 8; ++c) o[b][c] = (f32x4){0.f, 0.f, 0.f, 0.f}; }
    const int q4 = fr >> 2, p4 = fr & 3, lbase = (int)(uintptr_t)ldsL;
    const int kaddr0 = lbase + fr * SLC_KPS + fq * 16;
    const int vaddr0 = lbase + SLC_KIMG + (4 * fq + q4) * SLC_VPS + (p4 >> 1) * 16 + (p4 & 1) * 8;
    unsigned so0 = (unsigned)((wid + 16 * (lane >> 4)) * ldk + (lane & 15) * 8) * 2u;
#define ISSUE16(jt) do { const int _b = ((jt) - j0) & 3; const char* _kp = (const char*)Kb + (size_t)(jt) * KVBLK * ldk * 2; asm volatile("" : "+v"(so0)); \
    _Pragma("unroll") for (int _i = 0; _i < 4; ++_i) \
        __builtin_amdgcn_global_load_lds((const unsigned*)(_kp + (_i >> 1) * 1024 + (_i & 1) * (8 * ldk * 2) + so0), \
            (LAS unsigned*)(ldsL + _b * SLC_BUF + ((_i >> 1) ? SLC_KIMG + (wid + 8 * (_i & 1)) * SLC_VPS : (wid + 8 * (_i & 1)) * SLC_KPS)), 16, 0, 0); } while (0)
    unsigned bmw[3];
#pragma unroll
    for (int b = 0; b < 3; ++b) bmw[b] = a.BM[((size_t)TQC(b) * 4 + g) * 8];
    asm volatile("s_waitcnt lgkmcnt(0)" ::: "memory");
    __builtin_amdgcn_s_barrier();
    asm volatile("" ::: "memory");
    ISSUE16(j0); if (j0 + 1 < j1) ISSUE16(j0 + 1);
    asm volatile("s_waitcnt vmcnt(0) lgkmcnt(0)" : "+v"(bmw[0]), "+v"(bmw[1]), "+v"(bmw[2]), "+v"(negBC), "+v"(qf[0][0]), "+v"(qf[0][1]), "+v"(qf[0][2]), "+v"(qf[0][3]),
                 "+v"(qf[1][0]), "+v"(qf[1][1]), "+v"(qf[1][2]), "+v"(qf[1][3]), "+v"(qf[2][0]), "+v"(qf[2][1]), "+v"(qf[2][2]), "+v"(qf[2][3]) :: "memory");
    int kadr = kaddr0, vadr = vaddr0;
    for (int j = j0; j < j1; ++j) {
        const int buf = (j - j0) & 3;
        if ((j & 1) == 0) {
            asm volatile("s_waitcnt vmcnt(0)" ::: "memory");
            __builtin_amdgcn_s_barrier();
            asm volatile("" ::: "memory");
            if (j + 2 < j1) ISSUE16(j + 2); if (j + 3 < j1) ISSUE16(j + 3); }
        const int kb = j * KVBLK;
#define KF16(ks, mt) lds_b128(kadr + 64 * (ks) + 256 * (mt))
#define TRA(dst, off) asm volatile("ds_read_b64_tr_b16 %0, %1 offset:%2" : "=v"(dst) : "v"(vadr), "n"(off))
#define VLOAD(dst, s, h) _Pragma("unroll") for (int _c = 0; _c < 4; ++_c) { TRA(dst[_c][0], 32 * (4 * (h) + _c) + 512 * (s)); TRA(dst[_c][1], 32 * (4 * (h) + _c) + 512 * (s) + 256); }
#define VWAIT(n, d) asm volatile("s_waitcnt lgkmcnt(" #n ")" : "+v"(d[0][0]), "+v"(d[0][1]), "+v"(d[1][0]), "+v"(d[1][1]), "+v"(d[2][0]), "+v"(d[2][1]), "+v"(d[3][0]), "+v"(d[3][1]))
#define PVMMA(src, pa, h) _Pragma("unroll") for (int _c = 0; _c < 4; ++_c) o[b][4 * (h) + _c] = __builtin_amdgcn_mfma_f32_16x16x32_bf16(pa, \
            (bf16x8){src[_c][0][0], src[_c][0][1], src[_c][0][2], src[_c][0][3], src[_c][1][0], src[_c][1][1], src[_c][1][2], src[_c][1][3]}, o[b][4 * (h) + _c], 0, 0, 0);
#define EXPH(h, pw) { if (uni) { _Pragma("unroll") for (int mt = 2 * (h); mt < 2 * (h) + 2; ++mt) _Pragma("unroll") for (int i = 0; i < 4; ++i) { \
                            const float e_ = __builtin_amdgcn_exp2f(fmaf(acc[mt][i], SM_C, off)); acc[mt][i] = e_; ps += e_; } } \
                      else { asm volatile("" ::: "memory"); _Pragma("unroll") for (int mt = 2 * (h); mt < 2 * (h) + 2; ++mt) _Pragma("unroll") for (int i = 0; i < 4; ++i) { \
                            float e_ = __builtin_amdgcn_exp2f(fmaf(acc[mt][i], SM_C, off)); e_ = (16 * mt + i <= lim4) ? e_ : 0.f; acc[mt][i] = e_; ps += e_; } } \
                      pw.x = cvt_pk_bf16(acc[2 * (h)][0], acc[2 * (h)][1]); pw.y = cvt_pk_bf16(acc[2 * (h)][2], acc[2 * (h)][3]); \
                      pw.z = cvt_pk_bf16(acc[2 * (h) + 1][0], acc[2 * (h) + 1][1]); pw.w = cvt_pk_bf16(acc[2 * (h) + 1][2], acc[2 * (h) + 1][3]); }
#pragma unroll
        for (int b = 0; b < 3; ++b) {
            const bool sel = (bmw[b] >> (j & 31)) & 1u;
            const int lim = tqv[b] - kb;
            const bool l_any = sel && lim >= 0, l_full = sel && lim >= 63;
            if (__any(l_any)) {
                f32x4 acc[4]; bf16x8 kr[8]; s16x4 va[4][2], vc[4][2];
#define KRD(i) asm volatile("ds_read_b128 %0, %1 offset:%2" : "=v"(kr[(i) & 7]) : "v"(kadr), "n"(64 * ((i) >> 2) + 256 * ((i) & 3)))
#define KWT(n, i) asm volatile("s_waitcnt lgkmcnt(" #n ")" : "+v"(kr[(i) & 7]))
#define KMM(i) acc[(i) & 3] = __builtin_amdgcn_mfma_f32_16x16x32_bf16(kr[(i) & 7], qf[b][(i) >> 2], (i) < 4 ? (f32x4){0.f, 0.f, 0.f, 0.f} : acc[(i) & 3], 0, 0, 0)
                KRD(0); KRD(1); KRD(2); KRD(3); KRD(4); KRD(5); KRD(6); KRD(7);
#define SB_ __builtin_amdgcn_sched_barrier(0)
                SB_; KWT(7, 0); KMM(0); SB_; KRD(8);  KWT(7, 1); KMM(1); SB_; KRD(9);  KWT(7, 2); KMM(2); SB_; KRD(10); KWT(7, 3); KMM(3); SB_; KRD(11);
                KWT(7, 4); KMM(4); SB_; KRD(12); KWT(7, 5); KMM(5); SB_; KRD(13); KWT(7, 6); KMM(6); SB_; KRD(14); KWT(7, 7); KMM(7); SB_; KRD(15);
                KWT(7, 8); KMM(8); SB_; KWT(6, 9); KMM(9); SB_; KWT(5, 10); KMM(10); SB_; KWT(4, 11); KMM(11); SB_; KWT(3, 12); KMM(12); SB_; KWT(2, 13); KMM(13); SB_; KWT(1, 14); KMM(14); SB_; KWT(0, 15); KMM(15);
#undef SB_
                __builtin_amdgcn_sched_barrier(0);
#undef KRD
#undef KWT
#undef KMM
                VLOAD(va, 0, 0)
                VLOAD(vc, 0, 1)
                const bool uni = __all(l_full || !l_any);
                const float off = (uni && !l_any) ? -1.0e30f : negBC;
                const int lim4 = l_any ? lim - 4 * fq : -1;
                float ps = 0.f;
                u32x4 pw0, pw1;
                EXPH(0, pw0)
                const bf16x8 pa0 = *reinterpret_cast<bf16x8*>(&pw0);
                __builtin_amdgcn_sched_barrier(0);
                VWAIT(8, va);
                PVMMA(va, pa0, 0)
                __builtin_amdgcn_sched_barrier(0);
                VLOAD(va, 1, 0)
                VWAIT(8, vc);
                PVMMA(vc, pa0, 1)
                __builtin_amdgcn_sched_barrier(0);
                VLOAD(vc, 1, 1)
                EXPH(1, pw1)
                const bf16x8 pa1 = *reinterpret_cast<bf16x8*>(&pw1);
                lsum[b] += ps;
                __builtin_amdgcn_sched_barrier(0);
                VWAIT(8, va);
                PVMMA(va, pa1, 0)
                __builtin_amdgcn_sched_barrier(0);
                VWAIT(0, vc);
                PVMMA(vc, pa1, 1)
                __builtin_amdgcn_sched_barrier(0);
            }
        }
#undef TRA
#undef VWAIT
#undef EXPH
#undef KF16
#undef VLOAD
#undef PVMMA
        if (((j + 1) & 31) == 0 && j + 1 < j1) {
#pragma unroll
            for (int b = 0; b < 3; ++b) bmw[b] = a.BM[((size_t)TQC(b) * 4 + g) * 8 + ((j + 1) >> 5)];
            asm volatile("s_waitcnt vmcnt(0)" : "+v"(bmw[0]), "+v"(bmw[1]), "+v"(bmw[2]) :: "memory"); }
        { const int step = buf == 3 ? -3 * SLC_BUF : SLC_BUF; kadr += step; vadr += step; asm volatile("" : "+v"(kadr), "+v"(vadr)); }
    }
#undef ISSUE16
    int fqe = fq, fre = fr; asm volatile("" : "+v"(fqe), "+v"(fre));
    float grow[3];
#pragma unroll
    for (int b = 0; b < 3; ++b) grow[b] = a.G[(size_t)TQC(b) * NGATE + (g * HPG + (16 * b + fre) % 6) * 3 + 1];
#pragma unroll
    for (int b = 0; b < 3; ++b) { float ls = lsum[b]; ls += __shfl_xor(ls, 16); ls += __shfl_xor(ls, 32);
        if (fqe == 0) { li_l[b * 32 + fre] = ls; li_l[b * 32 + 16 + fre] = grow[b]; } }
    asm volatile("s_waitcnt lgkmcnt(0)" ::: "memory");
#pragma unroll
    for (int b = 0; b < 3; ++b) {
        float pv_[4][8]; float gtv[4];
#pragma unroll
        for (int i = 0; i < 4; ++i) { const int q = 4 * fqe + i, R = 16 * b + q; const float lv = li_l[b * 32 + q]; gtv[i] = li_l[b * 32 + 16 + q] * (lv > 0.f ? __builtin_amdgcn_rcpf(lv) : 0.f);
            const int t = t0 + wid * 8 + R / 6, h = g * HPG + R % 6;
            const bf16_t* oc = (const bf16_t*)a.OACC + (size_t)t * 3072 + h * HD + fre; const bf16_t* ow = oc + (size_t)S_ * 3072;
            bf16_t c_[8], w_[8];
#pragma unroll
            for (int c = 0; c < 8; ++c) { c_[c] = oc[c * 16]; w_[c] = ow[c * 16]; }
#pragma unroll
            for (int c = 0; c < 8; ++c) pv_[i][c] = bf2f(c_[c]) + bf2f(w_[c]); }
#pragma unroll
        for (int i = 0; i < 4; ++i) { const int R = 16 * b + 4 * fqe + i; const int t = t0 + wid * 8 + R / 6, h = g * HPG + R % 6;
            bf16_t* mp = a.MIX + (size_t)t * DM + POOLW + h * HD + fre;
#pragma unroll
            for (int c = 0; c < 8; ++c) mp[c * 16] = (bf16_t)(cvt_pk_bf16(pv_[i][c] + o[b][c][i] * gtv[i], 0.f) & 0xffffu); }
    }
#undef TQC
#undef HQ
}

__device__ __forceinline__ void imp_task(const AttnArgs& a, float* IMPP, float* IMPF, int tqi, int g) {
    const int lane = threadIdx.x & 63, fr = lane & 15, fq = lane >> 4;
    const int t = tqi * 16 + fr;
    const int tmax = tqi * 16 + 15;
    if (tmax < 31) return;
    const int lim = t >= 31 ? ((t - 31) >> 4) : -1;
    const int nstep = ((((tmax - 31) >> 4) >> 6) + 1) * 4;
    const float negBC = -a.TAB[512];
    bf16x8 qf[HPG][4]; float rl[HPG];
#pragma unroll
    for (int h = 0; h < HPG; ++h) {
        const bf16_t* qp = a.Z + (size_t)t * LDZ + OFF_Q + (g * HPG + h) * HD + fq * 8;
#pragma unroll
        for (int ks = 0; ks < 4; ++ks) qf[h][ks] = *reinterpret_cast<const bf16x8*>(qp + ks * 32);
        const float lv = a.L[(size_t)t * NH + g * HPG + h]; rl[h] = lv > 0.f ? 1.0f / lv : 0.f;
    }
    const bf16_t* kbase = a.KC + (size_t)g * 1024 * HD + (size_t)fr * HD + fq * 8;
    bf16x8 kf[4], kn[4], kn2[4];
#pragma unroll
    for (int ks = 0; ks < 4; ++ks) { kf[ks] = *reinterpret_cast<const bf16x8*>(kbase + ks * 32); kn[ks] = *reinterpret_cast<const bf16x8*>(kbase + (size_t)(nstep > 1 ? 1 : 0) * 16 * HD + ks * 32); }
    float* op = IMPP + ((size_t)t * 4 + g) * 256 + fq; float* of = IMPF + ((size_t)t * 4 + g) * 256 + fq;
    for (int st = 0; st < nstep; ++st) {
        const int sn = (st + 2 < nstep) ? st + 2 : nstep - 1;
#pragma unroll
        for (int ks = 0; ks < 4; ++ks) kn2[ks] = *reinterpret_cast<const bf16x8*>(kbase + (size_t)sn * 16 * HD + ks * 32);
        f32x4 imp4 = {0.f, 0.f, 0.f, 0.f};
        const int n0 = st * 16 + fq * 4;
#pragma unroll
        for (int h = 0; h < HPG; ++h) {
            f32x4 acc = {0.f, 0.f, 0.f, 0.f};
#pragma unroll
            for (int ks = 0; ks < 4; ++ks) acc = __builtin_amdgcn_mfma_f32_16x16x32_bf16(kf[ks], qf[h][ks], acc, 0, 0, 0);
#pragma unroll
            for (int i = 0; i < 4; ++i) { const float e = __builtin_amdgcn_exp2f(fmaf(acc[i], SM_C, negBC)) * rl[h]; imp4[i] += (n0 + i <= lim) ? e : 0.f; }
        }
        op[st * 4] = imp4[0] + 2.0f * (imp4[1] + imp4[2] + imp4[3]);
        of[st * 4] = imp4[0];
#pragma unroll
        for (int ks = 0; ks < 4; ++ks) { kf[ks] = kn[ks]; kn[ks] = kn2[ks]; }
    }
}

__device__ __forceinline__ void topk_load(const float* IMPP, const float* IMPF, int t, int g, f32x4& pp, f32x4& ff) {
    const int lane = threadIdx.x & 63, cur = t >> 6, jb = lane * 4;
    pp = (f32x4){0.f, 0.f, 0.f, 0.f}; ff = pp;
    if (cur > 15 && jb <= cur) { const size_t base = ((size_t)t * 4 + g) * 256; pp = *(const f32x4*)(IMPP + base + jb); ff = *(const f32x4*)(IMPF + base + jb); }
}
__device__ __forceinline__ void topk_task(const f32x4 pp, const f32x4 ff, unsigned* BM, int t, int g) {
    const int lane = threadIdx.x & 63;
    const int cur = t >> 6;
    unsigned nib = 0u;
    if (cur <= 15) { const int jb = lane * 4;
#pragma unroll
        for (int c = 0; c < 4; ++c) if (jb + c <= cur) nib |= 1u << c; }
    else {
        const int jb = lane * 4;
        unsigned key[4];
        {
            float fnext = __shfl_down(ff[0], 1);
            if (lane == 63) fnext = 0.f;
            const float v0 = pp[0] + ff[1], v1 = pp[1] + ff[2], v2 = pp[2] + ff[3], v3 = pp[3] + fnext;
            key[0] = (jb + 0 >= 1 && jb + 0 <= cur - 2) ? __float_as_uint(fmaxf(v0, 0.f)) + 1u : 0u;
            key[1] = (jb + 1 >= 1 && jb + 1 <= cur - 2) ? __float_as_uint(fmaxf(v1, 0.f)) + 1u : 0u;
            key[2] = (jb + 2 >= 1 && jb + 2 <= cur - 2) ? __float_as_uint(fmaxf(v2, 0.f)) + 1u : 0u;
            key[3] = (jb + 3 >= 1 && jb + 3 <= cur - 2) ? __float_as_uint(fmaxf(v3, 0.f)) + 1u : 0u;
        }
        unsigned prefix = 0u; bool exact = false;
        for (int b = 30; b >= 0; --b) {
            const unsigned trial = prefix | (1u << b);
            const int cnt = __popcll(__ballot(key[0] >= trial)) + __popcll(__ballot(key[1] >= trial)) + __popcll(__ballot(key[2] >= trial)) + __popcll(__ballot(key[3] >= trial));
            if (cnt >= 13) { prefix = trial; if (cnt == 13) { exact = true; break; } }
        }
#pragma unroll
        for (int c = 0; c < 4; ++c) if (exact ? (key[c] >= prefix) : (key[c] > prefix)) nib |= 1u << c;
        if (!exact) {
            int need = 13 - (__popcll(__ballot(key[0] > prefix)) + __popcll(__ballot(key[1] > prefix)) + __popcll(__ballot(key[2] > prefix)) + __popcll(__ballot(key[3] > prefix)));
            unsigned tie = 0u;
#pragma unroll
            for (int c = 0; c < 4; ++c) if (key[c] == prefix) tie |= 1u << c;
            for (int guard = 0; need > 0 && guard < 16; ++guard) {
                const unsigned long long any = __ballot(tie != 0u);
                if (any == 0ull) break;
                const int L = __builtin_ctzll(any);
                if (lane == L) { const unsigned low = tie & (0u - tie); nib |= low; tie ^= low; }
                --need;
            }
        }
        if (lane == 0) nib |= 1u;
        if (lane == (cur >> 2)) nib |= 1u << (cur & 3);
        if (lane == ((cur - 1) >> 2)) nib |= 1u << ((cur - 1) & 3);
    }
    unsigned x = nib << (4 * (lane & 7));
    x |= __shfl_xor(x, 1); x |= __shfl_xor(x, 2); x |= __shfl_xor(x, 4);
    if ((lane & 7) == 0) BM[((size_t)t * 4 + g) * 8 + (lane >> 3)] = x;
}
#undef KSWZ
}

template <bool FFN_REMAP = false>
__device__ __forceinline__ void convT(const float* __restrict__ src0, int K, int N, bf16_t* __restrict__ dst, int ldd, LAS float* tile, int bid, int nb, int Nfull = 0, int n0 = 0) {
    const float* __restrict__ src = src0 + n0; if (Nfull == 0) Nfull = N;
    const int tid = threadIdx.x, tk = K >> 6, tn = (N + 63) >> 6, total = tk * tn;
    const int r = tid >> 4, c4 = (tid & 15) * 4;
    f32x4 v[2] = {{0.f, 0.f, 0.f, 0.f}, {0.f, 0.f, 0.f, 0.f}}, vn[2];
    if (bid < total) { const int nti = bid % tn, kti = bid / tn, ng = nti * 64 + c4;
#pragma unroll
        for (int h = 0; h < 2; ++h) if (ng < N) v[h] = *(const f32x4*)(src + (size_t)(kti * 64 + r + h * 32) * Nfull + ng); }
    for (int idx = bid; idx < total; idx += nb) {
        const int nti = idx % tn, kti = idx / tn;
#pragma unroll
        for (int h = 0; h < 2; ++h) { LAS float* tp = tile + (r + h * 32) * 65 + c4; tp[0] = v[h][0]; tp[1] = v[h][1]; tp[2] = v[h][2]; tp[3] = v[h][3]; }
        {
            const int nx = idx + nb; vn[0] = (f32x4){0.f, 0.f, 0.f, 0.f}; vn[1] = vn[0];
            if (nx < total) { const int nti2 = nx % tn, kti2 = nx / tn, ng2 = nti2 * 64 + c4;
#pragma unroll
                for (int h = 0; h < 2; ++h) if (ng2 < N) vn[h] = *(const f32x4*)(src + (size_t)(kti2 * 64 + r + h * 32) * Nfull + ng2); } }
        __syncthreads();
        const int n = tid >> 3, k8 = (tid & 7) * 8, ngl = nti * 64 + n;
        float e[8];
#pragma unroll
        for (int i = 0; i < 8; ++i) e[i] = tile[(k8 + i) * 65 + n];
        if (ngl < N) { u32x4 w; w.x = cvt_pk_bf16(e[0], e[1]); w.y = cvt_pk_bf16(e[2], e[3]); w.z = cvt_pk_bf16(e[4], e[5]); w.w = cvt_pk_bf16(e[6], e[7]);
            int drow = ngl; if (FFN_REMAP) { const int up = ngl >= DFF ? 1 : 0, f = ngl - up * DFF; drow = (f >> 7) * 256 + up * 128 + (f & 127); }
            *(u32x4*)(dst + (size_t)drow * ldd + kti * 64 + k8) = w; }
        __syncthreads();
        v[0] = vn[0]; v[1] = vn[1];
    }
}
__device__ __forceinline__ void convT8(const float* __restrict__ src0, int K, int N, unsigned char* __restrict__ dst, int ldd, float scale, LAS float* tile, int bid, int nb, int Nfull = 0, int n0 = 0) {
    const float* __restrict__ src = src0 + n0; if (Nfull == 0) Nfull = N;
    const int tid = threadIdx.x, tk = K >> 6, tn = (N + 63) >> 6, total = tk * tn;
    const int r = tid >> 4, c4 = (tid & 15) * 4;
    f32x4 v[2] = {{0.f, 0.f, 0.f, 0.f}, {0.f, 0.f, 0.f, 0.f}}, vn[2];
    if (bid < total) { const int nti = bid % tn, kti = bid / tn, ng = nti * 64 + c4;
#pragma unroll
        for (int h = 0; h < 2; ++h) if (ng < N) v[h] = *(const f32x4*)(src + (size_t)(kti * 64 + r + h * 32) * Nfull + ng); }
    for (int idx = bid; idx < total; idx += nb) {
        const int nti = idx % tn, kti = idx / tn;
#pragma unroll
        for (int h = 0; h < 2; ++h) { LAS float* tp = tile + (r + h * 32) * 65 + c4; tp[0] = v[h][0]; tp[1] = v[h][1]; tp[2] = v[h][2]; tp[3] = v[h][3]; }
        { const int nx = idx + nb; vn[0] = (f32x4){0.f, 0.f, 0.f, 0.f}; vn[1] = vn[0];
            if (nx < total) { const int nti2 = nx % tn, kti2 = nx / tn, ng2 = nti2 * 64 + c4;
#pragma unroll
                for (int h = 0; h < 2; ++h) if (ng2 < N) vn[h] = *(const f32x4*)(src + (size_t)(kti2 * 64 + r + h * 32) * Nfull + ng2); } }
        __syncthreads();
        const int n = tid >> 3, k8 = (tid & 7) * 8, ngl = nti * 64 + n;
        float e[8];
#pragma unroll
        for (int i = 0; i < 8; ++i) e[i] = tile[(k8 + i) * 65 + n] * scale;
        if (ngl < N) { int p0 = __builtin_amdgcn_cvt_pk_fp8_f32(e[0], e[1], 0, false); p0 = __builtin_amdgcn_cvt_pk_fp8_f32(e[2], e[3], p0, true);
            int p1 = __builtin_amdgcn_cvt_pk_fp8_f32(e[4], e[5], 0, false); p1 = __builtin_amdgcn_cvt_pk_fp8_f32(e[6], e[7], p1, true);
            *(u32x2*)(dst + (size_t)ngl * ldd + kti * 64 + k8) = (u32x2){(unsigned)p0, (unsigned)p1}; }
        __syncthreads();
        v[0] = vn[0]; v[1] = vn[1];
    }
}
__device__ __forceinline__ void rmsnorm_rows(const float* __restrict__ src, const float* __restrict__ w, bf16_t* __restrict__ dst, int rows, int gw, int nw, unsigned char* __restrict__ dst8 = nullptr) {
    const int lane = threadIdx.x & 63;
    f32x4 v[16], vn[16];
    if (gw < rows) { const f32x4* sp = (const f32x4*)(src + (size_t)gw * DM);
#pragma unroll
        for (int i = 0; i < 16; ++i) v[i] = sp[lane + 64 * i]; }
    for (int row = gw; row < rows; row += nw) {
        const int nr = row + nw < rows ? row + nw : row;
        { const f32x4* sp = (const f32x4*)(src + (size_t)nr * DM);
#pragma unroll
          for (int i = 0; i < 16; ++i) vn[i] = sp[lane + 64 * i]; }
        float ss = 0.f;
#pragma unroll
        for (int i = 0; i < 16; ++i) ss += v[i][0] * v[i][0] + v[i][1] * v[i][1] + v[i][2] * v[i][2] + v[i][3] * v[i][3];
        ss = wave_sum(ss);
        const float rstd = rsqrtf(ss * (1.0f / DM) + EPS);
#pragma unroll
        for (int i = 0; i < 16; ++i) { const f32x4 ww = ((const f32x4*)w)[lane + 64 * i];
            u32x2 o; o.x = cvt_pk_bf16(v[i][0] * rstd * ww[0], v[i][1] * rstd * ww[1]); o.y = cvt_pk_bf16(v[i][2] * rstd * ww[2], v[i][3] * rstd * ww[3]);
            *(u32x2*)(dst + (size_t)row * DM + (lane + 64 * i) * 4) = o;
            if (dst8) { int pk = __builtin_amdgcn_cvt_pk_fp8_f32(v[i][0] * rstd * ww[0], v[i][1] * rstd * ww[1], 0, false); pk = __builtin_amdgcn_cvt_pk_fp8_f32(v[i][2] * rstd * ww[2], v[i][3] * rstd * ww[3], pk, true);
                *(int*)(dst8 + (size_t)row * DM + (lane + 64 * i) * 4) = pk; } }
#pragma unroll
        for (int i = 0; i < 16; ++i) v[i] = vn[i];
    }
}

struct Ptrs {
    bf16_t *Win, *Wo, *Wfi, *Wfo, *Wg, *Wple, *Wpool, *Wc1k, *Wc1v, *XN, *PB, *Z, *M, *KC, *VC, *MIX, *ACT, *ERAW;
    float *COS, *SIN, *TAB, *G, *H1, *L, *OACC, *IMPP, *IMPF, *ERSTD; unsigned* BM;
};

__device__ __forceinline__ void phase_prologue(const Params& P, const Ptrs& W, LAS unsigned char* lds) {
    const int bid = blockIdx.x, nb = gridDim.x, tid = threadIdx.x, lane = tid & 63, wv = tid >> 6;
    const int gw = bid * NWAVES + wv, nw = nb * NWAVES; const size_t gt = (size_t)bid * NTHREADS + tid, ntot = (size_t)nb * NTHREADS;
    LAS float* tile = (LAS float*)lds;
    rmsnorm_rows(P.x, P.norm1_w, W.XN, S_, gw, nw, P.ws + WS_XN8);
    convT(P.w_in, DM, POOLW, W.Win, DM, tile, bid, nb, INW, 0);
    convT(P.w_in, DM, INW - OFF_G, W.Win + (size_t)OFF_G * DM, DM, tile, bid, nb, INW, OFF_G);
    convT8(P.w_in, DM, OFF_G - POOLW, P.ws + WS_WIN8, DM, WG8_SCALE, tile, bid, nb, INW, POOLW);
    for (size_t i = gt; i < (size_t)(LDZ - INW) * DM / 8; i += ntot) *(u32x4*)(W.Win + (size_t)INW * DM + i * 8) = (u32x4){0u, 0u, 0u, 0u};
    convT(P.w_o, DM, DM, W.Wo, DM, tile, bid, nb);
    convT<true>(P.w_ffn_in, DM, NFI, W.Wfi, DM, tile, bid, nb);
    for (size_t i = gt; i < (size_t)2 * DM / 8; i += ntot) *(u32x4*)(W.XN - 2 * DM + i * 8) = (u32x4){0u, 0u, 0u, 0u};
    convT(P.w_ffn_out, DFF, DM, W.Wfo, DFF, tile, bid, nb);
    convT8(P.w_ple_gate, DM, DM, (unsigned char*)W.Wg, DM, WG8_SCALE, tile, bid, nb);
    convT(P.w_ple_proj, PLE, DM, W.Wple, PLE, tile, bid, nb);
    for (int g = 0; g < 4; ++g) convT(P.w_pool + (size_t)g * 65536, 256, 256, W.Wpool + (size_t)g * 65536, 256, tile, bid, nb);
    convT(P.cmp_k_w1, 4096, 256, W.Wc1k, 4096, tile, bid, nb);
    convT(P.cmp_v_w1, 4096, 256, W.Wc1v, 4096, tile, bid, nb);
    { constexpr size_t NP8 = (size_t)S_ * PLE / 8;
      for (size_t ib = gt; ib < NP8; ib += 4 * ntot) { f32x4 av[4], bv[4];
#pragma unroll
          for (int k = 0; k < 4; ++k) { size_t i = ib + k * ntot; if (i >= NP8) i = NP8 - 1; av[k] = *(const f32x4*)(P.p + i * 8); bv[k] = *(const f32x4*)(P.p + i * 8 + 4); }
#pragma unroll
          for (int k = 0; k < 4; ++k) { const size_t i = ib + k * ntot; if (i < NP8) { u32x4 w; w.x = cvt_pk_bf16(av[k][0], av[k][1]); w.y = cvt_pk_bf16(av[k][2], av[k][3]); w.z = cvt_pk_bf16(bv[k][0], bv[k][1]); w.w = cvt_pk_bf16(bv[k][2], bv[k][3]); *(u32x4*)(W.PB + i * 8) = w; } } } }
    for (size_t i = gt; i < (size_t)S_ * 16; i += ntot) { const int t = (int)(i >> 4), fi = (int)(i & 15);
        const float inv = exp2f(-(float)fi * (18.931568569324174f / 16.0f)); const float ang = (float)P.positions[t] * inv;
        const double ad = (double)ang; const double kk = rint(ad * 0.15915494309189535); const float rf = (float)(ad - kk * 6.283185307179586);
        W.COS[i] = __cosf(rf); W.SIN[i] = __sinf(rf); }
    for (int task = gw; task < 128; task += nw) { const int which = task >> 6, r0 = (task & 63) * 64; const float* pe = which ? P.cmp_pos_v : P.cmp_pos_k; const float* w1 = which ? P.cmp_v_w1 : P.cmp_k_w1;
        f32x4 s = {0.f, 0.f, 0.f, 0.f};
#pragma unroll 8
        for (int r = 0; r < 64; ++r) { const f32x4 wv = *(const f32x4*)(w1 + (size_t)(r0 + r) * 256 + lane * 4); s += wv * pe[r0 + r]; }
        float* cbp = (float*)(P.ws + WS_CBIAS) + which * 256 + lane * 4;
        unsafeAtomicAdd(cbp + 0, s[0]); unsafeAtomicAdd(cbp + 1, s[1]); unsafeAtomicAdd(cbp + 2, s[2]); unsafeAtomicAdd(cbp + 3, s[3]); }
    if (gw == 0) { float mq = fmaxf(fabsf(P.q_norm_w[lane]), fabsf(P.q_norm_w[lane + 64])); mq = wave_max(mq);
        float mc = wave_max(fmaxf(fabsf(P.k_norm_cmp_w[lane]), fabsf(P.k_norm_cmp_w[lane + 64])));
        float ms = wave_max(fmaxf(fabsf(P.k_norm_slc_w[lane]), fabsf(P.k_norm_slc_w[lane + 64])));
        float mw = wave_max(fmaxf(fabsf(P.k_norm_win_w[lane]), fabsf(P.k_norm_win_w[lane + 64])));
        const float c = 11.313708498984761f * 1.4426950408889634f * mq * 1.01f;
        if (lane == 0) { W.TAB[512] = c * mc; W.TAB[513] = c * ms; W.TAB[514] = c * mw; } }
}

__device__ __forceinline__ void phase_postz(const Params& P, const Ptrs& W, int gw, int nw) {
    const int tid = threadIdx.x, lane = tid & 63;
    const f32x2 wq = *(const f32x2*)(P.q_norm_w + 2 * lane), wks = *(const f32x2*)(P.k_norm_slc_w + 2 * lane), wkw = *(const f32x2*)(P.k_norm_win_w + 2 * lane);
    for (int t = gw; t < S_; t += nw) {
        bf16_t* zr = W.Z + (size_t)t * LDZ;
        float cs0 = 0.f, cs1 = 0.f, sn0 = 0.f, sn1 = 0.f;
        if (lane < 16) { const int i0 = (2 * lane) & 15; cs0 = W.COS[t * 16 + i0]; cs1 = W.COS[t * 16 + i0 + 1]; sn0 = W.SIN[t * 16 + i0]; sn1 = W.SIN[t * 16 + i0 + 1]; }
        unsigned uv[32];
#pragma unroll
        for (int v = 0; v < 32; ++v) { const int col = v < 24 ? OFF_Q + v * HD : (v < 28 ? OFF_KV + 2 * 512 + (v - 24) * HD : OFF_KV + 4 * 512 + (v - 28) * HD);
            uv[v] = *((const unsigned*)(zr + col) + lane); }
#pragma unroll
        for (int v = 0; v < 32; ++v) {
            const f32x2 ww = v < 24 ? wq : (v < 28 ? wks : wkw);
            const unsigned u = uv[v]; const float x0 = bf_lo(u), x1 = bf_hi(u);
            const float ss = wave_sum(x0 * x0 + x1 * x1);
            const float rstd = rsqrtf(ss * (1.0f / HD) + EPS);
            float y0 = x0 * rstd * ww[0], y1 = x1 * rstd * ww[1];
            const float p0 = __shfl_xor(y0, 8), p1 = __shfl_xor(y1, 8);
            if (lane < 8) { y0 = y0 * cs0 - p0 * sn0; y1 = y1 * cs1 - p1 * sn1; }
            else if (lane < 16) { y0 = y0 * cs0 + p0 * sn0; y1 = y1 * cs1 + p1 * sn1; }
            uv[v] = cvt_pk_bf16(y0, y1);
        }
        {
            const int gi = lane >> 4, wlen = 2 << gi, c0 = lane * 16; const int cnt = (t + 1) < wlen ? (t + 1) : wlen;
            float s[16];
#pragma unroll
            for (int i = 0; i < 16; ++i) s[i] = 0.f;
            float cur[16];
#pragma unroll
            for (int bt = 0; bt < 2; ++bt) {
                u32x4 ra[8], rb[8];
#pragma unroll
                for (int i = 0; i < 8; ++i) { const int ii = bt * 8 + i; const size_t row = (size_t)(ii < cnt ? t - ii : t);
                    ra[i] = *(const u32x4*)(W.Z + row * LDZ + c0); rb[i] = *(const u32x4*)(W.Z + row * LDZ + c0 + 8); }
#pragma unroll
                for (int i = 0; i < 8; ++i) { const int ii = bt * 8 + i; const float mk = ii < cnt ? 1.0f : 0.0f; const u32x4 a = ra[i], b = rb[i];
                    const float ev[16] = {bf_lo(a.x), bf_hi(a.x), bf_lo(a.y), bf_hi(a.y), bf_lo(a.z), bf_hi(a.z), bf_lo(a.w), bf_hi(a.w), bf_lo(b.x), bf_hi(b.x), bf_lo(b.y), bf_hi(b.y), bf_lo(b.z), bf_hi(b.z), bf_lo(b.w), bf_hi(b.w)};
#pragma unroll
                    for (int q = 0; q < 16; ++q) { s[q] += ev[q] * mk; if (ii == 0) cur[q] = ev[q]; } }
                if (bt == 0 && __all(cnt <= 8)) break;
            }
            const float rc = 1.0f / (float)cnt;
            u32x4 o0, o1;
            o0.x = cvt_pk_bf16(s[0] * rc - cur[0], s[1] * rc - cur[1]); o0.y = cvt_pk_bf16(s[2] * rc - cur[2], s[3] * rc - cur[3]);
            o0.z = cvt_pk_bf16(s[4] * rc - cur[4], s[5] * rc - cur[5]); o0.w = cvt_pk_bf16(s[6] * rc - cur[6], s[7] * rc - cur[7]);
            o1.x = cvt_pk_bf16(s[8] * rc - cur[8], s[9] * rc - cur[9]); o1.y = cvt_pk_bf16(s[10] * rc - cur[10], s[11] * rc - cur[11]);
            o1.z = cvt_pk_bf16(s[12] * rc - cur[12], s[13] * rc - cur[13]); o1.w = cvt_pk_bf16(s[14] * rc - cur[14], s[15] * rc - cur[15]);
            *(u32x4*)(W.M + (size_t)t * POOLW + c0) = o0; *(u32x4*)(W.M + (size_t)t * POOLW + c0 + 8) = o1;
        }
#pragma unroll
        for (int v = 0; v < 32; ++v) { const int col = v < 24 ? OFF_Q + v * HD : (v < 28 ? OFF_KV + 2 * 512 + (v - 24) * HD : OFF_KV + 4 * 512 + (v - 28) * HD);
            *((unsigned*)(zr + col) + lane) = uv[v]; }

    }
}

__device__ __forceinline__ void phase_cmpfin(const Params& P, const Ptrs& W) {
    const int tid = threadIdx.x, lane = tid & 63, gw = blockIdx.x * NWAVES + (tid >> 6), nw = gridDim.x * NWAVES;
    const f32x2 wk = *(const f32x2*)(P.k_norm_cmp_w + 2 * lane);
    for (int task = gw; task < 8192; task += nw) {
        const int tk = __builtin_amdgcn_readfirstlane(task);
        const int which = tk >> 12, g = (tk >> 10) & 3, n = tk & 1023;
        bf16_t* dst = (which ? W.VC : W.KC) + ((size_t)g * 1024 + n) * HD;
        if (n == 1023) { ((unsigned*)dst)[lane] = 0u; continue; }
        const float* h = W.H1 + (size_t)tk * 256; const float* w2 = which ? P.cmp_v_w2 : P.cmp_k_w2;
        float a0 = 0.f, a1 = 0.f;
        for (int j = 0; j < 256; ++j) { const float hj = h[j]; const f32x2 wv = *(const f32x2*)(w2 + j * HD + 2 * lane); a0 += hj * wv[0]; a1 += hj * wv[1]; }
        if (which == 0) {
            const float ss = wave_sum(a0 * a0 + a1 * a1); const float rstd = rsqrtf(ss * (1.0f / HD) + EPS);
            a0 = a0 * rstd * wk[0]; a1 = a1 * rstd * wk[1];
            const int tp = 16 * n + 31; const float p0 = __shfl_xor(a0, 8), p1 = __shfl_xor(a1, 8);
            if (lane < 16) { const int i0 = (2 * lane) & 15; const float cs0 = W.COS[tp * 16 + i0], cs1 = W.COS[tp * 16 + i0 + 1], sn0 = W.SIN[tp * 16 + i0], sn1 = W.SIN[tp * 16 + i0 + 1];
                if (lane < 8) { a0 = a0 * cs0 - p0 * sn0; a1 = a1 * cs1 - p1 * sn1; } else { a0 = a0 * cs0 + p0 * sn0; a1 = a1 * cs1 + p1 * sn1; } }
        }
        ((unsigned*)dst)[lane] = cvt_pk_bf16(a0, a1);
    }
}

__device__ __forceinline__ void phase_erstd(const Ptrs& W) {
    const int tid = threadIdx.x, lane = tid & 63, gw = blockIdx.x * NWAVES + (tid >> 6), nw = gridDim.x * NWAVES;
    u32x4 a[8], an[8];
    if (gw < S_) { const u32x4* sp = (const u32x4*)(W.ERAW + (size_t)gw * DM);
#pragma unroll
        for (int i = 0; i < 8; ++i) a[i] = sp[lane + 64 * i]; }
    for (int row = gw; row < S_; row += nw) {
        const int nr = row + nw < S_ ? row + nw : row;
        { const u32x4* sp = (const u32x4*)(W.ERAW + (size_t)nr * DM);
#pragma unroll
          for (int i = 0; i < 8; ++i) an[i] = sp[lane + 64 * i]; }
        float ss = 0.f;
#pragma unroll
        for (int i = 0; i < 8; ++i) {
            const float e0 = bf_lo(a[i].x), e1 = bf_hi(a[i].x), e2 = bf_lo(a[i].y), e3 = bf_hi(a[i].y), e4 = bf_lo(a[i].z), e5 = bf_hi(a[i].z), e6 = bf_lo(a[i].w), e7 = bf_hi(a[i].w);
            ss += e0 * e0 + e1 * e1 + e2 * e2 + e3 * e3 + e4 * e4 + e5 * e5 + e6 * e6 + e7 * e7; }
        ss = wave_sum(ss);
        if (lane == 0) W.ERSTD[row] = rsqrtf(ss * (1.0f / DM) + EPS);
#pragma unroll
        for (int i = 0; i < 8; ++i) a[i] = an[i];
    }
}

constexpr int N_PHASES = 11;
__device__ __forceinline__ Params kargs() {
#if defined(__HIP_DEVICE_COMPILE__)
    unsigned long long p = (unsigned long long)__builtin_amdgcn_kernarg_segment_ptr();
    asm volatile("" : "+s"(p));
    return *(const __attribute__((address_space(4))) Params*)p;
#else
    return Params{};
#endif
}
__device__ __forceinline__ Ptrs mkptrs(unsigned char* ws) {
    Ptrs W;
    W.Win = (bf16_t*)(ws + WS_WIN); W.Wo = (bf16_t*)(ws + WS_WO); W.Wfi = (bf16_t*)(ws + WS_WFI); W.Wfo = (bf16_t*)(ws + WS_WFO); W.Wg = (bf16_t*)(ws + WS_WG);
    W.Wple = (bf16_t*)(ws + WS_WPLE); W.Wpool = (bf16_t*)(ws + WS_WPOOL); W.Wc1k = (bf16_t*)(ws + WS_WC1K); W.Wc1v = (bf16_t*)(ws + WS_WC1V);
    W.XN = (bf16_t*)(ws + WS_XN); W.PB = (bf16_t*)(ws + WS_PB); W.Z = (bf16_t*)(ws + WS_Z); W.M = (bf16_t*)(ws + WS_M); W.KC = (bf16_t*)(ws + WS_KC); W.VC = (bf16_t*)(ws + WS_VC);
    W.MIX = (bf16_t*)(ws + WS_MIX); W.ACT = (bf16_t*)(ws + WS_ACT); W.ERAW = (bf16_t*)(ws + WS_ERAW);
    W.COS = (float*)(ws + WS_COS); W.SIN = (float*)(ws + WS_SIN); W.TAB = (float*)(ws + WS_TAB); W.G = (float*)(ws + WS_G); W.H1 = (float*)(ws + WS_H1); W.L = (float*)(ws + WS_L);
    W.OACC = (float*)(ws + WS_OACC); W.IMPP = (float*)(ws + WS_IMPP); W.IMPF = (float*)(ws + WS_IMPF); W.ERSTD = (float*)(ws + WS_ERSTD); W.BM = (unsigned*)(ws + WS_BM);
    return W;
}
__global__ void __launch_bounds__(NTHREADS, 2) fwd(Params Punused) {
    extern __shared__ __attribute__((aligned(16))) unsigned char lds_raw[];
    LAS unsigned char* lds = (LAS unsigned char*)lds_raw;
    const int tid = threadIdx.x;
    const int G = gridDim.x, bid = blockIdx.x;
    const int gw = bid * NWAVES + (tid >> 6), nw = G * NWAVES;

    if (tid < 16) ((LAS unsigned*)(lds + LDS_MISC))[tid] = 0u;
    __syncthreads();
    int lo, hi; XcdBarrier bar;
    { const Params P = kargs(); lo = P.ph_lo; hi = P.ph_hi;
      bar.bar = (unsigned*)(P.ws + WS_CTL); bar.x = 0; bar.st = (volatile LAS unsigned*)(lds + LDS_MISC);
      if (hi - lo > 1) bar = xcd_barrier_post((unsigned*)(P.ws + WS_CTL), (volatile LAS unsigned*)(lds + LDS_MISC)); }
#ifdef PH_MASK
#define IN(k) (((PH_MASK >> (k)) & 1) && lo <= (k) && (k) < hi)
#else
#define IN(k) (lo <= (k) && (k) < hi)
#endif
#define SEAM(k) do { if (IN(k) && IN((k) + 1)) xcd_barrier(bar); } while (0)
#define PHASE_VARS const Params P = kargs(); const Ptrs W = mkptrs(P.ws); (void)W;
#define ATT_ARGS att::AttnArgs AA{W.Z, W.KC, W.VC, W.G, W.L, W.OACC, W.MIX, W.BM, W.TAB};

    if (IN(0)) { PHASE_VARS REP(0) { phase_prologue(P, W, lds); } SEAM(0); }
    if (IN(1)) {
        PHASE_VARS
        { pg8::GStd g{(const char*)W.XN, (const char*)W.Win, DM, DM, DM / 64}; pg8::StaticOrder S; S.init(S_ / 256, POOLW / 256, G, bid);
          pg8::EpiBf16 E{W.Z, LDZ}; pg8::gemm_phase(lds, g, S, E); }
        { pg8::GStd g{(const char*)(P.ws + WS_XN8), (const char*)(P.ws + WS_WIN8), DM / 2, DM / 2, DM / 128}; pg8::StaticOrder S; S.init(S_ / 256, (OFF_G - POOLW) / 256, G, bid);
          pg8::EpiBf16S E{W.Z + POOLW, LDZ, 1.0f / WG8_SCALE}; pg8::gemm_phase<pg8::GStd, pg8::EpiBf16S, true>(lds, g, S, E); }
        SEAM(1);
    }
    if (IN(2)) {
        PHASE_VARS
        if (G > 64) {
            if (bid < 32) { pg8::GCmp g{(const char*)W.Z, (const char*)W.Wc1k, (const char*)W.Wc1v, 16 * LDZ, 4096, 64}; pg8::StaticOrder S; S.init(32, 1, 32, bid);
                pg8::EpiCmpGelu E{W.H1, (const float*)(P.ws + WS_CBIAS)}; pg8::gemm_phase(lds, g, S, E); }
            else if (bid < 96) {
                pg8::GStd g{(const char*)W.XN, (const char*)(W.Win + (size_t)OFF_G * DM), DM, DM, DM / 64}; pg8::StaticOrder S; S.init(S_ / 256, 1, 64, bid - 32);
                pg8::EpiBf16 E{W.Z + OFF_G, LDZ}; pg8::gemm_phase(lds, g, S, E); }
            else phase_postz(P, W, (bid - 96) * NWAVES + (tid >> 6), (G - 96) * NWAVES);
        } else {
            { pg8::GStd g{(const char*)W.XN, (const char*)(W.Win + (size_t)OFF_G * DM), DM, DM, DM / 64}; pg8::StaticOrder S; S.init(S_ / 256, 1, G, bid);
              pg8::EpiBf16 E{W.Z + OFF_G, LDZ}; pg8::gemm_phase(lds, g, S, E); }
            { pg8::GCmp g{(const char*)W.Z, (const char*)W.Wc1k, (const char*)W.Wc1v, 16 * LDZ, 4096, 64}; pg8::StaticOrder S; S.init(32, 1, G, bid);
              pg8::EpiCmpGelu E{W.H1, (const float*)(P.ws + WS_CBIAS)}; pg8::gemm_phase(lds, g, S, E); }
            phase_postz(P, W, gw, nw);
        }
        SEAM(2);
    }
    if (IN(3)) {
        PHASE_VARS
        {
            const size_t i0 = (size_t)bid * NTHREADS + tid, st = (size_t)G * NTHREADS, NG = (size_t)S_ * NGATE;
            for (size_t ib = i0; ib < NG; ib += 9 * st) { float zv[9];
#pragma unroll
                for (int k = 0; k < 9; ++k) { size_t i = ib + k * st; if (i >= NG) i = NG - 1; const int t = (int)(i / NGATE), c = (int)(i % NGATE); zv[k] = bf2f(W.Z[(size_t)t * LDZ + OFF_G + c]); }
#pragma unroll
                for (int k = 0; k < 9; ++k) { const size_t i = ib + k * st; if (i < NG) W.G[i] = sigmoidf_(zv[k]); } } }
        phase_cmpfin(P, W);
        { pg8::GPool g{(const char*)W.M, (const char*)W.Wpool, POOLW, 256, 4}; pg8::StaticOrder S; S.init(S_ / 256, 4, G, bid);
          pg8::EpiBf16Scale E{W.MIX, DM, P.pool_scale}; pg8::gemm_phase(lds, g, S, E); }
        SEAM(3);
    }
    if (IN(4)) {
        PHASE_VARS ATT_ARGS
        if ((tid >> 6) < 4) __builtin_amdgcn_s_setprio(2);
        REP(4)
        for (int base = 0, rnd = 0; base < 1536; base += G, ++rnd) {
            int qt, g, hp;
            if (G == 256) { const int x = bid & 7, r = bid >> 3, qp = (rnd / 3) ? 63 - r : r; if (rnd >= 6) break; g = x & 3; qt = 2 * qp + (x >> 2); hp = rnd % 3; }
            else { const int Lu = base + ((rnd & 1) ? G - 1 - bid : bid); if (Lu >= 1536) continue; qt = Lu / 12; const int rem = Lu % 12; g = rem / 3; hp = rem % 3; }
            att::attn_unit<att::MODE_CMP>(AA, (LAS char*)lds, qt, g, hp);
            asm volatile("s_waitcnt vmcnt(0)" ::: "memory");
            att::attn_unit<att::MODE_WIN>(AA, (LAS char*)lds, qt, g, hp);
            if (G == 256 && hp == 2) {
                asm volatile("s_waitcnt vmcnt(0)" ::: "memory");
                const int tqi = qt * 8 + (tid >> 6);
                att::imp_task(AA, W.IMPP, W.IMPF, tqi, g);
                asm volatile("s_waitcnt vmcnt(0)" ::: "memory");
                f32x4 pp, ff, pn, fn; att::topk_load(W.IMPP, W.IMPF, tqi * 16, g, pp, ff);
                for (int q = 0; q < 16; ++q) { att::topk_load(W.IMPP, W.IMPF, tqi * 16 + (q < 15 ? q + 1 : q), g, pn, fn); att::topk_task(pp, ff, W.BM, tqi * 16 + q, g); pp = pn; ff = fn; } } }
        __builtin_amdgcn_s_setprio(0);
        if (G != 256) SEAM(4);
    }
    if (IN(5)) {
        PHASE_VARS ATT_ARGS
        if (G != 256)
        for (int k = gw, r = 0; k < 4096; k += nw, ++r) { const int hiT = (r + 1) * nw < 4096 ? (r + 1) * nw : 4096;
            const int task = (r & 1) ? hiT - 1 - (k - r * nw) : k;
            att::imp_task(AA, W.IMPP, W.IMPF, task >> 2, task & 3);
            asm volatile("s_waitcnt vmcnt(0)" ::: "memory");
            { const int tb = (task >> 2) * 16, gg = task & 3; f32x4 pp, ff, pn, fn;
              att::topk_load(W.IMPP, W.IMPF, tb, gg, pp, ff);
              for (int q = 0; q < 16; ++q) { att::topk_load(W.IMPP, W.IMPF, tb + (q < 15 ? q + 1 : q), gg, pn, fn); att::topk_task(pp, ff, W.BM, tb + q, gg); pp = pn; ff = fn; } } }
        SEAM(5);
    }
    if (IN(6)) {
        PHASE_VARS ATT_ARGS
#if SLC16
        for (int base = 0, rnd = 0; base < 1024 + G; base += G, ++rnd) {
            int ut, g;
            if (G == 256) { const int x = bid & 7, r = bid >> 3, k = rnd * 32 + ((rnd & 1) ? 31 - r : r); if (k >= 128) break; g = x & 3; ut = 255 - (2 * k + (x >> 2)); }
            else { const int Lu = base + ((rnd & 1) ? G - 1 - bid : bid); if (Lu >= 1024) continue; ut = 255 - Lu / 4; g = Lu % 4; }
            att::slc16_unit(AA, (LAS char*)lds, ut, g); }
#else
        REP(6)
        for (int base = 0, rnd = 0; base < 1640 + G; base += G, ++rnd) {
            int ut, g;
            if (G == 256) { const int x = bid & 7, r = bid >> 3, k = rnd * 32 + ((rnd & 1) ? 31 - r : r); if (k >= 205) break; g = x & 3; ut = 409 - (2 * k + (x >> 2)); }
            else { const int Lu = base + ((rnd & 1) ? G - 1 - bid : bid); if (Lu >= 1640) continue; ut = 409 - Lu / 4; g = Lu % 4; }
            att::attn_unit<att::MODE_SLC>(AA, (LAS char*)lds, ut, g, 0); }
#endif
        SEAM(6);
    }
    if (IN(7)) {
        PHASE_VARS
        { pg8::GStd g{(const char*)W.MIX, (const char*)W.Wo, DM, DM, DM / 64}; pg8::StaticOrder S; S.init(S_ / 256, DM / 256, G, bid);
          pg8::EpiResNorm E{P.x, (bf16_t*)(P.ws + WS_HRES), W.XN, P.norm2_w, (float*)(P.ws + WS_SSQ1), DM}; pg8::gemm_phase(lds, g, S, E); }
        { pg8::GStd g{(const char*)W.PB, (const char*)W.Wple, PLE, PLE, PLE / 64}; pg8::StaticOrder S; S.init(S_ / 256, DM / 256, G, bid);
          pg8::EpiBf16Ssq E{W.ERAW, DM, (float*)(P.ws + WS_SSQ3)}; pg8::gemm_phase(lds, g, S, E); }
        SEAM(7);
    }
    if (IN(8)) {
        PHASE_VARS
        pg8::GFfn g{(const char*)W.XN, (const char*)W.Wfi, DM, DM, DM / 64}; pg8::StaticOrder S; S.init(65, DFF / 128, G, bid);
        pg8::EpiFfn E{W.ACT, P.conv_w, P.conv_b, (LAS float*)(lds + LDS_XCH), (const float*)(P.ws + WS_SSQ1)}; REP(8) { pg8::gemm_phase(lds, g, S, E); } SEAM(8);
    }
    if (IN(9)) {
        PHASE_VARS
        pg8::GStd g{(const char*)W.ACT, (const char*)W.Wfo, DFF, DFF, DFF / 64}; pg8::StaticOrder S; S.init(S_ / 256, DM / 256, G, bid);
        pg8::EpiResNormF8 E{P.ws + WS_HRES, (bf16_t*)(P.ws + WS_HRES), W.XN, P.ple_gate_norm_w, (float*)(P.ws + WS_SSQ2), DM}; pg8::gemm_phase(lds, g, S, E); SEAM(9);
    }
    if (IN(10)) {
        PHASE_VARS
        pg8::GStd g{(const char*)W.XN, (const char*)W.Wg, DM / 2, DM / 2, DM / 128}; pg8::StaticOrder S; S.init(S_ / 256, DM / 256, G, bid);
        pg8::EpiGate E{P.out, (const bf16_t*)(P.ws + WS_HRES), W.ERAW, (const float*)(P.ws + WS_SSQ3), P.ple_norm_w, (const float*)(P.ws + WS_SSQ2), DM, 1.0f / WG8_SCALE};
        pg8::gemm_phase<pg8::GStd, pg8::EpiGate, true>(lds, g, S, E);
    }
#undef IN
#undef SEAM
}

extern "C" void kernel_launch(void* const* d_in, const int* in_sizes, int n_in, void* d_out, int out_size, void* d_ws, size_t ws_size, hipStream_t stream) {
    static int grid = 0;
    if (grid == 0) {
        if (n_in != 27 || in_sizes[0] != S_ * DM || out_size != S_ * DM || ws_size < WS_NEED) {
            fprintf(stderr, "kernel_launch: unexpected shapes (n_in %d, in0 %d, out %d, ws %zu < %zu); nothing launched\n", n_in, n_in > 0 ? in_sizes[0] : -1, out_size, ws_size, (size_t)WS_NEED); grid = -1; return; }
        int dev = 0, cus = 0, per_cu = 0;
        if (hipGetDevice(&dev) != hipSuccess || hipDeviceGetAttribute(&cus, hipDeviceAttributeMultiprocessorCount, dev) != hipSuccess) { grid = -1; return; }
        if (hipFuncSetAttribute((const void*)fwd, hipFuncAttributeMaxDynamicSharedMemorySize, LDS_BYTES) != hipSuccess) { fprintf(stderr, "kernel_launch: hipFuncSetAttribute failed\n"); grid = -1; return; }
        if (hipOccupancyMaxActiveBlocksPerMultiprocessor(&per_cu, (const void*)fwd, NTHREADS, LDS_BYTES) != hipSuccess || per_cu < 1) { fprintf(stderr, "kernel_launch: occupancy query says %d\n", per_cu); (void)hipGetLastError(); }
        grid = cus > 256 ? 256 : cus;
    }
    if (grid < 0) return;
    (void)hipMemsetAsync((char*)d_ws + WS_CTL, 0, CTL_BYTES, stream);
    Params P{};
    const float** fp = (const float**)&P;
    P.x = (const float*)d_in[0]; P.p = (const float*)d_in[1]; P.positions = (const int*)d_in[2]; P.norm1_w = (const float*)d_in[3]; P.w_in = (const float*)d_in[4];
    P.w_pool = (const float*)d_in[5]; P.pool_scale = (const float*)d_in[6]; P.q_norm_w = (const float*)d_in[7]; P.k_norm_cmp_w = (const float*)d_in[8];
    P.k_norm_slc_w = (const float*)d_in[9]; P.k_norm_win_w = (const float*)d_in[10]; P.cmp_pos_k = (const float*)d_in[11]; P.cmp_pos_v = (const float*)d_in[12];
    P.cmp_k_w1 = (const float*)d_in[13]; P.cmp_k_w2 = (const float*)d_in[14]; P.cmp_v_w1 = (const float*)d_in[15]; P.cmp_v_w2 = (const float*)d_in[16];
    P.w_o = (const float*)d_in[17]; P.norm2_w = (const float*)d_in[18]; P.w_ffn_in = (const float*)d_in[19]; P.conv_w = (const float*)d_in[20]; P.conv_b = (const float*)d_in[21];
    P.w_ffn_out = (const float*)d_in[22]; P.w_ple_proj = (const float*)d_in[23]; P.ple_norm_w = (const float*)d_in[24]; P.ple_gate_norm_w = (const float*)d_in[25]; P.w_ple_gate = (const float*)d_in[26];
    (void)fp;
    P.out = (float*)d_out; P.ws = (unsigned char*)d_ws;
#if MK_ONE_LAUNCH
    P.ph_lo = 0; P.ph_hi = N_PHASES;
    hipLaunchKernelGGL(fwd, dim3(grid), dim3(NTHREADS), LDS_BYTES, stream, P);
#else
    for (int ph = 0; ph < N_PHASES; ++ph) { P.ph_lo = ph; P.ph_hi = ph + 1; hipLaunchKernelGGL(fwd, dim3(grid), dim3(NTHREADS), LDS_BYTES, stream, P); }
#endif
    const hipError_t le = hipPeekAtLastError();
    if (le != hipSuccess) fprintf(stderr, "kernel_launch: launch failed: %s\n", hipGetErrorName(le));
}
```

```cpp
#include <hip/hip_runtime.h>
#include <cstdio>
#include <cstdint>

#ifndef PROBE_DBL
#define PROBE_DBL 0
#endif
#define REP(k) _Pragma("unroll") for (int rep_ = 0; rep_ < 1 + ((PROBE_DBL >> (k)) & 1); ++rep_)
#ifndef SLC16
#define SLC16 1
#endif
#ifndef MK_ONE_LAUNCH
#define MK_ONE_LAUNCH 1
#endif

#define LAS __attribute__((address_space(3)))
typedef unsigned short bf16_t;
typedef short bf16x8 __attribute__((ext_vector_type(8)));
typedef short s16x4 __attribute__((ext_vector_type(4)));
typedef float f32x2 __attribute__((ext_vector_type(2)));
typedef float f32x4 __attribute__((ext_vector_type(4)));
typedef float f32x16 __attribute__((ext_vector_type(16)));
typedef unsigned u32x2 __attribute__((ext_vector_type(2)));
typedef unsigned u32x4 __attribute__((ext_vector_type(4)));
typedef int i32x4 __attribute__((ext_vector_type(4)));
typedef int i32x8 __attribute__((ext_vector_type(8)));

constexpr int S_ = 16384, DM = 4096, INW = 7240, LDZ = 7424, POOLW = 1024, NH = 24, NKV = 4, HPG = 6, HD = 128;
constexpr int OFF_Q = 1024, OFF_KV = 4096, OFF_G = 7168, DFF = 11008, NFI = 22016, PLE = 256, NGATE = 72;
constexpr int ZROWS = S_ + 64, XNROWS = S_ + 256, CHUNK = 8192;
constexpr float EPS = 1e-6f;
constexpr float SM_C = 0.08838834764831845f * 1.4426950408889634f;
constexpr int NWAVES = 8, NTHREADS = 512;
constexpr float WG8_SCALE = 128.0f;

constexpr size_t al256(size_t x) { return (x + 255) / 256 * 256; }
constexpr size_t WS_CTL   = 0;
constexpr size_t CTL_BYTES = 262144;
constexpr size_t WS_CBIAS = WS_CTL + 32768;
constexpr size_t WS_SSQ1 = WS_CTL + 65536, WS_SSQ2 = WS_CTL + 131072, WS_SSQ3 = WS_CTL + 196608;
constexpr size_t WS_WIN   = WS_CTL + CTL_BYTES;
constexpr size_t WS_WO    = WS_WIN + al256((size_t)LDZ * DM * 2);
constexpr size_t WS_WFI   = WS_WO + al256((size_t)DM * DM * 2);
constexpr size_t WS_WFO   = WS_WFI + al256((size_t)NFI * DM * 2);
constexpr size_t WS_WG    = WS_WFO + al256((size_t)DM * DFF * 2);
constexpr size_t WS_WPLE  = WS_WG + al256((size_t)DM * DM * 2);
constexpr size_t WS_WPOOL = WS_WPLE + al256((size_t)DM * PLE * 2);
constexpr size_t WS_WC1K  = WS_WPOOL + al256((size_t)1024 * 256 * 2);
constexpr size_t WS_WC1V  = WS_WC1K + al256((size_t)256 * 4096 * 2);
constexpr size_t WS_COS   = WS_WC1V + al256((size_t)256 * 4096 * 2);
constexpr size_t WS_SIN   = WS_COS + al256((size_t)S_ * 16 * 4);
constexpr size_t WS_TAB   = WS_SIN + al256((size_t)S_ * 16 * 4);
constexpr size_t WS_XNP   = WS_TAB + 4096;
constexpr size_t WS_XN    = WS_XNP + (size_t)2 * DM * 2;
constexpr size_t WS_PB    = WS_XN + al256((size_t)XNROWS * DM * 2);
constexpr size_t WS_XN8   = WS_PB + al256((size_t)S_ * PLE * 2);
constexpr size_t WS_WIN8  = WS_XN8 + al256((size_t)S_ * DM);
constexpr size_t WS_R     = WS_WIN8 + al256((size_t)(OFF_G - POOLW) * DM);
constexpr size_t WS_Z     = WS_R;
constexpr size_t WS_M     = WS_Z + al256((size_t)ZROWS * LDZ * 2);
constexpr size_t WS_G     = WS_M + al256((size_t)S_ * POOLW * 2);
constexpr size_t WS_H1    = WS_G + al256((size_t)S_ * NGATE * 4);
constexpr size_t WS_KC    = WS_H1 + al256((size_t)8192 * 256 * 4);
constexpr size_t WS_VC    = WS_KC + al256((size_t)4 * 1024 * 128 * 2);
constexpr size_t WS_L     = WS_VC + al256((size_t)4 * 1024 * 128 * 2);
constexpr size_t WS_OACC  = WS_L + al256((size_t)S_ * NH * 4);
constexpr size_t WS_IMPP  = WS_OACC + al256((size_t)S_ * 3072 * 4);
constexpr size_t WS_IMPF  = WS_IMPP + al256((size_t)S_ * 4 * 256 * 4);
constexpr size_t WS_BM    = WS_IMPF + al256((size_t)S_ * 4 * 256 * 4);
constexpr size_t WS_MIX   = WS_BM + al256((size_t)S_ * 4 * 8 * 4);
constexpr size_t WS_END_A = WS_MIX + al256((size_t)S_ * DM * 2);
constexpr size_t WS_ERAW  = WS_R;
constexpr size_t WS_ACT   = WS_ERAW + al256((size_t)S_ * DM * 2);
constexpr size_t WS_ERSTD = WS_ACT + al256((size_t)S_ * DFF * 2);
constexpr size_t WS_END_B = WS_ERSTD + al256((size_t)S_ * 4);
constexpr size_t WS_HRES  = WS_IMPP + (size_t)2 * DM * 2;
static_assert(WS_HRES - (size_t)2 * DM * 2 >= WS_END_B && WS_HRES + (size_t)S_ * DM * 2 <= WS_MIX, "residual stream must sit in the dead importance / bitmap buffers, clear of act / mix");
static_assert(WS_ERAW + (size_t)S_ * DM * 2 <= WS_Z + (size_t)ZROWS * LDZ * 2, "eraw must fit inside the dead z region while mix is still being read");
constexpr size_t WS_NEED  = WS_END_A > WS_END_B ? WS_END_A : WS_END_B;
static_assert(WS_NEED <= (size_t)1440000000, "workspace map exceeds the guaranteed 4 x largest-tensor bytes");

constexpr int LDS_STAGE = 131072;
constexpr int LDS_XCH   = LDS_STAGE + 64;
constexpr int LDS_MISC  = 147456;
constexpr int LDS_BYTES = LDS_MISC + 64;

__device__ __forceinline__ unsigned cvt_pk_bf16(float lo, float hi) { unsigned r; asm volatile("v_cvt_pk_bf16_f32 %0, %1, %2" : "=v"(r) : "v"(lo), "v"(hi)); return r; }
__device__ __forceinline__ float bf_lo(unsigned u) { return __uint_as_float(u << 16); }
__device__ __forceinline__ float bf_hi(unsigned u) { return __uint_as_float(u & 0xffff0000u); }
__device__ __forceinline__ float bf2f(bf16_t b) { return __uint_as_float(((unsigned)b) << 16); }
__device__ __forceinline__ float wave_sum(float v) {
#pragma unroll
    for (int o = 32; o >= 1; o >>= 1) v += __shfl_xor(v, o);
    return v;
}
__device__ __forceinline__ float wave_max(float v) {
#pragma unroll
    for (int o = 32; o >= 1; o >>= 1) v = fmaxf(v, __shfl_xor(v, o));
    return v;
}
__device__ __forceinline__ float sigmoidf_(float x) { return __builtin_amdgcn_rcpf(1.0f + __expf(-x)); }

#define XB_TMO      128
#define XB_XCNT(j)  (256  + 64 * (j))
#define XB_XSUB(j)  (1280 + 64 * (j))
#define XB_XGEN(j)  (2304 + 64 * (j))
#define XB_TOP      3328
#define XB_TOPGEN   3392
#define XCD_BAR_WORDS 3456
#define XB_SPIN_CAP (1u << 18)
__device__ __forceinline__ unsigned xb_ld(unsigned* p)              { return __hip_atomic_load(p, __ATOMIC_RELAXED, __HIP_MEMORY_SCOPE_AGENT); }
__device__ __forceinline__ unsigned xb_add(unsigned* p, unsigned v) { return __hip_atomic_fetch_add(p, v, __ATOMIC_RELAXED, __HIP_MEMORY_SCOPE_AGENT); }
__device__ __forceinline__ unsigned xb_xcc_id() { return (unsigned)__builtin_amdgcn_s_getreg((3 << 11) | 20) & 0xFu; }
#define XB_SPIN(cond, bar) do { unsigned _sp = 0; while (cond) { __builtin_amdgcn_s_sleep(1); \
    if ((++_sp & 255u) == 0u) { if (xb_ld(&(bar)[XB_TMO])) break; if (_sp > XB_SPIN_CAP) { atomicAdd(&(bar)[XB_TMO], 1u); break; } } } } while (0)
struct XcdBarrier { unsigned* bar; unsigned x; volatile LAS unsigned* st; };
__device__ __forceinline__ XcdBarrier xcd_barrier_post(unsigned* bar, volatile LAS unsigned* st) {
    XcdBarrier b; b.bar = bar; b.x = xb_xcc_id(); b.st = st;
    if (threadIdx.x == 0) (void)xb_add(&bar[XB_XCNT(b.x)], 1u);
    return b;
}
__device__ __forceinline__ void xcd_barrier_complete(unsigned* bar, unsigned x, unsigned& nloc, unsigned& nx) {
    const unsigned G = gridDim.x * gridDim.y * gridDim.z;
    unsigned sum, cnt, mine, sp = 0u;
    for (;;) {
        sum = 0u; cnt = 0u; mine = 0u;
#pragma unroll
        for (unsigned j = 0; j < 16; ++j) { const unsigned c = xb_ld(&bar[XB_XCNT(j)]); sum += c; cnt += (c > 0u) ? 1u : 0u; mine = (j == x) ? c : mine; }
        if (sum == G) break;
        __builtin_amdgcn_s_sleep(1);
        if ((++sp & 255u) == 0u) { if (xb_ld(&bar[XB_TMO])) break; if (sp > XB_SPIN_CAP) { atomicAdd(&bar[XB_TMO], 1u); break; } }
    }
    nloc = mine > 0u ? mine : 1u; nx = cnt > 0u ? cnt : 1u;
}
__device__ __forceinline__ void xcd_barrier(const XcdBarrier& b) {
    asm volatile("s_waitcnt vmcnt(0)" ::: "memory");
    __syncthreads();
    if (threadIdx.x == 0) {
        unsigned* bar = b.bar;
        __builtin_amdgcn_s_waitcnt(0);
        unsigned nloc = b.st[0], nx = b.st[1];
        if (nloc == 0u) { xcd_barrier_complete(bar, b.x, nloc, nx); b.st[0] = nloc; b.st[1] = nx; }
        const unsigned old = xb_add(&bar[XB_XSUB(b.x)], 1u);
        const unsigned gen = old / nloc;
        if (old + 1u == (gen + 1u) * nloc) {
            __builtin_amdgcn_fence(__ATOMIC_RELEASE, "agent");
            asm volatile("s_waitcnt vmcnt(0)" ::: "memory");
            const unsigned og = xb_add(&bar[XB_TOP], 1u);
            const unsigned tg = og / nx;
            if (og + 1u == (tg + 1u) * nx) xb_add(&bar[XB_TOPGEN], 1u);
            else XB_SPIN(xb_ld(&bar[XB_TOPGEN]) == tg, bar);
            __builtin_amdgcn_fence(__ATOMIC_ACQUIRE, "agent");
            xb_add(&bar[XB_XGEN(b.x)], 1u);
            asm volatile("s_waitcnt vmcnt(0)" ::: "memory");
        } else {
            XB_SPIN(xb_ld(&bar[XB_XGEN(b.x)]) == gen, bar);
            __builtin_amdgcn_fence(__ATOMIC_ACQUIRE, "agent");
            asm volatile("s_waitcnt vmcnt(0)" ::: "memory");
        }
    }
    __syncthreads();
}

struct Params {
    const float* x; const float* p; const int* positions; const float* norm1_w; const float* w_in; const float* w_pool; const float* pool_scale;
    const float* q_norm_w; const float* k_norm_cmp_w; const float* k_norm_slc_w; const float* k_norm_win_w; const float* cmp_pos_k; const float* cmp_pos_v;
    const float* cmp_k_w1; const float* cmp_k_w2; const float* cmp_v_w1; const float* cmp_v_w2; const float* w_o; const float* norm2_w; const float* w_ffn_in;
    const float* conv_w; const float* conv_b; const float* w_ffn_out; const float* w_ple_proj; const float* ple_norm_w; const float* ple_gate_norm_w; const float* w_ple_gate;
    float* out; unsigned char* ws; int ph_lo, ph_hi;
};

namespace pg8 {
constexpr int BM = 256, BK = 64, HALF = 128, HTB = HALF * BK * 2, STAGE_BYTES = 8 * HTB, NXCD = 8, WGM = 8;
__host__ __device__ __forceinline__ int lds_byte(int r, int c) { const int st = (r >> 4) * 2 + (c >> 5), rr = r & 15, cc = c & 31, ob = rr * 64 + cc * 2; return st * 1024 + (ob ^ (((ob >> 9) & 1) << 5)); }
__host__ __device__ __forceinline__ void stage_rc(int b, int& R, int& C) { const int st = b / 1024, sb = b % 1024, swz = sb ^ (((sb >> 9) & 1) << 5); R = (st >> 1) * 16 + swz / 64; C = (st & 1) * 32 + (swz % 64) / 2; }
__host__ __device__ __forceinline__ int perm32(int rho) { const int n = rho >> 4, i = rho & 15; return 8 * (i >> 2) + 4 * n + (i & 3); }
struct Unit { int pm, pn; };

struct StaticOrder {
    int nM, nN, nwg, G, c;
    __device__ void init(int nM_, int nN_, int G_, int c_) { nM = nM_; nN = nN_; nwg = nM * nN; G = G_; c = c_; }
    __device__ bool next(int i, Unit& u) const {
        const long L = (long)i * G + c; if (L >= nwg) return false;
        int wgid = (int)L; { const int q = nwg / NXCD, r = nwg % NXCD, xcd = wgid % NXCD, off = wgid / NXCD; wgid = (xcd < r ? xcd * (q + 1) : r * (q + 1) + (xcd - r) * q) + off; }
        const int nig = WGM * nN, gid = wgid / nig, fm = gid * WGM, gsz = (nM - fm) < WGM ? (nM - fm) : WGM;
        u.pm = fm + ((wgid % nig) % gsz); u.pn = (wgid % nig) / gsz; return true;
    }
};

struct GStd {
    const char* A; const char* B; unsigned lda, ldb; int nt;
    __device__ __forceinline__ const char* a_base(const Unit& u) const { return A + (size_t)u.pm * 256 * lda * 2; }
    __device__ __forceinline__ const char* b_base(const Unit& u) const { return B + (size_t)u.pn * 256 * ldb * 2; }
    __device__ __forceinline__ size_t kpairA() const { return 256; }
};
struct GPool {
    const char* A; const char* B; unsigned lda, ldb; int nt;
    __device__ __forceinline__ const char* a_base(const Unit& u) const { return A + (size_t)u.pm * 256 * lda * 2 + (size_t)u.pn * 512; }
    __device__ __forceinline__ const char* b_base(const Unit& u) const { return B + (size_t)u.pn * 256 * ldb * 2; }
    __device__ __forceinline__ size_t kpairA() const { return 256; }
};
struct GCmp {
    const char* Z; const char* Bk; const char* Bv; unsigned lda, ldb; int nt;
    __device__ __forceinline__ const char* a_base(const Unit& u) const { const int which = u.pm >> 4, g = (u.pm >> 2) & 3, rt = u.pm & 3;
        return Z + (size_t)(OFF_KV + which * 512 + g * 128) * 2 + (size_t)rt * 256 * lda * 2; }
    __device__ __forceinline__ const char* b_base(const Unit& u) const { return (u.pm >> 4) ? Bv : Bk; }
    __device__ __forceinline__ size_t kpairA() const { return (size_t)LDZ * 2; }
};

struct EpiBf16 {
    static constexpr bool PERM = true;
    bf16_t* O; int ldc;
    __device__ __forceinline__ void operator()(const f32x4 (&acc)[2][2][4][2], const Unit& u, int wr, int wc, int fr, int fq) const {
        const int row0 = u.pm * BM + wr * 64 + fr, col0 = u.pn * BM + wc * 32 + 8 * fq;
#pragma unroll
        for (int ai = 0; ai < 2; ++ai)
#pragma unroll
            for (int m = 0; m < 4; ++m) { bf16_t* rowp = O + (size_t)(row0 + ai * HALF + m * 16) * ldc + col0;
#pragma unroll
                for (int bj = 0; bj < 2; ++bj) { const f32x4 v0 = acc[ai][bj][m][0], v1 = acc[ai][bj][m][1];
                    u32x4 w; w.x = cvt_pk_bf16(v0[0], v0[1]); w.y = cvt_pk_bf16(v0[2], v0[3]); w.z = cvt_pk_bf16(v1[0], v1[1]); w.w = cvt_pk_bf16(v1[2], v1[3]);
                    *(u32x4*)(rowp + bj * HALF) = w; } }
    }
};
struct EpiBf16S {
    static constexpr bool PERM = true;
    bf16_t* O; int ldc; float s;
    __device__ __forceinline__ void operator()(const f32x4 (&acc)[2][2][4][2], const Unit& u, int wr, int wc, int fr, int fq) const {
        const int row0 = u.pm * BM + wr * 64 + fr, col0 = u.pn * BM + wc * 32 + 8 * fq;
#pragma unroll
        for (int ai = 0; ai < 2; ++ai)
#pragma unroll
            for (int m = 0; m < 4; ++m) { bf16_t* rowp = O + (size_t)(row0 + ai * HALF + m * 16) * ldc + col0;
#pragma unroll
                for (int bj = 0; bj < 2; ++bj) { const f32x4 v0 = acc[ai][bj][m][0] * s, v1 = acc[ai][bj][m][1] * s;
                    u32x4 w; w.x = cvt_pk_bf16(v0[0], v0[1]); w.y = cvt_pk_bf16(v0[2], v0[3]); w.z = cvt_pk_bf16(v1[0], v1[1]); w.w = cvt_pk_bf16(v1[2], v1[3]);
                    *(u32x4*)(rowp + bj * HALF) = w; } }
    }
};
struct EpiBf16Ssq {
    static constexpr bool PERM = true;
    bf16_t* O; int ldc; float* ssq;
    __device__ __forceinline__ void operator()(const f32x4 (&acc)[2][2][4][2], const Unit& u, int wr, int wc, int fr, int fq) const {
        const int row0 = u.pm * BM + wr * 64 + fr, col0 = u.pn * BM + wc * 32 + 8 * fq;
#pragma unroll
        for (int ai = 0; ai < 2; ++ai)
#pragma unroll
            for (int m = 0; m < 4; ++m) { const int row = row0 + ai * HALF + m * 16; bf16_t* rowp = O + (size_t)row * ldc + col0; float s = 0.f;
#pragma unroll
                for (int bj = 0; bj < 2; ++bj) { const f32x4 v0 = acc[ai][bj][m][0], v1 = acc[ai][bj][m][1];
                    s += v0[0] * v0[0] + v0[1] * v0[1] + v0[2] * v0[2] + v0[3] * v0[3] + v1[0] * v1[0] + v1[1] * v1[1] + v1[2] * v1[2] + v1[3] * v1[3];
                    u32x4 w; w.x = cvt_pk_bf16(v0[0], v0[1]); w.y = cvt_pk_bf16(v0[2], v0[3]); w.z = cvt_pk_bf16(v1[0], v1[1]); w.w = cvt_pk_bf16(v1[2], v1[3]);
                    *(u32x4*)(rowp + bj * HALF) = w; }
                s += __shfl_xor(s, 16); s += __shfl_xor(s, 32);
                if (fq == 0) unsafeAtomicAdd(ssq + row, s); }
    }
};
struct EpiBf16Scale {
    static constexpr bool PERM = true;
    bf16_t* O; int ldc; const float* colscale;
    __device__ __forceinline__ void operator()(const f32x4 (&acc)[2][2][4][2], const Unit& u, int wr, int wc, int fr, int fq) const {
        const int row0 = u.pm * BM + wr * 64 + fr, col0 = u.pn * BM + wc * 32 + 8 * fq;
#pragma unroll
        for (int bj = 0; bj < 2; ++bj) { const f32x4 s0 = *(const f32x4*)(colscale + col0 + bj * HALF), s1 = *(const f32x4*)(colscale + col0 + bj * HALF + 4);
#pragma unroll
            for (int ai = 0; ai < 2; ++ai)
#pragma unroll
                for (int m = 0; m < 4; ++m) { bf16_t* rowp = O + (size_t)(row0 + ai * HALF + m * 16) * ldc + col0;
                    const f32x4 v0 = acc[ai][bj][m][0] * s0, v1 = acc[ai][bj][m][1] * s1;
                    u32x4 w; w.x = cvt_pk_bf16(v0[0], v0[1]); w.y = cvt_pk_bf16(v0[2], v0[3]); w.z = cvt_pk_bf16(v1[0], v1[1]); w.w = cvt_pk_bf16(v1[2], v1[3]);
                    *(u32x4*)(rowp + bj * HALF) = w; } }
    }
};
struct EpiResF32 {
    static constexpr bool PERM = false;
    const float* base; float* C; int ldc; int row_off;
    __device__ __forceinline__ void operator()(const f32x4 (&acc)[2][2][4][2], const Unit& u, int wr, int wc, int fr, int fq) const {
        const int row0 = u.pm * BM + wr * 64 + fr + row_off, col0 = u.pn * BM + wc * 32 + 4 * fq;
#pragma unroll
        for (int ai = 0; ai < 2; ++ai)
#pragma unroll
            for (int m = 0; m < 4; ++m) { const size_t off = (size_t)(row0 + ai * HALF + m * 16) * ldc + col0;
#pragma unroll
                for (int bj = 0; bj < 2; ++bj)
#pragma unroll
                    for (int n = 0; n < 2; ++n) { const f32x4 b = *(const f32x4*)(base + off + bj * HALF + n * 16); *(f32x4*)(C + off + bj * HALF + n * 16) = b + acc[ai][bj][m][n]; }
                asm volatile("" ::: "memory"); }
    }
};
template <bool FP8OUT, bool BASEBF, bool WXN = true>
struct EpiResNormT {
    static constexpr bool PERM = false;
    const void* base; bf16_t* C; bf16_t* XN; const float* nw; float* ssq; int ldc;
    typedef typename std::conditional<BASEBF, u32x2, f32x4>::type RawT;
    __device__ __forceinline__ RawT ldb(size_t idx) const { if constexpr (BASEBF) return *(const u32x2*)((const bf16_t*)base + idx); else return *(const f32x4*)((const float*)base + idx); }
    static __device__ __forceinline__ f32x4 cv(const RawT& r) { if constexpr (BASEBF) return (f32x4){bf_lo(r.x), bf_hi(r.x), bf_lo(r.y), bf_hi(r.y)}; else return r; }
    __device__ __forceinline__ void operator()(const f32x4 (&acc)[2][2][4][2], const Unit& u, int wr, int wc, int fr, int fq) const {
        const int row0 = u.pm * BM + wr * 64 + fr, col0 = u.pn * BM + wc * 32 + 4 * fq;
        f32x4 wv[2][2];
#pragma unroll
        for (int bj = 0; bj < 2; ++bj)
#pragma unroll
            for (int n = 0; n < 2; ++n) wv[bj][n] = *(const f32x4*)(nw + col0 + bj * HALF + n * 16);
        RawT bv[2][2][2];
#pragma unroll
        for (int bj = 0; bj < 2; ++bj)
#pragma unroll
            for (int n = 0; n < 2; ++n) bv[0][bj][n] = ldb((size_t)row0 * ldc + col0 + bj * HALF + n * 16);
#pragma unroll
        for (int rg = 0; rg < 8; ++rg) { const int ai = rg >> 2, m = rg & 3; const int row = row0 + ai * HALF + m * 16; const size_t off = (size_t)row * ldc + col0;
            if (rg < 7) { const int ai2 = (rg + 1) >> 2, m2 = (rg + 1) & 3; const size_t off2 = (size_t)(row0 + ai2 * HALF + m2 * 16) * ldc + col0;
#pragma unroll
                for (int bj = 0; bj < 2; ++bj)
#pragma unroll
                    for (int n = 0; n < 2; ++n) bv[(rg + 1) & 1][bj][n] = ldb(off2 + bj * HALF + n * 16); }
            float s = 0.f;
#pragma unroll
            for (int bj = 0; bj < 2; ++bj)
#pragma unroll
                for (int n = 0; n < 2; ++n) { const f32x4 v = cv(bv[rg & 1][bj][n]) + acc[ai][bj][m][n];
                    { u32x2 c; c.x = cvt_pk_bf16(v[0], v[1]); c.y = cvt_pk_bf16(v[2], v[3]); *(u32x2*)(C + off + bj * HALF + n * 16) = c; }
                    s += v[0] * v[0] + v[1] * v[1] + v[2] * v[2] + v[3] * v[3];
                    if (!WXN) { }
                    else if (FP8OUT) { int pk = __builtin_amdgcn_cvt_pk_fp8_f32(v[0] * wv[bj][n][0], v[1] * wv[bj][n][1], 0, false); pk = __builtin_amdgcn_cvt_pk_fp8_f32(v[2] * wv[bj][n][2], v[3] * wv[bj][n][3], pk, true);
                        *(int*)((unsigned char*)XN + off + bj * HALF + n * 16) = pk; }
                    else { u32x2 o; o.x = cvt_pk_bf16(v[0] * wv[bj][n][0], v[1] * wv[bj][n][1]); o.y = cvt_pk_bf16(v[2] * wv[bj][n][2], v[3] * wv[bj][n][3]);
                        *(u32x2*)(XN + off + bj * HALF + n * 16) = o; } }
            s += __shfl_xor(s, 16); s += __shfl_xor(s, 32);
            if (fq == 0) unsafeAtomicAdd(ssq + row, s);
        }
    }
};
typedef EpiResNormT<false, false, false> EpiResNorm;
typedef EpiResNormT<true, true> EpiResNormF8;
struct EpiCmpGelu {
    static constexpr bool PERM = false;
    float* H; const float* bias;
    __device__ __forceinline__ void operator()(const f32x4 (&acc)[2][2][4][2], const Unit& u, int wr, int wc, int fr, int fq) const {
        const int row0 = u.pm * BM + wr * 64 + fr, col0 = wc * 32 + 4 * fq; const float* bs = bias + (u.pm >> 4) * 256;
        f32x4 bvv[2][2];
#pragma unroll
        for (int bj = 0; bj < 2; ++bj)
#pragma unroll
            for (int n = 0; n < 2; ++n) bvv[bj][n] = *(const f32x4*)(bs + col0 + bj * HALF + n * 16);
#pragma unroll
        for (int ai = 0; ai < 2; ++ai)
#pragma unroll
            for (int m = 0; m < 4; ++m) { float* rowp = H + (size_t)(row0 + ai * HALF + m * 16) * 256 + col0;
#pragma unroll
                for (int bj = 0; bj < 2; ++bj)
#pragma unroll
                    for (int n = 0; n < 2; ++n) { f32x4 v = acc[ai][bj][m][n] + bvv[bj][n];
#pragma unroll
                        for (int j = 0; j < 4; ++j) { const float xx = v[j], uu = 0.7978845608028654f * (xx + 0.044715f * xx * xx * xx); const float th = 1.0f - 2.0f / (1.0f + __expf(2.0f * uu)); v[j] = 0.5f * xx * (1.0f + th); }
                        *(f32x4*)(rowp + bj * HALF + n * 16) = v; } }
    }
};
struct EpiGate {
    static constexpr bool PERM = false;
    float* C; const bf16_t* H; const bf16_t* eraw; const float* erstd; const float* pw; const float* ssq; int ldc; float ascale;
    __device__ __forceinline__ void operator()(const f32x4 (&acc)[2][2][4][2], const Unit& u, int wr, int wc, int fr, int fq) const {
        const int row0 = u.pm * BM + wr * 64 + fr, col0 = u.pn * BM + wc * 32 + 4 * fq;
        f32x4 wv[2][2];
#pragma unroll
        for (int bj = 0; bj < 2; ++bj)
#pragma unroll
            for (int n = 0; n < 2; ++n) wv[bj][n] = *(const f32x4*)(pw + col0 + bj * HALF + n * 16);
        u32x2 bv[2][2][2]; u32x2 ev[2][2][2]; float rsv[2], rgv[2];
#pragma unroll
        for (int bj = 0; bj < 2; ++bj)
#pragma unroll
            for (int n = 0; n < 2; ++n) { bv[0][bj][n] = *(const u32x2*)(H + (size_t)row0 * ldc + col0 + bj * HALF + n * 16); ev[0][bj][n] = *(const u32x2*)(eraw + (size_t)row0 * ldc + col0 + bj * HALF + n * 16); }
        rsv[0] = erstd[row0]; rgv[0] = ssq[row0];
#pragma unroll
        for (int rg = 0; rg < 8; ++rg) { const int ai = rg >> 2, m = rg & 3; const int row = row0 + ai * HALF + m * 16; const size_t off = (size_t)row * ldc + col0;
            if (rg < 7) { const int ai2 = (rg + 1) >> 2, m2 = (rg + 1) & 3; const int row2 = row0 + ai2 * HALF + m2 * 16; const size_t off2 = (size_t)row2 * ldc + col0;
#pragma unroll
                for (int bj = 0; bj < 2; ++bj)
#pragma unroll
                    for (int n = 0; n < 2; ++n) { bv[(rg + 1) & 1][bj][n] = *(const u32x2*)(H + off2 + bj * HALF + n * 16); ev[(rg + 1) & 1][bj][n] = *(const u32x2*)(eraw + off2 + bj * HALF + n * 16); }
                rsv[(rg + 1) & 1] = erstd[row2]; rgv[(rg + 1) & 1] = ssq[row2]; }
            const float rs = rsqrtf(rsv[rg & 1] * (1.0f / DM) + EPS), rg_ = rsqrtf(rgv[rg & 1] * (1.0f / DM) + EPS) * ascale;
#pragma unroll
            for (int bj = 0; bj < 2; ++bj)
#pragma unroll
                for (int n = 0; n < 2; ++n) { const u32x2 br = bv[rg & 1][bj][n]; const f32x4 b = {bf_lo(br.x), bf_hi(br.x), bf_lo(br.y), bf_hi(br.y)}; const u32x2 e = ev[rg & 1][bj][n]; const f32x4 a = acc[ai][bj][m][n]; f32x4 o;
                    o[0] = b[0] + bf_lo(e.x) * rs * wv[bj][n][0] * sigmoidf_(a[0] * rg_); o[1] = b[1] + bf_hi(e.x) * rs * wv[bj][n][1] * sigmoidf_(a[1] * rg_);
                    o[2] = b[2] + bf_lo(e.y) * rs * wv[bj][n][2] * sigmoidf_(a[2] * rg_); o[3] = b[3] + bf_hi(e.y) * rs * wv[bj][n][3] * sigmoidf_(a[3] * rg_);
                    *(f32x4*)(C + off + bj * HALF + n * 16) = o; }
        }
    }
};
struct GFfn {
    const char* A; const char* B; unsigned lda, ldb; int nt;
    __device__ __forceinline__ const char* a_base(const Unit& u) const { return A + ((long)u.pm * 254 - 2) * (long)lda * 2; }
    __device__ __forceinline__ const char* b_base(const Unit& u) const { return B + (size_t)u.pn * 256 * ldb * 2; }
    __device__ __forceinline__ size_t kpairA() const { return 256; }
};
template <int CTRL> __device__ __forceinline__ float dpp_f(float v) { return __int_as_float(__builtin_amdgcn_update_dpp(0, __float_as_int(v), CTRL, 0xf, 0xf, false)); }
struct EpiFfn {
    static constexpr bool PERM = true;
    bf16_t* ACT; const float* cw; const float* cb; LAS float* X; const float* ssq;
    __device__ __forceinline__ void operator()(const f32x4 (&acc)[2][2][4][2], const Unit& u, int wr, int wc, int fr, int fq) const {
        const int colw = wc * 32 + 8 * fq;
        const int f0 = u.pn * 128 + colw;
        f32x4 w0[2], w1[2], w2[2], cbv[2];
#pragma unroll
        for (int n = 0; n < 2; ++n) { w0[n] = *(const f32x4*)(cw + f0 + 4 * n); w1[n] = *(const f32x4*)(cw + DFF + f0 + 4 * n); w2[n] = *(const f32x4*)(cw + 2 * DFF + f0 + 4 * n); cbv[n] = *(const f32x4*)(cb + f0 + 4 * n); }
        float rsv[2][4];
#pragma unroll
        for (int ai = 0; ai < 2; ++ai)
#pragma unroll
            for (int m = 0; m < 4; ++m) { const long t = (long)u.pm * 254 - 2 + ai * HALF + wr * 64 + m * 16 + fr; rsv[ai][m] = ssq[t < 0 ? 0 : (t >= S_ ? S_ - 1 : t)]; }
#pragma unroll
        for (int ai = 0; ai < 2; ++ai)
#pragma unroll
            for (int m = 0; m < 4; ++m) { const long t = (long)u.pm * 254 - 2 + ai * HALF + wr * 64 + m * 16 + fr; rsv[ai][m] = (t >= 0 && t < S_) ? rsqrtf(rsv[ai][m] * (1.0f / DM) + EPS) : 0.f; }
        if (fr >= 14) {
#pragma unroll
            for (int ai = 0; ai < 2; ++ai)
#pragma unroll
                for (int n = 0; n < 2; ++n) *(LAS f32x4*)(X + ((2 * ai + wr) * 2 + (fr - 14)) * 128 + colw + 4 * n) = acc[ai][0][3][n] * rsv[ai][3];
        }
        asm volatile("s_waitcnt lgkmcnt(0)" ::: "memory");
        __builtin_amdgcn_s_barrier(); asm volatile("" ::: "memory");
        __builtin_amdgcn_s_barrier(); asm volatile("" ::: "memory");
        const bool sel1 = fr == 15, sel2 = fr >= 14;
#pragma unroll
        for (int ai = 0; ai < 2; ++ai) {
            f32x4 pv[2];
            const int pseg = 2 * ai + wr - 1;
#pragma unroll
            for (int n = 0; n < 2; ++n) { pv[n] = (f32x4){0.f, 0.f, 0.f, 0.f}; if (pseg >= 0 && fr >= 14) pv[n] = *(const LAS f32x4*)(X + (pseg * 2 + (fr - 14)) * 128 + colw + 4 * n); }
#pragma unroll
            for (int m = 0; m < 4; ++m) {
                const int r = ai * HALF + wr * 64 + m * 16 + fr; const long t = (long)u.pm * 254 - 2 + r;
                unsigned ow[4];
#pragma unroll
                for (int n = 0; n < 2; ++n) {
                    const f32x4 cur = acc[ai][0][m][n] * rsv[ai][m], up = acc[ai][1][m][n] * rsv[ai][m];
                    f32x4 x1, x2;
#pragma unroll
                    for (int i = 0; i < 4; ++i) { x1[i] = dpp_f<0x121>(sel1 ? pv[n][i] : cur[i]); x2[i] = dpp_f<0x122>(sel2 ? pv[n][i] : cur[i]); }
                    const f32x4 y = cbv[n] + w0[n] * x2 + w1[n] * x1 + w2[n] * cur;
                    f32x4 sg;
#pragma unroll
                    for (int i = 0; i < 4; ++i) sg[i] = sigmoidf_(y[i]);
                    const f32x4 o = y * sg * up;
                    ow[2 * n] = cvt_pk_bf16(o[0], o[1]); ow[2 * n + 1] = cvt_pk_bf16(o[2], o[3]);
                    pv[n] = cur;
                }
                if (r >= 2 && t < S_) *(u32x4*)(ACT + (size_t)t * DFF + f0) = (u32x4){ow[0], ow[1], ow[2], ow[3]};
            }
        }
    }
};

template <class GD, class Epi, bool F8 = false>
__device__ __forceinline__ void gemm_phase(LAS unsigned char* lds, const GD g, const StaticOrder& S, const Epi& E) {
    const int tid = threadIdx.x, wid = __builtin_amdgcn_readfirstlane(tid >> 6), lane = tid & 63, wr = wid >> 2, wc = wid & 3, fr = lane & 15, fq = lane >> 4;
    const int nt = g.nt;
    unsigned voffA[2], voffB[2];
#pragma unroll
    for (int i = 0; i < 2; ++i) { int R, C; stage_rc(tid * 16 + i * 8192, R, C); const int Rb = Epi::PERM ? ((R & ~31) + perm32(R & 31)) : R;
        voffA[i] = (unsigned)(R * g.lda + C) * 2u; voffB[i] = (unsigned)(Rb * g.ldb + C) * 2u; }
    const size_t kpA = g.kpairA();
    const size_t hstepA = (size_t)HALF * g.lda * 2, hstepB = (size_t)HALF * g.ldb * 2;
    const unsigned ldsw = (unsigned)wid * 1024u;
    const int aoff = lds_byte(wr * 64 + fr, fq * 8), boff = lds_byte(wc * 32 + fr, fq * 8);
#define PG8_SA(b, h) (((b) * 2 + (h)) * HTB)
#define PG8_SB(b, h) ((4 + (b) * 2 + (h)) * HTB)
#define PG8_STAGE(bufoff, gbase, voff) do { _Pragma("unroll") for (int _i = 0; _i < 2; ++_i) \
        __builtin_amdgcn_global_load_lds((const unsigned*)((const char*)(gbase) + (voff)[_i]), (LAS unsigned*)(lds + (bufoff) + ldsw + _i * 8192), 16, 0, 0); } while (0)
#define PG8_LDA(dst, b, h) do { if constexpr (F8) { _Pragma("unroll") for (int m = 0; m < 4; ++m) { const i32x4 lo_ = *(const LAS i32x4*)(lds + PG8_SA(b, h) + aoff + m * 2048), hi_ = *(const LAS i32x4*)(lds + PG8_SA(b, h) + aoff + m * 2048 + 1024); \
            dst##8[m] = __builtin_shufflevector(lo_, hi_, 0, 1, 2, 3, 4, 5, 6, 7); } } \
        else { _Pragma("unroll") for (int m = 0; m < 4; ++m) _Pragma("unroll") for (int k = 0; k < 2; ++k) dst[m][k] = *(const LAS bf16x8*)(lds + PG8_SA(b, h) + aoff + m * 2048 + k * 1024); } } while (0)
#define PG8_LDB(dst, b, h) do { if constexpr (F8) { _Pragma("unroll") for (int n = 0; n < 2; ++n) { const i32x4 lo_ = *(const LAS i32x4*)(lds + PG8_SB(b, h) + boff + n * 2048), hi_ = *(const LAS i32x4*)(lds + PG8_SB(b, h) + boff + n * 2048 + 1024); \
            dst##8[n] = __builtin_shufflevector(lo_, hi_, 0, 1, 2, 3, 4, 5, 6, 7); } } \
        else { _Pragma("unroll") for (int n = 0; n < 2; ++n) _Pragma("unroll") for (int k = 0; k < 2; ++k) dst[n][k] = *(const LAS bf16x8*)(lds + PG8_SB(b, h) + boff + n * 2048 + k * 1024); } } while (0)
#define PG8_MMA(ai, bj, At, Bt) do { __builtin_amdgcn_s_setprio(1); \
        if constexpr (F8) { _Pragma("unroll") for (int m = 0; m < 4; ++m) _Pragma("unroll") for (int n = 0; n < 2; ++n) \
            asm volatile("v_mfma_scale_f32_16x16x128_f8f6f4 %0, %1, %2, %0, %3, %3 op_sel_hi:[0,0,0]" : "+v"(acc[ai][bj][m][n]) : "v"(Bt##8[n]), "v"(At##8[m]), "v"(one_scale)); } \
        else { _Pragma("unroll") for (int m = 0; m < 4; ++m) _Pragma("unroll") for (int n = 0; n < 2; ++n) _Pragma("unroll") for (int k = 0; k < 2; ++k) \
            acc[ai][bj][m][n] = __builtin_amdgcn_mfma_f32_16x16x32_bf16(Bt[n][k], At[m][k], acc[ai][bj][m][n], 0, 0, 0); } \
        __builtin_amdgcn_s_setprio(0); } while (0)
#define PG8_WAIT_V(n) asm volatile("s_waitcnt vmcnt(" #n ")" ::: "memory")
#define PG8_WAIT_L(n) asm volatile("s_waitcnt lgkmcnt(" #n ")" ::: "memory")
#define PG8_BAR __builtin_amdgcn_s_barrier()
#define PG8_SCHED __builtin_amdgcn_sched_barrier(0)
    Unit cur, nxt; int ui = 0;
    if (!S.next(0, cur)) return;
    f32x4 acc[2][2][4][2];
#pragma unroll
    for (int a = 0; a < 2; ++a)
#pragma unroll
        for (int b = 0; b < 2; ++b)
#pragma unroll
            for (int m = 0; m < 4; ++m)
#pragma unroll
                for (int n = 0; n < 2; ++n) acc[a][b][m][n] = (f32x4){0.f, 0.f, 0.f, 0.f};
    bf16x8 At[4][2], B0[2][2], B1[2][2];
    i32x8 At8[4], B08[2], B18[2];
    (void)At; (void)B0; (void)B1; (void)At8; (void)B08; (void)B18;
    int one_scale = 0x7F7F7F7F; (void)one_scale;
    const char* cA = g.a_base(cur); const char* cB = g.b_base(cur);
    PG8_STAGE(PG8_SB(0, 0), cB, voffB); PG8_STAGE(PG8_SA(0, 0), cA, voffA); PG8_STAGE(PG8_SB(0, 1), cB + hstepB, voffB); PG8_STAGE(PG8_SA(0, 1), cA + hstepA, voffA);
    if (wr == 1) PG8_BAR;
    PG8_WAIT_V(4); PG8_BAR;
    PG8_STAGE(PG8_SB(1, 0), cB + 128, voffB); PG8_STAGE(PG8_SA(1, 0), cA + 128, voffA); PG8_STAGE(PG8_SB(1, 1), cB + hstepB + 128, voffB);
    PG8_WAIT_V(6); PG8_BAR;
    for (;;) {
        const bool has_next = S.next(ui + 1, nxt);
        const char* nA = has_next ? g.a_base(nxt) : cA; const char* nB = has_next ? g.b_base(nxt) : cB;
        for (int t = 0; t < nt; t += 2) {
            const bool last = (t == nt - 2);
            const char* a0 = cA + (size_t)(t >> 1) * kpA;
            const char* a1 = a0 + 128;
            const char* a2 = last ? nA : a0 + kpA; const char* b2 = last ? nB : cB + (size_t)(t + 2) * 128;
            const char* a3 = a2 + 128; const char* b3 = b2 + 128;
            PG8_LDB(B0, 0, 0); PG8_SCHED; PG8_LDA(At, 0, 0); PG8_STAGE(PG8_SA(1, 1), a1 + hstepA, voffA);
            PG8_WAIT_L(8); PG8_BAR; PG8_WAIT_L(0); PG8_MMA(0, 0, At, B0); PG8_BAR; PG8_SCHED;
            PG8_LDB(B1, 0, 1); PG8_STAGE(PG8_SB(0, 0), b2, voffB);
            PG8_BAR; PG8_WAIT_L(0); PG8_MMA(0, 1, At, B1); PG8_BAR;
            PG8_LDA(At, 0, 1); PG8_STAGE(PG8_SA(0, 0), a2, voffA);
            PG8_BAR; PG8_WAIT_L(0); PG8_MMA(1, 0, At, B0); PG8_BAR; PG8_SCHED;
            PG8_STAGE(PG8_SB(0, 1), b2 + hstepB, voffB);
            PG8_WAIT_V(6); PG8_BAR; PG8_MMA(1, 1, At, B1); PG8_BAR;
            PG8_LDB(B0, 1, 0); PG8_SCHED; PG8_LDA(At, 1, 0); PG8_STAGE(PG8_SA(0, 1), a2 + hstepA, voffA);
            PG8_WAIT_L(8); PG8_BAR; PG8_WAIT_L(0); PG8_MMA(0, 0, At, B0); PG8_BAR; PG8_SCHED;
            PG8_LDB(B1, 1, 1); PG8_STAGE(PG8_SB(1, 0), b3, voffB);
            PG8_BAR; PG8_WAIT_L(0); PG8_MMA(0, 1, At, B1); PG8_BAR;
            PG8_LDA(At, 1, 1); PG8_STAGE(PG8_SA(1, 0), a3, voffA);
            PG8_BAR; PG8_WAIT_L(0); PG8_MMA(1, 0, At, B0); PG8_BAR; PG8_SCHED;
            PG8_STAGE(PG8_SB(1, 1), b3 + hstepB, voffB);
            PG8_WAIT_V(6); PG8_BAR; PG8_MMA(1, 1, At, B1); PG8_BAR;
        }
        if constexpr (F8) asm volatile("s_nop 15\n\ts_nop 15\n\ts_nop 15" ::: "memory");
        E(acc, cur, wr, wc, fr, fq);
        if (!has_next) break;
#pragma unroll
        for (int a = 0; a < 2; ++a)
#pragma unroll
            for (int b = 0; b < 2; ++b)
#pragma unroll
                for (int m = 0; m < 4; ++m)
#pragma unroll
                    for (int n = 0; n < 2; ++n) acc[a][b][m][n] = (f32x4){0.f, 0.f, 0.f, 0.f};
        cur = nxt; cA = nA; cB = nB; ++ui;
    }
    PG8_WAIT_V(0);
    if (wr == 0) PG8_BAR;
    PG8_BAR;
#undef PG8_SA
#undef PG8_SB
#undef PG8_STAGE
#undef PG8_LDA
#undef PG8_LDB
#undef PG8_MMA
#undef PG8_WAIT_V
#undef PG8_WAIT_L
#undef PG8_BAR
#undef PG8_SCHED
}
}

namespace att {
constexpr int KVBLK = 64;
constexpr int SHM_V = KVBLK * HD * 2, SHM_K = KVBLK * HD * 2, SHM_ATTN = 2 * SHM_V + 2 * SHM_K + NWAVES * 64 * 4;
#define KSWZ(row, colB) ((row) * 256 + ((colB) ^ (((row) & 7) << 4)))
#define SBAR() __builtin_amdgcn_sched_barrier(0)
__device__ __forceinline__ int crow(int r, int hi) { return (r & 3) + 8 * (r >> 2) + 4 * hi; }
__device__ __forceinline__ void qkt(f32x16& p0, f32x16& p1, const char* Ks, const bf16x8* qr, int r32, int hi) {
    p0 = f32x16{}; p1 = f32x16{};
    bf16x8 ka[2], kb[2];
    { const int cb = (hi * 8) * 2; ka[0] = *reinterpret_cast<const bf16x8*>(Ks + KSWZ(r32, cb)); kb[0] = *reinterpret_cast<const bf16x8*>(Ks + KSWZ(32 + r32, cb)); }
#pragma unroll
    for (int d0 = 0; d0 < 8; ++d0) {
        if (d0 < 7) { const int cb = ((d0 + 1) * 16 + hi * 8) * 2;
            ka[(d0 + 1) & 1] = *reinterpret_cast<const bf16x8*>(Ks + KSWZ(r32, cb)); kb[(d0 + 1) & 1] = *reinterpret_cast<const bf16x8*>(Ks + KSWZ(32 + r32, cb)); }
        SBAR();
        p0 = __builtin_amdgcn_mfma_f32_32x32x16_bf16(ka[d0 & 1], qr[d0], p0, 0, 0, 0);
        p1 = __builtin_amdgcn_mfma_f32_32x32x16_bf16(kb[d0 & 1], qr[d0], p1, 0, 0, 0);
        SBAR();
    }
}
__device__ __forceinline__ int v_st(int k, int c) { const int kk = (k & ~0xC) | ((k & 4) << 1) | ((k & 8) >> 1); return ((kk >> 3) * 4 + (c >> 5)) * 512 + ((kk & 7) * 32 + (c & 31)) * 2; }
__device__ __forceinline__ int v_rd_base(int lane) { return ((lane & 3) << 3) | (((lane >> 2) & 3) << 6) | (((lane >> 4) & 1) << 5) | (((lane >> 5) & 1) << 8); }
constexpr int v_rd_off(int d0, int ks, int half) { return d0 * 512 + ks * 4096 + half * 2048; }
__device__ __forceinline__ s16x4 tr_read(int vb, int off) { return __builtin_amdgcn_ds_read_tr16_b64_v4i16((LAS s16x4*)(unsigned long)(unsigned)(vb + off)); }
__device__ __forceinline__ void pv_d0(f32x16* o, int vb, bf16x8 pa0, bf16x8 pa1, bf16x8 pa2, bf16x8 pa3) {
    s16x4 L[2][4], H[2][4];
#pragma unroll
    for (int d0 = 0; d0 < 4; ++d0) { L[0][d0] = tr_read(vb, v_rd_off(d0, 0, 0)); H[0][d0] = tr_read(vb, v_rd_off(d0, 0, 1)); }
#pragma unroll
    for (int ks = 0; ks < 4; ++ks) {
        if (ks < 3) {
#pragma unroll
            for (int d0 = 0; d0 < 4; ++d0) { L[(ks + 1) & 1][d0] = tr_read(vb, v_rd_off(d0, ks + 1, 0)); H[(ks + 1) & 1][d0] = tr_read(vb, v_rd_off(d0, ks + 1, 1)); }
        }
        const bf16x8 pa = ks == 0 ? pa0 : (ks == 1 ? pa1 : (ks == 2 ? pa2 : pa3));
#pragma unroll
        for (int d0 = 0; d0 < 4; ++d0) { const s16x4 l = L[ks & 1][d0], h = H[ks & 1][d0];
            o[d0] = __builtin_amdgcn_mfma_f32_32x32x16_bf16(pa, (bf16x8){l[0], l[1], l[2], l[3], h[0], h[1], h[2], h[3]}, o[d0], 0, 0, 0); }
    }
}
__device__ __forceinline__ void pack_p(const f32x16& p0, const f32x16& p1, bf16x8& pa0, bf16x8& pa1, bf16x8& pa2, bf16x8& pa3) {
#define PK4(P, BASE, OUT) do { unsigned a0 = cvt_pk_bf16(P[BASE + 0], P[BASE + 1]), a1 = cvt_pk_bf16(P[BASE + 2], P[BASE + 3]);   \
    unsigned b0 = cvt_pk_bf16(P[BASE + 4], P[BASE + 5]), b1 = cvt_pk_bf16(P[BASE + 6], P[BASE + 7]);                              \
    auto r0 = __builtin_amdgcn_permlane32_swap(a0, b0, false, false); auto r1 = __builtin_amdgcn_permlane32_swap(a1, b1, false, false); \
    u32x4 w = {r0[0], r1[0], r0[1], r1[1]}; OUT = *reinterpret_cast<bf16x8*>(&w); } while (0)
    PK4(p0, 0, pa0); PK4(p0, 8, pa1); PK4(p1, 0, pa2); PK4(p1, 8, pa3);
#undef PK4
}

__device__ __forceinline__ void pack_half(const f32x16& p, bf16x8& paA, bf16x8& paB) {
#define PK4(P, BASE, OUT) do { unsigned a0 = cvt_pk_bf16(P[BASE + 0], P[BASE + 1]), a1 = cvt_pk_bf16(P[BASE + 2], P[BASE + 3]);   \
    unsigned b0 = cvt_pk_bf16(P[BASE + 4], P[BASE + 5]), b1 = cvt_pk_bf16(P[BASE + 6], P[BASE + 7]);                              \
    auto r0 = __builtin_amdgcn_permlane32_swap(a0, b0, false, false); auto r1 = __builtin_amdgcn_permlane32_swap(a1, b1, false, false); \
    u32x4 w = {r0[0], r1[0], r0[1], r1[1]}; OUT = *reinterpret_cast<bf16x8*>(&w); } while (0)
    PK4(p, 0, paA); PK4(p, 8, paB);
#undef PK4
}
template <int KS0, bool WITH_EXP>
__device__ __forceinline__ void pv_half(f32x16* o, int vb, bf16x8 paA, bf16x8 paB, f32x16& px, float off) {
    s16x4 L[2][4], H[2][4];
#pragma unroll
    for (int d0 = 0; d0 < 4; ++d0) { L[0][d0] = tr_read(vb, v_rd_off(d0, KS0, 0)); H[0][d0] = tr_read(vb, v_rd_off(d0, KS0, 1)); }
#pragma unroll
    for (int d0 = 0; d0 < 4; ++d0) { L[1][d0] = tr_read(vb, v_rd_off(d0, KS0 + 1, 0)); H[1][d0] = tr_read(vb, v_rd_off(d0, KS0 + 1, 1)); }
#pragma unroll
    for (int kk = 0; kk < 2; ++kk) {
        const bf16x8 pa = kk == 0 ? paA : paB;
#pragma unroll
        for (int d0 = 0; d0 < 4; ++d0) { const s16x4 l = L[kk][d0], h = H[kk][d0];
            if (WITH_EXP) SBAR();
            o[d0] = __builtin_amdgcn_mfma_f32_32x32x16_bf16(pa, (bf16x8){l[0], l[1], l[2], l[3], h[0], h[1], h[2], h[3]}, o[d0], 0, 0, 0);
            if (WITH_EXP) {
#pragma unroll
                for (int q = 0; q < 2; ++q) { const int r = (kk * 4 + d0) * 2 + q; px[r] = __builtin_amdgcn_exp2f(fmaf(px[r], SM_C, off)); }
                SBAR(); }
        }
    }
}
enum { MODE_CMP = 0, MODE_WIN = 1, MODE_SLC = 2 };
struct AttnArgs {
    const bf16_t* Z; const bf16_t* KC; const bf16_t* VC; const float* G; float* L; float* OACC; bf16_t* MIX; const unsigned* BM; const float* TAB;
};
template <int MODE>
__device__ __forceinline__ void attn_unit(const AttnArgs& a, LAS char* ldsL, int qt, int g, int hp) {
    char* lds = (char*)ldsL;
    const int tid = threadIdx.x, wid = __builtin_amdgcn_readfirstlane(tid >> 6), lane = tid & 63, r32 = lane & 31, hi = lane >> 5;
    float* li_l = (float*)(lds + LDS_XCH) + wid * 64;
    const int t0 = MODE == MODE_SLC ? qt * 40 : qt * 128;
    const int tq_raw = MODE == MODE_SLC ? t0 + wid * 5 + r32 / 6 : t0 + wid * 16 + (r32 & 15);
    const bool rvalid = MODE == MODE_SLC ? (r32 < 30 && tq_raw < S_) : true;
    const int tq = tq_raw < S_ ? tq_raw : S_ - 1;
    const int hq = MODE == MODE_SLC ? g * HPG + r32 % 6 : g * HPG + hp * 2 + (r32 >> 4);
    const int tlast = MODE == MODE_SLC ? ((t0 + 39) < S_ ? (t0 + 39) : S_ - 1) : t0 + 127;
    const bf16_t* Kb; const bf16_t* Vb; long ldk;
    if (MODE == MODE_CMP) { Kb = a.KC + (size_t)g * 1024 * HD; Vb = a.VC + (size_t)g * 1024 * HD; ldk = HD; }
    else if (MODE == MODE_WIN) { Kb = a.Z + OFF_KV + 4 * 512 + g * HD; Vb = a.Z + OFF_KV + 5 * 512 + g * HD; ldk = LDZ; }
    else { Kb = a.Z + OFF_KV + 2 * 512 + g * HD; Vb = a.Z + OFF_KV + 3 * 512 + g * HD; ldk = LDZ; }
    int j0, j1;
    if (MODE == MODE_CMP) { j0 = 0; j1 = (((t0 + 127 - 31) >> 4) >> 6) + 1; }
    else if (MODE == MODE_WIN) { j0 = (t0 - 511) > 0 ? ((t0 - 511) >> 6) : 0; j1 = ((t0 + 127) >> 6) + 1; }
    else { j0 = 0; j1 = (tlast >> 6) + 1; }
    int klo, khi;
    if (MODE == MODE_CMP) { klo = 0; khi = tq >= 31 ? ((tq - 31) >> 4) : -1; }
    else if (MODE == MODE_WIN) { klo = tq - 511; khi = tq; }
    else { klo = 0; khi = rvalid ? tq : -1; }
    float negBC = -a.TAB[512 + (MODE == MODE_CMP ? 0 : (MODE == MODE_SLC ? 1 : 2))];
    bf16x8 qr[8];
    { const bf16_t* Qw = a.Z + (size_t)tq * LDZ + OFF_Q + hq * HD + hi * 8;
#pragma unroll
      for (int d0 = 0; d0 < 8; ++d0) qr[d0] = *reinterpret_cast<const bf16x8*>(Qw + d0 * 16); }
    f32x16 o[4] = {}; float lsum = 0.f;
    unsigned soK[2], soV[2];
#pragma unroll
    for (int i = 0; i < 2; ++i) { const int p = (wid + 8 * i) * 64 + lane;
        { const int row = p >> 4, c = (p & 15) ^ (row & 7); soK[i] = (unsigned)(row * ldk + c * 8) * 2u; }
        { const int sub = p >> 5, within = p & 31, kk = (sub >> 2) * 8 + (within >> 2), c = (sub & 3) * 32 + (within & 3) * 8, k = (kk & ~0xC) | ((kk & 4) << 1) | ((kk & 8) >> 1);
          soV[i] = (unsigned)(k * ldk + c) * 2u; } }
    const int vb0 = (int)(uintptr_t)(LAS char*)ldsL + 16384 + v_rd_base(lane);
#define ISSUE(jt) do { const int _b = ((jt) - j0) & 3; const char* _kp = (const char*)Kb + (size_t)(jt) * KVBLK * ldk * 2; const char* _vp = (const char*)Vb + (size_t)(jt) * KVBLK * ldk * 2; \
    _Pragma("unroll") for (int _i = 0; _i < 2; ++_i) { \
        __builtin_amdgcn_global_load_lds((const unsigned*)(_kp + soK[_i]), (LAS unsigned*)(ldsL + _b * 32768 + (wid + 8 * _i) * 1024), 16, 0, 0); \
        __builtin_amdgcn_global_load_lds((const unsigned*)(_vp + soV[_i]), (LAS unsigned*)(ldsL + _b * 32768 + 16384 + (wid + 8 * _i) * 1024), 16, 0, 0); } } while (0)
    unsigned bmw = 0u;
    if (MODE == MODE_SLC) bmw = a.BM[((size_t)tq * 4 + g) * 8];
    asm volatile("s_waitcnt lgkmcnt(0)" ::: "memory");
    __builtin_amdgcn_s_barrier();
    asm volatile("" ::: "memory");
    ISSUE(j0);
    asm volatile("s_waitcnt vmcnt(4) lgkmcnt(0)" : "+v"(bmw), "+v"(negBC), "+v"(qr[0]), "+v"(qr[1]), "+v"(qr[2]), "+v"(qr[3]), "+v"(qr[4]), "+v"(qr[5]), "+v"(qr[6]), "+v"(qr[7]) :: "memory");
    if (j0 + 1 < j1) ISSUE(j0 + 1); if (j0 + 2 < j1) ISSUE(j0 + 2);
    for (int j = j0; j < j1; ++j) {
        const int buf = (j - j0) & 3;
        if (j + 2 < j1) asm volatile("s_waitcnt vmcnt(8)" ::: "memory"); else if (j + 1 < j1) asm volatile("s_waitcnt vmcnt(4)" ::: "memory"); else asm volatile("s_waitcnt vmcnt(0)" ::: "memory");
        __builtin_amdgcn_s_barrier();
        asm volatile("" ::: "memory");
        if (j + 3 < j1) ISSUE(j + 3);
        int lhi = khi;
        if (MODE == MODE_SLC) { if (!((bmw >> (j & 31)) & 1u)) lhi = -1; }
        const int kb = j * KVBLK;
        const bool l_any = (kb + 63 >= klo) && (kb <= lhi);
        const bool l_full = (kb >= klo) && (kb + 63 <= lhi);
        if (__any(l_any)) {
            f32x16 p0, p1;
            qkt(p0, p1, lds + buf * 32768, qr, r32, hi);
            const bool uni = __all(l_full || !l_any);
            const float off = (uni && !l_any) ? -1.0e30f : negBC;
#pragma unroll
            for (int r = 0; r < 16; ++r) p0[r] = __builtin_amdgcn_exp2f(fmaf(p0[r], SM_C, off));
            if (!uni) {
#pragma unroll
                for (int r = 0; r < 16; ++r) { const int k0i = kb + crow(r, hi); p0[r] = (k0i >= klo && k0i <= lhi) ? p0[r] : 0.f; } }
            float ps = 0.f;
#pragma unroll
            for (int r = 0; r < 16; ++r) ps += p0[r];
            bf16x8 pa0, pa1, pa2, pa3; pack_half(p0, pa0, pa1);
            pv_half<0, true>(o, vb0 + buf * 32768, pa0, pa1, p1, off);
            if (!uni) {
#pragma unroll
                for (int r = 0; r < 16; ++r) { const int k1i = kb + 32 + crow(r, hi); p1[r] = (k1i >= klo && k1i <= lhi) ? p1[r] : 0.f; } }
#pragma unroll
            for (int r = 0; r < 16; ++r) ps += p1[r];
            lsum += ps;
            pack_half(p1, pa2, pa3);
            pv_half<2, false>(o, vb0 + buf * 32768, pa2, pa3, p1, off);
        }
        if (MODE == MODE_SLC) { if (((j + 1) & 31) == 0 && j + 1 < j1) { bmw = a.BM[((size_t)tq * 4 + g) * 8 + ((j + 1) >> 5)]; asm volatile("s_waitcnt vmcnt(0)" : "+v"(bmw) :: "memory"); } }
    }
#undef ISSUE
    lsum += __shfl_xor(lsum, 32);
    const float grow = a.G[(size_t)tq * NGATE + hq * 3 + (MODE == MODE_CMP ? 0 : (MODE == MODE_SLC ? 1 : 2))];
    if (hi == 0) { li_l[r32] = lsum; li_l[32 + r32] = rvalid ? grow : 0.f; }
    if (MODE == MODE_CMP) { if (hi == 0) a.L[(size_t)tq * NH + hq] = lsum; }
    asm volatile("s_waitcnt lgkmcnt(0)" ::: "memory");
#pragma unroll
    for (int hf = 0; hf < 2; ++hf) {
        float gtv[8]; float pvv[8][4];
#pragma unroll
        for (int rr = 0; rr < 8; ++rr) { const int r = hf * 8 + rr;
            const int orow = crow(r, hi); const float lv = li_l[orow]; const float rl = lv > 0.f ? __builtin_amdgcn_rcpf(lv) : 0.f;
            const int t = MODE == MODE_SLC ? t0 + wid * 5 + orow / 6 : t0 + wid * 16 + (orow & 15);
            const int h = MODE == MODE_SLC ? g * HPG + orow % 6 : g * HPG + hp * 2 + (orow >> 4);
            const bool valid = !(MODE == MODE_SLC && (orow >= 30 || t >= S_)); const int tc = valid ? t : 0;
            gtv[rr] = li_l[32 + orow] * rl;
            if (MODE == MODE_SLC) { const bf16_t* oc = (const bf16_t*)a.OACC + (size_t)tc * 3072 + h * HD + r32; const bf16_t* ow = oc + (size_t)S_ * 3072;
#pragma unroll
                for (int d0 = 0; d0 < 4; ++d0) pvv[rr][d0] = bf2f(oc[d0 * 32]) + bf2f(ow[d0 * 32]); }
        }
#pragma unroll
        for (int rr = 0; rr < 8; ++rr) { const int r = hf * 8 + rr;
            const int orow = crow(r, hi);
            const int t = MODE == MODE_SLC ? t0 + wid * 5 + orow / 6 : t0 + wid * 16 + (orow & 15);
            const int h = MODE == MODE_SLC ? g * HPG + orow % 6 : g * HPG + hp * 2 + (orow >> 4);
            if (MODE == MODE_SLC && (orow >= 30 || t >= S_)) continue;
            bf16_t* oa = (bf16_t*)a.OACC + (MODE == MODE_WIN ? (size_t)S_ * 3072 : 0) + (size_t)t * 3072 + h * HD + r32;
#pragma unroll
            for (int d0 = 0; d0 < 4; ++d0) {
                const float v = o[d0][r] * gtv[rr];
                if (MODE != MODE_SLC) oa[d0 * 32] = (bf16_t)(cvt_pk_bf16(v, 0.f) & 0xffffu);
                else a.MIX[(size_t)t * DM + POOLW + h * HD + d0 * 32 + r32] = (bf16_t)(cvt_pk_bf16(pvv[rr][d0] + v, 0.f) & 0xffffu);
            }
        }
    }
}

constexpr int SLC_KPS = 1040, SLC_VPS = 1056, SLC_KIMG = 16 * SLC_KPS, SLC_BUF = SLC_KIMG + 16 * SLC_VPS, LDS_SLCX = 4 * SLC_BUF;
static_assert(LDS_SLCX + 3072 <= LDS_MISC, "slc ring overlaps the barrier words");
__device__ __forceinline__ bf16x8 lds_b128(int adr) { return *reinterpret_cast<const LAS bf16x8*>((LAS char*)(unsigned long)(unsigned)adr); }
__device__ __forceinline__ void slc16_unit(const AttnArgs& a, LAS char* ldsL, int ut, int g) {
    char* lds = (char*)ldsL;
    const int tid = threadIdx.x, wid = __builtin_amdgcn_readfirstlane(tid >> 6), lane = tid & 63, fr = lane & 15, fq = lane >> 4;
    float* li_l = (float*)(lds + LDS_SLCX) + wid * 96;
    const int t0 = ut * 64, j0 = 0, j1 = ut + 1;
    const bf16_t* Kb = a.Z + OFF_KV + 2 * 512 + g * HD; const long ldk = LDZ;
    int tqv[3];
#pragma unroll
    for (int b = 0; b < 3; ++b) tqv[b] = t0 + wid * 8 + (16 * b + fr) / 6;
#define TQC(b) tqv[b]
#define HQ(b) (g * HPG + (16 * (b) + fr) % 6)
    float negBC = -a.TAB[513];
    bf16x8 qf[3][4];
#pragma unroll
    for (int b = 0; b < 3; ++b) { const bf16_t* qp = a.Z + (size_t)TQC(b) * LDZ + OFF_Q + HQ(b) * HD + fq * 8;
#pragma unroll
        for (int ks = 0; ks < 4; ++ks) qf[b][ks] = *reinterpret_cast<const bf16x8*>(qp + ks * 32); }
    f32x4 o[3][8]; float lsum[3];
#pragma unroll
    for (int b = 0; b < 3; ++b) { lsum[b] = 0.f;
#pragma unroll
        for (int c = 0; c < 8; ++c) o[b][c] = (f32x4){0.f, 0.f, 0.f, 0.f}; }
    const int q4 = fr >> 2, p4 = fr & 3, lbase = (int)(uintptr_t)ldsL;
    const int kaddr0 = lbase + fr * SLC_KPS + fq * 16;
    const int vaddr0 = lbase + SLC_KIMG + (4 * fq + q4) * SLC_VPS + (p4 >> 1) * 16 + (p4 & 1) * 8;
    unsigned so0 = (unsigned)((wid + 16 * (lane >> 4)) * ldk + (lane & 15) * 8) * 2u;
#define ISSUE16(jt) do { const int _b = ((jt) - j0) & 3; const char* _kp = (const char*)Kb + (size_t)(jt) * KVBLK * ldk * 2; asm volatile("" : "+v"(so0)); \
    _Pragma("unroll") for (int _i = 0; _i < 4; ++_i) \
        __builtin_amdgcn_global_load_lds((const unsigned*)(_kp + (_i >> 1) * 1024 + (_i & 1) * (8 * ldk * 2) + so0), \
            (LAS unsigned*)(ldsL + _b * SLC_BUF + ((_i >> 1) ? SLC_KIMG + (wid + 8 * (_i & 1)) * SLC_VPS : (wid + 8 * (_i & 1)) * SLC_KPS)), 16, 0, 0); } while (0)
    unsigned bmw[3];
#pragma unroll
    for (int b = 0; b < 3; ++b) bmw[b] = a.BM[((size_t)TQC(b) * 4 + g) * 8];
    asm volatile("s_waitcnt lgkmcnt(0)" ::: "memory");
    __builtin_amdgcn_s_barrier();
    asm volatile("" ::: "memory");
    ISSUE16(j0); if (j0 + 1 < j1) ISSUE16(j0 + 1);
    asm volatile("s_waitcnt vmcnt(0) lgkmcnt(0)" : "+v"(bmw[0]), "+v"(bmw[1]), "+v"(bmw[2]), "+v"(negBC), "+v"(qf[0][0]), "+v"(qf[0][1]), "+v"(qf[0][2]), "+v"(qf[0][3]),
                 "+v"(qf[1][0]), "+v"(qf[1][1]), "+v"(qf[1][2]), "+v"(qf[1][3]), "+v"(qf[2][0]), "+v"(qf[2][1]), "+v"(qf[2][2]), "+v"(qf[2][3]) :: "memory");
    int kadr = kaddr0, vadr = vaddr0;
    for (int j = j0; j < j1; ++j) {
        const int buf = (j - j0) & 3;
        if ((j & 1) == 0) {
            asm volatile("s_waitcnt vmcnt(0)" ::: "memory");
            __builtin_amdgcn_s_barrier();
            asm volatile("" ::: "memory");
            if (j + 2 < j1) ISSUE16(j + 2); if (j + 3 < j1) ISSUE16(j + 3); }
        const int kb = j * KVBLK;
#define KF16(ks, mt) lds_b128(kadr + 64 * (ks) + 256 * (mt))
#define TRA(dst, off) asm volatile("ds_read_b64_tr_b16 %0, %1 offset:%2" : "=v"(dst) : "v"(vadr), "n"(off))
#define VLOAD(dst, s, h) _Pragma("unroll") for (int _c = 0; _c < 4; ++_c) { TRA(dst[_c][0], 32 * (4 * (h) + _c) + 512 * (s)); TRA(dst[_c][1], 32 * (4 * (h) + _c) + 512 * (s) + 256); }
#define VWAIT(n, d) asm volatile("s_waitcnt lgkmcnt(" #n ")" : "+v"(d[0][0]), "+v"(d[0][1]), "+v"(d[1][0]), "+v"(d[1][1]), "+v"(d[2][0]), "+v"(d[2][1]), "+v"(d[3][0]), "+v"(d[3][1]))
#define PVMMA(src, pa, h) _Pragma("unroll") for (int _c = 0; _c < 4; ++_c) o[b][4 * (h) + _c] = __builtin_amdgcn_mfma_f32_16x16x32_bf16(pa, \
            (bf16x8){src[_c][0][0], src[_c][0][1], src[_c][0][2], src[_c][0][3], src[_c][1][0], src[_c][1][1], src[_c][1][2], src[_c][1][3]}, o[b][4 * (h) + _c], 0, 0, 0);
#define EXPH(h, pw) { if (uni) { _Pragma("unroll") for (int mt = 2 * (h); mt < 2 * (h) + 2; ++mt) _Pragma("unroll") for (int i = 0; i < 4; ++i) { \
                            const float e_ = __builtin_amdgcn_exp2f(fmaf(acc[mt][i], SM_C, off)); acc[mt][i] = e_; ps += e_; } } \
                      else { asm volatile("" ::: "memory"); _Pragma("unroll") for (int mt = 2 * (h); mt < 2 * (h) + 2; ++mt) _Pragma("unroll") for (int i = 0; i < 4; ++i) { \
                            float e_ = __builtin_amdgcn_exp2f(fmaf(acc[mt][i], SM_C, off)); e_ = (16 * mt + i <= lim4) ? e_ : 0.f; acc[mt][i] = e_; ps += e_; } } \
                      pw.x = cvt_pk_bf16(acc[2 * (h)][0], acc[2 * (h)][1]); pw.y = cvt_pk_bf16(acc[2 * (h)][2], acc[2 * (h)][3]); \
                      pw.z = cvt_pk_bf16(acc[2 * (h) + 1][0], acc[2 * (h) + 1][1]); pw.w = cvt_pk_bf16(acc[2 * (h) + 1][2], acc[2 * (h) + 1][3]); }
#pragma unroll
        for (int b = 0; b < 3; ++b) {
            const bool sel = (bmw[b] >> (j & 31)) & 1u;
            const int lim = tqv[b] - kb;
            const bool l_any = sel && lim >= 0, l_full = sel && lim >= 63;
            if (__any(l_any)) {
                f32x4 acc[4]; bf16x8 kr[8]; s16x4 va[4][2], vc[4][2];
#define KRD(i) asm volatile("ds_read_b128 %0, %1 offset:%2" : "=v"(kr[(i) & 7]) : "v"(kadr), "n"(64 * ((i) >> 2) + 256 * ((i) & 3)))
#define KWT(n, i) asm volatile("s_waitcnt lgkmcnt(" #n ")" : "+v"(kr[(i) & 7]))
#define KMM(i) acc[(i) & 3] = __builtin_amdgcn_mfma_f32_16x16x32_bf16(kr[(i) & 7], qf[b][(i) >> 2], (i) < 4 ? (f32x4){0.f, 0.f, 0.f, 0.f} : acc[(i) & 3], 0, 0, 0)
                KRD(0); KRD(1); KRD(2); KRD(3); KRD(4); KRD(5); KRD(6); KRD(7);
#define SB_ __builtin_amdgcn_sched_barrier(0)
                SB_; KWT(7, 0); KMM(0); SB_; KRD(8);  KWT(7, 1); KMM(1); SB_; KRD(9);  KWT(7, 2); KMM(2); SB_; KRD(10); KWT(7, 3); KMM(3); SB_; KRD(11);
                KWT(7, 4); KMM(4); SB_; KRD(12); KWT(7, 5); KMM(5); SB_; KRD(13); KWT(7, 6); KMM(6); SB_; KRD(14); KWT(7, 7); KMM(7); SB_; KRD(15);
                KWT(7, 8); KMM(8); SB_; KWT(6, 9); KMM(9); SB_; KWT(5, 10); KMM(10); SB_; KWT(4, 11); KMM(11); SB_; KWT(3, 12); KMM(12); SB_; KWT(2, 13); KMM(13); SB_; KWT(1, 14); KMM(14); SB_; KWT(0, 15); KMM(15);
#undef SB_
                __builtin_amdgcn_sched_barrier(0);
#undef KRD
#undef KWT
#undef KMM
                VLOAD(va, 0, 0)
                VLOAD(vc, 0, 1)
                const bool uni = __all(l_full || !l_any);
                const float off = (uni && !l_any) ? -1.0e30f : negBC;
                const int lim4 = l_any ? lim - 4 * fq : -1;
                float ps = 0.f;
                u32x4 pw0, pw1;
                EXPH(0, pw0)
                const bf16x8 pa0 = *reinterpret_cast<bf16x8*>(&pw0);
                __builtin_amdgcn_sched_barrier(0);
                VWAIT(8, va);
                PVMMA(va, pa0, 0)
                __builtin_amdgcn_sched_barrier(0);
                VLOAD(va, 1, 0)
                VWAIT(8, vc);
                PVMMA(vc, pa0, 1)
                __builtin_amdgcn_sched_barrier(0);
                VLOAD(vc, 1, 1)
                EXPH(1, pw1)
                const bf16x8 pa1 = *reinterpret_cast<bf16x8*>(&pw1);
                lsum[b] += ps;
                __builtin_amdgcn_sched_barrier(0);
                VWAIT(8, va);
                PVMMA(va, pa1, 0)
                __builtin_amdgcn_sched_barrier(0);
                VWAIT(0, vc);
                PVMMA(vc, pa1, 1)
                __builtin_amdgcn_sched_barrier(0);
            }
        }
#undef TRA
#undef VWAIT
#undef EXPH
#undef KF16
#undef VLOAD
#undef PVMMA
        if (((j + 1) & 31) == 0 && j + 1 < j1) {
#pragma unroll
            for (int b = 0; b < 3; ++b) bmw[b] = a.BM[((size_t)TQC(b) * 4 + g) * 8 + ((j + 1) >> 5)];
            asm volatile("s_waitcnt vmcnt(0)" : "+v"(bmw[0]), "+v"(bmw[1]), "+v"(bmw[2]) :: "memory"); }
        { const int step = buf == 3 ? -3 * SLC_BUF : SLC_BUF; kadr += step; vadr += step; asm volatile("" : "+v"(kadr), "+v"(vadr)); }
    }
#undef ISSUE16
    int fqe = fq, fre = fr; asm volatile("" : "+v"(fqe), "+v"(fre));
    float grow[3];
#pragma unroll
    for (int b = 0; b < 3; ++b) grow[b] = a.G[(size_t)TQC(b) * NGATE + (g * HPG + (16 * b + fre) % 6) * 3 + 1];
#pragma unroll
    for (int b = 0; b < 3; ++b) { float ls = lsum[b]; ls += __shfl_xor(ls, 16); ls += __shfl_xor(ls, 32);
        if (fqe == 0) { li_l[b * 32 + fre] = ls; li_l[b * 32 + 16 + fre] = grow[b]; } }
    asm volatile("s_waitcnt lgkmcnt(0)" ::: "memory");
#pragma unroll
    for (int b = 0; b < 3; ++b) {
        float pv_[4][8]; float gtv[4];
#pragma unroll
        for (int i = 0; i < 4; ++i) { const int q = 4 * fqe + i, R = 16 * b + q; const float lv = li_l[b * 32 + q]; gtv[i] = li_l[b * 32 + 16 + q] * (lv > 0.f ? __builtin_amdgcn_rcpf(lv) : 0.f);
            const int t = t0 + wid * 8 + R / 6, h = g * HPG + R % 6;
            const bf16_t* oc = (const bf16_t*)a.OACC + (size_t)t * 3072 + h * HD + fre; const bf16_t* ow = oc + (size_t)S_ * 3072;
            bf16_t c_[8], w_[8];
#pragma unroll
            for (int c = 0; c < 8; ++c) { c_[c] = oc[c * 16]; w_[c] = ow[c * 16]; }
#pragma unroll
            for (int c = 0; c < 8; ++c) pv_[i][c] = bf2f(c_[c]) + bf2f(w_[c]); }
#pragma unroll
        for (int i = 0; i < 4; ++i) { const int R = 16 * b + 4 * fqe + i; const int t = t0 + wid * 8 + R / 6, h = g * HPG + R % 6;
            bf16_t* mp = a.MIX + (size_t)t * DM + POOLW + h * HD + fre;
#pragma unroll
            for (int c = 0; c < 8; ++c) mp[c * 16] = (bf16_t)(cvt_pk_bf16(pv_[i][c] + o[b][c][i] * gtv[i], 0.f) & 0xffffu); }
    }
#undef TQC
#undef HQ
}

__device__ __forceinline__ void imp_task(const AttnArgs& a, float* IMPP, float* IMPF, int tqi, int g) {
    const int lane = threadIdx.x & 63, fr = lane & 15, fq = lane >> 4;
    const int t = tqi * 16 + fr;
    const int tmax = tqi * 16 + 15;
    if (tmax < 31) return;
    const int lim = t >= 31 ? ((t - 31) >> 4) : -1;
    const int nstep = ((((tmax - 31) >> 4) >> 6) + 1) * 4;
    const float negBC = -a.TAB[512];
    bf16x8 qf[HPG][4]; float rl[HPG];
#pragma unroll
    for (int h = 0; h < HPG; ++h) {
        const bf16_t* qp = a.Z + (size_t)t * LDZ + OFF_Q + (g * HPG + h) * HD + fq * 8;
#pragma unroll
        for (int ks = 0; ks < 4; ++ks) qf[h][ks] = *reinterpret_cast<const bf16x8*>(qp + ks * 32);
        const float lv = a.L[(size_t)t * NH + g * HPG + h]; rl[h] = lv > 0.f ? 1.0f / lv : 0.f;
    }
    const bf16_t* kbase = a.KC + (size_t)g * 1024 * HD + (size_t)fr * HD + fq * 8;
    bf16x8 kf[4], kn[4], kn2[4];
#pragma unroll
    for (int ks = 0; ks < 4; ++ks) { kf[ks] = *reinterpret_cast<const bf16x8*>(kbase + ks * 32); kn[ks] = *reinterpret_cast<const bf16x8*>(kbase + (size_t)(nstep > 1 ? 1 : 0) * 16 * HD + ks * 32); }
    float* op = IMPP + ((size_t)t * 4 + g) * 256 + fq; float* of = IMPF + ((size_t)t * 4 + g) * 256 + fq;
    for (int st = 0; st < nstep; ++st) {
        const int sn = (st + 2 < nstep) ? st + 2 : nstep - 1;
#pragma unroll
        for (int ks = 0; ks < 4; ++ks) kn2[ks] = *reinterpret_cast<const bf16x8*>(kbase + (size_t)sn * 16 * HD + ks * 32);
        f32x4 imp4 = {0.f, 0.f, 0.f, 0.f};
        const int n0 = st * 16 + fq * 4;
#pragma unroll
        for (int h = 0; h < HPG; ++h) {
            f32x4 acc = {0.f, 0.f, 0.f, 0.f};
#pragma unroll
            for (int ks = 0; ks < 4; ++ks) acc = __builtin_amdgcn_mfma_f32_16x16x32_bf16(kf[ks], qf[h][ks], acc, 0, 0, 0);
#pragma unroll
            for (int i = 0; i < 4; ++i) { const float e = __builtin_amdgcn_exp2f(fmaf(acc[i], SM_C, negBC)) * rl[h]; imp4[i] += (n0 + i <= lim) ? e : 0.f; }
        }
        op[st * 4] = imp4[0] + 2.0f * (imp4[1] + imp4[2] + imp4[3]);
        of[st * 4] = imp4[0];
#pragma unroll
        for (int ks = 0; ks < 4; ++ks) { kf[ks] = kn[ks]; kn[ks] = kn2[ks]; }
    }
}

__device__ __forceinline__ void topk_load(const float* IMPP, const float* IMPF, int t, int g, f32x4& pp, f32x4& ff) {
    const int lane = threadIdx.x & 63, cur = t >> 6, jb = lane * 4;
    pp = (f32x4){0.f, 0.f, 0.f, 0.f}; ff = pp;
    if (cur > 15 && jb <= cur) { const size_t base = ((size_t)t * 4 + g) * 256; pp = *(const f32x4*)(IMPP + base + jb); ff = *(const f32x4*)(IMPF + base + jb); }
}
__device__ __forceinline__ void topk_task(const f32x4 pp, const f32x4 ff, unsigned* BM, int t, int g) {
    const int lane = threadIdx.x & 63;
    const int cur = t >> 6;
    unsigned nib = 0u;
    if (cur <= 15) { const int jb = lane * 4;
#pragma unroll
        for (int c = 0; c < 4; ++c) if (jb + c <= cur) nib |= 1u << c; }
    else {
        const int jb = lane * 4;
        unsigned key[4];
        {
            float fnext = __shfl_down(ff[0], 1);
            if (lane == 63) fnext = 0.f;
            const float v0 = pp[0] + ff[1], v1 = pp[1] + ff[2], v2 = pp[2] + ff[3], v3 = pp[3] + fnext;
            key[0] = (jb + 0 >= 1 && jb + 0 <= cur - 2) ? __float_as_uint(fmaxf(v0, 0.f)) + 1u : 0u;
            key[1] = (jb + 1 >= 1 && jb + 1 <= cur - 2) ? __float_as_uint(fmaxf(v1, 0.f)) + 1u : 0u;
            key[2] = (jb + 2 >= 1 && jb + 2 <= cur - 2) ? __float_as_uint(fmaxf(v2, 0.f)) + 1u : 0u;
            key[3] = (jb + 3 >= 1 && jb + 3 <= cur - 2) ? __float_as_uint(fmaxf(v3, 0.f)) + 1u : 0u;
        }
        unsigned prefix = 0u; bool exact = false;
        for (int b = 30; b >= 0; --b) {
            const unsigned trial = prefix | (1u << b);
            const int cnt = __popcll(__ballot(key[0] >= trial)) + __popcll(__ballot(key[1] >= trial)) + __popcll(__ballot(key[2] >= trial)) + __popcll(__ballot(key[3] >= trial));
            if (cnt >= 13) { prefix = trial; if (cnt == 13) { exact = true; break; } }
        }
#pragma unroll
        for (int c = 0; c < 4; ++c) if (exact ? (key[c] >= prefix) : (key[c] > prefix)) nib |= 1u << c;
        if (!exact) {
            int need = 13 - (__popcll(__ballot(key[0] > prefix)) + __popcll(__ballot(key[1] > prefix)) + __popcll(__ballot(key[2] > prefix)) + __popcll(__ballot(key[3] > prefix)));
            unsigned tie = 0u;
#pragma unroll
            for (int c = 0; c < 4; ++c) if (key[c] == prefix) tie |= 1u << c;
            for (int guard = 0; need > 0 && guard < 16; ++guard) {
                const unsigned long long any = __ballot(tie != 0u);
                if (any == 0ull) break;
                const int L = __builtin_ctzll(any);
                if (lane == L) { const unsigned low = tie & (0u - tie); nib |= low; tie ^= low; }
                --need;
            }
        }
        if (lane == 0) nib |= 1u;
        if (lane == (cur >> 2)) nib |= 1u << (cur & 3);
        if (lane == ((cur - 1) >> 2)) nib |= 1u << ((cur - 1) & 3);
    }
    unsigned x = nib << (4 * (lane & 7));
    x |= __shfl_xor(x, 1); x |= __shfl_xor(x, 2); x |= __shfl_xor(x, 4);
    if ((lane & 7) == 0) BM[((size_t)t * 4 + g) * 8 + (lane >> 3)] = x;
}
#undef KSWZ
}

template <bool FFN_REMAP = false>
__device__ __forceinline__ void convT(const float* __restrict__ src0, int K, int N, bf16_t* __restrict__ dst, int ldd, LAS float* tile, int bid, int nb, int Nfull = 0, int n0 = 0, const float* __restrict__ kscale = nullptr) {
    const float* __restrict__ src = src0 + n0; if (Nfull == 0) Nfull = N;
    const int tid = threadIdx.x, tk = K >> 6, tn = (N + 63) >> 6, total = tk * tn;
    const int r = tid >> 4, c4 = (tid & 15) * 4;
    f32x4 v[2] = {{0.f, 0.f, 0.f, 0.f}, {0.f, 0.f, 0.f, 0.f}}, vn[2];
    if (bid < total) { const int nti = bid % tn, kti = bid / tn, ng = nti * 64 + c4;
#pragma unroll
        for (int h = 0; h < 2; ++h) if (ng < N) v[h] = *(const f32x4*)(src + (size_t)(kti * 64 + r + h * 32) * Nfull + ng); }
    for (int idx = bid; idx < total; idx += nb) {
        const int nti = idx % tn, kti = idx / tn;
#pragma unroll
        for (int h = 0; h < 2; ++h) { LAS float* tp = tile + (r + h * 32) * 65 + c4; tp[0] = v[h][0]; tp[1] = v[h][1]; tp[2] = v[h][2]; tp[3] = v[h][3]; }
        {
            const int nx = idx + nb; vn[0] = (f32x4){0.f, 0.f, 0.f, 0.f}; vn[1] = vn[0];
            if (nx < total) { const int nti2 = nx % tn, kti2 = nx / tn, ng2 = nti2 * 64 + c4;
#pragma unroll
                for (int h = 0; h < 2; ++h) if (ng2 < N) vn[h] = *(const f32x4*)(src + (size_t)(kti2 * 64 + r + h * 32) * Nfull + ng2); } }
        __syncthreads();
        const int n = tid >> 3, k8 = (tid & 7) * 8, ngl = nti * 64 + n;
        float e[8];
#pragma unroll
        for (int i = 0; i < 8; ++i) e[i] = tile[(k8 + i) * 65 + n];
        if (kscale) { const f32x4 s0 = *(const f32x4*)(kscale + kti * 64 + k8), s1 = *(const f32x4*)(kscale + kti * 64 + k8 + 4);
            e[0] *= s0[0]; e[1] *= s0[1]; e[2] *= s0[2]; e[3] *= s0[3]; e[4] *= s1[0]; e[5] *= s1[1]; e[6] *= s1[2]; e[7] *= s1[3]; }
        if (ngl < N) { u32x4 w; w.x = cvt_pk_bf16(e[0], e[1]); w.y = cvt_pk_bf16(e[2], e[3]); w.z = cvt_pk_bf16(e[4], e[5]); w.w = cvt_pk_bf16(e[6], e[7]);
            int drow = ngl; if (FFN_REMAP) { const int up = ngl >= DFF ? 1 : 0, f = ngl - up * DFF; drow = (f >> 7) * 256 + up * 128 + (f & 127); }
            *(u32x4*)(dst + (size_t)drow * ldd + kti * 64 + k8) = w; }
        __syncthreads();
        v[0] = vn[0]; v[1] = vn[1];
    }
}
__device__ __forceinline__ void convT8(const float* __restrict__ src0, int K, int N, unsigned char* __restrict__ dst, int ldd, float scale, LAS float* tile, int bid, int nb, int Nfull = 0, int n0 = 0) {
    const float* __restrict__ src = src0 + n0; if (Nfull == 0) Nfull = N;
    const int tid = threadIdx.x, tk = K >> 6, tn = (N + 63) >> 6, total = tk * tn;
    const int r = tid >> 4, c4 = (tid & 15) * 4;
    f32x4 v[2] = {{0.f, 0.f, 0.f, 0.f}, {0.f, 0.f, 0.f, 0.f}}, vn[2];
    if (bid < total) { const int nti = bid % tn, kti = bid / tn, ng = nti * 64 + c4;
#pragma unroll
        for (int h = 0; h < 2; ++h) if (ng < N) v[h] = *(const f32x4*)(src + (size_t)(kti * 64 + r + h * 32) * Nfull + ng); }
    for (int idx = bid; idx < total; idx += nb) {
        const int nti = idx % tn, kti = idx / tn;
#pragma unroll
        for (int h = 0; h < 2; ++h) { LAS float* tp = tile + (r + h * 32) * 65 + c4; tp[0] = v[h][0]; tp[1] = v[h][1]; tp[2] = v[h][2]; tp[3] = v[h][3]; }
        { const int nx = idx + nb; vn[0] = (f32x4){0.f, 0.f, 0.f, 0.f}; vn[1] = vn[0];
            if (nx < total) { const int nti2 = nx % tn, kti2 = nx / tn, ng2 = nti2 * 64 + c4;
#pragma unroll
                for (int h = 0; h < 2; ++h) if (ng2 < N) vn[h] = *(const f32x4*)(src + (size_t)(kti2 * 64 + r + h * 32) * Nfull + ng2); } }
        __syncthreads();
        const int n = tid >> 3, k8 = (tid & 7) * 8, ngl = nti * 64 + n;
        float e[8];
#pragma unroll
        for (int i = 0; i < 8; ++i) e[i] = tile[(k8 + i) * 65 + n] * scale;
        if (ngl < N) { int p0 = __builtin_amdgcn_cvt_pk_fp8_f32(e[0], e[1], 0, false); p0 = __builtin_amdgcn_cvt_pk_fp8_f32(e[2], e[3], p0, true);
            int p1 = __builtin_amdgcn_cvt_pk_fp8_f32(e[4], e[5], 0, false); p1 = __builtin_amdgcn_cvt_pk_fp8_f32(e[6], e[7], p1, true);
            *(u32x2*)(dst + (size_t)ngl * ldd + kti * 64 + k8) = (u32x2){(unsigned)p0, (unsigned)p1}; }
        __syncthreads();
        v[0] = vn[0]; v[1] = vn[1];
    }
}
__device__ __forceinline__ void rmsnorm_rows(const float* __restrict__ src, const float* __restrict__ w, bf16_t* __restrict__ dst, int rows, int gw, int nw, unsigned char* __restrict__ dst8 = nullptr) {
    const int lane = threadIdx.x & 63;
    f32x4 v[16], vn[16];
    if (gw < rows) { const f32x4* sp = (const f32x4*)(src + (size_t)gw * DM);
#pragma unroll
        for (int i = 0; i < 16; ++i) v[i] = sp[lane + 64 * i]; }
    for (int row = gw; row < rows; row += nw) {
        const int nr = row + nw < rows ? row + nw : row;
        { const f32x4* sp = (const f32x4*)(src + (size_t)nr * DM);
#pragma unroll
          for (int i = 0; i < 16; ++i) vn[i] = sp[lane + 64 * i]; }
        float ss = 0.f;
#pragma unroll
        for (int i = 0; i < 16; ++i) ss += v[i][0] * v[i][0] + v[i][1] * v[i][1] + v[i][2] * v[i][2] + v[i][3] * v[i][3];
        ss = wave_sum(ss);
        const float rstd = rsqrtf(ss * (1.0f / DM) + EPS);
#pragma unroll
        for (int i = 0; i < 16; ++i) { const f32x4 ww = ((const f32x4*)w)[lane + 64 * i];
            u32x2 o; o.x = cvt_pk_bf16(v[i][0] * rstd * ww[0], v[i][1] * rstd * ww[1]); o.y = cvt_pk_bf16(v[i][2] * rstd * ww[2], v[i][3] * rstd * ww[3]);
            *(u32x2*)(dst + (size_t)row * DM + (lane + 64 * i) * 4) = o;
            if (dst8) { int pk = __builtin_amdgcn_cvt_pk_fp8_f32(v[i][0] * rstd * ww[0], v[i][1] * rstd * ww[1], 0, false); pk = __builtin_amdgcn_cvt_pk_fp8_f32(v[i][2] * rstd * ww[2], v[i][3] * rstd * ww[3], pk, true);
                *(int*)(dst8 + (size_t)row * DM + (lane + 64 * i) * 4) = pk; } }
#pragma unroll
        for (int i = 0; i < 16; ++i) v[i] = vn[i];
    }
}

struct Ptrs {
    bf16_t *Win, *Wo, *Wfi, *Wfo, *Wg, *Wple, *Wpool, *Wc1k, *Wc1v, *XN, *PB, *Z, *M, *KC, *VC, *MIX, *ACT, *ERAW;
    float *COS, *SIN, *TAB, *G, *H1, *L, *OACC, *IMPP, *IMPF, *ERSTD; unsigned* BM;
};

__device__ __forceinline__ void phase_prologue(const Params& P, const Ptrs& W, LAS unsigned char* lds) {
    const int bid = blockIdx.x, nb = gridDim.x, tid = threadIdx.x, lane = tid & 63, wv = tid >> 6;
    const int gw = bid * NWAVES + wv, nw = nb * NWAVES; const size_t gt = (size_t)bid * NTHREADS + tid, ntot = (size_t)nb * NTHREADS;
    LAS float* tile = (LAS float*)lds;
    rmsnorm_rows(P.x, P.norm1_w, W.XN, S_, gw, nw, P.ws + WS_XN8);
    convT(P.w_in, DM, POOLW, W.Win, DM, tile, bid, nb, INW, 0);
    convT(P.w_in, DM, INW - OFF_G, W.Win + (size_t)OFF_G * DM, DM, tile, bid, nb, INW, OFF_G);
    convT8(P.w_in, DM, OFF_G - POOLW, P.ws + WS_WIN8, DM, WG8_SCALE, tile, bid, nb, INW, POOLW);
    for (size_t i = gt; i < (size_t)(LDZ - INW) * DM / 8; i += ntot) *(u32x4*)(W.Win + (size_t)INW * DM + i * 8) = (u32x4){0u, 0u, 0u, 0u};
    convT(P.w_o, DM, DM, W.Wo, DM, tile, bid, nb);
    convT<true>(P.w_ffn_in, DM, NFI, W.Wfi, DM, tile, bid, nb, 0, 0, P.norm2_w);
    for (size_t i = gt; i < (size_t)2 * DM / 8; i += ntot) *(u32x4*)(W.XN - 2 * DM + i * 8) = (u32x4){0u, 0u, 0u, 0u};
    convT(P.w_ffn_out, DFF, DM, W.Wfo, DFF, tile, bid, nb);
    convT8(P.w_ple_gate, DM, DM, (unsigned char*)W.Wg, DM, WG8_SCALE, tile, bid, nb);
    convT(P.w_ple_proj, PLE, DM, W.Wple, PLE, tile, bid, nb);
    for (int g = 0; g < 4; ++g) convT(P.w_pool + (size_t)g * 65536, 256, 256, W.Wpool + (size_t)g * 65536, 256, tile, bid, nb);
    convT(P.cmp_k_w1, 4096, 256, W.Wc1k, 4096, tile, bid, nb);
    convT(P.cmp_v_w1, 4096, 256, W.Wc1v, 4096, tile, bid, nb);
    { constexpr size_t NP8 = (size_t)S_ * PLE / 8;
      for (size_t ib = gt; ib < NP8; ib += 4 * ntot) { f32x4 av[4], bv[4];
#pragma unroll
          for (int k = 0; k < 4; ++k) { size_t i = ib + k * ntot; if (i >= NP8) i = NP8 - 1; av[k] = *(const f32x4*)(P.p + i * 8); bv[k] = *(const f32x4*)(P.p + i * 8 + 4); }
#pragma unroll
          for (int k = 0; k < 4; ++k) { const size_t i = ib + k * ntot; if (i < NP8) { u32x4 w; w.x = cvt_pk_bf16(av[k][0], av[k][1]); w.y = cvt_pk_bf16(av[k][2], av[k][3]); w.z = cvt_pk_bf16(bv[k][0], bv[k][1]); w.w = cvt_pk_bf16(bv[k][2], bv[k][3]); *(u32x4*)(W.PB + i * 8) = w; } } } }
    for (size_t i = gt; i < (size_t)S_ * 16; i += ntot) { const int t = (int)(i >> 4), fi = (int)(i & 15);
        const float inv = exp2f(-(float)fi * (18.931568569324174f / 16.0f)); const float ang = (float)P.positions[t] * inv;
        const double ad = (double)ang; const double kk = rint(ad * 0.15915494309189535); const float rf = (float)(ad - kk * 6.283185307179586);
        W.COS[i] = __cosf(rf); W.SIN[i] = __sinf(rf); }
    for (int task = gw; task < 128; task += nw) { const int which = task >> 6, r0 = (task & 63) * 64; const float* pe = which ? P.cmp_pos_v : P.cmp_pos_k; const float* w1 = which ? P.cmp_v_w1 : P.cmp_k_w1;
        f32x4 s = {0.f, 0.f, 0.f, 0.f};
#pragma unroll 8
        for (int r = 0; r < 64; ++r) { const f32x4 wv = *(const f32x4*)(w1 + (size_t)(r0 + r) * 256 + lane * 4); s += wv * pe[r0 + r]; }
        float* cbp = (float*)(P.ws + WS_CBIAS) + which * 256 + lane * 4;
        unsafeAtomicAdd(cbp + 0, s[0]); unsafeAtomicAdd(cbp + 1, s[1]); unsafeAtomicAdd(cbp + 2, s[2]); unsafeAtomicAdd(cbp + 3, s[3]); }
    if (gw == 0) { float mq = fmaxf(fabsf(P.q_norm_w[lane]), fabsf(P.q_norm_w[lane + 64])); mq = wave_max(mq);
        float mc = wave_max(fmaxf(fabsf(P.k_norm_cmp_w[lane]), fabsf(P.k_norm_cmp_w[lane + 64])));
        float ms = wave_max(fmaxf(fabsf(P.k_norm_slc_w[lane]), fabsf(P.k_norm_slc_w[lane + 64])));
        float mw = wave_max(fmaxf(fabsf(P.k_norm_win_w[lane]), fabsf(P.k_norm_win_w[lane + 64])));
        const float c = 11.313708498984761f * 1.4426950408889634f * mq * 1.01f;
        if (lane == 0) { W.TAB[512] = c * mc; W.TAB[513] = c * ms; W.TAB[514] = c * mw; } }
}

__device__ __forceinline__ void phase_postz(const Params& P, const Ptrs& W, int gw, int nw) {
    const int tid = threadIdx.x, lane = tid & 63;
    const f32x2 wq = *(const f32x2*)(P.q_norm_w + 2 * lane), wks = *(const f32x2*)(P.k_norm_slc_w + 2 * lane), wkw = *(const f32x2*)(P.k_norm_win_w + 2 * lane);
    for (int t = gw; t < S_; t += nw) {
        bf16_t* zr = W.Z + (size_t)t * LDZ;
        float cs0 = 0.f, cs1 = 0.f, sn0 = 0.f, sn1 = 0.f;
        if (lane < 16) { const int i0 = (2 * lane) & 15; cs0 = W.COS[t * 16 + i0]; cs1 = W.COS[t * 16 + i0 + 1]; sn0 = W.SIN[t * 16 + i0]; sn1 = W.SIN[t * 16 + i0 + 1]; }
        unsigned uv[32];
#pragma unroll
        for (int v = 0; v < 32; ++v) { const int col = v < 24 ? OFF_Q + v * HD : (v < 28 ? OFF_KV + 2 * 512 + (v - 24) * HD : OFF_KV + 4 * 512 + (v - 28) * HD);
            uv[v] = *((const unsigned*)(zr + col) + lane); }
#pragma unroll
        for (int v = 0; v < 32; ++v) {
            const f32x2 ww = v < 24 ? wq : (v < 28 ? wks : wkw);
            const unsigned u = uv[v]; const float x0 = bf_lo(u), x1 = bf_hi(u);
            const float ss = wave_sum(x0 * x0 + x1 * x1);
            const float rstd = rsqrtf(ss * (1.0f / HD) + EPS);
            float y0 = x0 * rstd * ww[0], y1 = x1 * rstd * ww[1];
            const float p0 = __shfl_xor(y0, 8), p1 = __shfl_xor(y1, 8);
            if (lane < 8) { y0 = y0 * cs0 - p0 * sn0; y1 = y1 * cs1 - p1 * sn1; }
            else if (lane < 16) { y0 = y0 * cs0 + p0 * sn0; y1 = y1 * cs1 + p1 * sn1; }
            uv[v] = cvt_pk_bf16(y0, y1);
        }
        {
            const int gi = lane >> 4, wlen = 2 << gi, c0 = lane * 16; const int cnt = (t + 1) < wlen ? (t + 1) : wlen;
            float s[16];
#pragma unroll
            for (int i = 0; i < 16; ++i) s[i] = 0.f;
            float cur[16];
#pragma unroll
            for (int bt = 0; bt < 2; ++bt) {
                u32x4 ra[8], rb[8];
#pragma unroll
                for (int i = 0; i < 8; ++i) { const int ii = bt * 8 + i; const size_t row = (size_t)(ii < cnt ? t - ii : t);
                    ra[i] = *(const u32x4*)(W.Z + row * LDZ + c0); rb[i] = *(const u32x4*)(W.Z + row * LDZ + c0 + 8); }
#pragma unroll
                for (int i = 0; i < 8; ++i) { const int ii = bt * 8 + i; const float mk = ii < cnt ? 1.0f : 0.0f; const u32x4 a = ra[i], b = rb[i];
                    const float ev[16] = {bf_lo(a.x), bf_hi(a.x), bf_lo(a.y), bf_hi(a.y), bf_lo(a.z), bf_hi(a.z), bf_lo(a.w), bf_hi(a.w), bf_lo(b.x), bf_hi(b.x), bf_lo(b.y), bf_hi(b.y), bf_lo(b.z), bf_hi(b.z), bf_lo(b.w), bf_hi(b.w)};
#pragma unroll
                    for (int q = 0; q < 16; ++q) { s[q] += ev[q] * mk; if (ii == 0) cur[q] = ev[q]; } }
                if (bt == 0 && __all(cnt <= 8)) break;
            }
            const float rc = 1.0f / (float)cnt;
            u32x4 o0, o1;
            o0.x = cvt_pk_bf16(s[0] * rc - cur[0], s[1] * rc - cur[1]); o0.y = cvt_pk_bf16(s[2] * rc - cur[2], s[3] * rc - cur[3]);
            o0.z = cvt_pk_bf16(s[4] * rc - cur[4], s[5] * rc - cur[5]); o0.w = cvt_pk_bf16(s[6] * rc - cur[6], s[7] * rc - cur[7]);
            o1.x = cvt_pk_bf16(s[8] * rc - cur[8], s[9] * rc - cur[9]); o1.y = cvt_pk_bf16(s[10] * rc - cur[10], s[11] * rc - cur[11]);
            o1.z = cvt_pk_bf16(s[12] * rc - cur[12], s[13] * rc - cur[13]); o1.w = cvt_pk_bf16(s[14] * rc - cur[14], s[15] * rc - cur[15]);
            *(u32x4*)(W.M + (size_t)t * POOLW + c0) = o0; *(u32x4*)(W.M + (size_t)t * POOLW + c0 + 8) = o1;
        }
#pragma unroll
        for (int v = 0; v < 32; ++v) { const int col = v < 24 ? OFF_Q + v * HD : (v < 28 ? OFF_KV + 2 * 512 + (v - 24) * HD : OFF_KV + 4 * 512 + (v - 28) * HD);
            *((unsigned*)(zr + col) + lane) = uv[v]; }

    }
}

__device__ __forceinline__ void phase_cmpfin(const Params& P, const Ptrs& W) {
    const int tid = threadIdx.x, lane = tid & 63, gw = blockIdx.x * NWAVES + (tid >> 6), nw = gridDim.x * NWAVES;
    const f32x2 wk = *(const f32x2*)(P.k_norm_cmp_w + 2 * lane);
    for (int task = gw; task < 8192; task += nw) {
        const int tk = __builtin_amdgcn_readfirstlane(task);
        const int which = tk >> 12, g = (tk >> 10) & 3, n = tk & 1023;
        bf16_t* dst = (which ? W.VC : W.KC) + ((size_t)g * 1024 + n) * HD;
        if (n == 1023) { ((unsigned*)dst)[lane] = 0u; continue; }
        const float* h = W.H1 + (size_t)tk * 256; const float* w2 = which ? P.cmp_v_w2 : P.cmp_k_w2;
        float a0 = 0.f, a1 = 0.f;
        for (int j = 0; j < 256; ++j) { const float hj = h[j]; const f32x2 wv = *(const f32x2*)(w2 + j * HD + 2 * lane); a0 += hj * wv[0]; a1 += hj * wv[1]; }
        if (which == 0) {
            const float ss = wave_sum(a0 * a0 + a1 * a1); const float rstd = rsqrtf(ss * (1.0f / HD) + EPS);
            a0 = a0 * rstd * wk[0]; a1 = a1 * rstd * wk[1];
            const int tp = 16 * n + 31; const float p0 = __shfl_xor(a0, 8), p1 = __shfl_xor(a1, 8);
            if (lane < 16) { const int i0 = (2 * lane) & 15; const float cs0 = W.COS[tp * 16 + i0], cs1 = W.COS[tp * 16 + i0 + 1], sn0 = W.SIN[tp * 16 + i0], sn1 = W.SIN[tp * 16 + i0 + 1];
                if (lane < 8) { a0 = a0 * cs0 - p0 * sn0; a1 = a1 * cs1 - p1 * sn1; } else { a0 = a0 * cs0 + p0 * sn0; a1 = a1 * cs1 + p1 * sn1; } }
        }
        ((unsigned*)dst)[lane] = cvt_pk_bf16(a0, a1);
    }
}

__device__ __forceinline__ void phase_erstd(const Ptrs& W) {
    const int tid = threadIdx.x, lane = tid & 63, gw = blockIdx.x * NWAVES + (tid >> 6), nw = gridDim.x * NWAVES;
    u32x4 a[8], an[8];
    if (gw < S_) { const u32x4* sp = (const u32x4*)(W.ERAW + (size_t)gw * DM);
#pragma unroll
        for (int i = 0; i < 8; ++i) a[i] = sp[lane + 64 * i]; }
    for (int row = gw; row < S_; row += nw) {
        const int nr = row + nw < S_ ? row + nw : row;
        { const u32x4* sp = (const u32x4*)(W.ERAW + (size_t)nr * DM);
#pragma unroll
          for (int i = 0; i < 8; ++i) an[i] = sp[lane + 64 * i]; }
        float ss = 0.f;
#pragma unroll
        for (int i = 0; i < 8; ++i) {
            const float e0 = bf_lo(a[i].x), e1 = bf_hi(a[i].x), e2 = bf_lo(a[i].y), e3 = bf_hi(a[i].y), e4 = bf_lo(a[i].z), e5 = bf_hi(a[i].z), e6 = bf_lo(a[i].w), e7 = bf_hi(a[i].w);
            ss += e0 * e0 + e1 * e1 + e2 * e2 + e3 * e3 + e4 * e4 + e5 * e5 + e6 * e6 + e7 * e7; }
        ss = wave_sum(ss);
        if (lane == 0) W.ERSTD[row] = rsqrtf(ss * (1.0f / DM) + EPS);
#pragma unroll
        for (int i = 0; i < 8; ++i) a[i] = an[i];
    }
}

constexpr int N_PHASES = 11;
__device__ __forceinline__ Params kargs() {
#if defined(__HIP_DEVICE_COMPILE__)
    unsigned long long p = (unsigned long long)__builtin_amdgcn_kernarg_segment_ptr();
    asm volatile("" : "+s"(p));
    return *(const __attribute__((address_space(4))) Params*)p;
#else
    return Params{};
#endif
}
__device__ __forceinline__ Ptrs mkptrs(unsigned char* ws) {
    Ptrs W;
    W.Win = (bf16_t*)(ws + WS_WIN); W.Wo = (bf16_t*)(ws + WS_WO); W.Wfi = (bf16_t*)(ws + WS_WFI); W.Wfo = (bf16_t*)(ws + WS_WFO); W.Wg = (bf16_t*)(ws + WS_WG);
    W.Wple = (bf16_t*)(ws + WS_WPLE); W.Wpool = (bf16_t*)(ws + WS_WPOOL); W.Wc1k = (bf16_t*)(ws + WS_WC1K); W.Wc1v = (bf16_t*)(ws + WS_WC1V);
    W.XN = (bf16_t*)(ws + WS_XN); W.PB = (bf16_t*)(ws + WS_PB); W.Z = (bf16_t*)(ws + WS_Z); W.M = (bf16_t*)(ws + WS_M); W.KC = (bf16_t*)(ws + WS_KC); W.VC = (bf16_t*)(ws + WS_VC);
    W.MIX = (bf16_t*)(ws + WS_MIX); W.ACT = (bf16_t*)(ws + WS_ACT); W.ERAW = (bf16_t*)(ws + WS_ERAW);
    W.COS = (float*)(ws + WS_COS); W.SIN = (float*)(ws + WS_SIN); W.TAB = (float*)(ws + WS_TAB); W.G = (float*)(ws + WS_G); W.H1 = (float*)(ws + WS_H1); W.L = (float*)(ws + WS_L);
    W.OACC = (float*)(ws + WS_OACC); W.IMPP = (float*)(ws + WS_IMPP); W.IMPF = (float*)(ws + WS_IMPF); W.ERSTD = (float*)(ws + WS_ERSTD); W.BM = (unsigned*)(ws + WS_BM);
    return W;
}
__global__ void __launch_bounds__(NTHREADS, 2) fwd(Params Punused) {
    extern __shared__ __attribute__((aligned(16))) unsigned char lds_raw[];
    LAS unsigned char* lds = (LAS unsigned char*)lds_raw;
    const int tid = threadIdx.x;
    const int G = gridDim.x, bid = blockIdx.x;
    const int gw = bid * NWAVES + (tid >> 6), nw = G * NWAVES;

    if (tid < 16) ((LAS unsigned*)(lds + LDS_MISC))[tid] = 0u;
    __syncthreads();
    int lo, hi; XcdBarrier bar;
    { const Params P = kargs(); lo = P.ph_lo; hi = P.ph_hi;
      bar.bar = (unsigned*)(P.ws + WS_CTL); bar.x = 0; bar.st = (volatile LAS unsigned*)(lds + LDS_MISC);
      if (hi - lo > 1) bar = xcd_barrier_post((unsigned*)(P.ws + WS_CTL), (volatile LAS unsigned*)(lds + LDS_MISC)); }
#ifdef PH_MASK
#define IN(k) (((PH_MASK >> (k)) & 1) && lo <= (k) && (k) < hi)
#else
#define IN(k) (lo <= (k) && (k) < hi)
#endif
#define SEAM(k) do { if (IN(k) && IN((k) + 1)) xcd_barrier(bar); } while (0)
#define PHASE_VARS const Params P = kargs(); const Ptrs W = mkptrs(P.ws); (void)W;
#define ATT_ARGS att::AttnArgs AA{W.Z, W.KC, W.VC, W.G, W.L, W.OACC, W.MIX, W.BM, W.TAB};

    if (IN(0)) { PHASE_VARS REP(0) { phase_prologue(P, W, lds); } SEAM(0); }
    if (IN(1)) {
        PHASE_VARS
        { pg8::GStd g{(const char*)W.XN, (const char*)W.Win, DM, DM, DM / 64}; pg8::StaticOrder S; S.init(S_ / 256, POOLW / 256, G, bid);
          pg8::EpiBf16 E{W.Z, LDZ}; pg8::gemm_phase(lds, g, S, E); }
        { pg8::GStd g{(const char*)(P.ws + WS_XN8), (const char*)(P.ws + WS_WIN8), DM / 2, DM / 2, DM / 128}; pg8::StaticOrder S; S.init(S_ / 256, (OFF_G - POOLW) / 256, G, bid);
          pg8::EpiBf16S E{W.Z + POOLW, LDZ, 1.0f / WG8_SCALE}; pg8::gemm_phase<pg8::GStd, pg8::EpiBf16S, true>(lds, g, S, E); }
        SEAM(1);
    }
    if (IN(2)) {
        PHASE_VARS
        if (G > 64) {
            if (bid < 32) { pg8::GCmp g{(const char*)W.Z, (const char*)W.Wc1k, (const char*)W.Wc1v, 16 * LDZ, 4096, 64}; pg8::StaticOrder S; S.init(32, 1, 32, bid);
                pg8::EpiCmpGelu E{W.H1, (const float*)(P.ws + WS_CBIAS)}; pg8::gemm_phase(lds, g, S, E); }
            else if (bid < 96) {
                pg8::GStd g{(const char*)W.XN, (const char*)(W.Win + (size_t)OFF_G * DM), DM, DM, DM / 64}; pg8::StaticOrder S; S.init(S_ / 256, 1, 64, bid - 32);
                pg8::EpiBf16 E{W.Z + OFF_G, LDZ}; pg8::gemm_phase(lds, g, S, E); }
            else phase_postz(P, W, (bid - 96) * NWAVES + (tid >> 6), (G - 96) * NWAVES);
        } else {
            { pg8::GStd g{(const char*)W.XN, (const char*)(W.Win + (size_t)OFF_G * DM), DM, DM, DM / 64}; pg8::StaticOrder S; S.init(S_ / 256, 1, G, bid);
              pg8::EpiBf16 E{W.Z + OFF_G, LDZ}; pg8::gemm_phase(lds, g, S, E); }
            { pg8::GCmp g{(const char*)W.Z, (const char*)W.Wc1k, (const char*)W.Wc1v, 16 * LDZ, 4096, 64}; pg8::StaticOrder S; S.init(32, 1, G, bid);
              pg8::EpiCmpGelu E{W.H1, (const float*)(P.ws + WS_CBIAS)}; pg8::gemm_phase(lds, g, S, E); }
            phase_postz(P, W, gw, nw);
        }
        SEAM(2);
    }
    if (IN(3)) {
        PHASE_VARS
        {
            const size_t i0 = (size_t)bid * NTHREADS + tid, st = (size_t)G * NTHREADS, NG = (size_t)S_ * NGATE;
            for (size_t ib = i0; ib < NG; ib += 9 * st) { float zv[9];
#pragma unroll
                for (int k = 0; k < 9; ++k) { size_t i = ib + k * st; if (i >= NG) i = NG - 1; const int t = (int)(i / NGATE), c = (int)(i % NGATE); zv[k] = bf2f(W.Z[(size_t)t * LDZ + OFF_G + c]); }
#pragma unroll
                for (int k = 0; k < 9; ++k) { const size_t i = ib + k * st; if (i < NG) W.G[i] = sigmoidf_(zv[k]); } } }
        phase_cmpfin(P, W);
        { pg8::GPool g{(const char*)W.M, (const char*)W.Wpool, POOLW, 256, 4}; pg8::StaticOrder S; S.init(S_ / 256, 4, G, bid);
          pg8::EpiBf16Scale E{W.MIX, DM, P.pool_scale}; pg8::gemm_phase(lds, g, S, E); }
        SEAM(3);
    }
    if (IN(4)) {
        PHASE_VARS ATT_ARGS
        if ((tid >> 6) < 4) __builtin_amdgcn_s_setprio(2);
        REP(4)
        for (int base = 0, rnd = 0; base < 1536; base += G, ++rnd) {
            int qt, g, hp;
            if (G == 256) { const int x = bid & 7, r = bid >> 3, qp = (rnd / 3) ? 63 - r : r; if (rnd >= 6) break; g = x & 3; qt = 2 * qp + (x >> 2); hp = rnd % 3; }
            else { const int Lu = base + ((rnd & 1) ? G - 1 - bid : bid); if (Lu >= 1536) continue; qt = Lu / 12; const int rem = Lu % 12; g = rem / 3; hp = rem % 3; }
            att::attn_unit<att::MODE_CMP>(AA, (LAS char*)lds, qt, g, hp);
            asm volatile("s_waitcnt vmcnt(0)" ::: "memory");
            att::attn_unit<att::MODE_WIN>(AA, (LAS char*)lds, qt, g, hp);
            if (G == 256 && hp == 2) {
                asm volatile("s_waitcnt vmcnt(0)" ::: "memory");
                const int tqi = qt * 8 + (tid >> 6);
                att::imp_task(AA, W.IMPP, W.IMPF, tqi, g);
                asm volatile("s_waitcnt vmcnt(0)" ::: "memory");
                f32x4 pp, ff, pn, fn; att::topk_load(W.IMPP, W.IMPF, tqi * 16, g, pp, ff);
                for (int q = 0; q < 16; ++q) { att::topk_load(W.IMPP, W.IMPF, tqi * 16 + (q < 15 ? q + 1 : q), g, pn, fn); att::topk_task(pp, ff, W.BM, tqi * 16 + q, g); pp = pn; ff = fn; } } }
        __builtin_amdgcn_s_setprio(0);
        if (G != 256) SEAM(4);
    }
    if (IN(5)) {
        PHASE_VARS ATT_ARGS
        if (G != 256)
        for (int k = gw, r = 0; k < 4096; k += nw, ++r) { const int hiT = (r + 1) * nw < 4096 ? (r + 1) * nw : 4096;
            const int task = (r & 1) ? hiT - 1 - (k - r * nw) : k;
            att::imp_task(AA, W.IMPP, W.IMPF, task >> 2, task & 3);
            asm volatile("s_waitcnt vmcnt(0)" ::: "memory");
            { const int tb = (task >> 2) * 16, gg = task & 3; f32x4 pp, ff, pn, fn;
              att::topk_load(W.IMPP, W.IMPF, tb, gg, pp, ff);
              for (int q = 0; q < 16; ++q) { att::topk_load(W.IMPP, W.IMPF, tb + (q < 15 ? q + 1 : q), gg, pn, fn); att::topk_task(pp, ff, W.BM, tb + q, gg); pp = pn; ff = fn; } } }
        SEAM(5);
    }
    if (IN(6)) {
        PHASE_VARS ATT_ARGS
#if SLC16
        for (int base = 0, rnd = 0; base < 1024 + G; base += G, ++rnd) {
            int ut, g;
            if (G == 256) { const int x = bid & 7, r = bid >> 3, k = rnd * 32 + ((rnd & 1) ? 31 - r : r); if (k >= 128) break; g = x & 3; ut = 255 - (2 * k + (x >> 2)); }
            else { const int Lu = base + ((rnd & 1) ? G - 1 - bid : bid); if (Lu >= 1024) continue; ut = 255 - Lu / 4; g = Lu % 4; }
            att::slc16_unit(AA, (LAS char*)lds, ut, g); }
#else
        REP(6)
        for (int base = 0, rnd = 0; base < 1640 + G; base += G, ++rnd) {
            int ut, g;
            if (G == 256) { const int x = bid & 7, r = bid >> 3, k = rnd * 32 + ((rnd & 1) ? 31 - r : r); if (k >= 205) break; g = x & 3; ut = 409 - (2 * k + (x >> 2)); }
            else { const int Lu = base + ((rnd & 1) ? G - 1 - bid : bid); if (Lu >= 1640) continue; ut = 409 - Lu / 4; g = Lu % 4; }
            att::attn_unit<att::MODE_SLC>(AA, (LAS char*)lds, ut, g, 0); }
#endif
        SEAM(6);
    }
    if (IN(7)) {
        PHASE_VARS
        if (bid == 0) { bf16_t* hz = (bf16_t*)(P.ws + WS_HRES) - 2 * DM; for (int i = tid; i < 2 * DM / 8; i += NTHREADS) *(u32x4*)(hz + i * 8) = (u32x4){0u, 0u, 0u, 0u}; }
        { pg8::GStd g{(const char*)W.MIX, (const char*)W.Wo, DM, DM, DM / 64}; pg8::StaticOrder S; S.init(S_ / 256, DM / 256, G, bid);
          pg8::EpiResNorm E{P.x, (bf16_t*)(P.ws + WS_HRES), W.XN, P.norm2_w, (float*)(P.ws + WS_SSQ1), DM}; pg8::gemm_phase(lds, g, S, E); }
        { pg8::GStd g{(const char*)W.PB, (const char*)W.Wple, PLE, PLE, PLE / 64}; pg8::StaticOrder S; S.init(S_ / 256, DM / 256, G, bid);
          pg8::EpiBf16Ssq E{W.ERAW, DM, (float*)(P.ws + WS_SSQ3)}; pg8::gemm_phase(lds, g, S, E); }
        SEAM(7);
    }
    if (IN(8)) {
        PHASE_VARS
        pg8::GFfn g{(const char*)(P.ws + WS_HRES), (const char*)W.Wfi, DM, DM, DM / 64}; pg8::StaticOrder S; S.init(65, DFF / 128, G, bid);
        pg8::EpiFfn E{W.ACT, P.conv_w, P.conv_b, (LAS float*)(lds + LDS_XCH), (const float*)(P.ws + WS_SSQ1)}; REP(8) { pg8::gemm_phase(lds, g, S, E); } SEAM(8);
    }
    if (IN(9)) {
        PHASE_VARS
        pg8::GStd g{(const char*)W.ACT, (const char*)W.Wfo, DFF, DFF, DFF / 64}; pg8::StaticOrder S; S.init(S_ / 256, DM / 256, G, bid);
        pg8::EpiResNormF8 E{P.ws + WS_HRES, (bf16_t*)(P.ws + WS_HRES), W.XN, P.ple_gate_norm_w, (float*)(P.ws + WS_SSQ2), DM}; pg8::gemm_phase(lds, g, S, E); SEAM(9);
    }
    if (IN(10)) {
        PHASE_VARS
        pg8::GStd g{(const char*)W.XN, (const char*)W.Wg, DM / 2, DM / 2, DM / 128}; pg8::StaticOrder S; S.init(S_ / 256, DM / 256, G, bid);
        pg8::EpiGate E{P.out, (const bf16_t*)(P.ws + WS_HRES), W.ERAW, (const float*)(P.ws + WS_SSQ3), P.ple_norm_w, (const float*)(P.ws + WS_SSQ2), DM, 1.0f / WG8_SCALE};
        pg8::gemm_phase<pg8::GStd, pg8::EpiGate, true>(lds, g, S, E);
    }
#undef IN
#undef SEAM
}

extern "C" void kernel_launch(void* const* d_in, const int* in_sizes, int n_in, void* d_out, int out_size, void* d_ws, size_t ws_size, hipStream_t stream) {
    static int grid = 0;
    if (grid == 0) {
        if (n_in != 27 || in_sizes[0] != S_ * DM || out_size != S_ * DM || ws_size < WS_NEED) {
            fprintf(stderr, "kernel_launch: unexpected shapes (n_in %d, in0 %d, out %d, ws %zu < %zu); nothing launched\n", n_in, n_in > 0 ? in_sizes[0] : -1, out_size, ws_size, (size_t)WS_NEED); grid = -1; return; }
        int dev = 0, cus = 0, per_cu = 0;
        if (hipGetDevice(&dev) != hipSuccess || hipDeviceGetAttribute(&cus, hipDeviceAttributeMultiprocessorCount, dev) != hipSuccess) { grid = -1; return; }
        if (hipFuncSetAttribute((const void*)fwd, hipFuncAttributeMaxDynamicSharedMemorySize, LDS_BYTES) != hipSuccess) { fprintf(stderr, "kernel_launch: hipFuncSetAttribute failed\n"); grid = -1; return; }
        if (hipOccupancyMaxActiveBlocksPerMultiprocessor(&per_cu, (const void*)fwd, NTHREADS, LDS_BYTES) != hipSuccess || per_cu < 1) { fprintf(stderr, "kernel_launch: occupancy query says %d\n", per_cu); (void)hipGetLastError(); }
        grid = cus > 256 ? 256 : cus;
    }
    if (grid < 0) return;
    (void)hipMemsetAsync((char*)d_ws + WS_CTL, 0, CTL_BYTES, stream);
    Params P{};
    const float** fp = (const float**)&P;
    P.x = (const float*)d_in[0]; P.p = (const float*)d_in[1]; P.positions = (const int*)d_in[2]; P.norm1_w = (const float*)d_in[3]; P.w_in = (const float*)d_in[4];
    P.w_pool = (const float*)d_in[5]; P.pool_scale = (const float*)d_in[6]; P.q_norm_w = (const float*)d_in[7]; P.k_norm_cmp_w = (const float*)d_in[8];
    P.k_norm_slc_w = (const float*)d_in[9]; P.k_norm_win_w = (const float*)d_in[10]; P.cmp_pos_k = (const float*)d_in[11]; P.cmp_pos_v = (const float*)d_in[12];
    P.cmp_k_w1 = (const float*)d_in[13]; P.cmp_k_w2 = (const float*)d_in[14]; P.cmp_v_w1 = (const float*)d_in[15]; P.cmp_v_w2 = (const float*)d_in[16];
    P.w_o = (const float*)d_in[17]; P.norm2_w = (const float*)d_in[18]; P.w_ffn_in = (const float*)d_in[19]; P.conv_w = (const float*)d_in[20]; P.conv_b = (const float*)d_in[21];
    P.w_ffn_out = (const float*)d_in[22]; P.w_ple_proj = (const float*)d_in[23]; P.ple_norm_w = (const float*)d_in[24]; P.ple_gate_norm_w = (const float*)d_in[25]; P.w_ple_gate = (const float*)d_in[26];
    (void)fp;
    P.out = (float*)d_out; P.ws = (unsigned char*)d_ws;
#if MK_ONE_LAUNCH
    P.ph_lo = 0; P.ph_hi = N_PHASES;
    hipLaunchKernelGGL(fwd, dim3(grid), dim3(NTHREADS), LDS_BYTES, stream, P);
#else
    for (int ph = 0; ph < N_PHASES; ++ph) { P.ph_lo = ph; P.ph_hi = ph + 1; hipLaunchKernelGGL(fwd, dim3(grid), dim3(NTHREADS), LDS_BYTES, stream, P); }
#endif
    const hipError_t le = hipPeekAtLastError();
    if (le != hipSuccess) fprintf(stderr, "kernel_launch: launch failed: %s\n", hipGetErrorName(le));
}
```

```cpp
#include <hip/hip_runtime.h>
#include <cstdio>
#include <cstdint>

#ifndef PROBE_DBL
#define PROBE_DBL 0
#endif
#define REP(k) _Pragma("unroll") for (int rep_ = 0; rep_ < 1 + ((PROBE_DBL >> (k)) & 1); ++rep_)
#ifndef SLC16
#define SLC16 1
#endif
#ifndef MK_ONE_LAUNCH
#define MK_ONE_LAUNCH 1
#endif

#define LAS __attribute__((address_space(3)))
typedef unsigned short bf16_t;
typedef short bf16x8 __attribute__((ext_vector_type(8)));
typedef short s16x4 __attribute__((ext_vector_type(4)));
typedef float f32x2 __attribute__((ext_vector_type(2)));
typedef float f32x4 __attribute__((ext_vector_type(4)));
typedef float f32x16 __attribute__((ext_vector_type(16)));
typedef unsigned u32x2 __attribute__((ext_vector_type(2)));
typedef unsigned u32x4 __attribute__((ext_vector_type(4)));
typedef int i32x4 __attribute__((ext_vector_type(4)));
typedef int i32x8 __attribute__((ext_vector_type(8)));

constexpr int S_ = 16384, DM = 4096, INW = 7240, LDZ = 7424, POOLW = 1024, NH = 24, NKV = 4, HPG = 6, HD = 128;
constexpr int OFF_Q = 1024, OFF_KV = 4096, OFF_G = 7168, DFF = 11008, NFI = 22016, PLE = 256, NGATE = 72;
constexpr int ZROWS = S_ + 64, XNROWS = S_ + 256, CHUNK = 8192;
constexpr float EPS = 1e-6f;
constexpr float SM_C = 0.08838834764831845f * 1.4426950408889634f;
constexpr int NWAVES = 8, NTHREADS = 512;
constexpr float WG8_SCALE = 128.0f;

constexpr size_t al256(size_t x) { return (x + 255) / 256 * 256; }
constexpr size_t WS_CTL   = 0;
constexpr size_t CTL_BYTES = 262144;
constexpr size_t WS_CBIAS = WS_CTL + 32768;
constexpr size_t WS_SSQ1 = WS_CTL + 65536, WS_SSQ2 = WS_CTL + 131072, WS_SSQ3 = WS_CTL + 196608;
constexpr size_t WS_WIN   = WS_CTL + CTL_BYTES;
constexpr size_t WS_WO    = WS_WIN + al256((size_t)LDZ * DM * 2);
constexpr size_t WS_WFI   = WS_WO + al256((size_t)DM * DM * 2);
constexpr size_t WS_WFO   = WS_WFI + al256((size_t)NFI * DM * 2);
constexpr size_t WS_WG    = WS_WFO + al256((size_t)DM * DFF * 2);
constexpr size_t WS_WPLE  = WS_WG + al256((size_t)DM * DM * 2);
constexpr size_t WS_WPOOL = WS_WPLE + al256((size_t)DM * PLE * 2);
constexpr size_t WS_WC1K  = WS_WPOOL + al256((size_t)1024 * 256 * 2);
constexpr size_t WS_WC1V  = WS_WC1K + al256((size_t)256 * 4096 * 2);
constexpr size_t WS_COS   = WS_WC1V + al256((size_t)256 * 4096 * 2);
constexpr size_t WS_SIN   = WS_COS + al256((size_t)S_ * 16 * 4);
constexpr size_t WS_TAB   = WS_SIN + al256((size_t)S_ * 16 * 4);
constexpr size_t WS_XNP   = WS_TAB + 4096;
constexpr size_t WS_XN    = WS_XNP + (size_t)2 * DM * 2;
constexpr size_t WS_PB    = WS_XN + al256((size_t)XNROWS * DM * 2);
constexpr size_t WS_XN8   = WS_PB + al256((size_t)S_ * PLE * 2);
constexpr size_t WS_WIN8  = WS_XN8 + al256((size_t)S_ * DM);
constexpr size_t WS_R     = WS_WIN8 + al256((size_t)(OFF_G - POOLW) * DM);
constexpr size_t WS_Z     = WS_R;
constexpr size_t WS_M     = WS_Z + al256((size_t)ZROWS * LDZ * 2);
constexpr size_t WS_G     = WS_M + al256((size_t)S_ * POOLW * 2);
constexpr size_t WS_H1    = WS_G + al256((size_t)S_ * NGATE * 4);
constexpr size_t WS_KC    = WS_H1 + al256((size_t)8192 * 256 * 4);
constexpr size_t WS_VC    = WS_KC + al256((size_t)4 * 1024 * 128 * 2);
constexpr size_t WS_L     = WS_VC + al256((size_t)4 * 1024 * 128 * 2);
constexpr size_t WS_OACC  = WS_L + al256((size_t)S_ * NH * 4);
constexpr size_t WS_IMPP  = WS_OACC + al256((size_t)S_ * 3072 * 4);
constexpr size_t WS_IMPF  = WS_IMPP + al256((size_t)S_ * 4 * 256 * 4);
constexpr size_t WS_BM    = WS_IMPF + al256((size_t)S_ * 4 * 256 * 4);
constexpr size_t WS_MIX   = WS_BM + al256((size_t)S_ * 4 * 8 * 4);
constexpr size_t WS_END_A = WS_MIX + al256((size_t)S_ * DM * 2);
constexpr size_t WS_ERAW  = WS_R;
constexpr size_t WS_ACT   = WS_ERAW + al256((size_t)S_ * DM * 2);
constexpr size_t WS_ERSTD = WS_ACT + al256((size_t)S_ * DFF * 2);
constexpr size_t WS_END_B = WS_ERSTD + al256((size_t)S_ * 4);
constexpr size_t WS_HRES  = WS_IMPP + (size_t)2 * DM * 2;
static_assert(WS_HRES - (size_t)2 * DM * 2 >= WS_END_B && WS_HRES + (size_t)S_ * DM * 2 <= WS_MIX, "residual stream must sit in the dead importance / bitmap buffers, clear of act / mix");
static_assert(WS_ERAW + (size_t)S_ * DM * 2 <= WS_Z + (size_t)ZROWS * LDZ * 2, "eraw must fit inside the dead z region while mix is still being read");
constexpr size_t WS_NEED  = WS_END_A > WS_END_B ? WS_END_A : WS_END_B;
static_assert(WS_NEED <= (size_t)1440000000, "workspace map exceeds the guaranteed 4 x largest-tensor bytes");

constexpr int LDS_STAGE = 131072;
constexpr int LDS_XCH   = LDS_STAGE + 64;
constexpr int LDS_MISC  = 147456;
constexpr int LDS_BYTES = LDS_MISC + 64;

__device__ __forceinline__ unsigned cvt_pk_bf16(float lo, float hi) { unsigned r; asm volatile("v_cvt_pk_bf16_f32 %0, %1, %2" : "=v"(r) : "v"(lo), "v"(hi)); return r; }
__device__ __forceinline__ float bf_lo(unsigned u) { return __uint_as_float(u << 16); }
__device__ __forceinline__ float bf_hi(unsigned u) { return __uint_as_float(u & 0xffff0000u); }
__device__ __forceinline__ float bf2f(bf16_t b) { return __uint_as_float(((unsigned)b) << 16); }
__device__ __forceinline__ float wave_sum(float v) {
#pragma unroll
    for (int o = 32; o >= 1; o >>= 1) v += __shfl_xor(v, o);
    return v;
}
__device__ __forceinline__ float wave_max(float v) {
#pragma unroll
    for (int o = 32; o >= 1; o >>= 1) v = fmaxf(v, __shfl_xor(v, o));
    return v;
}
__device__ __forceinline__ float sigmoidf_(float x) { return __builtin_amdgcn_rcpf(1.0f + __expf(-x)); }

#define XB_TMO      128
#define XB_XCNT(j)  (256  + 64 * (j))
#define XB_XSUB(j)  (1280 + 64 * (j))
#define XB_XGEN(j)  (2304 + 64 * (j))
#define XB_TOP      3328
#define XB_TOPGEN   3392
#define XCD_BAR_WORDS 3456
#define XB_SPIN_CAP (1u << 18)
__device__ __forceinline__ unsigned xb_ld(unsigned* p)              { return __hip_atomic_load(p, __ATOMIC_RELAXED, __HIP_MEMORY_SCOPE_AGENT); }
__device__ __forceinline__ unsigned xb_add(unsigned* p, unsigned v) { return __hip_atomic_fetch_add(p, v, __ATOMIC_RELAXED, __HIP_MEMORY_SCOPE_AGENT); }
__device__ __forceinline__ unsigned xb_xcc_id() { return (unsigned)__builtin_amdgcn_s_getreg((3 << 11) | 20) & 0xFu; }
#define XB_SPIN(cond, bar) do { unsigned _sp = 0; while (cond) { __builtin_amdgcn_s_sleep(1); \
    if ((++_sp & 255u) == 0u) { if (xb_ld(&(bar)[XB_TMO])) break; if (_sp > XB_SPIN_CAP) { atomicAdd(&(bar)[XB_TMO], 1u); break; } } } } while (0)
struct XcdBarrier { unsigned* bar; unsigned x; volatile LAS unsigned* st; };
__device__ __forceinline__ XcdBarrier xcd_barrier_post(unsigned* bar, volatile LAS unsigned* st) {
    XcdBarrier b; b.bar = bar; b.x = xb_xcc_id(); b.st = st;
    if (threadIdx.x == 0) (void)xb_add(&bar[XB_XCNT(b.x)], 1u);
    return b;
}
__device__ __forceinline__ void xcd_barrier_complete(unsigned* bar, unsigned x, unsigned& nloc, unsigned& nx) {
    const unsigned G = gridDim.x * gridDim.y * gridDim.z;
    unsigned sum, cnt, mine, sp = 0u;
    for (;;) {
        sum = 0u; cnt = 0u; mine = 0u;
#pragma unroll
        for (unsigned j = 0; j < 16; ++j) { const unsigned c = xb_ld(&bar[XB_XCNT(j)]); sum += c; cnt += (c > 0u) ? 1u : 0u; mine = (j == x) ? c : mine; }
        if (sum == G) break;
        __builtin_amdgcn_s_sleep(1);
        if ((++sp & 255u) == 0u) { if (xb_ld(&bar[XB_TMO])) break; if (sp > XB_SPIN_CAP) { atomicAdd(&bar[XB_TMO], 1u); break; } }
    }
    nloc = mine > 0u ? mine : 1u; nx = cnt > 0u ? cnt : 1u;
}
__device__ __forceinline__ void xcd_barrier(const XcdBarrier& b) {
    asm volatile("s_waitcnt vmcnt(0)" ::: "memory");
    __syncthreads();
    if (threadIdx.x == 0) {
        unsigned* bar = b.bar;
        __builtin_amdgcn_s_waitcnt(0);
        unsigned nloc = b.st[0], nx = b.st[1];
        if (nloc == 0u) { xcd_barrier_complete(bar, b.x, nloc, nx); b.st[0] = nloc; b.st[1] = nx; }
        const unsigned old = xb_add(&bar[XB_XSUB(b.x)], 1u);
        const unsigned gen = old / nloc;
        if (old + 1u == (gen + 1u) * nloc) {
            __builtin_amdgcn_fence(__ATOMIC_RELEASE, "agent");
            asm volatile("s_waitcnt vmcnt(0)" ::: "memory");
            const unsigned og = xb_add(&bar[XB_TOP], 1u);
            const unsigned tg = og / nx;
            if (og + 1u == (tg + 1u) * nx) xb_add(&bar[XB_TOPGEN], 1u);
            else XB_SPIN(xb_ld(&bar[XB_TOPGEN]) == tg, bar);
            __builtin_amdgcn_fence(__ATOMIC_ACQUIRE, "agent");
            xb_add(&bar[XB_XGEN(b.x)], 1u);
            asm volatile("s_waitcnt vmcnt(0)" ::: "memory");
        } else {
            XB_SPIN(xb_ld(&bar[XB_XGEN(b.x)]) == gen, bar);
            __builtin_amdgcn_fence(__ATOMIC_ACQUIRE, "agent");
            asm volatile("s_waitcnt vmcnt(0)" ::: "memory");
        }
    }
    __syncthreads();
}

struct Params {
    const float* x; const float* p; const int* positions; const float* norm1_w; const float* w_in; const float* w_pool; const float* pool_scale;
    const float* q_norm_w; const float* k_norm_cmp_w; const float* k_norm_slc_w; const float* k_norm_win_w; const float* cmp_pos_k; const float* cmp_pos_v;
    const float* cmp_k_w1; const float* cmp_k_w2; const float* cmp_v_w1; const float* cmp_v_w2; const float* w_o; const float* norm2_w; const float* w_ffn_in;
    const float* conv_w; const float* conv_b; const float* w_ffn_out; const float* w_ple_proj; const float* ple_norm_w; const float* ple_gate_norm_w; const float* w_ple_gate;
    float* out; unsigned char* ws; int ph_lo, ph_hi;
};

namespace pg8 {
constexpr int BM = 256, BK = 64, HALF = 128, HTB = HALF * BK * 2, STAGE_BYTES = 8 * HTB, NXCD = 8, WGM = 8;
__host__ __device__ __forceinline__ int lds_byte(int r, int c) { const int st = (r >> 4) * 2 + (c >> 5), rr = r & 15, cc = c & 31, ob = rr * 64 + cc * 2; return st * 1024 + (ob ^ (((ob >> 9) & 1) << 5)); }
__host__ __device__ __forceinline__ void stage_rc(int b, int& R, int& C) { const int st = b / 1024, sb = b % 1024, swz = sb ^ (((sb >> 9) & 1) << 5); R = (st >> 1) * 16 + swz / 64; C = (st & 1) * 32 + (swz % 64) / 2; }
__host__ __device__ __forceinline__ int perm32(int rho) { const int n = rho >> 4, i = rho & 15; return 8 * (i >> 2) + 4 * n + (i & 3); }
struct Unit { int pm, pn; };

struct StaticOrder {
    int nM, nN, nwg, G, c;
    __device__ void init(int nM_, int nN_, int G_, int c_) { nM = nM_; nN = nN_; nwg = nM * nN; G = G_; c = c_; }
    __device__ bool next(int i, Unit& u) const {
        const long L = (long)i * G + c; if (L >= nwg) return false;
        int wgid = (int)L; { const int q = nwg / NXCD, r = nwg % NXCD, xcd = wgid % NXCD, off = wgid / NXCD; wgid = (xcd < r ? xcd * (q + 1) : r * (q + 1) + (xcd - r) * q) + off; }
        const int nig = WGM * nN, gid = wgid / nig, fm = gid * WGM, gsz = (nM - fm) < WGM ? (nM - fm) : WGM;
        u.pm = fm + ((wgid % nig) % gsz); u.pn = (wgid % nig) / gsz; return true;
    }
};

struct GStd {
    const char* A; const char* B; unsigned lda, ldb; int nt;
    __device__ __forceinline__ const char* a_base(const Unit& u) const { return A + (size_t)u.pm * 256 * lda * 2; }
    __device__ __forceinline__ const char* b_base(const Unit& u) const { return B + (size_t)u.pn * 256 * ldb * 2; }
    __device__ __forceinline__ size_t kpairA() const { return 256; }
};
struct GPool {
    const char* A; const char* B; unsigned lda, ldb; int nt;
    __device__ __forceinline__ const char* a_base(const Unit& u) const { return A + (size_t)u.pm * 256 * lda * 2 + (size_t)u.pn * 512; }
    __device__ __forceinline__ const char* b_base(const Unit& u) const { return B + (size_t)u.pn * 256 * ldb * 2; }
    __device__ __forceinline__ size_t kpairA() const { return 256; }
};
struct GCmp {
    const char* Z; const char* Bk; const char* Bv; unsigned lda, ldb; int nt;
    __device__ __forceinline__ const char* a_base(const Unit& u) const { const int which = u.pm >> 4, g = (u.pm >> 2) & 3, rt = u.pm & 3;
        return Z + (size_t)(OFF_KV + which * 512 + g * 128) * 2 + (size_t)rt * 256 * lda * 2; }
    __device__ __forceinline__ const char* b_base(const Unit& u) const { return (u.pm >> 4) ? Bv : Bk; }
    __device__ __forceinline__ size_t kpairA() const { return (size_t)LDZ * 2; }
};

struct EpiBf16 {
    static constexpr bool PERM = true;
    bf16_t* O; int ldc;
    __device__ __forceinline__ void operator()(const f32x4 (&acc)[2][2][4][2], const Unit& u, int wr, int wc, int fr, int fq) const {
        const int row0 = u.pm * BM + wr * 64 + fr, col0 = u.pn * BM + wc * 32 + 8 * fq;
#pragma unroll
        for (int ai = 0; ai < 2; ++ai)
#pragma unroll
            for (int m = 0; m < 4; ++m) { bf16_t* rowp = O + (size_t)(row0 + ai * HALF + m * 16) * ldc + col0;
#pragma unroll
                for (int bj = 0; bj < 2; ++bj) { const f32x4 v0 = acc[ai][bj][m][0], v1 = acc[ai][bj][m][1];
                    u32x4 w; w.x = cvt_pk_bf16(v0[0], v0[1]); w.y = cvt_pk_bf16(v0[2], v0[3]); w.z = cvt_pk_bf16(v1[0], v1[1]); w.w = cvt_pk_bf16(v1[2], v1[3]);
                    *(u32x4*)(rowp + bj * HALF) = w; } }
    }
};
struct EpiBf16S {
    static constexpr bool PERM = true;
    bf16_t* O; int ldc; float s;
    __device__ __forceinline__ void operator()(const f32x4 (&acc)[2][2][4][2], const Unit& u, int wr, int wc, int fr, int fq) const {
        const int row0 = u.pm * BM + wr * 64 + fr, col0 = u.pn * BM + wc * 32 + 8 * fq;
#pragma unroll
        for (int ai = 0; ai < 2; ++ai)
#pragma unroll
            for (int m = 0; m < 4; ++m) { bf16_t* rowp = O + (size_t)(row0 + ai * HALF + m * 16) * ldc + col0;
#pragma unroll
                for (int bj = 0; bj < 2; ++bj) { const f32x4 v0 = acc[ai][bj][m][0] * s, v1 = acc[ai][bj][m][1] * s;
                    u32x4 w; w.x = cvt_pk_bf16(v0[0], v0[1]); w.y = cvt_pk_bf16(v0[2], v0[3]); w.z = cvt_pk_bf16(v1[0], v1[1]); w.w = cvt_pk_bf16(v1[2], v1[3]);
                    *(u32x4*)(rowp + bj * HALF) = w; } }
    }
};
struct EpiBf16Ssq {
    static constexpr bool PERM = true;
    bf16_t* O; int ldc; float* ssq;
    __device__ __forceinline__ void operator()(const f32x4 (&acc)[2][2][4][2], const Unit& u, int wr, int wc, int fr, int fq) const {
        const int row0 = u.pm * BM + wr * 64 + fr, col0 = u.pn * BM + wc * 32 + 8 * fq;
#pragma unroll
        for (int ai = 0; ai < 2; ++ai)
#pragma unroll
            for (int m = 0; m < 4; ++m) { const int row = row0 + ai * HALF + m * 16; bf16_t* rowp = O + (size_t)row * ldc + col0; float s = 0.f;
#pragma unroll
                for (int bj = 0; bj < 2; ++bj) { const f32x4 v0 = acc[ai][bj][m][0], v1 = acc[ai][bj][m][1];
                    s += v0[0] * v0[0] + v0[1] * v0[1] + v0[2] * v0[2] + v0[3] * v0[3] + v1[0] * v1[0] + v1[1] * v1[1] + v1[2] * v1[2] + v1[3] * v1[3];
                    u32x4 w; w.x = cvt_pk_bf16(v0[0], v0[1]); w.y = cvt_pk_bf16(v0[2], v0[3]); w.z = cvt_pk_bf16(v1[0], v1[1]); w.w = cvt_pk_bf16(v1[2], v1[3]);
                    *(u32x4*)(rowp + bj * HALF) = w; }
                s += __shfl_xor(s, 16); s += __shfl_xor(s, 32);
                if (fq == 0) unsafeAtomicAdd(ssq + row, s); }
    }
};
struct EpiBf16Scale {
    static constexpr bool PERM = true;
    bf16_t* O; int ldc; const float* colscale;
    __device__ __forceinline__ void operator()(const f32x4 (&acc)[2][2][4][2], const Unit& u, int wr, int wc, int fr, int fq) const {
        const int row0 = u.pm * BM + wr * 64 + fr, col0 = u.pn * BM + wc * 32 + 8 * fq;
#pragma unroll
        for (int bj = 0; bj < 2; ++bj) { const f32x4 s0 = *(const f32x4*)(colscale + col0 + bj * HALF), s1 = *(const f32x4*)(colscale + col0 + bj * HALF + 4);
#pragma unroll
            for (int ai = 0; ai < 2; ++ai)
#pragma unroll
                for (int m = 0; m < 4; ++m) { bf16_t* rowp = O + (size_t)(row0 + ai * HALF + m * 16) * ldc + col0;
                    const f32x4 v0 = acc[ai][bj][m][0] * s0, v1 = acc[ai][bj][m][1] * s1;
                    u32x4 w; w.x = cvt_pk_bf16(v0[0], v0[1]); w.y = cvt_pk_bf16(v0[2], v0[3]); w.z = cvt_pk_bf16(v1[0], v1[1]); w.w = cvt_pk_bf16(v1[2], v1[3]);
                    *(u32x4*)(rowp + bj * HALF) = w; } }
    }
};
struct EpiResF32 {
    static constexpr bool PERM = false;
    const float* base; float* C; int ldc; int row_off;
    __device__ __forceinline__ void operator()(const f32x4 (&acc)[2][2][4][2], const Unit& u, int wr, int wc, int fr, int fq) const {
        const int row0 = u.pm * BM + wr * 64 + fr + row_off, col0 = u.pn * BM + wc * 32 + 4 * fq;
#pragma unroll
        for (int ai = 0; ai < 2; ++ai)
#pragma unroll
            for (int m = 0; m < 4; ++m) { const size_t off = (size_t)(row0 + ai * HALF + m * 16) * ldc + col0;
#pragma unroll
                for (int bj = 0; bj < 2; ++bj)
#pragma unroll
                    for (int n = 0; n < 2; ++n) { const f32x4 b = *(const f32x4*)(base + off + bj * HALF + n * 16); *(f32x4*)(C + off + bj * HALF + n * 16) = b + acc[ai][bj][m][n]; }
                asm volatile("" ::: "memory"); }
    }
};
template <bool FP8OUT, bool BASEBF, bool WXN = true>
struct EpiResNormT {
    static constexpr bool PERM = false;
    const void* base; bf16_t* C; bf16_t* XN; const float* nw; float* ssq; int ldc;
    typedef typename std::conditional<BASEBF, u32x2, f32x4>::type RawT;
    __device__ __forceinline__ RawT ldb(size_t idx) const { if constexpr (BASEBF) return *(const u32x2*)((const bf16_t*)base + idx); else return *(const f32x4*)((const float*)base + idx); }
    static __device__ __forceinline__ f32x4 cv(const RawT& r) { if constexpr (BASEBF) return (f32x4){bf_lo(r.x), bf_hi(r.x), bf_lo(r.y), bf_hi(r.y)}; else return r; }
    __device__ __forceinline__ void operator()(const f32x4 (&acc)[2][2][4][2], const Unit& u, int wr, int wc, int fr, int fq) const {
        const int row0 = u.pm * BM + wr * 64 + fr, col0 = u.pn * BM + wc * 32 + 4 * fq;
        f32x4 wv[2][2];
#pragma unroll
        for (int bj = 0; bj < 2; ++bj)
#pragma unroll
            for (int n = 0; n < 2; ++n) wv[bj][n] = *(const f32x4*)(nw + col0 + bj * HALF + n * 16);
        constexpr int PF = BASEBF ? 3 : 2, NB = PF + 1;
        RawT bv[NB][2][2];
#pragma unroll
        for (int p = 0; p < PF; ++p)
#pragma unroll
            for (int bj = 0; bj < 2; ++bj)
#pragma unroll
                for (int n = 0; n < 2; ++n) bv[p][bj][n] = ldb((size_t)(row0 + (p >> 2) * HALF + (p & 3) * 16) * ldc + col0 + bj * HALF + n * 16);
#pragma unroll
        for (int rg = 0; rg < 8; ++rg) { const int ai = rg >> 2, m = rg & 3; const int row = row0 + ai * HALF + m * 16; const size_t off = (size_t)row * ldc + col0;
            if (rg + PF < 8) { const int ai2 = (rg + PF) >> 2, m2 = (rg + PF) & 3; const size_t off2 = (size_t)(row0 + ai2 * HALF + m2 * 16) * ldc + col0;
#pragma unroll
                for (int bj = 0; bj < 2; ++bj)
#pragma unroll
                    for (int n = 0; n < 2; ++n) bv[(rg + PF) % NB][bj][n] = ldb(off2 + bj * HALF + n * 16); }
            float s = 0.f;
#pragma unroll
            for (int bj = 0; bj < 2; ++bj)
#pragma unroll
                for (int n = 0; n < 2; ++n) { const f32x4 v = cv(bv[rg % NB][bj][n]) + acc[ai][bj][m][n];
                    { u32x2 c; c.x = cvt_pk_bf16(v[0], v[1]); c.y = cvt_pk_bf16(v[2], v[3]); *(u32x2*)(C + off + bj * HALF + n * 16) = c; }
                    s += v[0] * v[0] + v[1] * v[1] + v[2] * v[2] + v[3] * v[3];
                    if (!WXN) { }
                    else if (FP8OUT) { int pk = __builtin_amdgcn_cvt_pk_fp8_f32(v[0] * wv[bj][n][0], v[1] * wv[bj][n][1], 0, false); pk = __builtin_amdgcn_cvt_pk_fp8_f32(v[2] * wv[bj][n][2], v[3] * wv[bj][n][3], pk, true);
                        *(int*)((unsigned char*)XN + off + bj * HALF + n * 16) = pk; }
                    else { u32x2 o; o.x = cvt_pk_bf16(v[0] * wv[bj][n][0], v[1] * wv[bj][n][1]); o.y = cvt_pk_bf16(v[2] * wv[bj][n][2], v[3] * wv[bj][n][3]);
                        *(u32x2*)(XN + off + bj * HALF + n * 16) = o; } }
            s += __shfl_xor(s, 16); s += __shfl_xor(s, 32);
            if (fq == 0) unsafeAtomicAdd(ssq + row, s);
        }
    }
};
typedef EpiResNormT<false, false, false> EpiResNorm;
typedef EpiResNormT<true, true> EpiResNormF8;
struct EpiCmpGelu {
    static constexpr bool PERM = false;
    float* H; const float* bias;
    __device__ __forceinline__ void operator()(const f32x4 (&acc)[2][2][4][2], const Unit& u, int wr, int wc, int fr, int fq) const {
        const int row0 = u.pm * BM + wr * 64 + fr, col0 = wc * 32 + 4 * fq; const float* bs = bias + (u.pm >> 4) * 256;
        f32x4 bvv[2][2];
#pragma unroll
        for (int bj = 0; bj < 2; ++bj)
#pragma unroll
            for (int n = 0; n < 2; ++n) bvv[bj][n] = *(const f32x4*)(bs + col0 + bj * HALF + n * 16);
#pragma unroll
        for (int ai = 0; ai < 2; ++ai)
#pragma unroll
            for (int m = 0; m < 4; ++m) { float* rowp = H + (size_t)(row0 + ai * HALF + m * 16) * 256 + col0;
#pragma unroll
                for (int bj = 0; bj < 2; ++bj)
#pragma unroll
                    for (int n = 0; n < 2; ++n) { f32x4 v = acc[ai][bj][m][n] + bvv[bj][n];
#pragma unroll
                        for (int j = 0; j < 4; ++j) { const float xx = v[j], uu = 0.7978845608028654f * (xx + 0.044715f * xx * xx * xx); const float th = 1.0f - 2.0f / (1.0f + __expf(2.0f * uu)); v[j] = 0.5f * xx * (1.0f + th); }
                        *(f32x4*)(rowp + bj * HALF + n * 16) = v; } }
    }
};
struct EpiGate {
    static constexpr bool PERM = false;
    float* C; const bf16_t* H; const bf16_t* eraw; const float* erstd; const float* pw; const float* ssq; int ldc; float ascale;
    __device__ __forceinline__ void operator()(const f32x4 (&acc)[2][2][4][2], const Unit& u, int wr, int wc, int fr, int fq) const {
        const int row0 = u.pm * BM + wr * 64 + fr, col0 = u.pn * BM + wc * 32 + 4 * fq;
        f32x4 wv[2][2];
#pragma unroll
        for (int bj = 0; bj < 2; ++bj)
#pragma unroll
            for (int n = 0; n < 2; ++n) wv[bj][n] = *(const f32x4*)(pw + col0 + bj * HALF + n * 16);
        constexpr int PF = 2, NB = PF + 1;
        u32x2 bv[NB][2][2]; u32x2 ev[NB][2][2]; float rsv[NB], rgv[NB];
#pragma unroll
        for (int p = 0; p < PF; ++p) { const int rowp = row0 + (p >> 2) * HALF + (p & 3) * 16;
#pragma unroll
            for (int bj = 0; bj < 2; ++bj)
#pragma unroll
                for (int n = 0; n < 2; ++n) { bv[p][bj][n] = *(const u32x2*)(H + (size_t)rowp * ldc + col0 + bj * HALF + n * 16); ev[p][bj][n] = *(const u32x2*)(eraw + (size_t)rowp * ldc + col0 + bj * HALF + n * 16); }
            rsv[p] = erstd[rowp]; rgv[p] = ssq[rowp]; }
#pragma unroll
        for (int rg = 0; rg < 8; ++rg) { const int ai = rg >> 2, m = rg & 3; const int row = row0 + ai * HALF + m * 16; const size_t off = (size_t)row * ldc + col0;
            if (rg + PF < 8) { const int ai2 = (rg + PF) >> 2, m2 = (rg + PF) & 3; const int row2 = row0 + ai2 * HALF + m2 * 16; const size_t off2 = (size_t)row2 * ldc + col0;
#pragma unroll
                for (int bj = 0; bj < 2; ++bj)
#pragma unroll
                    for (int n = 0; n < 2; ++n) { bv[(rg + PF) % NB][bj][n] = *(const u32x2*)(H + off2 + bj * HALF + n * 16); ev[(rg + PF) % NB][bj][n] = *(const u32x2*)(eraw + off2 + bj * HALF + n * 16); }
                rsv[(rg + PF) % NB] = erstd[row2]; rgv[(rg + PF) % NB] = ssq[row2]; }
            const float rs = rsqrtf(rsv[rg % NB] * (1.0f / DM) + EPS), rg_ = rsqrtf(rgv[rg % NB] * (1.0f / DM) + EPS) * ascale;
#pragma unroll
            for (int bj = 0; bj < 2; ++bj)
#pragma unroll
                for (int n = 0; n < 2; ++n) { const u32x2 br = bv[rg % NB][bj][n]; const f32x4 b = {bf_lo(br.x), bf_hi(br.x), bf_lo(br.y), bf_hi(br.y)}; const u32x2 e = ev[rg % NB][bj][n]; const f32x4 a = acc[ai][bj][m][n]; f32x4 o;
                    o[0] = b[0] + bf_lo(e.x) * rs * wv[bj][n][0] * sigmoidf_(a[0] * rg_); o[1] = b[1] + bf_hi(e.x) * rs * wv[bj][n][1] * sigmoidf_(a[1] * rg_);
                    o[2] = b[2] + bf_lo(e.y) * rs * wv[bj][n][2] * sigmoidf_(a[2] * rg_); o[3] = b[3] + bf_hi(e.y) * rs * wv[bj][n][3] * sigmoidf_(a[3] * rg_);
                    *(f32x4*)(C + off + bj * HALF + n * 16) = o; }
        }
    }
};
struct GFfn {
    const char* A; const char* B; unsigned lda, ldb; int nt;
    __device__ __forceinline__ const char* a_base(const Unit& u) const { return A + ((long)u.pm * 254 - 2) * (long)lda * 2; }
    __device__ __forceinline__ const char* b_base(const Unit& u) const { return B + (size_t)u.pn * 256 * ldb * 2; }
    __device__ __forceinline__ size_t kpairA() const { return 256; }
};
template <int CTRL> __device__ __forceinline__ float dpp_f(float v) { return __int_as_float(__builtin_amdgcn_update_dpp(0, __float_as_int(v), CTRL, 0xf, 0xf, false)); }
struct EpiFfn {
    static constexpr bool PERM = true;
    bf16_t* ACT; const float* cw; const float* cb; LAS float* X; const float* ssq;
    __device__ __forceinline__ void operator()(const f32x4 (&acc)[2][2][4][2], const Unit& u, int wr, int wc, int fr, int fq) const {
        const int colw = wc * 32 + 8 * fq;
        const int f0 = u.pn * 128 + colw;
        f32x4 w0[2], w1[2], w2[2], cbv[2];
#pragma unroll
        for (int n = 0; n < 2; ++n) { w0[n] = *(const f32x4*)(cw + f0 + 4 * n); w1[n] = *(const f32x4*)(cw + DFF + f0 + 4 * n); w2[n] = *(const f32x4*)(cw + 2 * DFF + f0 + 4 * n); cbv[n] = *(const f32x4*)(cb + f0 + 4 * n); }
        float rsv[2][4];
#pragma unroll
        for (int ai = 0; ai < 2; ++ai)
#pragma unroll
            for (int m = 0; m < 4; ++m) { const long t = (long)u.pm * 254 - 2 + ai * HALF + wr * 64 + m * 16 + fr; rsv[ai][m] = ssq[t < 0 ? 0 : (t >= S_ ? S_ - 1 : t)]; }
#pragma unroll
        for (int ai = 0; ai < 2; ++ai)
#pragma unroll
            for (int m = 0; m < 4; ++m) { const long t = (long)u.pm * 254 - 2 + ai * HALF + wr * 64 + m * 16 + fr; rsv[ai][m] = (t >= 0 && t < S_) ? rsqrtf(rsv[ai][m] * (1.0f / DM) + EPS) : 0.f; }
        if (fr >= 14) {
#pragma unroll
            for (int ai = 0; ai < 2; ++ai)
#pragma unroll
                for (int n = 0; n < 2; ++n) *(LAS f32x4*)(X + ((2 * ai + wr) * 2 + (fr - 14)) * 128 + colw + 4 * n) = acc[ai][0][3][n] * rsv[ai][3];
        }
        asm volatile("s_waitcnt lgkmcnt(0)" ::: "memory");
        __builtin_amdgcn_s_barrier(); asm volatile("" ::: "memory");
        __builtin_amdgcn_s_barrier(); asm volatile("" ::: "memory");
        const bool sel1 = fr == 15, sel2 = fr >= 14;
#pragma unroll
        for (int ai = 0; ai < 2; ++ai) {
            f32x4 pv[2];
            const int pseg = 2 * ai + wr - 1;
#pragma unroll
            for (int n = 0; n < 2; ++n) { pv[n] = (f32x4){0.f, 0.f, 0.f, 0.f}; if (pseg >= 0 && fr >= 14) pv[n] = *(const LAS f32x4*)(X + (pseg * 2 + (fr - 14)) * 128 + colw + 4 * n); }
#pragma unroll
            for (int m = 0; m < 4; ++m) {
                const int r = ai * HALF + wr * 64 + m * 16 + fr; const long t = (long)u.pm * 254 - 2 + r;
                unsigned ow[4];
#pragma unroll
                for (int n = 0; n < 2; ++n) {
                    const f32x4 cur = acc[ai][0][m][n] * rsv[ai][m], up = acc[ai][1][m][n] * rsv[ai][m];
                    f32x4 x1, x2;
#pragma unroll
                    for (int i = 0; i < 4; ++i) { x1[i] = dpp_f<0x121>(sel1 ? pv[n][i] : cur[i]); x2[i] = dpp_f<0x122>(sel2 ? pv[n][i] : cur[i]); }
                    const f32x4 y = cbv[n] + w0[n] * x2 + w1[n] * x1 + w2[n] * cur;
                    f32x4 sg;
#pragma unroll
                    for (int i = 0; i < 4; ++i) sg[i] = sigmoidf_(y[i]);
                    const f32x4 o = y * sg * up;
                    ow[2 * n] = cvt_pk_bf16(o[0], o[1]); ow[2 * n + 1] = cvt_pk_bf16(o[2], o[3]);
                    pv[n] = cur;
                }
                if (r >= 2 && t < S_) *(u32x4*)(ACT + (size_t)t * DFF + f0) = (u32x4){ow[0], ow[1], ow[2], ow[3]};
            }
        }
    }
};

template <class GD, class Epi, bool F8 = false>
__device__ __forceinline__ void gemm_phase(LAS unsigned char* lds, const GD g, const StaticOrder& S, const Epi& E) {
    const int tid = threadIdx.x, wid = __builtin_amdgcn_readfirstlane(tid >> 6), lane = tid & 63, wr = wid >> 2, wc = wid & 3, fr = lane & 15, fq = lane >> 4;
    const int nt = g.nt;
    unsigned voffA[2], voffB[2];
#pragma unroll
    for (int i = 0; i < 2; ++i) { int R, C; stage_rc(tid * 16 + i * 8192, R, C); const int Rb = Epi::PERM ? ((R & ~31) + perm32(R & 31)) : R;
        voffA[i] = (unsigned)(R * g.lda + C) * 2u; voffB[i] = (unsigned)(Rb * g.ldb + C) * 2u; }
    const size_t kpA = g.kpairA();
    const size_t hstepA = (size_t)HALF * g.lda * 2, hstepB = (size_t)HALF * g.ldb * 2;
    const unsigned ldsw = (unsigned)wid * 1024u;
    const int aoff = lds_byte(wr * 64 + fr, fq * 8), boff = lds_byte(wc * 32 + fr, fq * 8);
#define PG8_SA(b, h) (((b) * 2 + (h)) * HTB)
#define PG8_SB(b, h) ((4 + (b) * 2 + (h)) * HTB)
#define PG8_STAGE(bufoff, gbase, voff) do { _Pragma("unroll") for (int _i = 0; _i < 2; ++_i) \
        __builtin_amdgcn_global_load_lds((const unsigned*)((const char*)(gbase) + (voff)[_i]), (LAS unsigned*)(lds + (bufoff) + ldsw + _i * 8192), 16, 0, 0); } while (0)
#define PG8_LDA(dst, b, h) do { if constexpr (F8) { _Pragma("unroll") for (int m = 0; m < 4; ++m) { const i32x4 lo_ = *(const LAS i32x4*)(lds + PG8_SA(b, h) + aoff + m * 2048), hi_ = *(const LAS i32x4*)(lds + PG8_SA(b, h) + aoff + m * 2048 + 1024); \
            dst##8[m] = __builtin_shufflevector(lo_, hi_, 0, 1, 2, 3, 4, 5, 6, 7); } } \
        else { _Pragma("unroll") for (int m = 0; m < 4; ++m) _Pragma("unroll") for (int k = 0; k < 2; ++k) dst[m][k] = *(const LAS bf16x8*)(lds + PG8_SA(b, h) + aoff + m * 2048 + k * 1024); } } while (0)
#define PG8_LDB(dst, b, h) do { if constexpr (F8) { _Pragma("unroll") for (int n = 0; n < 2; ++n) { const i32x4 lo_ = *(const LAS i32x4*)(lds + PG8_SB(b, h) + boff + n * 2048), hi_ = *(const LAS i32x4*)(lds + PG8_SB(b, h) + boff + n * 2048 + 1024); \
            dst##8[n] = __builtin_shufflevector(lo_, hi_, 0, 1, 2, 3, 4, 5, 6, 7); } } \
        else { _Pragma("unroll") for (int n = 0; n < 2; ++n) _Pragma("unroll") for (int k = 0; k < 2; ++k) dst[n][k] = *(const LAS bf16x8*)(lds + PG8_SB(b, h) + boff + n * 2048 + k * 1024); } } while (0)
#define PG8_MMA(ai, bj, At, Bt) do { __builtin_amdgcn_s_setprio(1); \
        if constexpr (F8) { _Pragma("unroll") for (int m = 0; m < 4; ++m) _Pragma("unroll") for (int n = 0; n < 2; ++n) \
            asm volatile("v_mfma_scale_f32_16x16x128_f8f6f4 %0, %1, %2, %0, %3, %3 op_sel_hi:[0,0,0]" : "+v"(acc[ai][bj][m][n]) : "v"(Bt##8[n]), "v"(At##8[m]), "v"(one_scale)); } \
        else { _Pragma("unroll") for (int m = 0; m < 4; ++m) _Pragma("unroll") for (int n = 0; n < 2; ++n) _Pragma("unroll") for (int k = 0; k < 2; ++k) \
            acc[ai][bj][m][n] = __builtin_amdgcn_mfma_f32_16x16x32_bf16(Bt[n][k], At[m][k], acc[ai][bj][m][n], 0, 0, 0); } \
        __builtin_amdgcn_s_setprio(0); } while (0)
#define PG8_WAIT_V(n) asm volatile("s_waitcnt vmcnt(" #n ")" ::: "memory")
#define PG8_WAIT_L(n) asm volatile("s_waitcnt lgkmcnt(" #n ")" ::: "memory")
#define PG8_BAR __builtin_amdgcn_s_barrier()
#define PG8_SCHED __builtin_amdgcn_sched_barrier(0)
    Unit cur, nxt; int ui = 0;
    if (!S.next(0, cur)) return;
    f32x4 acc[2][2][4][2];
#pragma unroll
    for (int a = 0; a < 2; ++a)
#pragma unroll
        for (int b = 0; b < 2; ++b)
#pragma unroll
            for (int m = 0; m < 4; ++m)
#pragma unroll
                for (int n = 0; n < 2; ++n) acc[a][b][m][n] = (f32x4){0.f, 0.f, 0.f, 0.f};
    bf16x8 At[4][2], B0[2][2], B1[2][2];
    i32x8 At8[4], B08[2], B18[2];
    (void)At; (void)B0; (void)B1; (void)At8; (void)B08; (void)B18;
    int one_scale = 0x7F7F7F7F; (void)one_scale;
    const char* cA = g.a_base(cur); const char* cB = g.b_base(cur);
    PG8_STAGE(PG8_SB(0, 0), cB, voffB); PG8_STAGE(PG8_SA(0, 0), cA, voffA); PG8_STAGE(PG8_SB(0, 1), cB + hstepB, voffB); PG8_STAGE(PG8_SA(0, 1), cA + hstepA, voffA);
    if (wr == 1) PG8_BAR;
    PG8_WAIT_V(4); PG8_BAR;
    PG8_STAGE(PG8_SB(1, 0), cB + 128, voffB); PG8_STAGE(PG8_SA(1, 0), cA + 128, voffA); PG8_STAGE(PG8_SB(1, 1), cB + hstepB + 128, voffB);
    PG8_WAIT_V(6); PG8_BAR;
    for (;;) {
        const bool has_next = S.next(ui + 1, nxt);
        const char* nA = has_next ? g.a_base(nxt) : cA; const char* nB = has_next ? g.b_base(nxt) : cB;
        for (int t = 0; t < nt; t += 2) {
            const bool last = (t == nt - 2);
            const char* a0 = cA + (size_t)(t >> 1) * kpA;
            const char* a1 = a0 + 128;
            const char* a2 = last ? nA : a0 + kpA; const char* b2 = last ? nB : cB + (size_t)(t + 2) * 128;
            const char* a3 = a2 + 128; const char* b3 = b2 + 128;
            PG8_LDB(B0, 0, 0); PG8_SCHED; PG8_LDA(At, 0, 0); PG8_STAGE(PG8_SA(1, 1), a1 + hstepA, voffA);
            PG8_WAIT_L(8); PG8_BAR; PG8_WAIT_L(0); PG8_MMA(0, 0, At, B0); PG8_BAR; PG8_SCHED;
            PG8_LDB(B1, 0, 1); PG8_STAGE(PG8_SB(0, 0), b2, voffB);
            PG8_BAR; PG8_WAIT_L(0); PG8_MMA(0, 1, At, B1); PG8_BAR;
            PG8_LDA(At, 0, 1); PG8_STAGE(PG8_SA(0, 0), a2, voffA);
            PG8_BAR; PG8_WAIT_L(0); PG8_MMA(1, 0, At, B0); PG8_BAR; PG8_SCHED;
            PG8_STAGE(PG8_SB(0, 1), b2 + hstepB, voffB);
            PG8_WAIT_V(6); PG8_BAR; PG8_MMA(1, 1, At, B1); PG8_BAR;
            PG8_LDB(B0, 1, 0); PG8_SCHED; PG8_LDA(At, 1, 0); PG8_STAGE(PG8_SA(0, 1), a2 + hstepA, voffA);
            PG8_WAIT_L(8); PG8_BAR; PG8_WAIT_L(0); PG8_MMA(0, 0, At, B0); PG8_BAR; PG8_SCHED;
            PG8_LDB(B1, 1, 1); PG8_STAGE(PG8_SB(1, 0), b3, voffB);
            PG8_BAR; PG8_WAIT_L(0); PG8_MMA(0, 1, At, B1); PG8_BAR;
            PG8_LDA(At, 1, 1); PG8_STAGE(PG8_SA(1, 0), a3, voffA);
            PG8_BAR; PG8_WAIT_L(0); PG8_MMA(1, 0, At, B0); PG8_BAR; PG8_SCHED;
            PG8_STAGE(PG8_SB(1, 1), b3 + hstepB, voffB);
            PG8_WAIT_V(6); PG8_BAR; PG8_MMA(1, 1, At, B1); PG8_BAR;
        }
        if constexpr (F8) asm volatile("s_nop 15\n\ts_nop 15\n\ts_nop 15" ::: "memory");
        E(acc, cur, wr, wc, fr, fq);
        if (!has_next) break;
#pragma unroll
        for (int a = 0; a < 2; ++a)
#pragma unroll
            for (int b = 0; b < 2; ++b)
#pragma unroll
                for (int m = 0; m < 4; ++m)
#pragma unroll
                    for (int n = 0; n < 2; ++n) acc[a][b][m][n] = (f32x4){0.f, 0.f, 0.f, 0.f};
        cur = nxt; cA = nA; cB = nB; ++ui;
    }
    PG8_WAIT_V(0);
    if (wr == 0) PG8_BAR;
    PG8_BAR;
#undef PG8_SA
#undef PG8_SB
#undef PG8_STAGE
#undef PG8_LDA
#undef PG8_LDB
#undef PG8_MMA
#undef PG8_WAIT_V
#undef PG8_WAIT_L
#undef PG8_BAR
#undef PG8_SCHED
}
}

namespace att {
constexpr int KVBLK = 64;
constexpr int SHM_V = KVBLK * HD * 2, SHM_K = KVBLK * HD * 2, SHM_ATTN = 2 * SHM_V + 2 * SHM_K + NWAVES * 64 * 4;
#define KSWZ(row, colB) ((row) * 256 + ((colB) ^ (((row) & 7) << 4)))
#define SBAR() __builtin_amdgcn_sched_barrier(0)
__device__ __forceinline__ int crow(int r, int hi) { return (r & 3) + 8 * (r >> 2) + 4 * hi; }
__device__ __forceinline__ void qkt(f32x16& p0, f32x16& p1, const char* Ks, const bf16x8* qr, int r32, int hi) {
    p0 = f32x16{}; p1 = f32x16{};
    bf16x8 ka[2], kb[2];
    { const int cb = (hi * 8) * 2; ka[0] = *reinterpret_cast<const bf16x8*>(Ks + KSWZ(r32, cb)); kb[0] = *reinterpret_cast<const bf16x8*>(Ks + KSWZ(32 + r32, cb)); }
#pragma unroll
    for (int d0 = 0; d0 < 8; ++d0) {
        if (d0 < 7) { const int cb = ((d0 + 1) * 16 + hi * 8) * 2;
            ka[(d0 + 1) & 1] = *reinterpret_cast<const bf16x8*>(Ks + KSWZ(r32, cb)); kb[(d0 + 1) & 1] = *reinterpret_cast<const bf16x8*>(Ks + KSWZ(32 + r32, cb)); }
        SBAR();
        p0 = __builtin_amdgcn_mfma_f32_32x32x16_bf16(ka[d0 & 1], qr[d0], p0, 0, 0, 0);
        p1 = __builtin_amdgcn_mfma_f32_32x32x16_bf16(kb[d0 & 1], qr[d0], p1, 0, 0, 0);
        SBAR();
    }
}
__device__ __forceinline__ int v_st(int k, int c) { const int kk = (k & ~0xC) | ((k & 4) << 1) | ((k & 8) >> 1); return ((kk >> 3) * 4 + (c >> 5)) * 512 + ((kk & 7) * 32 + (c & 31)) * 2; }
__device__ __forceinline__ int v_rd_base(int lane) { return ((lane & 3) << 3) | (((lane >> 2) & 3) << 6) | (((lane >> 4) & 1) << 5) | (((lane >> 5) & 1) << 8); }
constexpr int v_rd_off(int d0, int ks, int half) { return d0 * 512 + ks * 4096 + half * 2048; }
__device__ __forceinline__ s16x4 tr_read(int vb, int off) { return __builtin_amdgcn_ds_read_tr16_b64_v4i16((LAS s16x4*)(unsigned long)(unsigned)(vb + off)); }
__device__ __forceinline__ void pv_d0(f32x16* o, int vb, bf16x8 pa0, bf16x8 pa1, bf16x8 pa2, bf16x8 pa3) {
    s16x4 L[2][4], H[2][4];
#pragma unroll
    for (int d0 = 0; d0 < 4; ++d0) { L[0][d0] = tr_read(vb, v_rd_off(d0, 0, 0)); H[0][d0] = tr_read(vb, v_rd_off(d0, 0, 1)); }
#pragma unroll
    for (int ks = 0; ks < 4; ++ks) {
        if (ks < 3) {
#pragma unroll
            for (int d0 = 0; d0 < 4; ++d0) { L[(ks + 1) & 1][d0] = tr_read(vb, v_rd_off(d0, ks + 1, 0)); H[(ks + 1) & 1][d0] = tr_read(vb, v_rd_off(d0, ks + 1, 1)); }
        }
        const bf16x8 pa = ks == 0 ? pa0 : (ks == 1 ? pa1 : (ks == 2 ? pa2 : pa3));
#pragma unroll
        for (int d0 = 0; d0 < 4; ++d0) { const s16x4 l = L[ks & 1][d0], h = H[ks & 1][d0];
            o[d0] = __builtin_amdgcn_mfma_f32_32x32x16_bf16(pa, (bf16x8){l[0], l[1], l[2], l[3], h[0], h[1], h[2], h[3]}, o[d0], 0, 0, 0); }
    }
}
__device__ __forceinline__ void pack_p(const f32x16& p0, const f32x16& p1, bf16x8& pa0, bf16x8& pa1, bf16x8& pa2, bf16x8& pa3) {
#define PK4(P, BASE, OUT) do { unsigned a0 = cvt_pk_bf16(P[BASE + 0], P[BASE + 1]), a1 = cvt_pk_bf16(P[BASE + 2], P[BASE + 3]);   \
    unsigned b0 = cvt_pk_bf16(P[BASE + 4], P[BASE + 5]), b1 = cvt_pk_bf16(P[BASE + 6], P[BASE + 7]);                              \
    auto r0 = __builtin_amdgcn_permlane32_swap(a0, b0, false, false); auto r1 = __builtin_amdgcn_permlane32_swap(a1, b1, false, false); \
    u32x4 w = {r0[0], r1[0], r0[1], r1[1]}; OUT = *reinterpret_cast<bf16x8*>(&w); } while (0)
    PK4(p0, 0, pa0); PK4(p0, 8, pa1); PK4(p1, 0, pa2); PK4(p1, 8, pa3);
#undef PK4
}

__device__ __forceinline__ void pack_half(const f32x16& p, bf16x8& paA, bf16x8& paB) {
#define PK4(P, BASE, OUT) do { unsigned a0 = cvt_pk_bf16(P[BASE + 0], P[BASE + 1]), a1 = cvt_pk_bf16(P[BASE + 2], P[BASE + 3]);   \
    unsigned b0 = cvt_pk_bf16(P[BASE + 4], P[BASE + 5]), b1 = cvt_pk_bf16(P[BASE + 6], P[BASE + 7]);                              \
    auto r0 = __builtin_amdgcn_permlane32_swap(a0, b0, false, false); auto r1 = __builtin_amdgcn_permlane32_swap(a1, b1, false, false); \
    u32x4 w = {r0[0], r1[0], r0[1], r1[1]}; OUT = *reinterpret_cast<bf16x8*>(&w); } while (0)
    PK4(p, 0, paA); PK4(p, 8, paB);
#undef PK4
}
template <int KS0, bool WITH_EXP>
__device__ __forceinline__ void pv_half(f32x16* o, int vb, bf16x8 paA, bf16x8 paB, f32x16& px, float off) {
    s16x4 L[2][4], H[2][4];
#pragma unroll
    for (int d0 = 0; d0 < 4; ++d0) { L[0][d0] = tr_read(vb, v_rd_off(d0, KS0, 0)); H[0][d0] = tr_read(vb, v_rd_off(d0, KS0, 1)); }
#pragma unroll
    for (int d0 = 0; d0 < 4; ++d0) { L[1][d0] = tr_read(vb, v_rd_off(d0, KS0 + 1, 0)); H[1][d0] = tr_read(vb, v_rd_off(d0, KS0 + 1, 1)); }
#pragma unroll
    for (int kk = 0; kk < 2; ++kk) {
        const bf16x8 pa = kk == 0 ? paA : paB;
#pragma unroll
        for (int d0 = 0; d0 < 4; ++d0) { const s16x4 l = L[kk][d0], h = H[kk][d0];
            if (WITH_EXP) SBAR();
            o[d0] = __builtin_amdgcn_mfma_f32_32x32x16_bf16(pa, (bf16x8){l[0], l[1], l[2], l[3], h[0], h[1], h[2], h[3]}, o[d0], 0, 0, 0);
            if (WITH_EXP) {
#pragma unroll
                for (int q = 0; q < 2; ++q) { const int r = (kk * 4 + d0) * 2 + q; px[r] = __builtin_amdgcn_exp2f(fmaf(px[r], SM_C, off)); }
                SBAR(); }
        }
    }
}
enum { MODE_CMP = 0, MODE_WIN = 1, MODE_SLC = 2 };
struct AttnArgs {
    const bf16_t* Z; const bf16_t* KC; const bf16_t* VC; const float* G; float* L; float* OACC; bf16_t* MIX; const unsigned* BM; const float* TAB;
};
template <int MODE>
__device__ __forceinline__ void attn_unit(const AttnArgs& a, LAS char* ldsL, int qt, int g, int hp) {
    char* lds = (char*)ldsL;
    const int tid = threadIdx.x, wid = __builtin_amdgcn_readfirstlane(tid >> 6), lane = tid & 63, r32 = lane & 31, hi = lane >> 5;
    float* li_l = (float*)(lds + LDS_XCH) + wid * 64;
    const int t0 = MODE == MODE_SLC ? qt * 40 : qt * 128;
    const int tq_raw = MODE == MODE_SLC ? t0 + wid * 5 + r32 / 6 : t0 + wid * 16 + (r32 & 15);
    const bool rvalid = MODE == MODE_SLC ? (r32 < 30 && tq_raw < S_) : true;
    const int tq = tq_raw < S_ ? tq_raw : S_ - 1;
    const int hq = MODE == MODE_SLC ? g * HPG + r32 % 6 : g * HPG + hp * 2 + (r32 >> 4);
    const int tlast = MODE == MODE_SLC ? ((t0 + 39) < S_ ? (t0 + 39) : S_ - 1) : t0 + 127;
    const bf16_t* Kb; const bf16_t* Vb; long ldk;
    if (MODE == MODE_CMP) { Kb = a.KC + (size_t)g * 1024 * HD; Vb = a.VC + (size_t)g * 1024 * HD; ldk = HD; }
    else if (MODE == MODE_WIN) { Kb = a.Z + OFF_KV + 4 * 512 + g * HD; Vb = a.Z + OFF_KV + 5 * 512 + g * HD; ldk = LDZ; }
    else { Kb = a.Z + OFF_KV + 2 * 512 + g * HD; Vb = a.Z + OFF_KV + 3 * 512 + g * HD; ldk = LDZ; }
    int j0, j1;
    if (MODE == MODE_CMP) { j0 = 0; j1 = (((t0 + 127 - 31) >> 4) >> 6) + 1; }
    else if (MODE == MODE_WIN) { j0 = (t0 - 511) > 0 ? ((t0 - 511) >> 6) : 0; j1 = ((t0 + 127) >> 6) + 1; }
    else { j0 = 0; j1 = (tlast >> 6) + 1; }
    int klo, khi;
    if (MODE == MODE_CMP) { klo = 0; khi = tq >= 31 ? ((tq - 31) >> 4) : -1; }
    else if (MODE == MODE_WIN) { klo = tq - 511; khi = tq; }
    else { klo = 0; khi = rvalid ? tq : -1; }
    float negBC = -a.TAB[512 + (MODE == MODE_CMP ? 0 : (MODE == MODE_SLC ? 1 : 2))];
    bf16x8 qr[8];
    { const bf16_t* Qw = a.Z + (size_t)tq * LDZ + OFF_Q + hq * HD + hi * 8;
#pragma unroll
      for (int d0 = 0; d0 < 8; ++d0) qr[d0] = *reinterpret_cast<const bf16x8*>(Qw + d0 * 16); }
    f32x16 o[4] = {}; float lsum = 0.f;
    unsigned soK[2], soV[2];
#pragma unroll
    for (int i = 0; i < 2; ++i) { const int p = (wid + 8 * i) * 64 + lane;
        { const int row = p >> 4, c = (p & 15) ^ (row & 7); soK[i] = (unsigned)(row * ldk + c * 8) * 2u; }
        { const int sub = p >> 5, within = p & 31, kk = (sub >> 2) * 8 + (within >> 2), c = (sub & 3) * 32 + (within & 3) * 8, k = (kk & ~0xC) | ((kk & 4) << 1) | ((kk & 8) >> 1);
          soV[i] = (unsigned)(k * ldk + c) * 2u; } }
    const int vb0 = (int)(uintptr_t)(LAS char*)ldsL + 16384 + v_rd_base(lane);
#define ISSUE(jt) do { const int _b = ((jt) - j0) & 3; const char* _kp = (const char*)Kb + (size_t)(jt) * KVBLK * ldk * 2; const char* _vp = (const char*)Vb + (size_t)(jt) * KVBLK * ldk * 2; \
    _Pragma("unroll") for (int _i = 0; _i < 2; ++_i) { \
        __builtin_amdgcn_global_load_lds((const unsigned*)(_kp + soK[_i]), (LAS unsigned*)(ldsL + _b * 32768 + (wid + 8 * _i) * 1024), 16, 0, 0); \
        __builtin_amdgcn_global_load_lds((const unsigned*)(_vp + soV[_i]), (LAS unsigned*)(ldsL + _b * 32768 + 16384 + (wid + 8 * _i) * 1024), 16, 0, 0); } } while (0)
    unsigned bmw = 0u;
    if (MODE == MODE_SLC) bmw = a.BM[((size_t)tq * 4 + g) * 8];
    asm volatile("s_waitcnt lgkmcnt(0)" ::: "memory");
    __builtin_amdgcn_s_barrier();
    asm volatile("" ::: "memory");
    ISSUE(j0);
    asm volatile("s_waitcnt vmcnt(4) lgkmcnt(0)" : "+v"(bmw), "+v"(negBC), "+v"(qr[0]), "+v"(qr[1]), "+v"(qr[2]), "+v"(qr[3]), "+v"(qr[4]), "+v"(qr[5]), "+v"(qr[6]), "+v"(qr[7]) :: "memory");
    if (j0 + 1 < j1) ISSUE(j0 + 1); if (j0 + 2 < j1) ISSUE(j0 + 2);
    for (int j = j0; j < j1; ++j) {
        const int buf = (j - j0) & 3;
        if (j + 2 < j1) asm volatile("s_waitcnt vmcnt(8)" ::: "memory"); else if (j + 1 < j1) asm volatile("s_waitcnt vmcnt(4)" ::: "memory"); else asm volatile("s_waitcnt vmcnt(0)" ::: "memory");
        __builtin_amdgcn_s_barrier();
        asm volatile("" ::: "memory");
        if (j + 3 < j1) ISSUE(j + 3);
        int lhi = khi;
        if (MODE == MODE_SLC) { if (!((bmw >> (j & 31)) & 1u)) lhi = -1; }
        const int kb = j * KVBLK;
        const bool l_any = (kb + 63 >= klo) && (kb <= lhi);
        const bool l_full = (kb >= klo) && (kb + 63 <= lhi);
        if (__any(l_any)) {
            f32x16 p0, p1;
            qkt(p0, p1, lds + buf * 32768, qr, r32, hi);
            const bool uni = __all(l_full || !l_any);
            const float off = (uni && !l_any) ? -1.0e30f : negBC;
#pragma unroll
            for (int r = 0; r < 16; ++r) p0[r] = __builtin_amdgcn_exp2f(fmaf(p0[r], SM_C, off));
            if (!uni) {
#pragma unroll
                for (int r = 0; r < 16; ++r) { const int k0i = kb + crow(r, hi); p0[r] = (k0i >= klo && k0i <= lhi) ? p0[r] : 0.f; } }
            float ps = 0.f;
#pragma unroll
            for (int r = 0; r < 16; ++r) ps += p0[r];
            bf16x8 pa0, pa1, pa2, pa3; pack_half(p0, pa0, pa1);
            pv_half<0, true>(o, vb0 + buf * 32768, pa0, pa1, p1, off);
            if (!uni) {
#pragma unroll
                for (int r = 0; r < 16; ++r) { const int k1i = kb + 32 + crow(r, hi); p1[r] = (k1i >= klo && k1i <= lhi) ? p1[r] : 0.f; } }
#pragma unroll
            for (int r = 0; r < 16; ++r) ps += p1[r];
            lsum += ps;
            pack_half(p1, pa2, pa3);
            pv_half<2, false>(o, vb0 + buf * 32768, pa2, pa3, p1, off);
        }
        if (MODE == MODE_SLC) { if (((j + 1) & 31) == 0 && j + 1 < j1) { bmw = a.BM[((size_t)tq * 4 + g) * 8 + ((j + 1) >> 5)]; asm volatile("s_waitcnt vmcnt(0)" : "+v"(bmw) :: "memory"); } }
    }
#undef ISSUE
    lsum += __shfl_xor(lsum, 32);
    const float grow = a.G[(size_t)tq * NGATE + hq * 3 + (MODE == MODE_CMP ? 0 : (MODE == MODE_SLC ? 1 : 2))];
    if (hi == 0) { li_l[r32] = lsum; li_l[32 + r32] = rvalid ? grow : 0.f; }
    if (MODE == MODE_CMP) { if (hi == 0) a.L[(size_t)tq * NH + hq] = lsum; }
    asm volatile("s_waitcnt lgkmcnt(0)" ::: "memory");
#pragma unroll
    for (int hf = 0; hf < 2; ++hf) {
        float gtv[8]; float pvv[8][4];
#pragma unroll
        for (int rr = 0; rr < 8; ++rr) { const int r = hf * 8 + rr;
            const int orow = crow(r, hi); const float lv = li_l[orow]; const float rl = lv > 0.f ? __builtin_amdgcn_rcpf(lv) : 0.f;
            const int t = MODE == MODE_SLC ? t0 + wid * 5 + orow / 6 : t0 + wid * 16 + (orow & 15);
            const int h = MODE == MODE_SLC ? g * HPG + orow % 6 : g * HPG + hp * 2 + (orow >> 4);
            const bool valid = !(MODE == MODE_SLC && (orow >= 30 || t >= S_)); const int tc = valid ? t : 0;
            gtv[rr] = li_l[32 + orow] * rl;
            if (MODE == MODE_SLC) { const bf16_t* oc = (const bf16_t*)a.OACC + (size_t)tc * 3072 + h * HD + r32; const bf16_t* ow = oc + (size_t)S_ * 3072;
#pragma unroll
                for (int d0 = 0; d0 < 4; ++d0) pvv[rr][d0] = bf2f(oc[d0 * 32]) + bf2f(ow[d0 * 32]); }
        }
#pragma unroll
        for (int rr = 0; rr < 8; ++rr) { const int r = hf * 8 + rr;
            const int orow = crow(r, hi);
            const int t = MODE == MODE_SLC ? t0 + wid * 5 + orow / 6 : t0 + wid * 16 + (orow & 15);
            const int h = MODE == MODE_SLC ? g * HPG + orow % 6 : g * HPG + hp * 2 + (orow >> 4);
            if (MODE == MODE_SLC && (orow >= 30 || t >= S_)) continue;
            bf16_t* oa = (bf16_t*)a.OACC + (MODE == MODE_WIN ? (size_t)S_ * 3072 : 0) + (size_t)t * 3072 + h * HD + r32;
#pragma unroll
            for (int d0 = 0; d0 < 4; ++d0) {
                const float v = o[d0][r] * gtv[rr];
                if (MODE != MODE_SLC) oa[d0 * 32] = (bf16_t)(cvt_pk_bf16(v, 0.f) & 0xffffu);
                else a.MIX[(size_t)t * DM + POOLW + h * HD + d0 * 32 + r32] = (bf16_t)(cvt_pk_bf16(pvv[rr][d0] + v, 0.f) & 0xffffu);
            }
        }
    }
}

constexpr int SLC_KPS = 1040, SLC_VPS = 1056, SLC_KIMG = 16 * SLC_KPS, SLC_BUF = SLC_KIMG + 16 * SLC_VPS, LDS_SLCX = 4 * SLC_BUF;
static_assert(LDS_SLCX + 3072 <= LDS_MISC, "slc ring overlaps the barrier words");
__device__ __forceinline__ bf16x8 lds_b128(int adr) { return *reinterpret_cast<const LAS bf16x8*>((LAS char*)(unsigned long)(unsigned)adr); }
__device__ __forceinline__ void slc16_unit(const AttnArgs& a, LAS char* ldsL, int ut, int g) {
    char* lds = (char*)ldsL;
    const int tid = threadIdx.x, wid = __builtin_amdgcn_readfirstlane(tid >> 6), lane = tid & 63, fr = lane & 15, fq = lane >> 4;
    float* li_l = (float*)(lds + LDS_SLCX) + wid * 96;
    const int t0 = ut * 64, j0 = 0, j1 = ut + 1;
    const bf16_t* Kb = a.Z + OFF_KV + 2 * 512 + g * HD; const long ldk = LDZ;
    int tqv[3];
#pragma unroll
    for (int b = 0; b < 3; ++b) tqv[b] = t0 + wid * 8 + (16 * b + fr) / 6;
#define TQC(b) tqv[b]
#define HQ(b) (g * HPG + (16 * (b) + fr) % 6)
    float negBC = -a.TAB[513];
    bf16x8 qf[3][4];
#pragma unroll
    for (int b = 0; b < 3; ++b) { const bf16_t* qp = a.Z + (size_t)TQC(b) * LDZ + OFF_Q + HQ(b) * HD + fq * 8;
#pragma unroll
        for (int ks = 0; ks < 4; ++ks) qf[b][ks] = *reinterpret_cast<const bf16x8*>(qp + ks * 32); }
    f32x4 o[3][8]; float lsum[3];
#pragma unroll
    for (int b = 0; b < 3; ++b) { lsum[b] = 0.f;
#pragma unroll
        for (int c = 0; c < 8; ++c) o[b][c] = (f32x4){0.f, 0.f, 0.f, 0.f}; }
    const int q4 = fr >> 2, p4 = fr & 3, lbase = (int)(uintptr_t)ldsL;
    const int kaddr0 = lbase + fr * SLC_KPS + fq * 16;
    const int vaddr0 = lbase + SLC_KIMG + (4 * fq + q4) * SLC_VPS + (p4 >> 1) * 16 + (p4 & 1) * 8;
    unsigned so0 = (unsigned)((wid + 16 * (lane >> 4)) * ldk + (lane & 15) * 8) * 2u;
#define ISSUE16(jt) do { const int _b = ((jt) - j0) & 3; const char* _kp = (const char*)Kb + (size_t)(jt) * KVBLK * ldk * 2; asm volatile("" : "+v"(so0)); \
    _Pragma("unroll") for (int _i = 0; _i < 4; ++_i) \
        __builtin_amdgcn_global_load_lds((const unsigned*)(_kp + (_i >> 1) * 1024 + (_i & 1) * (8 * ldk * 2) + so0), \
            (LAS unsigned*)(ldsL + _b * SLC_BUF + ((_i >> 1) ? SLC_KIMG + (wid + 8 * (_i & 1)) * SLC_VPS : (wid + 8 * (_i & 1)) * SLC_KPS)), 16, 0, 0); } while (0)
    unsigned bmw[3];
#pragma unroll
    for (int b = 0; b < 3; ++b) bmw[b] = a.BM[((size_t)TQC(b) * 4 + g) * 8];
    asm volatile("s_waitcnt lgkmcnt(0)" ::: "memory");
    __builtin_amdgcn_s_barrier();
    asm volatile("" ::: "memory");
    ISSUE16(j0); if (j0 + 1 < j1) ISSUE16(j0 + 1);
    asm volatile("s_waitcnt vmcnt(0) lgkmcnt(0)" : "+v"(bmw[0]), "+v"(bmw[1]), "+v"(bmw[2]), "+v"(negBC), "+v"(qf[0][0]), "+v"(qf[0][1]), "+v"(qf[0][2]), "+v"(qf[0][3]),
                 "+v"(qf[1][0]), "+v"(qf[1][1]), "+v"(qf[1][2]), "+v"(qf[1][3]), "+v"(qf[2][0]), "+v"(qf[2][1]), "+v"(qf[2][2]), "+v"(qf[2][3]) :: "memory");
    int kadr = kaddr0, vadr = vaddr0;
    for (int j = j0; j < j1; ++j) {
        const int buf = (j - j0) & 3;
        if ((j & 1) == 0) {
            asm volatile("s_waitcnt vmcnt(0)" ::: "memory");
            __builtin_amdgcn_s_barrier();
            asm volatile("" ::: "memory");
            if (j + 2 < j1) ISSUE16(j + 2); if (j + 3 < j1) ISSUE16(j + 3); }
        const int kb = j * KVBLK;
#define KF16(ks, mt) lds_b128(kadr + 64 * (ks) + 256 * (mt))
#define TRA(dst, off) asm volatile("ds_read_b64_tr_b16 %0, %1 offset:%2" : "=v"(dst) : "v"(vadr), "n"(off))
#define VLOAD(dst, s, h) _Pragma("unroll") for (int _c = 0; _c < 4; ++_c) { TRA(dst[_c][0], 32 * (4 * (h) + _c) + 512 * (s)); TRA(dst[_c][1], 32 * (4 * (h) + _c) + 512 * (s) + 256); }
#define VWAIT(n, d) asm volatile("s_waitcnt lgkmcnt(" #n ")" : "+v"(d[0][0]), "+v"(d[0][1]), "+v"(d[1][0]), "+v"(d[1][1]), "+v"(d[2][0]), "+v"(d[2][1]), "+v"(d[3][0]), "+v"(d[3][1]))
#define PVMMA(src, pa, h) _Pragma("unroll") for (int _c = 0; _c < 4; ++_c) o[b][4 * (h) + _c] = __builtin_amdgcn_mfma_f32_16x16x32_bf16(pa, \
            (bf16x8){src[_c][0][0], src[_c][0][1], src[_c][0][2], src[_c][0][3], src[_c][1][0], src[_c][1][1], src[_c][1][2], src[_c][1][3]}, o[b][4 * (h) + _c], 0, 0, 0);
#define EXPH(h, pw) { if (uni) { _Pragma("unroll") for (int mt = 2 * (h); mt < 2 * (h) + 2; ++mt) _Pragma("unroll") for (int i = 0; i < 4; ++i) { \
                            const float e_ = __builtin_amdgcn_exp2f(fmaf(acc[mt][i], SM_C, off)); acc[mt][i] = e_; ps += e_; } } \
                      else { asm volatile("" ::: "memory"); _Pragma("unroll") for (int mt = 2 * (h); mt < 2 * (h) + 2; ++mt) _Pragma("unroll") for (int i = 0; i < 4; ++i) { \
                            float e_ = __builtin_amdgcn_exp2f(fmaf(acc[mt][i], SM_C, off)); e_ = (16 * mt + i <= lim4) ? e_ : 0.f; acc[mt][i] = e_; ps += e_; } } \
                      pw.x = cvt_pk_bf16(acc[2 * (h)][0], acc[2 * (h)][1]); pw.y = cvt_pk_bf16(acc[2 * (h)][2], acc[2 * (h)][3]); \
                      pw.z = cvt_pk_bf16(acc[2 * (h) + 1][0], acc[2 * (h) + 1][1]); pw.w = cvt_pk_bf16(acc[2 * (h) + 1][2], acc[2 * (h) + 1][3]); }
#pragma unroll
        for (int b = 0; b < 3; ++b) {
            const bool sel = (bmw[b] >> (j & 31)) & 1u;
            const int lim = tqv[b] - kb;
            const bool l_any = sel && lim >= 0, l_full = sel && lim >= 63;
            if (__any(l_any)) {
                f32x4 acc[4]; bf16x8 kr[8]; s16x4 va[4][2], vc[4][2];
#define KRD(i) asm volatile("ds_read_b128 %0, %1 offset:%2" : "=v"(kr[(i) & 7]) : "v"(kadr), "n"(64 * ((i) >> 2) + 256 * ((i) & 3)))
#define KWT(n, i) asm volatile("s_waitcnt lgkmcnt(" #n ")" : "+v"(kr[(i) & 7]))
#define KMM(i) acc[(i) & 3] = __builtin_amdgcn_mfma_f32_16x16x32_bf16(kr[(i) & 7], qf[b][(i) >> 2], (i) < 4 ? (f32x4){0.f, 0.f, 0.f, 0.f} : acc[(i) & 3], 0, 0, 0)
                KRD(0); KRD(1); KRD(2); KRD(3); KRD(4); KRD(5); KRD(6); KRD(7);
#define SB_ __builtin_amdgcn_sched_barrier(0)
                SB_; KWT(7, 0); KMM(0); SB_; KRD(8);  KWT(7, 1); KMM(1); SB_; KRD(9);  KWT(7, 2); KMM(2); SB_; KRD(10); KWT(7, 3); KMM(3); SB_; KRD(11);
                KWT(7, 4); KMM(4); SB_; KRD(12); KWT(7, 5); KMM(5); SB_; KRD(13); KWT(7, 6); KMM(6); SB_; KRD(14); KWT(7, 7); KMM(7); SB_; KRD(15);
                KWT(7, 8); KMM(8); SB_; KWT(6, 9); KMM(9); SB_; KWT(5, 10); KMM(10); SB_; KWT(4, 11); KMM(11); SB_; KWT(3, 12); KMM(12); SB_; KWT(2, 13); KMM(13); SB_; KWT(1, 14); KMM(14); SB_; KWT(0, 15); KMM(15);
#undef SB_
                __builtin_amdgcn_sched_barrier(0);
#undef KRD
#undef KWT
#undef KMM
                VLOAD(va, 0, 0)
                VLOAD(vc, 0, 1)
                const bool uni = __all(l_full || !l_any);
                const float off = (uni && !l_any) ? -1.0e30f : negBC;
                const int lim4 = l_any ? lim - 4 * fq : -1;
                float ps = 0.f;
                u32x4 pw0, pw1;
                EXPH(0, pw0)
                const bf16x8 pa0 = *reinterpret_cast<bf16x8*>(&pw0);
                __builtin_amdgcn_sched_barrier(0);
                VWAIT(8, va);
                PVMMA(va, pa0, 0)
                __builtin_amdgcn_sched_barrier(0);
                VLOAD(va, 1, 0)
                VWAIT(8, vc);
                PVMMA(vc, pa0, 1)
                __builtin_amdgcn_sched_barrier(0);
                VLOAD(vc, 1, 1)
                EXPH(1, pw1)
                const bf16x8 pa1 = *reinterpret_cast<bf16x8*>(&pw1);
                lsum[b] += ps;
                __builtin_amdgcn_sched_barrier(0);
                VWAIT(8, va);
                PVMMA(va, pa1, 0)
                __builtin_amdgcn_sched_barrier(0);
                VWAIT(0, vc);
                PVMMA(vc, pa1, 1)
                __builtin_amdgcn_sched_barrier(0);
            }
        }
#undef TRA
#undef VWAIT
#undef EXPH
#undef KF16
#undef VLOAD
#undef PVMMA
        if (((j + 1) & 31) == 0 && j + 1 < j1) {
#pragma unroll
            for (int b = 0; b < 3; ++b) bmw[b] = a.BM[((size_t)TQC(b) * 4 + g) * 8 + ((j + 1) >> 5)];
            asm volatile("s_waitcnt vmcnt(0)" : "+v"(bmw[0]), "+v"(bmw[1]), "+v"(bmw[2]) :: "memory"); }
        { const int step = buf == 3 ? -3 * SLC_BUF : SLC_BUF; kadr += step; vadr += step; asm volatile("" : "+v"(kadr), "+v"(vadr)); }
    }
#undef ISSUE16
    int fqe = fq, fre = fr; asm volatile("" : "+v"(fqe), "+v"(fre));
    float grow[3];
#pragma unroll
    for (int b = 0; b < 3; ++b) grow[b] = a.G[(size_t)TQC(b) * NGATE + (g * HPG + (16 * b + fre) % 6) * 3 + 1];
#pragma unroll
    for (int b = 0; b < 3; ++b) { float ls = lsum[b]; ls += __shfl_xor(ls, 16); ls += __shfl_xor(ls, 32);
        if (fqe == 0) { li_l[b * 32 + fre] = ls; li_l[b * 32 + 16 + fre] = grow[b]; } }
    asm volatile("s_waitcnt lgkmcnt(0)" ::: "memory");
#pragma unroll
    for (int b = 0; b < 3; ++b) {
        float pv_[4][8]; float gtv[4];
#pragma unroll
        for (int i = 0; i < 4; ++i) { const int q = 4 * fqe + i, R = 16 * b + q; const float lv = li_l[b * 32 + q]; gtv[i] = li_l[b * 32 + 16 + q] * (lv > 0.f ? __builtin_amdgcn_rcpf(lv) : 0.f);
            const int t = t0 + wid * 8 + R / 6, h = g * HPG + R % 6;
            const bf16_t* oc = (const bf16_t*)a.OACC + (size_t)t * 3072 + h * HD + fre; const bf16_t* ow = oc + (size_t)S_ * 3072;
            bf16_t c_[8], w_[8];
#pragma unroll
            for (int c = 0; c < 8; ++c) { c_[c] = oc[c * 16]; w_[c] = ow[c * 16]; }
#pragma unroll
            for (int c = 0; c < 8; ++c) pv_[i][c] = bf2f(c_[c]) + bf2f(w_[c]); }
#pragma unroll
        for (int i = 0; i < 4; ++i) { const int R = 16 * b + 4 * fqe + i; const int t = t0 + wid * 8 + R / 6, h = g * HPG + R % 6;
            bf16_t* mp = a.MIX + (size_t)t * DM + POOLW + h * HD + fre;
#pragma unroll
            for (int c = 0; c < 8; ++c) mp[c * 16] = (bf16_t)(cvt_pk_bf16(pv_[i][c] + o[b][c][i] * gtv[i], 0.f) & 0xffffu); }
    }
#undef TQC
#undef HQ
}

__device__ __forceinline__ void imp_task(const AttnArgs& a, float* IMPP, float* IMPF, int tqi, int g) {
    const int lane = threadIdx.x & 63, fr = lane & 15, fq = lane >> 4;
    const int t = tqi * 16 + fr;
    const int tmax = tqi * 16 + 15;
    if (tmax < 31) return;
    const int lim = t >= 31 ? ((t - 31) >> 4) : -1;
    const int nstep = ((((tmax - 31) >> 4) >> 6) + 1) * 4;
    const float negBC = -a.TAB[512];
    bf16x8 qf[HPG][4]; float rl[HPG];
#pragma unroll
    for (int h = 0; h < HPG; ++h) {
        const bf16_t* qp = a.Z + (size_t)t * LDZ + OFF_Q + (g * HPG + h) * HD + fq * 8;
#pragma unroll
        for (int ks = 0; ks < 4; ++ks) qf[h][ks] = *reinterpret_cast<const bf16x8*>(qp + ks * 32);
        const float lv = a.L[(size_t)t * NH + g * HPG + h]; rl[h] = lv > 0.f ? 1.0f / lv : 0.f;
    }
    const bf16_t* kbase = a.KC + (size_t)g * 1024 * HD + (size_t)fr * HD + fq * 8;
    bf16x8 kf[4], kn[4], kn2[4];
#pragma unroll
    for (int ks = 0; ks < 4; ++ks) { kf[ks] = *reinterpret_cast<const bf16x8*>(kbase + ks * 32); kn[ks] = *reinterpret_cast<const bf16x8*>(kbase + (size_t)(nstep > 1 ? 1 : 0) * 16 * HD + ks * 32); }
    float* op = IMPP + ((size_t)t * 4 + g) * 256 + fq; float* of = IMPF + ((size_t)t * 4 + g) * 256 + fq;
    for (int st = 0; st < nstep; ++st) {
        const int sn = (st + 2 < nstep) ? st + 2 : nstep - 1;
#pragma unroll
        for (int ks = 0; ks < 4; ++ks) kn2[ks] = *reinterpret_cast<const bf16x8*>(kbase + (size_t)sn * 16 * HD + ks * 32);
        f32x4 imp4 = {0.f, 0.f, 0.f, 0.f};
        const int n0 = st * 16 + fq * 4;
#pragma unroll
        for (int h = 0; h < HPG; ++h) {
            f32x4 acc = {0.f, 0.f, 0.f, 0.f};
#pragma unroll
            for (int ks = 0; ks < 4; ++ks) acc = __builtin_amdgcn_mfma_f32_16x16x32_bf16(kf[ks], qf[h][ks], acc, 0, 0, 0);
#pragma unroll
            for (int i = 0; i < 4; ++i) { const float e = __builtin_amdgcn_exp2f(fmaf(acc[i], SM_C, negBC)) * rl[h]; imp4[i] += (n0 + i <= lim) ? e : 0.f; }
        }
        op[st * 4] = imp4[0] + 2.0f * (imp4[1] + imp4[2] + imp4[3]);
        of[st * 4] = imp4[0];
#pragma unroll
        for (int ks = 0; ks < 4; ++ks) { kf[ks] = kn[ks]; kn[ks] = kn2[ks]; }
    }
}

__device__ __forceinline__ void topk_load(const float* IMPP, const float* IMPF, int t, int g, f32x4& pp, f32x4& ff) {
    const int lane = threadIdx.x & 63, cur = t >> 6, jb = lane * 4;
    pp = (f32x4){0.f, 0.f, 0.f, 0.f}; ff = pp;
    if (cur > 15 && jb <= cur) { const size_t base = ((size_t)t * 4 + g) * 256; pp = *(const f32x4*)(IMPP + base + jb); ff = *(const f32x4*)(IMPF + base + jb); }
}
__device__ __forceinline__ void topk_task(const f32x4 pp, const f32x4 ff, unsigned* BM, int t, int g) {
    const int lane = threadIdx.x & 63;
    const int cur = t >> 6;
    unsigned nib = 0u;
    if (cur <= 15) { const int jb = lane * 4;
#pragma unroll
        for (int c = 0; c < 4; ++c) if (jb + c <= cur) nib |= 1u << c; }
    else {
        const int jb = lane * 4;
        unsigned key[4];
        {
            float fnext = __shfl_down(ff[0], 1);
            if (lane == 63) fnext = 0.f;
            const float v0 = pp[0] + ff[1], v1 = pp[1] + ff[2], v2 = pp[2] + ff[3], v3 = pp[3] + fnext;
            key[0] = (jb + 0 >= 1 && jb + 0 <= cur - 2) ? __float_as_uint(fmaxf(v0, 0.f)) + 1u : 0u;
            key[1] = (jb + 1 >= 1 && jb + 1 <= cur - 2) ? __float_as_uint(fmaxf(v1, 0.f)) + 1u : 0u;
            key[2] = (jb + 2 >= 1 && jb + 2 <= cur - 2) ? __float_as_uint(fmaxf(v2, 0.f)) + 1u : 0u;
            key[3] = (jb + 3 >= 1 && jb + 3 <= cur - 2) ? __float_as_uint(fmaxf(v3, 0.f)) + 1u : 0u;
        }
        unsigned prefix = 0u; bool exact = false;
        for (int b = 30; b >= 0; --b) {
            const unsigned trial = prefix | (1u << b);
            const int cnt = __popcll(__ballot(key[0] >= trial)) + __popcll(__ballot(key[1] >= trial)) + __popcll(__ballot(key[2] >= trial)) + __popcll(__ballot(key[3] >= trial));
            if (cnt >= 13) { prefix = trial; if (cnt == 13) { exact = true; break; } }
        }
#pragma unroll
        for (int c = 0; c < 4; ++c) if (exact ? (key[c] >= prefix) : (key[c] > prefix)) nib |= 1u << c;
        if (!exact) {
            int need = 13 - (__popcll(__ballot(key[0] > prefix)) + __popcll(__ballot(key[1] > prefix)) + __popcll(__ballot(key[2] > prefix)) + __popcll(__ballot(key[3] > prefix)));
            unsigned tie = 0u;
#pragma unroll
            for (int c = 0; c < 4; ++c) if (key[c] == prefix) tie |= 1u << c;
            for (int guard = 0; need > 0 && guard < 16; ++guard) {
                const unsigned long long any = __ballot(tie != 0u);
                if (any == 0ull) break;
                const int L = __builtin_ctzll(any);
                if (lane == L) { const unsigned low = tie & (0u - tie); nib |= low; tie ^= low; }
                --need;
            }
        }
        if (lane == 0) nib |= 1u;
        if (lane == (cur >> 2)) nib |= 1u << (cur & 3);
        if (lane == ((cur - 1) >> 2)) nib |= 1u << ((cur - 1) & 3);
    }
    unsigned x = nib << (4 * (lane & 7));
    x |= __shfl_xor(x, 1); x |= __shfl_xor(x, 2); x |= __shfl_xor(x, 4);
    if ((lane & 7) == 0) BM[((size_t)t * 4 + g) * 8 + (lane >> 3)] = x;
}
#undef KSWZ
}

template <bool FFN_REMAP = false>
__device__ __forceinline__ void convT(const float* __restrict__ src0, int K, int N, bf16_t* __restrict__ dst, int ldd, LAS float* tile, int bid, int nb, int Nfull = 0, int n0 = 0, const float* __restrict__ kscale = nullptr) {
    const float* __restrict__ src = src0 + n0; if (Nfull == 0) Nfull = N;
    const int tid = threadIdx.x, tk = K >> 6, tn = (N + 63) >> 6, total = tk * tn;
    const int r = tid >> 4, c4 = (tid & 15) * 4;
    f32x4 v[2] = {{0.f, 0.f, 0.f, 0.f}, {0.f, 0.f, 0.f, 0.f}}, vn[2];
    if (bid < total) { const int nti = bid % tn, kti = bid / tn, ng = nti * 64 + c4;
#pragma unroll
        for (int h = 0; h < 2; ++h) if (ng < N) v[h] = *(const f32x4*)(src + (size_t)(kti * 64 + r + h * 32) * Nfull + ng); }
    for (int idx = bid; idx < total; idx += nb) {
        const int nti = idx % tn, kti = idx / tn;
#pragma unroll
        for (int h = 0; h < 2; ++h) { LAS float* tp = tile + (r + h * 32) * 65 + c4; tp[0] = v[h][0]; tp[1] = v[h][1]; tp[2] = v[h][2]; tp[3] = v[h][3]; }
        {
            const int nx = idx + nb; vn[0] = (f32x4){0.f, 0.f, 0.f, 0.f}; vn[1] = vn[0];
            if (nx < total) { const int nti2 = nx % tn, kti2 = nx / tn, ng2 = nti2 * 64 + c4;
#pragma unroll
                for (int h = 0; h < 2; ++h) if (ng2 < N) vn[h] = *(const f32x4*)(src + (size_t)(kti2 * 64 + r + h * 32) * Nfull + ng2); } }
        __syncthreads();
        const int n = tid >> 3, k8 = (tid & 7) * 8, ngl = nti * 64 + n;
        float e[8];
#pragma unroll
        for (int i = 0; i < 8; ++i) e[i] = tile[(k8 + i) * 65 + n];
        if (kscale) { const f32x4 s0 = *(const f32x4*)(kscale + kti * 64 + k8), s1 = *(const f32x4*)(kscale + kti * 64 + k8 + 4);
            e[0] *= s0[0]; e[1] *= s0[1]; e[2] *= s0[2]; e[3] *= s0[3]; e[4] *= s1[0]; e[5] *= s1[1]; e[6] *= s1[2]; e[7] *= s1[3]; }
        if (ngl < N) { u32x4 w; w.x = cvt_pk_bf16(e[0], e[1]); w.y = cvt_pk_bf16(e[2], e[3]); w.z = cvt_pk_bf16(e[4], e[5]); w.w = cvt_pk_bf16(e[6], e[7]);
            int drow = ngl; if (FFN_REMAP) { const int up = ngl >= DFF ? 1 : 0, f = ngl - up * DFF; drow = (f >> 7) * 256 + up * 128 + (f & 127); }
            *(u32x4*)(dst + (size_t)drow * ldd + kti * 64 + k8) = w; }
        __syncthreads();
        v[0] = vn[0]; v[1] = vn[1];
    }
}
__device__ __forceinline__ void convT8(const float* __restrict__ src0, int K, int N, unsigned char* __restrict__ dst, int ldd, float scale, LAS float* tile, int bid, int nb, int Nfull = 0, int n0 = 0) {
    const float* __restrict__ src = src0 + n0; if (Nfull == 0) Nfull = N;
    const int tid = threadIdx.x, tk = K >> 6, tn = (N + 63) >> 6, total = tk * tn;
    const int r = tid >> 4, c4 = (tid & 15) * 4;
    f32x4 v[2] = {{0.f, 0.f, 0.f, 0.f}, {0.f, 0.f, 0.f, 0.f}}, vn[2];
    if (bid < total) { const int nti = bid % tn, kti = bid / tn, ng = nti * 64 + c4;
#pragma unroll
        for (int h = 0; h < 2; ++h) if (ng < N) v[h] = *(const f32x4*)(src + (size_t)(kti * 64 + r + h * 32) * Nfull + ng); }
    for (int idx = bid; idx < total; idx += nb) {
        const int nti = idx % tn, kti = idx / tn;
#pragma unroll
        for (int h = 0; h < 2; ++h) { LAS float* tp = tile + (r + h * 32) * 65 + c4; tp[0] = v[h][0]; tp[1] = v[h][1]; tp[2] = v[h][2]; tp[3] = v[h][3]; }
        { const int nx = idx + nb; vn[0] = (f32x4){0.f, 0.f, 0.f, 0.f}; vn[1] = vn[0];
            if (nx < total) { const int nti2 = nx % tn, kti2 = nx / tn, ng2 = nti2 * 64 + c4;
#pragma unroll
                for (int h = 0; h < 2; ++h) if (ng2 < N) vn[h] = *(const f32x4*)(src + (size_t)(kti2 * 64 + r + h * 32) * Nfull + ng2); } }
        __syncthreads();
        const int n = tid >> 3, k8 = (tid & 7) * 8, ngl = nti * 64 + n;
        float e[8];
#pragma unroll
        for (int i = 0; i < 8; ++i) e[i] = tile[(k8 + i) * 65 + n] * scale;
        if (ngl < N) { int p0 = __builtin_amdgcn_cvt_pk_fp8_f32(e[0], e[1], 0, false); p0 = __builtin_amdgcn_cvt_pk_fp8_f32(e[2], e[3], p0, true);
            int p1 = __builtin_amdgcn_cvt_pk_fp8_f32(e[4], e[5], 0, false); p1 = __builtin_amdgcn_cvt_pk_fp8_f32(e[6], e[7], p1, true);
            *(u32x2*)(dst + (size_t)ngl * ldd + kti * 64 + k8) = (u32x2){(unsigned)p0, (unsigned)p1}; }
        __syncthreads();
        v[0] = vn[0]; v[1] = vn[1];
    }
}
__device__ __forceinline__ void rmsnorm_rows(const float* __restrict__ src, const float* __restrict__ w, bf16_t* __restrict__ dst, int rows, int gw, int nw, unsigned char* __restrict__ dst8 = nullptr) {
    const int lane = threadIdx.x & 63;
    f32x4 v[16], vn[16];
    if (gw < rows) { const f32x4* sp = (const f32x4*)(src + (size_t)gw * DM);
#pragma unroll
        for (int i = 0; i < 16; ++i) v[i] = sp[lane + 64 * i]; }
    for (int row = gw; row < rows; row += nw) {
        const int nr = row + nw < rows ? row + nw : row;
        { const f32x4* sp = (const f32x4*)(src + (size_t)nr * DM);
#pragma unroll
          for (int i = 0; i < 16; ++i) vn[i] = sp[lane + 64 * i]; }
        float ss = 0.f;
#pragma unroll
        for (int i = 0; i < 16; ++i) ss += v[i][0] * v[i][0] + v[i][1] * v[i][1] + v[i][2] * v[i][2] + v[i][3] * v[i][3];
        ss = wave_sum(ss);
        const float rstd = rsqrtf(ss * (1.0f / DM) + EPS);
#pragma unroll
        for (int i = 0; i < 16; ++i) { const f32x4 ww = ((const f32x4*)w)[lane + 64 * i];
            u32x2 o; o.x = cvt_pk_bf16(v[i][0] * rstd * ww[0], v[i][1] * rstd * ww[1]); o.y = cvt_pk_bf16(v[i][2] * rstd * ww[2], v[i][3] * rstd * ww[3]);
            *(u32x2*)(dst + (size_t)row * DM + (lane + 64 * i) * 4) = o;
            if (dst8) { int pk = __builtin_amdgcn_cvt_pk_fp8_f32(v[i][0] * rstd * ww[0], v[i][1] * rstd * ww[1], 0, false); pk = __builtin_amdgcn_cvt_pk_fp8_f32(v[i][2] * rstd * ww[2], v[i][3] * rstd * ww[3], pk, true);
                *(int*)(dst8 + (size_t)row * DM + (lane + 64 * i) * 4) = pk; } }
#pragma unroll
        for (int i = 0; i < 16; ++i) v[i] = vn[i];
    }
}

struct Ptrs {
    bf16_t *Win, *Wo, *Wfi, *Wfo, *Wg, *Wple, *Wpool, *Wc1k, *Wc1v, *XN, *PB, *Z, *M, *KC, *VC, *MIX, *ACT, *ERAW;
    float *COS, *SIN, *TAB, *G, *H1, *L, *OACC, *IMPP, *IMPF, *ERSTD; unsigned* BM;
};

__device__ __forceinline__ void phase_prologue(const Params& P, const Ptrs& W, LAS unsigned char* lds) {
    const int bid = blockIdx.x, nb = gridDim.x, tid = threadIdx.x, lane = tid & 63, wv = tid >> 6;
    const int gw = bid * NWAVES + wv, nw = nb * NWAVES; const size_t gt = (size_t)bid * NTHREADS + tid, ntot = (size_t)nb * NTHREADS;
    LAS float* tile = (LAS float*)lds;
    rmsnorm_rows(P.x, P.norm1_w, W.XN, S_, gw, nw, P.ws + WS_XN8);
    convT(P.w_in, DM, POOLW, W.Win, DM, tile, bid, nb, INW, 0);
    convT(P.w_in, DM, INW - OFF_G, W.Win + (size_t)OFF_G * DM, DM, tile, bid, nb, INW, OFF_G);
    convT8(P.w_in, DM, OFF_G - POOLW, P.ws + WS_WIN8, DM, WG8_SCALE, tile, bid, nb, INW, POOLW);
    for (size_t i = gt; i < (size_t)(LDZ - INW) * DM / 8; i += ntot) *(u32x4*)(W.Win + (size_t)INW * DM + i * 8) = (u32x4){0u, 0u, 0u, 0u};
    convT(P.w_o, DM, DM, W.Wo, DM, tile, bid, nb);
    convT<true>(P.w_ffn_in, DM, NFI, W.Wfi, DM, tile, bid, nb, 0, 0, P.norm2_w);
    for (size_t i = gt; i < (size_t)2 * DM / 8; i += ntot) *(u32x4*)(W.XN - 2 * DM + i * 8) = (u32x4){0u, 0u, 0u, 0u};
    convT(P.w_ffn_out, DFF, DM, W.Wfo, DFF, tile, bid, nb);
    convT8(P.w_ple_gate, DM, DM, (unsigned char*)W.Wg, DM, WG8_SCALE, tile, bid, nb);
    convT(P.w_ple_proj, PLE, DM, W.Wple, PLE, tile, bid, nb);
    for (int g = 0; g < 4; ++g) convT(P.w_pool + (size_t)g * 65536, 256, 256, W.Wpool + (size_t)g * 65536, 256, tile, bid, nb);
    convT(P.cmp_k_w1, 4096, 256, W.Wc1k, 4096, tile, bid, nb);
    convT(P.cmp_v_w1, 4096, 256, W.Wc1v, 4096, tile, bid, nb);
    { constexpr size_t NP8 = (size_t)S_ * PLE / 8;
      for (size_t ib = gt; ib < NP8; ib += 4 * ntot) { f32x4 av[4], bv[4];
#pragma unroll
          for (int k = 0; k < 4; ++k) { size_t i = ib + k * ntot; if (i >= NP8) i = NP8 - 1; av[k] = *(const f32x4*)(P.p + i * 8); bv[k] = *(const f32x4*)(P.p + i * 8 + 4); }
#pragma unroll
          for (int k = 0; k < 4; ++k) { const size_t i = ib + k * ntot; if (i < NP8) { u32x4 w; w.x = cvt_pk_bf16(av[k][0], av[k][1]); w.y = cvt_pk_bf16(av[k][2], av[k][3]); w.z = cvt_pk_bf16(bv[k][0], bv[k][1]); w.w = cvt_pk_bf16(bv[k][2], bv[k][3]); *(u32x4*)(W.PB + i * 8) = w; } } } }
    for (size_t i = gt; i < (size_t)S_ * 16; i += ntot) { const int t = (int)(i >> 4), fi = (int)(i & 15);
        const float inv = exp2f(-(float)fi * (18.931568569324174f / 16.0f)); const float ang = (float)P.positions[t] * inv;
        const double ad = (double)ang; const double kk = rint(ad * 0.15915494309189535); const float rf = (float)(ad - kk * 6.283185307179586);
        W.COS[i] = __cosf(rf); W.SIN[i] = __sinf(rf); }
    for (int task = gw; task < 128; task += nw) { const int which = task >> 6, r0 = (task & 63) * 64; const float* pe = which ? P.cmp_pos_v : P.cmp_pos_k; const float* w1 = which ? P.cmp_v_w1 : P.cmp_k_w1;
        f32x4 s = {0.f, 0.f, 0.f, 0.f};
#pragma unroll 8
        for (int r = 0; r < 64; ++r) { const f32x4 wv = *(const f32x4*)(w1 + (size_t)(r0 + r) * 256 + lane * 4); s += wv * pe[r0 + r]; }
        float* cbp = (float*)(P.ws + WS_CBIAS) + which * 256 + lane * 4;
        unsafeAtomicAdd(cbp + 0, s[0]); unsafeAtomicAdd(cbp + 1, s[1]); unsafeAtomicAdd(cbp + 2, s[2]); unsafeAtomicAdd(cbp + 3, s[3]); }
    if (gw == 0) { float mq = fmaxf(fabsf(P.q_norm_w[lane]), fabsf(P.q_norm_w[lane + 64])); mq = wave_max(mq);
        float mc = wave_max(fmaxf(fabsf(P.k_norm_cmp_w[lane]), fabsf(P.k_norm_cmp_w[lane + 64])));
        float ms = wave_max(fmaxf(fabsf(P.k_norm_slc_w[lane]), fabsf(P.k_norm_slc_w[lane + 64])));
        float mw = wave_max(fmaxf(fabsf(P.k_norm_win_w[lane]), fabsf(P.k_norm_win_w[lane + 64])));
        const float c = 11.313708498984761f * 1.4426950408889634f * mq * 1.01f;
        if (lane == 0) { W.TAB[512] = c * mc; W.TAB[513] = c * ms; W.TAB[514] = c * mw; } }
}

__device__ __forceinline__ void phase_postz(const Params& P, const Ptrs& W, int gw, int nw) {
    const int tid = threadIdx.x, lane = tid & 63;
    const f32x2 wq = *(const f32x2*)(P.q_norm_w + 2 * lane), wks = *(const f32x2*)(P.k_norm_slc_w + 2 * lane), wkw = *(const f32x2*)(P.k_norm_win_w + 2 * lane);
    for (int t = gw; t < S_; t += nw) {
        bf16_t* zr = W.Z + (size_t)t * LDZ;
        float cs0 = 0.f, cs1 = 0.f, sn0 = 0.f, sn1 = 0.f;
        if (lane < 16) { const int i0 = (2 * lane) & 15; cs0 = W.COS[t * 16 + i0]; cs1 = W.COS[t * 16 + i0 + 1]; sn0 = W.SIN[t * 16 + i0]; sn1 = W.SIN[t * 16 + i0 + 1]; }
        unsigned uv[32];
#pragma unroll
        for (int v = 0; v < 32; ++v) { const int col = v < 24 ? OFF_Q + v * HD : (v < 28 ? OFF_KV + 2 * 512 + (v - 24) * HD : OFF_KV + 4 * 512 + (v - 28) * HD);
            uv[v] = *((const unsigned*)(zr + col) + lane); }
#pragma unroll
        for (int v = 0; v < 32; ++v) {
            const f32x2 ww = v < 24 ? wq : (v < 28 ? wks : wkw);
            const unsigned u = uv[v]; const float x0 = bf_lo(u), x1 = bf_hi(u);
            const float ss = wave_sum(x0 * x0 + x1 * x1);
            const float rstd = rsqrtf(ss * (1.0f / HD) + EPS);
            float y0 = x0 * rstd * ww[0], y1 = x1 * rstd * ww[1];
            const float p0 = __shfl_xor(y0, 8), p1 = __shfl_xor(y1, 8);
            if (lane < 8) { y0 = y0 * cs0 - p0 * sn0; y1 = y1 * cs1 - p1 * sn1; }
            else if (lane < 16) { y0 = y0 * cs0 + p0 * sn0; y1 = y1 * cs1 + p1 * sn1; }
            uv[v] = cvt_pk_bf16(y0, y1);
        }
        {
            const int gi = lane >> 4, wlen = 2 << gi, c0 = lane * 16; const int cnt = (t + 1) < wlen ? (t + 1) : wlen;
            float s[16];
#pragma unroll
            for (int i = 0; i < 16; ++i) s[i] = 0.f;
            float cur[16];
#pragma unroll
            for (int bt = 0; bt < 2; ++bt) {
                u32x4 ra[8], rb[8];
#pragma unroll
                for (int i = 0; i < 8; ++i) { const int ii = bt * 8 + i; const size_t row = (size_t)(ii < cnt ? t - ii : t);
                    ra[i] = *(const u32x4*)(W.Z + row * LDZ + c0); rb[i] = *(const u32x4*)(W.Z + row * LDZ + c0 + 8); }
#pragma unroll
                for (int i = 0; i < 8; ++i) { const int ii = bt * 8 + i; const float mk = ii < cnt ? 1.0f : 0.0f; const u32x4 a = ra[i], b = rb[i];
                    const float ev[16] = {bf_lo(a.x), bf_hi(a.x), bf_lo(a.y), bf_hi(a.y), bf_lo(a.z), bf_hi(a.z), bf_lo(a.w), bf_hi(a.w), bf_lo(b.x), bf_hi(b.x), bf_lo(b.y), bf_hi(b.y), bf_lo(b.z), bf_hi(b.z), bf_lo(b.w), bf_hi(b.w)};
#pragma unroll
                    for (int q = 0; q < 16; ++q) { s[q] += ev[q] * mk; if (ii == 0) cur[q] = ev[q]; } }
                if (bt == 0 && __all(cnt <= 8)) break;
            }
            const float rc = 1.0f / (float)cnt;
            u32x4 o0, o1;
            o0.x = cvt_pk_bf16(s[0] * rc - cur[0], s[1] * rc - cur[1]); o0.y = cvt_pk_bf16(s[2] * rc - cur[2], s[3] * rc - cur[3]);
            o0.z = cvt_pk_bf16(s[4] * rc - cur[4], s[5] * rc - cur[5]); o0.w = cvt_pk_bf16(s[6] * rc - cur[6], s[7] * rc - cur[7]);
            o1.x = cvt_pk_bf16(s[8] * rc - cur[8], s[9] * rc - cur[9]); o1.y = cvt_pk_bf16(s[10] * rc - cur[10], s[11] * rc - cur[11]);
            o1.z = cvt_pk_bf16(s[12] * rc - cur[12], s[13] * rc - cur[13]); o1.w = cvt_pk_bf16(s[14] * rc - cur[14], s[15] * rc - cur[15]);
            *(u32x4*)(W.M + (size_t)t * POOLW + c0) = o0; *(u32x4*)(W.M + (size_t)t * POOLW + c0 + 8) = o1;
        }
#pragma unroll
        for (int v = 0; v < 32; ++v) { const int col = v < 24 ? OFF_Q + v * HD : (v < 28 ? OFF_KV + 2 * 512 + (v - 24) * HD : OFF_KV + 4 * 512 + (v - 28) * HD);
            *((unsigned*)(zr + col) + lane) = uv[v]; }

    }
}

__device__ __forceinline__ void phase_cmpfin(const Params& P, const Ptrs& W) {
    const int tid = threadIdx.x, lane = tid & 63, gw = blockIdx.x * NWAVES + (tid >> 6), nw = gridDim.x * NWAVES;
    const f32x2 wk = *(const f32x2*)(P.k_norm_cmp_w + 2 * lane);
    for (int task = gw; task < 8192; task += nw) {
        const int tk = __builtin_amdgcn_readfirstlane(task);
        const int which = tk >> 12, g = (tk >> 10) & 3, n = tk & 1023;
        bf16_t* dst = (which ? W.VC : W.KC) + ((size_t)g * 1024 + n) * HD;
        if (n == 1023) { ((unsigned*)dst)[lane] = 0u; continue; }
        const float* h = W.H1 + (size_t)tk * 256; const float* w2 = which ? P.cmp_v_w2 : P.cmp_k_w2;
        float a0 = 0.f, a1 = 0.f;
        for (int j = 0; j < 256; ++j) { const float hj = h[j]; const f32x2 wv = *(const f32x2*)(w2 + j * HD + 2 * lane); a0 += hj * wv[0]; a1 += hj * wv[1]; }
        if (which == 0) {
            const float ss = wave_sum(a0 * a0 + a1 * a1); const float rstd = rsqrtf(ss * (1.0f / HD) + EPS);
            a0 = a0 * rstd * wk[0]; a1 = a1 * rstd * wk[1];
            const int tp = 16 * n + 31; const float p0 = __shfl_xor(a0, 8), p1 = __shfl_xor(a1, 8);
            if (lane < 16) { const int i0 = (2 * lane) & 15; const float cs0 = W.COS[tp * 16 + i0], cs1 = W.COS[tp * 16 + i0 + 1], sn0 = W.SIN[tp * 16 + i0], sn1 = W.SIN[tp * 16 + i0 + 1];
                if (lane < 8) { a0 = a0 * cs0 - p0 * sn0; a1 = a1 * cs1 - p1 * sn1; } else { a0 = a0 * cs0 + p0 * sn0; a1 = a1 * cs1 + p1 * sn1; } }
        }
        ((unsigned*)dst)[lane] = cvt_pk_bf16(a0, a1);
    }
}

__device__ __forceinline__ void phase_erstd(const Ptrs& W) {
    const int tid = threadIdx.x, lane = tid & 63, gw = blockIdx.x * NWAVES + (tid >> 6), nw = gridDim.x * NWAVES;
    u32x4 a[8], an[8];
    if (gw < S_) { const u32x4* sp = (const u32x4*)(W.ERAW + (size_t)gw * DM);
#pragma unroll
        for (int i = 0; i < 8; ++i) a[i] = sp[lane + 64 * i]; }
    for (int row = gw; row < S_; row += nw) {
        const int nr = row + nw < S_ ? row + nw : row;
        { const u32x4* sp = (const u32x4*)(W.ERAW + (size_t)nr * DM);
#pragma unroll
          for (int i = 0; i < 8; ++i) an[i] = sp[lane + 64 * i]; }
        float ss = 0.f;
#pragma unroll
        for (int i = 0; i < 8; ++i) {
            const float e0 = bf_lo(a[i].x), e1 = bf_hi(a[i].x), e2 = bf_lo(a[i].y), e3 = bf_hi(a[i].y), e4 = bf_lo(a[i].z), e5 = bf_hi(a[i].z), e6 = bf_lo(a[i].w), e7 = bf_hi(a[i].w);
            ss += e0 * e0 + e1 * e1 + e2 * e2 + e3 * e3 + e4 * e4 + e5 * e5 + e6 * e6 + e7 * e7; }
        ss = wave_sum(ss);
        if (lane == 0) W.ERSTD[row] = rsqrtf(ss * (1.0f / DM) + EPS);
#pragma unroll
        for (int i = 0; i < 8; ++i) a[i] = an[i];
    }
}

constexpr int N_PHASES = 11;
__device__ __forceinline__ Params kargs() {
#if defined(__HIP_DEVICE_COMPILE__)
    unsigned long long p = (unsigned long long)__builtin_amdgcn_kernarg_segment_ptr();
    asm volatile("" : "+s"(p));
    return *(const __attribute__((address_space(4))) Params*)p;
#else
    return Params{};
#endif
}
__device__ __forceinline__ Ptrs mkptrs(unsigned char* ws) {
    Ptrs W;
    W.Win = (bf16_t*)(ws + WS_WIN); W.Wo = (bf16_t*)(ws + WS_WO); W.Wfi = (bf16_t*)(ws + WS_WFI); W.Wfo = (bf16_t*)(ws + WS_WFO); W.Wg = (bf16_t*)(ws + WS_WG);
    W.Wple = (bf16_t*)(ws + WS_WPLE); W.Wpool = (bf16_t*)(ws + WS_WPOOL); W.Wc1k = (bf16_t*)(ws + WS_WC1K); W.Wc1v = (bf16_t*)(ws + WS_WC1V);
    W.XN = (bf16_t*)(ws + WS_XN); W.PB = (bf16_t*)(ws + WS_PB); W.Z = (bf16_t*)(ws + WS_Z); W.M = (bf16_t*)(ws + WS_M); W.KC = (bf16_t*)(ws + WS_KC); W.VC = (bf16_t*)(ws + WS_VC);
    W.MIX = (bf16_t*)(ws + WS_MIX); W.ACT = (bf16_t*)(ws + WS_ACT); W.ERAW = (bf16_t*)(ws + WS_ERAW);
    W.COS = (float*)(ws + WS_COS); W.SIN = (float*)(ws + WS_SIN); W.TAB = (float*)(ws + WS_TAB); W.G = (float*)(ws + WS_G); W.H1 = (float*)(ws + WS_H1); W.L = (float*)(ws + WS_L);
    W.OACC = (float*)(ws + WS_OACC); W.IMPP = (float*)(ws + WS_IMPP); W.IMPF = (float*)(ws + WS_IMPF); W.ERSTD = (float*)(ws + WS_ERSTD); W.BM = (unsigned*)(ws + WS_BM);
    return W;
}
__global__ void __launch_bounds__(NTHREADS, 2) fwd(Params Punused) {
    extern __shared__ __attribute__((aligned(16))) unsigned char lds_raw[];
    LAS unsigned char* lds = (LAS unsigned char*)lds_raw;
    const int tid = threadIdx.x;
    const int G = gridDim.x, bid = blockIdx.x;
    const int gw = bid * NWAVES + (tid >> 6), nw = G * NWAVES;

    if (tid < 16) ((LAS unsigned*)(lds + LDS_MISC))[tid] = 0u;
    __syncthreads();
    int lo, hi; XcdBarrier bar;
    { const Params P = kargs(); lo = P.ph_lo; hi = P.ph_hi;
      bar.bar = (unsigned*)(P.ws + WS_CTL); bar.x = 0; bar.st = (volatile LAS unsigned*)(lds + LDS_MISC);
      if (hi - lo > 1) bar = xcd_barrier_post((unsigned*)(P.ws + WS_CTL), (volatile LAS unsigned*)(lds + LDS_MISC)); }
#ifdef PH_MASK
#define IN(k) (((PH_MASK >> (k)) & 1) && lo <= (k) && (k) < hi)
#else
#define IN(k) (lo <= (k) && (k) < hi)
#endif
#define SEAM(k) do { if (IN(k) && IN((k) + 1)) xcd_barrier(bar); } while (0)
#define PHASE_VARS const Params P = kargs(); const Ptrs W = mkptrs(P.ws); (void)W;
#define ATT_ARGS att::AttnArgs AA{W.Z, W.KC, W.VC, W.G, W.L, W.OACC, W.MIX, W.BM, W.TAB};

    if (IN(0)) { PHASE_VARS REP(0) { phase_prologue(P, W, lds); } SEAM(0); }
    if (IN(1)) {
        PHASE_VARS
        { pg8::GStd g{(const char*)W.XN, (const char*)W.Win, DM, DM, DM / 64}; pg8::StaticOrder S; S.init(S_ / 256, POOLW / 256, G, bid);
          pg8::EpiBf16 E{W.Z, LDZ}; pg8::gemm_phase(lds, g, S, E); }
        { pg8::GStd g{(const char*)(P.ws + WS_XN8), (const char*)(P.ws + WS_WIN8), DM / 2, DM / 2, DM / 128}; pg8::StaticOrder S; S.init(S_ / 256, (OFF_G - POOLW) / 256, G, bid);
          pg8::EpiBf16S E{W.Z + POOLW, LDZ, 1.0f / WG8_SCALE}; pg8::gemm_phase<pg8::GStd, pg8::EpiBf16S, true>(lds, g, S, E); }
        SEAM(1);
    }
    if (IN(2)) {
        PHASE_VARS
        if (G > 64) {
            if (bid < 32) { pg8::GCmp g{(const char*)W.Z, (const char*)W.Wc1k, (const char*)W.Wc1v, 16 * LDZ, 4096, 64}; pg8::StaticOrder S; S.init(32, 1, 32, bid);
                pg8::EpiCmpGelu E{W.H1, (const float*)(P.ws + WS_CBIAS)}; pg8::gemm_phase(lds, g, S, E); }
            else if (bid < 96) {
                pg8::GStd g{(const char*)W.XN, (const char*)(W.Win + (size_t)OFF_G * DM), DM, DM, DM / 64}; pg8::StaticOrder S; S.init(S_ / 256, 1, 64, bid - 32);
                pg8::EpiBf16 E{W.Z + OFF_G, LDZ}; pg8::gemm_phase(lds, g, S, E); }
            else phase_postz(P, W, (bid - 96) * NWAVES + (tid >> 6), (G - 96) * NWAVES);
        } else {
            { pg8::GStd g{(const char*)W.XN, (const char*)(W.Win + (size_t)OFF_G * DM), DM, DM, DM / 64}; pg8::StaticOrder S; S.init(S_ / 256, 1, G, bid);
              pg8::EpiBf16 E{W.Z + OFF_G, LDZ}; pg8::gemm_phase(lds, g, S, E); }
            { pg8::GCmp g{(const char*)W.Z, (const char*)W.Wc1k, (const char*)W.Wc1v, 16 * LDZ, 4096, 64}; pg8::StaticOrder S; S.init(32, 1, G, bid);
              pg8::EpiCmpGelu E{W.H1, (const float*)(P.ws + WS_CBIAS)}; pg8::gemm_phase(lds, g, S, E); }
            phase_postz(P, W, gw, nw);
        }
        SEAM(2);
    }
    if (IN(3)) {
        PHASE_VARS
        {
            const size_t i0 = (size_t)bid * NTHREADS + tid, st = (size_t)G * NTHREADS, NG = (size_t)S_ * NGATE;
            for (size_t ib = i0; ib < NG; ib += 9 * st) { float zv[9];
#pragma unroll
                for (int k = 0; k < 9; ++k) { size_t i = ib + k * st; if (i >= NG) i = NG - 1; const int t = (int)(i / NGATE), c = (int)(i % NGATE); zv[k] = bf2f(W.Z[(size_t)t * LDZ + OFF_G + c]); }
#pragma unroll
                for (int k = 0; k < 9; ++k) { const size_t i = ib + k * st; if (i < NG) W.G[i] = sigmoidf_(zv[k]); } } }
        phase_cmpfin(P, W);
        { pg8::GPool g{(const char*)W.M, (const char*)W.Wpool, POOLW, 256, 4}; pg8::StaticOrder S; S.init(S_ / 256, 4, G, bid);
          pg8::EpiBf16Scale E{W.MIX, DM, P.pool_scale}; pg8::gemm_phase(lds, g, S, E); }
        SEAM(3);
    }
    if (IN(4)) {
        PHASE_VARS ATT_ARGS
        if ((tid >> 6) < 4) __builtin_amdgcn_s_setprio(2);
        REP(4)
        for (int base = 0, rnd = 0; base < 1536; base += G, ++rnd) {
            int qt, g, hp;
            if (G == 256) { const int x = bid & 7, r = bid >> 3, qp = (rnd / 3) ? 63 - r : r; if (rnd >= 6) break; g = x & 3; qt = 2 * qp + (x >> 2); hp = rnd % 3; }
            else { const int Lu = base + ((rnd & 1) ? G - 1 - bid : bid); if (Lu >= 1536) continue; qt = Lu / 12; const int rem = Lu % 12; g = rem / 3; hp = rem % 3; }
            att::attn_unit<att::MODE_CMP>(AA, (LAS char*)lds, qt, g, hp);
            asm volatile("s_waitcnt vmcnt(0)" ::: "memory");
            att::attn_unit<att::MODE_WIN>(AA, (LAS char*)lds, qt, g, hp);
            if (G == 256 && hp == 2) {
                asm volatile("s_waitcnt vmcnt(0)" ::: "memory");
                const int tqi = qt * 8 + (tid >> 6);
                att::imp_task(AA, W.IMPP, W.IMPF, tqi, g);
                asm volatile("s_waitcnt vmcnt(0)" ::: "memory");
                f32x4 pp, ff, pn, fn; att::topk_load(W.IMPP, W.IMPF, tqi * 16, g, pp, ff);
                for (int q = 0; q < 16; ++q) { att::topk_load(W.IMPP, W.IMPF, tqi * 16 + (q < 15 ? q + 1 : q), g, pn, fn); att::topk_task(pp, ff, W.BM, tqi * 16 + q, g); pp = pn; ff = fn; } } }
        __builtin_amdgcn_s_setprio(0);
        if (G != 256) SEAM(4);
    }
    if (IN(5)) {
        PHASE_VARS ATT_ARGS
        if (G != 256)
        for (int k = gw, r = 0; k < 4096; k += nw, ++r) { const int hiT = (r + 1) * nw < 4096 ? (r + 1) * nw : 4096;
            const int task = (r & 1) ? hiT - 1 - (k - r * nw) : k;
            att::imp_task(AA, W.IMPP, W.IMPF, task >> 2, task & 3);
            asm volatile("s_waitcnt vmcnt(0)" ::: "memory");
            { const int tb = (task >> 2) * 16, gg = task & 3; f32x4 pp, ff, pn, fn;
              att::topk_load(W.IMPP, W.IMPF, tb, gg, pp, ff);
              for (int q = 0; q < 16; ++q) { att::topk_load(W.IMPP, W.IMPF, tb + (q < 15 ? q + 1 : q), gg, pn, fn); att::topk_task(pp, ff, W.BM, tb + q, gg); pp = pn; ff = fn; } } }
        SEAM(5);
    }
    if (IN(6)) {
        PHASE_VARS ATT_ARGS
#if SLC16
        for (int base = 0, rnd = 0; base < 1024 + G; base += G, ++rnd) {
            int ut, g;
            if (G == 256) { const int x = bid & 7, r = bid >> 3, k = rnd * 32 + ((rnd & 1) ? 31 - r : r); if (k >= 128) break; g = x & 3; ut = 255 - (2 * k + (x >> 2)); }
            else { const int Lu = base + ((rnd & 1) ? G - 1 - bid : bid); if (Lu >= 1024) continue; ut = 255 - Lu / 4; g = Lu % 4; }
            att::slc16_unit(AA, (LAS char*)lds, ut, g); }
#else
        REP(6)
        for (int base = 0, rnd = 0; base < 1640 + G; base += G, ++rnd) {
            int ut, g;
            if (G == 256) { const int x = bid & 7, r = bid >> 3, k = rnd * 32 + ((rnd & 1) ? 31 - r : r); if (k >= 205) break; g = x & 3; ut = 409 - (2 * k + (x >> 2)); }
            else { const int Lu = base + ((rnd & 1) ? G - 1 - bid : bid); if (Lu >= 1640) continue; ut = 409 - Lu / 4; g = Lu % 4; }
            att::attn_unit<att::MODE_SLC>(AA, (LAS char*)lds, ut, g, 0); }
#endif
        SEAM(6);
    }
    if (IN(7)) {
        PHASE_VARS
        if (bid == 0) { bf16_t* hz = (bf16_t*)(P.ws + WS_HRES) - 2 * DM; for (int i = tid; i < 2 * DM / 8; i += NTHREADS) *(u32x4*)(hz + i * 8) = (u32x4){0u, 0u, 0u, 0u}; }
        { pg8::GStd g{(const char*)W.MIX, (const char*)W.Wo, DM, DM, DM / 64}; pg8::StaticOrder S; S.init(S_ / 256, DM / 256, G, bid);
          pg8::EpiResNorm E{P.x, (bf16_t*)(P.ws + WS_HRES), W.XN, P.norm2_w, (float*)(P.ws + WS_SSQ1), DM}; pg8::gemm_phase(lds, g, S, E); }
        { pg8::GStd g{(const char*)W.PB, (const char*)W.Wple, PLE, PLE, PLE / 64}; pg8::StaticOrder S; S.init(S_ / 256, DM / 256, G, bid);
          pg8::EpiBf16Ssq E{W.ERAW, DM, (float*)(P.ws + WS_SSQ3)}; pg8::gemm_phase(lds, g, S, E); }
        SEAM(7);
    }
    if (IN(8)) {
        PHASE_VARS
        pg8::GFfn g{(const char*)(P.ws + WS_HRES), (const char*)W.Wfi, DM, DM, DM / 64}; pg8::StaticOrder S; S.init(65, DFF / 128, G, bid);
        pg8::EpiFfn E{W.ACT, P.conv_w, P.conv_b, (LAS float*)(lds + LDS_XCH), (const float*)(P.ws + WS_SSQ1)}; REP(8) { pg8::gemm_phase(lds, g, S, E); } SEAM(8);
    }
    if (IN(9)) {
        PHASE_VARS
        pg8::GStd g{(const char*)W.ACT, (const char*)W.Wfo, DFF, DFF, DFF / 64}; pg8::StaticOrder S; S.init(S_ / 256, DM / 256, G, bid);
        pg8::EpiResNormF8 E{P.ws + WS_HRES, (bf16_t*)(P.ws + WS_HRES), W.XN, P.ple_gate_norm_w, (float*)(P.ws + WS_SSQ2), DM}; pg8::gemm_phase(lds, g, S, E); SEAM(9);
    }
    if (IN(10)) {
        PHASE_VARS
        pg8::GStd g{(const char*)W.XN, (const char*)W.Wg, DM / 2, DM / 2, DM / 128}; pg8::StaticOrder S; S.init(S_ / 256, DM / 256, G, bid);
        pg8::EpiGate E{P.out, (const bf16_t*)(P.ws + WS_HRES), W.ERAW, (const float*)(P.ws + WS_SSQ3), P.ple_norm_w, (const float*)(P.ws + WS_SSQ2), DM, 1.0f / WG8_SCALE};
        pg8::gemm_phase<pg8::GStd, pg8::EpiGate, true>(lds, g, S, E);
    }
#undef IN
#undef SEAM
}

extern "C" void kernel_launch(void* const* d_in, const int* in_sizes, int n_in, void* d_out, int out_size, void* d_ws, size_t ws_size, hipStream_t stream) {
    static int grid = 0;
    if (grid == 0) {
        if (n_in != 27 || in_sizes[0] != S_ * DM || out_size != S_ * DM || ws_size < WS_NEED) {
            fprintf(stderr, "kernel_launch: unexpected shapes (n_in %d, in0 %d, out %d, ws %zu < %zu); nothing launched\n", n_in, n_in > 0 ? in_sizes[0] : -1, out_size, ws_size, (size_t)WS_NEED); grid = -1; return; }
        int dev = 0, cus = 0, per_cu = 0;
        if (hipGetDevice(&dev) != hipSuccess || hipDeviceGetAttribute(&cus, hipDeviceAttributeMultiprocessorCount, dev) != hipSuccess) { grid = -1; return; }
        if (hipFuncSetAttribute((const void*)fwd, hipFuncAttributeMaxDynamicSharedMemorySize, LDS_BYTES) != hipSuccess) { fprintf(stderr, "kernel_launch: hipFuncSetAttribute failed\n"); grid = -1; return; }
        if (hipOccupancyMaxActiveBlocksPerMultiprocessor(&per_cu, (const void*)fwd, NTHREADS, LDS_BYTES) != hipSuccess || per_cu < 1) { fprintf(stderr, "kernel_launch: occupancy query says %d\n", per_cu); (void)hipGetLastError(); }
        grid = cus > 256 ? 256 : cus;
    }
    if (grid < 0) return;
    (void)hipMemsetAsync((char*)d_ws + WS_CTL, 0, CTL_BYTES, stream);
    Params P{};
    const float** fp = (const float**)&P;
    P.x = (const float*)d_in[0]; P.p = (const float*)d_in[1]; P.positions = (const int*)d_in[2]; P.norm1_w = (const float*)d_in[3]; P.w_in = (const float*)d_in[4];
    P.w_pool = (const float*)d_in[5]; P.pool_scale = (const float*)d_in[6]; P.q_norm_w = (const float*)d_in[7]; P.k_norm_cmp_w = (const float*)d_in[8];
    P.k_norm_slc_w = (const float*)d_in[9]; P.k_norm_win_w = (const float*)d_in[10]; P.cmp_pos_k = (const float*)d_in[11]; P.cmp_pos_v = (const float*)d_in[12];
    P.cmp_k_w1 = (const float*)d_in[13]; P.cmp_k_w2 = (const float*)d_in[14]; P.cmp_v_w1 = (const float*)d_in[15]; P.cmp_v_w2 = (const float*)d_in[16];
    P.w_o = (const float*)d_in[17]; P.norm2_w = (const float*)d_in[18]; P.w_ffn_in = (const float*)d_in[19]; P.conv_w = (const float*)d_in[20]; P.conv_b = (const float*)d_in[21];
    P.w_ffn_out = (const float*)d_in[22]; P.w_ple_proj = (const float*)d_in[23]; P.ple_norm_w = (const float*)d_in[24]; P.ple_gate_norm_w = (const float*)d_in[25]; P.w_ple_gate = (const float*)d_in[26];
    (void)fp;
    P.out = (float*)d_out; P.ws = (unsigned char*)d_ws;
#if MK_ONE_LAUNCH
    P.ph_lo = 0; P.ph_hi = N_PHASES;
    hipLaunchKernelGGL(fwd, dim3(grid), dim3(NTHREADS), LDS_BYTES, stream, P);
#else
    for (int ph = 0; ph < N_PHASES; ++ph) { P.ph_lo = ph; P.ph_hi = ph + 1; hipLaunchKernelGGL(fwd, dim3(grid), dim3(NTHREADS), LDS_BYTES, stream, P); }
#endif
    const hipError_t le = hipPeekAtLastError();
    if (le != hipSuccess) fprintf(stderr, "kernel_launch: launch failed: %s\n", hipGetErrorName(le));
}
```

```cpp
#include <hip/hip_runtime.h>
#include <cstdio>
#include <cstdint>

#ifndef PROBE_DBL
#define PROBE_DBL 0
#endif
#define REP(k) _Pragma("unroll") for (int rep_ = 0; rep_ < 1 + ((PROBE_DBL >> (k)) & 1); ++rep_)
#ifndef SLC16
#define SLC16 1
#endif
#if !SLC16
#error "the 32-row selected-branch path writes a bf16 mix; the output projection expects the fp8 image of the 16-row path"
#endif
#ifndef MK_ONE_LAUNCH
#define MK_ONE_LAUNCH 1
#endif

#define LAS __attribute__((address_space(3)))
typedef unsigned short bf16_t;
typedef short bf16x8 __attribute__((ext_vector_type(8)));
typedef short s16x4 __attribute__((ext_vector_type(4)));
typedef float f32x2 __attribute__((ext_vector_type(2)));
typedef float f32x4 __attribute__((ext_vector_type(4)));
typedef float f32x16 __attribute__((ext_vector_type(16)));
typedef unsigned u32x2 __attribute__((ext_vector_type(2)));
typedef unsigned u32x4 __attribute__((ext_vector_type(4)));
typedef int i32x4 __attribute__((ext_vector_type(4)));
typedef int i32x8 __attribute__((ext_vector_type(8)));

constexpr int S_ = 16384, DM = 4096, INW = 7240, LDZ = 7424, POOLW = 1024, NH = 24, NKV = 4, HPG = 6, HD = 128;
constexpr int OFF_Q = 1024, OFF_KV = 4096, OFF_G = 7168, DFF = 11008, NFI = 22016, PLE = 256, NGATE = 72;
constexpr int ZROWS = S_ + 64, XNROWS = S_ + 256, CHUNK = 8192;
constexpr float EPS = 1e-6f;
constexpr float SM_C = 0.08838834764831845f * 1.4426950408889634f;
constexpr int NWAVES = 8, NTHREADS = 512;
constexpr float WG8_SCALE = 128.0f;

constexpr size_t al256(size_t x) { return (x + 255) / 256 * 256; }
constexpr size_t WS_CTL   = 0;
constexpr size_t CTL_BYTES = 262144;
constexpr size_t WS_CBIAS = WS_CTL + 32768;
constexpr size_t WS_SSQ1 = WS_CTL + 65536, WS_SSQ2 = WS_CTL + 131072, WS_SSQ3 = WS_CTL + 196608;
constexpr size_t WS_WIN   = WS_CTL + CTL_BYTES;
constexpr size_t WS_WO    = WS_WIN + al256((size_t)LDZ * DM * 2);
constexpr size_t WS_WFI   = WS_WO + al256((size_t)DM * DM * 2);
constexpr size_t WS_WFO   = WS_WFI + al256((size_t)NFI * DM * 2);
constexpr size_t WS_WG    = WS_WFO + al256((size_t)DM * DFF * 2);
constexpr size_t WS_WPLE  = WS_WG + al256((size_t)DM * DM * 2);
constexpr size_t WS_WPOOL = WS_WPLE + al256((size_t)DM * PLE * 2);
constexpr size_t WS_WC1K  = WS_WPOOL + al256((size_t)1024 * 256 * 2);
constexpr size_t WS_WC1V  = WS_WC1K + al256((size_t)256 * 4096 * 2);
constexpr size_t WS_COS   = WS_WC1V + al256((size_t)256 * 4096 * 2);
constexpr size_t WS_SIN   = WS_COS + al256((size_t)S_ * 16 * 4);
constexpr size_t WS_TAB   = WS_SIN + al256((size_t)S_ * 16 * 4);
constexpr size_t WS_XNP   = WS_TAB + 4096;
constexpr size_t WS_XN    = WS_XNP + (size_t)2 * DM * 2;
constexpr size_t WS_PB    = WS_XN + al256((size_t)XNROWS * DM * 2);
constexpr size_t WS_XN8   = WS_PB + al256((size_t)S_ * PLE * 2);
constexpr size_t WS_WIN8  = WS_XN8 + al256((size_t)S_ * DM);
constexpr size_t WS_R     = WS_WIN8 + al256((size_t)(OFF_G - POOLW) * DM);
constexpr size_t WS_Z     = WS_R;
constexpr size_t WS_M     = WS_Z + al256((size_t)ZROWS * LDZ * 2);
constexpr size_t WS_G     = WS_M + al256((size_t)S_ * POOLW * 2);
constexpr size_t WS_H1    = WS_G + al256((size_t)S_ * NGATE * 4);
constexpr size_t WS_KC    = WS_H1 + al256((size_t)8192 * 256 * 4);
constexpr size_t WS_VC    = WS_KC + al256((size_t)4 * 1024 * 128 * 2);
constexpr size_t WS_L     = WS_VC + al256((size_t)4 * 1024 * 128 * 2);
constexpr size_t WS_OACC  = WS_L + al256((size_t)S_ * NH * 4);
constexpr size_t WS_IMPP  = WS_OACC + al256((size_t)S_ * 3072 * 4);
constexpr size_t WS_IMPF  = WS_IMPP + al256((size_t)S_ * 4 * 256 * 4);
constexpr size_t WS_BM    = WS_IMPF + al256((size_t)S_ * 4 * 256 * 4);
constexpr size_t WS_MIX   = WS_BM + al256((size_t)S_ * 4 * 8 * 4);
constexpr size_t WS_K8    = WS_MIX + al256((size_t)S_ * DM * 2);
constexpr size_t WS_K8W   = WS_K8 + al256((size_t)S_ * 4 * HD);
constexpr size_t WS_K8C   = WS_K8W + al256((size_t)S_ * 4 * HD);
constexpr size_t WS_END_A = WS_K8C + al256((size_t)1024 * 4 * HD);
constexpr size_t WS_ERAW  = WS_R;
constexpr size_t WS_ACT   = WS_ERAW + al256((size_t)S_ * DM * 2);
constexpr size_t WS_ERSTD = WS_ACT + al256((size_t)S_ * DFF * 2);
constexpr size_t WS_END_B = WS_ERSTD + al256((size_t)S_ * 4);
constexpr size_t WS_HRES  = WS_IMPP + (size_t)2 * DM * 2;
static_assert(WS_HRES - (size_t)2 * DM * 2 >= WS_END_B && WS_HRES + (size_t)S_ * DM * 2 <= WS_MIX, "residual stream must sit in the dead importance / bitmap buffers, clear of act / mix");
static_assert(WS_ERAW + (size_t)S_ * DM * 2 <= WS_Z + (size_t)ZROWS * LDZ * 2, "eraw must fit inside the dead z region while mix is still being read");
constexpr size_t WS_NEED  = WS_END_A > WS_END_B ? WS_END_A : WS_END_B;
static_assert(WS_NEED <= (size_t)1440000000, "workspace map exceeds the guaranteed 4 x largest-tensor bytes");

constexpr int LDS_STAGE = 131072;
constexpr int LDS_XCH   = LDS_STAGE + 64;
constexpr int LDS_MISC  = 155648;
constexpr int LDS_BYTES = LDS_MISC + 64;

__device__ __forceinline__ unsigned cvt_pk_bf16(float lo, float hi) { unsigned r; asm volatile("v_cvt_pk_bf16_f32 %0, %1, %2" : "=v"(r) : "v"(lo), "v"(hi)); return r; }
__device__ __forceinline__ float bf_lo(unsigned u) { return __uint_as_float(u << 16); }
__device__ __forceinline__ float bf_hi(unsigned u) { return __uint_as_float(u & 0xffff0000u); }
__device__ __forceinline__ float bf2f(bf16_t b) { return __uint_as_float(((unsigned)b) << 16); }
__device__ __forceinline__ float wave_sum(float v) {
#pragma unroll
    for (int o = 32; o >= 1; o >>= 1) v += __shfl_xor(v, o);
    return v;
}
__device__ __forceinline__ float wave_max(float v) {
#pragma unroll
    for (int o = 32; o >= 1; o >>= 1) v = fmaxf(v, __shfl_xor(v, o));
    return v;
}
__device__ __forceinline__ float sigmoidf_(float x) { return __builtin_amdgcn_rcpf(1.0f + __expf(-x)); }

#define XB_TMO      128
#define XB_XCNT(j)  (256  + 64 * (j))
#define XB_XSUB(j)  (1280 + 64 * (j))
#define XB_XGEN(j)  (2304 + 64 * (j))
#define XB_TOP      3328
#define XB_TOPGEN   3392
#define XCD_BAR_WORDS 3456
#define XB_SPIN_CAP (1u << 18)
__device__ __forceinline__ unsigned xb_ld(unsigned* p)              { return __hip_atomic_load(p, __ATOMIC_RELAXED, __HIP_MEMORY_SCOPE_AGENT); }
__device__ __forceinline__ unsigned xb_add(unsigned* p, unsigned v) { return __hip_atomic_fetch_add(p, v, __ATOMIC_RELAXED, __HIP_MEMORY_SCOPE_AGENT); }
__device__ __forceinline__ unsigned xb_xcc_id() { return (unsigned)__builtin_amdgcn_s_getreg((3 << 11) | 20) & 0xFu; }
#define XB_SPIN(cond, bar) do { unsigned _sp = 0; while (cond) { __builtin_amdgcn_s_sleep(1); \
    if ((++_sp & 255u) == 0u) { if (xb_ld(&(bar)[XB_TMO])) break; if (_sp > XB_SPIN_CAP) { atomicAdd(&(bar)[XB_TMO], 1u); break; } } } } while (0)
struct XcdBarrier { unsigned* bar; unsigned x; volatile LAS unsigned* st; };
__device__ __forceinline__ XcdBarrier xcd_barrier_post(unsigned* bar, volatile LAS unsigned* st) {
    XcdBarrier b; b.bar = bar; b.x = xb_xcc_id(); b.st = st;
    if (threadIdx.x == 0) (void)xb_add(&bar[XB_XCNT(b.x)], 1u);
    return b;
}
__device__ __forceinline__ void xcd_barrier_complete(unsigned* bar, unsigned x, unsigned& nloc, unsigned& nx) {
    const unsigned G = gridDim.x * gridDim.y * gridDim.z;
    unsigned sum, cnt, mine, sp = 0u;
    for (;;) {
        sum = 0u; cnt = 0u; mine = 0u;
#pragma unroll
        for (unsigned j = 0; j < 16; ++j) { const unsigned c = xb_ld(&bar[XB_XCNT(j)]); sum += c; cnt += (c > 0u) ? 1u : 0u; mine = (j == x) ? c : mine; }
        if (sum == G) break;
        __builtin_amdgcn_s_sleep(1);
        if ((++sp & 255u) == 0u) { if (xb_ld(&bar[XB_TMO])) break; if (sp > XB_SPIN_CAP) { atomicAdd(&bar[XB_TMO], 1u); break; } }
    }
    nloc = mine > 0u ? mine : 1u; nx = cnt > 0u ? cnt : 1u;
}
__device__ __forceinline__ void xcd_barrier(const XcdBarrier& b) {
    asm volatile("s_waitcnt vmcnt(0)" ::: "memory");
    __syncthreads();
    if (threadIdx.x == 0) {
        unsigned* bar = b.bar;
        __builtin_amdgcn_s_waitcnt(0);
        unsigned nloc = b.st[0], nx = b.st[1];
        if (nloc == 0u) { xcd_barrier_complete(bar, b.x, nloc, nx); b.st[0] = nloc; b.st[1] = nx; }
        const unsigned old = xb_add(&bar[XB_XSUB(b.x)], 1u);
        const unsigned gen = old / nloc;
        if (old + 1u == (gen + 1u) * nloc) {
            __builtin_amdgcn_fence(__ATOMIC_RELEASE, "agent");
            asm volatile("s_waitcnt vmcnt(0)" ::: "memory");
            const unsigned og = xb_add(&bar[XB_TOP], 1u);
            const unsigned tg = og / nx;
            if (og + 1u == (tg + 1u) * nx) xb_add(&bar[XB_TOPGEN], 1u);
            else XB_SPIN(xb_ld(&bar[XB_TOPGEN]) == tg, bar);
            __builtin_amdgcn_fence(__ATOMIC_ACQUIRE, "agent");
            xb_add(&bar[XB_XGEN(b.x)], 1u);
            asm volatile("s_waitcnt vmcnt(0)" ::: "memory");
        } else {
            XB_SPIN(xb_ld(&bar[XB_XGEN(b.x)]) == gen, bar);
            __builtin_amdgcn_fence(__ATOMIC_ACQUIRE, "agent");
            asm volatile("s_waitcnt vmcnt(0)" ::: "memory");
        }
    }
    __syncthreads();
}

struct Params {
    const float* x; const float* p; const int* positions; const float* norm1_w; const float* w_in; const float* w_pool; const float* pool_scale;
    const float* q_norm_w; const float* k_norm_cmp_w; const float* k_norm_slc_w; const float* k_norm_win_w; const float* cmp_pos_k; const float* cmp_pos_v;
    const float* cmp_k_w1; const float* cmp_k_w2; const float* cmp_v_w1; const float* cmp_v_w2; const float* w_o; const float* norm2_w; const float* w_ffn_in;
    const float* conv_w; const float* conv_b; const float* w_ffn_out; const float* w_ple_proj; const float* ple_norm_w; const float* ple_gate_norm_w; const float* w_ple_gate;
    float* out; unsigned char* ws; int ph_lo, ph_hi;
};

namespace pg8 {
constexpr int BM = 256, BK = 64, HALF = 128, HTB = HALF * BK * 2, STAGE_BYTES = 8 * HTB, NXCD = 8, WGM = 8;
__host__ __device__ __forceinline__ int lds_byte(int r, int c) { const int st = (r >> 4) * 2 + (c >> 5), rr = r & 15, cc = c & 31, ob = rr * 64 + cc * 2; return st * 1024 + (ob ^ (((ob >> 9) & 1) << 5)); }
__host__ __device__ __forceinline__ void stage_rc(int b, int& R, int& C) { const int st = b / 1024, sb = b % 1024, swz = sb ^ (((sb >> 9) & 1) << 5); R = (st >> 1) * 16 + swz / 64; C = (st & 1) * 32 + (swz % 64) / 2; }
__host__ __device__ __forceinline__ int perm32(int rho) { const int n = rho >> 4, i = rho & 15; return 8 * (i >> 2) + 4 * n + (i & 3); }
struct Unit { int pm, pn; };

struct StaticOrder {
    int nM, nN, nwg, G, c;
    __device__ void init(int nM_, int nN_, int G_, int c_) { nM = nM_; nN = nN_; nwg = nM * nN; G = G_; c = c_; }
    __device__ bool next(int i, Unit& u) const {
        const long L = (long)i * G + c; if (L >= nwg) return false;
        int wgid = (int)L; { const int q = nwg / NXCD, r = nwg % NXCD, xcd = wgid % NXCD, off = wgid / NXCD; wgid = (xcd < r ? xcd * (q + 1) : r * (q + 1) + (xcd - r) * q) + off; }
        const int nig = WGM * nN, gid = wgid / nig, fm = gid * WGM, gsz = (nM - fm) < WGM ? (nM - fm) : WGM;
        u.pm = fm + ((wgid % nig) % gsz); u.pn = (wgid % nig) / gsz; return true;
    }
};

struct GStd {
    const char* A; const char* B; unsigned lda, ldb; int nt;
    __device__ __forceinline__ const char* a_base(const Unit& u) const { return A + (size_t)u.pm * 256 * lda * 2; }
    __device__ __forceinline__ const char* b_base(const Unit& u) const { return B + (size_t)u.pn * 256 * ldb * 2; }
    __device__ __forceinline__ size_t kpairA() const { return 256; }
};
struct GPool {
    const char* A; const char* B; unsigned lda, ldb; int nt;
    __device__ __forceinline__ const char* a_base(const Unit& u) const { return A + (size_t)u.pm * 256 * lda * 2 + (size_t)u.pn * 512; }
    __device__ __forceinline__ const char* b_base(const Unit& u) const { return B + (size_t)u.pn * 256 * ldb * 2; }
    __device__ __forceinline__ size_t kpairA() const { return 256; }
};
struct GCmp {
    const char* Z; const char* Bk; const char* Bv; unsigned lda, ldb; int nt;
    __device__ __forceinline__ const char* a_base(const Unit& u) const { const int which = u.pm >> 4, g = (u.pm >> 2) & 3, rt = u.pm & 3;
        return Z + (size_t)(OFF_KV + which * 512 + g * 128) * 2 + (size_t)rt * 256 * lda * 2; }
    __device__ __forceinline__ const char* b_base(const Unit& u) const { return (u.pm >> 4) ? Bv : Bk; }
    __device__ __forceinline__ size_t kpairA() const { return (size_t)LDZ * 2; }
};

struct EpiBf16 {
    static constexpr bool PERM = true;
    bf16_t* O; int ldc;
    __device__ __forceinline__ void operator()(const f32x4 (&acc)[2][2][4][2], const Unit& u, int wr, int wc, int fr, int fq) const {
        const int row0 = u.pm * BM + wr * 64 + fr, col0 = u.pn * BM + wc * 32 + 8 * fq;
#pragma unroll
        for (int ai = 0; ai < 2; ++ai)
#pragma unroll
            for (int m = 0; m < 4; ++m) { bf16_t* rowp = O + (size_t)(row0 + ai * HALF + m * 16) * ldc + col0;
#pragma unroll
                for (int bj = 0; bj < 2; ++bj) { const f32x4 v0 = acc[ai][bj][m][0], v1 = acc[ai][bj][m][1];
                    u32x4 w; w.x = cvt_pk_bf16(v0[0], v0[1]); w.y = cvt_pk_bf16(v0[2], v0[3]); w.z = cvt_pk_bf16(v1[0], v1[1]); w.w = cvt_pk_bf16(v1[2], v1[3]);
                    *(u32x4*)(rowp + bj * HALF) = w; } }
    }
};
struct EpiBf16S {
    static constexpr bool PERM = true;
    bf16_t* O; int ldc; float s;
    __device__ __forceinline__ void operator()(const f32x4 (&acc)[2][2][4][2], const Unit& u, int wr, int wc, int fr, int fq) const {
        const int row0 = u.pm * BM + wr * 64 + fr, col0 = u.pn * BM + wc * 32 + 8 * fq;
#pragma unroll
        for (int ai = 0; ai < 2; ++ai)
#pragma unroll
            for (int m = 0; m < 4; ++m) { bf16_t* rowp = O + (size_t)(row0 + ai * HALF + m * 16) * ldc + col0;
#pragma unroll
                for (int bj = 0; bj < 2; ++bj) { const f32x4 v0 = acc[ai][bj][m][0] * s, v1 = acc[ai][bj][m][1] * s;
                    u32x4 w; w.x = cvt_pk_bf16(v0[0], v0[1]); w.y = cvt_pk_bf16(v0[2], v0[3]); w.z = cvt_pk_bf16(v1[0], v1[1]); w.w = cvt_pk_bf16(v1[2], v1[3]);
                    *(u32x4*)(rowp + bj * HALF) = w; } }
    }
};
struct EpiBf16Ssq {
    static constexpr bool PERM = true;
    bf16_t* O; int ldc; float* ssq;
    __device__ __forceinline__ void operator()(const f32x4 (&acc)[2][2][4][2], const Unit& u, int wr, int wc, int fr, int fq) const {
        const int row0 = u.pm * BM + wr * 64 + fr, col0 = u.pn * BM + wc * 32 + 8 * fq;
#pragma unroll
        for (int ai = 0; ai < 2; ++ai)
#pragma unroll
            for (int m = 0; m < 4; ++m) { const int row = row0 + ai * HALF + m * 16; bf16_t* rowp = O + (size_t)row * ldc + col0; float s = 0.f;
#pragma unroll
                for (int bj = 0; bj < 2; ++bj) { const f32x4 v0 = acc[ai][bj][m][0], v1 = acc[ai][bj][m][1];
                    s += v0[0] * v0[0] + v0[1] * v0[1] + v0[2] * v0[2] + v0[3] * v0[3] + v1[0] * v1[0] + v1[1] * v1[1] + v1[2] * v1[2] + v1[3] * v1[3];
                    u32x4 w; w.x = cvt_pk_bf16(v0[0], v0[1]); w.y = cvt_pk_bf16(v0[2], v0[3]); w.z = cvt_pk_bf16(v1[0], v1[1]); w.w = cvt_pk_bf16(v1[2], v1[3]);
                    *(u32x4*)(rowp + bj * HALF) = w; }
                s += __shfl_xor(s, 16); s += __shfl_xor(s, 32);
                if (fq == 0) unsafeAtomicAdd(ssq + row, s); }
    }
};
struct EpiBf16Scale {
    static constexpr bool PERM = true;
    bf16_t* O; int ldc; const float* colscale;
    __device__ __forceinline__ void operator()(const f32x4 (&acc)[2][2][4][2], const Unit& u, int wr, int wc, int fr, int fq) const {
        const int row0 = u.pm * BM + wr * 64 + fr, col0 = u.pn * BM + wc * 32 + 8 * fq;
#pragma unroll
        for (int bj = 0; bj < 2; ++bj) { const f32x4 s0 = *(const f32x4*)(colscale + col0 + bj * HALF), s1 = *(const f32x4*)(colscale + col0 + bj * HALF + 4);
#pragma unroll
            for (int ai = 0; ai < 2; ++ai)
#pragma unroll
                for (int m = 0; m < 4; ++m) { bf16_t* rowp = O + (size_t)(row0 + ai * HALF + m * 16) * ldc + col0;
                    const f32x4 v0 = acc[ai][bj][m][0] * s0, v1 = acc[ai][bj][m][1] * s1;
                    u32x4 w; w.x = cvt_pk_bf16(v0[0], v0[1]); w.y = cvt_pk_bf16(v0[2], v0[3]); w.z = cvt_pk_bf16(v1[0], v1[1]); w.w = cvt_pk_bf16(v1[2], v1[3]);
                    *(u32x4*)(rowp + bj * HALF) = w; } }
    }
};
struct EpiResF32 {
    static constexpr bool PERM = false;
    const float* base; float* C; int ldc; int row_off;
    __device__ __forceinline__ void operator()(const f32x4 (&acc)[2][2][4][2], const Unit& u, int wr, int wc, int fr, int fq) const {
        const int row0 = u.pm * BM + wr * 64 + fr + row_off, col0 = u.pn * BM + wc * 32 + 4 * fq;
#pragma unroll
        for (int ai = 0; ai < 2; ++ai)
#pragma unroll
            for (int m = 0; m < 4; ++m) { const size_t off = (size_t)(row0 + ai * HALF + m * 16) * ldc + col0;
#pragma unroll
                for (int bj = 0; bj < 2; ++bj)
#pragma unroll
                    for (int n = 0; n < 2; ++n) { const f32x4 b = *(const f32x4*)(base + off + bj * HALF + n * 16); *(f32x4*)(C + off + bj * HALF + n * 16) = b + acc[ai][bj][m][n]; }
                asm volatile("" ::: "memory"); }
    }
};
template <bool FP8OUT, bool BASEBF, bool WXN = true>
struct EpiResNormT {
    static constexpr bool PERM = false;
    const void* base; bf16_t* C; bf16_t* XN; const float* nw; float* ssq; int ldc; float ascale = 1.0f;
    typedef typename std::conditional<BASEBF, u32x2, f32x4>::type RawT;
    __device__ __forceinline__ RawT ldb(size_t idx) const { if constexpr (BASEBF) return *(const u32x2*)((const bf16_t*)base + idx); else return *(const f32x4*)((const float*)base + idx); }
    static __device__ __forceinline__ f32x4 cv(const RawT& r) { if constexpr (BASEBF) return (f32x4){bf_lo(r.x), bf_hi(r.x), bf_lo(r.y), bf_hi(r.y)}; else return r; }
    __device__ __forceinline__ void operator()(const f32x4 (&acc)[2][2][4][2], const Unit& u, int wr, int wc, int fr, int fq) const {
        const int row0 = u.pm * BM + wr * 64 + fr, col0 = u.pn * BM + wc * 32 + 4 * fq;
        f32x4 wv[2][2];
#pragma unroll
        for (int bj = 0; bj < 2; ++bj)
#pragma unroll
            for (int n = 0; n < 2; ++n) wv[bj][n] = *(const f32x4*)(nw + col0 + bj * HALF + n * 16);
        RawT bv[2][2][2];
#pragma unroll
        for (int bj = 0; bj < 2; ++bj)
#pragma unroll
            for (int n = 0; n < 2; ++n) bv[0][bj][n] = ldb((size_t)row0 * ldc + col0 + bj * HALF + n * 16);
#pragma unroll
        for (int rg = 0; rg < 8; ++rg) { const int ai = rg >> 2, m = rg & 3; const int row = row0 + ai * HALF + m * 16; const size_t off = (size_t)row * ldc + col0;
            if (rg < 7) { const int ai2 = (rg + 1) >> 2, m2 = (rg + 1) & 3; const size_t off2 = (size_t)(row0 + ai2 * HALF + m2 * 16) * ldc + col0;
#pragma unroll
                for (int bj = 0; bj < 2; ++bj)
#pragma unroll
                    for (int n = 0; n < 2; ++n) bv[(rg + 1) & 1][bj][n] = ldb(off2 + bj * HALF + n * 16); }
            float s = 0.f;
#pragma unroll
            for (int bj = 0; bj < 2; ++bj)
#pragma unroll
                for (int n = 0; n < 2; ++n) { const f32x4 v = cv(bv[rg & 1][bj][n]) + acc[ai][bj][m][n] * ascale;
                    { u32x2 c; c.x = cvt_pk_bf16(v[0], v[1]); c.y = cvt_pk_bf16(v[2], v[3]); *(u32x2*)(C + off + bj * HALF + n * 16) = c; }
                    s += v[0] * v[0] + v[1] * v[1] + v[2] * v[2] + v[3] * v[3];
                    if (!WXN) { }
                    else if (FP8OUT) { int pk = __builtin_amdgcn_cvt_pk_fp8_f32(v[0] * wv[bj][n][0], v[1] * wv[bj][n][1], 0, false); pk = __builtin_amdgcn_cvt_pk_fp8_f32(v[2] * wv[bj][n][2], v[3] * wv[bj][n][3], pk, true);
                        *(int*)((unsigned char*)XN + off + bj * HALF + n * 16) = pk; }
                    else { u32x2 o; o.x = cvt_pk_bf16(v[0] * wv[bj][n][0], v[1] * wv[bj][n][1]); o.y = cvt_pk_bf16(v[2] * wv[bj][n][2], v[3] * wv[bj][n][3]);
                        *(u32x2*)(XN + off + bj * HALF + n * 16) = o; } }
            s += __shfl_xor(s, 16); s += __shfl_xor(s, 32);
            if (fq == 0) unsafeAtomicAdd(ssq + row, s);
        }
    }
};
typedef EpiResNormT<false, false, false> EpiResNorm;
typedef EpiResNormT<true, true> EpiResNormF8;
struct EpiCmpGelu {
    static constexpr bool PERM = false;
    float* H; const float* bias;
    __device__ __forceinline__ void operator()(const f32x4 (&acc)[2][2][4][2], const Unit& u, int wr, int wc, int fr, int fq) const {
        const int row0 = u.pm * BM + wr * 64 + fr, col0 = wc * 32 + 4 * fq; const float* bs = bias + (u.pm >> 4) * 256;
        f32x4 bvv[2][2];
#pragma unroll
        for (int bj = 0; bj < 2; ++bj)
#pragma unroll
            for (int n = 0; n < 2; ++n) bvv[bj][n] = *(const f32x4*)(bs + col0 + bj * HALF + n * 16);
#pragma unroll
        for (int ai = 0; ai < 2; ++ai)
#pragma unroll
            for (int m = 0; m < 4; ++m) { float* rowp = H + (size_t)(row0 + ai * HALF + m * 16) * 256 + col0;
#pragma unroll
                for (int bj = 0; bj < 2; ++bj)
#pragma unroll
                    for (int n = 0; n < 2; ++n) { f32x4 v = acc[ai][bj][m][n] + bvv[bj][n];
#pragma unroll
                        for (int j = 0; j < 4; ++j) { const float xx = v[j], uu = 0.7978845608028654f * (xx + 0.044715f * xx * xx * xx); const float th = 1.0f - 2.0f / (1.0f + __expf(2.0f * uu)); v[j] = 0.5f * xx * (1.0f + th); }
                        *(f32x4*)(rowp + bj * HALF + n * 16) = v; } }
    }
};
struct EpiGate {
    static constexpr bool PERM = false;
    float* C; const bf16_t* H; const bf16_t* eraw; const float* erstd; const float* pw; const float* ssq; int ldc; float ascale;
    __device__ __forceinline__ void operator()(const f32x4 (&acc)[2][2][4][2], const Unit& u, int wr, int wc, int fr, int fq) const {
        const int row0 = u.pm * BM + wr * 64 + fr, col0 = u.pn * BM + wc * 32 + 4 * fq;
        f32x4 wv[2][2];
#pragma unroll
        for (int bj = 0; bj < 2; ++bj)
#pragma unroll
            for (int n = 0; n < 2; ++n) wv[bj][n] = *(const f32x4*)(pw + col0 + bj * HALF + n * 16);
        u32x2 bv[2][2][2]; u32x2 ev[2][2][2]; float rsv[2], rgv[2];
#pragma unroll
        for (int bj = 0; bj < 2; ++bj)
#pragma unroll
            for (int n = 0; n < 2; ++n) { bv[0][bj][n] = *(const u32x2*)(H + (size_t)row0 * ldc + col0 + bj * HALF + n * 16); ev[0][bj][n] = *(const u32x2*)(eraw + (size_t)row0 * ldc + col0 + bj * HALF + n * 16); }
        rsv[0] = erstd[row0]; rgv[0] = ssq[row0];
#pragma unroll
        for (int rg = 0; rg < 8; ++rg) { const int ai = rg >> 2, m = rg & 3; const int row = row0 + ai * HALF + m * 16; const size_t off = (size_t)row * ldc + col0;
            if (rg < 7) { const int ai2 = (rg + 1) >> 2, m2 = (rg + 1) & 3; const int row2 = row0 + ai2 * HALF + m2 * 16; const size_t off2 = (size_t)row2 * ldc + col0;
#pragma unroll
                for (int bj = 0; bj < 2; ++bj)
#pragma unroll
                    for (int n = 0; n < 2; ++n) { bv[(rg + 1) & 1][bj][n] = *(const u32x2*)(H + off2 + bj * HALF + n * 16); ev[(rg + 1) & 1][bj][n] = *(const u32x2*)(eraw + off2 + bj * HALF + n * 16); }
                rsv[(rg + 1) & 1] = erstd[row2]; rgv[(rg + 1) & 1] = ssq[row2]; }
            const float rs = rsqrtf(rsv[rg & 1] * (1.0f / DM) + EPS), rg_ = rsqrtf(rgv[rg & 1] * (1.0f / DM) + EPS) * ascale;
#pragma unroll
            for (int bj = 0; bj < 2; ++bj)
#pragma unroll
                for (int n = 0; n < 2; ++n) { const u32x2 br = bv[rg & 1][bj][n]; const f32x4 b = {bf_lo(br.x), bf_hi(br.x), bf_lo(br.y), bf_hi(br.y)}; const u32x2 e = ev[rg & 1][bj][n]; const f32x4 a = acc[ai][bj][m][n]; f32x4 o;
                    o[0] = b[0] + bf_lo(e.x) * rs * wv[bj][n][0] * sigmoidf_(a[0] * rg_); o[1] = b[1] + bf_hi(e.x) * rs * wv[bj][n][1] * sigmoidf_(a[1] * rg_);
                    o[2] = b[2] + bf_lo(e.y) * rs * wv[bj][n][2] * sigmoidf_(a[2] * rg_); o[3] = b[3] + bf_hi(e.y) * rs * wv[bj][n][3] * sigmoidf_(a[3] * rg_);
                    *(f32x4*)(C + off + bj * HALF + n * 16) = o; }
        }
    }
};
struct GFfn {
    const char* A; const char* B; unsigned lda, ldb; int nt;
    __device__ __forceinline__ const char* a_base(const Unit& u) const { return A + ((long)u.pm * 254 - 2) * (long)lda * 2; }
    __device__ __forceinline__ const char* b_base(const Unit& u) const { return B + (size_t)u.pn * 256 * ldb * 2; }
    __device__ __forceinline__ size_t kpairA() const { return 256; }
};
template <int CTRL> __device__ __forceinline__ float dpp_f(float v) { return __int_as_float(__builtin_amdgcn_update_dpp(0, __float_as_int(v), CTRL, 0xf, 0xf, false)); }
struct EpiFfn {
    static constexpr bool PERM = true;
    bf16_t* ACT; const float* cw; const float* cb; LAS float* X; const float* ssq;
    __device__ __forceinline__ void operator()(const f32x4 (&acc)[2][2][4][2], const Unit& u, int wr, int wc, int fr, int fq) const {
        const int colw = wc * 32 + 8 * fq;
        const int f0 = u.pn * 128 + colw;
        f32x4 w0[2], w1[2], w2[2], cbv[2];
#pragma unroll
        for (int n = 0; n < 2; ++n) { w0[n] = *(const f32x4*)(cw + f0 + 4 * n); w1[n] = *(const f32x4*)(cw + DFF + f0 + 4 * n); w2[n] = *(const f32x4*)(cw + 2 * DFF + f0 + 4 * n); cbv[n] = *(const f32x4*)(cb + f0 + 4 * n); }
        float rsv[2][4];
#pragma unroll
        for (int ai = 0; ai < 2; ++ai)
#pragma unroll
            for (int m = 0; m < 4; ++m) { const long t = (long)u.pm * 254 - 2 + ai * HALF + wr * 64 + m * 16 + fr; rsv[ai][m] = ssq[t < 0 ? 0 : (t >= S_ ? S_ - 1 : t)]; }
#pragma unroll
        for (int ai = 0; ai < 2; ++ai)
#pragma unroll
            for (int m = 0; m < 4; ++m) { const long t = (long)u.pm * 254 - 2 + ai * HALF + wr * 64 + m * 16 + fr; rsv[ai][m] = (t >= 0 && t < S_) ? rsqrtf(rsv[ai][m] * (1.0f / DM) + EPS) : 0.f; }
        if (fr >= 14) {
#pragma unroll
            for (int ai = 0; ai < 2; ++ai)
#pragma unroll
                for (int n = 0; n < 2; ++n) *(LAS f32x4*)(X + ((2 * ai + wr) * 2 + (fr - 14)) * 128 + colw + 4 * n) = acc[ai][0][3][n] * rsv[ai][3];
        }
        asm volatile("s_waitcnt lgkmcnt(0)" ::: "memory");
        __builtin_amdgcn_s_barrier(); asm volatile("" ::: "memory");
        __builtin_amdgcn_s_barrier(); asm volatile("" ::: "memory");
        const bool sel1 = fr == 15, sel2 = fr >= 14;
#pragma unroll
        for (int ai = 0; ai < 2; ++ai) {
            f32x4 pv[2];
            const int pseg = 2 * ai + wr - 1;
#pragma unroll
            for (int n = 0; n < 2; ++n) { pv[n] = (f32x4){0.f, 0.f, 0.f, 0.f}; if (pseg >= 0 && fr >= 14) pv[n] = *(const LAS f32x4*)(X + (pseg * 2 + (fr - 14)) * 128 + colw + 4 * n); }
#pragma unroll
            for (int m = 0; m < 4; ++m) {
                const int r = ai * HALF + wr * 64 + m * 16 + fr; const long t = (long)u.pm * 254 - 2 + r;
                unsigned ow[4];
#pragma unroll
                for (int n = 0; n < 2; ++n) {
                    const f32x4 cur = acc[ai][0][m][n] * rsv[ai][m], up = acc[ai][1][m][n] * rsv[ai][m];
                    f32x4 x1, x2;
#pragma unroll
                    for (int i = 0; i < 4; ++i) { x1[i] = dpp_f<0x121>(sel1 ? pv[n][i] : cur[i]); x2[i] = dpp_f<0x122>(sel2 ? pv[n][i] : cur[i]); }
                    const f32x4 y = cbv[n] + w0[n] * x2 + w1[n] * x1 + w2[n] * cur;
                    f32x4 sg;
#pragma unroll
                    for (int i = 0; i < 4; ++i) sg[i] = sigmoidf_(y[i]);
                    const f32x4 o = y * sg * up;
                    ow[2 * n] = cvt_pk_bf16(o[0], o[1]); ow[2 * n + 1] = cvt_pk_bf16(o[2], o[3]);
                    pv[n] = cur;
                }
                if (r >= 2 && t < S_) *(u32x4*)(ACT + (size_t)t * DFF + f0) = (u32x4){ow[0], ow[1], ow[2], ow[3]};
            }
        }
    }
};

template <class GD, class Epi, bool F8T = false, int MIXT = 0>
__device__ __forceinline__ void gemm_phase(LAS unsigned char* lds, const GD g, const StaticOrder& S, const Epi& E) {
    constexpr bool F8 = F8T;
    const int tid = threadIdx.x, wid = __builtin_amdgcn_readfirstlane(tid >> 6), lane = tid & 63, wr = wid >> 2, wc = wid & 3, fr = lane & 15, fq = lane >> 4;
    const int nt = g.nt;
    unsigned voffA[2], voffB[2];
#pragma unroll
    for (int i = 0; i < 2; ++i) { int R, C; stage_rc(tid * 16 + i * 8192, R, C); const int Rb = Epi::PERM ? ((R & ~31) + perm32(R & 31)) : R;
        voffA[i] = (unsigned)(R * g.lda + C) * 2u; voffB[i] = (unsigned)(Rb * g.ldb + C) * 2u; }
    const size_t kpA = g.kpairA();
    const size_t hstepA = (size_t)HALF * g.lda * 2, hstepB = (size_t)HALF * g.ldb * 2;
    const unsigned ldsw = (unsigned)wid * 1024u;
    const int aoff = lds_byte(wr * 64 + fr, fq * 8), boff = lds_byte(wc * 32 + fr, fq * 8);
#define PG8_SA(b, h) (((b) * 2 + (h)) * HTB)
#define PG8_SB(b, h) ((4 + (b) * 2 + (h)) * HTB)
#define PG8_STAGE(bufoff, gbase, voff) do { _Pragma("unroll") for (int _i = 0; _i < 2; ++_i) \
        __builtin_amdgcn_global_load_lds((const unsigned*)((const char*)(gbase) + (voff)[_i]), (LAS unsigned*)(lds + (bufoff) + ldsw + _i * 8192), 16, 0, 0); } while (0)
#define PG8_LDA(dst, b, h) do { if constexpr (F8) { _Pragma("unroll") for (int m = 0; m < 4; ++m) { const i32x4 lo_ = *(const LAS i32x4*)(lds + PG8_SA(b, h) + aoff + m * 2048), hi_ = *(const LAS i32x4*)(lds + PG8_SA(b, h) + aoff + m * 2048 + 1024); \
            dst##8[m] = __builtin_shufflevector(lo_, hi_, 0, 1, 2, 3, 4, 5, 6, 7); } } \
        else { _Pragma("unroll") for (int m = 0; m < 4; ++m) _Pragma("unroll") for (int k = 0; k < 2; ++k) dst[m][k] = *(const LAS bf16x8*)(lds + PG8_SA(b, h) + aoff + m * 2048 + k * 1024); } } while (0)
#define PG8_LDB(dst, b, h) do { if constexpr (F8) { _Pragma("unroll") for (int n = 0; n < 2; ++n) { const i32x4 lo_ = *(const LAS i32x4*)(lds + PG8_SB(b, h) + boff + n * 2048), hi_ = *(const LAS i32x4*)(lds + PG8_SB(b, h) + boff + n * 2048 + 1024); \
            dst##8[n] = __builtin_shufflevector(lo_, hi_, 0, 1, 2, 3, 4, 5, 6, 7); } } \
        else { _Pragma("unroll") for (int n = 0; n < 2; ++n) _Pragma("unroll") for (int k = 0; k < 2; ++k) dst[n][k] = *(const LAS bf16x8*)(lds + PG8_SB(b, h) + boff + n * 2048 + k * 1024); } } while (0)
#define PG8_MMA(ai, bj, At, Bt) do { __builtin_amdgcn_s_setprio(1); \
        if constexpr (F8) { _Pragma("unroll") for (int m = 0; m < 4; ++m) _Pragma("unroll") for (int n = 0; n < 2; ++n) \
            asm volatile("v_mfma_scale_f32_16x16x128_f8f6f4 %0, %1, %2, %0, %3, %3 op_sel_hi:[0,0,0]" : "+v"(acc[ai][bj][m][n]) : "v"(Bt##8[n]), "v"(At##8[m]), "v"(one_scale)); } \
        else { _Pragma("unroll") for (int m = 0; m < 4; ++m) _Pragma("unroll") for (int n = 0; n < 2; ++n) _Pragma("unroll") for (int k = 0; k < 2; ++k) \
            acc[ai][bj][m][n] = __builtin_amdgcn_mfma_f32_16x16x32_bf16(Bt[n][k], At[m][k], acc[ai][bj][m][n], 0, 0, 0); } \
        __builtin_amdgcn_s_setprio(0); } while (0)
#define PG8_WAIT_V(n) asm volatile("s_waitcnt vmcnt(" #n ")" ::: "memory")
#define PG8_WAIT_L(n) asm volatile("s_waitcnt lgkmcnt(" #n ")" ::: "memory")
#define PG8_BAR __builtin_amdgcn_s_barrier()
#define PG8_SCHED __builtin_amdgcn_sched_barrier(0)
#define PG8_BODY \
            PG8_LDB(B0, 0, 0); PG8_SCHED; PG8_LDA(At, 0, 0); PG8_STAGE(PG8_SA(1, 1), a1 + hstepA, voffA); \
            PG8_WAIT_L(8); PG8_BAR; PG8_WAIT_L(0); PG8_MMA(0, 0, At, B0); PG8_BAR; PG8_SCHED; \
            PG8_LDB(B1, 0, 1); PG8_STAGE(PG8_SB(0, 0), b2, voffB); \
            PG8_BAR; PG8_WAIT_L(0); PG8_MMA(0, 1, At, B1); PG8_BAR; \
            PG8_LDA(At, 0, 1); PG8_STAGE(PG8_SA(0, 0), a2, voffA); \
            PG8_BAR; PG8_WAIT_L(0); PG8_MMA(1, 0, At, B0); PG8_BAR; PG8_SCHED; \
            PG8_STAGE(PG8_SB(0, 1), b2 + hstepB, voffB); \
            PG8_WAIT_V(6); PG8_BAR; PG8_MMA(1, 1, At, B1); PG8_BAR; \
            PG8_LDB(B0, 1, 0); PG8_SCHED; PG8_LDA(At, 1, 0); PG8_STAGE(PG8_SA(0, 1), a2 + hstepA, voffA); \
            PG8_WAIT_L(8); PG8_BAR; PG8_WAIT_L(0); PG8_MMA(0, 0, At, B0); PG8_BAR; PG8_SCHED; \
            PG8_LDB(B1, 1, 1); PG8_STAGE(PG8_SB(1, 0), b3, voffB); \
            PG8_BAR; PG8_WAIT_L(0); PG8_MMA(0, 1, At, B1); PG8_BAR; \
            PG8_LDA(At, 1, 1); PG8_STAGE(PG8_SA(1, 0), a3, voffA); \
            PG8_BAR; PG8_WAIT_L(0); PG8_MMA(1, 0, At, B0); PG8_BAR; PG8_SCHED; \
            PG8_STAGE(PG8_SB(1, 1), b3 + hstepB, voffB); \
            PG8_WAIT_V(6); PG8_BAR; PG8_MMA(1, 1, At, B1); PG8_BAR;
    Unit cur, nxt; int ui = 0;
    if (!S.next(0, cur)) return;
    f32x4 acc[2][2][4][2];
#pragma unroll
    for (int a = 0; a < 2; ++a)
#pragma unroll
        for (int b = 0; b < 2; ++b)
#pragma unroll
            for (int m = 0; m < 4; ++m)
#pragma unroll
                for (int n = 0; n < 2; ++n) acc[a][b][m][n] = (f32x4){0.f, 0.f, 0.f, 0.f};
    bf16x8 At[4][2], B0[2][2], B1[2][2];
    i32x8 At8[4], B08[2], B18[2];
    (void)At; (void)B0; (void)B1; (void)At8; (void)B08; (void)B18;
    int one_scale = 0x7F7F7F7F; (void)one_scale;
    const char* cA = g.a_base(cur); const char* cB = g.b_base(cur);
    PG8_STAGE(PG8_SB(0, 0), cB, voffB); PG8_STAGE(PG8_SA(0, 0), cA, voffA); PG8_STAGE(PG8_SB(0, 1), cB + hstepB, voffB); PG8_STAGE(PG8_SA(0, 1), cA + hstepA, voffA);
    if (wr == 1) PG8_BAR;
    PG8_WAIT_V(4); PG8_BAR;
    PG8_STAGE(PG8_SB(1, 0), cB + 128, voffB); PG8_STAGE(PG8_SA(1, 0), cA + 128, voffA); PG8_STAGE(PG8_SB(1, 1), cB + hstepB + 128, voffB);
    PG8_WAIT_V(6); PG8_BAR;
    for (;;) {
        const bool has_next = S.next(ui + 1, nxt);
        const char* nA = has_next ? g.a_base(nxt) : cA; const char* nB = has_next ? g.b_base(nxt) : cB;
#define PG8_ADDR const bool last = (t == nt - 2); const char* a0 = cA + (size_t)(t >> 1) * kpA; const char* a1 = a0 + 128; \
            const char* a2 = last ? nA : a0 + kpA; const char* b2 = last ? nB : cB + (size_t)(t + 2) * 128; const char* a3 = a2 + 128; const char* b3 = b2 + 128;
        if constexpr (MIXT > 0) {
            for (int t = 0; t < MIXT; t += 2) { PG8_ADDR PG8_BODY }
            for (int t = MIXT; t < nt; t += 2) { constexpr bool F8 = true; (void)F8; PG8_ADDR PG8_BODY }
        } else {
            for (int t = 0; t < nt; t += 2) { PG8_ADDR PG8_BODY }
        }
#undef PG8_ADDR
        if constexpr (F8 || MIXT > 0) asm volatile("s_nop 15\n\ts_nop 15\n\ts_nop 15" ::: "memory");
        E(acc, cur, wr, wc, fr, fq);
        if (!has_next) break;
#pragma unroll
        for (int a = 0; a < 2; ++a)
#pragma unroll
            for (int b = 0; b < 2; ++b)
#pragma unroll
                for (int m = 0; m < 4; ++m)
#pragma unroll
                    for (int n = 0; n < 2; ++n) acc[a][b][m][n] = (f32x4){0.f, 0.f, 0.f, 0.f};
        cur = nxt; cA = nA; cB = nB; ++ui;
    }
    PG8_WAIT_V(0);
    if (wr == 0) PG8_BAR;
    PG8_BAR;
#undef PG8_SA
#undef PG8_SB
#undef PG8_STAGE
#undef PG8_LDA
#undef PG8_LDB
#undef PG8_MMA
#undef PG8_WAIT_V
#undef PG8_WAIT_L
#undef PG8_BAR
#undef PG8_SCHED
#undef PG8_BODY
}
}

namespace att {
constexpr int KVBLK = 64;
constexpr int SHM_V = KVBLK * HD * 2, SHM_K = KVBLK * HD * 2, SHM_ATTN = 2 * SHM_V + 2 * SHM_K + NWAVES * 64 * 4;
#define KSWZ(row, colB) ((row) * 256 + ((colB) ^ (((row) & 7) << 4)))
#define SBAR() __builtin_amdgcn_sched_barrier(0)
__device__ __forceinline__ int crow(int r, int hi) { return (r & 3) + 8 * (r >> 2) + 4 * hi; }
__device__ __forceinline__ void qkt(f32x16& p0, f32x16& p1, const char* Ks, const bf16x8* qr, int r32, int hi) {
    p0 = f32x16{}; p1 = f32x16{};
    bf16x8 ka[2], kb[2];
    { const int cb = (hi * 8) * 2; ka[0] = *reinterpret_cast<const bf16x8*>(Ks + KSWZ(r32, cb)); kb[0] = *reinterpret_cast<const bf16x8*>(Ks + KSWZ(32 + r32, cb)); }
#pragma unroll
    for (int d0 = 0; d0 < 8; ++d0) {
        if (d0 < 7) { const int cb = ((d0 + 1) * 16 + hi * 8) * 2;
            ka[(d0 + 1) & 1] = *reinterpret_cast<const bf16x8*>(Ks + KSWZ(r32, cb)); kb[(d0 + 1) & 1] = *reinterpret_cast<const bf16x8*>(Ks + KSWZ(32 + r32, cb)); }
        SBAR();
        p0 = __builtin_amdgcn_mfma_f32_32x32x16_bf16(ka[d0 & 1], qr[d0], p0, 0, 0, 0);
        p1 = __builtin_amdgcn_mfma_f32_32x32x16_bf16(kb[d0 & 1], qr[d0], p1, 0, 0, 0);
        SBAR();
    }
}
__device__ __forceinline__ int v_st(int k, int c) { const int kk = (k & ~0xC) | ((k & 4) << 1) | ((k & 8) >> 1); return ((kk >> 3) * 4 + (c >> 5)) * 512 + ((kk & 7) * 32 + (c & 31)) * 2; }
__device__ __forceinline__ int v_rd_base(int lane) { return ((lane & 3) << 3) | (((lane >> 2) & 3) << 6) | (((lane >> 4) & 1) << 5) | (((lane >> 5) & 1) << 8); }
constexpr int v_rd_off(int d0, int ks, int half) { return d0 * 512 + ks * 4096 + half * 2048; }
__device__ __forceinline__ s16x4 tr_read(int vb, int off) { return __builtin_amdgcn_ds_read_tr16_b64_v4i16((LAS s16x4*)(unsigned long)(unsigned)(vb + off)); }
__device__ __forceinline__ void pv_d0(f32x16* o, int vb, bf16x8 pa0, bf16x8 pa1, bf16x8 pa2, bf16x8 pa3) {
    s16x4 L[2][4], H[2][4];
#pragma unroll
    for (int d0 = 0; d0 < 4; ++d0) { L[0][d0] = tr_read(vb, v_rd_off(d0, 0, 0)); H[0][d0] = tr_read(vb, v_rd_off(d0, 0, 1)); }
#pragma unroll
    for (int ks = 0; ks < 4; ++ks) {
        if (ks < 3) {
#pragma unroll
            for (int d0 = 0; d0 < 4; ++d0) { L[(ks + 1) & 1][d0] = tr_read(vb, v_rd_off(d0, ks + 1, 0)); H[(ks + 1) & 1][d0] = tr_read(vb, v_rd_off(d0, ks + 1, 1)); }
        }
        const bf16x8 pa = ks == 0 ? pa0 : (ks == 1 ? pa1 : (ks == 2 ? pa2 : pa3));
#pragma unroll
        for (int d0 = 0; d0 < 4; ++d0) { const s16x4 l = L[ks & 1][d0], h = H[ks & 1][d0];
            o[d0] = __builtin_amdgcn_mfma_f32_32x32x16_bf16(pa, (bf16x8){l[0], l[1], l[2], l[3], h[0], h[1], h[2], h[3]}, o[d0], 0, 0, 0); }
    }
}
__device__ __forceinline__ void pack_p(const f32x16& p0, const f32x16& p1, bf16x8& pa0, bf16x8& pa1, bf16x8& pa2, bf16x8& pa3) {
#define PK4(P, BASE, OUT) do { unsigned a0 = cvt_pk_bf16(P[BASE + 0], P[BASE + 1]), a1 = cvt_pk_bf16(P[BASE + 2], P[BASE + 3]);   \
    unsigned b0 = cvt_pk_bf16(P[BASE + 4], P[BASE + 5]), b1 = cvt_pk_bf16(P[BASE + 6], P[BASE + 7]);                              \
    auto r0 = __builtin_amdgcn_permlane32_swap(a0, b0, false, false); auto r1 = __builtin_amdgcn_permlane32_swap(a1, b1, false, false); \
    u32x4 w = {r0[0], r1[0], r0[1], r1[1]}; OUT = *reinterpret_cast<bf16x8*>(&w); } while (0)
    PK4(p0, 0, pa0); PK4(p0, 8, pa1); PK4(p1, 0, pa2); PK4(p1, 8, pa3);
#undef PK4
}

__device__ __forceinline__ void pack_half(const f32x16& p, bf16x8& paA, bf16x8& paB) {
#define PK4(P, BASE, OUT) do { unsigned a0 = cvt_pk_bf16(P[BASE + 0], P[BASE + 1]), a1 = cvt_pk_bf16(P[BASE + 2], P[BASE + 3]);   \
    unsigned b0 = cvt_pk_bf16(P[BASE + 4], P[BASE + 5]), b1 = cvt_pk_bf16(P[BASE + 6], P[BASE + 7]);                              \
    auto r0 = __builtin_amdgcn_permlane32_swap(a0, b0, false, false); auto r1 = __builtin_amdgcn_permlane32_swap(a1, b1, false, false); \
    u32x4 w = {r0[0], r1[0], r0[1], r1[1]}; OUT = *reinterpret_cast<bf16x8*>(&w); } while (0)
    PK4(p, 0, paA); PK4(p, 8, paB);
#undef PK4
}
template <int KS0, bool WITH_EXP>
__device__ __forceinline__ void pv_half(f32x16* o, int vb, bf16x8 paA, bf16x8 paB, f32x16& px, float off) {
    s16x4 L[2][4], H[2][4];
#pragma unroll
    for (int d0 = 0; d0 < 4; ++d0) { L[0][d0] = tr_read(vb, v_rd_off(d0, KS0, 0)); H[0][d0] = tr_read(vb, v_rd_off(d0, KS0, 1)); }
#pragma unroll
    for (int d0 = 0; d0 < 4; ++d0) { L[1][d0] = tr_read(vb, v_rd_off(d0, KS0 + 1, 0)); H[1][d0] = tr_read(vb, v_rd_off(d0, KS0 + 1, 1)); }
#pragma unroll
    for (int kk = 0; kk < 2; ++kk) {
        const bf16x8 pa = kk == 0 ? paA : paB;
#pragma unroll
        for (int d0 = 0; d0 < 4; ++d0) { const s16x4 l = L[kk][d0], h = H[kk][d0];
            if (WITH_EXP) SBAR();
            o[d0] = __builtin_amdgcn_mfma_f32_32x32x16_bf16(pa, (bf16x8){l[0], l[1], l[2], l[3], h[0], h[1], h[2], h[3]}, o[d0], 0, 0, 0);
            if (WITH_EXP) {
#pragma unroll
                for (int q = 0; q < 2; ++q) { const int r = (kk * 4 + d0) * 2 + q; px[r] = __builtin_amdgcn_exp2f(fmaf(px[r], SM_C, off)); }
                SBAR(); }
        }
    }
}
enum { MODE_CMP = 0, MODE_WIN = 1, MODE_SLC = 2 };
struct AttnArgs {
    const bf16_t* Z; const bf16_t* KC; const bf16_t* VC; const float* G; float* L; float* OACC; bf16_t* MIX; const unsigned* BM; const float* TAB;
};
template <int MODE>
__device__ __forceinline__ void attn_unit(const AttnArgs& a, LAS char* ldsL, int qt, int g, int hp) {
    char* lds = (char*)ldsL;
    const int tid = threadIdx.x, wid = __builtin_amdgcn_readfirstlane(tid >> 6), lane = tid & 63, r32 = lane & 31, hi = lane >> 5;
    float* li_l = (float*)(lds + LDS_XCH) + wid * 64;
    const int t0 = MODE == MODE_SLC ? qt * 40 : qt * 128;
    const int tq_raw = MODE == MODE_SLC ? t0 + wid * 5 + r32 / 6 : t0 + wid * 16 + (r32 & 15);
    const bool rvalid = MODE == MODE_SLC ? (r32 < 30 && tq_raw < S_) : true;
    const int tq = tq_raw < S_ ? tq_raw : S_ - 1;
    const int hq = MODE == MODE_SLC ? g * HPG + r32 % 6 : g * HPG + hp * 2 + (r32 >> 4);
    const int tlast = MODE == MODE_SLC ? ((t0 + 39) < S_ ? (t0 + 39) : S_ - 1) : t0 + 127;
    const bf16_t* Kb; const bf16_t* Vb; long ldk;
    if (MODE == MODE_CMP) { Kb = a.KC + (size_t)g * 1024 * HD; Vb = a.VC + (size_t)g * 1024 * HD; ldk = HD; }
    else if (MODE == MODE_WIN) { Kb = a.Z + OFF_KV + 4 * 512 + g * HD; Vb = a.Z + OFF_KV + 5 * 512 + g * HD; ldk = LDZ; }
    else { Kb = a.Z + OFF_KV + 2 * 512 + g * HD; Vb = a.Z + OFF_KV + 3 * 512 + g * HD; ldk = LDZ; }
    int j0, j1;
    if (MODE == MODE_CMP) { j0 = 0; j1 = (((t0 + 127 - 31) >> 4) >> 6) + 1; }
    else if (MODE == MODE_WIN) { j0 = (t0 - 511) > 0 ? ((t0 - 511) >> 6) : 0; j1 = ((t0 + 127) >> 6) + 1; }
    else { j0 = 0; j1 = (tlast >> 6) + 1; }
    int klo, khi;
    if (MODE == MODE_CMP) { klo = 0; khi = tq >= 31 ? ((tq - 31) >> 4) : -1; }
    else if (MODE == MODE_WIN) { klo = tq - 511; khi = tq; }
    else { klo = 0; khi = rvalid ? tq : -1; }
    float negBC = -a.TAB[512 + (MODE == MODE_CMP ? 0 : (MODE == MODE_SLC ? 1 : 2))];
    bf16x8 qr[8];
    { const bf16_t* Qw = a.Z + (size_t)tq * LDZ + OFF_Q + hq * HD + hi * 8;
#pragma unroll
      for (int d0 = 0; d0 < 8; ++d0) qr[d0] = *reinterpret_cast<const bf16x8*>(Qw + d0 * 16); }
    f32x16 o[4] = {}; float lsum = 0.f;
    unsigned soK[2], soV[2];
#pragma unroll
    for (int i = 0; i < 2; ++i) { const int p = (wid + 8 * i) * 64 + lane;
        { const int row = p >> 4, c = (p & 15) ^ (row & 7); soK[i] = (unsigned)(row * ldk + c * 8) * 2u; }
        { const int sub = p >> 5, within = p & 31, kk = (sub >> 2) * 8 + (within >> 2), c = (sub & 3) * 32 + (within & 3) * 8, k = (kk & ~0xC) | ((kk & 4) << 1) | ((kk & 8) >> 1);
          soV[i] = (unsigned)(k * ldk + c) * 2u; } }
    const int vb0 = (int)(uintptr_t)(LAS char*)ldsL + 16384 + v_rd_base(lane);
#define ISSUE(jt) do { const int _b = ((jt) - j0) & 3; const char* _kp = (const char*)Kb + (size_t)(jt) * KVBLK * ldk * 2; const char* _vp = (const char*)Vb + (size_t)(jt) * KVBLK * ldk * 2; \
    _Pragma("unroll") for (int _i = 0; _i < 2; ++_i) { \
        __builtin_amdgcn_global_load_lds((const unsigned*)(_kp + soK[_i]), (LAS unsigned*)(ldsL + _b * 32768 + (wid + 8 * _i) * 1024), 16, 0, 0); \
        __builtin_amdgcn_global_load_lds((const unsigned*)(_vp + soV[_i]), (LAS unsigned*)(ldsL + _b * 32768 + 16384 + (wid + 8 * _i) * 1024), 16, 0, 0); } } while (0)
    unsigned bmw = 0u;
    if (MODE == MODE_SLC) bmw = a.BM[((size_t)tq * 4 + g) * 8];
    asm volatile("s_waitcnt lgkmcnt(0)" ::: "memory");
    __builtin_amdgcn_s_barrier();
    asm volatile("" ::: "memory");
    ISSUE(j0);
    asm volatile("s_waitcnt vmcnt(4) lgkmcnt(0)" : "+v"(bmw), "+v"(negBC), "+v"(qr[0]), "+v"(qr[1]), "+v"(qr[2]), "+v"(qr[3]), "+v"(qr[4]), "+v"(qr[5]), "+v"(qr[6]), "+v"(qr[7]) :: "memory");
    if (j0 + 1 < j1) ISSUE(j0 + 1); if (j0 + 2 < j1) ISSUE(j0 + 2);
    for (int j = j0; j < j1; ++j) {
        const int buf = (j - j0) & 3;
        if (j + 2 < j1) asm volatile("s_waitcnt vmcnt(8)" ::: "memory"); else if (j + 1 < j1) asm volatile("s_waitcnt vmcnt(4)" ::: "memory"); else asm volatile("s_waitcnt vmcnt(0)" ::: "memory");
        __builtin_amdgcn_s_barrier();
        asm volatile("" ::: "memory");
        if (j + 3 < j1) ISSUE(j + 3);
        int lhi = khi;
        if (MODE == MODE_SLC) { if (!((bmw >> (j & 31)) & 1u)) lhi = -1; }
        const int kb = j * KVBLK;
        const bool l_any = (kb + 63 >= klo) && (kb <= lhi);
        const bool l_full = (kb >= klo) && (kb + 63 <= lhi);
        if (__any(l_any)) {
            f32x16 p0, p1;
            qkt(p0, p1, lds + buf * 32768, qr, r32, hi);
            const bool uni = __all(l_full || !l_any);
            const float off = (uni && !l_any) ? -1.0e30f : negBC;
#pragma unroll
            for (int r = 0; r < 16; ++r) p0[r] = __builtin_amdgcn_exp2f(fmaf(p0[r], SM_C, off));
            if (!uni) {
#pragma unroll
                for (int r = 0; r < 16; ++r) { const int k0i = kb + crow(r, hi); p0[r] = (k0i >= klo && k0i <= lhi) ? p0[r] : 0.f; } }
            float ps = 0.f;
#pragma unroll
            for (int r = 0; r < 16; ++r) ps += p0[r];
            bf16x8 pa0, pa1, pa2, pa3; pack_half(p0, pa0, pa1);
            pv_half<0, true>(o, vb0 + buf * 32768, pa0, pa1, p1, off);
            if (!uni) {
#pragma unroll
                for (int r = 0; r < 16; ++r) { const int k1i = kb + 32 + crow(r, hi); p1[r] = (k1i >= klo && k1i <= lhi) ? p1[r] : 0.f; } }
#pragma unroll
            for (int r = 0; r < 16; ++r) ps += p1[r];
            lsum += ps;
            pack_half(p1, pa2, pa3);
            pv_half<2, false>(o, vb0 + buf * 32768, pa2, pa3, p1, off);
        }
        if (MODE == MODE_SLC) { if (((j + 1) & 31) == 0 && j + 1 < j1) { bmw = a.BM[((size_t)tq * 4 + g) * 8 + ((j + 1) >> 5)]; asm volatile("s_waitcnt vmcnt(0)" : "+v"(bmw) :: "memory"); } }
    }
#undef ISSUE
    lsum += __shfl_xor(lsum, 32);
    const float grow = a.G[(size_t)tq * NGATE + hq * 3 + (MODE == MODE_CMP ? 0 : (MODE == MODE_SLC ? 1 : 2))];
    if (hi == 0) { li_l[r32] = lsum; li_l[32 + r32] = rvalid ? grow : 0.f; }
    if (MODE == MODE_CMP) { if (hi == 0) a.L[(size_t)tq * NH + hq] = lsum; }
    asm volatile("s_waitcnt lgkmcnt(0)" ::: "memory");
#pragma unroll
    for (int hf = 0; hf < 2; ++hf) {
        float gtv[8]; float pvv[8][4];
#pragma unroll
        for (int rr = 0; rr < 8; ++rr) { const int r = hf * 8 + rr;
            const int orow = crow(r, hi); const float lv = li_l[orow]; const float rl = lv > 0.f ? __builtin_amdgcn_rcpf(lv) : 0.f;
            const int t = MODE == MODE_SLC ? t0 + wid * 5 + orow / 6 : t0 + wid * 16 + (orow & 15);
            const int h = MODE == MODE_SLC ? g * HPG + orow % 6 : g * HPG + hp * 2 + (orow >> 4);
            const bool valid = !(MODE == MODE_SLC && (orow >= 30 || t >= S_)); const int tc = valid ? t : 0;
            gtv[rr] = li_l[32 + orow] * rl;
            if (MODE == MODE_SLC) { const bf16_t* oc = (const bf16_t*)a.OACC + (size_t)tc * 3072 + h * HD + r32; const bf16_t* ow = oc + (size_t)S_ * 3072;
#pragma unroll
                for (int d0 = 0; d0 < 4; ++d0) pvv[rr][d0] = bf2f(oc[d0 * 32]) + bf2f(ow[d0 * 32]); }
        }
#pragma unroll
        for (int rr = 0; rr < 8; ++rr) { const int r = hf * 8 + rr;
            const int orow = crow(r, hi);
            const int t = MODE == MODE_SLC ? t0 + wid * 5 + orow / 6 : t0 + wid * 16 + (orow & 15);
            const int h = MODE == MODE_SLC ? g * HPG + orow % 6 : g * HPG + hp * 2 + (orow >> 4);
            if (MODE == MODE_SLC && (orow >= 30 || t >= S_)) continue;
            bf16_t* oa = (bf16_t*)a.OACC + (MODE == MODE_WIN ? (size_t)S_ * 3072 : 0) + (size_t)t * 3072 + h * HD + r32;
#pragma unroll
            for (int d0 = 0; d0 < 4; ++d0) {
                const float v = o[d0][r] * gtv[rr];
                if (MODE != MODE_SLC) oa[d0 * 32] = (bf16_t)(cvt_pk_bf16(v, 0.f) & 0xffffu);
                else a.MIX[(size_t)t * DM + POOLW + h * HD + d0 * 32 + r32] = (bf16_t)(cvt_pk_bf16(pvv[rr][d0] + v, 0.f) & 0xffffu);
            }
        }
    }
}

constexpr int SLC_KPS = 1040, SLC_VPS = 1056, SLC_KIMG = 8 * SLC_KPS, SLC_BUF = SLC_KIMG + 16 * SLC_VPS, SLC_NBUF = 6, LDS_SLCX = SLC_NBUF * SLC_BUF;
static_assert(LDS_SLCX + 3072 <= LDS_MISC, "slc ring overlaps the barrier words");
__device__ __forceinline__ bf16x8 lds_b128(int adr) { return *reinterpret_cast<const LAS bf16x8*>((LAS char*)(unsigned long)(unsigned)adr); }
template <int MODE16>
__device__ __forceinline__ void slc16_unit(const AttnArgs& a, LAS char* ldsL, int ut, int g) {
    constexpr bool WIN16 = MODE16 == 1, CMP16 = MODE16 == 2, DENSE16 = MODE16 != 0;
    char* lds = (char*)ldsL;
    const int tid = threadIdx.x, wid = __builtin_amdgcn_readfirstlane(tid >> 6), lane = tid & 63, fr = lane & 15, fq = lane >> 4;
    float* li_l = (float*)(lds + LDS_SLCX) + wid * 96;
    const int t0 = ut * 64, j0 = WIN16 ? (ut > 8 ? ut - 8 : 0) : 0, j1 = CMP16 ? (((t0 + 63 - 31) >> 4) >> 6) + 1 : ut + 1;
    const bf16_t* Vb = CMP16 ? a.VC + (size_t)g * 1024 * HD : a.Z + OFF_KV + (WIN16 ? 5 : 3) * 512 + g * HD; const long ldk = CMP16 ? HD : LDZ;
    const unsigned char* K8 = (const unsigned char*)a.MIX + ((CMP16 ? WS_K8C : (WIN16 ? WS_K8W : WS_K8)) - WS_MIX) + g * HD;
    int tqv[3];
#pragma unroll
    for (int b = 0; b < 3; ++b) tqv[b] = t0 + wid * 8 + (16 * b + fr) / 6;
#define TQC(b) tqv[b]
#define HQ(b) (g * HPG + (16 * (b) + fr) % 6)
    float negBC = -a.TAB[CMP16 ? 512 : (WIN16 ? 514 : 513)];
    bf16x8 qraw[3][4];
#pragma unroll
    for (int b = 0; b < 3; ++b) { const bf16_t* qp = a.Z + (size_t)TQC(b) * LDZ + OFF_Q + HQ(b) * HD + fq * 32;
#pragma unroll
        for (int ks = 0; ks < 4; ++ks) qraw[b][ks] = *reinterpret_cast<const bf16x8*>(qp + ks * 8); }
    f32x4 o[3][8]; float lsum[3];
#pragma unroll
    for (int b = 0; b < 3; ++b) { lsum[b] = 0.f;
#pragma unroll
        for (int c = 0; c < 8; ++c) o[b][c] = (f32x4){0.f, 0.f, 0.f, 0.f}; }
    const int q4 = fr >> 2, p4 = fr & 3, lbase = (int)(uintptr_t)ldsL;
    const int kaddr0 = lbase + (fr & 7) * SLC_KPS + (fr >> 3) * 128 + fq * 32;
    const int vaddr0 = lbase + SLC_KIMG + (4 * fq + q4) * SLC_VPS + (p4 >> 1) * 16 + (p4 & 1) * 8;
    unsigned so0 = (unsigned)((wid + 16 * (lane >> 4)) * ldk + (lane & 15) * 8) * 2u, so8 = (unsigned)((wid + 8 * (lane >> 3)) * (4 * HD) + (lane & 7) * 16);
#define ISSUE16(jt) do { const int _b = (jt) % SLC_NBUF; const char* _vp = (const char*)Vb + (size_t)(jt) * KVBLK * ldk * 2; asm volatile("" : "+v"(so0), "+v"(so8)); \
    __builtin_amdgcn_global_load_lds((const unsigned*)(K8 + (size_t)(jt) * KVBLK * (4 * HD) + so8), (LAS unsigned*)(ldsL + _b * SLC_BUF + wid * SLC_KPS), 16, 0, 0); \
    _Pragma("unroll") for (int _i = 0; _i < 2; ++_i) \
        __builtin_amdgcn_global_load_lds((const unsigned*)(_vp + _i * (8 * ldk * 2) + so0), (LAS unsigned*)(ldsL + _b * SLC_BUF + SLC_KIMG + (wid + 8 * _i) * SLC_VPS), 16, 0, 0); } while (0)
    unsigned bmw[3];
#pragma unroll
    for (int b = 0; b < 3; ++b) bmw[b] = DENSE16 ? 0xffffffffu : a.BM[((size_t)TQC(b) * 4 + g) * 8];
    asm volatile("s_waitcnt lgkmcnt(0)" ::: "memory");
    __builtin_amdgcn_s_barrier();
    asm volatile("" ::: "memory");
    ISSUE16(j0); if (j0 + 1 < j1) ISSUE16(j0 + 1); if (j0 + 2 < j1) ISSUE16(j0 + 2);
    asm volatile("s_waitcnt vmcnt(0) lgkmcnt(0)" : "+v"(bmw[0]), "+v"(bmw[1]), "+v"(bmw[2]), "+v"(negBC), "+v"(qraw[0][0]), "+v"(qraw[0][1]), "+v"(qraw[0][2]), "+v"(qraw[0][3]),
                 "+v"(qraw[1][0]), "+v"(qraw[1][1]), "+v"(qraw[1][2]), "+v"(qraw[1][3]), "+v"(qraw[2][0]), "+v"(qraw[2][1]), "+v"(qraw[2][2]), "+v"(qraw[2][3]) :: "memory");
    i32x8 qf[3];
#pragma unroll
    for (int b = 0; b < 3; ++b)
#pragma unroll
        for (int ks = 0; ks < 4; ++ks) { const bf16x8 r = qraw[b][ks];
            int p0 = __builtin_amdgcn_cvt_pk_fp8_f32(bf2f((bf16_t)r[0]), bf2f((bf16_t)r[1]), 0, false); p0 = __builtin_amdgcn_cvt_pk_fp8_f32(bf2f((bf16_t)r[2]), bf2f((bf16_t)r[3]), p0, true);
            int p1 = __builtin_amdgcn_cvt_pk_fp8_f32(bf2f((bf16_t)r[4]), bf2f((bf16_t)r[5]), 0, false); p1 = __builtin_amdgcn_cvt_pk_fp8_f32(bf2f((bf16_t)r[6]), bf2f((bf16_t)r[7]), p1, true);
            qf[b][2 * ks] = p0; qf[b][2 * ks + 1] = p1; }
    const int one_scale = 0x7F7F7F7F;
    int kadr = kaddr0 + (j0 % SLC_NBUF) * SLC_BUF, vadr = vaddr0 + (j0 % SLC_NBUF) * SLC_BUF;
    for (int j = j0, jm = 0, buf = j0 % SLC_NBUF; j < j1; ++j) {
        if (jm == 0) {
            asm volatile("s_waitcnt vmcnt(0)" ::: "memory");
            __builtin_amdgcn_s_barrier();
            asm volatile("" ::: "memory");
            if (j + 3 < j1) ISSUE16(j + 3); if (j + 4 < j1) ISSUE16(j + 4); if (j + 5 < j1) ISSUE16(j + 5); }
        const int kb = j * KVBLK;
#define KF16(ks, mt) lds_b128(kadr + 64 * (ks) + 256 * (mt))
#define TRA(dst, off) asm volatile("ds_read_b64_tr_b16 %0, %1 offset:%2" : "=v"(dst) : "v"(vadr), "n"(off))
#define VLOAD(dst, s, h) _Pragma("unroll") for (int _c = 0; _c < 4; ++_c) { TRA(dst[_c][0], 32 * (4 * (h) + _c) + 512 * (s)); TRA(dst[_c][1], 32 * (4 * (h) + _c) + 512 * (s) + 256); }
#define VWAIT(n, d) asm volatile("s_waitcnt lgkmcnt(" #n ")" : "+v"(d[0][0]), "+v"(d[0][1]), "+v"(d[1][0]), "+v"(d[1][1]), "+v"(d[2][0]), "+v"(d[2][1]), "+v"(d[3][0]), "+v"(d[3][1]))
#define PVMMA(src, pa, h) _Pragma("unroll") for (int _c = 0; _c < 4; ++_c) o[b][4 * (h) + _c] = __builtin_amdgcn_mfma_f32_16x16x32_bf16(pa, \
            (bf16x8){src[_c][0][0], src[_c][0][1], src[_c][0][2], src[_c][0][3], src[_c][1][0], src[_c][1][1], src[_c][1][2], src[_c][1][3]}, o[b][4 * (h) + _c], 0, 0, 0);
#define EXPH(h, pw) { if (uni) { _Pragma("unroll") for (int mt = 2 * (h); mt < 2 * (h) + 2; ++mt) _Pragma("unroll") for (int i = 0; i < 4; ++i) { \
                            const float e_ = __builtin_amdgcn_exp2f(fmaf(acc[mt][i], SM_C, off)); acc[mt][i] = e_; ps += e_; } } \
                      else { asm volatile("" ::: "memory"); _Pragma("unroll") for (int mt = 2 * (h); mt < 2 * (h) + 2; ++mt) _Pragma("unroll") for (int i = 0; i < 4; ++i) { \
                            float e_ = __builtin_amdgcn_exp2f(fmaf(acc[mt][i], SM_C, off)); e_ = (16 * mt + i <= lim4 && (!WIN16 || 16 * mt + i >= lim4 - 511)) ? e_ : 0.f; acc[mt][i] = e_; ps += e_; } } \
                      pw.x = cvt_pk_bf16(acc[2 * (h)][0], acc[2 * (h)][1]); pw.y = cvt_pk_bf16(acc[2 * (h)][2], acc[2 * (h)][3]); \
                      pw.z = cvt_pk_bf16(acc[2 * (h) + 1][0], acc[2 * (h) + 1][1]); pw.w = cvt_pk_bf16(acc[2 * (h) + 1][2], acc[2 * (h) + 1][3]); }
        if constexpr (DENSE16) {
            int limv[3]; bool lany[3], lfull[3];
#pragma unroll
            for (int b = 0; b < 3; ++b) { limv[b] = (CMP16 ? ((tqv[b] - 31) >> 4) : tqv[b]) - kb; lany[b] = limv[b] >= 0 && (!WIN16 || limv[b] <= 511 + 63); lfull[b] = limv[b] >= 63 && (!WIN16 || limv[b] <= 511); }
            if (__any(lany[0] || lany[1] || lany[2])) {
                f32x4 acc3[3][4]; i32x4 kr[8]; s16x4 va[4][2], vc[4][2];
#define KRD(i) asm volatile("ds_read_b128 %0, %1 offset:%2" : "=v"(kr[i]) : "v"(kadr), "n"(256 * ((i) >> 1) + 16 * ((i) & 1)))
                KRD(0); KRD(1); KRD(2); KRD(3); KRD(4); KRD(5); KRD(6); KRD(7);
#define KMM3(mt, n) { asm volatile("s_waitcnt lgkmcnt(" #n ")" : "+v"(kr[2 * (mt)]), "+v"(kr[2 * (mt) + 1])); \
                     const i32x8 kf_ = __builtin_shufflevector(kr[2 * (mt)], kr[2 * (mt) + 1], 0, 1, 2, 3, 4, 5, 6, 7); \
                     _Pragma("unroll") for (int b_ = 0; b_ < 3; ++b_) \
                     asm volatile("v_mfma_scale_f32_16x16x128_f8f6f4 %0, %1, %2, 0, %3, %3 op_sel_hi:[0,0,0]" : "=v"(acc3[b_][mt]) : "v"(kf_), "v"(qf[b_]), "v"(one_scale)); }
                KMM3(0, 6) KMM3(1, 4) KMM3(2, 2) KMM3(3, 0)
                __builtin_amdgcn_sched_barrier(0);
#undef KRD
#undef KMM3
                VLOAD(va, 0, 0)
                asm volatile("s_nop 7" : "+v"(acc3[0][0]), "+v"(acc3[0][1]), "+v"(acc3[0][2]), "+v"(acc3[0][3]), "+v"(acc3[1][0]), "+v"(acc3[1][1]), "+v"(acc3[1][2]), "+v"(acc3[1][3]),
                                  "+v"(acc3[2][0]), "+v"(acc3[2][1]), "+v"(acc3[2][2]), "+v"(acc3[2][3]));
                bf16x8 pa3[3][2];
#pragma unroll
                for (int b = 0; b < 3; ++b) {
                    const bool l_any = lany[b], l_full = lfull[b]; const int lim = limv[b];
                    const bool uni = __all(l_full || !l_any);
                    const float off = (uni && !l_any) ? -1.0e30f : negBC;
                    const int lim4 = l_any ? lim - 4 * fq : -1;
                    float ps = 0.f;
                    if (uni) {
#pragma unroll
                        for (int mt = 0; mt < 4; ++mt)
#pragma unroll
                            for (int i = 0; i < 4; ++i) { const float e_ = __builtin_amdgcn_exp2f(fmaf(acc3[b][mt][i], SM_C, off)); acc3[b][mt][i] = e_; ps += e_; } }
                    else { asm volatile("" ::: "memory");
#pragma unroll
                        for (int mt = 0; mt < 4; ++mt)
#pragma unroll
                            for (int i = 0; i < 4; ++i) { float e_ = __builtin_amdgcn_exp2f(fmaf(acc3[b][mt][i], SM_C, off)); e_ = (16 * mt + i <= lim4 && (!WIN16 || 16 * mt + i >= lim4 - 511)) ? e_ : 0.f; acc3[b][mt][i] = e_; ps += e_; } }
                    lsum[b] += ps;
#pragma unroll
                    for (int s = 0; s < 2; ++s) { u32x4 pw; pw.x = cvt_pk_bf16(acc3[b][2 * s][0], acc3[b][2 * s][1]); pw.y = cvt_pk_bf16(acc3[b][2 * s][2], acc3[b][2 * s][3]);
                        pw.z = cvt_pk_bf16(acc3[b][2 * s + 1][0], acc3[b][2 * s + 1][1]); pw.w = cvt_pk_bf16(acc3[b][2 * s + 1][2], acc3[b][2 * s + 1][3]); pa3[b][s] = *reinterpret_cast<bf16x8*>(&pw); }
                }
#define PV3(src, s, h) _Pragma("unroll") for (int _c = 0; _c < 4; ++_c) { const bf16x8 vf_ = (bf16x8){src[_c][0][0], src[_c][0][1], src[_c][0][2], src[_c][0][3], src[_c][1][0], src[_c][1][1], src[_c][1][2], src[_c][1][3]}; \
                    _Pragma("unroll") for (int b_ = 0; b_ < 3; ++b_) o[b_][4 * (h) + _c] = __builtin_amdgcn_mfma_f32_16x16x32_bf16(pa3[b_][s], vf_, o[b_][4 * (h) + _c], 0, 0, 0); }
                __builtin_amdgcn_sched_barrier(0);
                VLOAD(vc, 0, 1)
                VWAIT(8, va);
                PV3(va, 0, 0)
                __builtin_amdgcn_sched_barrier(0);
                VLOAD(va, 1, 0)
                VWAIT(8, vc);
                PV3(vc, 0, 1)
                __builtin_amdgcn_sched_barrier(0);
                VLOAD(vc, 1, 1)
                VWAIT(8, va);
                PV3(va, 1, 0)
                __builtin_amdgcn_sched_barrier(0);
                VWAIT(0, vc);
                PV3(vc, 1, 1)
                __builtin_amdgcn_sched_barrier(0);
#undef PV3
            }
        } else
#pragma unroll
        for (int b = 0; b < 3; ++b) {
            const bool sel = DENSE16 ? true : (bool)((bmw[b] >> (j & 31)) & 1u);
            const int lim = tqv[b] - kb;
            const bool l_any = sel && lim >= 0 && (!WIN16 || lim <= 511 + 63), l_full = sel && lim >= 63 && (!WIN16 || lim <= 511);
            if (__any(l_any)) {
                f32x4 acc[4]; i32x4 kr[8]; s16x4 va[4][2], vc[4][2];
#define KRD(i) asm volatile("ds_read_b128 %0, %1 offset:%2" : "=v"(kr[i]) : "v"(kadr), "n"(256 * ((i) >> 1) + 16 * ((i) & 1)))
                KRD(0); KRD(1); KRD(2); KRD(3); KRD(4); KRD(5); KRD(6); KRD(7);
#define KMM(mt, n) { asm volatile("s_waitcnt lgkmcnt(" #n ")" : "+v"(kr[2 * (mt)]), "+v"(kr[2 * (mt) + 1])); \
                     const i32x8 kf_ = __builtin_shufflevector(kr[2 * (mt)], kr[2 * (mt) + 1], 0, 1, 2, 3, 4, 5, 6, 7); \
                     asm volatile("v_mfma_scale_f32_16x16x128_f8f6f4 %0, %1, %2, 0, %3, %3 op_sel_hi:[0,0,0]" : "=v"(acc[mt]) : "v"(kf_), "v"(qf[b]), "v"(one_scale)); }
                KMM(0, 6) KMM(1, 4) KMM(2, 2) KMM(3, 0)
                __builtin_amdgcn_sched_barrier(0);
#undef KRD
#undef KMM
                VLOAD(va, 0, 0)
                VLOAD(vc, 0, 1)
                asm volatile("" : "+v"(acc[0]), "+v"(acc[1]), "+v"(acc[2]), "+v"(acc[3]));
                const bool uni = __all(l_full || !l_any);
                const float off = (uni && !l_any) ? -1.0e30f : negBC;
                const int lim4 = l_any ? lim - 4 * fq : -1;
                float ps = 0.f;
                u32x4 pw0, pw1;
                EXPH(0, pw0)
                const bf16x8 pa0 = *reinterpret_cast<bf16x8*>(&pw0);
                __builtin_amdgcn_sched_barrier(0);
                VWAIT(8, va);
                PVMMA(va, pa0, 0)
                __builtin_amdgcn_sched_barrier(0);
                VLOAD(va, 1, 0)
                VWAIT(8, vc);
                PVMMA(vc, pa0, 1)
                __builtin_amdgcn_sched_barrier(0);
                VLOAD(vc, 1, 1)
                EXPH(1, pw1)
                const bf16x8 pa1 = *reinterpret_cast<bf16x8*>(&pw1);
                lsum[b] += ps;
                __builtin_amdgcn_sched_barrier(0);
                VWAIT(8, va);
                PVMMA(va, pa1, 0)
                __builtin_amdgcn_sched_barrier(0);
                VWAIT(0, vc);
                PVMMA(vc, pa1, 1)
                __builtin_amdgcn_sched_barrier(0);
            }
        }
#undef TRA
#undef VWAIT
#undef EXPH
#undef KF16
#undef VLOAD
#undef PVMMA
        if (!DENSE16 && ((j + 1) & 31) == 0 && j + 1 < j1) {
#pragma unroll
            for (int b = 0; b < 3; ++b) bmw[b] = a.BM[((size_t)TQC(b) * 4 + g) * 8 + ((j + 1) >> 5)];
            asm volatile("s_waitcnt vmcnt(0)" : "+v"(bmw[0]), "+v"(bmw[1]), "+v"(bmw[2]) :: "memory"); }
        { const int step = buf == SLC_NBUF - 1 ? -(SLC_NBUF - 1) * SLC_BUF : SLC_BUF; kadr += step; vadr += step; asm volatile("" : "+v"(kadr), "+v"(vadr)); buf = buf == SLC_NBUF - 1 ? 0 : buf + 1; jm = jm == 2 ? 0 : jm + 1; }
    }
#undef ISSUE16
    int fqe = fq, fre = fr; asm volatile("" : "+v"(fqe), "+v"(fre));
    float grow[3];
#pragma unroll
    for (int b = 0; b < 3; ++b) grow[b] = a.G[(size_t)TQC(b) * NGATE + (g * HPG + (16 * b + fre) % 6) * 3 + (CMP16 ? 0 : (WIN16 ? 2 : 1))];
#pragma unroll
    for (int b = 0; b < 3; ++b) { float ls = lsum[b]; ls += __shfl_xor(ls, 16); ls += __shfl_xor(ls, 32);
        if (fqe == 0) { li_l[b * 32 + fre] = ls; li_l[b * 32 + 16 + fre] = grow[b]; if (CMP16) a.L[(size_t)TQC(b) * NH + g * HPG + (16 * b + fre) % 6] = ls; } }
    asm volatile("s_waitcnt lgkmcnt(0)" ::: "memory");
#pragma unroll
    for (int b = 0; b < 3; ++b) {
        float pv_[4][8]; float gtv[4];
#pragma unroll
        for (int i = 0; i < 4; ++i) { const int q = 4 * fqe + i, R = 16 * b + q; const float lv = li_l[b * 32 + q]; gtv[i] = li_l[b * 32 + 16 + q] * (lv > 0.f ? __builtin_amdgcn_rcpf(lv) : 0.f);
            const int t = t0 + wid * 8 + R / 6, h = g * HPG + R % 6;
            const bf16_t* oc = (const bf16_t*)a.OACC + (size_t)t * 3072 + h * HD + fre; const bf16_t* ow = oc + (size_t)S_ * 3072;
            bf16_t c_[8], w_[8];
            if (!DENSE16) {
#pragma unroll
                for (int c = 0; c < 8; ++c) { c_[c] = oc[c * 16]; w_[c] = ow[c * 16]; }
#pragma unroll
                for (int c = 0; c < 8; ++c) pv_[i][c] = bf2f(c_[c]) + bf2f(w_[c]); } }
#pragma unroll
        for (int i = 0; i < 4; ++i) { const int R = 16 * b + 4 * fqe + i; const int t = t0 + wid * 8 + R / 6, h = g * HPG + R % 6;
            if (DENSE16) { bf16_t* wp = (bf16_t*)a.OACC + (WIN16 ? (size_t)S_ * 3072 : 0) + (size_t)t * 3072 + h * HD + fre;
#pragma unroll
                for (int c = 0; c < 8; ++c) wp[c * 16] = (bf16_t)(cvt_pk_bf16(o[b][c][i] * gtv[i], 0.f) & 0xffffu); }
            else { unsigned char* mp = (unsigned char*)a.MIX + (size_t)t * DM * 2 + 2 * POOLW + h * HD + fre;
#pragma unroll
                for (int c = 0; c < 8; ++c) mp[c * 16] = (unsigned char)(__builtin_amdgcn_cvt_pk_fp8_f32((pv_[i][c] + o[b][c][i] * gtv[i]) * 2.0f, 0.f, 0, false) & 0xff); } }
    }
#undef TQC
#undef HQ
}

__device__ __forceinline__ void imp_task(const AttnArgs& a, float* IMPP, float* IMPF, int tqi, int g) {
    const int lane = threadIdx.x & 63, fr = lane & 15, fq = lane >> 4;
    const int t = tqi * 16 + fr;
    const int tmax = tqi * 16 + 15;
    if (tmax < 31) return;
    const int lim = t >= 31 ? ((t - 31) >> 4) : -1;
    const int nstep = ((((tmax - 31) >> 4) >> 6) + 1) * 4;
    const float negBC = -a.TAB[512];
    bf16x8 qf[HPG][4]; float rl[HPG];
#pragma unroll
    for (int h = 0; h < HPG; ++h) {
        const bf16_t* qp = a.Z + (size_t)t * LDZ + OFF_Q + (g * HPG + h) * HD + fq * 8;
#pragma unroll
        for (int ks = 0; ks < 4; ++ks) qf[h][ks] = *reinterpret_cast<const bf16x8*>(qp + ks * 32);
        const float lv = a.L[(size_t)t * NH + g * HPG + h]; rl[h] = negBC + (lv > 0.f ? -__builtin_amdgcn_logf(lv) : -1.0e30f);
    }
    const bf16_t* kbase = a.KC + (size_t)g * 1024 * HD + (size_t)fr * HD + fq * 8;
    bf16x8 kf[4], kn[4], kn2[4];
#pragma unroll
    for (int ks = 0; ks < 4; ++ks) { kf[ks] = *reinterpret_cast<const bf16x8*>(kbase + ks * 32); kn[ks] = *reinterpret_cast<const bf16x8*>(kbase + (size_t)(nstep > 1 ? 1 : 0) * 16 * HD + ks * 32); }
    float* op = IMPP + ((size_t)t * 4 + g) * 256 + fq; float* of = IMPF + ((size_t)t * 4 + g) * 256 + fq;
    for (int st = 0; st < nstep; ++st) {
        const int sn = (st + 2 < nstep) ? st + 2 : nstep - 1;
#pragma unroll
        for (int ks = 0; ks < 4; ++ks) kn2[ks] = *reinterpret_cast<const bf16x8*>(kbase + (size_t)sn * 16 * HD + ks * 32);
        f32x4 imp4 = {0.f, 0.f, 0.f, 0.f};
        const int n0 = st * 16 + fq * 4;
        const bool full = __all(st * 16 + 15 <= lim);
#pragma unroll
        for (int h = 0; h < HPG; ++h) {
            f32x4 acc = {0.f, 0.f, 0.f, 0.f};
#pragma unroll
            for (int ks = 0; ks < 4; ++ks) acc = __builtin_amdgcn_mfma_f32_16x16x32_bf16(kf[ks], qf[h][ks], acc, 0, 0, 0);
            if (full) {
#pragma unroll
                for (int i = 0; i < 4; ++i) imp4[i] += __builtin_amdgcn_exp2f(fmaf(acc[i], SM_C, rl[h])); }
            else {
#pragma unroll
                for (int i = 0; i < 4; ++i) { const float e = __builtin_amdgcn_exp2f(fmaf(acc[i], SM_C, rl[h])); imp4[i] += (n0 + i <= lim) ? e : 0.f; } }
        }
        op[st * 4] = imp4[0] + 2.0f * (imp4[1] + imp4[2] + imp4[3]);
        of[st * 4] = imp4[0];
#pragma unroll
        for (int ks = 0; ks < 4; ++ks) { kf[ks] = kn[ks]; kn[ks] = kn2[ks]; }
    }
}

__device__ __forceinline__ void topk_load(const float* IMPP, const float* IMPF, int t, int g, f32x4& pp, f32x4& ff) {
    const int lane = threadIdx.x & 63, cur = t >> 6, jb = lane * 4;
    pp = (f32x4){0.f, 0.f, 0.f, 0.f}; ff = pp;
    if (cur > 15 && jb <= cur) { const size_t base = ((size_t)t * 4 + g) * 256; pp = *(const f32x4*)(IMPP + base + jb); ff = *(const f32x4*)(IMPF + base + jb); }
}
__device__ __forceinline__ void topk_task(const f32x4 pp, const f32x4 ff, unsigned* BM, int t, int g) {
    const int lane = threadIdx.x & 63;
    const int cur = t >> 6;
    unsigned nib = 0u;
    if (cur <= 15) { const int jb = lane * 4;
#pragma unroll
        for (int c = 0; c < 4; ++c) if (jb + c <= cur) nib |= 1u << c; }
    else {
        const int jb = lane * 4;
        unsigned key[4];
        {
            float fnext = __shfl_down(ff[0], 1);
            if (lane == 63) fnext = 0.f;
            const float v0 = pp[0] + ff[1], v1 = pp[1] + ff[2], v2 = pp[2] + ff[3], v3 = pp[3] + fnext;
            key[0] = (jb + 0 >= 1 && jb + 0 <= cur - 2) ? __float_as_uint(fmaxf(v0, 0.f)) + 1u : 0u;
            key[1] = (jb + 1 >= 1 && jb + 1 <= cur - 2) ? __float_as_uint(fmaxf(v1, 0.f)) + 1u : 0u;
            key[2] = (jb + 2 >= 1 && jb + 2 <= cur - 2) ? __float_as_uint(fmaxf(v2, 0.f)) + 1u : 0u;
            key[3] = (jb + 3 >= 1 && jb + 3 <= cur - 2) ? __float_as_uint(fmaxf(v3, 0.f)) + 1u : 0u;
        }
        unsigned prefix = 0u; bool exact = false;
        for (int b = 30; b >= 0; --b) {
            const unsigned trial = prefix | (1u << b);
            const int cnt = __popcll(__ballot(key[0] >= trial)) + __popcll(__ballot(key[1] >= trial)) + __popcll(__ballot(key[2] >= trial)) + __popcll(__ballot(key[3] >= trial));
            if (cnt >= 13) { prefix = trial; if (cnt == 13) { exact = true; break; } }
        }
#pragma unroll
        for (int c = 0; c < 4; ++c) if (exact ? (key[c] >= prefix) : (key[c] > prefix)) nib |= 1u << c;
        if (!exact) {
            int need = 13 - (__popcll(__ballot(key[0] > prefix)) + __popcll(__ballot(key[1] > prefix)) + __popcll(__ballot(key[2] > prefix)) + __popcll(__ballot(key[3] > prefix)));
            unsigned tie = 0u;
#pragma unroll
            for (int c = 0; c < 4; ++c) if (key[c] == prefix) tie |= 1u << c;
            for (int guard = 0; need > 0 && guard < 16; ++guard) {
                const unsigned long long any = __ballot(tie != 0u);
                if (any == 0ull) break;
                const int L = __builtin_ctzll(any);
                if (lane == L) { const unsigned low = tie & (0u - tie); nib |= low; tie ^= low; }
                --need;
            }
        }
        if (lane == 0) nib |= 1u;
        if (lane == (cur >> 2)) nib |= 1u << (cur & 3);
        if (lane == ((cur - 1) >> 2)) nib |= 1u << ((cur - 1) & 3);
    }
    unsigned x = nib << (4 * (lane & 7));
    x |= __shfl_xor(x, 1); x |= __shfl_xor(x, 2); x |= __shfl_xor(x, 4);
    if ((lane & 7) == 0) BM[((size_t)t * 4 + g) * 8 + (lane >> 3)] = x;
}
#undef KSWZ
}

template <bool FFN_REMAP = false>
__device__ __forceinline__ void convT(const float* __restrict__ src0, int K, int N, bf16_t* __restrict__ dst, int ldd, LAS float* tile, int bid, int nb, int Nfull = 0, int n0 = 0, const float* __restrict__ kscale = nullptr) {
    const float* __restrict__ src = src0 + n0; if (Nfull == 0) Nfull = N;
    const int tid = threadIdx.x, tk = K >> 6, tn = (N + 63) >> 6, total = tk * tn;
    const int r = tid >> 4, c4 = (tid & 15) * 4;
    f32x4 v[2] = {{0.f, 0.f, 0.f, 0.f}, {0.f, 0.f, 0.f, 0.f}}, vn[2];
    if (bid < total) { const int nti = bid % tn, kti = bid / tn, ng = nti * 64 + c4;
#pragma unroll
        for (int h = 0; h < 2; ++h) if (ng < N) v[h] = *(const f32x4*)(src + (size_t)(kti * 64 + r + h * 32) * Nfull + ng); }
    for (int idx = bid; idx < total; idx += nb) {
        const int nti = idx % tn, kti = idx / tn;
#pragma unroll
        for (int h = 0; h < 2; ++h) { LAS float* tp = tile + (r + h * 32) * 65 + c4; tp[0] = v[h][0]; tp[1] = v[h][1]; tp[2] = v[h][2]; tp[3] = v[h][3]; }
        {
            const int nx = idx + nb; vn[0] = (f32x4){0.f, 0.f, 0.f, 0.f}; vn[1] = vn[0];
            if (nx < total) { const int nti2 = nx % tn, kti2 = nx / tn, ng2 = nti2 * 64 + c4;
#pragma unroll
                for (int h = 0; h < 2; ++h) if (ng2 < N) vn[h] = *(const f32x4*)(src + (size_t)(kti2 * 64 + r + h * 32) * Nfull + ng2); } }
        __syncthreads();
        const int n = tid >> 3, k8 = (tid & 7) * 8, ngl = nti * 64 + n;
        float e[8];
#pragma unroll
        for (int i = 0; i < 8; ++i) e[i] = tile[(k8 + i) * 65 + n];
        if (kscale) { const f32x4 s0 = *(const f32x4*)(kscale + kti * 64 + k8), s1 = *(const f32x4*)(kscale + kti * 64 + k8 + 4);
            e[0] *= s0[0]; e[1] *= s0[1]; e[2] *= s0[2]; e[3] *= s0[3]; e[4] *= s1[0]; e[5] *= s1[1]; e[6] *= s1[2]; e[7] *= s1[3]; }
        if (ngl < N) { u32x4 w; w.x = cvt_pk_bf16(e[0], e[1]); w.y = cvt_pk_bf16(e[2], e[3]); w.z = cvt_pk_bf16(e[4], e[5]); w.w = cvt_pk_bf16(e[6], e[7]);
            int drow = ngl; if (FFN_REMAP) { const int up = ngl >= DFF ? 1 : 0, f = ngl - up * DFF; drow = (f >> 7) * 256 + up * 128 + (f & 127); }
            *(u32x4*)(dst + (size_t)drow * ldd + kti * 64 + k8) = w; }
        __syncthreads();
        v[0] = vn[0]; v[1] = vn[1];
    }
}
__device__ __forceinline__ void convT_wo(const float* __restrict__ src0, int K, int N, bf16_t* __restrict__ dst, int ldd, LAS float* tile, int bid, int nb) { const int n0 = 0; int Nfull = 0;
    const float* __restrict__ src = src0 + n0; if (Nfull == 0) Nfull = N;
    const int tid = threadIdx.x, tk = K >> 6, tn = (N + 63) >> 6, total = tk * tn;
    const int r = tid >> 4, c4 = (tid & 15) * 4;
    f32x4 v[2] = {{0.f, 0.f, 0.f, 0.f}, {0.f, 0.f, 0.f, 0.f}}, vn[2];
    if (bid < total) { const int nti = bid % tn, kti = bid / tn, ng = nti * 64 + c4;
#pragma unroll
        for (int h = 0; h < 2; ++h) if (ng < N) v[h] = *(const f32x4*)(src + (size_t)(kti * 64 + r + h * 32) * Nfull + ng); }
    for (int idx = bid; idx < total; idx += nb) {
        const int nti = idx % tn, kti = idx / tn;
#pragma unroll
        for (int h = 0; h < 2; ++h) { LAS float* tp = tile + (r + h * 32) * 65 + c4; tp[0] = v[h][0]; tp[1] = v[h][1]; tp[2] = v[h][2]; tp[3] = v[h][3]; }
        {
            const int nx = idx + nb; vn[0] = (f32x4){0.f, 0.f, 0.f, 0.f}; vn[1] = vn[0];
            if (nx < total) { const int nti2 = nx % tn, kti2 = nx / tn, ng2 = nti2 * 64 + c4;
#pragma unroll
                for (int h = 0; h < 2; ++h) if (ng2 < N) vn[h] = *(const f32x4*)(src + (size_t)(kti2 * 64 + r + h * 32) * Nfull + ng2); } }
        __syncthreads();
        const int n = tid >> 3, k8 = (tid & 7) * 8, ngl = nti * 64 + n;
        float e[8];
#pragma unroll
        for (int i = 0; i < 8; ++i) e[i] = tile[(k8 + i) * 65 + n];
        if (ngl < N) {
            if (kti < POOLW / 64) { u32x4 w; w.x = cvt_pk_bf16(e[0] * 128.f, e[1] * 128.f); w.y = cvt_pk_bf16(e[2] * 128.f, e[3] * 128.f); w.z = cvt_pk_bf16(e[4] * 128.f, e[5] * 128.f); w.w = cvt_pk_bf16(e[6] * 128.f, e[7] * 128.f);
                *(u32x4*)(dst + (size_t)ngl * ldd + kti * 64 + k8) = w; }
            else { int p0 = __builtin_amdgcn_cvt_pk_fp8_f32(e[0] * 64.f, e[1] * 64.f, 0, false); p0 = __builtin_amdgcn_cvt_pk_fp8_f32(e[2] * 64.f, e[3] * 64.f, p0, true);
                int p1 = __builtin_amdgcn_cvt_pk_fp8_f32(e[4] * 64.f, e[5] * 64.f, 0, false); p1 = __builtin_amdgcn_cvt_pk_fp8_f32(e[6] * 64.f, e[7] * 64.f, p1, true);
                *(u32x2*)((unsigned char*)dst + (size_t)ngl * ldd * 2 + 2 * POOLW + (kti * 64 - POOLW) + k8) = (u32x2){(unsigned)p0, (unsigned)p1}; } }
        __syncthreads();
        v[0] = vn[0]; v[1] = vn[1];
    }
}
__device__ __forceinline__ void convT8(const float* __restrict__ src0, int K, int N, unsigned char* __restrict__ dst, int ldd, float scale, LAS float* tile, int bid, int nb, int Nfull = 0, int n0 = 0) {
    const float* __restrict__ src = src0 + n0; if (Nfull == 0) Nfull = N;
    const int tid = threadIdx.x, tk = K >> 6, tn = (N + 63) >> 6, total = tk * tn;
    const int r = tid >> 4, c4 = (tid & 15) * 4;
    f32x4 v[2] = {{0.f, 0.f, 0.f, 0.f}, {0.f, 0.f, 0.f, 0.f}}, vn[2];
    if (bid < total) { const int nti = bid % tn, kti = bid / tn, ng = nti * 64 + c4;
#pragma unroll
        for (int h = 0; h < 2; ++h) if (ng < N) v[h] = *(const f32x4*)(src + (size_t)(kti * 64 + r + h * 32) * Nfull + ng); }
    for (int idx = bid; idx < total; idx += nb) {
        const int nti = idx % tn, kti = idx / tn;
#pragma unroll
        for (int h = 0; h < 2; ++h) { LAS float* tp = tile + (r + h * 32) * 65 + c4; tp[0] = v[h][0]; tp[1] = v[h][1]; tp[2] = v[h][2]; tp[3] = v[h][3]; }
        { const int nx = idx + nb; vn[0] = (f32x4){0.f, 0.f, 0.f, 0.f}; vn[1] = vn[0];
            if (nx < total) { const int nti2 = nx % tn, kti2 = nx / tn, ng2 = nti2 * 64 + c4;
#pragma unroll
                for (int h = 0; h < 2; ++h) if (ng2 < N) vn[h] = *(const f32x4*)(src + (size_t)(kti2 * 64 + r + h * 32) * Nfull + ng2); } }
        __syncthreads();
        const int n = tid >> 3, k8 = (tid & 7) * 8, ngl = nti * 64 + n;
        float e[8];
#pragma unroll
        for (int i = 0; i < 8; ++i) e[i] = tile[(k8 + i) * 65 + n] * scale;
        if (ngl < N) { int p0 = __builtin_amdgcn_cvt_pk_fp8_f32(e[0], e[1], 0, false); p0 = __builtin_amdgcn_cvt_pk_fp8_f32(e[2], e[3], p0, true);
            int p1 = __builtin_amdgcn_cvt_pk_fp8_f32(e[4], e[5], 0, false); p1 = __builtin_amdgcn_cvt_pk_fp8_f32(e[6], e[7], p1, true);
            *(u32x2*)(dst + (size_t)ngl * ldd + kti * 64 + k8) = (u32x2){(unsigned)p0, (unsigned)p1}; }
        __syncthreads();
        v[0] = vn[0]; v[1] = vn[1];
    }
}
__device__ __forceinline__ void rmsnorm_rows(const float* __restrict__ src, const float* __restrict__ w, bf16_t* __restrict__ dst, int rows, int gw, int nw, unsigned char* __restrict__ dst8 = nullptr) {
    const int lane = threadIdx.x & 63;
    f32x4 v[16], vn[16];
    if (gw < rows) { const f32x4* sp = (const f32x4*)(src + (size_t)gw * DM);
#pragma unroll
        for (int i = 0; i < 16; ++i) v[i] = sp[lane + 64 * i]; }
    for (int row = gw; row < rows; row += nw) {
        const int nr = row + nw < rows ? row + nw : row;
        { const f32x4* sp = (const f32x4*)(src + (size_t)nr * DM);
#pragma unroll
          for (int i = 0; i < 16; ++i) vn[i] = sp[lane + 64 * i]; }
        float ss = 0.f;
#pragma unroll
        for (int i = 0; i < 16; ++i) ss += v[i][0] * v[i][0] + v[i][1] * v[i][1] + v[i][2] * v[i][2] + v[i][3] * v[i][3];
        ss = wave_sum(ss);
        const float rstd = rsqrtf(ss * (1.0f / DM) + EPS);
#pragma unroll
        for (int i = 0; i < 16; ++i) { const f32x4 ww = ((const f32x4*)w)[lane + 64 * i];
            u32x2 o; o.x = cvt_pk_bf16(v[i][0] * rstd * ww[0], v[i][1] * rstd * ww[1]); o.y = cvt_pk_bf16(v[i][2] * rstd * ww[2], v[i][3] * rstd * ww[3]);
            *(u32x2*)(dst + (size_t)row * DM + (lane + 64 * i) * 4) = o;
            if (dst8) { int pk = __builtin_amdgcn_cvt_pk_fp8_f32(v[i][0] * rstd * ww[0], v[i][1] * rstd * ww[1], 0, false); pk = __builtin_amdgcn_cvt_pk_fp8_f32(v[i][2] * rstd * ww[2], v[i][3] * rstd * ww[3], pk, true);
                *(int*)(dst8 + (size_t)row * DM + (lane + 64 * i) * 4) = pk; } }
#pragma unroll
        for (int i = 0; i < 16; ++i) v[i] = vn[i];
    }
}

struct Ptrs {
    bf16_t *Win, *Wo, *Wfi, *Wfo, *Wg, *Wple, *Wpool, *Wc1k, *Wc1v, *XN, *PB, *Z, *M, *KC, *VC, *MIX, *ACT, *ERAW;
    float *COS, *SIN, *TAB, *G, *H1, *L, *OACC, *IMPP, *IMPF, *ERSTD; unsigned* BM;
};

__device__ __forceinline__ void phase_prologue(const Params& P, const Ptrs& W, LAS unsigned char* lds) {
    const int bid = blockIdx.x, nb = gridDim.x, tid = threadIdx.x, lane = tid & 63, wv = tid >> 6;
    const int gw = bid * NWAVES + wv, nw = nb * NWAVES; const size_t gt = (size_t)bid * NTHREADS + tid, ntot = (size_t)nb * NTHREADS;
    LAS float* tile = (LAS float*)lds;
    rmsnorm_rows(P.x, P.norm1_w, W.XN, S_, gw, nw, P.ws + WS_XN8);
    convT(P.w_in, DM, POOLW, W.Win, DM, tile, bid, nb, INW, 0);
    convT(P.w_in, DM, INW - OFF_G, W.Win + (size_t)OFF_G * DM, DM, tile, bid, nb, INW, OFF_G);
    convT8(P.w_in, DM, OFF_G - POOLW, P.ws + WS_WIN8, DM, WG8_SCALE, tile, bid, nb, INW, POOLW);
    for (size_t i = gt; i < (size_t)(LDZ - INW) * DM / 8; i += ntot) *(u32x4*)(W.Win + (size_t)INW * DM + i * 8) = (u32x4){0u, 0u, 0u, 0u};
    convT_wo(P.w_o, DM, DM, W.Wo, DM, tile, bid, nb);
    convT<true>(P.w_ffn_in, DM, NFI, W.Wfi, DM, tile, bid, nb, 0, 0, P.norm2_w);
    for (size_t i = gt; i < (size_t)2 * DM / 8; i += ntot) *(u32x4*)(W.XN - 2 * DM + i * 8) = (u32x4){0u, 0u, 0u, 0u};
    convT(P.w_ffn_out, DFF, DM, W.Wfo, DFF, tile, bid, nb);
    convT8(P.w_ple_gate, DM, DM, (unsigned char*)W.Wg, DM, WG8_SCALE, tile, bid, nb);
    convT(P.w_ple_proj, PLE, DM, W.Wple, PLE, tile, bid, nb);
    for (int g = 0; g < 4; ++g) convT(P.w_pool + (size_t)g * 65536, 256, 256, W.Wpool + (size_t)g * 65536, 256, tile, bid, nb);
    convT(P.cmp_k_w1, 4096, 256, W.Wc1k, 4096, tile, bid, nb);
    convT(P.cmp_v_w1, 4096, 256, W.Wc1v, 4096, tile, bid, nb);
    { constexpr size_t NP8 = (size_t)S_ * PLE / 8;
      for (size_t ib = gt; ib < NP8; ib += 4 * ntot) { f32x4 av[4], bv[4];
#pragma unroll
          for (int k = 0; k < 4; ++k) { size_t i = ib + k * ntot; if (i >= NP8) i = NP8 - 1; av[k] = *(const f32x4*)(P.p + i * 8); bv[k] = *(const f32x4*)(P.p + i * 8 + 4); }
#pragma unroll
          for (int k = 0; k < 4; ++k) { const size_t i = ib + k * ntot; if (i < NP8) { u32x4 w; w.x = cvt_pk_bf16(av[k][0], av[k][1]); w.y = cvt_pk_bf16(av[k][2], av[k][3]); w.z = cvt_pk_bf16(bv[k][0], bv[k][1]); w.w = cvt_pk_bf16(bv[k][2], bv[k][3]); *(u32x4*)(W.PB + i * 8) = w; } } } }
    for (size_t i = gt; i < (size_t)S_ * 16; i += ntot) { const int t = (int)(i >> 4), fi = (int)(i & 15);
        const float inv = exp2f(-(float)fi * (18.931568569324174f / 16.0f)); const float ang = (float)P.positions[t] * inv;
        const double ad = (double)ang; const double kk = rint(ad * 0.15915494309189535); const float rf = (float)(ad - kk * 6.283185307179586);
        W.COS[i] = __cosf(rf); W.SIN[i] = __sinf(rf); }
    for (int task = gw; task < 128; task += nw) { const int which = task >> 6, r0 = (task & 63) * 64; const float* pe = which ? P.cmp_pos_v : P.cmp_pos_k; const float* w1 = which ? P.cmp_v_w1 : P.cmp_k_w1;
        f32x4 s = {0.f, 0.f, 0.f, 0.f};
#pragma unroll 8
        for (int r = 0; r < 64; ++r) { const f32x4 wv = *(const f32x4*)(w1 + (size_t)(r0 + r) * 256 + lane * 4); s += wv * pe[r0 + r]; }
        float* cbp = (float*)(P.ws + WS_CBIAS) + which * 256 + lane * 4;
        unsafeAtomicAdd(cbp + 0, s[0]); unsafeAtomicAdd(cbp + 1, s[1]); unsafeAtomicAdd(cbp + 2, s[2]); unsafeAtomicAdd(cbp + 3, s[3]); }
    if (gw == 0) { float mq = fmaxf(fabsf(P.q_norm_w[lane]), fabsf(P.q_norm_w[lane + 64])); mq = wave_max(mq);
        float mc = wave_max(fmaxf(fabsf(P.k_norm_cmp_w[lane]), fabsf(P.k_norm_cmp_w[lane + 64])));
        float ms = wave_max(fmaxf(fabsf(P.k_norm_slc_w[lane]), fabsf(P.k_norm_slc_w[lane + 64])));
        float mw = wave_max(fmaxf(fabsf(P.k_norm_win_w[lane]), fabsf(P.k_norm_win_w[lane + 64])));
        const float c = 11.313708498984761f * 1.4426950408889634f * mq * 1.01f;
        if (lane == 0) { W.TAB[512] = c * mc; W.TAB[513] = c * ms; W.TAB[514] = c * mw; } }
}

__device__ __forceinline__ void phase_postz(const Params& P, const Ptrs& W, int gw, int nw) {
    const int tid = threadIdx.x, lane = tid & 63;
    const f32x2 wq = *(const f32x2*)(P.q_norm_w + 2 * lane), wks = *(const f32x2*)(P.k_norm_slc_w + 2 * lane), wkw = *(const f32x2*)(P.k_norm_win_w + 2 * lane);
    for (int t = gw; t < S_; t += nw) {
        bf16_t* zr = W.Z + (size_t)t * LDZ;
        float cs0 = 0.f, cs1 = 0.f, sn0 = 0.f, sn1 = 0.f;
        if (lane < 16) { const int i0 = (2 * lane) & 15; cs0 = W.COS[t * 16 + i0]; cs1 = W.COS[t * 16 + i0 + 1]; sn0 = W.SIN[t * 16 + i0]; sn1 = W.SIN[t * 16 + i0 + 1]; }
        unsigned uv[32];
#pragma unroll
        for (int v = 0; v < 32; ++v) { const int col = v < 24 ? OFF_Q + v * HD : (v < 28 ? OFF_KV + 2 * 512 + (v - 24) * HD : OFF_KV + 4 * 512 + (v - 28) * HD);
            uv[v] = *((const unsigned*)(zr + col) + lane); }
#pragma unroll
        for (int v = 0; v < 32; ++v) {
            const f32x2 ww = v < 24 ? wq : (v < 28 ? wks : wkw);
            const unsigned u = uv[v]; const float x0 = bf_lo(u), x1 = bf_hi(u);
            const float ss = wave_sum(x0 * x0 + x1 * x1);
            const float rstd = rsqrtf(ss * (1.0f / HD) + EPS);
            float y0 = x0 * rstd * ww[0], y1 = x1 * rstd * ww[1];
            const float p0 = __shfl_xor(y0, 8), p1 = __shfl_xor(y1, 8);
            if (lane < 8) { y0 = y0 * cs0 - p0 * sn0; y1 = y1 * cs1 - p1 * sn1; }
            else if (lane < 16) { y0 = y0 * cs0 + p0 * sn0; y1 = y1 * cs1 + p1 * sn1; }
            uv[v] = cvt_pk_bf16(y0, y1);
            if (v >= 24) *((unsigned short*)((unsigned char*)W.MIX + ((v < 28 ? WS_K8 : WS_K8W) - WS_MIX) + ((size_t)t * 4 + ((v - 24) & 3)) * HD) + lane) = (unsigned short)(__builtin_amdgcn_cvt_pk_fp8_f32(y0, y1, 0, false) & 0xffff);
        }
        {
            const int gi = lane >> 4, wlen = 2 << gi, c0 = lane * 16; const int cnt = (t + 1) < wlen ? (t + 1) : wlen;
            float s[16];
#pragma unroll
            for (int i = 0; i < 16; ++i) s[i] = 0.f;
            float cur[16];
#pragma unroll
            for (int bt = 0; bt < 2; ++bt) {
                u32x4 ra[8], rb[8];
#pragma unroll
                for (int i = 0; i < 8; ++i) { const int ii = bt * 8 + i; const size_t row = (size_t)(ii < cnt ? t - ii : t);
                    ra[i] = *(const u32x4*)(W.Z + row * LDZ + c0); rb[i] = *(const u32x4*)(W.Z + row * LDZ + c0 + 8); }
#pragma unroll
                for (int i = 0; i < 8; ++i) { const int ii = bt * 8 + i; const float mk = ii < cnt ? 1.0f : 0.0f; const u32x4 a = ra[i], b = rb[i];
                    const float ev[16] = {bf_lo(a.x), bf_hi(a.x), bf_lo(a.y), bf_hi(a.y), bf_lo(a.z), bf_hi(a.z), bf_lo(a.w), bf_hi(a.w), bf_lo(b.x), bf_hi(b.x), bf_lo(b.y), bf_hi(b.y), bf_lo(b.z), bf_hi(b.z), bf_lo(b.w), bf_hi(b.w)};
#pragma unroll
                    for (int q = 0; q < 16; ++q) { s[q] += ev[q] * mk; if (ii == 0) cur[q] = ev[q]; } }
                if (bt == 0 && __all(cnt <= 8)) break;
            }
            const float rc = 1.0f / (float)cnt;
            u32x4 o0, o1;
            o0.x = cvt_pk_bf16(s[0] * rc - cur[0], s[1] * rc - cur[1]); o0.y = cvt_pk_bf16(s[2] * rc - cur[2], s[3] * rc - cur[3]);
            o0.z = cvt_pk_bf16(s[4] * rc - cur[4], s[5] * rc - cur[5]); o0.w = cvt_pk_bf16(s[6] * rc - cur[6], s[7] * rc - cur[7]);
            o1.x = cvt_pk_bf16(s[8] * rc - cur[8], s[9] * rc - cur[9]); o1.y = cvt_pk_bf16(s[10] * rc - cur[10], s[11] * rc - cur[11]);
            o1.z = cvt_pk_bf16(s[12] * rc - cur[12], s[13] * rc - cur[13]); o1.w = cvt_pk_bf16(s[14] * rc - cur[14], s[15] * rc - cur[15]);
            *(u32x4*)(W.M + (size_t)t * POOLW + c0) = o0; *(u32x4*)(W.M + (size_t)t * POOLW + c0 + 8) = o1;
        }
#pragma unroll
        for (int v = 0; v < 32; ++v) { const int col = v < 24 ? OFF_Q + v * HD : (v < 28 ? OFF_KV + 2 * 512 + (v - 24) * HD : OFF_KV + 4 * 512 + (v - 28) * HD);
            *((unsigned*)(zr + col) + lane) = uv[v]; }

    }
}

__device__ __forceinline__ void phase_cmpfin(const Params& P, const Ptrs& W) {
    const int tid = threadIdx.x, lane = tid & 63, gw = blockIdx.x * NWAVES + (tid >> 6), nw = gridDim.x * NWAVES;
    const f32x2 wk = *(const f32x2*)(P.k_norm_cmp_w + 2 * lane);
    for (int task = gw; task < 8192; task += nw) {
        const int tk = __builtin_amdgcn_readfirstlane(task);
        const int which = tk >> 12, g = (tk >> 10) & 3, n = tk & 1023;
        bf16_t* dst = (which ? W.VC : W.KC) + ((size_t)g * 1024 + n) * HD;
        if (n == 1023) { ((unsigned*)dst)[lane] = 0u; if (which == 0) *((unsigned short*)((unsigned char*)W.MIX + (WS_K8C - WS_MIX) + ((size_t)n * 4 + g) * HD) + lane) = 0; continue; }
        const float* h = W.H1 + (size_t)tk * 256; const float* w2 = which ? P.cmp_v_w2 : P.cmp_k_w2;
        float a0 = 0.f, a1 = 0.f;
        for (int j = 0; j < 256; ++j) { const float hj = h[j]; const f32x2 wv = *(const f32x2*)(w2 + j * HD + 2 * lane); a0 += hj * wv[0]; a1 += hj * wv[1]; }
        if (which == 0) {
            const float ss = wave_sum(a0 * a0 + a1 * a1); const float rstd = rsqrtf(ss * (1.0f / HD) + EPS);
            a0 = a0 * rstd * wk[0]; a1 = a1 * rstd * wk[1];
            const int tp = 16 * n + 31; const float p0 = __shfl_xor(a0, 8), p1 = __shfl_xor(a1, 8);
            if (lane < 16) { const int i0 = (2 * lane) & 15; const float cs0 = W.COS[tp * 16 + i0], cs1 = W.COS[tp * 16 + i0 + 1], sn0 = W.SIN[tp * 16 + i0], sn1 = W.SIN[tp * 16 + i0 + 1];
                if (lane < 8) { a0 = a0 * cs0 - p0 * sn0; a1 = a1 * cs1 - p1 * sn1; } else { a0 = a0 * cs0 + p0 * sn0; a1 = a1 * cs1 + p1 * sn1; } }
        }
        ((unsigned*)dst)[lane] = cvt_pk_bf16(a0, a1);
        if (which == 0) *((unsigned short*)((unsigned char*)W.MIX + (WS_K8C - WS_MIX) + ((size_t)n * 4 + g) * HD) + lane) = (unsigned short)(__builtin_amdgcn_cvt_pk_fp8_f32(a0, a1, 0, false) & 0xffff);
    }
}

__device__ __forceinline__ void phase_erstd(const Ptrs& W) {
    const int tid = threadIdx.x, lane = tid & 63, gw = blockIdx.x * NWAVES + (tid >> 6), nw = gridDim.x * NWAVES;
    u32x4 a[8], an[8];
    if (gw < S_) { const u32x4* sp = (const u32x4*)(W.ERAW + (size_t)gw * DM);
#pragma unroll
        for (int i = 0; i < 8; ++i) a[i] = sp[lane + 64 * i]; }
    for (int row = gw; row < S_; row += nw) {
        const int nr = row + nw < S_ ? row + nw : row;
        { const u32x4* sp = (const u32x4*)(W.ERAW + (size_t)nr * DM);
#pragma unroll
          for (int i = 0; i < 8; ++i) an[i] = sp[lane + 64 * i]; }
        float ss = 0.f;
#pragma unroll
        for (int i = 0; i < 8; ++i) {
            const float e0 = bf_lo(a[i].x), e1 = bf_hi(a[i].x), e2 = bf_lo(a[i].y), e3 = bf_hi(a[i].y), e4 = bf_lo(a[i].z), e5 = bf_hi(a[i].z), e6 = bf_lo(a[i].w), e7 = bf_hi(a[i].w);
            ss += e0 * e0 + e1 * e1 + e2 * e2 + e3 * e3 + e4 * e4 + e5 * e5 + e6 * e6 + e7 * e7; }
        ss = wave_sum(ss);
        if (lane == 0) W.ERSTD[row] = rsqrtf(ss * (1.0f / DM) + EPS);
#pragma unroll
        for (int i = 0; i < 8; ++i) a[i] = an[i];
    }
}

constexpr int N_PHASES = 11;
__device__ __forceinline__ Params kargs() {
#if defined(__HIP_DEVICE_COMPILE__)
    unsigned long long p = (unsigned long long)__builtin_amdgcn_kernarg_segment_ptr();
    asm volatile("" : "+s"(p));
    return *(const __attribute__((address_space(4))) Params*)p;
#else
    return Params{};
#endif
}
__device__ __forceinline__ Ptrs mkptrs(unsigned char* ws) {
    Ptrs W;
    W.Win = (bf16_t*)(ws + WS_WIN); W.Wo = (bf16_t*)(ws + WS_WO); W.Wfi = (bf16_t*)(ws + WS_WFI); W.Wfo = (bf16_t*)(ws + WS_WFO); W.Wg = (bf16_t*)(ws + WS_WG);
    W.Wple = (bf16_t*)(ws + WS_WPLE); W.Wpool = (bf16_t*)(ws + WS_WPOOL); W.Wc1k = (bf16_t*)(ws + WS_WC1K); W.Wc1v = (bf16_t*)(ws + WS_WC1V);
    W.XN = (bf16_t*)(ws + WS_XN); W.PB = (bf16_t*)(ws + WS_PB); W.Z = (bf16_t*)(ws + WS_Z); W.M = (bf16_t*)(ws + WS_M); W.KC = (bf16_t*)(ws + WS_KC); W.VC = (bf16_t*)(ws + WS_VC);
    W.MIX = (bf16_t*)(ws + WS_MIX); W.ACT = (bf16_t*)(ws + WS_ACT); W.ERAW = (bf16_t*)(ws + WS_ERAW);
    W.COS = (float*)(ws + WS_COS); W.SIN = (float*)(ws + WS_SIN); W.TAB = (float*)(ws + WS_TAB); W.G = (float*)(ws + WS_G); W.H1 = (float*)(ws + WS_H1); W.L = (float*)(ws + WS_L);
    W.OACC = (float*)(ws + WS_OACC); W.IMPP = (float*)(ws + WS_IMPP); W.IMPF = (float*)(ws + WS_IMPF); W.ERSTD = (float*)(ws + WS_ERSTD); W.BM = (unsigned*)(ws + WS_BM);
    return W;
}
__global__ void __launch_bounds__(NTHREADS, 2) fwd(Params Punused) {
    extern __shared__ __attribute__((aligned(16))) unsigned char lds_raw[];
    LAS unsigned char* lds = (LAS unsigned char*)lds_raw;
    const int tid = threadIdx.x;
    const int G = gridDim.x, bid = blockIdx.x;
    const int gw = bid * NWAVES + (tid >> 6), nw = G * NWAVES;

    if (tid < 16) ((LAS unsigned*)(lds + LDS_MISC))[tid] = 0u;
    __syncthreads();
    int lo, hi; XcdBarrier bar;
    { const Params P = kargs(); lo = P.ph_lo; hi = P.ph_hi;
      bar.bar = (unsigned*)(P.ws + WS_CTL); bar.x = 0; bar.st = (volatile LAS unsigned*)(lds + LDS_MISC);
      if (hi - lo > 1) bar = xcd_barrier_post((unsigned*)(P.ws + WS_CTL), (volatile LAS unsigned*)(lds + LDS_MISC)); }
#ifdef PH_MASK
#define IN(k) (((PH_MASK >> (k)) & 1) && lo <= (k) && (k) < hi)
#else
#define IN(k) (lo <= (k) && (k) < hi)
#endif
#define SEAM(k) do { if (IN(k) && IN((k) + 1)) xcd_barrier(bar); } while (0)
#define PHASE_VARS const Params P = kargs(); const Ptrs W = mkptrs(P.ws); (void)W;
#define ATT_ARGS att::AttnArgs AA{W.Z, W.KC, W.VC, W.G, W.L, W.OACC, W.MIX, W.BM, W.TAB};

    if (IN(0)) { PHASE_VARS REP(0) { phase_prologue(P, W, lds); } SEAM(0); }
    if (IN(1)) {
        PHASE_VARS
        { pg8::GStd g{(const char*)W.XN, (const char*)W.Win, DM, DM, DM / 64}; pg8::StaticOrder S; S.init(S_ / 256, POOLW / 256, G, bid);
          pg8::EpiBf16 E{W.Z, LDZ}; pg8::gemm_phase(lds, g, S, E); }
        { pg8::GStd g{(const char*)(P.ws + WS_XN8), (const char*)(P.ws + WS_WIN8), DM / 2, DM / 2, DM / 128}; pg8::StaticOrder S; S.init(S_ / 256, (OFF_G - POOLW) / 256, G, bid);
          pg8::EpiBf16S E{W.Z + POOLW, LDZ, 1.0f / WG8_SCALE}; pg8::gemm_phase<pg8::GStd, pg8::EpiBf16S, true>(lds, g, S, E); }
        SEAM(1);
    }
    if (IN(2)) {
        PHASE_VARS
        if (G > 64) {
            if (bid < 32) { pg8::GCmp g{(const char*)W.Z, (const char*)W.Wc1k, (const char*)W.Wc1v, 16 * LDZ, 4096, 64}; pg8::StaticOrder S; S.init(32, 1, 32, bid);
                pg8::EpiCmpGelu E{W.H1, (const float*)(P.ws + WS_CBIAS)}; pg8::gemm_phase(lds, g, S, E); }
            else if (bid < 96) {
                pg8::GStd g{(const char*)W.XN, (const char*)(W.Win + (size_t)OFF_G * DM), DM, DM, DM / 64}; pg8::StaticOrder S; S.init(S_ / 256, 1, 64, bid - 32);
                pg8::EpiBf16 E{W.Z + OFF_G, LDZ}; pg8::gemm_phase(lds, g, S, E); }
            else phase_postz(P, W, (bid - 96) * NWAVES + (tid >> 6), (G - 96) * NWAVES);
        } else {
            { pg8::GStd g{(const char*)W.XN, (const char*)(W.Win + (size_t)OFF_G * DM), DM, DM, DM / 64}; pg8::StaticOrder S; S.init(S_ / 256, 1, G, bid);
              pg8::EpiBf16 E{W.Z + OFF_G, LDZ}; pg8::gemm_phase(lds, g, S, E); }
            { pg8::GCmp g{(const char*)W.Z, (const char*)W.Wc1k, (const char*)W.Wc1v, 16 * LDZ, 4096, 64}; pg8::StaticOrder S; S.init(32, 1, G, bid);
              pg8::EpiCmpGelu E{W.H1, (const float*)(P.ws + WS_CBIAS)}; pg8::gemm_phase(lds, g, S, E); }
            phase_postz(P, W, gw, nw);
        }
        SEAM(2);
    }
    if (IN(3)) {
        PHASE_VARS
        {
            const size_t i0 = (size_t)bid * NTHREADS + tid, st = (size_t)G * NTHREADS, NG = (size_t)S_ * NGATE;
            for (size_t ib = i0; ib < NG; ib += 9 * st) { float zv[9];
#pragma unroll
                for (int k = 0; k < 9; ++k) { size_t i = ib + k * st; if (i >= NG) i = NG - 1; const int t = (int)(i / NGATE), c = (int)(i % NGATE); zv[k] = bf2f(W.Z[(size_t)t * LDZ + OFF_G + c]); }
#pragma unroll
                for (int k = 0; k < 9; ++k) { const size_t i = ib + k * st; if (i < NG) W.G[i] = sigmoidf_(zv[k]); } } }
        phase_cmpfin(P, W);
        { pg8::GPool g{(const char*)W.M, (const char*)W.Wpool, POOLW, 256, 4}; pg8::StaticOrder S; S.init(S_ / 256, 4, G, bid);
          pg8::EpiBf16Scale E{W.MIX, DM, P.pool_scale}; pg8::gemm_phase(lds, g, S, E); }
        SEAM(3);
    }
    if (IN(4)) {
        PHASE_VARS ATT_ARGS
        if (G == 256) {
            for (int rnd = 0; rnd < 2; ++rnd) {
                const int x = bid & 7, r = bid >> 3, qp = rnd ? 63 - r : r, g = x & 3, qt = 2 * qp + (x >> 2);
                for (int uu = 0; uu < 2; ++uu) att::slc16_unit<2>(AA, (LAS char*)lds, 2 * qt + uu, g); }
            asm volatile("s_waitcnt vmcnt(0)" ::: "memory");
            __builtin_amdgcn_fence(__ATOMIC_RELEASE, "workgroup");
            __syncthreads();
            __builtin_amdgcn_fence(__ATOMIC_ACQUIRE, "workgroup");
            for (int rnd = 0; rnd < 2; ++rnd) {
                const int x = bid & 7, r = bid >> 3, qp = rnd ? 63 - r : r, g = x & 3, qt = 2 * qp + (x >> 2);
                const int tqi = qt * 8 + (tid >> 6);
                att::imp_task(AA, W.IMPP, W.IMPF, tqi, g);
                asm volatile("s_waitcnt vmcnt(0)" ::: "memory");
                f32x4 pp, ff, pn, fn; att::topk_load(W.IMPP, W.IMPF, tqi * 16, g, pp, ff);
                for (int q = 0; q < 16; ++q) { att::topk_load(W.IMPP, W.IMPF, tqi * 16 + (q < 15 ? q + 1 : q), g, pn, fn); att::topk_task(pp, ff, W.BM, tqi * 16 + q, g); pp = pn; ff = fn; } }
        } else {
            for (int base = 0, rnd = 0; base < 1536; base += G, ++rnd) {
                const int Lu = base + ((rnd & 1) ? G - 1 - bid : bid); if (Lu >= 1536) continue;
                const int qt = Lu / 12, rem = Lu % 12, g = rem / 3, hp = rem % 3;
                att::attn_unit<att::MODE_CMP>(AA, (LAS char*)lds, qt, g, hp); }
        }
        __builtin_amdgcn_s_setprio(0);
        for (int base = 0, rnd = 0; base < 1024 + G; base += G, ++rnd) {
            int ut, g;
            if (G == 256) { const int x = bid & 7, r = bid >> 3, k = rnd * 32 + r; if (k >= 128) break; g = x & 3; ut = 2 * k + (x >> 2); }
            else { const int Lu = base + bid; if (Lu >= 1024) continue; ut = Lu / 4; g = Lu % 4; }
            att::slc16_unit<1>(AA, (LAS char*)lds, ut, g); }
        if (G != 256) SEAM(4);
    }
    if (IN(5)) {
        PHASE_VARS ATT_ARGS
        if (G != 256)
        for (int k = gw, r = 0; k < 4096; k += nw, ++r) { const int hiT = (r + 1) * nw < 4096 ? (r + 1) * nw : 4096;
            const int task = (r & 1) ? hiT - 1 - (k - r * nw) : k;
            att::imp_task(AA, W.IMPP, W.IMPF, task >> 2, task & 3);
            asm volatile("s_waitcnt vmcnt(0)" ::: "memory");
            { const int tb = (task >> 2) * 16, gg = task & 3; f32x4 pp, ff, pn, fn;
              att::topk_load(W.IMPP, W.IMPF, tb, gg, pp, ff);
              for (int q = 0; q < 16; ++q) { att::topk_load(W.IMPP, W.IMPF, tb + (q < 15 ? q + 1 : q), gg, pn, fn); att::topk_task(pp, ff, W.BM, tb + q, gg); pp = pn; ff = fn; } } }
        SEAM(5);
    }
    if (IN(6)) {
        PHASE_VARS ATT_ARGS
#if SLC16
        for (int base = 0, rnd = 0; base < 1024 + G; base += G, ++rnd) {
            int ut, g;
            if (G == 256) { const int x = bid & 7, r = bid >> 3, k = rnd * 32 + ((rnd & 1) ? 31 - r : r); if (k >= 128) break; g = x & 3; ut = 255 - (2 * k + (x >> 2)); }
            else { const int Lu = base + ((rnd & 1) ? G - 1 - bid : bid); if (Lu >= 1024) continue; ut = 255 - Lu / 4; g = Lu % 4; }
            att::slc16_unit<0>(AA, (LAS char*)lds, ut, g); }
#else
        REP(6)
        for (int base = 0, rnd = 0; base < 1640 + G; base += G, ++rnd) {
            int ut, g;
            if (G == 256) { const int x = bid & 7, r = bid >> 3, k = rnd * 32 + ((rnd & 1) ? 31 - r : r); if (k >= 205) break; g = x & 3; ut = 409 - (2 * k + (x >> 2)); }
            else { const int Lu = base + ((rnd & 1) ? G - 1 - bid : bid); if (Lu >= 1640) continue; ut = 409 - Lu / 4; g = Lu % 4; }
            att::attn_unit<att::MODE_SLC>(AA, (LAS char*)lds, ut, g, 0); }
#endif
        SEAM(6);
    }
    if (IN(7)) {
        PHASE_VARS
        if (bid == 0) { bf16_t* hz = (bf16_t*)(P.ws + WS_HRES) - 2 * DM; for (int i = tid; i < 2 * DM / 8; i += NTHREADS) *(u32x4*)(hz + i * 8) = (u32x4){0u, 0u, 0u, 0u}; }
        { pg8::GStd g{(const char*)W.MIX, (const char*)W.Wo, DM, DM, POOLW / 64 + (DM - POOLW) / 128}; pg8::StaticOrder S; S.init(S_ / 256, DM / 256, G, bid);
          pg8::EpiResNorm E{P.x, (bf16_t*)(P.ws + WS_HRES), W.XN, P.norm2_w, (float*)(P.ws + WS_SSQ1), DM, 1.0f / 128.0f}; pg8::gemm_phase<pg8::GStd, pg8::EpiResNorm, false, POOLW / 64>(lds, g, S, E); }
        { pg8::GStd g{(const char*)W.PB, (const char*)W.Wple, PLE, PLE, PLE / 64}; pg8::StaticOrder S; S.init(S_ / 256, DM / 256, G, bid);
          pg8::EpiBf16Ssq E{W.ERAW, DM, (float*)(P.ws + WS_SSQ3)}; pg8::gemm_phase(lds, g, S, E); }
        SEAM(7);
    }
    if (IN(8)) {
        PHASE_VARS
        pg8::GFfn g{(const char*)(P.ws + WS_HRES), (const char*)W.Wfi, DM, DM, DM / 64}; pg8::StaticOrder S; S.init(65, DFF / 128, G, bid);
        pg8::EpiFfn E{W.ACT, P.conv_w, P.conv_b, (LAS float*)(lds + LDS_XCH), (const float*)(P.ws + WS_SSQ1)}; REP(8) { pg8::gemm_phase(lds, g, S, E); } SEAM(8);
    }
    if (IN(9)) {
        PHASE_VARS
        pg8::GStd g{(const char*)W.ACT, (const char*)W.Wfo, DFF, DFF, DFF / 64}; pg8::StaticOrder S; S.init(S_ / 256, DM / 256, G, bid);
        pg8::EpiResNormF8 E{P.ws + WS_HRES, (bf16_t*)(P.ws + WS_HRES), W.XN, P.ple_gate_norm_w, (float*)(P.ws + WS_SSQ2), DM}; pg8::gemm_phase(lds, g, S, E); SEAM(9);
    }
    if (IN(10)) {
        PHASE_VARS
        pg8::GStd g{(const char*)W.XN, (const char*)W.Wg, DM / 2, DM / 2, DM / 128}; pg8::StaticOrder S; S.init(S_ / 256, DM / 256, G, bid);
        pg8::EpiGate E{P.out, (const bf16_t*)(P.ws + WS_HRES), W.ERAW, (const float*)(P.ws + WS_SSQ3), P.ple_norm_w, (const float*)(P.ws + WS_SSQ2), DM, 1.0f / WG8_SCALE};
        pg8::gemm_phase<pg8::GStd, pg8::EpiGate, true>(lds, g, S, E);
    }
#undef IN
#undef SEAM
}

extern "C" void kernel_launch(void* const* d_in, const int* in_sizes, int n_in, void* d_out, int out_size, void* d_ws, size_t ws_size, hipStream_t stream) {
    static int grid = 0;
    if (grid == 0) {
        if (n_in != 27 || in_sizes[0] != S_ * DM || out_size != S_ * DM || ws_size < WS_NEED) {
            fprintf(stderr, "kernel_launch: unexpected shapes (n_in %d, in0 %d, out %d, ws %zu < %zu); nothing launched\n", n_in, n_in > 0 ? in_sizes[0] : -1, out_size, ws_size, (size_t)WS_NEED); grid = -1; return; }
        int dev = 0, cus = 0, per_cu = 0;
        if (hipGetDevice(&dev) != hipSuccess || hipDeviceGetAttribute(&cus, hipDeviceAttributeMultiprocessorCount, dev) != hipSuccess) { grid = -1; return; }
        if (hipFuncSetAttribute((const void*)fwd, hipFuncAttributeMaxDynamicSharedMemorySize, LDS_BYTES) != hipSuccess) { fprintf(stderr, "kernel_launch: hipFuncSetAttribute failed\n"); grid = -1; return; }
        if (hipOccupancyMaxActiveBlocksPerMultiprocessor(&per_cu, (const void*)fwd, NTHREADS, LDS_BYTES) != hipSuccess || per_cu < 1) { fprintf(stderr, "kernel_launch: occupancy query says %d\n", per_cu); (void)hipGetLastError(); }
        grid = cus > 256 ? 256 : cus;
    }
    if (grid < 0) return;
    (void)hipMemsetAsync((char*)d_ws + WS_CTL, 0, CTL_BYTES, stream);
    Params P{};
    const float** fp = (const float**)&P;
    P.x = (const float*)d_in[0]; P.p = (const float*)d_in[1]; P.positions = (const int*)d_in[2]; P.norm1_w = (const float*)d_in[3]; P.w_in = (const float*)d_in[4];
    P.w_pool = (const float*)d_in[5]; P.pool_scale = (const float*)d_in[6]; P.q_norm_w = (const float*)d_in[7]; P.k_norm_cmp_w = (const float*)d_in[8];
    P.k_norm_slc_w = (const float*)d_in[9]; P.k_norm_win_w = (const float*)d_in[10]; P.cmp_pos_k = (const float*)d_in[11]; P.cmp_pos_v = (const float*)d_in[12];
    P.cmp_k_w1 = (const float*)d_in[13]; P.cmp_k_w2 = (const float*)d_in[14]; P.cmp_v_w1 = (const float*)d_in[15]; P.cmp_v_w2 = (const float*)d_in[16];
    P.w_o = (const float*)d_in[17]; P.norm2_w = (const float*)d_in[18]; P.w_ffn_in = (const float*)d_in[19]; P.conv_w = (const float*)d_in[20]; P.conv_b = (const float*)d_in[21];
    P.w_ffn_out = (const float*)d_in[22]; P.w_ple_proj = (const float*)d_in[23]; P.ple_norm_w = (const float*)d_in[24]; P.ple_gate_norm_w = (const float*)d_in[25]; P.w_ple_gate = (const float*)d_in[26];
    (void)fp;
    P.out = (float*)d_out; P.ws = (unsigned char*)d_ws;
#if MK_ONE_LAUNCH
    P.ph_lo = 0; P.ph_hi = N_PHASES;
    hipLaunchKernelGGL(fwd, dim3(grid), dim3(NTHREADS), LDS_BYTES, stream, P);
#else
    for (int ph = 0; ph < N_PHASES; ++ph) { P.ph_lo = ph; P.ph_hi = ph + 1; hipLaunchKernelGGL(fwd, dim3(grid), dim3(NTHREADS), LDS_BYTES, stream, P); }
#endif
    const hipError_t le = hipPeekAtLastError();
    if (le != hipSuccess) fprintf(stderr, "kernel_launch: launch failed: %s\n", hipGetErrorName(le));
}
```

```cpp
#include <hip/hip_runtime.h>
#include <cstdio>
#include <cstdint>

#ifndef PROBE_DBL
#define PROBE_DBL 0
#endif
#define REP(k) _Pragma("unroll") for (int rep_ = 0; rep_ < 1 + ((PROBE_DBL >> (k)) & 1); ++rep_)
#ifndef SLC16
#define SLC16 1
#endif
#if !SLC16
#error "the 32-row selected-branch path writes a bf16 mix; the output projection expects the fp8 image of the 16-row path"
#endif
#ifndef MK_ONE_LAUNCH
#define MK_ONE_LAUNCH 1
#endif

#define LAS __attribute__((address_space(3)))
typedef unsigned short bf16_t;
typedef short bf16x8 __attribute__((ext_vector_type(8)));
typedef short s16x4 __attribute__((ext_vector_type(4)));
typedef float f32x2 __attribute__((ext_vector_type(2)));
typedef float f32x4 __attribute__((ext_vector_type(4)));
typedef float f32x16 __attribute__((ext_vector_type(16)));
typedef unsigned u32x2 __attribute__((ext_vector_type(2)));
typedef unsigned u32x4 __attribute__((ext_vector_type(4)));
typedef int i32x4 __attribute__((ext_vector_type(4)));
typedef int i32x8 __attribute__((ext_vector_type(8)));

constexpr int S_ = 16384, DM = 4096, INW = 7240, LDZ = 7424, POOLW = 1024, NH = 24, NKV = 4, HPG = 6, HD = 128;
constexpr int OFF_Q = 1024, OFF_KV = 4096, OFF_G = 7168, DFF = 11008, NFI = 22016, PLE = 256, NGATE = 72;
constexpr int ZROWS = S_ + 64, XNROWS = S_ + 256, CHUNK = 8192;
constexpr float EPS = 1e-6f;
constexpr float SM_C = 0.08838834764831845f * 1.4426950408889634f;
constexpr int NWAVES = 8, NTHREADS = 512;
constexpr float WG8_SCALE = 128.0f;

constexpr size_t al256(size_t x) { return (x + 255) / 256 * 256; }
constexpr size_t WS_CTL   = 0;
constexpr size_t CTL_BYTES = 262144;
constexpr size_t WS_CBIAS = WS_CTL + 32768;
constexpr size_t WS_SSQ1 = WS_CTL + 65536, WS_SSQ2 = WS_CTL + 131072, WS_SSQ3 = WS_CTL + 196608;
constexpr size_t WS_WIN   = WS_CTL + CTL_BYTES;
constexpr size_t WS_WO    = WS_WIN + al256((size_t)LDZ * DM * 2);
constexpr size_t WS_WFI   = WS_WO + al256((size_t)DM * DM * 2);
constexpr size_t WS_WFO   = WS_WFI + al256((size_t)NFI * DM * 2);
constexpr size_t WS_WG    = WS_WFO + al256((size_t)DM * DFF * 2);
constexpr size_t WS_WPLE  = WS_WG + al256((size_t)DM * DM * 2);
constexpr size_t WS_WPOOL = WS_WPLE + al256((size_t)DM * PLE * 2);
constexpr size_t WS_WC1K  = WS_WPOOL + al256((size_t)1024 * 256 * 2);
constexpr size_t WS_WC1V  = WS_WC1K + al256((size_t)256 * 4096 * 2);
constexpr size_t WS_COS   = WS_WC1V + al256((size_t)256 * 4096 * 2);
constexpr size_t WS_SIN   = WS_COS + al256((size_t)S_ * 16 * 4);
constexpr size_t WS_TAB   = WS_SIN + al256((size_t)S_ * 16 * 4);
constexpr size_t WS_XNP   = WS_TAB + 4096;
constexpr size_t WS_XN    = WS_XNP + (size_t)2 * DM * 2;
constexpr size_t WS_PB    = WS_XN + al256((size_t)XNROWS * DM * 2);
constexpr size_t WS_XN8   = WS_PB + al256((size_t)S_ * PLE * 2);
constexpr size_t WS_WIN8  = WS_XN8 + al256((size_t)S_ * DM);
constexpr size_t WS_R     = WS_WIN8 + al256((size_t)(OFF_G - POOLW) * DM);
constexpr size_t WS_Z     = WS_R;
constexpr size_t WS_M     = WS_Z + al256((size_t)ZROWS * LDZ * 2);
constexpr size_t WS_G     = WS_M + al256((size_t)S_ * POOLW * 2);
constexpr size_t WS_H1    = WS_G + al256((size_t)S_ * NGATE * 4);
constexpr size_t WS_KC    = WS_H1 + al256((size_t)8192 * 256 * 4);
constexpr size_t WS_VC    = WS_KC + al256((size_t)4 * 1024 * 128 * 2);
constexpr size_t WS_L     = WS_VC + al256((size_t)4 * 1024 * 128 * 2);
constexpr size_t WS_OACC  = WS_L + al256((size_t)S_ * NH * 4);
constexpr size_t WS_IMPP  = WS_OACC + al256((size_t)S_ * 3072 * 4);
constexpr size_t WS_IMPF  = WS_IMPP + al256((size_t)S_ * 4 * 256 * 4);
constexpr size_t WS_BM    = WS_IMPF + al256((size_t)S_ * 4 * 256 * 4);
constexpr size_t WS_MIX   = WS_BM + al256((size_t)S_ * 4 * 8 * 4);
constexpr size_t WS_K8    = WS_MIX + al256((size_t)S_ * DM * 2);
constexpr size_t WS_K8W   = WS_K8 + al256((size_t)S_ * 4 * HD);
constexpr size_t WS_K8C   = WS_K8W + al256((size_t)S_ * 4 * HD);
constexpr size_t WS_END_A = WS_K8C + al256((size_t)1024 * 4 * HD);
constexpr size_t WS_ERAW  = WS_R;
constexpr size_t WS_ACT   = WS_ERAW + al256((size_t)S_ * DM * 2);
constexpr size_t WS_ERSTD = WS_ACT + al256((size_t)S_ * DFF * 2);
constexpr size_t WS_END_B = WS_ERSTD + al256((size_t)S_ * 4);
constexpr size_t WS_HRES  = WS_IMPP + (size_t)2 * DM * 2;
static_assert(WS_HRES - (size_t)2 * DM * 2 >= WS_END_B && WS_HRES + (size_t)S_ * DM * 2 <= WS_MIX, "residual stream must sit in the dead importance / bitmap buffers, clear of act / mix");
static_assert(WS_ERAW + (size_t)S_ * DM * 2 <= WS_Z + (size_t)ZROWS * LDZ * 2, "eraw must fit inside the dead z region while mix is still being read");
constexpr size_t WS_NEED  = WS_END_A > WS_END_B ? WS_END_A : WS_END_B;
static_assert(WS_NEED <= (size_t)1440000000, "workspace map exceeds the guaranteed 4 x largest-tensor bytes");

constexpr int LDS_STAGE = 131072;
constexpr int LDS_XCH   = LDS_STAGE + 64;
constexpr int LDS_MISC  = 155648;
constexpr int LDS_BYTES = LDS_MISC + 64;

__device__ __forceinline__ unsigned cvt_pk_bf16(float lo, float hi) { unsigned r; asm volatile("v_cvt_pk_bf16_f32 %0, %1, %2" : "=v"(r) : "v"(lo), "v"(hi)); return r; }
__device__ __forceinline__ float bf_lo(unsigned u) { return __uint_as_float(u << 16); }
__device__ __forceinline__ float bf_hi(unsigned u) { return __uint_as_float(u & 0xffff0000u); }
__device__ __forceinline__ float bf2f(bf16_t b) { return __uint_as_float(((unsigned)b) << 16); }
__device__ __forceinline__ float wave_sum(float v) {
#pragma unroll
    for (int o = 32; o >= 1; o >>= 1) v += __shfl_xor(v, o);
    return v;
}
__device__ __forceinline__ float wave_max(float v) {
#pragma unroll
    for (int o = 32; o >= 1; o >>= 1) v = fmaxf(v, __shfl_xor(v, o));
    return v;
}
__device__ __forceinline__ float sigmoidf_(float x) { return __builtin_amdgcn_rcpf(1.0f + __expf(-x)); }

#define XB_TMO      128
#define XB_XCNT(j)  (256  + 64 * (j))
#define XB_XSUB(j)  (1280 + 64 * (j))
#define XB_XGEN(j)  (2304 + 64 * (j))
#define XB_TOP      3328
#define XB_TOPGEN   3392
#define XCD_BAR_WORDS 3456
#define XB_SPIN_CAP (1u << 18)
__device__ __forceinline__ unsigned xb_ld(unsigned* p)              { return __hip_atomic_load(p, __ATOMIC_RELAXED, __HIP_MEMORY_SCOPE_AGENT); }
__device__ __forceinline__ unsigned xb_add(unsigned* p, unsigned v) { return __hip_atomic_fetch_add(p, v, __ATOMIC_RELAXED, __HIP_MEMORY_SCOPE_AGENT); }
__device__ __forceinline__ unsigned xb_xcc_id() { return (unsigned)__builtin_amdgcn_s_getreg((3 << 11) | 20) & 0xFu; }
#define XB_SPIN(cond, bar) do { unsigned _sp = 0; while (cond) { __builtin_amdgcn_s_sleep(1); \
    if ((++_sp & 255u) == 0u) { if (xb_ld(&(bar)[XB_TMO])) break; if (_sp > XB_SPIN_CAP) { atomicAdd(&(bar)[XB_TMO], 1u); break; } } } } while (0)
struct XcdBarrier { unsigned* bar; unsigned x; volatile LAS unsigned* st; };
__device__ __forceinline__ XcdBarrier xcd_barrier_post(unsigned* bar, volatile LAS unsigned* st) {
    XcdBarrier b; b.bar = bar; b.x = xb_xcc_id(); b.st = st;
    if (threadIdx.x == 0) (void)xb_add(&bar[XB_XCNT(b.x)], 1u);
    return b;
}
__device__ __forceinline__ void xcd_barrier_complete(unsigned* bar, unsigned x, unsigned& nloc, unsigned& nx) {
    const unsigned G = gridDim.x * gridDim.y * gridDim.z;
    unsigned sum, cnt, mine, sp = 0u;
    for (;;) {
        sum = 0u; cnt = 0u; mine = 0u;
#pragma unroll
        for (unsigned j = 0; j < 16; ++j) { const unsigned c = xb_ld(&bar[XB_XCNT(j)]); sum += c; cnt += (c > 0u) ? 1u : 0u; mine = (j == x) ? c : mine; }
        if (sum == G) break;
        __builtin_amdgcn_s_sleep(1);
        if ((++sp & 255u) == 0u) { if (xb_ld(&bar[XB_TMO])) break; if (sp > XB_SPIN_CAP) { atomicAdd(&bar[XB_TMO], 1u); break; } }
    }
    nloc = mine > 0u ? mine : 1u; nx = cnt > 0u ? cnt : 1u;
}
__device__ __forceinline__ void xcd_barrier(const XcdBarrier& b) {
    asm volatile("s_waitcnt vmcnt(0)" ::: "memory");
    __syncthreads();
    if (threadIdx.x == 0) {
        unsigned* bar = b.bar;
        __builtin_amdgcn_s_waitcnt(0);
        unsigned nloc = b.st[0], nx = b.st[1];
        if (nloc == 0u) { xcd_barrier_complete(bar, b.x, nloc, nx); b.st[0] = nloc; b.st[1] = nx; }
        const unsigned old = xb_add(&bar[XB_XSUB(b.x)], 1u);
        const unsigned gen = old / nloc;
        if (old + 1u == (gen + 1u) * nloc) {
            __builtin_amdgcn_fence(__ATOMIC_RELEASE, "agent");
            asm volatile("s_waitcnt vmcnt(0)" ::: "memory");
            const unsigned og = xb_add(&bar[XB_TOP], 1u);
            const unsigned tg = og / nx;
            if (og + 1u == (tg + 1u) * nx) xb_add(&bar[XB_TOPGEN], 1u);
            else XB_SPIN(xb_ld(&bar[XB_TOPGEN]) == tg, bar);
            __builtin_amdgcn_fence(__ATOMIC_ACQUIRE, "agent");
            xb_add(&bar[XB_XGEN(b.x)], 1u);
            asm volatile("s_waitcnt vmcnt(0)" ::: "memory");
        } else {
            XB_SPIN(xb_ld(&bar[XB_XGEN(b.x)]) == gen, bar);
            __builtin_amdgcn_fence(__ATOMIC_ACQUIRE, "agent");
            asm volatile("s_waitcnt vmcnt(0)" ::: "memory");
        }
    }
    __syncthreads();
}

struct Params {
    const float* x; const float* p; const int* positions; const float* norm1_w; const float* w_in; const float* w_pool; const float* pool_scale;
    const float* q_norm_w; const float* k_norm_cmp_w; const float* k_norm_slc_w; const float* k_norm_win_w; const float* cmp_pos_k; const float* cmp_pos_v;
    const float* cmp_k_w1; const float* cmp_k_w2; const float* cmp_v_w1; const float* cmp_v_w2; const float* w_o; const float* norm2_w; const float* w_ffn_in;
    const float* conv_w; const float* conv_b; const float* w_ffn_out; const float* w_ple_proj; const float* ple_norm_w; const float* ple_gate_norm_w; const float* w_ple_gate;
    float* out; unsigned char* ws; int ph_lo, ph_hi;
};

namespace pg8 {
constexpr int BM = 256, BK = 64, HALF = 128, HTB = HALF * BK * 2, STAGE_BYTES = 8 * HTB, NXCD = 8, WGM = 8;
__host__ __device__ __forceinline__ int lds_byte(int r, int c) { const int st = (r >> 4) * 2 + (c >> 5), rr = r & 15, cc = c & 31, ob = rr * 64 + cc * 2; return st * 1024 + (ob ^ (((ob >> 9) & 1) << 5)); }
__host__ __device__ __forceinline__ void stage_rc(int b, int& R, int& C) { const int st = b / 1024, sb = b % 1024, swz = sb ^ (((sb >> 9) & 1) << 5); R = (st >> 1) * 16 + swz / 64; C = (st & 1) * 32 + (swz % 64) / 2; }
__host__ __device__ __forceinline__ int perm32(int rho) { const int n = rho >> 4, i = rho & 15; return 8 * (i >> 2) + 4 * n + (i & 3); }
struct Unit { int pm, pn; };

struct StaticOrder {
    int nM, nN, nwg, G, c;
    __device__ void init(int nM_, int nN_, int G_, int c_) { nM = nM_; nN = nN_; nwg = nM * nN; G = G_; c = c_; }
    __device__ bool next(int i, Unit& u) const {
        const long L = (long)i * G + c; if (L >= nwg) return false;
        int wgid = (int)L; { const int q = nwg / NXCD, r = nwg % NXCD, xcd = wgid % NXCD, off = wgid / NXCD; wgid = (xcd < r ? xcd * (q + 1) : r * (q + 1) + (xcd - r) * q) + off; }
        const int nig = WGM * nN, gid = wgid / nig, fm = gid * WGM, gsz = (nM - fm) < WGM ? (nM - fm) : WGM;
        u.pm = fm + ((wgid % nig) % gsz); u.pn = (wgid % nig) / gsz; return true;
    }
};

struct GStd {
    const char* A; const char* B; unsigned lda, ldb; int nt;
    __device__ __forceinline__ const char* a_base(const Unit& u) const { return A + (size_t)u.pm * 256 * lda * 2; }
    __device__ __forceinline__ const char* b_base(const Unit& u) const { return B + (size_t)u.pn * 256 * ldb * 2; }
    __device__ __forceinline__ size_t kpairA() const { return 256; }
};
struct GPool {
    const char* A; const char* B; unsigned lda, ldb; int nt;
    __device__ __forceinline__ const char* a_base(const Unit& u) const { return A + (size_t)u.pm * 256 * lda * 2 + (size_t)u.pn * 512; }
    __device__ __forceinline__ const char* b_base(const Unit& u) const { return B + (size_t)u.pn * 256 * ldb * 2; }
    __device__ __forceinline__ size_t kpairA() const { return 256; }
};
struct GCmp {
    const char* Z; const char* Bk; const char* Bv; unsigned lda, ldb; int nt;
    __device__ __forceinline__ const char* a_base(const Unit& u) const { const int which = u.pm >> 4, g = (u.pm >> 2) & 3, rt = u.pm & 3;
        return Z + (size_t)(OFF_KV + which * 512 + g * 128) * 2 + (size_t)rt * 256 * lda * 2; }
    __device__ __forceinline__ const char* b_base(const Unit& u) const { return (u.pm >> 4) ? Bv : Bk; }
    __device__ __forceinline__ size_t kpairA() const { return (size_t)LDZ * 2; }
};

struct EpiBf16 {
    static constexpr bool PERM = true;
    bf16_t* O; int ldc;
    __device__ __forceinline__ void operator()(const f32x4 (&acc)[2][2][4][2], const Unit& u, int wr, int wc, int fr, int fq) const {
        const int row0 = u.pm * BM + wr * 64 + fr, col0 = u.pn * BM + wc * 32 + 8 * fq;
#pragma unroll
        for (int ai = 0; ai < 2; ++ai)
#pragma unroll
            for (int m = 0; m < 4; ++m) { bf16_t* rowp = O + (size_t)(row0 + ai * HALF + m * 16) * ldc + col0;
#pragma unroll
                for (int bj = 0; bj < 2; ++bj) { const f32x4 v0 = acc[ai][bj][m][0], v1 = acc[ai][bj][m][1];
                    u32x4 w; w.x = cvt_pk_bf16(v0[0], v0[1]); w.y = cvt_pk_bf16(v0[2], v0[3]); w.z = cvt_pk_bf16(v1[0], v1[1]); w.w = cvt_pk_bf16(v1[2], v1[3]);
                    *(u32x4*)(rowp + bj * HALF) = w; } }
    }
};
struct EpiBf16S {
    static constexpr bool PERM = true;
    bf16_t* O; int ldc; float s;
    __device__ __forceinline__ void operator()(const f32x4 (&acc)[2][2][4][2], const Unit& u, int wr, int wc, int fr, int fq) const {
        const int row0 = u.pm * BM + wr * 64 + fr, col0 = u.pn * BM + wc * 32 + 8 * fq;
#pragma unroll
        for (int ai = 0; ai < 2; ++ai)
#pragma unroll
            for (int m = 0; m < 4; ++m) { bf16_t* rowp = O + (size_t)(row0 + ai * HALF + m * 16) * ldc + col0;
#pragma unroll
                for (int bj = 0; bj < 2; ++bj) { const f32x4 v0 = acc[ai][bj][m][0] * s, v1 = acc[ai][bj][m][1] * s;
                    u32x4 w; w.x = cvt_pk_bf16(v0[0], v0[1]); w.y = cvt_pk_bf16(v0[2], v0[3]); w.z = cvt_pk_bf16(v1[0], v1[1]); w.w = cvt_pk_bf16(v1[2], v1[3]);
                    *(u32x4*)(rowp + bj * HALF) = w; } }
    }
};
struct EpiBf16Ssq {
    static constexpr bool PERM = true;
    bf16_t* O; int ldc; float* ssq;
    __device__ __forceinline__ void operator()(const f32x4 (&acc)[2][2][4][2], const Unit& u, int wr, int wc, int fr, int fq) const {
        const int row0 = u.pm * BM + wr * 64 + fr, col0 = u.pn * BM + wc * 32 + 8 * fq;
#pragma unroll
        for (int ai = 0; ai < 2; ++ai)
#pragma unroll
            for (int m = 0; m < 4; ++m) { const int row = row0 + ai * HALF + m * 16; bf16_t* rowp = O + (size_t)row * ldc + col0; float s = 0.f;
#pragma unroll
                for (int bj = 0; bj < 2; ++bj) { const f32x4 v0 = acc[ai][bj][m][0], v1 = acc[ai][bj][m][1];
                    s += v0[0] * v0[0] + v0[1] * v0[1] + v0[2] * v0[2] + v0[3] * v0[3] + v1[0] * v1[0] + v1[1] * v1[1] + v1[2] * v1[2] + v1[3] * v1[3];
                    u32x4 w; w.x = cvt_pk_bf16(v0[0], v0[1]); w.y = cvt_pk_bf16(v0[2], v0[3]); w.z = cvt_pk_bf16(v1[0], v1[1]); w.w = cvt_pk_bf16(v1[2], v1[3]);
                    *(u32x4*)(rowp + bj * HALF) = w; }
                s += __shfl_xor(s, 16); s += __shfl_xor(s, 32);
                if (fq == 0) unsafeAtomicAdd(ssq + row, s); }
    }
};
struct EpiBf16Scale {
    static constexpr bool PERM = true;
    bf16_t* O; int ldc; const float* colscale;
    __device__ __forceinline__ void operator()(const f32x4 (&acc)[2][2][4][2], const Unit& u, int wr, int wc, int fr, int fq) const {
        const int row0 = u.pm * BM + wr * 64 + fr, col0 = u.pn * BM + wc * 32 + 8 * fq;
#pragma unroll
        for (int bj = 0; bj < 2; ++bj) { const f32x4 s0 = *(const f32x4*)(colscale + col0 + bj * HALF), s1 = *(const f32x4*)(colscale + col0 + bj * HALF + 4);
#pragma unroll
            for (int ai = 0; ai < 2; ++ai)
#pragma unroll
                for (int m = 0; m < 4; ++m) { bf16_t* rowp = O + (size_t)(row0 + ai * HALF + m * 16) * ldc + col0;
                    const f32x4 v0 = acc[ai][bj][m][0] * s0, v1 = acc[ai][bj][m][1] * s1;
                    u32x4 w; w.x = cvt_pk_bf16(v0[0], v0[1]); w.y = cvt_pk_bf16(v0[2], v0[3]); w.z = cvt_pk_bf16(v1[0], v1[1]); w.w = cvt_pk_bf16(v1[2], v1[3]);
                    *(u32x4*)(rowp + bj * HALF) = w; } }
    }
};
struct EpiResF32 {
    static constexpr bool PERM = false;
    const float* base; float* C; int ldc; int row_off;
    __device__ __forceinline__ void operator()(const f32x4 (&acc)[2][2][4][2], const Unit& u, int wr, int wc, int fr, int fq) const {
        const int row0 = u.pm * BM + wr * 64 + fr + row_off, col0 = u.pn * BM + wc * 32 + 4 * fq;
#pragma unroll
        for (int ai = 0; ai < 2; ++ai)
#pragma unroll
            for (int m = 0; m < 4; ++m) { const size_t off = (size_t)(row0 + ai * HALF + m * 16) * ldc + col0;
#pragma unroll
                for (int bj = 0; bj < 2; ++bj)
#pragma unroll
                    for (int n = 0; n < 2; ++n) { const f32x4 b = *(const f32x4*)(base + off + bj * HALF + n * 16); *(f32x4*)(C + off + bj * HALF + n * 16) = b + acc[ai][bj][m][n]; }
                asm volatile("" ::: "memory"); }
    }
};
template <bool FP8OUT, bool BASEBF, bool WXN = true>
struct EpiResNormT {
    static constexpr bool PERM = false;
    const void* base; bf16_t* C; bf16_t* XN; const float* nw; float* ssq; int ldc; float ascale = 1.0f;
    typedef typename std::conditional<BASEBF, u32x2, f32x4>::type RawT;
    __device__ __forceinline__ RawT ldb(size_t idx) const { if constexpr (BASEBF) return *(const u32x2*)((const bf16_t*)base + idx); else return *(const f32x4*)((const float*)base + idx); }
    static __device__ __forceinline__ f32x4 cv(const RawT& r) { if constexpr (BASEBF) return (f32x4){bf_lo(r.x), bf_hi(r.x), bf_lo(r.y), bf_hi(r.y)}; else return r; }
    __device__ __forceinline__ void operator()(const f32x4 (&acc)[2][2][4][2], const Unit& u, int wr, int wc, int fr, int fq) const {
        const int row0 = u.pm * BM + wr * 64 + fr, col0 = u.pn * BM + wc * 32 + 4 * fq;
        f32x4 wv[2][2];
#pragma unroll
        for (int bj = 0; bj < 2; ++bj)
#pragma unroll
            for (int n = 0; n < 2; ++n) wv[bj][n] = *(const f32x4*)(nw + col0 + bj * HALF + n * 16);
        RawT bv[2][2][2];
#pragma unroll
        for (int bj = 0; bj < 2; ++bj)
#pragma unroll
            for (int n = 0; n < 2; ++n) bv[0][bj][n] = ldb((size_t)row0 * ldc + col0 + bj * HALF + n * 16);
#pragma unroll
        for (int rg = 0; rg < 8; ++rg) { const int ai = rg >> 2, m = rg & 3; const int row = row0 + ai * HALF + m * 16; const size_t off = (size_t)row * ldc + col0;
            if (rg < 7) { const int ai2 = (rg + 1) >> 2, m2 = (rg + 1) & 3; const size_t off2 = (size_t)(row0 + ai2 * HALF + m2 * 16) * ldc + col0;
#pragma unroll
                for (int bj = 0; bj < 2; ++bj)
#pragma unroll
                    for (int n = 0; n < 2; ++n) bv[(rg + 1) & 1][bj][n] = ldb(off2 + bj * HALF + n * 16); }
            float s = 0.f;
#pragma unroll
            for (int bj = 0; bj < 2; ++bj)
#pragma unroll
                for (int n = 0; n < 2; ++n) { const f32x4 v = cv(bv[rg & 1][bj][n]) + acc[ai][bj][m][n] * ascale;
                    { u32x2 c; c.x = cvt_pk_bf16(v[0], v[1]); c.y = cvt_pk_bf16(v[2], v[3]); *(u32x2*)(C + off + bj * HALF + n * 16) = c; }
                    s += v[0] * v[0] + v[1] * v[1] + v[2] * v[2] + v[3] * v[3];
                    if (!WXN) { }
                    else if (FP8OUT) { int pk = __builtin_amdgcn_cvt_pk_fp8_f32(v[0] * wv[bj][n][0], v[1] * wv[bj][n][1], 0, false); pk = __builtin_amdgcn_cvt_pk_fp8_f32(v[2] * wv[bj][n][2], v[3] * wv[bj][n][3], pk, true);
                        *(int*)((unsigned char*)XN + off + bj * HALF + n * 16) = pk; }
                    else { u32x2 o; o.x = cvt_pk_bf16(v[0] * wv[bj][n][0], v[1] * wv[bj][n][1]); o.y = cvt_pk_bf16(v[2] * wv[bj][n][2], v[3] * wv[bj][n][3]);
                        *(u32x2*)(XN + off + bj * HALF + n * 16) = o; } }
            s += __shfl_xor(s, 16); s += __shfl_xor(s, 32);
            if (fq == 0) unsafeAtomicAdd(ssq + row, s);
        }
    }
};
typedef EpiResNormT<false, false, false> EpiResNorm;
typedef EpiResNormT<true, true> EpiResNormF8;
struct EpiCmpGelu {
    static constexpr bool PERM = false;
    float* H; const float* bias;
    __device__ __forceinline__ void operator()(const f32x4 (&acc)[2][2][4][2], const Unit& u, int wr, int wc, int fr, int fq) const {
        const int row0 = u.pm * BM + wr * 64 + fr, col0 = wc * 32 + 4 * fq; const float* bs = bias + (u.pm >> 4) * 256;
        f32x4 bvv[2][2];
#pragma unroll
        for (int bj = 0; bj < 2; ++bj)
#pragma unroll
            for (int n = 0; n < 2; ++n) bvv[bj][n] = *(const f32x4*)(bs + col0 + bj * HALF + n * 16);
#pragma unroll
        for (int ai = 0; ai < 2; ++ai)
#pragma unroll
            for (int m = 0; m < 4; ++m) { float* rowp = H + (size_t)(row0 + ai * HALF + m * 16) * 256 + col0;
#pragma unroll
                for (int bj = 0; bj < 2; ++bj)
#pragma unroll
                    for (int n = 0; n < 2; ++n) { f32x4 v = acc[ai][bj][m][n] + bvv[bj][n];
#pragma unroll
                        for (int j = 0; j < 4; ++j) { const float xx = v[j], uu = 0.7978845608028654f * (xx + 0.044715f * xx * xx * xx); const float th = 1.0f - 2.0f / (1.0f + __expf(2.0f * uu)); v[j] = 0.5f * xx * (1.0f + th); }
                        *(f32x4*)(rowp + bj * HALF + n * 16) = v; } }
    }
};
struct EpiGate {
    static constexpr bool PERM = false;
    float* C; const bf16_t* H; const bf16_t* eraw; const float* erstd; const float* pw; const float* ssq; int ldc; float ascale;
    __device__ __forceinline__ void operator()(const f32x4 (&acc)[2][2][4][2], const Unit& u, int wr, int wc, int fr, int fq) const {
        const int row0 = u.pm * BM + wr * 64 + fr, col0 = u.pn * BM + wc * 32 + 4 * fq;
        f32x4 wv[2][2];
#pragma unroll
        for (int bj = 0; bj < 2; ++bj)
#pragma unroll
            for (int n = 0; n < 2; ++n) wv[bj][n] = *(const f32x4*)(pw + col0 + bj * HALF + n * 16);
        u32x2 bv[2][2][2]; u32x2 ev[2][2][2]; float rsv[2], rgv[2];
#pragma unroll
        for (int bj = 0; bj < 2; ++bj)
#pragma unroll
            for (int n = 0; n < 2; ++n) { bv[0][bj][n] = *(const u32x2*)(H + (size_t)row0 * ldc + col0 + bj * HALF + n * 16); ev[0][bj][n] = *(const u32x2*)(eraw + (size_t)row0 * ldc + col0 + bj * HALF + n * 16); }
        rsv[0] = erstd[row0]; rgv[0] = ssq[row0];
#pragma unroll
        for (int rg = 0; rg < 8; ++rg) { const int ai = rg >> 2, m = rg & 3; const int row = row0 + ai * HALF + m * 16; const size_t off = (size_t)row * ldc + col0;
            if (rg < 7) { const int ai2 = (rg + 1) >> 2, m2 = (rg + 1) & 3; const int row2 = row0 + ai2 * HALF + m2 * 16; const size_t off2 = (size_t)row2 * ldc + col0;
#pragma unroll
                for (int bj = 0; bj < 2; ++bj)
#pragma unroll
                    for (int n = 0; n < 2; ++n) { bv[(rg + 1) & 1][bj][n] = *(const u32x2*)(H + off2 + bj * HALF + n * 16); ev[(rg + 1) & 1][bj][n] = *(const u32x2*)(eraw + off2 + bj * HALF + n * 16); }
                rsv[(rg + 1) & 1] = erstd[row2]; rgv[(rg + 1) & 1] = ssq[row2]; }
            const float rs = rsqrtf(rsv[rg & 1] * (1.0f / DM) + EPS), rg_ = rsqrtf(rgv[rg & 1] * (1.0f / DM) + EPS) * ascale;
#pragma unroll
            for (int bj = 0; bj < 2; ++bj)
#pragma unroll
                for (int n = 0; n < 2; ++n) { const u32x2 br = bv[rg & 1][bj][n]; const f32x4 b = {bf_lo(br.x), bf_hi(br.x), bf_lo(br.y), bf_hi(br.y)}; const u32x2 e = ev[rg & 1][bj][n]; const f32x4 a = acc[ai][bj][m][n]; f32x4 o;
                    o[0] = b[0] + bf_lo(e.x) * rs * wv[bj][n][0] * sigmoidf_(a[0] * rg_); o[1] = b[1] + bf_hi(e.x) * rs * wv[bj][n][1] * sigmoidf_(a[1] * rg_);
                    o[2] = b[2] + bf_lo(e.y) * rs * wv[bj][n][2] * sigmoidf_(a[2] * rg_); o[3] = b[3] + bf_hi(e.y) * rs * wv[bj][n][3] * sigmoidf_(a[3] * rg_);
                    *(f32x4*)(C + off + bj * HALF + n * 16) = o; }
        }
    }
};
struct GFfn {
    const char* A; const char* B; unsigned lda, ldb; int nt;
    __device__ __forceinline__ const char* a_base(const Unit& u) const { return A + ((long)u.pm * 254 - 2) * (long)lda * 2; }
    __device__ __forceinline__ const char* b_base(const Unit& u) const { return B + (size_t)u.pn * 256 * ldb * 2; }
    __device__ __forceinline__ size_t kpairA() const { return 256; }
};
template <int CTRL> __device__ __forceinline__ float dpp_f(float v) { return __int_as_float(__builtin_amdgcn_update_dpp(0, __float_as_int(v), CTRL, 0xf, 0xf, false)); }
struct EpiFfn {
    static constexpr bool PERM = true;
    bf16_t* ACT; const float* cw; const float* cb; LAS float* X; const float* ssq;
    __device__ __forceinline__ void operator()(const f32x4 (&acc)[2][2][4][2], const Unit& u, int wr, int wc, int fr, int fq) const {
        const int colw = wc * 32 + 8 * fq;
        const int f0 = u.pn * 128 + colw;
        f32x4 w0[2], w1[2], w2[2], cbv[2];
#pragma unroll
        for (int n = 0; n < 2; ++n) { w0[n] = *(const f32x4*)(cw + f0 + 4 * n); w1[n] = *(const f32x4*)(cw + DFF + f0 + 4 * n); w2[n] = *(const f32x4*)(cw + 2 * DFF + f0 + 4 * n); cbv[n] = *(const f32x4*)(cb + f0 + 4 * n); }
        float rsv[2][4];
#pragma unroll
        for (int ai = 0; ai < 2; ++ai)
#pragma unroll
            for (int m = 0; m < 4; ++m) { const long t = (long)u.pm * 254 - 2 + ai * HALF + wr * 64 + m * 16 + fr; rsv[ai][m] = ssq[t < 0 ? 0 : (t >= S_ ? S_ - 1 : t)]; }
#pragma unroll
        for (int ai = 0; ai < 2; ++ai)
#pragma unroll
            for (int m = 0; m < 4; ++m) { const long t = (long)u.pm * 254 - 2 + ai * HALF + wr * 64 + m * 16 + fr; rsv[ai][m] = (t >= 0 && t < S_) ? rsqrtf(rsv[ai][m] * (1.0f / DM) + EPS) : 0.f; }
        if (fr >= 14) {
#pragma unroll
            for (int ai = 0; ai < 2; ++ai)
#pragma unroll
                for (int n = 0; n < 2; ++n) *(LAS f32x4*)(X + ((2 * ai + wr) * 2 + (fr - 14)) * 128 + colw + 4 * n) = acc[ai][0][3][n] * rsv[ai][3];
        }
        asm volatile("s_waitcnt lgkmcnt(0)" ::: "memory");
        __builtin_amdgcn_s_barrier(); asm volatile("" ::: "memory");
        __builtin_amdgcn_s_barrier(); asm volatile("" ::: "memory");
        const bool sel1 = fr == 15, sel2 = fr >= 14;
#pragma unroll
        for (int ai = 0; ai < 2; ++ai) {
            f32x4 pv[2];
            const int pseg = 2 * ai + wr - 1;
#pragma unroll
            for (int n = 0; n < 2; ++n) { pv[n] = (f32x4){0.f, 0.f, 0.f, 0.f}; if (pseg >= 0 && fr >= 14) pv[n] = *(const LAS f32x4*)(X + (pseg * 2 + (fr - 14)) * 128 + colw + 4 * n); }
#pragma unroll
            for (int m = 0; m < 4; ++m) {
                const int r = ai * HALF + wr * 64 + m * 16 + fr; const long t = (long)u.pm * 254 - 2 + r;
                unsigned ow[4];
#pragma unroll
                for (int n = 0; n < 2; ++n) {
                    const f32x4 cur = acc[ai][0][m][n] * rsv[ai][m], up = acc[ai][1][m][n] * rsv[ai][m];
                    f32x4 x1, x2;
#pragma unroll
                    for (int i = 0; i < 4; ++i) { x1[i] = dpp_f<0x121>(sel1 ? pv[n][i] : cur[i]); x2[i] = dpp_f<0x122>(sel2 ? pv[n][i] : cur[i]); }
                    const f32x4 y = cbv[n] + w0[n] * x2 + w1[n] * x1 + w2[n] * cur;
                    f32x4 sg;
#pragma unroll
                    for (int i = 0; i < 4; ++i) sg[i] = sigmoidf_(y[i]);
                    const f32x4 o = y * sg * up;
                    ow[2 * n] = cvt_pk_bf16(o[0], o[1]); ow[2 * n + 1] = cvt_pk_bf16(o[2], o[3]);
                    pv[n] = cur;
                }
                if (r >= 2 && t < S_) *(u32x4*)(ACT + (size_t)t * DFF + f0) = (u32x4){ow[0], ow[1], ow[2], ow[3]};
            }
        }
    }
};

template <class GD, class Epi, bool F8T = false, int MIXT = 0>
__device__ __forceinline__ void gemm_phase(LAS unsigned char* lds, const GD g, const StaticOrder& S, const Epi& E) {
    constexpr bool F8 = F8T;
    const int tid = threadIdx.x, wid = __builtin_amdgcn_readfirstlane(tid >> 6), lane = tid & 63, wr = wid >> 2, wc = wid & 3, fr = lane & 15, fq = lane >> 4;
    const int nt = g.nt;
    unsigned voffA[2], voffB[2];
#pragma unroll
    for (int i = 0; i < 2; ++i) { int R, C; stage_rc(tid * 16 + i * 8192, R, C); const int Rb = Epi::PERM ? ((R & ~31) + perm32(R & 31)) : R;
        voffA[i] = (unsigned)(R * g.lda + C) * 2u; voffB[i] = (unsigned)(Rb * g.ldb + C) * 2u; }
    const size_t kpA = g.kpairA();
    const size_t hstepA = (size_t)HALF * g.lda * 2, hstepB = (size_t)HALF * g.ldb * 2;
    const unsigned ldsw = (unsigned)wid * 1024u;
    const int aoff = lds_byte(wr * 64 + fr, fq * 8), boff = lds_byte(wc * 32 + fr, fq * 8);
#define PG8_SA(b, h) (((b) * 2 + (h)) * HTB)
#define PG8_SB(b, h) ((4 + (b) * 2 + (h)) * HTB)
#define PG8_STAGE(bufoff, gbase, voff) do { _Pragma("unroll") for (int _i = 0; _i < 2; ++_i) \
        __builtin_amdgcn_global_load_lds((const unsigned*)((const char*)(gbase) + (voff)[_i]), (LAS unsigned*)(lds + (bufoff) + ldsw + _i * 8192), 16, 0, 0); } while (0)
#define PG8_LDA(dst, b, h) do { if constexpr (F8) { _Pragma("unroll") for (int m = 0; m < 4; ++m) { const i32x4 lo_ = *(const LAS i32x4*)(lds + PG8_SA(b, h) + aoff + m * 2048), hi_ = *(const LAS i32x4*)(lds + PG8_SA(b, h) + aoff + m * 2048 + 1024); \
            dst##8[m] = __builtin_shufflevector(lo_, hi_, 0, 1, 2, 3, 4, 5, 6, 7); } } \
        else { _Pragma("unroll") for (int m = 0; m < 4; ++m) _Pragma("unroll") for (int k = 0; k < 2; ++k) dst[m][k] = *(const LAS bf16x8*)(lds + PG8_SA(b, h) + aoff + m * 2048 + k * 1024); } } while (0)
#define PG8_LDB(dst, b, h) do { if constexpr (F8) { _Pragma("unroll") for (int n = 0; n < 2; ++n) { const i32x4 lo_ = *(const LAS i32x4*)(lds + PG8_SB(b, h) + boff + n * 2048), hi_ = *(const LAS i32x4*)(lds + PG8_SB(b, h) + boff + n * 2048 + 1024); \
            dst##8[n] = __builtin_shufflevector(lo_, hi_, 0, 1, 2, 3, 4, 5, 6, 7); } } \
        else { _Pragma("unroll") for (int n = 0; n < 2; ++n) _Pragma("unroll") for (int k = 0; k < 2; ++k) dst[n][k] = *(const LAS bf16x8*)(lds + PG8_SB(b, h) + boff + n * 2048 + k * 1024); } } while (0)
#define PG8_MMA(ai, bj, At, Bt) do { __builtin_amdgcn_s_setprio(1); \
        if constexpr (F8) { _Pragma("unroll") for (int m = 0; m < 4; ++m) _Pragma("unroll") for (int n = 0; n < 2; ++n) \
            asm volatile("v_mfma_scale_f32_16x16x128_f8f6f4 %0, %1, %2, %0, %3, %3 op_sel_hi:[0,0,0]" : "+v"(acc[ai][bj][m][n]) : "v"(Bt##8[n]), "v"(At##8[m]), "v"(one_scale)); } \
        else { _Pragma("unroll") for (int m = 0; m < 4; ++m) _Pragma("unroll") for (int n = 0; n < 2; ++n) _Pragma("unroll") for (int k = 0; k < 2; ++k) \
            acc[ai][bj][m][n] = __builtin_amdgcn_mfma_f32_16x16x32_bf16(Bt[n][k], At[m][k], acc[ai][bj][m][n], 0, 0, 0); } \
        __builtin_amdgcn_s_setprio(0); } while (0)
#define PG8_WAIT_V(n) asm volatile("s_waitcnt vmcnt(" #n ")" ::: "memory")
#define PG8_WAIT_L(n) asm volatile("s_waitcnt lgkmcnt(" #n ")" ::: "memory")
#define PG8_BAR __builtin_amdgcn_s_barrier()
#define PG8_SCHED __builtin_amdgcn_sched_barrier(0)
#define PG8_BODY \
            PG8_LDB(B0, 0, 0); PG8_SCHED; PG8_LDA(At, 0, 0); PG8_STAGE(PG8_SA(1, 1), a1 + hstepA, voffA); \
            PG8_WAIT_L(8); PG8_BAR; PG8_WAIT_L(0); PG8_MMA(0, 0, At, B0); PG8_BAR; PG8_SCHED; \
            PG8_LDB(B1, 0, 1); PG8_STAGE(PG8_SB(0, 0), b2, voffB); \
            PG8_BAR; PG8_WAIT_L(0); PG8_MMA(0, 1, At, B1); PG8_BAR; \
            PG8_LDA(At, 0, 1); PG8_STAGE(PG8_SA(0, 0), a2, voffA); \
            PG8_BAR; PG8_WAIT_L(0); PG8_MMA(1, 0, At, B0); PG8_BAR; PG8_SCHED; \
            PG8_STAGE(PG8_SB(0, 1), b2 + hstepB, voffB); \
            PG8_WAIT_V(6); PG8_BAR; PG8_MMA(1, 1, At, B1); PG8_BAR; \
            PG8_LDB(B0, 1, 0); PG8_SCHED; PG8_LDA(At, 1, 0); PG8_STAGE(PG8_SA(0, 1), a2 + hstepA, voffA); \
            PG8_WAIT_L(8); PG8_BAR; PG8_WAIT_L(0); PG8_MMA(0, 0, At, B0); PG8_BAR; PG8_SCHED; \
            PG8_LDB(B1, 1, 1); PG8_STAGE(PG8_SB(1, 0), b3, voffB); \
            PG8_BAR; PG8_WAIT_L(0); PG8_MMA(0, 1, At, B1); PG8_BAR; \
            PG8_LDA(At, 1, 1); PG8_STAGE(PG8_SA(1, 0), a3, voffA); \
            PG8_BAR; PG8_WAIT_L(0); PG8_MMA(1, 0, At, B0); PG8_BAR; PG8_SCHED; \
            PG8_STAGE(PG8_SB(1, 1), b3 + hstepB, voffB); \
            PG8_WAIT_V(6); PG8_BAR; PG8_MMA(1, 1, At, B1); PG8_BAR;
    Unit cur, nxt; int ui = 0;
    if (!S.next(0, cur)) return;
    f32x4 acc[2][2][4][2];
#pragma unroll
    for (int a = 0; a < 2; ++a)
#pragma unroll
        for (int b = 0; b < 2; ++b)
#pragma unroll
            for (int m = 0; m < 4; ++m)
#pragma unroll
                for (int n = 0; n < 2; ++n) acc[a][b][m][n] = (f32x4){0.f, 0.f, 0.f, 0.f};
    bf16x8 At[4][2], B0[2][2], B1[2][2];
    i32x8 At8[4], B08[2], B18[2];
    (void)At; (void)B0; (void)B1; (void)At8; (void)B08; (void)B18;
    int one_scale = 0x7F7F7F7F; (void)one_scale;
    const char* cA = g.a_base(cur); const char* cB = g.b_base(cur);
    PG8_STAGE(PG8_SB(0, 0), cB, voffB); PG8_STAGE(PG8_SA(0, 0), cA, voffA); PG8_STAGE(PG8_SB(0, 1), cB + hstepB, voffB); PG8_STAGE(PG8_SA(0, 1), cA + hstepA, voffA);
    if (wr == 1) PG8_BAR;
    PG8_WAIT_V(4); PG8_BAR;
    PG8_STAGE(PG8_SB(1, 0), cB + 128, voffB); PG8_STAGE(PG8_SA(1, 0), cA + 128, voffA); PG8_STAGE(PG8_SB(1, 1), cB + hstepB + 128, voffB);
    PG8_WAIT_V(6); PG8_BAR;
    for (;;) {
        const bool has_next = S.next(ui + 1, nxt);
        const char* nA = has_next ? g.a_base(nxt) : cA; const char* nB = has_next ? g.b_base(nxt) : cB;
#define PG8_ADDR const bool last = (t == nt - 2); const char* a0 = cA + (size_t)(t >> 1) * kpA; const char* a1 = a0 + 128; \
            const char* a2 = last ? nA : a0 + kpA; const char* b2 = last ? nB : cB + (size_t)(t + 2) * 128; const char* a3 = a2 + 128; const char* b3 = b2 + 128;
        if constexpr (MIXT > 0) {
            for (int t = 0; t < MIXT; t += 2) { PG8_ADDR PG8_BODY }
            for (int t = MIXT; t < nt; t += 2) { constexpr bool F8 = true; (void)F8; PG8_ADDR PG8_BODY }
        } else {
            for (int t = 0; t < nt; t += 2) { PG8_ADDR PG8_BODY }
        }
#undef PG8_ADDR
        if constexpr (F8 || MIXT > 0) asm volatile("s_nop 15\n\ts_nop 15\n\ts_nop 15" ::: "memory");
        E(acc, cur, wr, wc, fr, fq);
        if (!has_next) break;
#pragma unroll
        for (int a = 0; a < 2; ++a)
#pragma unroll
            for (int b = 0; b < 2; ++b)
#pragma unroll
                for (int m = 0; m < 4; ++m)
#pragma unroll
                    for (int n = 0; n < 2; ++n) acc[a][b][m][n] = (f32x4){0.f, 0.f, 0.f, 0.f};
        cur = nxt; cA = nA; cB = nB; ++ui;
    }
    PG8_WAIT_V(0);
    if (wr == 0) PG8_BAR;
    PG8_BAR;
#undef PG8_SA
#undef PG8_SB
#undef PG8_STAGE
#undef PG8_LDA
#undef PG8_LDB
#undef PG8_MMA
#undef PG8_WAIT_V
#undef PG8_WAIT_L
#undef PG8_BAR
#undef PG8_SCHED
#undef PG8_BODY
}
}

namespace att {
constexpr int KVBLK = 64;
constexpr int SHM_V = KVBLK * HD * 2, SHM_K = KVBLK * HD * 2, SHM_ATTN = 2 * SHM_V + 2 * SHM_K + NWAVES * 64 * 4;
#define KSWZ(row, colB) ((row) * 256 + ((colB) ^ (((row) & 7) << 4)))
#define SBAR() __builtin_amdgcn_sched_barrier(0)
__device__ __forceinline__ int crow(int r, int hi) { return (r & 3) + 8 * (r >> 2) + 4 * hi; }
__device__ __forceinline__ void qkt(f32x16& p0, f32x16& p1, const char* Ks, const bf16x8* qr, int r32, int hi) {
    p0 = f32x16{}; p1 = f32x16{};
    bf16x8 ka[2], kb[2];
    { const int cb = (hi * 8) * 2; ka[0] = *reinterpret_cast<const bf16x8*>(Ks + KSWZ(r32, cb)); kb[0] = *reinterpret_cast<const bf16x8*>(Ks + KSWZ(32 + r32, cb)); }
#pragma unroll
    for (int d0 = 0; d0 < 8; ++d0) {
        if (d0 < 7) { const int cb = ((d0 + 1) * 16 + hi * 8) * 2;
            ka[(d0 + 1) & 1] = *reinterpret_cast<const bf16x8*>(Ks + KSWZ(r32, cb)); kb[(d0 + 1) & 1] = *reinterpret_cast<const bf16x8*>(Ks + KSWZ(32 + r32, cb)); }
        SBAR();
        p0 = __builtin_amdgcn_mfma_f32_32x32x16_bf16(ka[d0 & 1], qr[d0], p0, 0, 0, 0);
        p1 = __builtin_amdgcn_mfma_f32_32x32x16_bf16(kb[d0 & 1], qr[d0], p1, 0, 0, 0);
        SBAR();
    }
}
__device__ __forceinline__ int v_st(int k, int c) { const int kk = (k & ~0xC) | ((k & 4) << 1) | ((k & 8) >> 1); return ((kk >> 3) * 4 + (c >> 5)) * 512 + ((kk & 7) * 32 + (c & 31)) * 2; }
__device__ __forceinline__ int v_rd_base(int lane) { return ((lane & 3) << 3) | (((lane >> 2) & 3) << 6) | (((lane >> 4) & 1) << 5) | (((lane >> 5) & 1) << 8); }
constexpr int v_rd_off(int d0, int ks, int half) { return d0 * 512 + ks * 4096 + half * 2048; }
__device__ __forceinline__ s16x4 tr_read(int vb, int off) { return __builtin_amdgcn_ds_read_tr16_b64_v4i16((LAS s16x4*)(unsigned long)(unsigned)(vb + off)); }
__device__ __forceinline__ void pv_d0(f32x16* o, int vb, bf16x8 pa0, bf16x8 pa1, bf16x8 pa2, bf16x8 pa3) {
    s16x4 L[2][4], H[2][4];
#pragma unroll
    for (int d0 = 0; d0 < 4; ++d0) { L[0][d0] = tr_read(vb, v_rd_off(d0, 0, 0)); H[0][d0] = tr_read(vb, v_rd_off(d0, 0, 1)); }
#pragma unroll
    for (int ks = 0; ks < 4; ++ks) {
        if (ks < 3) {
#pragma unroll
            for (int d0 = 0; d0 < 4; ++d0) { L[(ks + 1) & 1][d0] = tr_read(vb, v_rd_off(d0, ks + 1, 0)); H[(ks + 1) & 1][d0] = tr_read(vb, v_rd_off(d0, ks + 1, 1)); }
        }
        const bf16x8 pa = ks == 0 ? pa0 : (ks == 1 ? pa1 : (ks == 2 ? pa2 : pa3));
#pragma unroll
        for (int d0 = 0; d0 < 4; ++d0) { const s16x4 l = L[ks & 1][d0], h = H[ks & 1][d0];
            o[d0] = __builtin_amdgcn_mfma_f32_32x32x16_bf16(pa, (bf16x8){l[0], l[1], l[2], l[3], h[0], h[1], h[2], h[3]}, o[d0], 0, 0, 0); }
    }
}
__device__ __forceinline__ void pack_p(const f32x16& p0, const f32x16& p1, bf16x8& pa0, bf16x8& pa1, bf16x8& pa2, bf16x8& pa3) {
#define PK4(P, BASE, OUT) do { unsigned a0 = cvt_pk_bf16(P[BASE + 0], P[BASE + 1]), a1 = cvt_pk_bf16(P[BASE + 2], P[BASE + 3]);   \
    unsigned b0 = cvt_pk_bf16(P[BASE + 4], P[BASE + 5]), b1 = cvt_pk_bf16(P[BASE + 6], P[BASE + 7]);                              \
    auto r0 = __builtin_amdgcn_permlane32_swap(a0, b0, false, false); auto r1 = __builtin_amdgcn_permlane32_swap(a1, b1, false, false); \
    u32x4 w = {r0[0], r1[0], r0[1], r1[1]}; OUT = *reinterpret_cast<bf16x8*>(&w); } while (0)
    PK4(p0, 0, pa0); PK4(p0, 8, pa1); PK4(p1, 0, pa2); PK4(p1, 8, pa3);
#undef PK4
}

__device__ __forceinline__ void pack_half(const f32x16& p, bf16x8& paA, bf16x8& paB) {
#define PK4(P, BASE, OUT) do { unsigned a0 = cvt_pk_bf16(P[BASE + 0], P[BASE + 1]), a1 = cvt_pk_bf16(P[BASE + 2], P[BASE + 3]);   \
    unsigned b0 = cvt_pk_bf16(P[BASE + 4], P[BASE + 5]), b1 = cvt_pk_bf16(P[BASE + 6], P[BASE + 7]);                              \
    auto r0 = __builtin_amdgcn_permlane32_swap(a0, b0, false, false); auto r1 = __builtin_amdgcn_permlane32_swap(a1, b1, false, false); \
    u32x4 w = {r0[0], r1[0], r0[1], r1[1]}; OUT = *reinterpret_cast<bf16x8*>(&w); } while (0)
    PK4(p, 0, paA); PK4(p, 8, paB);
#undef PK4
}
template <int KS0, bool WITH_EXP>
__device__ __forceinline__ void pv_half(f32x16* o, int vb, bf16x8 paA, bf16x8 paB, f32x16& px, float off) {
    s16x4 L[2][4], H[2][4];
#pragma unroll
    for (int d0 = 0; d0 < 4; ++d0) { L[0][d0] = tr_read(vb, v_rd_off(d0, KS0, 0)); H[0][d0] = tr_read(vb, v_rd_off(d0, KS0, 1)); }
#pragma unroll
    for (int d0 = 0; d0 < 4; ++d0) { L[1][d0] = tr_read(vb, v_rd_off(d0, KS0 + 1, 0)); H[1][d0] = tr_read(vb, v_rd_off(d0, KS0 + 1, 1)); }
#pragma unroll
    for (int kk = 0; kk < 2; ++kk) {
        const bf16x8 pa = kk == 0 ? paA : paB;
#pragma unroll
        for (int d0 = 0; d0 < 4; ++d0) { const s16x4 l = L[kk][d0], h = H[kk][d0];
            if (WITH_EXP) SBAR();
            o[d0] = __builtin_amdgcn_mfma_f32_32x32x16_bf16(pa, (bf16x8){l[0], l[1], l[2], l[3], h[0], h[1], h[2], h[3]}, o[d0], 0, 0, 0);
            if (WITH_EXP) {
#pragma unroll
                for (int q = 0; q < 2; ++q) { const int r = (kk * 4 + d0) * 2 + q; px[r] = __builtin_amdgcn_exp2f(fmaf(px[r], SM_C, off)); }
                SBAR(); }
        }
    }
}
enum { MODE_CMP = 0, MODE_WIN = 1, MODE_SLC = 2 };
struct AttnArgs {
    const bf16_t* Z; const bf16_t* KC; const bf16_t* VC; const float* G; float* L; float* OACC; bf16_t* MIX; const unsigned* BM; const float* TAB;
};
template <int MODE>
__device__ __forceinline__ void attn_unit(const AttnArgs& a, LAS char* ldsL, int qt, int g, int hp) {
    char* lds = (char*)ldsL;
    const int tid = threadIdx.x, wid = __builtin_amdgcn_readfirstlane(tid >> 6), lane = tid & 63, r32 = lane & 31, hi = lane >> 5;
    float* li_l = (float*)(lds + LDS_XCH) + wid * 64;
    const int t0 = MODE == MODE_SLC ? qt * 40 : qt * 128;
    const int tq_raw = MODE == MODE_SLC ? t0 + wid * 5 + r32 / 6 : t0 + wid * 16 + (r32 & 15);
    const bool rvalid = MODE == MODE_SLC ? (r32 < 30 && tq_raw < S_) : true;
    const int tq = tq_raw < S_ ? tq_raw : S_ - 1;
    const int hq = MODE == MODE_SLC ? g * HPG + r32 % 6 : g * HPG + hp * 2 + (r32 >> 4);
    const int tlast = MODE == MODE_SLC ? ((t0 + 39) < S_ ? (t0 + 39) : S_ - 1) : t0 + 127;
    const bf16_t* Kb; const bf16_t* Vb; long ldk;
    if (MODE == MODE_CMP) { Kb = a.KC + (size_t)g * 1024 * HD; Vb = a.VC + (size_t)g * 1024 * HD; ldk = HD; }
    else if (MODE == MODE_WIN) { Kb = a.Z + OFF_KV + 4 * 512 + g * HD; Vb = a.Z + OFF_KV + 5 * 512 + g * HD; ldk = LDZ; }
    else { Kb = a.Z + OFF_KV + 2 * 512 + g * HD; Vb = a.Z + OFF_KV + 3 * 512 + g * HD; ldk = LDZ; }
    int j0, j1;
    if (MODE == MODE_CMP) { j0 = 0; j1 = (((t0 + 127 - 31) >> 4) >> 6) + 1; }
    else if (MODE == MODE_WIN) { j0 = (t0 - 511) > 0 ? ((t0 - 511) >> 6) : 0; j1 = ((t0 + 127) >> 6) + 1; }
    else { j0 = 0; j1 = (tlast >> 6) + 1; }
    int klo, khi;
    if (MODE == MODE_CMP) { klo = 0; khi = tq >= 31 ? ((tq - 31) >> 4) : -1; }
    else if (MODE == MODE_WIN) { klo = tq - 511; khi = tq; }
    else { klo = 0; khi = rvalid ? tq : -1; }
    float negBC = -a.TAB[512 + (MODE == MODE_CMP ? 0 : (MODE == MODE_SLC ? 1 : 2))];
    bf16x8 qr[8];
    { const bf16_t* Qw = a.Z + (size_t)tq * LDZ + OFF_Q + hq * HD + hi * 8;
#pragma unroll
      for (int d0 = 0; d0 < 8; ++d0) qr[d0] = *reinterpret_cast<const bf16x8*>(Qw + d0 * 16); }
    f32x16 o[4] = {}; float lsum = 0.f;
    unsigned soK[2], soV[2];
#pragma unroll
    for (int i = 0; i < 2; ++i) { const int p = (wid + 8 * i) * 64 + lane;
        { const int row = p >> 4, c = (p & 15) ^ (row & 7); soK[i] = (unsigned)(row * ldk + c * 8) * 2u; }
        { const int sub = p >> 5, within = p & 31, kk = (sub >> 2) * 8 + (within >> 2), c = (sub & 3) * 32 + (within & 3) * 8, k = (kk & ~0xC) | ((kk & 4) << 1) | ((kk & 8) >> 1);
          soV[i] = (unsigned)(k * ldk + c) * 2u; } }
    const int vb0 = (int)(uintptr_t)(LAS char*)ldsL + 16384 + v_rd_base(lane);
#define ISSUE(jt) do { const int _b = ((jt) - j0) & 3; const char* _kp = (const char*)Kb + (size_t)(jt) * KVBLK * ldk * 2; const char* _vp = (const char*)Vb + (size_t)(jt) * KVBLK * ldk * 2; \
    _Pragma("unroll") for (int _i = 0; _i < 2; ++_i) { \
        __builtin_amdgcn_global_load_lds((const unsigned*)(_kp + soK[_i]), (LAS unsigned*)(ldsL + _b * 32768 + (wid + 8 * _i) * 1024), 16, 0, 0); \
        __builtin_amdgcn_global_load_lds((const unsigned*)(_vp + soV[_i]), (LAS unsigned*)(ldsL + _b * 32768 + 16384 + (wid + 8 * _i) * 1024), 16, 0, 0); } } while (0)
    unsigned bmw = 0u;
    if (MODE == MODE_SLC) bmw = a.BM[((size_t)tq * 4 + g) * 8];
    asm volatile("s_waitcnt lgkmcnt(0)" ::: "memory");
    __builtin_amdgcn_s_barrier();
    asm volatile("" ::: "memory");
    ISSUE(j0);
    asm volatile("s_waitcnt vmcnt(4) lgkmcnt(0)" : "+v"(bmw), "+v"(negBC), "+v"(qr[0]), "+v"(qr[1]), "+v"(qr[2]), "+v"(qr[3]), "+v"(qr[4]), "+v"(qr[5]), "+v"(qr[6]), "+v"(qr[7]) :: "memory");
    if (j0 + 1 < j1) ISSUE(j0 + 1); if (j0 + 2 < j1) ISSUE(j0 + 2);
    for (int j = j0; j < j1; ++j) {
        const int buf = (j - j0) & 3;
        if (j + 2 < j1) asm volatile("s_waitcnt vmcnt(8)" ::: "memory"); else if (j + 1 < j1) asm volatile("s_waitcnt vmcnt(4)" ::: "memory"); else asm volatile("s_waitcnt vmcnt(0)" ::: "memory");
        __builtin_amdgcn_s_barrier();
        asm volatile("" ::: "memory");
        if (j + 3 < j1) ISSUE(j + 3);
        int lhi = khi;
        if (MODE == MODE_SLC) { if (!((bmw >> (j & 31)) & 1u)) lhi = -1; }
        const int kb = j * KVBLK;
        const bool l_any = (kb + 63 >= klo) && (kb <= lhi);
        const bool l_full = (kb >= klo) && (kb + 63 <= lhi);
        if (__any(l_any)) {
            f32x16 p0, p1;
            qkt(p0, p1, lds + buf * 32768, qr, r32, hi);
            const bool uni = __all(l_full || !l_any);
            const float off = (uni && !l_any) ? -1.0e30f : negBC;
#pragma unroll
            for (int r = 0; r < 16; ++r) p0[r] = __builtin_amdgcn_exp2f(fmaf(p0[r], SM_C, off));
            if (!uni) {
#pragma unroll
                for (int r = 0; r < 16; ++r) { const int k0i = kb + crow(r, hi); p0[r] = (k0i >= klo && k0i <= lhi) ? p0[r] : 0.f; } }
            float ps = 0.f;
#pragma unroll
            for (int r = 0; r < 16; ++r) ps += p0[r];
            bf16x8 pa0, pa1, pa2, pa3; pack_half(p0, pa0, pa1);
            pv_half<0, true>(o, vb0 + buf * 32768, pa0, pa1, p1, off);
            if (!uni) {
#pragma unroll
                for (int r = 0; r < 16; ++r) { const int k1i = kb + 32 + crow(r, hi); p1[r] = (k1i >= klo && k1i <= lhi) ? p1[r] : 0.f; } }
#pragma unroll
            for (int r = 0; r < 16; ++r) ps += p1[r];
            lsum += ps;
            pack_half(p1, pa2, pa3);
            pv_half<2, false>(o, vb0 + buf * 32768, pa2, pa3, p1, off);
        }
        if (MODE == MODE_SLC) { if (((j + 1) & 31) == 0 && j + 1 < j1) { bmw = a.BM[((size_t)tq * 4 + g) * 8 + ((j + 1) >> 5)]; asm volatile("s_waitcnt vmcnt(0)" : "+v"(bmw) :: "memory"); } }
    }
#undef ISSUE
    lsum += __shfl_xor(lsum, 32);
    const float grow = a.G[(size_t)tq * NGATE + hq * 3 + (MODE == MODE_CMP ? 0 : (MODE == MODE_SLC ? 1 : 2))];
    if (hi == 0) { li_l[r32] = lsum; li_l[32 + r32] = rvalid ? grow : 0.f; }
    if (MODE == MODE_CMP) { if (hi == 0) a.L[(size_t)tq * NH + hq] = lsum; }
    asm volatile("s_waitcnt lgkmcnt(0)" ::: "memory");
#pragma unroll
    for (int hf = 0; hf < 2; ++hf) {
        float gtv[8]; float pvv[8][4];
#pragma unroll
        for (int rr = 0; rr < 8; ++rr) { const int r = hf * 8 + rr;
            const int orow = crow(r, hi); const float lv = li_l[orow]; const float rl = lv > 0.f ? __builtin_amdgcn_rcpf(lv) : 0.f;
            const int t = MODE == MODE_SLC ? t0 + wid * 5 + orow / 6 : t0 + wid * 16 + (orow & 15);
            const int h = MODE == MODE_SLC ? g * HPG + orow % 6 : g * HPG + hp * 2 + (orow >> 4);
            const bool valid = !(MODE == MODE_SLC && (orow >= 30 || t >= S_)); const int tc = valid ? t : 0;
            gtv[rr] = li_l[32 + orow] * rl;
            if (MODE == MODE_SLC) { const bf16_t* oc = (const bf16_t*)a.OACC + (size_t)tc * 3072 + h * HD + r32; const bf16_t* ow = oc + (size_t)S_ * 3072;
#pragma unroll
                for (int d0 = 0; d0 < 4; ++d0) pvv[rr][d0] = bf2f(oc[d0 * 32]) + bf2f(ow[d0 * 32]); }
        }
#pragma unroll
        for (int rr = 0; rr < 8; ++rr) { const int r = hf * 8 + rr;
            const int orow = crow(r, hi);
            const int t = MODE == MODE_SLC ? t0 + wid * 5 + orow / 6 : t0 + wid * 16 + (orow & 15);
            const int h = MODE == MODE_SLC ? g * HPG + orow % 6 : g * HPG + hp * 2 + (orow >> 4);
            if (MODE == MODE_SLC && (orow >= 30 || t >= S_)) continue;
            bf16_t* oa = (bf16_t*)a.OACC + (MODE == MODE_WIN ? (size_t)S_ * 3072 : 0) + (size_t)t * 3072 + h * HD + r32;
#pragma unroll
            for (int d0 = 0; d0 < 4; ++d0) {
                const float v = o[d0][r] * gtv[rr];
                if (MODE != MODE_SLC) oa[d0 * 32] = (bf16_t)(cvt_pk_bf16(v, 0.f) & 0xffffu);
                else a.MIX[(size_t)t * DM + POOLW + h * HD + d0 * 32 + r32] = (bf16_t)(cvt_pk_bf16(pvv[rr][d0] + v, 0.f) & 0xffffu);
            }
        }
    }
}

constexpr float QS16 = SM_C * 8.0f;
constexpr int SLC_KPS = 1040, SLC_VPS = 1056, SLC_KIMG = 8 * SLC_KPS, SLC_BUF = SLC_KIMG + 16 * SLC_VPS, SLC_NBUF = 6, LDS_SLCX = SLC_NBUF * SLC_BUF;
static_assert(LDS_SLCX + 3072 <= LDS_MISC, "slc ring overlaps the barrier words");
__device__ __forceinline__ bf16x8 lds_b128(int adr) { return *reinterpret_cast<const LAS bf16x8*>((LAS char*)(unsigned long)(unsigned)adr); }
template <int MODE16>
__device__ __forceinline__ void slc16_unit(const AttnArgs& a, LAS char* ldsL, int ut, int g) {
    constexpr bool WIN16 = MODE16 == 1, CMP16 = MODE16 == 2, DENSE16 = MODE16 != 0;
    char* lds = (char*)ldsL;
    const int tid = threadIdx.x, wid = __builtin_amdgcn_readfirstlane(tid >> 6), lane = tid & 63, fr = lane & 15, fq = lane >> 4;
    float* li_l = (float*)(lds + LDS_SLCX) + wid * 96;
    const int t0 = ut * 64, j0 = WIN16 ? (ut > 8 ? ut - 8 : 0) : 0, j1 = CMP16 ? (((t0 + 63 - 31) >> 4) >> 6) + 1 : ut + 1;
    const bf16_t* Vb = CMP16 ? a.VC + (size_t)g * 1024 * HD : a.Z + OFF_KV + (WIN16 ? 5 : 3) * 512 + g * HD; const long ldk = CMP16 ? HD : LDZ;
    const unsigned char* K8 = (const unsigned char*)a.MIX + ((CMP16 ? WS_K8C : (WIN16 ? WS_K8W : WS_K8)) - WS_MIX) + g * HD;
    int tqv[3];
#pragma unroll
    for (int b = 0; b < 3; ++b) tqv[b] = t0 + wid * 8 + (16 * b + fr) / 6;
#define TQC(b) tqv[b]
#define HQ(b) (g * HPG + (16 * (b) + fr) % 6)
    float negBC = -a.TAB[CMP16 ? 512 : (WIN16 ? 514 : 513)];
    bf16x8 qraw[3][4];
#pragma unroll
    for (int b = 0; b < 3; ++b) { const bf16_t* qp = a.Z + (size_t)TQC(b) * LDZ + OFF_Q + HQ(b) * HD + fq * 32;
#pragma unroll
        for (int ks = 0; ks < 4; ++ks) qraw[b][ks] = *reinterpret_cast<const bf16x8*>(qp + ks * 8); }
    f32x4 o[3][8]; float lsum[3];
#pragma unroll
    for (int b = 0; b < 3; ++b) { lsum[b] = 0.f;
#pragma unroll
        for (int c = 0; c < 8; ++c) o[b][c] = (f32x4){0.f, 0.f, 0.f, 0.f}; }
    const int q4 = fr >> 2, p4 = fr & 3, lbase = (int)(uintptr_t)ldsL;
    const int kaddr0 = lbase + (fr & 7) * SLC_KPS + (fr >> 3) * 128 + fq * 32;
    const int vaddr0 = lbase + SLC_KIMG + (4 * fq + q4) * SLC_VPS + (p4 >> 1) * 16 + (p4 & 1) * 8;
    unsigned so0 = (unsigned)((wid + 16 * (lane >> 4)) * ldk + (lane & 15) * 8) * 2u, so8 = (unsigned)((wid + 8 * (lane >> 3)) * (4 * HD) + (lane & 7) * 16);
#define ISSUE16(jt) do { const int _b = (jt) % SLC_NBUF; const char* _vp = (const char*)Vb + (size_t)(jt) * KVBLK * ldk * 2; asm volatile("" : "+v"(so0), "+v"(so8)); \
    __builtin_amdgcn_global_load_lds((const unsigned*)(K8 + (size_t)(jt) * KVBLK * (4 * HD) + so8), (LAS unsigned*)(ldsL + _b * SLC_BUF + wid * SLC_KPS), 16, 0, 0); \
    _Pragma("unroll") for (int _i = 0; _i < 2; ++_i) \
        __builtin_amdgcn_global_load_lds((const unsigned*)(_vp + _i * (8 * ldk * 2) + so0), (LAS unsigned*)(ldsL + _b * SLC_BUF + SLC_KIMG + (wid + 8 * _i) * SLC_VPS), 16, 0, 0); } while (0)
    unsigned bmw[3];
#pragma unroll
    for (int b = 0; b < 3; ++b) bmw[b] = DENSE16 ? 0xffffffffu : a.BM[((size_t)TQC(b) * 4 + g) * 8];
    asm volatile("s_waitcnt lgkmcnt(0)" ::: "memory");
    __builtin_amdgcn_s_barrier();
    asm volatile("" ::: "memory");
    ISSUE16(j0); if (j0 + 1 < j1) ISSUE16(j0 + 1); if (j0 + 2 < j1) ISSUE16(j0 + 2);
    asm volatile("s_waitcnt vmcnt(0) lgkmcnt(0)" : "+v"(bmw[0]), "+v"(bmw[1]), "+v"(bmw[2]), "+v"(negBC), "+v"(qraw[0][0]), "+v"(qraw[0][1]), "+v"(qraw[0][2]), "+v"(qraw[0][3]),
                 "+v"(qraw[1][0]), "+v"(qraw[1][1]), "+v"(qraw[1][2]), "+v"(qraw[1][3]), "+v"(qraw[2][0]), "+v"(qraw[2][1]), "+v"(qraw[2][2]), "+v"(qraw[2][3]) :: "memory");
    i32x8 qf[3];
#pragma unroll
    for (int b = 0; b < 3; ++b)
#pragma unroll
        for (int ks = 0; ks < 4; ++ks) { const bf16x8 r = qraw[b][ks];
            int p0 = __builtin_amdgcn_cvt_pk_fp8_f32(bf2f((bf16_t)r[0]) * QS16, bf2f((bf16_t)r[1]) * QS16, 0, false); p0 = __builtin_amdgcn_cvt_pk_fp8_f32(bf2f((bf16_t)r[2]) * QS16, bf2f((bf16_t)r[3]) * QS16, p0, true);
            int p1 = __builtin_amdgcn_cvt_pk_fp8_f32(bf2f((bf16_t)r[4]) * QS16, bf2f((bf16_t)r[5]) * QS16, 0, false); p1 = __builtin_amdgcn_cvt_pk_fp8_f32(bf2f((bf16_t)r[6]) * QS16, bf2f((bf16_t)r[7]) * QS16, p1, true);
            qf[b][2 * ks] = p0; qf[b][2 * ks + 1] = p1; }
    const int one_scale = 0x7F7F7F7F, key_scale = 0x7C7C7C7C;
    int kadr = kaddr0 + (j0 % SLC_NBUF) * SLC_BUF, vadr = vaddr0 + (j0 % SLC_NBUF) * SLC_BUF;
    for (int j = j0, jm = 0, buf = j0 % SLC_NBUF; j < j1; ++j) {
        if (jm == 0) {
            asm volatile("s_waitcnt vmcnt(0)" ::: "memory");
            __builtin_amdgcn_s_barrier();
            asm volatile("" ::: "memory");
            if (j + 3 < j1) ISSUE16(j + 3); if (j + 4 < j1) ISSUE16(j + 4); if (j + 5 < j1) ISSUE16(j + 5); }
        const int kb = j * KVBLK;
#define KF16(ks, mt) lds_b128(kadr + 64 * (ks) + 256 * (mt))
#define TRA(dst, off) asm volatile("ds_read_b64_tr_b16 %0, %1 offset:%2" : "=v"(dst) : "v"(vadr), "n"(off))
#define VLOAD(dst, s, h) _Pragma("unroll") for (int _c = 0; _c < 4; ++_c) { TRA(dst[_c][0], 32 * (4 * (h) + _c) + 512 * (s)); TRA(dst[_c][1], 32 * (4 * (h) + _c) + 512 * (s) + 256); }
#define VWAIT(n, d) asm volatile("s_waitcnt lgkmcnt(" #n ")" : "+v"(d[0][0]), "+v"(d[0][1]), "+v"(d[1][0]), "+v"(d[1][1]), "+v"(d[2][0]), "+v"(d[2][1]), "+v"(d[3][0]), "+v"(d[3][1]))
#define PVMMA(src, pa, h) _Pragma("unroll") for (int _c = 0; _c < 4; ++_c) o[b][4 * (h) + _c] = __builtin_amdgcn_mfma_f32_16x16x32_bf16(pa, \
            (bf16x8){src[_c][0][0], src[_c][0][1], src[_c][0][2], src[_c][0][3], src[_c][1][0], src[_c][1][1], src[_c][1][2], src[_c][1][3]}, o[b][4 * (h) + _c], 0, 0, 0);
#define EXPH(h, pw) { if (uni) { _Pragma("unroll") for (int mt = 2 * (h); mt < 2 * (h) + 2; ++mt) _Pragma("unroll") for (int i = 0; i < 4; ++i) { \
                            const float e_ = __builtin_amdgcn_exp2f(acc[mt][i]); acc[mt][i] = e_; ps += e_; } } \
                      else { asm volatile("" ::: "memory"); _Pragma("unroll") for (int mt = 2 * (h); mt < 2 * (h) + 2; ++mt) _Pragma("unroll") for (int i = 0; i < 4; ++i) { \
                            float e_ = __builtin_amdgcn_exp2f(acc[mt][i]); e_ = (16 * mt + i <= lim4 && (!WIN16 || 16 * mt + i >= lim4 - 511)) ? e_ : 0.f; acc[mt][i] = e_; ps += e_; } } \
                      pw.x = cvt_pk_bf16(acc[2 * (h)][0], acc[2 * (h)][1]); pw.y = cvt_pk_bf16(acc[2 * (h)][2], acc[2 * (h)][3]); \
                      pw.z = cvt_pk_bf16(acc[2 * (h) + 1][0], acc[2 * (h) + 1][1]); pw.w = cvt_pk_bf16(acc[2 * (h) + 1][2], acc[2 * (h) + 1][3]); }
        if constexpr (DENSE16) {
            int limv[3]; bool lany[3], lfull[3];
#pragma unroll
            for (int b = 0; b < 3; ++b) { limv[b] = (CMP16 ? ((tqv[b] - 31) >> 4) : tqv[b]) - kb; lany[b] = limv[b] >= 0 && (!WIN16 || limv[b] <= 511 + 63); lfull[b] = limv[b] >= 63 && (!WIN16 || limv[b] <= 511); }
            if (__any(lany[0] || lany[1] || lany[2])) {
                f32x4 acc3[3][4]; i32x4 kr[8]; s16x4 va[4][2], vc[4][2];
                bool uni3[3]; f32x4 off3[3];
#pragma unroll
                for (int b = 0; b < 3; ++b) { uni3[b] = __all(lfull[b] || !lany[b]); const float o_ = (uni3[b] && !lany[b]) ? -1.0e30f : negBC; off3[b] = (f32x4){o_, o_, o_, o_}; }
#define KRD(i) asm volatile("ds_read_b128 %0, %1 offset:%2" : "=v"(kr[i]) : "v"(kadr), "n"(256 * ((i) >> 1) + 16 * ((i) & 1)))
                KRD(0); KRD(1); KRD(2); KRD(3); KRD(4); KRD(5); KRD(6); KRD(7);
#define KMM3(mt, n) { asm volatile("s_waitcnt lgkmcnt(" #n ")" : "+v"(kr[2 * (mt)]), "+v"(kr[2 * (mt) + 1])); \
                     const i32x8 kf_ = __builtin_shufflevector(kr[2 * (mt)], kr[2 * (mt) + 1], 0, 1, 2, 3, 4, 5, 6, 7); \
                     _Pragma("unroll") for (int b_ = 0; b_ < 3; ++b_) \
                     asm volatile("v_mfma_scale_f32_16x16x128_f8f6f4 %0, %1, %2, %3, %4, %5 op_sel_hi:[0,0,0]" : "=v"(acc3[b_][mt]) : "v"(kf_), "v"(qf[b_]), "v"(off3[b_]), "v"(key_scale), "v"(one_scale)); }
                KMM3(0, 6) KMM3(1, 4) KMM3(2, 2) KMM3(3, 0)
                __builtin_amdgcn_sched_barrier(0);
#undef KRD
#undef KMM3
                VLOAD(va, 0, 0)
                asm volatile("s_nop 7" : "+v"(acc3[0][0]), "+v"(acc3[0][1]), "+v"(acc3[0][2]), "+v"(acc3[0][3]), "+v"(acc3[1][0]), "+v"(acc3[1][1]), "+v"(acc3[1][2]), "+v"(acc3[1][3]),
                                  "+v"(acc3[2][0]), "+v"(acc3[2][1]), "+v"(acc3[2][2]), "+v"(acc3[2][3]));
                bf16x8 pa3[3][2];
#pragma unroll
                for (int b = 0; b < 3; ++b) {
                    const bool l_any = lany[b], l_full = lfull[b]; const int lim = limv[b];
                    const bool uni = uni3[b]; (void)l_full;
                    const int lim4 = l_any ? lim - 4 * fq : -1;
                    float ps = 0.f;
                    if (uni) {
#pragma unroll
                        for (int mt = 0; mt < 4; ++mt)
#pragma unroll
                            for (int i = 0; i < 4; ++i) { const float e_ = __builtin_amdgcn_exp2f(acc3[b][mt][i]); acc3[b][mt][i] = e_; ps += e_; } }
                    else { asm volatile("" ::: "memory");
#pragma unroll
                        for (int mt = 0; mt < 4; ++mt)
#pragma unroll
                            for (int i = 0; i < 4; ++i) { float e_ = __builtin_amdgcn_exp2f(acc3[b][mt][i]); e_ = (16 * mt + i <= lim4 && (!WIN16 || 16 * mt + i >= lim4 - 511)) ? e_ : 0.f; acc3[b][mt][i] = e_; ps += e_; } }
                    lsum[b] += ps;
#pragma unroll
                    for (int s = 0; s < 2; ++s) { u32x4 pw; pw.x = cvt_pk_bf16(acc3[b][2 * s][0], acc3[b][2 * s][1]); pw.y = cvt_pk_bf16(acc3[b][2 * s][2], acc3[b][2 * s][3]);
                        pw.z = cvt_pk_bf16(acc3[b][2 * s + 1][0], acc3[b][2 * s + 1][1]); pw.w = cvt_pk_bf16(acc3[b][2 * s + 1][2], acc3[b][2 * s + 1][3]); pa3[b][s] = *reinterpret_cast<bf16x8*>(&pw); }
                }
#define PV3(src, s, h) _Pragma("unroll") for (int _c = 0; _c < 4; ++_c) { const bf16x8 vf_ = (bf16x8){src[_c][0][0], src[_c][0][1], src[_c][0][2], src[_c][0][3], src[_c][1][0], src[_c][1][1], src[_c][1][2], src[_c][1][3]}; \
                    _Pragma("unroll") for (int b_ = 0; b_ < 3; ++b_) o[b_][4 * (h) + _c] = __builtin_amdgcn_mfma_f32_16x16x32_bf16(pa3[b_][s], vf_, o[b_][4 * (h) + _c], 0, 0, 0); }
                __builtin_amdgcn_sched_barrier(0);
                VLOAD(vc, 0, 1)
                VWAIT(8, va);
                PV3(va, 0, 0)
                __builtin_amdgcn_sched_barrier(0);
                VLOAD(va, 1, 0)
                VWAIT(8, vc);
                PV3(vc, 0, 1)
                __builtin_amdgcn_sched_barrier(0);
                VLOAD(vc, 1, 1)
                VWAIT(8, va);
                PV3(va, 1, 0)
                __builtin_amdgcn_sched_barrier(0);
                VWAIT(0, vc);
                PV3(vc, 1, 1)
                __builtin_amdgcn_sched_barrier(0);
#undef PV3
            }
        } else
#pragma unroll
        for (int b = 0; b < 3; ++b) {
            const bool sel = DENSE16 ? true : (bool)((bmw[b] >> (j & 31)) & 1u);
            const int lim = tqv[b] - kb;
            const bool l_any = sel && lim >= 0 && (!WIN16 || lim <= 511 + 63), l_full = sel && lim >= 63 && (!WIN16 || lim <= 511);
            if (__any(l_any)) {
                f32x4 acc[4]; i32x4 kr[8]; s16x4 va[4][2], vc[4][2];
                const bool uni = __all(l_full || !l_any);
                const float off = (uni && !l_any) ? -1.0e30f : negBC;
                const f32x4 off4 = {off, off, off, off};
#define KRD(i) asm volatile("ds_read_b128 %0, %1 offset:%2" : "=v"(kr[i]) : "v"(kadr), "n"(256 * ((i) >> 1) + 16 * ((i) & 1)))
                KRD(0); KRD(1); KRD(2); KRD(3); KRD(4); KRD(5); KRD(6); KRD(7);
#define KMM(mt, n) { asm volatile("s_waitcnt lgkmcnt(" #n ")" : "+v"(kr[2 * (mt)]), "+v"(kr[2 * (mt) + 1])); \
                     const i32x8 kf_ = __builtin_shufflevector(kr[2 * (mt)], kr[2 * (mt) + 1], 0, 1, 2, 3, 4, 5, 6, 7); \
                     asm volatile("v_mfma_scale_f32_16x16x128_f8f6f4 %0, %1, %2, %3, %4, %5 op_sel_hi:[0,0,0]" : "=v"(acc[mt]) : "v"(kf_), "v"(qf[b]), "v"(off4), "v"(key_scale), "v"(one_scale)); }
                KMM(0, 6) KMM(1, 4) KMM(2, 2) KMM(3, 0)
                __builtin_amdgcn_sched_barrier(0);
#undef KRD
#undef KMM
                VLOAD(va, 0, 0)
                VLOAD(vc, 0, 1)
                asm volatile("" : "+v"(acc[0]), "+v"(acc[1]), "+v"(acc[2]), "+v"(acc[3]));
                const int lim4 = l_any ? lim - 4 * fq : -1;
                float ps = 0.f;
                u32x4 pw0, pw1;
                EXPH(0, pw0)
                const bf16x8 pa0 = *reinterpret_cast<bf16x8*>(&pw0);
                __builtin_amdgcn_sched_barrier(0);
                VWAIT(8, va);
                PVMMA(va, pa0, 0)
                __builtin_amdgcn_sched_barrier(0);
                VLOAD(va, 1, 0)
                VWAIT(8, vc);
                PVMMA(vc, pa0, 1)
                __builtin_amdgcn_sched_barrier(0);
                VLOAD(vc, 1, 1)
                EXPH(1, pw1)
                const bf16x8 pa1 = *reinterpret_cast<bf16x8*>(&pw1);
                lsum[b] += ps;
                __builtin_amdgcn_sched_barrier(0);
                VWAIT(8, va);
                PVMMA(va, pa1, 0)
                __builtin_amdgcn_sched_barrier(0);
                VWAIT(0, vc);
                PVMMA(vc, pa1, 1)
                __builtin_amdgcn_sched_barrier(0);
            }
        }
#undef TRA
#undef VWAIT
#undef EXPH
#undef KF16
#undef VLOAD
#undef PVMMA
        if (!DENSE16 && ((j + 1) & 31) == 0 && j + 1 < j1) {
#pragma unroll
            for (int b = 0; b < 3; ++b) bmw[b] = a.BM[((size_t)TQC(b) * 4 + g) * 8 + ((j + 1) >> 5)];
            asm volatile("s_waitcnt vmcnt(0)" : "+v"(bmw[0]), "+v"(bmw[1]), "+v"(bmw[2]) :: "memory"); }
        { const int step = buf == SLC_NBUF - 1 ? -(SLC_NBUF - 1) * SLC_BUF : SLC_BUF; kadr += step; vadr += step; asm volatile("" : "+v"(kadr), "+v"(vadr)); buf = buf == SLC_NBUF - 1 ? 0 : buf + 1; jm = jm == 2 ? 0 : jm + 1; }
    }
#undef ISSUE16
    int fqe = fq, fre = fr; asm volatile("" : "+v"(fqe), "+v"(fre));
    float grow[3];
#pragma unroll
    for (int b = 0; b < 3; ++b) grow[b] = a.G[(size_t)TQC(b) * NGATE + (g * HPG + (16 * b + fre) % 6) * 3 + (CMP16 ? 0 : (WIN16 ? 2 : 1))];
#pragma unroll
    for (int b = 0; b < 3; ++b) { float ls = lsum[b]; ls += __shfl_xor(ls, 16); ls += __shfl_xor(ls, 32);
        if (fqe == 0) { li_l[b * 32 + fre] = ls; li_l[b * 32 + 16 + fre] = grow[b]; if (CMP16) a.L[(size_t)TQC(b) * NH + g * HPG + (16 * b + fre) % 6] = ls; } }
    asm volatile("s_waitcnt lgkmcnt(0)" ::: "memory");
#pragma unroll
    for (int b = 0; b < 3; ++b) {
        float pv_[4][8]; float gtv[4];
#pragma unroll
        for (int i = 0; i < 4; ++i) { const int q = 4 * fqe + i, R = 16 * b + q; const float lv = li_l[b * 32 + q]; gtv[i] = li_l[b * 32 + 16 + q] * (lv > 0.f ? __builtin_amdgcn_rcpf(lv) : 0.f);
            const int t = t0 + wid * 8 + R / 6, h = g * HPG + R % 6;
            const bf16_t* oc = (const bf16_t*)a.OACC + (size_t)t * 3072 + h * HD + fre; const bf16_t* ow = oc + (size_t)S_ * 3072;
            bf16_t c_[8], w_[8];
            if (!DENSE16) {
#pragma unroll
                for (int c = 0; c < 8; ++c) { c_[c] = oc[c * 16]; w_[c] = ow[c * 16]; }
#pragma unroll
                for (int c = 0; c < 8; ++c) pv_[i][c] = bf2f(c_[c]) + bf2f(w_[c]); } }
#pragma unroll
        for (int i = 0; i < 4; ++i) { const int R = 16 * b + 4 * fqe + i; const int t = t0 + wid * 8 + R / 6, h = g * HPG + R % 6;
            if (DENSE16) { bf16_t* wp = (bf16_t*)a.OACC + (WIN16 ? (size_t)S_ * 3072 : 0) + (size_t)t * 3072 + h * HD + fre;
#pragma unroll
                for (int c = 0; c < 8; ++c) wp[c * 16] = (bf16_t)(cvt_pk_bf16(o[b][c][i] * gtv[i], 0.f) & 0xffffu); }
            else { unsigned char* mp = (unsigned char*)a.MIX + (size_t)t * DM * 2 + 2 * POOLW + h * HD + fre;
#pragma unroll
                for (int c = 0; c < 8; ++c) mp[c * 16] = (unsigned char)(__builtin_amdgcn_cvt_pk_fp8_f32((pv_[i][c] + o[b][c][i] * gtv[i]) * 2.0f, 0.f, 0, false) & 0xff); } }
    }
#undef TQC
#undef HQ
}

__device__ __forceinline__ void imp_task(const AttnArgs& a, float* IMPP, float* IMPF, int tqi, int g) {
    const int lane = threadIdx.x & 63, fr = lane & 15, fq = lane >> 4;
    const int t = tqi * 16 + fr;
    const int tmax = tqi * 16 + 15;
    if (tmax < 31) return;
    const int lim = t >= 31 ? ((t - 31) >> 4) : -1;
    const int nstep = ((((tmax - 31) >> 4) >> 6) + 1) * 4;
    const float negBC = -a.TAB[512];
    bf16x8 qf[HPG][4]; float rl[HPG];
#pragma unroll
    for (int h = 0; h < HPG; ++h) {
        const bf16_t* qp = a.Z + (size_t)t * LDZ + OFF_Q + (g * HPG + h) * HD + fq * 8;
#pragma unroll
        for (int ks = 0; ks < 4; ++ks) qf[h][ks] = *reinterpret_cast<const bf16x8*>(qp + ks * 32);
        const float lv = a.L[(size_t)t * NH + g * HPG + h]; rl[h] = negBC + (lv > 0.f ? -__builtin_amdgcn_logf(lv) : -1.0e30f);
    }
    const bf16_t* kbase = a.KC + (size_t)g * 1024 * HD + (size_t)fr * HD + fq * 8;
    bf16x8 kf[4], kn[4], kn2[4];
#pragma unroll
    for (int ks = 0; ks < 4; ++ks) { kf[ks] = *reinterpret_cast<const bf16x8*>(kbase + ks * 32); kn[ks] = *reinterpret_cast<const bf16x8*>(kbase + (size_t)(nstep > 1 ? 1 : 0) * 16 * HD + ks * 32); }
    float* op = IMPP + ((size_t)t * 4 + g) * 256 + fq; float* of = IMPF + ((size_t)t * 4 + g) * 256 + fq;
    for (int st = 0; st < nstep; ++st) {
        const int sn = (st + 2 < nstep) ? st + 2 : nstep - 1;
#pragma unroll
        for (int ks = 0; ks < 4; ++ks) kn2[ks] = *reinterpret_cast<const bf16x8*>(kbase + (size_t)sn * 16 * HD + ks * 32);
        f32x4 imp4 = {0.f, 0.f, 0.f, 0.f};
        const int n0 = st * 16 + fq * 4;
        const bool full = __all(st * 16 + 15 <= lim);
#pragma unroll
        for (int h = 0; h < HPG; ++h) {
            f32x4 acc = {0.f, 0.f, 0.f, 0.f};
#pragma unroll
            for (int ks = 0; ks < 4; ++ks) acc = __builtin_amdgcn_mfma_f32_16x16x32_bf16(kf[ks], qf[h][ks], acc, 0, 0, 0);
            if (full) {
#pragma unroll
                for (int i = 0; i < 4; ++i) imp4[i] += __builtin_amdgcn_exp2f(fmaf(acc[i], SM_C, rl[h])); }
            else {
#pragma unroll
                for (int i = 0; i < 4; ++i) { const float e = __builtin_amdgcn_exp2f(fmaf(acc[i], SM_C, rl[h])); imp4[i] += (n0 + i <= lim) ? e : 0.f; } }
        }
        op[st * 4] = imp4[0] + 2.0f * (imp4[1] + imp4[2] + imp4[3]);
        of[st * 4] = imp4[0];
#pragma unroll
        for (int ks = 0; ks < 4; ++ks) { kf[ks] = kn[ks]; kn[ks] = kn2[ks]; }
    }
}

__device__ __forceinline__ void topk_load(const float* IMPP, const float* IMPF, int t, int g, f32x4& pp, f32x4& ff) {
    const int lane = threadIdx.x & 63, cur = t >> 6, jb = lane * 4;
    pp = (f32x4){0.f, 0.f, 0.f, 0.f}; ff = pp;
    if (cur > 15 && jb <= cur) { const size_t base = ((size_t)t * 4 + g) * 256; pp = *(const f32x4*)(IMPP + base + jb); ff = *(const f32x4*)(IMPF + base + jb); }
}
__device__ __forceinline__ void topk_task(const f32x4 pp, const f32x4 ff, unsigned* BM, int t, int g) {
    const int lane = threadIdx.x & 63;
    const int cur = t >> 6;
    unsigned nib = 0u;
    if (cur <= 15) { const int jb = lane * 4;
#pragma unroll
        for (int c = 0; c < 4; ++c) if (jb + c <= cur) nib |= 1u << c; }
    else {
        const int jb = lane * 4;
        unsigned key[4];
        {
            float fnext = __shfl_down(ff[0], 1);
            if (lane == 63) fnext = 0.f;
            const float v0 = pp[0] + ff[1], v1 = pp[1] + ff[2], v2 = pp[2] + ff[3], v3 = pp[3] + fnext;
            key[0] = (jb + 0 >= 1 && jb + 0 <= cur - 2) ? __float_as_uint(fmaxf(v0, 0.f)) + 1u : 0u;
            key[1] = (jb + 1 >= 1 && jb + 1 <= cur - 2) ? __float_as_uint(fmaxf(v1, 0.f)) + 1u : 0u;
            key[2] = (jb + 2 >= 1 && jb + 2 <= cur - 2) ? __float_as_uint(fmaxf(v2, 0.f)) + 1u : 0u;
            key[3] = (jb + 3 >= 1 && jb + 3 <= cur - 2) ? __float_as_uint(fmaxf(v3, 0.f)) + 1u : 0u;
        }
        unsigned prefix = 0u; bool exact = false;
        for (int b = 30; b >= 0; --b) {
            const unsigned trial = prefix | (1u << b);
            const int cnt = __popcll(__ballot(key[0] >= trial)) + __popcll(__ballot(key[1] >= trial)) + __popcll(__ballot(key[2] >= trial)) + __popcll(__ballot(key[3] >= trial));
            if (cnt >= 13) { prefix = trial; if (cnt == 13) { exact = true; break; } }
        }
#pragma unroll
        for (int c = 0; c < 4; ++c) if (exact ? (key[c] >= prefix) : (key[c] > prefix)) nib |= 1u << c;
        if (!exact) {
            int need = 13 - (__popcll(__ballot(key[0] > prefix)) + __popcll(__ballot(key[1] > prefix)) + __popcll(__ballot(key[2] > prefix)) + __popcll(__ballot(key[3] > prefix)));
            unsigned tie = 0u;
#pragma unroll
            for (int c = 0; c < 4; ++c) if (key[c] == prefix) tie |= 1u << c;
            for (int guard = 0; need > 0 && guard < 16; ++guard) {
                const unsigned long long any = __ballot(tie != 0u);
                if (any == 0ull) break;
                const int L = __builtin_ctzll(any);
                if (lane == L) { const unsigned low = tie & (0u - tie); nib |= low; tie ^= low; }
                --need;
            }
        }
        if (lane == 0) nib |= 1u;
        if (lane == (cur >> 2)) nib |= 1u << (cur & 3);
        if (lane == ((cur - 1) >> 2)) nib |= 1u << ((cur - 1) & 3);
    }
    unsigned x = nib << (4 * (lane & 7));
    x |= __shfl_xor(x, 1); x |= __shfl_xor(x, 2); x |= __shfl_xor(x, 4);
    if ((lane & 7) == 0) BM[((size_t)t * 4 + g) * 8 + (lane >> 3)] = x;
}
#undef KSWZ
}

template <bool FFN_REMAP = false>
__device__ __forceinline__ void convT(const float* __restrict__ src0, int K, int N, bf16_t* __restrict__ dst, int ldd, LAS float* tile, int bid, int nb, int Nfull = 0, int n0 = 0, const float* __restrict__ kscale = nullptr) {
    const float* __restrict__ src = src0 + n0; if (Nfull == 0) Nfull = N;
    const int tid = threadIdx.x, tk = K >> 6, tn = (N + 63) >> 6, total = tk * tn;
    const int r = tid >> 4, c4 = (tid & 15) * 4;
    f32x4 v[2] = {{0.f, 0.f, 0.f, 0.f}, {0.f, 0.f, 0.f, 0.f}}, vn[2];
    if (bid < total) { const int nti = bid % tn, kti = bid / tn, ng = nti * 64 + c4;
#pragma unroll
        for (int h = 0; h < 2; ++h) if (ng < N) v[h] = *(const f32x4*)(src + (size_t)(kti * 64 + r + h * 32) * Nfull + ng); }
    for (int idx = bid; idx < total; idx += nb) {
        const int nti = idx % tn, kti = idx / tn;
#pragma unroll
        for (int h = 0; h < 2; ++h) { LAS float* tp = tile + (r + h * 32) * 65 + c4; tp[0] = v[h][0]; tp[1] = v[h][1]; tp[2] = v[h][2]; tp[3] = v[h][3]; }
        {
            const int nx = idx + nb; vn[0] = (f32x4){0.f, 0.f, 0.f, 0.f}; vn[1] = vn[0];
            if (nx < total) { const int nti2 = nx % tn, kti2 = nx / tn, ng2 = nti2 * 64 + c4;
#pragma unroll
                for (int h = 0; h < 2; ++h) if (ng2 < N) vn[h] = *(const f32x4*)(src + (size_t)(kti2 * 64 + r + h * 32) * Nfull + ng2); } }
        __syncthreads();
        const int n = tid >> 3, k8 = (tid & 7) * 8, ngl = nti * 64 + n;
        float e[8];
#pragma unroll
        for (int i = 0; i < 8; ++i) e[i] = tile[(k8 + i) * 65 + n];
        if (kscale) { const f32x4 s0 = *(const f32x4*)(kscale + kti * 64 + k8), s1 = *(const f32x4*)(kscale + kti * 64 + k8 + 4);
            e[0] *= s0[0]; e[1] *= s0[1]; e[2] *= s0[2]; e[3] *= s0[3]; e[4] *= s1[0]; e[5] *= s1[1]; e[6] *= s1[2]; e[7] *= s1[3]; }
        if (ngl < N) { u32x4 w; w.x = cvt_pk_bf16(e[0], e[1]); w.y = cvt_pk_bf16(e[2], e[3]); w.z = cvt_pk_bf16(e[4], e[5]); w.w = cvt_pk_bf16(e[6], e[7]);
            int drow = ngl; if (FFN_REMAP) { const int up = ngl >= DFF ? 1 : 0, f = ngl - up * DFF; drow = (f >> 7) * 256 + up * 128 + (f & 127); }
            *(u32x4*)(dst + (size_t)drow * ldd + kti * 64 + k8) = w; }
        __syncthreads();
        v[0] = vn[0]; v[1] = vn[1];
    }
}
__device__ __forceinline__ void convT_wo(const float* __restrict__ src0, int K, int N, bf16_t* __restrict__ dst, int ldd, LAS float* tile, int bid, int nb) { const int n0 = 0; int Nfull = 0;
    const float* __restrict__ src = src0 + n0; if (Nfull == 0) Nfull = N;
    const int tid = threadIdx.x, tk = K >> 6, tn = (N + 63) >> 6, total = tk * tn;
    const int r = tid >> 4, c4 = (tid & 15) * 4;
    f32x4 v[2] = {{0.f, 0.f, 0.f, 0.f}, {0.f, 0.f, 0.f, 0.f}}, vn[2];
    if (bid < total) { const int nti = bid % tn, kti = bid / tn, ng = nti * 64 + c4;
#pragma unroll
        for (int h = 0; h < 2; ++h) if (ng < N) v[h] = *(const f32x4*)(src + (size_t)(kti * 64 + r + h * 32) * Nfull + ng); }
    for (int idx = bid; idx < total; idx += nb) {
        const int nti = idx % tn, kti = idx / tn;
#pragma unroll
        for (int h = 0; h < 2; ++h) { LAS float* tp = tile + (r + h * 32) * 65 + c4; tp[0] = v[h][0]; tp[1] = v[h][1]; tp[2] = v[h][2]; tp[3] = v[h][3]; }
        {
            const int nx = idx + nb; vn[0] = (f32x4){0.f, 0.f, 0.f, 0.f}; vn[1] = vn[0];
            if (nx < total) { const int nti2 = nx % tn, kti2 = nx / tn, ng2 = nti2 * 64 + c4;
#pragma unroll
                for (int h = 0; h < 2; ++h) if (ng2 < N) vn[h] = *(const f32x4*)(src + (size_t)(kti2 * 64 + r + h * 32) * Nfull + ng2); } }
        __syncthreads();
        const int n = tid >> 3, k8 = (tid & 7) * 8, ngl = nti * 64 + n;
        float e[8];
#pragma unroll
        for (int i = 0; i < 8; ++i) e[i] = tile[(k8 + i) * 65 + n];
        if (ngl < N) {
            if (kti < POOLW / 64) { u32x4 w; w.x = cvt_pk_bf16(e[0] * 128.f, e[1] * 128.f); w.y = cvt_pk_bf16(e[2] * 128.f, e[3] * 128.f); w.z = cvt_pk_bf16(e[4] * 128.f, e[5] * 128.f); w.w = cvt_pk_bf16(e[6] * 128.f, e[7] * 128.f);
                *(u32x4*)(dst + (size_t)ngl * ldd + kti * 64 + k8) = w; }
            else { int p0 = __builtin_amdgcn_cvt_pk_fp8_f32(e[0] * 64.f, e[1] * 64.f, 0, false); p0 = __builtin_amdgcn_cvt_pk_fp8_f32(e[2] * 64.f, e[3] * 64.f, p0, true);
                int p1 = __builtin_amdgcn_cvt_pk_fp8_f32(e[4] * 64.f, e[5] * 64.f, 0, false); p1 = __builtin_amdgcn_cvt_pk_fp8_f32(e[6] * 64.f, e[7] * 64.f, p1, true);
                *(u32x2*)((unsigned char*)dst + (size_t)ngl * ldd * 2 + 2 * POOLW + (kti * 64 - POOLW) + k8) = (u32x2){(unsigned)p0, (unsigned)p1}; } }
        __syncthreads();
        v[0] = vn[0]; v[1] = vn[1];
    }
}
__device__ __forceinline__ void convT8(const float* __restrict__ src0, int K, int N, unsigned char* __restrict__ dst, int ldd, float scale, LAS float* tile, int bid, int nb, int Nfull = 0, int n0 = 0) {
    const float* __restrict__ src = src0 + n0; if (Nfull == 0) Nfull = N;
    const int tid = threadIdx.x, tk = K >> 6, tn = (N + 63) >> 6, total = tk * tn;
    const int r = tid >> 4, c4 = (tid & 15) * 4;
    f32x4 v[2] = {{0.f, 0.f, 0.f, 0.f}, {0.f, 0.f, 0.f, 0.f}}, vn[2];
    if (bid < total) { const int nti = bid % tn, kti = bid / tn, ng = nti * 64 + c4;
#pragma unroll
        for (int h = 0; h < 2; ++h) if (ng < N) v[h] = *(const f32x4*)(src + (size_t)(kti * 64 + r + h * 32) * Nfull + ng); }
    for (int idx = bid; idx < total; idx += nb) {
        const int nti = idx % tn, kti = idx / tn;
#pragma unroll
        for (int h = 0; h < 2; ++h) { LAS float* tp = tile + (r + h * 32) * 65 + c4; tp[0] = v[h][0]; tp[1] = v[h][1]; tp[2] = v[h][2]; tp[3] = v[h][3]; }
        { const int nx = idx + nb; vn[0] = (f32x4){0.f, 0.f, 0.f, 0.f}; vn[1] = vn[0];
            if (nx < total) { const int nti2 = nx % tn, kti2 = nx / tn, ng2 = nti2 * 64 + c4;
#pragma unroll
                for (int h = 0; h < 2; ++h) if (ng2 < N) vn[h] = *(const f32x4*)(src + (size_t)(kti2 * 64 + r + h * 32) * Nfull + ng2); } }
        __syncthreads();
        const int n = tid >> 3, k8 = (tid & 7) * 8, ngl = nti * 64 + n;
        float e[8];
#pragma unroll
        for (int i = 0; i < 8; ++i) e[i] = tile[(k8 + i) * 65 + n] * scale;
        if (ngl < N) { int p0 = __builtin_amdgcn_cvt_pk_fp8_f32(e[0], e[1], 0, false); p0 = __builtin_amdgcn_cvt_pk_fp8_f32(e[2], e[3], p0, true);
            int p1 = __builtin_amdgcn_cvt_pk_fp8_f32(e[4], e[5], 0, false); p1 = __builtin_amdgcn_cvt_pk_fp8_f32(e[6], e[7], p1, true);
            *(u32x2*)(dst + (size_t)ngl * ldd + kti * 64 + k8) = (u32x2){(unsigned)p0, (unsigned)p1}; }
        __syncthreads();
        v[0] = vn[0]; v[1] = vn[1];
    }
}
__device__ __forceinline__ void rmsnorm_rows(const float* __restrict__ src, const float* __restrict__ w, bf16_t* __restrict__ dst, int rows, int gw, int nw, unsigned char* __restrict__ dst8 = nullptr) {
    const int lane = threadIdx.x & 63;
    f32x4 v[16], vn[16];
    if (gw < rows) { const f32x4* sp = (const f32x4*)(src + (size_t)gw * DM);
#pragma unroll
        for (int i = 0; i < 16; ++i) v[i] = sp[lane + 64 * i]; }
    for (int row = gw; row < rows; row += nw) {
        const int nr = row + nw < rows ? row + nw : row;
        { const f32x4* sp = (const f32x4*)(src + (size_t)nr * DM);
#pragma unroll
          for (int i = 0; i < 16; ++i) vn[i] = sp[lane + 64 * i]; }
        float ss = 0.f;
#pragma unroll
        for (int i = 0; i < 16; ++i) ss += v[i][0] * v[i][0] + v[i][1] * v[i][1] + v[i][2] * v[i][2] + v[i][3] * v[i][3];
        ss = wave_sum(ss);
        const float rstd = rsqrtf(ss * (1.0f / DM) + EPS);
#pragma unroll
        for (int i = 0; i < 16; ++i) { const f32x4 ww = ((const f32x4*)w)[lane + 64 * i];
            u32x2 o; o.x = cvt_pk_bf16(v[i][0] * rstd * ww[0], v[i][1] * rstd * ww[1]); o.y = cvt_pk_bf16(v[i][2] * rstd * ww[2], v[i][3] * rstd * ww[3]);
            *(u32x2*)(dst + (size_t)row * DM + (lane + 64 * i) * 4) = o;
            if (dst8) { int pk = __builtin_amdgcn_cvt_pk_fp8_f32(v[i][0] * rstd * ww[0], v[i][1] * rstd * ww[1], 0, false); pk = __builtin_amdgcn_cvt_pk_fp8_f32(v[i][2] * rstd * ww[2], v[i][3] * rstd * ww[3], pk, true);
                *(int*)(dst8 + (size_t)row * DM + (lane + 64 * i) * 4) = pk; } }
#pragma unroll
        for (int i = 0; i < 16; ++i) v[i] = vn[i];
    }
}

struct Ptrs {
    bf16_t *Win, *Wo, *Wfi, *Wfo, *Wg, *Wple, *Wpool, *Wc1k, *Wc1v, *XN, *PB, *Z, *M, *KC, *VC, *MIX, *ACT, *ERAW;
    float *COS, *SIN, *TAB, *G, *H1, *L, *OACC, *IMPP, *IMPF, *ERSTD; unsigned* BM;
};

__device__ __forceinline__ void phase_prologue(const Params& P, const Ptrs& W, LAS unsigned char* lds) {
    const int bid = blockIdx.x, nb = gridDim.x, tid = threadIdx.x, lane = tid & 63, wv = tid >> 6;
    const int gw = bid * NWAVES + wv, nw = nb * NWAVES; const size_t gt = (size_t)bid * NTHREADS + tid, ntot = (size_t)nb * NTHREADS;
    LAS float* tile = (LAS float*)lds;
    rmsnorm_rows(P.x, P.norm1_w, W.XN, S_, gw, nw, P.ws + WS_XN8);
    convT(P.w_in, DM, POOLW, W.Win, DM, tile, bid, nb, INW, 0);
    convT(P.w_in, DM, INW - OFF_G, W.Win + (size_t)OFF_G * DM, DM, tile, bid, nb, INW, OFF_G);
    convT8(P.w_in, DM, OFF_G - POOLW, P.ws + WS_WIN8, DM, WG8_SCALE, tile, bid, nb, INW, POOLW);
    for (size_t i = gt; i < (size_t)(LDZ - INW) * DM / 8; i += ntot) *(u32x4*)(W.Win + (size_t)INW * DM + i * 8) = (u32x4){0u, 0u, 0u, 0u};
    convT_wo(P.w_o, DM, DM, W.Wo, DM, tile, bid, nb);
    convT<true>(P.w_ffn_in, DM, NFI, W.Wfi, DM, tile, bid, nb, 0, 0, P.norm2_w);
    for (size_t i = gt; i < (size_t)2 * DM / 8; i += ntot) *(u32x4*)(W.XN - 2 * DM + i * 8) = (u32x4){0u, 0u, 0u, 0u};
    convT(P.w_ffn_out, DFF, DM, W.Wfo, DFF, tile, bid, nb);
    convT8(P.w_ple_gate, DM, DM, (unsigned char*)W.Wg, DM, WG8_SCALE, tile, bid, nb);
    convT(P.w_ple_proj, PLE, DM, W.Wple, PLE, tile, bid, nb);
    for (int g = 0; g < 4; ++g) convT(P.w_pool + (size_t)g * 65536, 256, 256, W.Wpool + (size_t)g * 65536, 256, tile, bid, nb);
    convT(P.cmp_k_w1, 4096, 256, W.Wc1k, 4096, tile, bid, nb);
    convT(P.cmp_v_w1, 4096, 256, W.Wc1v, 4096, tile, bid, nb);
    { constexpr size_t NP8 = (size_t)S_ * PLE / 8;
      for (size_t ib = gt; ib < NP8; ib += 4 * ntot) { f32x4 av[4], bv[4];
#pragma unroll
          for (int k = 0; k < 4; ++k) { size_t i = ib + k * ntot; if (i >= NP8) i = NP8 - 1; av[k] = *(const f32x4*)(P.p + i * 8); bv[k] = *(const f32x4*)(P.p + i * 8 + 4); }
#pragma unroll
          for (int k = 0; k < 4; ++k) { const size_t i = ib + k * ntot; if (i < NP8) { u32x4 w; w.x = cvt_pk_bf16(av[k][0], av[k][1]); w.y = cvt_pk_bf16(av[k][2], av[k][3]); w.z = cvt_pk_bf16(bv[k][0], bv[k][1]); w.w = cvt_pk_bf16(bv[k][2], bv[k][3]); *(u32x4*)(W.PB + i * 8) = w; } } } }
    for (size_t i = gt; i < (size_t)S_ * 16; i += ntot) { const int t = (int)(i >> 4), fi = (int)(i & 15);
        const float inv = exp2f(-(float)fi * (18.931568569324174f / 16.0f)); const float ang = (float)P.positions[t] * inv;
        const double ad = (double)ang; const double kk = rint(ad * 0.15915494309189535); const float rf = (float)(ad - kk * 6.283185307179586);
        W.COS[i] = __cosf(rf); W.SIN[i] = __sinf(rf); }
    for (int task = gw; task < 128; task += nw) { const int which = task >> 6, r0 = (task & 63) * 64; const float* pe = which ? P.cmp_pos_v : P.cmp_pos_k; const float* w1 = which ? P.cmp_v_w1 : P.cmp_k_w1;
        f32x4 s = {0.f, 0.f, 0.f, 0.f};
#pragma unroll 8
        for (int r = 0; r < 64; ++r) { const f32x4 wv = *(const f32x4*)(w1 + (size_t)(r0 + r) * 256 + lane * 4); s += wv * pe[r0 + r]; }
        float* cbp = (float*)(P.ws + WS_CBIAS) + which * 256 + lane * 4;
        unsafeAtomicAdd(cbp + 0, s[0]); unsafeAtomicAdd(cbp + 1, s[1]); unsafeAtomicAdd(cbp + 2, s[2]); unsafeAtomicAdd(cbp + 3, s[3]); }
    if (gw == 0) { float mq = fmaxf(fabsf(P.q_norm_w[lane]), fabsf(P.q_norm_w[lane + 64])); mq = wave_max(mq);
        float mc = wave_max(fmaxf(fabsf(P.k_norm_cmp_w[lane]), fabsf(P.k_norm_cmp_w[lane + 64])));
        float ms = wave_max(fmaxf(fabsf(P.k_norm_slc_w[lane]), fabsf(P.k_norm_slc_w[lane + 64])));
        float mw = wave_max(fmaxf(fabsf(P.k_norm_win_w[lane]), fabsf(P.k_norm_win_w[lane + 64])));
        const float c = 11.313708498984761f * 1.4426950408889634f * mq * 1.01f;
        if (lane == 0) { W.TAB[512] = c * mc; W.TAB[513] = c * ms; W.TAB[514] = c * mw; } }
}

__device__ __forceinline__ void phase_postz(const Params& P, const Ptrs& W, int gw, int nw) {
    const int tid = threadIdx.x, lane = tid & 63;
    const f32x2 wq = *(const f32x2*)(P.q_norm_w + 2 * lane), wks = *(const f32x2*)(P.k_norm_slc_w + 2 * lane), wkw = *(const f32x2*)(P.k_norm_win_w + 2 * lane);
    for (int t = gw; t < S_; t += nw) {
        bf16_t* zr = W.Z + (size_t)t * LDZ;
        float cs0 = 0.f, cs1 = 0.f, sn0 = 0.f, sn1 = 0.f;
        if (lane < 16) { const int i0 = (2 * lane) & 15; cs0 = W.COS[t * 16 + i0]; cs1 = W.COS[t * 16 + i0 + 1]; sn0 = W.SIN[t * 16 + i0]; sn1 = W.SIN[t * 16 + i0 + 1]; }
        unsigned uv[32];
#pragma unroll
        for (int v = 0; v < 32; ++v) { const int col = v < 24 ? OFF_Q + v * HD : (v < 28 ? OFF_KV + 2 * 512 + (v - 24) * HD : OFF_KV + 4 * 512 + (v - 28) * HD);
            uv[v] = *((const unsigned*)(zr + col) + lane); }
#pragma unroll
        for (int v = 0; v < 32; ++v) {
            const f32x2 ww = v < 24 ? wq : (v < 28 ? wks : wkw);
            const unsigned u = uv[v]; const float x0 = bf_lo(u), x1 = bf_hi(u);
            const float ss = wave_sum(x0 * x0 + x1 * x1);
            const float rstd = rsqrtf(ss * (1.0f / HD) + EPS);
            float y0 = x0 * rstd * ww[0], y1 = x1 * rstd * ww[1];
            const float p0 = __shfl_xor(y0, 8), p1 = __shfl_xor(y1, 8);
            if (lane < 8) { y0 = y0 * cs0 - p0 * sn0; y1 = y1 * cs1 - p1 * sn1; }
            else if (lane < 16) { y0 = y0 * cs0 + p0 * sn0; y1 = y1 * cs1 + p1 * sn1; }
            uv[v] = cvt_pk_bf16(y0, y1);
            if (v >= 24) *((unsigned short*)((unsigned char*)W.MIX + ((v < 28 ? WS_K8 : WS_K8W) - WS_MIX) + ((size_t)t * 4 + ((v - 24) & 3)) * HD) + lane) = (unsigned short)(__builtin_amdgcn_cvt_pk_fp8_f32(y0, y1, 0, false) & 0xffff);
        }
        {
            const int gi = lane >> 4, wlen = 2 << gi, c0 = lane * 16; const int cnt = (t + 1) < wlen ? (t + 1) : wlen;
            float s[16];
#pragma unroll
            for (int i = 0; i < 16; ++i) s[i] = 0.f;
            float cur[16];
#pragma unroll
            for (int bt = 0; bt < 2; ++bt) {
                u32x4 ra[8], rb[8];
#pragma unroll
                for (int i = 0; i < 8; ++i) { const int ii = bt * 8 + i; const size_t row = (size_t)(ii < cnt ? t - ii : t);
                    ra[i] = *(const u32x4*)(W.Z + row * LDZ + c0); rb[i] = *(const u32x4*)(W.Z + row * LDZ + c0 + 8); }
#pragma unroll
                for (int i = 0; i < 8; ++i) { const int ii = bt * 8 + i; const float mk = ii < cnt ? 1.0f : 0.0f; const u32x4 a = ra[i], b = rb[i];
                    const float ev[16] = {bf_lo(a.x), bf_hi(a.x), bf_lo(a.y), bf_hi(a.y), bf_lo(a.z), bf_hi(a.z), bf_lo(a.w), bf_hi(a.w), bf_lo(b.x), bf_hi(b.x), bf_lo(b.y), bf_hi(b.y), bf_lo(b.z), bf_hi(b.z), bf_lo(b.w), bf_hi(b.w)};
#pragma unroll
                    for (int q = 0; q < 16; ++q) { s[q] += ev[q] * mk; if (ii == 0) cur[q] = ev[q]; } }
                if (bt == 0 && __all(cnt <= 8)) break;
            }
            const float rc = 1.0f / (float)cnt;
            u32x4 o0, o1;
            o0.x = cvt_pk_bf16(s[0] * rc - cur[0], s[1] * rc - cur[1]); o0.y = cvt_pk_bf16(s[2] * rc - cur[2], s[3] * rc - cur[3]);
            o0.z = cvt_pk_bf16(s[4] * rc - cur[4], s[5] * rc - cur[5]); o0.w = cvt_pk_bf16(s[6] * rc - cur[6], s[7] * rc - cur[7]);
            o1.x = cvt_pk_bf16(s[8] * rc - cur[8], s[9] * rc - cur[9]); o1.y = cvt_pk_bf16(s[10] * rc - cur[10], s[11] * rc - cur[11]);
            o1.z = cvt_pk_bf16(s[12] * rc - cur[12], s[13] * rc - cur[13]); o1.w = cvt_pk_bf16(s[14] * rc - cur[14], s[15] * rc - cur[15]);
            *(u32x4*)(W.M + (size_t)t * POOLW + c0) = o0; *(u32x4*)(W.M + (size_t)t * POOLW + c0 + 8) = o1;
        }
#pragma unroll
        for (int v = 0; v < 32; ++v) { const int col = v < 24 ? OFF_Q + v * HD : (v < 28 ? OFF_KV + 2 * 512 + (v - 24) * HD : OFF_KV + 4 * 512 + (v - 28) * HD);
            *((unsigned*)(zr + col) + lane) = uv[v]; }

    }
}

__device__ __forceinline__ void phase_cmpfin(const Params& P, const Ptrs& W) {
    const int tid = threadIdx.x, lane = tid & 63, gw = blockIdx.x * NWAVES + (tid >> 6), nw = gridDim.x * NWAVES;
    const f32x2 wk = *(const f32x2*)(P.k_norm_cmp_w + 2 * lane);
    for (int task = gw; task < 8192; task += nw) {
        const int tk = __builtin_amdgcn_readfirstlane(task);
        const int which = tk >> 12, g = (tk >> 10) & 3, n = tk & 1023;
        bf16_t* dst = (which ? W.VC : W.KC) + ((size_t)g * 1024 + n) * HD;
        if (n == 1023) { ((unsigned*)dst)[lane] = 0u; if (which == 0) *((unsigned short*)((unsigned char*)W.MIX + (WS_K8C - WS_MIX) + ((size_t)n * 4 + g) * HD) + lane) = 0; continue; }
        const float* h = W.H1 + (size_t)tk * 256; const float* w2 = which ? P.cmp_v_w2 : P.cmp_k_w2;
        float a0 = 0.f, a1 = 0.f;
        for (int j = 0; j < 256; ++j) { const float hj = h[j]; const f32x2 wv = *(const f32x2*)(w2 + j * HD + 2 * lane); a0 += hj * wv[0]; a1 += hj * wv[1]; }
        if (which == 0) {
            const float ss = wave_sum(a0 * a0 + a1 * a1); const float rstd = rsqrtf(ss * (1.0f / HD) + EPS);
            a0 = a0 * rstd * wk[0]; a1 = a1 * rstd * wk[1];
            const int tp = 16 * n + 31; const float p0 = __shfl_xor(a0, 8), p1 = __shfl_xor(a1, 8);
            if (lane < 16) { const int i0 = (2 * lane) & 15; const float cs0 = W.COS[tp * 16 + i0], cs1 = W.COS[tp * 16 + i0 + 1], sn0 = W.SIN[tp * 16 + i0], sn1 = W.SIN[tp * 16 + i0 + 1];
                if (lane < 8) { a0 = a0 * cs0 - p0 * sn0; a1 = a1 * cs1 - p1 * sn1; } else { a0 = a0 * cs0 + p0 * sn0; a1 = a1 * cs1 + p1 * sn1; } }
        }
        ((unsigned*)dst)[lane] = cvt_pk_bf16(a0, a1);
        if (which == 0) *((unsigned short*)((unsigned char*)W.MIX + (WS_K8C - WS_MIX) + ((size_t)n * 4 + g) * HD) + lane) = (unsigned short)(__builtin_amdgcn_cvt_pk_fp8_f32(a0, a1, 0, false) & 0xffff);
    }
}

__device__ __forceinline__ void phase_erstd(const Ptrs& W) {
    const int tid = threadIdx.x, lane = tid & 63, gw = blockIdx.x * NWAVES + (tid >> 6), nw = gridDim.x * NWAVES;
    u32x4 a[8], an[8];
    if (gw < S_) { const u32x4* sp = (const u32x4*)(W.ERAW + (size_t)gw * DM);
#pragma unroll
        for (int i = 0; i < 8; ++i) a[i] = sp[lane + 64 * i]; }
    for (int row = gw; row < S_; row += nw) {
        const int nr = row + nw < S_ ? row + nw : row;
        { const u32x4* sp = (const u32x4*)(W.ERAW + (size_t)nr * DM);
#pragma unroll
          for (int i = 0; i < 8; ++i) an[i] = sp[lane + 64 * i]; }
        float ss = 0.f;
#pragma unroll
        for (int i = 0; i < 8; ++i) {
            const float e0 = bf_lo(a[i].x), e1 = bf_hi(a[i].x), e2 = bf_lo(a[i].y), e3 = bf_hi(a[i].y), e4 = bf_lo(a[i].z), e5 = bf_hi(a[i].z), e6 = bf_lo(a[i].w), e7 = bf_hi(a[i].w);
            ss += e0 * e0 + e1 * e1 + e2 * e2 + e3 * e3 + e4 * e4 + e5 * e5 + e6 * e6 + e7 * e7; }
        ss = wave_sum(ss);
        if (lane == 0) W.ERSTD[row] = rsqrtf(ss * (1.0f / DM) + EPS);
#pragma unroll
        for (int i = 0; i < 8; ++i) a[i] = an[i];
    }
}

constexpr int N_PHASES = 11;
__device__ __forceinline__ Params kargs() {
#if defined(__HIP_DEVICE_COMPILE__)
    unsigned long long p = (unsigned long long)__builtin_amdgcn_kernarg_segment_ptr();
    asm volatile("" : "+s"(p));
    return *(const __attribute__((address_space(4))) Params*)p;
#else
    return Params{};
#endif
}
__device__ __forceinline__ Ptrs mkptrs(unsigned char* ws) {
    Ptrs W;
    W.Win = (bf16_t*)(ws + WS_WIN); W.Wo = (bf16_t*)(ws + WS_WO); W.Wfi = (bf16_t*)(ws + WS_WFI); W.Wfo = (bf16_t*)(ws + WS_WFO); W.Wg = (bf16_t*)(ws + WS_WG);
    W.Wple = (bf16_t*)(ws + WS_WPLE); W.Wpool = (bf16_t*)(ws + WS_WPOOL); W.Wc1k = (bf16_t*)(ws + WS_WC1K); W.Wc1v = (bf16_t*)(ws + WS_WC1V);
    W.XN = (bf16_t*)(ws + WS_XN); W.PB = (bf16_t*)(ws + WS_PB); W.Z = (bf16_t*)(ws + WS_Z); W.M = (bf16_t*)(ws + WS_M); W.KC = (bf16_t*)(ws + WS_KC); W.VC = (bf16_t*)(ws + WS_VC);
    W.MIX = (bf16_t*)(ws + WS_MIX); W.ACT = (bf16_t*)(ws + WS_ACT); W.ERAW = (bf16_t*)(ws + WS_ERAW);
    W.COS = (float*)(ws + WS_COS); W.SIN = (float*)(ws + WS_SIN); W.TAB = (float*)(ws + WS_TAB); W.G = (float*)(ws + WS_G); W.H1 = (float*)(ws + WS_H1); W.L = (float*)(ws + WS_L);
    W.OACC = (float*)(ws + WS_OACC); W.IMPP = (float*)(ws + WS_IMPP); W.IMPF = (float*)(ws + WS_IMPF); W.ERSTD = (float*)(ws + WS_ERSTD); W.BM = (unsigned*)(ws + WS_BM);
    return W;
}
__global__ void __launch_bounds__(NTHREADS, 2) fwd(Params Punused) {
    extern __shared__ __attribute__((aligned(16))) unsigned char lds_raw[];
    LAS unsigned char* lds = (LAS unsigned char*)lds_raw;
    const int tid = threadIdx.x;
    const int G = gridDim.x, bid = blockIdx.x;
    const int gw = bid * NWAVES + (tid >> 6), nw = G * NWAVES;

    if (tid < 16) ((LAS unsigned*)(lds + LDS_MISC))[tid] = 0u;
    __syncthreads();
    int lo, hi; XcdBarrier bar;
    { const Params P = kargs(); lo = P.ph_lo; hi = P.ph_hi;
      bar.bar = (unsigned*)(P.ws + WS_CTL); bar.x = 0; bar.st = (volatile LAS unsigned*)(lds + LDS_MISC);
      if (hi - lo > 1) bar = xcd_barrier_post((unsigned*)(P.ws + WS_CTL), (volatile LAS unsigned*)(lds + LDS_MISC)); }
#ifdef PH_MASK
#define IN(k) (((PH_MASK >> (k)) & 1) && lo <= (k) && (k) < hi)
#else
#define IN(k) (lo <= (k) && (k) < hi)
#endif
#define SEAM(k) do { if (IN(k) && IN((k) + 1)) xcd_barrier(bar); } while (0)
#define PHASE_VARS const Params P = kargs(); const Ptrs W = mkptrs(P.ws); (void)W;
#define ATT_ARGS att::AttnArgs AA{W.Z, W.KC, W.VC, W.G, W.L, W.OACC, W.MIX, W.BM, W.TAB};

    if (IN(0)) { PHASE_VARS REP(0) { phase_prologue(P, W, lds); } SEAM(0); }
    if (IN(1)) {
        PHASE_VARS
        { pg8::GStd g{(const char*)W.XN, (const char*)W.Win, DM, DM, DM / 64}; pg8::StaticOrder S; S.init(S_ / 256, POOLW / 256, G, bid);
          pg8::EpiBf16 E{W.Z, LDZ}; pg8::gemm_phase(lds, g, S, E); }
        { pg8::GStd g{(const char*)(P.ws + WS_XN8), (const char*)(P.ws + WS_WIN8), DM / 2, DM / 2, DM / 128}; pg8::StaticOrder S; S.init(S_ / 256, (OFF_G - POOLW) / 256, G, bid);
          pg8::EpiBf16S E{W.Z + POOLW, LDZ, 1.0f / WG8_SCALE}; pg8::gemm_phase<pg8::GStd, pg8::EpiBf16S, true>(lds, g, S, E); }
        SEAM(1);
    }
    if (IN(2)) {
        PHASE_VARS
        if (G > 64) {
            if (bid < 32) { pg8::GCmp g{(const char*)W.Z, (const char*)W.Wc1k, (const char*)W.Wc1v, 16 * LDZ, 4096, 64}; pg8::StaticOrder S; S.init(32, 1, 32, bid);
                pg8::EpiCmpGelu E{W.H1, (const float*)(P.ws + WS_CBIAS)}; pg8::gemm_phase(lds, g, S, E); }
            else if (bid < 96) {
                pg8::GStd g{(const char*)W.XN, (const char*)(W.Win + (size_t)OFF_G * DM), DM, DM, DM / 64}; pg8::StaticOrder S; S.init(S_ / 256, 1, 64, bid - 32);
                pg8::EpiBf16 E{W.Z + OFF_G, LDZ}; pg8::gemm_phase(lds, g, S, E); }
            else phase_postz(P, W, (bid - 96) * NWAVES + (tid >> 6), (G - 96) * NWAVES);
        } else {
            { pg8::GStd g{(const char*)W.XN, (const char*)(W.Win + (size_t)OFF_G * DM), DM, DM, DM / 64}; pg8::StaticOrder S; S.init(S_ / 256, 1, G, bid);
              pg8::EpiBf16 E{W.Z + OFF_G, LDZ}; pg8::gemm_phase(lds, g, S, E); }
            { pg8::GCmp g{(const char*)W.Z, (const char*)W.Wc1k, (const char*)W.Wc1v, 16 * LDZ, 4096, 64}; pg8::StaticOrder S; S.init(32, 1, G, bid);
              pg8::EpiCmpGelu E{W.H1, (const float*)(P.ws + WS_CBIAS)}; pg8::gemm_phase(lds, g, S, E); }
            phase_postz(P, W, gw, nw);
        }
        SEAM(2);
    }
    if (IN(3)) {
        PHASE_VARS
        {
            const size_t i0 = (size_t)bid * NTHREADS + tid, st = (size_t)G * NTHREADS, NG = (size_t)S_ * NGATE;
            for (size_t ib = i0; ib < NG; ib += 9 * st) { float zv[9];
#pragma unroll
                for (int k = 0; k < 9; ++k) { size_t i = ib + k * st; if (i >= NG) i = NG - 1; const int t = (int)(i / NGATE), c = (int)(i % NGATE); zv[k] = bf2f(W.Z[(size_t)t * LDZ + OFF_G + c]); }
#pragma unroll
                for (int k = 0; k < 9; ++k) { const size_t i = ib + k * st; if (i < NG) W.G[i] = sigmoidf_(zv[k]); } } }
        phase_cmpfin(P, W);
        { pg8::GPool g{(const char*)W.M, (const char*)W.Wpool, POOLW, 256, 4}; pg8::StaticOrder S; S.init(S_ / 256, 4, G, bid);
          pg8::EpiBf16Scale E{W.MIX, DM, P.pool_scale}; pg8::gemm_phase(lds, g, S, E); }
        SEAM(3);
    }
    if (IN(4)) {
        PHASE_VARS ATT_ARGS
        if (G == 256) {
            for (int rnd = 0; rnd < 2; ++rnd) {
                const int x = bid & 7, r = bid >> 3, qp = rnd ? 63 - r : r, g = x & 3, qt = 2 * qp + (x >> 2);
                for (int uu = 0; uu < 2; ++uu) att::slc16_unit<2>(AA, (LAS char*)lds, 2 * qt + uu, g); }
            asm volatile("s_waitcnt vmcnt(0)" ::: "memory");
            __builtin_amdgcn_fence(__ATOMIC_RELEASE, "workgroup");
            __syncthreads();
            __builtin_amdgcn_fence(__ATOMIC_ACQUIRE, "workgroup");
            for (int rnd = 0; rnd < 2; ++rnd) {
                const int x = bid & 7, r = bid >> 3, qp = rnd ? 63 - r : r, g = x & 3, qt = 2 * qp + (x >> 2);
                const int tqi = qt * 8 + (tid >> 6);
                att::imp_task(AA, W.IMPP, W.IMPF, tqi, g);
                asm volatile("s_waitcnt vmcnt(0)" ::: "memory");
                f32x4 pp, ff, pn, fn; att::topk_load(W.IMPP, W.IMPF, tqi * 16, g, pp, ff);
                for (int q = 0; q < 16; ++q) { att::topk_load(W.IMPP, W.IMPF, tqi * 16 + (q < 15 ? q + 1 : q), g, pn, fn); att::topk_task(pp, ff, W.BM, tqi * 16 + q, g); pp = pn; ff = fn; } }
        } else {
            for (int base = 0, rnd = 0; base < 1536; base += G, ++rnd) {
                const int Lu = base + ((rnd & 1) ? G - 1 - bid : bid); if (Lu >= 1536) continue;
                const int qt = Lu / 12, rem = Lu % 12, g = rem / 3, hp = rem % 3;
                att::attn_unit<att::MODE_CMP>(AA, (LAS char*)lds, qt, g, hp); }
        }
        __builtin_amdgcn_s_setprio(0);
        for (int base = 0, rnd = 0; base < 1024 + G; base += G, ++rnd) {
            int ut, g;
            if (G == 256) { const int x = bid & 7, r = bid >> 3, k = rnd * 32 + r; if (k >= 128) break; g = x & 3; ut = 2 * k + (x >> 2); }
            else { const int Lu = base + bid; if (Lu >= 1024) continue; ut = Lu / 4; g = Lu % 4; }
            att::slc16_unit<1>(AA, (LAS char*)lds, ut, g); }
        if (G != 256) SEAM(4);
    }
    if (IN(5)) {
        PHASE_VARS ATT_ARGS
        if (G != 256)
        for (int k = gw, r = 0; k < 4096; k += nw, ++r) { const int hiT = (r + 1) * nw < 4096 ? (r + 1) * nw : 4096;
            const int task = (r & 1) ? hiT - 1 - (k - r * nw) : k;
            att::imp_task(AA, W.IMPP, W.IMPF, task >> 2, task & 3);
            asm volatile("s_waitcnt vmcnt(0)" ::: "memory");
            { const int tb = (task >> 2) * 16, gg = task & 3; f32x4 pp, ff, pn, fn;
              att::topk_load(W.IMPP, W.IMPF, tb, gg, pp, ff);
              for (int q = 0; q < 16; ++q) { att::topk_load(W.IMPP, W.IMPF, tb + (q < 15 ? q + 1 : q), gg, pn, fn); att::topk_task(pp, ff, W.BM, tb + q, gg); pp = pn; ff = fn; } } }
        SEAM(5);
    }
    if (IN(6)) {
        PHASE_VARS ATT_ARGS
#if SLC16
        for (int base = 0, rnd = 0; base < 1024 + G; base += G, ++rnd) {
            int ut, g;
            if (G == 256) { const int x = bid & 7, r = bid >> 3, k = rnd * 32 + ((rnd & 1) ? 31 - r : r); if (k >= 128) break; g = x & 3; ut = 255 - (2 * k + (x >> 2)); }
            else { const int Lu = base + ((rnd & 1) ? G - 1 - bid : bid); if (Lu >= 1024) continue; ut = 255 - Lu / 4; g = Lu % 4; }
            att::slc16_unit<0>(AA, (LAS char*)lds, ut, g); }
#else
        REP(6)
        for (int base = 0, rnd = 0; base < 1640 + G; base += G, ++rnd) {
            int ut, g;
            if (G == 256) { const int x = bid & 7, r = bid >> 3, k = rnd * 32 + ((rnd & 1) ? 31 - r : r); if (k >= 205) break; g = x & 3; ut = 409 - (2 * k + (x >> 2)); }
            else { const int Lu = base + ((rnd & 1) ? G - 1 - bid : bid); if (Lu >= 1640) continue; ut = 409 - Lu / 4; g = Lu % 4; }
            att::attn_unit<att::MODE_SLC>(AA, (LAS char*)lds, ut, g, 0); }
#endif
        SEAM(6);
    }
    if (IN(7)) {
        PHASE_VARS
        if (bid == 0) { bf16_t* hz = (bf16_t*)(P.ws + WS_HRES) - 2 * DM; for (int i = tid; i < 2 * DM / 8; i += NTHREADS) *(u32x4*)(hz + i * 8) = (u32x4){0u, 0u, 0u, 0u}; }
        { pg8::GStd g{(const char*)W.MIX, (const char*)W.Wo, DM, DM, POOLW / 64 + (DM - POOLW) / 128}; pg8::StaticOrder S; S.init(S_ / 256, DM / 256, G, bid);
          pg8::EpiResNorm E{P.x, (bf16_t*)(P.ws + WS_HRES), W.XN, P.norm2_w, (float*)(P.ws + WS_SSQ1), DM, 1.0f / 128.0f}; pg8::gemm_phase<pg8::GStd, pg8::EpiResNorm, false, POOLW / 64>(lds, g, S, E); }
        { pg8::GStd g{(const char*)W.PB, (const char*)W.Wple, PLE, PLE, PLE / 64}; pg8::StaticOrder S; S.init(S_ / 256, DM / 256, G, bid);
          pg8::EpiBf16Ssq E{W.ERAW, DM, (float*)(P.ws + WS_SSQ3)}; pg8::gemm_phase(lds, g, S, E); }
        SEAM(7);
    }
    if (IN(8)) {
        PHASE_VARS
        pg8::GFfn g{(const char*)(P.ws + WS_HRES), (const char*)W.Wfi, DM, DM, DM / 64}; pg8::StaticOrder S; S.init(65, DFF / 128, G, bid);
        pg8::EpiFfn E{W.ACT, P.conv_w, P.conv_b, (LAS float*)(lds + LDS_XCH), (const float*)(P.ws + WS_SSQ1)}; REP(8) { pg8::gemm_phase(lds, g, S, E); } SEAM(8);
    }
    if (IN(9)) {
        PHASE_VARS
        pg8::GStd g{(const char*)W.ACT, (const char*)W.Wfo, DFF, DFF, DFF / 64}; pg8::StaticOrder S; S.init(S_ / 256, DM / 256, G, bid);
        pg8::EpiResNormF8 E{P.ws + WS_HRES, (bf16_t*)(P.ws + WS_HRES), W.XN, P.ple_gate_norm_w, (float*)(P.ws + WS_SSQ2), DM}; pg8::gemm_phase(lds, g, S, E); SEAM(9);
    }
    if (IN(10)) {
        PHASE_VARS
        pg8::GStd g{(const char*)W.XN, (const char*)W.Wg, DM / 2, DM / 2, DM / 128}; pg8::StaticOrder S; S.init(S_ / 256, DM / 256, G, bid);
        pg8::EpiGate E{P.out, (const bf16_t*)(P.ws + WS_HRES), W.ERAW, (const float*)(P.ws + WS_SSQ3), P.ple_norm_w, (const float*)(P.ws + WS_SSQ2), DM, 1.0f / WG8_SCALE};
        pg8::gemm_phase<pg8::GStd, pg8::EpiGate, true>(lds, g, S, E);
    }
#undef IN
#undef SEAM
}

extern "C" void kernel_launch(void* const* d_in, const int* in_sizes, int n_in, void* d_out, int out_size, void* d_ws, size_t ws_size, hipStream_t stream) {
    static int grid = 0;
    if (grid == 0) {
        if (n_in != 27 || in_sizes[0] != S_ * DM || out_size != S_ * DM || ws_size < WS_NEED) {
            fprintf(stderr, "kernel_launch: unexpected shapes (n_in %d, in0 %d, out %d, ws %zu < %zu); nothing launched\n", n_in, n_in > 0 ? in_sizes[0] : -1, out_size, ws_size, (size_t)WS_NEED); grid = -1; return; }
        int dev = 0, cus = 0, per_cu = 0;
        if (hipGetDevice(&dev) != hipSuccess || hipDeviceGetAttribute(&cus, hipDeviceAttributeMultiprocessorCount, dev) != hipSuccess) { grid = -1; return; }
        if (hipFuncSetAttribute((const void*)fwd, hipFuncAttributeMaxDynamicSharedMemorySize, LDS_BYTES) != hipSuccess) { fprintf(stderr, "kernel_launch: hipFuncSetAttribute failed\n"); grid = -1; return; }
        if (hipOccupancyMaxActiveBlocksPerMultiprocessor(&per_cu, (const void*)fwd, NTHREADS, LDS_BYTES) != hipSuccess || per_cu < 1) { fprintf(stderr, "kernel_launch: occupancy query says %d\n", per_cu); (void)hipGetLastError(); }
        grid = cus > 256 ? 256 : cus;
    }
    if (grid < 0) return;
    (void)hipMemsetAsync((char*)d_ws + WS_CTL, 0, CTL_BYTES, stream);
    Params P{};
    const float** fp = (const float**)&P;
    P.x = (const float*)d_in[0]; P.p = (const float*)d_in[1]; P.positions = (const int*)d_in[2]; P.norm1_w = (const float*)d_in[3]; P.w_in = (const float*)d_in[4];
    P.w_pool = (const float*)d_in[5]; P.pool_scale = (const float*)d_in[6]; P.q_norm_w = (const float*)d_in[7]; P.k_norm_cmp_w = (const float*)d_in[8];
    P.k_norm_slc_w = (const float*)d_in[9]; P.k_norm_win_w = (const float*)d_in[10]; P.cmp_pos_k = (const float*)d_in[11]; P.cmp_pos_v = (const float*)d_in[12];
    P.cmp_k_w1 = (const float*)d_in[13]; P.cmp_k_w2 = (const float*)d_in[14]; P.cmp_v_w1 = (const float*)d_in[15]; P.cmp_v_w2 = (const float*)d_in[16];
    P.w_o = (const float*)d_in[17]; P.norm2_w = (const float*)d_in[18]; P.w_ffn_in = (const float*)d_in[19]; P.conv_w = (const float*)d_in[20]; P.conv_b = (const float*)d_in[21];
    P.w_ffn_out = (const float*)d_in[22]; P.w_ple_proj = (const float*)d_in[23]; P.ple_norm_w = (const float*)d_in[24]; P.ple_gate_norm_w = (const float*)d_in[25]; P.w_ple_gate = (const float*)d_in[26];
    (void)fp;
    P.out = (float*)d_out; P.ws = (unsigned char*)d_ws;
#if MK_ONE_LAUNCH
    P.ph_lo = 0; P.ph_hi = N_PHASES;
    hipLaunchKernelGGL(fwd, dim3(grid), dim3(NTHREADS), LDS_BYTES, stream, P);
#else
    for (int ph = 0; ph < N_PHASES; ++ph) { P.ph_lo = ph; P.ph_hi = ph + 1; hipLaunchKernelGGL(fwd, dim3(grid), dim3(NTHREADS), LDS_BYTES, stream, P); }
#endif
    const hipError_t le = hipPeekAtLastError();
    if (le != hipSuccess) fprintf(stderr, "kernel_launch: launch failed: %s\n", hipGetErrorName(le));
}
```

```cpp
#include <hip/hip_runtime.h>
#include <cstdio>
#include <cstdint>

#ifndef PROBE_DBL
#define PROBE_DBL 0
#endif
#define REP(k) _Pragma("unroll") for (int rep_ = 0; rep_ < 1 + ((PROBE_DBL >> (k)) & 1); ++rep_)
#ifndef SLC16
#define SLC16 1
#endif
#if !SLC16
#error "the 32-row selected-branch path writes a bf16 mix; the output projection expects the fp8 image of the 16-row path"
#endif
#ifndef MK_ONE_LAUNCH
#define MK_ONE_LAUNCH 1
#endif

#define LAS __attribute__((address_space(3)))
typedef unsigned short bf16_t;
typedef short bf16x8 __attribute__((ext_vector_type(8)));
typedef short s16x4 __attribute__((ext_vector_type(4)));
typedef float f32x2 __attribute__((ext_vector_type(2)));
typedef float f32x4 __attribute__((ext_vector_type(4)));
typedef float f32x16 __attribute__((ext_vector_type(16)));
typedef unsigned u32x2 __attribute__((ext_vector_type(2)));
typedef unsigned u32x4 __attribute__((ext_vector_type(4)));
typedef int i32x4 __attribute__((ext_vector_type(4)));
typedef int i32x8 __attribute__((ext_vector_type(8)));

constexpr int S_ = 16384, DM = 4096, INW = 7240, LDZ = 7424, POOLW = 1024, NH = 24, NKV = 4, HPG = 6, HD = 128;
constexpr int OFF_Q = 1024, OFF_KV = 4096, OFF_G = 7168, DFF = 11008, NFI = 22016, PLE = 256, NGATE = 72;
constexpr int ZROWS = S_ + 64, XNROWS = S_ + 256, CHUNK = 8192;
constexpr float EPS = 1e-6f;
constexpr float SM_C = 0.08838834764831845f * 1.4426950408889634f;
constexpr int NWAVES = 8, NTHREADS = 512;
constexpr float WG8_SCALE = 128.0f;

constexpr size_t al256(size_t x) { return (x + 255) / 256 * 256; }
constexpr size_t WS_CTL   = 0;
constexpr size_t CTL_BYTES = 262144;
constexpr size_t WS_CBIAS = WS_CTL + 32768;
constexpr size_t WS_SSQ1 = WS_CTL + 65536, WS_SSQ2 = WS_CTL + 131072, WS_SSQ3 = WS_CTL + 196608;
constexpr size_t WS_WIN   = WS_CTL + CTL_BYTES;
constexpr size_t WS_WO    = WS_WIN + al256((size_t)LDZ * DM * 2);
constexpr size_t WS_WFI   = WS_WO + al256((size_t)DM * DM * 2);
constexpr size_t WS_WFO   = WS_WFI + al256((size_t)NFI * DM * 2);
constexpr size_t WS_WG    = WS_WFO + al256((size_t)DM * DFF * 2);
constexpr size_t WS_WPLE  = WS_WG + al256((size_t)DM * DM * 2);
constexpr size_t WS_WPOOL = WS_WPLE + al256((size_t)DM * PLE * 2);
constexpr size_t WS_WC1K  = WS_WPOOL + al256((size_t)1024 * 256 * 2);
constexpr size_t WS_WC1V  = WS_WC1K + al256((size_t)256 * 4096 * 2);
constexpr size_t WS_COS   = WS_WC1V + al256((size_t)256 * 4096 * 2);
constexpr size_t WS_SIN   = WS_COS + al256((size_t)S_ * 16 * 4);
constexpr size_t WS_TAB   = WS_SIN + al256((size_t)S_ * 16 * 4);
constexpr size_t WS_XNP   = WS_TAB + 4096;
constexpr size_t WS_XN    = WS_XNP + (size_t)2 * DM * 2;
constexpr size_t WS_PB    = WS_XN + al256((size_t)XNROWS * DM * 2);
constexpr size_t WS_XN8   = WS_PB + al256((size_t)S_ * PLE * 2);
constexpr size_t WS_WIN8  = WS_XN8 + al256((size_t)S_ * DM);
constexpr size_t WS_R     = WS_WIN8 + al256((size_t)(OFF_G - POOLW) * DM);
constexpr size_t WS_Z     = WS_R;
constexpr size_t WS_M     = WS_Z + al256((size_t)ZROWS * LDZ * 2);
constexpr size_t WS_G     = WS_M + al256((size_t)S_ * POOLW * 2);
constexpr size_t WS_H1    = WS_G + al256((size_t)S_ * NGATE * 4);
constexpr size_t WS_KC    = WS_H1 + al256((size_t)8192 * 256 * 4);
constexpr size_t WS_VC    = WS_KC + al256((size_t)4 * 1024 * 128 * 2);
constexpr size_t WS_L     = WS_VC + al256((size_t)4 * 1024 * 128 * 2);
constexpr size_t WS_OACC  = WS_L + al256((size_t)S_ * NH * 4);
constexpr size_t WS_IMPP  = WS_OACC + al256((size_t)S_ * 3072 * 4);
constexpr size_t WS_IMPF  = WS_IMPP + al256((size_t)S_ * 4 * 256 * 4);
constexpr size_t WS_BM    = WS_IMPF + al256((size_t)S_ * 4 * 256 * 4);
constexpr size_t WS_MIX   = WS_BM + al256((size_t)S_ * 4 * 8 * 4);
constexpr size_t WS_K8    = WS_MIX + al256((size_t)S_ * DM * 2);
constexpr size_t WS_K8W   = WS_K8 + al256((size_t)S_ * 4 * HD);
constexpr size_t WS_K8C   = WS_K8W + al256((size_t)S_ * 4 * HD);
constexpr size_t WS_END_A = WS_K8C + al256((size_t)1024 * 4 * HD);
constexpr size_t WS_ERAW  = WS_R;
constexpr size_t WS_ACT   = WS_ERAW + al256((size_t)S_ * DM * 2);
constexpr size_t WS_ERSTD = WS_ACT + al256((size_t)S_ * DFF * 2);
constexpr size_t WS_END_B = WS_ERSTD + al256((size_t)S_ * 4);
constexpr size_t WS_HRES  = WS_IMPP + (size_t)2 * DM * 2;
static_assert(WS_HRES - (size_t)2 * DM * 2 >= WS_END_B && WS_HRES + (size_t)S_ * DM * 2 <= WS_MIX, "residual stream must sit in the dead importance / bitmap buffers, clear of act / mix");
static_assert(WS_ERAW + (size_t)S_ * DM * 2 <= WS_Z + (size_t)ZROWS * LDZ * 2, "eraw must fit inside the dead z region while mix is still being read");
constexpr size_t WS_NEED  = WS_END_A > WS_END_B ? WS_END_A : WS_END_B;
static_assert(WS_NEED <= (size_t)1440000000, "workspace map exceeds the guaranteed 4 x largest-tensor bytes");

constexpr int LDS_STAGE = 131072;
constexpr int LDS_XCH   = LDS_STAGE + 64;
constexpr int LDS_MISC  = 155648;
constexpr int LDS_BYTES = LDS_MISC + 64;

__device__ __forceinline__ unsigned cvt_pk_bf16(float lo, float hi) { unsigned r; asm volatile("v_cvt_pk_bf16_f32 %0, %1, %2" : "=v"(r) : "v"(lo), "v"(hi)); return r; }
__device__ __forceinline__ float bf_lo(unsigned u) { return __uint_as_float(u << 16); }
__device__ __forceinline__ float bf_hi(unsigned u) { return __uint_as_float(u & 0xffff0000u); }
__device__ __forceinline__ float bf2f(bf16_t b) { return __uint_as_float(((unsigned)b) << 16); }
__device__ __forceinline__ float wave_sum(float v) {
#pragma unroll
    for (int o = 32; o >= 1; o >>= 1) v += __shfl_xor(v, o);
    return v;
}
__device__ __forceinline__ float wave_max(float v) {
#pragma unroll
    for (int o = 32; o >= 1; o >>= 1) v = fmaxf(v, __shfl_xor(v, o));
    return v;
}
__device__ __forceinline__ float sigmoidf_(float x) { return __builtin_amdgcn_rcpf(1.0f + __expf(-x)); }

#define XB_TMO      128
#define XB_XCNT(j)  (256  + 64 * (j))
#define XB_XSUB(j)  (1280 + 64 * (j))
#define XB_XGEN(j)  (2304 + 64 * (j))
#define XB_TOP      3328
#define XB_TOPGEN   3392
#define XCD_BAR_WORDS 3456
#define XB_SPIN_CAP (1u << 18)
__device__ __forceinline__ unsigned xb_ld(unsigned* p)              { return __hip_atomic_load(p, __ATOMIC_RELAXED, __HIP_MEMORY_SCOPE_AGENT); }
__device__ __forceinline__ unsigned xb_add(unsigned* p, unsigned v) { return __hip_atomic_fetch_add(p, v, __ATOMIC_RELAXED, __HIP_MEMORY_SCOPE_AGENT); }
__device__ __forceinline__ unsigned xb_xcc_id() { return (unsigned)__builtin_amdgcn_s_getreg((3 << 11) | 20) & 0xFu; }
#define XB_SPIN(cond, bar) do { unsigned _sp = 0; while (cond) { __builtin_amdgcn_s_sleep(1); \
    if ((++_sp & 255u) == 0u) { if (xb_ld(&(bar)[XB_TMO])) break; if (_sp > XB_SPIN_CAP) { atomicAdd(&(bar)[XB_TMO], 1u); break; } } } } while (0)
struct XcdBarrier { unsigned* bar; unsigned x; volatile LAS unsigned* st; };
__device__ __forceinline__ XcdBarrier xcd_barrier_post(unsigned* bar, volatile LAS unsigned* st) {
    XcdBarrier b; b.bar = bar; b.x = xb_xcc_id(); b.st = st;
    if (threadIdx.x == 0) (void)xb_add(&bar[XB_XCNT(b.x)], 1u);
    return b;
}
__device__ __forceinline__ void xcd_barrier_complete(unsigned* bar, unsigned x, unsigned& nloc, unsigned& nx) {
    const unsigned G = gridDim.x * gridDim.y * gridDim.z;
    unsigned sum, cnt, mine, sp = 0u;
    for (;;) {
        sum = 0u; cnt = 0u; mine = 0u;
#pragma unroll
        for (unsigned j = 0; j < 16; ++j) { const unsigned c = xb_ld(&bar[XB_XCNT(j)]); sum += c; cnt += (c > 0u) ? 1u : 0u; mine = (j == x) ? c : mine; }
        if (sum == G) break;
        __builtin_amdgcn_s_sleep(1);
        if ((++sp & 255u) == 0u) { if (xb_ld(&bar[XB_TMO])) break; if (sp > XB_SPIN_CAP) { atomicAdd(&bar[XB_TMO], 1u); break; } }
    }
    nloc = mine > 0u ? mine : 1u; nx = cnt > 0u ? cnt : 1u;
}
__device__ __forceinline__ void xcd_barrier(const XcdBarrier& b) {
    asm volatile("s_waitcnt vmcnt(0)" ::: "memory");
    __syncthreads();
    if (threadIdx.x == 0) {
        unsigned* bar = b.bar;
        __builtin_amdgcn_s_waitcnt(0);
        unsigned nloc = b.st[0], nx = b.st[1];
        if (nloc == 0u) { xcd_barrier_complete(bar, b.x, nloc, nx); b.st[0] = nloc; b.st[1] = nx; }
        const unsigned old = xb_add(&bar[XB_XSUB(b.x)], 1u);
        const unsigned gen = old / nloc;
        if (old + 1u == (gen + 1u) * nloc) {
            __builtin_amdgcn_fence(__ATOMIC_RELEASE, "agent");
            asm volatile("s_waitcnt vmcnt(0)" ::: "memory");
            const unsigned og = xb_add(&bar[XB_TOP], 1u);
            const unsigned tg = og / nx;
            if (og + 1u == (tg + 1u) * nx) xb_add(&bar[XB_TOPGEN], 1u);
            else XB_SPIN(xb_ld(&bar[XB_TOPGEN]) == tg, bar);
            __builtin_amdgcn_fence(__ATOMIC_ACQUIRE, "agent");
            xb_add(&bar[XB_XGEN(b.x)], 1u);
            asm volatile("s_waitcnt vmcnt(0)" ::: "memory");
        } else {
            XB_SPIN(xb_ld(&bar[XB_XGEN(b.x)]) == gen, bar);
            __builtin_amdgcn_fence(__ATOMIC_ACQUIRE, "agent");
            asm volatile("s_waitcnt vmcnt(0)" ::: "memory");
        }
    }
    __syncthreads();
}

struct Params {
    const float* x; const float* p; const int* positions; const float* norm1_w; const float* w_in; const float* w_pool; const float* pool_scale;
    const float* q_norm_w; const float* k_norm_cmp_w; const float* k_norm_slc_w; const float* k_norm_win_w; const float* cmp_pos_k; const float* cmp_pos_v;
    const float* cmp_k_w1; const float* cmp_k_w2; const float* cmp_v_w1; const float* cmp_v_w2; const float* w_o; const float* norm2_w; const float* w_ffn_in;
    const float* conv_w; const float* conv_b; const float* w_ffn_out; const float* w_ple_proj; const float* ple_norm_w; const float* ple_gate_norm_w; const float* w_ple_gate;
    float* out; unsigned char* ws; int ph_lo, ph_hi;
};

namespace pg8 {
constexpr int BM = 256, BK = 64, HALF = 128, HTB = HALF * BK * 2, STAGE_BYTES = 8 * HTB, NXCD = 8, WGM = 8;
__host__ __device__ __forceinline__ int lds_byte(int r, int c) { const int st = (r >> 4) * 2 + (c >> 5), rr = r & 15, cc = c & 31, ob = rr * 64 + cc * 2; return st * 1024 + (ob ^ (((ob >> 9) & 1) << 5)); }
__host__ __device__ __forceinline__ void stage_rc(int b, int& R, int& C) { const int st = b / 1024, sb = b % 1024, swz = sb ^ (((sb >> 9) & 1) << 5); R = (st >> 1) * 16 + swz / 64; C = (st & 1) * 32 + (swz % 64) / 2; }
__host__ __device__ __forceinline__ int perm32(int rho) { const int n = rho >> 4, i = rho & 15; return 8 * (i >> 2) + 4 * n + (i & 3); }
struct Unit { int pm, pn; };

struct StaticOrder {
    int nM, nN, nwg, G, c;
    __device__ void init(int nM_, int nN_, int G_, int c_) { nM = nM_; nN = nN_; nwg = nM * nN; G = G_; c = c_; }
    __device__ bool next(int i, Unit& u) const {
        const long L = (long)i * G + c; if (L >= nwg) return false;
        int wgid = (int)L; { const int q = nwg / NXCD, r = nwg % NXCD, xcd = wgid % NXCD, off = wgid / NXCD; wgid = (xcd < r ? xcd * (q + 1) : r * (q + 1) + (xcd - r) * q) + off; }
        const int nig = WGM * nN, gid = wgid / nig, fm = gid * WGM, gsz = (nM - fm) < WGM ? (nM - fm) : WGM;
        u.pm = fm + ((wgid % nig) % gsz); u.pn = (wgid % nig) / gsz; return true;
    }
};

struct GStd {
    const char* A; const char* B; unsigned lda, ldb; int nt;
    __device__ __forceinline__ const char* a_base(const Unit& u) const { return A + (size_t)u.pm * 256 * lda * 2; }
    __device__ __forceinline__ const char* b_base(const Unit& u) const { return B + (size_t)u.pn * 256 * ldb * 2; }
    __device__ __forceinline__ size_t kpairA() const { return 256; }
};
struct GPool {
    const char* A; const char* B; unsigned lda, ldb; int nt;
    __device__ __forceinline__ const char* a_base(const Unit& u) const { return A + (size_t)u.pm * 256 * lda * 2 + (size_t)u.pn * 512; }
    __device__ __forceinline__ const char* b_base(const Unit& u) const { return B + (size_t)u.pn * 256 * ldb * 2; }
    __device__ __forceinline__ size_t kpairA() const { return 256; }
};
struct GCmp {
    const char* Z; const char* Bk; const char* Bv; unsigned lda, ldb; int nt;
    __device__ __forceinline__ const char* a_base(const Unit& u) const { const int which = u.pm >> 4, g = (u.pm >> 2) & 3, rt = u.pm & 3;
        return Z + (size_t)(OFF_KV + which * 512 + g * 128) * 2 + (size_t)rt * 256 * lda * 2; }
    __device__ __forceinline__ const char* b_base(const Unit& u) const { return (u.pm >> 4) ? Bv : Bk; }
    __device__ __forceinline__ size_t kpairA() const { return (size_t)LDZ * 2; }
};

struct EpiBf16 {
    static constexpr bool PERM = true;
    bf16_t* O; int ldc;
    __device__ __forceinline__ void operator()(const f32x4 (&acc)[2][2][4][2], const Unit& u, int wr, int wc, int fr, int fq) const {
        const int row0 = u.pm * BM + wr * 64 + fr, col0 = u.pn * BM + wc * 32 + 8 * fq;
#pragma unroll
        for (int ai = 0; ai < 2; ++ai)
#pragma unroll
            for (int m = 0; m < 4; ++m) { bf16_t* rowp = O + (size_t)(row0 + ai * HALF + m * 16) * ldc + col0;
#pragma unroll
                for (int bj = 0; bj < 2; ++bj) { const f32x4 v0 = acc[ai][bj][m][0], v1 = acc[ai][bj][m][1];
                    u32x4 w; w.x = cvt_pk_bf16(v0[0], v0[1]); w.y = cvt_pk_bf16(v0[2], v0[3]); w.z = cvt_pk_bf16(v1[0], v1[1]); w.w = cvt_pk_bf16(v1[2], v1[3]);
                    *(u32x4*)(rowp + bj * HALF) = w; } }
    }
};
struct EpiBf16S {
    static constexpr bool PERM = true;
    bf16_t* O; int ldc; float s;
    __device__ __forceinline__ void operator()(const f32x4 (&acc)[2][2][4][2], const Unit& u, int wr, int wc, int fr, int fq) const {
        const int row0 = u.pm * BM + wr * 64 + fr, col0 = u.pn * BM + wc * 32 + 8 * fq;
#pragma unroll
        for (int ai = 0; ai < 2; ++ai)
#pragma unroll
            for (int m = 0; m < 4; ++m) { bf16_t* rowp = O + (size_t)(row0 + ai * HALF + m * 16) * ldc + col0;
#pragma unroll
                for (int bj = 0; bj < 2; ++bj) { const f32x4 v0 = acc[ai][bj][m][0] * s, v1 = acc[ai][bj][m][1] * s;
                    u32x4 w; w.x = cvt_pk_bf16(v0[0], v0[1]); w.y = cvt_pk_bf16(v0[2], v0[3]); w.z = cvt_pk_bf16(v1[0], v1[1]); w.w = cvt_pk_bf16(v1[2], v1[3]);
                    *(u32x4*)(rowp + bj * HALF) = w; } }
    }
};
struct EpiBf16Ssq {
    static constexpr bool PERM = true;
    bf16_t* O; int ldc; float* ssq;
    __device__ __forceinline__ void operator()(const f32x4 (&acc)[2][2][4][2], const Unit& u, int wr, int wc, int fr, int fq) const {
        const int row0 = u.pm * BM + wr * 64 + fr, col0 = u.pn * BM + wc * 32 + 8 * fq;
#pragma unroll
        for (int ai = 0; ai < 2; ++ai)
#pragma unroll
            for (int m = 0; m < 4; ++m) { const int row = row0 + ai * HALF + m * 16; bf16_t* rowp = O + (size_t)row * ldc + col0; float s = 0.f;
#pragma unroll
                for (int bj = 0; bj < 2; ++bj) { const f32x4 v0 = acc[ai][bj][m][0], v1 = acc[ai][bj][m][1];
                    s += v0[0] * v0[0] + v0[1] * v0[1] + v0[2] * v0[2] + v0[3] * v0[3] + v1[0] * v1[0] + v1[1] * v1[1] + v1[2] * v1[2] + v1[3] * v1[3];
                    u32x4 w; w.x = cvt_pk_bf16(v0[0], v0[1]); w.y = cvt_pk_bf16(v0[2], v0[3]); w.z = cvt_pk_bf16(v1[0], v1[1]); w.w = cvt_pk_bf16(v1[2], v1[3]);
                    *(u32x4*)(rowp + bj * HALF) = w; }
                s += __shfl_xor(s, 16); s += __shfl_xor(s, 32);
                if (fq == 0) unsafeAtomicAdd(ssq + row, s); }
    }
};
struct EpiBf16Scale {
    static constexpr bool PERM = true;
    bf16_t* O; int ldc; const float* colscale;
    __device__ __forceinline__ void operator()(const f32x4 (&acc)[2][2][4][2], const Unit& u, int wr, int wc, int fr, int fq) const {
        const int row0 = u.pm * BM + wr * 64 + fr, col0 = u.pn * BM + wc * 32 + 8 * fq;
#pragma unroll
        for (int bj = 0; bj < 2; ++bj) { const f32x4 s0 = *(const f32x4*)(colscale + col0 + bj * HALF), s1 = *(const f32x4*)(colscale + col0 + bj * HALF + 4);
#pragma unroll
            for (int ai = 0; ai < 2; ++ai)
#pragma unroll
                for (int m = 0; m < 4; ++m) { bf16_t* rowp = O + (size_t)(row0 + ai * HALF + m * 16) * ldc + col0;
                    const f32x4 v0 = acc[ai][bj][m][0] * s0, v1 = acc[ai][bj][m][1] * s1;
                    u32x4 w; w.x = cvt_pk_bf16(v0[0], v0[1]); w.y = cvt_pk_bf16(v0[2], v0[3]); w.z = cvt_pk_bf16(v1[0], v1[1]); w.w = cvt_pk_bf16(v1[2], v1[3]);
                    *(u32x4*)(rowp + bj * HALF) = w; } }
    }
};
struct EpiResF32 {
    static constexpr bool PERM = false;
    const float* base; float* C; int ldc; int row_off;
    __device__ __forceinline__ void operator()(const f32x4 (&acc)[2][2][4][2], const Unit& u, int wr, int wc, int fr, int fq) const {
        const int row0 = u.pm * BM + wr * 64 + fr + row_off, col0 = u.pn * BM + wc * 32 + 4 * fq;
#pragma unroll
        for (int ai = 0; ai < 2; ++ai)
#pragma unroll
            for (int m = 0; m < 4; ++m) { const size_t off = (size_t)(row0 + ai * HALF + m * 16) * ldc + col0;
#pragma unroll
                for (int bj = 0; bj < 2; ++bj)
#pragma unroll
                    for (int n = 0; n < 2; ++n) { const f32x4 b = *(const f32x4*)(base + off + bj * HALF + n * 16); *(f32x4*)(C + off + bj * HALF + n * 16) = b + acc[ai][bj][m][n]; }
                asm volatile("" ::: "memory"); }
    }
};
template <bool FP8OUT, bool BASEBF, bool WXN = true>
struct EpiResNormT {
    static constexpr bool PERM = false;
    const void* base; bf16_t* C; bf16_t* XN; const float* nw; float* ssq; int ldc; float ascale = 1.0f;
    typedef typename std::conditional<BASEBF, u32x2, f32x4>::type RawT;
    __device__ __forceinline__ RawT ldb(size_t idx) const { if constexpr (BASEBF) return *(const u32x2*)((const bf16_t*)base + idx); else return *(const f32x4*)((const float*)base + idx); }
    static __device__ __forceinline__ f32x4 cv(const RawT& r) { if constexpr (BASEBF) return (f32x4){bf_lo(r.x), bf_hi(r.x), bf_lo(r.y), bf_hi(r.y)}; else return r; }
    __device__ __forceinline__ void operator()(const f32x4 (&acc)[2][2][4][2], const Unit& u, int wr, int wc, int fr, int fq) const {
        const int row0 = u.pm * BM + wr * 64 + fr, col0 = u.pn * BM + wc * 32 + 4 * fq;
        f32x4 wv[2][2];
#pragma unroll
        for (int bj = 0; bj < 2; ++bj)
#pragma unroll
            for (int n = 0; n < 2; ++n) wv[bj][n] = *(const f32x4*)(nw + col0 + bj * HALF + n * 16);
        RawT bv[2][2][2];
#pragma unroll
        for (int bj = 0; bj < 2; ++bj)
#pragma unroll
            for (int n = 0; n < 2; ++n) bv[0][bj][n] = ldb((size_t)row0 * ldc + col0 + bj * HALF + n * 16);
#pragma unroll
        for (int rg = 0; rg < 8; ++rg) { const int ai = rg >> 2, m = rg & 3; const int row = row0 + ai * HALF + m * 16; const size_t off = (size_t)row * ldc + col0;
            if (rg < 7) { const int ai2 = (rg + 1) >> 2, m2 = (rg + 1) & 3; const size_t off2 = (size_t)(row0 + ai2 * HALF + m2 * 16) * ldc + col0;
#pragma unroll
                for (int bj = 0; bj < 2; ++bj)
#pragma unroll
                    for (int n = 0; n < 2; ++n) bv[(rg + 1) & 1][bj][n] = ldb(off2 + bj * HALF + n * 16); }
            float s = 0.f;
#pragma unroll
            for (int bj = 0; bj < 2; ++bj)
#pragma unroll
                for (int n = 0; n < 2; ++n) { const f32x4 v = cv(bv[rg & 1][bj][n]) + acc[ai][bj][m][n] * ascale;
                    { u32x2 c; c.x = cvt_pk_bf16(v[0], v[1]); c.y = cvt_pk_bf16(v[2], v[3]); *(u32x2*)(C + off + bj * HALF + n * 16) = c; }
                    s += v[0] * v[0] + v[1] * v[1] + v[2] * v[2] + v[3] * v[3];
                    if (!WXN) { }
                    else if (FP8OUT) { int pk = __builtin_amdgcn_cvt_pk_fp8_f32(v[0] * wv[bj][n][0], v[1] * wv[bj][n][1], 0, false); pk = __builtin_amdgcn_cvt_pk_fp8_f32(v[2] * wv[bj][n][2], v[3] * wv[bj][n][3], pk, true);
                        *(int*)((unsigned char*)XN + off + bj * HALF + n * 16) = pk; }
                    else { u32x2 o; o.x = cvt_pk_bf16(v[0] * wv[bj][n][0], v[1] * wv[bj][n][1]); o.y = cvt_pk_bf16(v[2] * wv[bj][n][2], v[3] * wv[bj][n][3]);
                        *(u32x2*)(XN + off + bj * HALF + n * 16) = o; } }
            s += __shfl_xor(s, 16); s += __shfl_xor(s, 32);
            if (fq == 0) unsafeAtomicAdd(ssq + row, s);
        }
    }
};
typedef EpiResNormT<false, false, false> EpiResNorm;
typedef EpiResNormT<true, true> EpiResNormF8;
struct EpiCmpGelu {
    static constexpr bool PERM = false;
    float* H; const float* bias;
    __device__ __forceinline__ void operator()(const f32x4 (&acc)[2][2][4][2], const Unit& u, int wr, int wc, int fr, int fq) const {
        const int row0 = u.pm * BM + wr * 64 + fr, col0 = wc * 32 + 4 * fq; const float* bs = bias + (u.pm >> 4) * 256;
        f32x4 bvv[2][2];
#pragma unroll
        for (int bj = 0; bj < 2; ++bj)
#pragma unroll
            for (int n = 0; n < 2; ++n) bvv[bj][n] = *(const f32x4*)(bs + col0 + bj * HALF + n * 16);
#pragma unroll
        for (int ai = 0; ai < 2; ++ai)
#pragma unroll
            for (int m = 0; m < 4; ++m) { float* rowp = H + (size_t)(row0 + ai * HALF + m * 16) * 256 + col0;
#pragma unroll
                for (int bj = 0; bj < 2; ++bj)
#pragma unroll
                    for (int n = 0; n < 2; ++n) { f32x4 v = acc[ai][bj][m][n] + bvv[bj][n];
#pragma unroll
                        for (int j = 0; j < 4; ++j) { const float xx = v[j], uu = 0.7978845608028654f * (xx + 0.044715f * xx * xx * xx); const float th = 1.0f - 2.0f / (1.0f + __expf(2.0f * uu)); v[j] = 0.5f * xx * (1.0f + th); }
                        *(f32x4*)(rowp + bj * HALF + n * 16) = v; } }
    }
};
struct EpiGate {
    static constexpr bool PERM = false;
    float* C; const bf16_t* H; const bf16_t* eraw; const float* erstd; const float* pw; const float* ssq; int ldc; float ascale;
    __device__ __forceinline__ void operator()(const f32x4 (&acc)[2][2][4][2], const Unit& u, int wr, int wc, int fr, int fq) const {
        const int row0 = u.pm * BM + wr * 64 + fr, col0 = u.pn * BM + wc * 32 + 4 * fq;
        f32x4 wv[2][2];
#pragma unroll
        for (int bj = 0; bj < 2; ++bj)
#pragma unroll
            for (int n = 0; n < 2; ++n) wv[bj][n] = *(const f32x4*)(pw + col0 + bj * HALF + n * 16);
        u32x2 bv[2][2][2]; u32x2 ev[2][2][2]; float rsv[2], rgv[2];
#pragma unroll
        for (int bj = 0; bj < 2; ++bj)
#pragma unroll
            for (int n = 0; n < 2; ++n) { bv[0][bj][n] = *(const u32x2*)(H + (size_t)row0 * ldc + col0 + bj * HALF + n * 16); ev[0][bj][n] = *(const u32x2*)(eraw + (size_t)row0 * ldc + col0 + bj * HALF + n * 16); }
        rsv[0] = erstd[row0]; rgv[0] = ssq[row0];
#pragma unroll
        for (int rg = 0; rg < 8; ++rg) { const int ai = rg >> 2, m = rg & 3; const int row = row0 + ai * HALF + m * 16; const size_t off = (size_t)row * ldc + col0;
            if (rg < 7) { const int ai2 = (rg + 1) >> 2, m2 = (rg + 1) & 3; const int row2 = row0 + ai2 * HALF + m2 * 16; const size_t off2 = (size_t)row2 * ldc + col0;
#pragma unroll
                for (int bj = 0; bj < 2; ++bj)
#pragma unroll
                    for (int n = 0; n < 2; ++n) { bv[(rg + 1) & 1][bj][n] = *(const u32x2*)(H + off2 + bj * HALF + n * 16); ev[(rg + 1) & 1][bj][n] = *(const u32x2*)(eraw + off2 + bj * HALF + n * 16); }
                rsv[(rg + 1) & 1] = erstd[row2]; rgv[(rg + 1) & 1] = ssq[row2]; }
            const float rs = rsqrtf(rsv[rg & 1] * (1.0f / DM) + EPS), rg_ = rsqrtf(rgv[rg & 1] * (1.0f / DM) + EPS) * ascale;
#pragma unroll
            for (int bj = 0; bj < 2; ++bj)
#pragma unroll
                for (int n = 0; n < 2; ++n) { const u32x2 br = bv[rg & 1][bj][n]; const f32x4 b = {bf_lo(br.x), bf_hi(br.x), bf_lo(br.y), bf_hi(br.y)}; const u32x2 e = ev[rg & 1][bj][n]; const f32x4 a = acc[ai][bj][m][n]; f32x4 o;
                    o[0] = b[0] + bf_lo(e.x) * rs * wv[bj][n][0] * sigmoidf_(a[0] * rg_); o[1] = b[1] + bf_hi(e.x) * rs * wv[bj][n][1] * sigmoidf_(a[1] * rg_);
                    o[2] = b[2] + bf_lo(e.y) * rs * wv[bj][n][2] * sigmoidf_(a[2] * rg_); o[3] = b[3] + bf_hi(e.y) * rs * wv[bj][n][3] * sigmoidf_(a[3] * rg_);
                    *(f32x4*)(C + off + bj * HALF + n * 16) = o; }
        }
    }
};
struct GFfn {
    const char* A; const char* B; unsigned lda, ldb; int nt;
    __device__ __forceinline__ const char* a_base(const Unit& u) const { return A + ((long)u.pm * 254 - 2) * (long)lda * 2; }
    __device__ __forceinline__ const char* b_base(const Unit& u) const { return B + (size_t)u.pn * 256 * ldb * 2; }
    __device__ __forceinline__ size_t kpairA() const { return 256; }
};
template <int CTRL> __device__ __forceinline__ float dpp_f(float v) { return __int_as_float(__builtin_amdgcn_update_dpp(0, __float_as_int(v), CTRL, 0xf, 0xf, false)); }
struct EpiFfn {
    static constexpr bool PERM = true;
    bf16_t* ACT; const float* cw; const float* cb; LAS float* X; const float* ssq;
    __device__ __forceinline__ void operator()(const f32x4 (&acc)[2][2][4][2], const Unit& u, int wr, int wc, int fr, int fq) const {
        const int colw = wc * 32 + 8 * fq;
        const int f0 = u.pn * 128 + colw;
        f32x4 w0[2], w1[2], w2[2], cbv[2];
#pragma unroll
        for (int n = 0; n < 2; ++n) { w0[n] = *(const f32x4*)(cw + f0 + 4 * n); w1[n] = *(const f32x4*)(cw + DFF + f0 + 4 * n); w2[n] = *(const f32x4*)(cw + 2 * DFF + f0 + 4 * n); cbv[n] = *(const f32x4*)(cb + f0 + 4 * n); }
        float rsv[2][4];
#pragma unroll
        for (int ai = 0; ai < 2; ++ai)
#pragma unroll
            for (int m = 0; m < 4; ++m) { const long t = (long)u.pm * 254 - 2 + ai * HALF + wr * 64 + m * 16 + fr; rsv[ai][m] = ssq[t < 0 ? 0 : (t >= S_ ? S_ - 1 : t)]; }
#pragma unroll
        for (int ai = 0; ai < 2; ++ai)
#pragma unroll
            for (int m = 0; m < 4; ++m) { const long t = (long)u.pm * 254 - 2 + ai * HALF + wr * 64 + m * 16 + fr; rsv[ai][m] = (t >= 0 && t < S_) ? rsqrtf(rsv[ai][m] * (1.0f / DM) + EPS) : 0.f; }
        if (fr >= 14) {
#pragma unroll
            for (int ai = 0; ai < 2; ++ai)
#pragma unroll
                for (int n = 0; n < 2; ++n) *(LAS f32x4*)(X + ((2 * ai + wr) * 2 + (fr - 14)) * 128 + colw + 4 * n) = acc[ai][0][3][n] * rsv[ai][3];
        }
        asm volatile("s_waitcnt lgkmcnt(0)" ::: "memory");
        __builtin_amdgcn_s_barrier(); asm volatile("" ::: "memory");
        __builtin_amdgcn_s_barrier(); asm volatile("" ::: "memory");
        const bool sel1 = fr == 15, sel2 = fr >= 14;
#pragma unroll
        for (int ai = 0; ai < 2; ++ai) {
            f32x4 pv[2];
            const int pseg = 2 * ai + wr - 1;
#pragma unroll
            for (int n = 0; n < 2; ++n) { pv[n] = (f32x4){0.f, 0.f, 0.f, 0.f}; if (pseg >= 0 && fr >= 14) pv[n] = *(const LAS f32x4*)(X + (pseg * 2 + (fr - 14)) * 128 + colw + 4 * n); }
#pragma unroll
            for (int m = 0; m < 4; ++m) {
                const int r = ai * HALF + wr * 64 + m * 16 + fr; const long t = (long)u.pm * 254 - 2 + r;
                unsigned ow[4];
#pragma unroll
                for (int n = 0; n < 2; ++n) {
                    const f32x4 cur = acc[ai][0][m][n] * rsv[ai][m], up = acc[ai][1][m][n] * rsv[ai][m];
                    f32x4 x1, x2;
#pragma unroll
                    for (int i = 0; i < 4; ++i) { x1[i] = dpp_f<0x121>(sel1 ? pv[n][i] : cur[i]); x2[i] = dpp_f<0x122>(sel2 ? pv[n][i] : cur[i]); }
                    const f32x4 y = cbv[n] + w0[n] * x2 + w1[n] * x1 + w2[n] * cur;
                    f32x4 sg;
#pragma unroll
                    for (int i = 0; i < 4; ++i) sg[i] = sigmoidf_(y[i]);
                    const f32x4 o = y * sg * up;
                    ow[2 * n] = cvt_pk_bf16(o[0], o[1]); ow[2 * n + 1] = cvt_pk_bf16(o[2], o[3]);
                    pv[n] = cur;
                }
                if (r >= 2 && t < S_) *(u32x4*)(ACT + (size_t)t * DFF + f0) = (u32x4){ow[0], ow[1], ow[2], ow[3]};
            }
        }
    }
};

template <class GD, class Epi, bool F8T = false, int MIXT = 0>
__device__ __forceinline__ void gemm_phase(LAS unsigned char* lds, const GD g, const StaticOrder& S, const Epi& E) {
    constexpr bool F8 = F8T;
    const int tid = threadIdx.x, wid = __builtin_amdgcn_readfirstlane(tid >> 6), lane = tid & 63, wr = wid >> 2, wc = wid & 3, fr = lane & 15, fq = lane >> 4;
    const int nt = g.nt;
    unsigned voffA[2], voffB[2];
#pragma unroll
    for (int i = 0; i < 2; ++i) { int R, C; stage_rc(tid * 16 + i * 8192, R, C); const int Rb = Epi::PERM ? ((R & ~31) + perm32(R & 31)) : R;
        voffA[i] = (unsigned)(R * g.lda + C) * 2u; voffB[i] = (unsigned)(Rb * g.ldb + C) * 2u; }
    const size_t kpA = g.kpairA();
    const size_t hstepA = (size_t)HALF * g.lda * 2, hstepB = (size_t)HALF * g.ldb * 2;
    const unsigned ldsw = (unsigned)wid * 1024u;
    const int aoff = lds_byte(wr * 64 + fr, fq * 8), boff = lds_byte(wc * 32 + fr, fq * 8);
#define PG8_SA(b, h) (((b) * 2 + (h)) * HTB)
#define PG8_SB(b, h) ((4 + (b) * 2 + (h)) * HTB)
#define PG8_STAGE(bufoff, gbase, voff) do { _Pragma("unroll") for (int _i = 0; _i < 2; ++_i) \
        __builtin_amdgcn_global_load_lds((const unsigned*)((const char*)(gbase) + (voff)[_i]), (LAS unsigned*)(lds + (bufoff) + ldsw + _i * 8192), 16, 0, 0); } while (0)
#define PG8_LDA(dst, b, h) do { if constexpr (F8) { _Pragma("unroll") for (int m = 0; m < 4; ++m) { const i32x4 lo_ = *(const LAS i32x4*)(lds + PG8_SA(b, h) + aoff + m * 2048), hi_ = *(const LAS i32x4*)(lds + PG8_SA(b, h) + aoff + m * 2048 + 1024); \
            dst##8[m] = __builtin_shufflevector(lo_, hi_, 0, 1, 2, 3, 4, 5, 6, 7); } } \
        else { _Pragma("unroll") for (int m = 0; m < 4; ++m) _Pragma("unroll") for (int k = 0; k < 2; ++k) dst[m][k] = *(const LAS bf16x8*)(lds + PG8_SA(b, h) + aoff + m * 2048 + k * 1024); } } while (0)
#define PG8_LDB(dst, b, h) do { if constexpr (F8) { _Pragma("unroll") for (int n = 0; n < 2; ++n) { const i32x4 lo_ = *(const LAS i32x4*)(lds + PG8_SB(b, h) + boff + n * 2048), hi_ = *(const LAS i32x4*)(lds + PG8_SB(b, h) + boff + n * 2048 + 1024); \
            dst##8[n] = __builtin_shufflevector(lo_, hi_, 0, 1, 2, 3, 4, 5, 6, 7); } } \
        else { _Pragma("unroll") for (int n = 0; n < 2; ++n) _Pragma("unroll") for (int k = 0; k < 2; ++k) dst[n][k] = *(const LAS bf16x8*)(lds + PG8_SB(b, h) + boff + n * 2048 + k * 1024); } } while (0)
#define PG8_MMA(ai, bj, At, Bt) do { __builtin_amdgcn_s_setprio(1); \
        if constexpr (F8) { _Pragma("unroll") for (int m = 0; m < 4; ++m) _Pragma("unroll") for (int n = 0; n < 2; ++n) \
            asm volatile("v_mfma_scale_f32_16x16x128_f8f6f4 %0, %1, %2, %0, %3, %3 op_sel_hi:[0,0,0]" : "+v"(acc[ai][bj][m][n]) : "v"(Bt##8[n]), "v"(At##8[m]), "v"(one_scale)); } \
        else { _Pragma("unroll") for (int m = 0; m < 4; ++m) _Pragma("unroll") for (int n = 0; n < 2; ++n) _Pragma("unroll") for (int k = 0; k < 2; ++k) \
            acc[ai][bj][m][n] = __builtin_amdgcn_mfma_f32_16x16x32_bf16(Bt[n][k], At[m][k], acc[ai][bj][m][n], 0, 0, 0); } \
        __builtin_amdgcn_s_setprio(0); } while (0)
#define PG8_WAIT_V(n) asm volatile("s_waitcnt vmcnt(" #n ")" ::: "memory")
#define PG8_WAIT_L(n) asm volatile("s_waitcnt lgkmcnt(" #n ")" ::: "memory")
#define PG8_BAR __builtin_amdgcn_s_barrier()
#define PG8_SCHED __builtin_amdgcn_sched_barrier(0)
#define PG8_BODY \
            PG8_LDB(B0, 0, 0); PG8_SCHED; PG8_LDA(At, 0, 0); PG8_STAGE(PG8_SA(1, 1), a1 + hstepA, voffA); \
            PG8_WAIT_L(8); PG8_BAR; PG8_WAIT_L(0); PG8_MMA(0, 0, At, B0); PG8_BAR; PG8_SCHED; \
            PG8_LDB(B1, 0, 1); PG8_STAGE(PG8_SB(0, 0), b2, voffB); \
            PG8_BAR; PG8_WAIT_L(0); PG8_MMA(0, 1, At, B1); PG8_BAR; \
            PG8_LDA(At, 0, 1); PG8_STAGE(PG8_SA(0, 0), a2, voffA); \
            PG8_BAR; PG8_WAIT_L(0); PG8_MMA(1, 0, At, B0); PG8_BAR; PG8_SCHED; \
            PG8_STAGE(PG8_SB(0, 1), b2 + hstepB, voffB); \
            PG8_WAIT_V(6); PG8_BAR; PG8_MMA(1, 1, At, B1); PG8_BAR; \
            PG8_LDB(B0, 1, 0); PG8_SCHED; PG8_LDA(At, 1, 0); PG8_STAGE(PG8_SA(0, 1), a2 + hstepA, voffA); \
            PG8_WAIT_L(8); PG8_BAR; PG8_WAIT_L(0); PG8_MMA(0, 0, At, B0); PG8_BAR; PG8_SCHED; \
            PG8_LDB(B1, 1, 1); PG8_STAGE(PG8_SB(1, 0), b3, voffB); \
            PG8_BAR; PG8_WAIT_L(0); PG8_MMA(0, 1, At, B1); PG8_BAR; \
            PG8_LDA(At, 1, 1); PG8_STAGE(PG8_SA(1, 0), a3, voffA); \
            PG8_BAR; PG8_WAIT_L(0); PG8_MMA(1, 0, At, B0); PG8_BAR; PG8_SCHED; \
            PG8_STAGE(PG8_SB(1, 1), b3 + hstepB, voffB); \
            PG8_WAIT_V(6); PG8_BAR; PG8_MMA(1, 1, At, B1); PG8_BAR;
    Unit cur, nxt; int ui = 0;
    if (!S.next(0, cur)) return;
    f32x4 acc[2][2][4][2];
#pragma unroll
    for (int a = 0; a < 2; ++a)
#pragma unroll
        for (int b = 0; b < 2; ++b)
#pragma unroll
            for (int m = 0; m < 4; ++m)
#pragma unroll
                for (int n = 0; n < 2; ++n) acc[a][b][m][n] = (f32x4){0.f, 0.f, 0.f, 0.f};
    bf16x8 At[4][2], B0[2][2], B1[2][2];
    i32x8 At8[4], B08[2], B18[2];
    (void)At; (void)B0; (void)B1; (void)At8; (void)B08; (void)B18;
    int one_scale = 0x7F7F7F7F; (void)one_scale;
    const char* cA = g.a_base(cur); const char* cB = g.b_base(cur);
    PG8_STAGE(PG8_SB(0, 0), cB, voffB); PG8_STAGE(PG8_SA(0, 0), cA, voffA); PG8_STAGE(PG8_SB(0, 1), cB + hstepB, voffB); PG8_STAGE(PG8_SA(0, 1), cA + hstepA, voffA);
    if (wr == 1) PG8_BAR;
    PG8_WAIT_V(4); PG8_BAR;
    PG8_STAGE(PG8_SB(1, 0), cB + 128, voffB); PG8_STAGE(PG8_SA(1, 0), cA + 128, voffA); PG8_STAGE(PG8_SB(1, 1), cB + hstepB + 128, voffB);
    PG8_WAIT_V(6); PG8_BAR;
    for (;;) {
        const bool has_next = S.next(ui + 1, nxt);
        const char* nA = has_next ? g.a_base(nxt) : cA; const char* nB = has_next ? g.b_base(nxt) : cB;
#define PG8_ADDR const bool last = (t == nt - 2); const char* a0 = cA + (size_t)(t >> 1) * kpA; const char* a1 = a0 + 128; \
            const char* a2 = last ? nA : a0 + kpA; const char* b2 = last ? nB : cB + (size_t)(t + 2) * 128; const char* a3 = a2 + 128; const char* b3 = b2 + 128;
        if constexpr (MIXT > 0) {
            for (int t = 0; t < MIXT; t += 2) { PG8_ADDR PG8_BODY }
            for (int t = MIXT; t < nt; t += 2) { constexpr bool F8 = true; (void)F8; PG8_ADDR PG8_BODY }
        } else {
            for (int t = 0; t < nt; t += 2) { PG8_ADDR PG8_BODY }
        }
#undef PG8_ADDR
        if constexpr (F8 || MIXT > 0) asm volatile("s_nop 15\n\ts_nop 15\n\ts_nop 15" ::: "memory");
        E(acc, cur, wr, wc, fr, fq);
        if (!has_next) break;
#pragma unroll
        for (int a = 0; a < 2; ++a)
#pragma unroll
            for (int b = 0; b < 2; ++b)
#pragma unroll
                for (int m = 0; m < 4; ++m)
#pragma unroll
                    for (int n = 0; n < 2; ++n) acc[a][b][m][n] = (f32x4){0.f, 0.f, 0.f, 0.f};
        cur = nxt; cA = nA; cB = nB; ++ui;
    }
    PG8_WAIT_V(0);
    if (wr == 0) PG8_BAR;
    PG8_BAR;
#undef PG8_SA
#undef PG8_SB
#undef PG8_STAGE
#undef PG8_LDA
#undef PG8_LDB
#undef PG8_MMA
#undef PG8_WAIT_V
#undef PG8_WAIT_L
#undef PG8_BAR
#undef PG8_SCHED
#undef PG8_BODY
}
}

namespace att {
constexpr int KVBLK = 64;
constexpr int SHM_V = KVBLK * HD * 2, SHM_K = KVBLK * HD * 2, SHM_ATTN = 2 * SHM_V + 2 * SHM_K + NWAVES * 64 * 4;
#define KSWZ(row, colB) ((row) * 256 + ((colB) ^ (((row) & 7) << 4)))
#define SBAR() __builtin_amdgcn_sched_barrier(0)
__device__ __forceinline__ int crow(int r, int hi) { return (r & 3) + 8 * (r >> 2) + 4 * hi; }
__device__ __forceinline__ void qkt(f32x16& p0, f32x16& p1, const char* Ks, const bf16x8* qr, int r32, int hi) {
    p0 = f32x16{}; p1 = f32x16{};
    bf16x8 ka[2], kb[2];
    { const int cb = (hi * 8) * 2; ka[0] = *reinterpret_cast<const bf16x8*>(Ks + KSWZ(r32, cb)); kb[0] = *reinterpret_cast<const bf16x8*>(Ks + KSWZ(32 + r32, cb)); }
#pragma unroll
    for (int d0 = 0; d0 < 8; ++d0) {
        if (d0 < 7) { const int cb = ((d0 + 1) * 16 + hi * 8) * 2;
            ka[(d0 + 1) & 1] = *reinterpret_cast<const bf16x8*>(Ks + KSWZ(r32, cb)); kb[(d0 + 1) & 1] = *reinterpret_cast<const bf16x8*>(Ks + KSWZ(32 + r32, cb)); }
        SBAR();
        p0 = __builtin_amdgcn_mfma_f32_32x32x16_bf16(ka[d0 & 1], qr[d0], p0, 0, 0, 0);
        p1 = __builtin_amdgcn_mfma_f32_32x32x16_bf16(kb[d0 & 1], qr[d0], p1, 0, 0, 0);
        SBAR();
    }
}
__device__ __forceinline__ int v_st(int k, int c) { const int kk = (k & ~0xC) | ((k & 4) << 1) | ((k & 8) >> 1); return ((kk >> 3) * 4 + (c >> 5)) * 512 + ((kk & 7) * 32 + (c & 31)) * 2; }
__device__ __forceinline__ int v_rd_base(int lane) { return ((lane & 3) << 3) | (((lane >> 2) & 3) << 6) | (((lane >> 4) & 1) << 5) | (((lane >> 5) & 1) << 8); }
constexpr int v_rd_off(int d0, int ks, int half) { return d0 * 512 + ks * 4096 + half * 2048; }
__device__ __forceinline__ s16x4 tr_read(int vb, int off) { return __builtin_amdgcn_ds_read_tr16_b64_v4i16((LAS s16x4*)(unsigned long)(unsigned)(vb + off)); }
__device__ __forceinline__ void pv_d0(f32x16* o, int vb, bf16x8 pa0, bf16x8 pa1, bf16x8 pa2, bf16x8 pa3) {
    s16x4 L[2][4], H[2][4];
#pragma unroll
    for (int d0 = 0; d0 < 4; ++d0) { L[0][d0] = tr_read(vb, v_rd_off(d0, 0, 0)); H[0][d0] = tr_read(vb, v_rd_off(d0, 0, 1)); }
#pragma unroll
    for (int ks = 0; ks < 4; ++ks) {
        if (ks < 3) {
#pragma unroll
            for (int d0 = 0; d0 < 4; ++d0) { L[(ks + 1) & 1][d0] = tr_read(vb, v_rd_off(d0, ks + 1, 0)); H[(ks + 1) & 1][d0] = tr_read(vb, v_rd_off(d0, ks + 1, 1)); }
        }
        const bf16x8 pa = ks == 0 ? pa0 : (ks == 1 ? pa1 : (ks == 2 ? pa2 : pa3));
#pragma unroll
        for (int d0 = 0; d0 < 4; ++d0) { const s16x4 l = L[ks & 1][d0], h = H[ks & 1][d0];
            o[d0] = __builtin_amdgcn_mfma_f32_32x32x16_bf16(pa, (bf16x8){l[0], l[1], l[2], l[3], h[0], h[1], h[2], h[3]}, o[d0], 0, 0, 0); }
    }
}
__device__ __forceinline__ void pack_p(const f32x16& p0, const f32x16& p1, bf16x8& pa0, bf16x8& pa1, bf16x8& pa2, bf16x8& pa3) {
#define PK4(P, BASE, OUT) do { unsigned a0 = cvt_pk_bf16(P[BASE + 0], P[BASE + 1]), a1 = cvt_pk_bf16(P[BASE + 2], P[BASE + 3]);   \
    unsigned b0 = cvt_pk_bf16(P[BASE + 4], P[BASE + 5]), b1 = cvt_pk_bf16(P[BASE + 6], P[BASE + 7]);                              \
    auto r0 = __builtin_amdgcn_permlane32_swap(a0, b0, false, false); auto r1 = __builtin_amdgcn_permlane32_swap(a1, b1, false, false); \
    u32x4 w = {r0[0], r1[0], r0[1], r1[1]}; OUT = *reinterpret_cast<bf16x8*>(&w); } while (0)
    PK4(p0, 0, pa0); PK4(p0, 8, pa1); PK4(p1, 0, pa2); PK4(p1, 8, pa3);
#undef PK4
}

__device__ __forceinline__ void pack_half(const f32x16& p, bf16x8& paA, bf16x8& paB) {
#define PK4(P, BASE, OUT) do { unsigned a0 = cvt_pk_bf16(P[BASE + 0], P[BASE + 1]), a1 = cvt_pk_bf16(P[BASE + 2], P[BASE + 3]);   \
    unsigned b0 = cvt_pk_bf16(P[BASE + 4], P[BASE + 5]), b1 = cvt_pk_bf16(P[BASE + 6], P[BASE + 7]);                              \
    auto r0 = __builtin_amdgcn_permlane32_swap(a0, b0, false, false); auto r1 = __builtin_amdgcn_permlane32_swap(a1, b1, false, false); \
    u32x4 w = {r0[0], r1[0], r0[1], r1[1]}; OUT = *reinterpret_cast<bf16x8*>(&w); } while (0)
    PK4(p, 0, paA); PK4(p, 8, paB);
#undef PK4
}
template <int KS0, bool WITH_EXP>
__device__ __forceinline__ void pv_half(f32x16* o, int vb, bf16x8 paA, bf16x8 paB, f32x16& px, float off) {
    s16x4 L[2][4], H[2][4];
#pragma unroll
    for (int d0 = 0; d0 < 4; ++d0) { L[0][d0] = tr_read(vb, v_rd_off(d0, KS0, 0)); H[0][d0] = tr_read(vb, v_rd_off(d0, KS0, 1)); }
#pragma unroll
    for (int d0 = 0; d0 < 4; ++d0) { L[1][d0] = tr_read(vb, v_rd_off(d0, KS0 + 1, 0)); H[1][d0] = tr_read(vb, v_rd_off(d0, KS0 + 1, 1)); }
#pragma unroll
    for (int kk = 0; kk < 2; ++kk) {
        const bf16x8 pa = kk == 0 ? paA : paB;
#pragma unroll
        for (int d0 = 0; d0 < 4; ++d0) { const s16x4 l = L[kk][d0], h = H[kk][d0];
            if (WITH_EXP) SBAR();
            o[d0] = __builtin_amdgcn_mfma_f32_32x32x16_bf16(pa, (bf16x8){l[0], l[1], l[2], l[3], h[0], h[1], h[2], h[3]}, o[d0], 0, 0, 0);
            if (WITH_EXP) {
#pragma unroll
                for (int q = 0; q < 2; ++q) { const int r = (kk * 4 + d0) * 2 + q; px[r] = __builtin_amdgcn_exp2f(fmaf(px[r], SM_C, off)); }
                SBAR(); }
        }
    }
}
enum { MODE_CMP = 0, MODE_WIN = 1, MODE_SLC = 2 };
struct AttnArgs {
    const bf16_t* Z; const bf16_t* KC; const bf16_t* VC; const float* G; float* L; float* OACC; bf16_t* MIX; const unsigned* BM; const float* TAB;
};
template <int MODE>
__device__ __forceinline__ void attn_unit(const AttnArgs& a, LAS char* ldsL, int qt, int g, int hp) {
    char* lds = (char*)ldsL;
    const int tid = threadIdx.x, wid = __builtin_amdgcn_readfirstlane(tid >> 6), lane = tid & 63, r32 = lane & 31, hi = lane >> 5;
    float* li_l = (float*)(lds + LDS_XCH) + wid * 64;
    const int t0 = MODE == MODE_SLC ? qt * 40 : qt * 128;
    const int tq_raw = MODE == MODE_SLC ? t0 + wid * 5 + r32 / 6 : t0 + wid * 16 + (r32 & 15);
    const bool rvalid = MODE == MODE_SLC ? (r32 < 30 && tq_raw < S_) : true;
    const int tq = tq_raw < S_ ? tq_raw : S_ - 1;
    const int hq = MODE == MODE_SLC ? g * HPG + r32 % 6 : g * HPG + hp * 2 + (r32 >> 4);
    const int tlast = MODE == MODE_SLC ? ((t0 + 39) < S_ ? (t0 + 39) : S_ - 1) : t0 + 127;
    const bf16_t* Kb; const bf16_t* Vb; long ldk;
    if (MODE == MODE_CMP) { Kb = a.KC + (size_t)g * 1024 * HD; Vb = a.VC + (size_t)g * 1024 * HD; ldk = HD; }
    else if (MODE == MODE_WIN) { Kb = a.Z + OFF_KV + 4 * 512 + g * HD; Vb = a.Z + OFF_KV + 5 * 512 + g * HD; ldk = LDZ; }
    else { Kb = a.Z + OFF_KV + 2 * 512 + g * HD; Vb = a.Z + OFF_KV + 3 * 512 + g * HD; ldk = LDZ; }
    int j0, j1;
    if (MODE == MODE_CMP) { j0 = 0; j1 = (((t0 + 127 - 31) >> 4) >> 6) + 1; }
    else if (MODE == MODE_WIN) { j0 = (t0 - 511) > 0 ? ((t0 - 511) >> 6) : 0; j1 = ((t0 + 127) >> 6) + 1; }
    else { j0 = 0; j1 = (tlast >> 6) + 1; }
    int klo, khi;
    if (MODE == MODE_CMP) { klo = 0; khi = tq >= 31 ? ((tq - 31) >> 4) : -1; }
    else if (MODE == MODE_WIN) { klo = tq - 511; khi = tq; }
    else { klo = 0; khi = rvalid ? tq : -1; }
    float negBC = -a.TAB[512 + (MODE == MODE_CMP ? 0 : (MODE == MODE_SLC ? 1 : 2))];
    bf16x8 qr[8];
    { const bf16_t* Qw = a.Z + (size_t)tq * LDZ + OFF_Q + hq * HD + hi * 8;
#pragma unroll
      for (int d0 = 0; d0 < 8; ++d0) qr[d0] = *reinterpret_cast<const bf16x8*>(Qw + d0 * 16); }
    f32x16 o[4] = {}; float lsum = 0.f;
    unsigned soK[2], soV[2];
#pragma unroll
    for (int i = 0; i < 2; ++i) { const int p = (wid + 8 * i) * 64 + lane;
        { const int row = p >> 4, c = (p & 15) ^ (row & 7); soK[i] = (unsigned)(row * ldk + c * 8) * 2u; }
        { const int sub = p >> 5, within = p & 31, kk = (sub >> 2) * 8 + (within >> 2), c = (sub & 3) * 32 + (within & 3) * 8, k = (kk & ~0xC) | ((kk & 4) << 1) | ((kk & 8) >> 1);
          soV[i] = (unsigned)(k * ldk + c) * 2u; } }
    const int vb0 = (int)(uintptr_t)(LAS char*)ldsL + 16384 + v_rd_base(lane);
#define ISSUE(jt) do { const int _b = ((jt) - j0) & 3; const char* _kp = (const char*)Kb + (size_t)(jt) * KVBLK * ldk * 2; const char* _vp = (const char*)Vb + (size_t)(jt) * KVBLK * ldk * 2; \
    _Pragma("unroll") for (int _i = 0; _i < 2; ++_i) { \
        __builtin_amdgcn_global_load_lds((const unsigned*)(_kp + soK[_i]), (LAS unsigned*)(ldsL + _b * 32768 + (wid + 8 * _i) * 1024), 16, 0, 0); \
        __builtin_amdgcn_global_load_lds((const unsigned*)(_vp + soV[_i]), (LAS unsigned*)(ldsL + _b * 32768 + 16384 + (wid + 8 * _i) * 1024), 16, 0, 0); } } while (0)
    unsigned bmw = 0u;
    if (MODE == MODE_SLC) bmw = a.BM[((size_t)tq * 4 + g) * 8];
    asm volatile("s_waitcnt lgkmcnt(0)" ::: "memory");
    __builtin_amdgcn_s_barrier();
    asm volatile("" ::: "memory");
    ISSUE(j0);
    asm volatile("s_waitcnt vmcnt(4) lgkmcnt(0)" : "+v"(bmw), "+v"(negBC), "+v"(qr[0]), "+v"(qr[1]), "+v"(qr[2]), "+v"(qr[3]), "+v"(qr[4]), "+v"(qr[5]), "+v"(qr[6]), "+v"(qr[7]) :: "memory");
    if (j0 + 1 < j1) ISSUE(j0 + 1); if (j0 + 2 < j1) ISSUE(j0 + 2);
    for (int j = j0; j < j1; ++j) {
        const int buf = (j - j0) & 3;
        if (j + 2 < j1) asm volatile("s_waitcnt vmcnt(8)" ::: "memory"); else if (j + 1 < j1) asm volatile("s_waitcnt vmcnt(4)" ::: "memory"); else asm volatile("s_waitcnt vmcnt(0)" ::: "memory");
        __builtin_amdgcn_s_barrier();
        asm volatile("" ::: "memory");
        if (j + 3 < j1) ISSUE(j + 3);
        int lhi = khi;
        if (MODE == MODE_SLC) { if (!((bmw >> (j & 31)) & 1u)) lhi = -1; }
        const int kb = j * KVBLK;
        const bool l_any = (kb + 63 >= klo) && (kb <= lhi);
        const bool l_full = (kb >= klo) && (kb + 63 <= lhi);
        if (__any(l_any)) {
            f32x16 p0, p1;
            qkt(p0, p1, lds + buf * 32768, qr, r32, hi);
            const bool uni = __all(l_full || !l_any);
            const float off = (uni && !l_any) ? -1.0e30f : negBC;
#pragma unroll
            for (int r = 0; r < 16; ++r) p0[r] = __builtin_amdgcn_exp2f(fmaf(p0[r], SM_C, off));
            if (!uni) {
#pragma unroll
                for (int r = 0; r < 16; ++r) { const int k0i = kb + crow(r, hi); p0[r] = (k0i >= klo && k0i <= lhi) ? p0[r] : 0.f; } }
            float ps = 0.f;
#pragma unroll
            for (int r = 0; r < 16; ++r) ps += p0[r];
            bf16x8 pa0, pa1, pa2, pa3; pack_half(p0, pa0, pa1);
            pv_half<0, true>(o, vb0 + buf * 32768, pa0, pa1, p1, off);
            if (!uni) {
#pragma unroll
                for (int r = 0; r < 16; ++r) { const int k1i = kb + 32 + crow(r, hi); p1[r] = (k1i >= klo && k1i <= lhi) ? p1[r] : 0.f; } }
#pragma unroll
            for (int r = 0; r < 16; ++r) ps += p1[r];
            lsum += ps;
            pack_half(p1, pa2, pa3);
            pv_half<2, false>(o, vb0 + buf * 32768, pa2, pa3, p1, off);
        }
        if (MODE == MODE_SLC) { if (((j + 1) & 31) == 0 && j + 1 < j1) { bmw = a.BM[((size_t)tq * 4 + g) * 8 + ((j + 1) >> 5)]; asm volatile("s_waitcnt vmcnt(0)" : "+v"(bmw) :: "memory"); } }
    }
#undef ISSUE
    lsum += __shfl_xor(lsum, 32);
    const float grow = a.G[(size_t)tq * NGATE + hq * 3 + (MODE == MODE_CMP ? 0 : (MODE == MODE_SLC ? 1 : 2))];
    if (hi == 0) { li_l[r32] = lsum; li_l[32 + r32] = rvalid ? grow : 0.f; }
    if (MODE == MODE_CMP) { if (hi == 0) a.L[(size_t)tq * NH + hq] = lsum; }
    asm volatile("s_waitcnt lgkmcnt(0)" ::: "memory");
#pragma unroll
    for (int hf = 0; hf < 2; ++hf) {
        float gtv[8]; float pvv[8][4];
#pragma unroll
        for (int rr = 0; rr < 8; ++rr) { const int r = hf * 8 + rr;
            const int orow = crow(r, hi); const float lv = li_l[orow]; const float rl = lv > 0.f ? __builtin_amdgcn_rcpf(lv) : 0.f;
            const int t = MODE == MODE_SLC ? t0 + wid * 5 + orow / 6 : t0 + wid * 16 + (orow & 15);
            const int h = MODE == MODE_SLC ? g * HPG + orow % 6 : g * HPG + hp * 2 + (orow >> 4);
            const bool valid = !(MODE == MODE_SLC && (orow >= 30 || t >= S_)); const int tc = valid ? t : 0;
            gtv[rr] = li_l[32 + orow] * rl;
            if (MODE == MODE_SLC) { const bf16_t* oc = (const bf16_t*)a.OACC + (size_t)tc * 3072 + h * HD + r32; const bf16_t* ow = oc + (size_t)S_ * 3072;
#pragma unroll
                for (int d0 = 0; d0 < 4; ++d0) pvv[rr][d0] = bf2f(oc[d0 * 32]) + bf2f(ow[d0 * 32]); }
        }
#pragma unroll
        for (int rr = 0; rr < 8; ++rr) { const int r = hf * 8 + rr;
            const int orow = crow(r, hi);
            const int t = MODE == MODE_SLC ? t0 + wid * 5 + orow / 6 : t0 + wid * 16 + (orow & 15);
            const int h = MODE == MODE_SLC ? g * HPG + orow % 6 : g * HPG + hp * 2 + (orow >> 4);
            if (MODE == MODE_SLC && (orow >= 30 || t >= S_)) continue;
            bf16_t* oa = (bf16_t*)a.OACC + (MODE == MODE_WIN ? (size_t)S_ * 3072 : 0) + (size_t)t * 3072 + h * HD + r32;
#pragma unroll
            for (int d0 = 0; d0 < 4; ++d0) {
                const float v = o[d0][r] * gtv[rr];
                if (MODE != MODE_SLC) oa[d0 * 32] = (bf16_t)(cvt_pk_bf16(v, 0.f) & 0xffffu);
                else a.MIX[(size_t)t * DM + POOLW + h * HD + d0 * 32 + r32] = (bf16_t)(cvt_pk_bf16(pvv[rr][d0] + v, 0.f) & 0xffffu);
            }
        }
    }
}

constexpr float QS16 = SM_C * 8.0f;
constexpr int SLC_KPS = 1040, SLC_VPS = 1056, SLC_KIMG = 8 * SLC_KPS, SLC_BUF = SLC_KIMG + 16 * SLC_VPS, SLC_NBUF = 6, LDS_SLCX = SLC_NBUF * SLC_BUF;
static_assert(LDS_SLCX + 3072 <= LDS_MISC, "slc ring overlaps the barrier words");
__device__ __forceinline__ bf16x8 lds_b128(int adr) { return *reinterpret_cast<const LAS bf16x8*>((LAS char*)(unsigned long)(unsigned)adr); }
template <int MODE16>
__device__ __forceinline__ void slc16_unit(const AttnArgs& a, LAS char* ldsL, int ut, int g) {
    constexpr bool WIN16 = MODE16 == 1, CMP16 = MODE16 == 2, DENSE16 = MODE16 != 0;
    char* lds = (char*)ldsL;
    const int tid = threadIdx.x, wid = __builtin_amdgcn_readfirstlane(tid >> 6), lane = tid & 63, fr = lane & 15, fq = lane >> 4;
    float* li_l = (float*)(lds + LDS_SLCX) + wid * 96;
    const int t0 = ut * 64, j0 = WIN16 ? (ut > 8 ? ut - 8 : 0) : 0, j1 = CMP16 ? (((t0 + 63 - 31) >> 4) >> 6) + 1 : ut + 1;
    const bf16_t* Vb = CMP16 ? a.VC + (size_t)g * 1024 * HD : a.Z + OFF_KV + (WIN16 ? 5 : 3) * 512 + g * HD; const long ldk = CMP16 ? HD : LDZ;
    const unsigned char* K8 = (const unsigned char*)a.MIX + ((CMP16 ? WS_K8C : (WIN16 ? WS_K8W : WS_K8)) - WS_MIX) + g * HD;
    int tqv[3];
#pragma unroll
    for (int b = 0; b < 3; ++b) tqv[b] = t0 + wid * 8 + (16 * b + fr) / 6;
#define TQC(b) tqv[b]
#define HQ(b) (g * HPG + (16 * (b) + fr) % 6)
    float negBC = -a.TAB[CMP16 ? 512 : (WIN16 ? 514 : 513)];
    bf16x8 qraw[3][4];
#pragma unroll
    for (int b = 0; b < 3; ++b) { const bf16_t* qp = a.Z + (size_t)TQC(b) * LDZ + OFF_Q + HQ(b) * HD + fq * 32;
#pragma unroll
        for (int ks = 0; ks < 4; ++ks) qraw[b][ks] = *reinterpret_cast<const bf16x8*>(qp + ks * 8); }
    f32x4 o[3][8]; float lsum[3];
#pragma unroll
    for (int b = 0; b < 3; ++b) { lsum[b] = 0.f;
#pragma unroll
        for (int c = 0; c < 8; ++c) o[b][c] = (f32x4){0.f, 0.f, 0.f, 0.f}; }
    const int q4 = fr >> 2, p4 = fr & 3, lbase = (int)(uintptr_t)ldsL;
    const int kaddr0 = lbase + (fr & 7) * SLC_KPS + (fr >> 3) * 128 + fq * 32;
    const int vaddr0 = lbase + SLC_KIMG + (4 * fq + q4) * SLC_VPS + (p4 >> 1) * 16 + (p4 & 1) * 8;
    unsigned so0 = (unsigned)((wid + 16 * (lane >> 4)) * ldk + (lane & 15) * 8) * 2u, so8 = (unsigned)((wid + 8 * (lane >> 3)) * (4 * HD) + (lane & 7) * 16);
#define ISSUE16(jt) do { const int _b = (jt) % SLC_NBUF; const char* _vp = (const char*)Vb + (size_t)(jt) * KVBLK * ldk * 2; asm volatile("" : "+v"(so0), "+v"(so8)); \
    __builtin_amdgcn_global_load_lds((const unsigned*)(K8 + (size_t)(jt) * KVBLK * (4 * HD) + so8), (LAS unsigned*)(ldsL + _b * SLC_BUF + wid * SLC_KPS), 16, 0, 0); \
    _Pragma("unroll") for (int _i = 0; _i < 2; ++_i) \
        __builtin_amdgcn_global_load_lds((const unsigned*)(_vp + _i * (8 * ldk * 2) + so0), (LAS unsigned*)(ldsL + _b * SLC_BUF + SLC_KIMG + (wid + 8 * _i) * SLC_VPS), 16, 0, 0); } while (0)
    unsigned bmw[3];
#pragma unroll
    for (int b = 0; b < 3; ++b) bmw[b] = DENSE16 ? 0xffffffffu : a.BM[((size_t)TQC(b) * 4 + g) * 8];
    asm volatile("s_waitcnt lgkmcnt(0)" ::: "memory");
    __builtin_amdgcn_s_barrier();
    asm volatile("" ::: "memory");
    ISSUE16(j0); if (j0 + 1 < j1) ISSUE16(j0 + 1); if (j0 + 2 < j1) ISSUE16(j0 + 2);
    asm volatile("s_waitcnt vmcnt(0) lgkmcnt(0)" : "+v"(bmw[0]), "+v"(bmw[1]), "+v"(bmw[2]), "+v"(negBC), "+v"(qraw[0][0]), "+v"(qraw[0][1]), "+v"(qraw[0][2]), "+v"(qraw[0][3]),
                 "+v"(qraw[1][0]), "+v"(qraw[1][1]), "+v"(qraw[1][2]), "+v"(qraw[1][3]), "+v"(qraw[2][0]), "+v"(qraw[2][1]), "+v"(qraw[2][2]), "+v"(qraw[2][3]) :: "memory");
    i32x8 qf[3];
#pragma unroll
    for (int b = 0; b < 3; ++b)
#pragma unroll
        for (int ks = 0; ks < 4; ++ks) { const bf16x8 r = qraw[b][ks];
            int p0 = __builtin_amdgcn_cvt_pk_fp8_f32(bf2f((bf16_t)r[0]) * QS16, bf2f((bf16_t)r[1]) * QS16, 0, false); p0 = __builtin_amdgcn_cvt_pk_fp8_f32(bf2f((bf16_t)r[2]) * QS16, bf2f((bf16_t)r[3]) * QS16, p0, true);
            int p1 = __builtin_amdgcn_cvt_pk_fp8_f32(bf2f((bf16_t)r[4]) * QS16, bf2f((bf16_t)r[5]) * QS16, 0, false); p1 = __builtin_amdgcn_cvt_pk_fp8_f32(bf2f((bf16_t)r[6]) * QS16, bf2f((bf16_t)r[7]) * QS16, p1, true);
            qf[b][2 * ks] = p0; qf[b][2 * ks + 1] = p1; }
    const int one_scale = 0x7F7F7F7F, key_scale = 0x7C7C7C7C;
    int kadr = kaddr0 + (j0 % SLC_NBUF) * SLC_BUF, vadr = vaddr0 + (j0 % SLC_NBUF) * SLC_BUF;
    for (int j = j0, jm = 0, buf = j0 % SLC_NBUF; j < j1; ++j) {
        if (jm == 0) {
            asm volatile("s_waitcnt vmcnt(0)" ::: "memory");
            __builtin_amdgcn_s_barrier();
            asm volatile("" ::: "memory");
            if (j + 3 < j1) ISSUE16(j + 3); if (j + 4 < j1) ISSUE16(j + 4); if (j + 5 < j1) ISSUE16(j + 5); }
        const int kb = j * KVBLK;
#define KF16(ks, mt) lds_b128(kadr + 64 * (ks) + 256 * (mt))
#define TRA(dst, off) asm volatile("ds_read_b64_tr_b16 %0, %1 offset:%2" : "=v"(dst) : "v"(vadr), "n"(off))
#define VLOAD(dst, s, h) _Pragma("unroll") for (int _c = 0; _c < 4; ++_c) { TRA(dst[_c][0], 32 * (4 * (h) + _c) + 512 * (s)); TRA(dst[_c][1], 32 * (4 * (h) + _c) + 512 * (s) + 256); }
#define VWAIT(n, d) asm volatile("s_waitcnt lgkmcnt(" #n ")" : "+v"(d[0][0]), "+v"(d[0][1]), "+v"(d[1][0]), "+v"(d[1][1]), "+v"(d[2][0]), "+v"(d[2][1]), "+v"(d[3][0]), "+v"(d[3][1]))
#define PVMMA(src, pa, h) _Pragma("unroll") for (int _c = 0; _c < 4; ++_c) o[b][4 * (h) + _c] = __builtin_amdgcn_mfma_f32_16x16x32_bf16(pa, \
            (bf16x8){src[_c][0][0], src[_c][0][1], src[_c][0][2], src[_c][0][3], src[_c][1][0], src[_c][1][1], src[_c][1][2], src[_c][1][3]}, o[b][4 * (h) + _c], 0, 0, 0);
#define EXPH(h, pw) { if (uni) { _Pragma("unroll") for (int mt = 2 * (h); mt < 2 * (h) + 2; ++mt) _Pragma("unroll") for (int i = 0; i < 4; ++i) { \
                            const float e_ = __builtin_amdgcn_exp2f(acc[mt][i]); acc[mt][i] = e_; ps += e_; } } \
                      else { asm volatile("" ::: "memory"); _Pragma("unroll") for (int mt = 2 * (h); mt < 2 * (h) + 2; ++mt) _Pragma("unroll") for (int i = 0; i < 4; ++i) { \
                            float e_ = __builtin_amdgcn_exp2f(acc[mt][i]); e_ = (16 * mt + i <= lim4 && (!WIN16 || 16 * mt + i >= lim4 - 511)) ? e_ : 0.f; acc[mt][i] = e_; ps += e_; } } \
                      pw.x = cvt_pk_bf16(acc[2 * (h)][0], acc[2 * (h)][1]); pw.y = cvt_pk_bf16(acc[2 * (h)][2], acc[2 * (h)][3]); \
                      pw.z = cvt_pk_bf16(acc[2 * (h) + 1][0], acc[2 * (h) + 1][1]); pw.w = cvt_pk_bf16(acc[2 * (h) + 1][2], acc[2 * (h) + 1][3]); }
        if constexpr (DENSE16) {
            int limv[3]; bool lany[3], lfull[3];
#pragma unroll
            for (int b = 0; b < 3; ++b) { limv[b] = (CMP16 ? ((tqv[b] - 31) >> 4) : tqv[b]) - kb; lany[b] = limv[b] >= 0 && (!WIN16 || limv[b] <= 511 + 63); lfull[b] = limv[b] >= 63 && (!WIN16 || limv[b] <= 511); }
            if (__any(lany[0] || lany[1] || lany[2])) {
                f32x4 acc3[3][4]; i32x4 kr[8]; s16x4 va[4][2], vc[4][2];
                bool uni3[3]; f32x4 off3[3];
#pragma unroll
                for (int b = 0; b < 3; ++b) { uni3[b] = __all(lfull[b] || !lany[b]); const float o_ = (uni3[b] && !lany[b]) ? -1.0e30f : negBC; off3[b] = (f32x4){o_, o_, o_, o_}; }
#define KRD(i) asm volatile("ds_read_b128 %0, %1 offset:%2" : "=v"(kr[i]) : "v"(kadr), "n"(256 * ((i) >> 1) + 16 * ((i) & 1)))
                KRD(0); KRD(1); KRD(2); KRD(3); KRD(4); KRD(5); KRD(6); KRD(7);
#define KMM3(mt, n) { asm volatile("s_waitcnt lgkmcnt(" #n ")" : "+v"(kr[2 * (mt)]), "+v"(kr[2 * (mt) + 1])); \
                     const i32x8 kf_ = __builtin_shufflevector(kr[2 * (mt)], kr[2 * (mt) + 1], 0, 1, 2, 3, 4, 5, 6, 7); \
                     _Pragma("unroll") for (int b_ = 0; b_ < 3; ++b_) \
                     asm volatile("v_mfma_scale_f32_16x16x128_f8f6f4 %0, %1, %2, %3, %4, %5 op_sel_hi:[0,0,0]" : "=v"(acc3[b_][mt]) : "v"(kf_), "v"(qf[b_]), "v"(off3[b_]), "v"(key_scale), "v"(one_scale)); }
                KMM3(0, 6) KMM3(1, 4) KMM3(2, 2) KMM3(3, 0)
                __builtin_amdgcn_sched_barrier(0);
#undef KRD
#undef KMM3
                VLOAD(va, 0, 0)
                asm volatile("s_nop 7" : "+v"(acc3[0][0]), "+v"(acc3[0][1]), "+v"(acc3[0][2]), "+v"(acc3[0][3]), "+v"(acc3[1][0]), "+v"(acc3[1][1]), "+v"(acc3[1][2]), "+v"(acc3[1][3]),
                                  "+v"(acc3[2][0]), "+v"(acc3[2][1]), "+v"(acc3[2][2]), "+v"(acc3[2][3]));
                bf16x8 pa3[3][2];
#pragma unroll
                for (int b = 0; b < 3; ++b) {
                    const bool l_any = lany[b], l_full = lfull[b]; const int lim = limv[b];
                    const bool uni = uni3[b]; (void)l_full;
                    const int lim4 = l_any ? lim - 4 * fq : -1;
                    float ps = 0.f;
                    if (uni) {
#pragma unroll
                        for (int mt = 0; mt < 4; ++mt)
#pragma unroll
                            for (int i = 0; i < 4; ++i) { const float e_ = __builtin_amdgcn_exp2f(acc3[b][mt][i]); acc3[b][mt][i] = e_; ps += e_; } }
                    else { asm volatile("" ::: "memory");
#pragma unroll
                        for (int mt = 0; mt < 4; ++mt)
#pragma unroll
                            for (int i = 0; i < 4; ++i) { float e_ = __builtin_amdgcn_exp2f(acc3[b][mt][i]); e_ = (16 * mt + i <= lim4 && (!WIN16 || 16 * mt + i >= lim4 - 511)) ? e_ : 0.f; acc3[b][mt][i] = e_; ps += e_; } }
                    lsum[b] += ps;
#pragma unroll
                    for (int s = 0; s < 2; ++s) { u32x4 pw; pw.x = cvt_pk_bf16(acc3[b][2 * s][0], acc3[b][2 * s][1]); pw.y = cvt_pk_bf16(acc3[b][2 * s][2], acc3[b][2 * s][3]);
                        pw.z = cvt_pk_bf16(acc3[b][2 * s + 1][0], acc3[b][2 * s + 1][1]); pw.w = cvt_pk_bf16(acc3[b][2 * s + 1][2], acc3[b][2 * s + 1][3]); pa3[b][s] = *reinterpret_cast<bf16x8*>(&pw); }
                }
#define PV3(src, s, h) _Pragma("unroll") for (int _c = 0; _c < 4; ++_c) { const bf16x8 vf_ = (bf16x8){src[_c][0][0], src[_c][0][1], src[_c][0][2], src[_c][0][3], src[_c][1][0], src[_c][1][1], src[_c][1][2], src[_c][1][3]}; \
                    _Pragma("unroll") for (int b_ = 0; b_ < 3; ++b_) o[b_][4 * (h) + _c] = __builtin_amdgcn_mfma_f32_16x16x32_bf16(pa3[b_][s], vf_, o[b_][4 * (h) + _c], 0, 0, 0); }
                __builtin_amdgcn_sched_barrier(0);
                VLOAD(vc, 0, 1)
                VWAIT(8, va);
                PV3(va, 0, 0)
                __builtin_amdgcn_sched_barrier(0);
                VLOAD(va, 1, 0)
                VWAIT(8, vc);
                PV3(vc, 0, 1)
                __builtin_amdgcn_sched_barrier(0);
                VLOAD(vc, 1, 1)
                VWAIT(8, va);
                PV3(va, 1, 0)
                __builtin_amdgcn_sched_barrier(0);
                VWAIT(0, vc);
                PV3(vc, 1, 1)
                __builtin_amdgcn_sched_barrier(0);
#undef PV3
            }
        } else
#pragma unroll
        for (int b = 0; b < 3; ++b) {
            const bool sel = DENSE16 ? true : (bool)((bmw[b] >> (j & 31)) & 1u);
            const int lim = tqv[b] - kb;
            const bool l_any = sel && lim >= 0 && (!WIN16 || lim <= 511 + 63), l_full = sel && lim >= 63 && (!WIN16 || lim <= 511);
            if (__any(l_any)) {
                f32x4 acc[4]; i32x4 kr[8]; s16x4 va[4][2], vc[4][2];
                const bool uni = __all(l_full || !l_any);
                const float off = (uni && !l_any) ? -1.0e30f : negBC;
                const f32x4 off4 = {off, off, off, off};
#define KRD(i) asm volatile("ds_read_b128 %0, %1 offset:%2" : "=v"(kr[i]) : "v"(kadr), "n"(256 * ((i) >> 1) + 16 * ((i) & 1)))
                KRD(0); KRD(1); KRD(2); KRD(3); KRD(4); KRD(5); KRD(6); KRD(7);
#define KMM(mt, n) { asm volatile("s_waitcnt lgkmcnt(" #n ")" : "+v"(kr[2 * (mt)]), "+v"(kr[2 * (mt) + 1])); \
                     const i32x8 kf_ = __builtin_shufflevector(kr[2 * (mt)], kr[2 * (mt) + 1], 0, 1, 2, 3, 4, 5, 6, 7); \
                     asm volatile("v_mfma_scale_f32_16x16x128_f8f6f4 %0, %1, %2, %3, %4, %5 op_sel_hi:[0,0,0]" : "=v"(acc[mt]) : "v"(kf_), "v"(qf[b]), "v"(off4), "v"(key_scale), "v"(one_scale)); }
                KMM(0, 6) KMM(1, 4) KMM(2, 2) KMM(3, 0)
                __builtin_amdgcn_sched_barrier(0);
#undef KRD
#undef KMM
                VLOAD(va, 0, 0)
                VLOAD(vc, 0, 1)
                asm volatile("" : "+v"(acc[0]), "+v"(acc[1]), "+v"(acc[2]), "+v"(acc[3]));
                const int lim4 = l_any ? lim - 4 * fq : -1;
                float ps = 0.f;
                u32x4 pw0, pw1;
                EXPH(0, pw0)
                const bf16x8 pa0 = *reinterpret_cast<bf16x8*>(&pw0);
                __builtin_amdgcn_sched_barrier(0);
                VWAIT(8, va);
                PVMMA(va, pa0, 0)
                __builtin_amdgcn_sched_barrier(0);
                VLOAD(va, 1, 0)
                VWAIT(8, vc);
                PVMMA(vc, pa0, 1)
                __builtin_amdgcn_sched_barrier(0);
                VLOAD(vc, 1, 1)
                EXPH(1, pw1)
                const bf16x8 pa1 = *reinterpret_cast<bf16x8*>(&pw1);
                lsum[b] += ps;
                __builtin_amdgcn_sched_barrier(0);
                VWAIT(8, va);
                PVMMA(va, pa1, 0)
                __builtin_amdgcn_sched_barrier(0);
                VWAIT(0, vc);
                PVMMA(vc, pa1, 1)
                __builtin_amdgcn_sched_barrier(0);
            }
        }
#undef TRA
#undef VWAIT
#undef EXPH
#undef KF16
#undef VLOAD
#undef PVMMA
        if (!DENSE16 && ((j + 1) & 31) == 0 && j + 1 < j1) {
#pragma unroll
            for (int b = 0; b < 3; ++b) bmw[b] = a.BM[((size_t)TQC(b) * 4 + g) * 8 + ((j + 1) >> 5)];
            asm volatile("s_waitcnt vmcnt(0)" : "+v"(bmw[0]), "+v"(bmw[1]), "+v"(bmw[2]) :: "memory"); }
        { const int step = buf == SLC_NBUF - 1 ? -(SLC_NBUF - 1) * SLC_BUF : SLC_BUF; kadr += step; vadr += step; asm volatile("" : "+v"(kadr), "+v"(vadr)); buf = buf == SLC_NBUF - 1 ? 0 : buf + 1; jm = jm == 2 ? 0 : jm + 1; }
    }
#undef ISSUE16
    int fqe = fq, fre = fr; asm volatile("" : "+v"(fqe), "+v"(fre));
    float grow[3];
#pragma unroll
    for (int b = 0; b < 3; ++b) grow[b] = a.G[(size_t)TQC(b) * NGATE + (g * HPG + (16 * b + fre) % 6) * 3 + (CMP16 ? 0 : (WIN16 ? 2 : 1))];
#pragma unroll
    for (int b = 0; b < 3; ++b) { float ls = lsum[b]; ls += __shfl_xor(ls, 16); ls += __shfl_xor(ls, 32);
        if (fqe == 0) { li_l[b * 32 + fre] = ls; li_l[b * 32 + 16 + fre] = grow[b]; if (CMP16) a.L[(size_t)TQC(b) * NH + g * HPG + (16 * b + fre) % 6] = ls; } }
    asm volatile("s_waitcnt lgkmcnt(0)" ::: "memory");
#pragma unroll
    for (int b = 0; b < 3; ++b) {
        float pv_[4][8]; float gtv[4];
#pragma unroll
        for (int i = 0; i < 4; ++i) { const int q = 4 * fqe + i, R = 16 * b + q; const float lv = li_l[b * 32 + q]; gtv[i] = li_l[b * 32 + 16 + q] * (lv > 0.f ? __builtin_amdgcn_rcpf(lv) : 0.f);
            const int t = t0 + wid * 8 + R / 6, h = g * HPG + R % 6;
            const bf16_t* oc = (const bf16_t*)a.OACC + (size_t)t * 3072 + h * HD + fre; const bf16_t* ow = oc + (size_t)S_ * 3072;
            bf16_t c_[8], w_[8];
            if (!DENSE16) {
#pragma unroll
                for (int c = 0; c < 8; ++c) { c_[c] = oc[c * 16]; w_[c] = ow[c * 16]; }
#pragma unroll
                for (int c = 0; c < 8; ++c) pv_[i][c] = bf2f(c_[c]) + bf2f(w_[c]); } }
#pragma unroll
        for (int i = 0; i < 4; ++i) { const int R = 16 * b + 4 * fqe + i; const int t = t0 + wid * 8 + R / 6, h = g * HPG + R % 6;
            if (DENSE16) { bf16_t* wp = (bf16_t*)a.OACC + (WIN16 ? (size_t)S_ * 3072 : 0) + (size_t)t * 3072 + h * HD + fre;
#pragma unroll
                for (int c = 0; c < 8; ++c) wp[c * 16] = (bf16_t)(cvt_pk_bf16(o[b][c][i] * gtv[i], 0.f) & 0xffffu); }
            else { unsigned char* mp = (unsigned char*)a.MIX + (size_t)t * DM * 2 + 2 * POOLW + h * HD + fre;
#pragma unroll
                for (int c = 0; c < 8; ++c) mp[c * 16] = (unsigned char)(__builtin_amdgcn_cvt_pk_fp8_f32((pv_[i][c] + o[b][c][i] * gtv[i]) * 2.0f, 0.f, 0, false) & 0xff); } }
    }
#undef TQC
#undef HQ
}

__device__ __forceinline__ void imp_task(const AttnArgs& a, float* IMPP, float* IMPF, int tqi, int g) {
    const int lane = threadIdx.x & 63, fr = lane & 15, fq = lane >> 4;
    const int t = tqi * 16 + fr;
    const int tmax = tqi * 16 + 15;
    if (tmax < 31) return;
    const int lim = t >= 31 ? ((t - 31) >> 4) : -1;
    const int nstep = ((((tmax - 31) >> 4) >> 6) + 1) * 4;
    const float negBC = -a.TAB[512];
    bf16x8 qf[HPG][4]; float rl[HPG];
#pragma unroll
    for (int h = 0; h < HPG; ++h) {
        const bf16_t* qp = a.Z + (size_t)t * LDZ + OFF_Q + (g * HPG + h) * HD + fq * 8;
#pragma unroll
        for (int ks = 0; ks < 4; ++ks) { const bf16x8 r = *reinterpret_cast<const bf16x8*>(qp + ks * 32); u32x4 w;
            w.x = cvt_pk_bf16(bf2f((bf16_t)r[0]) * SM_C, bf2f((bf16_t)r[1]) * SM_C); w.y = cvt_pk_bf16(bf2f((bf16_t)r[2]) * SM_C, bf2f((bf16_t)r[3]) * SM_C);
            w.z = cvt_pk_bf16(bf2f((bf16_t)r[4]) * SM_C, bf2f((bf16_t)r[5]) * SM_C); w.w = cvt_pk_bf16(bf2f((bf16_t)r[6]) * SM_C, bf2f((bf16_t)r[7]) * SM_C);
            qf[h][ks] = *reinterpret_cast<bf16x8*>(&w); }
        const float lv = a.L[(size_t)t * NH + g * HPG + h]; rl[h] = negBC + (lv > 0.f ? -__builtin_amdgcn_logf(lv) : -1.0e30f);
    }
    const bf16_t* kbase = a.KC + (size_t)g * 1024 * HD + (size_t)fr * HD + fq * 8;
    bf16x8 kf[4], kn[4], kn2[4];
#pragma unroll
    for (int ks = 0; ks < 4; ++ks) { kf[ks] = *reinterpret_cast<const bf16x8*>(kbase + ks * 32); kn[ks] = *reinterpret_cast<const bf16x8*>(kbase + (size_t)(nstep > 1 ? 1 : 0) * 16 * HD + ks * 32); }
    float* op = IMPP + ((size_t)t * 4 + g) * 256 + fq; float* of = IMPF + ((size_t)t * 4 + g) * 256 + fq;
    for (int st = 0; st < nstep; ++st) {
        const int sn = (st + 2 < nstep) ? st + 2 : nstep - 1;
#pragma unroll
        for (int ks = 0; ks < 4; ++ks) kn2[ks] = *reinterpret_cast<const bf16x8*>(kbase + (size_t)sn * 16 * HD + ks * 32);
        f32x4 imp4 = {0.f, 0.f, 0.f, 0.f};
        const int n0 = st * 16 + fq * 4;
        const bool full = __all(st * 16 + 15 <= lim);
#pragma unroll
        for (int h = 0; h < HPG; ++h) {
            f32x4 acc = {rl[h], rl[h], rl[h], rl[h]};
#pragma unroll
            for (int ks = 0; ks < 4; ++ks) acc = __builtin_amdgcn_mfma_f32_16x16x32_bf16(kf[ks], qf[h][ks], acc, 0, 0, 0);
            if (full) {
#pragma unroll
                for (int i = 0; i < 4; ++i) imp4[i] += __builtin_amdgcn_exp2f(acc[i]); }
            else {
#pragma unroll
                for (int i = 0; i < 4; ++i) { const float e = __builtin_amdgcn_exp2f(acc[i]); imp4[i] += (n0 + i <= lim) ? e : 0.f; } }
        }
        op[st * 4] = imp4[0] + 2.0f * (imp4[1] + imp4[2] + imp4[3]);
        of[st * 4] = imp4[0];
#pragma unroll
        for (int ks = 0; ks < 4; ++ks) { kf[ks] = kn[ks]; kn[ks] = kn2[ks]; }
    }
}

__device__ __forceinline__ void topk_load(const float* IMPP, const float* IMPF, int t, int g, f32x4& pp, f32x4& ff) {
    const int lane = threadIdx.x & 63, cur = t >> 6, jb = lane * 4;
    pp = (f32x4){0.f, 0.f, 0.f, 0.f}; ff = pp;
    if (cur > 15 && jb <= cur) { const size_t base = ((size_t)t * 4 + g) * 256; pp = *(const f32x4*)(IMPP + base + jb); ff = *(const f32x4*)(IMPF + base + jb); }
}
__device__ __forceinline__ void topk_task(const f32x4 pp, const f32x4 ff, unsigned* BM, int t, int g) {
    const int lane = threadIdx.x & 63;
    const int cur = t >> 6;
    unsigned nib = 0u;
    if (cur <= 15) { const int jb = lane * 4;
#pragma unroll
        for (int c = 0; c < 4; ++c) if (jb + c <= cur) nib |= 1u << c; }
    else {
        const int jb = lane * 4;
        unsigned key[4];
        {
            float fnext = __shfl_down(ff[0], 1);
            if (lane == 63) fnext = 0.f;
            const float v0 = pp[0] + ff[1], v1 = pp[1] + ff[2], v2 = pp[2] + ff[3], v3 = pp[3] + fnext;
            key[0] = (jb + 0 >= 1 && jb + 0 <= cur - 2) ? __float_as_uint(fmaxf(v0, 0.f)) + 1u : 0u;
            key[1] = (jb + 1 >= 1 && jb + 1 <= cur - 2) ? __float_as_uint(fmaxf(v1, 0.f)) + 1u : 0u;
            key[2] = (jb + 2 >= 1 && jb + 2 <= cur - 2) ? __float_as_uint(fmaxf(v2, 0.f)) + 1u : 0u;
            key[3] = (jb + 3 >= 1 && jb + 3 <= cur - 2) ? __float_as_uint(fmaxf(v3, 0.f)) + 1u : 0u;
        }
        unsigned prefix = 0u; bool exact = false;
        for (int b = 30; b >= 0; --b) {
            const unsigned trial = prefix | (1u << b);
            const int cnt = __popcll(__ballot(key[0] >= trial)) + __popcll(__ballot(key[1] >= trial)) + __popcll(__ballot(key[2] >= trial)) + __popcll(__ballot(key[3] >= trial));
            if (cnt >= 13) { prefix = trial; if (cnt == 13) { exact = true; break; } }
        }
#pragma unroll
        for (int c = 0; c < 4; ++c) if (exact ? (key[c] >= prefix) : (key[c] > prefix)) nib |= 1u << c;
        if (!exact) {
            int need = 13 - (__popcll(__ballot(key[0] > prefix)) + __popcll(__ballot(key[1] > prefix)) + __popcll(__ballot(key[2] > prefix)) + __popcll(__ballot(key[3] > prefix)));
            unsigned tie = 0u;
#pragma unroll
            for (int c = 0; c < 4; ++c) if (key[c] == prefix) tie |= 1u << c;
            for (int guard = 0; need > 0 && guard < 16; ++guard) {
                const unsigned long long any = __ballot(tie != 0u);
                if (any == 0ull) break;
                const int L = __builtin_ctzll(any);
                if (lane == L) { const unsigned low = tie & (0u - tie); nib |= low; tie ^= low; }
                --need;
            }
        }
        if (lane == 0) nib |= 1u;
        if (lane == (cur >> 2)) nib |= 1u << (cur & 3);
        if (lane == ((cur - 1) >> 2)) nib |= 1u << ((cur - 1) & 3);
    }
    unsigned x = nib << (4 * (lane & 7));
    x |= __shfl_xor(x, 1); x |= __shfl_xor(x, 2); x |= __shfl_xor(x, 4);
    if ((lane & 7) == 0) BM[((size_t)t * 4 + g) * 8 + (lane >> 3)] = x;
}
#undef KSWZ
}

template <bool FFN_REMAP = false>
__device__ __forceinline__ void convT(const float* __restrict__ src0, int K, int N, bf16_t* __restrict__ dst, int ldd, LAS float* tile, int bid, int nb, int Nfull = 0, int n0 = 0, const float* __restrict__ kscale = nullptr) {
    const float* __restrict__ src = src0 + n0; if (Nfull == 0) Nfull = N;
    const int tid = threadIdx.x, tk = K >> 6, tn = (N + 63) >> 6, total = tk * tn;
    const int r = tid >> 4, c4 = (tid & 15) * 4;
    f32x4 v[2] = {{0.f, 0.f, 0.f, 0.f}, {0.f, 0.f, 0.f, 0.f}}, vn[2];
    if (bid < total) { const int nti = bid % tn, kti = bid / tn, ng = nti * 64 + c4;
#pragma unroll
        for (int h = 0; h < 2; ++h) if (ng < N) v[h] = *(const f32x4*)(src + (size_t)(kti * 64 + r + h * 32) * Nfull + ng); }
    for (int idx = bid; idx < total; idx += nb) {
        const int nti = idx % tn, kti = idx / tn;
#pragma unroll
        for (int h = 0; h < 2; ++h) { LAS float* tp = tile + (r + h * 32) * 65 + c4; tp[0] = v[h][0]; tp[1] = v[h][1]; tp[2] = v[h][2]; tp[3] = v[h][3]; }
        {
            const int nx = idx + nb; vn[0] = (f32x4){0.f, 0.f, 0.f, 0.f}; vn[1] = vn[0];
            if (nx < total) { const int nti2 = nx % tn, kti2 = nx / tn, ng2 = nti2 * 64 + c4;
#pragma unroll
                for (int h = 0; h < 2; ++h) if (ng2 < N) vn[h] = *(const f32x4*)(src + (size_t)(kti2 * 64 + r + h * 32) * Nfull + ng2); } }
        __syncthreads();
        const int n = tid >> 3, k8 = (tid & 7) * 8, ngl = nti * 64 + n;
        float e[8];
#pragma unroll
        for (int i = 0; i < 8; ++i) e[i] = tile[(k8 + i) * 65 + n];
        if (kscale) { const f32x4 s0 = *(const f32x4*)(kscale + kti * 64 + k8), s1 = *(const f32x4*)(kscale + kti * 64 + k8 + 4);
            e[0] *= s0[0]; e[1] *= s0[1]; e[2] *= s0[2]; e[3] *= s0[3]; e[4] *= s1[0]; e[5] *= s1[1]; e[6] *= s1[2]; e[7] *= s1[3]; }
        if (ngl < N) { u32x4 w; w.x = cvt_pk_bf16(e[0], e[1]); w.y = cvt_pk_bf16(e[2], e[3]); w.z = cvt_pk_bf16(e[4], e[5]); w.w = cvt_pk_bf16(e[6], e[7]);
            int drow = ngl; if (FFN_REMAP) { const int up = ngl >= DFF ? 1 : 0, f = ngl - up * DFF; drow = (f >> 7) * 256 + up * 128 + (f & 127); }
            *(u32x4*)(dst + (size_t)drow * ldd + kti * 64 + k8) = w; }
        __syncthreads();
        v[0] = vn[0]; v[1] = vn[1];
    }
}
__device__ __forceinline__ void convT_wo(const float* __restrict__ src0, int K, int N, bf16_t* __restrict__ dst, int ldd, LAS float* tile, int bid, int nb) { const int n0 = 0; int Nfull = 0;
    const float* __restrict__ src = src0 + n0; if (Nfull == 0) Nfull = N;
    const int tid = threadIdx.x, tk = K >> 6, tn = (N + 63) >> 6, total = tk * tn;
    const int r = tid >> 4, c4 = (tid & 15) * 4;
    f32x4 v[2] = {{0.f, 0.f, 0.f, 0.f}, {0.f, 0.f, 0.f, 0.f}}, vn[2];
    if (bid < total) { const int nti = bid % tn, kti = bid / tn, ng = nti * 64 + c4;
#pragma unroll
        for (int h = 0; h < 2; ++h) if (ng < N) v[h] = *(const f32x4*)(src + (size_t)(kti * 64 + r + h * 32) * Nfull + ng); }
    for (int idx = bid; idx < total; idx += nb) {
        const int nti = idx % tn, kti = idx / tn;
#pragma unroll
        for (int h = 0; h < 2; ++h) { LAS float* tp = tile + (r + h * 32) * 65 + c4; tp[0] = v[h][0]; tp[1] = v[h][1]; tp[2] = v[h][2]; tp[3] = v[h][3]; }
        {
            const int nx = idx + nb; vn[0] = (f32x4){0.f, 0.f, 0.f, 0.f}; vn[1] = vn[0];
            if (nx < total) { const int nti2 = nx % tn, kti2 = nx / tn, ng2 = nti2 * 64 + c4;
#pragma unroll
                for (int h = 0; h < 2; ++h) if (ng2 < N) vn[h] = *(const f32x4*)(src + (size_t)(kti2 * 64 + r + h * 32) * Nfull + ng2); } }
        __syncthreads();
        const int n = tid >> 3, k8 = (tid & 7) * 8, ngl = nti * 64 + n;
        float e[8];
#pragma unroll
        for (int i = 0; i < 8; ++i) e[i] = tile[(k8 + i) * 65 + n];
        if (ngl < N) {
            if (kti < POOLW / 64) { u32x4 w; w.x = cvt_pk_bf16(e[0] * 128.f, e[1] * 128.f); w.y = cvt_pk_bf16(e[2] * 128.f, e[3] * 128.f); w.z = cvt_pk_bf16(e[4] * 128.f, e[5] * 128.f); w.w = cvt_pk_bf16(e[6] * 128.f, e[7] * 128.f);
                *(u32x4*)(dst + (size_t)ngl * ldd + kti * 64 + k8) = w; }
            else { int p0 = __builtin_amdgcn_cvt_pk_fp8_f32(e[0] * 64.f, e[1] * 64.f, 0, false); p0 = __builtin_amdgcn_cvt_pk_fp8_f32(e[2] * 64.f, e[3] * 64.f, p0, true);
                int p1 = __builtin_amdgcn_cvt_pk_fp8_f32(e[4] * 64.f, e[5] * 64.f, 0, false); p1 = __builtin_amdgcn_cvt_pk_fp8_f32(e[6] * 64.f, e[7] * 64.f, p1, true);
                *(u32x2*)((unsigned char*)dst + (size_t)ngl * ldd * 2 + 2 * POOLW + (kti * 64 - POOLW) + k8) = (u32x2){(unsigned)p0, (unsigned)p1}; } }
        __syncthreads();
        v[0] = vn[0]; v[1] = vn[1];
    }
}
__device__ __forceinline__ void convT8(const float* __restrict__ src0, int K, int N, unsigned char* __restrict__ dst, int ldd, float scale, LAS float* tile, int bid, int nb, int Nfull = 0, int n0 = 0) {
    const float* __restrict__ src = src0 + n0; if (Nfull == 0) Nfull = N;
    const int tid = threadIdx.x, tk = K >> 6, tn = (N + 63) >> 6, total = tk * tn;
    const int r = tid >> 4, c4 = (tid & 15) * 4;
    f32x4 v[2] = {{0.f, 0.f, 0.f, 0.f}, {0.f, 0.f, 0.f, 0.f}}, vn[2];
    if (bid < total) { const int nti = bid % tn, kti = bid / tn, ng = nti * 64 + c4;
#pragma unroll
        for (int h = 0; h < 2; ++h) if (ng < N) v[h] = *(const f32x4*)(src + (size_t)(kti * 64 + r + h * 32) * Nfull + ng); }
    for (int idx = bid; idx < total; idx += nb) {
        const int nti = idx % tn, kti = idx / tn;
#pragma unroll
        for (int h = 0; h < 2; ++h) { LAS float* tp = tile + (r + h * 32) * 65 + c4; tp[0] = v[h][0]; tp[1] = v[h][1]; tp[2] = v[h][2]; tp[3] = v[h][3]; }
        { const int nx = idx + nb; vn[0] = (f32x4){0.f, 0.f, 0.f, 0.f}; vn[1] = vn[0];
            if (nx < total) { const int nti2 = nx % tn, kti2 = nx / tn, ng2 = nti2 * 64 + c4;
#pragma unroll
                for (int h = 0; h < 2; ++h) if (ng2 < N) vn[h] = *(const f32x4*)(src + (size_t)(kti2 * 64 + r + h * 32) * Nfull + ng2); } }
        __syncthreads();
        const int n = tid >> 3, k8 = (tid & 7) * 8, ngl = nti * 64 + n;
        float e[8];
#pragma unroll
        for (int i = 0; i < 8; ++i) e[i] = tile[(k8 + i) * 65 + n] * scale;
        if (ngl < N) { int p0 = __builtin_amdgcn_cvt_pk_fp8_f32(e[0], e[1], 0, false); p0 = __builtin_amdgcn_cvt_pk_fp8_f32(e[2], e[3], p0, true);
            int p1 = __builtin_amdgcn_cvt_pk_fp8_f32(e[4], e[5], 0, false); p1 = __builtin_amdgcn_cvt_pk_fp8_f32(e[6], e[7], p1, true);
            *(u32x2*)(dst + (size_t)ngl * ldd + kti * 64 + k8) = (u32x2){(unsigned)p0, (unsigned)p1}; }
        __syncthreads();
        v[0] = vn[0]; v[1] = vn[1];
    }
}
__device__ __forceinline__ void rmsnorm_rows(const float* __restrict__ src, const float* __restrict__ w, bf16_t* __restrict__ dst, int rows, int gw, int nw, unsigned char* __restrict__ dst8 = nullptr) {
    const int lane = threadIdx.x & 63;
    f32x4 v[16], vn[16];
    if (gw < rows) { const f32x4* sp = (const f32x4*)(src + (size_t)gw * DM);
#pragma unroll
        for (int i = 0; i < 16; ++i) v[i] = sp[lane + 64 * i]; }
    for (int row = gw; row < rows; row += nw) {
        const int nr = row + nw < rows ? row + nw : row;
        { const f32x4* sp = (const f32x4*)(src + (size_t)nr * DM);
#pragma unroll
          for (int i = 0; i < 16; ++i) vn[i] = sp[lane + 64 * i]; }
        float ss = 0.f;
#pragma unroll
        for (int i = 0; i < 16; ++i) ss += v[i][0] * v[i][0] + v[i][1] * v[i][1] + v[i][2] * v[i][2] + v[i][3] * v[i][3];
        ss = wave_sum(ss);
        const float rstd = rsqrtf(ss * (1.0f / DM) + EPS);
#pragma unroll
        for (int i = 0; i < 16; ++i) { const f32x4 ww = ((const f32x4*)w)[lane + 64 * i];
            u32x2 o; o.x = cvt_pk_bf16(v[i][0] * rstd * ww[0], v[i][1] * rstd * ww[1]); o.y = cvt_pk_bf16(v[i][2] * rstd * ww[2], v[i][3] * rstd * ww[3]);
            *(u32x2*)(dst + (size_t)row * DM + (lane + 64 * i) * 4) = o;
            if (dst8) { int pk = __builtin_amdgcn_cvt_pk_fp8_f32(v[i][0] * rstd * ww[0], v[i][1] * rstd * ww[1], 0, false); pk = __builtin_amdgcn_cvt_pk_fp8_f32(v[i][2] * rstd * ww[2], v[i][3] * rstd * ww[3], pk, true);
                *(int*)(dst8 + (size_t)row * DM + (lane + 64 * i) * 4) = pk; } }
#pragma unroll
        for (int i = 0; i < 16; ++i) v[i] = vn[i];
    }
}

struct Ptrs {
    bf16_t *Win, *Wo, *Wfi, *Wfo, *Wg, *Wple, *Wpool, *Wc1k, *Wc1v, *XN, *PB, *Z, *M, *KC, *VC, *MIX, *ACT, *ERAW;
    float *COS, *SIN, *TAB, *G, *H1, *L, *OACC, *IMPP, *IMPF, *ERSTD; unsigned* BM;
};

__device__ __forceinline__ void phase_prologue(const Params& P, const Ptrs& W, LAS unsigned char* lds) {
    const int bid = blockIdx.x, nb = gridDim.x, tid = threadIdx.x, lane = tid & 63, wv = tid >> 6;
    const int gw = bid * NWAVES + wv, nw = nb * NWAVES; const size_t gt = (size_t)bid * NTHREADS + tid, ntot = (size_t)nb * NTHREADS;
    LAS float* tile = (LAS float*)lds;
    rmsnorm_rows(P.x, P.norm1_w, W.XN, S_, gw, nw, P.ws + WS_XN8);
    convT(P.w_in, DM, POOLW, W.Win, DM, tile, bid, nb, INW, 0);
    convT(P.w_in, DM, INW - OFF_G, W.Win + (size_t)OFF_G * DM, DM, tile, bid, nb, INW, OFF_G);
    convT8(P.w_in, DM, OFF_G - POOLW, P.ws + WS_WIN8, DM, WG8_SCALE, tile, bid, nb, INW, POOLW);
    for (size_t i = gt; i < (size_t)(LDZ - INW) * DM / 8; i += ntot) *(u32x4*)(W.Win + (size_t)INW * DM + i * 8) = (u32x4){0u, 0u, 0u, 0u};
    convT_wo(P.w_o, DM, DM, W.Wo, DM, tile, bid, nb);
    convT<true>(P.w_ffn_in, DM, NFI, W.Wfi, DM, tile, bid, nb, 0, 0, P.norm2_w);
    for (size_t i = gt; i < (size_t)2 * DM / 8; i += ntot) *(u32x4*)(W.XN - 2 * DM + i * 8) = (u32x4){0u, 0u, 0u, 0u};
    convT(P.w_ffn_out, DFF, DM, W.Wfo, DFF, tile, bid, nb);
    convT8(P.w_ple_gate, DM, DM, (unsigned char*)W.Wg, DM, WG8_SCALE, tile, bid, nb);
    convT(P.w_ple_proj, PLE, DM, W.Wple, PLE, tile, bid, nb);
    for (int g = 0; g < 4; ++g) convT(P.w_pool + (size_t)g * 65536, 256, 256, W.Wpool + (size_t)g * 65536, 256, tile, bid, nb);
    convT(P.cmp_k_w1, 4096, 256, W.Wc1k, 4096, tile, bid, nb);
    convT(P.cmp_v_w1, 4096, 256, W.Wc1v, 4096, tile, bid, nb);
    { constexpr size_t NP8 = (size_t)S_ * PLE / 8;
      for (size_t ib = gt; ib < NP8; ib += 4 * ntot) { f32x4 av[4], bv[4];
#pragma unroll
          for (int k = 0; k < 4; ++k) { size_t i = ib + k * ntot; if (i >= NP8) i = NP8 - 1; av[k] = *(const f32x4*)(P.p + i * 8); bv[k] = *(const f32x4*)(P.p + i * 8 + 4); }
#pragma unroll
          for (int k = 0; k < 4; ++k) { const size_t i = ib + k * ntot; if (i < NP8) { u32x4 w; w.x = cvt_pk_bf16(av[k][0], av[k][1]); w.y = cvt_pk_bf16(av[k][2], av[k][3]); w.z = cvt_pk_bf16(bv[k][0], bv[k][1]); w.w = cvt_pk_bf16(bv[k][2], bv[k][3]); *(u32x4*)(W.PB + i * 8) = w; } } } }
    for (size_t i = gt; i < (size_t)S_ * 16; i += ntot) { const int t = (int)(i >> 4), fi = (int)(i & 15);
        const float inv = exp2f(-(float)fi * (18.931568569324174f / 16.0f)); const float ang = (float)P.positions[t] * inv;
        const double ad = (double)ang; const double kk = rint(ad * 0.15915494309189535); const float rf = (float)(ad - kk * 6.283185307179586);
        W.COS[i] = __cosf(rf); W.SIN[i] = __sinf(rf); }
    for (int task = gw; task < 128; task += nw) { const int which = task >> 6, r0 = (task & 63) * 64; const float* pe = which ? P.cmp_pos_v : P.cmp_pos_k; const float* w1 = which ? P.cmp_v_w1 : P.cmp_k_w1;
        f32x4 s = {0.f, 0.f, 0.f, 0.f};
#pragma unroll 8
        for (int r = 0; r < 64; ++r) { const f32x4 wv = *(const f32x4*)(w1 + (size_t)(r0 + r) * 256 + lane * 4); s += wv * pe[r0 + r]; }
        float* cbp = (float*)(P.ws + WS_CBIAS) + which * 256 + lane * 4;
        unsafeAtomicAdd(cbp + 0, s[0]); unsafeAtomicAdd(cbp + 1, s[1]); unsafeAtomicAdd(cbp + 2, s[2]); unsafeAtomicAdd(cbp + 3, s[3]); }
    if (gw == 0) { float mq = fmaxf(fabsf(P.q_norm_w[lane]), fabsf(P.q_norm_w[lane + 64])); mq = wave_max(mq);
        float mc = wave_max(fmaxf(fabsf(P.k_norm_cmp_w[lane]), fabsf(P.k_norm_cmp_w[lane + 64])));
        float ms = wave_max(fmaxf(fabsf(P.k_norm_slc_w[lane]), fabsf(P.k_norm_slc_w[lane + 64])));
        float mw = wave_max(fmaxf(fabsf(P.k_norm_win_w[lane]), fabsf(P.k_norm_win_w[lane + 64])));
        const float c = 11.313708498984761f * 1.4426950408889634f * mq * 1.01f;
        if (lane == 0) { W.TAB[512] = c * mc; W.TAB[513] = c * ms; W.TAB[514] = c * mw; } }
}

__device__ __forceinline__ void phase_postz(const Params& P, const Ptrs& W, int gw, int nw) {
    const int tid = threadIdx.x, lane = tid & 63;
    const f32x2 wq = *(const f32x2*)(P.q_norm_w + 2 * lane), wks = *(const f32x2*)(P.k_norm_slc_w + 2 * lane), wkw = *(const f32x2*)(P.k_norm_win_w + 2 * lane);
    for (int t = gw; t < S_; t += nw) {
        bf16_t* zr = W.Z + (size_t)t * LDZ;
        float cs0 = 0.f, cs1 = 0.f, sn0 = 0.f, sn1 = 0.f;
        if (lane < 16) { const int i0 = (2 * lane) & 15; cs0 = W.COS[t * 16 + i0]; cs1 = W.COS[t * 16 + i0 + 1]; sn0 = W.SIN[t * 16 + i0]; sn1 = W.SIN[t * 16 + i0 + 1]; }
        unsigned uv[32];
#pragma unroll
        for (int v = 0; v < 32; ++v) { const int col = v < 24 ? OFF_Q + v * HD : (v < 28 ? OFF_KV + 2 * 512 + (v - 24) * HD : OFF_KV + 4 * 512 + (v - 28) * HD);
            uv[v] = *((const unsigned*)(zr + col) + lane); }
#pragma unroll
        for (int v = 0; v < 32; ++v) {
            const f32x2 ww = v < 24 ? wq : (v < 28 ? wks : wkw);
            const unsigned u = uv[v]; const float x0 = bf_lo(u), x1 = bf_hi(u);
            const float ss = wave_sum(x0 * x0 + x1 * x1);
            const float rstd = rsqrtf(ss * (1.0f / HD) + EPS);
            float y0 = x0 * rstd * ww[0], y1 = x1 * rstd * ww[1];
            const float p0 = __shfl_xor(y0, 8), p1 = __shfl_xor(y1, 8);
            if (lane < 8) { y0 = y0 * cs0 - p0 * sn0; y1 = y1 * cs1 - p1 * sn1; }
            else if (lane < 16) { y0 = y0 * cs0 + p0 * sn0; y1 = y1 * cs1 + p1 * sn1; }
            uv[v] = cvt_pk_bf16(y0, y1);
            if (v >= 24) *((unsigned short*)((unsigned char*)W.MIX + ((v < 28 ? WS_K8 : WS_K8W) - WS_MIX) + ((size_t)t * 4 + ((v - 24) & 3)) * HD) + lane) = (unsigned short)(__builtin_amdgcn_cvt_pk_fp8_f32(y0, y1, 0, false) & 0xffff);
        }
        {
            const int gi = lane >> 4, wlen = 2 << gi, c0 = lane * 16; const int cnt = (t + 1) < wlen ? (t + 1) : wlen;
            float s[16];
#pragma unroll
            for (int i = 0; i < 16; ++i) s[i] = 0.f;
            float cur[16];
#pragma unroll
            for (int bt = 0; bt < 2; ++bt) {
                u32x4 ra[8], rb[8];
#pragma unroll
                for (int i = 0; i < 8; ++i) { const int ii = bt * 8 + i; const size_t row = (size_t)(ii < cnt ? t - ii : t);
                    ra[i] = *(const u32x4*)(W.Z + row * LDZ + c0); rb[i] = *(const u32x4*)(W.Z + row * LDZ + c0 + 8); }
#pragma unroll
                for (int i = 0; i < 8; ++i) { const int ii = bt * 8 + i; const float mk = ii < cnt ? 1.0f : 0.0f; const u32x4 a = ra[i], b = rb[i];
                    const float ev[16] = {bf_lo(a.x), bf_hi(a.x), bf_lo(a.y), bf_hi(a.y), bf_lo(a.z), bf_hi(a.z), bf_lo(a.w), bf_hi(a.w), bf_lo(b.x), bf_hi(b.x), bf_lo(b.y), bf_hi(b.y), bf_lo(b.z), bf_hi(b.z), bf_lo(b.w), bf_hi(b.w)};
#pragma unroll
                    for (int q = 0; q < 16; ++q) { s[q] += ev[q] * mk; if (ii == 0) cur[q] = ev[q]; } }
                if (bt == 0 && __all(cnt <= 8)) break;
            }
            const float rc = 1.0f / (float)cnt;
            u32x4 o0, o1;
            o0.x = cvt_pk_bf16(s[0] * rc - cur[0], s[1] * rc - cur[1]); o0.y = cvt_pk_bf16(s[2] * rc - cur[2], s[3] * rc - cur[3]);
            o0.z = cvt_pk_bf16(s[4] * rc - cur[4], s[5] * rc - cur[5]); o0.w = cvt_pk_bf16(s[6] * rc - cur[6], s[7] * rc - cur[7]);
            o1.x = cvt_pk_bf16(s[8] * rc - cur[8], s[9] * rc - cur[9]); o1.y = cvt_pk_bf16(s[10] * rc - cur[10], s[11] * rc - cur[11]);
            o1.z = cvt_pk_bf16(s[12] * rc - cur[12], s[13] * rc - cur[13]); o1.w = cvt_pk_bf16(s[14] * rc - cur[14], s[15] * rc - cur[15]);
            *(u32x4*)(W.M + (size_t)t * POOLW + c0) = o0; *(u32x4*)(W.M + (size_t)t * POOLW + c0 + 8) = o1;
        }
#pragma unroll
        for (int v = 0; v < 32; ++v) { const int col = v < 24 ? OFF_Q + v * HD : (v < 28 ? OFF_KV + 2 * 512 + (v - 24) * HD : OFF_KV + 4 * 512 + (v - 28) * HD);
            *((unsigned*)(zr + col) + lane) = uv[v]; }

    }
}

__device__ __forceinline__ void phase_cmpfin(const Params& P, const Ptrs& W) {
    const int tid = threadIdx.x, lane = tid & 63, gw = blockIdx.x * NWAVES + (tid >> 6), nw = gridDim.x * NWAVES;
    const f32x2 wk = *(const f32x2*)(P.k_norm_cmp_w + 2 * lane);
    for (int task = gw; task < 8192; task += nw) {
        const int tk = __builtin_amdgcn_readfirstlane(task);
        const int which = tk >> 12, g = (tk >> 10) & 3, n = tk & 1023;
        bf16_t* dst = (which ? W.VC : W.KC) + ((size_t)g * 1024 + n) * HD;
        if (n == 1023) { ((unsigned*)dst)[lane] = 0u; if (which == 0) *((unsigned short*)((unsigned char*)W.MIX + (WS_K8C - WS_MIX) + ((size_t)n * 4 + g) * HD) + lane) = 0; continue; }
        const float* h = W.H1 + (size_t)tk * 256; const float* w2 = which ? P.cmp_v_w2 : P.cmp_k_w2;
        float a0 = 0.f, a1 = 0.f;
        for (int j = 0; j < 256; ++j) { const float hj = h[j]; const f32x2 wv = *(const f32x2*)(w2 + j * HD + 2 * lane); a0 += hj * wv[0]; a1 += hj * wv[1]; }
        if (which == 0) {
            const float ss = wave_sum(a0 * a0 + a1 * a1); const float rstd = rsqrtf(ss * (1.0f / HD) + EPS);
            a0 = a0 * rstd * wk[0]; a1 = a1 * rstd * wk[1];
            const int tp = 16 * n + 31; const float p0 = __shfl_xor(a0, 8), p1 = __shfl_xor(a1, 8);
            if (lane < 16) { const int i0 = (2 * lane) & 15; const float cs0 = W.COS[tp * 16 + i0], cs1 = W.COS[tp * 16 + i0 + 1], sn0 = W.SIN[tp * 16 + i0], sn1 = W.SIN[tp * 16 + i0 + 1];
                if (lane < 8) { a0 = a0 * cs0 - p0 * sn0; a1 = a1 * cs1 - p1 * sn1; } else { a0 = a0 * cs0 + p0 * sn0; a1 = a1 * cs1 + p1 * sn1; } }
        }
        ((unsigned*)dst)[lane] = cvt_pk_bf16(a0, a1);
        if (which == 0) *((unsigned short*)((unsigned char*)W.MIX + (WS_K8C - WS_MIX) + ((size_t)n * 4 + g) * HD) + lane) = (unsigned short)(__builtin_amdgcn_cvt_pk_fp8_f32(a0, a1, 0, false) & 0xffff);
    }
}

__device__ __forceinline__ void phase_erstd(const Ptrs& W) {
    const int tid = threadIdx.x, lane = tid & 63, gw = blockIdx.x * NWAVES + (tid >> 6), nw = gridDim.x * NWAVES;
    u32x4 a[8], an[8];
    if (gw < S_) { const u32x4* sp = (const u32x4*)(W.ERAW + (size_t)gw * DM);
#pragma unroll
        for (int i = 0; i < 8; ++i) a[i] = sp[lane + 64 * i]; }
    for (int row = gw; row < S_; row += nw) {
        const int nr = row + nw < S_ ? row + nw : row;
        { const u32x4* sp = (const u32x4*)(W.ERAW + (size_t)nr * DM);
#pragma unroll
          for (int i = 0; i < 8; ++i) an[i] = sp[lane + 64 * i]; }
        float ss = 0.f;
#pragma unroll
        for (int i = 0; i < 8; ++i) {
            const float e0 = bf_lo(a[i].x), e1 = bf_hi(a[i].x), e2 = bf_lo(a[i].y), e3 = bf_hi(a[i].y), e4 = bf_lo(a[i].z), e5 = bf_hi(a[i].z), e6 = bf_lo(a[i].w), e7 = bf_hi(a[i].w);
            ss += e0 * e0 + e1 * e1 + e2 * e2 + e3 * e3 + e4 * e4 + e5 * e5 + e6 * e6 + e7 * e7; }
        ss = wave_sum(ss);
        if (lane == 0) W.ERSTD[row] = rsqrtf(ss * (1.0f / DM) + EPS);
#pragma unroll
        for (int i = 0; i < 8; ++i) a[i] = an[i];
    }
}

constexpr int N_PHASES = 11;
__device__ __forceinline__ Params kargs() {
#if defined(__HIP_DEVICE_COMPILE__)
    unsigned long long p = (unsigned long long)__builtin_amdgcn_kernarg_segment_ptr();
    asm volatile("" : "+s"(p));
    return *(const __attribute__((address_space(4))) Params*)p;
#else
    return Params{};
#endif
}
__device__ __forceinline__ Ptrs mkptrs(unsigned char* ws) {
    Ptrs W;
    W.Win = (bf16_t*)(ws + WS_WIN); W.Wo = (bf16_t*)(ws + WS_WO); W.Wfi = (bf16_t*)(ws + WS_WFI); W.Wfo = (bf16_t*)(ws + WS_WFO); W.Wg = (bf16_t*)(ws + WS_WG);
    W.Wple = (bf16_t*)(ws + WS_WPLE); W.Wpool = (bf16_t*)(ws + WS_WPOOL); W.Wc1k = (bf16_t*)(ws + WS_WC1K); W.Wc1v = (bf16_t*)(ws + WS_WC1V);
    W.XN = (bf16_t*)(ws + WS_XN); W.PB = (bf16_t*)(ws + WS_PB); W.Z = (bf16_t*)(ws + WS_Z); W.M = (bf16_t*)(ws + WS_M); W.KC = (bf16_t*)(ws + WS_KC); W.VC = (bf16_t*)(ws + WS_VC);
    W.MIX = (bf16_t*)(ws + WS_MIX); W.ACT = (bf16_t*)(ws + WS_ACT); W.ERAW = (bf16_t*)(ws + WS_ERAW);
    W.COS = (float*)(ws + WS_COS); W.SIN = (float*)(ws + WS_SIN); W.TAB = (float*)(ws + WS_TAB); W.G = (float*)(ws + WS_G); W.H1 = (float*)(ws + WS_H1); W.L = (float*)(ws + WS_L);
    W.OACC = (float*)(ws + WS_OACC); W.IMPP = (float*)(ws + WS_IMPP); W.IMPF = (float*)(ws + WS_IMPF); W.ERSTD = (float*)(ws + WS_ERSTD); W.BM = (unsigned*)(ws + WS_BM);
    return W;
}
__global__ void __launch_bounds__(NTHREADS, 2) fwd(Params Punused) {
    extern __shared__ __attribute__((aligned(16))) unsigned char lds_raw[];
    LAS unsigned char* lds = (LAS unsigned char*)lds_raw;
    const int tid = threadIdx.x;
    const int G = gridDim.x, bid = blockIdx.x;
    const int gw = bid * NWAVES + (tid >> 6), nw = G * NWAVES;

    if (tid < 16) ((LAS unsigned*)(lds + LDS_MISC))[tid] = 0u;
    __syncthreads();
    int lo, hi; XcdBarrier bar;
    { const Params P = kargs(); lo = P.ph_lo; hi = P.ph_hi;
      bar.bar = (unsigned*)(P.ws + WS_CTL); bar.x = 0; bar.st = (volatile LAS unsigned*)(lds + LDS_MISC);
      if (hi - lo > 1) bar = xcd_barrier_post((unsigned*)(P.ws + WS_CTL), (volatile LAS unsigned*)(lds + LDS_MISC)); }
#ifdef PH_MASK
#define IN(k) (((PH_MASK >> (k)) & 1) && lo <= (k) && (k) < hi)
#else
#define IN(k) (lo <= (k) && (k) < hi)
#endif
#define SEAM(k) do { if (IN(k) && IN((k) + 1)) xcd_barrier(bar); } while (0)
#define PHASE_VARS const Params P = kargs(); const Ptrs W = mkptrs(P.ws); (void)W;
#define ATT_ARGS att::AttnArgs AA{W.Z, W.KC, W.VC, W.G, W.L, W.OACC, W.MIX, W.BM, W.TAB};

    if (IN(0)) { PHASE_VARS REP(0) { phase_prologue(P, W, lds); } SEAM(0); }
    if (IN(1)) {
        PHASE_VARS
        { pg8::GStd g{(const char*)W.XN, (const char*)W.Win, DM, DM, DM / 64}; pg8::StaticOrder S; S.init(S_ / 256, POOLW / 256, G, bid);
          pg8::EpiBf16 E{W.Z, LDZ}; pg8::gemm_phase(lds, g, S, E); }
        { pg8::GStd g{(const char*)(P.ws + WS_XN8), (const char*)(P.ws + WS_WIN8), DM / 2, DM / 2, DM / 128}; pg8::StaticOrder S; S.init(S_ / 256, (OFF_G - POOLW) / 256, G, bid);
          pg8::EpiBf16S E{W.Z + POOLW, LDZ, 1.0f / WG8_SCALE}; pg8::gemm_phase<pg8::GStd, pg8::EpiBf16S, true>(lds, g, S, E); }
        SEAM(1);
    }
    if (IN(2)) {
        PHASE_VARS
        if (G > 64) {
            if (bid < 32) { pg8::GCmp g{(const char*)W.Z, (const char*)W.Wc1k, (const char*)W.Wc1v, 16 * LDZ, 4096, 64}; pg8::StaticOrder S; S.init(32, 1, 32, bid);
                pg8::EpiCmpGelu E{W.H1, (const float*)(P.ws + WS_CBIAS)}; pg8::gemm_phase(lds, g, S, E); }
            else if (bid < 96) {
                pg8::GStd g{(const char*)W.XN, (const char*)(W.Win + (size_t)OFF_G * DM), DM, DM, DM / 64}; pg8::StaticOrder S; S.init(S_ / 256, 1, 64, bid - 32);
                pg8::EpiBf16 E{W.Z + OFF_G, LDZ}; pg8::gemm_phase(lds, g, S, E); }
            else phase_postz(P, W, (bid - 96) * NWAVES + (tid >> 6), (G - 96) * NWAVES);
        } else {
            { pg8::GStd g{(const char*)W.XN, (const char*)(W.Win + (size_t)OFF_G * DM), DM, DM, DM / 64}; pg8::StaticOrder S; S.init(S_ / 256, 1, G, bid);
              pg8::EpiBf16 E{W.Z + OFF_G, LDZ}; pg8::gemm_phase(lds, g, S, E); }
            { pg8::GCmp g{(const char*)W.Z, (const char*)W.Wc1k, (const char*)W.Wc1v, 16 * LDZ, 4096, 64}; pg8::StaticOrder S; S.init(32, 1, G, bid);
              pg8::EpiCmpGelu E{W.H1, (const float*)(P.ws + WS_CBIAS)}; pg8::gemm_phase(lds, g, S, E); }
            phase_postz(P, W, gw, nw);
        }
        SEAM(2);
    }
    if (IN(3)) {
        PHASE_VARS
        {
            const size_t i0 = (size_t)bid * NTHREADS + tid, st = (size_t)G * NTHREADS, NG = (size_t)S_ * NGATE;
            for (size_t ib = i0; ib < NG; ib += 9 * st) { float zv[9];
#pragma unroll
                for (int k = 0; k < 9; ++k) { size_t i = ib + k * st; if (i >= NG) i = NG - 1; const int t = (int)(i / NGATE), c = (int)(i % NGATE); zv[k] = bf2f(W.Z[(size_t)t * LDZ + OFF_G + c]); }
#pragma unroll
                for (int k = 0; k < 9; ++k) { const size_t i = ib + k * st; if (i < NG) W.G[i] = sigmoidf_(zv[k]); } } }
        phase_cmpfin(P, W);
        { pg8::GPool g{(const char*)W.M, (const char*)W.Wpool, POOLW, 256, 4}; pg8::StaticOrder S; S.init(S_ / 256, 4, G, bid);
          pg8::EpiBf16Scale E{W.MIX, DM, P.pool_scale}; pg8::gemm_phase(lds, g, S, E); }
        SEAM(3);
    }
    if (IN(4)) {
        PHASE_VARS ATT_ARGS
        if (G == 256) {
            for (int rnd = 0; rnd < 2; ++rnd) {
                const int x = bid & 7, r = bid >> 3, qp = rnd ? 63 - r : r, g = x & 3, qt = 2 * qp + (x >> 2);
                for (int uu = 0; uu < 2; ++uu) att::slc16_unit<2>(AA, (LAS char*)lds, 2 * qt + uu, g); }
            asm volatile("s_waitcnt vmcnt(0)" ::: "memory");
            __builtin_amdgcn_fence(__ATOMIC_RELEASE, "workgroup");
            __syncthreads();
            __builtin_amdgcn_fence(__ATOMIC_ACQUIRE, "workgroup");
            for (int rnd = 0; rnd < 2; ++rnd) {
                const int x = bid & 7, r = bid >> 3, qp = rnd ? 63 - r : r, g = x & 3, qt = 2 * qp + (x >> 2);
                const int tqi = qt * 8 + (tid >> 6);
                att::imp_task(AA, W.IMPP, W.IMPF, tqi, g);
                asm volatile("s_waitcnt vmcnt(0)" ::: "memory");
                f32x4 pp, ff, pn, fn; att::topk_load(W.IMPP, W.IMPF, tqi * 16, g, pp, ff);
                for (int q = 0; q < 16; ++q) { att::topk_load(W.IMPP, W.IMPF, tqi * 16 + (q < 15 ? q + 1 : q), g, pn, fn); att::topk_task(pp, ff, W.BM, tqi * 16 + q, g); pp = pn; ff = fn; } }
        } else {
            for (int base = 0, rnd = 0; base < 1536; base += G, ++rnd) {
                const int Lu = base + ((rnd & 1) ? G - 1 - bid : bid); if (Lu >= 1536) continue;
                const int qt = Lu / 12, rem = Lu % 12, g = rem / 3, hp = rem % 3;
                att::attn_unit<att::MODE_CMP>(AA, (LAS char*)lds, qt, g, hp); }
        }
        __builtin_amdgcn_s_setprio(0);
        for (int base = 0, rnd = 0; base < 1024 + G; base += G, ++rnd) {
            int ut, g;
            if (G == 256) { const int x = bid & 7, r = bid >> 3, k = rnd * 32 + r; if (k >= 128) break; g = x & 3; ut = 2 * k + (x >> 2); }
            else { const int Lu = base + bid; if (Lu >= 1024) continue; ut = Lu / 4; g = Lu % 4; }
            att::slc16_unit<1>(AA, (LAS char*)lds, ut, g); }
        if (G != 256) SEAM(4);
    }
    if (IN(5)) {
        PHASE_VARS ATT_ARGS
        if (G != 256)
        for (int k = gw, r = 0; k < 4096; k += nw, ++r) { const int hiT = (r + 1) * nw < 4096 ? (r + 1) * nw : 4096;
            const int task = (r & 1) ? hiT - 1 - (k - r * nw) : k;
            att::imp_task(AA, W.IMPP, W.IMPF, task >> 2, task & 3);
            asm volatile("s_waitcnt vmcnt(0)" ::: "memory");
            { const int tb = (task >> 2) * 16, gg = task & 3; f32x4 pp, ff, pn, fn;
              att::topk_load(W.IMPP, W.IMPF, tb, gg, pp, ff);
              for (int q = 0; q < 16; ++q) { att::topk_load(W.IMPP, W.IMPF, tb + (q < 15 ? q + 1 : q), gg, pn, fn); att::topk_task(pp, ff, W.BM, tb + q, gg); pp = pn; ff = fn; } } }
        SEAM(5);
    }
    if (IN(6)) {
        PHASE_VARS ATT_ARGS
#if SLC16
        for (int base = 0, rnd = 0; base < 1024 + G; base += G, ++rnd) {
            int ut, g;
            if (G == 256) { const int x = bid & 7, r = bid >> 3, k = rnd * 32 + ((rnd & 1) ? 31 - r : r); if (k >= 128) break; g = x & 3; ut = 255 - (2 * k + (x >> 2)); }
            else { const int Lu = base + ((rnd & 1) ? G - 1 - bid : bid); if (Lu >= 1024) continue; ut = 255 - Lu / 4; g = Lu % 4; }
            att::slc16_unit<0>(AA, (LAS char*)lds, ut, g); }
#else
        REP(6)
        for (int base = 0, rnd = 0; base < 1640 + G; base += G, ++rnd) {
            int ut, g;
            if (G == 256) { const int x = bid & 7, r = bid >> 3, k = rnd * 32 + ((rnd & 1) ? 31 - r : r); if (k >= 205) break; g = x & 3; ut = 409 - (2 * k + (x >> 2)); }
            else { const int Lu = base + ((rnd & 1) ? G - 1 - bid : bid); if (Lu >= 1640) continue; ut = 409 - Lu / 4; g = Lu % 4; }
            att::attn_unit<att::MODE_SLC>(AA, (LAS char*)lds, ut, g, 0); }
#endif
        SEAM(6);
    }
    if (IN(7)) {
        PHASE_VARS
        if (bid == 0) { bf16_t* hz = (bf16_t*)(P.ws + WS_HRES) - 2 * DM; for (int i = tid; i < 2 * DM / 8; i += NTHREADS) *(u32x4*)(hz + i * 8) = (u32x4){0u, 0u, 0u, 0u}; }
        { pg8::GStd g{(const char*)W.MIX, (const char*)W.Wo, DM, DM, POOLW / 64 + (DM - POOLW) / 128}; pg8::StaticOrder S; S.init(S_ / 256, DM / 256, G, bid);
          pg8::EpiResNorm E{P.x, (bf16_t*)(P.ws + WS_HRES), W.XN, P.norm2_w, (float*)(P.ws + WS_SSQ1), DM, 1.0f / 128.0f}; pg8::gemm_phase<pg8::GStd, pg8::EpiResNorm, false, POOLW / 64>(lds, g, S, E); }
        { pg8::GStd g{(const char*)W.PB, (const char*)W.Wple, PLE, PLE, PLE / 64}; pg8::StaticOrder S; S.init(S_ / 256, DM / 256, G, bid);
          pg8::EpiBf16Ssq E{W.ERAW, DM, (float*)(P.ws + WS_SSQ3)}; pg8::gemm_phase(lds, g, S, E); }
        SEAM(7);
    }
    if (IN(8)) {
        PHASE_VARS
        pg8::GFfn g{(const char*)(P.ws + WS_HRES), (const char*)W.Wfi, DM, DM, DM / 64}; pg8::StaticOrder S; S.init(65, DFF / 128, G, bid);
        pg8::EpiFfn E{W.ACT, P.conv_w, P.conv_b, (LAS float*)(lds + LDS_XCH), (const float*)(P.ws + WS_SSQ1)}; REP(8) { pg8::gemm_phase(lds, g, S, E); } SEAM(8);
    }
    if (IN(9)) {
        PHASE_VARS
        pg8::GStd g{(const char*)W.ACT, (const char*)W.Wfo, DFF, DFF, DFF / 64}; pg8::StaticOrder S; S.init(S_ / 256, DM / 256, G, bid);
        pg8::EpiResNormF8 E{P.ws + WS_HRES, (bf16_t*)(P.ws + WS_HRES), W.XN, P.ple_gate_norm_w, (float*)(P.ws + WS_SSQ2), DM}; pg8::gemm_phase(lds, g, S, E); SEAM(9);
    }
    if (IN(10)) {
        PHASE_VARS
        pg8::GStd g{(const char*)W.XN, (const char*)W.Wg, DM / 2, DM / 2, DM / 128}; pg8::StaticOrder S; S.init(S_ / 256, DM / 256, G, bid);
        pg8::EpiGate E{P.out, (const bf16_t*)(P.ws + WS_HRES), W.ERAW, (const float*)(P.ws + WS_SSQ3), P.ple_norm_w, (const float*)(P.ws + WS_SSQ2), DM, 1.0f / WG8_SCALE};
        pg8::gemm_phase<pg8::GStd, pg8::EpiGate, true>(lds, g, S, E);
    }
#undef IN
#undef SEAM
}

extern "C" void kernel_launch(void* const* d_in, const int* in_sizes, int n_in, void* d_out, int out_size, void* d_ws, size_t ws_size, hipStream_t stream) {
    static int grid = 0;
    if (grid == 0) {
        if (n_in != 27 || in_sizes[0] != S_ * DM || out_size != S_ * DM || ws_size < WS_NEED) {
            fprintf(stderr, "kernel_launch: unexpected shapes (n_in %d, in0 %d, out %d, ws %zu < %zu); nothing launched\n", n_in, n_in > 0 ? in_sizes[0] : -1, out_size, ws_size, (size_t)WS_NEED); grid = -1; return; }
        int dev = 0, cus = 0, per_cu = 0;
        if (hipGetDevice(&dev) != hipSuccess || hipDeviceGetAttribute(&cus, hipDeviceAttributeMultiprocessorCount, dev) != hipSuccess) { grid = -1; return; }
        if (hipFuncSetAttribute((const void*)fwd, hipFuncAttributeMaxDynamicSharedMemorySize, LDS_BYTES) != hipSuccess) { fprintf(stderr, "kernel_launch: hipFuncSetAttribute failed\n"); grid = -1; return; }
        if (hipOccupancyMaxActiveBlocksPerMultiprocessor(&per_cu, (const void*)fwd, NTHREADS, LDS_BYTES) != hipSuccess || per_cu < 1) { fprintf(stderr, "kernel_launch: occupancy query says %d\n", per_cu); (void)hipGetLastError(); }
        grid = cus > 256 ? 256 : cus;
    }
    if (grid < 0) return;
    (void)hipMemsetAsync((char*)d_ws + WS_CTL, 0, CTL_BYTES, stream);
    Params P{};
    const float** fp = (const float**)&P;
    P.x = (const float*)d_in[0]; P.p = (const float*)d_in[1]; P.positions = (const int*)d_in[2]; P.norm1_w = (const float*)d_in[3]; P.w_in = (const float*)d_in[4];
    P.w_pool = (const float*)d_in[5]; P.pool_scale = (const float*)d_in[6]; P.q_norm_w = (const float*)d_in[7]; P.k_norm_cmp_w = (const float*)d_in[8];
    P.k_norm_slc_w = (const float*)d_in[9]; P.k_norm_win_w = (const float*)d_in[10]; P.cmp_pos_k = (const float*)d_in[11]; P.cmp_pos_v = (const float*)d_in[12];
    P.cmp_k_w1 = (const float*)d_in[13]; P.cmp_k_w2 = (const float*)d_in[14]; P.cmp_v_w1 = (const float*)d_in[15]; P.cmp_v_w2 = (const float*)d_in[16];
    P.w_o = (const float*)d_in[17]; P.norm2_w = (const float*)d_in[18]; P.w_ffn_in = (const float*)d_in[19]; P.conv_w = (const float*)d_in[20]; P.conv_b = (const float*)d_in[21];
    P.w_ffn_out = (const float*)d_in[22]; P.w_ple_proj = (const float*)d_in[23]; P.ple_norm_w = (const float*)d_in[24]; P.ple_gate_norm_w = (const float*)d_in[25]; P.w_ple_gate = (const float*)d_in[26];
    (void)fp;
    P.out = (float*)d_out; P.ws = (unsigned char*)d_ws;
#if MK_ONE_LAUNCH
    P.ph_lo = 0; P.ph_hi = N_PHASES;
    hipLaunchKernelGGL(fwd, dim3(grid), dim3(NTHREADS), LDS_BYTES, stream, P);
#else
    for (int ph = 0; ph < N_PHASES; ++ph) { P.ph_lo = ph; P.ph_hi = ph + 1; hipLaunchKernelGGL(fwd, dim3(grid), dim3(NTHREADS), LDS_BYTES, stream, P); }
#endif
    const hipError_t le = hipPeekAtLastError();
    if (le != hipSuccess) fprintf(stderr, "kernel_launch: launch failed: %s\n", hipGetErrorName(le));
}
```
